# Optimizing an MI355X kernel written in HIP

```python
import jax
import jax.numpy as jnp
from jax import lax
import numpy as np

D_MODEL = 1024
BATCH = 1
SEQ = 16384
DEPTH = 2

HEAD_DIM = 64
N_HEADS_A = 8
WIDTH_A = N_HEADS_A * HEAD_DIM
DILATION_PATTERNS = ((128, 1), (512, 4), (2048, 16))
ROPE_DIM = HEAD_DIM // 4
ROPE_THETA = 500000.0
N_HEADS_B = 8
WIDTH_B = N_HEADS_B * HEAD_DIM
DECAY_LORA = 64
ICLR_LORA = 64
GATE_LORA = 128
RWKV_LN_EPS = 64e-5
WIDTH_C = 512
CONV_WIDTH = 3
N_HEADS_D = 4
HEAD_DIM_D = 128
WIDTH_D = N_HEADS_D * HEAD_DIM_D
DN_CHUNK = 64
D_FF_DENSE = 2816
N_EXPERTS = 8
TOP_K = 2
D_FF_EXPERT = 3584
EVEN_IN = 3 * WIDTH_A + 3 * WIDTH_B
ODD_SPLITS = (WIDTH_C, 2 * WIDTH_C, 3 * WIDTH_C, 3 * WIDTH_C + 3 * WIDTH_D, 3 * WIDTH_C + 4 * WIDTH_D, 3 * WIDTH_C + 4 * WIDTH_D + 2 * N_HEADS_D)
ODD_IN = ODD_SPLITS[-1] + 2 * N_HEADS_D
NORM_EPS = 1e-6
NEG_INF = -1e30

kernel_name = "hybrid_dilated_rwkv7_conv_deltanet_moe"


def rmsnorm(x, w, eps=NORM_EPS):
    xf = x.astype(jnp.float32)
    y = xf * lax.rsqrt(jnp.mean(xf * xf, axis=-1, keepdims=True) + eps)
    return (y * w.astype(jnp.float32)).astype(x.dtype)


def l2norm(x, eps=1e-6):
    xf = x.astype(jnp.float32)
    return (xf * lax.rsqrt(jnp.sum(xf * xf, axis=-1, keepdims=True) + eps)).astype(x.dtype)


def shift_prev(t):
    return jnp.pad(t, ((0, 0), (1, 0), (0, 0)))[:, :-1]


def shift_next(t):
    return jnp.pad(t, ((0, 0), (0, 1), (0, 0)))[:, 1:]


def conv3_centred(t, w):
    return w[0] * shift_prev(t) + w[1] * t + w[2] * shift_next(t)


def both(t, seq_axis):
    return jnp.stack([t, jnp.flip(t, axis=seq_axis)])


def orient(t, seq_axis):
    return jnp.stack([t[0], jnp.flip(t[1], axis=seq_axis)])


def unorient(t, seq_axis):
    return t[0] + jnp.flip(t[1], axis=seq_axis)


def swiglu(h, w_gate, w_up, w_down):
    return (jax.nn.silu(h @ w_gate) * (h @ w_up)) @ w_down


def partial_rope(t, positions):
    half = ROPE_DIM // 2
    inv_freq = jnp.power(ROPE_THETA, -jnp.arange(half, dtype=jnp.float32) / half)
    ang = positions[:, None, :, None].astype(jnp.float32) * inv_freq
    cos, sin = jnp.cos(ang), jnp.sin(ang)
    tf = t[..., :ROPE_DIM].astype(jnp.float32)
    x1, x2 = tf[..., :half], tf[..., half:]
    rot = jnp.concatenate([x1 * cos - x2 * sin, x2 * cos + x1 * sin], axis=-1)
    return jnp.concatenate([rot.astype(t.dtype), t[..., ROPE_DIM:]], axis=-1)


def banded_attention(q, k, v, radius):
    Bb, H, R, L, Dh = q.shape
    blk = radius
    nb = -(-L // blk)
    pad = nb * blk - L
    cfg = lambda lo, hi: ((0, 0), (0, 0), (0, 0), (lo, hi), (0, 0))
    qb = jnp.pad(q, cfg(0, pad)).reshape(Bb, H, R, nb, blk, Dh)

    def windows(t):
        tp = jnp.pad(t, cfg(blk, blk + pad)).reshape(Bb, H, R, nb + 2, blk, Dh)
        return jnp.concatenate([tp[:, :, :, :-2], tp[:, :, :, 1:-1], tp[:, :, :, 2:]], axis=-2)

    kw, vw = windows(k), windows(v)
    s = jnp.einsum('bhrnid,bhrnjd->bhrnij', qb, kw).astype(jnp.float32)
    qi = (jnp.arange(nb)[:, None] * blk + jnp.arange(blk)[None, :])[:, :, None]
    kj = (jnp.arange(nb)[:, None] * blk - blk + jnp.arange(3 * blk)[None, :])[:, None, :]
    valid = (jnp.abs(qi - kj) <= radius) & (kj >= 0) & (kj < L)
    s = jnp.where(valid, s, NEG_INF)
    m = jnp.max(s, axis=-1)
    p = jnp.exp(s - m[..., None])
    l = jnp.sum(p, axis=-1)
    acc = jnp.einsum('bhrnij,bhrnjd->bhrnid', p, vw.astype(jnp.float32))
    m = m.reshape(Bb, H, R, nb * blk)[..., :L]
    l = l.reshape(Bb, H, R, nb * blk)[..., :L]
    acc = acc.reshape(Bb, H, R, nb * blk, Dh)[..., :L, :]
    return m, l, acc


def dilated_branch(q, k, v, window, dilation):
    Bb, H, S, Dh = q.shape
    radius = window // (2 * dilation)
    L = S // dilation
    to_sub = lambda t: t.reshape(Bb, H, L, dilation, Dh).transpose(0, 1, 3, 2, 4)
    m, l, acc = banded_attention(to_sub(q), to_sub(k), to_sub(v), radius)
    m = m.transpose(0, 1, 3, 2).reshape(Bb, H, S)
    l = l.transpose(0, 1, 3, 2).reshape(Bb, H, S)
    acc = acc.transpose(0, 1, 3, 2, 4).reshape(Bb, H, S, Dh)
    return m, l, acc


def dilated_attention(q, k, v):
    branches = [dilated_branch(q, k, v, w, d) for (w, d) in DILATION_PATTERNS]
    m_all = branches[0][0]
    for m, _, _ in branches[1:]:
        m_all = jnp.maximum(m_all, m)
    num = jnp.zeros(q.shape, jnp.float32)
    den = jnp.zeros(q.shape[:-1], jnp.float32)
    for m, l, acc in branches:
        scale = jnp.exp(m - m_all)
        num = num + scale[..., None] * acc
        den = den + scale * l
    return (num / den[..., None]).astype(q.dtype)


def rwkv7_bidir_scan(r, w, k, a, b, v):
    Z, Bb, S, H, N = r.shape
    xs = tuple(jnp.moveaxis(t.astype(jnp.float32), 2, 0) for t in (r, w, k, a, b, v))
    state0 = jnp.zeros((Z, Bb, H, N, N), jnp.float32)

    def step(state, inp):
        rt, wt, kt, at, bt, vt = inp
        sa = jnp.einsum('zbhvk,zbhk->zbhv', state, at)
        state = state * wt[..., None, :] + sa[..., None] * bt[..., None, :] + vt[..., None] * kt[..., None, :]
        return state, jnp.einsum('zbhvk,zbhk->zbhv', state, rt)

    _, ys = lax.scan(step, state0, xs)
    return jnp.moveaxis(ys, 0, 2)


def rwkv7_mixer(h, rkv, shift_mu, lora_mu, w0, w1, w2, a0, a1, a2, g1, g2, k_k, k_a, r_k, ln_w, ln_b):
    Bb, S, _ = h.shape
    rkv = rkv + shift_mu[0] * (shift_prev(rkv) - rkv) + shift_mu[1] * (shift_next(rkv) - rkv)
    r, k, v = jnp.split(rkv, 3, axis=-1)
    hx = h + lora_mu[0] * (shift_prev(h) - h) + lora_mu[1] * (shift_next(h) - h)
    w_pre = w0[:, None, None, :] + jnp.einsum('zbsr,zrc->zbsc', jnp.tanh(jnp.einsum('bsd,zdr->zbsr', hx, w1)), w2)
    decay = jnp.exp(-jnp.exp(-jax.nn.softplus(-w_pre.astype(jnp.float32)) - 0.5))
    iclr = jax.nn.sigmoid(a0[:, None, None, :] + jnp.einsum('zbsr,zrc->zbsc', jnp.einsum('bsd,zdr->zbsr', hx, a1), a2))
    gate = jax.nn.sigmoid(hx @ g1) @ g2
    heads = lambda t: t.reshape(*t.shape[:-1], N_HEADS_B, HEAD_DIM)
    kk = l2norm(heads(k * k_k))
    k_dir = heads(k[None] * (1.0 + (iclr - 1.0) * k_a))
    r_h, v_h = heads(r), heads(v)
    b_vec = kk[None] * heads(iclr)
    a_vec = jnp.broadcast_to(-kk[None], b_vec.shape)
    ys = rwkv7_bidir_scan(both(r_h, 1), orient(heads(decay), 1), orient(k_dir, 1), orient(a_vec, 1), orient(b_vec, 1), both(v_h, 1))
    yf = unorient(ys, 1)
    mu = jnp.mean(yf, axis=-1, keepdims=True)
    var = jnp.mean(jnp.square(yf - mu), axis=-1, keepdims=True)
    yn = ((yf - mu) * lax.rsqrt(var + RWKV_LN_EPS)).reshape(Bb, S, WIDTH_B) * ln_w + ln_b
    bonus = (jnp.sum(r_h * (k_dir[0] + k_dir[1]) * r_k, axis=-1, keepdims=True) * v_h).reshape(Bb, S, WIDTH_B)
    return ((yn + bonus) * gate).astype(h.dtype)


def even_mixer(h, positions, w_in, q_norm, k_norm, shift_mu, lora_mu, w0, w1, w2, a0, a1, a2, g1, g2, k_k, k_a, r_k, ln_w, ln_b, w_out):
    Bb, S, _ = h.shape
    proj = h @ w_in
    a_qkv, b_rkv = proj[..., :3 * WIDTH_A], proj[..., 3 * WIDTH_A:]
    q, k, v = (t.reshape(Bb, S, N_HEADS_A, HEAD_DIM).transpose(0, 2, 1, 3) for t in jnp.split(a_qkv, 3, axis=-1))
    q = partial_rope(rmsnorm(q, q_norm), positions) * HEAD_DIM ** -0.5
    k = partial_rope(rmsnorm(k, k_norm), positions)
    y_a = dilated_attention(q, k, v).transpose(0, 2, 1, 3).reshape(Bb, S, WIDTH_A)
    y_b = rwkv7_mixer(h, b_rkv, shift_mu, lora_mu, w0, w1, w2, a0, a1, a2, g1, g2, k_k, k_a, r_k, ln_w, ln_b)
    return jnp.concatenate([y_a, y_b], axis=-1) @ w_out


def chunk_gated_delta_rule(q, k, v, g, beta):
    out_dtype = v.dtype
    q, k, v, g, beta = (t.astype(jnp.float32) for t in (q, k, v, g, beta))
    Z, Bb, H, T, Dk = q.shape
    Dv = v.shape[-1]
    C = DN_CHUNK
    n = T // C
    q = q.reshape(Z, Bb, H, n, C, Dk)
    k = k.reshape(Z, Bb, H, n, C, Dk)
    v = v.reshape(Z, Bb, H, n, C, Dv)
    g = g.reshape(Z, Bb, H, n, C)
    beta = beta.reshape(Z, Bb, H, n, C)
    gc = jnp.cumsum(g, axis=-1)
    incl = jnp.tril(jnp.ones((C, C), bool))
    strict = jnp.tril(jnp.ones((C, C), bool), -1)
    diff = gc[..., :, None] - gc[..., None, :]
    decay = jnp.where(incl, jnp.exp(jnp.where(incl, diff, 0.0)), 0.0)
    kb = k * beta[..., None]
    lhs = jnp.where(strict, jnp.einsum('zbhnid,zbhnjd->zbhnij', kb, k) * decay, 0.0) + jnp.eye(C, dtype=jnp.float32)
    u_base = lax.linalg.triangular_solve(lhs, v * beta[..., None], left_side=True, lower=True, unit_diagonal=True)
    k_cum = lax.linalg.triangular_solve(lhs, kb * jnp.exp(gc)[..., None], left_side=True, lower=True, unit_diagonal=True)
    attn = jnp.einsum('zbhnid,zbhnjd->zbhnij', q, k) * decay
    xs = tuple(jnp.moveaxis(t, 3, 0) for t in (q, k, gc, u_base, k_cum, attn))

    def step(state, inp):
        qc, kc, gcc, ub, kcm, at = inp
        u = ub - jnp.einsum('zbhcd,zbhdv->zbhcv', kcm, state)
        o = jnp.einsum('zbhcd,zbhdv->zbhcv', qc * jnp.exp(gcc)[..., None], state) + jnp.einsum('zbhij,zbhjv->zbhiv', at, u)
        glast = gcc[..., -1]
        state = state * jnp.exp(glast)[..., None, None] + jnp.einsum('zbhcd,zbhcv->zbhdv', kc * jnp.exp(glast[..., None] - gcc)[..., None], u)
        return state, o

    state0 = jnp.zeros((Z, Bb, H, Dk, Dv), jnp.float32)
    _, o = lax.scan(step, state0, xs)
    return jnp.moveaxis(o, 0, 3).reshape(Z, Bb, H, T, Dv).astype(out_dtype)


def odd_mixer(h, w_in, conv_c, conv_dn, A_log, dt_bias, dn_norm, w_out):
    Bb, S, _ = h.shape
    c_b, c_c, c_x, dn_qkv, dn_z, dn_beta, dn_alpha = jnp.split(h @ w_in, ODD_SPLITS, axis=-1)
    y_c = c_b * conv3_centred(c_c * c_x, conv_c)
    qkv = jax.nn.silu(conv3_centred(dn_qkv, conv_dn))
    q, k, v = (t.reshape(Bb, S, N_HEADS_D, HEAD_DIM_D).transpose(0, 2, 1, 3) for t in jnp.split(qkv, 3, axis=-1))
    q = l2norm(q) * HEAD_DIM_D ** -0.5
    k = l2norm(k)
    beta = jax.nn.sigmoid(dn_beta).reshape(Bb, S, 2, N_HEADS_D).transpose(2, 0, 3, 1)
    alpha = dn_alpha.reshape(Bb, S, 2, N_HEADS_D).transpose(2, 0, 3, 1).astype(jnp.float32)
    g = -jnp.exp(A_log.astype(jnp.float32))[:, None, :, None] * jax.nn.softplus(alpha + dt_bias[:, None, :, None])
    o = chunk_gated_delta_rule(both(q, 2), both(k, 2), both(v, 2), orient(g, 2), orient(beta, 2))
    o = unorient(o, 2).transpose(0, 2, 1, 3)
    y_d = (rmsnorm(o, dn_norm) * jax.nn.silu(dn_z.reshape(Bb, S, N_HEADS_D, HEAD_DIM_D))).reshape(Bb, S, WIDTH_D)
    return jnp.concatenate([y_c, y_d], axis=-1) @ w_out


def moe_swiglu(h, router, w_gate, w_up, w_down):
    logits = (h @ router).astype(jnp.float32)
    probs = jax.nn.softmax(logits, axis=-1)
    top_p, top_i = lax.top_k(probs, TOP_K)
    top_p = top_p / jnp.sum(top_p, axis=-1, keepdims=True)
    gates = jnp.einsum('bsk,bske->bse', top_p, jax.nn.one_hot(top_i, N_EXPERTS, dtype=jnp.float32)).astype(h.dtype)
    out = jnp.zeros_like(h)
    for e in range(N_EXPERTS):
        out = out + gates[..., e:e + 1] * swiglu(h, w_gate[e], w_up[e], w_down[e])
    return out


def setup_inputs(seed: int = 0) -> dict:
    key = jax.random.key(seed)
    ks = iter(jax.random.split(key, 64))
    ne, no = (DEPTH + 1) // 2, DEPTH // 2
    D = D_MODEL

    def nrm(shape, scale):
        return scale * jax.random.normal(next(ks), shape, jnp.float32)

    def gain(shape):
        return 1.0 + 0.05 * jax.random.normal(next(ks), shape, jnp.float32)

    def unif(shape, lo, hi):
        return jax.random.uniform(next(ks), shape, jnp.float32, lo, hi)

    return {
        "x": nrm((BATCH, SEQ, D), 1.0),
        "positions": jnp.broadcast_to(jnp.arange(SEQ, dtype=jnp.int32), (BATCH, SEQ)),
        "ev_mix_norm": gain((ne, D)),
        "ev_w_in": nrm((ne, D, EVEN_IN), D ** -0.5),
        "ev_q_norm": gain((ne, HEAD_DIM)),
        "ev_k_norm": gain((ne, HEAD_DIM)),
        "ev_shift_mu": unif((ne, 2, 3 * WIDTH_B), 0.0, 0.5),
        "ev_lora_mu": unif((ne, 2, D), 0.0, 0.5),
        "ev_w0": unif((ne, 2, WIDTH_B), -4.0, 1.0),
        "ev_w1": nrm((ne, 2, D, DECAY_LORA), D ** -0.5),
        "ev_w2": nrm((ne, 2, DECAY_LORA, WIDTH_B), 0.5 * DECAY_LORA ** -0.5),
        "ev_a0": nrm((ne, 2, WIDTH_B), 0.5),
        "ev_a1": nrm((ne, 2, D, ICLR_LORA), D ** -0.5),
        "ev_a2": nrm((ne, 2, ICLR_LORA, WIDTH_B), 0.5 * ICLR_LORA ** -0.5),
        "ev_g1": nrm((ne, D, GATE_LORA), D ** -0.5),
        "ev_g2": nrm((ne, GATE_LORA, WIDTH_B), GATE_LORA ** -0.5),
        "ev_k_k": gain((ne, WIDTH_B)),
        "ev_k_a": gain((ne, WIDTH_B)),
        "ev_r_k": nrm((ne, N_HEADS_B, HEAD_DIM), 0.1),
        "ev_ln_w": gain((ne, WIDTH_B)),
        "ev_ln_b": nrm((ne, WIDTH_B), 0.02),
        "ev_w_out": nrm((ne, WIDTH_A + WIDTH_B, D), (WIDTH_A + WIDTH_B) ** -0.5),
        "ev_ffn_norm": gain((ne, D)),
        "ev_ffn_gate": nrm((ne, D, D_FF_DENSE), D ** -0.5),
        "ev_ffn_up": nrm((ne, D, D_FF_DENSE), D ** -0.5),
        "ev_ffn_down": nrm((ne, D_FF_DENSE, D), D_FF_DENSE ** -0.5),
        "od_mix_norm": gain((no, D)),
        "od_w_in": nrm((no, D, ODD_IN), D ** -0.5),
        "od_conv_c": nrm((no, CONV_WIDTH, WIDTH_C), CONV_WIDTH ** -0.5),
        "od_conv_dn": nrm((no, CONV_WIDTH, 3 * WIDTH_D), CONV_WIDTH ** -0.5),
        "od_A_log": jnp.log(unif((no, 2, N_HEADS_D), 1.0, 16.0)),
        "od_dt_bias": jnp.log(jnp.expm1(unif((no, 2, N_HEADS_D), 0.001, 0.1))),
        "od_dn_norm": gain((no, HEAD_DIM_D)),
        "od_w_out": nrm((no, WIDTH_C + WIDTH_D, D), (WIDTH_C + WIDTH_D) ** -0.5),
        "od_ffn_norm": gain((no, D)),
        "od_router": nrm((no, D, N_EXPERTS), D ** -0.5),
        "od_moe_gate": nrm((no, N_EXPERTS, D, D_FF_EXPERT), D ** -0.5),
        "od_moe_up": nrm((no, N_EXPERTS, D, D_FF_EXPERT), D ** -0.5),
        "od_moe_down": nrm((no, N_EXPERTS, D_FF_EXPERT, D), D_FF_EXPERT ** -0.5),
    }


def reference(x, positions, ev_mix_norm, ev_w_in, ev_q_norm, ev_k_norm, ev_shift_mu, ev_lora_mu, ev_w0, ev_w1, ev_w2, ev_a0, ev_a1, ev_a2, ev_g1, ev_g2, ev_k_k, ev_k_a, ev_r_k, ev_ln_w, ev_ln_b, ev_w_out, ev_ffn_norm, ev_ffn_gate, ev_ffn_up, ev_ffn_down, od_mix_norm, od_w_in, od_conv_c, od_conv_dn, od_A_log, od_dt_bias, od_dn_norm, od_w_out, od_ffn_norm, od_router, od_moe_gate, od_moe_up, od_moe_down):
    for layer in range(DEPTH):
        i = layer // 2
        if layer % 2 == 0:
            h = rmsnorm(x, ev_mix_norm[i])
            x = x + even_mixer(h, positions, ev_w_in[i], ev_q_norm[i], ev_k_norm[i], ev_shift_mu[i], ev_lora_mu[i], ev_w0[i], ev_w1[i], ev_w2[i], ev_a0[i], ev_a1[i], ev_a2[i], ev_g1[i], ev_g2[i], ev_k_k[i], ev_k_a[i], ev_r_k[i], ev_ln_w[i], ev_ln_b[i], ev_w_out[i])
            h = rmsnorm(x, ev_ffn_norm[i])
            x = x + swiglu(h, ev_ffn_gate[i], ev_ffn_up[i], ev_ffn_down[i])
        else:
            h = rmsnorm(x, od_mix_norm[i])
            x = x + odd_mixer(h, od_w_in[i], od_conv_c[i], od_conv_dn[i], od_A_log[i], od_dt_bias[i], od_dn_norm[i], od_w_out[i])
            h = rmsnorm(x, od_ffn_norm[i])
            x = x + moe_swiglu(h, od_router[i], od_moe_gate[i], od_moe_up[i], od_moe_down[i])
    return x
```

```cpp
#include <hip/hip_runtime.h>
#include <cstdio>
#include <cstdint>
namespace pg8 {
#define PG8_LAS __attribute__((address_space(3)))
typedef unsigned short bf16_t;
typedef short bf16x8 __attribute__((ext_vector_type(8)));
typedef float f32x4 __attribute__((ext_vector_type(4)));
typedef unsigned u32x4 __attribute__((ext_vector_type(4)));
constexpr int BM = 256, BK = 64, HALF = 128, HTB = HALF * BK * 2  , STAGE_BYTES = 8 * HTB, NXCD = 8, WGM = 8;

__host__ __device__ __forceinline__ int lds_byte(int r, int c) { const int st = (r >> 4) * 2 + (c >> 5), rr = r & 15, cc = c & 31, ob = rr * 64 + cc * 2; return st * 1024 + (ob ^ (((ob >> 9) & 1) << 5)); }
__host__ __device__ __forceinline__ void stage_rc(int b, int& R, int& C) { const int st = b / 1024, sb = b % 1024, swz = sb ^ (((sb >> 9) & 1) << 5); R = (st >> 1) * 16 + swz / 64; C = (st & 1) * 32 + (swz % 64) / 2; }
__host__ __device__ __forceinline__ int perm32(int rho) { const int n = rho >> 4, i = rho & 15; return 8 * (i >> 2) + 4 * n + (i & 3); }

struct Unit { int pm, pn; };
struct Gemm { const bf16_t* A; const bf16_t* Bt; int M, N, K; };

struct StaticOrder {
    int nM, nN, nwg, G, c;
    __host__ __device__ void init(int M, int N, int G_, int c_) { nM = M / BM; nN = N / BM; nwg = nM * nN; G = G_; c = c_; }
    __host__ __device__ bool next(int i, Unit& u) const {
        const long L = (long)i * G + c; if (L >= nwg) return false;
        int wgid = (int)L; { const int q = nwg / NXCD, r = nwg % NXCD, xcd = wgid % NXCD, off = wgid / NXCD; wgid = (xcd < r ? xcd * (q + 1) : r * (q + 1) + (xcd - r) * q) + off; }
        const int nig = WGM * nN, gid = wgid / nig, fm = gid * WGM, gsz = (nM - fm) < WGM ? (nM - fm) : WGM;
        u.pm = fm + ((wgid % nig) % gsz); u.pn = (wgid % nig) / gsz; return true;
    }
    __device__ __forceinline__ void a_ready(const Unit&) const {}
    __device__ __forceinline__ void done(const Unit&) const {}
};

__device__ __forceinline__ unsigned cvt_pk_bf16(float lo, float hi) { unsigned r; asm volatile("v_cvt_pk_bf16_f32 %0, %1, %2" : "=v"(r) : "v"(lo), "v"(hi)); return r; }
struct EpiStoreBf16 {
    static constexpr bool PERM = true, AFTER_DRAIN = false;
    bf16_t* O; int ldc; int ntn;
    __device__ __forceinline__ void operator()(const f32x4 (&acc)[2][2][4][2], const Unit& u, int wr, int wc, int fr, int fq) const {
        const int row0 = u.pm * BM + wr * 64 + fr; const int pn = ntn ? (u.pn % ntn) : u.pn;
        const int col0 = pn * BM + wc * 32 + 8 * fq;
#pragma unroll
        for (int ai = 0; ai < 2; ++ai)
#pragma unroll
            for (int m = 0; m < 4; ++m) { bf16_t* rowp = O + (size_t)(row0 + ai * HALF + m * 16) * ldc + col0;
#pragma unroll
                for (int bj = 0; bj < 2; ++bj) { const f32x4 v0 = acc[ai][bj][m][0], v1 = acc[ai][bj][m][1];
                    u32x4 w; w.x = cvt_pk_bf16(v0[0], v0[1]); w.y = cvt_pk_bf16(v0[2], v0[3]); w.z = cvt_pk_bf16(v1[0], v1[1]); w.w = cvt_pk_bf16(v1[2], v1[3]);
                    *(u32x4*)(rowp + bj * HALF) = w; } }
    }
};
struct EpiResF32 {
    static constexpr bool PERM = false, AFTER_DRAIN = false;
    const float* base; float* out; int ldc;
    __device__ __forceinline__ void operator()(const f32x4 (&acc)[2][2][4][2], const Unit& u, int wr, int wc, int fr, int fq) const {
        const int row0 = u.pm * BM + wr * 64 + fr, col0 = u.pn * BM + wc * 32 + 4 * fq;
#pragma unroll
        for (int ai = 0; ai < 2; ++ai)
#pragma unroll
            for (int m = 0; m < 4; ++m) { const size_t off = (size_t)(row0 + ai * HALF + m * 16) * ldc + col0;
#pragma unroll
                for (int bj = 0; bj < 2; ++bj)
#pragma unroll
                    for (int n = 0; n < 2; ++n) { const f32x4 b = *(const f32x4*)(base + off + bj * HALF + n * 16); *(f32x4*)(out + off + bj * HALF + n * 16) = b + acc[ai][bj][m][n]; } }
    }
};
struct EpiSwiGLU {
    static constexpr bool PERM = true, AFTER_DRAIN = false;
    bf16_t* O; int ldc; int ntn;
    __device__ __forceinline__ void operator()(const f32x4 (&acc)[2][2][4][2], const Unit& u, int wr, int wc, int fr, int fq) const {
        const int row0 = u.pm * BM + wr * 64 + fr; const int pn = ntn ? (u.pn % ntn) : u.pn;
        const int col0 = pn * HALF + wc * 32 + 8 * fq;
#pragma unroll
        for (int ai = 0; ai < 2; ++ai)
#pragma unroll
            for (int m = 0; m < 4; ++m) { bf16_t* rowp = O + (size_t)(row0 + ai * HALF + m * 16) * ldc + col0;
                float r[8];
#pragma unroll
                for (int n = 0; n < 2; ++n)
#pragma unroll
                    for (int i = 0; i < 4; ++i) { const float g = acc[ai][0][m][n][i], up = acc[ai][1][m][n][i]; r[n * 4 + i] = g * __builtin_amdgcn_rcpf(1.0f + __expf(-g)) * up; }
                u32x4 w; w.x = cvt_pk_bf16(r[0], r[1]); w.y = cvt_pk_bf16(r[2], r[3]); w.z = cvt_pk_bf16(r[4], r[5]); w.w = cvt_pk_bf16(r[6], r[7]);
                *(u32x4*)rowp = w; }
    }
};
struct MoeOrder {
    const int* tile_exp; int tlo, nt, nN, G, c;
    __device__ __forceinline__ bool next(int i, Unit& u) const {
        const int L = i * G + c; if (nt <= 0 || L >= nt * nN) return false;
        const int t = tlo + (L % nt), cn = L / nt;
        const int e = __builtin_amdgcn_readfirstlane(__hip_atomic_load(tile_exp + t, __ATOMIC_RELAXED, __HIP_MEMORY_SCOPE_AGENT));
        u.pm = t; u.pn = e * nN + cn; return true;
    }
    __device__ __forceinline__ void a_ready(const Unit&) const {}
    __device__ __forceinline__ void done(const Unit&) const {}
};
template <class Epi, class Sched, bool ALIGN_EPI = false, bool SP2 = false>
__device__ __forceinline__ void gemm_phase(PG8_LAS unsigned char* lds, const Gemm g, const Sched& S, const Epi& E) {
    int tid_ = threadIdx.x; asm volatile("" : "+v"(tid_));
    const int tid = tid_, wid = __builtin_amdgcn_readfirstlane(tid >> 6), lane = tid & 63, wr = wid >> 2, wc = wid & 3, fr = lane & 15, fq = lane >> 4;
    const int K = g.K, nt = K / BK;
    unsigned voffA[2], voffB[2];
#pragma unroll
    for (int i = 0; i < 2; ++i) { int R, C; stage_rc(tid * 16 + i * 8192, R, C); const int Rb = Epi::PERM ? ((R & ~31) + perm32(R & 31)) : R;
        voffA[i] = (unsigned)(R * K + C) * 2u; voffB[i] = (unsigned)(Rb * K + C) * 2u; }
    const size_t kstep = (size_t)(BK * 2);
    const size_t hstep = (size_t)HALF * K * 2;
    const size_t tstep = 2 * hstep;
    const unsigned ldsw = (unsigned)wid * 1024u;
    const int aoff = lds_byte(wr * 64 + fr, fq * 8), boff = lds_byte(wc * 32 + fr, fq * 8);
#define PG8_SA(b, h) (((b) * 2 + (h)) * HTB)
#define PG8_SB(b, h) ((4 + (b) * 2 + (h)) * HTB)
#define PG8_STAGE(bufoff, gbase, voff) do { _Pragma("unroll") for (int _i = 0; _i < 2; ++_i) \
        __builtin_amdgcn_global_load_lds((const unsigned*)((const char*)(gbase) + (voff)[_i]), (PG8_LAS unsigned*)(lds + (bufoff) + ldsw + _i * 8192), 16, 0, 0); } while (0)
#define PG8_LDA(dst, b, h) do { _Pragma("unroll") for (int m = 0; m < 4; ++m) _Pragma("unroll") for (int k = 0; k < 2; ++k) dst[m][k] = *(const PG8_LAS bf16x8*)(lds + PG8_SA(b, h) + aoff + m * 2048 + k * 1024); } while (0)
#define PG8_LDB(dst, b, h) do { _Pragma("unroll") for (int n = 0; n < 2; ++n) _Pragma("unroll") for (int k = 0; k < 2; ++k) dst[n][k] = *(const PG8_LAS bf16x8*)(lds + PG8_SB(b, h) + boff + n * 2048 + k * 1024); } while (0)
#define PG8_MMA(ai, bj, At, Bt) do { __builtin_amdgcn_s_setprio(1); _Pragma("unroll") for (int m = 0; m < 4; ++m) _Pragma("unroll") for (int n = 0; n < 2; ++n) _Pragma("unroll") for (int k = 0; k < 2; ++k) \
        acc[ai][bj][m][n] = __builtin_amdgcn_mfma_f32_16x16x32_bf16(Bt[n][k], At[m][k], acc[ai][bj][m][n], 0, 0, 0); __builtin_amdgcn_s_setprio(0); } while (0)
#define PG8_WAIT_V(n) asm volatile("s_waitcnt vmcnt(" #n ")" ::: "memory")
#define PG8_WAIT_L(n) asm volatile("s_waitcnt lgkmcnt(" #n ")" ::: "memory")
#define PG8_BAR __builtin_amdgcn_s_barrier()
#define PG8_SCHED __builtin_amdgcn_sched_barrier(0)
    Unit cur, nxt; int ui = 0;
    if (!S.next(0, cur)) return;
    f32x4 acc[2][2][4][2];
#pragma unroll
    for (int a = 0; a < 2; ++a)
#pragma unroll
        for (int b = 0; b < 2; ++b)
#pragma unroll
            for (int m = 0; m < 4; ++m)
#pragma unroll
                for (int n = 0; n < 2; ++n) acc[a][b][m][n] = (f32x4){0.f, 0.f, 0.f, 0.f};
    bf16x8 At[4][2], B0[2][2], B1[2][2];
    const char* cA = (const char*)g.A + (size_t)cur.pm * tstep; const char* cB = (const char*)g.Bt + (size_t)cur.pn * tstep;
    S.a_ready(cur);
    if constexpr (SP2) {
        PG8_STAGE(PG8_SB(0, 0), cB, voffB); PG8_STAGE(PG8_SB(0, 1), cB + hstep, voffB); PG8_STAGE(PG8_SA(0, 0), cA, voffA); PG8_STAGE(PG8_SA(0, 1), cA + hstep, voffA);
        if (wr == 1) PG8_BAR;
        PG8_WAIT_V(2); PG8_BAR;
        PG8_STAGE(PG8_SB(1, 0), cB + kstep, voffB); PG8_STAGE(PG8_SA(1, 0), cA + kstep, voffA); PG8_STAGE(PG8_SB(1, 1), cB + hstep + kstep, voffB);
        PG8_WAIT_V(6); PG8_BAR;
    } else {
        PG8_STAGE(PG8_SB(0, 0), cB, voffB); PG8_STAGE(PG8_SA(0, 0), cA, voffA); PG8_STAGE(PG8_SB(0, 1), cB + hstep, voffB); PG8_STAGE(PG8_SA(0, 1), cA + hstep, voffA);
        if (wr == 1) PG8_BAR;
        PG8_WAIT_V(4); PG8_BAR;
        PG8_STAGE(PG8_SB(1, 0), cB + kstep, voffB); PG8_STAGE(PG8_SA(1, 0), cA + kstep, voffA); PG8_STAGE(PG8_SB(1, 1), cB + hstep + kstep, voffB);
        PG8_WAIT_V(6); PG8_BAR;
    }
    for (;;) {
        const bool has_next = S.next(ui + 1, nxt);
        const char* nA = has_next ? (const char*)g.A + (size_t)nxt.pm * tstep : cA; const char* nB = has_next ? (const char*)g.Bt + (size_t)nxt.pn * tstep : cB;
        for (int t = 0; t < nt; t += 2) {
            const bool last = (t == nt - 2);
            const char* a1 = cA + (size_t)(t + 1) * kstep;
            const char* a2 = last ? nA : cA + (size_t)(t + 2) * kstep; const char* b2 = last ? nB : cB + (size_t)(t + 2) * kstep;
            const char* a3 = a2 + kstep; const char* b3 = b2 + kstep;
            if (last && has_next) S.a_ready(nxt);
            if constexpr (SP2) {
            PG8_LDB(B0, 0, 0); PG8_LDB(B1, 0, 1); PG8_SCHED; PG8_LDA(At, 0, 0); PG8_STAGE(PG8_SA(1, 1), a1 + hstep, voffA);
            PG8_WAIT_V(8); PG8_WAIT_L(0); PG8_BAR; PG8_MMA(0, 0, At, B0); PG8_MMA(0, 1, At, B1); PG8_BAR; PG8_SCHED;
            PG8_LDA(At, 0, 1); PG8_STAGE(PG8_SB(0, 0), b2, voffB); PG8_STAGE(PG8_SB(0, 1), b2 + hstep, voffB); PG8_STAGE(PG8_SA(0, 0), a2, voffA);
            PG8_WAIT_V(8); PG8_WAIT_L(0); PG8_BAR; PG8_MMA(1, 0, At, B0); PG8_MMA(1, 1, At, B1); PG8_BAR; PG8_SCHED;
            PG8_LDB(B0, 1, 0); PG8_LDB(B1, 1, 1); PG8_SCHED; PG8_LDA(At, 1, 0); PG8_STAGE(PG8_SA(0, 1), a2 + hstep, voffA);
            PG8_WAIT_V(8); PG8_WAIT_L(0); PG8_BAR; PG8_MMA(0, 0, At, B0); PG8_MMA(0, 1, At, B1); PG8_BAR; PG8_SCHED;
            PG8_LDA(At, 1, 1); PG8_STAGE(PG8_SB(1, 0), b3, voffB); PG8_STAGE(PG8_SB(1, 1), b3 + hstep, voffB); PG8_STAGE(PG8_SA(1, 0), a3, voffA);
            PG8_WAIT_V(8); PG8_WAIT_L(0); PG8_BAR; PG8_MMA(1, 0, At, B0); PG8_MMA(1, 1, At, B1); PG8_BAR; PG8_SCHED;
            } else {
            PG8_LDB(B0, 0, 0); PG8_SCHED; PG8_LDA(At, 0, 0); PG8_STAGE(PG8_SA(1, 1), a1 + hstep, voffA);
            PG8_WAIT_L(8); PG8_BAR; PG8_WAIT_L(0); PG8_MMA(0, 0, At, B0); PG8_BAR; PG8_SCHED;
            PG8_LDB(B1, 0, 1); PG8_STAGE(PG8_SB(0, 0), b2, voffB);
            PG8_BAR; PG8_WAIT_L(0); PG8_MMA(0, 1, At, B1); PG8_BAR;
            PG8_LDA(At, 0, 1); PG8_STAGE(PG8_SA(0, 0), a2, voffA);
            PG8_BAR; PG8_WAIT_L(0); PG8_MMA(1, 0, At, B0); PG8_BAR; PG8_SCHED;
            PG8_STAGE(PG8_SB(0, 1), b2 + hstep, voffB);
            PG8_WAIT_V(6); PG8_BAR; PG8_MMA(1, 1, At, B1); PG8_BAR;
            PG8_LDB(B0, 1, 0); PG8_SCHED; PG8_LDA(At, 1, 0); PG8_STAGE(PG8_SA(0, 1), a2 + hstep, voffA);
            PG8_WAIT_L(8); PG8_BAR; PG8_WAIT_L(0); PG8_MMA(0, 0, At, B0); PG8_BAR; PG8_SCHED;
            PG8_LDB(B1, 1, 1); PG8_STAGE(PG8_SB(1, 0), b3, voffB);
            PG8_BAR; PG8_WAIT_L(0); PG8_MMA(0, 1, At, B1); PG8_BAR;
            PG8_LDA(At, 1, 1); PG8_STAGE(PG8_SA(1, 0), a3, voffA);
            PG8_BAR; PG8_WAIT_L(0); PG8_MMA(1, 0, At, B0); PG8_BAR; PG8_SCHED;
            PG8_STAGE(PG8_SB(1, 1), b3 + hstep, voffB);
            PG8_WAIT_V(6); PG8_BAR; PG8_MMA(1, 1, At, B1); PG8_BAR;
            }
        }
        if constexpr (ALIGN_EPI) { if (wr == 0) PG8_BAR; }
        if constexpr (!Epi::AFTER_DRAIN) { E(acc, cur, wr, wc, fr, fq); S.done(cur); }
        if (!has_next) break;
#pragma unroll
        for (int a = 0; a < 2; ++a)
#pragma unroll
            for (int b = 0; b < 2; ++b)
#pragma unroll
                for (int m = 0; m < 4; ++m)
#pragma unroll
                    for (int n = 0; n < 2; ++n) acc[a][b][m][n] = (f32x4){0.f, 0.f, 0.f, 0.f};
        cur = nxt; cA = nA; cB = nB; ++ui;
        if constexpr (ALIGN_EPI) { if (wr == 1) PG8_BAR; }
    }
    PG8_WAIT_V(0);
    if constexpr (!ALIGN_EPI) { if (wr == 0) PG8_BAR; }
    PG8_BAR;
    if constexpr (Epi::AFTER_DRAIN) { E.fused(acc, cur, wr, wc, fr, fq, lds, wid, lane); S.done(cur); }
#undef PG8_SA
#undef PG8_SB
#undef PG8_STAGE
#undef PG8_LDA
#undef PG8_LDB
#undef PG8_MMA
#undef PG8_WAIT_V
#undef PG8_WAIT_L
#undef PG8_BAR
#undef PG8_SCHED
}
}
constexpr int S_ = 16384, D_ = 1024;
constexpr int EVEN_IN = 3072, LORA_N = 512, FF0 = 2816, ODD_IN = 3600, ODD_PAD = 3840, FFE = 3584, NEXP = 8;
constexpr int MOE_ROWS = 32768 + 8 * 256;
constexpr int MOE_BATCH_TILES = 64;
constexpr size_t MiB = 1u << 20;
constexpr size_t WS_CTL = 0, CTL_ZERO_BYTES = 1 * MiB;
constexpr size_t WS_WIN0 = 2 * MiB, WS_WL = 8 * MiB, WS_WOUT0 = 9 * MiB, WS_WGU0 = 11 * MiB, WS_WD0 = 22 * MiB, WS_WIN1 = 28 * MiB, WS_WOUT1 = 36 * MiB;
constexpr size_t WS_TOK = 38 * MiB;
constexpr size_t WS_TILE = 39 * MiB;
constexpr size_t WS_A = 40 * MiB;
constexpr size_t WS_H = WS_A, WS_HX = WS_A + 32 * MiB;
constexpr size_t WS_LW0 = WS_A, WS_LW1 = WS_A + 32 * MiB, WS_R = WS_A + 64 * MiB, WS_V = WS_A + 80 * MiB, WS_KK = WS_A + 96 * MiB, WS_KD0 = WS_A + 112 * MiB, WS_KD1 = WS_A + 128 * MiB, WS_B0 = WS_A + 144 * MiB;
constexpr size_t WS_H2 = WS_A, WS_H3 = WS_A + 32 * MiB;
constexpr size_t WS_WMGU = WS_A, WS_WMD = WS_A + 112 * MiB;
constexpr size_t WS_B = 208 * MiB;
constexpr size_t WS_PROJ0 = WS_B, WS_LORA = WS_B + 96 * MiB, WS_QN = WS_B + 112 * MiB, WS_KN = WS_B + 128 * MiB, WS_Y = WS_B + 144 * MiB;
constexpr size_t WS_B1 = WS_B + 176 * MiB, WS_GATE = WS_B + 192 * MiB, WS_BONUS = WS_B + 208 * MiB, WS_Y0 = WS_LORA, WS_Y1 = WS_B + 224 * MiB;
constexpr size_t WS_ACT0 = WS_B, WS_PROJ1 = WS_B + 88 * MiB;
constexpr size_t WS_QD = WS_B, WS_KD = WS_B + 16 * MiB, WS_VD = WS_B + 32 * MiB, WS_YCAT1 = WS_B + 48 * MiB, WS_GB = WS_B + 80 * MiB  ;
constexpr size_t WS_O0 = WS_B + 208 * MiB, WS_O1 = WS_B + 224 * MiB;
constexpr size_t WS_AMOE = WS_B, WS_MACT = WS_B + 88 * MiB;
constexpr size_t WS_END = 448 * MiB;
static_assert(WS_MACT + (size_t)MOE_BATCH_TILES * 256 * FFE * 2 <= WS_END, "moe act");
static_assert(WS_AMOE + (size_t)MOE_ROWS * D_ * 2 <= WS_MACT, "amoe");
static_assert(WS_PROJ1 + (size_t)S_ * ODD_PAD * 2 <= WS_O0, "proj1");
constexpr int CW_CNT = 64;
constexpr int CW_BAR = 4096;
constexpr int LDS_BYTES = 147456, MISC_OFF = 131072 + 320;

#define GAS __attribute__((address_space(1)))
#define LAS __attribute__((address_space(3)))
#define DI __device__ __forceinline__
typedef unsigned short bf16;
typedef unsigned v4u __attribute__((ext_vector_type(4)));
typedef float f32x4 __attribute__((ext_vector_type(4)));
typedef GAS unsigned gu32;
#define LDS_WAIT() asm volatile("s_waitcnt lgkmcnt(0)" ::: "memory")
DI unsigned f2bf(float f) { unsigned u = __builtin_bit_cast(unsigned, f); return (u + 0x7fffu + ((u >> 16) & 1u)) >> 16; }
DI unsigned pk2(float lo, float hi) { return f2bf(lo) | (f2bf(hi) << 16); }
DI float bflo(unsigned w) { return __uint_as_float(w << 16); }
DI float bfhi(unsigned w) { return __uint_as_float(w & 0xffff0000u); }
DI float bf2f(bf16 b) { return __uint_as_float(((unsigned)b) << 16); }
DI void ld8(const bf16* p, float (&v)[8]) { const v4u w = *(const v4u*)p; v[0] = bflo(w.x); v[1] = bfhi(w.x); v[2] = bflo(w.y); v[3] = bfhi(w.y); v[4] = bflo(w.z); v[5] = bfhi(w.z); v[6] = bflo(w.w); v[7] = bfhi(w.w); }
DI void st8(bf16* p, const float (&v)[8]) { v4u w; w.x = pk2(v[0], v[1]); w.y = pk2(v[2], v[3]); w.z = pk2(v[4], v[5]); w.w = pk2(v[6], v[7]); *(v4u*)p = w; }
DI void ld8f(const float* p, float (&v)[8]) { const f32x4 a = *(const f32x4*)p, b = *(const f32x4*)(p + 4); v[0] = a.x; v[1] = a.y; v[2] = a.z; v[3] = a.w; v[4] = b.x; v[5] = b.y; v[6] = b.z; v[7] = b.w; }
DI void st8f(float* p, const float (&v)[8]) { *(f32x4*)p = (f32x4){v[0], v[1], v[2], v[3]}; *(f32x4*)(p + 4) = (f32x4){v[4], v[5], v[6], v[7]}; }
DI float wave_sum(float v) {
#pragma unroll
    for (int o = 1; o < 64; o <<= 1) v += __shfl_xor(v, o);
    return v;
}
template <int W> DI float grp_sum(float v) {
#pragma unroll
    for (int o = 1; o < W; o <<= 1) v += __shfl_xor(v, o);
    return v;
}
DI float sigmoidf_(float x) { return 1.0f / (1.0f + __expf(-x)); }
DI float softplusf_(float x) { return x > 20.f ? x : log1pf(__expf(x)); }
DI float siluf_(float x) { return x / (1.0f + __expf(-x)); }

struct Args { const float* in[39]; float* out; unsigned char* ws; };

DI void transpose_item(const float* W, int K, int N, bf16* WT, int rowbase, LAS float* scr, int k0, int n0, int lane) {
    const int nn = n0 + (lane & 31); const bool ok = nn < N;
#pragma unroll 8
    for (int i = 0; i < 32; ++i) { const int kk = 2 * i + (lane >> 5); scr[kk * 33 + (lane & 31)] = ok ? W[(size_t)(k0 + kk) * N + nn] : 0.f; }
    LDS_WAIT(); asm volatile("" ::: "memory");
    const int c = lane & 7;
#pragma unroll
    for (int j = 0; j < 4; ++j) { const int n = (lane >> 3) + 8 * j; const LAS float* s = scr + (8 * c) * 33 + n;
        v4u o; o.x = pk2(s[0 * 33], s[1 * 33]); o.y = pk2(s[2 * 33], s[3 * 33]); o.z = pk2(s[4 * 33], s[5 * 33]); o.w = pk2(s[6 * 33], s[7 * 33]);
        *(v4u*)(WT + (size_t)(rowbase + n) * K + k0 + 8 * c) = o; }
    LDS_WAIT(); asm volatile("" ::: "memory");
}
DI bool transpose_job(int& r, const float* W, int K, int N, int Npad, bf16* WT, int row_off, int grp, int sel, LAS float* scr, int lane) {
    const int nblk = Npad / 32, cnt = (K / 64) * nblk;
    if (r >= cnt) { r -= cnt; return false; }
    const int kb = r / nblk, nb = r % nblk, n0 = 32 * nb;
    const int rowbase = row_off + (grp ? (n0 / grp) * (2 * grp) + sel * grp + (n0 % grp) : n0);
    transpose_item(W, K, N, WT, rowbase, scr, 64 * kb, n0, lane);
    return true;
}
#define XB_TMO      128
#define XB_XCNT(j)  (256  + 64 * (j))
#define XB_XSUB(j)  (1280 + 64 * (j))
#define XB_XGEN(j)  (2304 + 64 * (j))
#define XB_TOP      3328
#define XB_TOPGEN   3392
#define XCD_BAR_WORDS 3456
#define XB_SPIN_CAP (1u << 22)

__device__ __forceinline__ unsigned xb_ld(unsigned* p)              { return __hip_atomic_load(p, __ATOMIC_RELAXED, __HIP_MEMORY_SCOPE_AGENT); }
__device__ __forceinline__ unsigned xb_add(unsigned* p, unsigned v) { return __hip_atomic_fetch_add(p, v, __ATOMIC_RELAXED, __HIP_MEMORY_SCOPE_AGENT); }
__device__ __forceinline__ unsigned xb_xcc_id() { return (unsigned)__builtin_amdgcn_s_getreg((3 << 11) | 20) & 0xFu; }
#define XB_SPIN(cond, bar) do { unsigned _sp = 0; while (cond) { __builtin_amdgcn_s_sleep(1); \
    if ((++_sp & 255u) == 0u) { if (xb_ld(&(bar)[XB_TMO])) break; if (_sp > XB_SPIN_CAP) { atomicAdd(&(bar)[XB_TMO], 1u); break; } } } } while (0)

struct XcdBarrier {
    unsigned* bar; unsigned x;
    volatile LAS unsigned* st;
};

__device__ __forceinline__ XcdBarrier xcd_barrier_post(unsigned* bar, volatile LAS unsigned* st) {
    XcdBarrier b; b.bar = bar; b.x = xb_xcc_id(); b.st = st;
    if (threadIdx.x == 0) (void)xb_add(&bar[XB_XCNT(b.x)], 1u);
    return b;
}
__device__ __forceinline__ void xcd_barrier_complete(unsigned* bar, unsigned x, unsigned& nloc, unsigned& nx) {
    const unsigned G = gridDim.x * gridDim.y * gridDim.z;
    unsigned sum, cnt, mine, sp = 0u;
    for (;;) {
        sum = 0u; cnt = 0u; mine = 0u;
#pragma unroll
        for (unsigned j = 0; j < 16; ++j) { const unsigned c = xb_ld(&bar[XB_XCNT(j)]); sum += c; cnt += (c > 0u) ? 1u : 0u; mine = (j == x) ? c : mine; }
        if (sum == G) break;
        __builtin_amdgcn_s_sleep(1);
        if ((++sp & 255u) == 0u) { if (xb_ld(&bar[XB_TMO])) break; if (sp > XB_SPIN_CAP) { atomicAdd(&bar[XB_TMO], 1u); break; } }
    }
    nloc = mine > 0u ? mine : 1u; nx = cnt > 0u ? cnt : 1u;
}

__device__ __forceinline__ void xcd_barrier(const XcdBarrier& b) {
    asm volatile("s_waitcnt vmcnt(0)" ::: "memory");
    __syncthreads();
    if (threadIdx.x == 0) {
        unsigned* bar = b.bar;
        __builtin_amdgcn_s_waitcnt(0);
        unsigned nloc = b.st[0], nx = b.st[1];
        if (nloc == 0u) { xcd_barrier_complete(bar, b.x, nloc, nx); b.st[0] = nloc; b.st[1] = nx; }
        const unsigned old = xb_add(&bar[XB_XSUB(b.x)], 1u);
        const unsigned gen = old / nloc;
        if (old + 1u == (gen + 1u) * nloc) {
            __builtin_amdgcn_fence(__ATOMIC_RELEASE, "agent");
            asm volatile("s_waitcnt vmcnt(0)" ::: "memory");
            const unsigned og = xb_add(&bar[XB_TOP], 1u);
            const unsigned tg = og / nx;
            if (og + 1u == (tg + 1u) * nx) xb_add(&bar[XB_TOPGEN], 1u);
            else XB_SPIN(xb_ld(&bar[XB_TOPGEN]) == tg, bar);
            __builtin_amdgcn_fence(__ATOMIC_ACQUIRE, "agent");
            xb_add(&bar[XB_XGEN(b.x)], 1u);
            asm volatile("s_waitcnt vmcnt(0)" ::: "memory");
        } else {
            XB_SPIN(xb_ld(&bar[XB_XGEN(b.x)]) == gen, bar);
            __builtin_amdgcn_fence(__ATOMIC_ACQUIRE, "agent");
            asm volatile("s_waitcnt vmcnt(0)" ::: "memory");
        }
    }
    __syncthreads();
}
DI float row_rstd(const f32x4 (&v)[4]) {
    float s = 0.f;
#pragma unroll
    for (int j = 0; j < 4; ++j) s += (v[j].x * v[j].x + v[j].y * v[j].y) + (v[j].z * v[j].z + v[j].w * v[j].w);
    return 1.0f / sqrtf(wave_sum(s) * (1.0f / D_) + 1e-6f);
}
DI void load_row(const float* x, int t, int lane, f32x4 (&v)[4]) {
    if (t >= 0 && t < S_) { const f32x4* p = (const f32x4*)(x + (size_t)t * D_) + lane;
#pragma unroll
        for (int j = 0; j < 4; ++j) v[j] = p[64 * j];
    } else {
#pragma unroll
        for (int j = 0; j < 4; ++j) v[j] = (f32x4){0.f, 0.f, 0.f, 0.f};
    }
}
DI void store_row_bf16(bf16* o, int lane, const f32x4 (&v)[4]) {
    unsigned long long* o8 = (unsigned long long*)o + lane;
#pragma unroll
    for (int j = 0; j < 4; ++j) o8[64 * j] = (unsigned long long)pk2(v[j].x, v[j].y) | ((unsigned long long)pk2(v[j].z, v[j].w) << 32);
}
DI void norm_rows(const float* x, const float* w, const float* mu  , bf16* H, bf16* HX, int gw, int NGW, int lane) {
    f32x4 wv[4];
#pragma unroll
    for (int j = 0; j < 4; ++j) wv[j] = ((const f32x4*)w)[lane + 64 * j];
    for (int t = gw; t < S_; t += NGW) {
        f32x4 v[4]; load_row(x, t, lane, v); const float rs = row_rstd(v);
#pragma unroll
        for (int j = 0; j < 4; ++j) v[j] = v[j] * rs * wv[j];
        store_row_bf16(H + (size_t)t * D_, lane, v);
        if (mu) {
            f32x4 p[4], n[4]; load_row(x, t - 1, lane, p); load_row(x, t + 1, lane, n);
            const float rp = row_rstd(p), rn = row_rstd(n);
#pragma unroll
            for (int j = 0; j < 4; ++j) { const f32x4 m0 = ((const f32x4*)mu)[lane + 64 * j], m1 = ((const f32x4*)(mu + D_))[lane + 64 * j];
                const f32x4 hp = p[j] * rp * wv[j], hn = n[j] * rn * wv[j]; p[j] = v[j] + m0 * (hp - v[j]) + m1 * (hn - v[j]); }
            store_row_bf16(HX + (size_t)t * D_, lane, p);
        }
    }
}

DI void prep0_token(const Args& a, unsigned char* ws, LAS float* scr, int t, int lane) {
    const bf16* P = (const bf16*)(ws + WS_PROJ0) + (size_t)t * EVEN_IN;
    const int c0 = 8 * lane;
    {
        float q[8], k[8]; ld8(P + c0, q); ld8(P + 512 + c0, k);
        float sq = 0.f, sk = 0.f;
#pragma unroll
        for (int i = 0; i < 8; ++i) { sq += q[i] * q[i]; sk += k[i] * k[i]; }
        sq = grp_sum<8>(sq); sk = grp_sum<8>(sk);
        const float rq = 1.0f / sqrtf(sq * (1.0f / 64.f) + 1e-6f), rk = 1.0f / sqrtf(sk * (1.0f / 64.f) + 1e-6f);
        const int d0 = 8 * (lane & 7);
        float qw[8], kw[8]; ld8f(a.in[4] + d0, qw); ld8f(a.in[5] + d0, kw);
#pragma unroll
        for (int i = 0; i < 8; ++i) { q[i] = q[i] * rq * qw[i]; k[i] = k[i] * rk * kw[i]; }
        const float pos = (float)((const int*)a.in[1])[t];
        float qo[8], ko[8];
#pragma unroll
        for (int i = 0; i < 8; ++i) { qo[i] = __shfl_xor(q[i], 1); ko[i] = __shfl_xor(k[i], 1); }
        const int sub = lane & 7;
        if (sub < 2) {
#pragma unroll
            for (int i = 0; i < 8; ++i) {
                const float inv = powf(500000.0f, -(float)i / 8.0f); float sn, cs; sincosf(pos * inv, &sn, &cs);
                if (sub == 0) { q[i] = q[i] * cs - qo[i] * sn; k[i] = k[i] * cs - ko[i] * sn; }
                else          { q[i] = q[i] * cs + qo[i] * sn; k[i] = k[i] * cs + ko[i] * sn; }
            }
        }
#pragma unroll
        for (int i = 0; i < 8; ++i) q[i] *= 0.125f;
        st8((bf16*)(ws + WS_QN) + (size_t)t * 512 + c0, q); st8((bf16*)(ws + WS_KN) + (size_t)t * 512 + c0, k);
    }
    float r[8], k[8], v[8];
    {
        const bool hp = t > 0, hn = t < S_ - 1;
        const float* mu = a.in[6];
#pragma unroll
        for (int part = 0; part < 3; ++part) {
            float cur[8], pv[8], nx[8], m0[8], m1[8];
            ld8(P + 1536 + part * 512 + c0, cur);
            if (hp) ld8(P - EVEN_IN + 1536 + part * 512 + c0, pv); else {
#pragma unroll
                for (int i = 0; i < 8; ++i) pv[i] = 0.f; }
            if (hn) ld8(P + EVEN_IN + 1536 + part * 512 + c0, nx); else {
#pragma unroll
                for (int i = 0; i < 8; ++i) nx[i] = 0.f; }
            ld8f(mu + part * 512 + c0, m0); ld8f(mu + 1536 + part * 512 + c0, m1);
#pragma unroll
            for (int i = 0; i < 8; ++i) { const float o = cur[i] + m0[i] * (pv[i] - cur[i]) + m1[i] * (nx[i] - cur[i]);
                if (part == 0) r[i] = o; else if (part == 1) k[i] = o; else v[i] = o; }
        }
    }
    float lv[8];
    { const bf16* L = (const bf16*)(ws + WS_LORA) + (size_t)t * LORA_N; ld8(L + c0, lv);
#pragma unroll
      for (int i = 0; i < 8; ++i) { if (lane < 16) lv[i] = tanhf(lv[i]); else if (lane >= 32 && lane < 48) lv[i] = sigmoidf_(lv[i]); } }
    float wp0[8], wp1[8], ap0[8], ap1[8], gt[8];
    ld8f(a.in[8] + c0, wp0); ld8f(a.in[8] + 512 + c0, wp1); ld8f(a.in[11] + c0, ap0); ld8f(a.in[11] + 512 + c0, ap1);
#pragma unroll
    for (int i = 0; i < 8; ++i) gt[i] = 0.f;
    *(LAS f32x4*)(scr + c0) = (f32x4){lv[0], lv[1], lv[2], lv[3]}; *(LAS f32x4*)(scr + c0 + 4) = (f32x4){lv[4], lv[5], lv[6], lv[7]};
    LDS_WAIT(); asm volatile("" ::: "memory");
    const float* w2 = a.in[10]; const float* a2 = a.in[13]; const float* g2 = a.in[15];
#pragma unroll 2
    for (int j = 0; j < 64; ++j) {
        const float sw0 = scr[j], sw1 = scr[64 + j], sa0 = scr[128 + j], sa1 = scr[192 + j];
        float x0[8], x1[8], y0[8], y1[8];
        ld8f(w2 + (size_t)j * 512 + c0, x0); ld8f(w2 + 32768 + (size_t)j * 512 + c0, x1); ld8f(a2 + (size_t)j * 512 + c0, y0); ld8f(a2 + 32768 + (size_t)j * 512 + c0, y1);
#pragma unroll
        for (int i = 0; i < 8; ++i) { wp0[i] += sw0 * x0[i]; wp1[i] += sw1 * x1[i]; ap0[i] += sa0 * y0[i]; ap1[i] += sa1 * y1[i]; }
    }
#pragma unroll 4
    for (int j = 0; j < 128; ++j) {
        const float sg = scr[256 + j];
        float x0[8]; ld8f(g2 + (size_t)j * 512 + c0, x0);
#pragma unroll
        for (int i = 0; i < 8; ++i) gt[i] += sg * x0[i];
    }
    LDS_WAIT(); asm volatile("" ::: "memory");
    float kkw[8], kaw[8], rkw[8]; ld8f(a.in[16] + c0, kkw); ld8f(a.in[17] + c0, kaw); ld8f(a.in[18] + c0, rkw);
    float kk[8], lw0[8], lw1[8], kd0[8], kd1[8], b0[8], b1[8], bon[8];
    float ss = 0.f;
#pragma unroll
    for (int i = 0; i < 8; ++i) { kk[i] = k[i] * kkw[i]; ss += kk[i] * kk[i]; }
    ss = grp_sum<8>(ss); const float rn = 1.0f / sqrtf(ss + 1e-6f);
    float dotb = 0.f;
#pragma unroll
    for (int i = 0; i < 8; ++i) {
        kk[i] *= rn;
        lw0[i] = -__expf(-softplusf_(-wp0[i]) - 0.5f); lw1[i] = -__expf(-softplusf_(-wp1[i]) - 0.5f);
        const float ic0 = sigmoidf_(ap0[i]), ic1 = sigmoidf_(ap1[i]);
        kd0[i] = k[i] * (1.0f + (ic0 - 1.0f) * kaw[i]); kd1[i] = k[i] * (1.0f + (ic1 - 1.0f) * kaw[i]);
        b0[i] = kk[i] * ic0; b1[i] = kk[i] * ic1;
        dotb += r[i] * (kd0[i] + kd1[i]) * rkw[i];
    }
    dotb = grp_sum<8>(dotb);
#pragma unroll
    for (int i = 0; i < 8; ++i) bon[i] = dotb * v[i];
    const size_t o = (size_t)t * 512 + c0;
    st8f((float*)(ws + WS_LW0) + o, lw0); st8f((float*)(ws + WS_LW1) + o, lw1);
    st8((bf16*)(ws + WS_R) + o, r); st8((bf16*)(ws + WS_V) + o, v); st8((bf16*)(ws + WS_KK) + o, kk);
    st8((bf16*)(ws + WS_KD0) + o, kd0); st8((bf16*)(ws + WS_KD1) + o, kd1); st8((bf16*)(ws + WS_B0) + o, b0); st8((bf16*)(ws + WS_B1) + o, b1);
    st8((bf16*)(ws + WS_GATE) + o, gt); st8((bf16*)(ws + WS_BONUS) + o, bon);
}

DI void rwkv_scan_naive(unsigned char* ws, int w  , int lane) {
    const int z = w >> 9, h = (w >> 6) & 7, vr = w & 63;
    const float* LW = (const float*)(ws + (z ? WS_LW1 : WS_LW0));
    const bf16* KD = (const bf16*)(ws + (z ? WS_KD1 : WS_KD0)); const bf16* BB = (const bf16*)(ws + (z ? WS_B1 : WS_B0));
    const bf16* KK = (const bf16*)(ws + WS_KK); const bf16* R = (const bf16*)(ws + WS_R); const bf16* V = (const bf16*)(ws + WS_V);
    bf16* Y = (bf16*)(ws + (z ? WS_Y1 : WS_Y0));
    const int cc = h * 64 + lane, cv = h * 64 + vr;
    float S = 0.f;
    int t = z ? S_ - 1 : 0; const int dt = z ? -1 : 1;
    size_t o = (size_t)t * 512;
    float lw = LW[o + cc], kd = bf2f(KD[o + cc]), bb = bf2f(BB[o + cc]), kk = bf2f(KK[o + cc]), rr = bf2f(R[o + cc]), vv = bf2f(V[o + cv]);
    for (int s = 0; s < S_; ++s) {
        const int tn = t + dt; const bool more = s + 1 < S_;
        const size_t on = (size_t)(more ? tn : t) * 512;
        const float lw_n = LW[on + cc], kd_n = bf2f(KD[on + cc]), bb_n = bf2f(BB[on + cc]), kk_n = bf2f(KK[on + cc]), rr_n = bf2f(R[on + cc]), vv_n = bf2f(V[on + cv]);
        const float sa = wave_sum(S * (-kk));
        S = S * __expf(lw) + sa * bb + vv * kd;
        const float y = wave_sum(S * rr);
        if (lane == 0) Y[(size_t)t * 512 + cv] = (bf16)f2bf(y);
        lw = lw_n; kd = kd_n; bb = bb_n; kk = kk_n; rr = rr_n; vv = vv_n; t = tn;
    }
}

DI void attn_token_naive(unsigned char* ws, int t, int lane) {
    const bf16* QN = (const bf16*)(ws + WS_QN); const bf16* KN = (const bf16*)(ws + WS_KN); const bf16* P = (const bf16*)(ws + WS_PROJ0);
    const int c0 = 8 * lane;
    float q[8]; ld8(QN + (size_t)t * 512 + c0, q);
    float m = -1e30f, l = 0.f, acc[8];
#pragma unroll
    for (int i = 0; i < 8; ++i) acc[i] = 0.f;
    for (int br = 0; br < 3; ++br) {
        const int d = br == 0 ? 1 : (br == 1 ? 4 : 16);
        for (int mm = -64; mm <= 64; ++mm) {
            const int j = t + d * mm; if (j < 0 || j >= S_) continue;
            float k[8], v[8]; ld8(KN + (size_t)j * 512 + c0, k); ld8(P + (size_t)j * EVEN_IN + 1024 + c0, v);
            float s = 0.f;
#pragma unroll
            for (int i = 0; i < 8; ++i) s += q[i] * k[i];
            s = grp_sum<8>(s);
            const float mn = fmaxf(m, s), sc = __expf(m - mn), p = __expf(s - mn);
            l = l * sc + p;
#pragma unroll
            for (int i = 0; i < 8; ++i) acc[i] = acc[i] * sc + p * v[i];
            m = mn;
        }
    }
    const float il = 1.0f / l;
#pragma unroll
    for (int i = 0; i < 8; ++i) acc[i] *= il;
    st8((bf16*)(ws + WS_Y) + (size_t)t * D_ + c0, acc);
}

DI void rwkv_post_token(const Args& a, unsigned char* ws, int t, int lane) {
    const int c0 = 8 * lane; const size_t o = (size_t)t * 512 + c0;
    float y0[8], y1[8], g[8], bn[8], lw[8], lb[8];
    ld8((const bf16*)(ws + WS_Y0) + o, y0); ld8((const bf16*)(ws + WS_Y1) + o, y1); ld8((const bf16*)(ws + WS_GATE) + o, g); ld8((const bf16*)(ws + WS_BONUS) + o, bn);
    ld8f(a.in[19] + c0, lw); ld8f(a.in[20] + c0, lb);
    float s = 0.f;
#pragma unroll
    for (int i = 0; i < 8; ++i) { y0[i] += y1[i]; s += y0[i]; }
    const float mu = grp_sum<8>(s) * (1.0f / 64.f);
    float q = 0.f;
#pragma unroll
    for (int i = 0; i < 8; ++i) { y0[i] -= mu; q += y0[i] * y0[i]; }
    const float rs = 1.0f / sqrtf(grp_sum<8>(q) * (1.0f / 64.f) + 64e-5f);
#pragma unroll
    for (int i = 0; i < 8; ++i) y0[i] = (y0[i] * rs * lw[i] + lb[i] + bn[i]) * g[i];
    st8((bf16*)(ws + WS_Y) + (size_t)t * D_ + 512 + c0, y0);
}
DI void prep1_token(const Args& a, unsigned char* ws, int t, int lane) {
    const bf16* P = (const bf16*)(ws + WS_PROJ1) + (size_t)t * ODD_PAD;
    const int c0 = 8 * lane; const bool hp = t > 0, hn = t < S_ - 1;
    float z8[8];
#pragma unroll
    for (int i = 0; i < 8; ++i) z8[i] = 0.f;
    {
        float cb[8], cc[8], cx[8], pc[8], px[8], nc[8], nx[8], w0[8], w1[8], w2[8], o[8];
        ld8(P + c0, cb); ld8(P + 512 + c0, cc); ld8(P + 1024 + c0, cx);
        if (hp) { ld8(P - ODD_PAD + 512 + c0, pc); ld8(P - ODD_PAD + 1024 + c0, px); } else {
#pragma unroll
            for (int i = 0; i < 8; ++i) { pc[i] = 0.f; px[i] = 0.f; } }
        if (hn) { ld8(P + ODD_PAD + 512 + c0, nc); ld8(P + ODD_PAD + 1024 + c0, nx); } else {
#pragma unroll
            for (int i = 0; i < 8; ++i) { nc[i] = 0.f; nx[i] = 0.f; } }
        ld8f(a.in[28] + c0, w0); ld8f(a.in[28] + 512 + c0, w1); ld8f(a.in[28] + 1024 + c0, w2);
#pragma unroll
        for (int i = 0; i < 8; ++i) o[i] = cb[i] * (w0[i] * pc[i] * px[i] + w1[i] * cc[i] * cx[i] + w2[i] * nc[i] * nx[i]);
        st8((bf16*)(ws + WS_YCAT1) + (size_t)t * D_ + c0, o);
    }
#pragma unroll
    for (int part = 0; part < 3; ++part) {
        float cu[8], pv[8], nx[8], w0[8], w1[8], w2[8], o[8];
        const int col = 1536 + part * 512 + c0;
        ld8(P + col, cu);
        if (hp) ld8(P - ODD_PAD + col, pv); else {
#pragma unroll
            for (int i = 0; i < 8; ++i) pv[i] = 0.f; }
        if (hn) ld8(P + ODD_PAD + col, nx); else {
#pragma unroll
            for (int i = 0; i < 8; ++i) nx[i] = 0.f; }
        const float* cw = a.in[29] + part * 512 + c0;
        ld8f(cw, w0); ld8f(cw + 1536, w1); ld8f(cw + 3072, w2);
        float ss = 0.f;
#pragma unroll
        for (int i = 0; i < 8; ++i) { o[i] = siluf_(w0[i] * pv[i] + w1[i] * cu[i] + w2[i] * nx[i]); ss += o[i] * o[i]; }
        if (part < 2) { ss = grp_sum<16>(ss); const float rn = (1.0f / sqrtf(ss + 1e-6f)) * (part == 0 ? 0.08838834764831845f : 1.0f);
#pragma unroll
            for (int i = 0; i < 8; ++i) o[i] *= rn; }
        st8((bf16*)(ws + (part == 0 ? WS_QD : (part == 1 ? WS_KD : WS_VD))) + (size_t)t * 512 + c0, o);
    }
    if (lane < 8) {
        const float bt = sigmoidf_(bf2f(P[3584 + lane])); const float al = bf2f(P[3592 + lane]);
        const float g = -__expf(a.in[30][lane]) * softplusf_(al + a.in[31][lane]);
        ((float*)(ws + WS_GB))[(size_t)t * 8 + lane] = g; ((float*)(ws + WS_GB + 512 * 1024))[(size_t)t * 8 + lane] = bt;
    }
}
DI void dn_scan_naive(unsigned char* ws, int w  , int lane) {
    const int z = w >> 9, h = (w >> 7) & 3, vc = w & 127;
    const bf16* Q = (const bf16*)(ws + WS_QD); const bf16* K = (const bf16*)(ws + WS_KD); const bf16* V = (const bf16*)(ws + WS_VD);
    const float* G = (const float*)(ws + WS_GB); const float* Bt = (const float*)(ws + WS_GB + 512 * 1024);
    bf16* O = (bf16*)(ws + (z ? WS_O1 : WS_O0));
    float s0 = 0.f, s1 = 0.f;
    int t = z ? S_ - 1 : 0; const int dt = z ? -1 : 1;
    size_t o = (size_t)t * 512 + h * 128;
    float k0 = bf2f(K[o + lane]), k1 = bf2f(K[o + 64 + lane]), q0 = bf2f(Q[o + lane]), q1 = bf2f(Q[o + 64 + lane]), vv = bf2f(V[o + vc]), g = G[(size_t)t * 8 + z * 4 + h], bt = Bt[(size_t)t * 8 + z * 4 + h];
    for (int s = 0; s < S_; ++s) {
        const int tn = (s + 1 < S_) ? t + dt : t; const size_t on = (size_t)tn * 512 + h * 128;
        const float k0n = bf2f(K[on + lane]), k1n = bf2f(K[on + 64 + lane]), q0n = bf2f(Q[on + lane]), q1n = bf2f(Q[on + 64 + lane]), vvn = bf2f(V[on + vc]), gn = G[(size_t)tn * 8 + z * 4 + h], btn = Bt[(size_t)tn * 8 + z * 4 + h];
        const float eg = __expf(g);
        const float dot = wave_sum(k0 * s0 + k1 * s1);
        const float cf = bt * (vv - eg * dot);
        s0 = eg * s0 + cf * k0; s1 = eg * s1 + cf * k1;
        const float ov = wave_sum(q0 * s0 + q1 * s1);
        if (lane == 0) O[(size_t)t * 512 + h * 128 + vc] = (bf16)f2bf(ov);
        k0 = k0n; k1 = k1n; q0 = q0n; q1 = q1n; vv = vvn; g = gn; bt = btn; t = tn;
    }
}
DI void dn_post_token(const Args& a, unsigned char* ws, int t, int lane) {
    const int c0 = 8 * lane; const size_t o = (size_t)t * 512 + c0;
    float o0[8], o1[8], zz[8], nw[8];
    ld8((const bf16*)(ws + WS_O0) + o, o0); ld8((const bf16*)(ws + WS_O1) + o, o1);
    ld8((const bf16*)(ws + WS_PROJ1) + (size_t)t * ODD_PAD + 3072 + c0, zz); ld8f(a.in[32] + (c0 & 127), nw);
    float ss = 0.f;
#pragma unroll
    for (int i = 0; i < 8; ++i) { o0[i] += o1[i]; ss += o0[i] * o0[i]; }
    const float rs = 1.0f / sqrtf(grp_sum<16>(ss) * (1.0f / 128.f) + 1e-6f);
#pragma unroll
    for (int i = 0; i < 8; ++i) o0[i] = o0[i] * rs * nw[i] * siluf_(zz[i]);
    st8((bf16*)(ws + WS_YCAT1) + (size_t)t * D_ + 512 + c0, o0);
}
struct TokInfo { int e1, e2, s1, s2; float p1, p2; int pad0, pad1; };
DI void route_token(const Args& a, unsigned char* ws, const float* x3, int t, int lane) {
    f32x4 v[4]; load_row(x3, t, lane, v); const float rs = row_rstd(v);
    float lg[8];
#pragma unroll
    for (int e = 0; e < 8; ++e) lg[e] = 0.f;
#pragma unroll
    for (int j = 0; j < 4; ++j) { const f32x4 wv = ((const f32x4*)a.in[34])[lane + 64 * j];
#pragma unroll
        for (int i = 0; i < 4; ++i) { const float hv = v[j][i] * rs * wv[i]; const float* rr = a.in[35] + (size_t)(4 * lane + 256 * j + i) * 8;
            const f32x4 r0 = *(const f32x4*)rr, r1 = *(const f32x4*)(rr + 4);
            lg[0] += hv * r0.x; lg[1] += hv * r0.y; lg[2] += hv * r0.z; lg[3] += hv * r0.w; lg[4] += hv * r1.x; lg[5] += hv * r1.y; lg[6] += hv * r1.z; lg[7] += hv * r1.w; } }
#pragma unroll
    for (int e = 0; e < 8; ++e) lg[e] = wave_sum(lg[e]);
    if (lane == 0) {
        int e1 = 0; float m1 = lg[0];
#pragma unroll
        for (int e = 1; e < 8; ++e) if (lg[e] > m1) { m1 = lg[e]; e1 = e; }
        int e2 = -1; float m2 = -3.0e38f;
#pragma unroll
        for (int e = 0; e < 8; ++e) if (e != e1 && lg[e] > m2) { m2 = lg[e]; e2 = e; }
        const float x2 = __expf(m2 - m1); const float p1 = 1.0f / (1.0f + x2), p2 = x2 / (1.0f + x2);
        unsigned* cnt = (unsigned*)(ws + WS_CTL) + CW_CNT;
        TokInfo ti; ti.e1 = e1; ti.e2 = e2; ti.s1 = (int)atomicAdd(cnt + e1, 1u); ti.s2 = (int)atomicAdd(cnt + e2, 1u); ti.p1 = p1; ti.p2 = p2; ti.pad0 = 0; ti.pad1 = 0;
        ((TokInfo*)(ws + WS_TOK))[t] = ti;
    }
}
DI void moe_offsets(const unsigned char* ws, int (&off)[9]) {
    const unsigned* cnt = (const unsigned*)(ws + WS_CTL) + CW_CNT; int o = 0;
#pragma unroll
    for (int e = 0; e < 8; ++e) { off[e] = o; const int c = (int)__hip_atomic_load(cnt + e, __ATOMIC_RELAXED, __HIP_MEMORY_SCOPE_AGENT); o += (c + 255) & ~255; }
    off[8] = o;
}
DI void gather_token(const Args& a, unsigned char* ws, const float* x3, const int (&off)[9], int t, int lane) {
    f32x4 v[4]; load_row(x3, t, lane, v); const float rs = row_rstd(v);
#pragma unroll
    for (int j = 0; j < 4; ++j) v[j] = v[j] * rs * ((const f32x4*)a.in[34])[lane + 64 * j];
    const TokInfo ti = ((const TokInfo*)(ws + WS_TOK))[t];
    int o1 = 0, o2 = 0;
#pragma unroll
    for (int e = 0; e < 8; ++e) { if (ti.e1 == e) o1 = off[e]; if (ti.e2 == e) o2 = off[e]; }
    bf16* A = (bf16*)(ws + WS_AMOE);
    store_row_bf16(A + (size_t)(o1 + ti.s1) * D_, lane, v); store_row_bf16(A + (size_t)(o2 + ti.s2) * D_, lane, v);
}
DI void combine_token(unsigned char* ws, float* out, const int (&off)[9], int t, int lane) {
    const TokInfo ti = ((const TokInfo*)(ws + WS_TOK))[t];
    int o1 = 0, o2 = 0;
#pragma unroll
    for (int e = 0; e < 8; ++e) { if (ti.e1 == e) o1 = off[e]; if (ti.e2 == e) o2 = off[e]; }
    const bf16* A = (const bf16*)(ws + WS_AMOE);
    const unsigned long long* r1 = (const unsigned long long*)(A + (size_t)(o1 + ti.s1) * D_) + lane; const unsigned long long* r2 = (const unsigned long long*)(A + (size_t)(o2 + ti.s2) * D_) + lane;
    f32x4* xo = (f32x4*)(out + (size_t)t * D_) + lane;
#pragma unroll
    for (int j = 0; j < 4; ++j) { const unsigned long long a1 = r1[64 * j], a2 = r2[64 * j]; f32x4 x = xo[64 * j];
        x.x += ti.p1 * bflo((unsigned)a1) + ti.p2 * bflo((unsigned)a2); x.y += ti.p1 * bfhi((unsigned)a1) + ti.p2 * bfhi((unsigned)a2);
        x.z += ti.p1 * bflo((unsigned)(a1 >> 32)) + ti.p2 * bflo((unsigned)(a2 >> 32)); x.w += ti.p1 * bfhi((unsigned)(a1 >> 32)) + ti.p2 * bfhi((unsigned)(a2 >> 32));
        xo[64 * j] = x; }
}
#ifndef PH_MASK
#define PH_MASK 0xFFFFFFFFu
#endif
__global__ void __launch_bounds__(512, 2) fwd_kernel(Args args) {
    extern __shared__ __attribute__((aligned(16))) unsigned char lds[];
    LAS unsigned char* L = (LAS unsigned char*)lds;
    volatile LAS unsigned* MISC = (volatile LAS unsigned*)(L + MISC_OFF);
    const int tid = threadIdx.x, lane = tid & 63, wave = __builtin_amdgcn_readfirstlane(tid >> 6);
    const int G = gridDim.x, bx = blockIdx.x;
    const int gw = bx * 8 + wave, NGW = G * 8;
    unsigned char* ws = args.ws;
    for (int u = tid; u < (LDS_BYTES - 131072) / 4; u += 512) ((LAS unsigned*)(L + 131072))[u] = 0u;
    __syncthreads();
    XcdBarrier bar = xcd_barrier_post((unsigned*)(ws + WS_CTL) + CW_BAR, MISC + 8);
    LAS float* scr = (LAS float*)(L + wave * 16384);
#define GRID_BAR() xcd_barrier(bar)

    if constexpr ((PH_MASK >> 0) & 1) {
    {
        const float* const* in = args.in;
        for (int it = gw; ; it += NGW) {
            int r = it;
            if (transpose_job(r, in[3], 1024, 3072, 3072, (bf16*)(ws + WS_WIN0), 0, 0, 0, scr, lane)) continue;
            if (transpose_job(r, in[9], 1024, 64, 64, (bf16*)(ws + WS_WL), 0, 0, 0, scr, lane)) continue;
            if (transpose_job(r, in[9] + 65536, 1024, 64, 64, (bf16*)(ws + WS_WL), 64, 0, 0, scr, lane)) continue;
            if (transpose_job(r, in[12], 1024, 64, 64, (bf16*)(ws + WS_WL), 128, 0, 0, scr, lane)) continue;
            if (transpose_job(r, in[12] + 65536, 1024, 64, 64, (bf16*)(ws + WS_WL), 192, 0, 0, scr, lane)) continue;
            if (transpose_job(r, in[14], 1024, 128, 256, (bf16*)(ws + WS_WL), 256, 0, 0, scr, lane)) continue;
            if (transpose_job(r, in[21], 1024, 1024, 1024, (bf16*)(ws + WS_WOUT0), 0, 0, 0, scr, lane)) continue;
            if (transpose_job(r, in[23], 1024, FF0, FF0, (bf16*)(ws + WS_WGU0), 0, 128, 0, scr, lane)) continue;
            if (transpose_job(r, in[24], 1024, FF0, FF0, (bf16*)(ws + WS_WGU0), 0, 128, 1, scr, lane)) continue;
            if (transpose_job(r, in[25], FF0, 1024, 1024, (bf16*)(ws + WS_WD0), 0, 0, 0, scr, lane)) continue;
            if (transpose_job(r, in[27], 1024, ODD_IN, ODD_PAD, (bf16*)(ws + WS_WIN1), 0, 0, 0, scr, lane)) continue;
            if (transpose_job(r, in[33], 1024, 1024, 1024, (bf16*)(ws + WS_WOUT1), 0, 0, 0, scr, lane)) continue;
            break;
        }
        norm_rows(args.in[0], args.in[2], args.in[7], (bf16*)(ws + WS_H), (bf16*)(ws + WS_HX), gw, NGW, lane);
    }
    GRID_BAR();
    }
    if constexpr ((PH_MASK >> 1) & 1) {
    {
        { pg8::Gemm g{(const bf16*)(ws + WS_H), (const bf16*)(ws + WS_WIN0), S_, EVEN_IN, D_}; pg8::StaticOrder S; S.init(S_, EVEN_IN, G, bx);
          pg8::EpiStoreBf16 E{(bf16*)(ws + WS_PROJ0), EVEN_IN, 0}; pg8::gemm_phase<pg8::EpiStoreBf16, pg8::StaticOrder, true, true>(L, g, S, E); }
        { pg8::Gemm g{(const bf16*)(ws + WS_HX), (const bf16*)(ws + WS_WL), S_, LORA_N, D_}; pg8::StaticOrder S; S.init(S_, LORA_N, G, bx);
          pg8::EpiStoreBf16 E{(bf16*)(ws + WS_LORA), LORA_N, 0}; pg8::gemm_phase<pg8::EpiStoreBf16, pg8::StaticOrder, true, true>(L, g, S, E); }
    }
    GRID_BAR();
    }
    if constexpr ((PH_MASK >> 2) & 1) {
    for (int t = gw; t < S_; t += NGW) prep0_token(args, ws, scr, t, lane);
    GRID_BAR();
    }
    if constexpr ((PH_MASK >> 3) & 1) {
    {
        const int half = NGW / 2;
        if (gw < half) { for (int w = gw; w < 1024; w += half) rwkv_scan_naive(ws, w, lane); }
        else { for (int t = gw - half; t < S_; t += NGW - half) attn_token_naive(ws, t, lane); }
    }
    GRID_BAR();
    }
    if constexpr ((PH_MASK >> 4) & 1) {
    for (int t = gw; t < S_; t += NGW) rwkv_post_token(args, ws, t, lane);
    GRID_BAR();
    }
    if constexpr ((PH_MASK >> 5) & 1) {
    { pg8::Gemm g{(const bf16*)(ws + WS_Y), (const bf16*)(ws + WS_WOUT0), S_, D_, D_}; pg8::StaticOrder S; S.init(S_, D_, G, bx);
      pg8::EpiResF32 E{args.in[0], args.out, D_}; pg8::gemm_phase<pg8::EpiResF32, pg8::StaticOrder, true, true>(L, g, S, E); }
    GRID_BAR();
    }
    if constexpr ((PH_MASK >> 6) & 1) {
    norm_rows(args.out, args.in[22], nullptr, (bf16*)(ws + WS_H2), nullptr, gw, NGW, lane);
    GRID_BAR();
    }
    if constexpr ((PH_MASK >> 7) & 1) {
    { pg8::Gemm g{(const bf16*)(ws + WS_H2), (const bf16*)(ws + WS_WGU0), S_, 2 * FF0, D_}; pg8::StaticOrder S; S.init(S_, 2 * FF0, G, bx);
      pg8::EpiSwiGLU E{(bf16*)(ws + WS_ACT0), FF0, 0}; pg8::gemm_phase<pg8::EpiSwiGLU, pg8::StaticOrder, true, true>(L, g, S, E); }
    GRID_BAR();
    }
    if constexpr ((PH_MASK >> 8) & 1) {
    { pg8::Gemm g{(const bf16*)(ws + WS_ACT0), (const bf16*)(ws + WS_WD0), S_, D_, FF0}; pg8::StaticOrder S; S.init(S_, D_, G, bx);
      pg8::EpiResF32 E{args.out, args.out, D_}; pg8::gemm_phase<pg8::EpiResF32, pg8::StaticOrder, true, true>(L, g, S, E); }
    GRID_BAR();
    }
    if constexpr ((PH_MASK >> 9) & 1) {
    norm_rows(args.out, args.in[26], nullptr, (bf16*)(ws + WS_H3), nullptr, gw, NGW, lane);
    GRID_BAR();
    }
    if constexpr ((PH_MASK >> 10) & 1) {
    { pg8::Gemm g{(const bf16*)(ws + WS_H3), (const bf16*)(ws + WS_WIN1), S_, ODD_PAD, D_}; pg8::StaticOrder S; S.init(S_, ODD_PAD, G, bx);
      pg8::EpiStoreBf16 E{(bf16*)(ws + WS_PROJ1), ODD_PAD, 0}; pg8::gemm_phase<pg8::EpiStoreBf16, pg8::StaticOrder, true, true>(L, g, S, E); }
    GRID_BAR();
    }
    if constexpr ((PH_MASK >> 11) & 1) {
    for (int t = gw; t < S_; t += NGW) prep1_token(args, ws, t, lane);
    GRID_BAR();
    }
    if constexpr ((PH_MASK >> 12) & 1) {
    {
        const int half = NGW / 2;
        if (gw < half) { for (int w = gw; w < 1024; w += half) dn_scan_naive(ws, w, lane); }
        else {
            for (int it = gw - half; ; it += NGW - half) {
                int r = it; bool did = false;
                for (int e = 0; e < NEXP && !did; ++e) {
                    if (transpose_job(r, args.in[36] + (size_t)e * 1024 * FFE, 1024, FFE, FFE, (bf16*)(ws + WS_WMGU) + (size_t)e * 2 * FFE * 1024, 0, 128, 0, scr, lane)) { did = true; break; }
                    if (transpose_job(r, args.in[37] + (size_t)e * 1024 * FFE, 1024, FFE, FFE, (bf16*)(ws + WS_WMGU) + (size_t)e * 2 * FFE * 1024, 0, 128, 1, scr, lane)) { did = true; break; }
                    if (transpose_job(r, args.in[38] + (size_t)e * 1024 * FFE, FFE, 1024, 1024, (bf16*)(ws + WS_WMD) + (size_t)e * 1024 * FFE, 0, 0, 0, scr, lane)) { did = true; break; }
                }
                if (!did) break;
            }
        }
    }
    GRID_BAR();
    }
    if constexpr ((PH_MASK >> 13) & 1) {
    for (int t = gw; t < S_; t += NGW) dn_post_token(args, ws, t, lane);
    GRID_BAR();
    }
    if constexpr ((PH_MASK >> 14) & 1) {
    { pg8::Gemm g{(const bf16*)(ws + WS_YCAT1), (const bf16*)(ws + WS_WOUT1), S_, D_, D_}; pg8::StaticOrder S; S.init(S_, D_, G, bx);
      pg8::EpiResF32 E{args.out, args.out, D_}; pg8::gemm_phase<pg8::EpiResF32, pg8::StaticOrder, true, true>(L, g, S, E); }
    GRID_BAR();
    }
    if constexpr ((PH_MASK >> 15) & 1) {
    for (int t = gw; t < S_; t += NGW) route_token(args, ws, args.out, t, lane);
    GRID_BAR();
    }
    int off[9]; moe_offsets(ws, off);
    const int ntiles = off[8] >> 8;
    if constexpr ((PH_MASK >> 16) & 1) {
    {
        for (int t = gw; t < S_; t += NGW) gather_token(args, ws, args.out, off, t, lane);
        if (bx == 0 && tid < 160) { int e = 0;
#pragma unroll
            for (int k = 1; k < 8; ++k) if (tid * 256 >= off[k]) e = k;
            ((int*)(ws + WS_TILE))[tid] = e; }
        const unsigned* cnt = (const unsigned*)(ws + WS_CTL) + CW_CNT;
        for (int e = 0; e < NEXP; ++e) { const int c = (int)__hip_atomic_load(cnt + e, __ATOMIC_RELAXED, __HIP_MEMORY_SCOPE_AGENT); const int r0 = off[e] + c, r1 = off[e + 1];
            for (int rr = r0 + gw; rr < r1; rr += NGW) { unsigned long long* o8 = (unsigned long long*)((bf16*)(ws + WS_AMOE) + (size_t)rr * D_) + lane;
#pragma unroll
                for (int j = 0; j < 4; ++j) o8[64 * j] = 0ull; } }
    }
    GRID_BAR();
    }
    if constexpr ((PH_MASK >> 17) & 1) {
    for (int b = 0; b < 3; ++b) {
        const int tlo = b * MOE_BATCH_TILES; int nt = ntiles - tlo; nt = nt < 0 ? 0 : (nt > MOE_BATCH_TILES ? MOE_BATCH_TILES : nt);
        { pg8::Gemm g{(const bf16*)(ws + WS_AMOE), (const bf16*)(ws + WS_WMGU), MOE_ROWS, NEXP * 2 * FFE, D_};
          pg8::MoeOrder S{(const int*)(ws + WS_TILE), tlo, nt, 2 * FFE / 256, G, bx};
          pg8::EpiSwiGLU E{(bf16*)(ws + WS_MACT) - (size_t)tlo * 256 * FFE, FFE, 2 * FFE / 256};
          pg8::gemm_phase<pg8::EpiSwiGLU, pg8::MoeOrder, true, true>(L, g, S, E); }
        GRID_BAR();
        { pg8::Gemm g{(const bf16*)(ws + WS_MACT) - (size_t)tlo * 256 * FFE, (const bf16*)(ws + WS_WMD), MOE_ROWS, NEXP * D_, FFE};
          pg8::MoeOrder S{(const int*)(ws + WS_TILE), tlo, nt, D_ / 256, G, bx};
          pg8::EpiStoreBf16 E{(bf16*)(ws + WS_AMOE), D_, D_ / 256};
          pg8::gemm_phase<pg8::EpiStoreBf16, pg8::MoeOrder, true, true>(L, g, S, E); }
        GRID_BAR();
    }
    }
    if constexpr ((PH_MASK >> 18) & 1) {
    for (int t = gw; t < S_; t += NGW) combine_token(ws, args.out, off, t, lane);
    }
}

extern "C" void kernel_launch(void* const* d_in, const int* in_sizes, int n_in, void* d_out, int out_size, void* d_ws, size_t ws_size, hipStream_t stream) {
    static int grid = 0;
    if (grid == 0) {
        if (n_in != 39 || out_size != S_ * D_ || ws_size < WS_END) { fprintf(stderr, "kernel_launch: unexpected shapes (n_in %d out %d ws %zu)\n", n_in, out_size, ws_size); grid = -1; return; }
        int dev = 0, cus = 0, per_cu = 0;
        if (hipGetDevice(&dev) != hipSuccess || hipDeviceGetAttribute(&cus, hipDeviceAttributeMultiprocessorCount, dev) != hipSuccess) { grid = -1; return; }
        if (hipFuncSetAttribute((const void*)fwd_kernel, hipFuncAttributeMaxDynamicSharedMemorySize, LDS_BYTES) != hipSuccess) { grid = -1; return; }
        if (hipOccupancyMaxActiveBlocksPerMultiprocessor(&per_cu, (const void*)fwd_kernel, 512, LDS_BYTES) != hipSuccess || per_cu < 1) { fprintf(stderr, "kernel_launch: occupancy query says %d\n", per_cu); }
        (void)hipGetLastError();
        grid = cus;
    }
    if (grid < 0) return;
    if (hipMemsetAsync((char*)d_ws + WS_CTL, 0, CTL_ZERO_BYTES, stream) != hipSuccess) return;
    Args a{};
    for (int i = 0; i < 39; ++i) a.in[i] = (const float*)d_in[i];
    a.out = (float*)d_out; a.ws = (unsigned char*)d_ws;
    hipLaunchKernelGGL(fwd_kernel, dim3(grid), dim3(512), LDS_BYTES, stream, a);
}
```

```cpp
#include <hip/hip_runtime.h>
#include <cstdio>
#include <cstdint>
namespace pg8 {
#define PG8_LAS __attribute__((address_space(3)))
typedef unsigned short bf16_t;
typedef short bf16x8 __attribute__((ext_vector_type(8)));
typedef float f32x4 __attribute__((ext_vector_type(4)));
typedef unsigned u32x4 __attribute__((ext_vector_type(4)));
constexpr int BM = 256, BK = 64, HALF = 128, HTB = HALF * BK * 2  , STAGE_BYTES = 8 * HTB, NXCD = 8, WGM = 8;

__host__ __device__ __forceinline__ int lds_byte(int r, int c) { const int st = (r >> 4) * 2 + (c >> 5), rr = r & 15, cc = c & 31, ob = rr * 64 + cc * 2; return st * 1024 + (ob ^ (((ob >> 9) & 1) << 5)); }
__host__ __device__ __forceinline__ void stage_rc(int b, int& R, int& C) { const int st = b / 1024, sb = b % 1024, swz = sb ^ (((sb >> 9) & 1) << 5); R = (st >> 1) * 16 + swz / 64; C = (st & 1) * 32 + (swz % 64) / 2; }
__host__ __device__ __forceinline__ int perm32(int rho) { const int n = rho >> 4, i = rho & 15; return 8 * (i >> 2) + 4 * n + (i & 3); }

struct Unit { int pm, pn; };
struct Gemm { const bf16_t* A; const bf16_t* Bt; int M, N, K; };

struct StaticOrder {
    int nM, nN, nwg, G, c;
    __host__ __device__ void init(int M, int N, int G_, int c_) { nM = M / BM; nN = N / BM; nwg = nM * nN; G = G_; c = c_; }
    __host__ __device__ bool next(int i, Unit& u) const {
        const long L = (long)i * G + c; if (L >= nwg) return false;
        int wgid = (int)L; { const int q = nwg / NXCD, r = nwg % NXCD, xcd = wgid % NXCD, off = wgid / NXCD; wgid = (xcd < r ? xcd * (q + 1) : r * (q + 1) + (xcd - r) * q) + off; }
        const int nig = WGM * nN, gid = wgid / nig, fm = gid * WGM, gsz = (nM - fm) < WGM ? (nM - fm) : WGM;
        u.pm = fm + ((wgid % nig) % gsz); u.pn = (wgid % nig) / gsz; return true;
    }
    __device__ __forceinline__ void a_ready(const Unit&) const {}
    __device__ __forceinline__ void done(const Unit&) const {}
};

__device__ __forceinline__ unsigned cvt_pk_bf16(float lo, float hi) { unsigned r; asm volatile("v_cvt_pk_bf16_f32 %0, %1, %2" : "=v"(r) : "v"(lo), "v"(hi)); return r; }
struct EpiStoreBf16 {
    static constexpr bool PERM = true, AFTER_DRAIN = false;
    bf16_t* O; int ldc; int ntn;
    __device__ __forceinline__ void operator()(const f32x4 (&acc)[2][2][4][2], const Unit& u, int wr, int wc, int fr, int fq) const {
        const int row0 = u.pm * BM + wr * 64 + fr; const int pn = ntn ? (u.pn % ntn) : u.pn;
        const int col0 = pn * BM + wc * 32 + 8 * fq;
#pragma unroll
        for (int ai = 0; ai < 2; ++ai)
#pragma unroll
            for (int m = 0; m < 4; ++m) { bf16_t* rowp = O + (size_t)(row0 + ai * HALF + m * 16) * ldc + col0;
#pragma unroll
                for (int bj = 0; bj < 2; ++bj) { const f32x4 v0 = acc[ai][bj][m][0], v1 = acc[ai][bj][m][1];
                    u32x4 w; w.x = cvt_pk_bf16(v0[0], v0[1]); w.y = cvt_pk_bf16(v0[2], v0[3]); w.z = cvt_pk_bf16(v1[0], v1[1]); w.w = cvt_pk_bf16(v1[2], v1[3]);
                    *(u32x4*)(rowp + bj * HALF) = w; } }
    }
};
struct EpiResF32 {
    static constexpr bool PERM = false, AFTER_DRAIN = false;
    const float* base; float* out; int ldc;
    __device__ __forceinline__ void operator()(const f32x4 (&acc)[2][2][4][2], const Unit& u, int wr, int wc, int fr, int fq) const {
        const int row0 = u.pm * BM + wr * 64 + fr, col0 = u.pn * BM + wc * 32 + 4 * fq;
#pragma unroll
        for (int ai = 0; ai < 2; ++ai)
#pragma unroll
            for (int m = 0; m < 4; ++m) { const size_t off = (size_t)(row0 + ai * HALF + m * 16) * ldc + col0;
#pragma unroll
                for (int bj = 0; bj < 2; ++bj)
#pragma unroll
                    for (int n = 0; n < 2; ++n) { const f32x4 b = *(const f32x4*)(base + off + bj * HALF + n * 16); *(f32x4*)(out + off + bj * HALF + n * 16) = b + acc[ai][bj][m][n]; } }
    }
};
struct EpiSwiGLU {
    static constexpr bool PERM = true, AFTER_DRAIN = false;
    bf16_t* O; int ldc; int ntn;
    __device__ __forceinline__ void operator()(const f32x4 (&acc)[2][2][4][2], const Unit& u, int wr, int wc, int fr, int fq) const {
        const int row0 = u.pm * BM + wr * 64 + fr; const int pn = ntn ? (u.pn % ntn) : u.pn;
        const int col0 = pn * HALF + wc * 32 + 8 * fq;
#pragma unroll
        for (int ai = 0; ai < 2; ++ai)
#pragma unroll
            for (int m = 0; m < 4; ++m) { bf16_t* rowp = O + (size_t)(row0 + ai * HALF + m * 16) * ldc + col0;
                float r[8];
#pragma unroll
                for (int n = 0; n < 2; ++n)
#pragma unroll
                    for (int i = 0; i < 4; ++i) { const float g = acc[ai][0][m][n][i], up = acc[ai][1][m][n][i]; r[n * 4 + i] = g * __builtin_amdgcn_rcpf(1.0f + __expf(-g)) * up; }
                u32x4 w; w.x = cvt_pk_bf16(r[0], r[1]); w.y = cvt_pk_bf16(r[2], r[3]); w.z = cvt_pk_bf16(r[4], r[5]); w.w = cvt_pk_bf16(r[6], r[7]);
                *(u32x4*)rowp = w; }
    }
};
struct MoeOrder {
    const int* tile_exp; int tlo, nt, nN, G, c;
    __device__ __forceinline__ bool next(int i, Unit& u) const {
        const int L = i * G + c; if (nt <= 0 || L >= nt * nN) return false;
        const int t = tlo + (L % nt), cn = L / nt;
        const int e = __builtin_amdgcn_readfirstlane(__hip_atomic_load(tile_exp + t, __ATOMIC_RELAXED, __HIP_MEMORY_SCOPE_AGENT));
        u.pm = t; u.pn = e * nN + cn; return true;
    }
    __device__ __forceinline__ void a_ready(const Unit&) const {}
    __device__ __forceinline__ void done(const Unit&) const {}
};
template <class Epi, class Sched, bool ALIGN_EPI = false, bool SP2 = false>
__device__ __forceinline__ void gemm_phase(PG8_LAS unsigned char* lds, const Gemm g, const Sched& S, const Epi& E) {
    int tid_ = threadIdx.x; asm volatile("" : "+v"(tid_));
    const int tid = tid_, wid = __builtin_amdgcn_readfirstlane(tid >> 6), lane = tid & 63, wr = wid >> 2, wc = wid & 3, fr = lane & 15, fq = lane >> 4;
    const int K = g.K, nt = K / BK;
    unsigned voffA[2], voffB[2];
#pragma unroll
    for (int i = 0; i < 2; ++i) { int R, C; stage_rc(tid * 16 + i * 8192, R, C); const int Rb = Epi::PERM ? ((R & ~31) + perm32(R & 31)) : R;
        voffA[i] = (unsigned)(R * K + C) * 2u; voffB[i] = (unsigned)(Rb * K + C) * 2u; }
    const size_t kstep = (size_t)(BK * 2);
    const size_t hstep = (size_t)HALF * K * 2;
    const size_t tstep = 2 * hstep;
    const unsigned ldsw = (unsigned)wid * 1024u;
    const int aoff = lds_byte(wr * 64 + fr, fq * 8), boff = lds_byte(wc * 32 + fr, fq * 8);
#define PG8_SA(b, h) (((b) * 2 + (h)) * HTB)
#define PG8_SB(b, h) ((4 + (b) * 2 + (h)) * HTB)
#define PG8_STAGE(bufoff, gbase, voff) do { _Pragma("unroll") for (int _i = 0; _i < 2; ++_i) \
        __builtin_amdgcn_global_load_lds((const unsigned*)((const char*)(gbase) + (voff)[_i]), (PG8_LAS unsigned*)(lds + (bufoff) + ldsw + _i * 8192), 16, 0, 0); } while (0)
#define PG8_LDA(dst, b, h) do { _Pragma("unroll") for (int m = 0; m < 4; ++m) _Pragma("unroll") for (int k = 0; k < 2; ++k) dst[m][k] = *(const PG8_LAS bf16x8*)(lds + PG8_SA(b, h) + aoff + m * 2048 + k * 1024); } while (0)
#define PG8_LDB(dst, b, h) do { _Pragma("unroll") for (int n = 0; n < 2; ++n) _Pragma("unroll") for (int k = 0; k < 2; ++k) dst[n][k] = *(const PG8_LAS bf16x8*)(lds + PG8_SB(b, h) + boff + n * 2048 + k * 1024); } while (0)
#define PG8_MMA(ai, bj, At, Bt) do { __builtin_amdgcn_s_setprio(1); _Pragma("unroll") for (int m = 0; m < 4; ++m) _Pragma("unroll") for (int n = 0; n < 2; ++n) _Pragma("unroll") for (int k = 0; k < 2; ++k) \
        acc[ai][bj][m][n] = __builtin_amdgcn_mfma_f32_16x16x32_bf16(Bt[n][k], At[m][k], acc[ai][bj][m][n], 0, 0, 0); __builtin_amdgcn_s_setprio(0); } while (0)
#define PG8_WAIT_V(n) asm volatile("s_waitcnt vmcnt(" #n ")" ::: "memory")
#define PG8_WAIT_L(n) asm volatile("s_waitcnt lgkmcnt(" #n ")" ::: "memory")
#define PG8_BAR __builtin_amdgcn_s_barrier()
#define PG8_SCHED __builtin_amdgcn_sched_barrier(0)
    Unit cur, nxt; int ui = 0;
    if (!S.next(0, cur)) return;
    f32x4 acc[2][2][4][2];
#pragma unroll
    for (int a = 0; a < 2; ++a)
#pragma unroll
        for (int b = 0; b < 2; ++b)
#pragma unroll
            for (int m = 0; m < 4; ++m)
#pragma unroll
                for (int n = 0; n < 2; ++n) acc[a][b][m][n] = (f32x4){0.f, 0.f, 0.f, 0.f};
    bf16x8 At[4][2], B0[2][2], B1[2][2];
    const char* cA = (const char*)g.A + (size_t)cur.pm * tstep; const char* cB = (const char*)g.Bt + (size_t)cur.pn * tstep;
    S.a_ready(cur);
    if constexpr (SP2) {
        PG8_STAGE(PG8_SB(0, 0), cB, voffB); PG8_STAGE(PG8_SB(0, 1), cB + hstep, voffB); PG8_STAGE(PG8_SA(0, 0), cA, voffA); PG8_STAGE(PG8_SA(0, 1), cA + hstep, voffA);
        if (wr == 1) PG8_BAR;
        PG8_WAIT_V(2); PG8_BAR;
        PG8_STAGE(PG8_SB(1, 0), cB + kstep, voffB); PG8_STAGE(PG8_SA(1, 0), cA + kstep, voffA); PG8_STAGE(PG8_SB(1, 1), cB + hstep + kstep, voffB);
        PG8_WAIT_V(6); PG8_BAR;
    } else {
        PG8_STAGE(PG8_SB(0, 0), cB, voffB); PG8_STAGE(PG8_SA(0, 0), cA, voffA); PG8_STAGE(PG8_SB(0, 1), cB + hstep, voffB); PG8_STAGE(PG8_SA(0, 1), cA + hstep, voffA);
        if (wr == 1) PG8_BAR;
        PG8_WAIT_V(4); PG8_BAR;
        PG8_STAGE(PG8_SB(1, 0), cB + kstep, voffB); PG8_STAGE(PG8_SA(1, 0), cA + kstep, voffA); PG8_STAGE(PG8_SB(1, 1), cB + hstep + kstep, voffB);
        PG8_WAIT_V(6); PG8_BAR;
    }
    for (;;) {
        const bool has_next = S.next(ui + 1, nxt);
        const char* nA = has_next ? (const char*)g.A + (size_t)nxt.pm * tstep : cA; const char* nB = has_next ? (const char*)g.Bt + (size_t)nxt.pn * tstep : cB;
        for (int t = 0; t < nt; t += 2) {
            const bool last = (t == nt - 2);
            const char* a1 = cA + (size_t)(t + 1) * kstep;
            const char* a2 = last ? nA : cA + (size_t)(t + 2) * kstep; const char* b2 = last ? nB : cB + (size_t)(t + 2) * kstep;
            const char* a3 = a2 + kstep; const char* b3 = b2 + kstep;
            if (last && has_next) S.a_ready(nxt);
            if constexpr (SP2) {
            PG8_LDB(B0, 0, 0); PG8_LDB(B1, 0, 1); PG8_SCHED; PG8_LDA(At, 0, 0); PG8_STAGE(PG8_SA(1, 1), a1 + hstep, voffA);
            PG8_WAIT_V(8); PG8_WAIT_L(0); PG8_BAR; PG8_MMA(0, 0, At, B0); PG8_MMA(0, 1, At, B1); PG8_BAR; PG8_SCHED;
            PG8_LDA(At, 0, 1); PG8_STAGE(PG8_SB(0, 0), b2, voffB); PG8_STAGE(PG8_SB(0, 1), b2 + hstep, voffB); PG8_STAGE(PG8_SA(0, 0), a2, voffA);
            PG8_WAIT_V(8); PG8_WAIT_L(0); PG8_BAR; PG8_MMA(1, 0, At, B0); PG8_MMA(1, 1, At, B1); PG8_BAR; PG8_SCHED;
            PG8_LDB(B0, 1, 0); PG8_LDB(B1, 1, 1); PG8_SCHED; PG8_LDA(At, 1, 0); PG8_STAGE(PG8_SA(0, 1), a2 + hstep, voffA);
            PG8_WAIT_V(8); PG8_WAIT_L(0); PG8_BAR; PG8_MMA(0, 0, At, B0); PG8_MMA(0, 1, At, B1); PG8_BAR; PG8_SCHED;
            PG8_LDA(At, 1, 1); PG8_STAGE(PG8_SB(1, 0), b3, voffB); PG8_STAGE(PG8_SB(1, 1), b3 + hstep, voffB); PG8_STAGE(PG8_SA(1, 0), a3, voffA);
            PG8_WAIT_V(8); PG8_WAIT_L(0); PG8_BAR; PG8_MMA(1, 0, At, B0); PG8_MMA(1, 1, At, B1); PG8_BAR; PG8_SCHED;
            } else {
            PG8_LDB(B0, 0, 0); PG8_SCHED; PG8_LDA(At, 0, 0); PG8_STAGE(PG8_SA(1, 1), a1 + hstep, voffA);
            PG8_WAIT_L(8); PG8_BAR; PG8_WAIT_L(0); PG8_MMA(0, 0, At, B0); PG8_BAR; PG8_SCHED;
            PG8_LDB(B1, 0, 1); PG8_STAGE(PG8_SB(0, 0), b2, voffB);
            PG8_BAR; PG8_WAIT_L(0); PG8_MMA(0, 1, At, B1); PG8_BAR;
            PG8_LDA(At, 0, 1); PG8_STAGE(PG8_SA(0, 0), a2, voffA);
            PG8_BAR; PG8_WAIT_L(0); PG8_MMA(1, 0, At, B0); PG8_BAR; PG8_SCHED;
            PG8_STAGE(PG8_SB(0, 1), b2 + hstep, voffB);
            PG8_WAIT_V(6); PG8_BAR; PG8_MMA(1, 1, At, B1); PG8_BAR;
            PG8_LDB(B0, 1, 0); PG8_SCHED; PG8_LDA(At, 1, 0); PG8_STAGE(PG8_SA(0, 1), a2 + hstep, voffA);
            PG8_WAIT_L(8); PG8_BAR; PG8_WAIT_L(0); PG8_MMA(0, 0, At, B0); PG8_BAR; PG8_SCHED;
            PG8_LDB(B1, 1, 1); PG8_STAGE(PG8_SB(1, 0), b3, voffB);
            PG8_BAR; PG8_WAIT_L(0); PG8_MMA(0, 1, At, B1); PG8_BAR;
            PG8_LDA(At, 1, 1); PG8_STAGE(PG8_SA(1, 0), a3, voffA);
            PG8_BAR; PG8_WAIT_L(0); PG8_MMA(1, 0, At, B0); PG8_BAR; PG8_SCHED;
            PG8_STAGE(PG8_SB(1, 1), b3 + hstep, voffB);
            PG8_WAIT_V(6); PG8_BAR; PG8_MMA(1, 1, At, B1); PG8_BAR;
            }
        }
        if constexpr (ALIGN_EPI) { if (wr == 0) PG8_BAR; }
        if constexpr (!Epi::AFTER_DRAIN) { E(acc, cur, wr, wc, fr, fq); S.done(cur); }
        if (!has_next) break;
#pragma unroll
        for (int a = 0; a < 2; ++a)
#pragma unroll
            for (int b = 0; b < 2; ++b)
#pragma unroll
                for (int m = 0; m < 4; ++m)
#pragma unroll
                    for (int n = 0; n < 2; ++n) acc[a][b][m][n] = (f32x4){0.f, 0.f, 0.f, 0.f};
        cur = nxt; cA = nA; cB = nB; ++ui;
        if constexpr (ALIGN_EPI) { if (wr == 1) PG8_BAR; }
    }
    PG8_WAIT_V(0);
    if constexpr (!ALIGN_EPI) { if (wr == 0) PG8_BAR; }
    PG8_BAR;
    if constexpr (Epi::AFTER_DRAIN) { E.fused(acc, cur, wr, wc, fr, fq, lds, wid, lane); S.done(cur); }
#undef PG8_SA
#undef PG8_SB
#undef PG8_STAGE
#undef PG8_LDA
#undef PG8_LDB
#undef PG8_MMA
#undef PG8_WAIT_V
#undef PG8_WAIT_L
#undef PG8_BAR
#undef PG8_SCHED
}
}
constexpr int S_ = 16384, D_ = 1024;
constexpr int EVEN_IN = 3072, LORA_N = 512, FF0 = 2816, ODD_IN = 3600, ODD_PAD = 3840, FFE = 3584, NEXP = 8;
constexpr int MOE_ROWS = 32768 + 8 * 256;
constexpr int MOE_BATCH_TILES = 64;
constexpr size_t MiB = 1u << 20;
constexpr size_t WS_CTL = 0, CTL_ZERO_BYTES = 1 * MiB;
constexpr size_t WS_WIN0 = 2 * MiB, WS_WL = 8 * MiB, WS_WOUT0 = 9 * MiB, WS_WGU0 = 11 * MiB, WS_WD0 = 22 * MiB, WS_WIN1 = 28 * MiB, WS_WOUT1 = 36 * MiB;
constexpr size_t WS_TOK = 38 * MiB;
constexpr size_t WS_TILE = 39 * MiB;
constexpr size_t WS_A = 40 * MiB;
constexpr size_t WS_H = WS_A, WS_HX = WS_A + 32 * MiB;
constexpr size_t WS_LW0 = WS_A, WS_LW1 = WS_A + 32 * MiB, WS_R = WS_A + 64 * MiB, WS_V = WS_A + 80 * MiB, WS_KK = WS_A + 96 * MiB, WS_KD0 = WS_A + 112 * MiB, WS_KD1 = WS_A + 128 * MiB, WS_B0 = WS_A + 144 * MiB;
constexpr size_t WS_H2 = WS_A, WS_H3 = WS_A + 32 * MiB;
constexpr size_t WS_WMGU = WS_A, WS_WMD = WS_A + 112 * MiB;
constexpr size_t WS_B = 208 * MiB;
constexpr size_t WS_PROJ0 = WS_B, WS_LORA = WS_B + 96 * MiB, WS_QN = WS_B + 112 * MiB, WS_KN = WS_B + 128 * MiB, WS_Y = WS_B + 144 * MiB;
constexpr size_t WS_B1 = WS_B + 176 * MiB, WS_GATE = WS_B + 192 * MiB, WS_BONUS = WS_B + 208 * MiB, WS_Y0 = WS_LORA, WS_Y1 = WS_B + 224 * MiB;
constexpr size_t WS_ACT0 = WS_B, WS_PROJ1 = WS_B + 88 * MiB;
constexpr size_t WS_QD = WS_B, WS_KD = WS_B + 16 * MiB, WS_VD = WS_B + 32 * MiB, WS_YCAT1 = WS_B + 48 * MiB, WS_GB = WS_B + 80 * MiB  ;
constexpr size_t WS_O0 = WS_B + 208 * MiB, WS_O1 = WS_B + 224 * MiB;
constexpr size_t WS_AMOE = WS_B, WS_MACT = WS_B + 88 * MiB;
constexpr size_t WS_END = 448 * MiB;
static_assert(WS_MACT + (size_t)MOE_BATCH_TILES * 256 * FFE * 2 <= WS_END, "moe act");
static_assert(WS_AMOE + (size_t)MOE_ROWS * D_ * 2 <= WS_MACT, "amoe");
static_assert(WS_PROJ1 + (size_t)S_ * ODD_PAD * 2 <= WS_O0, "proj1");
constexpr int CW_CNT = 64;
constexpr int CW_BAR = 4096;
constexpr int LDS_BYTES = 147456, MISC_OFF = 131072 + 320;

#define GAS __attribute__((address_space(1)))
#define LAS __attribute__((address_space(3)))
#define DI __device__ __forceinline__
typedef unsigned short bf16;
typedef unsigned v4u __attribute__((ext_vector_type(4)));
typedef float f32x4 __attribute__((ext_vector_type(4)));
typedef GAS unsigned gu32;
#define LDS_WAIT() asm volatile("s_waitcnt lgkmcnt(0)" ::: "memory")
DI unsigned f2bf(float f) { unsigned u = __builtin_bit_cast(unsigned, f); return (u + 0x7fffu + ((u >> 16) & 1u)) >> 16; }
DI unsigned pk2(float lo, float hi) { return f2bf(lo) | (f2bf(hi) << 16); }
DI float bflo(unsigned w) { return __uint_as_float(w << 16); }
DI float bfhi(unsigned w) { return __uint_as_float(w & 0xffff0000u); }
DI float bf2f(bf16 b) { return __uint_as_float(((unsigned)b) << 16); }
DI void ld8(const bf16* p, float (&v)[8]) { const v4u w = *(const v4u*)p; v[0] = bflo(w.x); v[1] = bfhi(w.x); v[2] = bflo(w.y); v[3] = bfhi(w.y); v[4] = bflo(w.z); v[5] = bfhi(w.z); v[6] = bflo(w.w); v[7] = bfhi(w.w); }
DI void st8(bf16* p, const float (&v)[8]) { v4u w; w.x = pk2(v[0], v[1]); w.y = pk2(v[2], v[3]); w.z = pk2(v[4], v[5]); w.w = pk2(v[6], v[7]); *(v4u*)p = w; }
DI void ld8f(const float* p, float (&v)[8]) { const f32x4 a = *(const f32x4*)p, b = *(const f32x4*)(p + 4); v[0] = a.x; v[1] = a.y; v[2] = a.z; v[3] = a.w; v[4] = b.x; v[5] = b.y; v[6] = b.z; v[7] = b.w; }
DI void st8f(float* p, const float (&v)[8]) { *(f32x4*)p = (f32x4){v[0], v[1], v[2], v[3]}; *(f32x4*)(p + 4) = (f32x4){v[4], v[5], v[6], v[7]}; }
DI float wave_sum(float v) {
#pragma unroll
    for (int o = 1; o < 64; o <<= 1) v += __shfl_xor(v, o);
    return v;
}
template <int W> DI float grp_sum(float v) {
#pragma unroll
    for (int o = 1; o < W; o <<= 1) v += __shfl_xor(v, o);
    return v;
}
DI float sigmoidf_(float x) { return 1.0f / (1.0f + __expf(-x)); }
DI float softplusf_(float x) { return x > 20.f ? x : log1pf(__expf(x)); }
DI float siluf_(float x) { return x / (1.0f + __expf(-x)); }

struct Args { const float* in[39]; float* out; unsigned char* ws; };

DI void transpose_item(const float* W, int K, int N, bf16* WT, int rowbase, LAS float* scr, int k0, int n0, int lane) {
    const int nn = n0 + (lane & 31); const bool ok = nn < N;
#pragma unroll 8
    for (int i = 0; i < 32; ++i) { const int kk = 2 * i + (lane >> 5); scr[kk * 33 + (lane & 31)] = ok ? W[(size_t)(k0 + kk) * N + nn] : 0.f; }
    LDS_WAIT(); asm volatile("" ::: "memory");
    const int c = lane & 7;
#pragma unroll
    for (int j = 0; j < 4; ++j) { const int n = (lane >> 3) + 8 * j; const LAS float* s = scr + (8 * c) * 33 + n;
        v4u o; o.x = pk2(s[0 * 33], s[1 * 33]); o.y = pk2(s[2 * 33], s[3 * 33]); o.z = pk2(s[4 * 33], s[5 * 33]); o.w = pk2(s[6 * 33], s[7 * 33]);
        *(v4u*)(WT + (size_t)(rowbase + n) * K + k0 + 8 * c) = o; }
    LDS_WAIT(); asm volatile("" ::: "memory");
}
DI bool transpose_job(int& r, const float* W, int K, int N, int Npad, bf16* WT, int row_off, int grp, int sel, LAS float* scr, int lane) {
    const int nblk = Npad / 32, cnt = (K / 64) * nblk;
    if (r >= cnt) { r -= cnt; return false; }
    const int kb = r / nblk, nb = r % nblk, n0 = 32 * nb;
    const int rowbase = row_off + (grp ? (n0 / grp) * (2 * grp) + sel * grp + (n0 % grp) : n0);
    transpose_item(W, K, N, WT, rowbase, scr, 64 * kb, n0, lane);
    return true;
}
#define XB_TMO      128
#define XB_XCNT(j)  (256  + 64 * (j))
#define XB_XSUB(j)  (1280 + 64 * (j))
#define XB_XGEN(j)  (2304 + 64 * (j))
#define XB_TOP      3328
#define XB_TOPGEN   3392
#define XCD_BAR_WORDS 3456
#define XB_SPIN_CAP (1u << 22)

__device__ __forceinline__ unsigned xb_ld(unsigned* p)              { return __hip_atomic_load(p, __ATOMIC_RELAXED, __HIP_MEMORY_SCOPE_AGENT); }
__device__ __forceinline__ unsigned xb_add(unsigned* p, unsigned v) { return __hip_atomic_fetch_add(p, v, __ATOMIC_RELAXED, __HIP_MEMORY_SCOPE_AGENT); }
__device__ __forceinline__ unsigned xb_xcc_id() { return (unsigned)__builtin_amdgcn_s_getreg((3 << 11) | 20) & 0xFu; }
#define XB_SPIN(cond, bar) do { unsigned _sp = 0; while (cond) { __builtin_amdgcn_s_sleep(1); \
    if ((++_sp & 255u) == 0u) { if (xb_ld(&(bar)[XB_TMO])) break; if (_sp > XB_SPIN_CAP) { atomicAdd(&(bar)[XB_TMO], 1u); break; } } } } while (0)

struct XcdBarrier {
    unsigned* bar; unsigned x;
    volatile LAS unsigned* st;
};

__device__ __forceinline__ XcdBarrier xcd_barrier_post(unsigned* bar, volatile LAS unsigned* st) {
    XcdBarrier b; b.bar = bar; b.x = xb_xcc_id(); b.st = st;
    if (threadIdx.x == 0) (void)xb_add(&bar[XB_XCNT(b.x)], 1u);
    return b;
}
__device__ __forceinline__ void xcd_barrier_complete(unsigned* bar, unsigned x, unsigned& nloc, unsigned& nx) {
    const unsigned G = gridDim.x * gridDim.y * gridDim.z;
    unsigned sum, cnt, mine, sp = 0u;
    for (;;) {
        sum = 0u; cnt = 0u; mine = 0u;
#pragma unroll
        for (unsigned j = 0; j < 16; ++j) { const unsigned c = xb_ld(&bar[XB_XCNT(j)]); sum += c; cnt += (c > 0u) ? 1u : 0u; mine = (j == x) ? c : mine; }
        if (sum == G) break;
        __builtin_amdgcn_s_sleep(1);
        if ((++sp & 255u) == 0u) { if (xb_ld(&bar[XB_TMO])) break; if (sp > XB_SPIN_CAP) { atomicAdd(&bar[XB_TMO], 1u); break; } }
    }
    nloc = mine > 0u ? mine : 1u; nx = cnt > 0u ? cnt : 1u;
}

__device__ __forceinline__ void xcd_barrier(const XcdBarrier& b) {
    asm volatile("s_waitcnt vmcnt(0)" ::: "memory");
    __syncthreads();
    if (threadIdx.x == 0) {
        unsigned* bar = b.bar;
        __builtin_amdgcn_s_waitcnt(0);
        unsigned nloc = b.st[0], nx = b.st[1];
        if (nloc == 0u) { xcd_barrier_complete(bar, b.x, nloc, nx); b.st[0] = nloc; b.st[1] = nx; }
        const unsigned old = xb_add(&bar[XB_XSUB(b.x)], 1u);
        const unsigned gen = old / nloc;
        if (old + 1u == (gen + 1u) * nloc) {
            __builtin_amdgcn_fence(__ATOMIC_RELEASE, "agent");
            asm volatile("s_waitcnt vmcnt(0)" ::: "memory");
            const unsigned og = xb_add(&bar[XB_TOP], 1u);
            const unsigned tg = og / nx;
            if (og + 1u == (tg + 1u) * nx) xb_add(&bar[XB_TOPGEN], 1u);
            else XB_SPIN(xb_ld(&bar[XB_TOPGEN]) == tg, bar);
            __builtin_amdgcn_fence(__ATOMIC_ACQUIRE, "agent");
            xb_add(&bar[XB_XGEN(b.x)], 1u);
            asm volatile("s_waitcnt vmcnt(0)" ::: "memory");
        } else {
            XB_SPIN(xb_ld(&bar[XB_XGEN(b.x)]) == gen, bar);
            __builtin_amdgcn_fence(__ATOMIC_ACQUIRE, "agent");
            asm volatile("s_waitcnt vmcnt(0)" ::: "memory");
        }
    }
    __syncthreads();
}
DI float row_rstd(const f32x4 (&v)[4]) {
    float s = 0.f;
#pragma unroll
    for (int j = 0; j < 4; ++j) s += (v[j].x * v[j].x + v[j].y * v[j].y) + (v[j].z * v[j].z + v[j].w * v[j].w);
    return 1.0f / sqrtf(wave_sum(s) * (1.0f / D_) + 1e-6f);
}
DI void load_row(const float* x, int t, int lane, f32x4 (&v)[4]) {
    if (t >= 0 && t < S_) { const f32x4* p = (const f32x4*)(x + (size_t)t * D_) + lane;
#pragma unroll
        for (int j = 0; j < 4; ++j) v[j] = p[64 * j];
    } else {
#pragma unroll
        for (int j = 0; j < 4; ++j) v[j] = (f32x4){0.f, 0.f, 0.f, 0.f};
    }
}
DI void store_row_bf16(bf16* o, int lane, const f32x4 (&v)[4]) {
    unsigned long long* o8 = (unsigned long long*)o + lane;
#pragma unroll
    for (int j = 0; j < 4; ++j) o8[64 * j] = (unsigned long long)pk2(v[j].x, v[j].y) | ((unsigned long long)pk2(v[j].z, v[j].w) << 32);
}
DI void norm_rows(const float* x, const float* w, const float* mu  , bf16* H, bf16* HX, int gw, int NGW, int lane) {
    f32x4 wv[4];
#pragma unroll
    for (int j = 0; j < 4; ++j) wv[j] = ((const f32x4*)w)[lane + 64 * j];
    for (int t = gw; t < S_; t += NGW) {
        f32x4 v[4]; load_row(x, t, lane, v); const float rs = row_rstd(v);
#pragma unroll
        for (int j = 0; j < 4; ++j) v[j] = v[j] * rs * wv[j];
        store_row_bf16(H + (size_t)t * D_, lane, v);
        if (mu) {
            f32x4 p[4], n[4]; load_row(x, t - 1, lane, p); load_row(x, t + 1, lane, n);
            const float rp = row_rstd(p), rn = row_rstd(n);
#pragma unroll
            for (int j = 0; j < 4; ++j) { const f32x4 m0 = ((const f32x4*)mu)[lane + 64 * j], m1 = ((const f32x4*)(mu + D_))[lane + 64 * j];
                const f32x4 hp = p[j] * rp * wv[j], hn = n[j] * rn * wv[j]; p[j] = v[j] + m0 * (hp - v[j]) + m1 * (hn - v[j]); }
            store_row_bf16(HX + (size_t)t * D_, lane, p);
        }
    }
}

DI void prep0_token(const Args& a, unsigned char* ws, LAS float* scr, int t, int lane) {
    const bf16* P = (const bf16*)(ws + WS_PROJ0) + (size_t)t * EVEN_IN;
    const int c0 = 8 * lane;
    {
        float q[8], k[8]; ld8(P + c0, q); ld8(P + 512 + c0, k);
        float sq = 0.f, sk = 0.f;
#pragma unroll
        for (int i = 0; i < 8; ++i) { sq += q[i] * q[i]; sk += k[i] * k[i]; }
        sq = grp_sum<8>(sq); sk = grp_sum<8>(sk);
        const float rq = 1.0f / sqrtf(sq * (1.0f / 64.f) + 1e-6f), rk = 1.0f / sqrtf(sk * (1.0f / 64.f) + 1e-6f);
        const int d0 = 8 * (lane & 7);
        float qw[8], kw[8]; ld8f(a.in[4] + d0, qw); ld8f(a.in[5] + d0, kw);
#pragma unroll
        for (int i = 0; i < 8; ++i) { q[i] = q[i] * rq * qw[i]; k[i] = k[i] * rk * kw[i]; }
        const float pos = (float)((const int*)a.in[1])[t];
        float qo[8], ko[8];
#pragma unroll
        for (int i = 0; i < 8; ++i) { qo[i] = __shfl_xor(q[i], 1); ko[i] = __shfl_xor(k[i], 1); }
        const int sub = lane & 7;
        if (sub < 2) {
#pragma unroll
            for (int i = 0; i < 8; ++i) {
                const float inv = powf(500000.0f, -(float)i / 8.0f); float sn, cs; sincosf(pos * inv, &sn, &cs);
                if (sub == 0) { q[i] = q[i] * cs - qo[i] * sn; k[i] = k[i] * cs - ko[i] * sn; }
                else          { q[i] = q[i] * cs + qo[i] * sn; k[i] = k[i] * cs + ko[i] * sn; }
            }
        }
#pragma unroll
        for (int i = 0; i < 8; ++i) q[i] *= 0.125f;
        st8((bf16*)(ws + WS_QN) + (size_t)t * 512 + c0, q); st8((bf16*)(ws + WS_KN) + (size_t)t * 512 + c0, k);
    }
    float r[8], k[8], v[8];
    {
        const bool hp = t > 0, hn = t < S_ - 1;
        const float* mu = a.in[6];
#pragma unroll
        for (int part = 0; part < 3; ++part) {
            float cur[8], pv[8], nx[8], m0[8], m1[8];
            ld8(P + 1536 + part * 512 + c0, cur);
            if (hp) ld8(P - EVEN_IN + 1536 + part * 512 + c0, pv); else {
#pragma unroll
                for (int i = 0; i < 8; ++i) pv[i] = 0.f; }
            if (hn) ld8(P + EVEN_IN + 1536 + part * 512 + c0, nx); else {
#pragma unroll
                for (int i = 0; i < 8; ++i) nx[i] = 0.f; }
            ld8f(mu + part * 512 + c0, m0); ld8f(mu + 1536 + part * 512 + c0, m1);
#pragma unroll
            for (int i = 0; i < 8; ++i) { const float o = cur[i] + m0[i] * (pv[i] - cur[i]) + m1[i] * (nx[i] - cur[i]);
                if (part == 0) r[i] = o; else if (part == 1) k[i] = o; else v[i] = o; }
        }
    }
    float lv[8];
    { const bf16* L = (const bf16*)(ws + WS_LORA) + (size_t)t * LORA_N; ld8(L + c0, lv);
#pragma unroll
      for (int i = 0; i < 8; ++i) { if (lane < 16) lv[i] = tanhf(lv[i]); else if (lane >= 32 && lane < 48) lv[i] = sigmoidf_(lv[i]); } }
    float wp0[8], wp1[8], ap0[8], ap1[8], gt[8];
    ld8f(a.in[8] + c0, wp0); ld8f(a.in[8] + 512 + c0, wp1); ld8f(a.in[11] + c0, ap0); ld8f(a.in[11] + 512 + c0, ap1);
#pragma unroll
    for (int i = 0; i < 8; ++i) gt[i] = 0.f;
    *(LAS f32x4*)(scr + c0) = (f32x4){lv[0], lv[1], lv[2], lv[3]}; *(LAS f32x4*)(scr + c0 + 4) = (f32x4){lv[4], lv[5], lv[6], lv[7]};
    LDS_WAIT(); asm volatile("" ::: "memory");
    const float* w2 = a.in[10]; const float* a2 = a.in[13]; const float* g2 = a.in[15];
#pragma unroll 2
    for (int j = 0; j < 64; ++j) {
        const float sw0 = scr[j], sw1 = scr[64 + j], sa0 = scr[128 + j], sa1 = scr[192 + j];
        float x0[8], x1[8], y0[8], y1[8];
        ld8f(w2 + (size_t)j * 512 + c0, x0); ld8f(w2 + 32768 + (size_t)j * 512 + c0, x1); ld8f(a2 + (size_t)j * 512 + c0, y0); ld8f(a2 + 32768 + (size_t)j * 512 + c0, y1);
#pragma unroll
        for (int i = 0; i < 8; ++i) { wp0[i] += sw0 * x0[i]; wp1[i] += sw1 * x1[i]; ap0[i] += sa0 * y0[i]; ap1[i] += sa1 * y1[i]; }
    }
#pragma unroll 4
    for (int j = 0; j < 128; ++j) {
        const float sg = scr[256 + j];
        float x0[8]; ld8f(g2 + (size_t)j * 512 + c0, x0);
#pragma unroll
        for (int i = 0; i < 8; ++i) gt[i] += sg * x0[i];
    }
    LDS_WAIT(); asm volatile("" ::: "memory");
    float kkw[8], kaw[8], rkw[8]; ld8f(a.in[16] + c0, kkw); ld8f(a.in[17] + c0, kaw); ld8f(a.in[18] + c0, rkw);
    float kk[8], lw0[8], lw1[8], kd0[8], kd1[8], b0[8], b1[8], bon[8];
    float ss = 0.f;
#pragma unroll
    for (int i = 0; i < 8; ++i) { kk[i] = k[i] * kkw[i]; ss += kk[i] * kk[i]; }
    ss = grp_sum<8>(ss); const float rn = 1.0f / sqrtf(ss + 1e-6f);
    float dotb = 0.f;
#pragma unroll
    for (int i = 0; i < 8; ++i) {
        kk[i] *= rn;
        lw0[i] = -__expf(-softplusf_(-wp0[i]) - 0.5f); lw1[i] = -__expf(-softplusf_(-wp1[i]) - 0.5f);
        const float ic0 = sigmoidf_(ap0[i]), ic1 = sigmoidf_(ap1[i]);
        kd0[i] = k[i] * (1.0f + (ic0 - 1.0f) * kaw[i]); kd1[i] = k[i] * (1.0f + (ic1 - 1.0f) * kaw[i]);
        b0[i] = kk[i] * ic0; b1[i] = kk[i] * ic1;
        dotb += r[i] * (kd0[i] + kd1[i]) * rkw[i];
    }
    dotb = grp_sum<8>(dotb);
#pragma unroll
    for (int i = 0; i < 8; ++i) bon[i] = dotb * v[i];
    const size_t o = (size_t)t * 512 + c0;
    st8f((float*)(ws + WS_LW0) + o, lw0); st8f((float*)(ws + WS_LW1) + o, lw1);
    st8((bf16*)(ws + WS_R) + o, r); st8((bf16*)(ws + WS_V) + o, v); st8((bf16*)(ws + WS_KK) + o, kk);
    st8((bf16*)(ws + WS_KD0) + o, kd0); st8((bf16*)(ws + WS_KD1) + o, kd1); st8((bf16*)(ws + WS_B0) + o, b0); st8((bf16*)(ws + WS_B1) + o, b1);
    st8((bf16*)(ws + WS_GATE) + o, gt); st8((bf16*)(ws + WS_BONUS) + o, bon);
}

DI void rwkv_scan_naive(unsigned char* ws, int w  , int lane) {
    const int z = w >> 9, h = (w >> 6) & 7, vr = w & 63;
    const float* LW = (const float*)(ws + (z ? WS_LW1 : WS_LW0));
    const bf16* KD = (const bf16*)(ws + (z ? WS_KD1 : WS_KD0)); const bf16* BB = (const bf16*)(ws + (z ? WS_B1 : WS_B0));
    const bf16* KK = (const bf16*)(ws + WS_KK); const bf16* R = (const bf16*)(ws + WS_R); const bf16* V = (const bf16*)(ws + WS_V);
    bf16* Y = (bf16*)(ws + (z ? WS_Y1 : WS_Y0));
    const int cc = h * 64 + lane, cv = h * 64 + vr;
    float S = 0.f;
    int t = z ? S_ - 1 : 0; const int dt = z ? -1 : 1;
    size_t o = (size_t)t * 512;
    float lw = LW[o + cc], kd = bf2f(KD[o + cc]), bb = bf2f(BB[o + cc]), kk = bf2f(KK[o + cc]), rr = bf2f(R[o + cc]), vv = bf2f(V[o + cv]);
    for (int s = 0; s < S_; ++s) {
        const int tn = t + dt; const bool more = s + 1 < S_;
        const size_t on = (size_t)(more ? tn : t) * 512;
        const float lw_n = LW[on + cc], kd_n = bf2f(KD[on + cc]), bb_n = bf2f(BB[on + cc]), kk_n = bf2f(KK[on + cc]), rr_n = bf2f(R[on + cc]), vv_n = bf2f(V[on + cv]);
        const float sa = wave_sum(S * (-kk));
        S = S * __expf(lw) + sa * bb + vv * kd;
        const float y = wave_sum(S * rr);
        if (lane == 0) Y[(size_t)t * 512 + cv] = (bf16)f2bf(y);
        lw = lw_n; kd = kd_n; bb = bb_n; kk = kk_n; rr = rr_n; vv = vv_n; t = tn;
    }
}

DI void attn_token_naive(unsigned char* ws, int t, int lane) {
    const bf16* QN = (const bf16*)(ws + WS_QN); const bf16* KN = (const bf16*)(ws + WS_KN); const bf16* P = (const bf16*)(ws + WS_PROJ0);
    const int c0 = 8 * lane;
    float q[8]; ld8(QN + (size_t)t * 512 + c0, q);
    float m = -1e30f, l = 0.f, acc[8];
#pragma unroll
    for (int i = 0; i < 8; ++i) acc[i] = 0.f;
    for (int br = 0; br < 3; ++br) {
        const int d = br == 0 ? 1 : (br == 1 ? 4 : 16);
        for (int mm = -64; mm <= 64; ++mm) {
            const int j = t + d * mm; if (j < 0 || j >= S_) continue;
            float k[8], v[8]; ld8(KN + (size_t)j * 512 + c0, k); ld8(P + (size_t)j * EVEN_IN + 1024 + c0, v);
            float s = 0.f;
#pragma unroll
            for (int i = 0; i < 8; ++i) s += q[i] * k[i];
            s = grp_sum<8>(s);
            const float mn = fmaxf(m, s), sc = __expf(m - mn), p = __expf(s - mn);
            l = l * sc + p;
#pragma unroll
            for (int i = 0; i < 8; ++i) acc[i] = acc[i] * sc + p * v[i];
            m = mn;
        }
    }
    const float il = 1.0f / l;
#pragma unroll
    for (int i = 0; i < 8; ++i) acc[i] *= il;
    st8((bf16*)(ws + WS_Y) + (size_t)t * D_ + c0, acc);
}

DI void rwkv_post_token(const Args& a, unsigned char* ws, int t, int lane) {
    const int c0 = 8 * lane; const size_t o = (size_t)t * 512 + c0;
    float y0[8], y1[8], g[8], bn[8], lw[8], lb[8];
    ld8((const bf16*)(ws + WS_Y0) + o, y0); ld8((const bf16*)(ws + WS_Y1) + o, y1); ld8((const bf16*)(ws + WS_GATE) + o, g); ld8((const bf16*)(ws + WS_BONUS) + o, bn);
    ld8f(a.in[19] + c0, lw); ld8f(a.in[20] + c0, lb);
    float s = 0.f;
#pragma unroll
    for (int i = 0; i < 8; ++i) { y0[i] += y1[i]; s += y0[i]; }
    const float mu = grp_sum<8>(s) * (1.0f / 64.f);
    float q = 0.f;
#pragma unroll
    for (int i = 0; i < 8; ++i) { y0[i] -= mu; q += y0[i] * y0[i]; }
    const float rs = 1.0f / sqrtf(grp_sum<8>(q) * (1.0f / 64.f) + 64e-5f);
#pragma unroll
    for (int i = 0; i < 8; ++i) y0[i] = (y0[i] * rs * lw[i] + lb[i] + bn[i]) * g[i];
    st8((bf16*)(ws + WS_Y) + (size_t)t * D_ + 512 + c0, y0);
}
typedef short s16x8 __attribute__((ext_vector_type(8)));
typedef short s16x4 __attribute__((ext_vector_type(4)));
typedef LAS unsigned char* ldsp;
DI f32x4 mfma16(s16x8 a, s16x8 b, f32x4 c) { return __builtin_amdgcn_mfma_f32_16x16x32_bf16(a, b, c, 0, 0, 0); }
DI s16x8 frag_row(ldsp img, int row0, int col0, int lane) { return *(LAS const s16x8*)(img + (row0 + (lane & 15)) * 128 + (col0 + 8 * (lane >> 4)) * 2); }
DI s16x4 tr16(ldsp p) { return __builtin_bit_cast(s16x4, __builtin_amdgcn_ds_read_tr16_b64_v4i16((LAS s16x4*)p)); }
DI s16x8 frag_tr(ldsp img, int row0, int col0, int lane) {
    ldsp a0 = img + (row0 + 8 * (lane >> 4) + ((lane & 15) >> 2)) * 128 + col0 * 2 + 8 * (lane & 3);
    const s16x4 lo = tr16(a0), hi = tr16(a0 + 4 * 128);
    return __builtin_shufflevector(lo, hi, 0, 1, 2, 3, 4, 5, 6, 7);
}
DI void ctile_to_img(ldsp img, int mt, int nt, const f32x4& c, int lane) {
    LAS bf16* p = (LAS bf16*)(img + (16 * mt + 4 * (lane >> 4)) * 128 + (16 * nt + (lane & 15)) * 2);
#pragma unroll
    for (int e = 0; e < 4; ++e) p[e * 64] = (bf16)f2bf(c[e]);
}
#define CFENCE() asm volatile("" ::: "memory")
#define MM_LOOP(ACC, AEXPR, BEXPR) _Pragma("unroll") for (int mt = 0; mt < 4; ++mt) _Pragma("unroll") for (int nt = 0; nt < 4; ++nt) _Pragma("unroll") for (int ks = 0; ks < 2; ++ks) ACC[mt][nt] = mfma16((AEXPR), (BEXPR), ACC[mt][nt])

DI int tok_of(int z, int cn, int i) { return z ? cn * 64 + 63 - i : cn * 64 + i; }

DI void rwkv_pass1_item(unsigned char* ws, ldsp lds, int item, int lane) {
    asm volatile("" : "+v"(lane));
    const int z = item >> 11, h = (item >> 8) & 7, c = item & 255;
    const int cn = z ? 255 - c : c;
    float* LW = (float*)(ws + (z ? WS_LW1 : WS_LW0));
    bf16* KD = (bf16*)(ws + (z ? WS_KD1 : WS_KD0)); bf16* BB = (bf16*)(ws + (z ? WS_B1 : WS_B0));
    const bf16* KK = (const bf16*)(ws + WS_KK); const bf16* R = (const bf16*)(ws + WS_R); const bf16* V = (const bf16*)(ws + WS_V);
    ldsp S0 = lds, S1 = lds + 8192, S2 = lds + 16384, S3 = lds + 24576, S4 = lds + 32768, S5 = lds + 40960, S6 = lds + 49152, S7 = lds + 57344;
    ldsp IA = S0, IB = S1, IK = S2, IR = S3;
    const int ch = h * 64 + lane;
    float G = 0.f;
#pragma unroll 8
    for (int i = 0; i < 64; ++i) {
        const size_t o = (size_t)tok_of(z, cn, i) * 512 + ch;
        const float lw = LW[o], a = -bf2f(KK[o]), b = bf2f(BB[o]), kd = bf2f(KD[o]), r = bf2f(R[o]);
        const float eprev = __expf(G); G += lw; const float ecur = __expf(G), einv = __expf(-G);
        ((LAS bf16*)IA)[i * 64 + lane] = (bf16)f2bf(a * eprev); ((LAS bf16*)IB)[i * 64 + lane] = (bf16)f2bf(b * einv);
        ((LAS bf16*)IK)[i * 64 + lane] = (bf16)f2bf(kd * einv); ((LAS bf16*)IR)[i * 64 + lane] = (bf16)f2bf(r * ecur);
    }
    const float GT = __expf(G);
    LDS_WAIT(); CFENCE();
    int lane2 = lane; asm volatile("" : "+v"(lane2));
    const int n_ = lane2 & 15, q_ = lane2 >> 4;
    {
        f32x4 acc[4][4];
#pragma unroll
        for (int mt = 0; mt < 4; ++mt)
#pragma unroll
            for (int nt = 0; nt < 4; ++nt) acc[mt][nt] = (f32x4){0.f, 0.f, 0.f, 0.f};
        MM_LOOP(acc, frag_row(IA, 16 * mt, 32 * ks, lane), frag_row(IB, 16 * nt, 32 * ks, lane));
#pragma unroll
        for (int mt = 0; mt < 4; ++mt)
#pragma unroll
            for (int nt = 0; nt < 4; ++nt)
#pragma unroll
                for (int e = 0; e < 4; ++e) { const int i = 16 * mt + 4 * q_ + e, j = 16 * nt + n_; ((LAS float*)S4)[i * 64 + j] = (j < i) ? acc[mt][nt][e] : 0.f; }
    }
    LDS_WAIT(); CFENCE();
    {
        float t[64];
        int lane_o = lane; asm volatile("" : "+v"(lane_o));
#pragma unroll
        for (int i = 0; i < 64; ++i) {
            float acc = (lane_o == i) ? 1.f : 0.f;
#pragma unroll
            for (int jg = 0; jg < (i + 3) / 4; ++jg) {
                const f32x4 a4 = *(LAS const f32x4*)(S4 + (i * 64 + 4 * jg) * 4);
#pragma unroll
                for (int e = 0; e < 4; ++e) if (4 * jg + e < i) acc += a4[e] * t[4 * jg + e];
            }
            t[i] = acc;
        }
        LDS_WAIT(); CFENCE();
#pragma unroll
        for (int i = 0; i < 64; ++i) ((LAS bf16*)S4)[i * 64 + lane] = (bf16)f2bf(t[i]);
    }
    LDS_WAIT(); CFENCE();
    ldsp IT = S4, IW = S5, IAK = S6;
    {
        f32x4 acc[4][4];
#pragma unroll
        for (int mt = 0; mt < 4; ++mt)
#pragma unroll
            for (int nt = 0; nt < 4; ++nt) acc[mt][nt] = (f32x4){0.f, 0.f, 0.f, 0.f};
        MM_LOOP(acc, frag_row(IA, 16 * mt, 32 * ks, lane), frag_row(IK, 16 * nt, 32 * ks, lane));
#pragma unroll
        for (int mt = 0; mt < 4; ++mt)
#pragma unroll
            for (int nt = 0; nt < 4; ++nt) {
#pragma unroll
                for (int e = 0; e < 4; ++e) { const int i = 16 * mt + 4 * q_ + e, j = 16 * nt + n_; if (!(j < i)) acc[mt][nt][e] = 0.f; }
                ctile_to_img(IAK, mt, nt, acc[mt][nt], lane); }
    }
    {
        f32x4 acc[4][4];
#pragma unroll
        for (int mt = 0; mt < 4; ++mt)
#pragma unroll
            for (int nt = 0; nt < 4; ++nt) acc[mt][nt] = (f32x4){0.f, 0.f, 0.f, 0.f};
        MM_LOOP(acc, frag_row(IT, 16 * mt, 32 * ks, lane), frag_tr(IA, 32 * ks, 16 * nt, lane));
#pragma unroll
        for (int mt = 0; mt < 4; ++mt)
#pragma unroll
            for (int nt = 0; nt < 4; ++nt) ctile_to_img(IW, mt, nt, acc[mt][nt], lane);
    }
    LDS_WAIT(); CFENCE();
    ldsp IV = S0;
#pragma unroll 16
    for (int i = 0; i < 64; ++i) ((LAS bf16*)IV)[i * 64 + lane] = V[(size_t)tok_of(z, cn, i) * 512 + ch];
    LDS_WAIT(); CFENCE();
    ldsp IAV = S7;
    {
        f32x4 acc[4][4];
#pragma unroll
        for (int mt = 0; mt < 4; ++mt)
#pragma unroll
            for (int nt = 0; nt < 4; ++nt) acc[mt][nt] = (f32x4){0.f, 0.f, 0.f, 0.f};
        MM_LOOP(acc, frag_row(IAK, 16 * mt, 32 * ks, lane), frag_tr(IV, 32 * ks, 16 * nt, lane));
#pragma unroll
        for (int mt = 0; mt < 4; ++mt)
#pragma unroll
            for (int nt = 0; nt < 4; ++nt) ctile_to_img(IAV, mt, nt, acc[mt][nt], lane);
    }
    LDS_WAIT(); CFENCE();
    ldsp IU = S6;
    {
        f32x4 acc[4][4];
#pragma unroll
        for (int mt = 0; mt < 4; ++mt)
#pragma unroll
            for (int nt = 0; nt < 4; ++nt) acc[mt][nt] = (f32x4){0.f, 0.f, 0.f, 0.f};
        MM_LOOP(acc, frag_row(IT, 16 * mt, 32 * ks, lane), frag_tr(IAV, 32 * ks, 16 * nt, lane));
        LDS_WAIT(); CFENCE();
#pragma unroll
        for (int mt = 0; mt < 4; ++mt)
#pragma unroll
            for (int nt = 0; nt < 4; ++nt) ctile_to_img(IU, mt, nt, acc[mt][nt], lane);
    }
    LDS_WAIT(); CFENCE();
    ldsp IRB = S4, IRK = S7;
    {
        f32x4 acc[4][4];
#pragma unroll
        for (int mt = 0; mt < 4; ++mt)
#pragma unroll
            for (int nt = 0; nt < 4; ++nt) acc[mt][nt] = (f32x4){0.f, 0.f, 0.f, 0.f};
        MM_LOOP(acc, frag_row(IR, 16 * mt, 32 * ks, lane), frag_row(IB, 16 * nt, 32 * ks, lane));
#pragma unroll
        for (int mt = 0; mt < 4; ++mt)
#pragma unroll
            for (int nt = 0; nt < 4; ++nt) {
#pragma unroll
                for (int e = 0; e < 4; ++e) { const int i = 16 * mt + 4 * q_ + e, j = 16 * nt + n_; if (!(j <= i)) acc[mt][nt][e] = 0.f; }
                ctile_to_img(IRB, mt, nt, acc[mt][nt], lane); }
    }
    {
        f32x4 acc[4][4];
#pragma unroll
        for (int mt = 0; mt < 4; ++mt)
#pragma unroll
            for (int nt = 0; nt < 4; ++nt) acc[mt][nt] = (f32x4){0.f, 0.f, 0.f, 0.f};
        MM_LOOP(acc, frag_row(IR, 16 * mt, 32 * ks, lane), frag_row(IK, 16 * nt, 32 * ks, lane));
#pragma unroll
        for (int mt = 0; mt < 4; ++mt)
#pragma unroll
            for (int nt = 0; nt < 4; ++nt) {
#pragma unroll
                for (int e = 0; e < 4; ++e) { const int i = 16 * mt + 4 * q_ + e, j = 16 * nt + n_; if (!(j <= i)) acc[mt][nt][e] = 0.f; }
                ctile_to_img(IRK, mt, nt, acc[mt][nt], lane); }
    }
    LDS_WAIT(); CFENCE();
    const size_t slot0 = (size_t)cn * 64 * 512 + h * 64;
    {
        f32x4 acc[4][4];
#pragma unroll
        for (int mt = 0; mt < 4; ++mt)
#pragma unroll
            for (int nt = 0; nt < 4; ++nt) { const s16x4 r4 = *(LAS const s16x4*)(IR + (16 * nt + n_) * 128 + (16 * mt + 4 * q_) * 2);
#pragma unroll
                for (int e = 0; e < 4; ++e) acc[mt][nt][e] = bf2f((bf16)r4[e]); }
        MM_LOOP(acc, frag_tr(IW, 32 * ks, 16 * mt, lane), frag_row(IRB, 16 * nt, 32 * ks, lane));
#pragma unroll
        for (int mt = 0; mt < 4; ++mt)
#pragma unroll
            for (int nt = 0; nt < 4; ++nt) { bf16* dst = (bf16*)(LW + slot0 + (size_t)(16 * nt + n_) * 512) + 16 * mt + 4 * q_;
                *(unsigned long long*)dst = (unsigned long long)pk2(acc[mt][nt][0], acc[mt][nt][1]) | ((unsigned long long)pk2(acc[mt][nt][2], acc[mt][nt][3]) << 32); }
    }
    {
        f32x4 acc[4][4];
#pragma unroll
        for (int mt = 0; mt < 4; ++mt)
#pragma unroll
            for (int nt = 0; nt < 4; ++nt) acc[mt][nt] = (f32x4){0.f, 0.f, 0.f, 0.f};
        MM_LOOP(acc, frag_tr(IU, 32 * ks, 16 * mt, lane), frag_row(IRB, 16 * nt, 32 * ks, lane));
        MM_LOOP(acc, frag_tr(IV, 32 * ks, 16 * mt, lane), frag_row(IRK, 16 * nt, 32 * ks, lane));
#pragma unroll
        for (int mt = 0; mt < 4; ++mt)
#pragma unroll
            for (int nt = 0; nt < 4; ++nt) { bf16* dst = (bf16*)(LW + slot0 + (size_t)(16 * nt + n_) * 512) + 64 + 16 * mt + 4 * q_;
                *(unsigned long long*)dst = (unsigned long long)pk2(acc[mt][nt][0], acc[mt][nt][1]) | ((unsigned long long)pk2(acc[mt][nt][2], acc[mt][nt][3]) << 32); }
    }
    {
        f32x4 acc[4][4];
#pragma unroll
        for (int mt = 0; mt < 4; ++mt)
#pragma unroll
            for (int nt = 0; nt < 4; ++nt) acc[mt][nt] = (f32x4){0.f, 0.f, 0.f, 0.f};
        MM_LOOP(acc, frag_tr(IW, 32 * ks, 16 * mt, lane), frag_tr(IB, 32 * ks, 16 * nt, lane));
#pragma unroll
        for (int nt = 0; nt < 4; ++nt) { const float gk = __shfl(GT, 16 * nt + n_);
#pragma unroll
            for (int mt = 0; mt < 4; ++mt) { float o[4];
#pragma unroll
                for (int e = 0; e < 4; ++e) o[e] = gk * (acc[mt][nt][e] + ((16 * mt + 4 * q_ + e) == (16 * nt + n_) ? 1.f : 0.f));
                bf16* dst = KD + slot0 + (size_t)(16 * nt + n_) * 512 + 16 * mt + 4 * q_;
                *(unsigned long long*)dst = (unsigned long long)pk2(o[0], o[1]) | ((unsigned long long)pk2(o[2], o[3]) << 32); } }
    }
    {
        f32x4 acc[4][4];
#pragma unroll
        for (int mt = 0; mt < 4; ++mt)
#pragma unroll
            for (int nt = 0; nt < 4; ++nt) acc[mt][nt] = (f32x4){0.f, 0.f, 0.f, 0.f};
        MM_LOOP(acc, frag_tr(IB, 32 * ks, 16 * mt, lane), frag_tr(IU, 32 * ks, 16 * nt, lane));
        MM_LOOP(acc, frag_tr(IK, 32 * ks, 16 * mt, lane), frag_tr(IV, 32 * ks, 16 * nt, lane));
#pragma unroll
        for (int mt = 0; mt < 4; ++mt) { float gk[4];
#pragma unroll
            for (int e = 0; e < 4; ++e) gk[e] = __shfl(GT, 16 * mt + 4 * q_ + e);
#pragma unroll
            for (int nt = 0; nt < 4; ++nt) { bf16* dst = BB + slot0 + (size_t)(16 * nt + n_) * 512 + 16 * mt + 4 * q_;
                *(unsigned long long*)dst = (unsigned long long)pk2(gk[0] * acc[mt][nt][0], gk[1] * acc[mt][nt][1]) | ((unsigned long long)pk2(gk[2] * acc[mt][nt][2], gk[3] * acc[mt][nt][3]) << 32); } }
    }
    LDS_WAIT(); CFENCE();
}
DI s16x8 pack_cpair(const f32x4& lo, const f32x4& hi) {
    v4u p; p.x = pk2(lo[0], lo[1]); p.y = pk2(lo[2], lo[3]); p.z = pk2(hi[0], hi[1]); p.w = pk2(hi[2], hi[3]);
    return __builtin_bit_cast(s16x8, p);
}
DI void rwkv_pass2_wave(unsigned char* ws, int w  , int lane) {
    const int z = w >> 5, h = (w >> 2) & 7, vs = w & 3;
    const bf16* Mm = (const bf16*)(ws + (z ? WS_KD1 : WS_KD0)); const bf16* Nn = (const bf16*)(ws + (z ? WS_B1 : WS_B0));
    bf16* Hst = (bf16*)(ws + (z ? WS_V : WS_R));
    const int n_ = lane & 15, q_ = lane >> 4;
    f32x4 H[4];
#pragma unroll
    for (int kt = 0; kt < 4; ++kt) H[kt] = (f32x4){0.f, 0.f, 0.f, 0.f};
    unsigned long long ma[4][2][2], nn[4];
    {
        const int cn = z ? 255 : 0; const size_t slot0 = (size_t)cn * 64 * 512 + h * 64;
#pragma unroll
        for (int kt = 0; kt < 4; ++kt) {
#pragma unroll
            for (int ks = 0; ks < 2; ++ks) { const bf16* row = Mm + slot0 + (size_t)(16 * kt + n_) * 512 + 32 * ks + 4 * q_;
                ma[kt][ks][0] = *(const unsigned long long*)row; ma[kt][ks][1] = *(const unsigned long long*)(row + 16); }
            nn[kt] = *(const unsigned long long*)(Nn + slot0 + (size_t)(16 * vs + n_) * 512 + 16 * kt + 4 * q_); }
    }
    for (int c = 0; c < 256; ++c) {
        { bf16* dst = Hst + ((size_t)(c * 8 + h) * 64 + 16 * vs + n_) * 64 + 4 * q_;
#pragma unroll
          for (int kt = 0; kt < 4; ++kt) *(unsigned long long*)(dst + 16 * kt) = (unsigned long long)pk2(H[kt][0], H[kt][1]) | ((unsigned long long)pk2(H[kt][2], H[kt][3]) << 32); }
        unsigned long long ma2[4][2][2], nn2[4];
        { const int c2 = c + 1 < 256 ? c + 1 : c; const int cn = z ? 255 - c2 : c2; const size_t slot0 = (size_t)cn * 64 * 512 + h * 64;
#pragma unroll
          for (int kt = 0; kt < 4; ++kt) {
#pragma unroll
            for (int ks = 0; ks < 2; ++ks) { const bf16* row = Mm + slot0 + (size_t)(16 * kt + n_) * 512 + 32 * ks + 4 * q_;
                ma2[kt][ks][0] = *(const unsigned long long*)row; ma2[kt][ks][1] = *(const unsigned long long*)(row + 16); }
            nn2[kt] = *(const unsigned long long*)(Nn + slot0 + (size_t)(16 * vs + n_) * 512 + 16 * kt + 4 * q_); } }
        const s16x8 b0 = pack_cpair(H[0], H[1]), b1 = pack_cpair(H[2], H[3]);
#pragma unroll
        for (int kt = 0; kt < 4; ++kt) {
            f32x4 acc = (f32x4){bflo((unsigned)nn[kt]), bfhi((unsigned)nn[kt]), bflo((unsigned)(nn[kt] >> 32)), bfhi((unsigned)(nn[kt] >> 32))};
            { v4u a; a.x = (unsigned)ma[kt][0][0]; a.y = (unsigned)(ma[kt][0][0] >> 32); a.z = (unsigned)ma[kt][0][1]; a.w = (unsigned)(ma[kt][0][1] >> 32); acc = mfma16(__builtin_bit_cast(s16x8, a), b0, acc); }
            { v4u a; a.x = (unsigned)ma[kt][1][0]; a.y = (unsigned)(ma[kt][1][0] >> 32); a.z = (unsigned)ma[kt][1][1]; a.w = (unsigned)(ma[kt][1][1] >> 32); acc = mfma16(__builtin_bit_cast(s16x8, a), b1, acc); }
            H[kt] = acc;
        }
#pragma unroll
        for (int kt = 0; kt < 4; ++kt) { nn[kt] = nn2[kt];
#pragma unroll
            for (int ks = 0; ks < 2; ++ks) { ma[kt][ks][0] = ma2[kt][ks][0]; ma[kt][ks][1] = ma2[kt][ks][1]; } }
    }
}
DI void rwkv_pass3_item(unsigned char* ws, int item, int lane) {
    const int z = item >> 11, h = (item >> 8) & 7, c = item & 255;
    const int cn = z ? 255 - c : c;
    const float* LW = (const float*)(ws + (z ? WS_LW1 : WS_LW0));
    const bf16* Hst = (const bf16*)(ws + (z ? WS_V : WS_R)) + (size_t)(c * 8 + h) * 64 * 64;
    bf16* Y = (bf16*)(ws + (z ? WS_Y1 : WS_Y0));
    const int n_ = lane & 15, q_ = lane >> 4;
    const size_t slot0 = (size_t)cn * 64 * 512 + h * 64;
    s16x8 hA[4][2], qB[4][2];
#pragma unroll
    for (int t = 0; t < 4; ++t)
#pragma unroll
        for (int ks = 0; ks < 2; ++ks) {
            hA[t][ks] = *(const s16x8*)(Hst + (size_t)(16 * t + n_) * 64 + 32 * ks + 8 * q_);
            qB[t][ks] = *(const s16x8*)((const bf16*)(LW + slot0 + (size_t)(16 * t + n_) * 512) + 32 * ks + 8 * q_); }
#pragma unroll
    for (int nt = 0; nt < 4; ++nt) {
        const int i = 16 * nt + n_; const bf16* ycrow = (const bf16*)(LW + slot0 + (size_t)i * 512) + 64;
        bf16* yrow = Y + (size_t)tok_of(z, cn, i) * 512 + h * 64;
#pragma unroll
        for (int mt = 0; mt < 4; ++mt) {
            const unsigned long long y4 = *(const unsigned long long*)(ycrow + 16 * mt + 4 * q_);
            f32x4 acc = (f32x4){bflo((unsigned)y4), bfhi((unsigned)y4), bflo((unsigned)(y4 >> 32)), bfhi((unsigned)(y4 >> 32))};
            acc = mfma16(hA[mt][0], qB[nt][0], acc); acc = mfma16(hA[mt][1], qB[nt][1], acc);
            *(unsigned long long*)(yrow + 16 * mt + 4 * q_) = (unsigned long long)pk2(acc[0], acc[1]) | ((unsigned long long)pk2(acc[2], acc[3]) << 32);
        }
    }
}
DI void prep1_token(const Args& a, unsigned char* ws, int t, int lane) {
    const bf16* P = (const bf16*)(ws + WS_PROJ1) + (size_t)t * ODD_PAD;
    const int c0 = 8 * lane; const bool hp = t > 0, hn = t < S_ - 1;
    float z8[8];
#pragma unroll
    for (int i = 0; i < 8; ++i) z8[i] = 0.f;
    {
        float cb[8], cc[8], cx[8], pc[8], px[8], nc[8], nx[8], w0[8], w1[8], w2[8], o[8];
        ld8(P + c0, cb); ld8(P + 512 + c0, cc); ld8(P + 1024 + c0, cx);
        if (hp) { ld8(P - ODD_PAD + 512 + c0, pc); ld8(P - ODD_PAD + 1024 + c0, px); } else {
#pragma unroll
            for (int i = 0; i < 8; ++i) { pc[i] = 0.f; px[i] = 0.f; } }
        if (hn) { ld8(P + ODD_PAD + 512 + c0, nc); ld8(P + ODD_PAD + 1024 + c0, nx); } else {
#pragma unroll
            for (int i = 0; i < 8; ++i) { nc[i] = 0.f; nx[i] = 0.f; } }
        ld8f(a.in[28] + c0, w0); ld8f(a.in[28] + 512 + c0, w1); ld8f(a.in[28] + 1024 + c0, w2);
#pragma unroll
        for (int i = 0; i < 8; ++i) o[i] = cb[i] * (w0[i] * pc[i] * px[i] + w1[i] * cc[i] * cx[i] + w2[i] * nc[i] * nx[i]);
        st8((bf16*)(ws + WS_YCAT1) + (size_t)t * D_ + c0, o);
    }
#pragma unroll
    for (int part = 0; part < 3; ++part) {
        float cu[8], pv[8], nx[8], w0[8], w1[8], w2[8], o[8];
        const int col = 1536 + part * 512 + c0;
        ld8(P + col, cu);
        if (hp) ld8(P - ODD_PAD + col, pv); else {
#pragma unroll
            for (int i = 0; i < 8; ++i) pv[i] = 0.f; }
        if (hn) ld8(P + ODD_PAD + col, nx); else {
#pragma unroll
            for (int i = 0; i < 8; ++i) nx[i] = 0.f; }
        const float* cw = a.in[29] + part * 512 + c0;
        ld8f(cw, w0); ld8f(cw + 1536, w1); ld8f(cw + 3072, w2);
        float ss = 0.f;
#pragma unroll
        for (int i = 0; i < 8; ++i) { o[i] = siluf_(w0[i] * pv[i] + w1[i] * cu[i] + w2[i] * nx[i]); ss += o[i] * o[i]; }
        if (part < 2) { ss = grp_sum<16>(ss); const float rn = (1.0f / sqrtf(ss + 1e-6f)) * (part == 0 ? 0.08838834764831845f : 1.0f);
#pragma unroll
            for (int i = 0; i < 8; ++i) o[i] *= rn; }
        st8((bf16*)(ws + (part == 0 ? WS_QD : (part == 1 ? WS_KD : WS_VD))) + (size_t)t * 512 + c0, o);
    }
    if (lane < 8) {
        const float bt = sigmoidf_(bf2f(P[3584 + lane])); const float al = bf2f(P[3592 + lane]);
        const float g = -__expf(a.in[30][lane]) * softplusf_(al + a.in[31][lane]);
        ((float*)(ws + WS_GB))[(size_t)t * 8 + lane] = g; ((float*)(ws + WS_GB + 512 * 1024))[(size_t)t * 8 + lane] = bt;
    }
}
DI void dn_scan_naive(unsigned char* ws, int w  , int lane) {
    const int z = w >> 9, h = (w >> 7) & 3, vc = w & 127;
    const bf16* Q = (const bf16*)(ws + WS_QD); const bf16* K = (const bf16*)(ws + WS_KD); const bf16* V = (const bf16*)(ws + WS_VD);
    const float* G = (const float*)(ws + WS_GB); const float* Bt = (const float*)(ws + WS_GB + 512 * 1024);
    bf16* O = (bf16*)(ws + (z ? WS_O1 : WS_O0));
    float s0 = 0.f, s1 = 0.f;
    int t = z ? S_ - 1 : 0; const int dt = z ? -1 : 1;
    size_t o = (size_t)t * 512 + h * 128;
    float k0 = bf2f(K[o + lane]), k1 = bf2f(K[o + 64 + lane]), q0 = bf2f(Q[o + lane]), q1 = bf2f(Q[o + 64 + lane]), vv = bf2f(V[o + vc]), g = G[(size_t)t * 8 + z * 4 + h], bt = Bt[(size_t)t * 8 + z * 4 + h];
    for (int s = 0; s < S_; ++s) {
        const int tn = (s + 1 < S_) ? t + dt : t; const size_t on = (size_t)tn * 512 + h * 128;
        const float k0n = bf2f(K[on + lane]), k1n = bf2f(K[on + 64 + lane]), q0n = bf2f(Q[on + lane]), q1n = bf2f(Q[on + 64 + lane]), vvn = bf2f(V[on + vc]), gn = G[(size_t)tn * 8 + z * 4 + h], btn = Bt[(size_t)tn * 8 + z * 4 + h];
        const float eg = __expf(g);
        const float dot = wave_sum(k0 * s0 + k1 * s1);
        const float cf = bt * (vv - eg * dot);
        s0 = eg * s0 + cf * k0; s1 = eg * s1 + cf * k1;
        const float ov = wave_sum(q0 * s0 + q1 * s1);
        if (lane == 0) O[(size_t)t * 512 + h * 128 + vc] = (bf16)f2bf(ov);
        k0 = k0n; k1 = k1n; q0 = q0n; q1 = q1n; vv = vvn; g = gn; bt = btn; t = tn;
    }
}
DI void dn_post_token(const Args& a, unsigned char* ws, int t, int lane) {
    const int c0 = 8 * lane; const size_t o = (size_t)t * 512 + c0;
    float o0[8], o1[8], zz[8], nw[8];
    ld8((const bf16*)(ws + WS_O0) + o, o0); ld8((const bf16*)(ws + WS_O1) + o, o1);
    ld8((const bf16*)(ws + WS_PROJ1) + (size_t)t * ODD_PAD + 3072 + c0, zz); ld8f(a.in[32] + (c0 & 127), nw);
    float ss = 0.f;
#pragma unroll
    for (int i = 0; i < 8; ++i) { o0[i] += o1[i]; ss += o0[i] * o0[i]; }
    const float rs = 1.0f / sqrtf(grp_sum<16>(ss) * (1.0f / 128.f) + 1e-6f);
#pragma unroll
    for (int i = 0; i < 8; ++i) o0[i] = o0[i] * rs * nw[i] * siluf_(zz[i]);
    st8((bf16*)(ws + WS_YCAT1) + (size_t)t * D_ + 512 + c0, o0);
}
struct TokInfo { int e1, e2, s1, s2; float p1, p2; int pad0, pad1; };
DI void route_token(const Args& a, unsigned char* ws, const float* x3, int t, int lane) {
    f32x4 v[4]; load_row(x3, t, lane, v); const float rs = row_rstd(v);
    float lg[8];
#pragma unroll
    for (int e = 0; e < 8; ++e) lg[e] = 0.f;
#pragma unroll
    for (int j = 0; j < 4; ++j) { const f32x4 wv = ((const f32x4*)a.in[34])[lane + 64 * j];
#pragma unroll
        for (int i = 0; i < 4; ++i) { const float hv = v[j][i] * rs * wv[i]; const float* rr = a.in[35] + (size_t)(4 * lane + 256 * j + i) * 8;
            const f32x4 r0 = *(const f32x4*)rr, r1 = *(const f32x4*)(rr + 4);
            lg[0] += hv * r0.x; lg[1] += hv * r0.y; lg[2] += hv * r0.z; lg[3] += hv * r0.w; lg[4] += hv * r1.x; lg[5] += hv * r1.y; lg[6] += hv * r1.z; lg[7] += hv * r1.w; } }
#pragma unroll
    for (int e = 0; e < 8; ++e) lg[e] = wave_sum(lg[e]);
    if (lane == 0) {
        int e1 = 0; float m1 = lg[0];
#pragma unroll
        for (int e = 1; e < 8; ++e) if (lg[e] > m1) { m1 = lg[e]; e1 = e; }
        int e2 = -1; float m2 = -3.0e38f;
#pragma unroll
        for (int e = 0; e < 8; ++e) if (e != e1 && lg[e] > m2) { m2 = lg[e]; e2 = e; }
        const float x2 = __expf(m2 - m1); const float p1 = 1.0f / (1.0f + x2), p2 = x2 / (1.0f + x2);
        unsigned* cnt = (unsigned*)(ws + WS_CTL) + CW_CNT;
        TokInfo ti; ti.e1 = e1; ti.e2 = e2; ti.s1 = (int)atomicAdd(cnt + e1, 1u); ti.s2 = (int)atomicAdd(cnt + e2, 1u); ti.p1 = p1; ti.p2 = p2; ti.pad0 = 0; ti.pad1 = 0;
        ((TokInfo*)(ws + WS_TOK))[t] = ti;
    }
}
DI void moe_offsets(const unsigned char* ws, int (&off)[9]) {
    const unsigned* cnt = (const unsigned*)(ws + WS_CTL) + CW_CNT; int o = 0;
#pragma unroll
    for (int e = 0; e < 8; ++e) { off[e] = o; const int c = (int)__hip_atomic_load(cnt + e, __ATOMIC_RELAXED, __HIP_MEMORY_SCOPE_AGENT); o += (c + 255) & ~255; }
    off[8] = o;
}
DI void gather_token(const Args& a, unsigned char* ws, const float* x3, const int (&off)[9], int t, int lane) {
    f32x4 v[4]; load_row(x3, t, lane, v); const float rs = row_rstd(v);
#pragma unroll
    for (int j = 0; j < 4; ++j) v[j] = v[j] * rs * ((const f32x4*)a.in[34])[lane + 64 * j];
    const TokInfo ti = ((const TokInfo*)(ws + WS_TOK))[t];
    int o1 = 0, o2 = 0;
#pragma unroll
    for (int e = 0; e < 8; ++e) { if (ti.e1 == e) o1 = off[e]; if (ti.e2 == e) o2 = off[e]; }
    bf16* A = (bf16*)(ws + WS_AMOE);
    store_row_bf16(A + (size_t)(o1 + ti.s1) * D_, lane, v); store_row_bf16(A + (size_t)(o2 + ti.s2) * D_, lane, v);
}
DI void combine_token(unsigned char* ws, float* out, const int (&off)[9], int t, int lane) {
    const TokInfo ti = ((const TokInfo*)(ws + WS_TOK))[t];
    int o1 = 0, o2 = 0;
#pragma unroll
    for (int e = 0; e < 8; ++e) { if (ti.e1 == e) o1 = off[e]; if (ti.e2 == e) o2 = off[e]; }
    const bf16* A = (const bf16*)(ws + WS_AMOE);
    const unsigned long long* r1 = (const unsigned long long*)(A + (size_t)(o1 + ti.s1) * D_) + lane; const unsigned long long* r2 = (const unsigned long long*)(A + (size_t)(o2 + ti.s2) * D_) + lane;
    f32x4* xo = (f32x4*)(out + (size_t)t * D_) + lane;
#pragma unroll
    for (int j = 0; j < 4; ++j) { const unsigned long long a1 = r1[64 * j], a2 = r2[64 * j]; f32x4 x = xo[64 * j];
        x.x += ti.p1 * bflo((unsigned)a1) + ti.p2 * bflo((unsigned)a2); x.y += ti.p1 * bfhi((unsigned)a1) + ti.p2 * bfhi((unsigned)a2);
        x.z += ti.p1 * bflo((unsigned)(a1 >> 32)) + ti.p2 * bflo((unsigned)(a2 >> 32)); x.w += ti.p1 * bfhi((unsigned)(a1 >> 32)) + ti.p2 * bfhi((unsigned)(a2 >> 32));
        xo[64 * j] = x; }
}
#ifndef PH_MASK
#define PH_MASK 0xFFFFFFFFu
#endif
DI int lane_opaque() { int l = threadIdx.x & 63; asm volatile("" : "+v"(l)); return l; }
__global__ void __launch_bounds__(512, 2) fwd_kernel(Args args) {
    extern __shared__ __attribute__((aligned(16))) unsigned char lds[];
    LAS unsigned char* L = (LAS unsigned char*)lds;
    volatile LAS unsigned* MISC = (volatile LAS unsigned*)(L + MISC_OFF);
    const int tid = threadIdx.x, lane0 = tid & 63, wave = __builtin_amdgcn_readfirstlane(tid >> 6);
    const int G = gridDim.x, bx = blockIdx.x;
    const int gw = bx * 8 + wave, NGW = G * 8;
    unsigned char* ws = args.ws;
    for (int u = tid; u < (LDS_BYTES - 131072) / 4; u += 512) ((LAS unsigned*)(L + 131072))[u] = 0u;
    __syncthreads();
    XcdBarrier bar = xcd_barrier_post((unsigned*)(ws + WS_CTL) + CW_BAR, MISC + 8);
    LAS float* scr = (LAS float*)(L + wave * 16384);
#define GRID_BAR() xcd_barrier(bar)

    if constexpr ((PH_MASK >> 0) & 1) {
    const int lane = lane_opaque();
    {
        const float* const* in = args.in;
        for (int it = gw; ; it += NGW) {
            int r = it;
            if (transpose_job(r, in[3], 1024, 3072, 3072, (bf16*)(ws + WS_WIN0), 0, 0, 0, scr, lane)) continue;
            if (transpose_job(r, in[9], 1024, 64, 64, (bf16*)(ws + WS_WL), 0, 0, 0, scr, lane)) continue;
            if (transpose_job(r, in[9] + 65536, 1024, 64, 64, (bf16*)(ws + WS_WL), 64, 0, 0, scr, lane)) continue;
            if (transpose_job(r, in[12], 1024, 64, 64, (bf16*)(ws + WS_WL), 128, 0, 0, scr, lane)) continue;
            if (transpose_job(r, in[12] + 65536, 1024, 64, 64, (bf16*)(ws + WS_WL), 192, 0, 0, scr, lane)) continue;
            if (transpose_job(r, in[14], 1024, 128, 256, (bf16*)(ws + WS_WL), 256, 0, 0, scr, lane)) continue;
            if (transpose_job(r, in[21], 1024, 1024, 1024, (bf16*)(ws + WS_WOUT0), 0, 0, 0, scr, lane)) continue;
            if (transpose_job(r, in[23], 1024, FF0, FF0, (bf16*)(ws + WS_WGU0), 0, 128, 0, scr, lane)) continue;
            if (transpose_job(r, in[24], 1024, FF0, FF0, (bf16*)(ws + WS_WGU0), 0, 128, 1, scr, lane)) continue;
            if (transpose_job(r, in[25], FF0, 1024, 1024, (bf16*)(ws + WS_WD0), 0, 0, 0, scr, lane)) continue;
            if (transpose_job(r, in[27], 1024, ODD_IN, ODD_PAD, (bf16*)(ws + WS_WIN1), 0, 0, 0, scr, lane)) continue;
            if (transpose_job(r, in[33], 1024, 1024, 1024, (bf16*)(ws + WS_WOUT1), 0, 0, 0, scr, lane)) continue;
            break;
        }
        norm_rows(args.in[0], args.in[2], args.in[7], (bf16*)(ws + WS_H), (bf16*)(ws + WS_HX), gw, NGW, lane);
    }
    GRID_BAR();
    }
    if constexpr ((PH_MASK >> 1) & 1) {
    const int lane = lane_opaque();
    {
        { pg8::Gemm g{(const bf16*)(ws + WS_H), (const bf16*)(ws + WS_WIN0), S_, EVEN_IN, D_}; pg8::StaticOrder S; S.init(S_, EVEN_IN, G, bx);
          pg8::EpiStoreBf16 E{(bf16*)(ws + WS_PROJ0), EVEN_IN, 0}; pg8::gemm_phase<pg8::EpiStoreBf16, pg8::StaticOrder, true, true>(L, g, S, E); }
        { pg8::Gemm g{(const bf16*)(ws + WS_HX), (const bf16*)(ws + WS_WL), S_, LORA_N, D_}; pg8::StaticOrder S; S.init(S_, LORA_N, G, bx);
          pg8::EpiStoreBf16 E{(bf16*)(ws + WS_LORA), LORA_N, 0}; pg8::gemm_phase<pg8::EpiStoreBf16, pg8::StaticOrder, true, true>(L, g, S, E); }
    }
    GRID_BAR();
    }
    if constexpr ((PH_MASK >> 2) & 1) {
    const int lane = lane_opaque();
    for (int t = gw; t < S_; t += NGW) prep0_token(args, ws, scr, t, lane);
    GRID_BAR();
    }
    if constexpr ((PH_MASK >> 3) & 1) {
    const int lane = lane_opaque();
    {
        if (wave < 2) { for (int it = bx * 2 + wave; it < 4096; it += G * 2) rwkv_pass1_item(ws, L + wave * 65536, it, lane); }
        else { for (int t = bx * 6 + (wave - 2); t < S_; t += G * 6) attn_token_naive(ws, t, lane); }
    }
    GRID_BAR();
    if (wave == 0 && bx < 64) rwkv_pass2_wave(ws, bx, lane);
    GRID_BAR();
    for (int it = gw; it < 4096; it += NGW) rwkv_pass3_item(ws, it, lane);
    GRID_BAR();
    }
    if constexpr ((PH_MASK >> 4) & 1) {
    const int lane = lane_opaque();
    for (int t = gw; t < S_; t += NGW) rwkv_post_token(args, ws, t, lane);
    GRID_BAR();
    }
    if constexpr ((PH_MASK >> 5) & 1) {
    const int lane = lane_opaque();
    { pg8::Gemm g{(const bf16*)(ws + WS_Y), (const bf16*)(ws + WS_WOUT0), S_, D_, D_}; pg8::StaticOrder S; S.init(S_, D_, G, bx);
      pg8::EpiResF32 E{args.in[0], args.out, D_}; pg8::gemm_phase<pg8::EpiResF32, pg8::StaticOrder, true, true>(L, g, S, E); }
    GRID_BAR();
    }
    if constexpr ((PH_MASK >> 6) & 1) {
    const int lane = lane_opaque();
    norm_rows(args.out, args.in[22], nullptr, (bf16*)(ws + WS_H2), nullptr, gw, NGW, lane);
    GRID_BAR();
    }
    if constexpr ((PH_MASK >> 7) & 1) {
    const int lane = lane_opaque();
    { pg8::Gemm g{(const bf16*)(ws + WS_H2), (const bf16*)(ws + WS_WGU0), S_, 2 * FF0, D_}; pg8::StaticOrder S; S.init(S_, 2 * FF0, G, bx);
      pg8::EpiSwiGLU E{(bf16*)(ws + WS_ACT0), FF0, 0}; pg8::gemm_phase<pg8::EpiSwiGLU, pg8::StaticOrder, true, true>(L, g, S, E); }
    GRID_BAR();
    }
    if constexpr ((PH_MASK >> 8) & 1) {
    const int lane = lane_opaque();
    { pg8::Gemm g{(const bf16*)(ws + WS_ACT0), (const bf16*)(ws + WS_WD0), S_, D_, FF0}; pg8::StaticOrder S; S.init(S_, D_, G, bx);
      pg8::EpiResF32 E{args.out, args.out, D_}; pg8::gemm_phase<pg8::EpiResF32, pg8::StaticOrder, true, true>(L, g, S, E); }
    GRID_BAR();
    }
    if constexpr ((PH_MASK >> 9) & 1) {
    const int lane = lane_opaque();
    norm_rows(args.out, args.in[26], nullptr, (bf16*)(ws + WS_H3), nullptr, gw, NGW, lane);
    GRID_BAR();
    }
    if constexpr ((PH_MASK >> 10) & 1) {
    const int lane = lane_opaque();
    { pg8::Gemm g{(const bf16*)(ws + WS_H3), (const bf16*)(ws + WS_WIN1), S_, ODD_PAD, D_}; pg8::StaticOrder S; S.init(S_, ODD_PAD, G, bx);
      pg8::EpiStoreBf16 E{(bf16*)(ws + WS_PROJ1), ODD_PAD, 0}; pg8::gemm_phase<pg8::EpiStoreBf16, pg8::StaticOrder, true, true>(L, g, S, E); }
    GRID_BAR();
    }
    if constexpr ((PH_MASK >> 11) & 1) {
    const int lane = lane_opaque();
    for (int t = gw; t < S_; t += NGW) prep1_token(args, ws, t, lane);
    GRID_BAR();
    }
    if constexpr ((PH_MASK >> 12) & 1) {
    const int lane = lane_opaque();
    {
        const int half = NGW / 2;
        if (gw < half) { for (int w = gw; w < 1024; w += half) dn_scan_naive(ws, w, lane); }
        else {
            for (int it = gw - half; ; it += NGW - half) {
                int r = it; bool did = false;
                for (int e = 0; e < NEXP && !did; ++e) {
                    if (transpose_job(r, args.in[36] + (size_t)e * 1024 * FFE, 1024, FFE, FFE, (bf16*)(ws + WS_WMGU) + (size_t)e * 2 * FFE * 1024, 0, 128, 0, scr, lane)) { did = true; break; }
                    if (transpose_job(r, args.in[37] + (size_t)e * 1024 * FFE, 1024, FFE, FFE, (bf16*)(ws + WS_WMGU) + (size_t)e * 2 * FFE * 1024, 0, 128, 1, scr, lane)) { did = true; break; }
                    if (transpose_job(r, args.in[38] + (size_t)e * 1024 * FFE, FFE, 1024, 1024, (bf16*)(ws + WS_WMD) + (size_t)e * 1024 * FFE, 0, 0, 0, scr, lane)) { did = true; break; }
                }
                if (!did) break;
            }
        }
    }
    GRID_BAR();
    }
    if constexpr ((PH_MASK >> 13) & 1) {
    const int lane = lane_opaque();
    for (int t = gw; t < S_; t += NGW) dn_post_token(args, ws, t, lane);
    GRID_BAR();
    }
    if constexpr ((PH_MASK >> 14) & 1) {
    const int lane = lane_opaque();
    { pg8::Gemm g{(const bf16*)(ws + WS_YCAT1), (const bf16*)(ws + WS_WOUT1), S_, D_, D_}; pg8::StaticOrder S; S.init(S_, D_, G, bx);
      pg8::EpiResF32 E{args.out, args.out, D_}; pg8::gemm_phase<pg8::EpiResF32, pg8::StaticOrder, true, true>(L, g, S, E); }
    GRID_BAR();
    }
    if constexpr ((PH_MASK >> 15) & 1) {
    const int lane = lane_opaque();
    for (int t = gw; t < S_; t += NGW) route_token(args, ws, args.out, t, lane);
    GRID_BAR();
    }
    int off[9]; moe_offsets(ws, off);
    const int ntiles = off[8] >> 8;
    if constexpr ((PH_MASK >> 16) & 1) {
    const int lane = lane_opaque();
    {
        for (int t = gw; t < S_; t += NGW) gather_token(args, ws, args.out, off, t, lane);
        if (bx == 0 && tid < 160) { int e = 0;
#pragma unroll
            for (int k = 1; k < 8; ++k) if (tid * 256 >= off[k]) e = k;
            ((int*)(ws + WS_TILE))[tid] = e; }
        const unsigned* cnt = (const unsigned*)(ws + WS_CTL) + CW_CNT;
        for (int e = 0; e < NEXP; ++e) { const int c = (int)__hip_atomic_load(cnt + e, __ATOMIC_RELAXED, __HIP_MEMORY_SCOPE_AGENT); const int r0 = off[e] + c, r1 = off[e + 1];
            for (int rr = r0 + gw; rr < r1; rr += NGW) { unsigned long long* o8 = (unsigned long long*)((bf16*)(ws + WS_AMOE) + (size_t)rr * D_) + lane;
#pragma unroll
                for (int j = 0; j < 4; ++j) o8[64 * j] = 0ull; } }
    }
    GRID_BAR();
    }
    if constexpr ((PH_MASK >> 17) & 1) {
    const int lane = lane_opaque();
    for (int b = 0; b < 3; ++b) {
        const int tlo = b * MOE_BATCH_TILES; int nt = ntiles - tlo; nt = nt < 0 ? 0 : (nt > MOE_BATCH_TILES ? MOE_BATCH_TILES : nt);
        { pg8::Gemm g{(const bf16*)(ws + WS_AMOE), (const bf16*)(ws + WS_WMGU), MOE_ROWS, NEXP * 2 * FFE, D_};
          pg8::MoeOrder S{(const int*)(ws + WS_TILE), tlo, nt, 2 * FFE / 256, G, bx};
          pg8::EpiSwiGLU E{(bf16*)(ws + WS_MACT) - (size_t)tlo * 256 * FFE, FFE, 2 * FFE / 256};
          pg8::gemm_phase<pg8::EpiSwiGLU, pg8::MoeOrder, true, true>(L, g, S, E); }
        GRID_BAR();
        { pg8::Gemm g{(const bf16*)(ws + WS_MACT) - (size_t)tlo * 256 * FFE, (const bf16*)(ws + WS_WMD), MOE_ROWS, NEXP * D_, FFE};
          pg8::MoeOrder S{(const int*)(ws + WS_TILE), tlo, nt, D_ / 256, G, bx};
          pg8::EpiStoreBf16 E{(bf16*)(ws + WS_AMOE), D_, D_ / 256};
          pg8::gemm_phase<pg8::EpiStoreBf16, pg8::MoeOrder, true, true>(L, g, S, E); }
        GRID_BAR();
    }
    }
    if constexpr ((PH_MASK >> 18) & 1) {
    const int lane = lane_opaque();
    for (int t = gw; t < S_; t += NGW) combine_token(ws, args.out, off, t, lane);
    }
}

extern "C" void kernel_launch(void* const* d_in, const int* in_sizes, int n_in, void* d_out, int out_size, void* d_ws, size_t ws_size, hipStream_t stream) {
    static int grid = 0;
    if (grid == 0) {
        if (n_in != 39 || out_size != S_ * D_ || ws_size < WS_END) { fprintf(stderr, "kernel_launch: unexpected shapes (n_in %d out %d ws %zu)\n", n_in, out_size, ws_size); grid = -1; return; }
        int dev = 0, cus = 0, per_cu = 0;
        if (hipGetDevice(&dev) != hipSuccess || hipDeviceGetAttribute(&cus, hipDeviceAttributeMultiprocessorCount, dev) != hipSuccess) { grid = -1; return; }
        if (hipFuncSetAttribute((const void*)fwd_kernel, hipFuncAttributeMaxDynamicSharedMemorySize, LDS_BYTES) != hipSuccess) { grid = -1; return; }
        if (hipOccupancyMaxActiveBlocksPerMultiprocessor(&per_cu, (const void*)fwd_kernel, 512, LDS_BYTES) != hipSuccess || per_cu < 1) { fprintf(stderr, "kernel_launch: occupancy query says %d\n", per_cu); }
        (void)hipGetLastError();
        grid = cus;
    }
    if (grid < 0) return;
    if (hipMemsetAsync((char*)d_ws + WS_CTL, 0, CTL_ZERO_BYTES, stream) != hipSuccess) return;
    Args a{};
    for (int i = 0; i < 39; ++i) a.in[i] = (const float*)d_in[i];
    a.out = (float*)d_out; a.ws = (unsigned char*)d_ws;
    hipLaunchKernelGGL(fwd_kernel, dim3(grid), dim3(512), LDS_BYTES, stream, a);
}
```

```cpp
#include <hip/hip_runtime.h>
#include <cstdio>
#include <cstdint>
namespace pg8 {
#define PG8_LAS __attribute__((address_space(3)))
typedef unsigned short bf16_t;
typedef short bf16x8 __attribute__((ext_vector_type(8)));
typedef float f32x4 __attribute__((ext_vector_type(4)));
typedef unsigned u32x4 __attribute__((ext_vector_type(4)));
constexpr int BM = 256, BK = 64, HALF = 128, HTB = HALF * BK * 2  , STAGE_BYTES = 8 * HTB, NXCD = 8, WGM = 8;

__host__ __device__ __forceinline__ int lds_byte(int r, int c) { const int st = (r >> 4) * 2 + (c >> 5), rr = r & 15, cc = c & 31, ob = rr * 64 + cc * 2; return st * 1024 + (ob ^ (((ob >> 9) & 1) << 5)); }
__host__ __device__ __forceinline__ void stage_rc(int b, int& R, int& C) { const int st = b / 1024, sb = b % 1024, swz = sb ^ (((sb >> 9) & 1) << 5); R = (st >> 1) * 16 + swz / 64; C = (st & 1) * 32 + (swz % 64) / 2; }
__host__ __device__ __forceinline__ int perm32(int rho) { const int n = rho >> 4, i = rho & 15; return 8 * (i >> 2) + 4 * n + (i & 3); }

struct Unit { int pm, pn; };
struct Gemm { const bf16_t* A; const bf16_t* Bt; int M, N, K; };

struct StaticOrder {
    int nM, nN, nwg, G, c;
    __host__ __device__ void init(int M, int N, int G_, int c_) { nM = M / BM; nN = N / BM; nwg = nM * nN; G = G_; c = c_; }
    __host__ __device__ bool next(int i, Unit& u) const {
        const long L = (long)i * G + c; if (L >= nwg) return false;
        int wgid = (int)L; { const int q = nwg / NXCD, r = nwg % NXCD, xcd = wgid % NXCD, off = wgid / NXCD; wgid = (xcd < r ? xcd * (q + 1) : r * (q + 1) + (xcd - r) * q) + off; }
        const int nig = WGM * nN, gid = wgid / nig, fm = gid * WGM, gsz = (nM - fm) < WGM ? (nM - fm) : WGM;
        u.pm = fm + ((wgid % nig) % gsz); u.pn = (wgid % nig) / gsz; return true;
    }
    __device__ __forceinline__ void a_ready(const Unit&) const {}
    __device__ __forceinline__ void done(const Unit&) const {}
};

__device__ __forceinline__ unsigned cvt_pk_bf16(float lo, float hi) { unsigned r; asm volatile("v_cvt_pk_bf16_f32 %0, %1, %2" : "=v"(r) : "v"(lo), "v"(hi)); return r; }
struct EpiStoreBf16 {
    static constexpr bool PERM = true, AFTER_DRAIN = false;
    bf16_t* O; int ldc; int ntn;
    __device__ __forceinline__ void operator()(const f32x4 (&acc)[2][2][4][2], const Unit& u, int wr, int wc, int fr, int fq) const {
        const int row0 = u.pm * BM + wr * 64 + fr; const int pn = ntn ? (u.pn % ntn) : u.pn;
        const int col0 = pn * BM + wc * 32 + 8 * fq;
#pragma unroll
        for (int ai = 0; ai < 2; ++ai)
#pragma unroll
            for (int m = 0; m < 4; ++m) { bf16_t* rowp = O + (size_t)(row0 + ai * HALF + m * 16) * ldc + col0;
#pragma unroll
                for (int bj = 0; bj < 2; ++bj) { const f32x4 v0 = acc[ai][bj][m][0], v1 = acc[ai][bj][m][1];
                    u32x4 w; w.x = cvt_pk_bf16(v0[0], v0[1]); w.y = cvt_pk_bf16(v0[2], v0[3]); w.z = cvt_pk_bf16(v1[0], v1[1]); w.w = cvt_pk_bf16(v1[2], v1[3]);
                    *(u32x4*)(rowp + bj * HALF) = w; } }
    }
};
struct EpiResF32 {
    static constexpr bool PERM = false, AFTER_DRAIN = false;
    const float* base; float* out; int ldc;
    __device__ __forceinline__ void operator()(const f32x4 (&acc)[2][2][4][2], const Unit& u, int wr, int wc, int fr, int fq) const {
        const int row0 = u.pm * BM + wr * 64 + fr, col0 = u.pn * BM + wc * 32 + 4 * fq;
#pragma unroll
        for (int ai = 0; ai < 2; ++ai)
#pragma unroll
            for (int m = 0; m < 4; ++m) { const size_t off = (size_t)(row0 + ai * HALF + m * 16) * ldc + col0;
#pragma unroll
                for (int bj = 0; bj < 2; ++bj)
#pragma unroll
                    for (int n = 0; n < 2; ++n) { const f32x4 b = *(const f32x4*)(base + off + bj * HALF + n * 16); *(f32x4*)(out + off + bj * HALF + n * 16) = b + acc[ai][bj][m][n]; } }
    }
};
struct EpiSwiGLU {
    static constexpr bool PERM = true, AFTER_DRAIN = false;
    bf16_t* O; int ldc; int ntn;
    __device__ __forceinline__ void operator()(const f32x4 (&acc)[2][2][4][2], const Unit& u, int wr, int wc, int fr, int fq) const {
        const int row0 = u.pm * BM + wr * 64 + fr; const int pn = ntn ? (u.pn % ntn) : u.pn;
        const int col0 = pn * HALF + wc * 32 + 8 * fq;
#pragma unroll
        for (int ai = 0; ai < 2; ++ai)
#pragma unroll
            for (int m = 0; m < 4; ++m) { bf16_t* rowp = O + (size_t)(row0 + ai * HALF + m * 16) * ldc + col0;
                float r[8];
#pragma unroll
                for (int n = 0; n < 2; ++n)
#pragma unroll
                    for (int i = 0; i < 4; ++i) { const float g = acc[ai][0][m][n][i], up = acc[ai][1][m][n][i]; r[n * 4 + i] = g * __builtin_amdgcn_rcpf(1.0f + __expf(-g)) * up; }
                u32x4 w; w.x = cvt_pk_bf16(r[0], r[1]); w.y = cvt_pk_bf16(r[2], r[3]); w.z = cvt_pk_bf16(r[4], r[5]); w.w = cvt_pk_bf16(r[6], r[7]);
                *(u32x4*)rowp = w; }
    }
};
struct MoeOrder {
    const int* tile_exp; int tlo, nt, nN, G, c;
    __device__ __forceinline__ bool next(int i, Unit& u) const {
        const int L = i * G + c; if (nt <= 0 || L >= nt * nN) return false;
        const int t = tlo + (L % nt), cn = L / nt;
        const int e = __builtin_amdgcn_readfirstlane(__hip_atomic_load(tile_exp + t, __ATOMIC_RELAXED, __HIP_MEMORY_SCOPE_AGENT));
        u.pm = t; u.pn = e * nN + cn; return true;
    }
    __device__ __forceinline__ void a_ready(const Unit&) const {}
    __device__ __forceinline__ void done(const Unit&) const {}
};
template <class Epi, class Sched, bool ALIGN_EPI = false, bool SP2 = false>
__device__ __forceinline__ void gemm_phase(PG8_LAS unsigned char* lds, const Gemm g, const Sched& S, const Epi& E) {
    int tid_ = threadIdx.x; asm volatile("" : "+v"(tid_));
    const int tid = tid_, wid = __builtin_amdgcn_readfirstlane(tid >> 6), lane = tid & 63, wr = wid >> 2, wc = wid & 3, fr = lane & 15, fq = lane >> 4;
    const int K = g.K, nt = K / BK;
    unsigned voffA[2], voffB[2];
#pragma unroll
    for (int i = 0; i < 2; ++i) { int R, C; stage_rc(tid * 16 + i * 8192, R, C); const int Rb = Epi::PERM ? ((R & ~31) + perm32(R & 31)) : R;
        voffA[i] = (unsigned)(R * K + C) * 2u; voffB[i] = (unsigned)(Rb * K + C) * 2u; }
    const size_t kstep = (size_t)(BK * 2);
    const size_t hstep = (size_t)HALF * K * 2;
    const size_t tstep = 2 * hstep;
    const unsigned ldsw = (unsigned)wid * 1024u;
    const int aoff = lds_byte(wr * 64 + fr, fq * 8), boff = lds_byte(wc * 32 + fr, fq * 8);
#define PG8_SA(b, h) (((b) * 2 + (h)) * HTB)
#define PG8_SB(b, h) ((4 + (b) * 2 + (h)) * HTB)
#define PG8_STAGE(bufoff, gbase, voff) do { _Pragma("unroll") for (int _i = 0; _i < 2; ++_i) \
        __builtin_amdgcn_global_load_lds((const unsigned*)((const char*)(gbase) + (voff)[_i]), (PG8_LAS unsigned*)(lds + (bufoff) + ldsw + _i * 8192), 16, 0, 0); } while (0)
#define PG8_LDA(dst, b, h) do { _Pragma("unroll") for (int m = 0; m < 4; ++m) _Pragma("unroll") for (int k = 0; k < 2; ++k) dst[m][k] = *(const PG8_LAS bf16x8*)(lds + PG8_SA(b, h) + aoff + m * 2048 + k * 1024); } while (0)
#define PG8_LDB(dst, b, h) do { _Pragma("unroll") for (int n = 0; n < 2; ++n) _Pragma("unroll") for (int k = 0; k < 2; ++k) dst[n][k] = *(const PG8_LAS bf16x8*)(lds + PG8_SB(b, h) + boff + n * 2048 + k * 1024); } while (0)
#define PG8_MMA(ai, bj, At, Bt) do { __builtin_amdgcn_s_setprio(1); _Pragma("unroll") for (int m = 0; m < 4; ++m) _Pragma("unroll") for (int n = 0; n < 2; ++n) _Pragma("unroll") for (int k = 0; k < 2; ++k) \
        acc[ai][bj][m][n] = __builtin_amdgcn_mfma_f32_16x16x32_bf16(Bt[n][k], At[m][k], acc[ai][bj][m][n], 0, 0, 0); __builtin_amdgcn_s_setprio(0); } while (0)
#define PG8_WAIT_V(n) asm volatile("s_waitcnt vmcnt(" #n ")" ::: "memory")
#define PG8_WAIT_L(n) asm volatile("s_waitcnt lgkmcnt(" #n ")" ::: "memory")
#define PG8_BAR __builtin_amdgcn_s_barrier()
#define PG8_SCHED __builtin_amdgcn_sched_barrier(0)
    Unit cur, nxt; int ui = 0;
    if (!S.next(0, cur)) return;
    f32x4 acc[2][2][4][2];
#pragma unroll
    for (int a = 0; a < 2; ++a)
#pragma unroll
        for (int b = 0; b < 2; ++b)
#pragma unroll
            for (int m = 0; m < 4; ++m)
#pragma unroll
                for (int n = 0; n < 2; ++n) acc[a][b][m][n] = (f32x4){0.f, 0.f, 0.f, 0.f};
    bf16x8 At[4][2], B0[2][2], B1[2][2];
    const char* cA = (const char*)g.A + (size_t)cur.pm * tstep; const char* cB = (const char*)g.Bt + (size_t)cur.pn * tstep;
    S.a_ready(cur);
    if constexpr (SP2) {
        PG8_STAGE(PG8_SB(0, 0), cB, voffB); PG8_STAGE(PG8_SB(0, 1), cB + hstep, voffB); PG8_STAGE(PG8_SA(0, 0), cA, voffA); PG8_STAGE(PG8_SA(0, 1), cA + hstep, voffA);
        if (wr == 1) PG8_BAR;
        PG8_WAIT_V(2); PG8_BAR;
        PG8_STAGE(PG8_SB(1, 0), cB + kstep, voffB); PG8_STAGE(PG8_SA(1, 0), cA + kstep, voffA); PG8_STAGE(PG8_SB(1, 1), cB + hstep + kstep, voffB);
        PG8_WAIT_V(6); PG8_BAR;
    } else {
        PG8_STAGE(PG8_SB(0, 0), cB, voffB); PG8_STAGE(PG8_SA(0, 0), cA, voffA); PG8_STAGE(PG8_SB(0, 1), cB + hstep, voffB); PG8_STAGE(PG8_SA(0, 1), cA + hstep, voffA);
        if (wr == 1) PG8_BAR;
        PG8_WAIT_V(4); PG8_BAR;
        PG8_STAGE(PG8_SB(1, 0), cB + kstep, voffB); PG8_STAGE(PG8_SA(1, 0), cA + kstep, voffA); PG8_STAGE(PG8_SB(1, 1), cB + hstep + kstep, voffB);
        PG8_WAIT_V(6); PG8_BAR;
    }
    for (;;) {
        const bool has_next = S.next(ui + 1, nxt);
        const char* nA = has_next ? (const char*)g.A + (size_t)nxt.pm * tstep : cA; const char* nB = has_next ? (const char*)g.Bt + (size_t)nxt.pn * tstep : cB;
        for (int t = 0; t < nt; t += 2) {
            const bool last = (t == nt - 2);
            const char* a1 = cA + (size_t)(t + 1) * kstep;
            const char* a2 = last ? nA : cA + (size_t)(t + 2) * kstep; const char* b2 = last ? nB : cB + (size_t)(t + 2) * kstep;
            const char* a3 = a2 + kstep; const char* b3 = b2 + kstep;
            if (last && has_next) S.a_ready(nxt);
            if constexpr (SP2) {
            PG8_LDB(B0, 0, 0); PG8_LDB(B1, 0, 1); PG8_SCHED; PG8_LDA(At, 0, 0); PG8_STAGE(PG8_SA(1, 1), a1 + hstep, voffA);
            PG8_WAIT_V(8); PG8_WAIT_L(0); PG8_BAR; PG8_MMA(0, 0, At, B0); PG8_MMA(0, 1, At, B1); PG8_BAR; PG8_SCHED;
            PG8_LDA(At, 0, 1); PG8_STAGE(PG8_SB(0, 0), b2, voffB); PG8_STAGE(PG8_SB(0, 1), b2 + hstep, voffB); PG8_STAGE(PG8_SA(0, 0), a2, voffA);
            PG8_WAIT_V(8); PG8_WAIT_L(0); PG8_BAR; PG8_MMA(1, 0, At, B0); PG8_MMA(1, 1, At, B1); PG8_BAR; PG8_SCHED;
            PG8_LDB(B0, 1, 0); PG8_LDB(B1, 1, 1); PG8_SCHED; PG8_LDA(At, 1, 0); PG8_STAGE(PG8_SA(0, 1), a2 + hstep, voffA);
            PG8_WAIT_V(8); PG8_WAIT_L(0); PG8_BAR; PG8_MMA(0, 0, At, B0); PG8_MMA(0, 1, At, B1); PG8_BAR; PG8_SCHED;
            PG8_LDA(At, 1, 1); PG8_STAGE(PG8_SB(1, 0), b3, voffB); PG8_STAGE(PG8_SB(1, 1), b3 + hstep, voffB); PG8_STAGE(PG8_SA(1, 0), a3, voffA);
            PG8_WAIT_V(8); PG8_WAIT_L(0); PG8_BAR; PG8_MMA(1, 0, At, B0); PG8_MMA(1, 1, At, B1); PG8_BAR; PG8_SCHED;
            } else {
            PG8_LDB(B0, 0, 0); PG8_SCHED; PG8_LDA(At, 0, 0); PG8_STAGE(PG8_SA(1, 1), a1 + hstep, voffA);
            PG8_WAIT_L(8); PG8_BAR; PG8_WAIT_L(0); PG8_MMA(0, 0, At, B0); PG8_BAR; PG8_SCHED;
            PG8_LDB(B1, 0, 1); PG8_STAGE(PG8_SB(0, 0), b2, voffB);
            PG8_BAR; PG8_WAIT_L(0); PG8_MMA(0, 1, At, B1); PG8_BAR;
            PG8_LDA(At, 0, 1); PG8_STAGE(PG8_SA(0, 0), a2, voffA);
            PG8_BAR; PG8_WAIT_L(0); PG8_MMA(1, 0, At, B0); PG8_BAR; PG8_SCHED;
            PG8_STAGE(PG8_SB(0, 1), b2 + hstep, voffB);
            PG8_WAIT_V(6); PG8_BAR; PG8_MMA(1, 1, At, B1); PG8_BAR;
            PG8_LDB(B0, 1, 0); PG8_SCHED; PG8_LDA(At, 1, 0); PG8_STAGE(PG8_SA(0, 1), a2 + hstep, voffA);
            PG8_WAIT_L(8); PG8_BAR; PG8_WAIT_L(0); PG8_MMA(0, 0, At, B0); PG8_BAR; PG8_SCHED;
            PG8_LDB(B1, 1, 1); PG8_STAGE(PG8_SB(1, 0), b3, voffB);
            PG8_BAR; PG8_WAIT_L(0); PG8_MMA(0, 1, At, B1); PG8_BAR;
            PG8_LDA(At, 1, 1); PG8_STAGE(PG8_SA(1, 0), a3, voffA);
            PG8_BAR; PG8_WAIT_L(0); PG8_MMA(1, 0, At, B0); PG8_BAR; PG8_SCHED;
            PG8_STAGE(PG8_SB(1, 1), b3 + hstep, voffB);
            PG8_WAIT_V(6); PG8_BAR; PG8_MMA(1, 1, At, B1); PG8_BAR;
            }
        }
        if constexpr (ALIGN_EPI) { if (wr == 0) PG8_BAR; }
        if constexpr (!Epi::AFTER_DRAIN) { E(acc, cur, wr, wc, fr, fq); S.done(cur); }
        if (!has_next) break;
#pragma unroll
        for (int a = 0; a < 2; ++a)
#pragma unroll
            for (int b = 0; b < 2; ++b)
#pragma unroll
                for (int m = 0; m < 4; ++m)
#pragma unroll
                    for (int n = 0; n < 2; ++n) acc[a][b][m][n] = (f32x4){0.f, 0.f, 0.f, 0.f};
        cur = nxt; cA = nA; cB = nB; ++ui;
        if constexpr (ALIGN_EPI) { if (wr == 1) PG8_BAR; }
    }
    PG8_WAIT_V(0);
    if constexpr (!ALIGN_EPI) { if (wr == 0) PG8_BAR; }
    PG8_BAR;
    if constexpr (Epi::AFTER_DRAIN) { E.fused(acc, cur, wr, wc, fr, fq, lds, wid, lane); S.done(cur); }
#undef PG8_SA
#undef PG8_SB
#undef PG8_STAGE
#undef PG8_LDA
#undef PG8_LDB
#undef PG8_MMA
#undef PG8_WAIT_V
#undef PG8_WAIT_L
#undef PG8_BAR
#undef PG8_SCHED
}
}
constexpr int S_ = 16384, D_ = 1024;
constexpr int EVEN_IN = 3072, LORA_N = 512, FF0 = 2816, ODD_IN = 3600, ODD_PAD = 3840, FFE = 3584, NEXP = 8;
constexpr int MOE_ROWS = 32768 + 8 * 256;
constexpr int MOE_BATCH_TILES = 64;
constexpr size_t MiB = 1u << 20;
constexpr size_t WS_CTL = 0, CTL_ZERO_BYTES = 1 * MiB;
constexpr size_t WS_WIN0 = 2 * MiB, WS_WL = 8 * MiB, WS_WOUT0 = 9 * MiB, WS_WGU0 = 11 * MiB, WS_WD0 = 22 * MiB, WS_WIN1 = 28 * MiB, WS_WOUT1 = 36 * MiB;
constexpr size_t WS_TOK = 38 * MiB;
constexpr size_t WS_TILE = 39 * MiB;
constexpr size_t WS_A = 40 * MiB;
constexpr size_t WS_H = WS_A, WS_HX = WS_A + 32 * MiB;
constexpr size_t WS_LW0 = WS_A, WS_LW1 = WS_A + 32 * MiB, WS_R = WS_A + 64 * MiB, WS_V = WS_A + 80 * MiB, WS_KK = WS_A + 96 * MiB, WS_KD0 = WS_A + 112 * MiB, WS_KD1 = WS_A + 128 * MiB, WS_B0 = WS_A + 144 * MiB;
constexpr size_t WS_H2 = WS_A, WS_H3 = WS_A + 32 * MiB;
constexpr size_t WS_WMGU = WS_A, WS_WMD = WS_A + 112 * MiB;
constexpr size_t WS_B = 208 * MiB;
constexpr size_t WS_PROJ0 = WS_B, WS_LORA = WS_B + 96 * MiB, WS_QN = WS_B + 112 * MiB, WS_KN = WS_B + 128 * MiB, WS_Y = WS_B + 144 * MiB;
constexpr size_t WS_B1 = WS_B + 176 * MiB, WS_GATE = WS_B + 192 * MiB, WS_BONUS = WS_B + 208 * MiB, WS_Y0 = WS_LORA, WS_Y1 = WS_B + 224 * MiB;
constexpr size_t WS_ACT0 = WS_B, WS_PROJ1 = WS_B + 88 * MiB;
constexpr size_t WS_QD = WS_B, WS_KD = WS_B + 16 * MiB, WS_VD = WS_B + 32 * MiB, WS_YCAT1 = WS_B + 48 * MiB, WS_GB = WS_B + 80 * MiB  ;
constexpr size_t WS_O0 = WS_B + 208 * MiB, WS_O1 = WS_B + 224 * MiB;
constexpr size_t WS_AMOE = WS_B, WS_MACT = WS_B + 88 * MiB;
constexpr size_t WS_END = 448 * MiB;
static_assert(WS_MACT + (size_t)MOE_BATCH_TILES * 256 * FFE * 2 <= WS_END, "moe act");
static_assert(WS_AMOE + (size_t)MOE_ROWS * D_ * 2 <= WS_MACT, "amoe");
static_assert(WS_PROJ1 + (size_t)S_ * ODD_PAD * 2 <= WS_O0, "proj1");
constexpr int CW_CNT = 64;
constexpr int CW_BAR = 4096;
constexpr int LDS_BYTES = 151552, LDS_ZERO_OFF = LDS_BYTES - 512, MISC_OFF = LDS_ZERO_OFF + 64;

#define GAS __attribute__((address_space(1)))
#define LAS __attribute__((address_space(3)))
#define DI __device__ __forceinline__
typedef unsigned short bf16;
typedef unsigned v4u __attribute__((ext_vector_type(4)));
typedef float f32x4 __attribute__((ext_vector_type(4)));
typedef GAS unsigned gu32;
#define LDS_WAIT() asm volatile("s_waitcnt lgkmcnt(0)" ::: "memory")
DI unsigned f2bf(float f) { unsigned u = __builtin_bit_cast(unsigned, f); return (u + 0x7fffu + ((u >> 16) & 1u)) >> 16; }
DI unsigned pk2(float lo, float hi) { return f2bf(lo) | (f2bf(hi) << 16); }
DI float bflo(unsigned w) { return __uint_as_float(w << 16); }
DI float bfhi(unsigned w) { return __uint_as_float(w & 0xffff0000u); }
DI float bf2f(bf16 b) { return __uint_as_float(((unsigned)b) << 16); }
DI void ld8(const bf16* p, float (&v)[8]) { const v4u w = *(const v4u*)p; v[0] = bflo(w.x); v[1] = bfhi(w.x); v[2] = bflo(w.y); v[3] = bfhi(w.y); v[4] = bflo(w.z); v[5] = bfhi(w.z); v[6] = bflo(w.w); v[7] = bfhi(w.w); }
DI void st8(bf16* p, const float (&v)[8]) { v4u w; w.x = pk2(v[0], v[1]); w.y = pk2(v[2], v[3]); w.z = pk2(v[4], v[5]); w.w = pk2(v[6], v[7]); *(v4u*)p = w; }
DI void ld8f(const float* p, float (&v)[8]) { const f32x4 a = *(const f32x4*)p, b = *(const f32x4*)(p + 4); v[0] = a.x; v[1] = a.y; v[2] = a.z; v[3] = a.w; v[4] = b.x; v[5] = b.y; v[6] = b.z; v[7] = b.w; }
DI void st8f(float* p, const float (&v)[8]) { *(f32x4*)p = (f32x4){v[0], v[1], v[2], v[3]}; *(f32x4*)(p + 4) = (f32x4){v[4], v[5], v[6], v[7]}; }
DI float wave_sum(float v) {
#pragma unroll
    for (int o = 1; o < 64; o <<= 1) v += __shfl_xor(v, o);
    return v;
}
template <int W> DI float grp_sum(float v) {
#pragma unroll
    for (int o = 1; o < W; o <<= 1) v += __shfl_xor(v, o);
    return v;
}
DI float sigmoidf_(float x) { return 1.0f / (1.0f + __expf(-x)); }
DI float softplusf_(float x) { return x > 20.f ? x : log1pf(__expf(x)); }
DI float siluf_(float x) { return x / (1.0f + __expf(-x)); }

struct Args { const float* in[39]; float* out; unsigned char* ws; };

DI void transpose_item(const float* W, int K, int N, bf16* WT, int rowbase, LAS float* scr, int k0, int n0, int lane) {
    const int nn = n0 + (lane & 31); const bool ok = nn < N;
#pragma unroll 8
    for (int i = 0; i < 32; ++i) { const int kk = 2 * i + (lane >> 5); scr[kk * 33 + (lane & 31)] = ok ? W[(size_t)(k0 + kk) * N + nn] : 0.f; }
    LDS_WAIT(); asm volatile("" ::: "memory");
    const int c = lane & 7;
#pragma unroll
    for (int j = 0; j < 4; ++j) { const int n = (lane >> 3) + 8 * j; const LAS float* s = scr + (8 * c) * 33 + n;
        v4u o; o.x = pk2(s[0 * 33], s[1 * 33]); o.y = pk2(s[2 * 33], s[3 * 33]); o.z = pk2(s[4 * 33], s[5 * 33]); o.w = pk2(s[6 * 33], s[7 * 33]);
        *(v4u*)(WT + (size_t)(rowbase + n) * K + k0 + 8 * c) = o; }
    LDS_WAIT(); asm volatile("" ::: "memory");
}
DI bool transpose_job(int& r, const float* W, int K, int N, int Npad, bf16* WT, int row_off, int grp, int sel, LAS float* scr, int lane) {
    const int nblk = Npad / 32, cnt = (K / 64) * nblk;
    if (r >= cnt) { r -= cnt; return false; }
    const int kb = r / nblk, nb = r % nblk, n0 = 32 * nb;
    const int rowbase = row_off + (grp ? (n0 / grp) * (2 * grp) + sel * grp + (n0 % grp) : n0);
    transpose_item(W, K, N, WT, rowbase, scr, 64 * kb, n0, lane);
    return true;
}
#define XB_TMO      128
#define XB_XCNT(j)  (256  + 64 * (j))
#define XB_XSUB(j)  (1280 + 64 * (j))
#define XB_XGEN(j)  (2304 + 64 * (j))
#define XB_TOP      3328
#define XB_TOPGEN   3392
#define XCD_BAR_WORDS 3456
#define XB_SPIN_CAP (1u << 22)

__device__ __forceinline__ unsigned xb_ld(unsigned* p)              { return __hip_atomic_load(p, __ATOMIC_RELAXED, __HIP_MEMORY_SCOPE_AGENT); }
__device__ __forceinline__ unsigned xb_add(unsigned* p, unsigned v) { return __hip_atomic_fetch_add(p, v, __ATOMIC_RELAXED, __HIP_MEMORY_SCOPE_AGENT); }
__device__ __forceinline__ unsigned xb_xcc_id() { return (unsigned)__builtin_amdgcn_s_getreg((3 << 11) | 20) & 0xFu; }
#define XB_SPIN(cond, bar) do { unsigned _sp = 0; while (cond) { __builtin_amdgcn_s_sleep(1); \
    if ((++_sp & 255u) == 0u) { if (xb_ld(&(bar)[XB_TMO])) break; if (_sp > XB_SPIN_CAP) { atomicAdd(&(bar)[XB_TMO], 1u); break; } } } } while (0)

struct XcdBarrier {
    unsigned* bar; unsigned x;
    volatile LAS unsigned* st;
};

__device__ __forceinline__ XcdBarrier xcd_barrier_post(unsigned* bar, volatile LAS unsigned* st) {
    XcdBarrier b; b.bar = bar; b.x = xb_xcc_id(); b.st = st;
    if (threadIdx.x == 0) (void)xb_add(&bar[XB_XCNT(b.x)], 1u);
    return b;
}
__device__ __forceinline__ void xcd_barrier_complete(unsigned* bar, unsigned x, unsigned& nloc, unsigned& nx) {
    const unsigned G = gridDim.x * gridDim.y * gridDim.z;
    unsigned sum, cnt, mine, sp = 0u;
    for (;;) {
        sum = 0u; cnt = 0u; mine = 0u;
#pragma unroll
        for (unsigned j = 0; j < 16; ++j) { const unsigned c = xb_ld(&bar[XB_XCNT(j)]); sum += c; cnt += (c > 0u) ? 1u : 0u; mine = (j == x) ? c : mine; }
        if (sum == G) break;
        __builtin_amdgcn_s_sleep(1);
        if ((++sp & 255u) == 0u) { if (xb_ld(&bar[XB_TMO])) break; if (sp > XB_SPIN_CAP) { atomicAdd(&bar[XB_TMO], 1u); break; } }
    }
    nloc = mine > 0u ? mine : 1u; nx = cnt > 0u ? cnt : 1u;
}

__device__ __forceinline__ void xcd_barrier(const XcdBarrier& b) {
    asm volatile("s_waitcnt vmcnt(0)" ::: "memory");
    __syncthreads();
    if (threadIdx.x == 0) {
        unsigned* bar = b.bar;
        __builtin_amdgcn_s_waitcnt(0);
        unsigned nloc = b.st[0], nx = b.st[1];
        if (nloc == 0u) { xcd_barrier_complete(bar, b.x, nloc, nx); b.st[0] = nloc; b.st[1] = nx; }
        const unsigned old = xb_add(&bar[XB_XSUB(b.x)], 1u);
        const unsigned gen = old / nloc;
        if (old + 1u == (gen + 1u) * nloc) {
            __builtin_amdgcn_fence(__ATOMIC_RELEASE, "agent");
            asm volatile("s_waitcnt vmcnt(0)" ::: "memory");
            const unsigned og = xb_add(&bar[XB_TOP], 1u);
            const unsigned tg = og / nx;
            if (og + 1u == (tg + 1u) * nx) xb_add(&bar[XB_TOPGEN], 1u);
            else XB_SPIN(xb_ld(&bar[XB_TOPGEN]) == tg, bar);
            __builtin_amdgcn_fence(__ATOMIC_ACQUIRE, "agent");
            xb_add(&bar[XB_XGEN(b.x)], 1u);
            asm volatile("s_waitcnt vmcnt(0)" ::: "memory");
        } else {
            XB_SPIN(xb_ld(&bar[XB_XGEN(b.x)]) == gen, bar);
            __builtin_amdgcn_fence(__ATOMIC_ACQUIRE, "agent");
            asm volatile("s_waitcnt vmcnt(0)" ::: "memory");
        }
    }
    __syncthreads();
}
DI float row_rstd(const f32x4 (&v)[4]) {
    float s = 0.f;
#pragma unroll
    for (int j = 0; j < 4; ++j) s += (v[j].x * v[j].x + v[j].y * v[j].y) + (v[j].z * v[j].z + v[j].w * v[j].w);
    return 1.0f / sqrtf(wave_sum(s) * (1.0f / D_) + 1e-6f);
}
DI void load_row(const float* x, int t, int lane, f32x4 (&v)[4]) {
    if (t >= 0 && t < S_) { const f32x4* p = (const f32x4*)(x + (size_t)t * D_) + lane;
#pragma unroll
        for (int j = 0; j < 4; ++j) v[j] = p[64 * j];
    } else {
#pragma unroll
        for (int j = 0; j < 4; ++j) v[j] = (f32x4){0.f, 0.f, 0.f, 0.f};
    }
}
DI void store_row_bf16(bf16* o, int lane, const f32x4 (&v)[4]) {
    unsigned long long* o8 = (unsigned long long*)o + lane;
#pragma unroll
    for (int j = 0; j < 4; ++j) o8[64 * j] = (unsigned long long)pk2(v[j].x, v[j].y) | ((unsigned long long)pk2(v[j].z, v[j].w) << 32);
}
DI void norm_rows(const float* x, const float* w, const float* mu  , bf16* H, bf16* HX, int gw, int NGW, int lane) {
    f32x4 wv[4];
#pragma unroll
    for (int j = 0; j < 4; ++j) wv[j] = ((const f32x4*)w)[lane + 64 * j];
    for (int t = gw; t < S_; t += NGW) {
        f32x4 v[4]; load_row(x, t, lane, v); const float rs = row_rstd(v);
#pragma unroll
        for (int j = 0; j < 4; ++j) v[j] = v[j] * rs * wv[j];
        store_row_bf16(H + (size_t)t * D_, lane, v);
        if (mu) {
            f32x4 p[4], n[4]; load_row(x, t - 1, lane, p); load_row(x, t + 1, lane, n);
            const float rp = row_rstd(p), rn = row_rstd(n);
#pragma unroll
            for (int j = 0; j < 4; ++j) { const f32x4 m0 = ((const f32x4*)mu)[lane + 64 * j], m1 = ((const f32x4*)(mu + D_))[lane + 64 * j];
                const f32x4 hp = p[j] * rp * wv[j], hn = n[j] * rn * wv[j]; p[j] = v[j] + m0 * (hp - v[j]) + m1 * (hn - v[j]); }
            store_row_bf16(HX + (size_t)t * D_, lane, p);
        }
    }
}

DI void prep0_token(const Args& a, unsigned char* ws, LAS float* scr, int t, int lane) {
    const bf16* P = (const bf16*)(ws + WS_PROJ0) + (size_t)t * EVEN_IN;
    const int c0 = 8 * lane;
    {
        float q[8], k[8]; ld8(P + c0, q); ld8(P + 512 + c0, k);
        float sq = 0.f, sk = 0.f;
#pragma unroll
        for (int i = 0; i < 8; ++i) { sq += q[i] * q[i]; sk += k[i] * k[i]; }
        sq = grp_sum<8>(sq); sk = grp_sum<8>(sk);
        const float rq = 1.0f / sqrtf(sq * (1.0f / 64.f) + 1e-6f), rk = 1.0f / sqrtf(sk * (1.0f / 64.f) + 1e-6f);
        const int d0 = 8 * (lane & 7);
        float qw[8], kw[8]; ld8f(a.in[4] + d0, qw); ld8f(a.in[5] + d0, kw);
#pragma unroll
        for (int i = 0; i < 8; ++i) { q[i] = q[i] * rq * qw[i]; k[i] = k[i] * rk * kw[i]; }
        const float pos = (float)((const int*)a.in[1])[t];
        float qo[8], ko[8];
#pragma unroll
        for (int i = 0; i < 8; ++i) { qo[i] = __shfl_xor(q[i], 1); ko[i] = __shfl_xor(k[i], 1); }
        const int sub = lane & 7;
        if (sub < 2) {
#pragma unroll
            for (int i = 0; i < 8; ++i) {
                const float inv = powf(500000.0f, -(float)i / 8.0f); float sn, cs; sincosf(pos * inv, &sn, &cs);
                if (sub == 0) { q[i] = q[i] * cs - qo[i] * sn; k[i] = k[i] * cs - ko[i] * sn; }
                else          { q[i] = q[i] * cs + qo[i] * sn; k[i] = k[i] * cs + ko[i] * sn; }
            }
        }
#pragma unroll
        for (int i = 0; i < 8; ++i) q[i] *= 0.125f;
        st8((bf16*)(ws + WS_QN) + (size_t)t * 512 + c0, q); st8((bf16*)(ws + WS_KN) + (size_t)t * 512 + c0, k);
    }
    float r[8], k[8], v[8];
    {
        const bool hp = t > 0, hn = t < S_ - 1;
        const float* mu = a.in[6];
#pragma unroll
        for (int part = 0; part < 3; ++part) {
            float cur[8], pv[8], nx[8], m0[8], m1[8];
            ld8(P + 1536 + part * 512 + c0, cur);
            if (hp) ld8(P - EVEN_IN + 1536 + part * 512 + c0, pv); else {
#pragma unroll
                for (int i = 0; i < 8; ++i) pv[i] = 0.f; }
            if (hn) ld8(P + EVEN_IN + 1536 + part * 512 + c0, nx); else {
#pragma unroll
                for (int i = 0; i < 8; ++i) nx[i] = 0.f; }
            ld8f(mu + part * 512 + c0, m0); ld8f(mu + 1536 + part * 512 + c0, m1);
#pragma unroll
            for (int i = 0; i < 8; ++i) { const float o = cur[i] + m0[i] * (pv[i] - cur[i]) + m1[i] * (nx[i] - cur[i]);
                if (part == 0) r[i] = o; else if (part == 1) k[i] = o; else v[i] = o; }
        }
    }
    float lv[8];
    { const bf16* L = (const bf16*)(ws + WS_LORA) + (size_t)t * LORA_N; ld8(L + c0, lv);
#pragma unroll
      for (int i = 0; i < 8; ++i) { if (lane < 16) lv[i] = tanhf(lv[i]); else if (lane >= 32 && lane < 48) lv[i] = sigmoidf_(lv[i]); } }
    float wp0[8], wp1[8], ap0[8], ap1[8], gt[8];
    ld8f(a.in[8] + c0, wp0); ld8f(a.in[8] + 512 + c0, wp1); ld8f(a.in[11] + c0, ap0); ld8f(a.in[11] + 512 + c0, ap1);
#pragma unroll
    for (int i = 0; i < 8; ++i) gt[i] = 0.f;
    *(LAS f32x4*)(scr + c0) = (f32x4){lv[0], lv[1], lv[2], lv[3]}; *(LAS f32x4*)(scr + c0 + 4) = (f32x4){lv[4], lv[5], lv[6], lv[7]};
    LDS_WAIT(); asm volatile("" ::: "memory");
    const float* w2 = a.in[10]; const float* a2 = a.in[13]; const float* g2 = a.in[15];
#pragma unroll 2
    for (int j = 0; j < 64; ++j) {
        const float sw0 = scr[j], sw1 = scr[64 + j], sa0 = scr[128 + j], sa1 = scr[192 + j];
        float x0[8], x1[8], y0[8], y1[8];
        ld8f(w2 + (size_t)j * 512 + c0, x0); ld8f(w2 + 32768 + (size_t)j * 512 + c0, x1); ld8f(a2 + (size_t)j * 512 + c0, y0); ld8f(a2 + 32768 + (size_t)j * 512 + c0, y1);
#pragma unroll
        for (int i = 0; i < 8; ++i) { wp0[i] += sw0 * x0[i]; wp1[i] += sw1 * x1[i]; ap0[i] += sa0 * y0[i]; ap1[i] += sa1 * y1[i]; }
    }
#pragma unroll 4
    for (int j = 0; j < 128; ++j) {
        const float sg = scr[256 + j];
        float x0[8]; ld8f(g2 + (size_t)j * 512 + c0, x0);
#pragma unroll
        for (int i = 0; i < 8; ++i) gt[i] += sg * x0[i];
    }
    LDS_WAIT(); asm volatile("" ::: "memory");
    float kkw[8], kaw[8], rkw[8]; ld8f(a.in[16] + c0, kkw); ld8f(a.in[17] + c0, kaw); ld8f(a.in[18] + c0, rkw);
    float kk[8], lw0[8], lw1[8], kd0[8], kd1[8], b0[8], b1[8], bon[8];
    float ss = 0.f;
#pragma unroll
    for (int i = 0; i < 8; ++i) { kk[i] = k[i] * kkw[i]; ss += kk[i] * kk[i]; }
    ss = grp_sum<8>(ss); const float rn = 1.0f / sqrtf(ss + 1e-6f);
    float dotb = 0.f;
#pragma unroll
    for (int i = 0; i < 8; ++i) {
        kk[i] *= rn;
        lw0[i] = -__expf(-softplusf_(-wp0[i]) - 0.5f); lw1[i] = -__expf(-softplusf_(-wp1[i]) - 0.5f);
        const float ic0 = sigmoidf_(ap0[i]), ic1 = sigmoidf_(ap1[i]);
        kd0[i] = k[i] * (1.0f + (ic0 - 1.0f) * kaw[i]); kd1[i] = k[i] * (1.0f + (ic1 - 1.0f) * kaw[i]);
        b0[i] = kk[i] * ic0; b1[i] = kk[i] * ic1;
        dotb += r[i] * (kd0[i] + kd1[i]) * rkw[i];
    }
    dotb = grp_sum<8>(dotb);
#pragma unroll
    for (int i = 0; i < 8; ++i) bon[i] = dotb * v[i];
    const size_t o = (size_t)t * 512 + c0;
    st8f((float*)(ws + WS_LW0) + o, lw0); st8f((float*)(ws + WS_LW1) + o, lw1);
    st8((bf16*)(ws + WS_R) + o, r); st8((bf16*)(ws + WS_V) + o, v); st8((bf16*)(ws + WS_KK) + o, kk);
    st8((bf16*)(ws + WS_KD0) + o, kd0); st8((bf16*)(ws + WS_KD1) + o, kd1); st8((bf16*)(ws + WS_B0) + o, b0); st8((bf16*)(ws + WS_B1) + o, b1);
    st8((bf16*)(ws + WS_GATE) + o, gt); st8((bf16*)(ws + WS_BONUS) + o, bon);
}

DI void rwkv_scan_naive(unsigned char* ws, int w  , int lane) {
    const int z = w >> 9, h = (w >> 6) & 7, vr = w & 63;
    const float* LW = (const float*)(ws + (z ? WS_LW1 : WS_LW0));
    const bf16* KD = (const bf16*)(ws + (z ? WS_KD1 : WS_KD0)); const bf16* BB = (const bf16*)(ws + (z ? WS_B1 : WS_B0));
    const bf16* KK = (const bf16*)(ws + WS_KK); const bf16* R = (const bf16*)(ws + WS_R); const bf16* V = (const bf16*)(ws + WS_V);
    bf16* Y = (bf16*)(ws + (z ? WS_Y1 : WS_Y0));
    const int cc = h * 64 + lane, cv = h * 64 + vr;
    float S = 0.f;
    int t = z ? S_ - 1 : 0; const int dt = z ? -1 : 1;
    size_t o = (size_t)t * 512;
    float lw = LW[o + cc], kd = bf2f(KD[o + cc]), bb = bf2f(BB[o + cc]), kk = bf2f(KK[o + cc]), rr = bf2f(R[o + cc]), vv = bf2f(V[o + cv]);
    for (int s = 0; s < S_; ++s) {
        const int tn = t + dt; const bool more = s + 1 < S_;
        const size_t on = (size_t)(more ? tn : t) * 512;
        const float lw_n = LW[on + cc], kd_n = bf2f(KD[on + cc]), bb_n = bf2f(BB[on + cc]), kk_n = bf2f(KK[on + cc]), rr_n = bf2f(R[on + cc]), vv_n = bf2f(V[on + cv]);
        const float sa = wave_sum(S * (-kk));
        S = S * __expf(lw) + sa * bb + vv * kd;
        const float y = wave_sum(S * rr);
        if (lane == 0) Y[(size_t)t * 512 + cv] = (bf16)f2bf(y);
        lw = lw_n; kd = kd_n; bb = bb_n; kk = kk_n; rr = rr_n; vv = vv_n; t = tn;
    }
}

DI void attn_token_naive(unsigned char* ws, int t, int lane) {
    const bf16* QN = (const bf16*)(ws + WS_QN); const bf16* KN = (const bf16*)(ws + WS_KN); const bf16* P = (const bf16*)(ws + WS_PROJ0);
    const int c0 = 8 * lane;
    float q[8]; ld8(QN + (size_t)t * 512 + c0, q);
    float m = -1e30f, l = 0.f, acc[8];
#pragma unroll
    for (int i = 0; i < 8; ++i) acc[i] = 0.f;
    for (int br = 0; br < 3; ++br) {
        const int d = br == 0 ? 1 : (br == 1 ? 4 : 16);
        for (int mm = -64; mm <= 64; ++mm) {
            const int j = t + d * mm; if (j < 0 || j >= S_) continue;
            float k[8], v[8]; ld8(KN + (size_t)j * 512 + c0, k); ld8(P + (size_t)j * EVEN_IN + 1024 + c0, v);
            float s = 0.f;
#pragma unroll
            for (int i = 0; i < 8; ++i) s += q[i] * k[i];
            s = grp_sum<8>(s);
            const float mn = fmaxf(m, s), sc = __expf(m - mn), p = __expf(s - mn);
            l = l * sc + p;
#pragma unroll
            for (int i = 0; i < 8; ++i) acc[i] = acc[i] * sc + p * v[i];
            m = mn;
        }
    }
    const float il = 1.0f / l;
#pragma unroll
    for (int i = 0; i < 8; ++i) acc[i] *= il;
    st8((bf16*)(ws + WS_Y) + (size_t)t * D_ + c0, acc);
}

DI void rwkv_post_token(const Args& a, unsigned char* ws, int t, int lane) {
    const int c0 = 8 * lane; const size_t o = (size_t)t * 512 + c0;
    float y0[8], y1[8], g[8], bn[8], lw[8], lb[8];
    ld8((const bf16*)(ws + WS_Y0) + o, y0); ld8((const bf16*)(ws + WS_Y1) + o, y1); ld8((const bf16*)(ws + WS_GATE) + o, g); ld8((const bf16*)(ws + WS_BONUS) + o, bn);
    ld8f(a.in[19] + c0, lw); ld8f(a.in[20] + c0, lb);
    float s = 0.f;
#pragma unroll
    for (int i = 0; i < 8; ++i) { y0[i] += y1[i]; s += y0[i]; }
    const float mu = grp_sum<8>(s) * (1.0f / 64.f);
    float q = 0.f;
#pragma unroll
    for (int i = 0; i < 8; ++i) { y0[i] -= mu; q += y0[i] * y0[i]; }
    const float rs = 1.0f / sqrtf(grp_sum<8>(q) * (1.0f / 64.f) + 64e-5f);
#pragma unroll
    for (int i = 0; i < 8; ++i) y0[i] = (y0[i] * rs * lw[i] + lb[i] + bn[i]) * g[i];
    st8((bf16*)(ws + WS_Y) + (size_t)t * D_ + 512 + c0, y0);
}
typedef short s16x8 __attribute__((ext_vector_type(8)));
typedef short s16x4 __attribute__((ext_vector_type(4)));
typedef LAS unsigned char* ldsp;
DI f32x4 mfma16(s16x8 a, s16x8 b, f32x4 c) { return __builtin_amdgcn_mfma_f32_16x16x32_bf16(a, b, c, 0, 0, 0); }
DI s16x8 frag_row(ldsp img, int row0, int col0, int lane) { return *(LAS const s16x8*)(img + (row0 + (lane & 15)) * 128 + (col0 + 8 * (lane >> 4)) * 2); }
DI s16x4 tr16(ldsp p) { return __builtin_bit_cast(s16x4, __builtin_amdgcn_ds_read_tr16_b64_v4i16((LAS s16x4*)p)); }
DI s16x8 frag_tr(ldsp img, int row0, int col0, int lane) {
    ldsp a0 = img + (row0 + 8 * (lane >> 4) + ((lane & 15) >> 2)) * 128 + col0 * 2 + 8 * (lane & 3);
    const s16x4 lo = tr16(a0), hi = tr16(a0 + 4 * 128);
    return __builtin_shufflevector(lo, hi, 0, 1, 2, 3, 4, 5, 6, 7);
}
DI void ctile_to_img(ldsp img, int mt, int nt, const f32x4& c, int lane) {
    LAS bf16* p = (LAS bf16*)(img + (16 * mt + 4 * (lane >> 4)) * 128 + (16 * nt + (lane & 15)) * 2);
#pragma unroll
    for (int e = 0; e < 4; ++e) p[e * 64] = (bf16)f2bf(c[e]);
}
#define CFENCE() asm volatile("" ::: "memory")
#define MM_LOOP(ACC, AEXPR, BEXPR) _Pragma("unroll") for (int mt = 0; mt < 4; ++mt) _Pragma("unroll") for (int nt = 0; nt < 4; ++nt) _Pragma("unroll") for (int ks = 0; ks < 2; ++ks) ACC[mt][nt] = mfma16((AEXPR), (BEXPR), ACC[mt][nt])

DI int tok_of(int z, int cn, int i) { return z ? cn * 64 + 63 - i : cn * 64 + i; }

DI void rwkv_pass1_item(unsigned char* ws, ldsp lds, int item, int lane) {
    asm volatile("" : "+v"(lane));
    const int z = item >> 11, h = (item >> 8) & 7, c = item & 255;
    const int cn = z ? 255 - c : c;
    float* LW = (float*)(ws + (z ? WS_LW1 : WS_LW0));
    bf16* KD = (bf16*)(ws + (z ? WS_KD1 : WS_KD0)); bf16* BB = (bf16*)(ws + (z ? WS_B1 : WS_B0));
    const bf16* KK = (const bf16*)(ws + WS_KK); const bf16* R = (const bf16*)(ws + WS_R); const bf16* V = (const bf16*)(ws + WS_V);
    ldsp S0 = lds, S1 = lds + 8192, S2 = lds + 16384, S3 = lds + 24576, S4 = lds + 32768, S5 = lds + 40960, S6 = lds + 49152, S7 = lds + 57344;
    ldsp IA = S0, IB = S1, IK = S2, IR = S3;
    const int ch = h * 64 + lane;
    float G = 0.f;
#pragma unroll 8
    for (int i = 0; i < 64; ++i) {
        const size_t o = (size_t)tok_of(z, cn, i) * 512 + ch;
        const float lw = LW[o], a = -bf2f(KK[o]), b = bf2f(BB[o]), kd = bf2f(KD[o]), r = bf2f(R[o]);
        const float eprev = __expf(G); G += lw; const float ecur = __expf(G), einv = __expf(-G);
        ((LAS bf16*)IA)[i * 64 + lane] = (bf16)f2bf(a * eprev); ((LAS bf16*)IB)[i * 64 + lane] = (bf16)f2bf(b * einv);
        ((LAS bf16*)IK)[i * 64 + lane] = (bf16)f2bf(kd * einv); ((LAS bf16*)IR)[i * 64 + lane] = (bf16)f2bf(r * ecur);
    }
    const float GT = __expf(G);
    LDS_WAIT(); CFENCE();
    int lane2 = lane; asm volatile("" : "+v"(lane2));
    const int n_ = lane2 & 15, q_ = lane2 >> 4;
    {
        f32x4 acc[4][4];
#pragma unroll
        for (int mt = 0; mt < 4; ++mt)
#pragma unroll
            for (int nt = 0; nt < 4; ++nt) acc[mt][nt] = (f32x4){0.f, 0.f, 0.f, 0.f};
        MM_LOOP(acc, frag_row(IA, 16 * mt, 32 * ks, lane), frag_row(IB, 16 * nt, 32 * ks, lane));
#pragma unroll
        for (int mt = 0; mt < 4; ++mt)
#pragma unroll
            for (int nt = 0; nt < 4; ++nt)
#pragma unroll
                for (int e = 0; e < 4; ++e) { const int i = 16 * mt + 4 * q_ + e, j = 16 * nt + n_; ((LAS float*)S4)[i * 64 + j] = (j < i) ? acc[mt][nt][e] : 0.f; }
    }
    LDS_WAIT(); CFENCE();
    {
        float t[64];
        int lane_o = lane; asm volatile("" : "+v"(lane_o));
#pragma unroll
        for (int i = 0; i < 64; ++i) {
            float acc = (lane_o == i) ? 1.f : 0.f;
#pragma unroll
            for (int jg = 0; jg < (i + 3) / 4; ++jg) {
                const f32x4 a4 = *(LAS const f32x4*)(S4 + (i * 64 + 4 * jg) * 4);
#pragma unroll
                for (int e = 0; e < 4; ++e) if (4 * jg + e < i) acc += a4[e] * t[4 * jg + e];
            }
            t[i] = acc;
        }
        LDS_WAIT(); CFENCE();
#pragma unroll
        for (int i = 0; i < 64; ++i) ((LAS bf16*)S4)[i * 64 + lane] = (bf16)f2bf(t[i]);
    }
    LDS_WAIT(); CFENCE();
    ldsp IT = S4, IW = S5, IAK = S6;
    {
        f32x4 acc[4][4];
#pragma unroll
        for (int mt = 0; mt < 4; ++mt)
#pragma unroll
            for (int nt = 0; nt < 4; ++nt) acc[mt][nt] = (f32x4){0.f, 0.f, 0.f, 0.f};
        MM_LOOP(acc, frag_row(IA, 16 * mt, 32 * ks, lane), frag_row(IK, 16 * nt, 32 * ks, lane));
#pragma unroll
        for (int mt = 0; mt < 4; ++mt)
#pragma unroll
            for (int nt = 0; nt < 4; ++nt) {
#pragma unroll
                for (int e = 0; e < 4; ++e) { const int i = 16 * mt + 4 * q_ + e, j = 16 * nt + n_; if (!(j < i)) acc[mt][nt][e] = 0.f; }
                ctile_to_img(IAK, mt, nt, acc[mt][nt], lane); }
    }
    {
        f32x4 acc[4][4];
#pragma unroll
        for (int mt = 0; mt < 4; ++mt)
#pragma unroll
            for (int nt = 0; nt < 4; ++nt) acc[mt][nt] = (f32x4){0.f, 0.f, 0.f, 0.f};
        MM_LOOP(acc, frag_row(IT, 16 * mt, 32 * ks, lane), frag_tr(IA, 32 * ks, 16 * nt, lane));
#pragma unroll
        for (int mt = 0; mt < 4; ++mt)
#pragma unroll
            for (int nt = 0; nt < 4; ++nt) ctile_to_img(IW, mt, nt, acc[mt][nt], lane);
    }
    LDS_WAIT(); CFENCE();
    ldsp IV = S0;
#pragma unroll 16
    for (int i = 0; i < 64; ++i) ((LAS bf16*)IV)[i * 64 + lane] = V[(size_t)tok_of(z, cn, i) * 512 + ch];
    LDS_WAIT(); CFENCE();
    ldsp IAV = S7;
    {
        f32x4 acc[4][4];
#pragma unroll
        for (int mt = 0; mt < 4; ++mt)
#pragma unroll
            for (int nt = 0; nt < 4; ++nt) acc[mt][nt] = (f32x4){0.f, 0.f, 0.f, 0.f};
        MM_LOOP(acc, frag_row(IAK, 16 * mt, 32 * ks, lane), frag_tr(IV, 32 * ks, 16 * nt, lane));
#pragma unroll
        for (int mt = 0; mt < 4; ++mt)
#pragma unroll
            for (int nt = 0; nt < 4; ++nt) ctile_to_img(IAV, mt, nt, acc[mt][nt], lane);
    }
    LDS_WAIT(); CFENCE();
    ldsp IU = S6;
    {
        f32x4 acc[4][4];
#pragma unroll
        for (int mt = 0; mt < 4; ++mt)
#pragma unroll
            for (int nt = 0; nt < 4; ++nt) acc[mt][nt] = (f32x4){0.f, 0.f, 0.f, 0.f};
        MM_LOOP(acc, frag_row(IT, 16 * mt, 32 * ks, lane), frag_tr(IAV, 32 * ks, 16 * nt, lane));
        LDS_WAIT(); CFENCE();
#pragma unroll
        for (int mt = 0; mt < 4; ++mt)
#pragma unroll
            for (int nt = 0; nt < 4; ++nt) ctile_to_img(IU, mt, nt, acc[mt][nt], lane);
    }
    LDS_WAIT(); CFENCE();
    ldsp IRB = S4, IRK = S7;
    {
        f32x4 acc[4][4];
#pragma unroll
        for (int mt = 0; mt < 4; ++mt)
#pragma unroll
            for (int nt = 0; nt < 4; ++nt) acc[mt][nt] = (f32x4){0.f, 0.f, 0.f, 0.f};
        MM_LOOP(acc, frag_row(IR, 16 * mt, 32 * ks, lane), frag_row(IB, 16 * nt, 32 * ks, lane));
#pragma unroll
        for (int mt = 0; mt < 4; ++mt)
#pragma unroll
            for (int nt = 0; nt < 4; ++nt) {
#pragma unroll
                for (int e = 0; e < 4; ++e) { const int i = 16 * mt + 4 * q_ + e, j = 16 * nt + n_; if (!(j <= i)) acc[mt][nt][e] = 0.f; }
                ctile_to_img(IRB, mt, nt, acc[mt][nt], lane); }
    }
    {
        f32x4 acc[4][4];
#pragma unroll
        for (int mt = 0; mt < 4; ++mt)
#pragma unroll
            for (int nt = 0; nt < 4; ++nt) acc[mt][nt] = (f32x4){0.f, 0.f, 0.f, 0.f};
        MM_LOOP(acc, frag_row(IR, 16 * mt, 32 * ks, lane), frag_row(IK, 16 * nt, 32 * ks, lane));
#pragma unroll
        for (int mt = 0; mt < 4; ++mt)
#pragma unroll
            for (int nt = 0; nt < 4; ++nt) {
#pragma unroll
                for (int e = 0; e < 4; ++e) { const int i = 16 * mt + 4 * q_ + e, j = 16 * nt + n_; if (!(j <= i)) acc[mt][nt][e] = 0.f; }
                ctile_to_img(IRK, mt, nt, acc[mt][nt], lane); }
    }
    LDS_WAIT(); CFENCE();
    const size_t slot0 = (size_t)cn * 64 * 512 + h * 64;
    {
        f32x4 acc[4][4];
#pragma unroll
        for (int mt = 0; mt < 4; ++mt)
#pragma unroll
            for (int nt = 0; nt < 4; ++nt) { const s16x4 r4 = *(LAS const s16x4*)(IR + (16 * nt + n_) * 128 + (16 * mt + 4 * q_) * 2);
#pragma unroll
                for (int e = 0; e < 4; ++e) acc[mt][nt][e] = bf2f((bf16)r4[e]); }
        MM_LOOP(acc, frag_tr(IW, 32 * ks, 16 * mt, lane), frag_row(IRB, 16 * nt, 32 * ks, lane));
#pragma unroll
        for (int mt = 0; mt < 4; ++mt)
#pragma unroll
            for (int nt = 0; nt < 4; ++nt) { bf16* dst = (bf16*)(LW + slot0 + (size_t)(16 * nt + n_) * 512) + 16 * mt + 4 * q_;
                *(unsigned long long*)dst = (unsigned long long)pk2(acc[mt][nt][0], acc[mt][nt][1]) | ((unsigned long long)pk2(acc[mt][nt][2], acc[mt][nt][3]) << 32); }
    }
    {
        f32x4 acc[4][4];
#pragma unroll
        for (int mt = 0; mt < 4; ++mt)
#pragma unroll
            for (int nt = 0; nt < 4; ++nt) acc[mt][nt] = (f32x4){0.f, 0.f, 0.f, 0.f};
        MM_LOOP(acc, frag_tr(IU, 32 * ks, 16 * mt, lane), frag_row(IRB, 16 * nt, 32 * ks, lane));
        MM_LOOP(acc, frag_tr(IV, 32 * ks, 16 * mt, lane), frag_row(IRK, 16 * nt, 32 * ks, lane));
#pragma unroll
        for (int mt = 0; mt < 4; ++mt)
#pragma unroll
            for (int nt = 0; nt < 4; ++nt) { bf16* dst = (bf16*)(LW + slot0 + (size_t)(16 * nt + n_) * 512) + 64 + 16 * mt + 4 * q_;
                *(unsigned long long*)dst = (unsigned long long)pk2(acc[mt][nt][0], acc[mt][nt][1]) | ((unsigned long long)pk2(acc[mt][nt][2], acc[mt][nt][3]) << 32); }
    }
    {
        f32x4 acc[4][4];
#pragma unroll
        for (int mt = 0; mt < 4; ++mt)
#pragma unroll
            for (int nt = 0; nt < 4; ++nt) acc[mt][nt] = (f32x4){0.f, 0.f, 0.f, 0.f};
        MM_LOOP(acc, frag_tr(IW, 32 * ks, 16 * mt, lane), frag_tr(IB, 32 * ks, 16 * nt, lane));
#pragma unroll
        for (int nt = 0; nt < 4; ++nt) { const float gk = __shfl(GT, 16 * nt + n_);
#pragma unroll
            for (int mt = 0; mt < 4; ++mt) { float o[4];
#pragma unroll
                for (int e = 0; e < 4; ++e) o[e] = gk * (acc[mt][nt][e] + ((16 * mt + 4 * q_ + e) == (16 * nt + n_) ? 1.f : 0.f));
                bf16* dst = KD + slot0 + (size_t)(16 * nt + n_) * 512 + 16 * mt + 4 * q_;
                *(unsigned long long*)dst = (unsigned long long)pk2(o[0], o[1]) | ((unsigned long long)pk2(o[2], o[3]) << 32); } }
    }
    {
        f32x4 acc[4][4];
#pragma unroll
        for (int mt = 0; mt < 4; ++mt)
#pragma unroll
            for (int nt = 0; nt < 4; ++nt) acc[mt][nt] = (f32x4){0.f, 0.f, 0.f, 0.f};
        MM_LOOP(acc, frag_tr(IB, 32 * ks, 16 * mt, lane), frag_tr(IU, 32 * ks, 16 * nt, lane));
        MM_LOOP(acc, frag_tr(IK, 32 * ks, 16 * mt, lane), frag_tr(IV, 32 * ks, 16 * nt, lane));
#pragma unroll
        for (int mt = 0; mt < 4; ++mt) { float gk[4];
#pragma unroll
            for (int e = 0; e < 4; ++e) gk[e] = __shfl(GT, 16 * mt + 4 * q_ + e);
#pragma unroll
            for (int nt = 0; nt < 4; ++nt) { bf16* dst = BB + slot0 + (size_t)(16 * nt + n_) * 512 + 16 * mt + 4 * q_;
                *(unsigned long long*)dst = (unsigned long long)pk2(gk[0] * acc[mt][nt][0], gk[1] * acc[mt][nt][1]) | ((unsigned long long)pk2(gk[2] * acc[mt][nt][2], gk[3] * acc[mt][nt][3]) << 32); } }
    }
    LDS_WAIT(); CFENCE();
}
DI s16x8 pack_cpair(const f32x4& lo, const f32x4& hi) {
    v4u p; p.x = pk2(lo[0], lo[1]); p.y = pk2(lo[2], lo[3]); p.z = pk2(hi[0], hi[1]); p.w = pk2(hi[2], hi[3]);
    return __builtin_bit_cast(s16x8, p);
}
DI void rwkv_pass2_wave(unsigned char* ws, int w  , int lane) {
    const int z = w >> 5, h = (w >> 2) & 7, vs = w & 3;
    const bf16* Mm = (const bf16*)(ws + (z ? WS_KD1 : WS_KD0)); const bf16* Nn = (const bf16*)(ws + (z ? WS_B1 : WS_B0));
    bf16* Hst = (bf16*)(ws + (z ? WS_V : WS_R));
    const int n_ = lane & 15, q_ = lane >> 4;
    f32x4 H[4];
#pragma unroll
    for (int kt = 0; kt < 4; ++kt) H[kt] = (f32x4){0.f, 0.f, 0.f, 0.f};
    unsigned long long ma[4][2][2], nn[4];
    {
        const int cn = z ? 255 : 0; const size_t slot0 = (size_t)cn * 64 * 512 + h * 64;
#pragma unroll
        for (int kt = 0; kt < 4; ++kt) {
#pragma unroll
            for (int ks = 0; ks < 2; ++ks) { const bf16* row = Mm + slot0 + (size_t)(16 * kt + n_) * 512 + 32 * ks + 4 * q_;
                ma[kt][ks][0] = *(const unsigned long long*)row; ma[kt][ks][1] = *(const unsigned long long*)(row + 16); }
            nn[kt] = *(const unsigned long long*)(Nn + slot0 + (size_t)(16 * vs + n_) * 512 + 16 * kt + 4 * q_); }
    }
    for (int c = 0; c < 256; ++c) {
        { bf16* dst = Hst + ((size_t)(c * 8 + h) * 64 + 16 * vs + n_) * 64 + 4 * q_;
#pragma unroll
          for (int kt = 0; kt < 4; ++kt) *(unsigned long long*)(dst + 16 * kt) = (unsigned long long)pk2(H[kt][0], H[kt][1]) | ((unsigned long long)pk2(H[kt][2], H[kt][3]) << 32); }
        unsigned long long ma2[4][2][2], nn2[4];
        { const int c2 = c + 1 < 256 ? c + 1 : c; const int cn = z ? 255 - c2 : c2; const size_t slot0 = (size_t)cn * 64 * 512 + h * 64;
#pragma unroll
          for (int kt = 0; kt < 4; ++kt) {
#pragma unroll
            for (int ks = 0; ks < 2; ++ks) { const bf16* row = Mm + slot0 + (size_t)(16 * kt + n_) * 512 + 32 * ks + 4 * q_;
                ma2[kt][ks][0] = *(const unsigned long long*)row; ma2[kt][ks][1] = *(const unsigned long long*)(row + 16); }
            nn2[kt] = *(const unsigned long long*)(Nn + slot0 + (size_t)(16 * vs + n_) * 512 + 16 * kt + 4 * q_); } }
        const s16x8 b0 = pack_cpair(H[0], H[1]), b1 = pack_cpair(H[2], H[3]);
#pragma unroll
        for (int kt = 0; kt < 4; ++kt) {
            f32x4 acc = (f32x4){bflo((unsigned)nn[kt]), bfhi((unsigned)nn[kt]), bflo((unsigned)(nn[kt] >> 32)), bfhi((unsigned)(nn[kt] >> 32))};
            { v4u a; a.x = (unsigned)ma[kt][0][0]; a.y = (unsigned)(ma[kt][0][0] >> 32); a.z = (unsigned)ma[kt][0][1]; a.w = (unsigned)(ma[kt][0][1] >> 32); acc = mfma16(__builtin_bit_cast(s16x8, a), b0, acc); }
            { v4u a; a.x = (unsigned)ma[kt][1][0]; a.y = (unsigned)(ma[kt][1][0] >> 32); a.z = (unsigned)ma[kt][1][1]; a.w = (unsigned)(ma[kt][1][1] >> 32); acc = mfma16(__builtin_bit_cast(s16x8, a), b1, acc); }
            H[kt] = acc;
        }
#pragma unroll
        for (int kt = 0; kt < 4; ++kt) { nn[kt] = nn2[kt];
#pragma unroll
            for (int ks = 0; ks < 2; ++ks) { ma[kt][ks][0] = ma2[kt][ks][0]; ma[kt][ks][1] = ma2[kt][ks][1]; } }
    }
}
DI void rwkv_pass3_item(unsigned char* ws, int item, int lane) {
    const int z = item >> 11, h = (item >> 8) & 7, c = item & 255;
    const int cn = z ? 255 - c : c;
    const float* LW = (const float*)(ws + (z ? WS_LW1 : WS_LW0));
    const bf16* Hst = (const bf16*)(ws + (z ? WS_V : WS_R)) + (size_t)(c * 8 + h) * 64 * 64;
    bf16* Y = (bf16*)(ws + (z ? WS_Y1 : WS_Y0));
    const int n_ = lane & 15, q_ = lane >> 4;
    const size_t slot0 = (size_t)cn * 64 * 512 + h * 64;
    s16x8 hA[4][2], qB[4][2];
#pragma unroll
    for (int t = 0; t < 4; ++t)
#pragma unroll
        for (int ks = 0; ks < 2; ++ks) {
            hA[t][ks] = *(const s16x8*)(Hst + (size_t)(16 * t + n_) * 64 + 32 * ks + 8 * q_);
            qB[t][ks] = *(const s16x8*)((const bf16*)(LW + slot0 + (size_t)(16 * t + n_) * 512) + 32 * ks + 8 * q_); }
#pragma unroll
    for (int nt = 0; nt < 4; ++nt) {
        const int i = 16 * nt + n_; const bf16* ycrow = (const bf16*)(LW + slot0 + (size_t)i * 512) + 64;
        bf16* yrow = Y + (size_t)tok_of(z, cn, i) * 512 + h * 64;
#pragma unroll
        for (int mt = 0; mt < 4; ++mt) {
            const unsigned long long y4 = *(const unsigned long long*)(ycrow + 16 * mt + 4 * q_);
            f32x4 acc = (f32x4){bflo((unsigned)y4), bfhi((unsigned)y4), bflo((unsigned)(y4 >> 32)), bfhi((unsigned)(y4 >> 32))};
            acc = mfma16(hA[mt][0], qB[nt][0], acc); acc = mfma16(hA[mt][1], qB[nt][1], acc);
            *(unsigned long long*)(yrow + 16 * mt + 4 * q_) = (unsigned long long)pk2(acc[0], acc[1]) | ((unsigned long long)pk2(acc[2], acc[3]) << 32);
        }
    }
}
constexpr size_t WS_SST = WS_PROJ1, WS_UB = WS_PROJ1 + 64 * MiB, WS_AT = WS_PROJ1 + 96 * MiB, WS_GC = WS_PROJ1 + 112 * MiB;
constexpr size_t WS_WN = WS_A + 112 * MiB, WS_KT = WS_A + 144 * MiB;
static_assert(WS_GC + 2048 * 64 * 4 <= WS_O0, "dn map");
template <int PITCH> DI s16x8 frag_row_p(ldsp img, int row0, int col0, int lane) { return *(LAS const s16x8*)(img + (row0 + (lane & 15)) * PITCH + (col0 + 8 * (lane >> 4)) * 2); }
template <int PITCH> DI s16x8 frag_tr_p(ldsp img, int row0, int col0, int lane) {
    ldsp a0 = img + (row0 + 8 * (lane >> 4) + ((lane & 15) >> 2)) * PITCH + col0 * 2 + 8 * (lane & 3);
    const s16x4 lo = tr16(a0), hi = tr16(a0 + 4 * PITCH);
    return __builtin_shufflevector(lo, hi, 0, 1, 2, 3, 4, 5, 6, 7);
}
DI unsigned long long pk4(const f32x4& v) { return (unsigned long long)pk2(v[0], v[1]) | ((unsigned long long)pk2(v[2], v[3]) << 32); }
DI f32x4 unpk4(unsigned long long w) { return (f32x4){bflo((unsigned)w), bfhi((unsigned)w), bflo((unsigned)(w >> 32)), bfhi((unsigned)(w >> 32))}; }
constexpr int DN_LDS_PER_WAVE = 49152 + 512;
DI void dn_pass1_item(unsigned char* ws, ldsp lds, int item, int lane) {
    asm volatile("" : "+v"(lane));
    const int z = item >> 10, h = (item >> 8) & 3, c = item & 255, cn = z ? 255 - c : c;
    const bf16* Q = (const bf16*)(ws + WS_QD); const bf16* K = (const bf16*)(ws + WS_KD); const bf16* V = (const bf16*)(ws + WS_VD);
    ldsp IKd = lds, IVd = lds + 16384, LT = lds + 32768; LAS float* gcs = (LAS float*)(lds + 49152); LAS float* bts = gcs + 64;
    const int n_ = lane & 15, q_ = lane >> 4;
    {
        const int tok = tok_of(z, cn, lane);
        float gc = ((const float*)(ws + WS_GB))[(size_t)tok * 8 + z * 4 + h]; const float bt = ((const float*)(ws + WS_GB + 512 * 1024))[(size_t)tok * 8 + z * 4 + h];
#pragma unroll
        for (int o = 1; o < 64; o <<= 1) { const float t = __shfl_up(gc, o); if (lane >= o) gc += t; }
        gcs[lane] = gc; bts[lane] = bt; ((float*)(ws + WS_GC))[(size_t)item * 64 + lane] = gc;
    }
#pragma unroll 4
    for (int it = 0; it < 16; ++it) { const int p = lane + 64 * it, row = p >> 4, ck = p & 15; const size_t go = (size_t)tok_of(z, cn, row) * 512 + h * 128 + ck * 8;
        *(LAS v4u*)(IKd + row * 256 + ck * 16) = *(const v4u*)(K + go); *(LAS v4u*)(IVd + row * 256 + ck * 16) = *(const v4u*)(V + go); }
    LDS_WAIT(); CFENCE();
    s16x8 kf[4][4];
#pragma unroll
    for (int rt = 0; rt < 4; ++rt)
#pragma unroll
        for (int ks = 0; ks < 4; ++ks) kf[rt][ks] = frag_row_p<256>(IKd, 16 * rt, 32 * ks, lane);
#pragma unroll
    for (int mt = 0; mt < 4; ++mt) { f32x4 gi, bi;
#pragma unroll
        for (int e = 0; e < 4; ++e) { gi[e] = gcs[16 * mt + 4 * q_ + e]; bi[e] = bts[16 * mt + 4 * q_ + e]; }
#pragma unroll
        for (int nt = 0; nt < 4; ++nt) { f32x4 acc = (f32x4){0.f, 0.f, 0.f, 0.f};
            if (nt <= mt) {
#pragma unroll
                for (int ks = 0; ks < 4; ++ks) acc = mfma16(kf[mt][ks], kf[nt][ks], acc); }
            const float gj = gcs[16 * nt + n_];
#pragma unroll
            for (int e = 0; e < 4; ++e) { const int i = 16 * mt + 4 * q_ + e, j = 16 * nt + n_; ((LAS float*)LT)[i * 64 + j] = (j < i) ? bi[e] * acc[e] * __expf(gi[e] - gj) : 0.f; } } }
    {
        bf16* At = (bf16*)(ws + WS_AT) + (size_t)item * 4096;
#pragma unroll
        for (int nt = 0; nt < 4; ++nt) { s16x8 qf[4]; const bf16* qrow = Q + (size_t)tok_of(z, cn, 16 * nt + n_) * 512 + h * 128 + 8 * q_;
#pragma unroll
            for (int ks = 0; ks < 4; ++ks) qf[ks] = *(const s16x8*)(qrow + 32 * ks);
            const float gi = gcs[16 * nt + n_];
#pragma unroll
            for (int mt = 0; mt < 4; ++mt) { f32x4 acc = (f32x4){0.f, 0.f, 0.f, 0.f};
                if (mt <= nt) {
#pragma unroll
                    for (int ks = 0; ks < 4; ++ks) acc = mfma16(kf[mt][ks], qf[ks], acc); }
                f32x4 o;
#pragma unroll
                for (int e = 0; e < 4; ++e) { const int j = 16 * mt + 4 * q_ + e, i = 16 * nt + n_; o[e] = (j <= i) ? acc[e] * __expf(gi - gcs[j]) : 0.f; }
                *(unsigned long long*)(At + (size_t)(16 * nt + n_) * 64 + 16 * mt + 4 * q_) = pk4(o); } }
    }
    LDS_WAIT(); CFENCE();
    {
        float t[64];
        int lane_o = lane; asm volatile("" : "+v"(lane_o));
#pragma unroll
        for (int i = 0; i < 64; ++i) {
            float acc = (lane_o == i) ? 1.f : 0.f;
#pragma unroll
            for (int jg = 0; jg < (i + 3) / 4; ++jg) { const f32x4 a4 = *(LAS const f32x4*)(LT + (i * 64 + 4 * jg) * 4);
#pragma unroll
                for (int e = 0; e < 4; ++e) if (4 * jg + e < i) acc -= a4[e] * t[4 * jg + e]; }
            t[i] = acc;
        }
        LDS_WAIT(); CFENCE();
        const float s1 = bts[lane], s2 = -s1 * __expf(gcs[lane]);
#pragma unroll
        for (int i = 0; i < 64; ++i) { ((LAS bf16*)LT)[i * 64 + lane] = (bf16)f2bf(t[i] * s1); ((LAS bf16*)(LT + 8192))[i * 64 + lane] = (bf16)f2bf(t[i] * s2); }
    }
    LDS_WAIT(); CFENCE();
    ldsp IT1 = LT, IT2 = LT + 8192;
    {
        bf16* Ub = (bf16*)(ws + WS_UB) + (size_t)item * 8192;
        s16x8 tf[4][2];
#pragma unroll
        for (int mt = 0; mt < 4; ++mt)
#pragma unroll
            for (int ks = 0; ks < 2; ++ks) tf[mt][ks] = frag_row_p<128>(IT1, 16 * mt, 32 * ks, lane);
#pragma unroll
        for (int nt = 0; nt < 8; ++nt) { const s16x8 v0 = frag_tr_p<256>(IVd, 0, 16 * nt, lane), v1 = frag_tr_p<256>(IVd, 32, 16 * nt, lane);
#pragma unroll
            for (int mt = 0; mt < 4; ++mt) { f32x4 acc = (f32x4){0.f, 0.f, 0.f, 0.f}; acc = mfma16(tf[mt][0], v0, acc); acc = mfma16(tf[mt][1], v1, acc);
                *(unsigned long long*)(Ub + (size_t)(16 * nt + n_) * 64 + 16 * mt + 4 * q_) = pk4(acc); } }
    }
    {
        bf16* Wn = (bf16*)(ws + WS_WN) + (size_t)item * 8192;
        s16x8 tf[4][2];
#pragma unroll
        for (int nt = 0; nt < 4; ++nt)
#pragma unroll
            for (int ks = 0; ks < 2; ++ks) tf[nt][ks] = frag_row_p<128>(IT2, 16 * nt, 32 * ks, lane);
#pragma unroll
        for (int mt = 0; mt < 8; ++mt) { const s16x8 k0 = frag_tr_p<256>(IKd, 0, 16 * mt, lane), k1 = frag_tr_p<256>(IKd, 32, 16 * mt, lane);
            if (z == 0) { bf16* KT = (bf16*)(ws + WS_KT) + ((size_t)(h * 256 + cn) * 128 + 16 * mt + n_) * 64 + 8 * q_; *(s16x8*)KT = k0; *(s16x8*)(KT + 32) = k1; }
#pragma unroll
            for (int nt = 0; nt < 4; ++nt) { f32x4 acc = (f32x4){0.f, 0.f, 0.f, 0.f}; acc = mfma16(k0, tf[nt][0], acc); acc = mfma16(k1, tf[nt][1], acc);
                *(unsigned long long*)(Wn + (size_t)(16 * nt + n_) * 128 + 16 * mt + 4 * q_) = pk4(acc); } }
    }
    LDS_WAIT(); CFENCE();
}
DI unsigned long long rev4(unsigned long long x) { return (x >> 48) | ((x >> 16) & 0xffff0000ull) | ((x << 16) & 0xffff00000000ull) | (x << 48); }
DI void dn_pass2_wave(unsigned char* ws, int w  , int lane) {
    const int z = w >> 5, h = (w >> 3) & 3, vs = w & 7;
    const int n_ = lane & 15, q_ = lane >> 4;
    f32x4 S[8];
#pragma unroll
    for (int kt = 0; kt < 8; ++kt) S[kt] = (f32x4){0.f, 0.f, 0.f, 0.f};
    for (int c = 0; c < 256; ++c) {
        const int item = (z * 4 + h) * 256 + c, cn = z ? 255 - c : c;
        const bf16* Wn = (const bf16*)(ws + WS_WN) + (size_t)item * 8192; const bf16* Ub = (const bf16*)(ws + WS_UB) + (size_t)item * 8192;
        const float* gcu = (const float*)(ws + WS_GC) + (size_t)item * 64;
        const bf16* KT = (const bf16*)(ws + WS_KT) + (size_t)(h * 256 + cn) * 128 * 64;
        bf16* Sst = (bf16*)(ws + WS_SST) + (size_t)item * 16384;
        f32x4 u[4], gv[4];
#pragma unroll
        for (int mt = 0; mt < 4; ++mt) { u[mt] = unpk4(*(const unsigned long long*)(Ub + (size_t)(16 * vs + n_) * 64 + 16 * mt + 4 * q_)); gv[mt] = *(const f32x4*)(gcu + 16 * mt + 4 * q_); }
        const float gl = gcu[63];
        unsigned long long wa[4][4][2], ka[8][2][2];
#pragma unroll
        for (int mt = 0; mt < 4; ++mt)
#pragma unroll
            for (int ks = 0; ks < 4; ++ks) { const bf16* row = Wn + (size_t)(16 * mt + n_) * 128 + 32 * ks + 4 * q_; wa[mt][ks][0] = *(const unsigned long long*)row; wa[mt][ks][1] = *(const unsigned long long*)(row + 16); }
#pragma unroll
        for (int kt = 0; kt < 8; ++kt)
#pragma unroll
            for (int ks = 0; ks < 2; ++ks) { const bf16* row = KT + (size_t)(16 * kt + n_) * 64;
                if (z == 0) { ka[kt][ks][0] = *(const unsigned long long*)(row + 32 * ks + 4 * q_); ka[kt][ks][1] = *(const unsigned long long*)(row + 32 * ks + 16 + 4 * q_); }
                else { ka[kt][ks][0] = rev4(*(const unsigned long long*)(row + 60 - 32 * ks - 4 * q_)); ka[kt][ks][1] = rev4(*(const unsigned long long*)(row + 44 - 32 * ks - 4 * q_)); } }
#pragma unroll
        for (int kt = 0; kt < 8; ++kt) *(unsigned long long*)(Sst + (size_t)(16 * vs + n_) * 128 + 16 * kt + 4 * q_) = pk4(S[kt]);
#pragma unroll
        for (int ks = 0; ks < 4; ++ks) { const s16x8 b = pack_cpair(S[2 * ks], S[2 * ks + 1]);
#pragma unroll
            for (int mt = 0; mt < 4; ++mt) { v4u a; a.x = (unsigned)wa[mt][ks][0]; a.y = (unsigned)(wa[mt][ks][0] >> 32); a.z = (unsigned)wa[mt][ks][1]; a.w = (unsigned)(wa[mt][ks][1] >> 32);
                u[mt] = mfma16(__builtin_bit_cast(s16x8, a), b, u[mt]); } }
#pragma unroll
        for (int mt = 0; mt < 4; ++mt)
#pragma unroll
            for (int e = 0; e < 4; ++e) u[mt][e] *= __expf(gl - gv[mt][e]);
        const float egl = __expf(gl);
        const s16x8 b0 = pack_cpair(u[0], u[1]), b1 = pack_cpair(u[2], u[3]);
#pragma unroll
        for (int kt = 0; kt < 8; ++kt) { f32x4 acc = S[kt] * egl;
            { v4u a; a.x = (unsigned)ka[kt][0][0]; a.y = (unsigned)(ka[kt][0][0] >> 32); a.z = (unsigned)ka[kt][0][1]; a.w = (unsigned)(ka[kt][0][1] >> 32); acc = mfma16(__builtin_bit_cast(s16x8, a), b0, acc); }
            { v4u a; a.x = (unsigned)ka[kt][1][0]; a.y = (unsigned)(ka[kt][1][0] >> 32); a.z = (unsigned)ka[kt][1][1]; a.w = (unsigned)(ka[kt][1][1] >> 32); acc = mfma16(__builtin_bit_cast(s16x8, a), b1, acc); }
            S[kt] = acc; }
    }
}
DI void dn_pass3_item(unsigned char* ws, int item, int lane) {
    asm volatile("" : "+v"(lane));
    const int z = item >> 10, h = (item >> 8) & 3, c = item & 255, cn = z ? 255 - c : c;
    const int n_ = lane & 15, q_ = lane >> 4;
    const bf16* Q = (const bf16*)(ws + WS_QD);
    const bf16* Wn = (const bf16*)(ws + WS_WN) + (size_t)item * 8192; const bf16* Ub = (const bf16*)(ws + WS_UB) + (size_t)item * 8192;
    const bf16* At = (const bf16*)(ws + WS_AT) + (size_t)item * 4096; const float* gcu = (const float*)(ws + WS_GC) + (size_t)item * 64;
    const bf16* Sst = (const bf16*)(ws + WS_SST) + (size_t)item * 16384;
    bf16* O = (bf16*)(ws + (z ? WS_O1 : WS_O0));
    s16x8 wf[4][4], qf[4][4]; unsigned long long af[4][2][2]; float eg[4];
#pragma unroll
    for (int t = 0; t < 4; ++t) {
        const bf16* qrow = Q + (size_t)tok_of(z, cn, 16 * t + n_) * 512 + h * 128 + 8 * q_;
#pragma unroll
        for (int ks = 0; ks < 4; ++ks) { wf[t][ks] = *(const s16x8*)(Wn + (size_t)(16 * t + n_) * 128 + 32 * ks + 8 * q_); qf[t][ks] = *(const s16x8*)(qrow + 32 * ks); }
#pragma unroll
        for (int ks = 0; ks < 2; ++ks) { const bf16* arow = At + (size_t)(16 * t + n_) * 64 + 32 * ks + 4 * q_; af[t][ks][0] = *(const unsigned long long*)arow; af[t][ks][1] = *(const unsigned long long*)(arow + 16); }
        eg[t] = __expf(gcu[16 * t + n_]);
    }
#pragma unroll
    for (int mt = 0; mt < 8; ++mt) {
        s16x8 sf[4];
#pragma unroll
        for (int ks = 0; ks < 4; ++ks) sf[ks] = *(const s16x8*)(Sst + (size_t)(16 * mt + n_) * 128 + 32 * ks + 8 * q_);
        f32x4 u[4];
#pragma unroll
        for (int jt = 0; jt < 4; ++jt) { u[jt] = unpk4(*(const unsigned long long*)(Ub + (size_t)(16 * mt + n_) * 64 + 16 * jt + 4 * q_));
#pragma unroll
            for (int ks = 0; ks < 4; ++ks) u[jt] = mfma16(wf[jt][ks], sf[ks], u[jt]); }
        const s16x8 ua0 = pack_cpair(u[0], u[1]), ua1 = pack_cpair(u[2], u[3]);
#pragma unroll
        for (int nt = 0; nt < 4; ++nt) {
            f32x4 acc = (f32x4){0.f, 0.f, 0.f, 0.f};
#pragma unroll
            for (int ks = 0; ks < 4; ++ks) acc = mfma16(sf[ks], qf[nt][ks], acc);
            acc = acc * eg[nt];
            { v4u b; b.x = (unsigned)af[nt][0][0]; b.y = (unsigned)(af[nt][0][0] >> 32); b.z = (unsigned)af[nt][0][1]; b.w = (unsigned)(af[nt][0][1] >> 32); acc = mfma16(ua0, __builtin_bit_cast(s16x8, b), acc); }
            { v4u b; b.x = (unsigned)af[nt][1][0]; b.y = (unsigned)(af[nt][1][0] >> 32); b.z = (unsigned)af[nt][1][1]; b.w = (unsigned)(af[nt][1][1] >> 32); acc = mfma16(ua1, __builtin_bit_cast(s16x8, b), acc); }
            *(unsigned long long*)(O + (size_t)tok_of(z, cn, 16 * nt + n_) * 512 + h * 128 + 16 * mt + 4 * q_) = pk4(acc);
        }
    }
}
DI void prep1_token(const Args& a, unsigned char* ws, int t, int lane) {
    const bf16* P = (const bf16*)(ws + WS_PROJ1) + (size_t)t * ODD_PAD;
    const int c0 = 8 * lane; const bool hp = t > 0, hn = t < S_ - 1;
    float z8[8];
#pragma unroll
    for (int i = 0; i < 8; ++i) z8[i] = 0.f;
    {
        float cb[8], cc[8], cx[8], pc[8], px[8], nc[8], nx[8], w0[8], w1[8], w2[8], o[8];
        ld8(P + c0, cb); ld8(P + 512 + c0, cc); ld8(P + 1024 + c0, cx);
        if (hp) { ld8(P - ODD_PAD + 512 + c0, pc); ld8(P - ODD_PAD + 1024 + c0, px); } else {
#pragma unroll
            for (int i = 0; i < 8; ++i) { pc[i] = 0.f; px[i] = 0.f; } }
        if (hn) { ld8(P + ODD_PAD + 512 + c0, nc); ld8(P + ODD_PAD + 1024 + c0, nx); } else {
#pragma unroll
            for (int i = 0; i < 8; ++i) { nc[i] = 0.f; nx[i] = 0.f; } }
        ld8f(a.in[28] + c0, w0); ld8f(a.in[28] + 512 + c0, w1); ld8f(a.in[28] + 1024 + c0, w2);
#pragma unroll
        for (int i = 0; i < 8; ++i) o[i] = cb[i] * (w0[i] * pc[i] * px[i] + w1[i] * cc[i] * cx[i] + w2[i] * nc[i] * nx[i]);
        st8((bf16*)(ws + WS_YCAT1) + (size_t)t * D_ + c0, o);
    }
#pragma unroll
    for (int part = 0; part < 3; ++part) {
        float cu[8], pv[8], nx[8], w0[8], w1[8], w2[8], o[8];
        const int col = 1536 + part * 512 + c0;
        ld8(P + col, cu);
        if (hp) ld8(P - ODD_PAD + col, pv); else {
#pragma unroll
            for (int i = 0; i < 8; ++i) pv[i] = 0.f; }
        if (hn) ld8(P + ODD_PAD + col, nx); else {
#pragma unroll
            for (int i = 0; i < 8; ++i) nx[i] = 0.f; }
        const float* cw = a.in[29] + part * 512 + c0;
        ld8f(cw, w0); ld8f(cw + 1536, w1); ld8f(cw + 3072, w2);
        float ss = 0.f;
#pragma unroll
        for (int i = 0; i < 8; ++i) { o[i] = siluf_(w0[i] * pv[i] + w1[i] * cu[i] + w2[i] * nx[i]); ss += o[i] * o[i]; }
        if (part < 2) { ss = grp_sum<16>(ss); const float rn = (1.0f / sqrtf(ss + 1e-6f)) * (part == 0 ? 0.08838834764831845f : 1.0f);
#pragma unroll
            for (int i = 0; i < 8; ++i) o[i] *= rn; }
        st8((bf16*)(ws + (part == 0 ? WS_QD : (part == 1 ? WS_KD : WS_VD))) + (size_t)t * 512 + c0, o);
    }
    *(v4u*)((bf16*)(ws + WS_YCAT1) + (size_t)t * D_ + 512 + c0) = *(const v4u*)(P + 3072 + c0);
    if (lane < 8) {
        const float bt = sigmoidf_(bf2f(P[3584 + lane])); const float al = bf2f(P[3592 + lane]);
        const float g = -__expf(a.in[30][lane]) * softplusf_(al + a.in[31][lane]);
        ((float*)(ws + WS_GB))[(size_t)t * 8 + lane] = g; ((float*)(ws + WS_GB + 512 * 1024))[(size_t)t * 8 + lane] = bt;
    }
}
DI void dn_scan_naive(unsigned char* ws, int w  , int lane) {
    const int z = w >> 9, h = (w >> 7) & 3, vc = w & 127;
    const bf16* Q = (const bf16*)(ws + WS_QD); const bf16* K = (const bf16*)(ws + WS_KD); const bf16* V = (const bf16*)(ws + WS_VD);
    const float* G = (const float*)(ws + WS_GB); const float* Bt = (const float*)(ws + WS_GB + 512 * 1024);
    bf16* O = (bf16*)(ws + (z ? WS_O1 : WS_O0));
    float s0 = 0.f, s1 = 0.f;
    int t = z ? S_ - 1 : 0; const int dt = z ? -1 : 1;
    size_t o = (size_t)t * 512 + h * 128;
    float k0 = bf2f(K[o + lane]), k1 = bf2f(K[o + 64 + lane]), q0 = bf2f(Q[o + lane]), q1 = bf2f(Q[o + 64 + lane]), vv = bf2f(V[o + vc]), g = G[(size_t)t * 8 + z * 4 + h], bt = Bt[(size_t)t * 8 + z * 4 + h];
    for (int s = 0; s < S_; ++s) {
        const int tn = (s + 1 < S_) ? t + dt : t; const size_t on = (size_t)tn * 512 + h * 128;
        const float k0n = bf2f(K[on + lane]), k1n = bf2f(K[on + 64 + lane]), q0n = bf2f(Q[on + lane]), q1n = bf2f(Q[on + 64 + lane]), vvn = bf2f(V[on + vc]), gn = G[(size_t)tn * 8 + z * 4 + h], btn = Bt[(size_t)tn * 8 + z * 4 + h];
        const float eg = __expf(g);
        const float dot = wave_sum(k0 * s0 + k1 * s1);
        const float cf = bt * (vv - eg * dot);
        s0 = eg * s0 + cf * k0; s1 = eg * s1 + cf * k1;
        const float ov = wave_sum(q0 * s0 + q1 * s1);
        if (lane == 0) O[(size_t)t * 512 + h * 128 + vc] = (bf16)f2bf(ov);
        k0 = k0n; k1 = k1n; q0 = q0n; q1 = q1n; vv = vvn; g = gn; bt = btn; t = tn;
    }
}
DI void dn_post_token(const Args& a, unsigned char* ws, int t, int lane) {
    const int c0 = 8 * lane; const size_t o = (size_t)t * 512 + c0;
    float o0[8], o1[8], zz[8], nw[8];
    ld8((const bf16*)(ws + WS_O0) + o, o0); ld8((const bf16*)(ws + WS_O1) + o, o1);
    ld8((const bf16*)(ws + WS_YCAT1) + (size_t)t * D_ + 512 + c0, zz); ld8f(a.in[32] + (c0 & 127), nw);
    float ss = 0.f;
#pragma unroll
    for (int i = 0; i < 8; ++i) { o0[i] += o1[i]; ss += o0[i] * o0[i]; }
    const float rs = 1.0f / sqrtf(grp_sum<16>(ss) * (1.0f / 128.f) + 1e-6f);
#pragma unroll
    for (int i = 0; i < 8; ++i) o0[i] = o0[i] * rs * nw[i] * siluf_(zz[i]);
    st8((bf16*)(ws + WS_YCAT1) + (size_t)t * D_ + 512 + c0, o0);
}
struct TokInfo { int e1, e2, s1, s2; float p1, p2; int pad0, pad1; };
DI void route_token(const Args& a, unsigned char* ws, const float* x3, int t, int lane) {
    f32x4 v[4]; load_row(x3, t, lane, v); const float rs = row_rstd(v);
    float lg[8];
#pragma unroll
    for (int e = 0; e < 8; ++e) lg[e] = 0.f;
#pragma unroll
    for (int j = 0; j < 4; ++j) { const f32x4 wv = ((const f32x4*)a.in[34])[lane + 64 * j];
#pragma unroll
        for (int i = 0; i < 4; ++i) { const float hv = v[j][i] * rs * wv[i]; const float* rr = a.in[35] + (size_t)(4 * lane + 256 * j + i) * 8;
            const f32x4 r0 = *(const f32x4*)rr, r1 = *(const f32x4*)(rr + 4);
            lg[0] += hv * r0.x; lg[1] += hv * r0.y; lg[2] += hv * r0.z; lg[3] += hv * r0.w; lg[4] += hv * r1.x; lg[5] += hv * r1.y; lg[6] += hv * r1.z; lg[7] += hv * r1.w; } }
#pragma unroll
    for (int e = 0; e < 8; ++e) lg[e] = wave_sum(lg[e]);
    if (lane == 0) {
        int e1 = 0; float m1 = lg[0];
#pragma unroll
        for (int e = 1; e < 8; ++e) if (lg[e] > m1) { m1 = lg[e]; e1 = e; }
        int e2 = -1; float m2 = -3.0e38f;
#pragma unroll
        for (int e = 0; e < 8; ++e) if (e != e1 && lg[e] > m2) { m2 = lg[e]; e2 = e; }
        const float x2 = __expf(m2 - m1); const float p1 = 1.0f / (1.0f + x2), p2 = x2 / (1.0f + x2);
        unsigned* cnt = (unsigned*)(ws + WS_CTL) + CW_CNT;
        TokInfo ti; ti.e1 = e1; ti.e2 = e2; ti.s1 = (int)atomicAdd(cnt + e1, 1u); ti.s2 = (int)atomicAdd(cnt + e2, 1u); ti.p1 = p1; ti.p2 = p2; ti.pad0 = 0; ti.pad1 = 0;
        ((TokInfo*)(ws + WS_TOK))[t] = ti;
    }
}
DI void moe_offsets(const unsigned char* ws, int (&off)[9]) {
    const unsigned* cnt = (const unsigned*)(ws + WS_CTL) + CW_CNT; int o = 0;
#pragma unroll
    for (int e = 0; e < 8; ++e) { off[e] = o; const int c = (int)__hip_atomic_load(cnt + e, __ATOMIC_RELAXED, __HIP_MEMORY_SCOPE_AGENT); o += (c + 255) & ~255; }
    off[8] = o;
}
DI void gather_token(const Args& a, unsigned char* ws, const float* x3, const int (&off)[9], int t, int lane) {
    f32x4 v[4]; load_row(x3, t, lane, v); const float rs = row_rstd(v);
#pragma unroll
    for (int j = 0; j < 4; ++j) v[j] = v[j] * rs * ((const f32x4*)a.in[34])[lane + 64 * j];
    const TokInfo ti = ((const TokInfo*)(ws + WS_TOK))[t];
    int o1 = 0, o2 = 0;
#pragma unroll
    for (int e = 0; e < 8; ++e) { if (ti.e1 == e) o1 = off[e]; if (ti.e2 == e) o2 = off[e]; }
    bf16* A = (bf16*)(ws + WS_AMOE);
    store_row_bf16(A + (size_t)(o1 + ti.s1) * D_, lane, v); store_row_bf16(A + (size_t)(o2 + ti.s2) * D_, lane, v);
}
DI void combine_token(unsigned char* ws, float* out, const int (&off)[9], int t, int lane) {
    const TokInfo ti = ((const TokInfo*)(ws + WS_TOK))[t];
    int o1 = 0, o2 = 0;
#pragma unroll
    for (int e = 0; e < 8; ++e) { if (ti.e1 == e) o1 = off[e]; if (ti.e2 == e) o2 = off[e]; }
    const bf16* A = (const bf16*)(ws + WS_AMOE);
    const unsigned long long* r1 = (const unsigned long long*)(A + (size_t)(o1 + ti.s1) * D_) + lane; const unsigned long long* r2 = (const unsigned long long*)(A + (size_t)(o2 + ti.s2) * D_) + lane;
    f32x4* xo = (f32x4*)(out + (size_t)t * D_) + lane;
#pragma unroll
    for (int j = 0; j < 4; ++j) { const unsigned long long a1 = r1[64 * j], a2 = r2[64 * j]; f32x4 x = xo[64 * j];
        x.x += ti.p1 * bflo((unsigned)a1) + ti.p2 * bflo((unsigned)a2); x.y += ti.p1 * bfhi((unsigned)a1) + ti.p2 * bfhi((unsigned)a2);
        x.z += ti.p1 * bflo((unsigned)(a1 >> 32)) + ti.p2 * bflo((unsigned)(a2 >> 32)); x.w += ti.p1 * bfhi((unsigned)(a1 >> 32)) + ti.p2 * bfhi((unsigned)(a2 >> 32));
        xo[64 * j] = x; }
}
#ifndef PH_MASK
#define PH_MASK 0xFFFFFFFFu
#endif
DI int lane_opaque() { int l = threadIdx.x & 63; asm volatile("" : "+v"(l)); return l; }
__global__ void __launch_bounds__(512, 2) fwd_kernel(Args args) {
    extern __shared__ __attribute__((aligned(16))) unsigned char lds[];
    LAS unsigned char* L = (LAS unsigned char*)lds;
    volatile LAS unsigned* MISC = (volatile LAS unsigned*)(L + MISC_OFF);
    const int tid = threadIdx.x, lane0 = tid & 63, wave = __builtin_amdgcn_readfirstlane(tid >> 6);
    const int G = gridDim.x, bx = blockIdx.x;
    const int gw = bx * 8 + wave, NGW = G * 8;
    unsigned char* ws = args.ws;
    if (tid < 128) ((LAS unsigned*)(L + LDS_ZERO_OFF))[tid] = 0u;
    __syncthreads();
    XcdBarrier bar = xcd_barrier_post((unsigned*)(ws + WS_CTL) + CW_BAR, MISC + 8);
    LAS float* scr = (LAS float*)(L + wave * 16384);
#define GRID_BAR() xcd_barrier(bar)

    if constexpr ((PH_MASK >> 0) & 1) {
    const int lane = lane_opaque();
    {
        const float* const* in = args.in;
        for (int it = gw; ; it += NGW) {
            int r = it;
            if (transpose_job(r, in[3], 1024, 3072, 3072, (bf16*)(ws + WS_WIN0), 0, 0, 0, scr, lane)) continue;
            if (transpose_job(r, in[9], 1024, 64, 64, (bf16*)(ws + WS_WL), 0, 0, 0, scr, lane)) continue;
            if (transpose_job(r, in[9] + 65536, 1024, 64, 64, (bf16*)(ws + WS_WL), 64, 0, 0, scr, lane)) continue;
            if (transpose_job(r, in[12], 1024, 64, 64, (bf16*)(ws + WS_WL), 128, 0, 0, scr, lane)) continue;
            if (transpose_job(r, in[12] + 65536, 1024, 64, 64, (bf16*)(ws + WS_WL), 192, 0, 0, scr, lane)) continue;
            if (transpose_job(r, in[14], 1024, 128, 256, (bf16*)(ws + WS_WL), 256, 0, 0, scr, lane)) continue;
            if (transpose_job(r, in[21], 1024, 1024, 1024, (bf16*)(ws + WS_WOUT0), 0, 0, 0, scr, lane)) continue;
            if (transpose_job(r, in[23], 1024, FF0, FF0, (bf16*)(ws + WS_WGU0), 0, 128, 0, scr, lane)) continue;
            if (transpose_job(r, in[24], 1024, FF0, FF0, (bf16*)(ws + WS_WGU0), 0, 128, 1, scr, lane)) continue;
            if (transpose_job(r, in[25], FF0, 1024, 1024, (bf16*)(ws + WS_WD0), 0, 0, 0, scr, lane)) continue;
            if (transpose_job(r, in[27], 1024, ODD_IN, ODD_PAD, (bf16*)(ws + WS_WIN1), 0, 0, 0, scr, lane)) continue;
            if (transpose_job(r, in[33], 1024, 1024, 1024, (bf16*)(ws + WS_WOUT1), 0, 0, 0, scr, lane)) continue;
            break;
        }
        norm_rows(args.in[0], args.in[2], args.in[7], (bf16*)(ws + WS_H), (bf16*)(ws + WS_HX), gw, NGW, lane);
    }
    GRID_BAR();
    }
    if constexpr ((PH_MASK >> 1) & 1) {
    const int lane = lane_opaque();
    {
        { pg8::Gemm g{(const bf16*)(ws + WS_H), (const bf16*)(ws + WS_WIN0), S_, EVEN_IN, D_}; pg8::StaticOrder S; S.init(S_, EVEN_IN, G, bx);
          pg8::EpiStoreBf16 E{(bf16*)(ws + WS_PROJ0), EVEN_IN, 0}; pg8::gemm_phase<pg8::EpiStoreBf16, pg8::StaticOrder, true, true>(L, g, S, E); }
        { pg8::Gemm g{(const bf16*)(ws + WS_HX), (const bf16*)(ws + WS_WL), S_, LORA_N, D_}; pg8::StaticOrder S; S.init(S_, LORA_N, G, bx);
          pg8::EpiStoreBf16 E{(bf16*)(ws + WS_LORA), LORA_N, 0}; pg8::gemm_phase<pg8::EpiStoreBf16, pg8::StaticOrder, true, true>(L, g, S, E); }
    }
    GRID_BAR();
    }
    if constexpr ((PH_MASK >> 2) & 1) {
    const int lane = lane_opaque();
    for (int t = gw; t < S_; t += NGW) prep0_token(args, ws, scr, t, lane);
    GRID_BAR();
    }
    if constexpr ((PH_MASK >> 3) & 1) {
    const int lane = lane_opaque();
    {
        if (wave < 2) { for (int it = bx * 2 + wave; it < 4096; it += G * 2) rwkv_pass1_item(ws, L + wave * 65536, it, lane); }
        else { for (int t = bx * 6 + (wave - 2); t < S_; t += G * 6) attn_token_naive(ws, t, lane); }
    }
    GRID_BAR();
    if (wave == 0 && bx < 64) rwkv_pass2_wave(ws, bx, lane);
    GRID_BAR();
    for (int it = gw; it < 4096; it += NGW) rwkv_pass3_item(ws, it, lane);
    GRID_BAR();
    }
    if constexpr ((PH_MASK >> 4) & 1) {
    const int lane = lane_opaque();
    for (int t = gw; t < S_; t += NGW) rwkv_post_token(args, ws, t, lane);
    GRID_BAR();
    }
    if constexpr ((PH_MASK >> 5) & 1) {
    const int lane = lane_opaque();
    { pg8::Gemm g{(const bf16*)(ws + WS_Y), (const bf16*)(ws + WS_WOUT0), S_, D_, D_}; pg8::StaticOrder S; S.init(S_, D_, G, bx);
      pg8::EpiResF32 E{args.in[0], args.out, D_}; pg8::gemm_phase<pg8::EpiResF32, pg8::StaticOrder, true, true>(L, g, S, E); }
    GRID_BAR();
    }
    if constexpr ((PH_MASK >> 6) & 1) {
    const int lane = lane_opaque();
    norm_rows(args.out, args.in[22], nullptr, (bf16*)(ws + WS_H2), nullptr, gw, NGW, lane);
    GRID_BAR();
    }
    if constexpr ((PH_MASK >> 7) & 1) {
    const int lane = lane_opaque();
    { pg8::Gemm g{(const bf16*)(ws + WS_H2), (const bf16*)(ws + WS_WGU0), S_, 2 * FF0, D_}; pg8::StaticOrder S; S.init(S_, 2 * FF0, G, bx);
      pg8::EpiSwiGLU E{(bf16*)(ws + WS_ACT0), FF0, 0}; pg8::gemm_phase<pg8::EpiSwiGLU, pg8::StaticOrder, true, true>(L, g, S, E); }
    GRID_BAR();
    }
    if constexpr ((PH_MASK >> 8) & 1) {
    const int lane = lane_opaque();
    { pg8::Gemm g{(const bf16*)(ws + WS_ACT0), (const bf16*)(ws + WS_WD0), S_, D_, FF0}; pg8::StaticOrder S; S.init(S_, D_, G, bx);
      pg8::EpiResF32 E{args.out, args.out, D_}; pg8::gemm_phase<pg8::EpiResF32, pg8::StaticOrder, true, true>(L, g, S, E); }
    GRID_BAR();
    }
    if constexpr ((PH_MASK >> 9) & 1) {
    const int lane = lane_opaque();
    norm_rows(args.out, args.in[26], nullptr, (bf16*)(ws + WS_H3), nullptr, gw, NGW, lane);
    GRID_BAR();
    }
    if constexpr ((PH_MASK >> 10) & 1) {
    const int lane = lane_opaque();
    { pg8::Gemm g{(const bf16*)(ws + WS_H3), (const bf16*)(ws + WS_WIN1), S_, ODD_PAD, D_}; pg8::StaticOrder S; S.init(S_, ODD_PAD, G, bx);
      pg8::EpiStoreBf16 E{(bf16*)(ws + WS_PROJ1), ODD_PAD, 0}; pg8::gemm_phase<pg8::EpiStoreBf16, pg8::StaticOrder, true, true>(L, g, S, E); }
    GRID_BAR();
    }
    if constexpr ((PH_MASK >> 11) & 1) {
    const int lane = lane_opaque();
    for (int t = gw; t < S_; t += NGW) prep1_token(args, ws, t, lane);
    GRID_BAR();
    }
    if constexpr ((PH_MASK >> 12) & 1) {
    const int lane = lane_opaque();
    {
        if (wave < 2) { for (int it = bx * 2 + wave; it < 2048; it += G * 2) dn_pass1_item(ws, L + wave * DN_LDS_PER_WAVE, it, lane); }
        else {
            LAS float* scr2 = (LAS float*)(L + 2 * DN_LDS_PER_WAVE + (wave - 2) * 8448);
            for (int it = bx * 6 + (wave - 2); ; it += G * 6) {
                int r = it; bool did = false;
                for (int e = 0; e < NEXP; ++e) {
                    if (transpose_job(r, args.in[36] + (size_t)e * 1024 * FFE, 1024, FFE, FFE, (bf16*)(ws + WS_WMGU) + (size_t)e * 2 * FFE * 1024, 0, 128, 0, scr2, lane)) { did = true; break; }
                    if (transpose_job(r, args.in[37] + (size_t)e * 1024 * FFE, 1024, FFE, FFE, (bf16*)(ws + WS_WMGU) + (size_t)e * 2 * FFE * 1024, 0, 128, 1, scr2, lane)) { did = true; break; }
                }
                if (!did) break;
            }
        }
    }
    GRID_BAR();
    if (wave == 0 && bx < 64) dn_pass2_wave(ws, bx, lane);
    GRID_BAR();
    for (int it = gw; it < 2048; it += NGW) dn_pass3_item(ws, it, lane);
    GRID_BAR();
    }
    if constexpr ((PH_MASK >> 13) & 1) {
    const int lane = lane_opaque();
    for (int t = gw; t < S_; t += NGW) dn_post_token(args, ws, t, lane);
    for (int it = gw; ; it += NGW) {
        int r = it; bool did = false;
        for (int e = 0; e < NEXP; ++e)
            if (transpose_job(r, args.in[38] + (size_t)e * 1024 * FFE, FFE, 1024, 1024, (bf16*)(ws + WS_WMD) + (size_t)e * 1024 * FFE, 0, 0, 0, scr, lane)) { did = true; break; }
        if (!did) break;
    }
    GRID_BAR();
    }
    if constexpr ((PH_MASK >> 14) & 1) {
    const int lane = lane_opaque();
    { pg8::Gemm g{(const bf16*)(ws + WS_YCAT1), (const bf16*)(ws + WS_WOUT1), S_, D_, D_}; pg8::StaticOrder S; S.init(S_, D_, G, bx);
      pg8::EpiResF32 E{args.out, args.out, D_}; pg8::gemm_phase<pg8::EpiResF32, pg8::StaticOrder, true, true>(L, g, S, E); }
    GRID_BAR();
    }
    if constexpr ((PH_MASK >> 15) & 1) {
    const int lane = lane_opaque();
    for (int t = gw; t < S_; t += NGW) route_token(args, ws, args.out, t, lane);
    GRID_BAR();
    }
    int off[9]; moe_offsets(ws, off);
    const int ntiles = off[8] >> 8;
    if constexpr ((PH_MASK >> 16) & 1) {
    const int lane = lane_opaque();
    {
        for (int t = gw; t < S_; t += NGW) gather_token(args, ws, args.out, off, t, lane);
        if (bx == 0 && tid < 160) { int e = 0;
#pragma unroll
            for (int k = 1; k < 8; ++k) if (tid * 256 >= off[k]) e = k;
            ((int*)(ws + WS_TILE))[tid] = e; }
        const unsigned* cnt = (const unsigned*)(ws + WS_CTL) + CW_CNT;
        for (int e = 0; e < NEXP; ++e) { const int c = (int)__hip_atomic_load(cnt + e, __ATOMIC_RELAXED, __HIP_MEMORY_SCOPE_AGENT); const int r0 = off[e] + c, r1 = off[e + 1];
            for (int rr = r0 + gw; rr < r1; rr += NGW) { unsigned long long* o8 = (unsigned long long*)((bf16*)(ws + WS_AMOE) + (size_t)rr * D_) + lane;
#pragma unroll
                for (int j = 0; j < 4; ++j) o8[64 * j] = 0ull; } }
    }
    GRID_BAR();
    }
    if constexpr ((PH_MASK >> 17) & 1) {
    const int lane = lane_opaque();
    for (int b = 0; b < 3; ++b) {
        const int tlo = b * MOE_BATCH_TILES; int nt = ntiles - tlo; nt = nt < 0 ? 0 : (nt > MOE_BATCH_TILES ? MOE_BATCH_TILES : nt);
        { pg8::Gemm g{(const bf16*)(ws + WS_AMOE), (const bf16*)(ws + WS_WMGU), MOE_ROWS, NEXP * 2 * FFE, D_};
          pg8::MoeOrder S{(const int*)(ws + WS_TILE), tlo, nt, 2 * FFE / 256, G, bx};
          pg8::EpiSwiGLU E{(bf16*)(ws + WS_MACT) - (size_t)tlo * 256 * FFE, FFE, 2 * FFE / 256};
          pg8::gemm_phase<pg8::EpiSwiGLU, pg8::MoeOrder, true, true>(L, g, S, E); }
        GRID_BAR();
        { pg8::Gemm g{(const bf16*)(ws + WS_MACT) - (size_t)tlo * 256 * FFE, (const bf16*)(ws + WS_WMD), MOE_ROWS, NEXP * D_, FFE};
          pg8::MoeOrder S{(const int*)(ws + WS_TILE), tlo, nt, D_ / 256, G, bx};
          pg8::EpiStoreBf16 E{(bf16*)(ws + WS_AMOE), D_, D_ / 256};
          pg8::gemm_phase<pg8::EpiStoreBf16, pg8::MoeOrder, true, true>(L, g, S, E); }
        GRID_BAR();
    }
    }
    if constexpr ((PH_MASK >> 18) & 1) {
    const int lane = lane_opaque();
    for (int t = gw; t < S_; t += NGW) combine_token(ws, args.out, off, t, lane);
    }
}

extern "C" void kernel_launch(void* const* d_in, const int* in_sizes, int n_in, void* d_out, int out_size, void* d_ws, size_t ws_size, hipStream_t stream) {
    static int grid = 0;
    if (grid == 0) {
        if (n_in != 39 || out_size != S_ * D_ || ws_size < WS_END) { fprintf(stderr, "kernel_launch: unexpected shapes (n_in %d out %d ws %zu)\n", n_in, out_size, ws_size); grid = -1; return; }
        int dev = 0, cus = 0, per_cu = 0;
        if (hipGetDevice(&dev) != hipSuccess || hipDeviceGetAttribute(&cus, hipDeviceAttributeMultiprocessorCount, dev) != hipSuccess) { grid = -1; return; }
        if (hipFuncSetAttribute((const void*)fwd_kernel, hipFuncAttributeMaxDynamicSharedMemorySize, LDS_BYTES) != hipSuccess) { grid = -1; return; }
        if (hipOccupancyMaxActiveBlocksPerMultiprocessor(&per_cu, (const void*)fwd_kernel, 512, LDS_BYTES) != hipSuccess || per_cu < 1) { fprintf(stderr, "kernel_launch: occupancy query says %d\n", per_cu); }
        (void)hipGetLastError();
        grid = cus;
    }
    if (grid < 0) return;
    if (hipMemsetAsync((char*)d_ws + WS_CTL, 0, CTL_ZERO_BYTES, stream) != hipSuccess) return;
    Args a{};
    for (int i = 0; i < 39; ++i) a.in[i] = (const float*)d_in[i];
    a.out = (float*)d_out; a.ws = (unsigned char*)d_ws;
    hipLaunchKernelGGL(fwd_kernel, dim3(grid), dim3(512), LDS_BYTES, stream, a);
}
```

```cpp
#include <hip/hip_runtime.h>
#include <cstdio>
#include <cstdint>
namespace pg8 {
#define PG8_LAS __attribute__((address_space(3)))
typedef unsigned short bf16_t;
typedef short bf16x8 __attribute__((ext_vector_type(8)));
typedef float f32x4 __attribute__((ext_vector_type(4)));
typedef unsigned u32x4 __attribute__((ext_vector_type(4)));
constexpr int BM = 256, BK = 64, HALF = 128, HTB = HALF * BK * 2  , STAGE_BYTES = 8 * HTB, NXCD = 8, WGM = 8;

__host__ __device__ __forceinline__ int lds_byte(int r, int c) { const int st = (r >> 4) * 2 + (c >> 5), rr = r & 15, cc = c & 31, ob = rr * 64 + cc * 2; return st * 1024 + (ob ^ (((ob >> 9) & 1) << 5)); }
__host__ __device__ __forceinline__ void stage_rc(int b, int& R, int& C) { const int st = b / 1024, sb = b % 1024, swz = sb ^ (((sb >> 9) & 1) << 5); R = (st >> 1) * 16 + swz / 64; C = (st & 1) * 32 + (swz % 64) / 2; }
__host__ __device__ __forceinline__ int perm32(int rho) { const int n = rho >> 4, i = rho & 15; return 8 * (i >> 2) + 4 * n + (i & 3); }

struct Unit { int pm, pn; };
struct Gemm { const bf16_t* A; const bf16_t* Bt; int M, N, K; };

struct StaticOrder {
    int nM, nN, nwg, G, c;
    __host__ __device__ void init(int M, int N, int G_, int c_) { nM = M / BM; nN = N / BM; nwg = nM * nN; G = G_; c = c_; }
    __host__ __device__ bool next(int i, Unit& u) const {
        const long L = (long)i * G + c; if (L >= nwg) return false;
        int wgid = (int)L; { const int q = nwg / NXCD, r = nwg % NXCD, xcd = wgid % NXCD, off = wgid / NXCD; wgid = (xcd < r ? xcd * (q + 1) : r * (q + 1) + (xcd - r) * q) + off; }
        const int nig = WGM * nN, gid = wgid / nig, fm = gid * WGM, gsz = (nM - fm) < WGM ? (nM - fm) : WGM;
        u.pm = fm + ((wgid % nig) % gsz); u.pn = (wgid % nig) / gsz; return true;
    }
    __device__ __forceinline__ void a_ready(const Unit&) const {}
    __device__ __forceinline__ void done(const Unit&) const {}
};

__device__ __forceinline__ unsigned cvt_pk_bf16(float lo, float hi) { unsigned r; asm volatile("v_cvt_pk_bf16_f32 %0, %1, %2" : "=v"(r) : "v"(lo), "v"(hi)); return r; }
struct EpiStoreBf16 {
    static constexpr bool PERM = true, AFTER_DRAIN = false;
    bf16_t* O; int ldc; int ntn; const float* rowss;
    __device__ __forceinline__ void operator()(const f32x4 (&acc)[2][2][4][2], const Unit& u, int wr, int wc, int fr, int fq) const {
        const int row0 = u.pm * BM + wr * 64 + fr; const int pn = ntn ? (u.pn % ntn) : u.pn;
        const int col0 = pn * BM + wc * 32 + 8 * fq;
#pragma unroll
        for (int ai = 0; ai < 2; ++ai)
#pragma unroll
            for (int m = 0; m < 4; ++m) { bf16_t* rowp = O + (size_t)(row0 + ai * HALF + m * 16) * ldc + col0;
                float rs = 1.0f; if (rowss) { const f32x4* sp = (const f32x4*)(rowss + (size_t)(row0 + ai * HALF + m * 16) * 16); const f32x4 s0 = sp[0], s1 = sp[1], s2 = sp[2], s3 = sp[3]; const f32x4 st = (s0 + s1) + (s2 + s3); rs = 1.0f / sqrtf(((st[0] + st[1]) + (st[2] + st[3])) * (1.0f / 1024.f) + 1e-6f); }
#pragma unroll
                for (int bj = 0; bj < 2; ++bj) { const f32x4 v0 = acc[ai][bj][m][0] * rs, v1 = acc[ai][bj][m][1] * rs;
                    u32x4 w; w.x = cvt_pk_bf16(v0[0], v0[1]); w.y = cvt_pk_bf16(v0[2], v0[3]); w.z = cvt_pk_bf16(v1[0], v1[1]); w.w = cvt_pk_bf16(v1[2], v1[3]);
                    *(u32x4*)(rowp + bj * HALF) = w; } }
    }
};
struct EpiResF32 {
    static constexpr bool PERM = false, AFTER_DRAIN = false;
    const float* base; float* out; int ldc; bf16_t* xb; float* rowss;
    __device__ __forceinline__ void operator()(const f32x4 (&acc)[2][2][4][2], const Unit& u, int wr, int wc, int fr, int fq) const {
        const int row0 = u.pm * BM + wr * 64 + fr, col0 = u.pn * BM + wc * 32 + 4 * fq;
#pragma unroll
        for (int ai = 0; ai < 2; ++ai)
#pragma unroll
            for (int m = 0; m < 4; ++m) { const size_t off = (size_t)(row0 + ai * HALF + m * 16) * ldc + col0; float ss = 0.f;
#pragma unroll
                for (int bj = 0; bj < 2; ++bj)
#pragma unroll
                    for (int n = 0; n < 2; ++n) { const f32x4 b = *(const f32x4*)(base + off + bj * HALF + n * 16); const f32x4 o = b + acc[ai][bj][m][n]; *(f32x4*)(out + off + bj * HALF + n * 16) = o;
                        if (xb) { ss += (o[0] * o[0] + o[1] * o[1]) + (o[2] * o[2] + o[3] * o[3]);
                            unsigned long long w = (unsigned long long)cvt_pk_bf16(o[0], o[1]) | ((unsigned long long)cvt_pk_bf16(o[2], o[3]) << 32); *(unsigned long long*)(xb + off + bj * HALF + n * 16) = w; } }
                if (xb) { ss += __shfl_xor(ss, 16); ss += __shfl_xor(ss, 32); if (fq == 0) rowss[(size_t)(row0 + ai * HALF + m * 16) * 16 + u.pn * 4 + wc] = ss; } }
    }
};
struct EpiSwiGLU {
    static constexpr bool PERM = true, AFTER_DRAIN = false;
    bf16_t* O; int ldc; int ntn; const float* rowss;
    __device__ __forceinline__ void operator()(const f32x4 (&acc)[2][2][4][2], const Unit& u, int wr, int wc, int fr, int fq) const {
        const int row0 = u.pm * BM + wr * 64 + fr; const int pn = ntn ? (u.pn % ntn) : u.pn;
        const int col0 = pn * HALF + wc * 32 + 8 * fq;
#pragma unroll
        for (int ai = 0; ai < 2; ++ai)
#pragma unroll
            for (int m = 0; m < 4; ++m) { bf16_t* rowp = O + (size_t)(row0 + ai * HALF + m * 16) * ldc + col0;
                float rs = 1.0f; if (rowss) { const f32x4* sp = (const f32x4*)(rowss + (size_t)(row0 + ai * HALF + m * 16) * 16); const f32x4 s0 = sp[0], s1 = sp[1], s2 = sp[2], s3 = sp[3]; const f32x4 st = (s0 + s1) + (s2 + s3); rs = 1.0f / sqrtf(((st[0] + st[1]) + (st[2] + st[3])) * (1.0f / 1024.f) + 1e-6f); }
                float r[8];
#pragma unroll
                for (int n = 0; n < 2; ++n)
#pragma unroll
                    for (int i = 0; i < 4; ++i) { const float g = acc[ai][0][m][n][i] * rs, up = acc[ai][1][m][n][i] * rs; r[n * 4 + i] = g * __builtin_amdgcn_rcpf(1.0f + __expf(-g)) * up; }
                u32x4 w; w.x = cvt_pk_bf16(r[0], r[1]); w.y = cvt_pk_bf16(r[2], r[3]); w.z = cvt_pk_bf16(r[4], r[5]); w.w = cvt_pk_bf16(r[6], r[7]);
                *(u32x4*)rowp = w; }
    }
};
struct MoeOrder {
    const int* tile_exp; int tlo, nt, nN, G, c;
    __device__ __forceinline__ bool next(int i, Unit& u) const {
        const int L = i * G + c; if (nt <= 0 || L >= nt * nN) return false;
        const int t = tlo + (L % nt), cn = L / nt;
        const int e = __builtin_amdgcn_readfirstlane(__hip_atomic_load(tile_exp + t, __ATOMIC_RELAXED, __HIP_MEMORY_SCOPE_AGENT));
        u.pm = t; u.pn = e * nN + cn; return true;
    }
    __device__ __forceinline__ void a_ready(const Unit&) const {}
    __device__ __forceinline__ void done(const Unit&) const {}
};
template <class Epi, class Sched, bool ALIGN_EPI = false, bool SP2 = false>
__device__ __forceinline__ void gemm_phase(PG8_LAS unsigned char* lds, const Gemm g, const Sched& S, const Epi& E, const int wave_id) {
    int tid_; asm volatile("v_mbcnt_lo_u32_b32 %0, -1, 0\n\tv_mbcnt_hi_u32_b32 %0, -1, %0" : "=v"(tid_)); tid_ += wave_id * 64;
    const int tid = tid_, wid = __builtin_amdgcn_readfirstlane(tid >> 6), lane = tid & 63, wr = wid >> 2, wc = wid & 3, fr = lane & 15, fq = lane >> 4;
    const int K = g.K, nt = K / BK;
    unsigned voffA[2], voffB[2];
#pragma unroll
    for (int i = 0; i < 2; ++i) { int R, C; stage_rc(tid * 16 + i * 8192, R, C); const int Rb = Epi::PERM ? ((R & ~31) + perm32(R & 31)) : R;
        voffA[i] = (unsigned)(R * K + C) * 2u; voffB[i] = (unsigned)(Rb * K + C) * 2u; }
    const size_t kstep = (size_t)(BK * 2);
    const size_t hstep = (size_t)HALF * K * 2;
    const size_t tstep = 2 * hstep;
    const unsigned ldsw = (unsigned)wid * 1024u;
    const int aoff = lds_byte(wr * 64 + fr, fq * 8), boff = lds_byte(wc * 32 + fr, fq * 8);
#define PG8_SA(b, h) (((b) * 2 + (h)) * HTB)
#define PG8_SB(b, h) ((4 + (b) * 2 + (h)) * HTB)
#define PG8_STAGE(bufoff, gbase, voff) do { _Pragma("unroll") for (int _i = 0; _i < 2; ++_i) \
        __builtin_amdgcn_global_load_lds((const unsigned*)((const char*)(gbase) + (voff)[_i]), (PG8_LAS unsigned*)(lds + (bufoff) + ldsw + _i * 8192), 16, 0, 0); } while (0)
#define PG8_LDA(dst, b, h) do { _Pragma("unroll") for (int m = 0; m < 4; ++m) _Pragma("unroll") for (int k = 0; k < 2; ++k) dst[m][k] = *(const PG8_LAS bf16x8*)(lds + PG8_SA(b, h) + aoff + m * 2048 + k * 1024); } while (0)
#define PG8_LDB(dst, b, h) do { _Pragma("unroll") for (int n = 0; n < 2; ++n) _Pragma("unroll") for (int k = 0; k < 2; ++k) dst[n][k] = *(const PG8_LAS bf16x8*)(lds + PG8_SB(b, h) + boff + n * 2048 + k * 1024); } while (0)
#define PG8_MMA(ai, bj, At, Bt) do { __builtin_amdgcn_s_setprio(1); _Pragma("unroll") for (int m = 0; m < 4; ++m) _Pragma("unroll") for (int n = 0; n < 2; ++n) _Pragma("unroll") for (int k = 0; k < 2; ++k) \
        acc[ai][bj][m][n] = __builtin_amdgcn_mfma_f32_16x16x32_bf16(Bt[n][k], At[m][k], acc[ai][bj][m][n], 0, 0, 0); __builtin_amdgcn_s_setprio(0); } while (0)
#define PG8_WAIT_V(n) asm volatile("s_waitcnt vmcnt(" #n ")" ::: "memory")
#define PG8_WAIT_L(n) asm volatile("s_waitcnt lgkmcnt(" #n ")" ::: "memory")
#define PG8_BAR __builtin_amdgcn_s_barrier()
#define PG8_SCHED __builtin_amdgcn_sched_barrier(0)
    Unit cur, nxt; int ui = 0;
    if (!S.next(0, cur)) return;
    f32x4 acc[2][2][4][2];
#pragma unroll
    for (int a = 0; a < 2; ++a)
#pragma unroll
        for (int b = 0; b < 2; ++b)
#pragma unroll
            for (int m = 0; m < 4; ++m)
#pragma unroll
                for (int n = 0; n < 2; ++n) acc[a][b][m][n] = (f32x4){0.f, 0.f, 0.f, 0.f};
    bf16x8 At[4][2], B0[2][2], B1[2][2];
    const char* cA = (const char*)g.A + (size_t)cur.pm * tstep; const char* cB = (const char*)g.Bt + (size_t)cur.pn * tstep;
    S.a_ready(cur);
    if constexpr (SP2) {
        PG8_STAGE(PG8_SB(0, 0), cB, voffB); PG8_STAGE(PG8_SB(0, 1), cB + hstep, voffB); PG8_STAGE(PG8_SA(0, 0), cA, voffA); PG8_STAGE(PG8_SA(0, 1), cA + hstep, voffA);
        if (wr == 1) PG8_BAR;
        PG8_WAIT_V(2); PG8_BAR;
        PG8_STAGE(PG8_SB(1, 0), cB + kstep, voffB); PG8_STAGE(PG8_SA(1, 0), cA + kstep, voffA); PG8_STAGE(PG8_SB(1, 1), cB + hstep + kstep, voffB);
        PG8_WAIT_V(6); PG8_BAR;
    } else {
        PG8_STAGE(PG8_SB(0, 0), cB, voffB); PG8_STAGE(PG8_SA(0, 0), cA, voffA); PG8_STAGE(PG8_SB(0, 1), cB + hstep, voffB); PG8_STAGE(PG8_SA(0, 1), cA + hstep, voffA);
        if (wr == 1) PG8_BAR;
        PG8_WAIT_V(4); PG8_BAR;
        PG8_STAGE(PG8_SB(1, 0), cB + kstep, voffB); PG8_STAGE(PG8_SA(1, 0), cA + kstep, voffA); PG8_STAGE(PG8_SB(1, 1), cB + hstep + kstep, voffB);
        PG8_WAIT_V(6); PG8_BAR;
    }
    for (;;) {
        const bool has_next = S.next(ui + 1, nxt);
        const char* nA = has_next ? (const char*)g.A + (size_t)nxt.pm * tstep : cA; const char* nB = has_next ? (const char*)g.Bt + (size_t)nxt.pn * tstep : cB;
        for (int t = 0; t < nt; t += 2) {
            const bool last = (t == nt - 2);
            const char* a1 = cA + (size_t)(t + 1) * kstep;
            const char* a2 = last ? nA : cA + (size_t)(t + 2) * kstep; const char* b2 = last ? nB : cB + (size_t)(t + 2) * kstep;
            const char* a3 = a2 + kstep; const char* b3 = b2 + kstep;
            if (last && has_next) S.a_ready(nxt);
            if constexpr (SP2) {
            PG8_LDB(B0, 0, 0); PG8_LDB(B1, 0, 1); PG8_SCHED; PG8_LDA(At, 0, 0); PG8_STAGE(PG8_SA(1, 1), a1 + hstep, voffA);
            PG8_WAIT_V(8); PG8_WAIT_L(0); PG8_BAR; PG8_MMA(0, 0, At, B0); PG8_MMA(0, 1, At, B1); PG8_BAR; PG8_SCHED;
            PG8_LDA(At, 0, 1); PG8_STAGE(PG8_SB(0, 0), b2, voffB); PG8_STAGE(PG8_SB(0, 1), b2 + hstep, voffB); PG8_STAGE(PG8_SA(0, 0), a2, voffA);
            PG8_WAIT_V(8); PG8_WAIT_L(0); PG8_BAR; PG8_MMA(1, 0, At, B0); PG8_MMA(1, 1, At, B1); PG8_BAR; PG8_SCHED;
            PG8_LDB(B0, 1, 0); PG8_LDB(B1, 1, 1); PG8_SCHED; PG8_LDA(At, 1, 0); PG8_STAGE(PG8_SA(0, 1), a2 + hstep, voffA);
            PG8_WAIT_V(8); PG8_WAIT_L(0); PG8_BAR; PG8_MMA(0, 0, At, B0); PG8_MMA(0, 1, At, B1); PG8_BAR; PG8_SCHED;
            PG8_LDA(At, 1, 1); PG8_STAGE(PG8_SB(1, 0), b3, voffB); PG8_STAGE(PG8_SB(1, 1), b3 + hstep, voffB); PG8_STAGE(PG8_SA(1, 0), a3, voffA);
            PG8_WAIT_V(8); PG8_WAIT_L(0); PG8_BAR; PG8_MMA(1, 0, At, B0); PG8_MMA(1, 1, At, B1); PG8_BAR; PG8_SCHED;
            } else {
            PG8_LDB(B0, 0, 0); PG8_SCHED; PG8_LDA(At, 0, 0); PG8_STAGE(PG8_SA(1, 1), a1 + hstep, voffA);
            PG8_WAIT_L(8); PG8_BAR; PG8_WAIT_L(0); PG8_MMA(0, 0, At, B0); PG8_BAR; PG8_SCHED;
            PG8_LDB(B1, 0, 1); PG8_STAGE(PG8_SB(0, 0), b2, voffB);
            PG8_BAR; PG8_WAIT_L(0); PG8_MMA(0, 1, At, B1); PG8_BAR;
            PG8_LDA(At, 0, 1); PG8_STAGE(PG8_SA(0, 0), a2, voffA);
            PG8_BAR; PG8_WAIT_L(0); PG8_MMA(1, 0, At, B0); PG8_BAR; PG8_SCHED;
            PG8_STAGE(PG8_SB(0, 1), b2 + hstep, voffB);
            PG8_WAIT_V(6); PG8_BAR; PG8_MMA(1, 1, At, B1); PG8_BAR;
            PG8_LDB(B0, 1, 0); PG8_SCHED; PG8_LDA(At, 1, 0); PG8_STAGE(PG8_SA(0, 1), a2 + hstep, voffA);
            PG8_WAIT_L(8); PG8_BAR; PG8_WAIT_L(0); PG8_MMA(0, 0, At, B0); PG8_BAR; PG8_SCHED;
            PG8_LDB(B1, 1, 1); PG8_STAGE(PG8_SB(1, 0), b3, voffB);
            PG8_BAR; PG8_WAIT_L(0); PG8_MMA(0, 1, At, B1); PG8_BAR;
            PG8_LDA(At, 1, 1); PG8_STAGE(PG8_SA(1, 0), a3, voffA);
            PG8_BAR; PG8_WAIT_L(0); PG8_MMA(1, 0, At, B0); PG8_BAR; PG8_SCHED;
            PG8_STAGE(PG8_SB(1, 1), b3 + hstep, voffB);
            PG8_WAIT_V(6); PG8_BAR; PG8_MMA(1, 1, At, B1); PG8_BAR;
            }
        }
        if constexpr (ALIGN_EPI) { if (wr == 0) PG8_BAR; }
        if constexpr (!Epi::AFTER_DRAIN) { E(acc, cur, wr, wc, fr, fq); S.done(cur); }
        if (!has_next) break;
#pragma unroll
        for (int a = 0; a < 2; ++a)
#pragma unroll
            for (int b = 0; b < 2; ++b)
#pragma unroll
                for (int m = 0; m < 4; ++m)
#pragma unroll
                    for (int n = 0; n < 2; ++n) acc[a][b][m][n] = (f32x4){0.f, 0.f, 0.f, 0.f};
        cur = nxt; cA = nA; cB = nB; ++ui;
        if constexpr (ALIGN_EPI) { if (wr == 1) PG8_BAR; }
    }
    PG8_WAIT_V(0);
    if constexpr (!ALIGN_EPI) { if (wr == 0) PG8_BAR; }
    PG8_BAR;
    if constexpr (Epi::AFTER_DRAIN) { E.fused(acc, cur, wr, wc, fr, fq, lds, wid, lane); S.done(cur); }
#undef PG8_SA
#undef PG8_SB
#undef PG8_STAGE
#undef PG8_LDA
#undef PG8_LDB
#undef PG8_MMA
#undef PG8_WAIT_V
#undef PG8_WAIT_L
#undef PG8_BAR
#undef PG8_SCHED
}
}
constexpr int S_ = 16384, D_ = 1024;
constexpr int EVEN_IN = 3072, LORA_N = 512, FF0 = 2816, ODD_IN = 3600, ODD_PAD = 3840, FFE = 3584, NEXP = 8;
constexpr int MOE_ROWS = 32768 + 8 * 256;
constexpr int MOE_BATCH_TILES = 64;
constexpr size_t MiB = 1u << 20;
constexpr size_t WS_CTL = 0, CTL_ZERO_BYTES = 1 * MiB;
constexpr size_t WS_WIN0 = 2 * MiB, WS_WL = 8 * MiB, WS_WOUT0 = 9 * MiB, WS_WGU0 = 11 * MiB, WS_WD0 = 22 * MiB, WS_WIN1 = 28 * MiB, WS_WOUT1 = 36 * MiB;
constexpr size_t WS_TOK = 38 * MiB;
constexpr size_t WS_TILE = 39 * MiB;
constexpr size_t WS_A = 40 * MiB;
constexpr size_t WS_H = WS_A, WS_HX = WS_A + 32 * MiB;
constexpr size_t WS_LW0 = WS_A, WS_LW1 = WS_A + 32 * MiB, WS_R = WS_A + 64 * MiB, WS_V = WS_A + 80 * MiB, WS_KK = WS_A + 96 * MiB, WS_KD0 = WS_A + 112 * MiB, WS_KD1 = WS_A + 128 * MiB, WS_B0 = WS_A + 144 * MiB;
constexpr size_t WS_H2 = WS_A, WS_H3 = WS_A + 32 * MiB;
constexpr size_t WS_WMGU = WS_A, WS_WMD = WS_A + 112 * MiB;
constexpr size_t WS_B = 208 * MiB;
constexpr size_t WS_PROJ0 = WS_B, WS_LORA = WS_B + 96 * MiB, WS_QN = WS_B + 112 * MiB, WS_KN = WS_B + 128 * MiB, WS_Y = WS_B + 144 * MiB;
constexpr size_t WS_B1 = WS_B + 176 * MiB, WS_GATE = WS_B + 192 * MiB, WS_BONUS = WS_B + 208 * MiB, WS_Y0 = WS_LORA, WS_Y1 = WS_B + 224 * MiB;
constexpr size_t WS_ACT0 = WS_B, WS_PROJ1 = WS_B + 88 * MiB;
constexpr size_t WS_QD = WS_B, WS_KD = WS_B + 16 * MiB, WS_VD = WS_B + 32 * MiB, WS_YCAT1 = WS_B + 48 * MiB, WS_GB = WS_B + 80 * MiB  ;
constexpr size_t WS_O0 = WS_B + 208 * MiB, WS_O1 = WS_B + 224 * MiB;
constexpr size_t WS_AMOE = WS_B, WS_MACT = WS_B + 88 * MiB;
constexpr size_t WS_END_OLD = 448 * MiB, WS_RSS1 = 460 * MiB, WS_RSS2 = 461 * MiB, WS_END = 462 * MiB;
static_assert(WS_MACT + (size_t)MOE_BATCH_TILES * 256 * FFE * 2 <= WS_END, "moe act");
static_assert(WS_AMOE + (size_t)MOE_ROWS * D_ * 2 <= WS_MACT, "amoe");
static_assert(WS_PROJ1 + (size_t)S_ * ODD_PAD * 2 <= WS_O0, "proj1");
constexpr int CW_CNT = 64;
constexpr int CW_RSS1 = 32768, CW_RSS2 = 32768 + 16384;
constexpr int CW_BAR = 4096;
constexpr int LDS_BYTES = 151552, LDS_ZERO_OFF = LDS_BYTES - 512, MISC_OFF = LDS_ZERO_OFF + 64;

#define GAS __attribute__((address_space(1)))
#define LAS __attribute__((address_space(3)))
#define DI __device__ __forceinline__
typedef unsigned short bf16;
typedef unsigned v4u __attribute__((ext_vector_type(4)));
typedef float f32x4 __attribute__((ext_vector_type(4)));
typedef GAS unsigned gu32;
#define LDS_WAIT() asm volatile("s_waitcnt lgkmcnt(0)" ::: "memory")
DI unsigned f2bf(float f) { unsigned u = __builtin_bit_cast(unsigned, f); return (u + 0x7fffu + ((u >> 16) & 1u)) >> 16; }
typedef float f32x2_t __attribute__((ext_vector_type(2))); typedef __bf16 bf16x2_t __attribute__((ext_vector_type(2)));
DI unsigned pk2(float lo, float hi) { const f32x2_t v = {lo, hi}; const bf16x2_t b = __builtin_convertvector(v, bf16x2_t); return __builtin_bit_cast(unsigned, b); }
DI float bflo(unsigned w) { return __uint_as_float(w << 16); }
DI float bfhi(unsigned w) { return __uint_as_float(w & 0xffff0000u); }
DI float bf2f(bf16 b) { return __uint_as_float(((unsigned)b) << 16); }
DI void ld8(const bf16* p, float (&v)[8]) { const v4u w = *(const v4u*)p; v[0] = bflo(w.x); v[1] = bfhi(w.x); v[2] = bflo(w.y); v[3] = bfhi(w.y); v[4] = bflo(w.z); v[5] = bfhi(w.z); v[6] = bflo(w.w); v[7] = bfhi(w.w); }
DI void st8(bf16* p, const float (&v)[8]) { v4u w; w.x = pk2(v[0], v[1]); w.y = pk2(v[2], v[3]); w.z = pk2(v[4], v[5]); w.w = pk2(v[6], v[7]); *(v4u*)p = w; }
DI void ld8f(const float* p, float (&v)[8]) { const f32x4 a = *(const f32x4*)p, b = *(const f32x4*)(p + 4); v[0] = a.x; v[1] = a.y; v[2] = a.z; v[3] = a.w; v[4] = b.x; v[5] = b.y; v[6] = b.z; v[7] = b.w; }
DI void st8f(float* p, const float (&v)[8]) { *(f32x4*)p = (f32x4){v[0], v[1], v[2], v[3]}; *(f32x4*)(p + 4) = (f32x4){v[4], v[5], v[6], v[7]}; }
DI float wave_sum(float v) {
#pragma unroll
    for (int o = 1; o < 64; o <<= 1) v += __shfl_xor(v, o);
    return v;
}
template <int W> DI float grp_sum(float v) {
#pragma unroll
    for (int o = 1; o < W; o <<= 1) v += __shfl_xor(v, o);
    return v;
}
DI float sigmoidf_(float x) { return 1.0f / (1.0f + __expf(-x)); }
DI float softplusf_(float x) { return x > 20.f ? x : log1pf(__expf(x)); }
DI float siluf_(float x) { return x / (1.0f + __expf(-x)); }

struct Args { const float* in[39]; float* out; unsigned char* ws; };

DI void transpose_item(const float* W, int K, int N, bf16* WT, int rowbase, LAS float* scr, int k0, int n0, int lane, const float* kscale = nullptr) {
    const int nn = n0 + (lane & 31); const bool ok = nn < N;
#pragma unroll 8
    for (int i = 0; i < 32; ++i) { const int kk = 2 * i + (lane >> 5); scr[kk * 33 + (lane & 31)] = ok ? W[(size_t)(k0 + kk) * N + nn] * (kscale ? kscale[k0 + kk] : 1.0f) : 0.f; }
    LDS_WAIT(); asm volatile("" ::: "memory");
    const int c = lane & 7;
#pragma unroll
    for (int j = 0; j < 4; ++j) { const int n = (lane >> 3) + 8 * j; const LAS float* s = scr + (8 * c) * 33 + n;
        v4u o; o.x = pk2(s[0 * 33], s[1 * 33]); o.y = pk2(s[2 * 33], s[3 * 33]); o.z = pk2(s[4 * 33], s[5 * 33]); o.w = pk2(s[6 * 33], s[7 * 33]);
        *(v4u*)(WT + (size_t)(rowbase + n) * K + k0 + 8 * c) = o; }
    LDS_WAIT(); asm volatile("" ::: "memory");
}
DI bool transpose_job(int& r, const float* W, int K, int N, int Npad, bf16* WT, int row_off, int grp, int sel, LAS float* scr, int lane, const float* kscale = nullptr) {
    const int nblk = Npad / 32, cnt = (K / 64) * nblk;
    if (r >= cnt) { r -= cnt; return false; }
    const int kb = r / nblk, nb = r % nblk, n0 = 32 * nb;
    const int rowbase = row_off + (grp ? (n0 / grp) * (2 * grp) + sel * grp + (n0 % grp) : n0);
    transpose_item(W, K, N, WT, rowbase, scr, 64 * kb, n0, lane, kscale);
    return true;
}
#define XB_TMO      128
#define XB_XCNT(j)  (256  + 64 * (j))
#define XB_XSUB(j)  (1280 + 64 * (j))
#define XB_XGEN(j)  (2304 + 64 * (j))
#define XB_TOP      3328
#define XB_TOPGEN   3392
#define XCD_BAR_WORDS 3456
#define XB_SPIN_CAP (1u << 22)

__device__ __forceinline__ unsigned xb_ld(unsigned* p)              { return __hip_atomic_load(p, __ATOMIC_RELAXED, __HIP_MEMORY_SCOPE_AGENT); }
__device__ __forceinline__ unsigned xb_add(unsigned* p, unsigned v) { return __hip_atomic_fetch_add(p, v, __ATOMIC_RELAXED, __HIP_MEMORY_SCOPE_AGENT); }
__device__ __forceinline__ unsigned xb_xcc_id() { return (unsigned)__builtin_amdgcn_s_getreg((3 << 11) | 20) & 0xFu; }
#define XB_SPIN(cond, bar) do { unsigned _sp = 0; while (cond) { __builtin_amdgcn_s_sleep(1); \
    if ((++_sp & 255u) == 0u) { if (xb_ld(&(bar)[XB_TMO])) break; if (_sp > XB_SPIN_CAP) { atomicAdd(&(bar)[XB_TMO], 1u); break; } } } } while (0)

struct XcdBarrier {
    unsigned* bar; unsigned x;
    volatile LAS unsigned* st;
};

__device__ __forceinline__ XcdBarrier xcd_barrier_post(unsigned* bar, volatile LAS unsigned* st) {
    XcdBarrier b; b.bar = bar; b.x = xb_xcc_id(); b.st = st;
    if (threadIdx.x == 0) (void)xb_add(&bar[XB_XCNT(b.x)], 1u);
    return b;
}
__device__ __forceinline__ void xcd_barrier_complete(unsigned* bar, unsigned x, unsigned& nloc, unsigned& nx) {
    const unsigned G = gridDim.x * gridDim.y * gridDim.z;
    unsigned sum, cnt, mine, sp = 0u;
    for (;;) {
        sum = 0u; cnt = 0u; mine = 0u;
#pragma unroll
        for (unsigned j = 0; j < 16; ++j) { const unsigned c = xb_ld(&bar[XB_XCNT(j)]); sum += c; cnt += (c > 0u) ? 1u : 0u; mine = (j == x) ? c : mine; }
        if (sum == G) break;
        __builtin_amdgcn_s_sleep(1);
        if ((++sp & 255u) == 0u) { if (xb_ld(&bar[XB_TMO])) break; if (sp > XB_SPIN_CAP) { atomicAdd(&bar[XB_TMO], 1u); break; } }
    }
    nloc = mine > 0u ? mine : 1u; nx = cnt > 0u ? cnt : 1u;
}

__device__ __forceinline__ void xcd_barrier(const XcdBarrier& b, const bool wave0) {
    asm volatile("s_waitcnt vmcnt(0)" ::: "memory");
    __syncthreads();
    if (wave0 && __builtin_amdgcn_mbcnt_hi(~0u, __builtin_amdgcn_mbcnt_lo(~0u, 0u)) == 0u) {
        unsigned* bar = b.bar; asm volatile("" : "+s"(bar)); const unsigned bx_ = xb_xcc_id();
        __builtin_amdgcn_s_waitcnt(0);
        unsigned nloc = b.st[0], nx = b.st[1];
        if (nloc == 0u) { xcd_barrier_complete(bar, bx_, nloc, nx); b.st[0] = nloc; b.st[1] = nx; }
        const unsigned old = xb_add(&bar[XB_XSUB(bx_)], 1u);
        const unsigned gen = old / nloc;
        if (old + 1u == (gen + 1u) * nloc) {
            __builtin_amdgcn_fence(__ATOMIC_RELEASE, "agent");
            asm volatile("s_waitcnt vmcnt(0)" ::: "memory");
            const unsigned og = xb_add(&bar[XB_TOP], 1u);
            const unsigned tg = og / nx;
            if (og + 1u == (tg + 1u) * nx) xb_add(&bar[XB_TOPGEN], 1u);
            else XB_SPIN(xb_ld(&bar[XB_TOPGEN]) == tg, bar);
            __builtin_amdgcn_fence(__ATOMIC_ACQUIRE, "agent");
            xb_add(&bar[XB_XGEN(bx_)], 1u);
            asm volatile("s_waitcnt vmcnt(0)" ::: "memory");
        } else {
            XB_SPIN(xb_ld(&bar[XB_XGEN(bx_)]) == gen, bar);
            __builtin_amdgcn_fence(__ATOMIC_ACQUIRE, "agent");
            asm volatile("s_waitcnt vmcnt(0)" ::: "memory");
        }
    }
    __syncthreads();
}
DI float row_rstd(const f32x4 (&v)[4]) {
    float s = 0.f;
#pragma unroll
    for (int j = 0; j < 4; ++j) s += (v[j].x * v[j].x + v[j].y * v[j].y) + (v[j].z * v[j].z + v[j].w * v[j].w);
    return 1.0f / sqrtf(wave_sum(s) * (1.0f / D_) + 1e-6f);
}
DI void load_row(const float* x, int t, int lane, f32x4 (&v)[4]) {
    if (t >= 0 && t < S_) { const f32x4* p = (const f32x4*)(x + (size_t)t * D_) + lane;
#pragma unroll
        for (int j = 0; j < 4; ++j) v[j] = p[64 * j];
    } else {
#pragma unroll
        for (int j = 0; j < 4; ++j) v[j] = (f32x4){0.f, 0.f, 0.f, 0.f};
    }
}
DI void store_row_bf16(bf16* o, int lane, const f32x4 (&v)[4]) {
    unsigned long long* o8 = (unsigned long long*)o + lane;
#pragma unroll
    for (int j = 0; j < 4; ++j) o8[64 * j] = (unsigned long long)pk2(v[j].x, v[j].y) | ((unsigned long long)pk2(v[j].z, v[j].w) << 32);
}
DI void norm_rows(const float* x, const float* w, const float* mu  , bf16* H, bf16* HX, int gw, int NGW, int lane) {
    f32x4 wv[4];
#pragma unroll
    for (int j = 0; j < 4; ++j) wv[j] = ((const f32x4*)w)[lane + 64 * j];
    for (int t = gw; t < S_; t += NGW) {
        f32x4 v[4]; load_row(x, t, lane, v); const float rs = row_rstd(v);
#pragma unroll
        for (int j = 0; j < 4; ++j) v[j] = v[j] * rs * wv[j];
        store_row_bf16(H + (size_t)t * D_, lane, v);
        if (mu) {
            f32x4 p[4], n[4]; load_row(x, t - 1, lane, p); load_row(x, t + 1, lane, n);
            const float rp = row_rstd(p), rn = row_rstd(n);
#pragma unroll
            for (int j = 0; j < 4; ++j) { const f32x4 m0 = ((const f32x4*)mu)[lane + 64 * j], m1 = ((const f32x4*)(mu + D_))[lane + 64 * j];
                const f32x4 hp = p[j] * rp * wv[j], hn = n[j] * rn * wv[j]; p[j] = v[j] + m0 * (hp - v[j]) + m1 * (hn - v[j]); }
            store_row_bf16(HX + (size_t)t * D_, lane, p);
        }
    }
}

DI void prep0_token(const Args& a, unsigned char* ws, LAS float* scr, int t, int lane) {
    const bf16* P = (const bf16*)(ws + WS_PROJ0) + (size_t)t * EVEN_IN;
    const int c0 = 8 * lane;
    {
        float q[8], k[8]; ld8(P + c0, q); ld8(P + 512 + c0, k);
        float sq = 0.f, sk = 0.f;
#pragma unroll
        for (int i = 0; i < 8; ++i) { sq += q[i] * q[i]; sk += k[i] * k[i]; }
        sq = grp_sum<8>(sq); sk = grp_sum<8>(sk);
        const float rq = 1.0f / sqrtf(sq * (1.0f / 64.f) + 1e-6f), rk = 1.0f / sqrtf(sk * (1.0f / 64.f) + 1e-6f);
        const int d0 = 8 * (lane & 7);
        float qw[8], kw[8]; ld8f(a.in[4] + d0, qw); ld8f(a.in[5] + d0, kw);
#pragma unroll
        for (int i = 0; i < 8; ++i) { q[i] = q[i] * rq * qw[i]; k[i] = k[i] * rk * kw[i]; }
        const float pos = (float)((const int*)a.in[1])[t];
        float qo[8], ko[8];
#pragma unroll
        for (int i = 0; i < 8; ++i) { qo[i] = __shfl_xor(q[i], 1); ko[i] = __shfl_xor(k[i], 1); }
        const int sub = lane & 7;
        if (sub < 2) {
#pragma unroll
            for (int i = 0; i < 8; ++i) {
                constexpr float kInv[8] = {1.0f, 0.1939227432012558f, 0.03760603070259094f, 0.007292664609849453f, 0.0014142135623842478f, 0.00027424818836152554f, 5.3182957344688475e-05f, 1.0313385246263351e-05f};
                const float ang = pos * kInv[i]; const float kq = rintf(ang * 0.15915494309189535f);
                float rr = fmaf(-kq, 6.28318548202514648f, ang); rr = fmaf(-kq, -1.74845553146951715e-07f, rr);
                const float sn = __sinf(rr), cs = __cosf(rr);
                if (sub == 0) { q[i] = q[i] * cs - qo[i] * sn; k[i] = k[i] * cs - ko[i] * sn; }
                else          { q[i] = q[i] * cs + qo[i] * sn; k[i] = k[i] * cs + ko[i] * sn; }
            }
        }
#pragma unroll
        for (int i = 0; i < 8; ++i) q[i] *= 0.125f;
        st8((bf16*)(ws + WS_QN) + (size_t)t * 512 + c0, q); st8((bf16*)(ws + WS_KN) + (size_t)t * 512 + c0, k);
    }
}

DI void rwkv_scan_naive(unsigned char* ws, int w  , int lane) {
    const int z = w >> 9, h = (w >> 6) & 7, vr = w & 63;
    const float* LW = (const float*)(ws + (z ? WS_LW1 : WS_LW0));
    const bf16* KD = (const bf16*)(ws + (z ? WS_KD1 : WS_KD0)); const bf16* BB = (const bf16*)(ws + (z ? WS_B1 : WS_B0));
    const bf16* KK = (const bf16*)(ws + WS_KK); const bf16* R = (const bf16*)(ws + WS_R); const bf16* V = (const bf16*)(ws + WS_V);
    bf16* Y = (bf16*)(ws + (z ? WS_Y1 : WS_Y0));
    const int cc = h * 64 + lane, cv = h * 64 + vr;
    float S = 0.f;
    int t = z ? S_ - 1 : 0; const int dt = z ? -1 : 1;
    size_t o = (size_t)t * 512;
    float lw = LW[o + cc], kd = bf2f(KD[o + cc]), bb = bf2f(BB[o + cc]), kk = bf2f(KK[o + cc]), rr = bf2f(R[o + cc]), vv = bf2f(V[o + cv]);
    for (int s = 0; s < S_; ++s) {
        const int tn = t + dt; const bool more = s + 1 < S_;
        const size_t on = (size_t)(more ? tn : t) * 512;
        const float lw_n = LW[on + cc], kd_n = bf2f(KD[on + cc]), bb_n = bf2f(BB[on + cc]), kk_n = bf2f(KK[on + cc]), rr_n = bf2f(R[on + cc]), vv_n = bf2f(V[on + cv]);
        const float sa = wave_sum(S * (-kk));
        S = S * __expf(lw) + sa * bb + vv * kd;
        const float y = wave_sum(S * rr);
        if (lane == 0) Y[(size_t)t * 512 + cv] = (bf16)f2bf(y);
        lw = lw_n; kd = kd_n; bb = bb_n; kk = kk_n; rr = rr_n; vv = vv_n; t = tn;
    }
}

DI void attn_token_naive(unsigned char* ws, int t, int lane) {
    const bf16* QN = (const bf16*)(ws + WS_QN); const bf16* KN = (const bf16*)(ws + WS_KN); const bf16* P = (const bf16*)(ws + WS_PROJ0);
    const int c0 = 8 * lane;
    float q[8]; ld8(QN + (size_t)t * 512 + c0, q);
    float m = -1e30f, l = 0.f, acc[8];
#pragma unroll
    for (int i = 0; i < 8; ++i) acc[i] = 0.f;
    for (int br = 0; br < 3; ++br) {
        const int d = br == 0 ? 1 : (br == 1 ? 4 : 16);
        for (int mm = -64; mm <= 64; ++mm) {
            const int j = t + d * mm; if (j < 0 || j >= S_) continue;
            float k[8], v[8]; ld8(KN + (size_t)j * 512 + c0, k); ld8(P + (size_t)j * EVEN_IN + 1024 + c0, v);
            float s = 0.f;
#pragma unroll
            for (int i = 0; i < 8; ++i) s += q[i] * k[i];
            s = grp_sum<8>(s);
            const float mn = fmaxf(m, s), sc = __expf(m - mn), p = __expf(s - mn);
            l = l * sc + p;
#pragma unroll
            for (int i = 0; i < 8; ++i) acc[i] = acc[i] * sc + p * v[i];
            m = mn;
        }
    }
    const float il = 1.0f / l;
#pragma unroll
    for (int i = 0; i < 8; ++i) acc[i] *= il;
    st8((bf16*)(ws + WS_Y) + (size_t)t * D_ + c0, acc);
}

DI void rwkv_post_token(const Args& a, unsigned char* ws, int t, int lane) {
    const int c0 = 8 * lane; const size_t o = (size_t)t * 512 + c0;
    float y0[8], y1[8], g[8], bn[8], lw[8], lb[8];
    ld8((const bf16*)(ws + WS_Y0) + o, y0); ld8((const bf16*)(ws + WS_Y1) + o, y1); ld8((const bf16*)(ws + WS_GATE) + o, g); ld8((const bf16*)(ws + WS_BONUS) + o, bn);
    ld8f(a.in[19] + c0, lw); ld8f(a.in[20] + c0, lb);
    float s = 0.f;
#pragma unroll
    for (int i = 0; i < 8; ++i) { y0[i] += y1[i]; s += y0[i]; }
    const float mu = grp_sum<8>(s) * (1.0f / 64.f);
    float q = 0.f;
#pragma unroll
    for (int i = 0; i < 8; ++i) { y0[i] -= mu; q += y0[i] * y0[i]; }
    const float rs = 1.0f / sqrtf(grp_sum<8>(q) * (1.0f / 64.f) + 64e-5f);
#pragma unroll
    for (int i = 0; i < 8; ++i) y0[i] = (y0[i] * rs * lw[i] + lb[i] + bn[i]) * g[i];
    st8((bf16*)(ws + WS_Y) + (size_t)t * D_ + 512 + c0, y0);
}
typedef short s16x8 __attribute__((ext_vector_type(8)));
typedef short s16x4 __attribute__((ext_vector_type(4)));
typedef LAS unsigned char* ldsp;
DI f32x4 mfma16(s16x8 a, s16x8 b, f32x4 c) { return __builtin_amdgcn_mfma_f32_16x16x32_bf16(a, b, c, 0, 0, 0); }
DI s16x8 frag_row(ldsp img, int row0, int col0, int lane) { return *(LAS const s16x8*)(img + (row0 + (lane & 15)) * 128 + (col0 + 8 * (lane >> 4)) * 2); }
DI s16x4 tr16(ldsp p) { return __builtin_bit_cast(s16x4, __builtin_amdgcn_ds_read_tr16_b64_v4i16((LAS s16x4*)p)); }
DI s16x8 frag_tr(ldsp img, int row0, int col0, int lane) {
    ldsp a0 = img + (row0 + 8 * (lane >> 4) + ((lane & 15) >> 2)) * 128 + col0 * 2 + 8 * (lane & 3);
    const s16x4 lo = tr16(a0), hi = tr16(a0 + 4 * 128);
    return __builtin_shufflevector(lo, hi, 0, 1, 2, 3, 4, 5, 6, 7);
}
DI void ctile_to_img(ldsp img, int mt, int nt, const f32x4& c, int lane) {
    LAS bf16* p = (LAS bf16*)(img + (16 * mt + 4 * (lane >> 4)) * 128 + (16 * nt + (lane & 15)) * 2);
#pragma unroll
    for (int e = 0; e < 4; ++e) p[e * 64] = (bf16)f2bf(c[e]);
}
#define CFENCE() asm volatile("" ::: "memory")
#define MM_LOOPH(ACC, AEXPR, BEXPR) _Pragma("unroll") for (int mt = 2 * mh; mt < 2 * mh + 2; ++mt) _Pragma("unroll") for (int nt = 0; nt < 4; ++nt) _Pragma("unroll") for (int ks = 0; ks < 2; ++ks) ACC[mt][nt] = mfma16((AEXPR), (BEXPR), ACC[mt][nt])
#define MM_LOOP(ACC, AEXPR, BEXPR) _Pragma("unroll") for (int mt = 0; mt < 4; ++mt) _Pragma("unroll") for (int nt = 0; nt < 4; ++nt) _Pragma("unroll") for (int ks = 0; ks < 2; ++ks) ACC[mt][nt] = mfma16((AEXPR), (BEXPR), ACC[mt][nt])

DI int tok_of(int z, int cn, int i) { return z ? cn * 64 + 63 - i : cn * 64 + i; }

template <bool DRY = false, int STOP = 99> DI void rwkv_pass1_item(unsigned char* ws, ldsp lds, int item, int lane) {
    asm volatile("" : "+v"(lane));
    const int z = item >> 11, h = (item >> 8) & 7, c = item & 255;
    const int cn = z ? 255 - c : c;
    float* LW = (float*)(ws + (z ? WS_LW1 : WS_LW0));
    bf16* KD = (bf16*)(ws + (z ? WS_KD1 : WS_KD0)); bf16* BB = (bf16*)(ws + (z ? WS_B1 : WS_B0));
    const bf16* KK = (const bf16*)(ws + WS_KK); const bf16* R = (const bf16*)(ws + WS_R); const bf16* V = (const bf16*)(ws + WS_V);
    float* LWo = DRY ? (float*)(ws + WS_Y) : LW; bf16* KDo = DRY ? (bf16*)(ws + WS_Y) : KD; bf16* BBo = DRY ? (bf16*)(ws + WS_Y) : BB;
    ldsp S0 = lds, S1 = lds + 8192, S2 = lds + 16384, S3 = lds + 24576, S4 = lds + 32768, S5 = lds + 40960, S6 = lds + 49152, S7 = lds + 57344;
    ldsp IA = S0, IB = S1, IK = S2, IR = S3;
    const int ch = h * 64 + lane;
    float G = 0.f;
#pragma unroll 16
    for (int i = 0; i < 64; ++i) {
        const size_t o = (size_t)tok_of(z, cn, i) * 512 + ch;
        const float lw = LW[o], a = -bf2f(KK[o]), b = bf2f(BB[o]), kd = bf2f(KD[o]), r = bf2f(R[o]);
        const float eprev = __expf(G); G += lw; const float ecur = __expf(G), einv = __expf(-G);
        ((LAS bf16*)IA)[i * 64 + lane] = (bf16)f2bf(a * eprev); ((LAS bf16*)IB)[i * 64 + lane] = (bf16)f2bf(b * einv);
        ((LAS bf16*)IK)[i * 64 + lane] = (bf16)f2bf(kd * einv); ((LAS bf16*)IR)[i * 64 + lane] = (bf16)f2bf(r * ecur);
    }
    const float GT = __expf(G);
    LDS_WAIT(); CFENCE();
    if (STOP == 1) { if (GT == 123.f) LWo[0] = GT; return; }
    int lane2 = lane; asm volatile("" : "+v"(lane2));
    const int n_ = lane2 & 15, q_ = lane2 >> 4;
    {
#pragma unroll
        for (int mh = 0; mh < 2; ++mh) {
        f32x4 acc[4][4];
#pragma unroll
        for (int mt = 2 * mh; mt < 2 * mh + 2; ++mt)
#pragma unroll
            for (int nt = 0; nt < 4; ++nt) acc[mt][nt] = (f32x4){0.f, 0.f, 0.f, 0.f};
        MM_LOOPH(acc, frag_row(IA, 16 * mt, 32 * ks, lane), frag_row(IB, 16 * nt, 32 * ks, lane));
#pragma unroll
        for (int mt = 2 * mh; mt < 2 * mh + 2; ++mt)
#pragma unroll
            for (int nt = 0; nt < 4; ++nt)
#pragma unroll
                for (int e = 0; e < 4; ++e) { const int i = 16 * mt + 4 * q_ + e, j = 16 * nt + n_; ((LAS float*)S4)[i * 64 + j] = (j < i) ? acc[mt][nt][e] : 0.f; }
        }
    }
    LDS_WAIT(); CFENCE();
    {
        float t[64];
        int lane_o = lane; asm volatile("" : "+v"(lane_o));
        f32x4 ar[2][16];
#pragma unroll
        for (int i = 0; i < 64; ++i) {
            if (i + 1 < 64) {
#pragma unroll
                for (int jg = 0; jg < (i + 1 + 3) / 4; ++jg) ar[(i + 1) & 1][jg] = *(LAS const f32x4*)(S4 + ((i + 1) * 64 + 4 * jg) * 4);
            }
            __builtin_amdgcn_sched_barrier(0);
            float acc0 = (lane_o == i) ? 1.f : 0.f, acc1 = 0.f, acc2 = 0.f, acc3 = 0.f;
#pragma unroll
            for (int jg = 0; jg < (i + 3) / 4; ++jg) { const f32x4 a4 = ar[i & 1][jg];
                if (4 * jg + 0 < i) acc0 += a4[0] * t[4 * jg + 0];
                if (4 * jg + 1 < i) acc1 += a4[1] * t[4 * jg + 1];
                if (4 * jg + 2 < i) acc2 += a4[2] * t[4 * jg + 2];
                if (4 * jg + 3 < i) acc3 += a4[3] * t[4 * jg + 3]; }
            t[i] = (acc0 + acc1) + (acc2 + acc3);
            __builtin_amdgcn_sched_barrier(0);
        }
        LDS_WAIT(); CFENCE();
#pragma unroll
        for (int i = 0; i < 64; ++i) ((LAS bf16*)S4)[i * 64 + lane] = (bf16)f2bf(t[i]);
    }
    LDS_WAIT(); CFENCE();
    if (STOP == 2) return;
    ldsp IT = S4, IW = S5, IAK = S6;
    {
#pragma unroll
        for (int mh = 0; mh < 2; ++mh) {
        f32x4 acc[4][4];
#pragma unroll
        for (int mt = 2 * mh; mt < 2 * mh + 2; ++mt)
#pragma unroll
            for (int nt = 0; nt < 4; ++nt) acc[mt][nt] = (f32x4){0.f, 0.f, 0.f, 0.f};
        MM_LOOPH(acc, frag_row(IA, 16 * mt, 32 * ks, lane), frag_row(IK, 16 * nt, 32 * ks, lane));
#pragma unroll
        for (int mt = 2 * mh; mt < 2 * mh + 2; ++mt)
#pragma unroll
            for (int nt = 0; nt < 4; ++nt) {
#pragma unroll
                for (int e = 0; e < 4; ++e) { const int i = 16 * mt + 4 * q_ + e, j = 16 * nt + n_; if (!(j < i)) acc[mt][nt][e] = 0.f; }
                ctile_to_img(IAK, mt, nt, acc[mt][nt], lane); }
        }
    }
    {
#pragma unroll
        for (int mh = 0; mh < 2; ++mh) {
        f32x4 acc[4][4];
#pragma unroll
        for (int mt = 2 * mh; mt < 2 * mh + 2; ++mt)
#pragma unroll
            for (int nt = 0; nt < 4; ++nt) acc[mt][nt] = (f32x4){0.f, 0.f, 0.f, 0.f};
        MM_LOOPH(acc, frag_row(IT, 16 * mt, 32 * ks, lane), frag_tr(IA, 32 * ks, 16 * nt, lane));
#pragma unroll
        for (int mt = 2 * mh; mt < 2 * mh + 2; ++mt)
#pragma unroll
            for (int nt = 0; nt < 4; ++nt) ctile_to_img(IW, mt, nt, acc[mt][nt], lane);
        }
    }
    LDS_WAIT(); CFENCE();
    ldsp IV = S0;
#pragma unroll 16
    for (int i = 0; i < 64; ++i) ((LAS bf16*)IV)[i * 64 + lane] = V[(size_t)tok_of(z, cn, i) * 512 + ch];
    LDS_WAIT(); CFENCE();
    ldsp IAV = S7;
    {
#pragma unroll
        for (int mh = 0; mh < 2; ++mh) {
        f32x4 acc[4][4];
#pragma unroll
        for (int mt = 2 * mh; mt < 2 * mh + 2; ++mt)
#pragma unroll
            for (int nt = 0; nt < 4; ++nt) acc[mt][nt] = (f32x4){0.f, 0.f, 0.f, 0.f};
        MM_LOOPH(acc, frag_row(IAK, 16 * mt, 32 * ks, lane), frag_tr(IV, 32 * ks, 16 * nt, lane));
#pragma unroll
        for (int mt = 2 * mh; mt < 2 * mh + 2; ++mt)
#pragma unroll
            for (int nt = 0; nt < 4; ++nt) ctile_to_img(IAV, mt, nt, acc[mt][nt], lane);
        }
    }
    LDS_WAIT(); CFENCE();
    ldsp IU = S6;
    {
#pragma unroll
        for (int mh = 0; mh < 2; ++mh) {
        f32x4 acc[4][4];
#pragma unroll
        for (int mt = 2 * mh; mt < 2 * mh + 2; ++mt)
#pragma unroll
            for (int nt = 0; nt < 4; ++nt) acc[mt][nt] = (f32x4){0.f, 0.f, 0.f, 0.f};
        MM_LOOPH(acc, frag_row(IT, 16 * mt, 32 * ks, lane), frag_tr(IAV, 32 * ks, 16 * nt, lane));
        LDS_WAIT(); CFENCE();
#pragma unroll
        for (int mt = 2 * mh; mt < 2 * mh + 2; ++mt)
#pragma unroll
            for (int nt = 0; nt < 4; ++nt) ctile_to_img(IU, mt, nt, acc[mt][nt], lane);
        }
    }
    LDS_WAIT(); CFENCE();
    if (STOP == 3) return;
    ldsp IRB = S4, IRK = S7;
    {
#pragma unroll
        for (int mh = 0; mh < 2; ++mh) {
        f32x4 acc[4][4];
#pragma unroll
        for (int mt = 2 * mh; mt < 2 * mh + 2; ++mt)
#pragma unroll
            for (int nt = 0; nt < 4; ++nt) acc[mt][nt] = (f32x4){0.f, 0.f, 0.f, 0.f};
        MM_LOOPH(acc, frag_row(IR, 16 * mt, 32 * ks, lane), frag_row(IB, 16 * nt, 32 * ks, lane));
#pragma unroll
        for (int mt = 2 * mh; mt < 2 * mh + 2; ++mt)
#pragma unroll
            for (int nt = 0; nt < 4; ++nt) {
#pragma unroll
                for (int e = 0; e < 4; ++e) { const int i = 16 * mt + 4 * q_ + e, j = 16 * nt + n_; if (!(j <= i)) acc[mt][nt][e] = 0.f; }
                ctile_to_img(IRB, mt, nt, acc[mt][nt], lane); }
        }
    }
    {
#pragma unroll
        for (int mh = 0; mh < 2; ++mh) {
        f32x4 acc[4][4];
#pragma unroll
        for (int mt = 2 * mh; mt < 2 * mh + 2; ++mt)
#pragma unroll
            for (int nt = 0; nt < 4; ++nt) acc[mt][nt] = (f32x4){0.f, 0.f, 0.f, 0.f};
        MM_LOOPH(acc, frag_row(IR, 16 * mt, 32 * ks, lane), frag_row(IK, 16 * nt, 32 * ks, lane));
#pragma unroll
        for (int mt = 2 * mh; mt < 2 * mh + 2; ++mt)
#pragma unroll
            for (int nt = 0; nt < 4; ++nt) {
#pragma unroll
                for (int e = 0; e < 4; ++e) { const int i = 16 * mt + 4 * q_ + e, j = 16 * nt + n_; if (!(j <= i)) acc[mt][nt][e] = 0.f; }
                ctile_to_img(IRK, mt, nt, acc[mt][nt], lane); }
        }
    }
    LDS_WAIT(); CFENCE();
    int lane3 = lane; asm volatile("" : "+v"(lane3));
    const int n3 = lane3 & 15, q3 = lane3 >> 4;
    const size_t slot0 = (size_t)cn * 64 * 512 + h * 64;
    {
#pragma unroll
        for (int mh = 0; mh < 2; ++mh) {
        f32x4 acc[4][4];
#pragma unroll
        for (int mt = 2 * mh; mt < 2 * mh + 2; ++mt)
#pragma unroll
            for (int nt = 0; nt < 4; ++nt) { const s16x4 r4 = *(LAS const s16x4*)(IR + (16 * nt + n3) * 128 + (16 * mt + 4 * q3) * 2);
#pragma unroll
                for (int e = 0; e < 4; ++e) acc[mt][nt][e] = bf2f((bf16)r4[e]); }
        MM_LOOPH(acc, frag_tr(IW, 32 * ks, 16 * mt, lane), frag_row(IRB, 16 * nt, 32 * ks, lane));
#pragma unroll
        for (int mt = 2 * mh; mt < 2 * mh + 2; ++mt)
#pragma unroll
            for (int nt = 0; nt < 4; ++nt) { bf16* dst = (bf16*)(LWo + slot0 + (size_t)(16 * nt + n3) * 512) + 16 * mt + 4 * q3;
                *(unsigned long long*)dst = (unsigned long long)pk2(acc[mt][nt][0], acc[mt][nt][1]) | ((unsigned long long)pk2(acc[mt][nt][2], acc[mt][nt][3]) << 32); }
        }
    }
    {
#pragma unroll
        for (int mh = 0; mh < 2; ++mh) {
        f32x4 acc[4][4];
#pragma unroll
        for (int mt = 2 * mh; mt < 2 * mh + 2; ++mt)
#pragma unroll
            for (int nt = 0; nt < 4; ++nt) acc[mt][nt] = (f32x4){0.f, 0.f, 0.f, 0.f};
        MM_LOOPH(acc, frag_tr(IU, 32 * ks, 16 * mt, lane), frag_row(IRB, 16 * nt, 32 * ks, lane));
        MM_LOOPH(acc, frag_tr(IV, 32 * ks, 16 * mt, lane), frag_row(IRK, 16 * nt, 32 * ks, lane));
#pragma unroll
        for (int mt = 2 * mh; mt < 2 * mh + 2; ++mt)
#pragma unroll
            for (int nt = 0; nt < 4; ++nt) { bf16* dst = (bf16*)(LWo + slot0 + (size_t)(16 * nt + n3) * 512) + 64 + 16 * mt + 4 * q3;
                *(unsigned long long*)dst = (unsigned long long)pk2(acc[mt][nt][0], acc[mt][nt][1]) | ((unsigned long long)pk2(acc[mt][nt][2], acc[mt][nt][3]) << 32); }
        }
    }
    {
#pragma unroll
        for (int mh = 0; mh < 2; ++mh) {
        f32x4 acc[4][4];
#pragma unroll
        for (int mt = 2 * mh; mt < 2 * mh + 2; ++mt)
#pragma unroll
            for (int nt = 0; nt < 4; ++nt) acc[mt][nt] = (f32x4){0.f, 0.f, 0.f, 0.f};
        MM_LOOPH(acc, frag_tr(IW, 32 * ks, 16 * mt, lane), frag_tr(IB, 32 * ks, 16 * nt, lane));
#pragma unroll
        for (int nt = 0; nt < 4; ++nt) { const float gk = __shfl(GT, 16 * nt + n3);
#pragma unroll
            for (int mt = 2 * mh; mt < 2 * mh + 2; ++mt) { float o[4];
#pragma unroll
                for (int e = 0; e < 4; ++e) o[e] = gk * (acc[mt][nt][e] + ((16 * mt + 4 * q3 + e) == (16 * nt + n3) ? 1.f : 0.f));
                bf16* dst = KDo + slot0 + (size_t)(16 * nt + n3) * 512 + 16 * mt + 4 * q3;
                *(unsigned long long*)dst = (unsigned long long)pk2(o[0], o[1]) | ((unsigned long long)pk2(o[2], o[3]) << 32); } }
        }
    }
    {
#pragma unroll
        for (int mh = 0; mh < 2; ++mh) {
        f32x4 acc[4][4];
#pragma unroll
        for (int mt = 2 * mh; mt < 2 * mh + 2; ++mt)
#pragma unroll
            for (int nt = 0; nt < 4; ++nt) acc[mt][nt] = (f32x4){0.f, 0.f, 0.f, 0.f};
        MM_LOOPH(acc, frag_tr(IB, 32 * ks, 16 * mt, lane), frag_tr(IU, 32 * ks, 16 * nt, lane));
        MM_LOOPH(acc, frag_tr(IK, 32 * ks, 16 * mt, lane), frag_tr(IV, 32 * ks, 16 * nt, lane));
#pragma unroll
        for (int mt = 2 * mh; mt < 2 * mh + 2; ++mt) { float gk[4];
#pragma unroll
            for (int e = 0; e < 4; ++e) gk[e] = __shfl(GT, 16 * mt + 4 * q3 + e);
#pragma unroll
            for (int nt = 0; nt < 4; ++nt) { bf16* dst = BBo + slot0 + (size_t)(16 * nt + n3) * 512 + 16 * mt + 4 * q3;
                *(unsigned long long*)dst = (unsigned long long)pk2(gk[0] * acc[mt][nt][0], gk[1] * acc[mt][nt][1]) | ((unsigned long long)pk2(gk[2] * acc[mt][nt][2], gk[3] * acc[mt][nt][3]) << 32); } }
        }
    }
    LDS_WAIT(); CFENCE();
}
DI unsigned long long pk4(const f32x4& v) { return (unsigned long long)pk2(v[0], v[1]) | ((unsigned long long)pk2(v[2], v[3]) << 32); }
DI f32x4 unpk4(unsigned long long w) { return (f32x4){bflo((unsigned)w), bfhi((unsigned)w), bflo((unsigned)(w >> 32)), bfhi((unsigned)(w >> 32))}; }
DI s16x8 pack_cpair(const f32x4& lo, const f32x4& hi) {
    v4u p; p.x = pk2(lo[0], lo[1]); p.y = pk2(lo[2], lo[3]); p.z = pk2(hi[0], hi[1]); p.w = pk2(hi[2], hi[3]);
    return __builtin_bit_cast(s16x8, p);
}
DI void rwkv_pass2_wave(unsigned char* ws, int w  , int lane) {
    const int z = w >> 5, h = (w >> 2) & 7, vs = w & 3;
    const bf16* Mm = (const bf16*)(ws + (z ? WS_KD1 : WS_KD0)); const bf16* Nn = (const bf16*)(ws + (z ? WS_B1 : WS_B0));
    bf16* Hst = (bf16*)(ws + (z ? WS_V : WS_R));
    const int n_ = lane & 15, q_ = lane >> 4;
    f32x4 H[4];
#pragma unroll
    for (int kt = 0; kt < 4; ++kt) H[kt] = (f32x4){0.f, 0.f, 0.f, 0.f};
    unsigned long long ma[4][2][2], nn[4];
    {
        const int cn = z ? 255 : 0; const size_t slot0 = (size_t)cn * 64 * 512 + h * 64;
#pragma unroll
        for (int kt = 0; kt < 4; ++kt) {
#pragma unroll
            for (int ks = 0; ks < 2; ++ks) { const bf16* row = Mm + slot0 + (size_t)(16 * kt + n_) * 512 + 32 * ks + 4 * q_;
                ma[kt][ks][0] = *(const unsigned long long*)row; ma[kt][ks][1] = *(const unsigned long long*)(row + 16); }
            nn[kt] = *(const unsigned long long*)(Nn + slot0 + (size_t)(16 * vs + n_) * 512 + 16 * kt + 4 * q_); }
    }
    for (int c = 0; c < 256; ++c) {
        { bf16* dst = Hst + ((size_t)(c * 8 + h) * 64 + 16 * vs + n_) * 64 + 4 * q_;
#pragma unroll
          for (int kt = 0; kt < 4; ++kt) *(unsigned long long*)(dst + 16 * kt) = (unsigned long long)pk2(H[kt][0], H[kt][1]) | ((unsigned long long)pk2(H[kt][2], H[kt][3]) << 32); }
        unsigned long long ma2[4][2][2], nn2[4];
        { const int c2 = c + 1 < 256 ? c + 1 : c; const int cn = z ? 255 - c2 : c2; const size_t slot0 = (size_t)cn * 64 * 512 + h * 64;
#pragma unroll
          for (int kt = 0; kt < 4; ++kt) {
#pragma unroll
            for (int ks = 0; ks < 2; ++ks) { const bf16* row = Mm + slot0 + (size_t)(16 * kt + n_) * 512 + 32 * ks + 4 * q_;
                ma2[kt][ks][0] = *(const unsigned long long*)row; ma2[kt][ks][1] = *(const unsigned long long*)(row + 16); }
            nn2[kt] = *(const unsigned long long*)(Nn + slot0 + (size_t)(16 * vs + n_) * 512 + 16 * kt + 4 * q_); } }
        const s16x8 b0 = pack_cpair(H[0], H[1]), b1 = pack_cpair(H[2], H[3]);
#pragma unroll
        for (int kt = 0; kt < 4; ++kt) {
            f32x4 acc = (f32x4){bflo((unsigned)nn[kt]), bfhi((unsigned)nn[kt]), bflo((unsigned)(nn[kt] >> 32)), bfhi((unsigned)(nn[kt] >> 32))};
            { v4u a; a.x = (unsigned)ma[kt][0][0]; a.y = (unsigned)(ma[kt][0][0] >> 32); a.z = (unsigned)ma[kt][0][1]; a.w = (unsigned)(ma[kt][0][1] >> 32); acc = mfma16(__builtin_bit_cast(s16x8, a), b0, acc); }
            { v4u a; a.x = (unsigned)ma[kt][1][0]; a.y = (unsigned)(ma[kt][1][0] >> 32); a.z = (unsigned)ma[kt][1][1]; a.w = (unsigned)(ma[kt][1][1] >> 32); acc = mfma16(__builtin_bit_cast(s16x8, a), b1, acc); }
            H[kt] = acc;
        }
#pragma unroll
        for (int kt = 0; kt < 4; ++kt) { nn[kt] = nn2[kt];
#pragma unroll
            for (int ks = 0; ks < 2; ++ks) { ma[kt][ks][0] = ma2[kt][ks][0]; ma[kt][ks][1] = ma2[kt][ks][1]; } }
    }
}
DI void rwkv_pass3_item(unsigned char* ws, int item, int lane) {
    const int z = item >> 11, h = (item >> 8) & 7, c = item & 255;
    const int cn = z ? 255 - c : c;
    const float* LW = (const float*)(ws + (z ? WS_LW1 : WS_LW0));
    const bf16* Hst = (const bf16*)(ws + (z ? WS_V : WS_R)) + (size_t)(c * 8 + h) * 64 * 64;
    bf16* Y = (bf16*)(ws + (z ? WS_Y1 : WS_Y0));
    const int n_ = lane & 15, q_ = lane >> 4;
    const size_t slot0 = (size_t)cn * 64 * 512 + h * 64;
    s16x8 hA[4][2], qB[4][2];
#pragma unroll
    for (int t = 0; t < 4; ++t)
#pragma unroll
        for (int ks = 0; ks < 2; ++ks) {
            hA[t][ks] = *(const s16x8*)(Hst + (size_t)(16 * t + n_) * 64 + 32 * ks + 8 * q_);
            qB[t][ks] = *(const s16x8*)((const bf16*)(LW + slot0 + (size_t)(16 * t + n_) * 512) + 32 * ks + 8 * q_); }
#pragma unroll
    for (int nt = 0; nt < 4; ++nt) {
        const int i = 16 * nt + n_; const bf16* ycrow = (const bf16*)(LW + slot0 + (size_t)i * 512) + 64;
        bf16* yrow = Y + (size_t)tok_of(z, cn, i) * 512 + h * 64;
#pragma unroll
        for (int mt = 0; mt < 4; ++mt) {
            const unsigned long long y4 = *(const unsigned long long*)(ycrow + 16 * mt + 4 * q_);
            f32x4 acc = (f32x4){bflo((unsigned)y4), bfhi((unsigned)y4), bflo((unsigned)(y4 >> 32)), bfhi((unsigned)(y4 >> 32))};
            acc = mfma16(hA[mt][0], qB[nt][0], acc); acc = mfma16(hA[mt][1], qB[nt][1], acc);
            *(unsigned long long*)(yrow + 16 * mt + 4 * q_) = (unsigned long long)pk2(acc[0], acc[1]) | ((unsigned long long)pk2(acc[2], acc[3]) << 32);
        }
    }
}
DI void rwkv_pass2_block(unsigned char* ws, ldsp L, int b  , int wave, int lane) {
    const int z = b >> 3, h = b & 7;
    if (wave >= 4) {
        const int lw = wave - 4;
        const char* Mm = (const char*)(ws + (z ? WS_KD1 : WS_KD0)); const char* Nn = (const char*)(ws + (z ? WS_B1 : WS_B0));
#define RW_ISSUE(cc) do { const int c_ = (cc); if (c_ < 256) { const int cn_ = z ? 255 - c_ : c_; const size_t slot0 = ((size_t)cn_ * 64 * 512 + h * 64) * 2; ldsp slot = L + (c_ & 7) * 16384; \
            _Pragma("unroll") for (int k = 0; k < 4; ++k) { const int pid = lw * 4 + k; const int pr = pid & 7; const int row = 8 * pr + (lane >> 3), p = lane & 7, cch = p ^ (row & 7); \
                const char* src = (pid < 8 ? Mm : Nn) + slot0 + (size_t)row * 1024 + cch * 16; \
                __builtin_amdgcn_global_load_lds((const unsigned*)src, (LAS unsigned*)(slot + (pid < 8 ? 0 : 8192) + pr * 1024), 16, 0, 0); } } } while (0)
        RW_ISSUE(0); RW_ISSUE(1); RW_ISSUE(2); RW_ISSUE(3); RW_ISSUE(4); RW_ISSUE(5); RW_ISSUE(6);
        for (int c = 0; c < 256; ++c) {
            if (c < 250) asm volatile("s_waitcnt vmcnt(24)" ::: "memory"); else asm volatile("s_waitcnt vmcnt(0)" ::: "memory");
            __builtin_amdgcn_s_barrier();
            asm volatile("" ::: "memory");
            RW_ISSUE(c + 7);
        }
#undef RW_ISSUE
        asm volatile("s_waitcnt vmcnt(0)" ::: "memory");
        return;
    }
    const int vs = wave;
    bf16* Hst = (bf16*)(ws + (z ? WS_V : WS_R));
    const int n_ = lane & 15, q_ = lane >> 4, wbyte = (q_ & 1) * 8, sw = n_ & 7;
    f32x4 H[4];
#pragma unroll
    for (int kt = 0; kt < 4; ++kt) H[kt] = (f32x4){0.f, 0.f, 0.f, 0.f};
    for (int c = 0; c < 256; ++c) {
        { bf16* dst = Hst + ((size_t)(c * 8 + h) * 64 + 16 * vs + n_) * 64 + 4 * q_;
#pragma unroll
          for (int kt = 0; kt < 4; ++kt) *(unsigned long long*)(dst + 16 * kt) = pk4(H[kt]); }
        asm volatile("s_waitcnt lgkmcnt(0)" ::: "memory");
        __builtin_amdgcn_s_barrier();
        asm volatile("" ::: "memory");
        ldsp slot = L + (c & 7) * 16384;
        const s16x8 b0 = pack_cpair(H[0], H[1]), b1 = pack_cpair(H[2], H[3]);
#pragma unroll
        for (int kt = 0; kt < 4; ++kt) {
            ldsp nrow = slot + 8192 + (16 * vs + n_) * 128 + wbyte;
            f32x4 acc = unpk4(*(LAS const unsigned long long*)(nrow + (((2 * kt + (q_ >> 1)) ^ sw) * 16)));
            ldsp mrow = slot + (16 * kt + n_) * 128 + wbyte;
#pragma unroll
            for (int ks = 0; ks < 2; ++ks) { const int c0 = 4 * ks + (q_ >> 1);
                const unsigned long long a0 = *(LAS const unsigned long long*)(mrow + ((c0 ^ sw) * 16)), a1 = *(LAS const unsigned long long*)(mrow + (((c0 + 2) ^ sw) * 16));
                v4u a; a.x = (unsigned)a0; a.y = (unsigned)(a0 >> 32); a.z = (unsigned)a1; a.w = (unsigned)(a1 >> 32);
                acc = mfma16(__builtin_bit_cast(s16x8, a), ks == 0 ? b0 : b1, acc); }
            H[kt] = acc;
        }
    }
}
DI void rwkv_pass3_post_item(const Args& a, unsigned char* ws, int item, int lane) {
    asm volatile("" : "+v"(lane));
    const int h = item >> 8, cn = item & 255;
    const int n_ = lane & 15, q_ = lane >> 4;
    const size_t slot0 = (size_t)cn * 64 * 512 + h * 64;
    const float* LW0 = (const float*)(ws + WS_LW0); const float* LW1 = (const float*)(ws + WS_LW1);
    const bf16* H0 = (const bf16*)(ws + WS_R) + (size_t)(cn * 8 + h) * 4096;
    const bf16* H1 = (const bf16*)(ws + WS_V) + (size_t)((255 - cn) * 8 + h) * 4096;
    s16x8 hA0[4][2], hA1[4][2];
#pragma unroll
    for (int t = 0; t < 4; ++t)
#pragma unroll
        for (int ks = 0; ks < 2; ++ks) { hA0[t][ks] = *(const s16x8*)(H0 + (size_t)(16 * t + n_) * 64 + 32 * ks + 8 * q_); hA1[t][ks] = *(const s16x8*)(H1 + (size_t)(16 * t + n_) * 64 + 32 * ks + 8 * q_); }
#pragma unroll
    for (int nt = 0; nt < 4; ++nt) {
        const int i0 = 16 * nt + n_, i1 = 63 - i0;
        const bf16* q0 = (const bf16*)(LW0 + slot0 + (size_t)i0 * 512); const bf16* q1 = (const bf16*)(LW1 + slot0 + (size_t)i1 * 512);
        s16x8 qB0[2], qB1[2];
#pragma unroll
        for (int ks = 0; ks < 2; ++ks) { qB0[ks] = *(const s16x8*)(q0 + 32 * ks + 8 * q_); qB1[ks] = *(const s16x8*)(q1 + 32 * ks + 8 * q_); }
        f32x4 y[4]; float sum = 0.f;
#pragma unroll
        for (int mt = 0; mt < 4; ++mt) {
            f32x4 acc = unpk4(*(const unsigned long long*)(q0 + 64 + 16 * mt + 4 * q_)) + unpk4(*(const unsigned long long*)(q1 + 64 + 16 * mt + 4 * q_));
            acc = mfma16(hA0[mt][0], qB0[0], acc); acc = mfma16(hA0[mt][1], qB0[1], acc);
            acc = mfma16(hA1[mt][0], qB1[0], acc); acc = mfma16(hA1[mt][1], qB1[1], acc);
            y[mt] = acc; sum += (acc[0] + acc[1]) + (acc[2] + acc[3]);
        }
        sum += __shfl_xor(sum, 16); sum += __shfl_xor(sum, 32);
        const float mu = sum * (1.0f / 64.f); float sq = 0.f;
#pragma unroll
        for (int mt = 0; mt < 4; ++mt)
#pragma unroll
            for (int e = 0; e < 4; ++e) { y[mt][e] -= mu; sq += y[mt][e] * y[mt][e]; }
        sq += __shfl_xor(sq, 16); sq += __shfl_xor(sq, 32);
        const float rs = 1.0f / sqrtf(sq * (1.0f / 64.f) + 64e-5f);
        const size_t tok = (size_t)(cn * 64 + i0);
#pragma unroll
        for (int mt = 0; mt < 4; ++mt) { const int c0 = h * 64 + 16 * mt + 4 * q_;
            const f32x4 lw = *(const f32x4*)(a.in[19] + c0), lb = *(const f32x4*)(a.in[20] + c0);
            const f32x4 bn = unpk4(*(const unsigned long long*)((const bf16*)(ws + WS_BONUS) + tok * 512 + c0)), gt = unpk4(*(const unsigned long long*)((const bf16*)(ws + WS_GATE) + tok * 512 + c0));
            const f32x4 o = (y[mt] * rs * lw + lb + bn) * gt;
            *(unsigned long long*)((bf16*)(ws + WS_Y) + tok * D_ + 512 + c0) = pk4(o); }
    }
}
constexpr size_t WS_W2T = WS_TILE + 65536;
constexpr size_t WS_PARK = WS_Y;
DI s16x8 act_frag(const bf16* p, int mode) {
    float v[8]; ld8(p, v);
#pragma unroll
    for (int i = 0; i < 8; ++i) { if (mode == 0) v[i] = 1.0f - 2.0f / (__expf(2.0f * v[i]) + 1.0f); else if (mode == 2) v[i] = 1.0f / (1.0f + __expf(-v[i])); }
    v4u w; w.x = pk2(v[0], v[1]); w.y = pk2(v[2], v[3]); w.z = pk2(v[4], v[5]); w.w = pk2(v[6], v[7]);
    return __builtin_bit_cast(s16x8, w);
}
DI void ld4(const bf16* p, float (&v)[4]) { const unsigned long long w = *(const unsigned long long*)p; v[0] = bflo((unsigned)w); v[1] = bfhi((unsigned)w); v[2] = bflo((unsigned)(w >> 32)); v[3] = bfhi((unsigned)(w >> 32)); }
DI void st4(bf16* p, const float (&v)[4]) { *(unsigned long long*)p = (unsigned long long)pk2(v[0], v[1]) | ((unsigned long long)pk2(v[2], v[3]) << 32); }
DI void prep0_rwkv_unit(const Args& a, unsigned char* ws, ldsp wl, int tile, int h, int lane) {
    asm volatile("" : "+v"(lane));
    const int t0 = tile * 16, n_ = lane & 15, q_ = lane >> 4, t = t0 + n_;
    const bf16* LR = (const bf16*)(ws + WS_LORA) + (size_t)t * LORA_N + 8 * q_;
    const bf16* P = (const bf16*)(ws + WS_PROJ0) + (size_t)t * EVEN_IN + 1536 + h * 64 + 4 * q_;
    const bool hp = t > 0, hn = t < S_ - 1;
    v4u lraw[12];
#pragma unroll
    for (int i = 0; i < 12; ++i) lraw[i] = *(const v4u*)(LR + 32 * i);
    unsigned long long cu[3][4], pv[3][4], nx[3][4];
#pragma unroll
    for (int part = 0; part < 3; ++part)
#pragma unroll
        for (int mt = 0; mt < 4; ++mt) { const bf16* p = P + part * 512 + 16 * mt;
            cu[part][mt] = *(const unsigned long long*)p; pv[part][mt] = hp ? *(const unsigned long long*)(p - EVEN_IN) : 0ull; nx[part][mt] = hn ? *(const unsigned long long*)(p + EVEN_IN) : 0ull; }
    float r[16], k[16], v[16];
#pragma unroll
    for (int part = 0; part < 3; ++part)
#pragma unroll
        for (int mt = 0; mt < 4; ++mt) { const int c0 = h * 64 + 16 * mt + 4 * q_;
            const f32x4 m0 = *(const f32x4*)(a.in[6] + part * 512 + c0), m1 = *(const f32x4*)(a.in[6] + 1536 + part * 512 + c0);
            const f32x4 c4 = unpk4(cu[part][mt]), p4 = unpk4(pv[part][mt]), n4 = unpk4(nx[part][mt]);
#pragma unroll
            for (int e = 0; e < 4; ++e) { const float o = c4[e] + m0[e] * (p4[e] - c4[e]) + m1[e] * (n4[e] - c4[e]);
                if (part == 0) r[4 * mt + e] = o; else if (part == 1) k[4 * mt + e] = o; else v[4 * mt + e] = o; } }
    float ss = 0.f;
#pragma unroll
    for (int mt = 0; mt < 4; ++mt) { const f32x4 kkw = *(const f32x4*)(a.in[16] + h * 64 + 16 * mt + 4 * q_);
#pragma unroll
        for (int e = 0; e < 4; ++e) { const float x = k[4 * mt + e] * kkw[e]; ss += x * x; } }
    ss += __shfl_xor(ss, 16); ss += __shfl_xor(ss, 32);
    const float rn = 1.0f / sqrtf(ss + 1e-6f);
    s16x8 lfr[12];
#pragma unroll
    for (int i = 0; i < 12; ++i) { float x[8]; const v4u w = lraw[i];
        x[0] = bflo(w.x); x[1] = bfhi(w.x); x[2] = bflo(w.y); x[3] = bfhi(w.y); x[4] = bflo(w.z); x[5] = bfhi(w.z); x[6] = bflo(w.w); x[7] = bfhi(w.w);
#pragma unroll
        for (int j = 0; j < 8; ++j) { if (i < 4) x[j] = 1.0f - 2.0f * __builtin_amdgcn_rcpf(__expf(2.0f * x[j]) + 1.0f); else if (i >= 8) x[j] = __builtin_amdgcn_rcpf(1.0f + __expf(-x[j])); }
        v4u o; o.x = pk2(x[0], x[1]); o.y = pk2(x[2], x[3]); o.z = pk2(x[4], x[5]); o.w = pk2(x[6], x[7]); lfr[i] = __builtin_bit_cast(s16x8, o); }
    float dotb = 0.f;
#pragma unroll
    for (int mt = 0; mt < 4; ++mt) {
        const int c0 = h * 64 + 16 * mt + 4 * q_;
        f32x4 aw0 = *(const f32x4*)(a.in[8] + c0), aw1 = *(const f32x4*)(a.in[8] + 512 + c0), aa0 = *(const f32x4*)(a.in[11] + c0), aa1 = *(const f32x4*)(a.in[11] + 512 + c0), ag = (f32x4){0.f, 0.f, 0.f, 0.f};
        const int rl = 16 * mt + n_, sw = rl & 7;
#pragma unroll
        for (int ks = 0; ks < 2; ++ks) { const int po = ((4 * ks + q_) ^ sw) * 16;
            aw0 = mfma16(*(LAS const s16x8*)(wl + rl * 128 + po), lfr[ks], aw0);
            aw1 = mfma16(*(LAS const s16x8*)(wl + 8192 + rl * 128 + po), lfr[2 + ks], aw1);
            aa0 = mfma16(*(LAS const s16x8*)(wl + 16384 + rl * 128 + po), lfr[4 + ks], aa0);
            aa1 = mfma16(*(LAS const s16x8*)(wl + 24576 + rl * 128 + po), lfr[6 + ks], aa1);
        }
#pragma unroll
        for (int ks = 0; ks < 4; ++ks) ag = mfma16(*(LAS const s16x8*)(wl + 32768 + rl * 256 + ((((4 * ks + q_) & 8) | (((4 * ks + q_) & 7) ^ sw)) * 16)), lfr[8 + ks], ag);
        const f32x4 kkw = *(const f32x4*)(a.in[16] + c0), kaw = *(const f32x4*)(a.in[17] + c0), rkw = *(const f32x4*)(a.in[18] + c0);
        float l0[4], l1[4], g4[4], d0[4], d1[4], kk4[4], b0[4], b1[4], r4[4], v4[4];
#pragma unroll
        for (int e = 0; e < 4; ++e) { const int i = 4 * mt + e;
            l0[e] = -__expf(-__logf(1.0f + __expf(-aw0[e])) - 0.5f); l1[e] = -__expf(-__logf(1.0f + __expf(-aw1[e])) - 0.5f);
            const float i0 = __builtin_amdgcn_rcpf(1.0f + __expf(-aa0[e])), i1 = __builtin_amdgcn_rcpf(1.0f + __expf(-aa1[e])); g4[e] = ag[e];
            kk4[e] = k[i] * kkw[e] * rn; b0[e] = kk4[e] * i0; b1[e] = kk4[e] * i1;
            d0[e] = k[i] * (1.0f + (i0 - 1.0f) * kaw[e]); d1[e] = k[i] * (1.0f + (i1 - 1.0f) * kaw[e]);
            dotb += r[i] * (d0[e] + d1[e]) * rkw[e]; r4[e] = r[i]; v4[e] = v[i]; }
        const size_t o = (size_t)t * 512 + c0;
        *(f32x4*)((float*)(ws + WS_LW0) + o) = (f32x4){l0[0], l0[1], l0[2], l0[3]};
        *(f32x4*)((float*)(ws + WS_LW1) + o) = (f32x4){l1[0], l1[1], l1[2], l1[3]};
        st4((bf16*)(ws + WS_R) + o, r4); st4((bf16*)(ws + WS_V) + o, v4); st4((bf16*)(ws + WS_KK) + o, kk4); st4((bf16*)(ws + WS_KD0) + o, d0); st4((bf16*)(ws + WS_KD1) + o, d1);
        st4((bf16*)(ws + WS_B0) + o, b0); st4((bf16*)(ws + WS_B1) + o, b1); st4((bf16*)(ws + WS_GATE) + o, g4);
    }
    dotb += __shfl_xor(dotb, 16); dotb += __shfl_xor(dotb, 32);
#pragma unroll
    for (int mt = 0; mt < 4; ++mt) { float bo[4];
#pragma unroll
        for (int e = 0; e < 4; ++e) bo[e] = dotb * v[4 * mt + e];
        st4((bf16*)(ws + WS_BONUS) + (size_t)t * 512 + h * 64 + 16 * mt + 4 * q_, bo); }
}
DI void prep0_stage_w2t(unsigned char* ws, ldsp wl, int h, int tid) {
    const bf16* W2T = (const bf16*)(ws + WS_W2T);
    for (int i = tid; i < 3072; i += 512) {
        if (i < 2048) { const int mtx = i >> 9, r = (i >> 3) & 63, c = i & 7;
            *(LAS v4u*)(wl + mtx * 8192 + r * 128 + ((c ^ (r & 7)) * 16)) = *(const v4u*)(W2T + (size_t)mtx * 32768 + (size_t)(h * 64 + r) * 64 + c * 8); }
        else { const int j = i - 2048, r = j >> 4, c = j & 15;
            *(LAS v4u*)(wl + 32768 + r * 256 + (((c & 8) | ((c & 7) ^ (r & 7))) * 16)) = *(const v4u*)(W2T + 131072 + (size_t)(h * 64 + r) * 128 + c * 8); }
    }
}
constexpr int AT_ACC = 0, AT_M = 65536, AT_L = 66560, AT_V = 67584;
DI void attn_unit(unsigned char* ws, ldsp L, int unit, int wave, int lane) {
    const int h = unit & 7, T0 = (unit >> 3) * 256;
    const bf16* QN = (const bf16*)(ws + WS_QN); const bf16* KN = (const bf16*)(ws + WS_KN); const bf16* P0 = (const bf16*)(ws + WS_PROJ0);
    LAS float* accO = (LAS float*)(L + AT_ACC); LAS float* accM = (LAS float*)(L + AT_M); LAS float* accL = (LAS float*)(L + AT_L);
    ldsp Vst = L + AT_V + wave * 8192;
#pragma unroll 1
    for (int br = 0; br < 3; ++br) {
        const int d = br == 0 ? 1 : (br == 1 ? 4 : 16);
#pragma unroll 1
        for (int si = 0; si < 2; ++si) {
            int lane_s = lane; asm volatile("" : "+v"(lane_s));
            const int n_ = lane_s & 15, q_ = lane_s >> 4;
            const int sidx = wave + 8 * si;
            const int tb = br == 0 ? T0 + 16 * sidx : (br == 1 ? T0 + (sidx & 3) + 64 * (sidx >> 2) : T0 + sidx);
            s16x8 qf[2];
            { const bf16* qrow = QN + (size_t)(tb + d * n_) * 512 + h * 64 + 8 * q_; qf[0] = *(const s16x8*)qrow; qf[1] = *(const s16x8*)(qrow + 32); }
            v4u vreg[5][4];
#pragma unroll
            for (int pp = 0; pp < 2; ++pp)
#pragma unroll
                for (int it = 0; it < 4; ++it) { const int pc = lane + 64 * it, row = pc >> 3, ck = pc & 7;
                    int tk = tb + d * (32 * pp + row - 64); tk = tk < 0 ? 0 : (tk > S_ - 1 ? S_ - 1 : tk);
                    vreg[pp][it] = *(const v4u*)(P0 + (size_t)tk * EVEN_IN + 1024 + h * 64 + ck * 8); }
            f32x4 st[10];
#pragma unroll
            for (int kt = 0; kt < 10; ++kt) {
                int tk = tb + d * (16 * kt + n_ - 64); tk = tk < 0 ? 0 : (tk > S_ - 1 ? S_ - 1 : tk);
                const bf16* krow = KN + (size_t)tk * 512 + h * 64 + 8 * q_;
                f32x4 acc = (f32x4){0.f, 0.f, 0.f, 0.f};
                acc = mfma16(*(const s16x8*)krow, qf[0], acc); acc = mfma16(*(const s16x8*)(krow + 32), qf[1], acc);
                st[kt] = acc;
            }
            float mx = -3.0e38f;
#pragma unroll
            for (int kt = 0; kt < 10; ++kt)
#pragma unroll
                for (int e = 0; e < 4; ++e) { const int j = 16 * kt + 4 * q_ + e; const int tk = tb + d * (j - 64);
                    const bool ok = (j >= n_) && (j <= n_ + 128) && (tk >= 0) && (tk < S_);
                    st[kt][e] = ok ? st[kt][e] : -3.0e38f; mx = fmaxf(mx, st[kt][e]); }
            mx = fmaxf(mx, __shfl_xor(mx, 16)); mx = fmaxf(mx, __shfl_xor(mx, 32));
            float ls = 0.f;
#pragma unroll
            for (int kt = 0; kt < 10; ++kt)
#pragma unroll
                for (int e = 0; e < 4; ++e) { const float p = st[kt][e] > -1.0e38f ? __expf(st[kt][e] - mx) : 0.f; st[kt][e] = p; ls += p; }
            ls += __shfl_xor(ls, 16); ls += __shfl_xor(ls, 32);
#pragma unroll
            for (int pp = 2; pp < 5; ++pp)
#pragma unroll
                for (int it = 0; it < 4; ++it) { const int pc = lane + 64 * it, row = pc >> 3, ck = pc & 7;
                    int tk = tb + d * (32 * pp + row - 64); tk = tk < 0 ? 0 : (tk > S_ - 1 ? S_ - 1 : tk);
                    vreg[pp][it] = *(const v4u*)(P0 + (size_t)tk * EVEN_IN + 1024 + h * 64 + ck * 8); }
            f32x4 O[4];
#pragma unroll
            for (int dt = 0; dt < 4; ++dt) O[dt] = (f32x4){0.f, 0.f, 0.f, 0.f};
#pragma unroll
            for (int pp = 0; pp < 5; ++pp) {
                ldsp vb = Vst + (pp & 1) * 4096;
#pragma unroll
                for (int it = 0; it < 4; ++it) { const int pc = lane + 64 * it, row = pc >> 3, ck = pc & 7; *(LAS v4u*)(vb + row * 128 + ck * 16) = vreg[pp][it]; }
                LDS_WAIT(); CFENCE();
                const s16x8 pa = pack_cpair(st[2 * pp], st[2 * pp + 1]);
                ldsp a0 = vb + (4 * q_ + ((lane & 15) >> 2)) * 128 + 8 * (lane & 3);
#pragma unroll
                for (int dt = 0; dt < 4; ++dt) { const s16x4 lo = tr16(a0 + 32 * dt), hi = tr16(a0 + 16 * 128 + 32 * dt);
                    O[dt] = mfma16(pa, __builtin_shufflevector(lo, hi, 0, 1, 2, 3, 4, 5, 6, 7), O[dt]); }
            }
            float ms[4], lsv[4]; int li[4];
#pragma unroll
            for (int e = 0; e < 4; ++e) { ms[e] = __shfl(mx, 4 * q_ + e); lsv[e] = __shfl(ls, 4 * q_ + e); li[e] = tb + d * (4 * q_ + e) - T0; }
            if (br == 0) {
#pragma unroll
                for (int e = 0; e < 4; ++e) {
#pragma unroll
                    for (int dt = 0; dt < 4; ++dt) accO[li[e] * 64 + 16 * dt + n_] = O[dt][e];
                    if (n_ == 0) { accM[li[e]] = ms[e]; accL[li[e]] = lsv[e]; } }
            } else {
                float fo[4], fn[4], mn[4], lo_[4];
#pragma unroll
                for (int e = 0; e < 4; ++e) { const float mo = accM[li[e]]; lo_[e] = accL[li[e]]; mn[e] = fmaxf(mo, ms[e]); fo[e] = __expf(mo - mn[e]); fn[e] = __expf(ms[e] - mn[e]); }
                LDS_WAIT(); CFENCE();
#pragma unroll
                for (int e = 0; e < 4; ++e) {
#pragma unroll
                    for (int dt = 0; dt < 4; ++dt) { LAS float* p = accO + li[e] * 64 + 16 * dt + n_; *p = *p * fo[e] + O[dt][e] * fn[e]; }
                    if (n_ == 0) { accM[li[e]] = mn[e]; accL[li[e]] = lo_[e] * fo[e] + lsv[e] * fn[e]; } }
            }
            LDS_WAIT(); CFENCE();
        }
        __syncthreads();
    }
    {
        const int tid = wave * 64 + lane, tl = tid >> 1, hf = tid & 1;
        const float il = 1.0f / accL[tl];
        const LAS float* src = accO + tl * 64 + 32 * hf; bf16* dst = (bf16*)(ws + WS_Y) + (size_t)(T0 + tl) * D_ + h * 64 + 32 * hf;
#pragma unroll
        for (int c = 0; c < 4; ++c) { const f32x4 a = *(LAS const f32x4*)(src + 8 * c), b = *(LAS const f32x4*)(src + 8 * c + 4);
            v4u w; w.x = pk2(a.x * il, a.y * il); w.y = pk2(a.z * il, a.w * il); w.z = pk2(b.x * il, b.y * il); w.w = pk2(b.z * il, b.w * il);
            *(v4u*)(dst + 8 * c) = w; }
    }
    __syncthreads();
}
constexpr size_t WS_SST = WS_PROJ1, WS_UB = WS_PROJ1 + 64 * MiB, WS_AT = WS_PROJ1 + 96 * MiB, WS_GC = WS_PROJ1 + 112 * MiB;
constexpr size_t WS_WN = WS_A + 112 * MiB, WS_KT = WS_A + 144 * MiB;
static_assert(WS_GC + 2048 * 64 * 4 <= WS_O0, "dn map");
template <int PITCH> DI s16x8 frag_row_p(ldsp img, int row0, int col0, int lane) { return *(LAS const s16x8*)(img + (row0 + (lane & 15)) * PITCH + (col0 + 8 * (lane >> 4)) * 2); }
template <int PITCH> DI s16x8 frag_tr_p(ldsp img, int row0, int col0, int lane) {
    ldsp a0 = img + (row0 + 8 * (lane >> 4) + ((lane & 15) >> 2)) * PITCH + col0 * 2 + 8 * (lane & 3);
    const s16x4 lo = tr16(a0), hi = tr16(a0 + 4 * PITCH);
    return __builtin_shufflevector(lo, hi, 0, 1, 2, 3, 4, 5, 6, 7);
}
constexpr int DN_LDS_PER_WAVE = 49152 + 512;
DI void dn_pass1_item(unsigned char* ws, ldsp lds, int item, int lane) {
    asm volatile("" : "+v"(lane));
    const int z = item >> 10, h = (item >> 8) & 3, c = item & 255, cn = z ? 255 - c : c;
    const bf16* Q = (const bf16*)(ws + WS_QD); const bf16* K = (const bf16*)(ws + WS_KD); const bf16* V = (const bf16*)(ws + WS_VD);
    ldsp IKd = lds, IVd = lds + 16384, LT = lds + 32768; LAS float* gcs = (LAS float*)(lds + 49152); LAS float* bts = gcs + 64;
    const int n_ = lane & 15, q_ = lane >> 4;
    {
        const int tok = tok_of(z, cn, lane);
        float gc = ((const float*)(ws + WS_GB))[(size_t)tok * 8 + z * 4 + h]; const float bt = ((const float*)(ws + WS_GB + 512 * 1024))[(size_t)tok * 8 + z * 4 + h];
#pragma unroll
        for (int o = 1; o < 64; o <<= 1) { const float t = __shfl_up(gc, o); if (lane >= o) gc += t; }
        gcs[lane] = gc; bts[lane] = bt; ((float*)(ws + WS_GC))[(size_t)item * 64 + lane] = gc;
    }
#pragma unroll 4
    for (int it = 0; it < 16; ++it) { const int p = lane + 64 * it, row = p >> 4, ck = p & 15; const size_t go = (size_t)tok_of(z, cn, row) * 512 + h * 128 + ck * 8;
        *(LAS v4u*)(IKd + row * 256 + ck * 16) = *(const v4u*)(K + go); *(LAS v4u*)(IVd + row * 256 + ck * 16) = *(const v4u*)(V + go); }
    LDS_WAIT(); CFENCE();
    s16x8 kf[4][4];
#pragma unroll
    for (int rt = 0; rt < 4; ++rt)
#pragma unroll
        for (int ks = 0; ks < 4; ++ks) kf[rt][ks] = frag_row_p<256>(IKd, 16 * rt, 32 * ks, lane);
#pragma unroll
    for (int mt = 0; mt < 4; ++mt) { f32x4 gi, bi;
#pragma unroll
        for (int e = 0; e < 4; ++e) { gi[e] = gcs[16 * mt + 4 * q_ + e]; bi[e] = bts[16 * mt + 4 * q_ + e]; }
#pragma unroll
        for (int nt = 0; nt < 4; ++nt) { f32x4 acc = (f32x4){0.f, 0.f, 0.f, 0.f};
            if (nt <= mt) {
#pragma unroll
                for (int ks = 0; ks < 4; ++ks) acc = mfma16(kf[mt][ks], kf[nt][ks], acc); }
            const float gj = gcs[16 * nt + n_];
#pragma unroll
            for (int e = 0; e < 4; ++e) { const int i = 16 * mt + 4 * q_ + e, j = 16 * nt + n_; ((LAS float*)LT)[i * 64 + j] = (j < i) ? bi[e] * acc[e] * __expf(gi[e] - gj) : 0.f; } } }
    {
        bf16* At = (bf16*)(ws + WS_AT) + (size_t)item * 4096;
#pragma unroll
        for (int nt = 0; nt < 4; ++nt) { s16x8 qf[4]; const bf16* qrow = Q + (size_t)tok_of(z, cn, 16 * nt + n_) * 512 + h * 128 + 8 * q_;
#pragma unroll
            for (int ks = 0; ks < 4; ++ks) qf[ks] = *(const s16x8*)(qrow + 32 * ks);
            const float gi = gcs[16 * nt + n_];
#pragma unroll
            for (int mt = 0; mt < 4; ++mt) { f32x4 acc = (f32x4){0.f, 0.f, 0.f, 0.f};
                if (mt <= nt) {
#pragma unroll
                    for (int ks = 0; ks < 4; ++ks) acc = mfma16(kf[mt][ks], qf[ks], acc); }
                f32x4 o;
#pragma unroll
                for (int e = 0; e < 4; ++e) { const int j = 16 * mt + 4 * q_ + e, i = 16 * nt + n_; o[e] = (j <= i) ? acc[e] * __expf(gi - gcs[j]) : 0.f; }
                *(unsigned long long*)(At + (size_t)(16 * nt + n_) * 64 + 16 * mt + 4 * q_) = pk4(o); } }
    }
    LDS_WAIT(); CFENCE();
    {
        float t[64];
        int lane_o = lane; asm volatile("" : "+v"(lane_o));
#pragma unroll
        for (int i = 0; i < 64; ++i) {
            float acc0 = (lane_o == i) ? 1.f : 0.f, acc1 = 0.f, acc2 = 0.f, acc3 = 0.f;
#pragma unroll
            for (int jg = 0; jg < (i + 3) / 4; ++jg) { const f32x4 a4 = *(LAS const f32x4*)(LT + (i * 64 + 4 * jg) * 4);
                if (4 * jg + 0 < i) acc0 -= a4[0] * t[4 * jg + 0];
                if (4 * jg + 1 < i) acc1 -= a4[1] * t[4 * jg + 1];
                if (4 * jg + 2 < i) acc2 -= a4[2] * t[4 * jg + 2];
                if (4 * jg + 3 < i) acc3 -= a4[3] * t[4 * jg + 3]; }
            t[i] = (acc0 + acc1) + (acc2 + acc3);
        }
        LDS_WAIT(); CFENCE();
        const float s1 = bts[lane], s2 = -s1 * __expf(gcs[lane]);
#pragma unroll
        for (int i = 0; i < 64; ++i) { ((LAS bf16*)LT)[i * 64 + lane] = (bf16)f2bf(t[i] * s1); ((LAS bf16*)(LT + 8192))[i * 64 + lane] = (bf16)f2bf(t[i] * s2); }
    }
    LDS_WAIT(); CFENCE();
    ldsp IT1 = LT, IT2 = LT + 8192;
    {
        bf16* Ub = (bf16*)(ws + WS_UB) + (size_t)item * 8192;
        s16x8 tf[4][2];
#pragma unroll
        for (int mt = 0; mt < 4; ++mt)
#pragma unroll
            for (int ks = 0; ks < 2; ++ks) tf[mt][ks] = frag_row_p<128>(IT1, 16 * mt, 32 * ks, lane);
#pragma unroll
        for (int nt = 0; nt < 8; ++nt) { const s16x8 v0 = frag_tr_p<256>(IVd, 0, 16 * nt, lane), v1 = frag_tr_p<256>(IVd, 32, 16 * nt, lane);
#pragma unroll
            for (int mt = 0; mt < 4; ++mt) { f32x4 acc = (f32x4){0.f, 0.f, 0.f, 0.f}; acc = mfma16(tf[mt][0], v0, acc); acc = mfma16(tf[mt][1], v1, acc);
                *(unsigned long long*)(Ub + (size_t)(16 * nt + n_) * 64 + 16 * mt + 4 * q_) = pk4(acc); } }
    }
    {
        bf16* Wn = (bf16*)(ws + WS_WN) + (size_t)item * 8192;
        s16x8 tf[4][2];
#pragma unroll
        for (int nt = 0; nt < 4; ++nt)
#pragma unroll
            for (int ks = 0; ks < 2; ++ks) tf[nt][ks] = frag_row_p<128>(IT2, 16 * nt, 32 * ks, lane);
#pragma unroll
        for (int mt = 0; mt < 8; ++mt) { const s16x8 k0 = frag_tr_p<256>(IKd, 0, 16 * mt, lane), k1 = frag_tr_p<256>(IKd, 32, 16 * mt, lane);
            if (z == 0) { bf16* KT = (bf16*)(ws + WS_KT) + ((size_t)(h * 256 + cn) * 128 + 16 * mt + n_) * 64 + 8 * q_; *(s16x8*)KT = k0; *(s16x8*)(KT + 32) = k1; }
#pragma unroll
            for (int nt = 0; nt < 4; ++nt) { f32x4 acc = (f32x4){0.f, 0.f, 0.f, 0.f}; acc = mfma16(k0, tf[nt][0], acc); acc = mfma16(k1, tf[nt][1], acc);
                *(unsigned long long*)(Wn + (size_t)(16 * nt + n_) * 128 + 16 * mt + 4 * q_) = pk4(acc); } }
    }
    LDS_WAIT(); CFENCE();
}
DI s16x8 pack_cpair_rev(const f32x4& lo, const f32x4& hi) { v4u p; p.x = pk2(lo[3], lo[2]); p.y = pk2(lo[1], lo[0]); p.z = pk2(hi[3], hi[2]); p.w = pk2(hi[1], hi[0]); return __builtin_bit_cast(s16x8, p); }
DI unsigned long long rev4(unsigned long long x) { return (x >> 48) | ((x >> 16) & 0xffff0000ull) | ((x << 16) & 0xffff00000000ull) | (x << 48); }
DI void dn_pass2_wave(unsigned char* ws, int w  , int lane) {
    const int z = w >> 5, h = (w >> 3) & 3, vs = w & 7;
    const int n_ = lane & 15, q_ = lane >> 4;
    f32x4 S[8];
#pragma unroll
    for (int kt = 0; kt < 8; ++kt) S[kt] = (f32x4){0.f, 0.f, 0.f, 0.f};
    for (int c = 0; c < 256; ++c) {
        const int item = (z * 4 + h) * 256 + c, cn = z ? 255 - c : c;
        const bf16* Wn = (const bf16*)(ws + WS_WN) + (size_t)item * 8192; const bf16* Ub = (const bf16*)(ws + WS_UB) + (size_t)item * 8192;
        const float* gcu = (const float*)(ws + WS_GC) + (size_t)item * 64;
        const bf16* KT = (const bf16*)(ws + WS_KT) + (size_t)(h * 256 + cn) * 128 * 64;
        bf16* Sst = (bf16*)(ws + WS_SST) + (size_t)item * 16384;
        f32x4 u[4], gv[4];
#pragma unroll
        for (int mt = 0; mt < 4; ++mt) { u[mt] = unpk4(*(const unsigned long long*)(Ub + (size_t)(16 * vs + n_) * 64 + 16 * mt + 4 * q_)); gv[mt] = *(const f32x4*)(gcu + 16 * mt + 4 * q_); }
        const float gl = gcu[63];
        unsigned long long wa[4][4][2], ka[8][2][2];
#pragma unroll
        for (int mt = 0; mt < 4; ++mt)
#pragma unroll
            for (int ks = 0; ks < 4; ++ks) { const bf16* row = Wn + (size_t)(16 * mt + n_) * 128 + 32 * ks + 4 * q_; wa[mt][ks][0] = *(const unsigned long long*)row; wa[mt][ks][1] = *(const unsigned long long*)(row + 16); }
#pragma unroll
        for (int kt = 0; kt < 8; ++kt)
#pragma unroll
            for (int ks = 0; ks < 2; ++ks) { const bf16* row = KT + (size_t)(16 * kt + n_) * 64;
                if (z == 0) { ka[kt][ks][0] = *(const unsigned long long*)(row + 32 * ks + 4 * q_); ka[kt][ks][1] = *(const unsigned long long*)(row + 32 * ks + 16 + 4 * q_); }
                else { ka[kt][ks][0] = rev4(*(const unsigned long long*)(row + 60 - 32 * ks - 4 * q_)); ka[kt][ks][1] = rev4(*(const unsigned long long*)(row + 44 - 32 * ks - 4 * q_)); } }
#pragma unroll
        for (int kt = 0; kt < 8; ++kt) *(unsigned long long*)(Sst + (size_t)(16 * vs + n_) * 128 + 16 * kt + 4 * q_) = pk4(S[kt]);
#pragma unroll
        for (int ks = 0; ks < 4; ++ks) { const s16x8 b = pack_cpair(S[2 * ks], S[2 * ks + 1]);
#pragma unroll
            for (int mt = 0; mt < 4; ++mt) { v4u a; a.x = (unsigned)wa[mt][ks][0]; a.y = (unsigned)(wa[mt][ks][0] >> 32); a.z = (unsigned)wa[mt][ks][1]; a.w = (unsigned)(wa[mt][ks][1] >> 32);
                u[mt] = mfma16(__builtin_bit_cast(s16x8, a), b, u[mt]); } }
#pragma unroll
        for (int mt = 0; mt < 4; ++mt)
#pragma unroll
            for (int e = 0; e < 4; ++e) u[mt][e] *= __expf(gl - gv[mt][e]);
        const float egl = __expf(gl);
        const s16x8 b0 = pack_cpair(u[0], u[1]), b1 = pack_cpair(u[2], u[3]);
#pragma unroll
        for (int kt = 0; kt < 8; ++kt) { f32x4 acc = S[kt] * egl;
            { v4u a; a.x = (unsigned)ka[kt][0][0]; a.y = (unsigned)(ka[kt][0][0] >> 32); a.z = (unsigned)ka[kt][0][1]; a.w = (unsigned)(ka[kt][0][1] >> 32); acc = mfma16(__builtin_bit_cast(s16x8, a), b0, acc); }
            { v4u a; a.x = (unsigned)ka[kt][1][0]; a.y = (unsigned)(ka[kt][1][0] >> 32); a.z = (unsigned)ka[kt][1][1]; a.w = (unsigned)(ka[kt][1][1] >> 32); acc = mfma16(__builtin_bit_cast(s16x8, a), b1, acc); }
            S[kt] = acc; }
    }
}
DI void dn_pass3_item(unsigned char* ws, int item, int lane) {
    asm volatile("" : "+v"(lane));
    const int z = item >> 10, h = (item >> 8) & 3, c = item & 255, cn = z ? 255 - c : c;
    const int n_ = lane & 15, q_ = lane >> 4;
    const bf16* Q = (const bf16*)(ws + WS_QD);
    const bf16* Wn = (const bf16*)(ws + WS_WN) + (size_t)item * 8192; const bf16* Ub = (const bf16*)(ws + WS_UB) + (size_t)item * 8192;
    const bf16* At = (const bf16*)(ws + WS_AT) + (size_t)item * 4096; const float* gcu = (const float*)(ws + WS_GC) + (size_t)item * 64;
    const bf16* Sst = (const bf16*)(ws + WS_SST) + (size_t)item * 16384;
    bf16* O = (bf16*)(ws + (z ? WS_O1 : WS_O0));
    s16x8 wf[4][4], qf[4][4]; unsigned long long af[4][2][2]; float eg[4];
#pragma unroll
    for (int t = 0; t < 4; ++t) {
        const bf16* qrow = Q + (size_t)tok_of(z, cn, 16 * t + n_) * 512 + h * 128 + 8 * q_;
#pragma unroll
        for (int ks = 0; ks < 4; ++ks) { wf[t][ks] = *(const s16x8*)(Wn + (size_t)(16 * t + n_) * 128 + 32 * ks + 8 * q_); qf[t][ks] = *(const s16x8*)(qrow + 32 * ks); }
#pragma unroll
        for (int ks = 0; ks < 2; ++ks) { const bf16* arow = At + (size_t)(16 * t + n_) * 64 + 32 * ks + 4 * q_; af[t][ks][0] = *(const unsigned long long*)arow; af[t][ks][1] = *(const unsigned long long*)(arow + 16); }
        eg[t] = __expf(gcu[16 * t + n_]);
    }
#pragma unroll
    for (int mt = 0; mt < 8; ++mt) {
        s16x8 sf[4];
#pragma unroll
        for (int ks = 0; ks < 4; ++ks) sf[ks] = *(const s16x8*)(Sst + (size_t)(16 * mt + n_) * 128 + 32 * ks + 8 * q_);
        f32x4 u[4];
#pragma unroll
        for (int jt = 0; jt < 4; ++jt) { u[jt] = unpk4(*(const unsigned long long*)(Ub + (size_t)(16 * mt + n_) * 64 + 16 * jt + 4 * q_));
#pragma unroll
            for (int ks = 0; ks < 4; ++ks) u[jt] = mfma16(wf[jt][ks], sf[ks], u[jt]); }
        const s16x8 ua0 = pack_cpair(u[0], u[1]), ua1 = pack_cpair(u[2], u[3]);
#pragma unroll
        for (int nt = 0; nt < 4; ++nt) {
            f32x4 acc = (f32x4){0.f, 0.f, 0.f, 0.f};
#pragma unroll
            for (int ks = 0; ks < 4; ++ks) acc = mfma16(sf[ks], qf[nt][ks], acc);
            acc = acc * eg[nt];
            { v4u b; b.x = (unsigned)af[nt][0][0]; b.y = (unsigned)(af[nt][0][0] >> 32); b.z = (unsigned)af[nt][0][1]; b.w = (unsigned)(af[nt][0][1] >> 32); acc = mfma16(ua0, __builtin_bit_cast(s16x8, b), acc); }
            { v4u b; b.x = (unsigned)af[nt][1][0]; b.y = (unsigned)(af[nt][1][0] >> 32); b.z = (unsigned)af[nt][1][1]; b.w = (unsigned)(af[nt][1][1] >> 32); acc = mfma16(ua1, __builtin_bit_cast(s16x8, b), acc); }
            *(unsigned long long*)(O + (size_t)tok_of(z, cn, 16 * nt + n_) * 512 + h * 128 + 16 * mt + 4 * q_) = pk4(acc);
        }
    }
}
constexpr int DN_SLOT = 41984, DN_GRP = 16;
constexpr size_t WS_MG = WS_END_OLD, WS_NG = WS_END_OLD + 4 * MiB, WS_SG = WS_END_OLD + 8 * MiB;
DI void dn_scan_block(unsigned char* ws, ldsp L, const int Z, const int MODE, int h, int hv, int g, int wave, int lane) {
    const int item0 = (Z * 4 + h) * 256, cb = g * DN_GRP, zhg = (Z * 4 + h) * 16 + g;
    if (wave >= 4) {
        const int lw = wave - 4;
        unsigned so[11], ld[11];
#pragma unroll
        for (int k = 0; k < 4; ++k) { const int pid = lw * 4 + k; const int row = 4 * pid + (lane >> 4), p = lane & 15, cch = p ^ (row & 15); so[k] = row * 256 + cch * 16; ld[k] = pid * 1024 + lane * 16; }
#pragma unroll
        for (int k = 0; k < 4; ++k) { const int pid = lw * 4 + k; const int row = 8 * pid + (lane >> 3), p = lane & 7, cch = p ^ (row & 7); so[4 + k] = row * 128 + cch * 16; ld[4 + k] = 16384 + pid * 1024 + lane * 16; }
#pragma unroll
        for (int k = 0; k < 2; ++k) { const int pid = lw * 2 + k; const int row = 8 * pid + (lane >> 3), p = lane & 7, cch = p ^ (row & 7); so[8 + k] = row * 128 + cch * 16; ld[8 + k] = 32768 + pid * 1024 + lane * 16; }
        so[10] = lane * 16; ld[10] = 40960 + lane * 16;
        v4u rA[11], rB[11];
#define DN_GLOAD(R, ss) do { const int s_ = (ss) < DN_GRP ? (ss) : DN_GRP - 1; const int c_ = cb + s_; const int cn_ = Z ? 255 - c_ : c_; \
            const char* wsrc = (const char*)((const bf16*)(ws + WS_WN) + (size_t)(item0 + c_) * 8192); const char* ksrc = (const char*)((const bf16*)(ws + WS_KT) + (size_t)(h * 256 + cn_) * 8192); \
            const char* usrc = (const char*)((const bf16*)(ws + WS_UB) + (size_t)(item0 + c_) * 8192 + hv * 4096); const char* gsrc = (const char*)((const float*)(ws + WS_GC) + (size_t)(item0 + c_) * 64); \
            _Pragma("unroll") for (int k = 0; k < 4; ++k) R[k] = *(const v4u*)(wsrc + so[k]); \
            _Pragma("unroll") for (int k = 4; k < 8; ++k) R[k] = *(const v4u*)(ksrc + so[k]); \
            _Pragma("unroll") for (int k = 8; k < 10; ++k) R[k] = *(const v4u*)(usrc + so[k]); \
            if (lw == 0) R[10] = *(const v4u*)(gsrc + so[10]); } while (0)
#define DN_LWRITE(R, ss) do { ldsp slot = L + ((ss) % 3) * DN_SLOT; \
            _Pragma("unroll") for (int k = 0; k < 10; ++k) *(LAS v4u*)(slot + ld[k]) = R[k]; \
            if (lw == 0) *(LAS v4u*)(slot + ld[10]) = R[10]; } while (0)
        DN_GLOAD(rA, 0); DN_GLOAD(rB, 1); DN_LWRITE(rA, 0); DN_LWRITE(rB, 1);
        DN_GLOAD(rA, 2); DN_GLOAD(rB, 3);
#define DN_LSTEP(R, ss) do { asm volatile("s_waitcnt lgkmcnt(0)" ::: "memory"); __builtin_amdgcn_s_barrier(); asm volatile("" ::: "memory"); \
            DN_LWRITE(R, (ss) + 2); DN_GLOAD(R, (ss) + 4); } while (0)
        for (int s2 = 0; s2 < DN_GRP; s2 += 2) { DN_LSTEP(rA, s2); DN_LSTEP(rB, s2 + 1); }
#undef DN_LSTEP
#undef DN_LWRITE
#undef DN_GLOAD
        asm volatile("s_waitcnt vmcnt(0) lgkmcnt(0)" ::: "memory");
        return;
    }
    const int vs = 4 * hv + wave;
    const int n_ = lane & 15, q_ = lane >> 4, wbyte = (q_ & 1) * 8, sw = n_ & 7;
    int kao[2][2];
#pragma unroll
    for (int ks = 0; ks < 2; ++ks) { const int r0 = Z ? 60 - 32 * ks - 4 * q_ : 32 * ks + 4 * q_, r1 = Z ? r0 - 16 : r0 + 16; kao[ks][0] = (((r0 >> 3) ^ sw) * 16) + (r0 & 7) * 2; kao[ks][1] = (((r1 >> 3) ^ sw) * 16) + (r1 & 7) * 2; }
    const float ubm = MODE == 2 ? 0.f : 1.f;
    f32x4 S[8];
    if (MODE == 0) { const bf16* SG = (const bf16*)(ws + WS_SG) + (size_t)zhg * 16384;
#pragma unroll
        for (int kt = 0; kt < 8; ++kt) S[kt] = unpk4(*(const unsigned long long*)(SG + (size_t)(16 * vs + n_) * 128 + 16 * kt + 4 * q_)); }
    else {
#pragma unroll
        for (int kt = 0; kt < 8; ++kt)
#pragma unroll
            for (int e = 0; e < 4; ++e) S[kt][e] = (MODE == 2 && (16 * kt + 4 * q_ + e) == (16 * vs + n_)) ? 1.f : 0.f; }
    for (int s = 0; s < DN_GRP; ++s) {
        const int c = cb + s;
        if (MODE == 0) { bf16* Sst = (bf16*)(ws + WS_SST) + (size_t)(item0 + c) * 16384;
#pragma unroll
            for (int kt = 0; kt < 8; ++kt) *(unsigned long long*)(Sst + (size_t)(16 * vs + n_) * 128 + 16 * kt + 4 * q_) = pk4(S[kt]); }
        asm volatile("s_waitcnt lgkmcnt(0)" ::: "memory");
        __builtin_amdgcn_s_barrier();
        asm volatile("" ::: "memory");
        ldsp slot = L + (s % 3) * DN_SLOT;
        f32x4 u[4], gv[4]; unsigned long long wa[4][4][2], ka[8][2][2];
        { ldsp urow = slot + 32768 + (16 * wave + n_) * 128 + wbyte;
#pragma unroll
          for (int mt = 0; mt < 4; ++mt) { u[mt] = unpk4(*(LAS const unsigned long long*)(urow + (((2 * mt + (q_ >> 1)) ^ sw) * 16))) * ubm; gv[mt] = *(LAS const f32x4*)(slot + 40960 + (16 * mt + 4 * q_) * 4); } }
        const float gl = *(LAS const float*)(slot + 40960 + 63 * 4);
#pragma unroll
        for (int ks = 0; ks < 4; ++ks)
#pragma unroll
            for (int mt = 0; mt < 4; ++mt) { ldsp row = slot + (16 * mt + n_) * 256 + wbyte; const int c0 = 4 * ks + (q_ >> 1);
                wa[mt][ks][0] = *(LAS const unsigned long long*)(row + ((c0 ^ n_) * 16)); wa[mt][ks][1] = *(LAS const unsigned long long*)(row + (((c0 + 2) ^ n_) * 16)); }
        __builtin_amdgcn_sched_barrier(0);
#pragma unroll
        for (int ks = 0; ks < 4; ++ks) { const s16x8 bb = pack_cpair(S[2 * ks], S[2 * ks + 1]);
#pragma unroll
            for (int mt = 0; mt < 4; ++mt) { v4u a; a.x = (unsigned)wa[mt][ks][0]; a.y = (unsigned)(wa[mt][ks][0] >> 32); a.z = (unsigned)wa[mt][ks][1]; a.w = (unsigned)(wa[mt][ks][1] >> 32);
                u[mt] = mfma16(__builtin_bit_cast(s16x8, a), bb, u[mt]); } }
        __builtin_amdgcn_sched_barrier(0);
#pragma unroll
        for (int kt = 0; kt < 8; ++kt) { ldsp row = slot + 16384 + (16 * kt + n_) * 128;
#pragma unroll
            for (int ks = 0; ks < 2; ++ks) { ka[kt][ks][0] = *(LAS const unsigned long long*)(row + kao[ks][0]); ka[kt][ks][1] = *(LAS const unsigned long long*)(row + kao[ks][1]); } }
        __builtin_amdgcn_sched_barrier(0);
#pragma unroll
        for (int mt = 0; mt < 4; ++mt)
#pragma unroll
            for (int e = 0; e < 4; ++e) u[mt][e] *= __expf(gl - gv[mt][e]);
        const float egl = __expf(gl);
#pragma unroll
        for (int mt = 0; mt < 4; ++mt) { const f32x4 t = u[mt]; u[mt][0] = Z ? t[3] : t[0]; u[mt][1] = Z ? t[2] : t[1]; u[mt][2] = Z ? t[1] : t[2]; u[mt][3] = Z ? t[0] : t[3]; }
        const s16x8 b0 = pack_cpair(u[0], u[1]), b1 = pack_cpair(u[2], u[3]);
#pragma unroll
        for (int kt = 0; kt < 8; ++kt) { f32x4 acc = S[kt] * egl;
#pragma unroll
            for (int ks = 0; ks < 2; ++ks) { const unsigned long long a0 = ka[kt][ks][0], a1 = ka[kt][ks][1];
                v4u a; a.x = (unsigned)a0; a.y = (unsigned)(a0 >> 32); a.z = (unsigned)a1; a.w = (unsigned)(a1 >> 32);
                acc = mfma16(__builtin_bit_cast(s16x8, a), ks == 0 ? b0 : b1, acc); }
            S[kt] = acc; }
    }
    if (MODE == 1) { bf16* NG = (bf16*)(ws + WS_NG) + (size_t)zhg * 16384;
#pragma unroll
        for (int kt = 0; kt < 8; ++kt) *(unsigned long long*)(NG + (size_t)(16 * vs + n_) * 128 + 16 * kt + 4 * q_) = pk4(S[kt]); }
    if (MODE == 2) { bf16* MG = (bf16*)(ws + WS_MG) + (size_t)zhg * 16384;
#pragma unroll
        for (int kt = 0; kt < 8; ++kt)
#pragma unroll
            for (int e = 0; e < 4; ++e) MG[(size_t)(16 * kt + 4 * q_ + e) * 128 + 16 * vs + n_] = (bf16)f2bf(S[kt][e]); }
}
DI void dn_scan_groups(unsigned char* ws, int w  , int lane) {
    const int zh = w >> 3, vs = w & 7, n_ = lane & 15, q_ = lane >> 4;
    f32x4 S[8];
#pragma unroll
    for (int kt = 0; kt < 8; ++kt) S[kt] = (f32x4){0.f, 0.f, 0.f, 0.f};
    for (int g = 0; g < 16; ++g) {
        const size_t zhg = (size_t)(zh * 16 + g) * 16384;
        bf16* SG = (bf16*)(ws + WS_SG) + zhg; const bf16* MG = (const bf16*)(ws + WS_MG) + zhg; const bf16* NG = (const bf16*)(ws + WS_NG) + zhg;
#pragma unroll
        for (int kt = 0; kt < 8; ++kt) *(unsigned long long*)(SG + (size_t)(16 * vs + n_) * 128 + 16 * kt + 4 * q_) = pk4(S[kt]);
        if (g == 15) break;
        s16x8 bb[4];
#pragma unroll
        for (int ks = 0; ks < 4; ++ks) bb[ks] = pack_cpair(S[2 * ks], S[2 * ks + 1]);
#pragma unroll
        for (int kt = 0; kt < 8; ++kt) { f32x4 acc = unpk4(*(const unsigned long long*)(NG + (size_t)(16 * vs + n_) * 128 + 16 * kt + 4 * q_));
#pragma unroll
            for (int ks = 0; ks < 4; ++ks) { const bf16* row = MG + (size_t)(16 * kt + n_) * 128 + 32 * ks + 4 * q_;
                const unsigned long long a0 = *(const unsigned long long*)row, a1 = *(const unsigned long long*)(row + 16);
                v4u a; a.x = (unsigned)a0; a.y = (unsigned)(a0 >> 32); a.z = (unsigned)a1; a.w = (unsigned)(a1 >> 32);
                acc = mfma16(__builtin_bit_cast(s16x8, a), bb[ks], acc); }
            S[kt] = acc; }
    }
}
DI void prep1_token(const Args& a, unsigned char* ws, int t, int lane) {
    const bf16* P = (const bf16*)(ws + WS_PROJ1) + (size_t)t * ODD_PAD;
    const int c0 = 8 * lane; const bool hp = t > 0, hn = t < S_ - 1;
    float z8[8];
#pragma unroll
    for (int i = 0; i < 8; ++i) z8[i] = 0.f;
    {
        float cb[8], cc[8], cx[8], pc[8], px[8], nc[8], nx[8], w0[8], w1[8], w2[8], o[8];
        ld8(P + c0, cb); ld8(P + 512 + c0, cc); ld8(P + 1024 + c0, cx);
        if (hp) { ld8(P - ODD_PAD + 512 + c0, pc); ld8(P - ODD_PAD + 1024 + c0, px); } else {
#pragma unroll
            for (int i = 0; i < 8; ++i) { pc[i] = 0.f; px[i] = 0.f; } }
        if (hn) { ld8(P + ODD_PAD + 512 + c0, nc); ld8(P + ODD_PAD + 1024 + c0, nx); } else {
#pragma unroll
            for (int i = 0; i < 8; ++i) { nc[i] = 0.f; nx[i] = 0.f; } }
        ld8f(a.in[28] + c0, w0); ld8f(a.in[28] + 512 + c0, w1); ld8f(a.in[28] + 1024 + c0, w2);
#pragma unroll
        for (int i = 0; i < 8; ++i) o[i] = cb[i] * (w0[i] * pc[i] * px[i] + w1[i] * cc[i] * cx[i] + w2[i] * nc[i] * nx[i]);
        st8((bf16*)(ws + WS_YCAT1) + (size_t)t * D_ + c0, o);
    }
#pragma unroll
    for (int part = 0; part < 3; ++part) {
        float cu[8], pv[8], nx[8], w0[8], w1[8], w2[8], o[8];
        const int col = 1536 + part * 512 + c0;
        ld8(P + col, cu);
        if (hp) ld8(P - ODD_PAD + col, pv); else {
#pragma unroll
            for (int i = 0; i < 8; ++i) pv[i] = 0.f; }
        if (hn) ld8(P + ODD_PAD + col, nx); else {
#pragma unroll
            for (int i = 0; i < 8; ++i) nx[i] = 0.f; }
        const float* cw = a.in[29] + part * 512 + c0;
        ld8f(cw, w0); ld8f(cw + 1536, w1); ld8f(cw + 3072, w2);
        float ss = 0.f;
#pragma unroll
        for (int i = 0; i < 8; ++i) { o[i] = siluf_(w0[i] * pv[i] + w1[i] * cu[i] + w2[i] * nx[i]); ss += o[i] * o[i]; }
        if (part < 2) { ss = grp_sum<16>(ss); const float rn = (1.0f / sqrtf(ss + 1e-6f)) * (part == 0 ? 0.08838834764831845f : 1.0f);
#pragma unroll
            for (int i = 0; i < 8; ++i) o[i] *= rn; }
        st8((bf16*)(ws + (part == 0 ? WS_QD : (part == 1 ? WS_KD : WS_VD))) + (size_t)t * 512 + c0, o);
    }
    *(v4u*)((bf16*)(ws + WS_YCAT1) + (size_t)t * D_ + 512 + c0) = *(const v4u*)(P + 3072 + c0);
    if (lane < 8) {
        const float bt = sigmoidf_(bf2f(P[3584 + lane])); const float al = bf2f(P[3592 + lane]);
        const float g = -__expf(a.in[30][lane]) * softplusf_(al + a.in[31][lane]);
        ((float*)(ws + WS_GB))[(size_t)t * 8 + lane] = g; ((float*)(ws + WS_GB + 512 * 1024))[(size_t)t * 8 + lane] = bt;
    }
}
DI void dn_scan_naive(unsigned char* ws, int w  , int lane) {
    const int z = w >> 9, h = (w >> 7) & 3, vc = w & 127;
    const bf16* Q = (const bf16*)(ws + WS_QD); const bf16* K = (const bf16*)(ws + WS_KD); const bf16* V = (const bf16*)(ws + WS_VD);
    const float* G = (const float*)(ws + WS_GB); const float* Bt = (const float*)(ws + WS_GB + 512 * 1024);
    bf16* O = (bf16*)(ws + (z ? WS_O1 : WS_O0));
    float s0 = 0.f, s1 = 0.f;
    int t = z ? S_ - 1 : 0; const int dt = z ? -1 : 1;
    size_t o = (size_t)t * 512 + h * 128;
    float k0 = bf2f(K[o + lane]), k1 = bf2f(K[o + 64 + lane]), q0 = bf2f(Q[o + lane]), q1 = bf2f(Q[o + 64 + lane]), vv = bf2f(V[o + vc]), g = G[(size_t)t * 8 + z * 4 + h], bt = Bt[(size_t)t * 8 + z * 4 + h];
    for (int s = 0; s < S_; ++s) {
        const int tn = (s + 1 < S_) ? t + dt : t; const size_t on = (size_t)tn * 512 + h * 128;
        const float k0n = bf2f(K[on + lane]), k1n = bf2f(K[on + 64 + lane]), q0n = bf2f(Q[on + lane]), q1n = bf2f(Q[on + 64 + lane]), vvn = bf2f(V[on + vc]), gn = G[(size_t)tn * 8 + z * 4 + h], btn = Bt[(size_t)tn * 8 + z * 4 + h];
        const float eg = __expf(g);
        const float dot = wave_sum(k0 * s0 + k1 * s1);
        const float cf = bt * (vv - eg * dot);
        s0 = eg * s0 + cf * k0; s1 = eg * s1 + cf * k1;
        const float ov = wave_sum(q0 * s0 + q1 * s1);
        if (lane == 0) O[(size_t)t * 512 + h * 128 + vc] = (bf16)f2bf(ov);
        k0 = k0n; k1 = k1n; q0 = q0n; q1 = q1n; vv = vvn; g = gn; bt = btn; t = tn;
    }
}
DI void dn_post_token(const Args& a, unsigned char* ws, int t, int lane) {
    const int c0 = 8 * lane; const size_t o = (size_t)t * 512 + c0;
    float o0[8], o1[8], zz[8], nw[8];
    ld8((const bf16*)(ws + WS_O0) + o, o0); ld8((const bf16*)(ws + WS_O1) + o, o1);
    ld8((const bf16*)(ws + WS_YCAT1) + (size_t)t * D_ + 512 + c0, zz); ld8f(a.in[32] + (c0 & 127), nw);
    float ss = 0.f;
#pragma unroll
    for (int i = 0; i < 8; ++i) { o0[i] += o1[i]; ss += o0[i] * o0[i]; }
    const float rs = 1.0f / sqrtf(grp_sum<16>(ss) * (1.0f / 128.f) + 1e-6f);
#pragma unroll
    for (int i = 0; i < 8; ++i) o0[i] = o0[i] * rs * nw[i] * siluf_(zz[i]);
    st8((bf16*)(ws + WS_YCAT1) + (size_t)t * D_ + 512 + c0, o0);
}
struct TokInfo { int e1, e2, s1, s2; float p1, p2; int pad0, pad1; };
struct RouterRegs { f32x4 r0[16], r1[16]; f32x4 w[4]; };
DI void route_load(const Args& a, RouterRegs& R, int lane) {
#pragma unroll
    for (int j = 0; j < 4; ++j) { R.w[j] = ((const f32x4*)a.in[34])[lane + 64 * j];
#pragma unroll
        for (int i = 0; i < 4; ++i) { const float* rr = a.in[35] + (size_t)(4 * lane + 256 * j + i) * 8; R.r0[4 * j + i] = *(const f32x4*)rr; R.r1[4 * j + i] = *(const f32x4*)(rr + 4); } }
}
DI void route_token(const RouterRegs& R, unsigned char* ws, const float* x3, int t, int lane) {
    f32x4 v[4]; load_row(x3, t, lane, v); const float rs = row_rstd(v);
    float lg[8];
#pragma unroll
    for (int e = 0; e < 8; ++e) lg[e] = 0.f;
#pragma unroll
    for (int j = 0; j < 4; ++j)
#pragma unroll
        for (int i = 0; i < 4; ++i) { const float hv = v[j][i] * rs * R.w[j][i]; const f32x4 r0 = R.r0[4 * j + i], r1 = R.r1[4 * j + i];
            lg[0] += hv * r0.x; lg[1] += hv * r0.y; lg[2] += hv * r0.z; lg[3] += hv * r0.w; lg[4] += hv * r1.x; lg[5] += hv * r1.y; lg[6] += hv * r1.z; lg[7] += hv * r1.w; }
#pragma unroll
    for (int e = 0; e < 8; ++e) lg[e] = wave_sum(lg[e]);
    if (lane == 0) {
        int e1 = 0; float m1 = lg[0];
#pragma unroll
        for (int e = 1; e < 8; ++e) if (lg[e] > m1) { m1 = lg[e]; e1 = e; }
        int e2 = -1; float m2 = -3.0e38f;
#pragma unroll
        for (int e = 0; e < 8; ++e) if (e != e1 && lg[e] > m2) { m2 = lg[e]; e2 = e; }
        const float x2 = __expf(m2 - m1); const float p1 = 1.0f / (1.0f + x2), p2 = x2 / (1.0f + x2);
        unsigned* cnt = (unsigned*)(ws + WS_CTL) + CW_CNT;
        TokInfo ti; ti.e1 = e1; ti.e2 = e2; ti.s1 = (int)atomicAdd(cnt + e1, 1u); ti.s2 = (int)atomicAdd(cnt + e2, 1u); ti.p1 = p1; ti.p2 = p2; ti.pad0 = 0; ti.pad1 = 0;
        ((TokInfo*)(ws + WS_TOK))[t] = ti;
    }
}
DI void moe_offsets(const unsigned char* ws, int (&off)[9]) {
    const unsigned* cnt = (const unsigned*)(ws + WS_CTL) + CW_CNT; int o = 0;
#pragma unroll
    for (int e = 0; e < 8; ++e) { off[e] = o; const int c = (int)__hip_atomic_load(cnt + e, __ATOMIC_RELAXED, __HIP_MEMORY_SCOPE_AGENT); o += (c + 255) & ~255; }
    off[8] = o;
}
DI void gather_token(const Args& a, unsigned char* ws, const float* x3, const int (&off)[9], int t, int lane) {
    f32x4 v[4]; load_row(x3, t, lane, v); const float rs = row_rstd(v);
#pragma unroll
    for (int j = 0; j < 4; ++j) v[j] = v[j] * rs * ((const f32x4*)a.in[34])[lane + 64 * j];
    const TokInfo ti = ((const TokInfo*)(ws + WS_TOK))[t];
    int o1 = 0, o2 = 0;
#pragma unroll
    for (int e = 0; e < 8; ++e) { if (ti.e1 == e) o1 = off[e]; if (ti.e2 == e) o2 = off[e]; }
    bf16* A = (bf16*)(ws + WS_AMOE);
    store_row_bf16(A + (size_t)(o1 + ti.s1) * D_, lane, v); store_row_bf16(A + (size_t)(o2 + ti.s2) * D_, lane, v);
}
DI void combine_token(unsigned char* ws, float* out, const int (&off)[9], int t, int lane) {
    const TokInfo ti = ((const TokInfo*)(ws + WS_TOK))[t];
    int o1 = 0, o2 = 0;
#pragma unroll
    for (int e = 0; e < 8; ++e) { if (ti.e1 == e) o1 = off[e]; if (ti.e2 == e) o2 = off[e]; }
    const bf16* A = (const bf16*)(ws + WS_AMOE);
    const unsigned long long* r1 = (const unsigned long long*)(A + (size_t)(o1 + ti.s1) * D_) + lane; const unsigned long long* r2 = (const unsigned long long*)(A + (size_t)(o2 + ti.s2) * D_) + lane;
    f32x4* xo = (f32x4*)(out + (size_t)t * D_) + lane;
#pragma unroll
    for (int j = 0; j < 4; ++j) { const unsigned long long a1 = r1[64 * j], a2 = r2[64 * j]; f32x4 x = xo[64 * j];
        x.x += ti.p1 * bflo((unsigned)a1) + ti.p2 * bflo((unsigned)a2); x.y += ti.p1 * bfhi((unsigned)a1) + ti.p2 * bfhi((unsigned)a2);
        x.z += ti.p1 * bflo((unsigned)(a1 >> 32)) + ti.p2 * bflo((unsigned)(a2 >> 32)); x.w += ti.p1 * bfhi((unsigned)(a1 >> 32)) + ti.p2 * bfhi((unsigned)(a2 >> 32));
        xo[64 * j] = x; }
}
#ifndef PROBE
#define PROBE 0
#endif
#ifndef PROBE_REP
#define PROBE_REP (-1)
#endif
#ifndef PH_MASK
#define PH_MASK 0xFFFFFFFFu
#endif
DI unsigned char* ptr_opaque(unsigned char* p) { GAS unsigned char* g = (GAS unsigned char*)p; asm volatile("" : "+s"(g)); return (unsigned char*)g; }
DI int lane_opaque() { int l; asm volatile("v_mbcnt_lo_u32_b32 %0, -1, 0\n\tv_mbcnt_hi_u32_b32 %0, -1, %0" : "=v"(l)); return l; }
__global__ void __launch_bounds__(512, 2) fwd_kernel(Args args) {
    extern __shared__ __attribute__((aligned(16))) unsigned char lds[];
    LAS unsigned char* L = (LAS unsigned char*)lds;
    volatile LAS unsigned* MISC = (volatile LAS unsigned*)(L + MISC_OFF);
    const int tid = threadIdx.x, lane0 = tid & 63, wave = __builtin_amdgcn_readfirstlane(tid >> 6);
    const int G = gridDim.x, bx = blockIdx.x;
    const int gw = bx * 8 + wave, NGW = G * 8;
    unsigned char* ws0 = args.ws;
    if (tid < 128) ((LAS unsigned*)(L + LDS_ZERO_OFF))[tid] = 0u;
    __syncthreads();
    XcdBarrier bar = xcd_barrier_post((unsigned*)(ws0 + WS_CTL) + CW_BAR, MISC + 8);
    LAS float* scr = (LAS float*)(L + wave * 16384);
#if PROBE
    int tsi = 0;
#define GRID_BAR() do { xcd_barrier(bar, wave == 0); if (bx == 0 && tid == 0) { ((unsigned*)(ws + WS_CTL))[512 + tsi] = (unsigned)__builtin_amdgcn_s_memrealtime(); } ++tsi; } while (0)
    if (bx == 0 && tid == 0) ((unsigned*)(ws + WS_CTL))[511] = (unsigned)__builtin_amdgcn_s_memrealtime();
#else
#define GRID_BAR() xcd_barrier(bar, wave == 0)
#endif

    if constexpr ((PH_MASK >> 0) & 1) {
    const int lane = lane_opaque(); unsigned char* const ws = ptr_opaque(args.ws);
    {
        const float* const* in = args.in;
        for (int it = gw; ; it += NGW) {
            int r = it;
            if (transpose_job(r, in[3], 1024, 3072, 3072, (bf16*)(ws + WS_WIN0), 0, 0, 0, scr, lane)) continue;
            if (transpose_job(r, in[9], 1024, 64, 64, (bf16*)(ws + WS_WL), 0, 0, 0, scr, lane)) continue;
            if (transpose_job(r, in[9] + 65536, 1024, 64, 64, (bf16*)(ws + WS_WL), 64, 0, 0, scr, lane)) continue;
            if (transpose_job(r, in[12], 1024, 64, 64, (bf16*)(ws + WS_WL), 128, 0, 0, scr, lane)) continue;
            if (transpose_job(r, in[12] + 65536, 1024, 64, 64, (bf16*)(ws + WS_WL), 192, 0, 0, scr, lane)) continue;
            if (transpose_job(r, in[14], 1024, 128, 256, (bf16*)(ws + WS_WL), 256, 0, 0, scr, lane)) continue;
            if (transpose_job(r, in[21], 1024, 1024, 1024, (bf16*)(ws + WS_WOUT0), 0, 0, 0, scr, lane)) continue;
            if (transpose_job(r, in[10], 64, 512, 512, (bf16*)(ws + WS_W2T), 0, 0, 0, scr, lane)) continue;
            if (transpose_job(r, in[10] + 32768, 64, 512, 512, (bf16*)(ws + WS_W2T) + 32768, 0, 0, 0, scr, lane)) continue;
            if (transpose_job(r, in[13], 64, 512, 512, (bf16*)(ws + WS_W2T) + 65536, 0, 0, 0, scr, lane)) continue;
            if (transpose_job(r, in[13] + 32768, 64, 512, 512, (bf16*)(ws + WS_W2T) + 98304, 0, 0, 0, scr, lane)) continue;
            if (transpose_job(r, in[15], 128, 512, 512, (bf16*)(ws + WS_W2T) + 131072, 0, 0, 0, scr, lane)) continue;
            break;
        }
        norm_rows(args.in[0], args.in[2], args.in[7], (bf16*)(ws + WS_H), (bf16*)(ws + WS_HX), gw, NGW, lane);
    }
    if constexpr (PROBE_REP == 0) {
    {
        const float* const* in = args.in;
        for (int it = gw; ; it += NGW) {
            int r = it;
            if (transpose_job(r, in[3], 1024, 3072, 3072, (bf16*)(ws + WS_WIN0), 0, 0, 0, scr, lane)) continue;
            if (transpose_job(r, in[9], 1024, 64, 64, (bf16*)(ws + WS_WL), 0, 0, 0, scr, lane)) continue;
            if (transpose_job(r, in[9] + 65536, 1024, 64, 64, (bf16*)(ws + WS_WL), 64, 0, 0, scr, lane)) continue;
            if (transpose_job(r, in[12], 1024, 64, 64, (bf16*)(ws + WS_WL), 128, 0, 0, scr, lane)) continue;
            if (transpose_job(r, in[12] + 65536, 1024, 64, 64, (bf16*)(ws + WS_WL), 192, 0, 0, scr, lane)) continue;
            if (transpose_job(r, in[14], 1024, 128, 256, (bf16*)(ws + WS_WL), 256, 0, 0, scr, lane)) continue;
            if (transpose_job(r, in[21], 1024, 1024, 1024, (bf16*)(ws + WS_WOUT0), 0, 0, 0, scr, lane)) continue;
            if (transpose_job(r, in[10], 64, 512, 512, (bf16*)(ws + WS_W2T), 0, 0, 0, scr, lane)) continue;
            if (transpose_job(r, in[10] + 32768, 64, 512, 512, (bf16*)(ws + WS_W2T) + 32768, 0, 0, 0, scr, lane)) continue;
            if (transpose_job(r, in[13], 64, 512, 512, (bf16*)(ws + WS_W2T) + 65536, 0, 0, 0, scr, lane)) continue;
            if (transpose_job(r, in[13] + 32768, 64, 512, 512, (bf16*)(ws + WS_W2T) + 98304, 0, 0, 0, scr, lane)) continue;
            if (transpose_job(r, in[15], 128, 512, 512, (bf16*)(ws + WS_W2T) + 131072, 0, 0, 0, scr, lane)) continue;
            break;
        }
        norm_rows(args.in[0], args.in[2], args.in[7], (bf16*)(ws + WS_H), (bf16*)(ws + WS_HX), gw, NGW, lane);
    }
    }
    GRID_BAR();
    }
    if constexpr (PROBE_REP == 50) { for (int i = 0; i < 10; ++i) GRID_BAR(); }
    if constexpr ((PH_MASK >> 1) & 1) {
    const int lane = lane_opaque(); unsigned char* const ws = ptr_opaque(args.ws);
    {
        { pg8::Gemm g{(const bf16*)(ws + WS_H), (const bf16*)(ws + WS_WIN0), S_, EVEN_IN, D_}; pg8::StaticOrder S; S.init(S_, EVEN_IN, G, bx);
          pg8::EpiStoreBf16 E{(bf16*)(ws + WS_PROJ0), EVEN_IN, 0, nullptr}; pg8::gemm_phase<pg8::EpiStoreBf16, pg8::StaticOrder, true, true>(L, g, S, E, wave); }
        { pg8::Gemm g{(const bf16*)(ws + WS_HX), (const bf16*)(ws + WS_WL), S_, LORA_N, D_}; pg8::StaticOrder S; S.init(S_, LORA_N, G, bx);
          pg8::EpiStoreBf16 E{(bf16*)(ws + WS_LORA), LORA_N, 0, nullptr}; pg8::gemm_phase<pg8::EpiStoreBf16, pg8::StaticOrder, true, true>(L, g, S, E, wave); }
        if constexpr (PROBE_REP == 1) {
        { pg8::Gemm g{(const bf16*)(ws + WS_H), (const bf16*)(ws + WS_WIN0), S_, EVEN_IN, D_}; pg8::StaticOrder S; S.init(S_, EVEN_IN, G, bx);
          pg8::EpiStoreBf16 E{(bf16*)(ws + WS_PROJ0), EVEN_IN, 0, nullptr}; pg8::gemm_phase<pg8::EpiStoreBf16, pg8::StaticOrder, true, true>(L, g, S, E, wave); }
        { pg8::Gemm g{(const bf16*)(ws + WS_HX), (const bf16*)(ws + WS_WL), S_, LORA_N, D_}; pg8::StaticOrder S; S.init(S_, LORA_N, G, bx);
          pg8::EpiStoreBf16 E{(bf16*)(ws + WS_LORA), LORA_N, 0, nullptr}; pg8::gemm_phase<pg8::EpiStoreBf16, pg8::StaticOrder, true, true>(L, g, S, E, wave); }
        }
    }
    GRID_BAR();
    }
    if constexpr ((PH_MASK >> 2) & 1) {
    const int lane = lane_opaque(); unsigned char* const ws = ptr_opaque(args.ws);
    for (int t = gw; t < S_; t += NGW) prep0_token(args, ws, scr, t, lane);
    if constexpr (PROBE_REP == 30) { for (int t = gw; t < S_; t += NGW) prep0_token(args, ws, scr, t, lane); }
    {
        const int hh = bx & 7, nbh = (G - hh + 7) >> 3;
        prep0_stage_w2t(ws, L, hh, wave * 64 + lane);
        LDS_WAIT(); __syncthreads();
        for (int tile = (bx >> 3) * 8 + wave; tile < 1024; tile += nbh * 8) prep0_rwkv_unit(args, ws, L, tile, hh, lane);
        if constexpr (PROBE_REP == 31) { for (int tile = (bx >> 3) * 8 + wave; tile < 1024; tile += nbh * 8) prep0_rwkv_unit(args, ws, L, tile, hh, lane); }
        __syncthreads();
    }
    GRID_BAR();
    }
    if constexpr ((PH_MASK >> 3) & 1) {
    const int lane = lane_opaque(); unsigned char* const ws = ptr_opaque(args.ws);
    {
        if constexpr (PROBE_REP == 40) { if (wave < 2) { for (int it = bx * 2 + wave; it < 4096; it += G * 2) rwkv_pass1_item<true>(ws, L + wave * 65536, it, lane); } }
        if constexpr (PROBE_REP >= 41 && PROBE_REP <= 43) { if (wave < 2) { for (int it = bx * 2 + wave; it < 4096; it += G * 2) rwkv_pass1_item<true, PROBE_REP - 40>(ws, L + wave * 65536, it, lane); } }
        if (wave < 2) { for (int it = bx * 2 + wave; it < 4096; it += G * 2) rwkv_pass1_item(ws, L + wave * 65536, it, lane); }
        else if (wave < 4) {
            const float* const* in = args.in; LAS float* scr2 = (LAS float*)(L + 131072 + (wave - 2) * 8448);
            for (int it = bx * 2 + (wave - 2); ; it += G * 2) {
                int r = it;
                if (transpose_job(r, in[23], 1024, FF0, FF0, (bf16*)(ws + WS_WGU0), 0, 128, 0, scr2, lane)) continue;
                if (transpose_job(r, in[24], 1024, FF0, FF0, (bf16*)(ws + WS_WGU0), 0, 128, 1, scr2, lane)) continue;
                if (transpose_job(r, in[25], FF0, 1024, 1024, (bf16*)(ws + WS_WD0), 0, 0, 0, scr2, lane)) continue;
                if (transpose_job(r, in[27], 1024, ODD_IN, ODD_PAD, (bf16*)(ws + WS_WIN1), 0, 0, 0, scr2, lane)) continue;
                if (transpose_job(r, in[33], 1024, 1024, 1024, (bf16*)(ws + WS_WOUT1), 0, 0, 0, scr2, lane)) continue;
                break;
            }
        }
    }
    GRID_BAR();
    if (bx < 16) { rwkv_pass2_block(ws, L, bx, wave, lane); __syncthreads(); if constexpr (PROBE_REP == 4) { rwkv_pass2_block(ws, L, bx, wave, lane); __syncthreads(); } }
    else { for (int rep_ = 0; rep_ < (PROBE_REP == 3 ? 2 : 1); ++rep_) for (int unit = bx - 16; unit < 512; unit += G - 16) attn_unit(ws, L, unit, wave, lane); }
    GRID_BAR();
    for (int it = gw; it < 2048; it += NGW) rwkv_pass3_post_item(args, ws, it, lane);
    GRID_BAR();
    }
    if constexpr ((PH_MASK >> 5) & 1) {
    const int lane = lane_opaque(); unsigned char* const ws = ptr_opaque(args.ws);
    { pg8::Gemm g{(const bf16*)(ws + WS_Y), (const bf16*)(ws + WS_WOUT0), S_, D_, D_}; pg8::StaticOrder S; S.init(S_, D_, G, bx);
      pg8::EpiResF32 E{args.in[0], args.out, D_, nullptr, nullptr}; pg8::gemm_phase<pg8::EpiResF32, pg8::StaticOrder, true, true>(L, g, S, E, wave); }
    if constexpr (PROBE_REP == 7) {
    { pg8::Gemm g{(const bf16*)(ws + WS_Y), (const bf16*)(ws + WS_WOUT0), S_, D_, D_}; pg8::StaticOrder S; S.init(S_, D_, G, bx);
      pg8::EpiResF32 E{args.in[0], args.out, D_, nullptr, nullptr}; pg8::gemm_phase<pg8::EpiResF32, pg8::StaticOrder, true, true>(L, g, S, E, wave); }
    }
    GRID_BAR();
    }
    if constexpr ((PH_MASK >> 6) & 1) {
    const int lane = lane_opaque(); unsigned char* const ws = ptr_opaque(args.ws);
    norm_rows(args.out, args.in[22], nullptr, (bf16*)(ws + WS_H2), nullptr, gw, NGW, lane);
    GRID_BAR();
    }
    if constexpr ((PH_MASK >> 7) & 1) {
    const int lane = lane_opaque(); unsigned char* const ws = ptr_opaque(args.ws);
    { pg8::Gemm g{(const bf16*)(ws + WS_H2), (const bf16*)(ws + WS_WGU0), S_, 2 * FF0, D_}; pg8::StaticOrder S; S.init(S_, 2 * FF0, G, bx);
      pg8::EpiSwiGLU E{(bf16*)(ws + WS_ACT0), FF0, 0, nullptr}; pg8::gemm_phase<pg8::EpiSwiGLU, pg8::StaticOrder, true, true>(L, g, S, E, wave); }
    if constexpr (PROBE_REP == 9) {
    { pg8::Gemm g{(const bf16*)(ws + WS_H2), (const bf16*)(ws + WS_WGU0), S_, 2 * FF0, D_}; pg8::StaticOrder S; S.init(S_, 2 * FF0, G, bx);
      pg8::EpiSwiGLU E{(bf16*)(ws + WS_ACT0), FF0, 0, nullptr}; pg8::gemm_phase<pg8::EpiSwiGLU, pg8::StaticOrder, true, true>(L, g, S, E, wave); }
    }
    GRID_BAR();
    }
    if constexpr ((PH_MASK >> 8) & 1) {
    const int lane = lane_opaque(); unsigned char* const ws = ptr_opaque(args.ws);
    { pg8::Gemm g{(const bf16*)(ws + WS_ACT0), (const bf16*)(ws + WS_WD0), S_, D_, FF0}; pg8::StaticOrder S; S.init(S_, D_, G, bx);
      pg8::EpiResF32 E{args.out, args.out, D_, nullptr, nullptr}; pg8::gemm_phase<pg8::EpiResF32, pg8::StaticOrder, true, true>(L, g, S, E, wave); }
    GRID_BAR();
    }
    if constexpr ((PH_MASK >> 9) & 1) {
    const int lane = lane_opaque(); unsigned char* const ws = ptr_opaque(args.ws);
    norm_rows(args.out, args.in[26], nullptr, (bf16*)(ws + WS_H3), nullptr, gw, NGW, lane);
    GRID_BAR();
    }
    if constexpr ((PH_MASK >> 10) & 1) {
    const int lane = lane_opaque(); unsigned char* const ws = ptr_opaque(args.ws);
    { pg8::Gemm g{(const bf16*)(ws + WS_H3), (const bf16*)(ws + WS_WIN1), S_, ODD_PAD, D_}; pg8::StaticOrder S; S.init(S_, ODD_PAD, G, bx);
      pg8::EpiStoreBf16 E{(bf16*)(ws + WS_PROJ1), ODD_PAD, 0, nullptr}; pg8::gemm_phase<pg8::EpiStoreBf16, pg8::StaticOrder, true, true>(L, g, S, E, wave); }
    if constexpr (PROBE_REP == 12) {
    { pg8::Gemm g{(const bf16*)(ws + WS_H3), (const bf16*)(ws + WS_WIN1), S_, ODD_PAD, D_}; pg8::StaticOrder S; S.init(S_, ODD_PAD, G, bx);
      pg8::EpiStoreBf16 E{(bf16*)(ws + WS_PROJ1), ODD_PAD, 0, nullptr}; pg8::gemm_phase<pg8::EpiStoreBf16, pg8::StaticOrder, true, true>(L, g, S, E, wave); }
    }
    GRID_BAR();
    }
    if constexpr ((PH_MASK >> 11) & 1) {
    const int lane = lane_opaque(); unsigned char* const ws = ptr_opaque(args.ws);
for (int rep_ = 0; rep_ < (PROBE_REP == 13 ? 2 : 1); ++rep_) {     for (int t = gw; t < S_; t += NGW) prep1_token(args, ws, t, lane); }
    GRID_BAR();
    }
    if constexpr ((PH_MASK >> 12) & 1) {
    const int lane = lane_opaque(); unsigned char* const ws = ptr_opaque(args.ws);
    {
        if (wave < 2) { for (int rep_ = 0; rep_ < (PROBE_REP == 14 ? 2 : 1); ++rep_) for (int it = bx * 2 + wave; it < 2048; it += G * 2) dn_pass1_item(ws, L + wave * DN_LDS_PER_WAVE, it, lane); }
        else {
            LAS float* scr2 = (LAS float*)(L + 2 * DN_LDS_PER_WAVE + (wave - 2) * 8448);
            for (int it = bx * 6 + (wave - 2); ; it += G * 6) {
                int r = it; bool did = false;
                for (int e = 0; e < NEXP; ++e) {
                    if (transpose_job(r, args.in[36] + (size_t)e * 1024 * FFE, 1024, FFE, FFE, (bf16*)(ws + WS_WMGU) + (size_t)e * 2 * FFE * 1024, 0, 128, 0, scr2, lane)) { did = true; break; }
                    if (transpose_job(r, args.in[37] + (size_t)e * 1024 * FFE, 1024, FFE, FFE, (bf16*)(ws + WS_WMGU) + (size_t)e * 2 * FFE * 1024, 0, 128, 1, scr2, lane)) { did = true; break; }
                }
                if (!did) break;
            }
        }
    }
    GRID_BAR();
    { const int task = bx; if (task < 512) dn_scan_block(ws, L, task >> 8, (task & 3) < 2 ? 1 : 2, (task >> 6) & 3, task & 1, (task >> 2) & 15, wave, lane); __syncthreads(); }
    { const int task = bx + G; if (task < 512) dn_scan_block(ws, L, task >> 8, (task & 3) < 2 ? 1 : 2, (task >> 6) & 3, task & 1, (task >> 2) & 15, wave, lane); __syncthreads(); }
    GRID_BAR();
    if (bx < 64) { if (wave == 0) dn_scan_groups(ws, bx, lane); }
    GRID_BAR();
    { const int task = bx; if (task < 256) dn_scan_block(ws, L, task >> 7, 0, (task >> 5) & 3, (task >> 4) & 1, task & 15, wave, lane); __syncthreads(); }
    GRID_BAR();
for (int rep_ = 0; rep_ < (PROBE_REP == 16 ? 2 : 1); ++rep_) {     for (int it = gw; it < 2048; it += NGW) dn_pass3_item(ws, it, lane); }
    GRID_BAR();
    }
    if constexpr ((PH_MASK >> 13) & 1) {
    const int lane = lane_opaque(); unsigned char* const ws = ptr_opaque(args.ws);
    for (int t = gw; t < S_; t += NGW) dn_post_token(args, ws, t, lane);
    for (int it = gw; ; it += NGW) {
        int r = it; bool did = false;
        for (int e = 0; e < NEXP; ++e)
            if (transpose_job(r, args.in[38] + (size_t)e * 1024 * FFE, FFE, 1024, 1024, (bf16*)(ws + WS_WMD) + (size_t)e * 1024 * FFE, 0, 0, 0, scr, lane)) { did = true; break; }
        if (!did) break;
    }
    GRID_BAR();
    }
    if constexpr ((PH_MASK >> 14) & 1) {
    const int lane = lane_opaque(); unsigned char* const ws = ptr_opaque(args.ws);
    { pg8::Gemm g{(const bf16*)(ws + WS_YCAT1), (const bf16*)(ws + WS_WOUT1), S_, D_, D_}; pg8::StaticOrder S; S.init(S_, D_, G, bx);
      pg8::EpiResF32 E{args.out, args.out, D_, nullptr, nullptr}; pg8::gemm_phase<pg8::EpiResF32, pg8::StaticOrder, true, true>(L, g, S, E, wave); }
    GRID_BAR();
    }
    if constexpr ((PH_MASK >> 15) & 1) {
    const int lane = lane_opaque(); unsigned char* const ws = ptr_opaque(args.ws);
    { RouterRegs RR; route_load(args, RR, lane); for (int t = gw; t < S_; t += NGW) route_token(RR, ws, args.out, t, lane); }
    GRID_BAR();
    }
    int off[9]; moe_offsets(ws0, off);
    const int ntiles = off[8] >> 8;
    if constexpr ((PH_MASK >> 16) & 1) {
    const int lane = lane_opaque(); unsigned char* const ws = ptr_opaque(args.ws);
    {
        for (int t = gw; t < S_; t += NGW) gather_token(args, ws, args.out, off, t, lane);
        const int tid2 = wave * 64 + lane;
        if (bx == 0 && tid2 < 160) { int e = 0;
#pragma unroll
            for (int k = 1; k < 8; ++k) if (tid2 * 256 >= off[k]) e = k;
            ((int*)(ws + WS_TILE))[tid2] = e; }
        const unsigned* cnt = (const unsigned*)(ws + WS_CTL) + CW_CNT;
        for (int e = 0; e < NEXP; ++e) { const int c = (int)__hip_atomic_load(cnt + e, __ATOMIC_RELAXED, __HIP_MEMORY_SCOPE_AGENT); const int r0 = off[e] + c, r1 = off[e + 1];
            for (int rr = r0 + gw; rr < r1; rr += NGW) { unsigned long long* o8 = (unsigned long long*)((bf16*)(ws + WS_AMOE) + (size_t)rr * D_) + lane;
#pragma unroll
                for (int j = 0; j < 4; ++j) o8[64 * j] = 0ull; } }
    }
    if constexpr (PROBE_REP == 20) {
    {
        for (int t = gw; t < S_; t += NGW) gather_token(args, ws, args.out, off, t, lane);
        const int tid2 = wave * 64 + lane;
        if (bx == 0 && tid2 < 160) { int e = 0;
#pragma unroll
            for (int k = 1; k < 8; ++k) if (tid2 * 256 >= off[k]) e = k;
            ((int*)(ws + WS_TILE))[tid2] = e; }
        const unsigned* cnt = (const unsigned*)(ws + WS_CTL) + CW_CNT;
        for (int e = 0; e < NEXP; ++e) { const int c = (int)__hip_atomic_load(cnt + e, __ATOMIC_RELAXED, __HIP_MEMORY_SCOPE_AGENT); const int r0 = off[e] + c, r1 = off[e + 1];
            for (int rr = r0 + gw; rr < r1; rr += NGW) { unsigned long long* o8 = (unsigned long long*)((bf16*)(ws + WS_AMOE) + (size_t)rr * D_) + lane;
#pragma unroll
                for (int j = 0; j < 4; ++j) o8[64 * j] = 0ull; } }
    }
    }
    GRID_BAR();
    }
    if constexpr ((PH_MASK >> 17) & 1) {
    const int lane = lane_opaque(); unsigned char* const ws = ptr_opaque(args.ws);
    for (int b = 0; b < 3; ++b) {
        const int tlo = b * MOE_BATCH_TILES; int nt = ntiles - tlo; nt = nt < 0 ? 0 : (nt > MOE_BATCH_TILES ? MOE_BATCH_TILES : nt);
        { pg8::Gemm g{(const bf16*)(ws + WS_AMOE), (const bf16*)(ws + WS_WMGU), MOE_ROWS, NEXP * 2 * FFE, D_};
          pg8::MoeOrder S{(const int*)(ws + WS_TILE), tlo, nt, 2 * FFE / 256, G, bx};
          pg8::EpiSwiGLU E{(bf16*)(ws + WS_MACT) - (size_t)tlo * 256 * FFE, FFE, 2 * FFE / 256, nullptr};
          pg8::gemm_phase<pg8::EpiSwiGLU, pg8::MoeOrder, true, true>(L, g, S, E, wave); }
        if constexpr (PROBE_REP == 21) {
        { pg8::Gemm g{(const bf16*)(ws + WS_AMOE), (const bf16*)(ws + WS_WMGU), MOE_ROWS, NEXP * 2 * FFE, D_};
          pg8::MoeOrder S{(const int*)(ws + WS_TILE), tlo, nt, 2 * FFE / 256, G, bx};
          pg8::EpiSwiGLU E{(bf16*)(ws + WS_MACT) - (size_t)tlo * 256 * FFE, FFE, 2 * FFE / 256, nullptr};
          pg8::gemm_phase<pg8::EpiSwiGLU, pg8::MoeOrder, true, true>(L, g, S, E, wave); }
        }
        GRID_BAR();
        { pg8::Gemm g{(const bf16*)(ws + WS_MACT) - (size_t)tlo * 256 * FFE, (const bf16*)(ws + WS_WMD), MOE_ROWS, NEXP * D_, FFE};
          pg8::MoeOrder S{(const int*)(ws + WS_TILE), tlo, nt, D_ / 256, G, bx};
          pg8::EpiStoreBf16 E{(bf16*)(ws + WS_AMOE), D_, D_ / 256, nullptr};
          pg8::gemm_phase<pg8::EpiStoreBf16, pg8::MoeOrder, true, true>(L, g, S, E, wave); }
        if constexpr (PROBE_REP == 22) {
        { pg8::Gemm g{(const bf16*)(ws + WS_MACT) - (size_t)tlo * 256 * FFE, (const bf16*)(ws + WS_WMD), MOE_ROWS, NEXP * D_, FFE};
          pg8::MoeOrder S{(const int*)(ws + WS_TILE), tlo, nt, D_ / 256, G, bx};
          pg8::EpiStoreBf16 E{(bf16*)(ws + WS_AMOE), D_, D_ / 256, nullptr};
          pg8::gemm_phase<pg8::EpiStoreBf16, pg8::MoeOrder, true, true>(L, g, S, E, wave); }
        }
        GRID_BAR();
    }
    }
    if constexpr ((PH_MASK >> 18) & 1) {
    const int lane = lane_opaque(); unsigned char* const ws = ptr_opaque(args.ws);
    for (int t = gw; t < S_; t += NGW) combine_token(ws, args.out, off, t, lane);
#if PROBE
    {
        const unsigned* ts = (const unsigned*)(ws + WS_CTL) + 512;
        const unsigned dA = PROBE_A < 0 ? 100000u : (__hip_atomic_load(ts + PROBE_A, __ATOMIC_RELAXED, __HIP_MEMORY_SCOPE_AGENT) - __hip_atomic_load(ts + PROBE_A - 1, __ATOMIC_RELAXED, __HIP_MEMORY_SCOPE_AGENT));
        const unsigned dB = __hip_atomic_load(ts + PROBE_B, __ATOMIC_RELAXED, __HIP_MEMORY_SCOPE_AGENT) - __hip_atomic_load(ts + PROBE_B - 1, __ATOMIC_RELAXED, __HIP_MEMORY_SCOPE_AGENT);
        const int rows = (int)(dA / 400u);
        for (int t = gw; t < S_; t += NGW) {
            if (t < rows) { f32x4* xo = (f32x4*)(args.out + (size_t)t * D_) + lane;
#pragma unroll
                for (int j = 0; j < 4; ++j) xo[64 * j] = xo[64 * j] + 5.0f; }
            if (t == S_ - 1 && lane == 63) args.out[(size_t)t * D_ + 1023] += (float)dB * 0.001f;
        }
    }
#endif
    }
}

extern "C" void kernel_launch(void* const* d_in, const int* in_sizes, int n_in, void* d_out, int out_size, void* d_ws, size_t ws_size, hipStream_t stream) {
    static int grid = 0;
    if (grid == 0) {
        if (n_in != 39 || out_size != S_ * D_ || ws_size < WS_END) { fprintf(stderr, "kernel_launch: unexpected shapes (n_in %d out %d ws %zu)\n", n_in, out_size, ws_size); grid = -1; return; }
        int dev = 0, cus = 0, per_cu = 0;
        if (hipGetDevice(&dev) != hipSuccess || hipDeviceGetAttribute(&cus, hipDeviceAttributeMultiprocessorCount, dev) != hipSuccess) { grid = -1; return; }
        if (hipFuncSetAttribute((const void*)fwd_kernel, hipFuncAttributeMaxDynamicSharedMemorySize, LDS_BYTES) != hipSuccess) { grid = -1; return; }
        if (hipOccupancyMaxActiveBlocksPerMultiprocessor(&per_cu, (const void*)fwd_kernel, 512, LDS_BYTES) != hipSuccess || per_cu < 1) { fprintf(stderr, "kernel_launch: occupancy query says %d\n", per_cu); }
        (void)hipGetLastError();
        if (cus < 256) { fprintf(stderr, "kernel_launch: this build needs >= 256 CUs (task slots of the delta-net scan); got %d\n", cus); grid = -1; return; }
        grid = 256;
    }
    if (grid < 0) return;
    if (hipMemsetAsync((char*)d_ws + WS_CTL, 0, CTL_ZERO_BYTES, stream) != hipSuccess) return;
    Args a{};
    for (int i = 0; i < 39; ++i) a.in[i] = (const float*)d_in[i];
    a.out = (float*)d_out; a.ws = (unsigned char*)d_ws;
    hipLaunchKernelGGL(fwd_kernel, dim3(grid), dim3(512), LDS_BYTES, stream, a);
}
```

```cpp
#include <hip/hip_runtime.h>
#include <cstdio>
#include <cstdint>
namespace pg8 {
#define PG8_LAS __attribute__((address_space(3)))
typedef unsigned short bf16_t;
typedef short bf16x8 __attribute__((ext_vector_type(8)));
typedef float f32x4 __attribute__((ext_vector_type(4)));
typedef unsigned u32x4 __attribute__((ext_vector_type(4)));
constexpr int BM = 256, BK = 64, HALF = 128, HTB = HALF * BK * 2  , STAGE_BYTES = 8 * HTB, NXCD = 8, WGM = 8;

__host__ __device__ __forceinline__ int lds_byte(int r, int c) { const int st = (r >> 4) * 2 + (c >> 5), rr = r & 15, cc = c & 31, ob = rr * 64 + cc * 2; return st * 1024 + (ob ^ (((ob >> 9) & 1) << 5)); }
__host__ __device__ __forceinline__ void stage_rc(int b, int& R, int& C) { const int st = b / 1024, sb = b % 1024, swz = sb ^ (((sb >> 9) & 1) << 5); R = (st >> 1) * 16 + swz / 64; C = (st & 1) * 32 + (swz % 64) / 2; }
__host__ __device__ __forceinline__ int perm32(int rho) { const int n = rho >> 4, i = rho & 15; return 8 * (i >> 2) + 4 * n + (i & 3); }

struct Unit { int pm, pn; };
struct Gemm { const bf16_t* A; const bf16_t* Bt; int M, N, K; };

struct StaticOrder {
    int nM, nN, nwg, G, c;
    __host__ __device__ void init(int M, int N, int G_, int c_) { nM = M / BM; nN = N / BM; nwg = nM * nN; G = G_; c = c_; }
    __host__ __device__ bool next(int i, Unit& u) const {
        const long L = (long)i * G + c; if (L >= nwg) return false;
        int wgid = (int)L; { const int q = nwg / NXCD, r = nwg % NXCD, xcd = wgid % NXCD, off = wgid / NXCD; wgid = (xcd < r ? xcd * (q + 1) : r * (q + 1) + (xcd - r) * q) + off; }
        const int nig = WGM * nN, gid = wgid / nig, fm = gid * WGM, gsz = (nM - fm) < WGM ? (nM - fm) : WGM;
        u.pm = fm + ((wgid % nig) % gsz); u.pn = (wgid % nig) / gsz; return true;
    }
    __device__ __forceinline__ void a_ready(const Unit&) const {}
    __device__ __forceinline__ void done(const Unit&) const {}
};

__device__ __forceinline__ unsigned cvt_pk_bf16(float lo, float hi) { unsigned r; asm volatile("v_cvt_pk_bf16_f32 %0, %1, %2" : "=v"(r) : "v"(lo), "v"(hi)); return r; }
struct EpiStoreBf16 {
    static constexpr bool PERM = true, AFTER_DRAIN = false;
    bf16_t* O; int ldc; int ntn; const float* rowss;
    __device__ __forceinline__ void operator()(const f32x4 (&acc)[2][2][4][2], const Unit& u, int wr, int wc, int fr, int fq) const {
        const int row0 = u.pm * BM + wr * 64 + fr; const int pn = ntn ? (u.pn % ntn) : u.pn;
        const int col0 = pn * BM + wc * 32 + 8 * fq;
#pragma unroll
        for (int ai = 0; ai < 2; ++ai)
#pragma unroll
            for (int m = 0; m < 4; ++m) { bf16_t* rowp = O + (size_t)(row0 + ai * HALF + m * 16) * ldc + col0;
                float rs = 1.0f; if (rowss) { const f32x4* sp = (const f32x4*)(rowss + (size_t)(row0 + ai * HALF + m * 16) * 16); const f32x4 s0 = sp[0], s1 = sp[1], s2 = sp[2], s3 = sp[3]; const f32x4 st = (s0 + s1) + (s2 + s3); rs = 1.0f / sqrtf(((st[0] + st[1]) + (st[2] + st[3])) * (1.0f / 1024.f) + 1e-6f); }
#pragma unroll
                for (int bj = 0; bj < 2; ++bj) { const f32x4 v0 = acc[ai][bj][m][0] * rs, v1 = acc[ai][bj][m][1] * rs;
                    u32x4 w; w.x = cvt_pk_bf16(v0[0], v0[1]); w.y = cvt_pk_bf16(v0[2], v0[3]); w.z = cvt_pk_bf16(v1[0], v1[1]); w.w = cvt_pk_bf16(v1[2], v1[3]);
                    *(u32x4*)(rowp + bj * HALF) = w; } }
    }
};
struct EpiResF32 {
    static constexpr bool PERM = false, AFTER_DRAIN = false;
    const float* base; float* out; int ldc; bf16_t* xb; float* rowss;
    __device__ __forceinline__ void operator()(const f32x4 (&acc)[2][2][4][2], const Unit& u, int wr, int wc, int fr, int fq) const {
        const int row0 = u.pm * BM + wr * 64 + fr, col0 = u.pn * BM + wc * 32 + 4 * fq;
#pragma unroll
        for (int ai = 0; ai < 2; ++ai)
#pragma unroll
            for (int m = 0; m < 4; ++m) { const size_t off = (size_t)(row0 + ai * HALF + m * 16) * ldc + col0; float ss = 0.f;
#pragma unroll
                for (int bj = 0; bj < 2; ++bj)
#pragma unroll
                    for (int n = 0; n < 2; ++n) { const f32x4 b = *(const f32x4*)(base + off + bj * HALF + n * 16); const f32x4 o = b + acc[ai][bj][m][n]; *(f32x4*)(out + off + bj * HALF + n * 16) = o;
                        if (xb) { ss += (o[0] * o[0] + o[1] * o[1]) + (o[2] * o[2] + o[3] * o[3]);
                            unsigned long long w = (unsigned long long)cvt_pk_bf16(o[0], o[1]) | ((unsigned long long)cvt_pk_bf16(o[2], o[3]) << 32); *(unsigned long long*)(xb + off + bj * HALF + n * 16) = w; } }
                if (xb) { ss += __shfl_xor(ss, 16); ss += __shfl_xor(ss, 32); if (fq == 0) rowss[(size_t)(row0 + ai * HALF + m * 16) * 16 + u.pn * 4 + wc] = ss; } }
    }
};
struct EpiSwiGLU {
    static constexpr bool PERM = true, AFTER_DRAIN = false;
    bf16_t* O; int ldc; int ntn; const float* rowss;
    __device__ __forceinline__ void operator()(const f32x4 (&acc)[2][2][4][2], const Unit& u, int wr, int wc, int fr, int fq) const {
        const int row0 = u.pm * BM + wr * 64 + fr; const int pn = ntn ? (u.pn % ntn) : u.pn;
        const int col0 = pn * HALF + wc * 32 + 8 * fq;
#pragma unroll
        for (int ai = 0; ai < 2; ++ai)
#pragma unroll
            for (int m = 0; m < 4; ++m) { bf16_t* rowp = O + (size_t)(row0 + ai * HALF + m * 16) * ldc + col0;
                float rs = 1.0f; if (rowss) { const f32x4* sp = (const f32x4*)(rowss + (size_t)(row0 + ai * HALF + m * 16) * 16); const f32x4 s0 = sp[0], s1 = sp[1], s2 = sp[2], s3 = sp[3]; const f32x4 st = (s0 + s1) + (s2 + s3); rs = 1.0f / sqrtf(((st[0] + st[1]) + (st[2] + st[3])) * (1.0f / 1024.f) + 1e-6f); }
                float r[8];
#pragma unroll
                for (int n = 0; n < 2; ++n)
#pragma unroll
                    for (int i = 0; i < 4; ++i) { const float g = acc[ai][0][m][n][i] * rs, up = acc[ai][1][m][n][i] * rs; r[n * 4 + i] = g * __builtin_amdgcn_rcpf(1.0f + __expf(-g)) * up; }
                u32x4 w; w.x = cvt_pk_bf16(r[0], r[1]); w.y = cvt_pk_bf16(r[2], r[3]); w.z = cvt_pk_bf16(r[4], r[5]); w.w = cvt_pk_bf16(r[6], r[7]);
                *(u32x4*)rowp = w; }
    }
};
struct MoeOrder {
    const int* tile_exp; int tlo, nt, nN, G, c;
    __device__ __forceinline__ bool next(int i, Unit& u) const {
        const int L = i * G + c; if (nt <= 0 || L >= nt * nN) return false;
        const int t = tlo + (L % nt), cn = L / nt;
        const int e = __builtin_amdgcn_readfirstlane(__hip_atomic_load(tile_exp + t, __ATOMIC_RELAXED, __HIP_MEMORY_SCOPE_AGENT));
        u.pm = t; u.pn = e * nN + cn; return true;
    }
    __device__ __forceinline__ void a_ready(const Unit&) const {}
    __device__ __forceinline__ void done(const Unit&) const {}
};
template <class Epi, class Sched, bool ALIGN_EPI = false, bool SP2 = false>
__device__ __forceinline__ void gemm_phase(PG8_LAS unsigned char* lds, const Gemm g, const Sched& S, const Epi& E, const int wave_id) {
    int tid_; asm volatile("v_mbcnt_lo_u32_b32 %0, -1, 0\n\tv_mbcnt_hi_u32_b32 %0, -1, %0" : "=v"(tid_)); tid_ += wave_id * 64;
    const int tid = tid_, wid = __builtin_amdgcn_readfirstlane(tid >> 6), lane = tid & 63, wr = wid >> 2, wc = wid & 3, fr = lane & 15, fq = lane >> 4;
    const int K = g.K, nt = K / BK;
    unsigned voffA[2], voffB[2];
#pragma unroll
    for (int i = 0; i < 2; ++i) { int R, C; stage_rc(tid * 16 + i * 8192, R, C); const int Rb = Epi::PERM ? ((R & ~31) + perm32(R & 31)) : R;
        voffA[i] = (unsigned)(R * K + C) * 2u; voffB[i] = (unsigned)(Rb * K + C) * 2u; }
    const size_t kstep = (size_t)(BK * 2);
    const size_t hstep = (size_t)HALF * K * 2;
    const size_t tstep = 2 * hstep;
    const unsigned ldsw = (unsigned)wid * 1024u;
    const int aoff = lds_byte(wr * 64 + fr, fq * 8), boff = lds_byte(wc * 32 + fr, fq * 8);
#define PG8_SA(b, h) (((b) * 2 + (h)) * HTB)
#define PG8_SB(b, h) ((4 + (b) * 2 + (h)) * HTB)
#define PG8_STAGE(bufoff, gbase, voff) do { _Pragma("unroll") for (int _i = 0; _i < 2; ++_i) \
        __builtin_amdgcn_global_load_lds((const unsigned*)((const char*)(gbase) + (voff)[_i]), (PG8_LAS unsigned*)(lds + (bufoff) + ldsw + _i * 8192), 16, 0, 0); } while (0)
#define PG8_LDA(dst, b, h) do { _Pragma("unroll") for (int m = 0; m < 4; ++m) _Pragma("unroll") for (int k = 0; k < 2; ++k) dst[m][k] = *(const PG8_LAS bf16x8*)(lds + PG8_SA(b, h) + aoff + m * 2048 + k * 1024); } while (0)
#define PG8_LDB(dst, b, h) do { _Pragma("unroll") for (int n = 0; n < 2; ++n) _Pragma("unroll") for (int k = 0; k < 2; ++k) dst[n][k] = *(const PG8_LAS bf16x8*)(lds + PG8_SB(b, h) + boff + n * 2048 + k * 1024); } while (0)
#define PG8_MMA(ai, bj, At, Bt) do { __builtin_amdgcn_s_setprio(1); _Pragma("unroll") for (int m = 0; m < 4; ++m) _Pragma("unroll") for (int n = 0; n < 2; ++n) _Pragma("unroll") for (int k = 0; k < 2; ++k) \
        acc[ai][bj][m][n] = __builtin_amdgcn_mfma_f32_16x16x32_bf16(Bt[n][k], At[m][k], acc[ai][bj][m][n], 0, 0, 0); __builtin_amdgcn_s_setprio(0); } while (0)
#define PG8_WAIT_V(n) asm volatile("s_waitcnt vmcnt(" #n ")" ::: "memory")
#define PG8_WAIT_L(n) asm volatile("s_waitcnt lgkmcnt(" #n ")" ::: "memory")
#define PG8_BAR __builtin_amdgcn_s_barrier()
#define PG8_SCHED __builtin_amdgcn_sched_barrier(0)
    Unit cur, nxt; int ui = 0;
    if (!S.next(0, cur)) return;
    f32x4 acc[2][2][4][2];
#pragma unroll
    for (int a = 0; a < 2; ++a)
#pragma unroll
        for (int b = 0; b < 2; ++b)
#pragma unroll
            for (int m = 0; m < 4; ++m)
#pragma unroll
                for (int n = 0; n < 2; ++n) acc[a][b][m][n] = (f32x4){0.f, 0.f, 0.f, 0.f};
    bf16x8 At[4][2], B0[2][2], B1[2][2];
    const char* cA = (const char*)g.A + (size_t)cur.pm * tstep; const char* cB = (const char*)g.Bt + (size_t)cur.pn * tstep;
    S.a_ready(cur);
    if constexpr (SP2) {
        PG8_STAGE(PG8_SB(0, 0), cB, voffB); PG8_STAGE(PG8_SB(0, 1), cB + hstep, voffB); PG8_STAGE(PG8_SA(0, 0), cA, voffA); PG8_STAGE(PG8_SA(0, 1), cA + hstep, voffA);
        if (wr == 1) PG8_BAR;
        PG8_WAIT_V(2); PG8_BAR;
        PG8_STAGE(PG8_SB(1, 0), cB + kstep, voffB); PG8_STAGE(PG8_SA(1, 0), cA + kstep, voffA); PG8_STAGE(PG8_SB(1, 1), cB + hstep + kstep, voffB);
        PG8_WAIT_V(6); PG8_BAR;
    } else {
        PG8_STAGE(PG8_SB(0, 0), cB, voffB); PG8_STAGE(PG8_SA(0, 0), cA, voffA); PG8_STAGE(PG8_SB(0, 1), cB + hstep, voffB); PG8_STAGE(PG8_SA(0, 1), cA + hstep, voffA);
        if (wr == 1) PG8_BAR;
        PG8_WAIT_V(4); PG8_BAR;
        PG8_STAGE(PG8_SB(1, 0), cB + kstep, voffB); PG8_STAGE(PG8_SA(1, 0), cA + kstep, voffA); PG8_STAGE(PG8_SB(1, 1), cB + hstep + kstep, voffB);
        PG8_WAIT_V(6); PG8_BAR;
    }
    for (;;) {
        const bool has_next = S.next(ui + 1, nxt);
        const char* nA = has_next ? (const char*)g.A + (size_t)nxt.pm * tstep : cA; const char* nB = has_next ? (const char*)g.Bt + (size_t)nxt.pn * tstep : cB;
        for (int t = 0; t < nt; t += 2) {
            const bool last = (t == nt - 2);
            const char* a1 = cA + (size_t)(t + 1) * kstep;
            const char* a2 = last ? nA : cA + (size_t)(t + 2) * kstep; const char* b2 = last ? nB : cB + (size_t)(t + 2) * kstep;
            const char* a3 = a2 + kstep; const char* b3 = b2 + kstep;
            if (last && has_next) S.a_ready(nxt);
            if constexpr (SP2) {
            PG8_LDB(B0, 0, 0); PG8_LDB(B1, 0, 1); PG8_SCHED; PG8_LDA(At, 0, 0); PG8_STAGE(PG8_SA(1, 1), a1 + hstep, voffA);
            PG8_WAIT_V(8); PG8_WAIT_L(0); PG8_BAR; PG8_MMA(0, 0, At, B0); PG8_MMA(0, 1, At, B1); PG8_BAR; PG8_SCHED;
            PG8_LDA(At, 0, 1); PG8_STAGE(PG8_SB(0, 0), b2, voffB); PG8_STAGE(PG8_SB(0, 1), b2 + hstep, voffB); PG8_STAGE(PG8_SA(0, 0), a2, voffA);
            PG8_WAIT_V(8); PG8_WAIT_L(0); PG8_BAR; PG8_MMA(1, 0, At, B0); PG8_MMA(1, 1, At, B1); PG8_BAR; PG8_SCHED;
            PG8_LDB(B0, 1, 0); PG8_LDB(B1, 1, 1); PG8_SCHED; PG8_LDA(At, 1, 0); PG8_STAGE(PG8_SA(0, 1), a2 + hstep, voffA);
            PG8_WAIT_V(8); PG8_WAIT_L(0); PG8_BAR; PG8_MMA(0, 0, At, B0); PG8_MMA(0, 1, At, B1); PG8_BAR; PG8_SCHED;
            PG8_LDA(At, 1, 1); PG8_STAGE(PG8_SB(1, 0), b3, voffB); PG8_STAGE(PG8_SB(1, 1), b3 + hstep, voffB); PG8_STAGE(PG8_SA(1, 0), a3, voffA);
            PG8_WAIT_V(8); PG8_WAIT_L(0); PG8_BAR; PG8_MMA(1, 0, At, B0); PG8_MMA(1, 1, At, B1); PG8_BAR; PG8_SCHED;
            } else {
            PG8_LDB(B0, 0, 0); PG8_SCHED; PG8_LDA(At, 0, 0); PG8_STAGE(PG8_SA(1, 1), a1 + hstep, voffA);
            PG8_WAIT_L(8); PG8_BAR; PG8_WAIT_L(0); PG8_MMA(0, 0, At, B0); PG8_BAR; PG8_SCHED;
            PG8_LDB(B1, 0, 1); PG8_STAGE(PG8_SB(0, 0), b2, voffB);
            PG8_BAR; PG8_WAIT_L(0); PG8_MMA(0, 1, At, B1); PG8_BAR;
            PG8_LDA(At, 0, 1); PG8_STAGE(PG8_SA(0, 0), a2, voffA);
            PG8_BAR; PG8_WAIT_L(0); PG8_MMA(1, 0, At, B0); PG8_BAR; PG8_SCHED;
            PG8_STAGE(PG8_SB(0, 1), b2 + hstep, voffB);
            PG8_WAIT_V(6); PG8_BAR; PG8_MMA(1, 1, At, B1); PG8_BAR;
            PG8_LDB(B0, 1, 0); PG8_SCHED; PG8_LDA(At, 1, 0); PG8_STAGE(PG8_SA(0, 1), a2 + hstep, voffA);
            PG8_WAIT_L(8); PG8_BAR; PG8_WAIT_L(0); PG8_MMA(0, 0, At, B0); PG8_BAR; PG8_SCHED;
            PG8_LDB(B1, 1, 1); PG8_STAGE(PG8_SB(1, 0), b3, voffB);
            PG8_BAR; PG8_WAIT_L(0); PG8_MMA(0, 1, At, B1); PG8_BAR;
            PG8_LDA(At, 1, 1); PG8_STAGE(PG8_SA(1, 0), a3, voffA);
            PG8_BAR; PG8_WAIT_L(0); PG8_MMA(1, 0, At, B0); PG8_BAR; PG8_SCHED;
            PG8_STAGE(PG8_SB(1, 1), b3 + hstep, voffB);
            PG8_WAIT_V(6); PG8_BAR; PG8_MMA(1, 1, At, B1); PG8_BAR;
            }
        }
        if constexpr (ALIGN_EPI) { if (wr == 0) PG8_BAR; }
        if constexpr (!Epi::AFTER_DRAIN) { E(acc, cur, wr, wc, fr, fq); S.done(cur); }
        if (!has_next) break;
#pragma unroll
        for (int a = 0; a < 2; ++a)
#pragma unroll
            for (int b = 0; b < 2; ++b)
#pragma unroll
                for (int m = 0; m < 4; ++m)
#pragma unroll
                    for (int n = 0; n < 2; ++n) acc[a][b][m][n] = (f32x4){0.f, 0.f, 0.f, 0.f};
        cur = nxt; cA = nA; cB = nB; ++ui;
        if constexpr (ALIGN_EPI) { if (wr == 1) PG8_BAR; }
    }
    PG8_WAIT_V(0);
    if constexpr (!ALIGN_EPI) { if (wr == 0) PG8_BAR; }
    PG8_BAR;
    if constexpr (Epi::AFTER_DRAIN) { E.fused(acc, cur, wr, wc, fr, fq, lds, wid, lane); S.done(cur); }
#undef PG8_SA
#undef PG8_SB
#undef PG8_STAGE
#undef PG8_LDA
#undef PG8_LDB
#undef PG8_MMA
#undef PG8_WAIT_V
#undef PG8_WAIT_L
#undef PG8_BAR
#undef PG8_SCHED
}
}
constexpr int S_ = 16384, D_ = 1024;
constexpr int EVEN_IN = 3072, LORA_N = 512, FF0 = 2816, ODD_IN = 3600, ODD_PAD = 3840, FFE = 3584, NEXP = 8;
constexpr int MOE_ROWS = 32768 + 8 * 256;
constexpr int MOE_BATCH_TILES = 64;
constexpr size_t MiB = 1u << 20;
constexpr size_t WS_CTL = 0, CTL_ZERO_BYTES = 1 * MiB;
constexpr size_t WS_WIN0 = 2 * MiB, WS_WL = 8 * MiB, WS_WOUT0 = 9 * MiB, WS_WGU0 = 11 * MiB, WS_WD0 = 22 * MiB, WS_WIN1 = 28 * MiB, WS_WOUT1 = 36 * MiB;
constexpr size_t WS_TOK = 38 * MiB;
constexpr size_t WS_TILE = 39 * MiB;
constexpr size_t WS_A = 40 * MiB;
constexpr size_t WS_H = WS_A, WS_HX = WS_A + 32 * MiB;
constexpr size_t WS_LW0 = WS_A, WS_LW1 = WS_A + 32 * MiB, WS_R = WS_A + 64 * MiB, WS_V = WS_A + 80 * MiB, WS_KK = WS_A + 96 * MiB, WS_KD0 = WS_A + 112 * MiB, WS_KD1 = WS_A + 128 * MiB, WS_B0 = WS_A + 144 * MiB;
constexpr size_t WS_H2 = WS_A, WS_H3 = WS_A + 32 * MiB;
constexpr size_t WS_WMGU = WS_A, WS_WMD = WS_A + 112 * MiB;
constexpr size_t WS_B = 208 * MiB;
constexpr size_t WS_PROJ0 = WS_B, WS_LORA = WS_B + 96 * MiB, WS_QN = WS_B + 112 * MiB, WS_KN = WS_B + 128 * MiB, WS_Y = WS_B + 144 * MiB;
constexpr size_t WS_B1 = WS_B + 176 * MiB, WS_GATE = WS_B + 192 * MiB, WS_BONUS = WS_B + 208 * MiB, WS_Y0 = WS_LORA, WS_Y1 = WS_B + 224 * MiB;
constexpr size_t WS_ACT0 = WS_B, WS_PROJ1 = WS_B + 88 * MiB;
constexpr size_t WS_QD = WS_B, WS_KD = WS_B + 16 * MiB, WS_VD = WS_B + 32 * MiB, WS_YCAT1 = WS_B + 48 * MiB, WS_GB = WS_B + 80 * MiB  ;
constexpr size_t WS_O0 = WS_B + 208 * MiB, WS_O1 = WS_B + 224 * MiB;
constexpr size_t WS_AMOE = WS_B, WS_MACT = WS_B + 88 * MiB;
constexpr size_t WS_END_OLD = 448 * MiB, WS_RSS1 = 460 * MiB, WS_RSS2 = 461 * MiB, WS_END = 462 * MiB;
static_assert(WS_MACT + (size_t)MOE_BATCH_TILES * 256 * FFE * 2 <= WS_END, "moe act");
static_assert(WS_AMOE + (size_t)MOE_ROWS * D_ * 2 <= WS_MACT, "amoe");
static_assert(WS_PROJ1 + (size_t)S_ * ODD_PAD * 2 <= WS_O0, "proj1");
constexpr int CW_CNT = 64;
constexpr int CW_RSS1 = 32768, CW_RSS2 = 32768 + 16384;
constexpr int CW_BAR = 4096;
constexpr int LDS_BYTES = 151552, LDS_ZERO_OFF = LDS_BYTES - 512, MISC_OFF = LDS_ZERO_OFF + 64;

#define GAS __attribute__((address_space(1)))
#define LAS __attribute__((address_space(3)))
#define DI __device__ __forceinline__
typedef unsigned short bf16;
typedef unsigned v4u __attribute__((ext_vector_type(4)));
typedef float f32x4 __attribute__((ext_vector_type(4)));
typedef GAS unsigned gu32;
#define LDS_WAIT() asm volatile("s_waitcnt lgkmcnt(0)" ::: "memory")
DI unsigned f2bf(float f) { unsigned u = __builtin_bit_cast(unsigned, f); return (u + 0x7fffu + ((u >> 16) & 1u)) >> 16; }
typedef float f32x2_t __attribute__((ext_vector_type(2))); typedef __bf16 bf16x2_t __attribute__((ext_vector_type(2)));
DI unsigned pk2(float lo, float hi) { const f32x2_t v = {lo, hi}; const bf16x2_t b = __builtin_convertvector(v, bf16x2_t); return __builtin_bit_cast(unsigned, b); }
DI float bflo(unsigned w) { return __uint_as_float(w << 16); }
DI float bfhi(unsigned w) { return __uint_as_float(w & 0xffff0000u); }
DI float bf2f(bf16 b) { return __uint_as_float(((unsigned)b) << 16); }
DI void ld8(const bf16* p, float (&v)[8]) { const v4u w = *(const v4u*)p; v[0] = bflo(w.x); v[1] = bfhi(w.x); v[2] = bflo(w.y); v[3] = bfhi(w.y); v[4] = bflo(w.z); v[5] = bfhi(w.z); v[6] = bflo(w.w); v[7] = bfhi(w.w); }
DI void st8(bf16* p, const float (&v)[8]) { v4u w; w.x = pk2(v[0], v[1]); w.y = pk2(v[2], v[3]); w.z = pk2(v[4], v[5]); w.w = pk2(v[6], v[7]); *(v4u*)p = w; }
DI void ld8f(const float* p, float (&v)[8]) { const f32x4 a = *(const f32x4*)p, b = *(const f32x4*)(p + 4); v[0] = a.x; v[1] = a.y; v[2] = a.z; v[3] = a.w; v[4] = b.x; v[5] = b.y; v[6] = b.z; v[7] = b.w; }
DI void st8f(float* p, const float (&v)[8]) { *(f32x4*)p = (f32x4){v[0], v[1], v[2], v[3]}; *(f32x4*)(p + 4) = (f32x4){v[4], v[5], v[6], v[7]}; }
DI float wave_sum(float v) {
#pragma unroll
    for (int o = 1; o < 64; o <<= 1) v += __shfl_xor(v, o);
    return v;
}
template <int W> DI float grp_sum(float v) {
#pragma unroll
    for (int o = 1; o < W; o <<= 1) v += __shfl_xor(v, o);
    return v;
}
DI float sigmoidf_(float x) { return 1.0f / (1.0f + __expf(-x)); }
DI float softplusf_(float x) { return x > 20.f ? x : log1pf(__expf(x)); }
DI float siluf_(float x) { return x / (1.0f + __expf(-x)); }

struct Args { const float* in[39]; float* out; unsigned char* ws; };

DI void transpose_item(const float* W, int K, int N, bf16* WT, int rowbase, LAS float* scr, int k0, int n0, int lane, const float* kscale = nullptr) {
    const int nn = n0 + (lane & 31); const bool ok = nn < N;
#pragma unroll 8
    for (int i = 0; i < 32; ++i) { const int kk = 2 * i + (lane >> 5); scr[kk * 33 + (lane & 31)] = ok ? W[(size_t)(k0 + kk) * N + nn] * (kscale ? kscale[k0 + kk] : 1.0f) : 0.f; }
    LDS_WAIT(); asm volatile("" ::: "memory");
    const int c = lane & 7;
#pragma unroll
    for (int j = 0; j < 4; ++j) { const int n = (lane >> 3) + 8 * j; const LAS float* s = scr + (8 * c) * 33 + n;
        v4u o; o.x = pk2(s[0 * 33], s[1 * 33]); o.y = pk2(s[2 * 33], s[3 * 33]); o.z = pk2(s[4 * 33], s[5 * 33]); o.w = pk2(s[6 * 33], s[7 * 33]);
        *(v4u*)(WT + (size_t)(rowbase + n) * K + k0 + 8 * c) = o; }
    LDS_WAIT(); asm volatile("" ::: "memory");
}
DI bool transpose_job(int& r, const float* W, int K, int N, int Npad, bf16* WT, int row_off, int grp, int sel, LAS float* scr, int lane, const float* kscale = nullptr) {
    const int nblk = Npad / 32, cnt = (K / 64) * nblk;
    if (r >= cnt) { r -= cnt; return false; }
    const int kb = r / nblk, nb = r % nblk, n0 = 32 * nb;
    const int rowbase = row_off + (grp ? (n0 / grp) * (2 * grp) + sel * grp + (n0 % grp) : n0);
    transpose_item(W, K, N, WT, rowbase, scr, 64 * kb, n0, lane, kscale);
    return true;
}
#define XB_TMO      128
#define XB_XCNT(j)  (256  + 64 * (j))
#define XB_XSUB(j)  (1280 + 64 * (j))
#define XB_XGEN(j)  (2304 + 64 * (j))
#define XB_TOP      3328
#define XB_TOPGEN   3392
#define XCD_BAR_WORDS 3456
#define XB_SPIN_CAP (1u << 22)

__device__ __forceinline__ unsigned xb_ld(unsigned* p)              { return __hip_atomic_load(p, __ATOMIC_RELAXED, __HIP_MEMORY_SCOPE_AGENT); }
__device__ __forceinline__ unsigned xb_add(unsigned* p, unsigned v) { return __hip_atomic_fetch_add(p, v, __ATOMIC_RELAXED, __HIP_MEMORY_SCOPE_AGENT); }
__device__ __forceinline__ unsigned xb_xcc_id() { return (unsigned)__builtin_amdgcn_s_getreg((3 << 11) | 20) & 0xFu; }
#define XB_SPIN(cond, bar) do { unsigned _sp = 0; while (cond) { __builtin_amdgcn_s_sleep(1); \
    if ((++_sp & 255u) == 0u) { if (xb_ld(&(bar)[XB_TMO])) break; if (_sp > XB_SPIN_CAP) { atomicAdd(&(bar)[XB_TMO], 1u); break; } } } } while (0)

struct XcdBarrier {
    unsigned* bar; unsigned x;
    volatile LAS unsigned* st;
};

__device__ __forceinline__ XcdBarrier xcd_barrier_post(unsigned* bar, volatile LAS unsigned* st) {
    XcdBarrier b; b.bar = bar; b.x = xb_xcc_id(); b.st = st;
    if (threadIdx.x == 0) (void)xb_add(&bar[XB_XCNT(b.x)], 1u);
    return b;
}
__device__ __forceinline__ void xcd_barrier_complete(unsigned* bar, unsigned x, unsigned& nloc, unsigned& nx) {
    const unsigned G = gridDim.x * gridDim.y * gridDim.z;
    unsigned sum, cnt, mine, sp = 0u;
    for (;;) {
        sum = 0u; cnt = 0u; mine = 0u;
#pragma unroll
        for (unsigned j = 0; j < 16; ++j) { const unsigned c = xb_ld(&bar[XB_XCNT(j)]); sum += c; cnt += (c > 0u) ? 1u : 0u; mine = (j == x) ? c : mine; }
        if (sum == G) break;
        __builtin_amdgcn_s_sleep(1);
        if ((++sp & 255u) == 0u) { if (xb_ld(&bar[XB_TMO])) break; if (sp > XB_SPIN_CAP) { atomicAdd(&bar[XB_TMO], 1u); break; } }
    }
    nloc = mine > 0u ? mine : 1u; nx = cnt > 0u ? cnt : 1u;
}

__device__ __forceinline__ void xcd_barrier(const XcdBarrier& b, const bool wave0) {
    asm volatile("s_waitcnt vmcnt(0)" ::: "memory");
    __syncthreads();
    if (wave0 && __builtin_amdgcn_mbcnt_hi(~0u, __builtin_amdgcn_mbcnt_lo(~0u, 0u)) == 0u) {
        unsigned* bar = b.bar; asm volatile("" : "+s"(bar)); const unsigned bx_ = xb_xcc_id();
        __builtin_amdgcn_s_waitcnt(0);
        unsigned nloc = b.st[0], nx = b.st[1];
        if (nloc == 0u) { xcd_barrier_complete(bar, bx_, nloc, nx); b.st[0] = nloc; b.st[1] = nx; }
        const unsigned old = xb_add(&bar[XB_XSUB(bx_)], 1u);
        const unsigned gen = old / nloc;
        if (old + 1u == (gen + 1u) * nloc) {
            __builtin_amdgcn_fence(__ATOMIC_RELEASE, "agent");
            asm volatile("s_waitcnt vmcnt(0)" ::: "memory");
            const unsigned og = xb_add(&bar[XB_TOP], 1u);
            const unsigned tg = og / nx;
            if (og + 1u == (tg + 1u) * nx) xb_add(&bar[XB_TOPGEN], 1u);
            else XB_SPIN(xb_ld(&bar[XB_TOPGEN]) == tg, bar);
            __builtin_amdgcn_fence(__ATOMIC_ACQUIRE, "agent");
            xb_add(&bar[XB_XGEN(bx_)], 1u);
            asm volatile("s_waitcnt vmcnt(0)" ::: "memory");
        } else {
            XB_SPIN(xb_ld(&bar[XB_XGEN(bx_)]) == gen, bar);
            __builtin_amdgcn_fence(__ATOMIC_ACQUIRE, "agent");
            asm volatile("s_waitcnt vmcnt(0)" ::: "memory");
        }
    }
    __syncthreads();
}
DI float row_rstd(const f32x4 (&v)[4]) {
    float s = 0.f;
#pragma unroll
    for (int j = 0; j < 4; ++j) s += (v[j].x * v[j].x + v[j].y * v[j].y) + (v[j].z * v[j].z + v[j].w * v[j].w);
    return 1.0f / sqrtf(wave_sum(s) * (1.0f / D_) + 1e-6f);
}
DI void load_row(const float* x, int t, int lane, f32x4 (&v)[4]) {
    if (t >= 0 && t < S_) { const f32x4* p = (const f32x4*)(x + (size_t)t * D_) + lane;
#pragma unroll
        for (int j = 0; j < 4; ++j) v[j] = p[64 * j];
    } else {
#pragma unroll
        for (int j = 0; j < 4; ++j) v[j] = (f32x4){0.f, 0.f, 0.f, 0.f};
    }
}
DI void store_row_bf16(bf16* o, int lane, const f32x4 (&v)[4]) {
    unsigned long long* o8 = (unsigned long long*)o + lane;
#pragma unroll
    for (int j = 0; j < 4; ++j) o8[64 * j] = (unsigned long long)pk2(v[j].x, v[j].y) | ((unsigned long long)pk2(v[j].z, v[j].w) << 32);
}
DI void norm_rows(const float* x, const float* w, const float* mu  , bf16* H, bf16* HX, int gw, int NGW, int lane) {
    f32x4 wv[4];
#pragma unroll
    for (int j = 0; j < 4; ++j) wv[j] = ((const f32x4*)w)[lane + 64 * j];
    for (int t = gw; t < S_; t += NGW) {
        f32x4 v[4]; load_row(x, t, lane, v); const float rs = row_rstd(v);
#pragma unroll
        for (int j = 0; j < 4; ++j) v[j] = v[j] * rs * wv[j];
        store_row_bf16(H + (size_t)t * D_, lane, v);
        if (mu) {
            f32x4 p[4], n[4]; load_row(x, t - 1, lane, p); load_row(x, t + 1, lane, n);
            const float rp = row_rstd(p), rn = row_rstd(n);
#pragma unroll
            for (int j = 0; j < 4; ++j) { const f32x4 m0 = ((const f32x4*)mu)[lane + 64 * j], m1 = ((const f32x4*)(mu + D_))[lane + 64 * j];
                const f32x4 hp = p[j] * rp * wv[j], hn = n[j] * rn * wv[j]; p[j] = v[j] + m0 * (hp - v[j]) + m1 * (hn - v[j]); }
            store_row_bf16(HX + (size_t)t * D_, lane, p);
        }
    }
}

DI void prep0_token(const Args& a, unsigned char* ws, LAS float* scr, int t, int lane) {
    const bf16* P = (const bf16*)(ws + WS_PROJ0) + (size_t)t * EVEN_IN;
    const int c0 = 8 * lane;
    {
        float q[8], k[8]; ld8(P + c0, q); ld8(P + 512 + c0, k);
        float sq = 0.f, sk = 0.f;
#pragma unroll
        for (int i = 0; i < 8; ++i) { sq += q[i] * q[i]; sk += k[i] * k[i]; }
        sq = grp_sum<8>(sq); sk = grp_sum<8>(sk);
        const float rq = 1.0f / sqrtf(sq * (1.0f / 64.f) + 1e-6f), rk = 1.0f / sqrtf(sk * (1.0f / 64.f) + 1e-6f);
        const int d0 = 8 * (lane & 7);
        float qw[8], kw[8]; ld8f(a.in[4] + d0, qw); ld8f(a.in[5] + d0, kw);
#pragma unroll
        for (int i = 0; i < 8; ++i) { q[i] = q[i] * rq * qw[i]; k[i] = k[i] * rk * kw[i]; }
        const float pos = (float)((const int*)a.in[1])[t];
        float qo[8], ko[8];
#pragma unroll
        for (int i = 0; i < 8; ++i) { qo[i] = __shfl_xor(q[i], 1); ko[i] = __shfl_xor(k[i], 1); }
        const int sub = lane & 7;
        if (sub < 2) {
#pragma unroll
            for (int i = 0; i < 8; ++i) {
                constexpr float kInv[8] = {1.0f, 0.1939227432012558f, 0.03760603070259094f, 0.007292664609849453f, 0.0014142135623842478f, 0.00027424818836152554f, 5.3182957344688475e-05f, 1.0313385246263351e-05f};
                const float ang = pos * kInv[i]; const float kq = rintf(ang * 0.15915494309189535f);
                float rr = fmaf(-kq, 6.28318548202514648f, ang); rr = fmaf(-kq, -1.74845553146951715e-07f, rr);
                const float sn = __sinf(rr), cs = __cosf(rr);
                if (sub == 0) { q[i] = q[i] * cs - qo[i] * sn; k[i] = k[i] * cs - ko[i] * sn; }
                else          { q[i] = q[i] * cs + qo[i] * sn; k[i] = k[i] * cs + ko[i] * sn; }
            }
        }
#pragma unroll
        for (int i = 0; i < 8; ++i) q[i] *= 0.125f;
        st8((bf16*)(ws + WS_QN) + (size_t)t * 512 + c0, q); st8((bf16*)(ws + WS_KN) + (size_t)t * 512 + c0, k);
    }
}

DI void rwkv_scan_naive(unsigned char* ws, int w  , int lane) {
    const int z = w >> 9, h = (w >> 6) & 7, vr = w & 63;
    const float* LW = (const float*)(ws + (z ? WS_LW1 : WS_LW0));
    const bf16* KD = (const bf16*)(ws + (z ? WS_KD1 : WS_KD0)); const bf16* BB = (const bf16*)(ws + (z ? WS_B1 : WS_B0));
    const bf16* KK = (const bf16*)(ws + WS_KK); const bf16* R = (const bf16*)(ws + WS_R); const bf16* V = (const bf16*)(ws + WS_V);
    bf16* Y = (bf16*)(ws + (z ? WS_Y1 : WS_Y0));
    const int cc = h * 64 + lane, cv = h * 64 + vr;
    float S = 0.f;
    int t = z ? S_ - 1 : 0; const int dt = z ? -1 : 1;
    size_t o = (size_t)t * 512;
    float lw = LW[o + cc], kd = bf2f(KD[o + cc]), bb = bf2f(BB[o + cc]), kk = bf2f(KK[o + cc]), rr = bf2f(R[o + cc]), vv = bf2f(V[o + cv]);
    for (int s = 0; s < S_; ++s) {
        const int tn = t + dt; const bool more = s + 1 < S_;
        const size_t on = (size_t)(more ? tn : t) * 512;
        const float lw_n = LW[on + cc], kd_n = bf2f(KD[on + cc]), bb_n = bf2f(BB[on + cc]), kk_n = bf2f(KK[on + cc]), rr_n = bf2f(R[on + cc]), vv_n = bf2f(V[on + cv]);
        const float sa = wave_sum(S * (-kk));
        S = S * __expf(lw) + sa * bb + vv * kd;
        const float y = wave_sum(S * rr);
        if (lane == 0) Y[(size_t)t * 512 + cv] = (bf16)f2bf(y);
        lw = lw_n; kd = kd_n; bb = bb_n; kk = kk_n; rr = rr_n; vv = vv_n; t = tn;
    }
}

DI void attn_token_naive(unsigned char* ws, int t, int lane) {
    const bf16* QN = (const bf16*)(ws + WS_QN); const bf16* KN = (const bf16*)(ws + WS_KN); const bf16* P = (const bf16*)(ws + WS_PROJ0);
    const int c0 = 8 * lane;
    float q[8]; ld8(QN + (size_t)t * 512 + c0, q);
    float m = -1e30f, l = 0.f, acc[8];
#pragma unroll
    for (int i = 0; i < 8; ++i) acc[i] = 0.f;
    for (int br = 0; br < 3; ++br) {
        const int d = br == 0 ? 1 : (br == 1 ? 4 : 16);
        for (int mm = -64; mm <= 64; ++mm) {
            const int j = t + d * mm; if (j < 0 || j >= S_) continue;
            float k[8], v[8]; ld8(KN + (size_t)j * 512 + c0, k); ld8(P + (size_t)j * EVEN_IN + 1024 + c0, v);
            float s = 0.f;
#pragma unroll
            for (int i = 0; i < 8; ++i) s += q[i] * k[i];
            s = grp_sum<8>(s);
            const float mn = fmaxf(m, s), sc = __expf(m - mn), p = __expf(s - mn);
            l = l * sc + p;
#pragma unroll
            for (int i = 0; i < 8; ++i) acc[i] = acc[i] * sc + p * v[i];
            m = mn;
        }
    }
    const float il = 1.0f / l;
#pragma unroll
    for (int i = 0; i < 8; ++i) acc[i] *= il;
    st8((bf16*)(ws + WS_Y) + (size_t)t * D_ + c0, acc);
}

DI void rwkv_post_token(const Args& a, unsigned char* ws, int t, int lane) {
    const int c0 = 8 * lane; const size_t o = (size_t)t * 512 + c0;
    float y0[8], y1[8], g[8], bn[8], lw[8], lb[8];
    ld8((const bf16*)(ws + WS_Y0) + o, y0); ld8((const bf16*)(ws + WS_Y1) + o, y1); ld8((const bf16*)(ws + WS_GATE) + o, g); ld8((const bf16*)(ws + WS_BONUS) + o, bn);
    ld8f(a.in[19] + c0, lw); ld8f(a.in[20] + c0, lb);
    float s = 0.f;
#pragma unroll
    for (int i = 0; i < 8; ++i) { y0[i] += y1[i]; s += y0[i]; }
    const float mu = grp_sum<8>(s) * (1.0f / 64.f);
    float q = 0.f;
#pragma unroll
    for (int i = 0; i < 8; ++i) { y0[i] -= mu; q += y0[i] * y0[i]; }
    const float rs = 1.0f / sqrtf(grp_sum<8>(q) * (1.0f / 64.f) + 64e-5f);
#pragma unroll
    for (int i = 0; i < 8; ++i) y0[i] = (y0[i] * rs * lw[i] + lb[i] + bn[i]) * g[i];
    st8((bf16*)(ws + WS_Y) + (size_t)t * D_ + 512 + c0, y0);
}
typedef short s16x8 __attribute__((ext_vector_type(8)));
typedef short s16x4 __attribute__((ext_vector_type(4)));
typedef LAS unsigned char* ldsp;
DI f32x4 mfma16(s16x8 a, s16x8 b, f32x4 c) { return __builtin_amdgcn_mfma_f32_16x16x32_bf16(a, b, c, 0, 0, 0); }
DI s16x8 frag_row(ldsp img, int row0, int col0, int lane) { return *(LAS const s16x8*)(img + (row0 + (lane & 15)) * 128 + (col0 + 8 * (lane >> 4)) * 2); }
DI s16x4 tr16(ldsp p) { return __builtin_bit_cast(s16x4, __builtin_amdgcn_ds_read_tr16_b64_v4i16((LAS s16x4*)p)); }
DI s16x8 frag_tr(ldsp img, int row0, int col0, int lane) {
    ldsp a0 = img + (row0 + 8 * (lane >> 4) + ((lane & 15) >> 2)) * 128 + col0 * 2 + 8 * (lane & 3);
    const s16x4 lo = tr16(a0), hi = tr16(a0 + 4 * 128);
    return __builtin_shufflevector(lo, hi, 0, 1, 2, 3, 4, 5, 6, 7);
}
DI void ctile_to_img(ldsp img, int mt, int nt, const f32x4& c, int lane) {
    LAS bf16* p = (LAS bf16*)(img + (16 * mt + 4 * (lane >> 4)) * 128 + (16 * nt + (lane & 15)) * 2);
#pragma unroll
    for (int e = 0; e < 4; ++e) p[e * 64] = (bf16)f2bf(c[e]);
}
#define CFENCE() asm volatile("" ::: "memory")
#define MM_LOOPH(ACC, AEXPR, BEXPR) _Pragma("unroll") for (int mt = 2 * mh; mt < 2 * mh + 2; ++mt) _Pragma("unroll") for (int nt = 0; nt < 4; ++nt) _Pragma("unroll") for (int ks = 0; ks < 2; ++ks) ACC[mt][nt] = mfma16((AEXPR), (BEXPR), ACC[mt][nt])
#define MM_LOOP(ACC, AEXPR, BEXPR) _Pragma("unroll") for (int mt = 0; mt < 4; ++mt) _Pragma("unroll") for (int nt = 0; nt < 4; ++nt) _Pragma("unroll") for (int ks = 0; ks < 2; ++ks) ACC[mt][nt] = mfma16((AEXPR), (BEXPR), ACC[mt][nt])

DI int tok_of(int z, int cn, int i) { return z ? cn * 64 + 63 - i : cn * 64 + i; }

template <bool DRY = false, int STOP = 99> DI void rwkv_pass1_item(unsigned char* ws, ldsp lds, int item, int lane) {
    asm volatile("" : "+v"(lane));
    const int z = item >> 11, h = (item >> 8) & 7, c = item & 255;
    const int cn = z ? 255 - c : c;
    float* LW = (float*)(ws + (z ? WS_LW1 : WS_LW0));
    bf16* KD = (bf16*)(ws + (z ? WS_KD1 : WS_KD0)); bf16* BB = (bf16*)(ws + (z ? WS_B1 : WS_B0));
    const bf16* KK = (const bf16*)(ws + WS_KK); const bf16* R = (const bf16*)(ws + WS_R); const bf16* V = (const bf16*)(ws + WS_V);
    float* LWo = DRY ? (float*)(ws + WS_Y) : LW; bf16* KDo = DRY ? (bf16*)(ws + WS_Y) : KD; bf16* BBo = DRY ? (bf16*)(ws + WS_Y) : BB;
    ldsp S0 = lds, S1 = lds + 8192, S2 = lds + 16384, S3 = lds + 24576, S4 = lds + 32768, S5 = lds + 40960, S6 = lds + 49152, S7 = lds + 57344;
    ldsp IA = S0, IB = S1, IK = S2, IR = S3;
    const int ch = h * 64 + lane;
    float G = 0.f;
#pragma unroll 16
    for (int i = 0; i < 64; ++i) {
        const size_t o = (size_t)tok_of(z, cn, i) * 512 + ch;
        const float lw = LW[o], a = -bf2f(KK[o]), b = bf2f(BB[o]), kd = bf2f(KD[o]), r = bf2f(R[o]);
        const float eprev = __expf(G); G += lw; const float ecur = __expf(G), einv = __expf(-G);
        ((LAS bf16*)IA)[i * 64 + lane] = (bf16)f2bf(a * eprev); ((LAS bf16*)IB)[i * 64 + lane] = (bf16)f2bf(b * einv);
        ((LAS bf16*)IK)[i * 64 + lane] = (bf16)f2bf(kd * einv); ((LAS bf16*)IR)[i * 64 + lane] = (bf16)f2bf(r * ecur);
    }
    const float GT = __expf(G);
    LDS_WAIT(); CFENCE();
    if (STOP == 1) { if (GT == 123.f) LWo[0] = GT; return; }
    int lane2 = lane; asm volatile("" : "+v"(lane2));
    const int n_ = lane2 & 15, q_ = lane2 >> 4;
    {
#pragma unroll
        for (int mh = 0; mh < 2; ++mh) {
        f32x4 acc[4][4];
#pragma unroll
        for (int mt = 2 * mh; mt < 2 * mh + 2; ++mt)
#pragma unroll
            for (int nt = 0; nt < 4; ++nt) acc[mt][nt] = (f32x4){0.f, 0.f, 0.f, 0.f};
        MM_LOOPH(acc, frag_row(IA, 16 * mt, 32 * ks, lane), frag_row(IB, 16 * nt, 32 * ks, lane));
#pragma unroll
        for (int mt = 2 * mh; mt < 2 * mh + 2; ++mt)
#pragma unroll
            for (int nt = 0; nt < 4; ++nt)
#pragma unroll
                for (int e = 0; e < 4; ++e) { const int i = 16 * mt + 4 * q_ + e, j = 16 * nt + n_; ((LAS float*)S4)[i * 64 + j] = (j < i) ? acc[mt][nt][e] : 0.f; }
        }
    }
    LDS_WAIT(); CFENCE();
    if (STOP == 4) return;
    {
        float t[64];
        int lane_o = lane; asm volatile("" : "+v"(lane_o));
        f32x4 ar[2][16];
#pragma unroll
        for (int i = 0; i < 64; ++i) {
            if (i + 1 < 64) {
#pragma unroll
                for (int jg = 0; jg < (i + 1 + 3) / 4; ++jg) ar[(i + 1) & 1][jg] = *(LAS const f32x4*)(S4 + ((i + 1) * 64 + 4 * jg) * 4);
            }
            __builtin_amdgcn_sched_barrier(0);
            float acc0 = (lane_o == i) ? 1.f : 0.f, acc1 = 0.f, acc2 = 0.f, acc3 = 0.f;
#pragma unroll
            for (int jg = 0; jg < (i + 3) / 4; ++jg) { const f32x4 a4 = ar[i & 1][jg];
                if (4 * jg + 0 < i) acc0 += a4[0] * t[4 * jg + 0];
                if (4 * jg + 1 < i) acc1 += a4[1] * t[4 * jg + 1];
                if (4 * jg + 2 < i) acc2 += a4[2] * t[4 * jg + 2];
                if (4 * jg + 3 < i) acc3 += a4[3] * t[4 * jg + 3]; }
            t[i] = (acc0 + acc1) + (acc2 + acc3);
            __builtin_amdgcn_sched_barrier(0);
        }
        LDS_WAIT(); CFENCE();
#pragma unroll
        for (int i = 0; i < 64; ++i) ((LAS bf16*)S4)[i * 64 + lane] = (bf16)f2bf(t[i]);
    }
    LDS_WAIT(); CFENCE();
    if (STOP == 2) return;
    ldsp IT = S4, IW = S5, IAK = S6;
    {
#pragma unroll
        for (int mh = 0; mh < 2; ++mh) {
        f32x4 acc[4][4];
#pragma unroll
        for (int mt = 2 * mh; mt < 2 * mh + 2; ++mt)
#pragma unroll
            for (int nt = 0; nt < 4; ++nt) acc[mt][nt] = (f32x4){0.f, 0.f, 0.f, 0.f};
        MM_LOOPH(acc, frag_row(IA, 16 * mt, 32 * ks, lane), frag_row(IK, 16 * nt, 32 * ks, lane));
#pragma unroll
        for (int mt = 2 * mh; mt < 2 * mh + 2; ++mt)
#pragma unroll
            for (int nt = 0; nt < 4; ++nt) {
#pragma unroll
                for (int e = 0; e < 4; ++e) { const int i = 16 * mt + 4 * q_ + e, j = 16 * nt + n_; if (!(j < i)) acc[mt][nt][e] = 0.f; }
                ctile_to_img(IAK, mt, nt, acc[mt][nt], lane); }
        }
    }
    if (STOP == 5) return;
    {
#pragma unroll
        for (int mh = 0; mh < 2; ++mh) {
        f32x4 acc[4][4];
#pragma unroll
        for (int mt = 2 * mh; mt < 2 * mh + 2; ++mt)
#pragma unroll
            for (int nt = 0; nt < 4; ++nt) acc[mt][nt] = (f32x4){0.f, 0.f, 0.f, 0.f};
        MM_LOOPH(acc, frag_row(IT, 16 * mt, 32 * ks, lane), frag_tr(IA, 32 * ks, 16 * nt, lane));
#pragma unroll
        for (int mt = 2 * mh; mt < 2 * mh + 2; ++mt)
#pragma unroll
            for (int nt = 0; nt < 4; ++nt) ctile_to_img(IW, mt, nt, acc[mt][nt], lane);
        }
    }
    LDS_WAIT(); CFENCE();
    if (STOP == 6) return;
    ldsp IV = S0;
    {
        v4u vr[8];
#pragma unroll
        for (int it = 0; it < 8; ++it) vr[it] = *(const v4u*)(V + (size_t)tok_of(z, cn, (lane >> 3) + 8 * it) * 512 + h * 64 + (lane & 7) * 8);
#pragma unroll
        for (int it = 0; it < 8; ++it) *(LAS v4u*)(IV + ((lane >> 3) + 8 * it) * 128 + (lane & 7) * 16) = vr[it];
    }
    LDS_WAIT(); CFENCE();
    ldsp IAV = S7;
    {
#pragma unroll
        for (int mh = 0; mh < 2; ++mh) {
        f32x4 acc[4][4];
#pragma unroll
        for (int mt = 2 * mh; mt < 2 * mh + 2; ++mt)
#pragma unroll
            for (int nt = 0; nt < 4; ++nt) acc[mt][nt] = (f32x4){0.f, 0.f, 0.f, 0.f};
        MM_LOOPH(acc, frag_row(IAK, 16 * mt, 32 * ks, lane), frag_tr(IV, 32 * ks, 16 * nt, lane));
#pragma unroll
        for (int mt = 2 * mh; mt < 2 * mh + 2; ++mt)
#pragma unroll
            for (int nt = 0; nt < 4; ++nt) ctile_to_img(IAV, mt, nt, acc[mt][nt], lane);
        }
    }
    LDS_WAIT(); CFENCE();
    if (STOP == 7) return;
    ldsp IU = S6;
    {
#pragma unroll
        for (int mh = 0; mh < 2; ++mh) {
        f32x4 acc[4][4];
#pragma unroll
        for (int mt = 2 * mh; mt < 2 * mh + 2; ++mt)
#pragma unroll
            for (int nt = 0; nt < 4; ++nt) acc[mt][nt] = (f32x4){0.f, 0.f, 0.f, 0.f};
        MM_LOOPH(acc, frag_row(IT, 16 * mt, 32 * ks, lane), frag_tr(IAV, 32 * ks, 16 * nt, lane));
        LDS_WAIT(); CFENCE();
#pragma unroll
        for (int mt = 2 * mh; mt < 2 * mh + 2; ++mt)
#pragma unroll
            for (int nt = 0; nt < 4; ++nt) ctile_to_img(IU, mt, nt, acc[mt][nt], lane);
        }
    }
    LDS_WAIT(); CFENCE();
    if (STOP == 3) return;
    ldsp IRB = S4, IRK = S7;
    {
#pragma unroll
        for (int mh = 0; mh < 2; ++mh) {
        f32x4 acc[4][4];
#pragma unroll
        for (int mt = 2 * mh; mt < 2 * mh + 2; ++mt)
#pragma unroll
            for (int nt = 0; nt < 4; ++nt) acc[mt][nt] = (f32x4){0.f, 0.f, 0.f, 0.f};
        MM_LOOPH(acc, frag_row(IR, 16 * mt, 32 * ks, lane), frag_row(IB, 16 * nt, 32 * ks, lane));
#pragma unroll
        for (int mt = 2 * mh; mt < 2 * mh + 2; ++mt)
#pragma unroll
            for (int nt = 0; nt < 4; ++nt) {
#pragma unroll
                for (int e = 0; e < 4; ++e) { const int i = 16 * mt + 4 * q_ + e, j = 16 * nt + n_; if (!(j <= i)) acc[mt][nt][e] = 0.f; }
                ctile_to_img(IRB, mt, nt, acc[mt][nt], lane); }
        }
    }
    {
#pragma unroll
        for (int mh = 0; mh < 2; ++mh) {
        f32x4 acc[4][4];
#pragma unroll
        for (int mt = 2 * mh; mt < 2 * mh + 2; ++mt)
#pragma unroll
            for (int nt = 0; nt < 4; ++nt) acc[mt][nt] = (f32x4){0.f, 0.f, 0.f, 0.f};
        MM_LOOPH(acc, frag_row(IR, 16 * mt, 32 * ks, lane), frag_row(IK, 16 * nt, 32 * ks, lane));
#pragma unroll
        for (int mt = 2 * mh; mt < 2 * mh + 2; ++mt)
#pragma unroll
            for (int nt = 0; nt < 4; ++nt) {
#pragma unroll
                for (int e = 0; e < 4; ++e) { const int i = 16 * mt + 4 * q_ + e, j = 16 * nt + n_; if (!(j <= i)) acc[mt][nt][e] = 0.f; }
                ctile_to_img(IRK, mt, nt, acc[mt][nt], lane); }
        }
    }
    LDS_WAIT(); CFENCE();
    int lane3 = lane; asm volatile("" : "+v"(lane3));
    const int n3 = lane3 & 15, q3 = lane3 >> 4;
    const size_t slot0 = (size_t)cn * 64 * 512 + h * 64;
    {
#pragma unroll
        for (int mh = 0; mh < 2; ++mh) {
        f32x4 acc[4][4];
#pragma unroll
        for (int mt = 2 * mh; mt < 2 * mh + 2; ++mt)
#pragma unroll
            for (int nt = 0; nt < 4; ++nt) { const s16x4 r4 = *(LAS const s16x4*)(IR + (16 * nt + n3) * 128 + (16 * mt + 4 * q3) * 2);
#pragma unroll
                for (int e = 0; e < 4; ++e) acc[mt][nt][e] = bf2f((bf16)r4[e]); }
        MM_LOOPH(acc, frag_tr(IW, 32 * ks, 16 * mt, lane), frag_row(IRB, 16 * nt, 32 * ks, lane));
#pragma unroll
        for (int mt = 2 * mh; mt < 2 * mh + 2; ++mt)
#pragma unroll
            for (int nt = 0; nt < 4; ++nt) { bf16* dst = (bf16*)(LWo + slot0 + (size_t)(16 * nt + n3) * 512) + 16 * mt + 4 * q3;
                *(unsigned long long*)dst = (unsigned long long)pk2(acc[mt][nt][0], acc[mt][nt][1]) | ((unsigned long long)pk2(acc[mt][nt][2], acc[mt][nt][3]) << 32); }
        }
    }
    {
#pragma unroll
        for (int mh = 0; mh < 2; ++mh) {
        f32x4 acc[4][4];
#pragma unroll
        for (int mt = 2 * mh; mt < 2 * mh + 2; ++mt)
#pragma unroll
            for (int nt = 0; nt < 4; ++nt) acc[mt][nt] = (f32x4){0.f, 0.f, 0.f, 0.f};
        MM_LOOPH(acc, frag_tr(IU, 32 * ks, 16 * mt, lane), frag_row(IRB, 16 * nt, 32 * ks, lane));
        MM_LOOPH(acc, frag_tr(IV, 32 * ks, 16 * mt, lane), frag_row(IRK, 16 * nt, 32 * ks, lane));
#pragma unroll
        for (int mt = 2 * mh; mt < 2 * mh + 2; ++mt)
#pragma unroll
            for (int nt = 0; nt < 4; ++nt) { bf16* dst = (bf16*)(LWo + slot0 + (size_t)(16 * nt + n3) * 512) + 64 + 16 * mt + 4 * q3;
                *(unsigned long long*)dst = (unsigned long long)pk2(acc[mt][nt][0], acc[mt][nt][1]) | ((unsigned long long)pk2(acc[mt][nt][2], acc[mt][nt][3]) << 32); }
        }
    }
    {
#pragma unroll
        for (int mh = 0; mh < 2; ++mh) {
        f32x4 acc[4][4];
#pragma unroll
        for (int mt = 2 * mh; mt < 2 * mh + 2; ++mt)
#pragma unroll
            for (int nt = 0; nt < 4; ++nt) acc[mt][nt] = (f32x4){0.f, 0.f, 0.f, 0.f};
        MM_LOOPH(acc, frag_tr(IW, 32 * ks, 16 * mt, lane), frag_tr(IB, 32 * ks, 16 * nt, lane));
#pragma unroll
        for (int nt = 0; nt < 4; ++nt) { const float gk = __shfl(GT, 16 * nt + n3);
#pragma unroll
            for (int mt = 2 * mh; mt < 2 * mh + 2; ++mt) { float o[4];
#pragma unroll
                for (int e = 0; e < 4; ++e) o[e] = gk * (acc[mt][nt][e] + ((16 * mt + 4 * q3 + e) == (16 * nt + n3) ? 1.f : 0.f));
                bf16* dst = KDo + slot0 + (size_t)(16 * nt + n3) * 512 + 16 * mt + 4 * q3;
                *(unsigned long long*)dst = (unsigned long long)pk2(o[0], o[1]) | ((unsigned long long)pk2(o[2], o[3]) << 32); } }
        }
    }
    {
#pragma unroll
        for (int mh = 0; mh < 2; ++mh) {
        f32x4 acc[4][4];
#pragma unroll
        for (int mt = 2 * mh; mt < 2 * mh + 2; ++mt)
#pragma unroll
            for (int nt = 0; nt < 4; ++nt) acc[mt][nt] = (f32x4){0.f, 0.f, 0.f, 0.f};
        MM_LOOPH(acc, frag_tr(IB, 32 * ks, 16 * mt, lane), frag_tr(IU, 32 * ks, 16 * nt, lane));
        MM_LOOPH(acc, frag_tr(IK, 32 * ks, 16 * mt, lane), frag_tr(IV, 32 * ks, 16 * nt, lane));
#pragma unroll
        for (int mt = 2 * mh; mt < 2 * mh + 2; ++mt) { float gk[4];
#pragma unroll
            for (int e = 0; e < 4; ++e) gk[e] = __shfl(GT, 16 * mt + 4 * q3 + e);
#pragma unroll
            for (int nt = 0; nt < 4; ++nt) { bf16* dst = BBo + slot0 + (size_t)(16 * nt + n3) * 512 + 16 * mt + 4 * q3;
                *(unsigned long long*)dst = (unsigned long long)pk2(gk[0] * acc[mt][nt][0], gk[1] * acc[mt][nt][1]) | ((unsigned long long)pk2(gk[2] * acc[mt][nt][2], gk[3] * acc[mt][nt][3]) << 32); } }
        }
    }
    LDS_WAIT(); CFENCE();
}
DI unsigned long long pk4(const f32x4& v) { return (unsigned long long)pk2(v[0], v[1]) | ((unsigned long long)pk2(v[2], v[3]) << 32); }
DI f32x4 unpk4(unsigned long long w) { return (f32x4){bflo((unsigned)w), bfhi((unsigned)w), bflo((unsigned)(w >> 32)), bfhi((unsigned)(w >> 32))}; }
DI s16x8 pack_cpair(const f32x4& lo, const f32x4& hi) {
    v4u p; p.x = pk2(lo[0], lo[1]); p.y = pk2(lo[2], lo[3]); p.z = pk2(hi[0], hi[1]); p.w = pk2(hi[2], hi[3]);
    return __builtin_bit_cast(s16x8, p);
}
DI void rwkv_pass2_wave(unsigned char* ws, int w  , int lane) {
    const int z = w >> 5, h = (w >> 2) & 7, vs = w & 3;
    const bf16* Mm = (const bf16*)(ws + (z ? WS_KD1 : WS_KD0)); const bf16* Nn = (const bf16*)(ws + (z ? WS_B1 : WS_B0));
    bf16* Hst = (bf16*)(ws + (z ? WS_V : WS_R));
    const int n_ = lane & 15, q_ = lane >> 4;
    f32x4 H[4];
#pragma unroll
    for (int kt = 0; kt < 4; ++kt) H[kt] = (f32x4){0.f, 0.f, 0.f, 0.f};
    unsigned long long ma[4][2][2], nn[4];
    {
        const int cn = z ? 255 : 0; const size_t slot0 = (size_t)cn * 64 * 512 + h * 64;
#pragma unroll
        for (int kt = 0; kt < 4; ++kt) {
#pragma unroll
            for (int ks = 0; ks < 2; ++ks) { const bf16* row = Mm + slot0 + (size_t)(16 * kt + n_) * 512 + 32 * ks + 4 * q_;
                ma[kt][ks][0] = *(const unsigned long long*)row; ma[kt][ks][1] = *(const unsigned long long*)(row + 16); }
            nn[kt] = *(const unsigned long long*)(Nn + slot0 + (size_t)(16 * vs + n_) * 512 + 16 * kt + 4 * q_); }
    }
    for (int c = 0; c < 256; ++c) {
        { bf16* dst = Hst + ((size_t)(c * 8 + h) * 64 + 16 * vs + n_) * 64 + 4 * q_;
#pragma unroll
          for (int kt = 0; kt < 4; ++kt) *(unsigned long long*)(dst + 16 * kt) = (unsigned long long)pk2(H[kt][0], H[kt][1]) | ((unsigned long long)pk2(H[kt][2], H[kt][3]) << 32); }
        unsigned long long ma2[4][2][2], nn2[4];
        { const int c2 = c + 1 < 256 ? c + 1 : c; const int cn = z ? 255 - c2 : c2; const size_t slot0 = (size_t)cn * 64 * 512 + h * 64;
#pragma unroll
          for (int kt = 0; kt < 4; ++kt) {
#pragma unroll
            for (int ks = 0; ks < 2; ++ks) { const bf16* row = Mm + slot0 + (size_t)(16 * kt + n_) * 512 + 32 * ks + 4 * q_;
                ma2[kt][ks][0] = *(const unsigned long long*)row; ma2[kt][ks][1] = *(const unsigned long long*)(row + 16); }
            nn2[kt] = *(const unsigned long long*)(Nn + slot0 + (size_t)(16 * vs + n_) * 512 + 16 * kt + 4 * q_); } }
        const s16x8 b0 = pack_cpair(H[0], H[1]), b1 = pack_cpair(H[2], H[3]);
#pragma unroll
        for (int kt = 0; kt < 4; ++kt) {
            f32x4 acc = (f32x4){bflo((unsigned)nn[kt]), bfhi((unsigned)nn[kt]), bflo((unsigned)(nn[kt] >> 32)), bfhi((unsigned)(nn[kt] >> 32))};
            { v4u a; a.x = (unsigned)ma[kt][0][0]; a.y = (unsigned)(ma[kt][0][0] >> 32); a.z = (unsigned)ma[kt][0][1]; a.w = (unsigned)(ma[kt][0][1] >> 32); acc = mfma16(__builtin_bit_cast(s16x8, a), b0, acc); }
            { v4u a; a.x = (unsigned)ma[kt][1][0]; a.y = (unsigned)(ma[kt][1][0] >> 32); a.z = (unsigned)ma[kt][1][1]; a.w = (unsigned)(ma[kt][1][1] >> 32); acc = mfma16(__builtin_bit_cast(s16x8, a), b1, acc); }
            H[kt] = acc;
        }
#pragma unroll
        for (int kt = 0; kt < 4; ++kt) { nn[kt] = nn2[kt];
#pragma unroll
            for (int ks = 0; ks < 2; ++ks) { ma[kt][ks][0] = ma2[kt][ks][0]; ma[kt][ks][1] = ma2[kt][ks][1]; } }
    }
}
DI void rwkv_pass3_item(unsigned char* ws, int item, int lane) {
    const int z = item >> 11, h = (item >> 8) & 7, c = item & 255;
    const int cn = z ? 255 - c : c;
    const float* LW = (const float*)(ws + (z ? WS_LW1 : WS_LW0));
    const bf16* Hst = (const bf16*)(ws + (z ? WS_V : WS_R)) + (size_t)(c * 8 + h) * 64 * 64;
    bf16* Y = (bf16*)(ws + (z ? WS_Y1 : WS_Y0));
    const int n_ = lane & 15, q_ = lane >> 4;
    const size_t slot0 = (size_t)cn * 64 * 512 + h * 64;
    s16x8 hA[4][2], qB[4][2];
#pragma unroll
    for (int t = 0; t < 4; ++t)
#pragma unroll
        for (int ks = 0; ks < 2; ++ks) {
            hA[t][ks] = *(const s16x8*)(Hst + (size_t)(16 * t + n_) * 64 + 32 * ks + 8 * q_);
            qB[t][ks] = *(const s16x8*)((const bf16*)(LW + slot0 + (size_t)(16 * t + n_) * 512) + 32 * ks + 8 * q_); }
#pragma unroll
    for (int nt = 0; nt < 4; ++nt) {
        const int i = 16 * nt + n_; const bf16* ycrow = (const bf16*)(LW + slot0 + (size_t)i * 512) + 64;
        bf16* yrow = Y + (size_t)tok_of(z, cn, i) * 512 + h * 64;
#pragma unroll
        for (int mt = 0; mt < 4; ++mt) {
            const unsigned long long y4 = *(const unsigned long long*)(ycrow + 16 * mt + 4 * q_);
            f32x4 acc = (f32x4){bflo((unsigned)y4), bfhi((unsigned)y4), bflo((unsigned)(y4 >> 32)), bfhi((unsigned)(y4 >> 32))};
            acc = mfma16(hA[mt][0], qB[nt][0], acc); acc = mfma16(hA[mt][1], qB[nt][1], acc);
            *(unsigned long long*)(yrow + 16 * mt + 4 * q_) = (unsigned long long)pk2(acc[0], acc[1]) | ((unsigned long long)pk2(acc[2], acc[3]) << 32);
        }
    }
}
DI void rwkv_pass2_block(unsigned char* ws, ldsp L, int b  , int wave, int lane) {
    const int z = b >> 3, h = b & 7;
    if (wave >= 4) {
        const int lw = wave - 4;
        const char* Mm = (const char*)(ws + (z ? WS_KD1 : WS_KD0)); const char* Nn = (const char*)(ws + (z ? WS_B1 : WS_B0));
#define RW_ISSUE(cc) do { const int c_ = (cc); if (c_ < 256) { const int cn_ = z ? 255 - c_ : c_; const size_t slot0 = ((size_t)cn_ * 64 * 512 + h * 64) * 2; ldsp slot = L + (c_ & 7) * 16384; \
            _Pragma("unroll") for (int k = 0; k < 4; ++k) { const int pid = lw * 4 + k; const int pr = pid & 7; const int row = 8 * pr + (lane >> 3), p = lane & 7, cch = p ^ (row & 7); \
                const char* src = (pid < 8 ? Mm : Nn) + slot0 + (size_t)row * 1024 + cch * 16; \
                __builtin_amdgcn_global_load_lds((const unsigned*)src, (LAS unsigned*)(slot + (pid < 8 ? 0 : 8192) + pr * 1024), 16, 0, 0); } } } while (0)
        RW_ISSUE(0); RW_ISSUE(1); RW_ISSUE(2); RW_ISSUE(3); RW_ISSUE(4); RW_ISSUE(5); RW_ISSUE(6);
        for (int c = 0; c < 256; ++c) {
            if (c < 250) asm volatile("s_waitcnt vmcnt(24)" ::: "memory"); else asm volatile("s_waitcnt vmcnt(0)" ::: "memory");
            __builtin_amdgcn_s_barrier();
            asm volatile("" ::: "memory");
            RW_ISSUE(c + 7);
        }
#undef RW_ISSUE
        asm volatile("s_waitcnt vmcnt(0)" ::: "memory");
        return;
    }
    const int vs = wave;
    bf16* Hst = (bf16*)(ws + (z ? WS_V : WS_R));
    const int n_ = lane & 15, q_ = lane >> 4, wbyte = (q_ & 1) * 8, sw = n_ & 7;
    f32x4 H[4];
#pragma unroll
    for (int kt = 0; kt < 4; ++kt) H[kt] = (f32x4){0.f, 0.f, 0.f, 0.f};
    for (int c = 0; c < 256; ++c) {
        { bf16* dst = Hst + ((size_t)(c * 8 + h) * 64 + 16 * vs + n_) * 64 + 4 * q_;
#pragma unroll
          for (int kt = 0; kt < 4; ++kt) *(unsigned long long*)(dst + 16 * kt) = pk4(H[kt]); }
        asm volatile("s_waitcnt lgkmcnt(0)" ::: "memory");
        __builtin_amdgcn_s_barrier();
        asm volatile("" ::: "memory");
        ldsp slot = L + (c & 7) * 16384;
        const s16x8 b0 = pack_cpair(H[0], H[1]), b1 = pack_cpair(H[2], H[3]);
#pragma unroll
        for (int kt = 0; kt < 4; ++kt) {
            ldsp nrow = slot + 8192 + (16 * vs + n_) * 128 + wbyte;
            f32x4 acc = unpk4(*(LAS const unsigned long long*)(nrow + (((2 * kt + (q_ >> 1)) ^ sw) * 16)));
            ldsp mrow = slot + (16 * kt + n_) * 128 + wbyte;
#pragma unroll
            for (int ks = 0; ks < 2; ++ks) { const int c0 = 4 * ks + (q_ >> 1);
                const unsigned long long a0 = *(LAS const unsigned long long*)(mrow + ((c0 ^ sw) * 16)), a1 = *(LAS const unsigned long long*)(mrow + (((c0 + 2) ^ sw) * 16));
                v4u a; a.x = (unsigned)a0; a.y = (unsigned)(a0 >> 32); a.z = (unsigned)a1; a.w = (unsigned)(a1 >> 32);
                acc = mfma16(__builtin_bit_cast(s16x8, a), ks == 0 ? b0 : b1, acc); }
            H[kt] = acc;
        }
    }
}
DI void rwkv_pass3_post_item(const Args& a, unsigned char* ws, int item, int lane) {
    asm volatile("" : "+v"(lane));
    const int h = item >> 8, cn = item & 255;
    const int n_ = lane & 15, q_ = lane >> 4;
    const size_t slot0 = (size_t)cn * 64 * 512 + h * 64;
    const float* LW0 = (const float*)(ws + WS_LW0); const float* LW1 = (const float*)(ws + WS_LW1);
    const bf16* H0 = (const bf16*)(ws + WS_R) + (size_t)(cn * 8 + h) * 4096;
    const bf16* H1 = (const bf16*)(ws + WS_V) + (size_t)((255 - cn) * 8 + h) * 4096;
    s16x8 hA0[4][2], hA1[4][2];
#pragma unroll
    for (int t = 0; t < 4; ++t)
#pragma unroll
        for (int ks = 0; ks < 2; ++ks) { hA0[t][ks] = *(const s16x8*)(H0 + (size_t)(16 * t + n_) * 64 + 32 * ks + 8 * q_); hA1[t][ks] = *(const s16x8*)(H1 + (size_t)(16 * t + n_) * 64 + 32 * ks + 8 * q_); }
#pragma unroll
    for (int nt = 0; nt < 4; ++nt) {
        const int i0 = 16 * nt + n_, i1 = 63 - i0;
        const bf16* q0 = (const bf16*)(LW0 + slot0 + (size_t)i0 * 512); const bf16* q1 = (const bf16*)(LW1 + slot0 + (size_t)i1 * 512);
        s16x8 qB0[2], qB1[2];
#pragma unroll
        for (int ks = 0; ks < 2; ++ks) { qB0[ks] = *(const s16x8*)(q0 + 32 * ks + 8 * q_); qB1[ks] = *(const s16x8*)(q1 + 32 * ks + 8 * q_); }
        f32x4 y[4]; float sum = 0.f;
#pragma unroll
        for (int mt = 0; mt < 4; ++mt) {
            f32x4 acc = unpk4(*(const unsigned long long*)(q0 + 64 + 16 * mt + 4 * q_)) + unpk4(*(const unsigned long long*)(q1 + 64 + 16 * mt + 4 * q_));
            acc = mfma16(hA0[mt][0], qB0[0], acc); acc = mfma16(hA0[mt][1], qB0[1], acc);
            acc = mfma16(hA1[mt][0], qB1[0], acc); acc = mfma16(hA1[mt][1], qB1[1], acc);
            y[mt] = acc; sum += (acc[0] + acc[1]) + (acc[2] + acc[3]);
        }
        sum += __shfl_xor(sum, 16); sum += __shfl_xor(sum, 32);
        const float mu = sum * (1.0f / 64.f); float sq = 0.f;
#pragma unroll
        for (int mt = 0; mt < 4; ++mt)
#pragma unroll
            for (int e = 0; e < 4; ++e) { y[mt][e] -= mu; sq += y[mt][e] * y[mt][e]; }
        sq += __shfl_xor(sq, 16); sq += __shfl_xor(sq, 32);
        const float rs = 1.0f / sqrtf(sq * (1.0f / 64.f) + 64e-5f);
        const size_t tok = (size_t)(cn * 64 + i0);
#pragma unroll
        for (int mt = 0; mt < 4; ++mt) { const int c0 = h * 64 + 16 * mt + 4 * q_;
            const f32x4 lw = *(const f32x4*)(a.in[19] + c0), lb = *(const f32x4*)(a.in[20] + c0);
            const f32x4 bn = unpk4(*(const unsigned long long*)((const bf16*)(ws + WS_BONUS) + tok * 512 + c0)), gt = unpk4(*(const unsigned long long*)((const bf16*)(ws + WS_GATE) + tok * 512 + c0));
            const f32x4 o = (y[mt] * rs * lw + lb + bn) * gt;
            *(unsigned long long*)((bf16*)(ws + WS_Y) + tok * D_ + 512 + c0) = pk4(o); }
    }
}
constexpr size_t WS_W2T = WS_TILE + 65536;
constexpr size_t WS_PARK = WS_Y;
DI s16x8 act_frag(const bf16* p, int mode) {
    float v[8]; ld8(p, v);
#pragma unroll
    for (int i = 0; i < 8; ++i) { if (mode == 0) v[i] = 1.0f - 2.0f / (__expf(2.0f * v[i]) + 1.0f); else if (mode == 2) v[i] = 1.0f / (1.0f + __expf(-v[i])); }
    v4u w; w.x = pk2(v[0], v[1]); w.y = pk2(v[2], v[3]); w.z = pk2(v[4], v[5]); w.w = pk2(v[6], v[7]);
    return __builtin_bit_cast(s16x8, w);
}
DI void ld4(const bf16* p, float (&v)[4]) { const unsigned long long w = *(const unsigned long long*)p; v[0] = bflo((unsigned)w); v[1] = bfhi((unsigned)w); v[2] = bflo((unsigned)(w >> 32)); v[3] = bfhi((unsigned)(w >> 32)); }
DI void st4(bf16* p, const float (&v)[4]) { *(unsigned long long*)p = (unsigned long long)pk2(v[0], v[1]) | ((unsigned long long)pk2(v[2], v[3]) << 32); }
DI void prep0_rwkv_unit(const Args& a, unsigned char* ws, ldsp wl, int tile, int h, int lane) {
    asm volatile("" : "+v"(lane));
    const int t0 = tile * 16, n_ = lane & 15, q_ = lane >> 4, t = t0 + n_;
    const bf16* LR = (const bf16*)(ws + WS_LORA) + (size_t)t * LORA_N + 8 * q_;
    const bf16* P = (const bf16*)(ws + WS_PROJ0) + (size_t)t * EVEN_IN + 1536 + h * 64 + 4 * q_;
    const bool hp = t > 0, hn = t < S_ - 1;
    v4u lraw[12];
#pragma unroll
    for (int i = 0; i < 12; ++i) lraw[i] = *(const v4u*)(LR + 32 * i);
    unsigned long long cu[3][4], pv[3][4], nx[3][4];
#pragma unroll
    for (int part = 0; part < 3; ++part)
#pragma unroll
        for (int mt = 0; mt < 4; ++mt) { const bf16* p = P + part * 512 + 16 * mt;
            cu[part][mt] = *(const unsigned long long*)p; pv[part][mt] = hp ? *(const unsigned long long*)(p - EVEN_IN) : 0ull; nx[part][mt] = hn ? *(const unsigned long long*)(p + EVEN_IN) : 0ull; }
    float r[16], k[16], v[16];
#pragma unroll
    for (int part = 0; part < 3; ++part)
#pragma unroll
        for (int mt = 0; mt < 4; ++mt) { const int c0 = h * 64 + 16 * mt + 4 * q_;
            const f32x4 m0 = *(const f32x4*)(a.in[6] + part * 512 + c0), m1 = *(const f32x4*)(a.in[6] + 1536 + part * 512 + c0);
            const f32x4 c4 = unpk4(cu[part][mt]), p4 = unpk4(pv[part][mt]), n4 = unpk4(nx[part][mt]);
#pragma unroll
            for (int e = 0; e < 4; ++e) { const float o = c4[e] + m0[e] * (p4[e] - c4[e]) + m1[e] * (n4[e] - c4[e]);
                if (part == 0) r[4 * mt + e] = o; else if (part == 1) k[4 * mt + e] = o; else v[4 * mt + e] = o; } }
    float ss = 0.f;
#pragma unroll
    for (int mt = 0; mt < 4; ++mt) { const f32x4 kkw = *(const f32x4*)(a.in[16] + h * 64 + 16 * mt + 4 * q_);
#pragma unroll
        for (int e = 0; e < 4; ++e) { const float x = k[4 * mt + e] * kkw[e]; ss += x * x; } }
    ss += __shfl_xor(ss, 16); ss += __shfl_xor(ss, 32);
    const float rn = 1.0f / sqrtf(ss + 1e-6f);
    s16x8 lfr[12];
#pragma unroll
    for (int i = 0; i < 12; ++i) { float x[8]; const v4u w = lraw[i];
        x[0] = bflo(w.x); x[1] = bfhi(w.x); x[2] = bflo(w.y); x[3] = bfhi(w.y); x[4] = bflo(w.z); x[5] = bfhi(w.z); x[6] = bflo(w.w); x[7] = bfhi(w.w);
#pragma unroll
        for (int j = 0; j < 8; ++j) { if (i < 4) x[j] = 1.0f - 2.0f * __builtin_amdgcn_rcpf(__expf(2.0f * x[j]) + 1.0f); else if (i >= 8) x[j] = __builtin_amdgcn_rcpf(1.0f + __expf(-x[j])); }
        v4u o; o.x = pk2(x[0], x[1]); o.y = pk2(x[2], x[3]); o.z = pk2(x[4], x[5]); o.w = pk2(x[6], x[7]); lfr[i] = __builtin_bit_cast(s16x8, o); }
    float dotb = 0.f;
#pragma unroll
    for (int mt = 0; mt < 4; ++mt) {
        const int c0 = h * 64 + 16 * mt + 4 * q_;
        f32x4 aw0 = *(const f32x4*)(a.in[8] + c0), aw1 = *(const f32x4*)(a.in[8] + 512 + c0), aa0 = *(const f32x4*)(a.in[11] + c0), aa1 = *(const f32x4*)(a.in[11] + 512 + c0), ag = (f32x4){0.f, 0.f, 0.f, 0.f};
        const int rl = 16 * mt + n_, sw = rl & 7;
#pragma unroll
        for (int ks = 0; ks < 2; ++ks) { const int po = ((4 * ks + q_) ^ sw) * 16;
            aw0 = mfma16(*(LAS const s16x8*)(wl + rl * 128 + po), lfr[ks], aw0);
            aw1 = mfma16(*(LAS const s16x8*)(wl + 8192 + rl * 128 + po), lfr[2 + ks], aw1);
            aa0 = mfma16(*(LAS const s16x8*)(wl + 16384 + rl * 128 + po), lfr[4 + ks], aa0);
            aa1 = mfma16(*(LAS const s16x8*)(wl + 24576 + rl * 128 + po), lfr[6 + ks], aa1);
        }
#pragma unroll
        for (int ks = 0; ks < 4; ++ks) ag = mfma16(*(LAS const s16x8*)(wl + 32768 + rl * 256 + ((((4 * ks + q_) & 8) | (((4 * ks + q_) & 7) ^ sw)) * 16)), lfr[8 + ks], ag);
        const f32x4 kkw = *(const f32x4*)(a.in[16] + c0), kaw = *(const f32x4*)(a.in[17] + c0), rkw = *(const f32x4*)(a.in[18] + c0);
        float l0[4], l1[4], g4[4], d0[4], d1[4], kk4[4], b0[4], b1[4], r4[4], v4[4];
#pragma unroll
        for (int e = 0; e < 4; ++e) { const int i = 4 * mt + e;
            l0[e] = -__expf(-__logf(1.0f + __expf(-aw0[e])) - 0.5f); l1[e] = -__expf(-__logf(1.0f + __expf(-aw1[e])) - 0.5f);
            const float i0 = __builtin_amdgcn_rcpf(1.0f + __expf(-aa0[e])), i1 = __builtin_amdgcn_rcpf(1.0f + __expf(-aa1[e])); g4[e] = ag[e];
            kk4[e] = k[i] * kkw[e] * rn; b0[e] = kk4[e] * i0; b1[e] = kk4[e] * i1;
            d0[e] = k[i] * (1.0f + (i0 - 1.0f) * kaw[e]); d1[e] = k[i] * (1.0f + (i1 - 1.0f) * kaw[e]);
            dotb += r[i] * (d0[e] + d1[e]) * rkw[e]; r4[e] = r[i]; v4[e] = v[i]; }
        const size_t o = (size_t)t * 512 + c0;
        *(f32x4*)((float*)(ws + WS_LW0) + o) = (f32x4){l0[0], l0[1], l0[2], l0[3]};
        *(f32x4*)((float*)(ws + WS_LW1) + o) = (f32x4){l1[0], l1[1], l1[2], l1[3]};
        st4((bf16*)(ws + WS_R) + o, r4); st4((bf16*)(ws + WS_V) + o, v4); st4((bf16*)(ws + WS_KK) + o, kk4); st4((bf16*)(ws + WS_KD0) + o, d0); st4((bf16*)(ws + WS_KD1) + o, d1);
        st4((bf16*)(ws + WS_B0) + o, b0); st4((bf16*)(ws + WS_B1) + o, b1); st4((bf16*)(ws + WS_GATE) + o, g4);
    }
    dotb += __shfl_xor(dotb, 16); dotb += __shfl_xor(dotb, 32);
#pragma unroll
    for (int mt = 0; mt < 4; ++mt) { float bo[4];
#pragma unroll
        for (int e = 0; e < 4; ++e) bo[e] = dotb * v[4 * mt + e];
        st4((bf16*)(ws + WS_BONUS) + (size_t)t * 512 + h * 64 + 16 * mt + 4 * q_, bo); }
}
DI void prep0_stage_w2t(unsigned char* ws, ldsp wl, int h, int tid) {
    const bf16* W2T = (const bf16*)(ws + WS_W2T);
    for (int i = tid; i < 3072; i += 512) {
        if (i < 2048) { const int mtx = i >> 9, r = (i >> 3) & 63, c = i & 7;
            *(LAS v4u*)(wl + mtx * 8192 + r * 128 + ((c ^ (r & 7)) * 16)) = *(const v4u*)(W2T + (size_t)mtx * 32768 + (size_t)(h * 64 + r) * 64 + c * 8); }
        else { const int j = i - 2048, r = j >> 4, c = j & 15;
            *(LAS v4u*)(wl + 32768 + r * 256 + (((c & 8) | ((c & 7) ^ (r & 7))) * 16)) = *(const v4u*)(W2T + 131072 + (size_t)(h * 64 + r) * 128 + c * 8); }
    }
}
constexpr int AT_ACC = 0, AT_M = 65536, AT_L = 66560, AT_V = 67584;
DI void attn_unit(unsigned char* ws, ldsp L, int unit, int wave, int lane) {
    const int h = unit & 7, T0 = (unit >> 3) * 256;
    const bf16* QN = (const bf16*)(ws + WS_QN); const bf16* KN = (const bf16*)(ws + WS_KN); const bf16* P0 = (const bf16*)(ws + WS_PROJ0);
    LAS float* accO = (LAS float*)(L + AT_ACC); LAS float* accM = (LAS float*)(L + AT_M); LAS float* accL = (LAS float*)(L + AT_L);
    ldsp Vst = L + AT_V + wave * 8192;
#pragma unroll 1
    for (int br = 0; br < 3; ++br) {
        const int d = br == 0 ? 1 : (br == 1 ? 4 : 16);
#pragma unroll 1
        for (int si = 0; si < 2; ++si) {
            int lane_s = lane; asm volatile("" : "+v"(lane_s));
            const int n_ = lane_s & 15, q_ = lane_s >> 4;
            const int sidx = wave + 8 * si;
            const int tb = br == 0 ? T0 + 16 * sidx : (br == 1 ? T0 + (sidx & 3) + 64 * (sidx >> 2) : T0 + sidx);
            s16x8 qf[2];
            { const bf16* qrow = QN + (size_t)(tb + d * n_) * 512 + h * 64 + 8 * q_; qf[0] = *(const s16x8*)qrow; qf[1] = *(const s16x8*)(qrow + 32); }
            v4u vreg[5][4];
#pragma unroll
            for (int pp = 0; pp < 2; ++pp)
#pragma unroll
                for (int it = 0; it < 4; ++it) { const int pc = lane + 64 * it, row = pc >> 3, ck = pc & 7;
                    int tk = tb + d * (32 * pp + row - 64); tk = tk < 0 ? 0 : (tk > S_ - 1 ? S_ - 1 : tk);
                    vreg[pp][it] = *(const v4u*)(P0 + (size_t)tk * EVEN_IN + 1024 + h * 64 + ck * 8); }
            f32x4 st[10];
#pragma unroll
            for (int kt = 0; kt < 10; ++kt) {
                int tk = tb + d * (16 * kt + n_ - 64); tk = tk < 0 ? 0 : (tk > S_ - 1 ? S_ - 1 : tk);
                const bf16* krow = KN + (size_t)tk * 512 + h * 64 + 8 * q_;
                f32x4 acc = (f32x4){0.f, 0.f, 0.f, 0.f};
                acc = mfma16(*(const s16x8*)krow, qf[0], acc); acc = mfma16(*(const s16x8*)(krow + 32), qf[1], acc);
                st[kt] = acc;
            }
            float mx = -3.0e38f;
#pragma unroll
            for (int kt = 0; kt < 10; ++kt)
#pragma unroll
                for (int e = 0; e < 4; ++e) { const int j = 16 * kt + 4 * q_ + e; const int tk = tb + d * (j - 64);
                    const bool ok = (j >= n_) && (j <= n_ + 128) && (tk >= 0) && (tk < S_);
                    st[kt][e] = ok ? st[kt][e] : -3.0e38f; mx = fmaxf(mx, st[kt][e]); }
            mx = fmaxf(mx, __shfl_xor(mx, 16)); mx = fmaxf(mx, __shfl_xor(mx, 32));
            float ls = 0.f;
#pragma unroll
            for (int kt = 0; kt < 10; ++kt)
#pragma unroll
                for (int e = 0; e < 4; ++e) { const float p = st[kt][e] > -1.0e38f ? __expf(st[kt][e] - mx) : 0.f; st[kt][e] = p; ls += p; }
            ls += __shfl_xor(ls, 16); ls += __shfl_xor(ls, 32);
#pragma unroll
            for (int pp = 2; pp < 5; ++pp)
#pragma unroll
                for (int it = 0; it < 4; ++it) { const int pc = lane + 64 * it, row = pc >> 3, ck = pc & 7;
                    int tk = tb + d * (32 * pp + row - 64); tk = tk < 0 ? 0 : (tk > S_ - 1 ? S_ - 1 : tk);
                    vreg[pp][it] = *(const v4u*)(P0 + (size_t)tk * EVEN_IN + 1024 + h * 64 + ck * 8); }
            f32x4 O[4];
#pragma unroll
            for (int dt = 0; dt < 4; ++dt) O[dt] = (f32x4){0.f, 0.f, 0.f, 0.f};
#pragma unroll
            for (int pp = 0; pp < 5; ++pp) {
                ldsp vb = Vst + (pp & 1) * 4096;
#pragma unroll
                for (int it = 0; it < 4; ++it) { const int pc = lane + 64 * it, row = pc >> 3, ck = pc & 7; *(LAS v4u*)(vb + row * 128 + ck * 16) = vreg[pp][it]; }
                LDS_WAIT(); CFENCE();
                const s16x8 pa = pack_cpair(st[2 * pp], st[2 * pp + 1]);
                ldsp a0 = vb + (4 * q_ + ((lane & 15) >> 2)) * 128 + 8 * (lane & 3);
#pragma unroll
                for (int dt = 0; dt < 4; ++dt) { const s16x4 lo = tr16(a0 + 32 * dt), hi = tr16(a0 + 16 * 128 + 32 * dt);
                    O[dt] = mfma16(pa, __builtin_shufflevector(lo, hi, 0, 1, 2, 3, 4, 5, 6, 7), O[dt]); }
            }
            float ms[4], lsv[4]; int li[4];
#pragma unroll
            for (int e = 0; e < 4; ++e) { ms[e] = __shfl(mx, 4 * q_ + e); lsv[e] = __shfl(ls, 4 * q_ + e); li[e] = tb + d * (4 * q_ + e) - T0; }
            if (br == 0) {
#pragma unroll
                for (int e = 0; e < 4; ++e) {
#pragma unroll
                    for (int dt = 0; dt < 4; ++dt) accO[li[e] * 64 + 16 * dt + n_] = O[dt][e];
                    if (n_ == 0) { accM[li[e]] = ms[e]; accL[li[e]] = lsv[e]; } }
            } else {
                float fo[4], fn[4], mn[4], lo_[4];
#pragma unroll
                for (int e = 0; e < 4; ++e) { const float mo = accM[li[e]]; lo_[e] = accL[li[e]]; mn[e] = fmaxf(mo, ms[e]); fo[e] = __expf(mo - mn[e]); fn[e] = __expf(ms[e] - mn[e]); }
                LDS_WAIT(); CFENCE();
#pragma unroll
                for (int e = 0; e < 4; ++e) {
#pragma unroll
                    for (int dt = 0; dt < 4; ++dt) { LAS float* p = accO + li[e] * 64 + 16 * dt + n_; *p = *p * fo[e] + O[dt][e] * fn[e]; }
                    if (n_ == 0) { accM[li[e]] = mn[e]; accL[li[e]] = lo_[e] * fo[e] + lsv[e] * fn[e]; } }
            }
            LDS_WAIT(); CFENCE();
        }
        __syncthreads();
    }
    {
        const int tid = wave * 64 + lane, tl = tid >> 1, hf = tid & 1;
        const float il = 1.0f / accL[tl];
        const LAS float* src = accO + tl * 64 + 32 * hf; bf16* dst = (bf16*)(ws + WS_Y) + (size_t)(T0 + tl) * D_ + h * 64 + 32 * hf;
#pragma unroll
        for (int c = 0; c < 4; ++c) { const f32x4 a = *(LAS const f32x4*)(src + 8 * c), b = *(LAS const f32x4*)(src + 8 * c + 4);
            v4u w; w.x = pk2(a.x * il, a.y * il); w.y = pk2(a.z * il, a.w * il); w.z = pk2(b.x * il, b.y * il); w.w = pk2(b.z * il, b.w * il);
            *(v4u*)(dst + 8 * c) = w; }
    }
    __syncthreads();
}
constexpr size_t WS_SST = WS_PROJ1, WS_UB = WS_PROJ1 + 64 * MiB, WS_AT = WS_PROJ1 + 96 * MiB, WS_GC = WS_PROJ1 + 112 * MiB;
constexpr size_t WS_WN = WS_A + 112 * MiB, WS_KT = WS_A + 144 * MiB;
static_assert(WS_GC + 2048 * 64 * 4 <= WS_O0, "dn map");
template <int PITCH> DI s16x8 frag_row_p(ldsp img, int row0, int col0, int lane) { return *(LAS const s16x8*)(img + (row0 + (lane & 15)) * PITCH + (col0 + 8 * (lane >> 4)) * 2); }
template <int PITCH> DI s16x8 frag_tr_p(ldsp img, int row0, int col0, int lane) {
    ldsp a0 = img + (row0 + 8 * (lane >> 4) + ((lane & 15) >> 2)) * PITCH + col0 * 2 + 8 * (lane & 3);
    const s16x4 lo = tr16(a0), hi = tr16(a0 + 4 * PITCH);
    return __builtin_shufflevector(lo, hi, 0, 1, 2, 3, 4, 5, 6, 7);
}
constexpr int DN_LDS_PER_WAVE = 49152 + 512;
DI void dn_pass1_item(unsigned char* ws, ldsp lds, int item, int lane) {
    asm volatile("" : "+v"(lane));
    const int z = item >> 10, h = (item >> 8) & 3, c = item & 255, cn = z ? 255 - c : c;
    const bf16* Q = (const bf16*)(ws + WS_QD); const bf16* K = (const bf16*)(ws + WS_KD); const bf16* V = (const bf16*)(ws + WS_VD);
    ldsp IKd = lds, IVd = lds + 16384, LT = lds + 32768; LAS float* gcs = (LAS float*)(lds + 49152); LAS float* bts = gcs + 64;
    const int n_ = lane & 15, q_ = lane >> 4;
    {
        const int tok = tok_of(z, cn, lane);
        float gc = ((const float*)(ws + WS_GB))[(size_t)tok * 8 + z * 4 + h]; const float bt = ((const float*)(ws + WS_GB + 512 * 1024))[(size_t)tok * 8 + z * 4 + h];
#pragma unroll
        for (int o = 1; o < 64; o <<= 1) { const float t = __shfl_up(gc, o); if (lane >= o) gc += t; }
        gcs[lane] = gc; bts[lane] = bt; ((float*)(ws + WS_GC))[(size_t)item * 64 + lane] = gc;
    }
#pragma unroll 4
    for (int it = 0; it < 16; ++it) { const int p = lane + 64 * it, row = p >> 4, ck = p & 15; const size_t go = (size_t)tok_of(z, cn, row) * 512 + h * 128 + ck * 8;
        *(LAS v4u*)(IKd + row * 256 + ck * 16) = *(const v4u*)(K + go); *(LAS v4u*)(IVd + row * 256 + ck * 16) = *(const v4u*)(V + go); }
    LDS_WAIT(); CFENCE();
    s16x8 kf[4][4];
#pragma unroll
    for (int rt = 0; rt < 4; ++rt)
#pragma unroll
        for (int ks = 0; ks < 4; ++ks) kf[rt][ks] = frag_row_p<256>(IKd, 16 * rt, 32 * ks, lane);
#pragma unroll
    for (int mt = 0; mt < 4; ++mt) { f32x4 gi, bi;
#pragma unroll
        for (int e = 0; e < 4; ++e) { gi[e] = gcs[16 * mt + 4 * q_ + e]; bi[e] = bts[16 * mt + 4 * q_ + e]; }
#pragma unroll
        for (int nt = 0; nt < 4; ++nt) { f32x4 acc = (f32x4){0.f, 0.f, 0.f, 0.f};
            if (nt <= mt) {
#pragma unroll
                for (int ks = 0; ks < 4; ++ks) acc = mfma16(kf[mt][ks], kf[nt][ks], acc); }
            const float gj = gcs[16 * nt + n_];
#pragma unroll
            for (int e = 0; e < 4; ++e) { const int i = 16 * mt + 4 * q_ + e, j = 16 * nt + n_; ((LAS float*)LT)[i * 64 + j] = (j < i) ? bi[e] * acc[e] * __expf(gi[e] - gj) : 0.f; } } }
    {
        bf16* At = (bf16*)(ws + WS_AT) + (size_t)item * 4096;
#pragma unroll
        for (int nt = 0; nt < 4; ++nt) { s16x8 qf[4]; const bf16* qrow = Q + (size_t)tok_of(z, cn, 16 * nt + n_) * 512 + h * 128 + 8 * q_;
#pragma unroll
            for (int ks = 0; ks < 4; ++ks) qf[ks] = *(const s16x8*)(qrow + 32 * ks);
            const float gi = gcs[16 * nt + n_];
#pragma unroll
            for (int mt = 0; mt < 4; ++mt) { f32x4 acc = (f32x4){0.f, 0.f, 0.f, 0.f};
                if (mt <= nt) {
#pragma unroll
                    for (int ks = 0; ks < 4; ++ks) acc = mfma16(kf[mt][ks], qf[ks], acc); }
                f32x4 o;
#pragma unroll
                for (int e = 0; e < 4; ++e) { const int j = 16 * mt + 4 * q_ + e, i = 16 * nt + n_; o[e] = (j <= i) ? acc[e] * __expf(gi - gcs[j]) : 0.f; }
                *(unsigned long long*)(At + (size_t)(16 * nt + n_) * 64 + 16 * mt + 4 * q_) = pk4(o); } }
    }
    LDS_WAIT(); CFENCE();
    {
        float t[64];
        int lane_o = lane; asm volatile("" : "+v"(lane_o));
#pragma unroll
        for (int i = 0; i < 64; ++i) {
            float acc0 = (lane_o == i) ? 1.f : 0.f, acc1 = 0.f, acc2 = 0.f, acc3 = 0.f;
#pragma unroll
            for (int jg = 0; jg < (i + 3) / 4; ++jg) { const f32x4 a4 = *(LAS const f32x4*)(LT + (i * 64 + 4 * jg) * 4);
                if (4 * jg + 0 < i) acc0 -= a4[0] * t[4 * jg + 0];
                if (4 * jg + 1 < i) acc1 -= a4[1] * t[4 * jg + 1];
                if (4 * jg + 2 < i) acc2 -= a4[2] * t[4 * jg + 2];
                if (4 * jg + 3 < i) acc3 -= a4[3] * t[4 * jg + 3]; }
            t[i] = (acc0 + acc1) + (acc2 + acc3);
        }
        LDS_WAIT(); CFENCE();
        const float s1 = bts[lane], s2 = -s1 * __expf(gcs[lane]);
#pragma unroll
        for (int i = 0; i < 64; ++i) { ((LAS bf16*)LT)[i * 64 + lane] = (bf16)f2bf(t[i] * s1); ((LAS bf16*)(LT + 8192))[i * 64 + lane] = (bf16)f2bf(t[i] * s2); }
    }
    LDS_WAIT(); CFENCE();
    ldsp IT1 = LT, IT2 = LT + 8192;
    {
        bf16* Ub = (bf16*)(ws + WS_UB) + (size_t)item * 8192;
        s16x8 tf[4][2];
#pragma unroll
        for (int mt = 0; mt < 4; ++mt)
#pragma unroll
            for (int ks = 0; ks < 2; ++ks) tf[mt][ks] = frag_row_p<128>(IT1, 16 * mt, 32 * ks, lane);
#pragma unroll
        for (int nt = 0; nt < 8; ++nt) { const s16x8 v0 = frag_tr_p<256>(IVd, 0, 16 * nt, lane), v1 = frag_tr_p<256>(IVd, 32, 16 * nt, lane);
#pragma unroll
            for (int mt = 0; mt < 4; ++mt) { f32x4 acc = (f32x4){0.f, 0.f, 0.f, 0.f}; acc = mfma16(tf[mt][0], v0, acc); acc = mfma16(tf[mt][1], v1, acc);
                *(unsigned long long*)(Ub + (size_t)(16 * nt + n_) * 64 + 16 * mt + 4 * q_) = pk4(acc); } }
    }
    {
        bf16* Wn = (bf16*)(ws + WS_WN) + (size_t)item * 8192;
        s16x8 tf[4][2];
#pragma unroll
        for (int nt = 0; nt < 4; ++nt)
#pragma unroll
            for (int ks = 0; ks < 2; ++ks) tf[nt][ks] = frag_row_p<128>(IT2, 16 * nt, 32 * ks, lane);
#pragma unroll
        for (int mt = 0; mt < 8; ++mt) { const s16x8 k0 = frag_tr_p<256>(IKd, 0, 16 * mt, lane), k1 = frag_tr_p<256>(IKd, 32, 16 * mt, lane);
            if (z == 0) { bf16* KT = (bf16*)(ws + WS_KT) + ((size_t)(h * 256 + cn) * 128 + 16 * mt + n_) * 64 + 8 * q_; *(s16x8*)KT = k0; *(s16x8*)(KT + 32) = k1; }
#pragma unroll
            for (int nt = 0; nt < 4; ++nt) { f32x4 acc = (f32x4){0.f, 0.f, 0.f, 0.f}; acc = mfma16(k0, tf[nt][0], acc); acc = mfma16(k1, tf[nt][1], acc);
                *(unsigned long long*)(Wn + (size_t)(16 * nt + n_) * 128 + 16 * mt + 4 * q_) = pk4(acc); } }
    }
    LDS_WAIT(); CFENCE();
}
DI s16x8 pack_cpair_rev(const f32x4& lo, const f32x4& hi) { v4u p; p.x = pk2(lo[3], lo[2]); p.y = pk2(lo[1], lo[0]); p.z = pk2(hi[3], hi[2]); p.w = pk2(hi[1], hi[0]); return __builtin_bit_cast(s16x8, p); }
DI unsigned long long rev4(unsigned long long x) { return (x >> 48) | ((x >> 16) & 0xffff0000ull) | ((x << 16) & 0xffff00000000ull) | (x << 48); }
DI void dn_pass2_wave(unsigned char* ws, int w  , int lane) {
    const int z = w >> 5, h = (w >> 3) & 3, vs = w & 7;
    const int n_ = lane & 15, q_ = lane >> 4;
    f32x4 S[8];
#pragma unroll
    for (int kt = 0; kt < 8; ++kt) S[kt] = (f32x4){0.f, 0.f, 0.f, 0.f};
    for (int c = 0; c < 256; ++c) {
        const int item = (z * 4 + h) * 256 + c, cn = z ? 255 - c : c;
        const bf16* Wn = (const bf16*)(ws + WS_WN) + (size_t)item * 8192; const bf16* Ub = (const bf16*)(ws + WS_UB) + (size_t)item * 8192;
        const float* gcu = (const float*)(ws + WS_GC) + (size_t)item * 64;
        const bf16* KT = (const bf16*)(ws + WS_KT) + (size_t)(h * 256 + cn) * 128 * 64;
        bf16* Sst = (bf16*)(ws + WS_SST) + (size_t)item * 16384;
        f32x4 u[4], gv[4];
#pragma unroll
        for (int mt = 0; mt < 4; ++mt) { u[mt] = unpk4(*(const unsigned long long*)(Ub + (size_t)(16 * vs + n_) * 64 + 16 * mt + 4 * q_)); gv[mt] = *(const f32x4*)(gcu + 16 * mt + 4 * q_); }
        const float gl = gcu[63];
        unsigned long long wa[4][4][2], ka[8][2][2];
#pragma unroll
        for (int mt = 0; mt < 4; ++mt)
#pragma unroll
            for (int ks = 0; ks < 4; ++ks) { const bf16* row = Wn + (size_t)(16 * mt + n_) * 128 + 32 * ks + 4 * q_; wa[mt][ks][0] = *(const unsigned long long*)row; wa[mt][ks][1] = *(const unsigned long long*)(row + 16); }
#pragma unroll
        for (int kt = 0; kt < 8; ++kt)
#pragma unroll
            for (int ks = 0; ks < 2; ++ks) { const bf16* row = KT + (size_t)(16 * kt + n_) * 64;
                if (z == 0) { ka[kt][ks][0] = *(const unsigned long long*)(row + 32 * ks + 4 * q_); ka[kt][ks][1] = *(const unsigned long long*)(row + 32 * ks + 16 + 4 * q_); }
                else { ka[kt][ks][0] = rev4(*(const unsigned long long*)(row + 60 - 32 * ks - 4 * q_)); ka[kt][ks][1] = rev4(*(const unsigned long long*)(row + 44 - 32 * ks - 4 * q_)); } }
#pragma unroll
        for (int kt = 0; kt < 8; ++kt) *(unsigned long long*)(Sst + (size_t)(16 * vs + n_) * 128 + 16 * kt + 4 * q_) = pk4(S[kt]);
#pragma unroll
        for (int ks = 0; ks < 4; ++ks) { const s16x8 b = pack_cpair(S[2 * ks], S[2 * ks + 1]);
#pragma unroll
            for (int mt = 0; mt < 4; ++mt) { v4u a; a.x = (unsigned)wa[mt][ks][0]; a.y = (unsigned)(wa[mt][ks][0] >> 32); a.z = (unsigned)wa[mt][ks][1]; a.w = (unsigned)(wa[mt][ks][1] >> 32);
                u[mt] = mfma16(__builtin_bit_cast(s16x8, a), b, u[mt]); } }
#pragma unroll
        for (int mt = 0; mt < 4; ++mt)
#pragma unroll
            for (int e = 0; e < 4; ++e) u[mt][e] *= __expf(gl - gv[mt][e]);
        const float egl = __expf(gl);
        const s16x8 b0 = pack_cpair(u[0], u[1]), b1 = pack_cpair(u[2], u[3]);
#pragma unroll
        for (int kt = 0; kt < 8; ++kt) { f32x4 acc = S[kt] * egl;
            { v4u a; a.x = (unsigned)ka[kt][0][0]; a.y = (unsigned)(ka[kt][0][0] >> 32); a.z = (unsigned)ka[kt][0][1]; a.w = (unsigned)(ka[kt][0][1] >> 32); acc = mfma16(__builtin_bit_cast(s16x8, a), b0, acc); }
            { v4u a; a.x = (unsigned)ka[kt][1][0]; a.y = (unsigned)(ka[kt][1][0] >> 32); a.z = (unsigned)ka[kt][1][1]; a.w = (unsigned)(ka[kt][1][1] >> 32); acc = mfma16(__builtin_bit_cast(s16x8, a), b1, acc); }
            S[kt] = acc; }
    }
}
DI void dn_pass3_item(unsigned char* ws, int item, int lane) {
    asm volatile("" : "+v"(lane));
    const int z = item >> 10, h = (item >> 8) & 3, c = item & 255, cn = z ? 255 - c : c;
    const int n_ = lane & 15, q_ = lane >> 4;
    const bf16* Q = (const bf16*)(ws + WS_QD);
    const bf16* Wn = (const bf16*)(ws + WS_WN) + (size_t)item * 8192; const bf16* Ub = (const bf16*)(ws + WS_UB) + (size_t)item * 8192;
    const bf16* At = (const bf16*)(ws + WS_AT) + (size_t)item * 4096; const float* gcu = (const float*)(ws + WS_GC) + (size_t)item * 64;
    const bf16* Sst = (const bf16*)(ws + WS_SST) + (size_t)item * 16384;
    bf16* O = (bf16*)(ws + (z ? WS_O1 : WS_O0));
    s16x8 wf[4][4], qf[4][4]; unsigned long long af[4][2][2]; float eg[4];
#pragma unroll
    for (int t = 0; t < 4; ++t) {
        const bf16* qrow = Q + (size_t)tok_of(z, cn, 16 * t + n_) * 512 + h * 128 + 8 * q_;
#pragma unroll
        for (int ks = 0; ks < 4; ++ks) { wf[t][ks] = *(const s16x8*)(Wn + (size_t)(16 * t + n_) * 128 + 32 * ks + 8 * q_); qf[t][ks] = *(const s16x8*)(qrow + 32 * ks); }
#pragma unroll
        for (int ks = 0; ks < 2; ++ks) { const bf16* arow = At + (size_t)(16 * t + n_) * 64 + 32 * ks + 4 * q_; af[t][ks][0] = *(const unsigned long long*)arow; af[t][ks][1] = *(const unsigned long long*)(arow + 16); }
        eg[t] = __expf(gcu[16 * t + n_]);
    }
#pragma unroll
    for (int mt = 0; mt < 8; ++mt) {
        s16x8 sf[4];
#pragma unroll
        for (int ks = 0; ks < 4; ++ks) sf[ks] = *(const s16x8*)(Sst + (size_t)(16 * mt + n_) * 128 + 32 * ks + 8 * q_);
        f32x4 u[4];
#pragma unroll
        for (int jt = 0; jt < 4; ++jt) { u[jt] = unpk4(*(const unsigned long long*)(Ub + (size_t)(16 * mt + n_) * 64 + 16 * jt + 4 * q_));
#pragma unroll
            for (int ks = 0; ks < 4; ++ks) u[jt] = mfma16(wf[jt][ks], sf[ks], u[jt]); }
        const s16x8 ua0 = pack_cpair(u[0], u[1]), ua1 = pack_cpair(u[2], u[3]);
#pragma unroll
        for (int nt = 0; nt < 4; ++nt) {
            f32x4 acc = (f32x4){0.f, 0.f, 0.f, 0.f};
#pragma unroll
            for (int ks = 0; ks < 4; ++ks) acc = mfma16(sf[ks], qf[nt][ks], acc);
            acc = acc * eg[nt];
            { v4u b; b.x = (unsigned)af[nt][0][0]; b.y = (unsigned)(af[nt][0][0] >> 32); b.z = (unsigned)af[nt][0][1]; b.w = (unsigned)(af[nt][0][1] >> 32); acc = mfma16(ua0, __builtin_bit_cast(s16x8, b), acc); }
            { v4u b; b.x = (unsigned)af[nt][1][0]; b.y = (unsigned)(af[nt][1][0] >> 32); b.z = (unsigned)af[nt][1][1]; b.w = (unsigned)(af[nt][1][1] >> 32); acc = mfma16(ua1, __builtin_bit_cast(s16x8, b), acc); }
            *(unsigned long long*)(O + (size_t)tok_of(z, cn, 16 * nt + n_) * 512 + h * 128 + 16 * mt + 4 * q_) = pk4(acc);
        }
    }
}
constexpr int DN_SLOT = 41984, DN_GRP = 16;
constexpr size_t WS_MG = WS_END_OLD, WS_NG = WS_END_OLD + 4 * MiB, WS_SG = WS_END_OLD + 8 * MiB;
DI void dn_scan_block(unsigned char* ws, ldsp L, const int Z, const int MODE, int h, int hv, int g, int wave, int lane) {
    const int item0 = (Z * 4 + h) * 256, cb = g * DN_GRP, zhg = (Z * 4 + h) * 16 + g;
    if (wave >= 4) {
        const int lw = wave - 4;
        unsigned so[11], ld[11];
#pragma unroll
        for (int k = 0; k < 4; ++k) { const int pid = lw * 4 + k; const int row = 4 * pid + (lane >> 4), p = lane & 15, cch = p ^ (row & 15); so[k] = row * 256 + cch * 16; ld[k] = pid * 1024 + lane * 16; }
#pragma unroll
        for (int k = 0; k < 4; ++k) { const int pid = lw * 4 + k; const int row = 8 * pid + (lane >> 3), p = lane & 7, cch = p ^ (row & 7); so[4 + k] = row * 128 + cch * 16; ld[4 + k] = 16384 + pid * 1024 + lane * 16; }
#pragma unroll
        for (int k = 0; k < 2; ++k) { const int pid = lw * 2 + k; const int row = 8 * pid + (lane >> 3), p = lane & 7, cch = p ^ (row & 7); so[8 + k] = row * 128 + cch * 16; ld[8 + k] = 32768 + pid * 1024 + lane * 16; }
        so[10] = lane * 16; ld[10] = 40960 + lane * 16;
        v4u rA[11], rB[11];
#define DN_GLOAD(R, ss) do { const int s_ = (ss) < DN_GRP ? (ss) : DN_GRP - 1; const int c_ = cb + s_; const int cn_ = Z ? 255 - c_ : c_; \
            const char* wsrc = (const char*)((const bf16*)(ws + WS_WN) + (size_t)(item0 + c_) * 8192); const char* ksrc = (const char*)((const bf16*)(ws + WS_KT) + (size_t)(h * 256 + cn_) * 8192); \
            const char* usrc = (const char*)((const bf16*)(ws + WS_UB) + (size_t)(item0 + c_) * 8192 + hv * 4096); const char* gsrc = (const char*)((const float*)(ws + WS_GC) + (size_t)(item0 + c_) * 64); \
            _Pragma("unroll") for (int k = 0; k < 4; ++k) R[k] = *(const v4u*)(wsrc + so[k]); \
            _Pragma("unroll") for (int k = 4; k < 8; ++k) R[k] = *(const v4u*)(ksrc + so[k]); \
            _Pragma("unroll") for (int k = 8; k < 10; ++k) R[k] = *(const v4u*)(usrc + so[k]); \
            if (lw == 0) R[10] = *(const v4u*)(gsrc + so[10]); } while (0)
#define DN_LWRITE(R, ss) do { ldsp slot = L + ((ss) % 3) * DN_SLOT; \
            _Pragma("unroll") for (int k = 0; k < 10; ++k) *(LAS v4u*)(slot + ld[k]) = R[k]; \
            if (lw == 0) *(LAS v4u*)(slot + ld[10]) = R[10]; } while (0)
        DN_GLOAD(rA, 0); DN_GLOAD(rB, 1); DN_LWRITE(rA, 0); DN_LWRITE(rB, 1);
        DN_GLOAD(rA, 2); DN_GLOAD(rB, 3);
#define DN_LSTEP(R, ss) do { asm volatile("s_waitcnt lgkmcnt(0)" ::: "memory"); __builtin_amdgcn_s_barrier(); asm volatile("" ::: "memory"); \
            DN_LWRITE(R, (ss) + 2); DN_GLOAD(R, (ss) + 4); } while (0)
        for (int s2 = 0; s2 < DN_GRP; s2 += 2) { DN_LSTEP(rA, s2); DN_LSTEP(rB, s2 + 1); }
#undef DN_LSTEP
#undef DN_LWRITE
#undef DN_GLOAD
        asm volatile("s_waitcnt vmcnt(0) lgkmcnt(0)" ::: "memory");
        return;
    }
    const int vs = 4 * hv + wave;
    const int n_ = lane & 15, q_ = lane >> 4, wbyte = (q_ & 1) * 8, sw = n_ & 7;
    int kao[2][2];
#pragma unroll
    for (int ks = 0; ks < 2; ++ks) { const int r0 = Z ? 60 - 32 * ks - 4 * q_ : 32 * ks + 4 * q_, r1 = Z ? r0 - 16 : r0 + 16; kao[ks][0] = (((r0 >> 3) ^ sw) * 16) + (r0 & 7) * 2; kao[ks][1] = (((r1 >> 3) ^ sw) * 16) + (r1 & 7) * 2; }
    const float ubm = MODE == 2 ? 0.f : 1.f;
    f32x4 S[8];
    if (MODE == 0) { const bf16* SG = (const bf16*)(ws + WS_SG) + (size_t)zhg * 16384;
#pragma unroll
        for (int kt = 0; kt < 8; ++kt) S[kt] = unpk4(*(const unsigned long long*)(SG + (size_t)(16 * vs + n_) * 128 + 16 * kt + 4 * q_)); }
    else {
#pragma unroll
        for (int kt = 0; kt < 8; ++kt)
#pragma unroll
            for (int e = 0; e < 4; ++e) S[kt][e] = (MODE == 2 && (16 * kt + 4 * q_ + e) == (16 * vs + n_)) ? 1.f : 0.f; }
    for (int s = 0; s < DN_GRP; ++s) {
        const int c = cb + s;
        if (MODE == 0) { bf16* Sst = (bf16*)(ws + WS_SST) + (size_t)(item0 + c) * 16384;
#pragma unroll
            for (int kt = 0; kt < 8; ++kt) *(unsigned long long*)(Sst + (size_t)(16 * vs + n_) * 128 + 16 * kt + 4 * q_) = pk4(S[kt]); }
        asm volatile("s_waitcnt lgkmcnt(0)" ::: "memory");
        __builtin_amdgcn_s_barrier();
        asm volatile("" ::: "memory");
        ldsp slot = L + (s % 3) * DN_SLOT;
        f32x4 u[4], gv[4]; unsigned long long wa[4][4][2], ka[8][2][2];
        { ldsp urow = slot + 32768 + (16 * wave + n_) * 128 + wbyte;
#pragma unroll
          for (int mt = 0; mt < 4; ++mt) { u[mt] = unpk4(*(LAS const unsigned long long*)(urow + (((2 * mt + (q_ >> 1)) ^ sw) * 16))) * ubm; gv[mt] = *(LAS const f32x4*)(slot + 40960 + (16 * mt + 4 * q_) * 4); } }
        const float gl = *(LAS const float*)(slot + 40960 + 63 * 4);
#pragma unroll
        for (int ks = 0; ks < 4; ++ks)
#pragma unroll
            for (int mt = 0; mt < 4; ++mt) { ldsp row = slot + (16 * mt + n_) * 256 + wbyte; const int c0 = 4 * ks + (q_ >> 1);
                wa[mt][ks][0] = *(LAS const unsigned long long*)(row + ((c0 ^ n_) * 16)); wa[mt][ks][1] = *(LAS const unsigned long long*)(row + (((c0 + 2) ^ n_) * 16)); }
        __builtin_amdgcn_sched_barrier(0);
#pragma unroll
        for (int ks = 0; ks < 4; ++ks) { const s16x8 bb = pack_cpair(S[2 * ks], S[2 * ks + 1]);
#pragma unroll
            for (int mt = 0; mt < 4; ++mt) { v4u a; a.x = (unsigned)wa[mt][ks][0]; a.y = (unsigned)(wa[mt][ks][0] >> 32); a.z = (unsigned)wa[mt][ks][1]; a.w = (unsigned)(wa[mt][ks][1] >> 32);
                u[mt] = mfma16(__builtin_bit_cast(s16x8, a), bb, u[mt]); } }
        __builtin_amdgcn_sched_barrier(0);
#pragma unroll
        for (int kt = 0; kt < 8; ++kt) { ldsp row = slot + 16384 + (16 * kt + n_) * 128;
#pragma unroll
            for (int ks = 0; ks < 2; ++ks) { ka[kt][ks][0] = *(LAS const unsigned long long*)(row + kao[ks][0]); ka[kt][ks][1] = *(LAS const unsigned long long*)(row + kao[ks][1]); } }
        __builtin_amdgcn_sched_barrier(0);
#pragma unroll
        for (int mt = 0; mt < 4; ++mt)
#pragma unroll
            for (int e = 0; e < 4; ++e) u[mt][e] *= __expf(gl - gv[mt][e]);
        const float egl = __expf(gl);
#pragma unroll
        for (int mt = 0; mt < 4; ++mt) { const f32x4 t = u[mt]; u[mt][0] = Z ? t[3] : t[0]; u[mt][1] = Z ? t[2] : t[1]; u[mt][2] = Z ? t[1] : t[2]; u[mt][3] = Z ? t[0] : t[3]; }
        const s16x8 b0 = pack_cpair(u[0], u[1]), b1 = pack_cpair(u[2], u[3]);
#pragma unroll
        for (int kt = 0; kt < 8; ++kt) { f32x4 acc = S[kt] * egl;
#pragma unroll
            for (int ks = 0; ks < 2; ++ks) { const unsigned long long a0 = ka[kt][ks][0], a1 = ka[kt][ks][1];
                v4u a; a.x = (unsigned)a0; a.y = (unsigned)(a0 >> 32); a.z = (unsigned)a1; a.w = (unsigned)(a1 >> 32);
                acc = mfma16(__builtin_bit_cast(s16x8, a), ks == 0 ? b0 : b1, acc); }
            S[kt] = acc; }
    }
    if (MODE == 1) { bf16* NG = (bf16*)(ws + WS_NG) + (size_t)zhg * 16384;
#pragma unroll
        for (int kt = 0; kt < 8; ++kt) *(unsigned long long*)(NG + (size_t)(16 * vs + n_) * 128 + 16 * kt + 4 * q_) = pk4(S[kt]); }
    if (MODE == 2) { bf16* MG = (bf16*)(ws + WS_MG) + (size_t)zhg * 16384;
#pragma unroll
        for (int kt = 0; kt < 8; ++kt)
#pragma unroll
            for (int e = 0; e < 4; ++e) MG[(size_t)(16 * kt + 4 * q_ + e) * 128 + 16 * vs + n_] = (bf16)f2bf(S[kt][e]); }
}
DI void dn_scan_groups(unsigned char* ws, int w  , int lane) {
    const int zh = w >> 3, vs = w & 7, n_ = lane & 15, q_ = lane >> 4;
    f32x4 S[8];
#pragma unroll
    for (int kt = 0; kt < 8; ++kt) S[kt] = (f32x4){0.f, 0.f, 0.f, 0.f};
    for (int g = 0; g < 16; ++g) {
        const size_t zhg = (size_t)(zh * 16 + g) * 16384;
        bf16* SG = (bf16*)(ws + WS_SG) + zhg; const bf16* MG = (const bf16*)(ws + WS_MG) + zhg; const bf16* NG = (const bf16*)(ws + WS_NG) + zhg;
#pragma unroll
        for (int kt = 0; kt < 8; ++kt) *(unsigned long long*)(SG + (size_t)(16 * vs + n_) * 128 + 16 * kt + 4 * q_) = pk4(S[kt]);
        if (g == 15) break;
        s16x8 bb[4];
#pragma unroll
        for (int ks = 0; ks < 4; ++ks) bb[ks] = pack_cpair(S[2 * ks], S[2 * ks + 1]);
#pragma unroll
        for (int kt = 0; kt < 8; ++kt) { f32x4 acc = unpk4(*(const unsigned long long*)(NG + (size_t)(16 * vs + n_) * 128 + 16 * kt + 4 * q_));
#pragma unroll
            for (int ks = 0; ks < 4; ++ks) { const bf16* row = MG + (size_t)(16 * kt + n_) * 128 + 32 * ks + 4 * q_;
                const unsigned long long a0 = *(const unsigned long long*)row, a1 = *(const unsigned long long*)(row + 16);
                v4u a; a.x = (unsigned)a0; a.y = (unsigned)(a0 >> 32); a.z = (unsigned)a1; a.w = (unsigned)(a1 >> 32);
                acc = mfma16(__builtin_bit_cast(s16x8, a), bb[ks], acc); }
            S[kt] = acc; }
    }
}
DI void prep1_token(const Args& a, unsigned char* ws, int t, int lane) {
    const bf16* P = (const bf16*)(ws + WS_PROJ1) + (size_t)t * ODD_PAD;
    const int c0 = 8 * lane; const bool hp = t > 0, hn = t < S_ - 1;
    float z8[8];
#pragma unroll
    for (int i = 0; i < 8; ++i) z8[i] = 0.f;
    {
        float cb[8], cc[8], cx[8], pc[8], px[8], nc[8], nx[8], w0[8], w1[8], w2[8], o[8];
        ld8(P + c0, cb); ld8(P + 512 + c0, cc); ld8(P + 1024 + c0, cx);
        if (hp) { ld8(P - ODD_PAD + 512 + c0, pc); ld8(P - ODD_PAD + 1024 + c0, px); } else {
#pragma unroll
            for (int i = 0; i < 8; ++i) { pc[i] = 0.f; px[i] = 0.f; } }
        if (hn) { ld8(P + ODD_PAD + 512 + c0, nc); ld8(P + ODD_PAD + 1024 + c0, nx); } else {
#pragma unroll
            for (int i = 0; i < 8; ++i) { nc[i] = 0.f; nx[i] = 0.f; } }
        ld8f(a.in[28] + c0, w0); ld8f(a.in[28] + 512 + c0, w1); ld8f(a.in[28] + 1024 + c0, w2);
#pragma unroll
        for (int i = 0; i < 8; ++i) o[i] = cb[i] * (w0[i] * pc[i] * px[i] + w1[i] * cc[i] * cx[i] + w2[i] * nc[i] * nx[i]);
        st8((bf16*)(ws + WS_YCAT1) + (size_t)t * D_ + c0, o);
    }
#pragma unroll
    for (int part = 0; part < 3; ++part) {
        float cu[8], pv[8], nx[8], w0[8], w1[8], w2[8], o[8];
        const int col = 1536 + part * 512 + c0;
        ld8(P + col, cu);
        if (hp) ld8(P - ODD_PAD + col, pv); else {
#pragma unroll
            for (int i = 0; i < 8; ++i) pv[i] = 0.f; }
        if (hn) ld8(P + ODD_PAD + col, nx); else {
#pragma unroll
            for (int i = 0; i < 8; ++i) nx[i] = 0.f; }
        const float* cw = a.in[29] + part * 512 + c0;
        ld8f(cw, w0); ld8f(cw + 1536, w1); ld8f(cw + 3072, w2);
        float ss = 0.f;
#pragma unroll
        for (int i = 0; i < 8; ++i) { o[i] = siluf_(w0[i] * pv[i] + w1[i] * cu[i] + w2[i] * nx[i]); ss += o[i] * o[i]; }
        if (part < 2) { ss = grp_sum<16>(ss); const float rn = (1.0f / sqrtf(ss + 1e-6f)) * (part == 0 ? 0.08838834764831845f : 1.0f);
#pragma unroll
            for (int i = 0; i < 8; ++i) o[i] *= rn; }
        st8((bf16*)(ws + (part == 0 ? WS_QD : (part == 1 ? WS_KD : WS_VD))) + (size_t)t * 512 + c0, o);
    }
    *(v4u*)((bf16*)(ws + WS_YCAT1) + (size_t)t * D_ + 512 + c0) = *(const v4u*)(P + 3072 + c0);
    if (lane < 8) {
        const float bt = sigmoidf_(bf2f(P[3584 + lane])); const float al = bf2f(P[3592 + lane]);
        const float g = -__expf(a.in[30][lane]) * softplusf_(al + a.in[31][lane]);
        ((float*)(ws + WS_GB))[(size_t)t * 8 + lane] = g; ((float*)(ws + WS_GB + 512 * 1024))[(size_t)t * 8 + lane] = bt;
    }
}
DI void dn_scan_naive(unsigned char* ws, int w  , int lane) {
    const int z = w >> 9, h = (w >> 7) & 3, vc = w & 127;
    const bf16* Q = (const bf16*)(ws + WS_QD); const bf16* K = (const bf16*)(ws + WS_KD); const bf16* V = (const bf16*)(ws + WS_VD);
    const float* G = (const float*)(ws + WS_GB); const float* Bt = (const float*)(ws + WS_GB + 512 * 1024);
    bf16* O = (bf16*)(ws + (z ? WS_O1 : WS_O0));
    float s0 = 0.f, s1 = 0.f;
    int t = z ? S_ - 1 : 0; const int dt = z ? -1 : 1;
    size_t o = (size_t)t * 512 + h * 128;
    float k0 = bf2f(K[o + lane]), k1 = bf2f(K[o + 64 + lane]), q0 = bf2f(Q[o + lane]), q1 = bf2f(Q[o + 64 + lane]), vv = bf2f(V[o + vc]), g = G[(size_t)t * 8 + z * 4 + h], bt = Bt[(size_t)t * 8 + z * 4 + h];
    for (int s = 0; s < S_; ++s) {
        const int tn = (s + 1 < S_) ? t + dt : t; const size_t on = (size_t)tn * 512 + h * 128;
        const float k0n = bf2f(K[on + lane]), k1n = bf2f(K[on + 64 + lane]), q0n = bf2f(Q[on + lane]), q1n = bf2f(Q[on + 64 + lane]), vvn = bf2f(V[on + vc]), gn = G[(size_t)tn * 8 + z * 4 + h], btn = Bt[(size_t)tn * 8 + z * 4 + h];
        const float eg = __expf(g);
        const float dot = wave_sum(k0 * s0 + k1 * s1);
        const float cf = bt * (vv - eg * dot);
        s0 = eg * s0 + cf * k0; s1 = eg * s1 + cf * k1;
        const float ov = wave_sum(q0 * s0 + q1 * s1);
        if (lane == 0) O[(size_t)t * 512 + h * 128 + vc] = (bf16)f2bf(ov);
        k0 = k0n; k1 = k1n; q0 = q0n; q1 = q1n; vv = vvn; g = gn; bt = btn; t = tn;
    }
}
DI void dn_post_token(const Args& a, unsigned char* ws, int t, int lane) {
    const int c0 = 8 * lane; const size_t o = (size_t)t * 512 + c0;
    float o0[8], o1[8], zz[8], nw[8];
    ld8((const bf16*)(ws + WS_O0) + o, o0); ld8((const bf16*)(ws + WS_O1) + o, o1);
    ld8((const bf16*)(ws + WS_YCAT1) + (size_t)t * D_ + 512 + c0, zz); ld8f(a.in[32] + (c0 & 127), nw);
    float ss = 0.f;
#pragma unroll
    for (int i = 0; i < 8; ++i) { o0[i] += o1[i]; ss += o0[i] * o0[i]; }
    const float rs = 1.0f / sqrtf(grp_sum<16>(ss) * (1.0f / 128.f) + 1e-6f);
#pragma unroll
    for (int i = 0; i < 8; ++i) o0[i] = o0[i] * rs * nw[i] * siluf_(zz[i]);
    st8((bf16*)(ws + WS_YCAT1) + (size_t)t * D_ + 512 + c0, o0);
}
struct TokInfo { int e1, e2, s1, s2; float p1, p2; int pad0, pad1; };
struct RouterRegs { f32x4 r0[16], r1[16]; f32x4 w[4]; };
DI void route_load(const Args& a, RouterRegs& R, int lane) {
#pragma unroll
    for (int j = 0; j < 4; ++j) { R.w[j] = ((const f32x4*)a.in[34])[lane + 64 * j];
#pragma unroll
        for (int i = 0; i < 4; ++i) { const float* rr = a.in[35] + (size_t)(4 * lane + 256 * j + i) * 8; R.r0[4 * j + i] = *(const f32x4*)rr; R.r1[4 * j + i] = *(const f32x4*)(rr + 4); } }
}
DI void route_token(const RouterRegs& R, unsigned char* ws, const float* x3, int t, int lane) {
    f32x4 v[4]; load_row(x3, t, lane, v); const float rs = row_rstd(v);
    float lg[8];
#pragma unroll
    for (int e = 0; e < 8; ++e) lg[e] = 0.f;
#pragma unroll
    for (int j = 0; j < 4; ++j)
#pragma unroll
        for (int i = 0; i < 4; ++i) { const float hv = v[j][i] * rs * R.w[j][i]; const f32x4 r0 = R.r0[4 * j + i], r1 = R.r1[4 * j + i];
            lg[0] += hv * r0.x; lg[1] += hv * r0.y; lg[2] += hv * r0.z; lg[3] += hv * r0.w; lg[4] += hv * r1.x; lg[5] += hv * r1.y; lg[6] += hv * r1.z; lg[7] += hv * r1.w; }
#pragma unroll
    for (int e = 0; e < 8; ++e) lg[e] = wave_sum(lg[e]);
    if (lane == 0) {
        int e1 = 0; float m1 = lg[0];
#pragma unroll
        for (int e = 1; e < 8; ++e) if (lg[e] > m1) { m1 = lg[e]; e1 = e; }
        int e2 = -1; float m2 = -3.0e38f;
#pragma unroll
        for (int e = 0; e < 8; ++e) if (e != e1 && lg[e] > m2) { m2 = lg[e]; e2 = e; }
        const float x2 = __expf(m2 - m1); const float p1 = 1.0f / (1.0f + x2), p2 = x2 / (1.0f + x2);
        unsigned* cnt = (unsigned*)(ws + WS_CTL) + CW_CNT;
        TokInfo ti; ti.e1 = e1; ti.e2 = e2; ti.s1 = (int)atomicAdd(cnt + e1, 1u); ti.s2 = (int)atomicAdd(cnt + e2, 1u); ti.p1 = p1; ti.p2 = p2; ti.pad0 = 0; ti.pad1 = 0;
        ((TokInfo*)(ws + WS_TOK))[t] = ti;
    }
}
DI void moe_offsets(const unsigned char* ws, int (&off)[9]) {
    const unsigned* cnt = (const unsigned*)(ws + WS_CTL) + CW_CNT; int o = 0;
#pragma unroll
    for (int e = 0; e < 8; ++e) { off[e] = o; const int c = (int)__hip_atomic_load(cnt + e, __ATOMIC_RELAXED, __HIP_MEMORY_SCOPE_AGENT); o += (c + 255) & ~255; }
    off[8] = o;
}
DI void gather_token(const Args& a, unsigned char* ws, const float* x3, const int (&off)[9], int t, int lane) {
    f32x4 v[4]; load_row(x3, t, lane, v); const float rs = row_rstd(v);
#pragma unroll
    for (int j = 0; j < 4; ++j) v[j] = v[j] * rs * ((const f32x4*)a.in[34])[lane + 64 * j];
    const TokInfo ti = ((const TokInfo*)(ws + WS_TOK))[t];
    int o1 = 0, o2 = 0;
#pragma unroll
    for (int e = 0; e < 8; ++e) { if (ti.e1 == e) o1 = off[e]; if (ti.e2 == e) o2 = off[e]; }
    bf16* A = (bf16*)(ws + WS_AMOE);
    store_row_bf16(A + (size_t)(o1 + ti.s1) * D_, lane, v); store_row_bf16(A + (size_t)(o2 + ti.s2) * D_, lane, v);
}
DI void combine_token(unsigned char* ws, float* out, const int (&off)[9], int t, int lane) {
    const TokInfo ti = ((const TokInfo*)(ws + WS_TOK))[t];
    int o1 = 0, o2 = 0;
#pragma unroll
    for (int e = 0; e < 8; ++e) { if (ti.e1 == e) o1 = off[e]; if (ti.e2 == e) o2 = off[e]; }
    const bf16* A = (const bf16*)(ws + WS_AMOE);
    const unsigned long long* r1 = (const unsigned long long*)(A + (size_t)(o1 + ti.s1) * D_) + lane; const unsigned long long* r2 = (const unsigned long long*)(A + (size_t)(o2 + ti.s2) * D_) + lane;
    f32x4* xo = (f32x4*)(out + (size_t)t * D_) + lane;
#pragma unroll
    for (int j = 0; j < 4; ++j) { const unsigned long long a1 = r1[64 * j], a2 = r2[64 * j]; f32x4 x = xo[64 * j];
        x.x += ti.p1 * bflo((unsigned)a1) + ti.p2 * bflo((unsigned)a2); x.y += ti.p1 * bfhi((unsigned)a1) + ti.p2 * bfhi((unsigned)a2);
        x.z += ti.p1 * bflo((unsigned)(a1 >> 32)) + ti.p2 * bflo((unsigned)(a2 >> 32)); x.w += ti.p1 * bfhi((unsigned)(a1 >> 32)) + ti.p2 * bfhi((unsigned)(a2 >> 32));
        xo[64 * j] = x; }
}
#ifndef PROBE
#define PROBE 0
#endif
#ifndef PROBE_REP
#define PROBE_REP (-1)
#endif
#ifndef PH_MASK
#define PH_MASK 0xFFFFFFFFu
#endif
DI unsigned char* ptr_opaque(unsigned char* p) { GAS unsigned char* g = (GAS unsigned char*)p; asm volatile("" : "+s"(g)); return (unsigned char*)g; }
DI int lane_opaque() { int l; asm volatile("v_mbcnt_lo_u32_b32 %0, -1, 0\n\tv_mbcnt_hi_u32_b32 %0, -1, %0" : "=v"(l)); return l; }
__global__ void __launch_bounds__(512, 2) fwd_kernel(Args args) {
    extern __shared__ __attribute__((aligned(16))) unsigned char lds[];
    LAS unsigned char* L = (LAS unsigned char*)lds;
    volatile LAS unsigned* MISC = (volatile LAS unsigned*)(L + MISC_OFF);
    const int tid = threadIdx.x, lane0 = tid & 63, wave = __builtin_amdgcn_readfirstlane(tid >> 6);
    const int G = gridDim.x, bx = blockIdx.x;
    const int gw = bx * 8 + wave, NGW = G * 8;
    unsigned char* ws0 = args.ws;
    if (tid < 128) ((LAS unsigned*)(L + LDS_ZERO_OFF))[tid] = 0u;
    __syncthreads();
    XcdBarrier bar = xcd_barrier_post((unsigned*)(ws0 + WS_CTL) + CW_BAR, MISC + 8);
    LAS float* scr = (LAS float*)(L + wave * 16384);
#if PROBE
    int tsi = 0;
#define GRID_BAR() do { xcd_barrier(bar, wave == 0); if (bx == 0 && tid == 0) { ((unsigned*)(ws + WS_CTL))[512 + tsi] = (unsigned)__builtin_amdgcn_s_memrealtime(); } ++tsi; } while (0)
    if (bx == 0 && tid == 0) ((unsigned*)(ws + WS_CTL))[511] = (unsigned)__builtin_amdgcn_s_memrealtime();
#else
#define GRID_BAR() xcd_barrier(bar, wave == 0)
#endif

    if constexpr ((PH_MASK >> 0) & 1) {
    const int lane = lane_opaque(); unsigned char* const ws = ptr_opaque(args.ws);
    {
        const float* const* in = args.in;
        for (int it = gw; ; it += NGW) {
            int r = it;
            if (transpose_job(r, in[3], 1024, 3072, 3072, (bf16*)(ws + WS_WIN0), 0, 0, 0, scr, lane)) continue;
            if (transpose_job(r, in[9], 1024, 64, 64, (bf16*)(ws + WS_WL), 0, 0, 0, scr, lane)) continue;
            if (transpose_job(r, in[9] + 65536, 1024, 64, 64, (bf16*)(ws + WS_WL), 64, 0, 0, scr, lane)) continue;
            if (transpose_job(r, in[12], 1024, 64, 64, (bf16*)(ws + WS_WL), 128, 0, 0, scr, lane)) continue;
            if (transpose_job(r, in[12] + 65536, 1024, 64, 64, (bf16*)(ws + WS_WL), 192, 0, 0, scr, lane)) continue;
            if (transpose_job(r, in[14], 1024, 128, 256, (bf16*)(ws + WS_WL), 256, 0, 0, scr, lane)) continue;
            if (transpose_job(r, in[21], 1024, 1024, 1024, (bf16*)(ws + WS_WOUT0), 0, 0, 0, scr, lane)) continue;
            if (transpose_job(r, in[10], 64, 512, 512, (bf16*)(ws + WS_W2T), 0, 0, 0, scr, lane)) continue;
            if (transpose_job(r, in[10] + 32768, 64, 512, 512, (bf16*)(ws + WS_W2T) + 32768, 0, 0, 0, scr, lane)) continue;
            if (transpose_job(r, in[13], 64, 512, 512, (bf16*)(ws + WS_W2T) + 65536, 0, 0, 0, scr, lane)) continue;
            if (transpose_job(r, in[13] + 32768, 64, 512, 512, (bf16*)(ws + WS_W2T) + 98304, 0, 0, 0, scr, lane)) continue;
            if (transpose_job(r, in[15], 128, 512, 512, (bf16*)(ws + WS_W2T) + 131072, 0, 0, 0, scr, lane)) continue;
            break;
        }
        norm_rows(args.in[0], args.in[2], args.in[7], (bf16*)(ws + WS_H), (bf16*)(ws + WS_HX), gw, NGW, lane);
    }
    if constexpr (PROBE_REP == 0) {
    {
        const float* const* in = args.in;
        for (int it = gw; ; it += NGW) {
            int r = it;
            if (transpose_job(r, in[3], 1024, 3072, 3072, (bf16*)(ws + WS_WIN0), 0, 0, 0, scr, lane)) continue;
            if (transpose_job(r, in[9], 1024, 64, 64, (bf16*)(ws + WS_WL), 0, 0, 0, scr, lane)) continue;
            if (transpose_job(r, in[9] + 65536, 1024, 64, 64, (bf16*)(ws + WS_WL), 64, 0, 0, scr, lane)) continue;
            if (transpose_job(r, in[12], 1024, 64, 64, (bf16*)(ws + WS_WL), 128, 0, 0, scr, lane)) continue;
            if (transpose_job(r, in[12] + 65536, 1024, 64, 64, (bf16*)(ws + WS_WL), 192, 0, 0, scr, lane)) continue;
            if (transpose_job(r, in[14], 1024, 128, 256, (bf16*)(ws + WS_WL), 256, 0, 0, scr, lane)) continue;
            if (transpose_job(r, in[21], 1024, 1024, 1024, (bf16*)(ws + WS_WOUT0), 0, 0, 0, scr, lane)) continue;
            if (transpose_job(r, in[10], 64, 512, 512, (bf16*)(ws + WS_W2T), 0, 0, 0, scr, lane)) continue;
            if (transpose_job(r, in[10] + 32768, 64, 512, 512, (bf16*)(ws + WS_W2T) + 32768, 0, 0, 0, scr, lane)) continue;
            if (transpose_job(r, in[13], 64, 512, 512, (bf16*)(ws + WS_W2T) + 65536, 0, 0, 0, scr, lane)) continue;
            if (transpose_job(r, in[13] + 32768, 64, 512, 512, (bf16*)(ws + WS_W2T) + 98304, 0, 0, 0, scr, lane)) continue;
            if (transpose_job(r, in[15], 128, 512, 512, (bf16*)(ws + WS_W2T) + 131072, 0, 0, 0, scr, lane)) continue;
            break;
        }
        norm_rows(args.in[0], args.in[2], args.in[7], (bf16*)(ws + WS_H), (bf16*)(ws + WS_HX), gw, NGW, lane);
    }
    }
    GRID_BAR();
    }
    if constexpr (PROBE_REP == 50) { for (int i = 0; i < 10; ++i) GRID_BAR(); }
    if constexpr ((PH_MASK >> 1) & 1) {
    const int lane = lane_opaque(); unsigned char* const ws = ptr_opaque(args.ws);
    {
        { pg8::Gemm g{(const bf16*)(ws + WS_H), (const bf16*)(ws + WS_WIN0), S_, EVEN_IN, D_}; pg8::StaticOrder S; S.init(S_, EVEN_IN, G, bx);
          pg8::EpiStoreBf16 E{(bf16*)(ws + WS_PROJ0), EVEN_IN, 0, nullptr}; pg8::gemm_phase<pg8::EpiStoreBf16, pg8::StaticOrder, true, true>(L, g, S, E, wave); }
        { pg8::Gemm g{(const bf16*)(ws + WS_HX), (const bf16*)(ws + WS_WL), S_, LORA_N, D_}; pg8::StaticOrder S; S.init(S_, LORA_N, G, bx);
          pg8::EpiStoreBf16 E{(bf16*)(ws + WS_LORA), LORA_N, 0, nullptr}; pg8::gemm_phase<pg8::EpiStoreBf16, pg8::StaticOrder, true, true>(L, g, S, E, wave); }
        if constexpr (PROBE_REP == 1) {
        { pg8::Gemm g{(const bf16*)(ws + WS_H), (const bf16*)(ws + WS_WIN0), S_, EVEN_IN, D_}; pg8::StaticOrder S; S.init(S_, EVEN_IN, G, bx);
          pg8::EpiStoreBf16 E{(bf16*)(ws + WS_PROJ0), EVEN_IN, 0, nullptr}; pg8::gemm_phase<pg8::EpiStoreBf16, pg8::StaticOrder, true, true>(L, g, S, E, wave); }
        { pg8::Gemm g{(const bf16*)(ws + WS_HX), (const bf16*)(ws + WS_WL), S_, LORA_N, D_}; pg8::StaticOrder S; S.init(S_, LORA_N, G, bx);
          pg8::EpiStoreBf16 E{(bf16*)(ws + WS_LORA), LORA_N, 0, nullptr}; pg8::gemm_phase<pg8::EpiStoreBf16, pg8::StaticOrder, true, true>(L, g, S, E, wave); }
        }
    }
    GRID_BAR();
    }
    if constexpr ((PH_MASK >> 2) & 1) {
    const int lane = lane_opaque(); unsigned char* const ws = ptr_opaque(args.ws);
    for (int t = gw; t < S_; t += NGW) prep0_token(args, ws, scr, t, lane);
    if constexpr (PROBE_REP == 30) { for (int t = gw; t < S_; t += NGW) prep0_token(args, ws, scr, t, lane); }
    {
        const int hh = bx & 7, nbh = (G - hh + 7) >> 3;
        prep0_stage_w2t(ws, L, hh, wave * 64 + lane);
        LDS_WAIT(); __syncthreads();
        for (int u = wave; ; u += 8) { const int cn = (bx >> 3) + nbh * (u >> 2); if (cn >= 256) break; prep0_rwkv_unit(args, ws, L, 4 * cn + (u & 3), hh, lane); }
        if constexpr (PROBE_REP == 31) { for (int u = wave; ; u += 8) { const int cn = (bx >> 3) + nbh * (u >> 2); if (cn >= 256) break; prep0_rwkv_unit(args, ws, L, 4 * cn + (u & 3), hh, lane); } }
        asm volatile("s_waitcnt vmcnt(0)" ::: "memory");
        __syncthreads();
    }
    }
    if constexpr ((PH_MASK >> 3) & 1) {
    const int lane = lane_opaque(); unsigned char* const ws = ptr_opaque(args.ws);
    {
        if constexpr (PROBE_REP == 40) { if (wave < 2) { for (int it = bx * 2 + wave; it < 4096; it += G * 2) rwkv_pass1_item<true>(ws, L + wave * 65536, it, lane); } }
        if constexpr (PROBE_REP >= 41 && PROBE_REP <= 47) { if (wave < 2) { for (int it = bx * 2 + wave; it < 4096; it += G * 2) rwkv_pass1_item<true, PROBE_REP - 40>(ws, L + wave * 65536, it, lane); } }
        if (wave < 2) { const int hh = bx & 7, nbh = (G - hh + 7) >> 3;
            for (int u = wave; ; u += 2) { const int cn = (bx >> 3) + nbh * (u >> 1); if (cn >= 256) break; const int z = u & 1;
                rwkv_pass1_item(ws, L + wave * 65536, z * 2048 + hh * 256 + (z ? 255 - cn : cn), lane); } }
        else if (wave < 4) {
            const float* const* in = args.in; LAS float* scr2 = (LAS float*)(L + 131072 + (wave - 2) * 8448);
            for (int it = bx * 2 + (wave - 2); ; it += G * 2) {
                int r = it;
                if (transpose_job(r, in[23], 1024, FF0, FF0, (bf16*)(ws + WS_WGU0), 0, 128, 0, scr2, lane)) continue;
                if (transpose_job(r, in[24], 1024, FF0, FF0, (bf16*)(ws + WS_WGU0), 0, 128, 1, scr2, lane)) continue;
                if (transpose_job(r, in[25], FF0, 1024, 1024, (bf16*)(ws + WS_WD0), 0, 0, 0, scr2, lane)) continue;
                if (transpose_job(r, in[27], 1024, ODD_IN, ODD_PAD, (bf16*)(ws + WS_WIN1), 0, 0, 0, scr2, lane)) continue;
                if (transpose_job(r, in[33], 1024, 1024, 1024, (bf16*)(ws + WS_WOUT1), 0, 0, 0, scr2, lane)) continue;
                break;
            }
        }
    }
    GRID_BAR();
    if (bx < 16) { rwkv_pass2_block(ws, L, bx, wave, lane); __syncthreads(); if constexpr (PROBE_REP == 4) { rwkv_pass2_block(ws, L, bx, wave, lane); __syncthreads(); } }
    else { for (int rep_ = 0; rep_ < (PROBE_REP == 3 ? 2 : 1); ++rep_) for (int unit = bx - 16; unit < 512; unit += G - 16) attn_unit(ws, L, unit, wave, lane); }
    GRID_BAR();
    for (int it = gw; it < 2048; it += NGW) rwkv_pass3_post_item(args, ws, it, lane);
    GRID_BAR();
    }
    if constexpr ((PH_MASK >> 5) & 1) {
    const int lane = lane_opaque(); unsigned char* const ws = ptr_opaque(args.ws);
    { pg8::Gemm g{(const bf16*)(ws + WS_Y), (const bf16*)(ws + WS_WOUT0), S_, D_, D_}; pg8::StaticOrder S; S.init(S_, D_, G, bx);
      pg8::EpiResF32 E{args.in[0], args.out, D_, nullptr, nullptr}; pg8::gemm_phase<pg8::EpiResF32, pg8::StaticOrder, true, true>(L, g, S, E, wave); }
    if constexpr (PROBE_REP == 7) {
    { pg8::Gemm g{(const bf16*)(ws + WS_Y), (const bf16*)(ws + WS_WOUT0), S_, D_, D_}; pg8::StaticOrder S; S.init(S_, D_, G, bx);
      pg8::EpiResF32 E{args.in[0], args.out, D_, nullptr, nullptr}; pg8::gemm_phase<pg8::EpiResF32, pg8::StaticOrder, true, true>(L, g, S, E, wave); }
    }
    GRID_BAR();
    }
    if constexpr ((PH_MASK >> 6) & 1) {
    const int lane = lane_opaque(); unsigned char* const ws = ptr_opaque(args.ws);
    norm_rows(args.out, args.in[22], nullptr, (bf16*)(ws + WS_H2), nullptr, gw, NGW, lane);
    GRID_BAR();
    }
    if constexpr ((PH_MASK >> 7) & 1) {
    const int lane = lane_opaque(); unsigned char* const ws = ptr_opaque(args.ws);
    { pg8::Gemm g{(const bf16*)(ws + WS_H2), (const bf16*)(ws + WS_WGU0), S_, 2 * FF0, D_}; pg8::StaticOrder S; S.init(S_, 2 * FF0, G, bx);
      pg8::EpiSwiGLU E{(bf16*)(ws + WS_ACT0), FF0, 0, nullptr}; pg8::gemm_phase<pg8::EpiSwiGLU, pg8::StaticOrder, true, true>(L, g, S, E, wave); }
    if constexpr (PROBE_REP == 9) {
    { pg8::Gemm g{(const bf16*)(ws + WS_H2), (const bf16*)(ws + WS_WGU0), S_, 2 * FF0, D_}; pg8::StaticOrder S; S.init(S_, 2 * FF0, G, bx);
      pg8::EpiSwiGLU E{(bf16*)(ws + WS_ACT0), FF0, 0, nullptr}; pg8::gemm_phase<pg8::EpiSwiGLU, pg8::StaticOrder, true, true>(L, g, S, E, wave); }
    }
    GRID_BAR();
    }
    if constexpr ((PH_MASK >> 8) & 1) {
    const int lane = lane_opaque(); unsigned char* const ws = ptr_opaque(args.ws);
    { pg8::Gemm g{(const bf16*)(ws + WS_ACT0), (const bf16*)(ws + WS_WD0), S_, D_, FF0}; pg8::StaticOrder S; S.init(S_, D_, G, bx);
      pg8::EpiResF32 E{args.out, args.out, D_, nullptr, nullptr}; pg8::gemm_phase<pg8::EpiResF32, pg8::StaticOrder, true, true>(L, g, S, E, wave); }
    GRID_BAR();
    }
    if constexpr ((PH_MASK >> 9) & 1) {
    const int lane = lane_opaque(); unsigned char* const ws = ptr_opaque(args.ws);
    norm_rows(args.out, args.in[26], nullptr, (bf16*)(ws + WS_H3), nullptr, gw, NGW, lane);
    GRID_BAR();
    }
    if constexpr ((PH_MASK >> 10) & 1) {
    const int lane = lane_opaque(); unsigned char* const ws = ptr_opaque(args.ws);
    { pg8::Gemm g{(const bf16*)(ws + WS_H3), (const bf16*)(ws + WS_WIN1), S_, ODD_PAD, D_}; pg8::StaticOrder S; S.init(S_, ODD_PAD, G, bx);
      pg8::EpiStoreBf16 E{(bf16*)(ws + WS_PROJ1), ODD_PAD, 0, nullptr}; pg8::gemm_phase<pg8::EpiStoreBf16, pg8::StaticOrder, true, true>(L, g, S, E, wave); }
    if constexpr (PROBE_REP == 12) {
    { pg8::Gemm g{(const bf16*)(ws + WS_H3), (const bf16*)(ws + WS_WIN1), S_, ODD_PAD, D_}; pg8::StaticOrder S; S.init(S_, ODD_PAD, G, bx);
      pg8::EpiStoreBf16 E{(bf16*)(ws + WS_PROJ1), ODD_PAD, 0, nullptr}; pg8::gemm_phase<pg8::EpiStoreBf16, pg8::StaticOrder, true, true>(L, g, S, E, wave); }
    }
    GRID_BAR();
    }
    if constexpr ((PH_MASK >> 11) & 1) {
    const int lane = lane_opaque(); unsigned char* const ws = ptr_opaque(args.ws);
    for (int cn = bx; cn < 256; cn += G) for (int i = wave; i < 64; i += 8) prep1_token(args, ws, cn * 64 + i, lane);
    GRID_BAR();
    }
    if constexpr ((PH_MASK >> 12) & 1) {
    const int lane = lane_opaque(); unsigned char* const ws = ptr_opaque(args.ws);
    {
        if (wave < 2) { const int z = wave;
            for (int cn = bx; cn < 256; cn += G) for (int hh = 0; hh < 4; ++hh) dn_pass1_item(ws, L + wave * DN_LDS_PER_WAVE, (z * 4 + hh) * 256 + (z ? 255 - cn : cn), lane); }
        else {
            LAS float* scr2 = (LAS float*)(L + 2 * DN_LDS_PER_WAVE + (wave - 2) * 8448);
            for (int it = bx * 6 + (wave - 2); ; it += G * 6) {
                int r = it; bool did = false;
                for (int e = 0; e < NEXP; ++e) {
                    if (transpose_job(r, args.in[36] + (size_t)e * 1024 * FFE, 1024, FFE, FFE, (bf16*)(ws + WS_WMGU) + (size_t)e * 2 * FFE * 1024, 0, 128, 0, scr2, lane)) { did = true; break; }
                    if (transpose_job(r, args.in[37] + (size_t)e * 1024 * FFE, 1024, FFE, FFE, (bf16*)(ws + WS_WMGU) + (size_t)e * 2 * FFE * 1024, 0, 128, 1, scr2, lane)) { did = true; break; }
                }
                if (!did) break;
            }
        }
    }
    GRID_BAR();
    { const int task = bx; if (task < 512) dn_scan_block(ws, L, task >> 8, (task & 3) < 2 ? 1 : 2, (task >> 6) & 3, task & 1, (task >> 2) & 15, wave, lane); __syncthreads(); }
    { const int task = bx + G; if (task < 512) dn_scan_block(ws, L, task >> 8, (task & 3) < 2 ? 1 : 2, (task >> 6) & 3, task & 1, (task >> 2) & 15, wave, lane); __syncthreads(); }
    GRID_BAR();
    if (bx < 64) { if (wave == 0) dn_scan_groups(ws, bx, lane); }
    GRID_BAR();
    { const int task = bx; if (task < 256) dn_scan_block(ws, L, task >> 7, 0, (task >> 5) & 3, (task >> 4) & 1, task & 15, wave, lane); __syncthreads(); }
    GRID_BAR();
for (int rep_ = 0; rep_ < (PROBE_REP == 16 ? 2 : 1); ++rep_) {     for (int it = gw; it < 2048; it += NGW) dn_pass3_item(ws, it, lane); }
    GRID_BAR();
    }
    if constexpr ((PH_MASK >> 13) & 1) {
    const int lane = lane_opaque(); unsigned char* const ws = ptr_opaque(args.ws);
    for (int t = gw; t < S_; t += NGW) dn_post_token(args, ws, t, lane);
    for (int it = gw; ; it += NGW) {
        int r = it; bool did = false;
        for (int e = 0; e < NEXP; ++e)
            if (transpose_job(r, args.in[38] + (size_t)e * 1024 * FFE, FFE, 1024, 1024, (bf16*)(ws + WS_WMD) + (size_t)e * 1024 * FFE, 0, 0, 0, scr, lane)) { did = true; break; }
        if (!did) break;
    }
    GRID_BAR();
    }
    if constexpr ((PH_MASK >> 14) & 1) {
    const int lane = lane_opaque(); unsigned char* const ws = ptr_opaque(args.ws);
    { pg8::Gemm g{(const bf16*)(ws + WS_YCAT1), (const bf16*)(ws + WS_WOUT1), S_, D_, D_}; pg8::StaticOrder S; S.init(S_, D_, G, bx);
      pg8::EpiResF32 E{args.out, args.out, D_, nullptr, nullptr}; pg8::gemm_phase<pg8::EpiResF32, pg8::StaticOrder, true, true>(L, g, S, E, wave); }
    GRID_BAR();
    }
    if constexpr ((PH_MASK >> 15) & 1) {
    const int lane = lane_opaque(); unsigned char* const ws = ptr_opaque(args.ws);
    { RouterRegs RR; route_load(args, RR, lane); for (int t = gw; t < S_; t += NGW) route_token(RR, ws, args.out, t, lane); }
    GRID_BAR();
    }
    int off[9]; moe_offsets(ws0, off);
    const int ntiles = off[8] >> 8;
    if constexpr ((PH_MASK >> 16) & 1) {
    const int lane = lane_opaque(); unsigned char* const ws = ptr_opaque(args.ws);
    {
        for (int t = gw; t < S_; t += NGW) gather_token(args, ws, args.out, off, t, lane);
        const int tid2 = wave * 64 + lane;
        if (bx == 0 && tid2 < 160) { int e = 0;
#pragma unroll
            for (int k = 1; k < 8; ++k) if (tid2 * 256 >= off[k]) e = k;
            ((int*)(ws + WS_TILE))[tid2] = e; }
        const unsigned* cnt = (const unsigned*)(ws + WS_CTL) + CW_CNT;
        for (int e = 0; e < NEXP; ++e) { const int c = (int)__hip_atomic_load(cnt + e, __ATOMIC_RELAXED, __HIP_MEMORY_SCOPE_AGENT); const int r0 = off[e] + c, r1 = off[e + 1];
            for (int rr = r0 + gw; rr < r1; rr += NGW) { unsigned long long* o8 = (unsigned long long*)((bf16*)(ws + WS_AMOE) + (size_t)rr * D_) + lane;
#pragma unroll
                for (int j = 0; j < 4; ++j) o8[64 * j] = 0ull; } }
    }
    if constexpr (PROBE_REP == 20) {
    {
        for (int t = gw; t < S_; t += NGW) gather_token(args, ws, args.out, off, t, lane);
        const int tid2 = wave * 64 + lane;
        if (bx == 0 && tid2 < 160) { int e = 0;
#pragma unroll
            for (int k = 1; k < 8; ++k) if (tid2 * 256 >= off[k]) e = k;
            ((int*)(ws + WS_TILE))[tid2] = e; }
        const unsigned* cnt = (const unsigned*)(ws + WS_CTL) + CW_CNT;
        for (int e = 0; e < NEXP; ++e) { const int c = (int)__hip_atomic_load(cnt + e, __ATOMIC_RELAXED, __HIP_MEMORY_SCOPE_AGENT); const int r0 = off[e] + c, r1 = off[e + 1];
            for (int rr = r0 + gw; rr < r1; rr += NGW) { unsigned long long* o8 = (unsigned long long*)((bf16*)(ws + WS_AMOE) + (size_t)rr * D_) + lane;
#pragma unroll
                for (int j = 0; j < 4; ++j) o8[64 * j] = 0ull; } }
    }
    }
    GRID_BAR();
    }
    if constexpr ((PH_MASK >> 17) & 1) {
    const int lane = lane_opaque(); unsigned char* const ws = ptr_opaque(args.ws);
    for (int b = 0; b < 3; ++b) {
        const int tlo = b * MOE_BATCH_TILES; int nt = ntiles - tlo; nt = nt < 0 ? 0 : (nt > MOE_BATCH_TILES ? MOE_BATCH_TILES : nt);
        { pg8::Gemm g{(const bf16*)(ws + WS_AMOE), (const bf16*)(ws + WS_WMGU), MOE_ROWS, NEXP * 2 * FFE, D_};
          pg8::MoeOrder S{(const int*)(ws + WS_TILE), tlo, nt, 2 * FFE / 256, G, bx};
          pg8::EpiSwiGLU E{(bf16*)(ws + WS_MACT) - (size_t)tlo * 256 * FFE, FFE, 2 * FFE / 256, nullptr};
          pg8::gemm_phase<pg8::EpiSwiGLU, pg8::MoeOrder, true, true>(L, g, S, E, wave); }
        if constexpr (PROBE_REP == 21) {
        { pg8::Gemm g{(const bf16*)(ws + WS_AMOE), (const bf16*)(ws + WS_WMGU), MOE_ROWS, NEXP * 2 * FFE, D_};
          pg8::MoeOrder S{(const int*)(ws + WS_TILE), tlo, nt, 2 * FFE / 256, G, bx};
          pg8::EpiSwiGLU E{(bf16*)(ws + WS_MACT) - (size_t)tlo * 256 * FFE, FFE, 2 * FFE / 256, nullptr};
          pg8::gemm_phase<pg8::EpiSwiGLU, pg8::MoeOrder, true, true>(L, g, S, E, wave); }
        }
        GRID_BAR();
        { pg8::Gemm g{(const bf16*)(ws + WS_MACT) - (size_t)tlo * 256 * FFE, (const bf16*)(ws + WS_WMD), MOE_ROWS, NEXP * D_, FFE};
          pg8::MoeOrder S{(const int*)(ws + WS_TILE), tlo, nt, D_ / 256, G, bx};
          pg8::EpiStoreBf16 E{(bf16*)(ws + WS_AMOE), D_, D_ / 256, nullptr};
          pg8::gemm_phase<pg8::EpiStoreBf16, pg8::MoeOrder, true, true>(L, g, S, E, wave); }
        if constexpr (PROBE_REP == 22) {
        { pg8::Gemm g{(const bf16*)(ws + WS_MACT) - (size_t)tlo * 256 * FFE, (const bf16*)(ws + WS_WMD), MOE_ROWS, NEXP * D_, FFE};
          pg8::MoeOrder S{(const int*)(ws + WS_TILE), tlo, nt, D_ / 256, G, bx};
          pg8::EpiStoreBf16 E{(bf16*)(ws + WS_AMOE), D_, D_ / 256, nullptr};
          pg8::gemm_phase<pg8::EpiStoreBf16, pg8::MoeOrder, true, true>(L, g, S, E, wave); }
        }
        GRID_BAR();
    }
    }
    if constexpr ((PH_MASK >> 18) & 1) {
    const int lane = lane_opaque(); unsigned char* const ws = ptr_opaque(args.ws);
    for (int t = gw; t < S_; t += NGW) combine_token(ws, args.out, off, t, lane);
#if PROBE
    {
        const unsigned* ts = (const unsigned*)(ws + WS_CTL) + 512;
        const unsigned dA = PROBE_A < 0 ? 100000u : (__hip_atomic_load(ts + PROBE_A, __ATOMIC_RELAXED, __HIP_MEMORY_SCOPE_AGENT) - __hip_atomic_load(ts + PROBE_A - 1, __ATOMIC_RELAXED, __HIP_MEMORY_SCOPE_AGENT));
        const unsigned dB = __hip_atomic_load(ts + PROBE_B, __ATOMIC_RELAXED, __HIP_MEMORY_SCOPE_AGENT) - __hip_atomic_load(ts + PROBE_B - 1, __ATOMIC_RELAXED, __HIP_MEMORY_SCOPE_AGENT);
        const int rows = (int)(dA / 400u);
        for (int t = gw; t < S_; t += NGW) {
            if (t < rows) { f32x4* xo = (f32x4*)(args.out + (size_t)t * D_) + lane;
#pragma unroll
                for (int j = 0; j < 4; ++j) xo[64 * j] = xo[64 * j] + 5.0f; }
            if (t == S_ - 1 && lane == 63) args.out[(size_t)t * D_ + 1023] += (float)dB * 0.001f;
        }
    }
#endif
    }
}

extern "C" void kernel_launch(void* const* d_in, const int* in_sizes, int n_in, void* d_out, int out_size, void* d_ws, size_t ws_size, hipStream_t stream) {
    static int grid = 0;
    if (grid == 0) {
        if (n_in != 39 || out_size != S_ * D_ || ws_size < WS_END) { fprintf(stderr, "kernel_launch: unexpected shapes (n_in %d out %d ws %zu)\n", n_in, out_size, ws_size); grid = -1; return; }
        int dev = 0, cus = 0, per_cu = 0;
        if (hipGetDevice(&dev) != hipSuccess || hipDeviceGetAttribute(&cus, hipDeviceAttributeMultiprocessorCount, dev) != hipSuccess) { grid = -1; return; }
        if (hipFuncSetAttribute((const void*)fwd_kernel, hipFuncAttributeMaxDynamicSharedMemorySize, LDS_BYTES) != hipSuccess) { grid = -1; return; }
        if (hipOccupancyMaxActiveBlocksPerMultiprocessor(&per_cu, (const void*)fwd_kernel, 512, LDS_BYTES) != hipSuccess || per_cu < 1) { fprintf(stderr, "kernel_launch: occupancy query says %d\n", per_cu); }
        (void)hipGetLastError();
        if (cus < 256) { fprintf(stderr, "kernel_launch: this build needs >= 256 CUs (task slots of the delta-net scan); got %d\n", cus); grid = -1; return; }
        grid = 256;
    }
    if (grid < 0) return;
    if (hipMemsetAsync((char*)d_ws + WS_CTL, 0, CTL_ZERO_BYTES, stream) != hipSuccess) return;
    Args a{};
    for (int i = 0; i < 39; ++i) a.in[i] = (const float*)d_in[i];
    a.out = (float*)d_out; a.ws = (unsigned char*)d_ws;
    hipLaunchKernelGGL(fwd_kernel, dim3(grid), dim3(512), LDS_BYTES, stream, a);
}
```

```cpp
#include <hip/hip_runtime.h>
#include <cstdio>
#include <cstdint>
namespace pg8 {
#define PG8_LAS __attribute__((address_space(3)))
typedef unsigned short bf16_t;
typedef short bf16x8 __attribute__((ext_vector_type(8)));
typedef float f32x4 __attribute__((ext_vector_type(4)));
typedef unsigned u32x4 __attribute__((ext_vector_type(4)));
constexpr int BM = 256, BK = 64, HALF = 128, HTB = HALF * BK * 2  , STAGE_BYTES = 8 * HTB, NXCD = 8, WGM = 8;

__host__ __device__ __forceinline__ int lds_byte(int r, int c) { const int st = (r >> 4) * 2 + (c >> 5), rr = r & 15, cc = c & 31, ob = rr * 64 + cc * 2; return st * 1024 + (ob ^ (((ob >> 9) & 1) << 5)); }
__host__ __device__ __forceinline__ void stage_rc(int b, int& R, int& C) { const int st = b / 1024, sb = b % 1024, swz = sb ^ (((sb >> 9) & 1) << 5); R = (st >> 1) * 16 + swz / 64; C = (st & 1) * 32 + (swz % 64) / 2; }
__host__ __device__ __forceinline__ int perm32(int rho) { const int n = rho >> 4, i = rho & 15; return 8 * (i >> 2) + 4 * n + (i & 3); }

struct Unit { int pm, pn; };
struct Gemm { const bf16_t* A; const bf16_t* Bt; int M, N, K; };

struct StaticOrder {
    int nM, nN, nwg, G, c;
    __host__ __device__ void init(int M, int N, int G_, int c_) { nM = M / BM; nN = N / BM; nwg = nM * nN; G = G_; c = c_; }
    __host__ __device__ bool next(int i, Unit& u) const {
        const long L = (long)i * G + c; if (L >= nwg) return false;
        int wgid = (int)L; { const int q = nwg / NXCD, r = nwg % NXCD, xcd = wgid % NXCD, off = wgid / NXCD; wgid = (xcd < r ? xcd * (q + 1) : r * (q + 1) + (xcd - r) * q) + off; }
        const int nig = WGM * nN, gid = wgid / nig, fm = gid * WGM, gsz = (nM - fm) < WGM ? (nM - fm) : WGM;
        u.pm = fm + ((wgid % nig) % gsz); u.pn = (wgid % nig) / gsz; return true;
    }
    __device__ __forceinline__ void a_ready(const Unit&) const {}
    __device__ __forceinline__ void done(const Unit&) const {}
};

__device__ __forceinline__ unsigned cvt_pk_bf16(float lo, float hi) { unsigned r; asm volatile("v_cvt_pk_bf16_f32 %0, %1, %2" : "=v"(r) : "v"(lo), "v"(hi)); return r; }
struct EpiStoreBf16 {
    static constexpr bool PERM = true, AFTER_DRAIN = false;
    bf16_t* O; int ldc; int ntn; const float* rowss;
    __device__ __forceinline__ void operator()(const f32x4 (&acc)[2][2][4][2], const Unit& u, int wr, int wc, int fr, int fq) const {
        const int row0 = u.pm * BM + wr * 64 + fr; const int pn = ntn ? (u.pn % ntn) : u.pn;
        const int col0 = pn * BM + wc * 32 + 8 * fq;
#pragma unroll
        for (int ai = 0; ai < 2; ++ai)
#pragma unroll
            for (int m = 0; m < 4; ++m) { bf16_t* rowp = O + (size_t)(row0 + ai * HALF + m * 16) * ldc + col0;
                float rs = 1.0f; if (rowss) { const f32x4* sp = (const f32x4*)(rowss + (size_t)(row0 + ai * HALF + m * 16) * 16); const f32x4 s0 = sp[0], s1 = sp[1], s2 = sp[2], s3 = sp[3]; const f32x4 st = (s0 + s1) + (s2 + s3); rs = 1.0f / sqrtf(((st[0] + st[1]) + (st[2] + st[3])) * (1.0f / 1024.f) + 1e-6f); }
#pragma unroll
                for (int bj = 0; bj < 2; ++bj) { const f32x4 v0 = acc[ai][bj][m][0] * rs, v1 = acc[ai][bj][m][1] * rs;
                    u32x4 w; w.x = cvt_pk_bf16(v0[0], v0[1]); w.y = cvt_pk_bf16(v0[2], v0[3]); w.z = cvt_pk_bf16(v1[0], v1[1]); w.w = cvt_pk_bf16(v1[2], v1[3]);
                    *(u32x4*)(rowp + bj * HALF) = w; } }
    }
};
struct EpiResF32 {
    static constexpr bool PERM = false, AFTER_DRAIN = false;
    const float* base; float* out; int ldc; bf16_t* xb; float* rowss;
    __device__ __forceinline__ void operator()(const f32x4 (&acc)[2][2][4][2], const Unit& u, int wr, int wc, int fr, int fq) const {
        const int row0 = u.pm * BM + wr * 64 + fr, col0 = u.pn * BM + wc * 32 + 4 * fq;
#pragma unroll
        for (int ai = 0; ai < 2; ++ai)
#pragma unroll
            for (int m = 0; m < 4; ++m) { const size_t off = (size_t)(row0 + ai * HALF + m * 16) * ldc + col0; float ss = 0.f;
#pragma unroll
                for (int bj = 0; bj < 2; ++bj)
#pragma unroll
                    for (int n = 0; n < 2; ++n) { const f32x4 b = *(const f32x4*)(base + off + bj * HALF + n * 16); const f32x4 o = b + acc[ai][bj][m][n]; *(f32x4*)(out + off + bj * HALF + n * 16) = o;
                        if (xb) { ss += (o[0] * o[0] + o[1] * o[1]) + (o[2] * o[2] + o[3] * o[3]);
                            unsigned long long w = (unsigned long long)cvt_pk_bf16(o[0], o[1]) | ((unsigned long long)cvt_pk_bf16(o[2], o[3]) << 32); *(unsigned long long*)(xb + off + bj * HALF + n * 16) = w; } }
                if (xb) { ss += __shfl_xor(ss, 16); ss += __shfl_xor(ss, 32); if (fq == 0) rowss[(size_t)(row0 + ai * HALF + m * 16) * 16 + u.pn * 4 + wc] = ss; } }
    }
};
struct EpiSwiGLU {
    static constexpr bool PERM = true, AFTER_DRAIN = false;
    bf16_t* O; int ldc; int ntn; const float* rowss;
    __device__ __forceinline__ void operator()(const f32x4 (&acc)[2][2][4][2], const Unit& u, int wr, int wc, int fr, int fq) const {
        const int row0 = u.pm * BM + wr * 64 + fr; const int pn = ntn ? (u.pn % ntn) : u.pn;
        const int col0 = pn * HALF + wc * 32 + 8 * fq;
#pragma unroll
        for (int ai = 0; ai < 2; ++ai)
#pragma unroll
            for (int m = 0; m < 4; ++m) { bf16_t* rowp = O + (size_t)(row0 + ai * HALF + m * 16) * ldc + col0;
                float rs = 1.0f; if (rowss) { const f32x4* sp = (const f32x4*)(rowss + (size_t)(row0 + ai * HALF + m * 16) * 16); const f32x4 s0 = sp[0], s1 = sp[1], s2 = sp[2], s3 = sp[3]; const f32x4 st = (s0 + s1) + (s2 + s3); rs = 1.0f / sqrtf(((st[0] + st[1]) + (st[2] + st[3])) * (1.0f / 1024.f) + 1e-6f); }
                float r[8];
#pragma unroll
                for (int n = 0; n < 2; ++n)
#pragma unroll
                    for (int i = 0; i < 4; ++i) { const float g = acc[ai][0][m][n][i] * rs, up = acc[ai][1][m][n][i] * rs; r[n * 4 + i] = g * __builtin_amdgcn_rcpf(1.0f + __expf(-g)) * up; }
                u32x4 w; w.x = cvt_pk_bf16(r[0], r[1]); w.y = cvt_pk_bf16(r[2], r[3]); w.z = cvt_pk_bf16(r[4], r[5]); w.w = cvt_pk_bf16(r[6], r[7]);
                *(u32x4*)rowp = w; }
    }
};
struct MoeOrder {
    const int* tile_exp; int tlo, nt, nN, G, c;
    __device__ __forceinline__ bool next(int i, Unit& u) const {
        const int L = i * G + c; if (nt <= 0 || L >= nt * nN) return false;
        const int t = tlo + (L % nt), cn = L / nt;
        const int e = __builtin_amdgcn_readfirstlane(__hip_atomic_load(tile_exp + t, __ATOMIC_RELAXED, __HIP_MEMORY_SCOPE_AGENT));
        u.pm = t; u.pn = e * nN + cn; return true;
    }
    __device__ __forceinline__ void a_ready(const Unit&) const {}
    __device__ __forceinline__ void done(const Unit&) const {}
};
template <class Epi, class Sched, bool ALIGN_EPI = false, bool SP2 = false>
__device__ __forceinline__ void gemm_phase(PG8_LAS unsigned char* lds, const Gemm g, const Sched& S, const Epi& E, const int wave_id) {
    int tid_; asm volatile("v_mbcnt_lo_u32_b32 %0, -1, 0\n\tv_mbcnt_hi_u32_b32 %0, -1, %0" : "=v"(tid_)); tid_ += wave_id * 64;
    const int tid = tid_, wid = __builtin_amdgcn_readfirstlane(tid >> 6), lane = tid & 63, wr = wid >> 2, wc = wid & 3, fr = lane & 15, fq = lane >> 4;
    const int K = g.K, nt = K / BK;
    unsigned voffA[2], voffB[2];
#pragma unroll
    for (int i = 0; i < 2; ++i) { int R, C; stage_rc(tid * 16 + i * 8192, R, C); const int Rb = Epi::PERM ? ((R & ~31) + perm32(R & 31)) : R;
        voffA[i] = (unsigned)(R * K + C) * 2u; voffB[i] = (unsigned)(Rb * K + C) * 2u; }
    const size_t kstep = (size_t)(BK * 2);
    const size_t hstep = (size_t)HALF * K * 2;
    const size_t tstep = 2 * hstep;
    const unsigned ldsw = (unsigned)wid * 1024u;
    const int aoff = lds_byte(wr * 64 + fr, fq * 8), boff = lds_byte(wc * 32 + fr, fq * 8);
#define PG8_SA(b, h) (((b) * 2 + (h)) * HTB)
#define PG8_SB(b, h) ((4 + (b) * 2 + (h)) * HTB)
#define PG8_STAGE(bufoff, gbase, voff) do { _Pragma("unroll") for (int _i = 0; _i < 2; ++_i) \
        __builtin_amdgcn_global_load_lds((const unsigned*)((const char*)(gbase) + (voff)[_i]), (PG8_LAS unsigned*)(lds + (bufoff) + ldsw + _i * 8192), 16, 0, 0); } while (0)
#define PG8_LDA(dst, b, h) do { _Pragma("unroll") for (int m = 0; m < 4; ++m) _Pragma("unroll") for (int k = 0; k < 2; ++k) dst[m][k] = *(const PG8_LAS bf16x8*)(lds + PG8_SA(b, h) + aoff + m * 2048 + k * 1024); } while (0)
#define PG8_LDB(dst, b, h) do { _Pragma("unroll") for (int n = 0; n < 2; ++n) _Pragma("unroll") for (int k = 0; k < 2; ++k) dst[n][k] = *(const PG8_LAS bf16x8*)(lds + PG8_SB(b, h) + boff + n * 2048 + k * 1024); } while (0)
#define PG8_MMA(ai, bj, At, Bt) do { __builtin_amdgcn_s_setprio(1); _Pragma("unroll") for (int m = 0; m < 4; ++m) _Pragma("unroll") for (int n = 0; n < 2; ++n) _Pragma("unroll") for (int k = 0; k < 2; ++k) \
        acc[ai][bj][m][n] = __builtin_amdgcn_mfma_f32_16x16x32_bf16(Bt[n][k], At[m][k], acc[ai][bj][m][n], 0, 0, 0); __builtin_amdgcn_s_setprio(0); } while (0)
#define PG8_WAIT_V(n) asm volatile("s_waitcnt vmcnt(" #n ")" ::: "memory")
#define PG8_WAIT_L(n) asm volatile("s_waitcnt lgkmcnt(" #n ")" ::: "memory")
#define PG8_BAR __builtin_amdgcn_s_barrier()
#define PG8_SCHED __builtin_amdgcn_sched_barrier(0)
    Unit cur, nxt; int ui = 0;
    if (!S.next(0, cur)) return;
    f32x4 acc[2][2][4][2];
#pragma unroll
    for (int a = 0; a < 2; ++a)
#pragma unroll
        for (int b = 0; b < 2; ++b)
#pragma unroll
            for (int m = 0; m < 4; ++m)
#pragma unroll
                for (int n = 0; n < 2; ++n) acc[a][b][m][n] = (f32x4){0.f, 0.f, 0.f, 0.f};
    bf16x8 At[4][2], B0[2][2], B1[2][2];
    const char* cA = (const char*)g.A + (size_t)cur.pm * tstep; const char* cB = (const char*)g.Bt + (size_t)cur.pn * tstep;
    S.a_ready(cur);
    if constexpr (SP2) {
        PG8_STAGE(PG8_SB(0, 0), cB, voffB); PG8_STAGE(PG8_SB(0, 1), cB + hstep, voffB); PG8_STAGE(PG8_SA(0, 0), cA, voffA); PG8_STAGE(PG8_SA(0, 1), cA + hstep, voffA);
        if (wr == 1) PG8_BAR;
        PG8_WAIT_V(2); PG8_BAR;
        PG8_STAGE(PG8_SB(1, 0), cB + kstep, voffB); PG8_STAGE(PG8_SA(1, 0), cA + kstep, voffA); PG8_STAGE(PG8_SB(1, 1), cB + hstep + kstep, voffB);
        PG8_WAIT_V(6); PG8_BAR;
    } else {
        PG8_STAGE(PG8_SB(0, 0), cB, voffB); PG8_STAGE(PG8_SA(0, 0), cA, voffA); PG8_STAGE(PG8_SB(0, 1), cB + hstep, voffB); PG8_STAGE(PG8_SA(0, 1), cA + hstep, voffA);
        if (wr == 1) PG8_BAR;
        PG8_WAIT_V(4); PG8_BAR;
        PG8_STAGE(PG8_SB(1, 0), cB + kstep, voffB); PG8_STAGE(PG8_SA(1, 0), cA + kstep, voffA); PG8_STAGE(PG8_SB(1, 1), cB + hstep + kstep, voffB);
        PG8_WAIT_V(6); PG8_BAR;
    }
    for (;;) {
        const bool has_next = S.next(ui + 1, nxt);
        const char* nA = has_next ? (const char*)g.A + (size_t)nxt.pm * tstep : cA; const char* nB = has_next ? (const char*)g.Bt + (size_t)nxt.pn * tstep : cB;
        for (int t = 0; t < nt; t += 2) {
            const bool last = (t == nt - 2);
            const char* a1 = cA + (size_t)(t + 1) * kstep;
            const char* a2 = last ? nA : cA + (size_t)(t + 2) * kstep; const char* b2 = last ? nB : cB + (size_t)(t + 2) * kstep;
            const char* a3 = a2 + kstep; const char* b3 = b2 + kstep;
            if (last && has_next) S.a_ready(nxt);
            if constexpr (SP2) {
            PG8_LDB(B0, 0, 0); PG8_LDB(B1, 0, 1); PG8_SCHED; PG8_LDA(At, 0, 0); PG8_STAGE(PG8_SA(1, 1), a1 + hstep, voffA);
            PG8_WAIT_V(8); PG8_WAIT_L(0); PG8_BAR; PG8_MMA(0, 0, At, B0); PG8_MMA(0, 1, At, B1); PG8_BAR; PG8_SCHED;
            PG8_LDA(At, 0, 1); PG8_STAGE(PG8_SB(0, 0), b2, voffB); PG8_STAGE(PG8_SB(0, 1), b2 + hstep, voffB); PG8_STAGE(PG8_SA(0, 0), a2, voffA);
            PG8_WAIT_V(8); PG8_WAIT_L(0); PG8_BAR; PG8_MMA(1, 0, At, B0); PG8_MMA(1, 1, At, B1); PG8_BAR; PG8_SCHED;
            PG8_LDB(B0, 1, 0); PG8_LDB(B1, 1, 1); PG8_SCHED; PG8_LDA(At, 1, 0); PG8_STAGE(PG8_SA(0, 1), a2 + hstep, voffA);
            PG8_WAIT_V(8); PG8_WAIT_L(0); PG8_BAR; PG8_MMA(0, 0, At, B0); PG8_MMA(0, 1, At, B1); PG8_BAR; PG8_SCHED;
            PG8_LDA(At, 1, 1); PG8_STAGE(PG8_SB(1, 0), b3, voffB); PG8_STAGE(PG8_SB(1, 1), b3 + hstep, voffB); PG8_STAGE(PG8_SA(1, 0), a3, voffA);
            PG8_WAIT_V(8); PG8_WAIT_L(0); PG8_BAR; PG8_MMA(1, 0, At, B0); PG8_MMA(1, 1, At, B1); PG8_BAR; PG8_SCHED;
            } else {
            PG8_LDB(B0, 0, 0); PG8_SCHED; PG8_LDA(At, 0, 0); PG8_STAGE(PG8_SA(1, 1), a1 + hstep, voffA);
            PG8_WAIT_L(8); PG8_BAR; PG8_WAIT_L(0); PG8_MMA(0, 0, At, B0); PG8_BAR; PG8_SCHED;
            PG8_LDB(B1, 0, 1); PG8_STAGE(PG8_SB(0, 0), b2, voffB);
            PG8_BAR; PG8_WAIT_L(0); PG8_MMA(0, 1, At, B1); PG8_BAR;
            PG8_LDA(At, 0, 1); PG8_STAGE(PG8_SA(0, 0), a2, voffA);
            PG8_BAR; PG8_WAIT_L(0); PG8_MMA(1, 0, At, B0); PG8_BAR; PG8_SCHED;
            PG8_STAGE(PG8_SB(0, 1), b2 + hstep, voffB);
            PG8_WAIT_V(6); PG8_BAR; PG8_MMA(1, 1, At, B1); PG8_BAR;
            PG8_LDB(B0, 1, 0); PG8_SCHED; PG8_LDA(At, 1, 0); PG8_STAGE(PG8_SA(0, 1), a2 + hstep, voffA);
            PG8_WAIT_L(8); PG8_BAR; PG8_WAIT_L(0); PG8_MMA(0, 0, At, B0); PG8_BAR; PG8_SCHED;
            PG8_LDB(B1, 1, 1); PG8_STAGE(PG8_SB(1, 0), b3, voffB);
            PG8_BAR; PG8_WAIT_L(0); PG8_MMA(0, 1, At, B1); PG8_BAR;
            PG8_LDA(At, 1, 1); PG8_STAGE(PG8_SA(1, 0), a3, voffA);
            PG8_BAR; PG8_WAIT_L(0); PG8_MMA(1, 0, At, B0); PG8_BAR; PG8_SCHED;
            PG8_STAGE(PG8_SB(1, 1), b3 + hstep, voffB);
            PG8_WAIT_V(6); PG8_BAR; PG8_MMA(1, 1, At, B1); PG8_BAR;
            }
        }
        if constexpr (ALIGN_EPI) { if (wr == 0) PG8_BAR; }
        if constexpr (!Epi::AFTER_DRAIN) { E(acc, cur, wr, wc, fr, fq); S.done(cur); }
        if (!has_next) break;
#pragma unroll
        for (int a = 0; a < 2; ++a)
#pragma unroll
            for (int b = 0; b < 2; ++b)
#pragma unroll
                for (int m = 0; m < 4; ++m)
#pragma unroll
                    for (int n = 0; n < 2; ++n) acc[a][b][m][n] = (f32x4){0.f, 0.f, 0.f, 0.f};
        cur = nxt; cA = nA; cB = nB; ++ui;
        if constexpr (ALIGN_EPI) { if (wr == 1) PG8_BAR; }
    }
    PG8_WAIT_V(0);
    if constexpr (!ALIGN_EPI) { if (wr == 0) PG8_BAR; }
    PG8_BAR;
    if constexpr (Epi::AFTER_DRAIN) { E.fused(acc, cur, wr, wc, fr, fq, lds, wid, lane); S.done(cur); }
#undef PG8_SA
#undef PG8_SB
#undef PG8_STAGE
#undef PG8_LDA
#undef PG8_LDB
#undef PG8_MMA
#undef PG8_WAIT_V
#undef PG8_WAIT_L
#undef PG8_BAR
#undef PG8_SCHED
}
}
constexpr int S_ = 16384, D_ = 1024;
constexpr int EVEN_IN = 3072, LORA_N = 512, FF0 = 2816, ODD_IN = 3600, ODD_PAD = 3840, FFE = 3584, NEXP = 8;
constexpr int MOE_ROWS = 32768 + 8 * 256;
constexpr int MOE_BATCH_TILES = 64;
constexpr size_t MiB = 1u << 20;
constexpr size_t WS_CTL = 0, CTL_ZERO_BYTES = 1 * MiB;
constexpr size_t WS_WIN0 = 2 * MiB, WS_WL = 8 * MiB, WS_WOUT0 = 9 * MiB, WS_WGU0 = 11 * MiB, WS_WD0 = 22 * MiB, WS_WIN1 = 28 * MiB, WS_WOUT1 = 36 * MiB;
constexpr size_t WS_TOK = 38 * MiB;
constexpr size_t WS_TILE = 39 * MiB;
constexpr size_t WS_A = 40 * MiB;
constexpr size_t WS_H = WS_A, WS_HX = WS_A + 32 * MiB;
constexpr size_t WS_LW0 = WS_A, WS_LW1 = WS_A + 32 * MiB, WS_R = WS_A + 64 * MiB, WS_V = WS_A + 80 * MiB, WS_KK = WS_A + 96 * MiB, WS_KD0 = WS_A + 112 * MiB, WS_KD1 = WS_A + 128 * MiB, WS_B0 = WS_A + 144 * MiB;
constexpr size_t WS_H2 = WS_A, WS_H3 = WS_A + 32 * MiB;
constexpr size_t WS_WMGU = WS_A, WS_WMD = WS_A + 112 * MiB;
constexpr size_t WS_B = 208 * MiB;
constexpr size_t WS_PROJ0 = WS_B, WS_LORA = WS_B + 96 * MiB, WS_QN = WS_B + 112 * MiB, WS_KN = WS_B + 128 * MiB, WS_Y = WS_B + 144 * MiB;
constexpr size_t WS_B1 = WS_B + 176 * MiB, WS_GATE = WS_B + 192 * MiB, WS_BONUS = WS_B + 208 * MiB, WS_Y0 = WS_LORA, WS_Y1 = WS_B + 224 * MiB;
constexpr size_t WS_ACT0 = WS_B, WS_PROJ1 = WS_B + 88 * MiB;
constexpr size_t WS_QD = WS_B, WS_KD = WS_B + 16 * MiB, WS_VD = WS_B + 32 * MiB, WS_YCAT1 = WS_B + 48 * MiB, WS_GB = WS_B + 80 * MiB  ;
constexpr size_t WS_O0 = WS_B + 208 * MiB, WS_O1 = WS_B + 224 * MiB;
constexpr size_t WS_AMOE = WS_B, WS_MACT = WS_B + 88 * MiB;
constexpr size_t WS_END_OLD = 448 * MiB, WS_RSS1 = 460 * MiB, WS_RSS2 = 461 * MiB, WS_END = 462 * MiB;
static_assert(WS_MACT + (size_t)MOE_BATCH_TILES * 256 * FFE * 2 <= WS_END, "moe act");
static_assert(WS_AMOE + (size_t)MOE_ROWS * D_ * 2 <= WS_MACT, "amoe");
static_assert(WS_PROJ1 + (size_t)S_ * ODD_PAD * 2 <= WS_O0, "proj1");
constexpr int CW_CNT = 64;
constexpr int CW_RSS1 = 32768, CW_RSS2 = 32768 + 16384;
constexpr int CW_BAR = 4096;
constexpr int LDS_BYTES = 151552, LDS_ZERO_OFF = LDS_BYTES - 512, MISC_OFF = LDS_ZERO_OFF + 64;

#define GAS __attribute__((address_space(1)))
#define LAS __attribute__((address_space(3)))
#define DI __device__ __forceinline__
typedef unsigned short bf16;
typedef unsigned v4u __attribute__((ext_vector_type(4)));
typedef float f32x4 __attribute__((ext_vector_type(4)));
typedef GAS unsigned gu32;
#define LDS_WAIT() asm volatile("s_waitcnt lgkmcnt(0)" ::: "memory")
DI unsigned f2bf(float f) { unsigned u = __builtin_bit_cast(unsigned, f); return (u + 0x7fffu + ((u >> 16) & 1u)) >> 16; }
typedef float f32x2_t __attribute__((ext_vector_type(2))); typedef __bf16 bf16x2_t __attribute__((ext_vector_type(2)));
DI unsigned pk2(float lo, float hi) { const f32x2_t v = {lo, hi}; const bf16x2_t b = __builtin_convertvector(v, bf16x2_t); return __builtin_bit_cast(unsigned, b); }
DI float bflo(unsigned w) { return __uint_as_float(w << 16); }
DI float bfhi(unsigned w) { return __uint_as_float(w & 0xffff0000u); }
DI float bf2f(bf16 b) { return __uint_as_float(((unsigned)b) << 16); }
DI void ld8(const bf16* p, float (&v)[8]) { const v4u w = *(const v4u*)p; v[0] = bflo(w.x); v[1] = bfhi(w.x); v[2] = bflo(w.y); v[3] = bfhi(w.y); v[4] = bflo(w.z); v[5] = bfhi(w.z); v[6] = bflo(w.w); v[7] = bfhi(w.w); }
DI void st8(bf16* p, const float (&v)[8]) { v4u w; w.x = pk2(v[0], v[1]); w.y = pk2(v[2], v[3]); w.z = pk2(v[4], v[5]); w.w = pk2(v[6], v[7]); *(v4u*)p = w; }
DI void ld8f(const float* p, float (&v)[8]) { const f32x4 a = *(const f32x4*)p, b = *(const f32x4*)(p + 4); v[0] = a.x; v[1] = a.y; v[2] = a.z; v[3] = a.w; v[4] = b.x; v[5] = b.y; v[6] = b.z; v[7] = b.w; }
DI void st8f(float* p, const float (&v)[8]) { *(f32x4*)p = (f32x4){v[0], v[1], v[2], v[3]}; *(f32x4*)(p + 4) = (f32x4){v[4], v[5], v[6], v[7]}; }
DI float wave_sum(float v) {
#pragma unroll
    for (int o = 1; o < 64; o <<= 1) v += __shfl_xor(v, o);
    return v;
}
template <int W> DI float grp_sum(float v) {
#pragma unroll
    for (int o = 1; o < W; o <<= 1) v += __shfl_xor(v, o);
    return v;
}
DI float sigmoidf_(float x) { return 1.0f / (1.0f + __expf(-x)); }
DI float softplusf_(float x) { return x > 20.f ? x : log1pf(__expf(x)); }
DI float siluf_(float x) { return x / (1.0f + __expf(-x)); }

struct Args { const float* in[39]; float* out; unsigned char* ws; };

DI void transpose_item(const float* W, int K, int N, bf16* WT, int rowbase, LAS float* scr, int k0, int n0, int lane, const float* kscale = nullptr) {
    const int nn = n0 + (lane & 31); const bool ok = nn < N;
#pragma unroll
    for (int i = 0; i < 32; ++i) { const int kk = 2 * i + (lane >> 5); scr[kk * 33 + (lane & 31)] = ok ? W[(size_t)(k0 + kk) * N + nn] * (kscale ? kscale[k0 + kk] : 1.0f) : 0.f; }
    LDS_WAIT(); asm volatile("" ::: "memory");
    const int c = lane & 7;
#pragma unroll
    for (int j = 0; j < 4; ++j) { const int n = (lane >> 3) + 8 * j; const LAS float* s = scr + (8 * c) * 33 + n;
        v4u o; o.x = pk2(s[0 * 33], s[1 * 33]); o.y = pk2(s[2 * 33], s[3 * 33]); o.z = pk2(s[4 * 33], s[5 * 33]); o.w = pk2(s[6 * 33], s[7 * 33]);
        *(v4u*)(WT + (size_t)(rowbase + n) * K + k0 + 8 * c) = o; }
    LDS_WAIT(); asm volatile("" ::: "memory");
}
DI bool transpose_job(int& r, const float* W, int K, int N, int Npad, bf16* WT, int row_off, int grp, int sel, LAS float* scr, int lane, const float* kscale = nullptr) {
    const int nblk = Npad / 32, cnt = (K / 64) * nblk;
    if (r >= cnt) { r -= cnt; return false; }
    const int kb = r / nblk, nb = r % nblk, n0 = 32 * nb;
    const int rowbase = row_off + (grp ? (n0 / grp) * (2 * grp) + sel * grp + (n0 % grp) : n0);
    transpose_item(W, K, N, WT, rowbase, scr, 64 * kb, n0, lane, kscale);
    return true;
}
#define XB_TMO      128
#define XB_XCNT(j)  (256  + 64 * (j))
#define XB_XSUB(j)  (1280 + 64 * (j))
#define XB_XGEN(j)  (2304 + 64 * (j))
#define XB_TOP      3328
#define XB_TOPGEN   3392
#define XCD_BAR_WORDS 3456
#define XB_SPIN_CAP (1u << 22)

__device__ __forceinline__ unsigned xb_ld(unsigned* p)              { return __hip_atomic_load(p, __ATOMIC_RELAXED, __HIP_MEMORY_SCOPE_AGENT); }
__device__ __forceinline__ unsigned xb_add(unsigned* p, unsigned v) { return __hip_atomic_fetch_add(p, v, __ATOMIC_RELAXED, __HIP_MEMORY_SCOPE_AGENT); }
__device__ __forceinline__ unsigned xb_xcc_id() { return (unsigned)__builtin_amdgcn_s_getreg((3 << 11) | 20) & 0xFu; }
#define XB_SPIN(cond, bar) do { unsigned _sp = 0; while (cond) { __builtin_amdgcn_s_sleep(1); \
    if ((++_sp & 255u) == 0u) { if (xb_ld(&(bar)[XB_TMO])) break; if (_sp > XB_SPIN_CAP) { atomicAdd(&(bar)[XB_TMO], 1u); break; } } } } while (0)

struct XcdBarrier {
    unsigned* bar; unsigned x;
    volatile LAS unsigned* st;
};

__device__ __forceinline__ XcdBarrier xcd_barrier_post(unsigned* bar, volatile LAS unsigned* st) {
    XcdBarrier b; b.bar = bar; b.x = xb_xcc_id(); b.st = st;
    if (threadIdx.x == 0) (void)xb_add(&bar[XB_XCNT(b.x)], 1u);
    return b;
}
__device__ __forceinline__ void xcd_barrier_complete(unsigned* bar, unsigned x, unsigned& nloc, unsigned& nx) {
    const unsigned G = gridDim.x * gridDim.y * gridDim.z;
    unsigned sum, cnt, mine, sp = 0u;
    for (;;) {
        sum = 0u; cnt = 0u; mine = 0u;
#pragma unroll
        for (unsigned j = 0; j < 16; ++j) { const unsigned c = xb_ld(&bar[XB_XCNT(j)]); sum += c; cnt += (c > 0u) ? 1u : 0u; mine = (j == x) ? c : mine; }
        if (sum == G) break;
        __builtin_amdgcn_s_sleep(1);
        if ((++sp & 255u) == 0u) { if (xb_ld(&bar[XB_TMO])) break; if (sp > XB_SPIN_CAP) { atomicAdd(&bar[XB_TMO], 1u); break; } }
    }
    nloc = mine > 0u ? mine : 1u; nx = cnt > 0u ? cnt : 1u;
}

__device__ __forceinline__ void xcd_barrier(const XcdBarrier& b, const bool wave0) {
    asm volatile("s_waitcnt vmcnt(0)" ::: "memory");
    __syncthreads();
    if (wave0 && __builtin_amdgcn_mbcnt_hi(~0u, __builtin_amdgcn_mbcnt_lo(~0u, 0u)) == 0u) {
        unsigned* bar = b.bar; asm volatile("" : "+s"(bar)); const unsigned bx_ = xb_xcc_id();
        __builtin_amdgcn_s_waitcnt(0);
        unsigned nloc = b.st[0], nx = b.st[1];
        if (nloc == 0u) { xcd_barrier_complete(bar, bx_, nloc, nx); b.st[0] = nloc; b.st[1] = nx; }
        const unsigned old = xb_add(&bar[XB_XSUB(bx_)], 1u);
        const unsigned gen = old / nloc;
        if (old + 1u == (gen + 1u) * nloc) {
            __builtin_amdgcn_fence(__ATOMIC_RELEASE, "agent");
            asm volatile("s_waitcnt vmcnt(0)" ::: "memory");
            const unsigned og = xb_add(&bar[XB_TOP], 1u);
            const unsigned tg = og / nx;
            if (og + 1u == (tg + 1u) * nx) xb_add(&bar[XB_TOPGEN], 1u);
            else XB_SPIN(xb_ld(&bar[XB_TOPGEN]) == tg, bar);
            __builtin_amdgcn_fence(__ATOMIC_ACQUIRE, "agent");
            xb_add(&bar[XB_XGEN(bx_)], 1u);
            asm volatile("s_waitcnt vmcnt(0)" ::: "memory");
        } else {
            XB_SPIN(xb_ld(&bar[XB_XGEN(bx_)]) == gen, bar);
            __builtin_amdgcn_fence(__ATOMIC_ACQUIRE, "agent");
            asm volatile("s_waitcnt vmcnt(0)" ::: "memory");
        }
    }
    __syncthreads();
}
DI float row_rstd(const f32x4 (&v)[4]) {
    float s = 0.f;
#pragma unroll
    for (int j = 0; j < 4; ++j) s += (v[j].x * v[j].x + v[j].y * v[j].y) + (v[j].z * v[j].z + v[j].w * v[j].w);
    return 1.0f / sqrtf(wave_sum(s) * (1.0f / D_) + 1e-6f);
}
DI void load_row(const float* x, int t, int lane, f32x4 (&v)[4]) {
    if (t >= 0 && t < S_) { const f32x4* p = (const f32x4*)(x + (size_t)t * D_) + lane;
#pragma unroll
        for (int j = 0; j < 4; ++j) v[j] = p[64 * j];
    } else {
#pragma unroll
        for (int j = 0; j < 4; ++j) v[j] = (f32x4){0.f, 0.f, 0.f, 0.f};
    }
}
DI void store_row_bf16(bf16* o, int lane, const f32x4 (&v)[4]) {
    unsigned long long* o8 = (unsigned long long*)o + lane;
#pragma unroll
    for (int j = 0; j < 4; ++j) o8[64 * j] = (unsigned long long)pk2(v[j].x, v[j].y) | ((unsigned long long)pk2(v[j].z, v[j].w) << 32);
}
DI void norm_rows(const float* x, const float* w, const float* mu  , bf16* H, bf16* HX, int gw, int NGW, int lane) {
    f32x4 wv[4];
#pragma unroll
    for (int j = 0; j < 4; ++j) wv[j] = ((const f32x4*)w)[lane + 64 * j];
    for (int t = gw; t < S_; t += NGW) {
        f32x4 v[4]; load_row(x, t, lane, v); const float rs = row_rstd(v);
#pragma unroll
        for (int j = 0; j < 4; ++j) v[j] = v[j] * rs * wv[j];
        store_row_bf16(H + (size_t)t * D_, lane, v);
        if (mu) {
            f32x4 p[4], n[4]; load_row(x, t - 1, lane, p); load_row(x, t + 1, lane, n);
            const float rp = row_rstd(p), rn = row_rstd(n);
#pragma unroll
            for (int j = 0; j < 4; ++j) { const f32x4 m0 = ((const f32x4*)mu)[lane + 64 * j], m1 = ((const f32x4*)(mu + D_))[lane + 64 * j];
                const f32x4 hp = p[j] * rp * wv[j], hn = n[j] * rn * wv[j]; p[j] = v[j] + m0 * (hp - v[j]) + m1 * (hn - v[j]); }
            store_row_bf16(HX + (size_t)t * D_, lane, p);
        }
    }
}

DI void prep0_token(const Args& a, unsigned char* ws, LAS float* scr, int t, int lane) {
    const bf16* P = (const bf16*)(ws + WS_PROJ0) + (size_t)t * EVEN_IN;
    const int c0 = 8 * lane;
    {
        float q[8], k[8]; ld8(P + c0, q); ld8(P + 512 + c0, k);
        float sq = 0.f, sk = 0.f;
#pragma unroll
        for (int i = 0; i < 8; ++i) { sq += q[i] * q[i]; sk += k[i] * k[i]; }
        sq = grp_sum<8>(sq); sk = grp_sum<8>(sk);
        const float rq = 1.0f / sqrtf(sq * (1.0f / 64.f) + 1e-6f), rk = 1.0f / sqrtf(sk * (1.0f / 64.f) + 1e-6f);
        const int d0 = 8 * (lane & 7);
        float qw[8], kw[8]; ld8f(a.in[4] + d0, qw); ld8f(a.in[5] + d0, kw);
#pragma unroll
        for (int i = 0; i < 8; ++i) { q[i] = q[i] * rq * qw[i]; k[i] = k[i] * rk * kw[i]; }
        const float pos = (float)((const int*)a.in[1])[t];
        float qo[8], ko[8];
#pragma unroll
        for (int i = 0; i < 8; ++i) { qo[i] = __shfl_xor(q[i], 1); ko[i] = __shfl_xor(k[i], 1); }
        const int sub = lane & 7;
        if (sub < 2) {
#pragma unroll
            for (int i = 0; i < 8; ++i) {
                constexpr float kInv[8] = {1.0f, 0.1939227432012558f, 0.03760603070259094f, 0.007292664609849453f, 0.0014142135623842478f, 0.00027424818836152554f, 5.3182957344688475e-05f, 1.0313385246263351e-05f};
                const float ang = pos * kInv[i]; const float kq = rintf(ang * 0.15915494309189535f);
                float rr = fmaf(-kq, 6.28318548202514648f, ang); rr = fmaf(-kq, -1.74845553146951715e-07f, rr);
                const float sn = __sinf(rr), cs = __cosf(rr);
                if (sub == 0) { q[i] = q[i] * cs - qo[i] * sn; k[i] = k[i] * cs - ko[i] * sn; }
                else          { q[i] = q[i] * cs + qo[i] * sn; k[i] = k[i] * cs + ko[i] * sn; }
            }
        }
#pragma unroll
        for (int i = 0; i < 8; ++i) q[i] *= 0.125f;
        st8((bf16*)(ws + WS_QN) + (size_t)t * 512 + c0, q); st8((bf16*)(ws + WS_KN) + (size_t)t * 512 + c0, k);
    }
}

DI void rwkv_scan_naive(unsigned char* ws, int w  , int lane) {
    const int z = w >> 9, h = (w >> 6) & 7, vr = w & 63;
    const float* LW = (const float*)(ws + (z ? WS_LW1 : WS_LW0));
    const bf16* KD = (const bf16*)(ws + (z ? WS_KD1 : WS_KD0)); const bf16* BB = (const bf16*)(ws + (z ? WS_B1 : WS_B0));
    const bf16* KK = (const bf16*)(ws + WS_KK); const bf16* R = (const bf16*)(ws + WS_R); const bf16* V = (const bf16*)(ws + WS_V);
    bf16* Y = (bf16*)(ws + (z ? WS_Y1 : WS_Y0));
    const int cc = h * 64 + lane, cv = h * 64 + vr;
    float S = 0.f;
    int t = z ? S_ - 1 : 0; const int dt = z ? -1 : 1;
    size_t o = (size_t)t * 512;
    float lw = LW[o + cc], kd = bf2f(KD[o + cc]), bb = bf2f(BB[o + cc]), kk = bf2f(KK[o + cc]), rr = bf2f(R[o + cc]), vv = bf2f(V[o + cv]);
    for (int s = 0; s < S_; ++s) {
        const int tn = t + dt; const bool more = s + 1 < S_;
        const size_t on = (size_t)(more ? tn : t) * 512;
        const float lw_n = LW[on + cc], kd_n = bf2f(KD[on + cc]), bb_n = bf2f(BB[on + cc]), kk_n = bf2f(KK[on + cc]), rr_n = bf2f(R[on + cc]), vv_n = bf2f(V[on + cv]);
        const float sa = wave_sum(S * (-kk));
        S = S * __expf(lw) + sa * bb + vv * kd;
        const float y = wave_sum(S * rr);
        if (lane == 0) Y[(size_t)t * 512 + cv] = (bf16)f2bf(y);
        lw = lw_n; kd = kd_n; bb = bb_n; kk = kk_n; rr = rr_n; vv = vv_n; t = tn;
    }
}

DI void attn_token_naive(unsigned char* ws, int t, int lane) {
    const bf16* QN = (const bf16*)(ws + WS_QN); const bf16* KN = (const bf16*)(ws + WS_KN); const bf16* P = (const bf16*)(ws + WS_PROJ0);
    const int c0 = 8 * lane;
    float q[8]; ld8(QN + (size_t)t * 512 + c0, q);
    float m = -1e30f, l = 0.f, acc[8];
#pragma unroll
    for (int i = 0; i < 8; ++i) acc[i] = 0.f;
    for (int br = 0; br < 3; ++br) {
        const int d = br == 0 ? 1 : (br == 1 ? 4 : 16);
        for (int mm = -64; mm <= 64; ++mm) {
            const int j = t + d * mm; if (j < 0 || j >= S_) continue;
            float k[8], v[8]; ld8(KN + (size_t)j * 512 + c0, k); ld8(P + (size_t)j * EVEN_IN + 1024 + c0, v);
            float s = 0.f;
#pragma unroll
            for (int i = 0; i < 8; ++i) s += q[i] * k[i];
            s = grp_sum<8>(s);
            const float mn = fmaxf(m, s), sc = __expf(m - mn), p = __expf(s - mn);
            l = l * sc + p;
#pragma unroll
            for (int i = 0; i < 8; ++i) acc[i] = acc[i] * sc + p * v[i];
            m = mn;
        }
    }
    const float il = 1.0f / l;
#pragma unroll
    for (int i = 0; i < 8; ++i) acc[i] *= il;
    st8((bf16*)(ws + WS_Y) + (size_t)t * D_ + c0, acc);
}

DI void rwkv_post_token(const Args& a, unsigned char* ws, int t, int lane) {
    const int c0 = 8 * lane; const size_t o = (size_t)t * 512 + c0;
    float y0[8], y1[8], g[8], bn[8], lw[8], lb[8];
    ld8((const bf16*)(ws + WS_Y0) + o, y0); ld8((const bf16*)(ws + WS_Y1) + o, y1); ld8((const bf16*)(ws + WS_GATE) + o, g); ld8((const bf16*)(ws + WS_BONUS) + o, bn);
    ld8f(a.in[19] + c0, lw); ld8f(a.in[20] + c0, lb);
    float s = 0.f;
#pragma unroll
    for (int i = 0; i < 8; ++i) { y0[i] += y1[i]; s += y0[i]; }
    const float mu = grp_sum<8>(s) * (1.0f / 64.f);
    float q = 0.f;
#pragma unroll
    for (int i = 0; i < 8; ++i) { y0[i] -= mu; q += y0[i] * y0[i]; }
    const float rs = 1.0f / sqrtf(grp_sum<8>(q) * (1.0f / 64.f) + 64e-5f);
#pragma unroll
    for (int i = 0; i < 8; ++i) y0[i] = (y0[i] * rs * lw[i] + lb[i] + bn[i]) * g[i];
    st8((bf16*)(ws + WS_Y) + (size_t)t * D_ + 512 + c0, y0);
}
typedef short s16x8 __attribute__((ext_vector_type(8)));
typedef short s16x4 __attribute__((ext_vector_type(4)));
typedef LAS unsigned char* ldsp;
DI f32x4 mfma16(s16x8 a, s16x8 b, f32x4 c) { return __builtin_amdgcn_mfma_f32_16x16x32_bf16(a, b, c, 0, 0, 0); }
DI s16x8 frag_row(ldsp img, int row0, int col0, int lane) { return *(LAS const s16x8*)(img + (row0 + (lane & 15)) * 128 + (col0 + 8 * (lane >> 4)) * 2); }
DI s16x4 tr16(ldsp p) { return __builtin_bit_cast(s16x4, __builtin_amdgcn_ds_read_tr16_b64_v4i16((LAS s16x4*)p)); }
DI s16x8 frag_tr(ldsp img, int row0, int col0, int lane) {
    ldsp a0 = img + (row0 + 8 * (lane >> 4) + ((lane & 15) >> 2)) * 128 + col0 * 2 + 8 * (lane & 3);
    const s16x4 lo = tr16(a0), hi = tr16(a0 + 4 * 128);
    return __builtin_shufflevector(lo, hi, 0, 1, 2, 3, 4, 5, 6, 7);
}
DI void ctile_to_img(ldsp img, int mt, int nt, const f32x4& c, int lane) {
    LAS bf16* p = (LAS bf16*)(img + (16 * mt + 4 * (lane >> 4)) * 128 + (16 * nt + (lane & 15)) * 2);
#pragma unroll
    for (int e = 0; e < 4; ++e) p[e * 64] = (bf16)f2bf(c[e]);
}
#define CFENCE() asm volatile("" ::: "memory")
#define MM_LOOPH(ACC, AEXPR, BEXPR) _Pragma("unroll") for (int mt = 2 * mh; mt < 2 * mh + 2; ++mt) _Pragma("unroll") for (int nt = 0; nt < 4; ++nt) _Pragma("unroll") for (int ks = 0; ks < 2; ++ks) ACC[mt][nt] = mfma16((AEXPR), (BEXPR), ACC[mt][nt])
#define MM_LOOP(ACC, AEXPR, BEXPR) _Pragma("unroll") for (int mt = 0; mt < 4; ++mt) _Pragma("unroll") for (int nt = 0; nt < 4; ++nt) _Pragma("unroll") for (int ks = 0; ks < 2; ++ks) ACC[mt][nt] = mfma16((AEXPR), (BEXPR), ACC[mt][nt])

DI int tok_of(int z, int cn, int i) { return z ? cn * 64 + 63 - i : cn * 64 + i; }

template <bool DRY = false, int STOP = 99> DI void rwkv_pass1_item(unsigned char* ws, ldsp lds, int item, int lane) {
    asm volatile("" : "+v"(lane));
    const int z = item >> 11, h = (item >> 8) & 7, c = item & 255;
    const int cn = z ? 255 - c : c;
    float* LW = (float*)(ws + (z ? WS_LW1 : WS_LW0));
    bf16* KD = (bf16*)(ws + (z ? WS_KD1 : WS_KD0)); bf16* BB = (bf16*)(ws + (z ? WS_B1 : WS_B0));
    const bf16* KK = (const bf16*)(ws + WS_KK); const bf16* R = (const bf16*)(ws + WS_R); const bf16* V = (const bf16*)(ws + WS_V);
    float* LWo = DRY ? (float*)(ws + WS_Y) : LW; bf16* KDo = DRY ? (bf16*)(ws + WS_Y) : KD; bf16* BBo = DRY ? (bf16*)(ws + WS_Y) : BB;
    ldsp S0 = lds, S1 = lds + 8192, S2 = lds + 16384, S3 = lds + 24576, S4 = lds + 32768, S5 = lds + 40960, S6 = lds + 49152, S7 = lds + 57344;
    ldsp IA = S0, IB = S1, IK = S2, IR = S3;
    const int ch = h * 64 + lane;
    float G = 0.f;
#pragma unroll 16
    for (int i = 0; i < 64; ++i) {
        const size_t o = (size_t)tok_of(z, cn, i) * 512 + ch;
        const float lw = LW[o], a = -bf2f(KK[o]), b = bf2f(BB[o]), kd = bf2f(KD[o]), r = bf2f(R[o]);
        const float eprev = __expf(G); G += lw; const float ecur = __expf(G), einv = __expf(-G);
        ((LAS bf16*)IA)[i * 64 + lane] = (bf16)f2bf(a * eprev); ((LAS bf16*)IB)[i * 64 + lane] = (bf16)f2bf(b * einv);
        ((LAS bf16*)IK)[i * 64 + lane] = (bf16)f2bf(kd * einv); ((LAS bf16*)IR)[i * 64 + lane] = (bf16)f2bf(r * ecur);
    }
    const float GT = __expf(G);
    LDS_WAIT(); CFENCE();
    if (STOP == 1) { if (GT == 123.f) LWo[0] = GT; return; }
    int lane2 = lane; asm volatile("" : "+v"(lane2));
    const int n_ = lane2 & 15, q_ = lane2 >> 4;
    {
#pragma unroll
        for (int mh = 0; mh < 2; ++mh) {
        f32x4 acc[4][4];
#pragma unroll
        for (int mt = 2 * mh; mt < 2 * mh + 2; ++mt)
#pragma unroll
            for (int nt = 0; nt < 4; ++nt) acc[mt][nt] = (f32x4){0.f, 0.f, 0.f, 0.f};
        MM_LOOPH(acc, frag_row(IA, 16 * mt, 32 * ks, lane), frag_row(IB, 16 * nt, 32 * ks, lane));
#pragma unroll
        for (int mt = 2 * mh; mt < 2 * mh + 2; ++mt)
#pragma unroll
            for (int nt = 0; nt < 4; ++nt)
#pragma unroll
                for (int e = 0; e < 4; ++e) { const int i = 16 * mt + 4 * q_ + e, j = 16 * nt + n_; ((LAS float*)S4)[i * 64 + j] = (j < i) ? acc[mt][nt][e] : 0.f; }
        }
    }
    LDS_WAIT(); CFENCE();
    if (STOP == 4) return;
    {
        float t[64];
        int lane_o = lane; asm volatile("" : "+v"(lane_o));
        f32x4 ar[2][16];
#pragma unroll
        for (int i = 0; i < 64; ++i) {
            if (i + 1 < 64) {
#pragma unroll
                for (int jg = 0; jg < (i + 1 + 3) / 4; ++jg) ar[(i + 1) & 1][jg] = *(LAS const f32x4*)(S4 + ((i + 1) * 64 + 4 * jg) * 4);
            }
            __builtin_amdgcn_sched_barrier(0);
            float acc0 = (lane_o == i) ? 1.f : 0.f, acc1 = 0.f, acc2 = 0.f, acc3 = 0.f;
#pragma unroll
            for (int jg = 0; jg < (i + 3) / 4; ++jg) { const f32x4 a4 = ar[i & 1][jg];
                if (4 * jg + 0 < i) acc0 += a4[0] * t[4 * jg + 0];
                if (4 * jg + 1 < i) acc1 += a4[1] * t[4 * jg + 1];
                if (4 * jg + 2 < i) acc2 += a4[2] * t[4 * jg + 2];
                if (4 * jg + 3 < i) acc3 += a4[3] * t[4 * jg + 3]; }
            t[i] = (acc0 + acc1) + (acc2 + acc3);
            __builtin_amdgcn_sched_barrier(0);
        }
        LDS_WAIT(); CFENCE();
#pragma unroll
        for (int i = 0; i < 64; ++i) ((LAS bf16*)S4)[i * 64 + lane] = (bf16)f2bf(t[i]);
    }
    LDS_WAIT(); CFENCE();
    if (STOP == 2) return;
    ldsp IT = S4, IW = S5, IAK = S6;
    {
#pragma unroll
        for (int mh = 0; mh < 2; ++mh) {
        f32x4 acc[4][4];
#pragma unroll
        for (int mt = 2 * mh; mt < 2 * mh + 2; ++mt)
#pragma unroll
            for (int nt = 0; nt < 4; ++nt) acc[mt][nt] = (f32x4){0.f, 0.f, 0.f, 0.f};
        MM_LOOPH(acc, frag_row(IA, 16 * mt, 32 * ks, lane), frag_row(IK, 16 * nt, 32 * ks, lane));
#pragma unroll
        for (int mt = 2 * mh; mt < 2 * mh + 2; ++mt)
#pragma unroll
            for (int nt = 0; nt < 4; ++nt) {
#pragma unroll
                for (int e = 0; e < 4; ++e) { const int i = 16 * mt + 4 * q_ + e, j = 16 * nt + n_; if (!(j < i)) acc[mt][nt][e] = 0.f; }
                ctile_to_img(IAK, mt, nt, acc[mt][nt], lane); }
        }
    }
    if (STOP == 5) return;
    {
#pragma unroll
        for (int mh = 0; mh < 2; ++mh) {
        f32x4 acc[4][4];
#pragma unroll
        for (int mt = 2 * mh; mt < 2 * mh + 2; ++mt)
#pragma unroll
            for (int nt = 0; nt < 4; ++nt) acc[mt][nt] = (f32x4){0.f, 0.f, 0.f, 0.f};
        MM_LOOPH(acc, frag_row(IT, 16 * mt, 32 * ks, lane), frag_tr(IA, 32 * ks, 16 * nt, lane));
#pragma unroll
        for (int mt = 2 * mh; mt < 2 * mh + 2; ++mt)
#pragma unroll
            for (int nt = 0; nt < 4; ++nt) ctile_to_img(IW, mt, nt, acc[mt][nt], lane);
        }
    }
    LDS_WAIT(); CFENCE();
    if (STOP == 6) return;
    ldsp IV = S0;
    {
        v4u vr[8];
#pragma unroll
        for (int it = 0; it < 8; ++it) vr[it] = *(const v4u*)(V + (size_t)tok_of(z, cn, (lane >> 3) + 8 * it) * 512 + h * 64 + (lane & 7) * 8);
#pragma unroll
        for (int it = 0; it < 8; ++it) *(LAS v4u*)(IV + ((lane >> 3) + 8 * it) * 128 + (lane & 7) * 16) = vr[it];
    }
    LDS_WAIT(); CFENCE();
    ldsp IAV = S7;
    {
#pragma unroll
        for (int mh = 0; mh < 2; ++mh) {
        f32x4 acc[4][4];
#pragma unroll
        for (int mt = 2 * mh; mt < 2 * mh + 2; ++mt)
#pragma unroll
            for (int nt = 0; nt < 4; ++nt) acc[mt][nt] = (f32x4){0.f, 0.f, 0.f, 0.f};
        MM_LOOPH(acc, frag_row(IAK, 16 * mt, 32 * ks, lane), frag_tr(IV, 32 * ks, 16 * nt, lane));
#pragma unroll
        for (int mt = 2 * mh; mt < 2 * mh + 2; ++mt)
#pragma unroll
            for (int nt = 0; nt < 4; ++nt) ctile_to_img(IAV, mt, nt, acc[mt][nt], lane);
        }
    }
    LDS_WAIT(); CFENCE();
    if (STOP == 7) return;
    ldsp IU = S6;
    {
#pragma unroll
        for (int mh = 0; mh < 2; ++mh) {
        f32x4 acc[4][4];
#pragma unroll
        for (int mt = 2 * mh; mt < 2 * mh + 2; ++mt)
#pragma unroll
            for (int nt = 0; nt < 4; ++nt) acc[mt][nt] = (f32x4){0.f, 0.f, 0.f, 0.f};
        MM_LOOPH(acc, frag_row(IT, 16 * mt, 32 * ks, lane), frag_tr(IAV, 32 * ks, 16 * nt, lane));
        LDS_WAIT(); CFENCE();
#pragma unroll
        for (int mt = 2 * mh; mt < 2 * mh + 2; ++mt)
#pragma unroll
            for (int nt = 0; nt < 4; ++nt) ctile_to_img(IU, mt, nt, acc[mt][nt], lane);
        }
    }
    LDS_WAIT(); CFENCE();
    if (STOP == 3) return;
    ldsp IRB = S4, IRK = S7;
    {
#pragma unroll
        for (int mh = 0; mh < 2; ++mh) {
        f32x4 acc[4][4];
#pragma unroll
        for (int mt = 2 * mh; mt < 2 * mh + 2; ++mt)
#pragma unroll
            for (int nt = 0; nt < 4; ++nt) acc[mt][nt] = (f32x4){0.f, 0.f, 0.f, 0.f};
        MM_LOOPH(acc, frag_row(IR, 16 * mt, 32 * ks, lane), frag_row(IB, 16 * nt, 32 * ks, lane));
#pragma unroll
        for (int mt = 2 * mh; mt < 2 * mh + 2; ++mt)
#pragma unroll
            for (int nt = 0; nt < 4; ++nt) {
#pragma unroll
                for (int e = 0; e < 4; ++e) { const int i = 16 * mt + 4 * q_ + e, j = 16 * nt + n_; if (!(j <= i)) acc[mt][nt][e] = 0.f; }
                ctile_to_img(IRB, mt, nt, acc[mt][nt], lane); }
        }
    }
    {
#pragma unroll
        for (int mh = 0; mh < 2; ++mh) {
        f32x4 acc[4][4];
#pragma unroll
        for (int mt = 2 * mh; mt < 2 * mh + 2; ++mt)
#pragma unroll
            for (int nt = 0; nt < 4; ++nt) acc[mt][nt] = (f32x4){0.f, 0.f, 0.f, 0.f};
        MM_LOOPH(acc, frag_row(IR, 16 * mt, 32 * ks, lane), frag_row(IK, 16 * nt, 32 * ks, lane));
#pragma unroll
        for (int mt = 2 * mh; mt < 2 * mh + 2; ++mt)
#pragma unroll
            for (int nt = 0; nt < 4; ++nt) {
#pragma unroll
                for (int e = 0; e < 4; ++e) { const int i = 16 * mt + 4 * q_ + e, j = 16 * nt + n_; if (!(j <= i)) acc[mt][nt][e] = 0.f; }
                ctile_to_img(IRK, mt, nt, acc[mt][nt], lane); }
        }
    }
    LDS_WAIT(); CFENCE();
    int lane3 = lane; asm volatile("" : "+v"(lane3));
    const int n3 = lane3 & 15, q3 = lane3 >> 4;
    const size_t slot0 = (size_t)cn * 64 * 512 + h * 64;
    {
#pragma unroll
        for (int mh = 0; mh < 2; ++mh) {
        f32x4 acc[4][4];
#pragma unroll
        for (int mt = 2 * mh; mt < 2 * mh + 2; ++mt)
#pragma unroll
            for (int nt = 0; nt < 4; ++nt) { const s16x4 r4 = *(LAS const s16x4*)(IR + (16 * nt + n3) * 128 + (16 * mt + 4 * q3) * 2);
#pragma unroll
                for (int e = 0; e < 4; ++e) acc[mt][nt][e] = bf2f((bf16)r4[e]); }
        MM_LOOPH(acc, frag_tr(IW, 32 * ks, 16 * mt, lane), frag_row(IRB, 16 * nt, 32 * ks, lane));
#pragma unroll
        for (int mt = 2 * mh; mt < 2 * mh + 2; ++mt)
#pragma unroll
            for (int nt = 0; nt < 4; ++nt) { bf16* dst = (bf16*)(LWo + slot0 + (size_t)(16 * nt + n3) * 512) + 16 * mt + 4 * q3;
                *(unsigned long long*)dst = (unsigned long long)pk2(acc[mt][nt][0], acc[mt][nt][1]) | ((unsigned long long)pk2(acc[mt][nt][2], acc[mt][nt][3]) << 32); }
        }
    }
    {
#pragma unroll
        for (int mh = 0; mh < 2; ++mh) {
        f32x4 acc[4][4];
#pragma unroll
        for (int mt = 2 * mh; mt < 2 * mh + 2; ++mt)
#pragma unroll
            for (int nt = 0; nt < 4; ++nt) acc[mt][nt] = (f32x4){0.f, 0.f, 0.f, 0.f};
        MM_LOOPH(acc, frag_tr(IU, 32 * ks, 16 * mt, lane), frag_row(IRB, 16 * nt, 32 * ks, lane));
        MM_LOOPH(acc, frag_tr(IV, 32 * ks, 16 * mt, lane), frag_row(IRK, 16 * nt, 32 * ks, lane));
#pragma unroll
        for (int mt = 2 * mh; mt < 2 * mh + 2; ++mt)
#pragma unroll
            for (int nt = 0; nt < 4; ++nt) { bf16* dst = (bf16*)(LWo + slot0 + (size_t)(16 * nt + n3) * 512) + 64 + 16 * mt + 4 * q3;
                *(unsigned long long*)dst = (unsigned long long)pk2(acc[mt][nt][0], acc[mt][nt][1]) | ((unsigned long long)pk2(acc[mt][nt][2], acc[mt][nt][3]) << 32); }
        }
    }
    {
#pragma unroll
        for (int mh = 0; mh < 2; ++mh) {
        f32x4 acc[4][4];
#pragma unroll
        for (int mt = 2 * mh; mt < 2 * mh + 2; ++mt)
#pragma unroll
            for (int nt = 0; nt < 4; ++nt) acc[mt][nt] = (f32x4){0.f, 0.f, 0.f, 0.f};
        MM_LOOPH(acc, frag_tr(IW, 32 * ks, 16 * mt, lane), frag_tr(IB, 32 * ks, 16 * nt, lane));
#pragma unroll
        for (int nt = 0; nt < 4; ++nt) { const float gk = __shfl(GT, 16 * nt + n3);
#pragma unroll
            for (int mt = 2 * mh; mt < 2 * mh + 2; ++mt) { float o[4];
#pragma unroll
                for (int e = 0; e < 4; ++e) o[e] = gk * (acc[mt][nt][e] + ((16 * mt + 4 * q3 + e) == (16 * nt + n3) ? 1.f : 0.f));
                bf16* dst = KDo + slot0 + (size_t)(16 * nt + n3) * 512 + 16 * mt + 4 * q3;
                *(unsigned long long*)dst = (unsigned long long)pk2(o[0], o[1]) | ((unsigned long long)pk2(o[2], o[3]) << 32); } }
        }
    }
    {
#pragma unroll
        for (int mh = 0; mh < 2; ++mh) {
        f32x4 acc[4][4];
#pragma unroll
        for (int mt = 2 * mh; mt < 2 * mh + 2; ++mt)
#pragma unroll
            for (int nt = 0; nt < 4; ++nt) acc[mt][nt] = (f32x4){0.f, 0.f, 0.f, 0.f};
        MM_LOOPH(acc, frag_tr(IB, 32 * ks, 16 * mt, lane), frag_tr(IU, 32 * ks, 16 * nt, lane));
        MM_LOOPH(acc, frag_tr(IK, 32 * ks, 16 * mt, lane), frag_tr(IV, 32 * ks, 16 * nt, lane));
#pragma unroll
        for (int mt = 2 * mh; mt < 2 * mh + 2; ++mt) { float gk[4];
#pragma unroll
            for (int e = 0; e < 4; ++e) gk[e] = __shfl(GT, 16 * mt + 4 * q3 + e);
#pragma unroll
            for (int nt = 0; nt < 4; ++nt) { bf16* dst = BBo + slot0 + (size_t)(16 * nt + n3) * 512 + 16 * mt + 4 * q3;
                *(unsigned long long*)dst = (unsigned long long)pk2(gk[0] * acc[mt][nt][0], gk[1] * acc[mt][nt][1]) | ((unsigned long long)pk2(gk[2] * acc[mt][nt][2], gk[3] * acc[mt][nt][3]) << 32); } }
        }
    }
    LDS_WAIT(); CFENCE();
}
DI unsigned long long pk4(const f32x4& v) { return (unsigned long long)pk2(v[0], v[1]) | ((unsigned long long)pk2(v[2], v[3]) << 32); }
DI f32x4 unpk4(unsigned long long w) { return (f32x4){bflo((unsigned)w), bfhi((unsigned)w), bflo((unsigned)(w >> 32)), bfhi((unsigned)(w >> 32))}; }
DI s16x8 pack_cpair(const f32x4& lo, const f32x4& hi) {
    v4u p; p.x = pk2(lo[0], lo[1]); p.y = pk2(lo[2], lo[3]); p.z = pk2(hi[0], hi[1]); p.w = pk2(hi[2], hi[3]);
    return __builtin_bit_cast(s16x8, p);
}
DI void rwkv_pass2_wave(unsigned char* ws, int w  , int lane) {
    const int z = w >> 5, h = (w >> 2) & 7, vs = w & 3;
    const bf16* Mm = (const bf16*)(ws + (z ? WS_KD1 : WS_KD0)); const bf16* Nn = (const bf16*)(ws + (z ? WS_B1 : WS_B0));
    bf16* Hst = (bf16*)(ws + (z ? WS_V : WS_R));
    const int n_ = lane & 15, q_ = lane >> 4;
    f32x4 H[4];
#pragma unroll
    for (int kt = 0; kt < 4; ++kt) H[kt] = (f32x4){0.f, 0.f, 0.f, 0.f};
    unsigned long long ma[4][2][2], nn[4];
    {
        const int cn = z ? 255 : 0; const size_t slot0 = (size_t)cn * 64 * 512 + h * 64;
#pragma unroll
        for (int kt = 0; kt < 4; ++kt) {
#pragma unroll
            for (int ks = 0; ks < 2; ++ks) { const bf16* row = Mm + slot0 + (size_t)(16 * kt + n_) * 512 + 32 * ks + 4 * q_;
                ma[kt][ks][0] = *(const unsigned long long*)row; ma[kt][ks][1] = *(const unsigned long long*)(row + 16); }
            nn[kt] = *(const unsigned long long*)(Nn + slot0 + (size_t)(16 * vs + n_) * 512 + 16 * kt + 4 * q_); }
    }
    for (int c = 0; c < 256; ++c) {
        { bf16* dst = Hst + ((size_t)(c * 8 + h) * 64 + 16 * vs + n_) * 64 + 4 * q_;
#pragma unroll
          for (int kt = 0; kt < 4; ++kt) *(unsigned long long*)(dst + 16 * kt) = (unsigned long long)pk2(H[kt][0], H[kt][1]) | ((unsigned long long)pk2(H[kt][2], H[kt][3]) << 32); }
        unsigned long long ma2[4][2][2], nn2[4];
        { const int c2 = c + 1 < 256 ? c + 1 : c; const int cn = z ? 255 - c2 : c2; const size_t slot0 = (size_t)cn * 64 * 512 + h * 64;
#pragma unroll
          for (int kt = 0; kt < 4; ++kt) {
#pragma unroll
            for (int ks = 0; ks < 2; ++ks) { const bf16* row = Mm + slot0 + (size_t)(16 * kt + n_) * 512 + 32 * ks + 4 * q_;
                ma2[kt][ks][0] = *(const unsigned long long*)row; ma2[kt][ks][1] = *(const unsigned long long*)(row + 16); }
            nn2[kt] = *(const unsigned long long*)(Nn + slot0 + (size_t)(16 * vs + n_) * 512 + 16 * kt + 4 * q_); } }
        const s16x8 b0 = pack_cpair(H[0], H[1]), b1 = pack_cpair(H[2], H[3]);
#pragma unroll
        for (int kt = 0; kt < 4; ++kt) {
            f32x4 acc = (f32x4){bflo((unsigned)nn[kt]), bfhi((unsigned)nn[kt]), bflo((unsigned)(nn[kt] >> 32)), bfhi((unsigned)(nn[kt] >> 32))};
            { v4u a; a.x = (unsigned)ma[kt][0][0]; a.y = (unsigned)(ma[kt][0][0] >> 32); a.z = (unsigned)ma[kt][0][1]; a.w = (unsigned)(ma[kt][0][1] >> 32); acc = mfma16(__builtin_bit_cast(s16x8, a), b0, acc); }
            { v4u a; a.x = (unsigned)ma[kt][1][0]; a.y = (unsigned)(ma[kt][1][0] >> 32); a.z = (unsigned)ma[kt][1][1]; a.w = (unsigned)(ma[kt][1][1] >> 32); acc = mfma16(__builtin_bit_cast(s16x8, a), b1, acc); }
            H[kt] = acc;
        }
#pragma unroll
        for (int kt = 0; kt < 4; ++kt) { nn[kt] = nn2[kt];
#pragma unroll
            for (int ks = 0; ks < 2; ++ks) { ma[kt][ks][0] = ma2[kt][ks][0]; ma[kt][ks][1] = ma2[kt][ks][1]; } }
    }
}
DI void rwkv_pass3_item(unsigned char* ws, int item, int lane) {
    const int z = item >> 11, h = (item >> 8) & 7, c = item & 255;
    const int cn = z ? 255 - c : c;
    const float* LW = (const float*)(ws + (z ? WS_LW1 : WS_LW0));
    const bf16* Hst = (const bf16*)(ws + (z ? WS_V : WS_R)) + (size_t)(c * 8 + h) * 64 * 64;
    bf16* Y = (bf16*)(ws + (z ? WS_Y1 : WS_Y0));
    const int n_ = lane & 15, q_ = lane >> 4;
    const size_t slot0 = (size_t)cn * 64 * 512 + h * 64;
    s16x8 hA[4][2], qB[4][2];
#pragma unroll
    for (int t = 0; t < 4; ++t)
#pragma unroll
        for (int ks = 0; ks < 2; ++ks) {
            hA[t][ks] = *(const s16x8*)(Hst + (size_t)(16 * t + n_) * 64 + 32 * ks + 8 * q_);
            qB[t][ks] = *(const s16x8*)((const bf16*)(LW + slot0 + (size_t)(16 * t + n_) * 512) + 32 * ks + 8 * q_); }
#pragma unroll
    for (int nt = 0; nt < 4; ++nt) {
        const int i = 16 * nt + n_; const bf16* ycrow = (const bf16*)(LW + slot0 + (size_t)i * 512) + 64;
        bf16* yrow = Y + (size_t)tok_of(z, cn, i) * 512 + h * 64;
#pragma unroll
        for (int mt = 0; mt < 4; ++mt) {
            const unsigned long long y4 = *(const unsigned long long*)(ycrow + 16 * mt + 4 * q_);
            f32x4 acc = (f32x4){bflo((unsigned)y4), bfhi((unsigned)y4), bflo((unsigned)(y4 >> 32)), bfhi((unsigned)(y4 >> 32))};
            acc = mfma16(hA[mt][0], qB[nt][0], acc); acc = mfma16(hA[mt][1], qB[nt][1], acc);
            *(unsigned long long*)(yrow + 16 * mt + 4 * q_) = (unsigned long long)pk2(acc[0], acc[1]) | ((unsigned long long)pk2(acc[2], acc[3]) << 32);
        }
    }
}
DI void rwkv_pass2_block(unsigned char* ws, ldsp L, int b  , int wave, int lane) {
    const int z = b >> 3, h = b & 7;
    if (wave >= 4) {
        const int lw = wave - 4;
        const char* Mm = (const char*)(ws + (z ? WS_KD1 : WS_KD0)); const char* Nn = (const char*)(ws + (z ? WS_B1 : WS_B0));
#define RW_ISSUE(cc) do { const int c_ = (cc); if (c_ < 256) { const int cn_ = z ? 255 - c_ : c_; const size_t slot0 = ((size_t)cn_ * 64 * 512 + h * 64) * 2; ldsp slot = L + (c_ & 7) * 16384; \
            _Pragma("unroll") for (int k = 0; k < 4; ++k) { const int pid = lw * 4 + k; const int pr = pid & 7; const int row = 8 * pr + (lane >> 3), p = lane & 7, cch = p ^ (row & 7); \
                const char* src = (pid < 8 ? Mm : Nn) + slot0 + (size_t)row * 1024 + cch * 16; \
                __builtin_amdgcn_global_load_lds((const unsigned*)src, (LAS unsigned*)(slot + (pid < 8 ? 0 : 8192) + pr * 1024), 16, 0, 0); } } } while (0)
        RW_ISSUE(0); RW_ISSUE(1); RW_ISSUE(2); RW_ISSUE(3); RW_ISSUE(4); RW_ISSUE(5); RW_ISSUE(6);
        for (int c = 0; c < 256; ++c) {
            if (c < 250) asm volatile("s_waitcnt vmcnt(24)" ::: "memory"); else asm volatile("s_waitcnt vmcnt(0)" ::: "memory");
            __builtin_amdgcn_s_barrier();
            asm volatile("" ::: "memory");
            RW_ISSUE(c + 7);
        }
#undef RW_ISSUE
        asm volatile("s_waitcnt vmcnt(0)" ::: "memory");
        return;
    }
    const int vs = wave;
    bf16* Hst = (bf16*)(ws + (z ? WS_V : WS_R));
    const int n_ = lane & 15, q_ = lane >> 4, wbyte = (q_ & 1) * 8, sw = n_ & 7;
    f32x4 H[4];
#pragma unroll
    for (int kt = 0; kt < 4; ++kt) H[kt] = (f32x4){0.f, 0.f, 0.f, 0.f};
    for (int c = 0; c < 256; ++c) {
        { bf16* dst = Hst + ((size_t)(c * 8 + h) * 64 + 16 * vs + n_) * 64 + 4 * q_;
#pragma unroll
          for (int kt = 0; kt < 4; ++kt) *(unsigned long long*)(dst + 16 * kt) = pk4(H[kt]); }
        asm volatile("s_waitcnt lgkmcnt(0)" ::: "memory");
        __builtin_amdgcn_s_barrier();
        asm volatile("" ::: "memory");
        ldsp slot = L + (c & 7) * 16384;
        const s16x8 b0 = pack_cpair(H[0], H[1]), b1 = pack_cpair(H[2], H[3]);
#pragma unroll
        for (int kt = 0; kt < 4; ++kt) {
            ldsp nrow = slot + 8192 + (16 * vs + n_) * 128 + wbyte;
            f32x4 acc = unpk4(*(LAS const unsigned long long*)(nrow + (((2 * kt + (q_ >> 1)) ^ sw) * 16)));
            ldsp mrow = slot + (16 * kt + n_) * 128 + wbyte;
#pragma unroll
            for (int ks = 0; ks < 2; ++ks) { const int c0 = 4 * ks + (q_ >> 1);
                const unsigned long long a0 = *(LAS const unsigned long long*)(mrow + ((c0 ^ sw) * 16)), a1 = *(LAS const unsigned long long*)(mrow + (((c0 + 2) ^ sw) * 16));
                v4u a; a.x = (unsigned)a0; a.y = (unsigned)(a0 >> 32); a.z = (unsigned)a1; a.w = (unsigned)(a1 >> 32);
                acc = mfma16(__builtin_bit_cast(s16x8, a), ks == 0 ? b0 : b1, acc); }
            H[kt] = acc;
        }
    }
}
DI void rwkv_pass3_post_item(const Args& a, unsigned char* ws, int item, int lane) {
    asm volatile("" : "+v"(lane));
    const int h = item >> 8, cn = item & 255;
    const int n_ = lane & 15, q_ = lane >> 4;
    const size_t slot0 = (size_t)cn * 64 * 512 + h * 64;
    const float* LW0 = (const float*)(ws + WS_LW0); const float* LW1 = (const float*)(ws + WS_LW1);
    const bf16* H0 = (const bf16*)(ws + WS_R) + (size_t)(cn * 8 + h) * 4096;
    const bf16* H1 = (const bf16*)(ws + WS_V) + (size_t)((255 - cn) * 8 + h) * 4096;
    s16x8 hA0[4][2], hA1[4][2];
#pragma unroll
    for (int t = 0; t < 4; ++t)
#pragma unroll
        for (int ks = 0; ks < 2; ++ks) { hA0[t][ks] = *(const s16x8*)(H0 + (size_t)(16 * t + n_) * 64 + 32 * ks + 8 * q_); hA1[t][ks] = *(const s16x8*)(H1 + (size_t)(16 * t + n_) * 64 + 32 * ks + 8 * q_); }
#pragma unroll
    for (int nt = 0; nt < 4; ++nt) {
        const int i0 = 16 * nt + n_, i1 = 63 - i0;
        const bf16* q0 = (const bf16*)(LW0 + slot0 + (size_t)i0 * 512); const bf16* q1 = (const bf16*)(LW1 + slot0 + (size_t)i1 * 512);
        s16x8 qB0[2], qB1[2];
#pragma unroll
        for (int ks = 0; ks < 2; ++ks) { qB0[ks] = *(const s16x8*)(q0 + 32 * ks + 8 * q_); qB1[ks] = *(const s16x8*)(q1 + 32 * ks + 8 * q_); }
        f32x4 y[4]; float sum = 0.f;
#pragma unroll
        for (int mt = 0; mt < 4; ++mt) {
            f32x4 acc = unpk4(*(const unsigned long long*)(q0 + 64 + 16 * mt + 4 * q_)) + unpk4(*(const unsigned long long*)(q1 + 64 + 16 * mt + 4 * q_));
            acc = mfma16(hA0[mt][0], qB0[0], acc); acc = mfma16(hA0[mt][1], qB0[1], acc);
            acc = mfma16(hA1[mt][0], qB1[0], acc); acc = mfma16(hA1[mt][1], qB1[1], acc);
            y[mt] = acc; sum += (acc[0] + acc[1]) + (acc[2] + acc[3]);
        }
        sum += __shfl_xor(sum, 16); sum += __shfl_xor(sum, 32);
        const float mu = sum * (1.0f / 64.f); float sq = 0.f;
#pragma unroll
        for (int mt = 0; mt < 4; ++mt)
#pragma unroll
            for (int e = 0; e < 4; ++e) { y[mt][e] -= mu; sq += y[mt][e] * y[mt][e]; }
        sq += __shfl_xor(sq, 16); sq += __shfl_xor(sq, 32);
        const float rs = 1.0f / sqrtf(sq * (1.0f / 64.f) + 64e-5f);
        const size_t tok = (size_t)(cn * 64 + i0);
#pragma unroll
        for (int mt = 0; mt < 4; ++mt) { const int c0 = h * 64 + 16 * mt + 4 * q_;
            const f32x4 lw = *(const f32x4*)(a.in[19] + c0), lb = *(const f32x4*)(a.in[20] + c0);
            const f32x4 bn = unpk4(*(const unsigned long long*)((const bf16*)(ws + WS_BONUS) + tok * 512 + c0)), gt = unpk4(*(const unsigned long long*)((const bf16*)(ws + WS_GATE) + tok * 512 + c0));
            const f32x4 o = (y[mt] * rs * lw + lb + bn) * gt;
            *(unsigned long long*)((bf16*)(ws + WS_Y) + tok * D_ + 512 + c0) = pk4(o); }
    }
}
constexpr size_t WS_W2T = WS_TILE + 65536;
constexpr size_t WS_PARK = WS_Y;
DI s16x8 act_frag(const bf16* p, int mode) {
    float v[8]; ld8(p, v);
#pragma unroll
    for (int i = 0; i < 8; ++i) { if (mode == 0) v[i] = 1.0f - 2.0f / (__expf(2.0f * v[i]) + 1.0f); else if (mode == 2) v[i] = 1.0f / (1.0f + __expf(-v[i])); }
    v4u w; w.x = pk2(v[0], v[1]); w.y = pk2(v[2], v[3]); w.z = pk2(v[4], v[5]); w.w = pk2(v[6], v[7]);
    return __builtin_bit_cast(s16x8, w);
}
DI void ld4(const bf16* p, float (&v)[4]) { const unsigned long long w = *(const unsigned long long*)p; v[0] = bflo((unsigned)w); v[1] = bfhi((unsigned)w); v[2] = bflo((unsigned)(w >> 32)); v[3] = bfhi((unsigned)(w >> 32)); }
DI void st4(bf16* p, const float (&v)[4]) { *(unsigned long long*)p = (unsigned long long)pk2(v[0], v[1]) | ((unsigned long long)pk2(v[2], v[3]) << 32); }
DI void prep0_rwkv_unit(const Args& a, unsigned char* ws, ldsp wl, int tile, int h, int lane) {
    asm volatile("" : "+v"(lane));
    const int t0 = tile * 16, n_ = lane & 15, q_ = lane >> 4, t = t0 + n_;
    const bf16* LR = (const bf16*)(ws + WS_LORA) + (size_t)t * LORA_N + 8 * q_;
    const bf16* P = (const bf16*)(ws + WS_PROJ0) + (size_t)t * EVEN_IN + 1536 + h * 64 + 4 * q_;
    const bool hp = t > 0, hn = t < S_ - 1;
    v4u lraw[12];
#pragma unroll
    for (int i = 0; i < 12; ++i) lraw[i] = *(const v4u*)(LR + 32 * i);
    unsigned long long cu[3][4], pv[3][4], nx[3][4];
#pragma unroll
    for (int part = 0; part < 3; ++part)
#pragma unroll
        for (int mt = 0; mt < 4; ++mt) { const bf16* p = P + part * 512 + 16 * mt;
            cu[part][mt] = *(const unsigned long long*)p; pv[part][mt] = hp ? *(const unsigned long long*)(p - EVEN_IN) : 0ull; nx[part][mt] = hn ? *(const unsigned long long*)(p + EVEN_IN) : 0ull; }
    float r[16], k[16], v[16];
#pragma unroll
    for (int part = 0; part < 3; ++part)
#pragma unroll
        for (int mt = 0; mt < 4; ++mt) { const int c0 = h * 64 + 16 * mt + 4 * q_;
            const f32x4 m0 = *(const f32x4*)(a.in[6] + part * 512 + c0), m1 = *(const f32x4*)(a.in[6] + 1536 + part * 512 + c0);
            const f32x4 c4 = unpk4(cu[part][mt]), p4 = unpk4(pv[part][mt]), n4 = unpk4(nx[part][mt]);
#pragma unroll
            for (int e = 0; e < 4; ++e) { const float o = c4[e] + m0[e] * (p4[e] - c4[e]) + m1[e] * (n4[e] - c4[e]);
                if (part == 0) r[4 * mt + e] = o; else if (part == 1) k[4 * mt + e] = o; else v[4 * mt + e] = o; } }
    float ss = 0.f;
#pragma unroll
    for (int mt = 0; mt < 4; ++mt) { const f32x4 kkw = *(const f32x4*)(a.in[16] + h * 64 + 16 * mt + 4 * q_);
#pragma unroll
        for (int e = 0; e < 4; ++e) { const float x = k[4 * mt + e] * kkw[e]; ss += x * x; } }
    ss += __shfl_xor(ss, 16); ss += __shfl_xor(ss, 32);
    const float rn = 1.0f / sqrtf(ss + 1e-6f);
    s16x8 lfr[12];
#pragma unroll
    for (int i = 0; i < 12; ++i) { float x[8]; const v4u w = lraw[i];
        x[0] = bflo(w.x); x[1] = bfhi(w.x); x[2] = bflo(w.y); x[3] = bfhi(w.y); x[4] = bflo(w.z); x[5] = bfhi(w.z); x[6] = bflo(w.w); x[7] = bfhi(w.w);
#pragma unroll
        for (int j = 0; j < 8; ++j) { if (i < 4) x[j] = 1.0f - 2.0f * __builtin_amdgcn_rcpf(__expf(2.0f * x[j]) + 1.0f); else if (i >= 8) x[j] = __builtin_amdgcn_rcpf(1.0f + __expf(-x[j])); }
        v4u o; o.x = pk2(x[0], x[1]); o.y = pk2(x[2], x[3]); o.z = pk2(x[4], x[5]); o.w = pk2(x[6], x[7]); lfr[i] = __builtin_bit_cast(s16x8, o); }
    float dotb = 0.f;
#pragma unroll
    for (int mt = 0; mt < 4; ++mt) {
        const int c0 = h * 64 + 16 * mt + 4 * q_;
        f32x4 aw0 = *(const f32x4*)(a.in[8] + c0), aw1 = *(const f32x4*)(a.in[8] + 512 + c0), aa0 = *(const f32x4*)(a.in[11] + c0), aa1 = *(const f32x4*)(a.in[11] + 512 + c0), ag = (f32x4){0.f, 0.f, 0.f, 0.f};
        const int rl = 16 * mt + n_, sw = rl & 7;
#pragma unroll
        for (int ks = 0; ks < 2; ++ks) { const int po = ((4 * ks + q_) ^ sw) * 16;
            aw0 = mfma16(*(LAS const s16x8*)(wl + rl * 128 + po), lfr[ks], aw0);
            aw1 = mfma16(*(LAS const s16x8*)(wl + 8192 + rl * 128 + po), lfr[2 + ks], aw1);
            aa0 = mfma16(*(LAS const s16x8*)(wl + 16384 + rl * 128 + po), lfr[4 + ks], aa0);
            aa1 = mfma16(*(LAS const s16x8*)(wl + 24576 + rl * 128 + po), lfr[6 + ks], aa1);
        }
#pragma unroll
        for (int ks = 0; ks < 4; ++ks) ag = mfma16(*(LAS const s16x8*)(wl + 32768 + rl * 256 + ((((4 * ks + q_) & 8) | (((4 * ks + q_) & 7) ^ sw)) * 16)), lfr[8 + ks], ag);
        const f32x4 kkw = *(const f32x4*)(a.in[16] + c0), kaw = *(const f32x4*)(a.in[17] + c0), rkw = *(const f32x4*)(a.in[18] + c0);
        float l0[4], l1[4], g4[4], d0[4], d1[4], kk4[4], b0[4], b1[4], r4[4], v4[4];
#pragma unroll
        for (int e = 0; e < 4; ++e) { const int i = 4 * mt + e;
            l0[e] = -__expf(-__logf(1.0f + __expf(-aw0[e])) - 0.5f); l1[e] = -__expf(-__logf(1.0f + __expf(-aw1[e])) - 0.5f);
            const float i0 = __builtin_amdgcn_rcpf(1.0f + __expf(-aa0[e])), i1 = __builtin_amdgcn_rcpf(1.0f + __expf(-aa1[e])); g4[e] = ag[e];
            kk4[e] = k[i] * kkw[e] * rn; b0[e] = kk4[e] * i0; b1[e] = kk4[e] * i1;
            d0[e] = k[i] * (1.0f + (i0 - 1.0f) * kaw[e]); d1[e] = k[i] * (1.0f + (i1 - 1.0f) * kaw[e]);
            dotb += r[i] * (d0[e] + d1[e]) * rkw[e]; r4[e] = r[i]; v4[e] = v[i]; }
        const size_t o = (size_t)t * 512 + c0;
        *(f32x4*)((float*)(ws + WS_LW0) + o) = (f32x4){l0[0], l0[1], l0[2], l0[3]};
        *(f32x4*)((float*)(ws + WS_LW1) + o) = (f32x4){l1[0], l1[1], l1[2], l1[3]};
        st4((bf16*)(ws + WS_R) + o, r4); st4((bf16*)(ws + WS_V) + o, v4); st4((bf16*)(ws + WS_KK) + o, kk4); st4((bf16*)(ws + WS_KD0) + o, d0); st4((bf16*)(ws + WS_KD1) + o, d1);
        st4((bf16*)(ws + WS_B0) + o, b0); st4((bf16*)(ws + WS_B1) + o, b1); st4((bf16*)(ws + WS_GATE) + o, g4);
    }
    dotb += __shfl_xor(dotb, 16); dotb += __shfl_xor(dotb, 32);
#pragma unroll
    for (int mt = 0; mt < 4; ++mt) { float bo[4];
#pragma unroll
        for (int e = 0; e < 4; ++e) bo[e] = dotb * v[4 * mt + e];
        st4((bf16*)(ws + WS_BONUS) + (size_t)t * 512 + h * 64 + 16 * mt + 4 * q_, bo); }
}
DI void prep0_stage_w2t(unsigned char* ws, ldsp wl, int h, int tid) {
    const bf16* W2T = (const bf16*)(ws + WS_W2T);
    for (int i = tid; i < 3072; i += 512) {
        if (i < 2048) { const int mtx = i >> 9, r = (i >> 3) & 63, c = i & 7;
            *(LAS v4u*)(wl + mtx * 8192 + r * 128 + ((c ^ (r & 7)) * 16)) = *(const v4u*)(W2T + (size_t)mtx * 32768 + (size_t)(h * 64 + r) * 64 + c * 8); }
        else { const int j = i - 2048, r = j >> 4, c = j & 15;
            *(LAS v4u*)(wl + 32768 + r * 256 + (((c & 8) | ((c & 7) ^ (r & 7))) * 16)) = *(const v4u*)(W2T + 131072 + (size_t)(h * 64 + r) * 128 + c * 8); }
    }
}
constexpr int AT_ACC = 0, AT_M = 65536, AT_L = 66560, AT_V = 67584;
DI void attn_unit(unsigned char* ws, ldsp L, int unit, int wave, int lane) {
    const int h = unit & 7, T0 = (unit >> 3) * 256;
    const bf16* QN = (const bf16*)(ws + WS_QN); const bf16* KN = (const bf16*)(ws + WS_KN); const bf16* P0 = (const bf16*)(ws + WS_PROJ0);
    LAS float* accO = (LAS float*)(L + AT_ACC); LAS float* accM = (LAS float*)(L + AT_M); LAS float* accL = (LAS float*)(L + AT_L);
    ldsp Vst = L + AT_V + wave * 8192;
#pragma unroll 1
    for (int br = 0; br < 3; ++br) {
        const int d = br == 0 ? 1 : (br == 1 ? 4 : 16);
#pragma unroll 1
        for (int si = 0; si < 2; ++si) {
            int lane_s = lane; asm volatile("" : "+v"(lane_s));
            const int n_ = lane_s & 15, q_ = lane_s >> 4;
            const int sidx = wave + 8 * si;
            const int tb = br == 0 ? T0 + 16 * sidx : (br == 1 ? T0 + (sidx & 3) + 64 * (sidx >> 2) : T0 + sidx);
            s16x8 qf[2];
            { const bf16* qrow = QN + (size_t)(tb + d * n_) * 512 + h * 64 + 8 * q_; qf[0] = *(const s16x8*)qrow; qf[1] = *(const s16x8*)(qrow + 32); }
            v4u vreg[5][4];
#pragma unroll
            for (int pp = 0; pp < 2; ++pp)
#pragma unroll
                for (int it = 0; it < 4; ++it) { const int pc = lane + 64 * it, row = pc >> 3, ck = pc & 7;
                    int tk = tb + d * (32 * pp + row - 64); tk = tk < 0 ? 0 : (tk > S_ - 1 ? S_ - 1 : tk);
                    vreg[pp][it] = *(const v4u*)(P0 + (size_t)tk * EVEN_IN + 1024 + h * 64 + ck * 8); }
            f32x4 st[10];
#pragma unroll
            for (int kt = 0; kt < 10; ++kt) {
                int tk = tb + d * (16 * kt + n_ - 64); tk = tk < 0 ? 0 : (tk > S_ - 1 ? S_ - 1 : tk);
                const bf16* krow = KN + (size_t)tk * 512 + h * 64 + 8 * q_;
                f32x4 acc = (f32x4){0.f, 0.f, 0.f, 0.f};
                acc = mfma16(*(const s16x8*)krow, qf[0], acc); acc = mfma16(*(const s16x8*)(krow + 32), qf[1], acc);
                st[kt] = acc;
            }
            float mx = -3.0e38f;
#pragma unroll
            for (int kt = 0; kt < 10; ++kt)
#pragma unroll
                for (int e = 0; e < 4; ++e) { const int j = 16 * kt + 4 * q_ + e; const int tk = tb + d * (j - 64);
                    const bool ok = (j >= n_) && (j <= n_ + 128) && (tk >= 0) && (tk < S_);
                    st[kt][e] = ok ? st[kt][e] : -3.0e38f; mx = fmaxf(mx, st[kt][e]); }
            mx = fmaxf(mx, __shfl_xor(mx, 16)); mx = fmaxf(mx, __shfl_xor(mx, 32));
            float ls = 0.f;
#pragma unroll
            for (int kt = 0; kt < 10; ++kt)
#pragma unroll
                for (int e = 0; e < 4; ++e) { const float p = st[kt][e] > -1.0e38f ? __expf(st[kt][e] - mx) : 0.f; st[kt][e] = p; ls += p; }
            ls += __shfl_xor(ls, 16); ls += __shfl_xor(ls, 32);
#pragma unroll
            for (int pp = 2; pp < 5; ++pp)
#pragma unroll
                for (int it = 0; it < 4; ++it) { const int pc = lane + 64 * it, row = pc >> 3, ck = pc & 7;
                    int tk = tb + d * (32 * pp + row - 64); tk = tk < 0 ? 0 : (tk > S_ - 1 ? S_ - 1 : tk);
                    vreg[pp][it] = *(const v4u*)(P0 + (size_t)tk * EVEN_IN + 1024 + h * 64 + ck * 8); }
            f32x4 O[4];
#pragma unroll
            for (int dt = 0; dt < 4; ++dt) O[dt] = (f32x4){0.f, 0.f, 0.f, 0.f};
#pragma unroll
            for (int pp = 0; pp < 5; ++pp) {
                ldsp vb = Vst + (pp & 1) * 4096;
#pragma unroll
                for (int it = 0; it < 4; ++it) { const int pc = lane + 64 * it, row = pc >> 3, ck = pc & 7; *(LAS v4u*)(vb + row * 128 + ck * 16) = vreg[pp][it]; }
                LDS_WAIT(); CFENCE();
                const s16x8 pa = pack_cpair(st[2 * pp], st[2 * pp + 1]);
                ldsp a0 = vb + (4 * q_ + ((lane & 15) >> 2)) * 128 + 8 * (lane & 3);
#pragma unroll
                for (int dt = 0; dt < 4; ++dt) { const s16x4 lo = tr16(a0 + 32 * dt), hi = tr16(a0 + 16 * 128 + 32 * dt);
                    O[dt] = mfma16(pa, __builtin_shufflevector(lo, hi, 0, 1, 2, 3, 4, 5, 6, 7), O[dt]); }
            }
            float ms[4], lsv[4]; int li[4];
#pragma unroll
            for (int e = 0; e < 4; ++e) { ms[e] = __shfl(mx, 4 * q_ + e); lsv[e] = __shfl(ls, 4 * q_ + e); li[e] = tb + d * (4 * q_ + e) - T0; }
            if (br == 0) {
#pragma unroll
                for (int e = 0; e < 4; ++e) {
#pragma unroll
                    for (int dt = 0; dt < 4; ++dt) accO[li[e] * 64 + 16 * dt + n_] = O[dt][e];
                    if (n_ == 0) { accM[li[e]] = ms[e]; accL[li[e]] = lsv[e]; } }
            } else {
                float fo[4], fn[4], mn[4], lo_[4];
#pragma unroll
                for (int e = 0; e < 4; ++e) { const float mo = accM[li[e]]; lo_[e] = accL[li[e]]; mn[e] = fmaxf(mo, ms[e]); fo[e] = __expf(mo - mn[e]); fn[e] = __expf(ms[e] - mn[e]); }
                LDS_WAIT(); CFENCE();
#pragma unroll
                for (int e = 0; e < 4; ++e) {
#pragma unroll
                    for (int dt = 0; dt < 4; ++dt) { LAS float* p = accO + li[e] * 64 + 16 * dt + n_; *p = *p * fo[e] + O[dt][e] * fn[e]; }
                    if (n_ == 0) { accM[li[e]] = mn[e]; accL[li[e]] = lo_[e] * fo[e] + lsv[e] * fn[e]; } }
            }
            LDS_WAIT(); CFENCE();
        }
        __syncthreads();
    }
    {
        const int tid = wave * 64 + lane, tl = tid >> 1, hf = tid & 1;
        const float il = 1.0f / accL[tl];
        const LAS float* src = accO + tl * 64 + 32 * hf; bf16* dst = (bf16*)(ws + WS_Y) + (size_t)(T0 + tl) * D_ + h * 64 + 32 * hf;
#pragma unroll
        for (int c = 0; c < 4; ++c) { const f32x4 a = *(LAS const f32x4*)(src + 8 * c), b = *(LAS const f32x4*)(src + 8 * c + 4);
            v4u w; w.x = pk2(a.x * il, a.y * il); w.y = pk2(a.z * il, a.w * il); w.z = pk2(b.x * il, b.y * il); w.w = pk2(b.z * il, b.w * il);
            *(v4u*)(dst + 8 * c) = w; }
    }
    __syncthreads();
}
constexpr size_t WS_SST = WS_PROJ1, WS_UB = WS_PROJ1 + 64 * MiB, WS_AT = WS_PROJ1 + 96 * MiB, WS_GC = WS_PROJ1 + 112 * MiB;
constexpr size_t WS_WN = WS_A + 112 * MiB, WS_KT = WS_A + 144 * MiB;
static_assert(WS_GC + 2048 * 64 * 4 <= WS_O0, "dn map");
template <int PITCH> DI s16x8 frag_row_p(ldsp img, int row0, int col0, int lane) { return *(LAS const s16x8*)(img + (row0 + (lane & 15)) * PITCH + (col0 + 8 * (lane >> 4)) * 2); }
template <int PITCH> DI s16x8 frag_tr_p(ldsp img, int row0, int col0, int lane) {
    ldsp a0 = img + (row0 + 8 * (lane >> 4) + ((lane & 15) >> 2)) * PITCH + col0 * 2 + 8 * (lane & 3);
    const s16x4 lo = tr16(a0), hi = tr16(a0 + 4 * PITCH);
    return __builtin_shufflevector(lo, hi, 0, 1, 2, 3, 4, 5, 6, 7);
}
constexpr int DN_LDS_PER_WAVE = 49152 + 512;
DI void dn_pass1_item(unsigned char* ws, ldsp lds, int item, int lane) {
    asm volatile("" : "+v"(lane));
    const int z = item >> 10, h = (item >> 8) & 3, c = item & 255, cn = z ? 255 - c : c;
    const bf16* Q = (const bf16*)(ws + WS_QD); const bf16* K = (const bf16*)(ws + WS_KD); const bf16* V = (const bf16*)(ws + WS_VD);
    ldsp IKd = lds, IVd = lds + 16384, LT = lds + 32768; LAS float* gcs = (LAS float*)(lds + 49152); LAS float* bts = gcs + 64;
    const int n_ = lane & 15, q_ = lane >> 4;
    {
        const int tok = tok_of(z, cn, lane);
        float gc = ((const float*)(ws + WS_GB))[(size_t)tok * 8 + z * 4 + h]; const float bt = ((const float*)(ws + WS_GB + 512 * 1024))[(size_t)tok * 8 + z * 4 + h];
#pragma unroll
        for (int o = 1; o < 64; o <<= 1) { const float t = __shfl_up(gc, o); if (lane >= o) gc += t; }
        gcs[lane] = gc; bts[lane] = bt; ((float*)(ws + WS_GC))[(size_t)item * 64 + lane] = gc;
    }
#pragma unroll 4
    for (int it = 0; it < 16; ++it) { const int p = lane + 64 * it, row = p >> 4, ck = p & 15; const size_t go = (size_t)tok_of(z, cn, row) * 512 + h * 128 + ck * 8;
        *(LAS v4u*)(IKd + row * 256 + ck * 16) = *(const v4u*)(K + go); *(LAS v4u*)(IVd + row * 256 + ck * 16) = *(const v4u*)(V + go); }
    LDS_WAIT(); CFENCE();
    s16x8 kf[4][4];
#pragma unroll
    for (int rt = 0; rt < 4; ++rt)
#pragma unroll
        for (int ks = 0; ks < 4; ++ks) kf[rt][ks] = frag_row_p<256>(IKd, 16 * rt, 32 * ks, lane);
#pragma unroll
    for (int mt = 0; mt < 4; ++mt) { f32x4 gi, bi;
#pragma unroll
        for (int e = 0; e < 4; ++e) { gi[e] = gcs[16 * mt + 4 * q_ + e]; bi[e] = bts[16 * mt + 4 * q_ + e]; }
#pragma unroll
        for (int nt = 0; nt < 4; ++nt) { f32x4 acc = (f32x4){0.f, 0.f, 0.f, 0.f};
            if (nt <= mt) {
#pragma unroll
                for (int ks = 0; ks < 4; ++ks) acc = mfma16(kf[mt][ks], kf[nt][ks], acc); }
            const float gj = gcs[16 * nt + n_];
#pragma unroll
            for (int e = 0; e < 4; ++e) { const int i = 16 * mt + 4 * q_ + e, j = 16 * nt + n_; ((LAS float*)LT)[i * 64 + j] = (j < i) ? bi[e] * acc[e] * __expf(gi[e] - gj) : 0.f; } } }
    {
        bf16* At = (bf16*)(ws + WS_AT) + (size_t)item * 4096;
#pragma unroll
        for (int nt = 0; nt < 4; ++nt) { s16x8 qf[4]; const bf16* qrow = Q + (size_t)tok_of(z, cn, 16 * nt + n_) * 512 + h * 128 + 8 * q_;
#pragma unroll
            for (int ks = 0; ks < 4; ++ks) qf[ks] = *(const s16x8*)(qrow + 32 * ks);
            const float gi = gcs[16 * nt + n_];
#pragma unroll
            for (int mt = 0; mt < 4; ++mt) { f32x4 acc = (f32x4){0.f, 0.f, 0.f, 0.f};
                if (mt <= nt) {
#pragma unroll
                    for (int ks = 0; ks < 4; ++ks) acc = mfma16(kf[mt][ks], qf[ks], acc); }
                f32x4 o;
#pragma unroll
                for (int e = 0; e < 4; ++e) { const int j = 16 * mt + 4 * q_ + e, i = 16 * nt + n_; o[e] = (j <= i) ? acc[e] * __expf(gi - gcs[j]) : 0.f; }
                *(unsigned long long*)(At + (size_t)(16 * nt + n_) * 64 + 16 * mt + 4 * q_) = pk4(o); } }
    }
    LDS_WAIT(); CFENCE();
    {
        float t[64];
        int lane_o = lane; asm volatile("" : "+v"(lane_o));
#pragma unroll
        for (int i = 0; i < 64; ++i) {
            float acc0 = (lane_o == i) ? 1.f : 0.f, acc1 = 0.f, acc2 = 0.f, acc3 = 0.f;
#pragma unroll
            for (int jg = 0; jg < (i + 3) / 4; ++jg) { const f32x4 a4 = *(LAS const f32x4*)(LT + (i * 64 + 4 * jg) * 4);
                if (4 * jg + 0 < i) acc0 -= a4[0] * t[4 * jg + 0];
                if (4 * jg + 1 < i) acc1 -= a4[1] * t[4 * jg + 1];
                if (4 * jg + 2 < i) acc2 -= a4[2] * t[4 * jg + 2];
                if (4 * jg + 3 < i) acc3 -= a4[3] * t[4 * jg + 3]; }
            t[i] = (acc0 + acc1) + (acc2 + acc3);
        }
        LDS_WAIT(); CFENCE();
        const float s1 = bts[lane], s2 = -s1 * __expf(gcs[lane]);
#pragma unroll
        for (int i = 0; i < 64; ++i) { ((LAS bf16*)LT)[i * 64 + lane] = (bf16)f2bf(t[i] * s1); ((LAS bf16*)(LT + 8192))[i * 64 + lane] = (bf16)f2bf(t[i] * s2); }
    }
    LDS_WAIT(); CFENCE();
    ldsp IT1 = LT, IT2 = LT + 8192;
    {
        bf16* Ub = (bf16*)(ws + WS_UB) + (size_t)item * 8192;
        s16x8 tf[4][2];
#pragma unroll
        for (int mt = 0; mt < 4; ++mt)
#pragma unroll
            for (int ks = 0; ks < 2; ++ks) tf[mt][ks] = frag_row_p<128>(IT1, 16 * mt, 32 * ks, lane);
#pragma unroll
        for (int nt = 0; nt < 8; ++nt) { const s16x8 v0 = frag_tr_p<256>(IVd, 0, 16 * nt, lane), v1 = frag_tr_p<256>(IVd, 32, 16 * nt, lane);
#pragma unroll
            for (int mt = 0; mt < 4; ++mt) { f32x4 acc = (f32x4){0.f, 0.f, 0.f, 0.f}; acc = mfma16(tf[mt][0], v0, acc); acc = mfma16(tf[mt][1], v1, acc);
                *(unsigned long long*)(Ub + (size_t)(16 * nt + n_) * 64 + 16 * mt + 4 * q_) = pk4(acc); } }
    }
    {
        bf16* Wn = (bf16*)(ws + WS_WN) + (size_t)item * 8192;
        s16x8 tf[4][2];
#pragma unroll
        for (int nt = 0; nt < 4; ++nt)
#pragma unroll
            for (int ks = 0; ks < 2; ++ks) tf[nt][ks] = frag_row_p<128>(IT2, 16 * nt, 32 * ks, lane);
#pragma unroll
        for (int mt = 0; mt < 8; ++mt) { const s16x8 k0 = frag_tr_p<256>(IKd, 0, 16 * mt, lane), k1 = frag_tr_p<256>(IKd, 32, 16 * mt, lane);
            if (z == 0) { bf16* KT = (bf16*)(ws + WS_KT) + ((size_t)(h * 256 + cn) * 128 + 16 * mt + n_) * 64 + 8 * q_; *(s16x8*)KT = k0; *(s16x8*)(KT + 32) = k1; }
#pragma unroll
            for (int nt = 0; nt < 4; ++nt) { f32x4 acc = (f32x4){0.f, 0.f, 0.f, 0.f}; acc = mfma16(k0, tf[nt][0], acc); acc = mfma16(k1, tf[nt][1], acc);
                *(unsigned long long*)(Wn + (size_t)(16 * nt + n_) * 128 + 16 * mt + 4 * q_) = pk4(acc); } }
    }
    LDS_WAIT(); CFENCE();
}
DI s16x8 pack_cpair_rev(const f32x4& lo, const f32x4& hi) { v4u p; p.x = pk2(lo[3], lo[2]); p.y = pk2(lo[1], lo[0]); p.z = pk2(hi[3], hi[2]); p.w = pk2(hi[1], hi[0]); return __builtin_bit_cast(s16x8, p); }
DI unsigned long long rev4(unsigned long long x) { return (x >> 48) | ((x >> 16) & 0xffff0000ull) | ((x << 16) & 0xffff00000000ull) | (x << 48); }
DI void dn_pass2_wave(unsigned char* ws, int w  , int lane) {
    const int z = w >> 5, h = (w >> 3) & 3, vs = w & 7;
    const int n_ = lane & 15, q_ = lane >> 4;
    f32x4 S[8];
#pragma unroll
    for (int kt = 0; kt < 8; ++kt) S[kt] = (f32x4){0.f, 0.f, 0.f, 0.f};
    for (int c = 0; c < 256; ++c) {
        const int item = (z * 4 + h) * 256 + c, cn = z ? 255 - c : c;
        const bf16* Wn = (const bf16*)(ws + WS_WN) + (size_t)item * 8192; const bf16* Ub = (const bf16*)(ws + WS_UB) + (size_t)item * 8192;
        const float* gcu = (const float*)(ws + WS_GC) + (size_t)item * 64;
        const bf16* KT = (const bf16*)(ws + WS_KT) + (size_t)(h * 256 + cn) * 128 * 64;
        bf16* Sst = (bf16*)(ws + WS_SST) + (size_t)item * 16384;
        f32x4 u[4], gv[4];
#pragma unroll
        for (int mt = 0; mt < 4; ++mt) { u[mt] = unpk4(*(const unsigned long long*)(Ub + (size_t)(16 * vs + n_) * 64 + 16 * mt + 4 * q_)); gv[mt] = *(const f32x4*)(gcu + 16 * mt + 4 * q_); }
        const float gl = gcu[63];
        unsigned long long wa[4][4][2], ka[8][2][2];
#pragma unroll
        for (int mt = 0; mt < 4; ++mt)
#pragma unroll
            for (int ks = 0; ks < 4; ++ks) { const bf16* row = Wn + (size_t)(16 * mt + n_) * 128 + 32 * ks + 4 * q_; wa[mt][ks][0] = *(const unsigned long long*)row; wa[mt][ks][1] = *(const unsigned long long*)(row + 16); }
#pragma unroll
        for (int kt = 0; kt < 8; ++kt)
#pragma unroll
            for (int ks = 0; ks < 2; ++ks) { const bf16* row = KT + (size_t)(16 * kt + n_) * 64;
                if (z == 0) { ka[kt][ks][0] = *(const unsigned long long*)(row + 32 * ks + 4 * q_); ka[kt][ks][1] = *(const unsigned long long*)(row + 32 * ks + 16 + 4 * q_); }
                else { ka[kt][ks][0] = rev4(*(const unsigned long long*)(row + 60 - 32 * ks - 4 * q_)); ka[kt][ks][1] = rev4(*(const unsigned long long*)(row + 44 - 32 * ks - 4 * q_)); } }
#pragma unroll
        for (int kt = 0; kt < 8; ++kt) *(unsigned long long*)(Sst + (size_t)(16 * vs + n_) * 128 + 16 * kt + 4 * q_) = pk4(S[kt]);
#pragma unroll
        for (int ks = 0; ks < 4; ++ks) { const s16x8 b = pack_cpair(S[2 * ks], S[2 * ks + 1]);
#pragma unroll
            for (int mt = 0; mt < 4; ++mt) { v4u a; a.x = (unsigned)wa[mt][ks][0]; a.y = (unsigned)(wa[mt][ks][0] >> 32); a.z = (unsigned)wa[mt][ks][1]; a.w = (unsigned)(wa[mt][ks][1] >> 32);
                u[mt] = mfma16(__builtin_bit_cast(s16x8, a), b, u[mt]); } }
#pragma unroll
        for (int mt = 0; mt < 4; ++mt)
#pragma unroll
            for (int e = 0; e < 4; ++e) u[mt][e] *= __expf(gl - gv[mt][e]);
        const float egl = __expf(gl);
        const s16x8 b0 = pack_cpair(u[0], u[1]), b1 = pack_cpair(u[2], u[3]);
#pragma unroll
        for (int kt = 0; kt < 8; ++kt) { f32x4 acc = S[kt] * egl;
            { v4u a; a.x = (unsigned)ka[kt][0][0]; a.y = (unsigned)(ka[kt][0][0] >> 32); a.z = (unsigned)ka[kt][0][1]; a.w = (unsigned)(ka[kt][0][1] >> 32); acc = mfma16(__builtin_bit_cast(s16x8, a), b0, acc); }
            { v4u a; a.x = (unsigned)ka[kt][1][0]; a.y = (unsigned)(ka[kt][1][0] >> 32); a.z = (unsigned)ka[kt][1][1]; a.w = (unsigned)(ka[kt][1][1] >> 32); acc = mfma16(__builtin_bit_cast(s16x8, a), b1, acc); }
            S[kt] = acc; }
    }
}
DI void dn_pass3_item(unsigned char* ws, int item, int lane) {
    asm volatile("" : "+v"(lane));
    const int z = item >> 10, h = (item >> 8) & 3, c = item & 255, cn = z ? 255 - c : c;
    const int n_ = lane & 15, q_ = lane >> 4;
    const bf16* Q = (const bf16*)(ws + WS_QD);
    const bf16* Wn = (const bf16*)(ws + WS_WN) + (size_t)item * 8192; const bf16* Ub = (const bf16*)(ws + WS_UB) + (size_t)item * 8192;
    const bf16* At = (const bf16*)(ws + WS_AT) + (size_t)item * 4096; const float* gcu = (const float*)(ws + WS_GC) + (size_t)item * 64;
    const bf16* Sst = (const bf16*)(ws + WS_SST) + (size_t)item * 16384;
    bf16* O = (bf16*)(ws + (z ? WS_O1 : WS_O0));
    s16x8 wf[4][4], qf[4][4]; unsigned long long af[4][2][2]; float eg[4];
#pragma unroll
    for (int t = 0; t < 4; ++t) {
        const bf16* qrow = Q + (size_t)tok_of(z, cn, 16 * t + n_) * 512 + h * 128 + 8 * q_;
#pragma unroll
        for (int ks = 0; ks < 4; ++ks) { wf[t][ks] = *(const s16x8*)(Wn + (size_t)(16 * t + n_) * 128 + 32 * ks + 8 * q_); qf[t][ks] = *(const s16x8*)(qrow + 32 * ks); }
#pragma unroll
        for (int ks = 0; ks < 2; ++ks) { const bf16* arow = At + (size_t)(16 * t + n_) * 64 + 32 * ks + 4 * q_; af[t][ks][0] = *(const unsigned long long*)arow; af[t][ks][1] = *(const unsigned long long*)(arow + 16); }
        eg[t] = __expf(gcu[16 * t + n_]);
    }
#pragma unroll
    for (int mt = 0; mt < 8; ++mt) {
        s16x8 sf[4];
#pragma unroll
        for (int ks = 0; ks < 4; ++ks) sf[ks] = *(const s16x8*)(Sst + (size_t)(16 * mt + n_) * 128 + 32 * ks + 8 * q_);
        f32x4 u[4];
#pragma unroll
        for (int jt = 0; jt < 4; ++jt) { u[jt] = unpk4(*(const unsigned long long*)(Ub + (size_t)(16 * mt + n_) * 64 + 16 * jt + 4 * q_));
#pragma unroll
            for (int ks = 0; ks < 4; ++ks) u[jt] = mfma16(wf[jt][ks], sf[ks], u[jt]); }
        const s16x8 ua0 = pack_cpair(u[0], u[1]), ua1 = pack_cpair(u[2], u[3]);
#pragma unroll
        for (int nt = 0; nt < 4; ++nt) {
            f32x4 acc = (f32x4){0.f, 0.f, 0.f, 0.f};
#pragma unroll
            for (int ks = 0; ks < 4; ++ks) acc = mfma16(sf[ks], qf[nt][ks], acc);
            acc = acc * eg[nt];
            { v4u b; b.x = (unsigned)af[nt][0][0]; b.y = (unsigned)(af[nt][0][0] >> 32); b.z = (unsigned)af[nt][0][1]; b.w = (unsigned)(af[nt][0][1] >> 32); acc = mfma16(ua0, __builtin_bit_cast(s16x8, b), acc); }
            { v4u b; b.x = (unsigned)af[nt][1][0]; b.y = (unsigned)(af[nt][1][0] >> 32); b.z = (unsigned)af[nt][1][1]; b.w = (unsigned)(af[nt][1][1] >> 32); acc = mfma16(ua1, __builtin_bit_cast(s16x8, b), acc); }
            *(unsigned long long*)(O + (size_t)tok_of(z, cn, 16 * nt + n_) * 512 + h * 128 + 16 * mt + 4 * q_) = pk4(acc);
        }
    }
}
constexpr int DN_SLOT = 41984, DN_GRP = 16;
constexpr size_t WS_MG = WS_END_OLD, WS_NG = WS_END_OLD + 4 * MiB, WS_SG = WS_END_OLD + 8 * MiB;
DI void dn_scan_block(unsigned char* ws, ldsp L, const int Z, const int MODE, int h, int hv, int g, int wave, int lane) {
    const int item0 = (Z * 4 + h) * 256, cb = g * DN_GRP, zhg = (Z * 4 + h) * 16 + g;
    if (wave >= 4) {
        const int lw = wave - 4;
        unsigned so[11], ld[11];
#pragma unroll
        for (int k = 0; k < 4; ++k) { const int pid = lw * 4 + k; const int row = 4 * pid + (lane >> 4), p = lane & 15, cch = p ^ (row & 15); so[k] = row * 256 + cch * 16; ld[k] = pid * 1024 + lane * 16; }
#pragma unroll
        for (int k = 0; k < 4; ++k) { const int pid = lw * 4 + k; const int row = 8 * pid + (lane >> 3), p = lane & 7, cch = p ^ (row & 7); so[4 + k] = row * 128 + cch * 16; ld[4 + k] = 16384 + pid * 1024 + lane * 16; }
#pragma unroll
        for (int k = 0; k < 2; ++k) { const int pid = lw * 2 + k; const int row = 8 * pid + (lane >> 3), p = lane & 7, cch = p ^ (row & 7); so[8 + k] = row * 128 + cch * 16; ld[8 + k] = 32768 + pid * 1024 + lane * 16; }
        so[10] = lane * 16; ld[10] = 40960 + lane * 16;
        v4u rA[11], rB[11];
#define DN_GLOAD(R, ss) do { const int s_ = (ss) < DN_GRP ? (ss) : DN_GRP - 1; const int c_ = cb + s_; const int cn_ = Z ? 255 - c_ : c_; \
            const char* wsrc = (const char*)((const bf16*)(ws + WS_WN) + (size_t)(item0 + c_) * 8192); const char* ksrc = (const char*)((const bf16*)(ws + WS_KT) + (size_t)(h * 256 + cn_) * 8192); \
            const char* usrc = (const char*)((const bf16*)(ws + WS_UB) + (size_t)(item0 + c_) * 8192 + hv * 4096); const char* gsrc = (const char*)((const float*)(ws + WS_GC) + (size_t)(item0 + c_) * 64); \
            _Pragma("unroll") for (int k = 0; k < 4; ++k) R[k] = *(const v4u*)(wsrc + so[k]); \
            _Pragma("unroll") for (int k = 4; k < 8; ++k) R[k] = *(const v4u*)(ksrc + so[k]); \
            _Pragma("unroll") for (int k = 8; k < 10; ++k) R[k] = *(const v4u*)(usrc + so[k]); \
            if (lw == 0) R[10] = *(const v4u*)(gsrc + so[10]); } while (0)
#define DN_LWRITE(R, ss) do { ldsp slot = L + ((ss) % 3) * DN_SLOT; \
            _Pragma("unroll") for (int k = 0; k < 10; ++k) *(LAS v4u*)(slot + ld[k]) = R[k]; \
            if (lw == 0) *(LAS v4u*)(slot + ld[10]) = R[10]; } while (0)
        DN_GLOAD(rA, 0); DN_GLOAD(rB, 1); DN_LWRITE(rA, 0); DN_LWRITE(rB, 1);
        DN_GLOAD(rA, 2); DN_GLOAD(rB, 3);
#define DN_LSTEP(R, ss) do { asm volatile("s_waitcnt lgkmcnt(0)" ::: "memory"); __builtin_amdgcn_s_barrier(); asm volatile("" ::: "memory"); \
            DN_LWRITE(R, (ss) + 2); DN_GLOAD(R, (ss) + 4); } while (0)
        for (int s2 = 0; s2 < DN_GRP; s2 += 2) { DN_LSTEP(rA, s2); DN_LSTEP(rB, s2 + 1); }
#undef DN_LSTEP
#undef DN_LWRITE
#undef DN_GLOAD
        asm volatile("s_waitcnt vmcnt(0) lgkmcnt(0)" ::: "memory");
        return;
    }
    const int vs = 4 * hv + wave;
    const int n_ = lane & 15, q_ = lane >> 4, wbyte = (q_ & 1) * 8, sw = n_ & 7;
    int kao[2][2];
#pragma unroll
    for (int ks = 0; ks < 2; ++ks) { const int r0 = Z ? 60 - 32 * ks - 4 * q_ : 32 * ks + 4 * q_, r1 = Z ? r0 - 16 : r0 + 16; kao[ks][0] = (((r0 >> 3) ^ sw) * 16) + (r0 & 7) * 2; kao[ks][1] = (((r1 >> 3) ^ sw) * 16) + (r1 & 7) * 2; }
    const float ubm = MODE == 2 ? 0.f : 1.f;
    f32x4 S[8];
    if (MODE == 0) { const bf16* SG = (const bf16*)(ws + WS_SG) + (size_t)zhg * 16384;
#pragma unroll
        for (int kt = 0; kt < 8; ++kt) S[kt] = unpk4(*(const unsigned long long*)(SG + (size_t)(16 * vs + n_) * 128 + 16 * kt + 4 * q_)); }
    else {
#pragma unroll
        for (int kt = 0; kt < 8; ++kt)
#pragma unroll
            for (int e = 0; e < 4; ++e) S[kt][e] = (MODE == 2 && (16 * kt + 4 * q_ + e) == (16 * vs + n_)) ? 1.f : 0.f; }
    for (int s = 0; s < DN_GRP; ++s) {
        const int c = cb + s;
        if (MODE == 0) { bf16* Sst = (bf16*)(ws + WS_SST) + (size_t)(item0 + c) * 16384;
#pragma unroll
            for (int kt = 0; kt < 8; ++kt) *(unsigned long long*)(Sst + (size_t)(16 * vs + n_) * 128 + 16 * kt + 4 * q_) = pk4(S[kt]); }
        asm volatile("s_waitcnt lgkmcnt(0)" ::: "memory");
        __builtin_amdgcn_s_barrier();
        asm volatile("" ::: "memory");
        ldsp slot = L + (s % 3) * DN_SLOT;
        f32x4 u[4], gv[4]; unsigned long long wa[4][4][2], ka[8][2][2];
        { ldsp urow = slot + 32768 + (16 * wave + n_) * 128 + wbyte;
#pragma unroll
          for (int mt = 0; mt < 4; ++mt) { u[mt] = unpk4(*(LAS const unsigned long long*)(urow + (((2 * mt + (q_ >> 1)) ^ sw) * 16))) * ubm; gv[mt] = *(LAS const f32x4*)(slot + 40960 + (16 * mt + 4 * q_) * 4); } }
        const float gl = *(LAS const float*)(slot + 40960 + 63 * 4);
#pragma unroll
        for (int ks = 0; ks < 4; ++ks)
#pragma unroll
            for (int mt = 0; mt < 4; ++mt) { ldsp row = slot + (16 * mt + n_) * 256 + wbyte; const int c0 = 4 * ks + (q_ >> 1);
                wa[mt][ks][0] = *(LAS const unsigned long long*)(row + ((c0 ^ n_) * 16)); wa[mt][ks][1] = *(LAS const unsigned long long*)(row + (((c0 + 2) ^ n_) * 16)); }
        __builtin_amdgcn_sched_barrier(0);
#pragma unroll
        for (int ks = 0; ks < 4; ++ks) { const s16x8 bb = pack_cpair(S[2 * ks], S[2 * ks + 1]);
#pragma unroll
            for (int mt = 0; mt < 4; ++mt) { v4u a; a.x = (unsigned)wa[mt][ks][0]; a.y = (unsigned)(wa[mt][ks][0] >> 32); a.z = (unsigned)wa[mt][ks][1]; a.w = (unsigned)(wa[mt][ks][1] >> 32);
                u[mt] = mfma16(__builtin_bit_cast(s16x8, a), bb, u[mt]); } }
        __builtin_amdgcn_sched_barrier(0);
#pragma unroll
        for (int kt = 0; kt < 8; ++kt) { ldsp row = slot + 16384 + (16 * kt + n_) * 128;
#pragma unroll
            for (int ks = 0; ks < 2; ++ks) { ka[kt][ks][0] = *(LAS const unsigned long long*)(row + kao[ks][0]); ka[kt][ks][1] = *(LAS const unsigned long long*)(row + kao[ks][1]); } }
        __builtin_amdgcn_sched_barrier(0);
#pragma unroll
        for (int mt = 0; mt < 4; ++mt)
#pragma unroll
            for (int e = 0; e < 4; ++e) u[mt][e] *= __expf(gl - gv[mt][e]);
        const float egl = __expf(gl);
#pragma unroll
        for (int mt = 0; mt < 4; ++mt) { const f32x4 t = u[mt]; u[mt][0] = Z ? t[3] : t[0]; u[mt][1] = Z ? t[2] : t[1]; u[mt][2] = Z ? t[1] : t[2]; u[mt][3] = Z ? t[0] : t[3]; }
        const s16x8 b0 = pack_cpair(u[0], u[1]), b1 = pack_cpair(u[2], u[3]);
#pragma unroll
        for (int kt = 0; kt < 8; ++kt) { f32x4 acc = S[kt] * egl;
#pragma unroll
            for (int ks = 0; ks < 2; ++ks) { const unsigned long long a0 = ka[kt][ks][0], a1 = ka[kt][ks][1];
                v4u a; a.x = (unsigned)a0; a.y = (unsigned)(a0 >> 32); a.z = (unsigned)a1; a.w = (unsigned)(a1 >> 32);
                acc = mfma16(__builtin_bit_cast(s16x8, a), ks == 0 ? b0 : b1, acc); }
            S[kt] = acc; }
    }
    if (MODE == 1) { bf16* NG = (bf16*)(ws + WS_NG) + (size_t)zhg * 16384;
#pragma unroll
        for (int kt = 0; kt < 8; ++kt) *(unsigned long long*)(NG + (size_t)(16 * vs + n_) * 128 + 16 * kt + 4 * q_) = pk4(S[kt]); }
    if (MODE == 2) { bf16* MG = (bf16*)(ws + WS_MG) + (size_t)zhg * 16384;
#pragma unroll
        for (int kt = 0; kt < 8; ++kt)
#pragma unroll
            for (int e = 0; e < 4; ++e) MG[(size_t)(16 * kt + 4 * q_ + e) * 128 + 16 * vs + n_] = (bf16)f2bf(S[kt][e]); }
}
DI void dn_scan_groups(unsigned char* ws, int w  , int lane) {
    const int zh = w >> 3, vs = w & 7, n_ = lane & 15, q_ = lane >> 4;
    f32x4 S[8];
#pragma unroll
    for (int kt = 0; kt < 8; ++kt) S[kt] = (f32x4){0.f, 0.f, 0.f, 0.f};
    for (int g = 0; g < 16; ++g) {
        const size_t zhg = (size_t)(zh * 16 + g) * 16384;
        bf16* SG = (bf16*)(ws + WS_SG) + zhg; const bf16* MG = (const bf16*)(ws + WS_MG) + zhg; const bf16* NG = (const bf16*)(ws + WS_NG) + zhg;
#pragma unroll
        for (int kt = 0; kt < 8; ++kt) *(unsigned long long*)(SG + (size_t)(16 * vs + n_) * 128 + 16 * kt + 4 * q_) = pk4(S[kt]);
        if (g == 15) break;
        s16x8 bb[4];
#pragma unroll
        for (int ks = 0; ks < 4; ++ks) bb[ks] = pack_cpair(S[2 * ks], S[2 * ks + 1]);
#pragma unroll
        for (int kt = 0; kt < 8; ++kt) { f32x4 acc = unpk4(*(const unsigned long long*)(NG + (size_t)(16 * vs + n_) * 128 + 16 * kt + 4 * q_));
#pragma unroll
            for (int ks = 0; ks < 4; ++ks) { const bf16* row = MG + (size_t)(16 * kt + n_) * 128 + 32 * ks + 4 * q_;
                const unsigned long long a0 = *(const unsigned long long*)row, a1 = *(const unsigned long long*)(row + 16);
                v4u a; a.x = (unsigned)a0; a.y = (unsigned)(a0 >> 32); a.z = (unsigned)a1; a.w = (unsigned)(a1 >> 32);
                acc = mfma16(__builtin_bit_cast(s16x8, a), bb[ks], acc); }
            S[kt] = acc; }
    }
}
DI void prep1_token(const Args& a, unsigned char* ws, int t, int lane) {
    const bf16* P = (const bf16*)(ws + WS_PROJ1) + (size_t)t * ODD_PAD;
    const int c0 = 8 * lane; const bool hp = t > 0, hn = t < S_ - 1;
    float z8[8];
#pragma unroll
    for (int i = 0; i < 8; ++i) z8[i] = 0.f;
    {
        float cb[8], cc[8], cx[8], pc[8], px[8], nc[8], nx[8], w0[8], w1[8], w2[8], o[8];
        ld8(P + c0, cb); ld8(P + 512 + c0, cc); ld8(P + 1024 + c0, cx);
        if (hp) { ld8(P - ODD_PAD + 512 + c0, pc); ld8(P - ODD_PAD + 1024 + c0, px); } else {
#pragma unroll
            for (int i = 0; i < 8; ++i) { pc[i] = 0.f; px[i] = 0.f; } }
        if (hn) { ld8(P + ODD_PAD + 512 + c0, nc); ld8(P + ODD_PAD + 1024 + c0, nx); } else {
#pragma unroll
            for (int i = 0; i < 8; ++i) { nc[i] = 0.f; nx[i] = 0.f; } }
        ld8f(a.in[28] + c0, w0); ld8f(a.in[28] + 512 + c0, w1); ld8f(a.in[28] + 1024 + c0, w2);
#pragma unroll
        for (int i = 0; i < 8; ++i) o[i] = cb[i] * (w0[i] * pc[i] * px[i] + w1[i] * cc[i] * cx[i] + w2[i] * nc[i] * nx[i]);
        st8((bf16*)(ws + WS_YCAT1) + (size_t)t * D_ + c0, o);
    }
#pragma unroll
    for (int part = 0; part < 3; ++part) {
        float cu[8], pv[8], nx[8], w0[8], w1[8], w2[8], o[8];
        const int col = 1536 + part * 512 + c0;
        ld8(P + col, cu);
        if (hp) ld8(P - ODD_PAD + col, pv); else {
#pragma unroll
            for (int i = 0; i < 8; ++i) pv[i] = 0.f; }
        if (hn) ld8(P + ODD_PAD + col, nx); else {
#pragma unroll
            for (int i = 0; i < 8; ++i) nx[i] = 0.f; }
        const float* cw = a.in[29] + part * 512 + c0;
        ld8f(cw, w0); ld8f(cw + 1536, w1); ld8f(cw + 3072, w2);
        float ss = 0.f;
#pragma unroll
        for (int i = 0; i < 8; ++i) { o[i] = siluf_(w0[i] * pv[i] + w1[i] * cu[i] + w2[i] * nx[i]); ss += o[i] * o[i]; }
        if (part < 2) { ss = grp_sum<16>(ss); const float rn = (1.0f / sqrtf(ss + 1e-6f)) * (part == 0 ? 0.08838834764831845f : 1.0f);
#pragma unroll
            for (int i = 0; i < 8; ++i) o[i] *= rn; }
        st8((bf16*)(ws + (part == 0 ? WS_QD : (part == 1 ? WS_KD : WS_VD))) + (size_t)t * 512 + c0, o);
    }
    *(v4u*)((bf16*)(ws + WS_YCAT1) + (size_t)t * D_ + 512 + c0) = *(const v4u*)(P + 3072 + c0);
    if (lane < 8) {
        const float bt = sigmoidf_(bf2f(P[3584 + lane])); const float al = bf2f(P[3592 + lane]);
        const float g = -__expf(a.in[30][lane]) * softplusf_(al + a.in[31][lane]);
        ((float*)(ws + WS_GB))[(size_t)t * 8 + lane] = g; ((float*)(ws + WS_GB + 512 * 1024))[(size_t)t * 8 + lane] = bt;
    }
}
DI void dn_scan_naive(unsigned char* ws, int w  , int lane) {
    const int z = w >> 9, h = (w >> 7) & 3, vc = w & 127;
    const bf16* Q = (const bf16*)(ws + WS_QD); const bf16* K = (const bf16*)(ws + WS_KD); const bf16* V = (const bf16*)(ws + WS_VD);
    const float* G = (const float*)(ws + WS_GB); const float* Bt = (const float*)(ws + WS_GB + 512 * 1024);
    bf16* O = (bf16*)(ws + (z ? WS_O1 : WS_O0));
    float s0 = 0.f, s1 = 0.f;
    int t = z ? S_ - 1 : 0; const int dt = z ? -1 : 1;
    size_t o = (size_t)t * 512 + h * 128;
    float k0 = bf2f(K[o + lane]), k1 = bf2f(K[o + 64 + lane]), q0 = bf2f(Q[o + lane]), q1 = bf2f(Q[o + 64 + lane]), vv = bf2f(V[o + vc]), g = G[(size_t)t * 8 + z * 4 + h], bt = Bt[(size_t)t * 8 + z * 4 + h];
    for (int s = 0; s < S_; ++s) {
        const int tn = (s + 1 < S_) ? t + dt : t; const size_t on = (size_t)tn * 512 + h * 128;
        const float k0n = bf2f(K[on + lane]), k1n = bf2f(K[on + 64 + lane]), q0n = bf2f(Q[on + lane]), q1n = bf2f(Q[on + 64 + lane]), vvn = bf2f(V[on + vc]), gn = G[(size_t)tn * 8 + z * 4 + h], btn = Bt[(size_t)tn * 8 + z * 4 + h];
        const float eg = __expf(g);
        const float dot = wave_sum(k0 * s0 + k1 * s1);
        const float cf = bt * (vv - eg * dot);
        s0 = eg * s0 + cf * k0; s1 = eg * s1 + cf * k1;
        const float ov = wave_sum(q0 * s0 + q1 * s1);
        if (lane == 0) O[(size_t)t * 512 + h * 128 + vc] = (bf16)f2bf(ov);
        k0 = k0n; k1 = k1n; q0 = q0n; q1 = q1n; vv = vvn; g = gn; bt = btn; t = tn;
    }
}
DI void dn_post_token(const Args& a, unsigned char* ws, int t, int lane) {
    const int c0 = 8 * lane; const size_t o = (size_t)t * 512 + c0;
    float o0[8], o1[8], zz[8], nw[8];
    ld8((const bf16*)(ws + WS_O0) + o, o0); ld8((const bf16*)(ws + WS_O1) + o, o1);
    ld8((const bf16*)(ws + WS_YCAT1) + (size_t)t * D_ + 512 + c0, zz); ld8f(a.in[32] + (c0 & 127), nw);
    float ss = 0.f;
#pragma unroll
    for (int i = 0; i < 8; ++i) { o0[i] += o1[i]; ss += o0[i] * o0[i]; }
    const float rs = 1.0f / sqrtf(grp_sum<16>(ss) * (1.0f / 128.f) + 1e-6f);
#pragma unroll
    for (int i = 0; i < 8; ++i) o0[i] = o0[i] * rs * nw[i] * siluf_(zz[i]);
    st8((bf16*)(ws + WS_YCAT1) + (size_t)t * D_ + 512 + c0, o0);
}
struct TokInfo { int e1, e2, s1, s2; float p1, p2; int pad0, pad1; };
struct RouterRegs { f32x4 r0[16], r1[16]; f32x4 w[4]; };
DI void route_load(const Args& a, RouterRegs& R, int lane) {
#pragma unroll
    for (int j = 0; j < 4; ++j) { R.w[j] = ((const f32x4*)a.in[34])[lane + 64 * j];
#pragma unroll
        for (int i = 0; i < 4; ++i) { const float* rr = a.in[35] + (size_t)(4 * lane + 256 * j + i) * 8; R.r0[4 * j + i] = *(const f32x4*)rr; R.r1[4 * j + i] = *(const f32x4*)(rr + 4); } }
}
DI void route_token(const RouterRegs& R, unsigned char* ws, const float* x3, int t, int lane) {
    f32x4 v[4]; load_row(x3, t, lane, v); const float rs = row_rstd(v);
    float lg[8];
#pragma unroll
    for (int e = 0; e < 8; ++e) lg[e] = 0.f;
#pragma unroll
    for (int j = 0; j < 4; ++j)
#pragma unroll
        for (int i = 0; i < 4; ++i) { const float hv = v[j][i] * rs * R.w[j][i]; const f32x4 r0 = R.r0[4 * j + i], r1 = R.r1[4 * j + i];
            lg[0] += hv * r0.x; lg[1] += hv * r0.y; lg[2] += hv * r0.z; lg[3] += hv * r0.w; lg[4] += hv * r1.x; lg[5] += hv * r1.y; lg[6] += hv * r1.z; lg[7] += hv * r1.w; }
#pragma unroll
    for (int e = 0; e < 8; ++e) lg[e] = wave_sum(lg[e]);
    if (lane == 0) {
        int e1 = 0; float m1 = lg[0];
#pragma unroll
        for (int e = 1; e < 8; ++e) if (lg[e] > m1) { m1 = lg[e]; e1 = e; }
        int e2 = -1; float m2 = -3.0e38f;
#pragma unroll
        for (int e = 0; e < 8; ++e) if (e != e1 && lg[e] > m2) { m2 = lg[e]; e2 = e; }
        const float x2 = __expf(m2 - m1); const float p1 = 1.0f / (1.0f + x2), p2 = x2 / (1.0f + x2);
        unsigned* cnt = (unsigned*)(ws + WS_CTL) + CW_CNT;
        TokInfo ti; ti.e1 = e1; ti.e2 = e2; ti.s1 = (int)atomicAdd(cnt + e1, 1u); ti.s2 = (int)atomicAdd(cnt + e2, 1u); ti.p1 = p1; ti.p2 = p2; ti.pad0 = 0; ti.pad1 = 0;
        ((TokInfo*)(ws + WS_TOK))[t] = ti;
    }
}
DI void moe_offsets(const unsigned char* ws, int (&off)[9]) {
    const unsigned* cnt = (const unsigned*)(ws + WS_CTL) + CW_CNT; int o = 0;
#pragma unroll
    for (int e = 0; e < 8; ++e) { off[e] = o; const int c = (int)__hip_atomic_load(cnt + e, __ATOMIC_RELAXED, __HIP_MEMORY_SCOPE_AGENT); o += (c + 255) & ~255; }
    off[8] = o;
}
DI void gather_token(const Args& a, unsigned char* ws, const float* x3, const int (&off)[9], int t, int lane) {
    f32x4 v[4]; load_row(x3, t, lane, v); const float rs = row_rstd(v);
#pragma unroll
    for (int j = 0; j < 4; ++j) v[j] = v[j] * rs * ((const f32x4*)a.in[34])[lane + 64 * j];
    const TokInfo ti = ((const TokInfo*)(ws + WS_TOK))[t];
    int o1 = 0, o2 = 0;
#pragma unroll
    for (int e = 0; e < 8; ++e) { if (ti.e1 == e) o1 = off[e]; if (ti.e2 == e) o2 = off[e]; }
    bf16* A = (bf16*)(ws + WS_AMOE);
    store_row_bf16(A + (size_t)(o1 + ti.s1) * D_, lane, v); store_row_bf16(A + (size_t)(o2 + ti.s2) * D_, lane, v);
}
DI void combine_token(unsigned char* ws, float* out, const int (&off)[9], int t, int lane) {
    const TokInfo ti = ((const TokInfo*)(ws + WS_TOK))[t];
    int o1 = 0, o2 = 0;
#pragma unroll
    for (int e = 0; e < 8; ++e) { if (ti.e1 == e) o1 = off[e]; if (ti.e2 == e) o2 = off[e]; }
    const bf16* A = (const bf16*)(ws + WS_AMOE);
    const unsigned long long* r1 = (const unsigned long long*)(A + (size_t)(o1 + ti.s1) * D_) + lane; const unsigned long long* r2 = (const unsigned long long*)(A + (size_t)(o2 + ti.s2) * D_) + lane;
    f32x4* xo = (f32x4*)(out + (size_t)t * D_) + lane;
#pragma unroll
    for (int j = 0; j < 4; ++j) { const unsigned long long a1 = r1[64 * j], a2 = r2[64 * j]; f32x4 x = xo[64 * j];
        x.x += ti.p1 * bflo((unsigned)a1) + ti.p2 * bflo((unsigned)a2); x.y += ti.p1 * bfhi((unsigned)a1) + ti.p2 * bfhi((unsigned)a2);
        x.z += ti.p1 * bflo((unsigned)(a1 >> 32)) + ti.p2 * bflo((unsigned)(a2 >> 32)); x.w += ti.p1 * bfhi((unsigned)(a1 >> 32)) + ti.p2 * bfhi((unsigned)(a2 >> 32));
        xo[64 * j] = x; }
}
#ifndef PROBE
#define PROBE 0
#endif
#ifndef PROBE_REP
#define PROBE_REP (-1)
#endif
#ifndef PH_MASK
#define PH_MASK 0xFFFFFFFFu
#endif
DI unsigned char* ptr_opaque(unsigned char* p) { GAS unsigned char* g = (GAS unsigned char*)p; asm volatile("" : "+s"(g)); return (unsigned char*)g; }
DI int lane_opaque() { int l; asm volatile("v_mbcnt_lo_u32_b32 %0, -1, 0\n\tv_mbcnt_hi_u32_b32 %0, -1, %0" : "=v"(l)); return l; }
__global__ void __launch_bounds__(512, 2) fwd_kernel(Args args) {
    extern __shared__ __attribute__((aligned(16))) unsigned char lds[];
    LAS unsigned char* L = (LAS unsigned char*)lds;
    volatile LAS unsigned* MISC = (volatile LAS unsigned*)(L + MISC_OFF);
    const int tid = threadIdx.x, lane0 = tid & 63, wave = __builtin_amdgcn_readfirstlane(tid >> 6);
    const int G = gridDim.x, bx = blockIdx.x;
    const int gw = bx * 8 + wave, NGW = G * 8;
    unsigned char* ws0 = args.ws;
    if (tid < 128) ((LAS unsigned*)(L + LDS_ZERO_OFF))[tid] = 0u;
    __syncthreads();
    XcdBarrier bar = xcd_barrier_post((unsigned*)(ws0 + WS_CTL) + CW_BAR, MISC + 8);
    LAS float* scr = (LAS float*)(L + wave * 16384);
#if PROBE
    int tsi = 0;
#define GRID_BAR() do { xcd_barrier(bar, wave == 0); if (bx == 0 && tid == 0) { ((unsigned*)(ws0 + WS_CTL))[512 + tsi] = (unsigned)__builtin_amdgcn_s_memrealtime(); } ++tsi; } while (0)
    if (bx == 0 && tid == 0) ((unsigned*)(ws0 + WS_CTL))[511] = (unsigned)__builtin_amdgcn_s_memrealtime();
#else
#define GRID_BAR() xcd_barrier(bar, wave == 0)
#endif

    if constexpr ((PH_MASK >> 0) & 1) {
    const int lane = lane_opaque(); unsigned char* const ws = ptr_opaque(args.ws);
    {
        const float* const* in = args.in;
        for (int it = gw; ; it += NGW) {
            int r = it;
            if (transpose_job(r, in[3], 1024, 3072, 3072, (bf16*)(ws + WS_WIN0), 0, 0, 0, scr, lane)) continue;
            if (transpose_job(r, in[9], 1024, 64, 64, (bf16*)(ws + WS_WL), 0, 0, 0, scr, lane)) continue;
            if (transpose_job(r, in[9] + 65536, 1024, 64, 64, (bf16*)(ws + WS_WL), 64, 0, 0, scr, lane)) continue;
            if (transpose_job(r, in[12], 1024, 64, 64, (bf16*)(ws + WS_WL), 128, 0, 0, scr, lane)) continue;
            if (transpose_job(r, in[12] + 65536, 1024, 64, 64, (bf16*)(ws + WS_WL), 192, 0, 0, scr, lane)) continue;
            if (transpose_job(r, in[14], 1024, 128, 256, (bf16*)(ws + WS_WL), 256, 0, 0, scr, lane)) continue;
            if (transpose_job(r, in[21], 1024, 1024, 1024, (bf16*)(ws + WS_WOUT0), 0, 0, 0, scr, lane)) continue;
            if (transpose_job(r, in[10], 64, 512, 512, (bf16*)(ws + WS_W2T), 0, 0, 0, scr, lane)) continue;
            if (transpose_job(r, in[10] + 32768, 64, 512, 512, (bf16*)(ws + WS_W2T) + 32768, 0, 0, 0, scr, lane)) continue;
            if (transpose_job(r, in[13], 64, 512, 512, (bf16*)(ws + WS_W2T) + 65536, 0, 0, 0, scr, lane)) continue;
            if (transpose_job(r, in[13] + 32768, 64, 512, 512, (bf16*)(ws + WS_W2T) + 98304, 0, 0, 0, scr, lane)) continue;
            if (transpose_job(r, in[15], 128, 512, 512, (bf16*)(ws + WS_W2T) + 131072, 0, 0, 0, scr, lane)) continue;
            break;
        }
        norm_rows(args.in[0], args.in[2], args.in[7], (bf16*)(ws + WS_H), (bf16*)(ws + WS_HX), gw, NGW, lane);
    }
    if constexpr (PROBE_REP == 0) {
    {
        const float* const* in = args.in;
        for (int it = gw; ; it += NGW) {
            int r = it;
            if (transpose_job(r, in[3], 1024, 3072, 3072, (bf16*)(ws + WS_WIN0), 0, 0, 0, scr, lane)) continue;
            if (transpose_job(r, in[9], 1024, 64, 64, (bf16*)(ws + WS_WL), 0, 0, 0, scr, lane)) continue;
            if (transpose_job(r, in[9] + 65536, 1024, 64, 64, (bf16*)(ws + WS_WL), 64, 0, 0, scr, lane)) continue;
            if (transpose_job(r, in[12], 1024, 64, 64, (bf16*)(ws + WS_WL), 128, 0, 0, scr, lane)) continue;
            if (transpose_job(r, in[12] + 65536, 1024, 64, 64, (bf16*)(ws + WS_WL), 192, 0, 0, scr, lane)) continue;
            if (transpose_job(r, in[14], 1024, 128, 256, (bf16*)(ws + WS_WL), 256, 0, 0, scr, lane)) continue;
            if (transpose_job(r, in[21], 1024, 1024, 1024, (bf16*)(ws + WS_WOUT0), 0, 0, 0, scr, lane)) continue;
            if (transpose_job(r, in[10], 64, 512, 512, (bf16*)(ws + WS_W2T), 0, 0, 0, scr, lane)) continue;
            if (transpose_job(r, in[10] + 32768, 64, 512, 512, (bf16*)(ws + WS_W2T) + 32768, 0, 0, 0, scr, lane)) continue;
            if (transpose_job(r, in[13], 64, 512, 512, (bf16*)(ws + WS_W2T) + 65536, 0, 0, 0, scr, lane)) continue;
            if (transpose_job(r, in[13] + 32768, 64, 512, 512, (bf16*)(ws + WS_W2T) + 98304, 0, 0, 0, scr, lane)) continue;
            if (transpose_job(r, in[15], 128, 512, 512, (bf16*)(ws + WS_W2T) + 131072, 0, 0, 0, scr, lane)) continue;
            break;
        }
        norm_rows(args.in[0], args.in[2], args.in[7], (bf16*)(ws + WS_H), (bf16*)(ws + WS_HX), gw, NGW, lane);
    }
    }
    GRID_BAR();
    }
    if constexpr (PROBE_REP == 50) { for (int i = 0; i < 10; ++i) GRID_BAR(); }
    if constexpr ((PH_MASK >> 1) & 1) {
    const int lane = lane_opaque(); unsigned char* const ws = ptr_opaque(args.ws);
    {
        { pg8::Gemm g{(const bf16*)(ws + WS_H), (const bf16*)(ws + WS_WIN0), S_, EVEN_IN, D_}; pg8::StaticOrder S; S.init(S_, EVEN_IN, G, bx);
          pg8::EpiStoreBf16 E{(bf16*)(ws + WS_PROJ0), EVEN_IN, 0, nullptr}; pg8::gemm_phase<pg8::EpiStoreBf16, pg8::StaticOrder, true, true>(L, g, S, E, wave); }
        { pg8::Gemm g{(const bf16*)(ws + WS_HX), (const bf16*)(ws + WS_WL), S_, LORA_N, D_}; pg8::StaticOrder S; S.init(S_, LORA_N, G, bx);
          pg8::EpiStoreBf16 E{(bf16*)(ws + WS_LORA), LORA_N, 0, nullptr}; pg8::gemm_phase<pg8::EpiStoreBf16, pg8::StaticOrder, true, true>(L, g, S, E, wave); }
        if constexpr (PROBE_REP == 1) {
        { pg8::Gemm g{(const bf16*)(ws + WS_H), (const bf16*)(ws + WS_WIN0), S_, EVEN_IN, D_}; pg8::StaticOrder S; S.init(S_, EVEN_IN, G, bx);
          pg8::EpiStoreBf16 E{(bf16*)(ws + WS_PROJ0), EVEN_IN, 0, nullptr}; pg8::gemm_phase<pg8::EpiStoreBf16, pg8::StaticOrder, true, true>(L, g, S, E, wave); }
        { pg8::Gemm g{(const bf16*)(ws + WS_HX), (const bf16*)(ws + WS_WL), S_, LORA_N, D_}; pg8::StaticOrder S; S.init(S_, LORA_N, G, bx);
          pg8::EpiStoreBf16 E{(bf16*)(ws + WS_LORA), LORA_N, 0, nullptr}; pg8::gemm_phase<pg8::EpiStoreBf16, pg8::StaticOrder, true, true>(L, g, S, E, wave); }
        }
    }
    GRID_BAR();
    }
    if constexpr ((PH_MASK >> 2) & 1) {
    const int lane = lane_opaque(); unsigned char* const ws = ptr_opaque(args.ws);
    for (int t = gw; t < S_; t += NGW) prep0_token(args, ws, scr, t, lane);
    if constexpr (PROBE_REP == 30) { for (int t = gw; t < S_; t += NGW) prep0_token(args, ws, scr, t, lane); }
    {
        const int hh = bx & 7, nbh = (G - hh + 7) >> 3;
        prep0_stage_w2t(ws, L, hh, wave * 64 + lane);
        LDS_WAIT(); __syncthreads();
        for (int u = wave; ; u += 8) { const int cn = (bx >> 3) + nbh * (u >> 2); if (cn >= 256) break; prep0_rwkv_unit(args, ws, L, 4 * cn + (u & 3), hh, lane); }
        if constexpr (PROBE_REP == 31) { for (int u = wave; ; u += 8) { const int cn = (bx >> 3) + nbh * (u >> 2); if (cn >= 256) break; prep0_rwkv_unit(args, ws, L, 4 * cn + (u & 3), hh, lane); } }
        asm volatile("s_waitcnt vmcnt(0)" ::: "memory");
        __syncthreads();
    }
    }
    if constexpr ((PH_MASK >> 3) & 1) {
    const int lane = lane_opaque(); unsigned char* const ws = ptr_opaque(args.ws);
    {
        if constexpr (PROBE_REP == 40) { if (wave < 2) { for (int it = bx * 2 + wave; it < 4096; it += G * 2) rwkv_pass1_item<true>(ws, L + wave * 65536, it, lane); } }
        if constexpr (PROBE_REP >= 41 && PROBE_REP <= 47) { if (wave < 2) { for (int it = bx * 2 + wave; it < 4096; it += G * 2) rwkv_pass1_item<true, PROBE_REP - 40>(ws, L + wave * 65536, it, lane); } }
        if (wave < 2) { const int hh = bx & 7, nbh = (G - hh + 7) >> 3;
            for (int u = wave; ; u += 2) { const int cn = (bx >> 3) + nbh * (u >> 1); if (cn >= 256) break; const int z = u & 1;
                rwkv_pass1_item(ws, L + wave * 65536, z * 2048 + hh * 256 + (z ? 255 - cn : cn), lane); } }
        else if (wave < 4) {
            const float* const* in = args.in; LAS float* scr2 = (LAS float*)(L + 131072 + (wave - 2) * 8448);
            for (int it = bx * 2 + (wave - 2); ; it += G * 2) {
                int r = it;
                if (transpose_job(r, in[23], 1024, FF0, FF0, (bf16*)(ws + WS_WGU0), 0, 128, 0, scr2, lane)) continue;
                if (transpose_job(r, in[24], 1024, FF0, FF0, (bf16*)(ws + WS_WGU0), 0, 128, 1, scr2, lane)) continue;
                if (transpose_job(r, in[25], FF0, 1024, 1024, (bf16*)(ws + WS_WD0), 0, 0, 0, scr2, lane)) continue;
                if (transpose_job(r, in[27], 1024, ODD_IN, ODD_PAD, (bf16*)(ws + WS_WIN1), 0, 0, 0, scr2, lane)) continue;
                if (transpose_job(r, in[33], 1024, 1024, 1024, (bf16*)(ws + WS_WOUT1), 0, 0, 0, scr2, lane)) continue;
                break;
            }
        }
    }
    GRID_BAR();
    if (bx < 16) { rwkv_pass2_block(ws, L, bx, wave, lane); __syncthreads(); if constexpr (PROBE_REP == 4) { rwkv_pass2_block(ws, L, bx, wave, lane); __syncthreads(); } }
    else { for (int rep_ = 0; rep_ < (PROBE_REP == 3 ? 2 : 1); ++rep_) for (int unit = bx - 16; unit < 512; unit += G - 16) attn_unit(ws, L, unit, wave, lane); }
    GRID_BAR();
    for (int it = gw; it < 2048; it += NGW) rwkv_pass3_post_item(args, ws, it, lane);
    if constexpr (PROBE_REP == 63) { for (int it = gw; it < 2048; it += NGW) rwkv_pass3_post_item(args, ws, it, lane); }
    GRID_BAR();
    }
    if constexpr ((PH_MASK >> 5) & 1) {
    const int lane = lane_opaque(); unsigned char* const ws = ptr_opaque(args.ws);
    { pg8::Gemm g{(const bf16*)(ws + WS_Y), (const bf16*)(ws + WS_WOUT0), S_, D_, D_}; pg8::StaticOrder S; S.init(S_, D_, G, bx);
      pg8::EpiResF32 E{args.in[0], args.out, D_, nullptr, nullptr}; pg8::gemm_phase<pg8::EpiResF32, pg8::StaticOrder, true, true>(L, g, S, E, wave); }
    if constexpr (PROBE_REP == 7) {
    { pg8::Gemm g{(const bf16*)(ws + WS_Y), (const bf16*)(ws + WS_WOUT0), S_, D_, D_}; pg8::StaticOrder S; S.init(S_, D_, G, bx);
      pg8::EpiResF32 E{args.in[0], args.out, D_, nullptr, nullptr}; pg8::gemm_phase<pg8::EpiResF32, pg8::StaticOrder, true, true>(L, g, S, E, wave); }
    }
    GRID_BAR();
    }
    if constexpr ((PH_MASK >> 6) & 1) {
    const int lane = lane_opaque(); unsigned char* const ws = ptr_opaque(args.ws);
    norm_rows(args.out, args.in[22], nullptr, (bf16*)(ws + WS_H2), nullptr, gw, NGW, lane);
    GRID_BAR();
    }
    if constexpr ((PH_MASK >> 7) & 1) {
    const int lane = lane_opaque(); unsigned char* const ws = ptr_opaque(args.ws);
    { pg8::Gemm g{(const bf16*)(ws + WS_H2), (const bf16*)(ws + WS_WGU0), S_, 2 * FF0, D_}; pg8::StaticOrder S; S.init(S_, 2 * FF0, G, bx);
      pg8::EpiSwiGLU E{(bf16*)(ws + WS_ACT0), FF0, 0, nullptr}; pg8::gemm_phase<pg8::EpiSwiGLU, pg8::StaticOrder, true, true>(L, g, S, E, wave); }
    if constexpr (PROBE_REP == 9) {
    { pg8::Gemm g{(const bf16*)(ws + WS_H2), (const bf16*)(ws + WS_WGU0), S_, 2 * FF0, D_}; pg8::StaticOrder S; S.init(S_, 2 * FF0, G, bx);
      pg8::EpiSwiGLU E{(bf16*)(ws + WS_ACT0), FF0, 0, nullptr}; pg8::gemm_phase<pg8::EpiSwiGLU, pg8::StaticOrder, true, true>(L, g, S, E, wave); }
    }
    GRID_BAR();
    }
    if constexpr ((PH_MASK >> 8) & 1) {
    const int lane = lane_opaque(); unsigned char* const ws = ptr_opaque(args.ws);
    { pg8::Gemm g{(const bf16*)(ws + WS_ACT0), (const bf16*)(ws + WS_WD0), S_, D_, FF0}; pg8::StaticOrder S; S.init(S_, D_, G, bx);
      pg8::EpiResF32 E{args.out, args.out, D_, nullptr, nullptr}; pg8::gemm_phase<pg8::EpiResF32, pg8::StaticOrder, true, true>(L, g, S, E, wave); }
    GRID_BAR();
    }
    if constexpr ((PH_MASK >> 9) & 1) {
    const int lane = lane_opaque(); unsigned char* const ws = ptr_opaque(args.ws);
    norm_rows(args.out, args.in[26], nullptr, (bf16*)(ws + WS_H3), nullptr, gw, NGW, lane);
    GRID_BAR();
    }
    if constexpr ((PH_MASK >> 10) & 1) {
    const int lane = lane_opaque(); unsigned char* const ws = ptr_opaque(args.ws);
    { pg8::Gemm g{(const bf16*)(ws + WS_H3), (const bf16*)(ws + WS_WIN1), S_, ODD_PAD, D_}; pg8::StaticOrder S; S.init(S_, ODD_PAD, G, bx);
      pg8::EpiStoreBf16 E{(bf16*)(ws + WS_PROJ1), ODD_PAD, 0, nullptr}; pg8::gemm_phase<pg8::EpiStoreBf16, pg8::StaticOrder, true, true>(L, g, S, E, wave); }
    if constexpr (PROBE_REP == 12) {
    { pg8::Gemm g{(const bf16*)(ws + WS_H3), (const bf16*)(ws + WS_WIN1), S_, ODD_PAD, D_}; pg8::StaticOrder S; S.init(S_, ODD_PAD, G, bx);
      pg8::EpiStoreBf16 E{(bf16*)(ws + WS_PROJ1), ODD_PAD, 0, nullptr}; pg8::gemm_phase<pg8::EpiStoreBf16, pg8::StaticOrder, true, true>(L, g, S, E, wave); }
    }
    GRID_BAR();
    }
    if constexpr ((PH_MASK >> 11) & 1) {
    const int lane = lane_opaque(); unsigned char* const ws = ptr_opaque(args.ws);
    for (int cn = bx; cn < 256; cn += G) for (int i = wave; i < 64; i += 8) prep1_token(args, ws, cn * 64 + i, lane);
    GRID_BAR();
    }
    if constexpr ((PH_MASK >> 12) & 1) {
    const int lane = lane_opaque(); unsigned char* const ws = ptr_opaque(args.ws);
    {
        if (wave < 2) { const int z = wave;
            for (int cn = bx; cn < 256; cn += G) for (int hh = 0; hh < 4; ++hh) dn_pass1_item(ws, L + wave * DN_LDS_PER_WAVE, (z * 4 + hh) * 256 + (z ? 255 - cn : cn), lane); }
        else {
            LAS float* scr2 = (LAS float*)(L + 2 * DN_LDS_PER_WAVE + (wave - 2) * 8448);
            for (int it = bx * 6 + (wave - 2); ; it += G * 6) {
                int r = it; bool did = false;
                for (int e = 0; e < NEXP; ++e) {
                    if (transpose_job(r, args.in[36] + (size_t)e * 1024 * FFE, 1024, FFE, FFE, (bf16*)(ws + WS_WMGU) + (size_t)e * 2 * FFE * 1024, 0, 128, 0, scr2, lane)) { did = true; break; }
                    if (transpose_job(r, args.in[37] + (size_t)e * 1024 * FFE, 1024, FFE, FFE, (bf16*)(ws + WS_WMGU) + (size_t)e * 2 * FFE * 1024, 0, 128, 1, scr2, lane)) { did = true; break; }
                }
                if (!did) break;
            }
        }
    }
    GRID_BAR();
    { const int task = bx; if (task < 512) dn_scan_block(ws, L, task >> 8, (task & 3) < 2 ? 1 : 2, (task >> 6) & 3, task & 1, (task >> 2) & 15, wave, lane); __syncthreads(); }
    { const int task = bx + G; if (task < 512) dn_scan_block(ws, L, task >> 8, (task & 3) < 2 ? 1 : 2, (task >> 6) & 3, task & 1, (task >> 2) & 15, wave, lane); __syncthreads(); }
    if constexpr (PROBE_REP == 60) { { const int task = bx; if (task < 512) dn_scan_block(ws, L, task >> 8, (task & 3) < 2 ? 1 : 2, (task >> 6) & 3, task & 1, (task >> 2) & 15, wave, lane); __syncthreads(); }
      { const int task = bx + G; if (task < 512) dn_scan_block(ws, L, task >> 8, (task & 3) < 2 ? 1 : 2, (task >> 6) & 3, task & 1, (task >> 2) & 15, wave, lane); __syncthreads(); } }
    GRID_BAR();
    if (bx < 64) { if (wave == 0) dn_scan_groups(ws, bx, lane); }
    if constexpr (PROBE_REP == 61) { if (bx < 64) { if (wave == 0) dn_scan_groups(ws, bx, lane); } }
    GRID_BAR();
    { const int task = bx; if (task < 256) dn_scan_block(ws, L, task >> 7, 0, (task >> 5) & 3, (task >> 4) & 1, task & 15, wave, lane); __syncthreads(); }
    if constexpr (PROBE_REP == 62) { const int task = bx; if (task < 256) dn_scan_block(ws, L, task >> 7, 0, (task >> 5) & 3, (task >> 4) & 1, task & 15, wave, lane); __syncthreads(); }
    GRID_BAR();
for (int rep_ = 0; rep_ < (PROBE_REP == 16 ? 2 : 1); ++rep_) {     for (int it = gw; it < 2048; it += NGW) dn_pass3_item(ws, it, lane); }
    GRID_BAR();
    }
    if constexpr ((PH_MASK >> 13) & 1) {
    const int lane = lane_opaque(); unsigned char* const ws = ptr_opaque(args.ws);
    for (int t = gw; t < S_; t += NGW) dn_post_token(args, ws, t, lane);
    for (int it = gw; ; it += NGW) {
        int r = it; bool did = false;
        for (int e = 0; e < NEXP; ++e)
            if (transpose_job(r, args.in[38] + (size_t)e * 1024 * FFE, FFE, 1024, 1024, (bf16*)(ws + WS_WMD) + (size_t)e * 1024 * FFE, 0, 0, 0, scr, lane)) { did = true; break; }
        if (!did) break;
    }
    GRID_BAR();
    }
    if constexpr ((PH_MASK >> 14) & 1) {
    const int lane = lane_opaque(); unsigned char* const ws = ptr_opaque(args.ws);
    { pg8::Gemm g{(const bf16*)(ws + WS_YCAT1), (const bf16*)(ws + WS_WOUT1), S_, D_, D_}; pg8::StaticOrder S; S.init(S_, D_, G, bx);
      pg8::EpiResF32 E{args.out, args.out, D_, nullptr, nullptr}; pg8::gemm_phase<pg8::EpiResF32, pg8::StaticOrder, true, true>(L, g, S, E, wave); }
    GRID_BAR();
    }
    if constexpr ((PH_MASK >> 15) & 1) {
    const int lane = lane_opaque(); unsigned char* const ws = ptr_opaque(args.ws);
    { RouterRegs RR; route_load(args, RR, lane); for (int t = gw; t < S_; t += NGW) route_token(RR, ws, args.out, t, lane); }
    GRID_BAR();
    }
    int off[9]; moe_offsets(ws0, off);
    const int ntiles = off[8] >> 8;
    if constexpr ((PH_MASK >> 16) & 1) {
    const int lane = lane_opaque(); unsigned char* const ws = ptr_opaque(args.ws);
    {
        for (int t = gw; t < S_; t += NGW) gather_token(args, ws, args.out, off, t, lane);
        const int tid2 = wave * 64 + lane;
        if (bx == 0 && tid2 < 160) { int e = 0;
#pragma unroll
            for (int k = 1; k < 8; ++k) if (tid2 * 256 >= off[k]) e = k;
            ((int*)(ws + WS_TILE))[tid2] = e; }
        const unsigned* cnt = (const unsigned*)(ws + WS_CTL) + CW_CNT;
        for (int e = 0; e < NEXP; ++e) { const int c = (int)__hip_atomic_load(cnt + e, __ATOMIC_RELAXED, __HIP_MEMORY_SCOPE_AGENT); const int r0 = off[e] + c, r1 = off[e + 1];
            for (int rr = r0 + gw; rr < r1; rr += NGW) { unsigned long long* o8 = (unsigned long long*)((bf16*)(ws + WS_AMOE) + (size_t)rr * D_) + lane;
#pragma unroll
                for (int j = 0; j < 4; ++j) o8[64 * j] = 0ull; } }
    }
    if constexpr (PROBE_REP == 20) {
    {
        for (int t = gw; t < S_; t += NGW) gather_token(args, ws, args.out, off, t, lane);
        const int tid2 = wave * 64 + lane;
        if (bx == 0 && tid2 < 160) { int e = 0;
#pragma unroll
            for (int k = 1; k < 8; ++k) if (tid2 * 256 >= off[k]) e = k;
            ((int*)(ws + WS_TILE))[tid2] = e; }
        const unsigned* cnt = (const unsigned*)(ws + WS_CTL) + CW_CNT;
        for (int e = 0; e < NEXP; ++e) { const int c = (int)__hip_atomic_load(cnt + e, __ATOMIC_RELAXED, __HIP_MEMORY_SCOPE_AGENT); const int r0 = off[e] + c, r1 = off[e + 1];
            for (int rr = r0 + gw; rr < r1; rr += NGW) { unsigned long long* o8 = (unsigned long long*)((bf16*)(ws + WS_AMOE) + (size_t)rr * D_) + lane;
#pragma unroll
                for (int j = 0; j < 4; ++j) o8[64 * j] = 0ull; } }
    }
    }
    GRID_BAR();
    }
    if constexpr ((PH_MASK >> 17) & 1) {
    const int lane = lane_opaque(); unsigned char* const ws = ptr_opaque(args.ws);
    for (int b = 0; b < 3; ++b) {
        const int tlo = b * MOE_BATCH_TILES; int nt = ntiles - tlo; nt = nt < 0 ? 0 : (nt > MOE_BATCH_TILES ? MOE_BATCH_TILES : nt);
        { pg8::Gemm g{(const bf16*)(ws + WS_AMOE), (const bf16*)(ws + WS_WMGU), MOE_ROWS, NEXP * 2 * FFE, D_};
          pg8::MoeOrder S{(const int*)(ws + WS_TILE), tlo, nt, 2 * FFE / 256, G, bx};
          pg8::EpiSwiGLU E{(bf16*)(ws + WS_MACT) - (size_t)tlo * 256 * FFE, FFE, 2 * FFE / 256, nullptr};
          pg8::gemm_phase<pg8::EpiSwiGLU, pg8::MoeOrder, true, true>(L, g, S, E, wave); }
        if constexpr (PROBE_REP == 21) {
        { pg8::Gemm g{(const bf16*)(ws + WS_AMOE), (const bf16*)(ws + WS_WMGU), MOE_ROWS, NEXP * 2 * FFE, D_};
          pg8::MoeOrder S{(const int*)(ws + WS_TILE), tlo, nt, 2 * FFE / 256, G, bx};
          pg8::EpiSwiGLU E{(bf16*)(ws + WS_MACT) - (size_t)tlo * 256 * FFE, FFE, 2 * FFE / 256, nullptr};
          pg8::gemm_phase<pg8::EpiSwiGLU, pg8::MoeOrder, true, true>(L, g, S, E, wave); }
        }
        GRID_BAR();
        { pg8::Gemm g{(const bf16*)(ws + WS_MACT) - (size_t)tlo * 256 * FFE, (const bf16*)(ws + WS_WMD), MOE_ROWS, NEXP * D_, FFE};
          pg8::MoeOrder S{(const int*)(ws + WS_TILE), tlo, nt, D_ / 256, G, bx};
          pg8::EpiStoreBf16 E{(bf16*)(ws + WS_AMOE), D_, D_ / 256, nullptr};
          pg8::gemm_phase<pg8::EpiStoreBf16, pg8::MoeOrder, true, true>(L, g, S, E, wave); }
        if constexpr (PROBE_REP == 22) {
        { pg8::Gemm g{(const bf16*)(ws + WS_MACT) - (size_t)tlo * 256 * FFE, (const bf16*)(ws + WS_WMD), MOE_ROWS, NEXP * D_, FFE};
          pg8::MoeOrder S{(const int*)(ws + WS_TILE), tlo, nt, D_ / 256, G, bx};
          pg8::EpiStoreBf16 E{(bf16*)(ws + WS_AMOE), D_, D_ / 256, nullptr};
          pg8::gemm_phase<pg8::EpiStoreBf16, pg8::MoeOrder, true, true>(L, g, S, E, wave); }
        }
        GRID_BAR();
    }
    }
    if constexpr ((PH_MASK >> 18) & 1) {
    const int lane = lane_opaque(); unsigned char* const ws = ptr_opaque(args.ws);
    for (int t = gw; t < S_; t += NGW) combine_token(ws, args.out, off, t, lane);
#if PROBE
    {
        const unsigned* ts = (const unsigned*)(ws + WS_CTL) + 512;
        const unsigned dA = PROBE_A < 0 ? 32000u : (__hip_atomic_load(ts + PROBE_A, __ATOMIC_RELAXED, __HIP_MEMORY_SCOPE_AGENT) - __hip_atomic_load(ts + PROBE_A - 1, __ATOMIC_RELAXED, __HIP_MEMORY_SCOPE_AGENT));
        const unsigned dB = __hip_atomic_load(ts + PROBE_B, __ATOMIC_RELAXED, __HIP_MEMORY_SCOPE_AGENT) - __hip_atomic_load(ts + PROBE_B - 1, __ATOMIC_RELAXED, __HIP_MEMORY_SCOPE_AGENT);
        const int rows = 8 * (int)(dA / 3200u) + 64;
        const float addB = 4.0f * (float)(dB / 3200u) + 8.0f;
        for (int t = gw; t < S_; t += NGW) {
            if (t < rows) { f32x4* xo = (f32x4*)(args.out + (size_t)t * D_) + lane;
#pragma unroll
                for (int j = 0; j < 4; ++j) xo[64 * j] = xo[64 * j] + 5.0f; }
            if (t == S_ - 1 && lane == 63) args.out[(size_t)t * D_ + 1023] += addB;
        }
    }
#endif
    }
}

extern "C" void kernel_launch(void* const* d_in, const int* in_sizes, int n_in, void* d_out, int out_size, void* d_ws, size_t ws_size, hipStream_t stream) {
    static int grid = 0;
    if (grid == 0) {
        if (n_in != 39 || out_size != S_ * D_ || ws_size < WS_END) { fprintf(stderr, "kernel_launch: unexpected shapes (n_in %d out %d ws %zu)\n", n_in, out_size, ws_size); grid = -1; return; }
        int dev = 0, cus = 0, per_cu = 0;
        if (hipGetDevice(&dev) != hipSuccess || hipDeviceGetAttribute(&cus, hipDeviceAttributeMultiprocessorCount, dev) != hipSuccess) { grid = -1; return; }
        if (hipFuncSetAttribute((const void*)fwd_kernel, hipFuncAttributeMaxDynamicSharedMemorySize, LDS_BYTES) != hipSuccess) { grid = -1; return; }
        if (hipOccupancyMaxActiveBlocksPerMultiprocessor(&per_cu, (const void*)fwd_kernel, 512, LDS_BYTES) != hipSuccess || per_cu < 1) { fprintf(stderr, "kernel_launch: occupancy query says %d\n", per_cu); }
        (void)hipGetLastError();
        if (cus < 256) { fprintf(stderr, "kernel_launch: this build needs >= 256 CUs (task slots of the delta-net scan); got %d\n", cus); grid = -1; return; }
        grid = 256;
    }
    if (grid < 0) return;
    if (hipMemsetAsync((char*)d_ws + WS_CTL, 0, CTL_ZERO_BYTES, stream) != hipSuccess) return;
    Args a{};
    for (int i = 0; i < 39; ++i) a.in[i] = (const float*)d_in[i];
    a.out = (float*)d_out; a.ws = (unsigned char*)d_ws;
    hipLaunchKernelGGL(fwd_kernel, dim3(grid), dim3(512), LDS_BYTES, stream, a);
}
```

```cpp
#include <hip/hip_runtime.h>
#include <cstdio>
#include <cstdint>
namespace pg8 {
#define PG8_LAS __attribute__((address_space(3)))
typedef unsigned short bf16_t;
typedef short bf16x8 __attribute__((ext_vector_type(8)));
typedef float f32x4 __attribute__((ext_vector_type(4)));
typedef unsigned u32x4 __attribute__((ext_vector_type(4)));
constexpr int BM = 256, BK = 64, HALF = 128, HTB = HALF * BK * 2  , STAGE_BYTES = 8 * HTB, NXCD = 8, WGM = 8;

__host__ __device__ __forceinline__ int lds_byte(int r, int c) { const int st = (r >> 4) * 2 + (c >> 5), rr = r & 15, cc = c & 31, ob = rr * 64 + cc * 2; return st * 1024 + (ob ^ (((ob >> 9) & 1) << 5)); }
__host__ __device__ __forceinline__ void stage_rc(int b, int& R, int& C) { const int st = b / 1024, sb = b % 1024, swz = sb ^ (((sb >> 9) & 1) << 5); R = (st >> 1) * 16 + swz / 64; C = (st & 1) * 32 + (swz % 64) / 2; }
__host__ __device__ __forceinline__ int perm32(int rho) { const int n = rho >> 4, i = rho & 15; return 8 * (i >> 2) + 4 * n + (i & 3); }

struct Unit { int pm, pn; };
struct Gemm { const bf16_t* A; const bf16_t* Bt; int M, N, K; };

struct StaticOrder {
    int nM, nN, nwg, G, c;
    __host__ __device__ void init(int M, int N, int G_, int c_) { nM = M / BM; nN = N / BM; nwg = nM * nN; G = G_; c = c_; }
    __host__ __device__ bool next(int i, Unit& u) const {
        const long L = (long)i * G + c; if (L >= nwg) return false;
        int wgid = (int)L; { const int q = nwg / NXCD, r = nwg % NXCD, xcd = wgid % NXCD, off = wgid / NXCD; wgid = (xcd < r ? xcd * (q + 1) : r * (q + 1) + (xcd - r) * q) + off; }
        const int nig = WGM * nN, gid = wgid / nig, fm = gid * WGM, gsz = (nM - fm) < WGM ? (nM - fm) : WGM;
        u.pm = fm + ((wgid % nig) % gsz); u.pn = (wgid % nig) / gsz; return true;
    }
    __device__ __forceinline__ void a_ready(const Unit&) const {}
    __device__ __forceinline__ void done(const Unit&) const {}
};

__device__ __forceinline__ unsigned cvt_pk_bf16(float lo, float hi) { unsigned r; asm volatile("v_cvt_pk_bf16_f32 %0, %1, %2" : "=v"(r) : "v"(lo), "v"(hi)); return r; }
struct EpiStoreBf16 {
    static constexpr bool PERM = true, AFTER_DRAIN = false;
    bf16_t* O; int ldc; int ntn; const float* rowss;
    __device__ __forceinline__ void operator()(const f32x4 (&acc)[2][2][4][2], const Unit& u, int wr, int wc, int fr, int fq) const {
        const int row0 = u.pm * BM + wr * 64 + fr; const int pn = ntn ? (u.pn % ntn) : u.pn;
        const int col0 = pn * BM + wc * 32 + 8 * fq;
#pragma unroll
        for (int ai = 0; ai < 2; ++ai)
#pragma unroll
            for (int m = 0; m < 4; ++m) { bf16_t* rowp = O + (size_t)(row0 + ai * HALF + m * 16) * ldc + col0;
                float rs = 1.0f; if (rowss) { const f32x4* sp = (const f32x4*)(rowss + (size_t)(row0 + ai * HALF + m * 16) * 16); const f32x4 s0 = sp[0], s1 = sp[1], s2 = sp[2], s3 = sp[3]; const f32x4 st = (s0 + s1) + (s2 + s3); rs = 1.0f / sqrtf(((st[0] + st[1]) + (st[2] + st[3])) * (1.0f / 1024.f) + 1e-6f); }
#pragma unroll
                for (int bj = 0; bj < 2; ++bj) { const f32x4 v0 = acc[ai][bj][m][0] * rs, v1 = acc[ai][bj][m][1] * rs;
                    u32x4 w; w.x = cvt_pk_bf16(v0[0], v0[1]); w.y = cvt_pk_bf16(v0[2], v0[3]); w.z = cvt_pk_bf16(v1[0], v1[1]); w.w = cvt_pk_bf16(v1[2], v1[3]);
                    *(u32x4*)(rowp + bj * HALF) = w; } }
    }
};
struct EpiResF32 {
    static constexpr bool PERM = false, AFTER_DRAIN = false;
    const float* base; float* out; int ldc; bf16_t* xb; float* rowss;
    __device__ __forceinline__ void operator()(const f32x4 (&acc)[2][2][4][2], const Unit& u, int wr, int wc, int fr, int fq) const {
        const int row0 = u.pm * BM + wr * 64 + fr, col0 = u.pn * BM + wc * 32 + 4 * fq;
#pragma unroll
        for (int ai = 0; ai < 2; ++ai)
#pragma unroll
            for (int m = 0; m < 4; ++m) { const size_t off = (size_t)(row0 + ai * HALF + m * 16) * ldc + col0; float ss = 0.f;
#pragma unroll
                for (int bj = 0; bj < 2; ++bj)
#pragma unroll
                    for (int n = 0; n < 2; ++n) { const f32x4 b = *(const f32x4*)(base + off + bj * HALF + n * 16); const f32x4 o = b + acc[ai][bj][m][n]; *(f32x4*)(out + off + bj * HALF + n * 16) = o;
                        if (xb) { ss += (o[0] * o[0] + o[1] * o[1]) + (o[2] * o[2] + o[3] * o[3]);
                            unsigned long long w = (unsigned long long)cvt_pk_bf16(o[0], o[1]) | ((unsigned long long)cvt_pk_bf16(o[2], o[3]) << 32); *(unsigned long long*)(xb + off + bj * HALF + n * 16) = w; } }
                if (xb) { ss += __shfl_xor(ss, 16); ss += __shfl_xor(ss, 32); if (fq == 0) rowss[(size_t)(row0 + ai * HALF + m * 16) * 16 + u.pn * 4 + wc] = ss; } }
    }
};
struct EpiSwiGLU {
    static constexpr bool PERM = true, AFTER_DRAIN = false;
    bf16_t* O; int ldc; int ntn; const float* rowss;
    __device__ __forceinline__ void operator()(const f32x4 (&acc)[2][2][4][2], const Unit& u, int wr, int wc, int fr, int fq) const {
        const int row0 = u.pm * BM + wr * 64 + fr; const int pn = ntn ? (u.pn % ntn) : u.pn;
        const int col0 = pn * HALF + wc * 32 + 8 * fq;
#pragma unroll
        for (int ai = 0; ai < 2; ++ai)
#pragma unroll
            for (int m = 0; m < 4; ++m) { bf16_t* rowp = O + (size_t)(row0 + ai * HALF + m * 16) * ldc + col0;
                float rs = 1.0f; if (rowss) { const f32x4* sp = (const f32x4*)(rowss + (size_t)(row0 + ai * HALF + m * 16) * 16); const f32x4 s0 = sp[0], s1 = sp[1], s2 = sp[2], s3 = sp[3]; const f32x4 st = (s0 + s1) + (s2 + s3); rs = 1.0f / sqrtf(((st[0] + st[1]) + (st[2] + st[3])) * (1.0f / 1024.f) + 1e-6f); }
                float r[8];
#pragma unroll
                for (int n = 0; n < 2; ++n)
#pragma unroll
                    for (int i = 0; i < 4; ++i) { const float g = acc[ai][0][m][n][i] * rs, up = acc[ai][1][m][n][i] * rs; r[n * 4 + i] = g * __builtin_amdgcn_rcpf(1.0f + __expf(-g)) * up; }
                u32x4 w; w.x = cvt_pk_bf16(r[0], r[1]); w.y = cvt_pk_bf16(r[2], r[3]); w.z = cvt_pk_bf16(r[4], r[5]); w.w = cvt_pk_bf16(r[6], r[7]);
                *(u32x4*)rowp = w; }
    }
};
struct MoeOrder {
    const int* tile_exp; int tlo, nt, nN, G, c;
    __device__ __forceinline__ bool next(int i, Unit& u) const {
        const int L = i * G + c; if (nt <= 0 || L >= nt * nN) return false;
        const int t = tlo + (L % nt), cn = L / nt;
        const int e = __builtin_amdgcn_readfirstlane(__hip_atomic_load(tile_exp + t, __ATOMIC_RELAXED, __HIP_MEMORY_SCOPE_AGENT));
        u.pm = t; u.pn = e * nN + cn; return true;
    }
    __device__ __forceinline__ void a_ready(const Unit&) const {}
    __device__ __forceinline__ void done(const Unit&) const {}
};
template <class Epi, class Sched, bool ALIGN_EPI = false, bool SP2 = false>
__device__ __forceinline__ void gemm_phase(PG8_LAS unsigned char* lds, const Gemm g, const Sched& S, const Epi& E, const int wave_id) {
    int tid_; asm volatile("v_mbcnt_lo_u32_b32 %0, -1, 0\n\tv_mbcnt_hi_u32_b32 %0, -1, %0" : "=v"(tid_)); tid_ += wave_id * 64;
    const int tid = tid_, wid = __builtin_amdgcn_readfirstlane(tid >> 6), lane = tid & 63, wr = wid >> 2, wc = wid & 3, fr = lane & 15, fq = lane >> 4;
    const int K = g.K, nt = K / BK;
    unsigned voffA[2], voffB[2];
#pragma unroll
    for (int i = 0; i < 2; ++i) { int R, C; stage_rc(tid * 16 + i * 8192, R, C); const int Rb = Epi::PERM ? ((R & ~31) + perm32(R & 31)) : R;
        voffA[i] = (unsigned)(R * K + C) * 2u; voffB[i] = (unsigned)(Rb * K + C) * 2u; }
    const size_t kstep = (size_t)(BK * 2);
    const size_t hstep = (size_t)HALF * K * 2;
    const size_t tstep = 2 * hstep;
    const unsigned ldsw = (unsigned)wid * 1024u;
    const int aoff = lds_byte(wr * 64 + fr, fq * 8), boff = lds_byte(wc * 32 + fr, fq * 8);
#define PG8_SA(b, h) (((b) * 2 + (h)) * HTB)
#define PG8_SB(b, h) ((4 + (b) * 2 + (h)) * HTB)
#define PG8_STAGE(bufoff, gbase, voff) do { _Pragma("unroll") for (int _i = 0; _i < 2; ++_i) \
        __builtin_amdgcn_global_load_lds((const unsigned*)((const char*)(gbase) + (voff)[_i]), (PG8_LAS unsigned*)(lds + (bufoff) + ldsw + _i * 8192), 16, 0, 0); } while (0)
#define PG8_LDA(dst, b, h) do { _Pragma("unroll") for (int m = 0; m < 4; ++m) _Pragma("unroll") for (int k = 0; k < 2; ++k) dst[m][k] = *(const PG8_LAS bf16x8*)(lds + PG8_SA(b, h) + aoff + m * 2048 + k * 1024); } while (0)
#define PG8_LDB(dst, b, h) do { _Pragma("unroll") for (int n = 0; n < 2; ++n) _Pragma("unroll") for (int k = 0; k < 2; ++k) dst[n][k] = *(const PG8_LAS bf16x8*)(lds + PG8_SB(b, h) + boff + n * 2048 + k * 1024); } while (0)
#define PG8_MMA(ai, bj, At, Bt) do { __builtin_amdgcn_s_setprio(1); _Pragma("unroll") for (int m = 0; m < 4; ++m) _Pragma("unroll") for (int n = 0; n < 2; ++n) _Pragma("unroll") for (int k = 0; k < 2; ++k) \
        acc[ai][bj][m][n] = __builtin_amdgcn_mfma_f32_16x16x32_bf16(Bt[n][k], At[m][k], acc[ai][bj][m][n], 0, 0, 0); __builtin_amdgcn_s_setprio(0); } while (0)
#define PG8_WAIT_V(n) asm volatile("s_waitcnt vmcnt(" #n ")" ::: "memory")
#define PG8_WAIT_L(n) asm volatile("s_waitcnt lgkmcnt(" #n ")" ::: "memory")
#define PG8_BAR __builtin_amdgcn_s_barrier()
#define PG8_SCHED __builtin_amdgcn_sched_barrier(0)
    Unit cur, nxt; int ui = 0;
    if (!S.next(0, cur)) return;
    f32x4 acc[2][2][4][2];
#pragma unroll
    for (int a = 0; a < 2; ++a)
#pragma unroll
        for (int b = 0; b < 2; ++b)
#pragma unroll
            for (int m = 0; m < 4; ++m)
#pragma unroll
                for (int n = 0; n < 2; ++n) acc[a][b][m][n] = (f32x4){0.f, 0.f, 0.f, 0.f};
    bf16x8 At[4][2], B0[2][2], B1[2][2];
    const char* cA = (const char*)g.A + (size_t)cur.pm * tstep; const char* cB = (const char*)g.Bt + (size_t)cur.pn * tstep;
    S.a_ready(cur);
    if constexpr (SP2) {
        PG8_STAGE(PG8_SB(0, 0), cB, voffB); PG8_STAGE(PG8_SB(0, 1), cB + hstep, voffB); PG8_STAGE(PG8_SA(0, 0), cA, voffA); PG8_STAGE(PG8_SA(0, 1), cA + hstep, voffA);
        if (wr == 1) PG8_BAR;
        PG8_WAIT_V(2); PG8_BAR;
        PG8_STAGE(PG8_SB(1, 0), cB + kstep, voffB); PG8_STAGE(PG8_SA(1, 0), cA + kstep, voffA); PG8_STAGE(PG8_SB(1, 1), cB + hstep + kstep, voffB);
        PG8_WAIT_V(6); PG8_BAR;
    } else {
        PG8_STAGE(PG8_SB(0, 0), cB, voffB); PG8_STAGE(PG8_SA(0, 0), cA, voffA); PG8_STAGE(PG8_SB(0, 1), cB + hstep, voffB); PG8_STAGE(PG8_SA(0, 1), cA + hstep, voffA);
        if (wr == 1) PG8_BAR;
        PG8_WAIT_V(4); PG8_BAR;
        PG8_STAGE(PG8_SB(1, 0), cB + kstep, voffB); PG8_STAGE(PG8_SA(1, 0), cA + kstep, voffA); PG8_STAGE(PG8_SB(1, 1), cB + hstep + kstep, voffB);
        PG8_WAIT_V(6); PG8_BAR;
    }
    for (;;) {
        const bool has_next = S.next(ui + 1, nxt);
        const char* nA = has_next ? (const char*)g.A + (size_t)nxt.pm * tstep : cA; const char* nB = has_next ? (const char*)g.Bt + (size_t)nxt.pn * tstep : cB;
        for (int t = 0; t < nt; t += 2) {
            const bool last = (t == nt - 2);
            const char* a1 = cA + (size_t)(t + 1) * kstep;
            const char* a2 = last ? nA : cA + (size_t)(t + 2) * kstep; const char* b2 = last ? nB : cB + (size_t)(t + 2) * kstep;
            const char* a3 = a2 + kstep; const char* b3 = b2 + kstep;
            if (last && has_next) S.a_ready(nxt);
            if constexpr (SP2) {
            PG8_LDB(B0, 0, 0); PG8_LDB(B1, 0, 1); PG8_SCHED; PG8_LDA(At, 0, 0); PG8_STAGE(PG8_SA(1, 1), a1 + hstep, voffA);
            PG8_WAIT_V(8); PG8_WAIT_L(0); PG8_BAR; PG8_MMA(0, 0, At, B0); PG8_MMA(0, 1, At, B1); PG8_BAR; PG8_SCHED;
            PG8_LDA(At, 0, 1); PG8_STAGE(PG8_SB(0, 0), b2, voffB); PG8_STAGE(PG8_SB(0, 1), b2 + hstep, voffB); PG8_STAGE(PG8_SA(0, 0), a2, voffA);
            PG8_WAIT_V(8); PG8_WAIT_L(0); PG8_BAR; PG8_MMA(1, 0, At, B0); PG8_MMA(1, 1, At, B1); PG8_BAR; PG8_SCHED;
            PG8_LDB(B0, 1, 0); PG8_LDB(B1, 1, 1); PG8_SCHED; PG8_LDA(At, 1, 0); PG8_STAGE(PG8_SA(0, 1), a2 + hstep, voffA);
            PG8_WAIT_V(8); PG8_WAIT_L(0); PG8_BAR; PG8_MMA(0, 0, At, B0); PG8_MMA(0, 1, At, B1); PG8_BAR; PG8_SCHED;
            PG8_LDA(At, 1, 1); PG8_STAGE(PG8_SB(1, 0), b3, voffB); PG8_STAGE(PG8_SB(1, 1), b3 + hstep, voffB); PG8_STAGE(PG8_SA(1, 0), a3, voffA);
            PG8_WAIT_V(8); PG8_WAIT_L(0); PG8_BAR; PG8_MMA(1, 0, At, B0); PG8_MMA(1, 1, At, B1); PG8_BAR; PG8_SCHED;
            } else {
            PG8_LDB(B0, 0, 0); PG8_SCHED; PG8_LDA(At, 0, 0); PG8_STAGE(PG8_SA(1, 1), a1 + hstep, voffA);
            PG8_WAIT_L(8); PG8_BAR; PG8_WAIT_L(0); PG8_MMA(0, 0, At, B0); PG8_BAR; PG8_SCHED;
            PG8_LDB(B1, 0, 1); PG8_STAGE(PG8_SB(0, 0), b2, voffB);
            PG8_BAR; PG8_WAIT_L(0); PG8_MMA(0, 1, At, B1); PG8_BAR;
            PG8_LDA(At, 0, 1); PG8_STAGE(PG8_SA(0, 0), a2, voffA);
            PG8_BAR; PG8_WAIT_L(0); PG8_MMA(1, 0, At, B0); PG8_BAR; PG8_SCHED;
            PG8_STAGE(PG8_SB(0, 1), b2 + hstep, voffB);
            PG8_WAIT_V(6); PG8_BAR; PG8_MMA(1, 1, At, B1); PG8_BAR;
            PG8_LDB(B0, 1, 0); PG8_SCHED; PG8_LDA(At, 1, 0); PG8_STAGE(PG8_SA(0, 1), a2 + hstep, voffA);
            PG8_WAIT_L(8); PG8_BAR; PG8_WAIT_L(0); PG8_MMA(0, 0, At, B0); PG8_BAR; PG8_SCHED;
            PG8_LDB(B1, 1, 1); PG8_STAGE(PG8_SB(1, 0), b3, voffB);
            PG8_BAR; PG8_WAIT_L(0); PG8_MMA(0, 1, At, B1); PG8_BAR;
            PG8_LDA(At, 1, 1); PG8_STAGE(PG8_SA(1, 0), a3, voffA);
            PG8_BAR; PG8_WAIT_L(0); PG8_MMA(1, 0, At, B0); PG8_BAR; PG8_SCHED;
            PG8_STAGE(PG8_SB(1, 1), b3 + hstep, voffB);
            PG8_WAIT_V(6); PG8_BAR; PG8_MMA(1, 1, At, B1); PG8_BAR;
            }
        }
        if constexpr (ALIGN_EPI) { if (wr == 0) PG8_BAR; }
        if constexpr (!Epi::AFTER_DRAIN) { E(acc, cur, wr, wc, fr, fq); S.done(cur); }
        if (!has_next) break;
#pragma unroll
        for (int a = 0; a < 2; ++a)
#pragma unroll
            for (int b = 0; b < 2; ++b)
#pragma unroll
                for (int m = 0; m < 4; ++m)
#pragma unroll
                    for (int n = 0; n < 2; ++n) acc[a][b][m][n] = (f32x4){0.f, 0.f, 0.f, 0.f};
        cur = nxt; cA = nA; cB = nB; ++ui;
        if constexpr (ALIGN_EPI) { if (wr == 1) PG8_BAR; }
    }
    PG8_WAIT_V(0);
    if constexpr (!ALIGN_EPI) { if (wr == 0) PG8_BAR; }
    PG8_BAR;
    if constexpr (Epi::AFTER_DRAIN) { E.fused(acc, cur, wr, wc, fr, fq, lds, wid, lane); S.done(cur); }
#undef PG8_SA
#undef PG8_SB
#undef PG8_STAGE
#undef PG8_LDA
#undef PG8_LDB
#undef PG8_MMA
#undef PG8_WAIT_V
#undef PG8_WAIT_L
#undef PG8_BAR
#undef PG8_SCHED
}
}
constexpr int S_ = 16384, D_ = 1024;
constexpr int EVEN_IN = 3072, LORA_N = 512, FF0 = 2816, ODD_IN = 3600, ODD_PAD = 3840, FFE = 3584, NEXP = 8;
constexpr int MOE_ROWS = 32768 + 8 * 256;
constexpr int MOE_BATCH_TILES = 64;
constexpr size_t MiB = 1u << 20;
constexpr size_t WS_CTL = 0, CTL_ZERO_BYTES = 1 * MiB;
constexpr size_t WS_WIN0 = 2 * MiB, WS_WL = 8 * MiB, WS_WOUT0 = 9 * MiB, WS_WGU0 = 11 * MiB, WS_WD0 = 22 * MiB, WS_WIN1 = 28 * MiB, WS_WOUT1 = 36 * MiB;
constexpr size_t WS_TOK = 38 * MiB;
constexpr size_t WS_TILE = 39 * MiB;
constexpr size_t WS_A = 40 * MiB;
constexpr size_t WS_H = WS_A, WS_HX = WS_A + 32 * MiB;
constexpr size_t WS_LW0 = WS_A, WS_LW1 = WS_A + 32 * MiB, WS_R = WS_A + 64 * MiB, WS_V = WS_A + 80 * MiB, WS_KK = WS_A + 96 * MiB, WS_KD0 = WS_A + 112 * MiB, WS_KD1 = WS_A + 128 * MiB, WS_B0 = WS_A + 144 * MiB;
constexpr size_t WS_H2 = WS_A, WS_H3 = WS_A + 32 * MiB;
constexpr size_t WS_WMGU = WS_A, WS_WMD = WS_A + 112 * MiB;
constexpr size_t WS_B = 208 * MiB;
constexpr size_t WS_PROJ0 = WS_B, WS_LORA = WS_B + 96 * MiB, WS_QN = WS_B + 112 * MiB, WS_KN = WS_B + 128 * MiB, WS_Y = WS_B + 144 * MiB;
constexpr size_t WS_B1 = WS_B + 176 * MiB, WS_GATE = WS_B + 192 * MiB, WS_BONUS = WS_B + 208 * MiB, WS_Y0 = WS_LORA, WS_Y1 = WS_B + 224 * MiB;
constexpr size_t WS_ACT0 = WS_B, WS_PROJ1 = WS_B + 88 * MiB;
constexpr size_t WS_QD = WS_B, WS_KD = WS_B + 16 * MiB, WS_VD = WS_B + 32 * MiB, WS_YCAT1 = WS_B + 48 * MiB, WS_GB = WS_B + 80 * MiB  ;
constexpr size_t WS_O0 = WS_B + 208 * MiB, WS_O1 = WS_B + 224 * MiB;
constexpr size_t WS_AMOE = WS_B, WS_MACT = WS_B + 88 * MiB;
constexpr size_t WS_END_OLD = 448 * MiB, WS_RSS1 = 460 * MiB, WS_RSS2 = 461 * MiB, WS_END = 462 * MiB;
static_assert(WS_MACT + (size_t)MOE_BATCH_TILES * 256 * FFE * 2 <= WS_END, "moe act");
static_assert(WS_AMOE + (size_t)MOE_ROWS * D_ * 2 <= WS_MACT, "amoe");
static_assert(WS_PROJ1 + (size_t)S_ * ODD_PAD * 2 <= WS_O0, "proj1");
constexpr int CW_CNT = 64;
constexpr int CW_RSS1 = 32768, CW_RSS2 = 32768 + 16384;
constexpr int CW_BAR = 4096;
constexpr int LDS_BYTES = 151552, LDS_ZERO_OFF = LDS_BYTES - 512, MISC_OFF = LDS_ZERO_OFF + 64;

#define GAS __attribute__((address_space(1)))
#define LAS __attribute__((address_space(3)))
#define DI __device__ __forceinline__
typedef unsigned short bf16;
typedef unsigned v4u __attribute__((ext_vector_type(4)));
typedef float f32x4 __attribute__((ext_vector_type(4)));
typedef GAS unsigned gu32;
#define LDS_WAIT() asm volatile("s_waitcnt lgkmcnt(0)" ::: "memory")
DI unsigned f2bf(float f) { unsigned u = __builtin_bit_cast(unsigned, f); return (u + 0x7fffu + ((u >> 16) & 1u)) >> 16; }
typedef float f32x2_t __attribute__((ext_vector_type(2))); typedef __bf16 bf16x2_t __attribute__((ext_vector_type(2)));
DI unsigned pk2(float lo, float hi) { const f32x2_t v = {lo, hi}; const bf16x2_t b = __builtin_convertvector(v, bf16x2_t); return __builtin_bit_cast(unsigned, b); }
DI float bflo(unsigned w) { return __uint_as_float(w << 16); }
DI float bfhi(unsigned w) { return __uint_as_float(w & 0xffff0000u); }
DI float bf2f(bf16 b) { return __uint_as_float(((unsigned)b) << 16); }
DI void ld8(const bf16* p, float (&v)[8]) { const v4u w = *(const v4u*)p; v[0] = bflo(w.x); v[1] = bfhi(w.x); v[2] = bflo(w.y); v[3] = bfhi(w.y); v[4] = bflo(w.z); v[5] = bfhi(w.z); v[6] = bflo(w.w); v[7] = bfhi(w.w); }
DI void st8(bf16* p, const float (&v)[8]) { v4u w; w.x = pk2(v[0], v[1]); w.y = pk2(v[2], v[3]); w.z = pk2(v[4], v[5]); w.w = pk2(v[6], v[7]); *(v4u*)p = w; }
DI void ld8f(const float* p, float (&v)[8]) { const f32x4 a = *(const f32x4*)p, b = *(const f32x4*)(p + 4); v[0] = a.x; v[1] = a.y; v[2] = a.z; v[3] = a.w; v[4] = b.x; v[5] = b.y; v[6] = b.z; v[7] = b.w; }
DI void st8f(float* p, const float (&v)[8]) { *(f32x4*)p = (f32x4){v[0], v[1], v[2], v[3]}; *(f32x4*)(p + 4) = (f32x4){v[4], v[5], v[6], v[7]}; }
DI float wave_sum(float v) {
#pragma unroll
    for (int o = 1; o < 64; o <<= 1) v += __shfl_xor(v, o);
    return v;
}
template <int W> DI float grp_sum(float v) {
#pragma unroll
    for (int o = 1; o < W; o <<= 1) v += __shfl_xor(v, o);
    return v;
}
DI float sigmoidf_(float x) { return 1.0f / (1.0f + __expf(-x)); }
DI float softplusf_(float x) { return x > 20.f ? x : log1pf(__expf(x)); }
DI float siluf_(float x) { return x / (1.0f + __expf(-x)); }

struct Args { const float* in[39]; float* out; unsigned char* ws; };

DI void transpose_item(const float* W, int K, int N, bf16* WT, int rowbase, LAS float* scr, int k0, int n0, int lane, const float* kscale = nullptr) {
    const int nn = n0 + (lane & 31); const bool ok = nn < N;
#pragma unroll
    for (int i = 0; i < 32; ++i) { const int kk = 2 * i + (lane >> 5); scr[kk * 33 + (lane & 31)] = ok ? W[(size_t)(k0 + kk) * N + nn] * (kscale ? kscale[k0 + kk] : 1.0f) : 0.f; }
    LDS_WAIT(); asm volatile("" ::: "memory");
    const int c = lane & 7;
#pragma unroll
    for (int j = 0; j < 4; ++j) { const int n = (lane >> 3) + 8 * j; const LAS float* s = scr + (8 * c) * 33 + n;
        v4u o; o.x = pk2(s[0 * 33], s[1 * 33]); o.y = pk2(s[2 * 33], s[3 * 33]); o.z = pk2(s[4 * 33], s[5 * 33]); o.w = pk2(s[6 * 33], s[7 * 33]);
        *(v4u*)(WT + (size_t)(rowbase + n) * K + k0 + 8 * c) = o; }
    LDS_WAIT(); asm volatile("" ::: "memory");
}
DI bool transpose_job(int& r, const float* W, int K, int N, int Npad, bf16* WT, int row_off, int grp, int sel, LAS float* scr, int lane, const float* kscale = nullptr) {
    const int nblk = Npad / 32, cnt = (K / 64) * nblk;
    if (r >= cnt) { r -= cnt; return false; }
    const int kb = r / nblk, nb = r % nblk, n0 = 32 * nb;
    const int rowbase = row_off + (grp ? (n0 / grp) * (2 * grp) + sel * grp + (n0 % grp) : n0);
    transpose_item(W, K, N, WT, rowbase, scr, 64 * kb, n0, lane, kscale);
    return true;
}
#define XB_TMO      128
#define XB_XCNT(j)  (256  + 64 * (j))
#define XB_XSUB(j)  (1280 + 64 * (j))
#define XB_XGEN(j)  (2304 + 64 * (j))
#define XB_TOP      3328
#define XB_TOPGEN   3392
#define XCD_BAR_WORDS 3456
#define XB_SPIN_CAP (1u << 22)

__device__ __forceinline__ unsigned xb_ld(unsigned* p)              { return __hip_atomic_load(p, __ATOMIC_RELAXED, __HIP_MEMORY_SCOPE_AGENT); }
__device__ __forceinline__ unsigned xb_add(unsigned* p, unsigned v) { return __hip_atomic_fetch_add(p, v, __ATOMIC_RELAXED, __HIP_MEMORY_SCOPE_AGENT); }
__device__ __forceinline__ unsigned xb_xcc_id() { return (unsigned)__builtin_amdgcn_s_getreg((3 << 11) | 20) & 0xFu; }
#define XB_SPIN(cond, bar) do { unsigned _sp = 0; while (cond) { __builtin_amdgcn_s_sleep(1); \
    if ((++_sp & 255u) == 0u) { if (xb_ld(&(bar)[XB_TMO])) break; if (_sp > XB_SPIN_CAP) { atomicAdd(&(bar)[XB_TMO], 1u); break; } } } } while (0)

struct XcdBarrier {
    unsigned* bar; unsigned x;
    volatile LAS unsigned* st;
};

__device__ __forceinline__ XcdBarrier xcd_barrier_post(unsigned* bar, volatile LAS unsigned* st) {
    XcdBarrier b; b.bar = bar; b.x = xb_xcc_id(); b.st = st;
    if (threadIdx.x == 0) (void)xb_add(&bar[XB_XCNT(b.x)], 1u);
    return b;
}
__device__ __forceinline__ void xcd_barrier_complete(unsigned* bar, unsigned x, unsigned& nloc, unsigned& nx) {
    const unsigned G = gridDim.x * gridDim.y * gridDim.z;
    unsigned sum, cnt, mine, sp = 0u;
    for (;;) {
        sum = 0u; cnt = 0u; mine = 0u;
#pragma unroll
        for (unsigned j = 0; j < 16; ++j) { const unsigned c = xb_ld(&bar[XB_XCNT(j)]); sum += c; cnt += (c > 0u) ? 1u : 0u; mine = (j == x) ? c : mine; }
        if (sum == G) break;
        __builtin_amdgcn_s_sleep(1);
        if ((++sp & 255u) == 0u) { if (xb_ld(&bar[XB_TMO])) break; if (sp > XB_SPIN_CAP) { atomicAdd(&bar[XB_TMO], 1u); break; } }
    }
    nloc = mine > 0u ? mine : 1u; nx = cnt > 0u ? cnt : 1u;
}

__device__ __forceinline__ void xcd_barrier(const XcdBarrier& b, const bool wave0) {
    asm volatile("s_waitcnt vmcnt(0)" ::: "memory");
    __syncthreads();
    if (wave0 && __builtin_amdgcn_mbcnt_hi(~0u, __builtin_amdgcn_mbcnt_lo(~0u, 0u)) == 0u) {
        unsigned* bar = b.bar; asm volatile("" : "+s"(bar)); const unsigned bx_ = xb_xcc_id();
        __builtin_amdgcn_s_waitcnt(0);
        unsigned nloc = b.st[0], nx = b.st[1];
        if (nloc == 0u) { xcd_barrier_complete(bar, bx_, nloc, nx); b.st[0] = nloc; b.st[1] = nx; }
        const unsigned old = xb_add(&bar[XB_XSUB(bx_)], 1u);
        const unsigned gen = old / nloc;
        if (old + 1u == (gen + 1u) * nloc) {
            __builtin_amdgcn_fence(__ATOMIC_RELEASE, "agent");
            asm volatile("s_waitcnt vmcnt(0)" ::: "memory");
            const unsigned og = xb_add(&bar[XB_TOP], 1u);
            const unsigned tg = og / nx;
            if (og + 1u == (tg + 1u) * nx) xb_add(&bar[XB_TOPGEN], 1u);
            else XB_SPIN(xb_ld(&bar[XB_TOPGEN]) == tg, bar);
            __builtin_amdgcn_fence(__ATOMIC_ACQUIRE, "agent");
            xb_add(&bar[XB_XGEN(bx_)], 1u);
            asm volatile("s_waitcnt vmcnt(0)" ::: "memory");
        } else {
            XB_SPIN(xb_ld(&bar[XB_XGEN(bx_)]) == gen, bar);
            __builtin_amdgcn_fence(__ATOMIC_ACQUIRE, "agent");
            asm volatile("s_waitcnt vmcnt(0)" ::: "memory");
        }
    }
    __syncthreads();
}
DI float row_rstd(const f32x4 (&v)[4]) {
    float s = 0.f;
#pragma unroll
    for (int j = 0; j < 4; ++j) s += (v[j].x * v[j].x + v[j].y * v[j].y) + (v[j].z * v[j].z + v[j].w * v[j].w);
    return 1.0f / sqrtf(wave_sum(s) * (1.0f / D_) + 1e-6f);
}
DI void load_row(const float* x, int t, int lane, f32x4 (&v)[4]) {
    if (t >= 0 && t < S_) { const f32x4* p = (const f32x4*)(x + (size_t)t * D_) + lane;
#pragma unroll
        for (int j = 0; j < 4; ++j) v[j] = p[64 * j];
    } else {
#pragma unroll
        for (int j = 0; j < 4; ++j) v[j] = (f32x4){0.f, 0.f, 0.f, 0.f};
    }
}
DI void store_row_bf16(bf16* o, int lane, const f32x4 (&v)[4]) {
    unsigned long long* o8 = (unsigned long long*)o + lane;
#pragma unroll
    for (int j = 0; j < 4; ++j) o8[64 * j] = (unsigned long long)pk2(v[j].x, v[j].y) | ((unsigned long long)pk2(v[j].z, v[j].w) << 32);
}
DI void norm_rows(const float* x, const float* w, const float* mu  , bf16* H, bf16* HX, int gw, int NGW, int lane) {
    f32x4 wv[4];
#pragma unroll
    for (int j = 0; j < 4; ++j) wv[j] = ((const f32x4*)w)[lane + 64 * j];
    for (int t = gw; t < S_; t += NGW) {
        f32x4 v[4]; load_row(x, t, lane, v); const float rs = row_rstd(v);
#pragma unroll
        for (int j = 0; j < 4; ++j) v[j] = v[j] * rs * wv[j];
        store_row_bf16(H + (size_t)t * D_, lane, v);
        if (mu) {
            f32x4 p[4], n[4]; load_row(x, t - 1, lane, p); load_row(x, t + 1, lane, n);
            const float rp = row_rstd(p), rn = row_rstd(n);
#pragma unroll
            for (int j = 0; j < 4; ++j) { const f32x4 m0 = ((const f32x4*)mu)[lane + 64 * j], m1 = ((const f32x4*)(mu + D_))[lane + 64 * j];
                const f32x4 hp = p[j] * rp * wv[j], hn = n[j] * rn * wv[j]; p[j] = v[j] + m0 * (hp - v[j]) + m1 * (hn - v[j]); }
            store_row_bf16(HX + (size_t)t * D_, lane, p);
        }
    }
}

DI void prep0_token(const Args& a, unsigned char* ws, LAS float* scr, int t, int lane) {
    const bf16* P = (const bf16*)(ws + WS_PROJ0) + (size_t)t * EVEN_IN;
    const int c0 = 8 * lane;
    {
        float q[8], k[8]; ld8(P + c0, q); ld8(P + 512 + c0, k);
        float sq = 0.f, sk = 0.f;
#pragma unroll
        for (int i = 0; i < 8; ++i) { sq += q[i] * q[i]; sk += k[i] * k[i]; }
        sq = grp_sum<8>(sq); sk = grp_sum<8>(sk);
        const float rq = 1.0f / sqrtf(sq * (1.0f / 64.f) + 1e-6f), rk = 1.0f / sqrtf(sk * (1.0f / 64.f) + 1e-6f);
        const int d0 = 8 * (lane & 7);
        float qw[8], kw[8]; ld8f(a.in[4] + d0, qw); ld8f(a.in[5] + d0, kw);
#pragma unroll
        for (int i = 0; i < 8; ++i) { q[i] = q[i] * rq * qw[i]; k[i] = k[i] * rk * kw[i]; }
        const float pos = (float)((const int*)a.in[1])[t];
        float qo[8], ko[8];
#pragma unroll
        for (int i = 0; i < 8; ++i) { qo[i] = __shfl_xor(q[i], 1); ko[i] = __shfl_xor(k[i], 1); }
        const int sub = lane & 7;
        if (sub < 2) {
#pragma unroll
            for (int i = 0; i < 8; ++i) {
                constexpr float kInv[8] = {1.0f, 0.1939227432012558f, 0.03760603070259094f, 0.007292664609849453f, 0.0014142135623842478f, 0.00027424818836152554f, 5.3182957344688475e-05f, 1.0313385246263351e-05f};
                const float ang = pos * kInv[i]; const float kq = rintf(ang * 0.15915494309189535f);
                float rr = fmaf(-kq, 6.28318548202514648f, ang); rr = fmaf(-kq, -1.74845553146951715e-07f, rr);
                const float sn = __sinf(rr), cs = __cosf(rr);
                if (sub == 0) { q[i] = q[i] * cs - qo[i] * sn; k[i] = k[i] * cs - ko[i] * sn; }
                else          { q[i] = q[i] * cs + qo[i] * sn; k[i] = k[i] * cs + ko[i] * sn; }
            }
        }
#pragma unroll
        for (int i = 0; i < 8; ++i) q[i] *= 0.125f;
        st8((bf16*)(ws + WS_QN) + (size_t)t * 512 + c0, q); st8((bf16*)(ws + WS_KN) + (size_t)t * 512 + c0, k);
    }
}

DI void rwkv_scan_naive(unsigned char* ws, int w  , int lane) {
    const int z = w >> 9, h = (w >> 6) & 7, vr = w & 63;
    const float* LW = (const float*)(ws + (z ? WS_LW1 : WS_LW0));
    const bf16* KD = (const bf16*)(ws + (z ? WS_KD1 : WS_KD0)); const bf16* BB = (const bf16*)(ws + (z ? WS_B1 : WS_B0));
    const bf16* KK = (const bf16*)(ws + WS_KK); const bf16* R = (const bf16*)(ws + WS_R); const bf16* V = (const bf16*)(ws + WS_V);
    bf16* Y = (bf16*)(ws + (z ? WS_Y1 : WS_Y0));
    const int cc = h * 64 + lane, cv = h * 64 + vr;
    float S = 0.f;
    int t = z ? S_ - 1 : 0; const int dt = z ? -1 : 1;
    size_t o = (size_t)t * 512;
    float lw = LW[o + cc], kd = bf2f(KD[o + cc]), bb = bf2f(BB[o + cc]), kk = bf2f(KK[o + cc]), rr = bf2f(R[o + cc]), vv = bf2f(V[o + cv]);
    for (int s = 0; s < S_; ++s) {
        const int tn = t + dt; const bool more = s + 1 < S_;
        const size_t on = (size_t)(more ? tn : t) * 512;
        const float lw_n = LW[on + cc], kd_n = bf2f(KD[on + cc]), bb_n = bf2f(BB[on + cc]), kk_n = bf2f(KK[on + cc]), rr_n = bf2f(R[on + cc]), vv_n = bf2f(V[on + cv]);
        const float sa = wave_sum(S * (-kk));
        S = S * __expf(lw) + sa * bb + vv * kd;
        const float y = wave_sum(S * rr);
        if (lane == 0) Y[(size_t)t * 512 + cv] = (bf16)f2bf(y);
        lw = lw_n; kd = kd_n; bb = bb_n; kk = kk_n; rr = rr_n; vv = vv_n; t = tn;
    }
}

DI void attn_token_naive(unsigned char* ws, int t, int lane) {
    const bf16* QN = (const bf16*)(ws + WS_QN); const bf16* KN = (const bf16*)(ws + WS_KN); const bf16* P = (const bf16*)(ws + WS_PROJ0);
    const int c0 = 8 * lane;
    float q[8]; ld8(QN + (size_t)t * 512 + c0, q);
    float m = -1e30f, l = 0.f, acc[8];
#pragma unroll
    for (int i = 0; i < 8; ++i) acc[i] = 0.f;
    for (int br = 0; br < 3; ++br) {
        const int d = br == 0 ? 1 : (br == 1 ? 4 : 16);
        for (int mm = -64; mm <= 64; ++mm) {
            const int j = t + d * mm; if (j < 0 || j >= S_) continue;
            float k[8], v[8]; ld8(KN + (size_t)j * 512 + c0, k); ld8(P + (size_t)j * EVEN_IN + 1024 + c0, v);
            float s = 0.f;
#pragma unroll
            for (int i = 0; i < 8; ++i) s += q[i] * k[i];
            s = grp_sum<8>(s);
            const float mn = fmaxf(m, s), sc = __expf(m - mn), p = __expf(s - mn);
            l = l * sc + p;
#pragma unroll
            for (int i = 0; i < 8; ++i) acc[i] = acc[i] * sc + p * v[i];
            m = mn;
        }
    }
    const float il = 1.0f / l;
#pragma unroll
    for (int i = 0; i < 8; ++i) acc[i] *= il;
    st8((bf16*)(ws + WS_Y) + (size_t)t * D_ + c0, acc);
}

DI void rwkv_post_token(const Args& a, unsigned char* ws, int t, int lane) {
    const int c0 = 8 * lane; const size_t o = (size_t)t * 512 + c0;
    float y0[8], y1[8], g[8], bn[8], lw[8], lb[8];
    ld8((const bf16*)(ws + WS_Y0) + o, y0); ld8((const bf16*)(ws + WS_Y1) + o, y1); ld8((const bf16*)(ws + WS_GATE) + o, g); ld8((const bf16*)(ws + WS_BONUS) + o, bn);
    ld8f(a.in[19] + c0, lw); ld8f(a.in[20] + c0, lb);
    float s = 0.f;
#pragma unroll
    for (int i = 0; i < 8; ++i) { y0[i] += y1[i]; s += y0[i]; }
    const float mu = grp_sum<8>(s) * (1.0f / 64.f);
    float q = 0.f;
#pragma unroll
    for (int i = 0; i < 8; ++i) { y0[i] -= mu; q += y0[i] * y0[i]; }
    const float rs = 1.0f / sqrtf(grp_sum<8>(q) * (1.0f / 64.f) + 64e-5f);
#pragma unroll
    for (int i = 0; i < 8; ++i) y0[i] = (y0[i] * rs * lw[i] + lb[i] + bn[i]) * g[i];
    st8((bf16*)(ws + WS_Y) + (size_t)t * D_ + 512 + c0, y0);
}
typedef short s16x8 __attribute__((ext_vector_type(8)));
typedef short s16x4 __attribute__((ext_vector_type(4)));
typedef LAS unsigned char* ldsp;
DI f32x4 mfma16(s16x8 a, s16x8 b, f32x4 c) { return __builtin_amdgcn_mfma_f32_16x16x32_bf16(a, b, c, 0, 0, 0); }
DI s16x8 frag_row(ldsp img, int row0, int col0, int lane) { return *(LAS const s16x8*)(img + (row0 + (lane & 15)) * 128 + (col0 + 8 * (lane >> 4)) * 2); }
DI s16x4 tr16(ldsp p) { return __builtin_bit_cast(s16x4, __builtin_amdgcn_ds_read_tr16_b64_v4i16((LAS s16x4*)p)); }
DI s16x8 frag_tr(ldsp img, int row0, int col0, int lane) {
    ldsp a0 = img + (row0 + 8 * (lane >> 4) + ((lane & 15) >> 2)) * 128 + col0 * 2 + 8 * (lane & 3);
    const s16x4 lo = tr16(a0), hi = tr16(a0 + 4 * 128);
    return __builtin_shufflevector(lo, hi, 0, 1, 2, 3, 4, 5, 6, 7);
}
DI void ctile_to_img(ldsp img, int mt, int nt, const f32x4& c, int lane) {
    LAS bf16* p = (LAS bf16*)(img + (16 * mt + 4 * (lane >> 4)) * 128 + (16 * nt + (lane & 15)) * 2);
#pragma unroll
    for (int e = 0; e < 4; ++e) p[e * 64] = (bf16)f2bf(c[e]);
}
#define CFENCE() asm volatile("" ::: "memory")
#define MM_LOOPH(ACC, AEXPR, BEXPR) _Pragma("unroll") for (int mt = 2 * mh; mt < 2 * mh + 2; ++mt) _Pragma("unroll") for (int nt = 0; nt < 4; ++nt) _Pragma("unroll") for (int ks = 0; ks < 2; ++ks) ACC[mt][nt] = mfma16((AEXPR), (BEXPR), ACC[mt][nt])
#define MM_LOOP(ACC, AEXPR, BEXPR) _Pragma("unroll") for (int mt = 0; mt < 4; ++mt) _Pragma("unroll") for (int nt = 0; nt < 4; ++nt) _Pragma("unroll") for (int ks = 0; ks < 2; ++ks) ACC[mt][nt] = mfma16((AEXPR), (BEXPR), ACC[mt][nt])

DI int tok_of(int z, int cn, int i) { return z ? cn * 64 + 63 - i : cn * 64 + i; }

template <bool DRY = false, int STOP = 99> DI void rwkv_pass1_item(unsigned char* ws, ldsp lds, int item, int lane) {
    asm volatile("" : "+v"(lane));
    const int z = item >> 11, h = (item >> 8) & 7, c = item & 255;
    const int cn = z ? 255 - c : c;
    float* LW = (float*)(ws + (z ? WS_LW1 : WS_LW0));
    bf16* KD = (bf16*)(ws + (z ? WS_KD1 : WS_KD0)); bf16* BB = (bf16*)(ws + (z ? WS_B1 : WS_B0));
    const bf16* KK = (const bf16*)(ws + WS_KK); const bf16* R = (const bf16*)(ws + WS_R); const bf16* V = (const bf16*)(ws + WS_V);
    float* LWo = DRY ? (float*)(ws + WS_Y) : LW; bf16* KDo = DRY ? (bf16*)(ws + WS_Y) : KD; bf16* BBo = DRY ? (bf16*)(ws + WS_Y) : BB;
    ldsp S0 = lds, S1 = lds + 8192, S2 = lds + 16384, S3 = lds + 24576, S4 = lds + 32768, S5 = lds + 40960, S6 = lds + 49152, S7 = lds + 57344;
    ldsp IA = S0, IB = S1, IK = S2, IR = S3;
    const int ch = h * 64 + lane;
    float G = 0.f;
#pragma unroll 16
    for (int i = 0; i < 64; ++i) {
        const size_t o = (size_t)tok_of(z, cn, i) * 512 + ch;
        const float lw = LW[o], a = -bf2f(KK[o]), b = bf2f(BB[o]), kd = bf2f(KD[o]), r = bf2f(R[o]);
        const float eprev = __expf(G); G += lw; const float ecur = __expf(G), einv = __expf(-G);
        ((LAS bf16*)IA)[i * 64 + lane] = (bf16)f2bf(a * eprev); ((LAS bf16*)IB)[i * 64 + lane] = (bf16)f2bf(b * einv);
        ((LAS bf16*)IK)[i * 64 + lane] = (bf16)f2bf(kd * einv); ((LAS bf16*)IR)[i * 64 + lane] = (bf16)f2bf(r * ecur);
    }
    const float GT = __expf(G);
    LDS_WAIT(); CFENCE();
    if (STOP == 1) { if (GT == 123.f) LWo[0] = GT; return; }
    int lane2 = lane; asm volatile("" : "+v"(lane2));
    const int n_ = lane2 & 15, q_ = lane2 >> 4;
    {
#pragma unroll
        for (int mh = 0; mh < 2; ++mh) {
        f32x4 acc[4][4];
#pragma unroll
        for (int mt = 2 * mh; mt < 2 * mh + 2; ++mt)
#pragma unroll
            for (int nt = 0; nt < 4; ++nt) acc[mt][nt] = (f32x4){0.f, 0.f, 0.f, 0.f};
        MM_LOOPH(acc, frag_row(IA, 16 * mt, 32 * ks, lane), frag_row(IB, 16 * nt, 32 * ks, lane));
#pragma unroll
        for (int mt = 2 * mh; mt < 2 * mh + 2; ++mt)
#pragma unroll
            for (int nt = 0; nt < 4; ++nt)
#pragma unroll
                for (int e = 0; e < 4; ++e) { const int i = 16 * mt + 4 * q_ + e, j = 16 * nt + n_; ((LAS float*)S4)[i * 64 + j] = (j < i) ? acc[mt][nt][e] : 0.f; }
        }
    }
    LDS_WAIT(); CFENCE();
    if (STOP == 4) return;
    {
        float t[64];
        int lane_o = lane; asm volatile("" : "+v"(lane_o));
        f32x4 ar[2][16];
#pragma unroll
        for (int i = 0; i < 64; ++i) {
            if (i + 1 < 64) {
#pragma unroll
                for (int jg = 0; jg < (i + 1 + 3) / 4; ++jg) ar[(i + 1) & 1][jg] = *(LAS const f32x4*)(S4 + ((i + 1) * 64 + 4 * jg) * 4);
            }
            __builtin_amdgcn_sched_barrier(0);
            float acc0 = (lane_o == i) ? 1.f : 0.f, acc1 = 0.f, acc2 = 0.f, acc3 = 0.f;
#pragma unroll
            for (int jg = 0; jg < (i + 3) / 4; ++jg) { const f32x4 a4 = ar[i & 1][jg];
                if (4 * jg + 0 < i) acc0 += a4[0] * t[4 * jg + 0];
                if (4 * jg + 1 < i) acc1 += a4[1] * t[4 * jg + 1];
                if (4 * jg + 2 < i) acc2 += a4[2] * t[4 * jg + 2];
                if (4 * jg + 3 < i) acc3 += a4[3] * t[4 * jg + 3]; }
            t[i] = (acc0 + acc1) + (acc2 + acc3);
            __builtin_amdgcn_sched_barrier(0);
        }
        LDS_WAIT(); CFENCE();
#pragma unroll
        for (int i = 0; i < 64; ++i) ((LAS bf16*)S4)[i * 64 + lane] = (bf16)f2bf(t[i]);
    }
    LDS_WAIT(); CFENCE();
    if (STOP == 2) return;
    ldsp IT = S4, IW = S5, IAK = S6;
    {
#pragma unroll
        for (int mh = 0; mh < 2; ++mh) {
        f32x4 acc[4][4];
#pragma unroll
        for (int mt = 2 * mh; mt < 2 * mh + 2; ++mt)
#pragma unroll
            for (int nt = 0; nt < 4; ++nt) acc[mt][nt] = (f32x4){0.f, 0.f, 0.f, 0.f};
        MM_LOOPH(acc, frag_row(IA, 16 * mt, 32 * ks, lane), frag_row(IK, 16 * nt, 32 * ks, lane));
#pragma unroll
        for (int mt = 2 * mh; mt < 2 * mh + 2; ++mt)
#pragma unroll
            for (int nt = 0; nt < 4; ++nt) {
#pragma unroll
                for (int e = 0; e < 4; ++e) { const int i = 16 * mt + 4 * q_ + e, j = 16 * nt + n_; if (!(j < i)) acc[mt][nt][e] = 0.f; }
                ctile_to_img(IAK, mt, nt, acc[mt][nt], lane); }
        }
    }
    if (STOP == 5) return;
    {
#pragma unroll
        for (int mh = 0; mh < 2; ++mh) {
        f32x4 acc[4][4];
#pragma unroll
        for (int mt = 2 * mh; mt < 2 * mh + 2; ++mt)
#pragma unroll
            for (int nt = 0; nt < 4; ++nt) acc[mt][nt] = (f32x4){0.f, 0.f, 0.f, 0.f};
        MM_LOOPH(acc, frag_row(IT, 16 * mt, 32 * ks, lane), frag_tr(IA, 32 * ks, 16 * nt, lane));
#pragma unroll
        for (int mt = 2 * mh; mt < 2 * mh + 2; ++mt)
#pragma unroll
            for (int nt = 0; nt < 4; ++nt) ctile_to_img(IW, mt, nt, acc[mt][nt], lane);
        }
    }
    LDS_WAIT(); CFENCE();
    if (STOP == 6) return;
    ldsp IV = S0;
    {
        v4u vr[8];
#pragma unroll
        for (int it = 0; it < 8; ++it) vr[it] = *(const v4u*)(V + (size_t)tok_of(z, cn, (lane >> 3) + 8 * it) * 512 + h * 64 + (lane & 7) * 8);
#pragma unroll
        for (int it = 0; it < 8; ++it) *(LAS v4u*)(IV + ((lane >> 3) + 8 * it) * 128 + (lane & 7) * 16) = vr[it];
    }
    LDS_WAIT(); CFENCE();
    ldsp IAV = S7;
    {
#pragma unroll
        for (int mh = 0; mh < 2; ++mh) {
        f32x4 acc[4][4];
#pragma unroll
        for (int mt = 2 * mh; mt < 2 * mh + 2; ++mt)
#pragma unroll
            for (int nt = 0; nt < 4; ++nt) acc[mt][nt] = (f32x4){0.f, 0.f, 0.f, 0.f};
        MM_LOOPH(acc, frag_row(IAK, 16 * mt, 32 * ks, lane), frag_tr(IV, 32 * ks, 16 * nt, lane));
#pragma unroll
        for (int mt = 2 * mh; mt < 2 * mh + 2; ++mt)
#pragma unroll
            for (int nt = 0; nt < 4; ++nt) ctile_to_img(IAV, mt, nt, acc[mt][nt], lane);
        }
    }
    LDS_WAIT(); CFENCE();
    if (STOP == 7) return;
    ldsp IU = S6;
    {
#pragma unroll
        for (int mh = 0; mh < 2; ++mh) {
        f32x4 acc[4][4];
#pragma unroll
        for (int mt = 2 * mh; mt < 2 * mh + 2; ++mt)
#pragma unroll
            for (int nt = 0; nt < 4; ++nt) acc[mt][nt] = (f32x4){0.f, 0.f, 0.f, 0.f};
        MM_LOOPH(acc, frag_row(IT, 16 * mt, 32 * ks, lane), frag_tr(IAV, 32 * ks, 16 * nt, lane));
        LDS_WAIT(); CFENCE();
#pragma unroll
        for (int mt = 2 * mh; mt < 2 * mh + 2; ++mt)
#pragma unroll
            for (int nt = 0; nt < 4; ++nt) ctile_to_img(IU, mt, nt, acc[mt][nt], lane);
        }
    }
    LDS_WAIT(); CFENCE();
    if (STOP == 3) return;
    ldsp IRB = S4, IRK = S7;
    {
#pragma unroll
        for (int mh = 0; mh < 2; ++mh) {
        f32x4 acc[4][4];
#pragma unroll
        for (int mt = 2 * mh; mt < 2 * mh + 2; ++mt)
#pragma unroll
            for (int nt = 0; nt < 4; ++nt) acc[mt][nt] = (f32x4){0.f, 0.f, 0.f, 0.f};
        MM_LOOPH(acc, frag_row(IR, 16 * mt, 32 * ks, lane), frag_row(IB, 16 * nt, 32 * ks, lane));
#pragma unroll
        for (int mt = 2 * mh; mt < 2 * mh + 2; ++mt)
#pragma unroll
            for (int nt = 0; nt < 4; ++nt) {
#pragma unroll
                for (int e = 0; e < 4; ++e) { const int i = 16 * mt + 4 * q_ + e, j = 16 * nt + n_; if (!(j <= i)) acc[mt][nt][e] = 0.f; }
                ctile_to_img(IRB, mt, nt, acc[mt][nt], lane); }
        }
    }
    {
#pragma unroll
        for (int mh = 0; mh < 2; ++mh) {
        f32x4 acc[4][4];
#pragma unroll
        for (int mt = 2 * mh; mt < 2 * mh + 2; ++mt)
#pragma unroll
            for (int nt = 0; nt < 4; ++nt) acc[mt][nt] = (f32x4){0.f, 0.f, 0.f, 0.f};
        MM_LOOPH(acc, frag_row(IR, 16 * mt, 32 * ks, lane), frag_row(IK, 16 * nt, 32 * ks, lane));
#pragma unroll
        for (int mt = 2 * mh; mt < 2 * mh + 2; ++mt)
#pragma unroll
            for (int nt = 0; nt < 4; ++nt) {
#pragma unroll
                for (int e = 0; e < 4; ++e) { const int i = 16 * mt + 4 * q_ + e, j = 16 * nt + n_; if (!(j <= i)) acc[mt][nt][e] = 0.f; }
                ctile_to_img(IRK, mt, nt, acc[mt][nt], lane); }
        }
    }
    LDS_WAIT(); CFENCE();
    int lane3 = lane; asm volatile("" : "+v"(lane3));
    const int n3 = lane3 & 15, q3 = lane3 >> 4;
    const size_t slot0 = (size_t)cn * 64 * 512 + h * 64;
    {
#pragma unroll
        for (int mh = 0; mh < 2; ++mh) {
        f32x4 acc[4][4];
#pragma unroll
        for (int mt = 2 * mh; mt < 2 * mh + 2; ++mt)
#pragma unroll
            for (int nt = 0; nt < 4; ++nt) { const s16x4 r4 = *(LAS const s16x4*)(IR + (16 * nt + n3) * 128 + (16 * mt + 4 * q3) * 2);
#pragma unroll
                for (int e = 0; e < 4; ++e) acc[mt][nt][e] = bf2f((bf16)r4[e]); }
        MM_LOOPH(acc, frag_tr(IW, 32 * ks, 16 * mt, lane), frag_row(IRB, 16 * nt, 32 * ks, lane));
#pragma unroll
        for (int mt = 2 * mh; mt < 2 * mh + 2; ++mt)
#pragma unroll
            for (int nt = 0; nt < 4; ++nt) { bf16* dst = (bf16*)(LWo + slot0 + (size_t)(16 * nt + n3) * 512) + 16 * mt + 4 * q3;
                *(unsigned long long*)dst = (unsigned long long)pk2(acc[mt][nt][0], acc[mt][nt][1]) | ((unsigned long long)pk2(acc[mt][nt][2], acc[mt][nt][3]) << 32); }
        }
    }
    {
#pragma unroll
        for (int mh = 0; mh < 2; ++mh) {
        f32x4 acc[4][4];
#pragma unroll
        for (int mt = 2 * mh; mt < 2 * mh + 2; ++mt)
#pragma unroll
            for (int nt = 0; nt < 4; ++nt) acc[mt][nt] = (f32x4){0.f, 0.f, 0.f, 0.f};
        MM_LOOPH(acc, frag_tr(IU, 32 * ks, 16 * mt, lane), frag_row(IRB, 16 * nt, 32 * ks, lane));
        MM_LOOPH(acc, frag_tr(IV, 32 * ks, 16 * mt, lane), frag_row(IRK, 16 * nt, 32 * ks, lane));
#pragma unroll
        for (int mt = 2 * mh; mt < 2 * mh + 2; ++mt)
#pragma unroll
            for (int nt = 0; nt < 4; ++nt) { bf16* dst = (bf16*)(LWo + slot0 + (size_t)(16 * nt + n3) * 512) + 64 + 16 * mt + 4 * q3;
                *(unsigned long long*)dst = (unsigned long long)pk2(acc[mt][nt][0], acc[mt][nt][1]) | ((unsigned long long)pk2(acc[mt][nt][2], acc[mt][nt][3]) << 32); }
        }
    }
    {
#pragma unroll
        for (int mh = 0; mh < 2; ++mh) {
        f32x4 acc[4][4];
#pragma unroll
        for (int mt = 2 * mh; mt < 2 * mh + 2; ++mt)
#pragma unroll
            for (int nt = 0; nt < 4; ++nt) acc[mt][nt] = (f32x4){0.f, 0.f, 0.f, 0.f};
        MM_LOOPH(acc, frag_tr(IW, 32 * ks, 16 * mt, lane), frag_tr(IB, 32 * ks, 16 * nt, lane));
#pragma unroll
        for (int nt = 0; nt < 4; ++nt) { const float gk = __shfl(GT, 16 * nt + n3);
#pragma unroll
            for (int mt = 2 * mh; mt < 2 * mh + 2; ++mt) { float o[4];
#pragma unroll
                for (int e = 0; e < 4; ++e) o[e] = gk * (acc[mt][nt][e] + ((16 * mt + 4 * q3 + e) == (16 * nt + n3) ? 1.f : 0.f));
                bf16* dst = KDo + slot0 + (size_t)(16 * nt + n3) * 512 + 16 * mt + 4 * q3;
                *(unsigned long long*)dst = (unsigned long long)pk2(o[0], o[1]) | ((unsigned long long)pk2(o[2], o[3]) << 32); } }
        }
    }
    {
#pragma unroll
        for (int mh = 0; mh < 2; ++mh) {
        f32x4 acc[4][4];
#pragma unroll
        for (int mt = 2 * mh; mt < 2 * mh + 2; ++mt)
#pragma unroll
            for (int nt = 0; nt < 4; ++nt) acc[mt][nt] = (f32x4){0.f, 0.f, 0.f, 0.f};
        MM_LOOPH(acc, frag_tr(IB, 32 * ks, 16 * mt, lane), frag_tr(IU, 32 * ks, 16 * nt, lane));
        MM_LOOPH(acc, frag_tr(IK, 32 * ks, 16 * mt, lane), frag_tr(IV, 32 * ks, 16 * nt, lane));
#pragma unroll
        for (int mt = 2 * mh; mt < 2 * mh + 2; ++mt) { float gk[4];
#pragma unroll
            for (int e = 0; e < 4; ++e) gk[e] = __shfl(GT, 16 * mt + 4 * q3 + e);
#pragma unroll
            for (int nt = 0; nt < 4; ++nt) { bf16* dst = BBo + slot0 + (size_t)(16 * nt + n3) * 512 + 16 * mt + 4 * q3;
                *(unsigned long long*)dst = (unsigned long long)pk2(gk[0] * acc[mt][nt][0], gk[1] * acc[mt][nt][1]) | ((unsigned long long)pk2(gk[2] * acc[mt][nt][2], gk[3] * acc[mt][nt][3]) << 32); } }
        }
    }
    LDS_WAIT(); CFENCE();
}
DI unsigned long long pk4(const f32x4& v) { return (unsigned long long)pk2(v[0], v[1]) | ((unsigned long long)pk2(v[2], v[3]) << 32); }
DI f32x4 unpk4(unsigned long long w) { return (f32x4){bflo((unsigned)w), bfhi((unsigned)w), bflo((unsigned)(w >> 32)), bfhi((unsigned)(w >> 32))}; }
DI s16x8 pack_cpair(const f32x4& lo, const f32x4& hi) {
    v4u p; p.x = pk2(lo[0], lo[1]); p.y = pk2(lo[2], lo[3]); p.z = pk2(hi[0], hi[1]); p.w = pk2(hi[2], hi[3]);
    return __builtin_bit_cast(s16x8, p);
}
DI void rwkv_pass2_wave(unsigned char* ws, int w  , int lane) {
    const int z = w >> 5, h = (w >> 2) & 7, vs = w & 3;
    const bf16* Mm = (const bf16*)(ws + (z ? WS_KD1 : WS_KD0)); const bf16* Nn = (const bf16*)(ws + (z ? WS_B1 : WS_B0));
    bf16* Hst = (bf16*)(ws + (z ? WS_V : WS_R));
    const int n_ = lane & 15, q_ = lane >> 4;
    f32x4 H[4];
#pragma unroll
    for (int kt = 0; kt < 4; ++kt) H[kt] = (f32x4){0.f, 0.f, 0.f, 0.f};
    unsigned long long ma[4][2][2], nn[4];
    {
        const int cn = z ? 255 : 0; const size_t slot0 = (size_t)cn * 64 * 512 + h * 64;
#pragma unroll
        for (int kt = 0; kt < 4; ++kt) {
#pragma unroll
            for (int ks = 0; ks < 2; ++ks) { const bf16* row = Mm + slot0 + (size_t)(16 * kt + n_) * 512 + 32 * ks + 4 * q_;
                ma[kt][ks][0] = *(const unsigned long long*)row; ma[kt][ks][1] = *(const unsigned long long*)(row + 16); }
            nn[kt] = *(const unsigned long long*)(Nn + slot0 + (size_t)(16 * vs + n_) * 512 + 16 * kt + 4 * q_); }
    }
    for (int c = 0; c < 256; ++c) {
        { bf16* dst = Hst + ((size_t)(c * 8 + h) * 64 + 16 * vs + n_) * 64 + 4 * q_;
#pragma unroll
          for (int kt = 0; kt < 4; ++kt) *(unsigned long long*)(dst + 16 * kt) = (unsigned long long)pk2(H[kt][0], H[kt][1]) | ((unsigned long long)pk2(H[kt][2], H[kt][3]) << 32); }
        unsigned long long ma2[4][2][2], nn2[4];
        { const int c2 = c + 1 < 256 ? c + 1 : c; const int cn = z ? 255 - c2 : c2; const size_t slot0 = (size_t)cn * 64 * 512 + h * 64;
#pragma unroll
          for (int kt = 0; kt < 4; ++kt) {
#pragma unroll
            for (int ks = 0; ks < 2; ++ks) { const bf16* row = Mm + slot0 + (size_t)(16 * kt + n_) * 512 + 32 * ks + 4 * q_;
                ma2[kt][ks][0] = *(const unsigned long long*)row; ma2[kt][ks][1] = *(const unsigned long long*)(row + 16); }
            nn2[kt] = *(const unsigned long long*)(Nn + slot0 + (size_t)(16 * vs + n_) * 512 + 16 * kt + 4 * q_); } }
        const s16x8 b0 = pack_cpair(H[0], H[1]), b1 = pack_cpair(H[2], H[3]);
#pragma unroll
        for (int kt = 0; kt < 4; ++kt) {
            f32x4 acc = (f32x4){bflo((unsigned)nn[kt]), bfhi((unsigned)nn[kt]), bflo((unsigned)(nn[kt] >> 32)), bfhi((unsigned)(nn[kt] >> 32))};
            { v4u a; a.x = (unsigned)ma[kt][0][0]; a.y = (unsigned)(ma[kt][0][0] >> 32); a.z = (unsigned)ma[kt][0][1]; a.w = (unsigned)(ma[kt][0][1] >> 32); acc = mfma16(__builtin_bit_cast(s16x8, a), b0, acc); }
            { v4u a; a.x = (unsigned)ma[kt][1][0]; a.y = (unsigned)(ma[kt][1][0] >> 32); a.z = (unsigned)ma[kt][1][1]; a.w = (unsigned)(ma[kt][1][1] >> 32); acc = mfma16(__builtin_bit_cast(s16x8, a), b1, acc); }
            H[kt] = acc;
        }
#pragma unroll
        for (int kt = 0; kt < 4; ++kt) { nn[kt] = nn2[kt];
#pragma unroll
            for (int ks = 0; ks < 2; ++ks) { ma[kt][ks][0] = ma2[kt][ks][0]; ma[kt][ks][1] = ma2[kt][ks][1]; } }
    }
}
DI void rwkv_pass3_item(unsigned char* ws, int item, int lane) {
    const int z = item >> 11, h = (item >> 8) & 7, c = item & 255;
    const int cn = z ? 255 - c : c;
    const float* LW = (const float*)(ws + (z ? WS_LW1 : WS_LW0));
    const bf16* Hst = (const bf16*)(ws + (z ? WS_V : WS_R)) + (size_t)(c * 8 + h) * 64 * 64;
    bf16* Y = (bf16*)(ws + (z ? WS_Y1 : WS_Y0));
    const int n_ = lane & 15, q_ = lane >> 4;
    const size_t slot0 = (size_t)cn * 64 * 512 + h * 64;
    s16x8 hA[4][2], qB[4][2];
#pragma unroll
    for (int t = 0; t < 4; ++t)
#pragma unroll
        for (int ks = 0; ks < 2; ++ks) {
            hA[t][ks] = *(const s16x8*)(Hst + (size_t)(16 * t + n_) * 64 + 32 * ks + 8 * q_);
            qB[t][ks] = *(const s16x8*)((const bf16*)(LW + slot0 + (size_t)(16 * t + n_) * 512) + 32 * ks + 8 * q_); }
#pragma unroll
    for (int nt = 0; nt < 4; ++nt) {
        const int i = 16 * nt + n_; const bf16* ycrow = (const bf16*)(LW + slot0 + (size_t)i * 512) + 64;
        bf16* yrow = Y + (size_t)tok_of(z, cn, i) * 512 + h * 64;
#pragma unroll
        for (int mt = 0; mt < 4; ++mt) {
            const unsigned long long y4 = *(const unsigned long long*)(ycrow + 16 * mt + 4 * q_);
            f32x4 acc = (f32x4){bflo((unsigned)y4), bfhi((unsigned)y4), bflo((unsigned)(y4 >> 32)), bfhi((unsigned)(y4 >> 32))};
            acc = mfma16(hA[mt][0], qB[nt][0], acc); acc = mfma16(hA[mt][1], qB[nt][1], acc);
            *(unsigned long long*)(yrow + 16 * mt + 4 * q_) = (unsigned long long)pk2(acc[0], acc[1]) | ((unsigned long long)pk2(acc[2], acc[3]) << 32);
        }
    }
}
DI void rwkv_pass2_block(unsigned char* ws, ldsp L, int b  , int wave, int lane) {
    const int z = b >> 3, h = b & 7;
    if (wave >= 4) {
        const int lw = wave - 4;
        const char* Mm = (const char*)(ws + (z ? WS_KD1 : WS_KD0)); const char* Nn = (const char*)(ws + (z ? WS_B1 : WS_B0));
#define RW_ISSUE(cc) do { const int c_ = (cc); if (c_ < 256) { const int cn_ = z ? 255 - c_ : c_; const size_t slot0 = ((size_t)cn_ * 64 * 512 + h * 64) * 2; ldsp slot = L + (c_ & 7) * 16384; \
            _Pragma("unroll") for (int k = 0; k < 4; ++k) { const int pid = lw * 4 + k; const int pr = pid & 7; const int row = 8 * pr + (lane >> 3), p = lane & 7, cch = p ^ (row & 7); \
                const char* src = (pid < 8 ? Mm : Nn) + slot0 + (size_t)row * 1024 + cch * 16; \
                __builtin_amdgcn_global_load_lds((const unsigned*)src, (LAS unsigned*)(slot + (pid < 8 ? 0 : 8192) + pr * 1024), 16, 0, 0); } } } while (0)
        RW_ISSUE(0); RW_ISSUE(1); RW_ISSUE(2); RW_ISSUE(3); RW_ISSUE(4); RW_ISSUE(5); RW_ISSUE(6);
        for (int c = 0; c < 256; ++c) {
            if (c < 250) asm volatile("s_waitcnt vmcnt(24)" ::: "memory"); else asm volatile("s_waitcnt vmcnt(0)" ::: "memory");
            __builtin_amdgcn_s_barrier();
            asm volatile("" ::: "memory");
            RW_ISSUE(c + 7);
        }
#undef RW_ISSUE
        asm volatile("s_waitcnt vmcnt(0)" ::: "memory");
        return;
    }
    const int vs = wave;
    bf16* Hst = (bf16*)(ws + (z ? WS_V : WS_R));
    const int n_ = lane & 15, q_ = lane >> 4, wbyte = (q_ & 1) * 8, sw = n_ & 7;
    f32x4 H[4];
#pragma unroll
    for (int kt = 0; kt < 4; ++kt) H[kt] = (f32x4){0.f, 0.f, 0.f, 0.f};
    for (int c = 0; c < 256; ++c) {
        { bf16* dst = Hst + ((size_t)(c * 8 + h) * 64 + 16 * vs + n_) * 64 + 4 * q_;
#pragma unroll
          for (int kt = 0; kt < 4; ++kt) *(unsigned long long*)(dst + 16 * kt) = pk4(H[kt]); }
        asm volatile("s_waitcnt lgkmcnt(0)" ::: "memory");
        __builtin_amdgcn_s_barrier();
        asm volatile("" ::: "memory");
        ldsp slot = L + (c & 7) * 16384;
        const s16x8 b0 = pack_cpair(H[0], H[1]), b1 = pack_cpair(H[2], H[3]);
#pragma unroll
        for (int kt = 0; kt < 4; ++kt) {
            ldsp nrow = slot + 8192 + (16 * vs + n_) * 128 + wbyte;
            f32x4 acc = unpk4(*(LAS const unsigned long long*)(nrow + (((2 * kt + (q_ >> 1)) ^ sw) * 16)));
            ldsp mrow = slot + (16 * kt + n_) * 128 + wbyte;
#pragma unroll
            for (int ks = 0; ks < 2; ++ks) { const int c0 = 4 * ks + (q_ >> 1);
                const unsigned long long a0 = *(LAS const unsigned long long*)(mrow + ((c0 ^ sw) * 16)), a1 = *(LAS const unsigned long long*)(mrow + (((c0 + 2) ^ sw) * 16));
                v4u a; a.x = (unsigned)a0; a.y = (unsigned)(a0 >> 32); a.z = (unsigned)a1; a.w = (unsigned)(a1 >> 32);
                acc = mfma16(__builtin_bit_cast(s16x8, a), ks == 0 ? b0 : b1, acc); }
            H[kt] = acc;
        }
    }
}
DI void rwkv_pass3_post_item(const Args& a, unsigned char* ws, int item, int lane) {
    asm volatile("" : "+v"(lane));
    const int h = item >> 8, cn = item & 255;
    const int n_ = lane & 15, q_ = lane >> 4;
    const size_t slot0 = (size_t)cn * 64 * 512 + h * 64;
    const float* LW0 = (const float*)(ws + WS_LW0); const float* LW1 = (const float*)(ws + WS_LW1);
    const bf16* H0 = (const bf16*)(ws + WS_R) + (size_t)(cn * 8 + h) * 4096;
    const bf16* H1 = (const bf16*)(ws + WS_V) + (size_t)((255 - cn) * 8 + h) * 4096;
    s16x8 hA0[4][2], hA1[4][2];
#pragma unroll
    for (int t = 0; t < 4; ++t)
#pragma unroll
        for (int ks = 0; ks < 2; ++ks) { hA0[t][ks] = *(const s16x8*)(H0 + (size_t)(16 * t + n_) * 64 + 32 * ks + 8 * q_); hA1[t][ks] = *(const s16x8*)(H1 + (size_t)(16 * t + n_) * 64 + 32 * ks + 8 * q_); }
#pragma unroll
    for (int nt = 0; nt < 4; ++nt) {
        const int i0 = 16 * nt + n_, i1 = 63 - i0;
        const bf16* q0 = (const bf16*)(LW0 + slot0 + (size_t)i0 * 512); const bf16* q1 = (const bf16*)(LW1 + slot0 + (size_t)i1 * 512);
        s16x8 qB0[2], qB1[2];
#pragma unroll
        for (int ks = 0; ks < 2; ++ks) { qB0[ks] = *(const s16x8*)(q0 + 32 * ks + 8 * q_); qB1[ks] = *(const s16x8*)(q1 + 32 * ks + 8 * q_); }
        f32x4 y[4]; float sum = 0.f;
#pragma unroll
        for (int mt = 0; mt < 4; ++mt) {
            f32x4 acc = unpk4(*(const unsigned long long*)(q0 + 64 + 16 * mt + 4 * q_)) + unpk4(*(const unsigned long long*)(q1 + 64 + 16 * mt + 4 * q_));
            acc = mfma16(hA0[mt][0], qB0[0], acc); acc = mfma16(hA0[mt][1], qB0[1], acc);
            acc = mfma16(hA1[mt][0], qB1[0], acc); acc = mfma16(hA1[mt][1], qB1[1], acc);
            y[mt] = acc; sum += (acc[0] + acc[1]) + (acc[2] + acc[3]);
        }
        sum += __shfl_xor(sum, 16); sum += __shfl_xor(sum, 32);
        const float mu = sum * (1.0f / 64.f); float sq = 0.f;
#pragma unroll
        for (int mt = 0; mt < 4; ++mt)
#pragma unroll
            for (int e = 0; e < 4; ++e) { y[mt][e] -= mu; sq += y[mt][e] * y[mt][e]; }
        sq += __shfl_xor(sq, 16); sq += __shfl_xor(sq, 32);
        const float rs = 1.0f / sqrtf(sq * (1.0f / 64.f) + 64e-5f);
        const size_t tok = (size_t)(cn * 64 + i0);
#pragma unroll
        for (int mt = 0; mt < 4; ++mt) { const int c0 = h * 64 + 16 * mt + 4 * q_;
            const f32x4 lw = *(const f32x4*)(a.in[19] + c0), lb = *(const f32x4*)(a.in[20] + c0);
            const f32x4 bn = unpk4(*(const unsigned long long*)((const bf16*)(ws + WS_BONUS) + tok * 512 + c0)), gt = unpk4(*(const unsigned long long*)((const bf16*)(ws + WS_GATE) + tok * 512 + c0));
            const f32x4 o = (y[mt] * rs * lw + lb + bn) * gt;
            *(unsigned long long*)((bf16*)(ws + WS_Y) + tok * D_ + 512 + c0) = pk4(o); }
    }
}
constexpr size_t WS_W2T = WS_TILE + 65536;
constexpr size_t WS_PARK = WS_Y;
DI s16x8 act_frag(const bf16* p, int mode) {
    float v[8]; ld8(p, v);
#pragma unroll
    for (int i = 0; i < 8; ++i) { if (mode == 0) v[i] = 1.0f - 2.0f / (__expf(2.0f * v[i]) + 1.0f); else if (mode == 2) v[i] = 1.0f / (1.0f + __expf(-v[i])); }
    v4u w; w.x = pk2(v[0], v[1]); w.y = pk2(v[2], v[3]); w.z = pk2(v[4], v[5]); w.w = pk2(v[6], v[7]);
    return __builtin_bit_cast(s16x8, w);
}
DI void ld4(const bf16* p, float (&v)[4]) { const unsigned long long w = *(const unsigned long long*)p; v[0] = bflo((unsigned)w); v[1] = bfhi((unsigned)w); v[2] = bflo((unsigned)(w >> 32)); v[3] = bfhi((unsigned)(w >> 32)); }
DI void st4(bf16* p, const float (&v)[4]) { *(unsigned long long*)p = (unsigned long long)pk2(v[0], v[1]) | ((unsigned long long)pk2(v[2], v[3]) << 32); }
DI void prep0_rwkv_unit(const Args& a, unsigned char* ws_, ldsp wl, int tile, int h, int lane) {
    asm volatile("" : "+v"(lane));
    GAS unsigned char* wsg = (GAS unsigned char*)ws_; asm volatile("" : "+s"(wsg)); unsigned char* ws = (unsigned char*)wsg;
    const int t0 = tile * 16, n_ = lane & 15, q_ = lane >> 4, t = t0 + n_;
    const bf16* LR = (const bf16*)(ws + WS_LORA) + (size_t)t * LORA_N + 8 * q_;
    const bf16* P = (const bf16*)(ws + WS_PROJ0) + (size_t)t * EVEN_IN + 1536 + h * 64 + 4 * q_;
    const bool hp = t > 0, hn = t < S_ - 1;
    v4u lraw[12];
#pragma unroll
    for (int i = 0; i < 12; ++i) lraw[i] = *(const v4u*)(LR + 32 * i);
    unsigned long long cu[3][4], pv[3][4], nx[3][4];
#pragma unroll
    for (int part = 0; part < 3; ++part)
#pragma unroll
        for (int mt = 0; mt < 4; ++mt) { const bf16* p = P + part * 512 + 16 * mt;
            cu[part][mt] = *(const unsigned long long*)p; pv[part][mt] = hp ? *(const unsigned long long*)(p - EVEN_IN) : 0ull; nx[part][mt] = hn ? *(const unsigned long long*)(p + EVEN_IN) : 0ull; }
    float r[16], k[16], v[16];
#pragma unroll
    for (int part = 0; part < 3; ++part)
#pragma unroll
        for (int mt = 0; mt < 4; ++mt) { const int c0 = h * 64 + 16 * mt + 4 * q_;
            const f32x4 m0 = *(const f32x4*)(a.in[6] + part * 512 + c0), m1 = *(const f32x4*)(a.in[6] + 1536 + part * 512 + c0);
            const f32x4 c4 = unpk4(cu[part][mt]), p4 = unpk4(pv[part][mt]), n4 = unpk4(nx[part][mt]);
#pragma unroll
            for (int e = 0; e < 4; ++e) { const float o = c4[e] + m0[e] * (p4[e] - c4[e]) + m1[e] * (n4[e] - c4[e]);
                if (part == 0) r[4 * mt + e] = o; else if (part == 1) k[4 * mt + e] = o; else v[4 * mt + e] = o; } }
    float ss = 0.f;
#pragma unroll
    for (int mt = 0; mt < 4; ++mt) { const f32x4 kkw = *(const f32x4*)(a.in[16] + h * 64 + 16 * mt + 4 * q_);
#pragma unroll
        for (int e = 0; e < 4; ++e) { const float x = k[4 * mt + e] * kkw[e]; ss += x * x; } }
    ss += __shfl_xor(ss, 16); ss += __shfl_xor(ss, 32);
    const float rn = 1.0f / sqrtf(ss + 1e-6f);
    s16x8 lfr[12];
#pragma unroll
    for (int i = 0; i < 12; ++i) { float x[8]; const v4u w = lraw[i];
        x[0] = bflo(w.x); x[1] = bfhi(w.x); x[2] = bflo(w.y); x[3] = bfhi(w.y); x[4] = bflo(w.z); x[5] = bfhi(w.z); x[6] = bflo(w.w); x[7] = bfhi(w.w);
#pragma unroll
        for (int j = 0; j < 8; ++j) { if (i < 4) x[j] = 1.0f - 2.0f * __builtin_amdgcn_rcpf(__expf(2.0f * x[j]) + 1.0f); else if (i >= 8) x[j] = __builtin_amdgcn_rcpf(1.0f + __expf(-x[j])); }
        v4u o; o.x = pk2(x[0], x[1]); o.y = pk2(x[2], x[3]); o.z = pk2(x[4], x[5]); o.w = pk2(x[6], x[7]); lfr[i] = __builtin_bit_cast(s16x8, o); }
    float dotb = 0.f;
#pragma unroll
    for (int mt = 0; mt < 4; ++mt) {
        const int c0 = h * 64 + 16 * mt + 4 * q_;
        f32x4 aw0 = *(const f32x4*)(a.in[8] + c0), aw1 = *(const f32x4*)(a.in[8] + 512 + c0), aa0 = *(const f32x4*)(a.in[11] + c0), aa1 = *(const f32x4*)(a.in[11] + 512 + c0), ag = (f32x4){0.f, 0.f, 0.f, 0.f};
        const int rl = 16 * mt + n_, sw = rl & 7;
#pragma unroll
        for (int ks = 0; ks < 2; ++ks) { const int po = ((4 * ks + q_) ^ sw) * 16;
            aw0 = mfma16(*(LAS const s16x8*)(wl + rl * 128 + po), lfr[ks], aw0);
            aw1 = mfma16(*(LAS const s16x8*)(wl + 8192 + rl * 128 + po), lfr[2 + ks], aw1);
            aa0 = mfma16(*(LAS const s16x8*)(wl + 16384 + rl * 128 + po), lfr[4 + ks], aa0);
            aa1 = mfma16(*(LAS const s16x8*)(wl + 24576 + rl * 128 + po), lfr[6 + ks], aa1);
        }
#pragma unroll
        for (int ks = 0; ks < 4; ++ks) ag = mfma16(*(LAS const s16x8*)(wl + 32768 + rl * 256 + ((((4 * ks + q_) & 8) | (((4 * ks + q_) & 7) ^ sw)) * 16)), lfr[8 + ks], ag);
        const f32x4 kkw = *(const f32x4*)(a.in[16] + c0), kaw = *(const f32x4*)(a.in[17] + c0), rkw = *(const f32x4*)(a.in[18] + c0);
        float l0[4], l1[4], g4[4], d0[4], d1[4], kk4[4], b0[4], b1[4], r4[4], v4[4];
#pragma unroll
        for (int e = 0; e < 4; ++e) { const int i = 4 * mt + e;
            l0[e] = -__expf(-__logf(1.0f + __expf(-aw0[e])) - 0.5f); l1[e] = -__expf(-__logf(1.0f + __expf(-aw1[e])) - 0.5f);
            const float i0 = __builtin_amdgcn_rcpf(1.0f + __expf(-aa0[e])), i1 = __builtin_amdgcn_rcpf(1.0f + __expf(-aa1[e])); g4[e] = ag[e];
            kk4[e] = k[i] * kkw[e] * rn; b0[e] = kk4[e] * i0; b1[e] = kk4[e] * i1;
            d0[e] = k[i] * (1.0f + (i0 - 1.0f) * kaw[e]); d1[e] = k[i] * (1.0f + (i1 - 1.0f) * kaw[e]);
            dotb += r[i] * (d0[e] + d1[e]) * rkw[e]; r4[e] = r[i]; v4[e] = v[i]; }
        const size_t o = (size_t)t * 512 + c0;
        *(f32x4*)((float*)(ws + WS_LW0) + o) = (f32x4){l0[0], l0[1], l0[2], l0[3]};
        *(f32x4*)((float*)(ws + WS_LW1) + o) = (f32x4){l1[0], l1[1], l1[2], l1[3]};
        st4((bf16*)(ws + WS_R) + o, r4); st4((bf16*)(ws + WS_V) + o, v4); st4((bf16*)(ws + WS_KK) + o, kk4); st4((bf16*)(ws + WS_KD0) + o, d0); st4((bf16*)(ws + WS_KD1) + o, d1);
        st4((bf16*)(ws + WS_B0) + o, b0); st4((bf16*)(ws + WS_B1) + o, b1); st4((bf16*)(ws + WS_GATE) + o, g4);
    }
    dotb += __shfl_xor(dotb, 16); dotb += __shfl_xor(dotb, 32);
#pragma unroll
    for (int mt = 0; mt < 4; ++mt) { float bo[4];
#pragma unroll
        for (int e = 0; e < 4; ++e) bo[e] = dotb * v[4 * mt + e];
        st4((bf16*)(ws + WS_BONUS) + (size_t)t * 512 + h * 64 + 16 * mt + 4 * q_, bo); }
}
DI void prep0_stage_w2t(unsigned char* ws, ldsp wl, int h, int tid) {
    const bf16* W2T = (const bf16*)(ws + WS_W2T);
    for (int i = tid; i < 3072; i += 512) {
        if (i < 2048) { const int mtx = i >> 9, r = (i >> 3) & 63, c = i & 7;
            *(LAS v4u*)(wl + mtx * 8192 + r * 128 + ((c ^ (r & 7)) * 16)) = *(const v4u*)(W2T + (size_t)mtx * 32768 + (size_t)(h * 64 + r) * 64 + c * 8); }
        else { const int j = i - 2048, r = j >> 4, c = j & 15;
            *(LAS v4u*)(wl + 32768 + r * 256 + (((c & 8) | ((c & 7) ^ (r & 7))) * 16)) = *(const v4u*)(W2T + 131072 + (size_t)(h * 64 + r) * 128 + c * 8); }
    }
}
constexpr int AT_ACC = 0, AT_M = 65536, AT_L = 66560, AT_V = 67584;
DI void attn_unit(unsigned char* ws, ldsp L, int unit, int wave, int lane) {
    const int h = unit & 7, T0 = (unit >> 3) * 256;
    const bf16* QN = (const bf16*)(ws + WS_QN); const bf16* KN = (const bf16*)(ws + WS_KN); const bf16* P0 = (const bf16*)(ws + WS_PROJ0);
    LAS float* accO = (LAS float*)(L + AT_ACC); LAS float* accM = (LAS float*)(L + AT_M); LAS float* accL = (LAS float*)(L + AT_L);
    ldsp Vst = L + AT_V + wave * 8192;
#pragma unroll 1
    for (int br = 0; br < 3; ++br) {
        const int d = br == 0 ? 1 : (br == 1 ? 4 : 16);
#pragma unroll 1
        for (int si = 0; si < 2; ++si) {
            int lane_s = lane; asm volatile("" : "+v"(lane_s));
            const int n_ = lane_s & 15, q_ = lane_s >> 4;
            const int sidx = wave + 8 * si;
            const int tb = br == 0 ? T0 + 16 * sidx : (br == 1 ? T0 + (sidx & 3) + 64 * (sidx >> 2) : T0 + sidx);
            s16x8 qf[2];
            { const bf16* qrow = QN + (size_t)(tb + d * n_) * 512 + h * 64 + 8 * q_; qf[0] = *(const s16x8*)qrow; qf[1] = *(const s16x8*)(qrow + 32); }
            v4u vreg[5][4];
#pragma unroll
            for (int pp = 0; pp < 2; ++pp)
#pragma unroll
                for (int it = 0; it < 4; ++it) { const int pc = lane + 64 * it, row = pc >> 3, ck = pc & 7;
                    int tk = tb + d * (32 * pp + row - 64); tk = tk < 0 ? 0 : (tk > S_ - 1 ? S_ - 1 : tk);
                    vreg[pp][it] = *(const v4u*)(P0 + (size_t)tk * EVEN_IN + 1024 + h * 64 + ck * 8); }
            f32x4 st[10];
#pragma unroll
            for (int kt = 0; kt < 10; ++kt) {
                int tk = tb + d * (16 * kt + n_ - 64); tk = tk < 0 ? 0 : (tk > S_ - 1 ? S_ - 1 : tk);
                const bf16* krow = KN + (size_t)tk * 512 + h * 64 + 8 * q_;
                f32x4 acc = (f32x4){0.f, 0.f, 0.f, 0.f};
                acc = mfma16(*(const s16x8*)krow, qf[0], acc); acc = mfma16(*(const s16x8*)(krow + 32), qf[1], acc);
                st[kt] = acc;
            }
            float mx = -3.0e38f;
#pragma unroll
            for (int kt = 0; kt < 10; ++kt)
#pragma unroll
                for (int e = 0; e < 4; ++e) { const int j = 16 * kt + 4 * q_ + e; const int tk = tb + d * (j - 64);
                    const bool ok = (j >= n_) && (j <= n_ + 128) && (tk >= 0) && (tk < S_);
                    st[kt][e] = ok ? st[kt][e] : -3.0e38f; mx = fmaxf(mx, st[kt][e]); }
            mx = fmaxf(mx, __shfl_xor(mx, 16)); mx = fmaxf(mx, __shfl_xor(mx, 32));
            float ls = 0.f;
#pragma unroll
            for (int kt = 0; kt < 10; ++kt)
#pragma unroll
                for (int e = 0; e < 4; ++e) { const float p = st[kt][e] > -1.0e38f ? __expf(st[kt][e] - mx) : 0.f; st[kt][e] = p; ls += p; }
            ls += __shfl_xor(ls, 16); ls += __shfl_xor(ls, 32);
#pragma unroll
            for (int pp = 2; pp < 5; ++pp)
#pragma unroll
                for (int it = 0; it < 4; ++it) { const int pc = lane + 64 * it, row = pc >> 3, ck = pc & 7;
                    int tk = tb + d * (32 * pp + row - 64); tk = tk < 0 ? 0 : (tk > S_ - 1 ? S_ - 1 : tk);
                    vreg[pp][it] = *(const v4u*)(P0 + (size_t)tk * EVEN_IN + 1024 + h * 64 + ck * 8); }
            f32x4 O[4];
#pragma unroll
            for (int dt = 0; dt < 4; ++dt) O[dt] = (f32x4){0.f, 0.f, 0.f, 0.f};
#pragma unroll
            for (int pp = 0; pp < 5; ++pp) {
                ldsp vb = Vst + (pp & 1) * 4096;
#pragma unroll
                for (int it = 0; it < 4; ++it) { const int pc = lane + 64 * it, row = pc >> 3, ck = pc & 7; *(LAS v4u*)(vb + row * 128 + ck * 16) = vreg[pp][it]; }
                LDS_WAIT(); CFENCE();
                const s16x8 pa = pack_cpair(st[2 * pp], st[2 * pp + 1]);
                ldsp a0 = vb + (4 * q_ + ((lane & 15) >> 2)) * 128 + 8 * (lane & 3);
#pragma unroll
                for (int dt = 0; dt < 4; ++dt) { const s16x4 lo = tr16(a0 + 32 * dt), hi = tr16(a0 + 16 * 128 + 32 * dt);
                    O[dt] = mfma16(pa, __builtin_shufflevector(lo, hi, 0, 1, 2, 3, 4, 5, 6, 7), O[dt]); }
            }
            float ms[4], lsv[4]; int li[4];
#pragma unroll
            for (int e = 0; e < 4; ++e) { ms[e] = __shfl(mx, 4 * q_ + e); lsv[e] = __shfl(ls, 4 * q_ + e); li[e] = tb + d * (4 * q_ + e) - T0; }
            if (br == 0) {
#pragma unroll
                for (int e = 0; e < 4; ++e) {
#pragma unroll
                    for (int dt = 0; dt < 4; ++dt) accO[li[e] * 64 + 16 * dt + n_] = O[dt][e];
                    if (n_ == 0) { accM[li[e]] = ms[e]; accL[li[e]] = lsv[e]; } }
            } else {
                float fo[4], fn[4], mn[4], lo_[4];
#pragma unroll
                for (int e = 0; e < 4; ++e) { const float mo = accM[li[e]]; lo_[e] = accL[li[e]]; mn[e] = fmaxf(mo, ms[e]); fo[e] = __expf(mo - mn[e]); fn[e] = __expf(ms[e] - mn[e]); }
                LDS_WAIT(); CFENCE();
#pragma unroll
                for (int e = 0; e < 4; ++e) {
#pragma unroll
                    for (int dt = 0; dt < 4; ++dt) { LAS float* p = accO + li[e] * 64 + 16 * dt + n_; *p = *p * fo[e] + O[dt][e] * fn[e]; }
                    if (n_ == 0) { accM[li[e]] = mn[e]; accL[li[e]] = lo_[e] * fo[e] + lsv[e] * fn[e]; } }
            }
            LDS_WAIT(); CFENCE();
        }
        __syncthreads();
    }
    {
        const int tid = wave * 64 + lane, tl = tid >> 1, hf = tid & 1;
        const float il = 1.0f / accL[tl];
        const LAS float* src = accO + tl * 64 + 32 * hf; bf16* dst = (bf16*)(ws + WS_Y) + (size_t)(T0 + tl) * D_ + h * 64 + 32 * hf;
#pragma unroll
        for (int c = 0; c < 4; ++c) { const f32x4 a = *(LAS const f32x4*)(src + 8 * c), b = *(LAS const f32x4*)(src + 8 * c + 4);
            v4u w; w.x = pk2(a.x * il, a.y * il); w.y = pk2(a.z * il, a.w * il); w.z = pk2(b.x * il, b.y * il); w.w = pk2(b.z * il, b.w * il);
            *(v4u*)(dst + 8 * c) = w; }
    }
    __syncthreads();
}
constexpr size_t WS_SST = WS_PROJ1, WS_UB = WS_PROJ1 + 64 * MiB, WS_AT = WS_PROJ1 + 96 * MiB, WS_GC = WS_PROJ1 + 112 * MiB;
constexpr size_t WS_WN = WS_A + 112 * MiB, WS_KT = WS_A + 144 * MiB;
static_assert(WS_GC + 2048 * 64 * 4 <= WS_O0, "dn map");
template <int PITCH> DI s16x8 frag_row_p(ldsp img, int row0, int col0, int lane) { return *(LAS const s16x8*)(img + (row0 + (lane & 15)) * PITCH + (col0 + 8 * (lane >> 4)) * 2); }
template <int PITCH> DI s16x8 frag_tr_p(ldsp img, int row0, int col0, int lane) {
    ldsp a0 = img + (row0 + 8 * (lane >> 4) + ((lane & 15) >> 2)) * PITCH + col0 * 2 + 8 * (lane & 3);
    const s16x4 lo = tr16(a0), hi = tr16(a0 + 4 * PITCH);
    return __builtin_shufflevector(lo, hi, 0, 1, 2, 3, 4, 5, 6, 7);
}
constexpr int DN_LDS_PER_WAVE = 49152 + 512;
DI void dn_pass1_item(unsigned char* ws, ldsp lds, int item, int lane) {
    asm volatile("" : "+v"(lane));
    const int z = item >> 10, h = (item >> 8) & 3, c = item & 255, cn = z ? 255 - c : c;
    const bf16* Q = (const bf16*)(ws + WS_QD); const bf16* K = (const bf16*)(ws + WS_KD); const bf16* V = (const bf16*)(ws + WS_VD);
    ldsp IKd = lds, IVd = lds + 16384, LT = lds + 32768; LAS float* gcs = (LAS float*)(lds + 49152); LAS float* bts = gcs + 64;
    const int n_ = lane & 15, q_ = lane >> 4;
    {
        const int tok = tok_of(z, cn, lane);
        float gc = ((const float*)(ws + WS_GB))[(size_t)tok * 8 + z * 4 + h]; const float bt = ((const float*)(ws + WS_GB + 512 * 1024))[(size_t)tok * 8 + z * 4 + h];
#pragma unroll
        for (int o = 1; o < 64; o <<= 1) { const float t = __shfl_up(gc, o); if (lane >= o) gc += t; }
        gcs[lane] = gc; bts[lane] = bt; ((float*)(ws + WS_GC))[(size_t)item * 64 + lane] = gc;
    }
#pragma unroll 4
    for (int it = 0; it < 16; ++it) { const int p = lane + 64 * it, row = p >> 4, ck = p & 15; const size_t go = (size_t)tok_of(z, cn, row) * 512 + h * 128 + ck * 8;
        *(LAS v4u*)(IKd + row * 256 + ck * 16) = *(const v4u*)(K + go); *(LAS v4u*)(IVd + row * 256 + ck * 16) = *(const v4u*)(V + go); }
    LDS_WAIT(); CFENCE();
    s16x8 kf[4][4];
#pragma unroll
    for (int rt = 0; rt < 4; ++rt)
#pragma unroll
        for (int ks = 0; ks < 4; ++ks) kf[rt][ks] = frag_row_p<256>(IKd, 16 * rt, 32 * ks, lane);
#pragma unroll
    for (int mt = 0; mt < 4; ++mt) { f32x4 gi, bi;
#pragma unroll
        for (int e = 0; e < 4; ++e) { gi[e] = gcs[16 * mt + 4 * q_ + e]; bi[e] = bts[16 * mt + 4 * q_ + e]; }
#pragma unroll
        for (int nt = 0; nt < 4; ++nt) { f32x4 acc = (f32x4){0.f, 0.f, 0.f, 0.f};
            if (nt <= mt) {
#pragma unroll
                for (int ks = 0; ks < 4; ++ks) acc = mfma16(kf[mt][ks], kf[nt][ks], acc); }
            const float gj = gcs[16 * nt + n_];
#pragma unroll
            for (int e = 0; e < 4; ++e) { const int i = 16 * mt + 4 * q_ + e, j = 16 * nt + n_; ((LAS float*)LT)[i * 64 + j] = (j < i) ? bi[e] * acc[e] * __expf(gi[e] - gj) : 0.f; } } }
    {
        bf16* At = (bf16*)(ws + WS_AT) + (size_t)item * 4096;
#pragma unroll
        for (int nt = 0; nt < 4; ++nt) { s16x8 qf[4]; const bf16* qrow = Q + (size_t)tok_of(z, cn, 16 * nt + n_) * 512 + h * 128 + 8 * q_;
#pragma unroll
            for (int ks = 0; ks < 4; ++ks) qf[ks] = *(const s16x8*)(qrow + 32 * ks);
            const float gi = gcs[16 * nt + n_];
#pragma unroll
            for (int mt = 0; mt < 4; ++mt) { f32x4 acc = (f32x4){0.f, 0.f, 0.f, 0.f};
                if (mt <= nt) {
#pragma unroll
                    for (int ks = 0; ks < 4; ++ks) acc = mfma16(kf[mt][ks], qf[ks], acc); }
                f32x4 o;
#pragma unroll
                for (int e = 0; e < 4; ++e) { const int j = 16 * mt + 4 * q_ + e, i = 16 * nt + n_; o[e] = (j <= i) ? acc[e] * __expf(gi - gcs[j]) : 0.f; }
                *(unsigned long long*)(At + (size_t)(16 * nt + n_) * 64 + 16 * mt + 4 * q_) = pk4(o); } }
    }
    LDS_WAIT(); CFENCE();
    {
        float t[64];
        int lane_o = lane; asm volatile("" : "+v"(lane_o));
#pragma unroll
        for (int i = 0; i < 64; ++i) {
            float acc0 = (lane_o == i) ? 1.f : 0.f, acc1 = 0.f, acc2 = 0.f, acc3 = 0.f;
#pragma unroll
            for (int jg = 0; jg < (i + 3) / 4; ++jg) { const f32x4 a4 = *(LAS const f32x4*)(LT + (i * 64 + 4 * jg) * 4);
                if (4 * jg + 0 < i) acc0 -= a4[0] * t[4 * jg + 0];
                if (4 * jg + 1 < i) acc1 -= a4[1] * t[4 * jg + 1];
                if (4 * jg + 2 < i) acc2 -= a4[2] * t[4 * jg + 2];
                if (4 * jg + 3 < i) acc3 -= a4[3] * t[4 * jg + 3]; }
            t[i] = (acc0 + acc1) + (acc2 + acc3);
        }
        LDS_WAIT(); CFENCE();
        const float s1 = bts[lane], s2 = -s1 * __expf(gcs[lane]);
#pragma unroll
        for (int i = 0; i < 64; ++i) { ((LAS bf16*)LT)[i * 64 + lane] = (bf16)f2bf(t[i] * s1); ((LAS bf16*)(LT + 8192))[i * 64 + lane] = (bf16)f2bf(t[i] * s2); }
    }
    LDS_WAIT(); CFENCE();
    ldsp IT1 = LT, IT2 = LT + 8192;
    {
        bf16* Ub = (bf16*)(ws + WS_UB) + (size_t)item * 8192;
        s16x8 tf[4][2];
#pragma unroll
        for (int mt = 0; mt < 4; ++mt)
#pragma unroll
            for (int ks = 0; ks < 2; ++ks) tf[mt][ks] = frag_row_p<128>(IT1, 16 * mt, 32 * ks, lane);
#pragma unroll
        for (int nt = 0; nt < 8; ++nt) { const s16x8 v0 = frag_tr_p<256>(IVd, 0, 16 * nt, lane), v1 = frag_tr_p<256>(IVd, 32, 16 * nt, lane);
#pragma unroll
            for (int mt = 0; mt < 4; ++mt) { f32x4 acc = (f32x4){0.f, 0.f, 0.f, 0.f}; acc = mfma16(tf[mt][0], v0, acc); acc = mfma16(tf[mt][1], v1, acc);
                *(unsigned long long*)(Ub + (size_t)(16 * nt + n_) * 64 + 16 * mt + 4 * q_) = pk4(acc); } }
    }
    {
        bf16* Wn = (bf16*)(ws + WS_WN) + (size_t)item * 8192;
        s16x8 tf[4][2];
#pragma unroll
        for (int nt = 0; nt < 4; ++nt)
#pragma unroll
            for (int ks = 0; ks < 2; ++ks) tf[nt][ks] = frag_row_p<128>(IT2, 16 * nt, 32 * ks, lane);
#pragma unroll
        for (int mt = 0; mt < 8; ++mt) { const s16x8 k0 = frag_tr_p<256>(IKd, 0, 16 * mt, lane), k1 = frag_tr_p<256>(IKd, 32, 16 * mt, lane);
            if (z == 0) { bf16* KT = (bf16*)(ws + WS_KT) + ((size_t)(h * 256 + cn) * 128 + 16 * mt + n_) * 64 + 8 * q_; *(s16x8*)KT = k0; *(s16x8*)(KT + 32) = k1; }
#pragma unroll
            for (int nt = 0; nt < 4; ++nt) { f32x4 acc = (f32x4){0.f, 0.f, 0.f, 0.f}; acc = mfma16(k0, tf[nt][0], acc); acc = mfma16(k1, tf[nt][1], acc);
                *(unsigned long long*)(Wn + (size_t)(16 * nt + n_) * 128 + 16 * mt + 4 * q_) = pk4(acc); } }
    }
    LDS_WAIT(); CFENCE();
}
DI s16x8 pack_cpair_rev(const f32x4& lo, const f32x4& hi) { v4u p; p.x = pk2(lo[3], lo[2]); p.y = pk2(lo[1], lo[0]); p.z = pk2(hi[3], hi[2]); p.w = pk2(hi[1], hi[0]); return __builtin_bit_cast(s16x8, p); }
DI unsigned long long rev4(unsigned long long x) { return (x >> 48) | ((x >> 16) & 0xffff0000ull) | ((x << 16) & 0xffff00000000ull) | (x << 48); }
DI void dn_pass2_wave(unsigned char* ws, int w  , int lane) {
    const int z = w >> 5, h = (w >> 3) & 3, vs = w & 7;
    const int n_ = lane & 15, q_ = lane >> 4;
    f32x4 S[8];
#pragma unroll
    for (int kt = 0; kt < 8; ++kt) S[kt] = (f32x4){0.f, 0.f, 0.f, 0.f};
    for (int c = 0; c < 256; ++c) {
        const int item = (z * 4 + h) * 256 + c, cn = z ? 255 - c : c;
        const bf16* Wn = (const bf16*)(ws + WS_WN) + (size_t)item * 8192; const bf16* Ub = (const bf16*)(ws + WS_UB) + (size_t)item * 8192;
        const float* gcu = (const float*)(ws + WS_GC) + (size_t)item * 64;
        const bf16* KT = (const bf16*)(ws + WS_KT) + (size_t)(h * 256 + cn) * 128 * 64;
        bf16* Sst = (bf16*)(ws + WS_SST) + (size_t)item * 16384;
        f32x4 u[4], gv[4];
#pragma unroll
        for (int mt = 0; mt < 4; ++mt) { u[mt] = unpk4(*(const unsigned long long*)(Ub + (size_t)(16 * vs + n_) * 64 + 16 * mt + 4 * q_)); gv[mt] = *(const f32x4*)(gcu + 16 * mt + 4 * q_); }
        const float gl = gcu[63];
        unsigned long long wa[4][4][2], ka[8][2][2];
#pragma unroll
        for (int mt = 0; mt < 4; ++mt)
#pragma unroll
            for (int ks = 0; ks < 4; ++ks) { const bf16* row = Wn + (size_t)(16 * mt + n_) * 128 + 32 * ks + 4 * q_; wa[mt][ks][0] = *(const unsigned long long*)row; wa[mt][ks][1] = *(const unsigned long long*)(row + 16); }
#pragma unroll
        for (int kt = 0; kt < 8; ++kt)
#pragma unroll
            for (int ks = 0; ks < 2; ++ks) { const bf16* row = KT + (size_t)(16 * kt + n_) * 64;
                if (z == 0) { ka[kt][ks][0] = *(const unsigned long long*)(row + 32 * ks + 4 * q_); ka[kt][ks][1] = *(const unsigned long long*)(row + 32 * ks + 16 + 4 * q_); }
                else { ka[kt][ks][0] = rev4(*(const unsigned long long*)(row + 60 - 32 * ks - 4 * q_)); ka[kt][ks][1] = rev4(*(const unsigned long long*)(row + 44 - 32 * ks - 4 * q_)); } }
#pragma unroll
        for (int kt = 0; kt < 8; ++kt) *(unsigned long long*)(Sst + (size_t)(16 * vs + n_) * 128 + 16 * kt + 4 * q_) = pk4(S[kt]);
#pragma unroll
        for (int ks = 0; ks < 4; ++ks) { const s16x8 b = pack_cpair(S[2 * ks], S[2 * ks + 1]);
#pragma unroll
            for (int mt = 0; mt < 4; ++mt) { v4u a; a.x = (unsigned)wa[mt][ks][0]; a.y = (unsigned)(wa[mt][ks][0] >> 32); a.z = (unsigned)wa[mt][ks][1]; a.w = (unsigned)(wa[mt][ks][1] >> 32);
                u[mt] = mfma16(__builtin_bit_cast(s16x8, a), b, u[mt]); } }
#pragma unroll
        for (int mt = 0; mt < 4; ++mt)
#pragma unroll
            for (int e = 0; e < 4; ++e) u[mt][e] *= __expf(gl - gv[mt][e]);
        const float egl = __expf(gl);
        const s16x8 b0 = pack_cpair(u[0], u[1]), b1 = pack_cpair(u[2], u[3]);
#pragma unroll
        for (int kt = 0; kt < 8; ++kt) { f32x4 acc = S[kt] * egl;
            { v4u a; a.x = (unsigned)ka[kt][0][0]; a.y = (unsigned)(ka[kt][0][0] >> 32); a.z = (unsigned)ka[kt][0][1]; a.w = (unsigned)(ka[kt][0][1] >> 32); acc = mfma16(__builtin_bit_cast(s16x8, a), b0, acc); }
            { v4u a; a.x = (unsigned)ka[kt][1][0]; a.y = (unsigned)(ka[kt][1][0] >> 32); a.z = (unsigned)ka[kt][1][1]; a.w = (unsigned)(ka[kt][1][1] >> 32); acc = mfma16(__builtin_bit_cast(s16x8, a), b1, acc); }
            S[kt] = acc; }
    }
}
DI void dn_pass3_item(unsigned char* ws, int item, int lane) {
    asm volatile("" : "+v"(lane));
    const int z = item >> 10, h = (item >> 8) & 3, c = item & 255, cn = z ? 255 - c : c;
    const int n_ = lane & 15, q_ = lane >> 4;
    const bf16* Q = (const bf16*)(ws + WS_QD);
    const bf16* Wn = (const bf16*)(ws + WS_WN) + (size_t)item * 8192; const bf16* Ub = (const bf16*)(ws + WS_UB) + (size_t)item * 8192;
    const bf16* At = (const bf16*)(ws + WS_AT) + (size_t)item * 4096; const float* gcu = (const float*)(ws + WS_GC) + (size_t)item * 64;
    const bf16* Sst = (const bf16*)(ws + WS_SST) + (size_t)item * 16384;
    bf16* O = (bf16*)(ws + (z ? WS_O1 : WS_O0));
    s16x8 wf[4][4], qf[4][4]; unsigned long long af[4][2][2]; float eg[4];
#pragma unroll
    for (int t = 0; t < 4; ++t) {
        const bf16* qrow = Q + (size_t)tok_of(z, cn, 16 * t + n_) * 512 + h * 128 + 8 * q_;
#pragma unroll
        for (int ks = 0; ks < 4; ++ks) { wf[t][ks] = *(const s16x8*)(Wn + (size_t)(16 * t + n_) * 128 + 32 * ks + 8 * q_); qf[t][ks] = *(const s16x8*)(qrow + 32 * ks); }
#pragma unroll
        for (int ks = 0; ks < 2; ++ks) { const bf16* arow = At + (size_t)(16 * t + n_) * 64 + 32 * ks + 4 * q_; af[t][ks][0] = *(const unsigned long long*)arow; af[t][ks][1] = *(const unsigned long long*)(arow + 16); }
        eg[t] = __expf(gcu[16 * t + n_]);
    }
#pragma unroll
    for (int mt = 0; mt < 8; ++mt) {
        s16x8 sf[4];
#pragma unroll
        for (int ks = 0; ks < 4; ++ks) sf[ks] = *(const s16x8*)(Sst + (size_t)(16 * mt + n_) * 128 + 32 * ks + 8 * q_);
        f32x4 u[4];
#pragma unroll
        for (int jt = 0; jt < 4; ++jt) { u[jt] = unpk4(*(const unsigned long long*)(Ub + (size_t)(16 * mt + n_) * 64 + 16 * jt + 4 * q_));
#pragma unroll
            for (int ks = 0; ks < 4; ++ks) u[jt] = mfma16(wf[jt][ks], sf[ks], u[jt]); }
        const s16x8 ua0 = pack_cpair(u[0], u[1]), ua1 = pack_cpair(u[2], u[3]);
#pragma unroll
        for (int nt = 0; nt < 4; ++nt) {
            f32x4 acc = (f32x4){0.f, 0.f, 0.f, 0.f};
#pragma unroll
            for (int ks = 0; ks < 4; ++ks) acc = mfma16(sf[ks], qf[nt][ks], acc);
            acc = acc * eg[nt];
            { v4u b; b.x = (unsigned)af[nt][0][0]; b.y = (unsigned)(af[nt][0][0] >> 32); b.z = (unsigned)af[nt][0][1]; b.w = (unsigned)(af[nt][0][1] >> 32); acc = mfma16(ua0, __builtin_bit_cast(s16x8, b), acc); }
            { v4u b; b.x = (unsigned)af[nt][1][0]; b.y = (unsigned)(af[nt][1][0] >> 32); b.z = (unsigned)af[nt][1][1]; b.w = (unsigned)(af[nt][1][1] >> 32); acc = mfma16(ua1, __builtin_bit_cast(s16x8, b), acc); }
            *(unsigned long long*)(O + (size_t)tok_of(z, cn, 16 * nt + n_) * 512 + h * 128 + 16 * mt + 4 * q_) = pk4(acc);
        }
    }
}
constexpr int DN_SLOT = 41984, DN_GRP = 16;
constexpr size_t WS_MG = WS_END_OLD, WS_NG = WS_END_OLD + 4 * MiB, WS_SG = WS_END_OLD + 8 * MiB;
DI void dn_scan_block(unsigned char* ws, ldsp L, const int Z, const int MODE, int h, int hv, int g, int wave, int lane) {
    const int item0 = (Z * 4 + h) * 256, cb = g * DN_GRP, zhg = (Z * 4 + h) * 16 + g;
    if (wave >= 4) {
        const int lw = wave - 4;
        unsigned so[11], ld[11];
#pragma unroll
        for (int k = 0; k < 4; ++k) { const int pid = lw * 4 + k; const int row = 4 * pid + (lane >> 4), p = lane & 15, cch = p ^ (row & 15); so[k] = row * 256 + cch * 16; ld[k] = pid * 1024 + lane * 16; }
#pragma unroll
        for (int k = 0; k < 4; ++k) { const int pid = lw * 4 + k; const int row = 8 * pid + (lane >> 3), p = lane & 7, cch = p ^ (row & 7); so[4 + k] = row * 128 + cch * 16; ld[4 + k] = 16384 + pid * 1024 + lane * 16; }
#pragma unroll
        for (int k = 0; k < 2; ++k) { const int pid = lw * 2 + k; const int row = 8 * pid + (lane >> 3), p = lane & 7, cch = p ^ (row & 7); so[8 + k] = row * 128 + cch * 16; ld[8 + k] = 32768 + pid * 1024 + lane * 16; }
        so[10] = lane * 16; ld[10] = 40960 + lane * 16;
        v4u rA[11], rB[11];
#define DN_GLOAD(R, ss) do { const int s_ = (ss) < DN_GRP ? (ss) : DN_GRP - 1; const int c_ = cb + s_; const int cn_ = Z ? 255 - c_ : c_; \
            const char* wsrc = (const char*)((const bf16*)(ws + WS_WN) + (size_t)(item0 + c_) * 8192); const char* ksrc = (const char*)((const bf16*)(ws + WS_KT) + (size_t)(h * 256 + cn_) * 8192); \
            const char* usrc = (const char*)((const bf16*)(ws + WS_UB) + (size_t)(item0 + c_) * 8192 + hv * 4096); const char* gsrc = (const char*)((const float*)(ws + WS_GC) + (size_t)(item0 + c_) * 64); \
            _Pragma("unroll") for (int k = 0; k < 4; ++k) R[k] = *(const v4u*)(wsrc + so[k]); \
            _Pragma("unroll") for (int k = 4; k < 8; ++k) R[k] = *(const v4u*)(ksrc + so[k]); \
            _Pragma("unroll") for (int k = 8; k < 10; ++k) R[k] = *(const v4u*)(usrc + so[k]); \
            if (lw == 0) R[10] = *(const v4u*)(gsrc + so[10]); } while (0)
#define DN_LWRITE(R, ss) do { ldsp slot = L + ((ss) % 3) * DN_SLOT; \
            _Pragma("unroll") for (int k = 0; k < 10; ++k) *(LAS v4u*)(slot + ld[k]) = R[k]; \
            if (lw == 0) *(LAS v4u*)(slot + ld[10]) = R[10]; } while (0)
        DN_GLOAD(rA, 0); DN_GLOAD(rB, 1); DN_LWRITE(rA, 0); DN_LWRITE(rB, 1);
        DN_GLOAD(rA, 2); DN_GLOAD(rB, 3);
#define DN_LSTEP(R, ss) do { asm volatile("s_waitcnt lgkmcnt(0)" ::: "memory"); __builtin_amdgcn_s_barrier(); asm volatile("" ::: "memory"); \
            DN_LWRITE(R, (ss) + 2); DN_GLOAD(R, (ss) + 4); } while (0)
        for (int s2 = 0; s2 < DN_GRP; s2 += 2) { DN_LSTEP(rA, s2); DN_LSTEP(rB, s2 + 1); }
#undef DN_LSTEP
#undef DN_LWRITE
#undef DN_GLOAD
        asm volatile("s_waitcnt vmcnt(0) lgkmcnt(0)" ::: "memory");
        return;
    }
    const int vs = 4 * hv + wave;
    const int n_ = lane & 15, q_ = lane >> 4, wbyte = (q_ & 1) * 8, sw = n_ & 7;
    int kao[2][2];
#pragma unroll
    for (int ks = 0; ks < 2; ++ks) { const int r0 = Z ? 60 - 32 * ks - 4 * q_ : 32 * ks + 4 * q_, r1 = Z ? r0 - 16 : r0 + 16; kao[ks][0] = (((r0 >> 3) ^ sw) * 16) + (r0 & 7) * 2; kao[ks][1] = (((r1 >> 3) ^ sw) * 16) + (r1 & 7) * 2; }
    const float ubm = MODE == 2 ? 0.f : 1.f;
    f32x4 S[8];
    if (MODE == 0) { const bf16* SG = (const bf16*)(ws + WS_SG) + (size_t)zhg * 16384;
#pragma unroll
        for (int kt = 0; kt < 8; ++kt) S[kt] = unpk4(*(const unsigned long long*)(SG + (size_t)(16 * vs + n_) * 128 + 16 * kt + 4 * q_)); }
    else {
#pragma unroll
        for (int kt = 0; kt < 8; ++kt)
#pragma unroll
            for (int e = 0; e < 4; ++e) S[kt][e] = (MODE == 2 && (16 * kt + 4 * q_ + e) == (16 * vs + n_)) ? 1.f : 0.f; }
    for (int s = 0; s < DN_GRP; ++s) {
        const int c = cb + s;
        if (MODE == 0) { bf16* Sst = (bf16*)(ws + WS_SST) + (size_t)(item0 + c) * 16384;
#pragma unroll
            for (int kt = 0; kt < 8; ++kt) *(unsigned long long*)(Sst + (size_t)(16 * vs + n_) * 128 + 16 * kt + 4 * q_) = pk4(S[kt]); }
        asm volatile("s_waitcnt lgkmcnt(0)" ::: "memory");
        __builtin_amdgcn_s_barrier();
        asm volatile("" ::: "memory");
        ldsp slot = L + (s % 3) * DN_SLOT;
        f32x4 u[4], gv[4]; unsigned long long wa[4][4][2], ka[8][2][2];
        { ldsp urow = slot + 32768 + (16 * wave + n_) * 128 + wbyte;
#pragma unroll
          for (int mt = 0; mt < 4; ++mt) { u[mt] = unpk4(*(LAS const unsigned long long*)(urow + (((2 * mt + (q_ >> 1)) ^ sw) * 16))) * ubm; gv[mt] = *(LAS const f32x4*)(slot + 40960 + (16 * mt + 4 * q_) * 4); } }
        const float gl = *(LAS const float*)(slot + 40960 + 63 * 4);
#pragma unroll
        for (int ks = 0; ks < 4; ++ks)
#pragma unroll
            for (int mt = 0; mt < 4; ++mt) { ldsp row = slot + (16 * mt + n_) * 256 + wbyte; const int c0 = 4 * ks + (q_ >> 1);
                wa[mt][ks][0] = *(LAS const unsigned long long*)(row + ((c0 ^ n_) * 16)); wa[mt][ks][1] = *(LAS const unsigned long long*)(row + (((c0 + 2) ^ n_) * 16)); }
        __builtin_amdgcn_sched_barrier(0);
#pragma unroll
        for (int ks = 0; ks < 4; ++ks) { const s16x8 bb = pack_cpair(S[2 * ks], S[2 * ks + 1]);
#pragma unroll
            for (int mt = 0; mt < 4; ++mt) { v4u a; a.x = (unsigned)wa[mt][ks][0]; a.y = (unsigned)(wa[mt][ks][0] >> 32); a.z = (unsigned)wa[mt][ks][1]; a.w = (unsigned)(wa[mt][ks][1] >> 32);
                u[mt] = mfma16(__builtin_bit_cast(s16x8, a), bb, u[mt]); } }
        __builtin_amdgcn_sched_barrier(0);
#pragma unroll
        for (int kt = 0; kt < 8; ++kt) { ldsp row = slot + 16384 + (16 * kt + n_) * 128;
#pragma unroll
            for (int ks = 0; ks < 2; ++ks) { ka[kt][ks][0] = *(LAS const unsigned long long*)(row + kao[ks][0]); ka[kt][ks][1] = *(LAS const unsigned long long*)(row + kao[ks][1]); } }
        __builtin_amdgcn_sched_barrier(0);
#pragma unroll
        for (int mt = 0; mt < 4; ++mt)
#pragma unroll
            for (int e = 0; e < 4; ++e) u[mt][e] *= __expf(gl - gv[mt][e]);
        const float egl = __expf(gl);
#pragma unroll
        for (int mt = 0; mt < 4; ++mt) { const f32x4 t = u[mt]; u[mt][0] = Z ? t[3] : t[0]; u[mt][1] = Z ? t[2] : t[1]; u[mt][2] = Z ? t[1] : t[2]; u[mt][3] = Z ? t[0] : t[3]; }
        const s16x8 b0 = pack_cpair(u[0], u[1]), b1 = pack_cpair(u[2], u[3]);
#pragma unroll
        for (int kt = 0; kt < 8; ++kt) { f32x4 acc = S[kt] * egl;
#pragma unroll
            for (int ks = 0; ks < 2; ++ks) { const unsigned long long a0 = ka[kt][ks][0], a1 = ka[kt][ks][1];
                v4u a; a.x = (unsigned)a0; a.y = (unsigned)(a0 >> 32); a.z = (unsigned)a1; a.w = (unsigned)(a1 >> 32);
                acc = mfma16(__builtin_bit_cast(s16x8, a), ks == 0 ? b0 : b1, acc); }
            S[kt] = acc; }
    }
    if (MODE == 1) { bf16* NG = (bf16*)(ws + WS_NG) + (size_t)zhg * 16384;
#pragma unroll
        for (int kt = 0; kt < 8; ++kt) *(unsigned long long*)(NG + (size_t)(16 * vs + n_) * 128 + 16 * kt + 4 * q_) = pk4(S[kt]); }
    if (MODE == 2) { bf16* MG = (bf16*)(ws + WS_MG) + (size_t)zhg * 16384;
#pragma unroll
        for (int kt = 0; kt < 8; ++kt)
#pragma unroll
            for (int e = 0; e < 4; ++e) MG[(size_t)(16 * kt + 4 * q_ + e) * 128 + 16 * vs + n_] = (bf16)f2bf(S[kt][e]); }
}
DI void dn_scan_groups(unsigned char* ws, int w  , int lane) {
    const int zh = w >> 3, vs = w & 7, n_ = lane & 15, q_ = lane >> 4;
    f32x4 S[8];
#pragma unroll
    for (int kt = 0; kt < 8; ++kt) S[kt] = (f32x4){0.f, 0.f, 0.f, 0.f};
    for (int g = 0; g < 16; ++g) {
        const size_t zhg = (size_t)(zh * 16 + g) * 16384;
        bf16* SG = (bf16*)(ws + WS_SG) + zhg; const bf16* MG = (const bf16*)(ws + WS_MG) + zhg; const bf16* NG = (const bf16*)(ws + WS_NG) + zhg;
#pragma unroll
        for (int kt = 0; kt < 8; ++kt) *(unsigned long long*)(SG + (size_t)(16 * vs + n_) * 128 + 16 * kt + 4 * q_) = pk4(S[kt]);
        if (g == 15) break;
        s16x8 bb[4];
#pragma unroll
        for (int ks = 0; ks < 4; ++ks) bb[ks] = pack_cpair(S[2 * ks], S[2 * ks + 1]);
#pragma unroll
        for (int kt = 0; kt < 8; ++kt) { f32x4 acc = unpk4(*(const unsigned long long*)(NG + (size_t)(16 * vs + n_) * 128 + 16 * kt + 4 * q_));
#pragma unroll
            for (int ks = 0; ks < 4; ++ks) { const bf16* row = MG + (size_t)(16 * kt + n_) * 128 + 32 * ks + 4 * q_;
                const unsigned long long a0 = *(const unsigned long long*)row, a1 = *(const unsigned long long*)(row + 16);
                v4u a; a.x = (unsigned)a0; a.y = (unsigned)(a0 >> 32); a.z = (unsigned)a1; a.w = (unsigned)(a1 >> 32);
                acc = mfma16(__builtin_bit_cast(s16x8, a), bb[ks], acc); }
            S[kt] = acc; }
    }
}
DI void prep1_token(const Args& a, unsigned char* ws, int t, int lane) {
    const bf16* P = (const bf16*)(ws + WS_PROJ1) + (size_t)t * ODD_PAD;
    const int c0 = 8 * lane; const bool hp = t > 0, hn = t < S_ - 1;
    float z8[8];
#pragma unroll
    for (int i = 0; i < 8; ++i) z8[i] = 0.f;
    {
        float cb[8], cc[8], cx[8], pc[8], px[8], nc[8], nx[8], w0[8], w1[8], w2[8], o[8];
        ld8(P + c0, cb); ld8(P + 512 + c0, cc); ld8(P + 1024 + c0, cx);
        if (hp) { ld8(P - ODD_PAD + 512 + c0, pc); ld8(P - ODD_PAD + 1024 + c0, px); } else {
#pragma unroll
            for (int i = 0; i < 8; ++i) { pc[i] = 0.f; px[i] = 0.f; } }
        if (hn) { ld8(P + ODD_PAD + 512 + c0, nc); ld8(P + ODD_PAD + 1024 + c0, nx); } else {
#pragma unroll
            for (int i = 0; i < 8; ++i) { nc[i] = 0.f; nx[i] = 0.f; } }
        ld8f(a.in[28] + c0, w0); ld8f(a.in[28] + 512 + c0, w1); ld8f(a.in[28] + 1024 + c0, w2);
#pragma unroll
        for (int i = 0; i < 8; ++i) o[i] = cb[i] * (w0[i] * pc[i] * px[i] + w1[i] * cc[i] * cx[i] + w2[i] * nc[i] * nx[i]);
        st8((bf16*)(ws + WS_YCAT1) + (size_t)t * D_ + c0, o);
    }
#pragma unroll
    for (int part = 0; part < 3; ++part) {
        float cu[8], pv[8], nx[8], w0[8], w1[8], w2[8], o[8];
        const int col = 1536 + part * 512 + c0;
        ld8(P + col, cu);
        if (hp) ld8(P - ODD_PAD + col, pv); else {
#pragma unroll
            for (int i = 0; i < 8; ++i) pv[i] = 0.f; }
        if (hn) ld8(P + ODD_PAD + col, nx); else {
#pragma unroll
            for (int i = 0; i < 8; ++i) nx[i] = 0.f; }
        const float* cw = a.in[29] + part * 512 + c0;
        ld8f(cw, w0); ld8f(cw + 1536, w1); ld8f(cw + 3072, w2);
        float ss = 0.f;
#pragma unroll
        for (int i = 0; i < 8; ++i) { o[i] = siluf_(w0[i] * pv[i] + w1[i] * cu[i] + w2[i] * nx[i]); ss += o[i] * o[i]; }
        if (part < 2) { ss = grp_sum<16>(ss); const float rn = (1.0f / sqrtf(ss + 1e-6f)) * (part == 0 ? 0.08838834764831845f : 1.0f);
#pragma unroll
            for (int i = 0; i < 8; ++i) o[i] *= rn; }
        st8((bf16*)(ws + (part == 0 ? WS_QD : (part == 1 ? WS_KD : WS_VD))) + (size_t)t * 512 + c0, o);
    }
    *(v4u*)((bf16*)(ws + WS_YCAT1) + (size_t)t * D_ + 512 + c0) = *(const v4u*)(P + 3072 + c0);
    if (lane < 8) {
        const float bt = sigmoidf_(bf2f(P[3584 + lane])); const float al = bf2f(P[3592 + lane]);
        const float g = -__expf(a.in[30][lane]) * softplusf_(al + a.in[31][lane]);
        ((float*)(ws + WS_GB))[(size_t)t * 8 + lane] = g; ((float*)(ws + WS_GB + 512 * 1024))[(size_t)t * 8 + lane] = bt;
    }
}
DI void dn_scan_naive(unsigned char* ws, int w  , int lane) {
    const int z = w >> 9, h = (w >> 7) & 3, vc = w & 127;
    const bf16* Q = (const bf16*)(ws + WS_QD); const bf16* K = (const bf16*)(ws + WS_KD); const bf16* V = (const bf16*)(ws + WS_VD);
    const float* G = (const float*)(ws + WS_GB); const float* Bt = (const float*)(ws + WS_GB + 512 * 1024);
    bf16* O = (bf16*)(ws + (z ? WS_O1 : WS_O0));
    float s0 = 0.f, s1 = 0.f;
    int t = z ? S_ - 1 : 0; const int dt = z ? -1 : 1;
    size_t o = (size_t)t * 512 + h * 128;
    float k0 = bf2f(K[o + lane]), k1 = bf2f(K[o + 64 + lane]), q0 = bf2f(Q[o + lane]), q1 = bf2f(Q[o + 64 + lane]), vv = bf2f(V[o + vc]), g = G[(size_t)t * 8 + z * 4 + h], bt = Bt[(size_t)t * 8 + z * 4 + h];
    for (int s = 0; s < S_; ++s) {
        const int tn = (s + 1 < S_) ? t + dt : t; const size_t on = (size_t)tn * 512 + h * 128;
        const float k0n = bf2f(K[on + lane]), k1n = bf2f(K[on + 64 + lane]), q0n = bf2f(Q[on + lane]), q1n = bf2f(Q[on + 64 + lane]), vvn = bf2f(V[on + vc]), gn = G[(size_t)tn * 8 + z * 4 + h], btn = Bt[(size_t)tn * 8 + z * 4 + h];
        const float eg = __expf(g);
        const float dot = wave_sum(k0 * s0 + k1 * s1);
        const float cf = bt * (vv - eg * dot);
        s0 = eg * s0 + cf * k0; s1 = eg * s1 + cf * k1;
        const float ov = wave_sum(q0 * s0 + q1 * s1);
        if (lane == 0) O[(size_t)t * 512 + h * 128 + vc] = (bf16)f2bf(ov);
        k0 = k0n; k1 = k1n; q0 = q0n; q1 = q1n; vv = vvn; g = gn; bt = btn; t = tn;
    }
}
DI void dn_post_token(const Args& a, unsigned char* ws, int t, int lane) {
    const int c0 = 8 * lane; const size_t o = (size_t)t * 512 + c0;
    float o0[8], o1[8], zz[8], nw[8];
    ld8((const bf16*)(ws + WS_O0) + o, o0); ld8((const bf16*)(ws + WS_O1) + o, o1);
    ld8((const bf16*)(ws + WS_YCAT1) + (size_t)t * D_ + 512 + c0, zz); ld8f(a.in[32] + (c0 & 127), nw);
    float ss = 0.f;
#pragma unroll
    for (int i = 0; i < 8; ++i) { o0[i] += o1[i]; ss += o0[i] * o0[i]; }
    const float rs = 1.0f / sqrtf(grp_sum<16>(ss) * (1.0f / 128.f) + 1e-6f);
#pragma unroll
    for (int i = 0; i < 8; ++i) o0[i] = o0[i] * rs * nw[i] * siluf_(zz[i]);
    st8((bf16*)(ws + WS_YCAT1) + (size_t)t * D_ + 512 + c0, o0);
}
struct TokInfo { int e1, e2, s1, s2; float p1, p2; int pad0, pad1; };
struct RouterRegs { f32x4 r0[16], r1[16]; f32x4 w[4]; };
DI void route_load(const Args& a, RouterRegs& R, int lane) {
#pragma unroll
    for (int j = 0; j < 4; ++j) { R.w[j] = ((const f32x4*)a.in[34])[lane + 64 * j];
#pragma unroll
        for (int i = 0; i < 4; ++i) { const float* rr = a.in[35] + (size_t)(4 * lane + 256 * j + i) * 8; R.r0[4 * j + i] = *(const f32x4*)rr; R.r1[4 * j + i] = *(const f32x4*)(rr + 4); } }
}
constexpr size_t WS_BC = WS_TILE + 4096;
DI int sel8(const int (&v)[8], int e) { int r = 0;
#pragma unroll
    for (int k = 0; k < 8; ++k) r += v[k] & -(int)(e == k);
    return r; }
DI int wave_isum(int v) {
#pragma unroll
    for (int o = 1; o < 64; o <<= 1) v += __shfl_xor(v, o);
    return v; }
DI void route_eval(const RouterRegs& R, const float* x3, int t, int lane, int& e1, int& e2, float& p1, float& p2) {
    f32x4 v[4]; load_row(x3, t, lane, v); const float rs = row_rstd(v);
    float lg[8];
#pragma unroll
    for (int e = 0; e < 8; ++e) lg[e] = 0.f;
#pragma unroll
    for (int j = 0; j < 4; ++j)
#pragma unroll
        for (int i = 0; i < 4; ++i) { const float hv = v[j][i] * rs * R.w[j][i]; const f32x4 r0 = R.r0[4 * j + i], r1 = R.r1[4 * j + i];
            lg[0] += hv * r0.x; lg[1] += hv * r0.y; lg[2] += hv * r0.z; lg[3] += hv * r0.w; lg[4] += hv * r1.x; lg[5] += hv * r1.y; lg[6] += hv * r1.z; lg[7] += hv * r1.w; }
#pragma unroll
    for (int e = 0; e < 8; ++e) lg[e] = wave_sum(lg[e]);
    e1 = 0; float m1 = lg[0];
#pragma unroll
    for (int e = 1; e < 8; ++e) if (lg[e] > m1) { m1 = lg[e]; e1 = e; }
    e2 = -1; float m2 = -3.0e38f;
#pragma unroll
    for (int e = 0; e < 8; ++e) if (e != e1 && lg[e] > m2) { m2 = lg[e]; e2 = e; }
    const float x2 = __expf(m2 - m1); p1 = 1.0f / (1.0f + x2); p2 = x2 / (1.0f + x2);
}
DI void route_group(const RouterRegs& R, unsigned char* ws, const float* x3, LAS int* wc, int tg, int wave, int lane) {
    int cw[8];
#pragma unroll
    for (int e = 0; e < 8; ++e) cw[e] = 0;
    TokInfo* TI = (TokInfo*)(ws + WS_TOK) + (size_t)tg * 64 + wave * 8;
#pragma unroll 1
    for (int i = 0; i < 8; ++i) {
        int e1, e2; float p1, p2; route_eval(R, x3, tg * 64 + wave * 8 + i, lane, e1, e2, p1, p2);
        const int s1 = sel8(cw, e1);
#pragma unroll
        for (int e = 0; e < 8; ++e) cw[e] += (e == e1) ? 1 : 0;
        const int s2 = sel8(cw, e2);
#pragma unroll
        for (int e = 0; e < 8; ++e) cw[e] += (e == e2) ? 1 : 0;
        if (lane == 0) { v4u* rec = (v4u*)(TI + i); rec[0] = (v4u){(unsigned)e1, (unsigned)e2, (unsigned)s1, (unsigned)s2}; rec[1] = (v4u){__float_as_uint(p1), __float_as_uint(p2), 0u, 0u}; }
    }
    if (lane < 8) wc[wave * 8 + lane] = sel8(cw, lane);
    LDS_WAIT(); __syncthreads();
    int wb[8], bc[8];
#pragma unroll
    for (int e = 0; e < 8; ++e) { wb[e] = 0; bc[e] = 0;
#pragma unroll
        for (int w = 0; w < 8; ++w) { const int c = wc[w * 8 + e]; bc[e] += c; wb[e] += (w < wave) ? c : 0; } }
    if (wave == 0 && lane < 8) ((int*)(ws + WS_BC))[tg * 8 + lane] = sel8(bc, lane);
    if (lane < 8) { v4u* rec = (v4u*)(TI + lane); v4u r = rec[0]; r.z += (unsigned)sel8(wb, (int)r.x); r.w += (unsigned)sel8(wb, (int)r.y); rec[0] = r; }
    LDS_WAIT(); __syncthreads();
}
DI void moe_totals(const unsigned char* ws, int lane, int (&tot)[8]) {
    const int* BC = (const int*)(ws + WS_BC); int part[8];
#pragma unroll
    for (int e = 0; e < 8; ++e) part[e] = 0;
#pragma unroll
    for (int k = 0; k < 4; ++k) { const int r = lane + 64 * k;
#pragma unroll
        for (int e = 0; e < 8; ++e) part[e] += __hip_atomic_load(BC + r * 8 + e, __ATOMIC_RELAXED, __HIP_MEMORY_SCOPE_AGENT); }
#pragma unroll
    for (int e = 0; e < 8; ++e) tot[e] = __builtin_amdgcn_readfirstlane(wave_isum(part[e]));
}
DI void moe_offsets(const int (&tot)[8], int (&off)[9]) { int o = 0;
#pragma unroll
    for (int e = 0; e < 8; ++e) { off[e] = o; o += (tot[e] + 255) & ~255; }
    off[8] = o; }
DI void gather_group(const Args& a, unsigned char* ws, const float* x3, const int (&off)[9], int tg, int wave, int lane) {
    const int* BC = (const int*)(ws + WS_BC); int pre[8];
#pragma unroll
    for (int e = 0; e < 8; ++e) pre[e] = 0;
#pragma unroll
    for (int k = 0; k < 4; ++k) { const int r = lane + 64 * k;
#pragma unroll
        for (int e = 0; e < 8; ++e) { const int c = __hip_atomic_load(BC + r * 8 + e, __ATOMIC_RELAXED, __HIP_MEMORY_SCOPE_AGENT); pre[e] += (r < tg) ? c : 0; } }
#pragma unroll
    for (int e = 0; e < 8; ++e) pre[e] = __builtin_amdgcn_readfirstlane(wave_isum(pre[e])) + off[e];
    TokInfo* TI = (TokInfo*)(ws + WS_TOK) + (size_t)tg * 64 + wave * 8;
    bf16* A = (bf16*)(ws + WS_AMOE);
#pragma unroll 1
    for (int i = 0; i < 8; ++i) { const int t = tg * 64 + wave * 8 + i;
        f32x4 v[4]; load_row(x3, t, lane, v); const float rs = row_rstd(v);
#pragma unroll
        for (int j = 0; j < 4; ++j) v[j] = v[j] * rs * ((const f32x4*)a.in[34])[lane + 64 * j];
        v4u* rec = (v4u*)(TI + i); v4u r = rec[0];
        const int r1 = sel8(pre, (int)r.x) + (int)r.z, r2 = sel8(pre, (int)r.y) + (int)r.w;
        store_row_bf16(A + (size_t)r1 * D_, lane, v); store_row_bf16(A + (size_t)r2 * D_, lane, v);
        if (lane == 0) { r.z = (unsigned)r1; r.w = (unsigned)r2; rec[0] = r; }
    }
}
DI void combine_token(unsigned char* ws, float* out, const int (&off)[9], int t, int lane) {
    const v4u* rec = (const v4u*)((const TokInfo*)(ws + WS_TOK) + t); const v4u ra = rec[0], rb = rec[1];
    struct { float p1, p2; } ti; ti.p1 = __uint_as_float(rb.x); ti.p2 = __uint_as_float(rb.y);
    const bf16* A = (const bf16*)(ws + WS_AMOE);
    const unsigned long long* r1 = (const unsigned long long*)(A + (size_t)ra.z * D_) + lane; const unsigned long long* r2 = (const unsigned long long*)(A + (size_t)ra.w * D_) + lane;
    f32x4* xo = (f32x4*)(out + (size_t)t * D_) + lane;
#pragma unroll
    for (int j = 0; j < 4; ++j) { const unsigned long long a1 = r1[64 * j], a2 = r2[64 * j]; f32x4 x = xo[64 * j];
        x.x += ti.p1 * bflo((unsigned)a1) + ti.p2 * bflo((unsigned)a2); x.y += ti.p1 * bfhi((unsigned)a1) + ti.p2 * bfhi((unsigned)a2);
        x.z += ti.p1 * bflo((unsigned)(a1 >> 32)) + ti.p2 * bflo((unsigned)(a2 >> 32)); x.w += ti.p1 * bfhi((unsigned)(a1 >> 32)) + ti.p2 * bfhi((unsigned)(a2 >> 32));
        xo[64 * j] = x; }
}
#ifndef PROBE
#define PROBE 0
#endif
#ifndef PROBE_REP
#define PROBE_REP (-1)
#endif
#ifndef PH_MASK
#define PH_MASK 0xFFFFFFFFu
#endif
DI unsigned char* ptr_opaque(unsigned char* p) { GAS unsigned char* g = (GAS unsigned char*)p; asm volatile("" : "+s"(g)); return (unsigned char*)g; }
DI int lane_opaque() { int l; asm volatile("v_mbcnt_lo_u32_b32 %0, -1, 0\n\tv_mbcnt_hi_u32_b32 %0, -1, %0" : "=v"(l)); return l; }
__global__ void __launch_bounds__(512, 2) fwd_kernel(Args args) {
    extern __shared__ __attribute__((aligned(16))) unsigned char lds[];
    LAS unsigned char* L = (LAS unsigned char*)lds;
    volatile LAS unsigned* MISC = (volatile LAS unsigned*)(L + MISC_OFF);
    const int tid = threadIdx.x, lane0 = tid & 63, wave = __builtin_amdgcn_readfirstlane(tid >> 6);
    const int G = gridDim.x, bx = blockIdx.x;
    const int gw = bx * 8 + wave, NGW = G * 8;
    unsigned char* ws0 = args.ws;
    if (tid < 128) ((LAS unsigned*)(L + LDS_ZERO_OFF))[tid] = 0u;
    __syncthreads();
    XcdBarrier bar = xcd_barrier_post((unsigned*)(ws0 + WS_CTL) + CW_BAR, MISC + 8);
    LAS float* scr = (LAS float*)(L + wave * 16384);
#if PROBE
    int tsi = 0;
#define GRID_BAR() do { xcd_barrier(bar, wave == 0); if (bx == 0 && tid == 0) { ((unsigned*)(ws0 + WS_CTL))[512 + tsi] = (unsigned)__builtin_amdgcn_s_memrealtime(); } ++tsi; } while (0)
    if (bx == 0 && tid == 0) ((unsigned*)(ws0 + WS_CTL))[511] = (unsigned)__builtin_amdgcn_s_memrealtime();
#else
#define GRID_BAR() xcd_barrier(bar, wave == 0)
#endif

    if constexpr ((PH_MASK >> 0) & 1) {
    const int lane = lane_opaque(); unsigned char* const ws = ptr_opaque(args.ws);
    {
        const float* const* in = args.in;
        for (int it = gw; ; it += NGW) {
            int r = it;
            if (transpose_job(r, in[3], 1024, 3072, 3072, (bf16*)(ws + WS_WIN0), 0, 0, 0, scr, lane)) continue;
            if (transpose_job(r, in[9], 1024, 64, 64, (bf16*)(ws + WS_WL), 0, 0, 0, scr, lane)) continue;
            if (transpose_job(r, in[9] + 65536, 1024, 64, 64, (bf16*)(ws + WS_WL), 64, 0, 0, scr, lane)) continue;
            if (transpose_job(r, in[12], 1024, 64, 64, (bf16*)(ws + WS_WL), 128, 0, 0, scr, lane)) continue;
            if (transpose_job(r, in[12] + 65536, 1024, 64, 64, (bf16*)(ws + WS_WL), 192, 0, 0, scr, lane)) continue;
            if (transpose_job(r, in[14], 1024, 128, 256, (bf16*)(ws + WS_WL), 256, 0, 0, scr, lane)) continue;
            if (transpose_job(r, in[21], 1024, 1024, 1024, (bf16*)(ws + WS_WOUT0), 0, 0, 0, scr, lane)) continue;
            if (transpose_job(r, in[10], 64, 512, 512, (bf16*)(ws + WS_W2T), 0, 0, 0, scr, lane)) continue;
            if (transpose_job(r, in[10] + 32768, 64, 512, 512, (bf16*)(ws + WS_W2T) + 32768, 0, 0, 0, scr, lane)) continue;
            if (transpose_job(r, in[13], 64, 512, 512, (bf16*)(ws + WS_W2T) + 65536, 0, 0, 0, scr, lane)) continue;
            if (transpose_job(r, in[13] + 32768, 64, 512, 512, (bf16*)(ws + WS_W2T) + 98304, 0, 0, 0, scr, lane)) continue;
            if (transpose_job(r, in[15], 128, 512, 512, (bf16*)(ws + WS_W2T) + 131072, 0, 0, 0, scr, lane)) continue;
            break;
        }
        norm_rows(args.in[0], args.in[2], args.in[7], (bf16*)(ws + WS_H), (bf16*)(ws + WS_HX), gw, NGW, lane);
    }
    if constexpr (PROBE_REP == 0) {
    {
        const float* const* in = args.in;
        for (int it = gw; ; it += NGW) {
            int r = it;
            if (transpose_job(r, in[3], 1024, 3072, 3072, (bf16*)(ws + WS_WIN0), 0, 0, 0, scr, lane)) continue;
            if (transpose_job(r, in[9], 1024, 64, 64, (bf16*)(ws + WS_WL), 0, 0, 0, scr, lane)) continue;
            if (transpose_job(r, in[9] + 65536, 1024, 64, 64, (bf16*)(ws + WS_WL), 64, 0, 0, scr, lane)) continue;
            if (transpose_job(r, in[12], 1024, 64, 64, (bf16*)(ws + WS_WL), 128, 0, 0, scr, lane)) continue;
            if (transpose_job(r, in[12] + 65536, 1024, 64, 64, (bf16*)(ws + WS_WL), 192, 0, 0, scr, lane)) continue;
            if (transpose_job(r, in[14], 1024, 128, 256, (bf16*)(ws + WS_WL), 256, 0, 0, scr, lane)) continue;
            if (transpose_job(r, in[21], 1024, 1024, 1024, (bf16*)(ws + WS_WOUT0), 0, 0, 0, scr, lane)) continue;
            if (transpose_job(r, in[10], 64, 512, 512, (bf16*)(ws + WS_W2T), 0, 0, 0, scr, lane)) continue;
            if (transpose_job(r, in[10] + 32768, 64, 512, 512, (bf16*)(ws + WS_W2T) + 32768, 0, 0, 0, scr, lane)) continue;
            if (transpose_job(r, in[13], 64, 512, 512, (bf16*)(ws + WS_W2T) + 65536, 0, 0, 0, scr, lane)) continue;
            if (transpose_job(r, in[13] + 32768, 64, 512, 512, (bf16*)(ws + WS_W2T) + 98304, 0, 0, 0, scr, lane)) continue;
            if (transpose_job(r, in[15], 128, 512, 512, (bf16*)(ws + WS_W2T) + 131072, 0, 0, 0, scr, lane)) continue;
            break;
        }
        norm_rows(args.in[0], args.in[2], args.in[7], (bf16*)(ws + WS_H), (bf16*)(ws + WS_HX), gw, NGW, lane);
    }
    }
    GRID_BAR();
    }
    if constexpr (PROBE_REP == 50) { for (int i = 0; i < 10; ++i) GRID_BAR(); }
    if constexpr ((PH_MASK >> 1) & 1) {
    const int lane = lane_opaque(); unsigned char* const ws = ptr_opaque(args.ws);
    {
        { pg8::Gemm g{(const bf16*)(ws + WS_H), (const bf16*)(ws + WS_WIN0), S_, EVEN_IN, D_}; pg8::StaticOrder S; S.init(S_, EVEN_IN, G, bx);
          pg8::EpiStoreBf16 E{(bf16*)(ws + WS_PROJ0), EVEN_IN, 0, nullptr}; pg8::gemm_phase<pg8::EpiStoreBf16, pg8::StaticOrder, true, true>(L, g, S, E, wave); }
        { pg8::Gemm g{(const bf16*)(ws + WS_HX), (const bf16*)(ws + WS_WL), S_, LORA_N, D_}; pg8::StaticOrder S; S.init(S_, LORA_N, G, bx);
          pg8::EpiStoreBf16 E{(bf16*)(ws + WS_LORA), LORA_N, 0, nullptr}; pg8::gemm_phase<pg8::EpiStoreBf16, pg8::StaticOrder, true, true>(L, g, S, E, wave); }
        if constexpr (PROBE_REP == 1) {
        { pg8::Gemm g{(const bf16*)(ws + WS_H), (const bf16*)(ws + WS_WIN0), S_, EVEN_IN, D_}; pg8::StaticOrder S; S.init(S_, EVEN_IN, G, bx);
          pg8::EpiStoreBf16 E{(bf16*)(ws + WS_PROJ0), EVEN_IN, 0, nullptr}; pg8::gemm_phase<pg8::EpiStoreBf16, pg8::StaticOrder, true, true>(L, g, S, E, wave); }
        { pg8::Gemm g{(const bf16*)(ws + WS_HX), (const bf16*)(ws + WS_WL), S_, LORA_N, D_}; pg8::StaticOrder S; S.init(S_, LORA_N, G, bx);
          pg8::EpiStoreBf16 E{(bf16*)(ws + WS_LORA), LORA_N, 0, nullptr}; pg8::gemm_phase<pg8::EpiStoreBf16, pg8::StaticOrder, true, true>(L, g, S, E, wave); }
        }
    }
    GRID_BAR();
    }
    if constexpr ((PH_MASK >> 2) & 1) {
    const int lane = lane_opaque(); unsigned char* const ws = ptr_opaque(args.ws);
    for (int t = gw; t < S_; t += NGW) prep0_token(args, ws, scr, t, lane);
    if constexpr (PROBE_REP == 30) { for (int t = gw; t < S_; t += NGW) prep0_token(args, ws, scr, t, lane); }
    {
        const int hh = bx & 7, nbh = (G - hh + 7) >> 3;
        const int lane = lane_opaque();
        prep0_stage_w2t(ws, L, hh, wave * 64 + lane);
        LDS_WAIT(); __syncthreads();
        for (int u = wave; ; u += 8) { const int cn = (bx >> 3) + nbh * (u >> 2); if (cn >= 256) break; prep0_rwkv_unit(args, ws, L, 4 * cn + (u & 3), hh, lane); }
        if constexpr (PROBE_REP == 31) { for (int u = wave; ; u += 8) { const int cn = (bx >> 3) + nbh * (u >> 2); if (cn >= 256) break; prep0_rwkv_unit(args, ws, L, 4 * cn + (u & 3), hh, lane); } }
        asm volatile("s_waitcnt vmcnt(0)" ::: "memory");
        __syncthreads();
    }
    }
    if constexpr ((PH_MASK >> 3) & 1) {
    const int lane = lane_opaque(); unsigned char* const ws = ptr_opaque(args.ws);
    {
        if constexpr (PROBE_REP == 40) { if (wave < 2) { for (int it = bx * 2 + wave; it < 4096; it += G * 2) rwkv_pass1_item<true>(ws, L + wave * 65536, it, lane); } }
        if constexpr (PROBE_REP >= 41 && PROBE_REP <= 47) { if (wave < 2) { for (int it = bx * 2 + wave; it < 4096; it += G * 2) rwkv_pass1_item<true, PROBE_REP - 40>(ws, L + wave * 65536, it, lane); } }
        if (wave < 2) { const int hh = bx & 7, nbh = (G - hh + 7) >> 3;
            for (int u = wave; ; u += 2) { const int cn = (bx >> 3) + nbh * (u >> 1); if (cn >= 256) break; const int z = u & 1;
                rwkv_pass1_item(ws, L + wave * 65536, z * 2048 + hh * 256 + (z ? 255 - cn : cn), lane); } }
        else if (wave < 4) {
            const float* const* in = args.in; LAS float* scr2 = (LAS float*)(L + 131072 + (wave - 2) * 8448);
            for (int it = bx * 2 + (wave - 2); ; it += G * 2) {
                int r = it;
                if (transpose_job(r, in[23], 1024, FF0, FF0, (bf16*)(ws + WS_WGU0), 0, 128, 0, scr2, lane)) continue;
                if (transpose_job(r, in[24], 1024, FF0, FF0, (bf16*)(ws + WS_WGU0), 0, 128, 1, scr2, lane)) continue;
                if (transpose_job(r, in[25], FF0, 1024, 1024, (bf16*)(ws + WS_WD0), 0, 0, 0, scr2, lane)) continue;
                if (transpose_job(r, in[27], 1024, ODD_IN, ODD_PAD, (bf16*)(ws + WS_WIN1), 0, 0, 0, scr2, lane)) continue;
                if (transpose_job(r, in[33], 1024, 1024, 1024, (bf16*)(ws + WS_WOUT1), 0, 0, 0, scr2, lane)) continue;
                break;
            }
        }
    }
    GRID_BAR();
    if (bx < 16) { rwkv_pass2_block(ws, L, bx, wave, lane); __syncthreads(); if constexpr (PROBE_REP == 4) { rwkv_pass2_block(ws, L, bx, wave, lane); __syncthreads(); } }
    else { for (int rep_ = 0; rep_ < (PROBE_REP == 3 ? 2 : 1); ++rep_) for (int unit = bx - 16; unit < 512; unit += G - 16) attn_unit(ws, L, unit, wave, lane); }
    GRID_BAR();
    for (int it = gw; it < 2048; it += NGW) rwkv_pass3_post_item(args, ws, it, lane);
    if constexpr (PROBE_REP == 63) { for (int it = gw; it < 2048; it += NGW) rwkv_pass3_post_item(args, ws, it, lane); }
    GRID_BAR();
    }
    if constexpr ((PH_MASK >> 5) & 1) {
    const int lane = lane_opaque(); unsigned char* const ws = ptr_opaque(args.ws);
    { pg8::Gemm g{(const bf16*)(ws + WS_Y), (const bf16*)(ws + WS_WOUT0), S_, D_, D_}; pg8::StaticOrder S; S.init(S_, D_, G, bx);
      pg8::EpiResF32 E{args.in[0], args.out, D_, nullptr, nullptr}; pg8::gemm_phase<pg8::EpiResF32, pg8::StaticOrder, true, true>(L, g, S, E, wave); }
    if constexpr (PROBE_REP == 7) {
    { pg8::Gemm g{(const bf16*)(ws + WS_Y), (const bf16*)(ws + WS_WOUT0), S_, D_, D_}; pg8::StaticOrder S; S.init(S_, D_, G, bx);
      pg8::EpiResF32 E{args.in[0], args.out, D_, nullptr, nullptr}; pg8::gemm_phase<pg8::EpiResF32, pg8::StaticOrder, true, true>(L, g, S, E, wave); }
    }
    GRID_BAR();
    }
    if constexpr ((PH_MASK >> 6) & 1) {
    const int lane = lane_opaque(); unsigned char* const ws = ptr_opaque(args.ws);
    norm_rows(args.out, args.in[22], nullptr, (bf16*)(ws + WS_H2), nullptr, gw, NGW, lane);
    GRID_BAR();
    }
    if constexpr ((PH_MASK >> 7) & 1) {
    const int lane = lane_opaque(); unsigned char* const ws = ptr_opaque(args.ws);
    { pg8::Gemm g{(const bf16*)(ws + WS_H2), (const bf16*)(ws + WS_WGU0), S_, 2 * FF0, D_}; pg8::StaticOrder S; S.init(S_, 2 * FF0, G, bx);
      pg8::EpiSwiGLU E{(bf16*)(ws + WS_ACT0), FF0, 0, nullptr}; pg8::gemm_phase<pg8::EpiSwiGLU, pg8::StaticOrder, true, true>(L, g, S, E, wave); }
    if constexpr (PROBE_REP == 9) {
    { pg8::Gemm g{(const bf16*)(ws + WS_H2), (const bf16*)(ws + WS_WGU0), S_, 2 * FF0, D_}; pg8::StaticOrder S; S.init(S_, 2 * FF0, G, bx);
      pg8::EpiSwiGLU E{(bf16*)(ws + WS_ACT0), FF0, 0, nullptr}; pg8::gemm_phase<pg8::EpiSwiGLU, pg8::StaticOrder, true, true>(L, g, S, E, wave); }
    }
    GRID_BAR();
    }
    if constexpr ((PH_MASK >> 8) & 1) {
    const int lane = lane_opaque(); unsigned char* const ws = ptr_opaque(args.ws);
    { pg8::Gemm g{(const bf16*)(ws + WS_ACT0), (const bf16*)(ws + WS_WD0), S_, D_, FF0}; pg8::StaticOrder S; S.init(S_, D_, G, bx);
      pg8::EpiResF32 E{args.out, args.out, D_, nullptr, nullptr}; pg8::gemm_phase<pg8::EpiResF32, pg8::StaticOrder, true, true>(L, g, S, E, wave); }
    GRID_BAR();
    }
    if constexpr ((PH_MASK >> 9) & 1) {
    const int lane = lane_opaque(); unsigned char* const ws = ptr_opaque(args.ws);
    norm_rows(args.out, args.in[26], nullptr, (bf16*)(ws + WS_H3), nullptr, gw, NGW, lane);
    GRID_BAR();
    }
    if constexpr ((PH_MASK >> 10) & 1) {
    const int lane = lane_opaque(); unsigned char* const ws = ptr_opaque(args.ws);
    { pg8::Gemm g{(const bf16*)(ws + WS_H3), (const bf16*)(ws + WS_WIN1), S_, ODD_PAD, D_}; pg8::StaticOrder S; S.init(S_, ODD_PAD, G, bx);
      pg8::EpiStoreBf16 E{(bf16*)(ws + WS_PROJ1), ODD_PAD, 0, nullptr}; pg8::gemm_phase<pg8::EpiStoreBf16, pg8::StaticOrder, true, true>(L, g, S, E, wave); }
    if constexpr (PROBE_REP == 12) {
    { pg8::Gemm g{(const bf16*)(ws + WS_H3), (const bf16*)(ws + WS_WIN1), S_, ODD_PAD, D_}; pg8::StaticOrder S; S.init(S_, ODD_PAD, G, bx);
      pg8::EpiStoreBf16 E{(bf16*)(ws + WS_PROJ1), ODD_PAD, 0, nullptr}; pg8::gemm_phase<pg8::EpiStoreBf16, pg8::StaticOrder, true, true>(L, g, S, E, wave); }
    }
    GRID_BAR();
    }
    if constexpr ((PH_MASK >> 11) & 1) {
    const int lane = lane_opaque(); unsigned char* const ws = ptr_opaque(args.ws);
    for (int cn = bx; cn < 256; cn += G) for (int i = wave; i < 64; i += 8) prep1_token(args, ws, cn * 64 + i, lane);
    GRID_BAR();
    }
    if constexpr ((PH_MASK >> 12) & 1) {
    const int lane = lane_opaque(); unsigned char* const ws = ptr_opaque(args.ws);
    {
        if (wave < 2) { const int z = wave;
            for (int cn = bx; cn < 256; cn += G) for (int hh = 0; hh < 4; ++hh) dn_pass1_item(ws, L + wave * DN_LDS_PER_WAVE, (z * 4 + hh) * 256 + (z ? 255 - cn : cn), lane); }
        else {
            LAS float* scr2 = (LAS float*)(L + 2 * DN_LDS_PER_WAVE + (wave - 2) * 8448);
            for (int it = bx * 6 + (wave - 2); ; it += G * 6) {
                int r = it; bool did = false;
                for (int e = 0; e < NEXP; ++e) {
                    if (transpose_job(r, args.in[36] + (size_t)e * 1024 * FFE, 1024, FFE, FFE, (bf16*)(ws + WS_WMGU) + (size_t)e * 2 * FFE * 1024, 0, 128, 0, scr2, lane)) { did = true; break; }
                    if (transpose_job(r, args.in[37] + (size_t)e * 1024 * FFE, 1024, FFE, FFE, (bf16*)(ws + WS_WMGU) + (size_t)e * 2 * FFE * 1024, 0, 128, 1, scr2, lane)) { did = true; break; }
                }
                if (!did) break;
            }
        }
    }
    GRID_BAR();
    { const int task = bx; if (task < 512) dn_scan_block(ws, L, task >> 8, (task & 3) < 2 ? 1 : 2, (task >> 6) & 3, task & 1, (task >> 2) & 15, wave, lane); __syncthreads(); }
    { const int task = bx + G; if (task < 512) dn_scan_block(ws, L, task >> 8, (task & 3) < 2 ? 1 : 2, (task >> 6) & 3, task & 1, (task >> 2) & 15, wave, lane); __syncthreads(); }
    if constexpr (PROBE_REP == 60) { { const int task = bx; if (task < 512) dn_scan_block(ws, L, task >> 8, (task & 3) < 2 ? 1 : 2, (task >> 6) & 3, task & 1, (task >> 2) & 15, wave, lane); __syncthreads(); }
      { const int task = bx + G; if (task < 512) dn_scan_block(ws, L, task >> 8, (task & 3) < 2 ? 1 : 2, (task >> 6) & 3, task & 1, (task >> 2) & 15, wave, lane); __syncthreads(); } }
    GRID_BAR();
    if (bx < 64) { if (wave == 0) dn_scan_groups(ws, bx, lane); }
    if constexpr (PROBE_REP == 61) { if (bx < 64) { if (wave == 0) dn_scan_groups(ws, bx, lane); } }
    GRID_BAR();
    { const int task = bx; if (task < 256) dn_scan_block(ws, L, task >> 7, 0, (task >> 5) & 3, (task >> 4) & 1, task & 15, wave, lane); __syncthreads(); }
    if constexpr (PROBE_REP == 62) { const int task = bx; if (task < 256) dn_scan_block(ws, L, task >> 7, 0, (task >> 5) & 3, (task >> 4) & 1, task & 15, wave, lane); __syncthreads(); }
    GRID_BAR();
for (int rep_ = 0; rep_ < (PROBE_REP == 16 ? 2 : 1); ++rep_) {     for (int it = gw; it < 2048; it += NGW) dn_pass3_item(ws, it, lane); }
    GRID_BAR();
    }
    if constexpr ((PH_MASK >> 13) & 1) {
    const int lane = lane_opaque(); unsigned char* const ws = ptr_opaque(args.ws);
    for (int t = gw; t < S_; t += NGW) dn_post_token(args, ws, t, lane);
    for (int it = gw; ; it += NGW) {
        int r = it; bool did = false;
        for (int e = 0; e < NEXP; ++e)
            if (transpose_job(r, args.in[38] + (size_t)e * 1024 * FFE, FFE, 1024, 1024, (bf16*)(ws + WS_WMD) + (size_t)e * 1024 * FFE, 0, 0, 0, scr, lane)) { did = true; break; }
        if (!did) break;
    }
    GRID_BAR();
    }
    if constexpr ((PH_MASK >> 14) & 1) {
    const int lane = lane_opaque(); unsigned char* const ws = ptr_opaque(args.ws);
    { pg8::Gemm g{(const bf16*)(ws + WS_YCAT1), (const bf16*)(ws + WS_WOUT1), S_, D_, D_}; pg8::StaticOrder S; S.init(S_, D_, G, bx);
      pg8::EpiResF32 E{args.out, args.out, D_, nullptr, nullptr}; pg8::gemm_phase<pg8::EpiResF32, pg8::StaticOrder, true, true>(L, g, S, E, wave); }
    GRID_BAR();
    }
    if constexpr ((PH_MASK >> 15) & 1) {
    const int lane = lane_opaque(); unsigned char* const ws = ptr_opaque(args.ws);
    { RouterRegs RR; route_load(args, RR, lane); for (int tg = bx; tg < 256; tg += G) route_group(RR, ws, args.out, (LAS int*)L, tg, wave, lane); }
    GRID_BAR();
    }
    int tot[8], off[9]; moe_totals(ws0, lane_opaque(), tot); moe_offsets(tot, off);
    const int ntiles = off[8] >> 8;
    if constexpr ((PH_MASK >> 16) & 1) {
    const int lane = lane_opaque(); unsigned char* const ws = ptr_opaque(args.ws);
    {
        for (int tg = bx; tg < 256; tg += G) gather_group(args, ws, args.out, off, tg, wave, lane);
        const int tid2 = wave * 64 + lane;
        if (bx == 0 && tid2 < 160) { int e = 0;
#pragma unroll
            for (int k = 1; k < 8; ++k) if (tid2 * 256 >= off[k]) e = k;
            ((int*)(ws + WS_TILE))[tid2] = e; }
#pragma unroll
        for (int e = 0; e < NEXP; ++e) { const int r0 = off[e] + tot[e], r1 = off[e + 1];
            for (int rr = r0 + gw; rr < r1; rr += NGW) { unsigned long long* o8 = (unsigned long long*)((bf16*)(ws + WS_AMOE) + (size_t)rr * D_) + lane;
#pragma unroll
                for (int j = 0; j < 4; ++j) o8[64 * j] = 0ull; } }
    }
    if constexpr (PROBE_REP == 20) {
    {
        for (int tg = bx; tg < 256; tg += G) gather_group(args, ws, args.out, off, tg, wave, lane);
        const int tid2 = wave * 64 + lane;
        if (bx == 0 && tid2 < 160) { int e = 0;
#pragma unroll
            for (int k = 1; k < 8; ++k) if (tid2 * 256 >= off[k]) e = k;
            ((int*)(ws + WS_TILE))[tid2] = e; }
#pragma unroll
        for (int e = 0; e < NEXP; ++e) { const int r0 = off[e] + tot[e], r1 = off[e + 1];
            for (int rr = r0 + gw; rr < r1; rr += NGW) { unsigned long long* o8 = (unsigned long long*)((bf16*)(ws + WS_AMOE) + (size_t)rr * D_) + lane;
#pragma unroll
                for (int j = 0; j < 4; ++j) o8[64 * j] = 0ull; } }
    }
    }
    GRID_BAR();
    }
    if constexpr ((PH_MASK >> 17) & 1) {
    const int lane = lane_opaque(); unsigned char* const ws = ptr_opaque(args.ws);
    for (int b = 0; b < 3; ++b) {
        const int tlo = b * MOE_BATCH_TILES; int nt = ntiles - tlo; nt = nt < 0 ? 0 : (nt > MOE_BATCH_TILES ? MOE_BATCH_TILES : nt);
        { pg8::Gemm g{(const bf16*)(ws + WS_AMOE), (const bf16*)(ws + WS_WMGU), MOE_ROWS, NEXP * 2 * FFE, D_};
          pg8::MoeOrder S{(const int*)(ws + WS_TILE), tlo, nt, 2 * FFE / 256, G, bx};
          pg8::EpiSwiGLU E{(bf16*)(ws + WS_MACT) - (size_t)tlo * 256 * FFE, FFE, 2 * FFE / 256, nullptr};
          pg8::gemm_phase<pg8::EpiSwiGLU, pg8::MoeOrder, true, true>(L, g, S, E, wave); }
        if constexpr (PROBE_REP == 21) {
        { pg8::Gemm g{(const bf16*)(ws + WS_AMOE), (const bf16*)(ws + WS_WMGU), MOE_ROWS, NEXP * 2 * FFE, D_};
          pg8::MoeOrder S{(const int*)(ws + WS_TILE), tlo, nt, 2 * FFE / 256, G, bx};
          pg8::EpiSwiGLU E{(bf16*)(ws + WS_MACT) - (size_t)tlo * 256 * FFE, FFE, 2 * FFE / 256, nullptr};
          pg8::gemm_phase<pg8::EpiSwiGLU, pg8::MoeOrder, true, true>(L, g, S, E, wave); }
        }
        GRID_BAR();
        { pg8::Gemm g{(const bf16*)(ws + WS_MACT) - (size_t)tlo * 256 * FFE, (const bf16*)(ws + WS_WMD), MOE_ROWS, NEXP * D_, FFE};
          pg8::MoeOrder S{(const int*)(ws + WS_TILE), tlo, nt, D_ / 256, G, bx};
          pg8::EpiStoreBf16 E{(bf16*)(ws + WS_AMOE), D_, D_ / 256, nullptr};
          pg8::gemm_phase<pg8::EpiStoreBf16, pg8::MoeOrder, true, true>(L, g, S, E, wave); }
        if constexpr (PROBE_REP == 22) {
        { pg8::Gemm g{(const bf16*)(ws + WS_MACT) - (size_t)tlo * 256 * FFE, (const bf16*)(ws + WS_WMD), MOE_ROWS, NEXP * D_, FFE};
          pg8::MoeOrder S{(const int*)(ws + WS_TILE), tlo, nt, D_ / 256, G, bx};
          pg8::EpiStoreBf16 E{(bf16*)(ws + WS_AMOE), D_, D_ / 256, nullptr};
          pg8::gemm_phase<pg8::EpiStoreBf16, pg8::MoeOrder, true, true>(L, g, S, E, wave); }
        }
        GRID_BAR();
    }
    }
    if constexpr ((PH_MASK >> 18) & 1) {
    const int lane = lane_opaque(); unsigned char* const ws = ptr_opaque(args.ws);
    for (int t = gw; t < S_; t += NGW) combine_token(ws, args.out, off, t, lane);
#if PROBE
    {
        const unsigned* ts = (const unsigned*)(ws + WS_CTL) + 512;
        const unsigned dA = PROBE_A < 0 ? 32000u : (__hip_atomic_load(ts + PROBE_A, __ATOMIC_RELAXED, __HIP_MEMORY_SCOPE_AGENT) - __hip_atomic_load(ts + PROBE_A - 1, __ATOMIC_RELAXED, __HIP_MEMORY_SCOPE_AGENT));
        const unsigned dB = __hip_atomic_load(ts + PROBE_B, __ATOMIC_RELAXED, __HIP_MEMORY_SCOPE_AGENT) - __hip_atomic_load(ts + PROBE_B - 1, __ATOMIC_RELAXED, __HIP_MEMORY_SCOPE_AGENT);
        const int rows = 8 * (int)(dA / 3200u) + 64;
        const float addB = 4.0f * (float)(dB / 3200u) + 8.0f;
        for (int t = gw; t < S_; t += NGW) {
            if (t < rows) { f32x4* xo = (f32x4*)(args.out + (size_t)t * D_) + lane;
#pragma unroll
                for (int j = 0; j < 4; ++j) xo[64 * j] = xo[64 * j] + 5.0f; }
            if (t == S_ - 1 && lane == 63) args.out[(size_t)t * D_ + 1023] += addB;
        }
    }
#endif
    }
}

extern "C" void kernel_launch(void* const* d_in, const int* in_sizes, int n_in, void* d_out, int out_size, void* d_ws, size_t ws_size, hipStream_t stream) {
    static int grid = 0;
    if (grid == 0) {
        if (n_in != 39 || out_size != S_ * D_ || ws_size < WS_END) { fprintf(stderr, "kernel_launch: unexpected shapes (n_in %d out %d ws %zu)\n", n_in, out_size, ws_size); grid = -1; return; }
        int dev = 0, cus = 0, per_cu = 0;
        if (hipGetDevice(&dev) != hipSuccess || hipDeviceGetAttribute(&cus, hipDeviceAttributeMultiprocessorCount, dev) != hipSuccess) { grid = -1; return; }
        if (hipFuncSetAttribute((const void*)fwd_kernel, hipFuncAttributeMaxDynamicSharedMemorySize, LDS_BYTES) != hipSuccess) { grid = -1; return; }
        if (hipOccupancyMaxActiveBlocksPerMultiprocessor(&per_cu, (const void*)fwd_kernel, 512, LDS_BYTES) != hipSuccess || per_cu < 1) { fprintf(stderr, "kernel_launch: occupancy query says %d\n", per_cu); }
        (void)hipGetLastError();
        if (cus < 256) { fprintf(stderr, "kernel_launch: this build needs >= 256 CUs (task slots of the delta-net scan); got %d\n", cus); grid = -1; return; }
        grid = 256;
    }
    if (grid < 0) return;
    if (hipMemsetAsync((char*)d_ws + WS_CTL, 0, CTL_ZERO_BYTES, stream) != hipSuccess) return;
    Args a{};
    for (int i = 0; i < 39; ++i) a.in[i] = (const float*)d_in[i];
    a.out = (float*)d_out; a.ws = (unsigned char*)d_ws;
    hipLaunchKernelGGL(fwd_kernel, dim3(grid), dim3(512), LDS_BYTES, stream, a);
}
```

```cpp
#include <hip/hip_runtime.h>
#include <cstdio>
#include <cstdint>
namespace pg8 {
#define PG8_LAS __attribute__((address_space(3)))
typedef unsigned short bf16_t;
typedef short bf16x8 __attribute__((ext_vector_type(8)));
typedef float f32x4 __attribute__((ext_vector_type(4)));
typedef unsigned u32x4 __attribute__((ext_vector_type(4)));
constexpr int BM = 256, BK = 64, HALF = 128, HTB = HALF * BK * 2  , STAGE_BYTES = 8 * HTB, NXCD = 8, WGM = 8;

__host__ __device__ __forceinline__ int lds_byte(int r, int c) { const int st = (r >> 4) * 2 + (c >> 5), rr = r & 15, cc = c & 31, ob = rr * 64 + cc * 2; return st * 1024 + (ob ^ (((ob >> 9) & 1) << 5)); }
__host__ __device__ __forceinline__ void stage_rc(int b, int& R, int& C) { const int st = b / 1024, sb = b % 1024, swz = sb ^ (((sb >> 9) & 1) << 5); R = (st >> 1) * 16 + swz / 64; C = (st & 1) * 32 + (swz % 64) / 2; }
__host__ __device__ __forceinline__ int perm32(int rho) { const int n = rho >> 4, i = rho & 15; return 8 * (i >> 2) + 4 * n + (i & 3); }

struct Unit { int pm, pn; };
struct Gemm { const bf16_t* A; const bf16_t* Bt; int M, N, K; };

struct StaticOrder {
    int nM, nN, nwg, G, c;
    __host__ __device__ void init(int M, int N, int G_, int c_) { nM = M / BM; nN = N / BM; nwg = nM * nN; G = G_; c = c_; }
    __host__ __device__ bool next(int i, Unit& u) const {
        const long L = (long)i * G + c; if (L >= nwg) return false;
        int wgid = (int)L; { const int q = nwg / NXCD, r = nwg % NXCD, xcd = wgid % NXCD, off = wgid / NXCD; wgid = (xcd < r ? xcd * (q + 1) : r * (q + 1) + (xcd - r) * q) + off; }
        const int nig = WGM * nN, gid = wgid / nig, fm = gid * WGM, gsz = (nM - fm) < WGM ? (nM - fm) : WGM;
        u.pm = fm + ((wgid % nig) % gsz); u.pn = (wgid % nig) / gsz; return true;
    }
    __device__ __forceinline__ void a_ready(const Unit&) const {}
    __device__ __forceinline__ void done(const Unit&) const {}
};

__device__ __forceinline__ unsigned cvt_pk_bf16(float lo, float hi) { unsigned r; asm volatile("v_cvt_pk_bf16_f32 %0, %1, %2" : "=v"(r) : "v"(lo), "v"(hi)); return r; }
struct EpiStoreBf16 {
    static constexpr bool PERM = true, AFTER_DRAIN = false;
    bf16_t* O; int ldc; int ntn; const float* rowss;
    __device__ __forceinline__ void operator()(const f32x4 (&acc)[2][2][4][2], const Unit& u, int wr, int wc, int fr, int fq) const {
        const int row0 = u.pm * BM + wr * 64 + fr; const int pn = ntn ? (u.pn % ntn) : u.pn;
        const int col0 = pn * BM + wc * 32 + 8 * fq;
#pragma unroll
        for (int ai = 0; ai < 2; ++ai)
#pragma unroll
            for (int m = 0; m < 4; ++m) { bf16_t* rowp = O + (size_t)(row0 + ai * HALF + m * 16) * ldc + col0;
                float rs = 1.0f; if (rowss) { const f32x4* sp = (const f32x4*)(rowss + (size_t)(row0 + ai * HALF + m * 16) * 16); const f32x4 s0 = sp[0], s1 = sp[1], s2 = sp[2], s3 = sp[3]; const f32x4 st = (s0 + s1) + (s2 + s3); rs = 1.0f / sqrtf(((st[0] + st[1]) + (st[2] + st[3])) * (1.0f / 1024.f) + 1e-6f); }
#pragma unroll
                for (int bj = 0; bj < 2; ++bj) { const f32x4 v0 = acc[ai][bj][m][0] * rs, v1 = acc[ai][bj][m][1] * rs;
                    u32x4 w; w.x = cvt_pk_bf16(v0[0], v0[1]); w.y = cvt_pk_bf16(v0[2], v0[3]); w.z = cvt_pk_bf16(v1[0], v1[1]); w.w = cvt_pk_bf16(v1[2], v1[3]);
                    *(u32x4*)(rowp + bj * HALF) = w; } }
    }
};
struct EpiResF32 {
    static constexpr bool PERM = false, AFTER_DRAIN = false;
    const float* base; float* out; int ldc; bf16_t* xb; float* rowss;
    __device__ __forceinline__ void operator()(const f32x4 (&acc)[2][2][4][2], const Unit& u, int wr, int wc, int fr, int fq) const {
        const int row0 = u.pm * BM + wr * 64 + fr, col0 = u.pn * BM + wc * 32 + 4 * fq;
#pragma unroll
        for (int ai = 0; ai < 2; ++ai)
#pragma unroll
            for (int m = 0; m < 4; ++m) { const size_t off = (size_t)(row0 + ai * HALF + m * 16) * ldc + col0; float ss = 0.f;
#pragma unroll
                for (int bj = 0; bj < 2; ++bj)
#pragma unroll
                    for (int n = 0; n < 2; ++n) { const f32x4 b = *(const f32x4*)(base + off + bj * HALF + n * 16); const f32x4 o = b + acc[ai][bj][m][n]; *(f32x4*)(out + off + bj * HALF + n * 16) = o;
                        if (xb) { ss += (o[0] * o[0] + o[1] * o[1]) + (o[2] * o[2] + o[3] * o[3]);
                            unsigned long long w = (unsigned long long)cvt_pk_bf16(o[0], o[1]) | ((unsigned long long)cvt_pk_bf16(o[2], o[3]) << 32); *(unsigned long long*)(xb + off + bj * HALF + n * 16) = w; } }
                if (xb) { ss += __shfl_xor(ss, 16); ss += __shfl_xor(ss, 32); if (fq == 0) rowss[(size_t)(row0 + ai * HALF + m * 16) * 16 + u.pn * 4 + wc] = ss; } }
    }
};
struct EpiSwiGLU {
    static constexpr bool PERM = true, AFTER_DRAIN = false;
    bf16_t* O; int ldc; int ntn; const float* rowss;
    __device__ __forceinline__ void operator()(const f32x4 (&acc)[2][2][4][2], const Unit& u, int wr, int wc, int fr, int fq) const {
        const int row0 = u.pm * BM + wr * 64 + fr; const int pn = ntn ? (u.pn % ntn) : u.pn;
        const int col0 = pn * HALF + wc * 32 + 8 * fq;
#pragma unroll
        for (int ai = 0; ai < 2; ++ai)
#pragma unroll
            for (int m = 0; m < 4; ++m) { bf16_t* rowp = O + (size_t)(row0 + ai * HALF + m * 16) * ldc + col0;
                float rs = 1.0f; if (rowss) { const f32x4* sp = (const f32x4*)(rowss + (size_t)(row0 + ai * HALF + m * 16) * 16); const f32x4 s0 = sp[0], s1 = sp[1], s2 = sp[2], s3 = sp[3]; const f32x4 st = (s0 + s1) + (s2 + s3); rs = 1.0f / sqrtf(((st[0] + st[1]) + (st[2] + st[3])) * (1.0f / 1024.f) + 1e-6f); }
                float r[8];
#pragma unroll
                for (int n = 0; n < 2; ++n)
#pragma unroll
                    for (int i = 0; i < 4; ++i) { const float g = acc[ai][0][m][n][i] * rs, up = acc[ai][1][m][n][i] * rs; r[n * 4 + i] = g * __builtin_amdgcn_rcpf(1.0f + __expf(-g)) * up; }
                u32x4 w; w.x = cvt_pk_bf16(r[0], r[1]); w.y = cvt_pk_bf16(r[2], r[3]); w.z = cvt_pk_bf16(r[4], r[5]); w.w = cvt_pk_bf16(r[6], r[7]);
                *(u32x4*)rowp = w; }
    }
};
struct MoeOrder {
    const int* tile_exp; int tlo, nt, nN, G, c;
    __device__ __forceinline__ bool next(int i, Unit& u) const {
        const int L = i * G + c; if (nt <= 0 || L >= nt * nN) return false;
        const int t = tlo + (L % nt), cn = L / nt;
        const int e = __builtin_amdgcn_readfirstlane(__hip_atomic_load(tile_exp + t, __ATOMIC_RELAXED, __HIP_MEMORY_SCOPE_AGENT));
        u.pm = t; u.pn = e * nN + cn; return true;
    }
    __device__ __forceinline__ void a_ready(const Unit&) const {}
    __device__ __forceinline__ void done(const Unit&) const {}
};
template <class Epi, class Sched, bool ALIGN_EPI = false, bool SP2 = false>
__device__ __forceinline__ void gemm_phase(PG8_LAS unsigned char* lds, const Gemm g, const Sched& S, const Epi& E, const int wave_id) {
    int tid_; asm volatile("v_mbcnt_lo_u32_b32 %0, -1, 0\n\tv_mbcnt_hi_u32_b32 %0, -1, %0" : "=v"(tid_)); tid_ += wave_id * 64;
    const int tid = tid_, wid = __builtin_amdgcn_readfirstlane(tid >> 6), lane = tid & 63, wr = wid >> 2, wc = wid & 3, fr = lane & 15, fq = lane >> 4;
    const int K = g.K, nt = K / BK;
    unsigned voffA[2], voffB[2];
#pragma unroll
    for (int i = 0; i < 2; ++i) { int R, C; stage_rc(tid * 16 + i * 8192, R, C); const int Rb = Epi::PERM ? ((R & ~31) + perm32(R & 31)) : R;
        voffA[i] = (unsigned)(R * K + C) * 2u; voffB[i] = (unsigned)(Rb * K + C) * 2u; }
    const size_t kstep = (size_t)(BK * 2);
    const size_t hstep = (size_t)HALF * K * 2;
    const size_t tstep = 2 * hstep;
    const unsigned ldsw = (unsigned)wid * 1024u;
    const int aoff = lds_byte(wr * 64 + fr, fq * 8), boff = lds_byte(wc * 32 + fr, fq * 8);
#define PG8_SA(b, h) (((b) * 2 + (h)) * HTB)
#define PG8_SB(b, h) ((4 + (b) * 2 + (h)) * HTB)
#define PG8_STAGE(bufoff, gbase, voff) do { _Pragma("unroll") for (int _i = 0; _i < 2; ++_i) \
        __builtin_amdgcn_global_load_lds((const unsigned*)((const char*)(gbase) + (voff)[_i]), (PG8_LAS unsigned*)(lds + (bufoff) + ldsw + _i * 8192), 16, 0, 0); } while (0)
#define PG8_LDA(dst, b, h) do { _Pragma("unroll") for (int m = 0; m < 4; ++m) _Pragma("unroll") for (int k = 0; k < 2; ++k) dst[m][k] = *(const PG8_LAS bf16x8*)(lds + PG8_SA(b, h) + aoff + m * 2048 + k * 1024); } while (0)
#define PG8_LDB(dst, b, h) do { _Pragma("unroll") for (int n = 0; n < 2; ++n) _Pragma("unroll") for (int k = 0; k < 2; ++k) dst[n][k] = *(const PG8_LAS bf16x8*)(lds + PG8_SB(b, h) + boff + n * 2048 + k * 1024); } while (0)
#define PG8_MMA(ai, bj, At, Bt) do { __builtin_amdgcn_s_setprio(1); _Pragma("unroll") for (int m = 0; m < 4; ++m) _Pragma("unroll") for (int n = 0; n < 2; ++n) _Pragma("unroll") for (int k = 0; k < 2; ++k) \
        acc[ai][bj][m][n] = __builtin_amdgcn_mfma_f32_16x16x32_bf16(Bt[n][k], At[m][k], acc[ai][bj][m][n], 0, 0, 0); __builtin_amdgcn_s_setprio(0); } while (0)
#define PG8_WAIT_V(n) asm volatile("s_waitcnt vmcnt(" #n ")" ::: "memory")
#define PG8_WAIT_L(n) asm volatile("s_waitcnt lgkmcnt(" #n ")" ::: "memory")
#define PG8_BAR __builtin_amdgcn_s_barrier()
#define PG8_SCHED __builtin_amdgcn_sched_barrier(0)
    Unit cur, nxt; int ui = 0;
    if (!S.next(0, cur)) return;
    f32x4 acc[2][2][4][2];
#pragma unroll
    for (int a = 0; a < 2; ++a)
#pragma unroll
        for (int b = 0; b < 2; ++b)
#pragma unroll
            for (int m = 0; m < 4; ++m)
#pragma unroll
                for (int n = 0; n < 2; ++n) acc[a][b][m][n] = (f32x4){0.f, 0.f, 0.f, 0.f};
    bf16x8 At[4][2], B0[2][2], B1[2][2];
    const char* cA = (const char*)g.A + (size_t)cur.pm * tstep; const char* cB = (const char*)g.Bt + (size_t)cur.pn * tstep;
    S.a_ready(cur);
    if constexpr (SP2) {
        PG8_STAGE(PG8_SB(0, 0), cB, voffB); PG8_STAGE(PG8_SB(0, 1), cB + hstep, voffB); PG8_STAGE(PG8_SA(0, 0), cA, voffA); PG8_STAGE(PG8_SA(0, 1), cA + hstep, voffA);
        if (wr == 1) PG8_BAR;
        PG8_WAIT_V(2); PG8_BAR;
        PG8_STAGE(PG8_SB(1, 0), cB + kstep, voffB); PG8_STAGE(PG8_SA(1, 0), cA + kstep, voffA); PG8_STAGE(PG8_SB(1, 1), cB + hstep + kstep, voffB);
        PG8_WAIT_V(6); PG8_BAR;
    } else {
        PG8_STAGE(PG8_SB(0, 0), cB, voffB); PG8_STAGE(PG8_SA(0, 0), cA, voffA); PG8_STAGE(PG8_SB(0, 1), cB + hstep, voffB); PG8_STAGE(PG8_SA(0, 1), cA + hstep, voffA);
        if (wr == 1) PG8_BAR;
        PG8_WAIT_V(4); PG8_BAR;
        PG8_STAGE(PG8_SB(1, 0), cB + kstep, voffB); PG8_STAGE(PG8_SA(1, 0), cA + kstep, voffA); PG8_STAGE(PG8_SB(1, 1), cB + hstep + kstep, voffB);
        PG8_WAIT_V(6); PG8_BAR;
    }
    for (;;) {
        const bool has_next = S.next(ui + 1, nxt);
        const char* nA = has_next ? (const char*)g.A + (size_t)nxt.pm * tstep : cA; const char* nB = has_next ? (const char*)g.Bt + (size_t)nxt.pn * tstep : cB;
        for (int t = 0; t < nt; t += 2) {
            const bool last = (t == nt - 2);
            const char* a1 = cA + (size_t)(t + 1) * kstep;
            const char* a2 = last ? nA : cA + (size_t)(t + 2) * kstep; const char* b2 = last ? nB : cB + (size_t)(t + 2) * kstep;
            const char* a3 = a2 + kstep; const char* b3 = b2 + kstep;
            if (last && has_next) S.a_ready(nxt);
            if constexpr (SP2) {
            PG8_LDB(B0, 0, 0); PG8_LDB(B1, 0, 1); PG8_SCHED; PG8_LDA(At, 0, 0); PG8_STAGE(PG8_SA(1, 1), a1 + hstep, voffA);
            PG8_WAIT_V(8); PG8_WAIT_L(0); PG8_BAR; PG8_MMA(0, 0, At, B0); PG8_MMA(0, 1, At, B1); PG8_BAR; PG8_SCHED;
            PG8_LDA(At, 0, 1); PG8_STAGE(PG8_SB(0, 0), b2, voffB); PG8_STAGE(PG8_SB(0, 1), b2 + hstep, voffB); PG8_STAGE(PG8_SA(0, 0), a2, voffA);
            PG8_WAIT_V(8); PG8_WAIT_L(0); PG8_BAR; PG8_MMA(1, 0, At, B0); PG8_MMA(1, 1, At, B1); PG8_BAR; PG8_SCHED;
            PG8_LDB(B0, 1, 0); PG8_LDB(B1, 1, 1); PG8_SCHED; PG8_LDA(At, 1, 0); PG8_STAGE(PG8_SA(0, 1), a2 + hstep, voffA);
            PG8_WAIT_V(8); PG8_WAIT_L(0); PG8_BAR; PG8_MMA(0, 0, At, B0); PG8_MMA(0, 1, At, B1); PG8_BAR; PG8_SCHED;
            PG8_LDA(At, 1, 1); PG8_STAGE(PG8_SB(1, 0), b3, voffB); PG8_STAGE(PG8_SB(1, 1), b3 + hstep, voffB); PG8_STAGE(PG8_SA(1, 0), a3, voffA);
            PG8_WAIT_V(8); PG8_WAIT_L(0); PG8_BAR; PG8_MMA(1, 0, At, B0); PG8_MMA(1, 1, At, B1); PG8_BAR; PG8_SCHED;
            } else {
            PG8_LDB(B0, 0, 0); PG8_SCHED; PG8_LDA(At, 0, 0); PG8_STAGE(PG8_SA(1, 1), a1 + hstep, voffA);
            PG8_WAIT_L(8); PG8_BAR; PG8_WAIT_L(0); PG8_MMA(0, 0, At, B0); PG8_BAR; PG8_SCHED;
            PG8_LDB(B1, 0, 1); PG8_STAGE(PG8_SB(0, 0), b2, voffB);
            PG8_BAR; PG8_WAIT_L(0); PG8_MMA(0, 1, At, B1); PG8_BAR;
            PG8_LDA(At, 0, 1); PG8_STAGE(PG8_SA(0, 0), a2, voffA);
            PG8_BAR; PG8_WAIT_L(0); PG8_MMA(1, 0, At, B0); PG8_BAR; PG8_SCHED;
            PG8_STAGE(PG8_SB(0, 1), b2 + hstep, voffB);
            PG8_WAIT_V(6); PG8_BAR; PG8_MMA(1, 1, At, B1); PG8_BAR;
            PG8_LDB(B0, 1, 0); PG8_SCHED; PG8_LDA(At, 1, 0); PG8_STAGE(PG8_SA(0, 1), a2 + hstep, voffA);
            PG8_WAIT_L(8); PG8_BAR; PG8_WAIT_L(0); PG8_MMA(0, 0, At, B0); PG8_BAR; PG8_SCHED;
            PG8_LDB(B1, 1, 1); PG8_STAGE(PG8_SB(1, 0), b3, voffB);
            PG8_BAR; PG8_WAIT_L(0); PG8_MMA(0, 1, At, B1); PG8_BAR;
            PG8_LDA(At, 1, 1); PG8_STAGE(PG8_SA(1, 0), a3, voffA);
            PG8_BAR; PG8_WAIT_L(0); PG8_MMA(1, 0, At, B0); PG8_BAR; PG8_SCHED;
            PG8_STAGE(PG8_SB(1, 1), b3 + hstep, voffB);
            PG8_WAIT_V(6); PG8_BAR; PG8_MMA(1, 1, At, B1); PG8_BAR;
            }
        }
        if constexpr (ALIGN_EPI) { if (wr == 0) PG8_BAR; }
        if constexpr (!Epi::AFTER_DRAIN) { E(acc, cur, wr, wc, fr, fq); S.done(cur); }
        if (!has_next) break;
#pragma unroll
        for (int a = 0; a < 2; ++a)
#pragma unroll
            for (int b = 0; b < 2; ++b)
#pragma unroll
                for (int m = 0; m < 4; ++m)
#pragma unroll
                    for (int n = 0; n < 2; ++n) acc[a][b][m][n] = (f32x4){0.f, 0.f, 0.f, 0.f};
        cur = nxt; cA = nA; cB = nB; ++ui;
        if constexpr (ALIGN_EPI) { if (wr == 1) PG8_BAR; }
    }
    PG8_WAIT_V(0);
    if constexpr (!ALIGN_EPI) { if (wr == 0) PG8_BAR; }
    PG8_BAR;
    if constexpr (Epi::AFTER_DRAIN) { E.fused(acc, cur, wr, wc, fr, fq, lds, wid, lane); S.done(cur); }
#undef PG8_SA
#undef PG8_SB
#undef PG8_STAGE
#undef PG8_LDA
#undef PG8_LDB
#undef PG8_MMA
#undef PG8_WAIT_V
#undef PG8_WAIT_L
#undef PG8_BAR
#undef PG8_SCHED
}
}
constexpr int S_ = 16384, D_ = 1024;
constexpr int EVEN_IN = 3072, LORA_N = 512, FF0 = 2816, ODD_IN = 3600, ODD_PAD = 3840, FFE = 3584, NEXP = 8;
constexpr int MOE_ROWS = 32768 + 8 * 256;
constexpr int MOE_BATCH_TILES = 64;
constexpr size_t MiB = 1u << 20;
constexpr size_t WS_CTL = 0, CTL_ZERO_BYTES = 1 * MiB;
constexpr size_t WS_WIN0 = 2 * MiB, WS_WL = 8 * MiB, WS_WOUT0 = 9 * MiB, WS_WGU0 = 11 * MiB, WS_WD0 = 22 * MiB, WS_WIN1 = 28 * MiB, WS_WOUT1 = 36 * MiB;
constexpr size_t WS_TOK = 38 * MiB;
constexpr size_t WS_TILE = 39 * MiB;
constexpr size_t WS_A = 40 * MiB;
constexpr size_t WS_H = WS_A, WS_HX = WS_A + 32 * MiB;
constexpr size_t WS_LW0 = WS_A, WS_LW1 = WS_A + 32 * MiB, WS_R = WS_A + 64 * MiB, WS_V = WS_A + 80 * MiB, WS_KK = WS_A + 96 * MiB, WS_KD0 = WS_A + 112 * MiB, WS_KD1 = WS_A + 128 * MiB, WS_B0 = WS_A + 144 * MiB;
constexpr size_t WS_H2 = WS_A, WS_H3 = WS_A + 32 * MiB;
constexpr size_t WS_WMGU = WS_A, WS_WMD = WS_A + 112 * MiB;
constexpr size_t WS_B = 208 * MiB;
constexpr size_t WS_PROJ0 = WS_B, WS_LORA = WS_B + 96 * MiB, WS_QN = WS_B + 112 * MiB, WS_KN = WS_B + 128 * MiB, WS_Y = WS_B + 144 * MiB;
constexpr size_t WS_B1 = WS_B + 176 * MiB, WS_GATE = WS_B + 192 * MiB, WS_BONUS = WS_B + 208 * MiB, WS_Y0 = WS_LORA, WS_Y1 = WS_B + 224 * MiB;
constexpr size_t WS_ACT0 = WS_B, WS_PROJ1 = WS_B + 88 * MiB;
constexpr size_t WS_QD = WS_B, WS_KD = WS_B + 16 * MiB, WS_VD = WS_B + 32 * MiB, WS_YCAT1 = WS_B + 48 * MiB, WS_GB = WS_B + 80 * MiB  ;
constexpr size_t WS_O0 = WS_B + 208 * MiB, WS_O1 = WS_B + 224 * MiB;
constexpr size_t WS_AMOE = WS_B, WS_MACT = WS_B + 88 * MiB;
constexpr size_t WS_END_OLD = 448 * MiB, WS_RSS1 = 460 * MiB, WS_RSS2 = 461 * MiB, WS_END = 462 * MiB;
static_assert(WS_MACT + (size_t)MOE_BATCH_TILES * 256 * FFE * 2 <= WS_END, "moe act");
static_assert(WS_AMOE + (size_t)MOE_ROWS * D_ * 2 <= WS_MACT, "amoe");
static_assert(WS_PROJ1 + (size_t)S_ * ODD_PAD * 2 <= WS_O0, "proj1");
constexpr int CW_CNT = 64;
constexpr int CW_RSS1 = 32768, CW_RSS2 = 32768 + 16384;
constexpr int CW_BAR = 4096;
constexpr int LDS_BYTES = 159744, LDS_ZERO_OFF = LDS_BYTES - 512, MISC_OFF = LDS_ZERO_OFF + 64;

#define GAS __attribute__((address_space(1)))
#define LAS __attribute__((address_space(3)))
#define DI __device__ __forceinline__
typedef unsigned short bf16;
typedef unsigned v4u __attribute__((ext_vector_type(4)));
typedef float f32x4 __attribute__((ext_vector_type(4)));
typedef GAS unsigned gu32;
#define LDS_WAIT() asm volatile("s_waitcnt lgkmcnt(0)" ::: "memory")
DI unsigned f2bf(float f) { unsigned u = __builtin_bit_cast(unsigned, f); return (u + 0x7fffu + ((u >> 16) & 1u)) >> 16; }
typedef float f32x2_t __attribute__((ext_vector_type(2))); typedef __bf16 bf16x2_t __attribute__((ext_vector_type(2)));
DI unsigned pk2(float lo, float hi) { const f32x2_t v = {lo, hi}; const bf16x2_t b = __builtin_convertvector(v, bf16x2_t); return __builtin_bit_cast(unsigned, b); }
DI float bflo(unsigned w) { return __uint_as_float(w << 16); }
DI float bfhi(unsigned w) { return __uint_as_float(w & 0xffff0000u); }
DI float bf2f(bf16 b) { return __uint_as_float(((unsigned)b) << 16); }
DI void ld8(const bf16* p, float (&v)[8]) { const v4u w = *(const v4u*)p; v[0] = bflo(w.x); v[1] = bfhi(w.x); v[2] = bflo(w.y); v[3] = bfhi(w.y); v[4] = bflo(w.z); v[5] = bfhi(w.z); v[6] = bflo(w.w); v[7] = bfhi(w.w); }
DI void st8(bf16* p, const float (&v)[8]) { v4u w; w.x = pk2(v[0], v[1]); w.y = pk2(v[2], v[3]); w.z = pk2(v[4], v[5]); w.w = pk2(v[6], v[7]); *(v4u*)p = w; }
DI void ld8f(const float* p, float (&v)[8]) { const f32x4 a = *(const f32x4*)p, b = *(const f32x4*)(p + 4); v[0] = a.x; v[1] = a.y; v[2] = a.z; v[3] = a.w; v[4] = b.x; v[5] = b.y; v[6] = b.z; v[7] = b.w; }
DI void st8f(float* p, const float (&v)[8]) { *(f32x4*)p = (f32x4){v[0], v[1], v[2], v[3]}; *(f32x4*)(p + 4) = (f32x4){v[4], v[5], v[6], v[7]}; }
DI float wave_sum(float v) {
#pragma unroll
    for (int o = 1; o < 64; o <<= 1) v += __shfl_xor(v, o);
    return v;
}
template <int W> DI float grp_sum(float v) {
#pragma unroll
    for (int o = 1; o < W; o <<= 1) v += __shfl_xor(v, o);
    return v;
}
DI float sigmoidf_(float x) { return 1.0f / (1.0f + __expf(-x)); }
DI float softplusf_(float x) { return x > 20.f ? x : log1pf(__expf(x)); }
DI float siluf_(float x) { return x / (1.0f + __expf(-x)); }

struct Args { const float* in[39]; float* out; unsigned char* ws; };

DI void transpose_item(const float* W, int K, int N, bf16* WT, int rowbase, LAS float* scr, int k0, int n0, int lane, const float* kscale = nullptr) {
    const int nn = n0 + (lane & 31); const bool ok = nn < N;
#pragma unroll
    for (int i = 0; i < 32; ++i) { const int kk = 2 * i + (lane >> 5); scr[kk * 33 + (lane & 31)] = ok ? W[(size_t)(k0 + kk) * N + nn] * (kscale ? kscale[k0 + kk] : 1.0f) : 0.f; }
    LDS_WAIT(); asm volatile("" ::: "memory");
    const int c = lane & 7;
#pragma unroll
    for (int j = 0; j < 4; ++j) { const int n = (lane >> 3) + 8 * j; const LAS float* s = scr + (8 * c) * 33 + n;
        v4u o; o.x = pk2(s[0 * 33], s[1 * 33]); o.y = pk2(s[2 * 33], s[3 * 33]); o.z = pk2(s[4 * 33], s[5 * 33]); o.w = pk2(s[6 * 33], s[7 * 33]);
        *(v4u*)(WT + (size_t)(rowbase + n) * K + k0 + 8 * c) = o; }
    LDS_WAIT(); asm volatile("" ::: "memory");
}

struct TrItem { const float* src; bf16* dst; int K, N, k0, n0, rowbase; };
DI void tr_load(const TrItem& d, int lane, float (&v)[32]) {
#pragma unroll
    for (int i = 0; i < 32; ++i) { const int kk = 2 * i + (lane >> 5); v[i] = d.src[(size_t)(d.k0 + kk) * d.N + d.n0 + (lane & 31)]; }
}
DI void tr_store(const TrItem& d, int lane, const float (&v)[32], LAS float* scr) {
#pragma unroll
    for (int i = 0; i < 32; ++i) scr[(2 * i + (lane >> 5)) * 33 + (lane & 31)] = v[i];
    LDS_WAIT(); asm volatile("" ::: "memory");
    const int c = lane & 7;
#pragma unroll
    for (int j = 0; j < 4; ++j) { const int n = (lane >> 3) + 8 * j; const LAS float* s = scr + (8 * c) * 33 + n;
        v4u o; o.x = pk2(s[0 * 33], s[1 * 33]); o.y = pk2(s[2 * 33], s[3 * 33]); o.z = pk2(s[4 * 33], s[5 * 33]); o.w = pk2(s[6 * 33], s[7 * 33]);
        *(v4u*)(d.dst + (size_t)(d.rowbase + n) * d.K + d.k0 + 8 * c) = o; }
    LDS_WAIT(); asm volatile("" ::: "memory");
}
DI void moe_gu_item(const Args& a, unsigned char* ws, int it, TrItem& d) {
    const int mtx = it / 1792, r = it % 1792, e = mtx >> 1, sel = mtx & 1, kb = r / 112, nb = r % 112, n0 = 32 * nb;
    d.src = (sel ? a.in[37] : a.in[36]) + (size_t)e * 1024 * FFE; d.dst = (bf16*)(ws + WS_WMGU) + (size_t)e * 2 * FFE * 1024; d.K = 1024; d.N = FFE; d.k0 = 64 * kb; d.n0 = n0;
    d.rowbase = (n0 / 128) * 256 + sel * 128 + (n0 % 128);
}
DI void moe_dn_item(const Args& a, unsigned char* ws, int it, TrItem& d) {
    const int e = it / 1792, r = it % 1792, kb = r / 32, nb = r % 32;
    d.src = a.in[38] + (size_t)e * 1024 * FFE; d.dst = (bf16*)(ws + WS_WMD) + (size_t)e * 1024 * FFE; d.K = FFE; d.N = 1024; d.k0 = 64 * kb; d.n0 = 32 * nb; d.rowbase = 32 * nb;
}
template <bool GU> DI void moe_copy_loop(const Args& a, unsigned char* ws, LAS float* scr, int first, int stride, int last, int lane) {
    first = __builtin_amdgcn_readfirstlane(first); stride = __builtin_amdgcn_readfirstlane(stride);
    if (first >= last) return;
    TrItem cur, nxt; float vc[32], vn[32];
    if (GU) moe_gu_item(a, ws, first, cur); else moe_dn_item(a, ws, first, cur);
    tr_load(cur, lane, vc);
    for (int it = first; it < last; it += stride) {
        const int itn = it + stride; const bool more = itn < last;
        if (more) { if (GU) moe_gu_item(a, ws, itn, nxt); else moe_dn_item(a, ws, itn, nxt); tr_load(nxt, lane, vn); }
        tr_store(cur, lane, vc, scr);
        if (more) { cur = nxt;
#pragma unroll
            for (int i = 0; i < 32; ++i) vc[i] = vn[i]; }
    }
}
DI bool transpose_job(int& r, const float* W, int K, int N, int Npad, bf16* WT, int row_off, int grp, int sel, LAS float* scr, int lane, const float* kscale = nullptr) {
    const int nblk = Npad / 32, cnt = (K / 64) * nblk;
    if (r >= cnt) { r -= cnt; return false; }
    const int kb = r / nblk, nb = r % nblk, n0 = 32 * nb;
    const int rowbase = row_off + (grp ? (n0 / grp) * (2 * grp) + sel * grp + (n0 % grp) : n0);
    transpose_item(W, K, N, WT, rowbase, scr, 64 * kb, n0, lane, kscale);
    return true;
}
#define XB_TMO      128
#define XB_XCNT(j)  (256  + 64 * (j))
#define XB_XSUB(j)  (1280 + 64 * (j))
#define XB_XGEN(j)  (2304 + 64 * (j))
#define XB_TOP      3328
#define XB_TOPGEN   3392
#define XCD_BAR_WORDS 3456
#define XB_SPIN_CAP (1u << 22)

__device__ __forceinline__ unsigned xb_ld(unsigned* p)              { return __hip_atomic_load(p, __ATOMIC_RELAXED, __HIP_MEMORY_SCOPE_AGENT); }
__device__ __forceinline__ unsigned xb_add(unsigned* p, unsigned v) { return __hip_atomic_fetch_add(p, v, __ATOMIC_RELAXED, __HIP_MEMORY_SCOPE_AGENT); }
__device__ __forceinline__ unsigned xb_xcc_id() { return (unsigned)__builtin_amdgcn_s_getreg((3 << 11) | 20) & 0xFu; }
#define XB_SPIN(cond, bar) do { unsigned _sp = 0; while (cond) { __builtin_amdgcn_s_sleep(1); \
    if ((++_sp & 255u) == 0u) { if (xb_ld(&(bar)[XB_TMO])) break; if (_sp > XB_SPIN_CAP) { atomicAdd(&(bar)[XB_TMO], 1u); break; } } } } while (0)

struct XcdBarrier {
    unsigned* bar; unsigned x;
    volatile LAS unsigned* st;
};

__device__ __forceinline__ XcdBarrier xcd_barrier_post(unsigned* bar, volatile LAS unsigned* st) {
    XcdBarrier b; b.bar = bar; b.x = xb_xcc_id(); b.st = st;
    if (threadIdx.x == 0) (void)xb_add(&bar[XB_XCNT(b.x)], 1u);
    return b;
}
__device__ __forceinline__ void xcd_barrier_complete(unsigned* bar, unsigned x, unsigned& nloc, unsigned& nx) {
    const unsigned G = gridDim.x * gridDim.y * gridDim.z;
    unsigned sum, cnt, mine, sp = 0u;
    for (;;) {
        sum = 0u; cnt = 0u; mine = 0u;
#pragma unroll
        for (unsigned j = 0; j < 16; ++j) { const unsigned c = xb_ld(&bar[XB_XCNT(j)]); sum += c; cnt += (c > 0u) ? 1u : 0u; mine = (j == x) ? c : mine; }
        if (sum == G) break;
        __builtin_amdgcn_s_sleep(1);
        if ((++sp & 255u) == 0u) { if (xb_ld(&bar[XB_TMO])) break; if (sp > XB_SPIN_CAP) { atomicAdd(&bar[XB_TMO], 1u); break; } }
    }
    nloc = mine > 0u ? mine : 1u; nx = cnt > 0u ? cnt : 1u;
}

__device__ __forceinline__ void xcd_barrier(const XcdBarrier& b, const bool wave0) {
    asm volatile("s_waitcnt vmcnt(0)" ::: "memory");
    __syncthreads();
    if (wave0 && __builtin_amdgcn_mbcnt_hi(~0u, __builtin_amdgcn_mbcnt_lo(~0u, 0u)) == 0u) {
        unsigned* bar = b.bar; asm volatile("" : "+s"(bar)); const unsigned bx_ = xb_xcc_id();
        __builtin_amdgcn_s_waitcnt(0);
        unsigned nloc = b.st[0], nx = b.st[1];
        if (nloc == 0u) { xcd_barrier_complete(bar, bx_, nloc, nx); b.st[0] = nloc; b.st[1] = nx; }
        const unsigned old = xb_add(&bar[XB_XSUB(bx_)], 1u);
        const unsigned gen = old / nloc;
        if (old + 1u == (gen + 1u) * nloc) {
            __builtin_amdgcn_fence(__ATOMIC_RELEASE, "agent");
            asm volatile("s_waitcnt vmcnt(0)" ::: "memory");
            const unsigned og = xb_add(&bar[XB_TOP], 1u);
            const unsigned tg = og / nx;
            if (og + 1u == (tg + 1u) * nx) xb_add(&bar[XB_TOPGEN], 1u);
            else XB_SPIN(xb_ld(&bar[XB_TOPGEN]) == tg, bar);
            __builtin_amdgcn_fence(__ATOMIC_ACQUIRE, "agent");
            xb_add(&bar[XB_XGEN(bx_)], 1u);
            asm volatile("s_waitcnt vmcnt(0)" ::: "memory");
        } else {
            XB_SPIN(xb_ld(&bar[XB_XGEN(bx_)]) == gen, bar);
            __builtin_amdgcn_fence(__ATOMIC_ACQUIRE, "agent");
            asm volatile("s_waitcnt vmcnt(0)" ::: "memory");
        }
    }
    __syncthreads();
}
DI float row_rstd(const f32x4 (&v)[4]) {
    float s = 0.f;
#pragma unroll
    for (int j = 0; j < 4; ++j) s += (v[j].x * v[j].x + v[j].y * v[j].y) + (v[j].z * v[j].z + v[j].w * v[j].w);
    return 1.0f / sqrtf(wave_sum(s) * (1.0f / D_) + 1e-6f);
}
DI void load_row(const float* x, int t, int lane, f32x4 (&v)[4]) {
    if (t >= 0 && t < S_) { const f32x4* p = (const f32x4*)(x + (size_t)t * D_) + lane;
#pragma unroll
        for (int j = 0; j < 4; ++j) v[j] = p[64 * j];
    } else {
#pragma unroll
        for (int j = 0; j < 4; ++j) v[j] = (f32x4){0.f, 0.f, 0.f, 0.f};
    }
}
DI void store_row_bf16(bf16* o, int lane, const f32x4 (&v)[4]) {
    unsigned long long* o8 = (unsigned long long*)o + lane;
#pragma unroll
    for (int j = 0; j < 4; ++j) o8[64 * j] = (unsigned long long)pk2(v[j].x, v[j].y) | ((unsigned long long)pk2(v[j].z, v[j].w) << 32);
}
DI void norm_rows(const float* x, const float* w, const float* mu  , bf16* H, bf16* HX, int gw, int NGW, int lane) {
    f32x4 wv[4];
#pragma unroll
    for (int j = 0; j < 4; ++j) wv[j] = ((const f32x4*)w)[lane + 64 * j];
    for (int t = gw; t < S_; t += NGW) {
        f32x4 v[4]; load_row(x, t, lane, v); const float rs = row_rstd(v);
#pragma unroll
        for (int j = 0; j < 4; ++j) v[j] = v[j] * rs * wv[j];
        store_row_bf16(H + (size_t)t * D_, lane, v);
        if (mu) {
            f32x4 p[4], n[4]; load_row(x, t - 1, lane, p); load_row(x, t + 1, lane, n);
            const float rp = row_rstd(p), rn = row_rstd(n);
#pragma unroll
            for (int j = 0; j < 4; ++j) { const f32x4 m0 = ((const f32x4*)mu)[lane + 64 * j], m1 = ((const f32x4*)(mu + D_))[lane + 64 * j];
                const f32x4 hp = p[j] * rp * wv[j], hn = n[j] * rn * wv[j]; p[j] = v[j] + m0 * (hp - v[j]) + m1 * (hn - v[j]); }
            store_row_bf16(HX + (size_t)t * D_, lane, p);
        }
    }
}

DI void prep0_token(const Args& a, unsigned char* ws, LAS float* scr, int t, int lane) {
    const bf16* P = (const bf16*)(ws + WS_PROJ0) + (size_t)t * EVEN_IN;
    const int c0 = 8 * lane;
    {
        float q[8], k[8]; ld8(P + c0, q); ld8(P + 512 + c0, k);
        float sq = 0.f, sk = 0.f;
#pragma unroll
        for (int i = 0; i < 8; ++i) { sq += q[i] * q[i]; sk += k[i] * k[i]; }
        sq = grp_sum<8>(sq); sk = grp_sum<8>(sk);
        const float rq = 1.0f / sqrtf(sq * (1.0f / 64.f) + 1e-6f), rk = 1.0f / sqrtf(sk * (1.0f / 64.f) + 1e-6f);
        const int d0 = 8 * (lane & 7);
        float qw[8], kw[8]; ld8f(a.in[4] + d0, qw); ld8f(a.in[5] + d0, kw);
#pragma unroll
        for (int i = 0; i < 8; ++i) { q[i] = q[i] * rq * qw[i]; k[i] = k[i] * rk * kw[i]; }
        const float pos = (float)((const int*)a.in[1])[t];
        float qo[8], ko[8];
#pragma unroll
        for (int i = 0; i < 8; ++i) { qo[i] = __shfl_xor(q[i], 1); ko[i] = __shfl_xor(k[i], 1); }
        const int sub = lane & 7;
        if (sub < 2) {
#pragma unroll
            for (int i = 0; i < 8; ++i) {
                constexpr float kInv[8] = {1.0f, 0.1939227432012558f, 0.03760603070259094f, 0.007292664609849453f, 0.0014142135623842478f, 0.00027424818836152554f, 5.3182957344688475e-05f, 1.0313385246263351e-05f};
                const float ang = pos * kInv[i]; const float kq = rintf(ang * 0.15915494309189535f);
                float rr = fmaf(-kq, 6.28318548202514648f, ang); rr = fmaf(-kq, -1.74845553146951715e-07f, rr);
                const float sn = __sinf(rr), cs = __cosf(rr);
                if (sub == 0) { q[i] = q[i] * cs - qo[i] * sn; k[i] = k[i] * cs - ko[i] * sn; }
                else          { q[i] = q[i] * cs + qo[i] * sn; k[i] = k[i] * cs + ko[i] * sn; }
            }
        }
#pragma unroll
        for (int i = 0; i < 8; ++i) q[i] *= 0.125f;
        st8((bf16*)(ws + WS_QN) + (size_t)t * 512 + c0, q); st8((bf16*)(ws + WS_KN) + (size_t)t * 512 + c0, k);
        *(v4u*)((bf16*)(ws + WS_Y1) + (size_t)t * 512 + c0) = *(const v4u*)(P + 1024 + c0);
    }
}

DI void rwkv_scan_naive(unsigned char* ws, int w  , int lane) {
    const int z = w >> 9, h = (w >> 6) & 7, vr = w & 63;
    const float* LW = (const float*)(ws + (z ? WS_LW1 : WS_LW0));
    const bf16* KD = (const bf16*)(ws + (z ? WS_KD1 : WS_KD0)); const bf16* BB = (const bf16*)(ws + (z ? WS_B1 : WS_B0));
    const bf16* KK = (const bf16*)(ws + WS_KK); const bf16* R = (const bf16*)(ws + WS_R); const bf16* V = (const bf16*)(ws + WS_V);
    bf16* Y = (bf16*)(ws + (z ? WS_Y1 : WS_Y0));
    const int cc = h * 64 + lane, cv = h * 64 + vr;
    float S = 0.f;
    int t = z ? S_ - 1 : 0; const int dt = z ? -1 : 1;
    size_t o = (size_t)t * 512;
    float lw = LW[o + cc], kd = bf2f(KD[o + cc]), bb = bf2f(BB[o + cc]), kk = bf2f(KK[o + cc]), rr = bf2f(R[o + cc]), vv = bf2f(V[o + cv]);
    for (int s = 0; s < S_; ++s) {
        const int tn = t + dt; const bool more = s + 1 < S_;
        const size_t on = (size_t)(more ? tn : t) * 512;
        const float lw_n = LW[on + cc], kd_n = bf2f(KD[on + cc]), bb_n = bf2f(BB[on + cc]), kk_n = bf2f(KK[on + cc]), rr_n = bf2f(R[on + cc]), vv_n = bf2f(V[on + cv]);
        const float sa = wave_sum(S * (-kk));
        S = S * __expf(lw) + sa * bb + vv * kd;
        const float y = wave_sum(S * rr);
        if (lane == 0) Y[(size_t)t * 512 + cv] = (bf16)f2bf(y);
        lw = lw_n; kd = kd_n; bb = bb_n; kk = kk_n; rr = rr_n; vv = vv_n; t = tn;
    }
}

DI void attn_token_naive(unsigned char* ws, int t, int lane) {
    const bf16* QN = (const bf16*)(ws + WS_QN); const bf16* KN = (const bf16*)(ws + WS_KN); const bf16* P = (const bf16*)(ws + WS_PROJ0);
    const int c0 = 8 * lane;
    float q[8]; ld8(QN + (size_t)t * 512 + c0, q);
    float m = -1e30f, l = 0.f, acc[8];
#pragma unroll
    for (int i = 0; i < 8; ++i) acc[i] = 0.f;
    for (int br = 0; br < 3; ++br) {
        const int d = br == 0 ? 1 : (br == 1 ? 4 : 16);
        for (int mm = -64; mm <= 64; ++mm) {
            const int j = t + d * mm; if (j < 0 || j >= S_) continue;
            float k[8], v[8]; ld8(KN + (size_t)j * 512 + c0, k); ld8(P + (size_t)j * EVEN_IN + 1024 + c0, v);
            float s = 0.f;
#pragma unroll
            for (int i = 0; i < 8; ++i) s += q[i] * k[i];
            s = grp_sum<8>(s);
            const float mn = fmaxf(m, s), sc = __expf(m - mn), p = __expf(s - mn);
            l = l * sc + p;
#pragma unroll
            for (int i = 0; i < 8; ++i) acc[i] = acc[i] * sc + p * v[i];
            m = mn;
        }
    }
    const float il = 1.0f / l;
#pragma unroll
    for (int i = 0; i < 8; ++i) acc[i] *= il;
    st8((bf16*)(ws + WS_Y) + (size_t)t * D_ + c0, acc);
}

DI void rwkv_post_token(const Args& a, unsigned char* ws, int t, int lane) {
    const int c0 = 8 * lane; const size_t o = (size_t)t * 512 + c0;
    float y0[8], y1[8], g[8], bn[8], lw[8], lb[8];
    ld8((const bf16*)(ws + WS_Y0) + o, y0); ld8((const bf16*)(ws + WS_Y1) + o, y1); ld8((const bf16*)(ws + WS_GATE) + o, g); ld8((const bf16*)(ws + WS_BONUS) + o, bn);
    ld8f(a.in[19] + c0, lw); ld8f(a.in[20] + c0, lb);
    float s = 0.f;
#pragma unroll
    for (int i = 0; i < 8; ++i) { y0[i] += y1[i]; s += y0[i]; }
    const float mu = grp_sum<8>(s) * (1.0f / 64.f);
    float q = 0.f;
#pragma unroll
    for (int i = 0; i < 8; ++i) { y0[i] -= mu; q += y0[i] * y0[i]; }
    const float rs = 1.0f / sqrtf(grp_sum<8>(q) * (1.0f / 64.f) + 64e-5f);
#pragma unroll
    for (int i = 0; i < 8; ++i) y0[i] = (y0[i] * rs * lw[i] + lb[i] + bn[i]) * g[i];
    st8((bf16*)(ws + WS_Y) + (size_t)t * D_ + 512 + c0, y0);
}
typedef short s16x8 __attribute__((ext_vector_type(8)));
typedef short s16x4 __attribute__((ext_vector_type(4)));
typedef LAS unsigned char* ldsp;
DI f32x4 mfma16(s16x8 a, s16x8 b, f32x4 c) { return __builtin_amdgcn_mfma_f32_16x16x32_bf16(a, b, c, 0, 0, 0); }
DI s16x8 frag_row(ldsp img, int row0, int col0, int lane) { return *(LAS const s16x8*)(img + (row0 + (lane & 15)) * 128 + (col0 + 8 * (lane >> 4)) * 2); }
DI s16x4 tr16(ldsp p) { return __builtin_bit_cast(s16x4, __builtin_amdgcn_ds_read_tr16_b64_v4i16((LAS s16x4*)p)); }
DI s16x8 frag_tr(ldsp img, int row0, int col0, int lane) {
    ldsp a0 = img + (row0 + 8 * (lane >> 4) + ((lane & 15) >> 2)) * 128 + col0 * 2 + 8 * (lane & 3);
    const s16x4 lo = tr16(a0), hi = tr16(a0 + 4 * 128);
    return __builtin_shufflevector(lo, hi, 0, 1, 2, 3, 4, 5, 6, 7);
}
DI void ctile_to_img(ldsp img, int mt, int nt, const f32x4& c, int lane) {
    LAS bf16* p = (LAS bf16*)(img + (16 * mt + 4 * (lane >> 4)) * 128 + (16 * nt + (lane & 15)) * 2);
#pragma unroll
    for (int e = 0; e < 4; ++e) p[e * 64] = (bf16)f2bf(c[e]);
}
#define CFENCE() asm volatile("" ::: "memory")
#define MM_LOOPH(ACC, AEXPR, BEXPR) _Pragma("unroll") for (int mt = 2 * mh; mt < 2 * mh + 2; ++mt) _Pragma("unroll") for (int nt = 0; nt < 4; ++nt) _Pragma("unroll") for (int ks = 0; ks < 2; ++ks) ACC[mt][nt] = mfma16((AEXPR), (BEXPR), ACC[mt][nt])
#define MM_LOOP(ACC, AEXPR, BEXPR) _Pragma("unroll") for (int mt = 0; mt < 4; ++mt) _Pragma("unroll") for (int nt = 0; nt < 4; ++nt) _Pragma("unroll") for (int ks = 0; ks < 2; ++ks) ACC[mt][nt] = mfma16((AEXPR), (BEXPR), ACC[mt][nt])

DI int tok_of(int z, int cn, int i) { return z ? cn * 64 + 63 - i : cn * 64 + i; }

template <bool DRY = false, int STOP = 99> DI void rwkv_pass1_item(unsigned char* ws, ldsp lds, int item, int lane) {
    asm volatile("" : "+v"(lane));
    const int z = item >> 11, h = (item >> 8) & 7, c = item & 255;
    const int cn = z ? 255 - c : c;
    float* LW = (float*)(ws + (z ? WS_LW1 : WS_LW0));
    bf16* KD = (bf16*)(ws + (z ? WS_KD1 : WS_KD0)); bf16* BB = (bf16*)(ws + (z ? WS_B1 : WS_B0));
    const bf16* KK = (const bf16*)(ws + WS_KK); const bf16* R = (const bf16*)(ws + WS_R); const bf16* V = (const bf16*)(ws + WS_V);
    float* LWo = DRY ? (float*)(ws + WS_Y) : LW; bf16* KDo = DRY ? (bf16*)(ws + WS_Y) : KD; bf16* BBo = DRY ? (bf16*)(ws + WS_Y) : BB;
    ldsp S0 = lds, S1 = lds + 8192, S2 = lds + 16384, S3 = lds + 24576, S4 = lds + 32768, S5 = lds + 40960, S6 = lds + 49152, S7 = lds + 57344;
    ldsp IA = S0, IB = S1, IK = S2, IR = S3;
    const int ch = h * 64 + lane;
    float G = 0.f;
#pragma unroll 16
    for (int i = 0; i < 64; ++i) {
        const size_t o = (size_t)tok_of(z, cn, i) * 512 + ch;
        const float lw = LW[o], a = -bf2f(KK[o]), b = bf2f(BB[o]), kd = bf2f(KD[o]), r = bf2f(R[o]);
        const float eprev = __expf(G); G += lw; const float ecur = __expf(G), einv = __expf(-G);
        ((LAS bf16*)IA)[i * 64 + lane] = (bf16)f2bf(a * eprev); ((LAS bf16*)IB)[i * 64 + lane] = (bf16)f2bf(b * einv);
        ((LAS bf16*)IK)[i * 64 + lane] = (bf16)f2bf(kd * einv); ((LAS bf16*)IR)[i * 64 + lane] = (bf16)f2bf(r * ecur);
    }
    const float GT = __expf(G);
    LDS_WAIT(); CFENCE();
    if (STOP == 1) { if (GT == 123.f) LWo[0] = GT; return; }
    int lane2 = lane; asm volatile("" : "+v"(lane2));
    const int n_ = lane2 & 15, q_ = lane2 >> 4;
    {
#pragma unroll
        for (int mh = 0; mh < 2; ++mh) {
        f32x4 acc[4][4];
#pragma unroll
        for (int mt = 2 * mh; mt < 2 * mh + 2; ++mt)
#pragma unroll
            for (int nt = 0; nt < 4; ++nt) acc[mt][nt] = (f32x4){0.f, 0.f, 0.f, 0.f};
        MM_LOOPH(acc, frag_row(IA, 16 * mt, 32 * ks, lane), frag_row(IB, 16 * nt, 32 * ks, lane));
#pragma unroll
        for (int mt = 2 * mh; mt < 2 * mh + 2; ++mt)
#pragma unroll
            for (int nt = 0; nt < 4; ++nt)
#pragma unroll
                for (int e = 0; e < 4; ++e) { const int i = 16 * mt + 4 * q_ + e, j = 16 * nt + n_; ((LAS float*)S4)[i * 64 + j] = (j < i) ? acc[mt][nt][e] : 0.f; }
        }
    }
    LDS_WAIT(); CFENCE();
    if (STOP == 4) return;
    {
        float t[64];
        int lane_o = lane; asm volatile("" : "+v"(lane_o));
        f32x4 ar[2][16];
#pragma unroll
        for (int i = 0; i < 64; ++i) {
            if (i + 1 < 64) {
#pragma unroll
                for (int jg = 0; jg < (i + 1 + 3) / 4; ++jg) ar[(i + 1) & 1][jg] = *(LAS const f32x4*)(S4 + ((i + 1) * 64 + 4 * jg) * 4);
            }
            __builtin_amdgcn_sched_barrier(0);
            float acc0 = (lane_o == i) ? 1.f : 0.f, acc1 = 0.f, acc2 = 0.f, acc3 = 0.f;
#pragma unroll
            for (int jg = 0; jg < (i + 3) / 4; ++jg) { const f32x4 a4 = ar[i & 1][jg];
                if (4 * jg + 0 < i) acc0 += a4[0] * t[4 * jg + 0];
                if (4 * jg + 1 < i) acc1 += a4[1] * t[4 * jg + 1];
                if (4 * jg + 2 < i) acc2 += a4[2] * t[4 * jg + 2];
                if (4 * jg + 3 < i) acc3 += a4[3] * t[4 * jg + 3]; }
            t[i] = (acc0 + acc1) + (acc2 + acc3);
            __builtin_amdgcn_sched_barrier(0);
        }
        LDS_WAIT(); CFENCE();
#pragma unroll
        for (int i = 0; i < 64; ++i) ((LAS bf16*)S4)[i * 64 + lane] = (bf16)f2bf(t[i]);
    }
    LDS_WAIT(); CFENCE();
    if (STOP == 2) return;
    ldsp IT = S4, IW = S5, IAK = S6;
    {
#pragma unroll
        for (int mh = 0; mh < 2; ++mh) {
        f32x4 acc[4][4];
#pragma unroll
        for (int mt = 2 * mh; mt < 2 * mh + 2; ++mt)
#pragma unroll
            for (int nt = 0; nt < 4; ++nt) acc[mt][nt] = (f32x4){0.f, 0.f, 0.f, 0.f};
        MM_LOOPH(acc, frag_row(IA, 16 * mt, 32 * ks, lane), frag_row(IK, 16 * nt, 32 * ks, lane));
#pragma unroll
        for (int mt = 2 * mh; mt < 2 * mh + 2; ++mt)
#pragma unroll
            for (int nt = 0; nt < 4; ++nt) {
#pragma unroll
                for (int e = 0; e < 4; ++e) { const int i = 16 * mt + 4 * q_ + e, j = 16 * nt + n_; if (!(j < i)) acc[mt][nt][e] = 0.f; }
                ctile_to_img(IAK, mt, nt, acc[mt][nt], lane); }
        }
    }
    if (STOP == 5) return;
    {
#pragma unroll
        for (int mh = 0; mh < 2; ++mh) {
        f32x4 acc[4][4];
#pragma unroll
        for (int mt = 2 * mh; mt < 2 * mh + 2; ++mt)
#pragma unroll
            for (int nt = 0; nt < 4; ++nt) acc[mt][nt] = (f32x4){0.f, 0.f, 0.f, 0.f};
        MM_LOOPH(acc, frag_row(IT, 16 * mt, 32 * ks, lane), frag_tr(IA, 32 * ks, 16 * nt, lane));
#pragma unroll
        for (int mt = 2 * mh; mt < 2 * mh + 2; ++mt)
#pragma unroll
            for (int nt = 0; nt < 4; ++nt) ctile_to_img(IW, mt, nt, acc[mt][nt], lane);
        }
    }
    LDS_WAIT(); CFENCE();
    if (STOP == 6) return;
    ldsp IV = S0;
    {
        v4u vr[8];
#pragma unroll
        for (int it = 0; it < 8; ++it) vr[it] = *(const v4u*)(V + (size_t)tok_of(z, cn, (lane >> 3) + 8 * it) * 512 + h * 64 + (lane & 7) * 8);
#pragma unroll
        for (int it = 0; it < 8; ++it) *(LAS v4u*)(IV + ((lane >> 3) + 8 * it) * 128 + (lane & 7) * 16) = vr[it];
    }
    LDS_WAIT(); CFENCE();
    ldsp IAV = S7;
    {
#pragma unroll
        for (int mh = 0; mh < 2; ++mh) {
        f32x4 acc[4][4];
#pragma unroll
        for (int mt = 2 * mh; mt < 2 * mh + 2; ++mt)
#pragma unroll
            for (int nt = 0; nt < 4; ++nt) acc[mt][nt] = (f32x4){0.f, 0.f, 0.f, 0.f};
        MM_LOOPH(acc, frag_row(IAK, 16 * mt, 32 * ks, lane), frag_tr(IV, 32 * ks, 16 * nt, lane));
#pragma unroll
        for (int mt = 2 * mh; mt < 2 * mh + 2; ++mt)
#pragma unroll
            for (int nt = 0; nt < 4; ++nt) ctile_to_img(IAV, mt, nt, acc[mt][nt], lane);
        }
    }
    LDS_WAIT(); CFENCE();
    if (STOP == 7) return;
    ldsp IU = S6;
    {
#pragma unroll
        for (int mh = 0; mh < 2; ++mh) {
        f32x4 acc[4][4];
#pragma unroll
        for (int mt = 2 * mh; mt < 2 * mh + 2; ++mt)
#pragma unroll
            for (int nt = 0; nt < 4; ++nt) acc[mt][nt] = (f32x4){0.f, 0.f, 0.f, 0.f};
        MM_LOOPH(acc, frag_row(IT, 16 * mt, 32 * ks, lane), frag_tr(IAV, 32 * ks, 16 * nt, lane));
        LDS_WAIT(); CFENCE();
#pragma unroll
        for (int mt = 2 * mh; mt < 2 * mh + 2; ++mt)
#pragma unroll
            for (int nt = 0; nt < 4; ++nt) ctile_to_img(IU, mt, nt, acc[mt][nt], lane);
        }
    }
    LDS_WAIT(); CFENCE();
    if (STOP == 3) return;
    ldsp IRB = S4, IRK = S7;
    {
#pragma unroll
        for (int mh = 0; mh < 2; ++mh) {
        f32x4 acc[4][4];
#pragma unroll
        for (int mt = 2 * mh; mt < 2 * mh + 2; ++mt)
#pragma unroll
            for (int nt = 0; nt < 4; ++nt) acc[mt][nt] = (f32x4){0.f, 0.f, 0.f, 0.f};
        MM_LOOPH(acc, frag_row(IR, 16 * mt, 32 * ks, lane), frag_row(IB, 16 * nt, 32 * ks, lane));
#pragma unroll
        for (int mt = 2 * mh; mt < 2 * mh + 2; ++mt)
#pragma unroll
            for (int nt = 0; nt < 4; ++nt) {
#pragma unroll
                for (int e = 0; e < 4; ++e) { const int i = 16 * mt + 4 * q_ + e, j = 16 * nt + n_; if (!(j <= i)) acc[mt][nt][e] = 0.f; }
                ctile_to_img(IRB, mt, nt, acc[mt][nt], lane); }
        }
    }
    {
#pragma unroll
        for (int mh = 0; mh < 2; ++mh) {
        f32x4 acc[4][4];
#pragma unroll
        for (int mt = 2 * mh; mt < 2 * mh + 2; ++mt)
#pragma unroll
            for (int nt = 0; nt < 4; ++nt) acc[mt][nt] = (f32x4){0.f, 0.f, 0.f, 0.f};
        MM_LOOPH(acc, frag_row(IR, 16 * mt, 32 * ks, lane), frag_row(IK, 16 * nt, 32 * ks, lane));
#pragma unroll
        for (int mt = 2 * mh; mt < 2 * mh + 2; ++mt)
#pragma unroll
            for (int nt = 0; nt < 4; ++nt) {
#pragma unroll
                for (int e = 0; e < 4; ++e) { const int i = 16 * mt + 4 * q_ + e, j = 16 * nt + n_; if (!(j <= i)) acc[mt][nt][e] = 0.f; }
                ctile_to_img(IRK, mt, nt, acc[mt][nt], lane); }
        }
    }
    LDS_WAIT(); CFENCE();
    int lane3 = lane; asm volatile("" : "+v"(lane3));
    const int n3 = lane3 & 15, q3 = lane3 >> 4;
    const size_t slot0 = (size_t)cn * 64 * 512 + h * 64;
    {
#pragma unroll
        for (int mh = 0; mh < 2; ++mh) {
        f32x4 acc[4][4];
#pragma unroll
        for (int mt = 2 * mh; mt < 2 * mh + 2; ++mt)
#pragma unroll
            for (int nt = 0; nt < 4; ++nt) { const s16x4 r4 = *(LAS const s16x4*)(IR + (16 * nt + n3) * 128 + (16 * mt + 4 * q3) * 2);
#pragma unroll
                for (int e = 0; e < 4; ++e) acc[mt][nt][e] = bf2f((bf16)r4[e]); }
        MM_LOOPH(acc, frag_tr(IW, 32 * ks, 16 * mt, lane), frag_row(IRB, 16 * nt, 32 * ks, lane));
#pragma unroll
        for (int mt = 2 * mh; mt < 2 * mh + 2; ++mt)
#pragma unroll
            for (int nt = 0; nt < 4; ++nt) { bf16* dst = (bf16*)(LWo + slot0 + (size_t)(16 * nt + n3) * 512) + 16 * mt + 4 * q3;
                *(unsigned long long*)dst = (unsigned long long)pk2(acc[mt][nt][0], acc[mt][nt][1]) | ((unsigned long long)pk2(acc[mt][nt][2], acc[mt][nt][3]) << 32); }
        }
    }
    {
#pragma unroll
        for (int mh = 0; mh < 2; ++mh) {
        f32x4 acc[4][4];
#pragma unroll
        for (int mt = 2 * mh; mt < 2 * mh + 2; ++mt)
#pragma unroll
            for (int nt = 0; nt < 4; ++nt) acc[mt][nt] = (f32x4){0.f, 0.f, 0.f, 0.f};
        MM_LOOPH(acc, frag_tr(IU, 32 * ks, 16 * mt, lane), frag_row(IRB, 16 * nt, 32 * ks, lane));
        MM_LOOPH(acc, frag_tr(IV, 32 * ks, 16 * mt, lane), frag_row(IRK, 16 * nt, 32 * ks, lane));
#pragma unroll
        for (int mt = 2 * mh; mt < 2 * mh + 2; ++mt)
#pragma unroll
            for (int nt = 0; nt < 4; ++nt) { bf16* dst = (bf16*)(LWo + slot0 + (size_t)(16 * nt + n3) * 512) + 64 + 16 * mt + 4 * q3;
                *(unsigned long long*)dst = (unsigned long long)pk2(acc[mt][nt][0], acc[mt][nt][1]) | ((unsigned long long)pk2(acc[mt][nt][2], acc[mt][nt][3]) << 32); }
        }
    }
    {
#pragma unroll
        for (int mh = 0; mh < 2; ++mh) {
        f32x4 acc[4][4];
#pragma unroll
        for (int mt = 2 * mh; mt < 2 * mh + 2; ++mt)
#pragma unroll
            for (int nt = 0; nt < 4; ++nt) acc[mt][nt] = (f32x4){0.f, 0.f, 0.f, 0.f};
        MM_LOOPH(acc, frag_tr(IW, 32 * ks, 16 * mt, lane), frag_tr(IB, 32 * ks, 16 * nt, lane));
#pragma unroll
        for (int nt = 0; nt < 4; ++nt) { const float gk = __shfl(GT, 16 * nt + n3);
#pragma unroll
            for (int mt = 2 * mh; mt < 2 * mh + 2; ++mt) { float o[4];
#pragma unroll
                for (int e = 0; e < 4; ++e) o[e] = gk * (acc[mt][nt][e] + ((16 * mt + 4 * q3 + e) == (16 * nt + n3) ? 1.f : 0.f));
                bf16* dst = KDo + slot0 + (size_t)(16 * nt + n3) * 512 + 16 * mt + 4 * q3;
                *(unsigned long long*)dst = (unsigned long long)pk2(o[0], o[1]) | ((unsigned long long)pk2(o[2], o[3]) << 32); } }
        }
    }
    {
#pragma unroll
        for (int mh = 0; mh < 2; ++mh) {
        f32x4 acc[4][4];
#pragma unroll
        for (int mt = 2 * mh; mt < 2 * mh + 2; ++mt)
#pragma unroll
            for (int nt = 0; nt < 4; ++nt) acc[mt][nt] = (f32x4){0.f, 0.f, 0.f, 0.f};
        MM_LOOPH(acc, frag_tr(IB, 32 * ks, 16 * mt, lane), frag_tr(IU, 32 * ks, 16 * nt, lane));
        MM_LOOPH(acc, frag_tr(IK, 32 * ks, 16 * mt, lane), frag_tr(IV, 32 * ks, 16 * nt, lane));
#pragma unroll
        for (int mt = 2 * mh; mt < 2 * mh + 2; ++mt) { float gk[4];
#pragma unroll
            for (int e = 0; e < 4; ++e) gk[e] = __shfl(GT, 16 * mt + 4 * q3 + e);
#pragma unroll
            for (int nt = 0; nt < 4; ++nt) { bf16* dst = BBo + slot0 + (size_t)(16 * nt + n3) * 512 + 16 * mt + 4 * q3;
                *(unsigned long long*)dst = (unsigned long long)pk2(gk[0] * acc[mt][nt][0], gk[1] * acc[mt][nt][1]) | ((unsigned long long)pk2(gk[2] * acc[mt][nt][2], gk[3] * acc[mt][nt][3]) << 32); } }
        }
    }
    LDS_WAIT(); CFENCE();
}
DI unsigned long long pk4(const f32x4& v) { return (unsigned long long)pk2(v[0], v[1]) | ((unsigned long long)pk2(v[2], v[3]) << 32); }
DI f32x4 unpk4(unsigned long long w) { return (f32x4){bflo((unsigned)w), bfhi((unsigned)w), bflo((unsigned)(w >> 32)), bfhi((unsigned)(w >> 32))}; }
DI s16x8 pack_cpair(const f32x4& lo, const f32x4& hi) {
    v4u p; p.x = pk2(lo[0], lo[1]); p.y = pk2(lo[2], lo[3]); p.z = pk2(hi[0], hi[1]); p.w = pk2(hi[2], hi[3]);
    return __builtin_bit_cast(s16x8, p);
}
DI void rwkv_pass2_wave(unsigned char* ws, int w  , int lane) {
    const int z = w >> 5, h = (w >> 2) & 7, vs = w & 3;
    const bf16* Mm = (const bf16*)(ws + (z ? WS_KD1 : WS_KD0)); const bf16* Nn = (const bf16*)(ws + (z ? WS_B1 : WS_B0));
    bf16* Hst = (bf16*)(ws + (z ? WS_V : WS_R));
    const int n_ = lane & 15, q_ = lane >> 4;
    f32x4 H[4];
#pragma unroll
    for (int kt = 0; kt < 4; ++kt) H[kt] = (f32x4){0.f, 0.f, 0.f, 0.f};
    unsigned long long ma[4][2][2], nn[4];
    {
        const int cn = z ? 255 : 0; const size_t slot0 = (size_t)cn * 64 * 512 + h * 64;
#pragma unroll
        for (int kt = 0; kt < 4; ++kt) {
#pragma unroll
            for (int ks = 0; ks < 2; ++ks) { const bf16* row = Mm + slot0 + (size_t)(16 * kt + n_) * 512 + 32 * ks + 4 * q_;
                ma[kt][ks][0] = *(const unsigned long long*)row; ma[kt][ks][1] = *(const unsigned long long*)(row + 16); }
            nn[kt] = *(const unsigned long long*)(Nn + slot0 + (size_t)(16 * vs + n_) * 512 + 16 * kt + 4 * q_); }
    }
    for (int c = 0; c < 256; ++c) {
        { bf16* dst = Hst + ((size_t)(c * 8 + h) * 64 + 16 * vs + n_) * 64 + 4 * q_;
#pragma unroll
          for (int kt = 0; kt < 4; ++kt) *(unsigned long long*)(dst + 16 * kt) = (unsigned long long)pk2(H[kt][0], H[kt][1]) | ((unsigned long long)pk2(H[kt][2], H[kt][3]) << 32); }
        unsigned long long ma2[4][2][2], nn2[4];
        { const int c2 = c + 1 < 256 ? c + 1 : c; const int cn = z ? 255 - c2 : c2; const size_t slot0 = (size_t)cn * 64 * 512 + h * 64;
#pragma unroll
          for (int kt = 0; kt < 4; ++kt) {
#pragma unroll
            for (int ks = 0; ks < 2; ++ks) { const bf16* row = Mm + slot0 + (size_t)(16 * kt + n_) * 512 + 32 * ks + 4 * q_;
                ma2[kt][ks][0] = *(const unsigned long long*)row; ma2[kt][ks][1] = *(const unsigned long long*)(row + 16); }
            nn2[kt] = *(const unsigned long long*)(Nn + slot0 + (size_t)(16 * vs + n_) * 512 + 16 * kt + 4 * q_); } }
        const s16x8 b0 = pack_cpair(H[0], H[1]), b1 = pack_cpair(H[2], H[3]);
#pragma unroll
        for (int kt = 0; kt < 4; ++kt) {
            f32x4 acc = (f32x4){bflo((unsigned)nn[kt]), bfhi((unsigned)nn[kt]), bflo((unsigned)(nn[kt] >> 32)), bfhi((unsigned)(nn[kt] >> 32))};
            { v4u a; a.x = (unsigned)ma[kt][0][0]; a.y = (unsigned)(ma[kt][0][0] >> 32); a.z = (unsigned)ma[kt][0][1]; a.w = (unsigned)(ma[kt][0][1] >> 32); acc = mfma16(__builtin_bit_cast(s16x8, a), b0, acc); }
            { v4u a; a.x = (unsigned)ma[kt][1][0]; a.y = (unsigned)(ma[kt][1][0] >> 32); a.z = (unsigned)ma[kt][1][1]; a.w = (unsigned)(ma[kt][1][1] >> 32); acc = mfma16(__builtin_bit_cast(s16x8, a), b1, acc); }
            H[kt] = acc;
        }
#pragma unroll
        for (int kt = 0; kt < 4; ++kt) { nn[kt] = nn2[kt];
#pragma unroll
            for (int ks = 0; ks < 2; ++ks) { ma[kt][ks][0] = ma2[kt][ks][0]; ma[kt][ks][1] = ma2[kt][ks][1]; } }
    }
}
DI void rwkv_pass3_item(unsigned char* ws, int item, int lane) {
    const int z = item >> 11, h = (item >> 8) & 7, c = item & 255;
    const int cn = z ? 255 - c : c;
    const float* LW = (const float*)(ws + (z ? WS_LW1 : WS_LW0));
    const bf16* Hst = (const bf16*)(ws + (z ? WS_V : WS_R)) + (size_t)(c * 8 + h) * 64 * 64;
    bf16* Y = (bf16*)(ws + (z ? WS_Y1 : WS_Y0));
    const int n_ = lane & 15, q_ = lane >> 4;
    const size_t slot0 = (size_t)cn * 64 * 512 + h * 64;
    s16x8 hA[4][2], qB[4][2];
#pragma unroll
    for (int t = 0; t < 4; ++t)
#pragma unroll
        for (int ks = 0; ks < 2; ++ks) {
            hA[t][ks] = *(const s16x8*)(Hst + (size_t)(16 * t + n_) * 64 + 32 * ks + 8 * q_);
            qB[t][ks] = *(const s16x8*)((const bf16*)(LW + slot0 + (size_t)(16 * t + n_) * 512) + 32 * ks + 8 * q_); }
#pragma unroll
    for (int nt = 0; nt < 4; ++nt) {
        const int i = 16 * nt + n_; const bf16* ycrow = (const bf16*)(LW + slot0 + (size_t)i * 512) + 64;
        bf16* yrow = Y + (size_t)tok_of(z, cn, i) * 512 + h * 64;
#pragma unroll
        for (int mt = 0; mt < 4; ++mt) {
            const unsigned long long y4 = *(const unsigned long long*)(ycrow + 16 * mt + 4 * q_);
            f32x4 acc = (f32x4){bflo((unsigned)y4), bfhi((unsigned)y4), bflo((unsigned)(y4 >> 32)), bfhi((unsigned)(y4 >> 32))};
            acc = mfma16(hA[mt][0], qB[nt][0], acc); acc = mfma16(hA[mt][1], qB[nt][1], acc);
            *(unsigned long long*)(yrow + 16 * mt + 4 * q_) = (unsigned long long)pk2(acc[0], acc[1]) | ((unsigned long long)pk2(acc[2], acc[3]) << 32);
        }
    }
}
DI void rwkv_pass2_block(unsigned char* ws, ldsp L, int b  , int wave, int lane) {
    const int z = b >> 3, h = b & 7;
    if (wave >= 4) {
        const int lw = wave - 4;
        const char* Mm = (const char*)(ws + (z ? WS_KD1 : WS_KD0)); const char* Nn = (const char*)(ws + (z ? WS_B1 : WS_B0));
#define RW_ISSUE(cc) do { const int c_ = (cc); if (c_ < 256) { const int cn_ = z ? 255 - c_ : c_; const size_t slot0 = ((size_t)cn_ * 64 * 512 + h * 64) * 2; ldsp slot = L + (c_ & 7) * 16384; \
            _Pragma("unroll") for (int k = 0; k < 4; ++k) { const int pid = lw * 4 + k; const int pr = pid & 7; const int row = 8 * pr + (lane >> 3), p = lane & 7, cch = p ^ (row & 7); \
                const char* src = (pid < 8 ? Mm : Nn) + slot0 + (size_t)row * 1024 + cch * 16; \
                __builtin_amdgcn_global_load_lds((const unsigned*)src, (LAS unsigned*)(slot + (pid < 8 ? 0 : 8192) + pr * 1024), 16, 0, 0); } } } while (0)
        RW_ISSUE(0); RW_ISSUE(1); RW_ISSUE(2); RW_ISSUE(3); RW_ISSUE(4); RW_ISSUE(5); RW_ISSUE(6);
        for (int c = 0; c < 256; ++c) {
            if (c < 250) asm volatile("s_waitcnt vmcnt(24)" ::: "memory"); else asm volatile("s_waitcnt vmcnt(0)" ::: "memory");
            __builtin_amdgcn_s_barrier();
            asm volatile("" ::: "memory");
            RW_ISSUE(c + 7);
        }
#undef RW_ISSUE
        asm volatile("s_waitcnt vmcnt(0)" ::: "memory");
        return;
    }
    const int vs = wave;
    bf16* Hst = (bf16*)(ws + (z ? WS_V : WS_R));
    const int n_ = lane & 15, q_ = lane >> 4, wbyte = (q_ & 1) * 8, sw = n_ & 7;
    f32x4 H[4];
#pragma unroll
    for (int kt = 0; kt < 4; ++kt) H[kt] = (f32x4){0.f, 0.f, 0.f, 0.f};
    for (int c = 0; c < 256; ++c) {
        { bf16* dst = Hst + ((size_t)(c * 8 + h) * 64 + 16 * vs + n_) * 64 + 4 * q_;
#pragma unroll
          for (int kt = 0; kt < 4; ++kt) *(unsigned long long*)(dst + 16 * kt) = pk4(H[kt]); }
        asm volatile("s_waitcnt lgkmcnt(0)" ::: "memory");
        __builtin_amdgcn_s_barrier();
        asm volatile("" ::: "memory");
        ldsp slot = L + (c & 7) * 16384;
        const s16x8 b0 = pack_cpair(H[0], H[1]), b1 = pack_cpair(H[2], H[3]);
#pragma unroll
        for (int kt = 0; kt < 4; ++kt) {
            ldsp nrow = slot + 8192 + (16 * vs + n_) * 128 + wbyte;
            f32x4 acc = unpk4(*(LAS const unsigned long long*)(nrow + (((2 * kt + (q_ >> 1)) ^ sw) * 16)));
            ldsp mrow = slot + (16 * kt + n_) * 128 + wbyte;
#pragma unroll
            for (int ks = 0; ks < 2; ++ks) { const int c0 = 4 * ks + (q_ >> 1);
                const unsigned long long a0 = *(LAS const unsigned long long*)(mrow + ((c0 ^ sw) * 16)), a1 = *(LAS const unsigned long long*)(mrow + (((c0 + 2) ^ sw) * 16));
                v4u a; a.x = (unsigned)a0; a.y = (unsigned)(a0 >> 32); a.z = (unsigned)a1; a.w = (unsigned)(a1 >> 32);
                acc = mfma16(__builtin_bit_cast(s16x8, a), ks == 0 ? b0 : b1, acc); }
            H[kt] = acc;
        }
    }
}
DI void rwkv_pass3_post_item(const Args& a, unsigned char* ws, int item, int lane) {
    asm volatile("" : "+v"(lane));
    const int h = item >> 8, cn = item & 255;
    const int n_ = lane & 15, q_ = lane >> 4;
    const size_t slot0 = (size_t)cn * 64 * 512 + h * 64;
    const float* LW0 = (const float*)(ws + WS_LW0); const float* LW1 = (const float*)(ws + WS_LW1);
    const bf16* H0 = (const bf16*)(ws + WS_R) + (size_t)(cn * 8 + h) * 4096;
    const bf16* H1 = (const bf16*)(ws + WS_V) + (size_t)((255 - cn) * 8 + h) * 4096;
    s16x8 hA0[4][2], hA1[4][2];
#pragma unroll
    for (int t = 0; t < 4; ++t)
#pragma unroll
        for (int ks = 0; ks < 2; ++ks) { hA0[t][ks] = *(const s16x8*)(H0 + (size_t)(16 * t + n_) * 64 + 32 * ks + 8 * q_); hA1[t][ks] = *(const s16x8*)(H1 + (size_t)(16 * t + n_) * 64 + 32 * ks + 8 * q_); }
#pragma unroll
    for (int nt = 0; nt < 4; ++nt) {
        const int i0 = 16 * nt + n_, i1 = 63 - i0;
        const bf16* q0 = (const bf16*)(LW0 + slot0 + (size_t)i0 * 512); const bf16* q1 = (const bf16*)(LW1 + slot0 + (size_t)i1 * 512);
        s16x8 qB0[2], qB1[2];
#pragma unroll
        for (int ks = 0; ks < 2; ++ks) { qB0[ks] = *(const s16x8*)(q0 + 32 * ks + 8 * q_); qB1[ks] = *(const s16x8*)(q1 + 32 * ks + 8 * q_); }
        f32x4 y[4]; float sum = 0.f;
#pragma unroll
        for (int mt = 0; mt < 4; ++mt) {
            f32x4 acc = unpk4(*(const unsigned long long*)(q0 + 64 + 16 * mt + 4 * q_)) + unpk4(*(const unsigned long long*)(q1 + 64 + 16 * mt + 4 * q_));
            acc = mfma16(hA0[mt][0], qB0[0], acc); acc = mfma16(hA0[mt][1], qB0[1], acc);
            acc = mfma16(hA1[mt][0], qB1[0], acc); acc = mfma16(hA1[mt][1], qB1[1], acc);
            y[mt] = acc; sum += (acc[0] + acc[1]) + (acc[2] + acc[3]);
        }
        sum += __shfl_xor(sum, 16); sum += __shfl_xor(sum, 32);
        const float mu = sum * (1.0f / 64.f); float sq = 0.f;
#pragma unroll
        for (int mt = 0; mt < 4; ++mt)
#pragma unroll
            for (int e = 0; e < 4; ++e) { y[mt][e] -= mu; sq += y[mt][e] * y[mt][e]; }
        sq += __shfl_xor(sq, 16); sq += __shfl_xor(sq, 32);
        const float rs = 1.0f / sqrtf(sq * (1.0f / 64.f) + 64e-5f);
        const size_t tok = (size_t)(cn * 64 + i0);
#pragma unroll
        for (int mt = 0; mt < 4; ++mt) { const int c0 = h * 64 + 16 * mt + 4 * q_;
            const f32x4 lw = *(const f32x4*)(a.in[19] + c0), lb = *(const f32x4*)(a.in[20] + c0);
            const f32x4 bn = unpk4(*(const unsigned long long*)((const bf16*)(ws + WS_BONUS) + tok * 512 + c0)), gt = unpk4(*(const unsigned long long*)((const bf16*)(ws + WS_GATE) + tok * 512 + c0));
            const f32x4 o = (y[mt] * rs * lw + lb + bn) * gt;
            *(unsigned long long*)((bf16*)(ws + WS_Y) + tok * D_ + 512 + c0) = pk4(o); }
    }
}
constexpr size_t WS_W2T = WS_TILE + 65536;
constexpr size_t WS_PARK = WS_Y;
DI s16x8 act_frag(const bf16* p, int mode) {
    float v[8]; ld8(p, v);
#pragma unroll
    for (int i = 0; i < 8; ++i) { if (mode == 0) v[i] = 1.0f - 2.0f / (__expf(2.0f * v[i]) + 1.0f); else if (mode == 2) v[i] = 1.0f / (1.0f + __expf(-v[i])); }
    v4u w; w.x = pk2(v[0], v[1]); w.y = pk2(v[2], v[3]); w.z = pk2(v[4], v[5]); w.w = pk2(v[6], v[7]);
    return __builtin_bit_cast(s16x8, w);
}
DI void ld4(const bf16* p, float (&v)[4]) { const unsigned long long w = *(const unsigned long long*)p; v[0] = bflo((unsigned)w); v[1] = bfhi((unsigned)w); v[2] = bflo((unsigned)(w >> 32)); v[3] = bfhi((unsigned)(w >> 32)); }
DI void st4(bf16* p, const float (&v)[4]) { *(unsigned long long*)p = (unsigned long long)pk2(v[0], v[1]) | ((unsigned long long)pk2(v[2], v[3]) << 32); }
DI void prep0_rwkv_unit(const Args& a, unsigned char* ws_, ldsp wl, int tile, int h, int lane) {
    asm volatile("" : "+v"(lane));
    GAS unsigned char* wsg = (GAS unsigned char*)ws_; asm volatile("" : "+s"(wsg)); unsigned char* ws = (unsigned char*)wsg;
    const int t0 = tile * 16, n_ = lane & 15, q_ = lane >> 4, t = t0 + n_;
    const bf16* LR = (const bf16*)(ws + WS_LORA) + (size_t)t * LORA_N + 8 * q_;
    const bf16* P = (const bf16*)(ws + WS_PROJ0) + (size_t)t * EVEN_IN + 1536 + h * 64 + 4 * q_;
    const bool hp = t > 0, hn = t < S_ - 1;
    v4u lraw[12];
#pragma unroll
    for (int i = 0; i < 12; ++i) lraw[i] = *(const v4u*)(LR + 32 * i);
    unsigned long long cu[3][4], pv[3][4], nx[3][4];
#pragma unroll
    for (int part = 0; part < 3; ++part)
#pragma unroll
        for (int mt = 0; mt < 4; ++mt) { const bf16* p = P + part * 512 + 16 * mt;
            cu[part][mt] = *(const unsigned long long*)p; pv[part][mt] = hp ? *(const unsigned long long*)(p - EVEN_IN) : 0ull; nx[part][mt] = hn ? *(const unsigned long long*)(p + EVEN_IN) : 0ull; }
    float r[16], k[16], v[16];
#pragma unroll
    for (int part = 0; part < 3; ++part)
#pragma unroll
        for (int mt = 0; mt < 4; ++mt) { const int c0 = h * 64 + 16 * mt + 4 * q_;
            const f32x4 m0 = *(const f32x4*)(a.in[6] + part * 512 + c0), m1 = *(const f32x4*)(a.in[6] + 1536 + part * 512 + c0);
            const f32x4 c4 = unpk4(cu[part][mt]), p4 = unpk4(pv[part][mt]), n4 = unpk4(nx[part][mt]);
#pragma unroll
            for (int e = 0; e < 4; ++e) { const float o = c4[e] + m0[e] * (p4[e] - c4[e]) + m1[e] * (n4[e] - c4[e]);
                if (part == 0) r[4 * mt + e] = o; else if (part == 1) k[4 * mt + e] = o; else v[4 * mt + e] = o; } }
    float ss = 0.f;
#pragma unroll
    for (int mt = 0; mt < 4; ++mt) { const f32x4 kkw = *(const f32x4*)(a.in[16] + h * 64 + 16 * mt + 4 * q_);
#pragma unroll
        for (int e = 0; e < 4; ++e) { const float x = k[4 * mt + e] * kkw[e]; ss += x * x; } }
    ss += __shfl_xor(ss, 16); ss += __shfl_xor(ss, 32);
    const float rn = 1.0f / sqrtf(ss + 1e-6f);
    s16x8 lfr[12];
#pragma unroll
    for (int i = 0; i < 12; ++i) { float x[8]; const v4u w = lraw[i];
        x[0] = bflo(w.x); x[1] = bfhi(w.x); x[2] = bflo(w.y); x[3] = bfhi(w.y); x[4] = bflo(w.z); x[5] = bfhi(w.z); x[6] = bflo(w.w); x[7] = bfhi(w.w);
#pragma unroll
        for (int j = 0; j < 8; ++j) { if (i < 4) x[j] = 1.0f - 2.0f * __builtin_amdgcn_rcpf(__expf(2.0f * x[j]) + 1.0f); else if (i >= 8) x[j] = __builtin_amdgcn_rcpf(1.0f + __expf(-x[j])); }
        v4u o; o.x = pk2(x[0], x[1]); o.y = pk2(x[2], x[3]); o.z = pk2(x[4], x[5]); o.w = pk2(x[6], x[7]); lfr[i] = __builtin_bit_cast(s16x8, o); }
    float dotb = 0.f;
#pragma unroll
    for (int mt = 0; mt < 4; ++mt) {
        const int c0 = h * 64 + 16 * mt + 4 * q_;
        f32x4 aw0 = *(const f32x4*)(a.in[8] + c0), aw1 = *(const f32x4*)(a.in[8] + 512 + c0), aa0 = *(const f32x4*)(a.in[11] + c0), aa1 = *(const f32x4*)(a.in[11] + 512 + c0), ag = (f32x4){0.f, 0.f, 0.f, 0.f};
        const int rl = 16 * mt + n_, sw = rl & 7;
#pragma unroll
        for (int ks = 0; ks < 2; ++ks) { const int po = ((4 * ks + q_) ^ sw) * 16;
            aw0 = mfma16(*(LAS const s16x8*)(wl + rl * 128 + po), lfr[ks], aw0);
            aw1 = mfma16(*(LAS const s16x8*)(wl + 8192 + rl * 128 + po), lfr[2 + ks], aw1);
            aa0 = mfma16(*(LAS const s16x8*)(wl + 16384 + rl * 128 + po), lfr[4 + ks], aa0);
            aa1 = mfma16(*(LAS const s16x8*)(wl + 24576 + rl * 128 + po), lfr[6 + ks], aa1);
        }
#pragma unroll
        for (int ks = 0; ks < 4; ++ks) ag = mfma16(*(LAS const s16x8*)(wl + 32768 + rl * 256 + ((((4 * ks + q_) & 8) | (((4 * ks + q_) & 7) ^ sw)) * 16)), lfr[8 + ks], ag);
        const f32x4 kkw = *(const f32x4*)(a.in[16] + c0), kaw = *(const f32x4*)(a.in[17] + c0), rkw = *(const f32x4*)(a.in[18] + c0);
        float l0[4], l1[4], g4[4], d0[4], d1[4], kk4[4], b0[4], b1[4], r4[4], v4[4];
#pragma unroll
        for (int e = 0; e < 4; ++e) { const int i = 4 * mt + e;
            l0[e] = -__expf(-__logf(1.0f + __expf(-aw0[e])) - 0.5f); l1[e] = -__expf(-__logf(1.0f + __expf(-aw1[e])) - 0.5f);
            const float i0 = __builtin_amdgcn_rcpf(1.0f + __expf(-aa0[e])), i1 = __builtin_amdgcn_rcpf(1.0f + __expf(-aa1[e])); g4[e] = ag[e];
            kk4[e] = k[i] * kkw[e] * rn; b0[e] = kk4[e] * i0; b1[e] = kk4[e] * i1;
            d0[e] = k[i] * (1.0f + (i0 - 1.0f) * kaw[e]); d1[e] = k[i] * (1.0f + (i1 - 1.0f) * kaw[e]);
            dotb += r[i] * (d0[e] + d1[e]) * rkw[e]; r4[e] = r[i]; v4[e] = v[i]; }
        const size_t o = (size_t)t * 512 + c0;
        *(f32x4*)((float*)(ws + WS_LW0) + o) = (f32x4){l0[0], l0[1], l0[2], l0[3]};
        *(f32x4*)((float*)(ws + WS_LW1) + o) = (f32x4){l1[0], l1[1], l1[2], l1[3]};
        st4((bf16*)(ws + WS_R) + o, r4); st4((bf16*)(ws + WS_V) + o, v4); st4((bf16*)(ws + WS_KK) + o, kk4); st4((bf16*)(ws + WS_KD0) + o, d0); st4((bf16*)(ws + WS_KD1) + o, d1);
        st4((bf16*)(ws + WS_B0) + o, b0); st4((bf16*)(ws + WS_B1) + o, b1); st4((bf16*)(ws + WS_GATE) + o, g4);
    }
    dotb += __shfl_xor(dotb, 16); dotb += __shfl_xor(dotb, 32);
#pragma unroll
    for (int mt = 0; mt < 4; ++mt) { float bo[4];
#pragma unroll
        for (int e = 0; e < 4; ++e) bo[e] = dotb * v[4 * mt + e];
        st4((bf16*)(ws + WS_BONUS) + (size_t)t * 512 + h * 64 + 16 * mt + 4 * q_, bo); }
}
DI void prep0_stage_w2t(unsigned char* ws, ldsp wl, int h, int tid) {
    const bf16* W2T = (const bf16*)(ws + WS_W2T);
    for (int i = tid; i < 3072; i += 512) {
        if (i < 2048) { const int mtx = i >> 9, r = (i >> 3) & 63, c = i & 7;
            *(LAS v4u*)(wl + mtx * 8192 + r * 128 + ((c ^ (r & 7)) * 16)) = *(const v4u*)(W2T + (size_t)mtx * 32768 + (size_t)(h * 64 + r) * 64 + c * 8); }
        else { const int j = i - 2048, r = j >> 4, c = j & 15;
            *(LAS v4u*)(wl + 32768 + r * 256 + (((c & 8) | ((c & 7) ^ (r & 7))) * 16)) = *(const v4u*)(W2T + 131072 + (size_t)(h * 64 + r) * 128 + c * 8); }
    }
}
constexpr int AT_ACC = 0, AT_M = 65536, AT_L = 66560, AT_V = 67584;
DI void attn_unit(unsigned char* ws, ldsp L, int unit, int wave, int lane) {
    const int h = unit & 7, T0 = (unit >> 3) * 256;
    const bf16* QN = (const bf16*)(ws + WS_QN); const bf16* KN = (const bf16*)(ws + WS_KN); const bf16* VN = (const bf16*)(ws + WS_Y1);
    LAS float* accO = (LAS float*)(L + AT_ACC); LAS float* accM = (LAS float*)(L + AT_M); LAS float* accL = (LAS float*)(L + AT_L);
    ldsp Vst = L + AT_V + wave * 8192;
#pragma unroll 1
    for (int br = 0; br < 3; ++br) {
        const int d = br == 0 ? 1 : (br == 1 ? 4 : 16);
#pragma unroll 1
        for (int si = 0; si < 2; ++si) {
            int lane_s = lane; asm volatile("" : "+v"(lane_s));
            const int n_ = lane_s & 15, q_ = lane_s >> 4;
            const int sidx = wave + 8 * si;
            const int tb = br == 0 ? T0 + 16 * sidx : (br == 1 ? T0 + (sidx & 3) + 64 * (sidx >> 2) : T0 + sidx);
            s16x8 qf[2];
            { const bf16* qrow = QN + (size_t)(tb + d * n_) * 512 + h * 64 + 8 * q_; qf[0] = *(const s16x8*)qrow; qf[1] = *(const s16x8*)(qrow + 32); }
            v4u vreg[5][4];
#pragma unroll
            for (int pp = 0; pp < 5; ++pp)
#pragma unroll
                for (int it = 0; it < 4; ++it) { const int pc = lane + 64 * it, row = pc >> 3, ck = pc & 7;
                    int tk = tb + d * (32 * pp + row - 64); tk = tk < 0 ? 0 : (tk > S_ - 1 ? S_ - 1 : tk);
                    vreg[pp][it] = *(const v4u*)(VN + (size_t)tk * 512 + h * 64 + ck * 8); }
            f32x4 st[10]; st[9] = (f32x4){0.f, 0.f, 0.f, 0.f};
#pragma unroll
            for (int kt = 0; kt < 9; ++kt) {
                int tk = tb + d * (16 * kt + n_ - 64); tk = tk < 0 ? 0 : (tk > S_ - 1 ? S_ - 1 : tk);
                const bf16* krow = KN + (size_t)tk * 512 + h * 64 + 8 * q_;
                f32x4 acc = (f32x4){0.f, 0.f, 0.f, 0.f};
                acc = mfma16(*(const s16x8*)krow, qf[0], acc); acc = mfma16(*(const s16x8*)(krow + 32), qf[1], acc);
                st[kt] = acc;
            }
            float mx = -3.0e38f;
            const bool edge = (tb - 64 * d < 0) || (tb + d * 95 >= S_);
#pragma unroll
            for (int kt = 0; kt < 9; ++kt)
#pragma unroll
                for (int e = 0; e < 4; ++e) { const int j = 16 * kt + 4 * q_ + e;
                    bool ok = true;
                    if (kt == 0) ok = (j >= n_);
                    if (kt == 8) ok = (j <= n_ + 128);
                    if (edge) { const int tk = tb + d * (j - 64); ok = ok && (tk >= 0) && (tk < S_); }
                    st[kt][e] = ok ? st[kt][e] : -3.0e38f; mx = fmaxf(mx, st[kt][e]); }
            mx = fmaxf(mx, __shfl_xor(mx, 16)); mx = fmaxf(mx, __shfl_xor(mx, 32));
            float ls = 0.f;
#pragma unroll
            for (int kt = 0; kt < 9; ++kt)
#pragma unroll
                for (int e = 0; e < 4; ++e) { const float p = st[kt][e] > -1.0e38f ? __expf(st[kt][e] - mx) : 0.f; st[kt][e] = p; ls += p; }
            ls += __shfl_xor(ls, 16); ls += __shfl_xor(ls, 32);
            f32x4 O[4];
#pragma unroll
            for (int dt = 0; dt < 4; ++dt) O[dt] = (f32x4){0.f, 0.f, 0.f, 0.f};
#pragma unroll
            for (int pp = 0; pp < 5; ++pp) {
                ldsp vb = Vst + (pp & 1) * 4096;
#pragma unroll
                for (int it = 0; it < 4; ++it) { const int pc = lane + 64 * it, row = pc >> 3, ck = pc & 7; *(LAS v4u*)(vb + row * 128 + ck * 16) = vreg[pp][it]; }
                LDS_WAIT(); CFENCE();
                const s16x8 pa = pack_cpair(st[2 * pp], st[2 * pp + 1]);
                ldsp a0 = vb + (4 * q_ + ((lane & 15) >> 2)) * 128 + 8 * (lane & 3);
#pragma unroll
                for (int dt = 0; dt < 4; ++dt) { const s16x4 lo = tr16(a0 + 32 * dt), hi = tr16(a0 + 16 * 128 + 32 * dt);
                    O[dt] = mfma16(pa, __builtin_shufflevector(lo, hi, 0, 1, 2, 3, 4, 5, 6, 7), O[dt]); }
            }
            float ms[4], lsv[4]; int li[4];
#pragma unroll
            for (int e = 0; e < 4; ++e) { ms[e] = __shfl(mx, 4 * q_ + e); lsv[e] = __shfl(ls, 4 * q_ + e); li[e] = tb + d * (4 * q_ + e) - T0; }
            if (br == 0) {
#pragma unroll
                for (int e = 0; e < 4; ++e) {
#pragma unroll
                    for (int dt = 0; dt < 4; ++dt) accO[li[e] * 64 + 16 * dt + n_] = O[dt][e];
                    if (n_ == 0) { accM[li[e]] = ms[e]; accL[li[e]] = lsv[e]; } }
            } else {
                float fo[4], fn[4], mn[4], lo_[4];
#pragma unroll
                for (int e = 0; e < 4; ++e) { const float mo = accM[li[e]]; lo_[e] = accL[li[e]]; mn[e] = fmaxf(mo, ms[e]); fo[e] = __expf(mo - mn[e]); fn[e] = __expf(ms[e] - mn[e]); }
                LDS_WAIT(); CFENCE();
#pragma unroll
                for (int e = 0; e < 4; ++e) {
#pragma unroll
                    for (int dt = 0; dt < 4; ++dt) { LAS float* p = accO + li[e] * 64 + 16 * dt + n_; *p = *p * fo[e] + O[dt][e] * fn[e]; }
                    if (n_ == 0) { accM[li[e]] = mn[e]; accL[li[e]] = lo_[e] * fo[e] + lsv[e] * fn[e]; } }
            }
            LDS_WAIT(); CFENCE();
        }
        __syncthreads();
    }
    {
        const int tid = wave * 64 + lane, tl = tid >> 1, hf = tid & 1;
        const float il = 1.0f / accL[tl];
        const LAS float* src = accO + tl * 64 + 32 * hf; bf16* dst = (bf16*)(ws + WS_Y) + (size_t)(T0 + tl) * D_ + h * 64 + 32 * hf;
#pragma unroll
        for (int c = 0; c < 4; ++c) { const f32x4 a = *(LAS const f32x4*)(src + 8 * c), b = *(LAS const f32x4*)(src + 8 * c + 4);
            v4u w; w.x = pk2(a.x * il, a.y * il); w.y = pk2(a.z * il, a.w * il); w.z = pk2(b.x * il, b.y * il); w.w = pk2(b.z * il, b.w * il);
            *(v4u*)(dst + 8 * c) = w; }
    }
    __syncthreads();
}
constexpr size_t WS_SST = WS_PROJ1, WS_UB = WS_PROJ1 + 64 * MiB, WS_AT = WS_PROJ1 + 96 * MiB, WS_GC = WS_PROJ1 + 112 * MiB;
constexpr size_t WS_WN = WS_A + 112 * MiB, WS_KT = WS_A + 144 * MiB;
static_assert(WS_GC + 2048 * 64 * 4 <= WS_O0, "dn map");
template <int PITCH> DI s16x8 frag_row_p(ldsp img, int row0, int col0, int lane) { return *(LAS const s16x8*)(img + (row0 + (lane & 15)) * PITCH + (col0 + 8 * (lane >> 4)) * 2); }
template <int PITCH> DI s16x8 frag_tr_p(ldsp img, int row0, int col0, int lane) {
    ldsp a0 = img + (row0 + 8 * (lane >> 4) + ((lane & 15) >> 2)) * PITCH + col0 * 2 + 8 * (lane & 3);
    const s16x4 lo = tr16(a0), hi = tr16(a0 + 4 * PITCH);
    return __builtin_shufflevector(lo, hi, 0, 1, 2, 3, 4, 5, 6, 7);
}
constexpr int DN_LDS_PER_WAVE = 32768 + 512;
DI void dn_pass1_item(unsigned char* ws, ldsp lds, int item, int lane) {
    asm volatile("" : "+v"(lane));
    const int z = item >> 10, h = (item >> 8) & 3, c = item & 255, cn = z ? 255 - c : c;
    const bf16* Q = (const bf16*)(ws + WS_QD); const bf16* K = (const bf16*)(ws + WS_KD); const bf16* V = (const bf16*)(ws + WS_VD);
    ldsp IKd = lds, IVd = lds, LT = lds + 16384; LAS float* gcs = (LAS float*)(lds + 32768); LAS float* bts = gcs + 64;
    const int n_ = lane & 15, q_ = lane >> 4;
    {
        const int tok = tok_of(z, cn, lane);
        float gc = ((const float*)(ws + WS_GB))[(size_t)tok * 8 + z * 4 + h]; const float bt = ((const float*)(ws + WS_GB + 512 * 1024))[(size_t)tok * 8 + z * 4 + h];
#pragma unroll
        for (int o = 1; o < 64; o <<= 1) { const float t = __shfl_up(gc, o); if (lane >= o) gc += t; }
        gcs[lane] = gc; bts[lane] = bt; ((float*)(ws + WS_GC))[(size_t)item * 64 + lane] = gc;
    }
#pragma unroll 4
    for (int it = 0; it < 16; ++it) { const int p = lane + 64 * it, row = p >> 4, ck = p & 15; const size_t go = (size_t)tok_of(z, cn, row) * 512 + h * 128 + ck * 8;
        *(LAS v4u*)(IKd + row * 256 + ck * 16) = *(const v4u*)(K + go); }
    LDS_WAIT(); CFENCE();
    s16x8 kf[4][4];
#pragma unroll
    for (int rt = 0; rt < 4; ++rt)
#pragma unroll
        for (int ks = 0; ks < 4; ++ks) kf[rt][ks] = frag_row_p<256>(IKd, 16 * rt, 32 * ks, lane);
#pragma unroll
    for (int mt = 0; mt < 4; ++mt) { f32x4 gi, bi;
#pragma unroll
        for (int e = 0; e < 4; ++e) { gi[e] = gcs[16 * mt + 4 * q_ + e]; bi[e] = bts[16 * mt + 4 * q_ + e]; }
#pragma unroll
        for (int nt = 0; nt < 4; ++nt) { f32x4 acc = (f32x4){0.f, 0.f, 0.f, 0.f};
            if (nt <= mt) {
#pragma unroll
                for (int ks = 0; ks < 4; ++ks) acc = mfma16(kf[mt][ks], kf[nt][ks], acc); }
            const float gj = gcs[16 * nt + n_];
#pragma unroll
            for (int e = 0; e < 4; ++e) { const int i = 16 * mt + 4 * q_ + e, j = 16 * nt + n_; ((LAS float*)LT)[i * 64 + j] = (j < i) ? bi[e] * acc[e] * __expf(gi[e] - gj) : 0.f; } } }
    {
        bf16* At = (bf16*)(ws + WS_AT) + (size_t)item * 4096;
#pragma unroll
        for (int nt = 0; nt < 4; ++nt) { s16x8 qf[4]; const bf16* qrow = Q + (size_t)tok_of(z, cn, 16 * nt + n_) * 512 + h * 128 + 8 * q_;
#pragma unroll
            for (int ks = 0; ks < 4; ++ks) qf[ks] = *(const s16x8*)(qrow + 32 * ks);
            const float gi = gcs[16 * nt + n_];
#pragma unroll
            for (int mt = 0; mt < 4; ++mt) { f32x4 acc = (f32x4){0.f, 0.f, 0.f, 0.f};
                if (mt <= nt) {
#pragma unroll
                    for (int ks = 0; ks < 4; ++ks) acc = mfma16(kf[mt][ks], qf[ks], acc); }
                f32x4 o;
#pragma unroll
                for (int e = 0; e < 4; ++e) { const int j = 16 * mt + 4 * q_ + e, i = 16 * nt + n_; o[e] = (j <= i) ? acc[e] * __expf(gi - gcs[j]) : 0.f; }
                *(unsigned long long*)(At + (size_t)(16 * nt + n_) * 64 + 16 * mt + 4 * q_) = pk4(o); } }
    }
    LDS_WAIT(); CFENCE();
    {
        float t[64];
        int lane_o = lane; asm volatile("" : "+v"(lane_o));
        f32x4 ar[2][16];
#pragma unroll
        for (int i = 0; i < 64; ++i) {
            if (i + 1 < 64) {
#pragma unroll
                for (int jg = 0; jg < (i + 1 + 3) / 4; ++jg) ar[(i + 1) & 1][jg] = *(LAS const f32x4*)(LT + ((i + 1) * 64 + 4 * jg) * 4);
            }
            __builtin_amdgcn_sched_barrier(0);
            float acc0 = (lane_o == i) ? 1.f : 0.f, acc1 = 0.f, acc2 = 0.f, acc3 = 0.f;
#pragma unroll
            for (int jg = 0; jg < (i + 3) / 4; ++jg) { const f32x4 a4 = ar[i & 1][jg];
                if (4 * jg + 0 < i) acc0 -= a4[0] * t[4 * jg + 0];
                if (4 * jg + 1 < i) acc1 -= a4[1] * t[4 * jg + 1];
                if (4 * jg + 2 < i) acc2 -= a4[2] * t[4 * jg + 2];
                if (4 * jg + 3 < i) acc3 -= a4[3] * t[4 * jg + 3]; }
            t[i] = (acc0 + acc1) + (acc2 + acc3);
            __builtin_amdgcn_sched_barrier(0);
        }
        LDS_WAIT(); CFENCE();
        const float s1 = bts[lane], s2 = -s1 * __expf(gcs[lane]);
#pragma unroll
        for (int i = 0; i < 64; ++i) { ((LAS bf16*)LT)[i * 64 + lane] = (bf16)f2bf(t[i] * s1); ((LAS bf16*)(LT + 8192))[i * 64 + lane] = (bf16)f2bf(t[i] * s2); }
    }
    LDS_WAIT(); CFENCE();
    ldsp IT1 = LT, IT2 = LT + 8192;
    v4u vimg[16];
#pragma unroll
    for (int it = 0; it < 16; ++it) { const int p = lane + 64 * it, row = p >> 4, ck = p & 15; vimg[it] = *(const v4u*)(V + (size_t)tok_of(z, cn, row) * 512 + h * 128 + ck * 8); }
    {
        bf16* Wn = (bf16*)(ws + WS_WN) + (size_t)item * 8192;
        s16x8 tf[4][2];
#pragma unroll
        for (int nt = 0; nt < 4; ++nt)
#pragma unroll
            for (int ks = 0; ks < 2; ++ks) tf[nt][ks] = frag_row_p<128>(IT2, 16 * nt, 32 * ks, lane);
#pragma unroll
        for (int mt = 0; mt < 8; ++mt) { const s16x8 k0 = frag_tr_p<256>(IKd, 0, 16 * mt, lane), k1 = frag_tr_p<256>(IKd, 32, 16 * mt, lane);
            if (z == 0) { bf16* KT = (bf16*)(ws + WS_KT) + ((size_t)(h * 256 + cn) * 128 + 16 * mt + n_) * 64 + 8 * q_; *(s16x8*)KT = k0; *(s16x8*)(KT + 32) = k1; }
#pragma unroll
            for (int nt = 0; nt < 4; ++nt) { f32x4 acc = (f32x4){0.f, 0.f, 0.f, 0.f}; acc = mfma16(k0, tf[nt][0], acc); acc = mfma16(k1, tf[nt][1], acc);
                *(unsigned long long*)(Wn + (size_t)(16 * nt + n_) * 128 + 16 * mt + 4 * q_) = pk4(acc); } }
    }
    LDS_WAIT(); CFENCE();
#pragma unroll
    for (int it = 0; it < 16; ++it) { const int p = lane + 64 * it, row = p >> 4, ck = p & 15; *(LAS v4u*)(IVd + row * 256 + ck * 16) = vimg[it]; }
    LDS_WAIT(); CFENCE();
    {
        bf16* Ub = (bf16*)(ws + WS_UB) + (size_t)item * 8192;
        s16x8 tf[4][2];
#pragma unroll
        for (int mt = 0; mt < 4; ++mt)
#pragma unroll
            for (int ks = 0; ks < 2; ++ks) tf[mt][ks] = frag_row_p<128>(IT1, 16 * mt, 32 * ks, lane);
#pragma unroll
        for (int nt = 0; nt < 8; ++nt) { const s16x8 v0 = frag_tr_p<256>(IVd, 0, 16 * nt, lane), v1 = frag_tr_p<256>(IVd, 32, 16 * nt, lane);
#pragma unroll
            for (int mt = 0; mt < 4; ++mt) { f32x4 acc = (f32x4){0.f, 0.f, 0.f, 0.f}; acc = mfma16(tf[mt][0], v0, acc); acc = mfma16(tf[mt][1], v1, acc);
                *(unsigned long long*)(Ub + (size_t)(16 * nt + n_) * 64 + 16 * mt + 4 * q_) = pk4(acc); } }
    }
    LDS_WAIT(); CFENCE();
}
DI s16x8 pack_cpair_rev(const f32x4& lo, const f32x4& hi) { v4u p; p.x = pk2(lo[3], lo[2]); p.y = pk2(lo[1], lo[0]); p.z = pk2(hi[3], hi[2]); p.w = pk2(hi[1], hi[0]); return __builtin_bit_cast(s16x8, p); }
DI unsigned long long rev4(unsigned long long x) { return (x >> 48) | ((x >> 16) & 0xffff0000ull) | ((x << 16) & 0xffff00000000ull) | (x << 48); }
DI void dn_pass2_wave(unsigned char* ws, int w  , int lane) {
    const int z = w >> 5, h = (w >> 3) & 3, vs = w & 7;
    const int n_ = lane & 15, q_ = lane >> 4;
    f32x4 S[8];
#pragma unroll
    for (int kt = 0; kt < 8; ++kt) S[kt] = (f32x4){0.f, 0.f, 0.f, 0.f};
    for (int c = 0; c < 256; ++c) {
        const int item = (z * 4 + h) * 256 + c, cn = z ? 255 - c : c;
        const bf16* Wn = (const bf16*)(ws + WS_WN) + (size_t)item * 8192; const bf16* Ub = (const bf16*)(ws + WS_UB) + (size_t)item * 8192;
        const float* gcu = (const float*)(ws + WS_GC) + (size_t)item * 64;
        const bf16* KT = (const bf16*)(ws + WS_KT) + (size_t)(h * 256 + cn) * 128 * 64;
        bf16* Sst = (bf16*)(ws + WS_SST) + (size_t)item * 16384;
        f32x4 u[4], gv[4];
#pragma unroll
        for (int mt = 0; mt < 4; ++mt) { u[mt] = unpk4(*(const unsigned long long*)(Ub + (size_t)(16 * vs + n_) * 64 + 16 * mt + 4 * q_)); gv[mt] = *(const f32x4*)(gcu + 16 * mt + 4 * q_); }
        const float gl = gcu[63];
        unsigned long long wa[4][4][2], ka[8][2][2];
#pragma unroll
        for (int mt = 0; mt < 4; ++mt)
#pragma unroll
            for (int ks = 0; ks < 4; ++ks) { const bf16* row = Wn + (size_t)(16 * mt + n_) * 128 + 32 * ks + 4 * q_; wa[mt][ks][0] = *(const unsigned long long*)row; wa[mt][ks][1] = *(const unsigned long long*)(row + 16); }
#pragma unroll
        for (int kt = 0; kt < 8; ++kt)
#pragma unroll
            for (int ks = 0; ks < 2; ++ks) { const bf16* row = KT + (size_t)(16 * kt + n_) * 64;
                if (z == 0) { ka[kt][ks][0] = *(const unsigned long long*)(row + 32 * ks + 4 * q_); ka[kt][ks][1] = *(const unsigned long long*)(row + 32 * ks + 16 + 4 * q_); }
                else { ka[kt][ks][0] = rev4(*(const unsigned long long*)(row + 60 - 32 * ks - 4 * q_)); ka[kt][ks][1] = rev4(*(const unsigned long long*)(row + 44 - 32 * ks - 4 * q_)); } }
#pragma unroll
        for (int kt = 0; kt < 8; ++kt) *(unsigned long long*)(Sst + (size_t)(16 * vs + n_) * 128 + 16 * kt + 4 * q_) = pk4(S[kt]);
#pragma unroll
        for (int ks = 0; ks < 4; ++ks) { const s16x8 b = pack_cpair(S[2 * ks], S[2 * ks + 1]);
#pragma unroll
            for (int mt = 0; mt < 4; ++mt) { v4u a; a.x = (unsigned)wa[mt][ks][0]; a.y = (unsigned)(wa[mt][ks][0] >> 32); a.z = (unsigned)wa[mt][ks][1]; a.w = (unsigned)(wa[mt][ks][1] >> 32);
                u[mt] = mfma16(__builtin_bit_cast(s16x8, a), b, u[mt]); } }
#pragma unroll
        for (int mt = 0; mt < 4; ++mt)
#pragma unroll
            for (int e = 0; e < 4; ++e) u[mt][e] *= __expf(gl - gv[mt][e]);
        const float egl = __expf(gl);
        const s16x8 b0 = pack_cpair(u[0], u[1]), b1 = pack_cpair(u[2], u[3]);
#pragma unroll
        for (int kt = 0; kt < 8; ++kt) { f32x4 acc = S[kt] * egl;
            { v4u a; a.x = (unsigned)ka[kt][0][0]; a.y = (unsigned)(ka[kt][0][0] >> 32); a.z = (unsigned)ka[kt][0][1]; a.w = (unsigned)(ka[kt][0][1] >> 32); acc = mfma16(__builtin_bit_cast(s16x8, a), b0, acc); }
            { v4u a; a.x = (unsigned)ka[kt][1][0]; a.y = (unsigned)(ka[kt][1][0] >> 32); a.z = (unsigned)ka[kt][1][1]; a.w = (unsigned)(ka[kt][1][1] >> 32); acc = mfma16(__builtin_bit_cast(s16x8, a), b1, acc); }
            S[kt] = acc; }
    }
}
DI void dn_pass3_item(unsigned char* ws, int item, int lane) {
    asm volatile("" : "+v"(lane));
    const int z = item >> 10, h = (item >> 8) & 3, c = item & 255, cn = z ? 255 - c : c;
    const int n_ = lane & 15, q_ = lane >> 4;
    const bf16* Q = (const bf16*)(ws + WS_QD);
    const bf16* Wn = (const bf16*)(ws + WS_WN) + (size_t)item * 8192; const bf16* Ub = (const bf16*)(ws + WS_UB) + (size_t)item * 8192;
    const bf16* At = (const bf16*)(ws + WS_AT) + (size_t)item * 4096; const float* gcu = (const float*)(ws + WS_GC) + (size_t)item * 64;
    const bf16* Sst = (const bf16*)(ws + WS_SST) + (size_t)item * 16384;
    bf16* O = (bf16*)(ws + (z ? WS_O1 : WS_O0));
    s16x8 wf[4][4], qf[4][4]; unsigned long long af[4][2][2]; float eg[4];
#pragma unroll
    for (int t = 0; t < 4; ++t) {
        const bf16* qrow = Q + (size_t)tok_of(z, cn, 16 * t + n_) * 512 + h * 128 + 8 * q_;
#pragma unroll
        for (int ks = 0; ks < 4; ++ks) { wf[t][ks] = *(const s16x8*)(Wn + (size_t)(16 * t + n_) * 128 + 32 * ks + 8 * q_); qf[t][ks] = *(const s16x8*)(qrow + 32 * ks); }
#pragma unroll
        for (int ks = 0; ks < 2; ++ks) { const bf16* arow = At + (size_t)(16 * t + n_) * 64 + 32 * ks + 4 * q_; af[t][ks][0] = *(const unsigned long long*)arow; af[t][ks][1] = *(const unsigned long long*)(arow + 16); }
        eg[t] = __expf(gcu[16 * t + n_]);
    }
#pragma unroll
    for (int mt = 0; mt < 8; ++mt) {
        s16x8 sf[4];
#pragma unroll
        for (int ks = 0; ks < 4; ++ks) sf[ks] = *(const s16x8*)(Sst + (size_t)(16 * mt + n_) * 128 + 32 * ks + 8 * q_);
        f32x4 u[4];
#pragma unroll
        for (int jt = 0; jt < 4; ++jt) { u[jt] = unpk4(*(const unsigned long long*)(Ub + (size_t)(16 * mt + n_) * 64 + 16 * jt + 4 * q_));
#pragma unroll
            for (int ks = 0; ks < 4; ++ks) u[jt] = mfma16(wf[jt][ks], sf[ks], u[jt]); }
        const s16x8 ua0 = pack_cpair(u[0], u[1]), ua1 = pack_cpair(u[2], u[3]);
#pragma unroll
        for (int nt = 0; nt < 4; ++nt) {
            f32x4 acc = (f32x4){0.f, 0.f, 0.f, 0.f};
#pragma unroll
            for (int ks = 0; ks < 4; ++ks) acc = mfma16(sf[ks], qf[nt][ks], acc);
            acc = acc * eg[nt];
            { v4u b; b.x = (unsigned)af[nt][0][0]; b.y = (unsigned)(af[nt][0][0] >> 32); b.z = (unsigned)af[nt][0][1]; b.w = (unsigned)(af[nt][0][1] >> 32); acc = mfma16(ua0, __builtin_bit_cast(s16x8, b), acc); }
            { v4u b; b.x = (unsigned)af[nt][1][0]; b.y = (unsigned)(af[nt][1][0] >> 32); b.z = (unsigned)af[nt][1][1]; b.w = (unsigned)(af[nt][1][1] >> 32); acc = mfma16(ua1, __builtin_bit_cast(s16x8, b), acc); }
            *(unsigned long long*)(O + (size_t)tok_of(z, cn, 16 * nt + n_) * 512 + h * 128 + 16 * mt + 4 * q_) = pk4(acc);
        }
    }
}
constexpr int DN_SLOT = 41984, DN_GRP = 16;
constexpr size_t WS_MG = WS_END_OLD, WS_NG = WS_END_OLD + 4 * MiB, WS_SG = WS_END_OLD + 8 * MiB;
DI void dn_scan_block(unsigned char* ws, ldsp L, const int Z, const int MODE, int h, int hv, int g, int wave, int lane) {
    const int item0 = (Z * 4 + h) * 256, cb = g * DN_GRP, zhg = (Z * 4 + h) * 16 + g;
    if (wave >= 4) {
        const int lw = wave - 4;
        unsigned so[11], ld[11];
#pragma unroll
        for (int k = 0; k < 4; ++k) { const int pid = lw * 4 + k; const int row = 4 * pid + (lane >> 4), p = lane & 15, cch = p ^ (row & 15); so[k] = row * 256 + cch * 16; ld[k] = pid * 1024 + lane * 16; }
#pragma unroll
        for (int k = 0; k < 4; ++k) { const int pid = lw * 4 + k; const int row = 8 * pid + (lane >> 3), p = lane & 7, cch = p ^ (row & 7); so[4 + k] = row * 128 + cch * 16; ld[4 + k] = 16384 + pid * 1024 + lane * 16; }
#pragma unroll
        for (int k = 0; k < 2; ++k) { const int pid = lw * 2 + k; const int row = 8 * pid + (lane >> 3), p = lane & 7, cch = p ^ (row & 7); so[8 + k] = row * 128 + cch * 16; ld[8 + k] = 32768 + pid * 1024 + lane * 16; }
        so[10] = lane * 16; ld[10] = 40960 + lane * 16;
        v4u rA[11], rB[11];
#define DN_GLOAD(R, ss) do { const int s_ = (ss) < DN_GRP ? (ss) : DN_GRP - 1; const int c_ = cb + s_; const int cn_ = Z ? 255 - c_ : c_; \
            const char* wsrc = (const char*)((const bf16*)(ws + WS_WN) + (size_t)(item0 + c_) * 8192); const char* ksrc = (const char*)((const bf16*)(ws + WS_KT) + (size_t)(h * 256 + cn_) * 8192); \
            const char* usrc = (const char*)((const bf16*)(ws + WS_UB) + (size_t)(item0 + c_) * 8192 + hv * 4096); const char* gsrc = (const char*)((const float*)(ws + WS_GC) + (size_t)(item0 + c_) * 64); \
            _Pragma("unroll") for (int k = 0; k < 4; ++k) R[k] = *(const v4u*)(wsrc + so[k]); \
            _Pragma("unroll") for (int k = 4; k < 8; ++k) R[k] = *(const v4u*)(ksrc + so[k]); \
            _Pragma("unroll") for (int k = 8; k < 10; ++k) R[k] = *(const v4u*)(usrc + so[k]); \
            if (lw == 0) R[10] = *(const v4u*)(gsrc + so[10]); } while (0)
#define DN_LWRITE(R, ss) do { ldsp slot = L + ((ss) % 3) * DN_SLOT; \
            _Pragma("unroll") for (int k = 0; k < 10; ++k) *(LAS v4u*)(slot + ld[k]) = R[k]; \
            if (lw == 0) *(LAS v4u*)(slot + ld[10]) = R[10]; } while (0)
        DN_GLOAD(rA, 0); DN_GLOAD(rB, 1); DN_LWRITE(rA, 0); DN_LWRITE(rB, 1);
        DN_GLOAD(rA, 2); DN_GLOAD(rB, 3);
#define DN_LSTEP(R, ss) do { asm volatile("s_waitcnt lgkmcnt(0)" ::: "memory"); __builtin_amdgcn_s_barrier(); asm volatile("" ::: "memory"); \
            DN_LWRITE(R, (ss) + 2); DN_GLOAD(R, (ss) + 4); } while (0)
        for (int s2 = 0; s2 < DN_GRP; s2 += 2) { DN_LSTEP(rA, s2); DN_LSTEP(rB, s2 + 1); }
#undef DN_LSTEP
#undef DN_LWRITE
#undef DN_GLOAD
        asm volatile("s_waitcnt vmcnt(0) lgkmcnt(0)" ::: "memory");
        return;
    }
    const int vs = 4 * hv + wave;
    const int n_ = lane & 15, q_ = lane >> 4, wbyte = (q_ & 1) * 8, sw = n_ & 7;
    int kao[2][2];
#pragma unroll
    for (int ks = 0; ks < 2; ++ks) { const int r0 = Z ? 60 - 32 * ks - 4 * q_ : 32 * ks + 4 * q_, r1 = Z ? r0 - 16 : r0 + 16; kao[ks][0] = (((r0 >> 3) ^ sw) * 16) + (r0 & 7) * 2; kao[ks][1] = (((r1 >> 3) ^ sw) * 16) + (r1 & 7) * 2; }
    const float ubm = MODE == 2 ? 0.f : 1.f;
    f32x4 S[8];
    if (MODE == 0) { const bf16* SG = (const bf16*)(ws + WS_SG) + (size_t)zhg * 16384;
#pragma unroll
        for (int kt = 0; kt < 8; ++kt) S[kt] = unpk4(*(const unsigned long long*)(SG + (size_t)(16 * vs + n_) * 128 + 16 * kt + 4 * q_)); }
    else {
#pragma unroll
        for (int kt = 0; kt < 8; ++kt)
#pragma unroll
            for (int e = 0; e < 4; ++e) S[kt][e] = (MODE == 2 && (16 * kt + 4 * q_ + e) == (16 * vs + n_)) ? 1.f : 0.f; }
    for (int s = 0; s < DN_GRP; ++s) {
        const int c = cb + s;
        if (MODE == 0) { bf16* Sst = (bf16*)(ws + WS_SST) + (size_t)(item0 + c) * 16384;
#pragma unroll
            for (int kt = 0; kt < 8; ++kt) *(unsigned long long*)(Sst + (size_t)(16 * vs + n_) * 128 + 16 * kt + 4 * q_) = pk4(S[kt]); }
        asm volatile("s_waitcnt lgkmcnt(0)" ::: "memory");
        __builtin_amdgcn_s_barrier();
        asm volatile("" ::: "memory");
        ldsp slot = L + (s % 3) * DN_SLOT;
        f32x4 u[4], gv[4]; unsigned long long wa[4][4][2], ka[8][2][2];
        { ldsp urow = slot + 32768 + (16 * wave + n_) * 128 + wbyte;
#pragma unroll
          for (int mt = 0; mt < 4; ++mt) { u[mt] = unpk4(*(LAS const unsigned long long*)(urow + (((2 * mt + (q_ >> 1)) ^ sw) * 16))) * ubm; gv[mt] = *(LAS const f32x4*)(slot + 40960 + (16 * mt + 4 * q_) * 4); } }
        const float gl = *(LAS const float*)(slot + 40960 + 63 * 4);
#pragma unroll
        for (int ks = 0; ks < 4; ++ks)
#pragma unroll
            for (int mt = 0; mt < 4; ++mt) { ldsp row = slot + (16 * mt + n_) * 256 + wbyte; const int c0 = 4 * ks + (q_ >> 1);
                wa[mt][ks][0] = *(LAS const unsigned long long*)(row + ((c0 ^ n_) * 16)); wa[mt][ks][1] = *(LAS const unsigned long long*)(row + (((c0 + 2) ^ n_) * 16)); }
        __builtin_amdgcn_sched_barrier(0);
#pragma unroll
        for (int ks = 0; ks < 4; ++ks) { const s16x8 bb = pack_cpair(S[2 * ks], S[2 * ks + 1]);
#pragma unroll
            for (int mt = 0; mt < 4; ++mt) { v4u a; a.x = (unsigned)wa[mt][ks][0]; a.y = (unsigned)(wa[mt][ks][0] >> 32); a.z = (unsigned)wa[mt][ks][1]; a.w = (unsigned)(wa[mt][ks][1] >> 32);
                u[mt] = mfma16(__builtin_bit_cast(s16x8, a), bb, u[mt]); } }
        __builtin_amdgcn_sched_barrier(0);
#pragma unroll
        for (int kt = 0; kt < 8; ++kt) { ldsp row = slot + 16384 + (16 * kt + n_) * 128;
#pragma unroll
            for (int ks = 0; ks < 2; ++ks) { ka[kt][ks][0] = *(LAS const unsigned long long*)(row + kao[ks][0]); ka[kt][ks][1] = *(LAS const unsigned long long*)(row + kao[ks][1]); } }
        __builtin_amdgcn_sched_barrier(0);
#pragma unroll
        for (int mt = 0; mt < 4; ++mt)
#pragma unroll
            for (int e = 0; e < 4; ++e) u[mt][e] *= __expf(gl - gv[mt][e]);
        const float egl = __expf(gl);
#pragma unroll
        for (int mt = 0; mt < 4; ++mt) { const f32x4 t = u[mt]; u[mt][0] = Z ? t[3] : t[0]; u[mt][1] = Z ? t[2] : t[1]; u[mt][2] = Z ? t[1] : t[2]; u[mt][3] = Z ? t[0] : t[3]; }
        const s16x8 b0 = pack_cpair(u[0], u[1]), b1 = pack_cpair(u[2], u[3]);
#pragma unroll
        for (int kt = 0; kt < 8; ++kt) { f32x4 acc = S[kt] * egl;
#pragma unroll
            for (int ks = 0; ks < 2; ++ks) { const unsigned long long a0 = ka[kt][ks][0], a1 = ka[kt][ks][1];
                v4u a; a.x = (unsigned)a0; a.y = (unsigned)(a0 >> 32); a.z = (unsigned)a1; a.w = (unsigned)(a1 >> 32);
                acc = mfma16(__builtin_bit_cast(s16x8, a), ks == 0 ? b0 : b1, acc); }
            S[kt] = acc; }
    }
    if (MODE == 1) { bf16* NG = (bf16*)(ws + WS_NG) + (size_t)zhg * 16384;
#pragma unroll
        for (int kt = 0; kt < 8; ++kt) *(unsigned long long*)(NG + (size_t)(16 * vs + n_) * 128 + 16 * kt + 4 * q_) = pk4(S[kt]); }
    if (MODE == 2) { bf16* MG = (bf16*)(ws + WS_MG) + (size_t)zhg * 16384;
#pragma unroll
        for (int kt = 0; kt < 8; ++kt)
#pragma unroll
            for (int e = 0; e < 4; ++e) MG[(size_t)(16 * kt + 4 * q_ + e) * 128 + 16 * vs + n_] = (bf16)f2bf(S[kt][e]); }
}
DI void dn_scan_groups(unsigned char* ws, int w  , int lane) {
    const int zh = w >> 3, vs = w & 7, n_ = lane & 15, q_ = lane >> 4;
    f32x4 S[8];
#pragma unroll
    for (int kt = 0; kt < 8; ++kt) S[kt] = (f32x4){0.f, 0.f, 0.f, 0.f};
    for (int g = 0; g < 16; ++g) {
        const size_t zhg = (size_t)(zh * 16 + g) * 16384;
        bf16* SG = (bf16*)(ws + WS_SG) + zhg; const bf16* MG = (const bf16*)(ws + WS_MG) + zhg; const bf16* NG = (const bf16*)(ws + WS_NG) + zhg;
#pragma unroll
        for (int kt = 0; kt < 8; ++kt) *(unsigned long long*)(SG + (size_t)(16 * vs + n_) * 128 + 16 * kt + 4 * q_) = pk4(S[kt]);
        if (g == 15) break;
        s16x8 bb[4];
#pragma unroll
        for (int ks = 0; ks < 4; ++ks) bb[ks] = pack_cpair(S[2 * ks], S[2 * ks + 1]);
#pragma unroll
        for (int kt = 0; kt < 8; ++kt) { f32x4 acc = unpk4(*(const unsigned long long*)(NG + (size_t)(16 * vs + n_) * 128 + 16 * kt + 4 * q_));
#pragma unroll
            for (int ks = 0; ks < 4; ++ks) { const bf16* row = MG + (size_t)(16 * kt + n_) * 128 + 32 * ks + 4 * q_;
                const unsigned long long a0 = *(const unsigned long long*)row, a1 = *(const unsigned long long*)(row + 16);
                v4u a; a.x = (unsigned)a0; a.y = (unsigned)(a0 >> 32); a.z = (unsigned)a1; a.w = (unsigned)(a1 >> 32);
                acc = mfma16(__builtin_bit_cast(s16x8, a), bb[ks], acc); }
            S[kt] = acc; }
    }
}
DI void prep1_token(const Args& a, unsigned char* ws, int t, int lane) {
    const bf16* P = (const bf16*)(ws + WS_PROJ1) + (size_t)t * ODD_PAD;
    const int c0 = 8 * lane; const bool hp = t > 0, hn = t < S_ - 1;
    float z8[8];
#pragma unroll
    for (int i = 0; i < 8; ++i) z8[i] = 0.f;
    {
        float cb[8], cc[8], cx[8], pc[8], px[8], nc[8], nx[8], w0[8], w1[8], w2[8], o[8];
        ld8(P + c0, cb); ld8(P + 512 + c0, cc); ld8(P + 1024 + c0, cx);
        if (hp) { ld8(P - ODD_PAD + 512 + c0, pc); ld8(P - ODD_PAD + 1024 + c0, px); } else {
#pragma unroll
            for (int i = 0; i < 8; ++i) { pc[i] = 0.f; px[i] = 0.f; } }
        if (hn) { ld8(P + ODD_PAD + 512 + c0, nc); ld8(P + ODD_PAD + 1024 + c0, nx); } else {
#pragma unroll
            for (int i = 0; i < 8; ++i) { nc[i] = 0.f; nx[i] = 0.f; } }
        ld8f(a.in[28] + c0, w0); ld8f(a.in[28] + 512 + c0, w1); ld8f(a.in[28] + 1024 + c0, w2);
#pragma unroll
        for (int i = 0; i < 8; ++i) o[i] = cb[i] * (w0[i] * pc[i] * px[i] + w1[i] * cc[i] * cx[i] + w2[i] * nc[i] * nx[i]);
        st8((bf16*)(ws + WS_YCAT1) + (size_t)t * D_ + c0, o);
    }
#pragma unroll
    for (int part = 0; part < 3; ++part) {
        float cu[8], pv[8], nx[8], w0[8], w1[8], w2[8], o[8];
        const int col = 1536 + part * 512 + c0;
        ld8(P + col, cu);
        if (hp) ld8(P - ODD_PAD + col, pv); else {
#pragma unroll
            for (int i = 0; i < 8; ++i) pv[i] = 0.f; }
        if (hn) ld8(P + ODD_PAD + col, nx); else {
#pragma unroll
            for (int i = 0; i < 8; ++i) nx[i] = 0.f; }
        const float* cw = a.in[29] + part * 512 + c0;
        ld8f(cw, w0); ld8f(cw + 1536, w1); ld8f(cw + 3072, w2);
        float ss = 0.f;
#pragma unroll
        for (int i = 0; i < 8; ++i) { o[i] = siluf_(w0[i] * pv[i] + w1[i] * cu[i] + w2[i] * nx[i]); ss += o[i] * o[i]; }
        if (part < 2) { ss = grp_sum<16>(ss); const float rn = (1.0f / sqrtf(ss + 1e-6f)) * (part == 0 ? 0.08838834764831845f : 1.0f);
#pragma unroll
            for (int i = 0; i < 8; ++i) o[i] *= rn; }
        st8((bf16*)(ws + (part == 0 ? WS_QD : (part == 1 ? WS_KD : WS_VD))) + (size_t)t * 512 + c0, o);
    }
    *(v4u*)((bf16*)(ws + WS_YCAT1) + (size_t)t * D_ + 512 + c0) = *(const v4u*)(P + 3072 + c0);
    if (lane < 8) {
        const float bt = sigmoidf_(bf2f(P[3584 + lane])); const float al = bf2f(P[3592 + lane]);
        const float g = -__expf(a.in[30][lane]) * softplusf_(al + a.in[31][lane]);
        ((float*)(ws + WS_GB))[(size_t)t * 8 + lane] = g; ((float*)(ws + WS_GB + 512 * 1024))[(size_t)t * 8 + lane] = bt;
    }
}
DI void dn_scan_naive(unsigned char* ws, int w  , int lane) {
    const int z = w >> 9, h = (w >> 7) & 3, vc = w & 127;
    const bf16* Q = (const bf16*)(ws + WS_QD); const bf16* K = (const bf16*)(ws + WS_KD); const bf16* V = (const bf16*)(ws + WS_VD);
    const float* G = (const float*)(ws + WS_GB); const float* Bt = (const float*)(ws + WS_GB + 512 * 1024);
    bf16* O = (bf16*)(ws + (z ? WS_O1 : WS_O0));
    float s0 = 0.f, s1 = 0.f;
    int t = z ? S_ - 1 : 0; const int dt = z ? -1 : 1;
    size_t o = (size_t)t * 512 + h * 128;
    float k0 = bf2f(K[o + lane]), k1 = bf2f(K[o + 64 + lane]), q0 = bf2f(Q[o + lane]), q1 = bf2f(Q[o + 64 + lane]), vv = bf2f(V[o + vc]), g = G[(size_t)t * 8 + z * 4 + h], bt = Bt[(size_t)t * 8 + z * 4 + h];
    for (int s = 0; s < S_; ++s) {
        const int tn = (s + 1 < S_) ? t + dt : t; const size_t on = (size_t)tn * 512 + h * 128;
        const float k0n = bf2f(K[on + lane]), k1n = bf2f(K[on + 64 + lane]), q0n = bf2f(Q[on + lane]), q1n = bf2f(Q[on + 64 + lane]), vvn = bf2f(V[on + vc]), gn = G[(size_t)tn * 8 + z * 4 + h], btn = Bt[(size_t)tn * 8 + z * 4 + h];
        const float eg = __expf(g);
        const float dot = wave_sum(k0 * s0 + k1 * s1);
        const float cf = bt * (vv - eg * dot);
        s0 = eg * s0 + cf * k0; s1 = eg * s1 + cf * k1;
        const float ov = wave_sum(q0 * s0 + q1 * s1);
        if (lane == 0) O[(size_t)t * 512 + h * 128 + vc] = (bf16)f2bf(ov);
        k0 = k0n; k1 = k1n; q0 = q0n; q1 = q1n; vv = vvn; g = gn; bt = btn; t = tn;
    }
}
DI void dn_post_token(const Args& a, unsigned char* ws, int t, int lane) {
    const int c0 = 8 * lane; const size_t o = (size_t)t * 512 + c0;
    float o0[8], o1[8], zz[8], nw[8];
    ld8((const bf16*)(ws + WS_O0) + o, o0); ld8((const bf16*)(ws + WS_O1) + o, o1);
    ld8((const bf16*)(ws + WS_YCAT1) + (size_t)t * D_ + 512 + c0, zz); ld8f(a.in[32] + (c0 & 127), nw);
    float ss = 0.f;
#pragma unroll
    for (int i = 0; i < 8; ++i) { o0[i] += o1[i]; ss += o0[i] * o0[i]; }
    const float rs = 1.0f / sqrtf(grp_sum<16>(ss) * (1.0f / 128.f) + 1e-6f);
#pragma unroll
    for (int i = 0; i < 8; ++i) o0[i] = o0[i] * rs * nw[i] * siluf_(zz[i]);
    st8((bf16*)(ws + WS_YCAT1) + (size_t)t * D_ + 512 + c0, o0);
}
struct TokInfo { int e1, e2, s1, s2; float p1, p2; int pad0, pad1; };
struct RouterRegs { f32x4 r0[16], r1[16]; f32x4 w[4]; };
DI void route_load(const Args& a, RouterRegs& R, int lane) {
#pragma unroll
    for (int j = 0; j < 4; ++j) { R.w[j] = ((const f32x4*)a.in[34])[lane + 64 * j];
#pragma unroll
        for (int i = 0; i < 4; ++i) { const float* rr = a.in[35] + (size_t)(4 * lane + 256 * j + i) * 8; R.r0[4 * j + i] = *(const f32x4*)rr; R.r1[4 * j + i] = *(const f32x4*)(rr + 4); } }
}
constexpr size_t WS_BC = WS_TILE + 4096;
DI int sel8(const int (&v)[8], int e) { int r = 0;
#pragma unroll
    for (int k = 0; k < 8; ++k) r += v[k] & -(int)(e == k);
    return r; }
DI int wave_isum(int v) {
#pragma unroll
    for (int o = 1; o < 64; o <<= 1) v += __shfl_xor(v, o);
    return v; }
DI void route_eval(const RouterRegs& R, const float* x3, int t, int lane, int& e1, int& e2, float& p1, float& p2) {
    f32x4 v[4]; load_row(x3, t, lane, v); const float rs = row_rstd(v);
    float lg[8];
#pragma unroll
    for (int e = 0; e < 8; ++e) lg[e] = 0.f;
#pragma unroll
    for (int j = 0; j < 4; ++j)
#pragma unroll
        for (int i = 0; i < 4; ++i) { const float hv = v[j][i] * rs * R.w[j][i]; const f32x4 r0 = R.r0[4 * j + i], r1 = R.r1[4 * j + i];
            lg[0] += hv * r0.x; lg[1] += hv * r0.y; lg[2] += hv * r0.z; lg[3] += hv * r0.w; lg[4] += hv * r1.x; lg[5] += hv * r1.y; lg[6] += hv * r1.z; lg[7] += hv * r1.w; }
#pragma unroll
    for (int e = 0; e < 8; ++e) lg[e] = wave_sum(lg[e]);
    e1 = 0; float m1 = lg[0];
#pragma unroll
    for (int e = 1; e < 8; ++e) if (lg[e] > m1) { m1 = lg[e]; e1 = e; }
    e2 = -1; float m2 = -3.0e38f;
#pragma unroll
    for (int e = 0; e < 8; ++e) if (e != e1 && lg[e] > m2) { m2 = lg[e]; e2 = e; }
    const float x2 = __expf(m2 - m1); p1 = 1.0f / (1.0f + x2); p2 = x2 / (1.0f + x2);
}
DI void route_group(const RouterRegs& R, unsigned char* ws, const float* x3, LAS int* wc, int tg, int wave, int lane) {
    int cw[8];
#pragma unroll
    for (int e = 0; e < 8; ++e) cw[e] = 0;
    TokInfo* TI = (TokInfo*)(ws + WS_TOK) + (size_t)tg * 64 + wave * 8;
#pragma unroll 1
    for (int i = 0; i < 8; ++i) {
        int e1, e2; float p1, p2; route_eval(R, x3, tg * 64 + wave * 8 + i, lane, e1, e2, p1, p2);
        const int s1 = sel8(cw, e1);
#pragma unroll
        for (int e = 0; e < 8; ++e) cw[e] += (e == e1) ? 1 : 0;
        const int s2 = sel8(cw, e2);
#pragma unroll
        for (int e = 0; e < 8; ++e) cw[e] += (e == e2) ? 1 : 0;
        if (lane == 0) { v4u* rec = (v4u*)(TI + i); rec[0] = (v4u){(unsigned)e1, (unsigned)e2, (unsigned)s1, (unsigned)s2}; rec[1] = (v4u){__float_as_uint(p1), __float_as_uint(p2), 0u, 0u}; }
    }
    if (lane < 8) wc[wave * 8 + lane] = sel8(cw, lane);
    LDS_WAIT(); __syncthreads();
    int wb[8], bc[8];
#pragma unroll
    for (int e = 0; e < 8; ++e) { wb[e] = 0; bc[e] = 0;
#pragma unroll
        for (int w = 0; w < 8; ++w) { const int c = wc[w * 8 + e]; bc[e] += c; wb[e] += (w < wave) ? c : 0; } }
    if (wave == 0 && lane < 8) ((int*)(ws + WS_BC))[tg * 8 + lane] = sel8(bc, lane);
    if (lane < 8) { v4u* rec = (v4u*)(TI + lane); v4u r = rec[0]; r.z += (unsigned)sel8(wb, (int)r.x); r.w += (unsigned)sel8(wb, (int)r.y); rec[0] = r; }
    LDS_WAIT(); __syncthreads();
}
DI void moe_totals(const unsigned char* ws, int lane, int (&tot)[8]) {
    const int* BC = (const int*)(ws + WS_BC); int part[8];
#pragma unroll
    for (int e = 0; e < 8; ++e) part[e] = 0;
#pragma unroll
    for (int k = 0; k < 4; ++k) { const int r = lane + 64 * k;
#pragma unroll
        for (int e = 0; e < 8; ++e) part[e] += __hip_atomic_load(BC + r * 8 + e, __ATOMIC_RELAXED, __HIP_MEMORY_SCOPE_AGENT); }
#pragma unroll
    for (int e = 0; e < 8; ++e) tot[e] = __builtin_amdgcn_readfirstlane(wave_isum(part[e]));
}
DI void moe_offsets(const int (&tot)[8], int (&off)[9]) { int o = 0;
#pragma unroll
    for (int e = 0; e < 8; ++e) { off[e] = o; o += (tot[e] + 255) & ~255; }
    off[8] = o; }
DI void gather_group(const Args& a, unsigned char* ws, const float* x3, const int (&off)[9], int tg, int wave, int lane) {
    const int* BC = (const int*)(ws + WS_BC); int pre[8];
#pragma unroll
    for (int e = 0; e < 8; ++e) pre[e] = 0;
#pragma unroll
    for (int k = 0; k < 4; ++k) { const int r = lane + 64 * k;
#pragma unroll
        for (int e = 0; e < 8; ++e) { const int c = __hip_atomic_load(BC + r * 8 + e, __ATOMIC_RELAXED, __HIP_MEMORY_SCOPE_AGENT); pre[e] += (r < tg) ? c : 0; } }
#pragma unroll
    for (int e = 0; e < 8; ++e) pre[e] = __builtin_amdgcn_readfirstlane(wave_isum(pre[e])) + off[e];
    TokInfo* TI = (TokInfo*)(ws + WS_TOK) + (size_t)tg * 64 + wave * 8;
    bf16* A = (bf16*)(ws + WS_AMOE);
#pragma unroll 1
    for (int i = 0; i < 8; ++i) { const int t = tg * 64 + wave * 8 + i;
        f32x4 v[4]; load_row(x3, t, lane, v); const float rs = row_rstd(v);
#pragma unroll
        for (int j = 0; j < 4; ++j) v[j] = v[j] * rs * ((const f32x4*)a.in[34])[lane + 64 * j];
        v4u* rec = (v4u*)(TI + i); v4u r = rec[0];
        const int r1 = sel8(pre, (int)r.x) + (int)r.z, r2 = sel8(pre, (int)r.y) + (int)r.w;
        store_row_bf16(A + (size_t)r1 * D_, lane, v); store_row_bf16(A + (size_t)r2 * D_, lane, v);
        if (lane == 0) { r.z = (unsigned)r1; r.w = (unsigned)r2; rec[0] = r; }
    }
}
DI void combine_token(unsigned char* ws, float* out, const int (&off)[9], int t, int lane) {
    const v4u* rec = (const v4u*)((const TokInfo*)(ws + WS_TOK) + t); const v4u ra = rec[0], rb = rec[1];
    struct { float p1, p2; } ti; ti.p1 = __uint_as_float(rb.x); ti.p2 = __uint_as_float(rb.y);
    const bf16* A = (const bf16*)(ws + WS_AMOE);
    const unsigned long long* r1 = (const unsigned long long*)(A + (size_t)ra.z * D_) + lane; const unsigned long long* r2 = (const unsigned long long*)(A + (size_t)ra.w * D_) + lane;
    f32x4* xo = (f32x4*)(out + (size_t)t * D_) + lane;
#pragma unroll
    for (int j = 0; j < 4; ++j) { const unsigned long long a1 = r1[64 * j], a2 = r2[64 * j]; f32x4 x = xo[64 * j];
        x.x += ti.p1 * bflo((unsigned)a1) + ti.p2 * bflo((unsigned)a2); x.y += ti.p1 * bfhi((unsigned)a1) + ti.p2 * bfhi((unsigned)a2);
        x.z += ti.p1 * bflo((unsigned)(a1 >> 32)) + ti.p2 * bflo((unsigned)(a2 >> 32)); x.w += ti.p1 * bfhi((unsigned)(a1 >> 32)) + ti.p2 * bfhi((unsigned)(a2 >> 32));
        xo[64 * j] = x; }
}
#ifndef PROBE
#define PROBE 0
#endif
#ifndef PROBE_REP
#define PROBE_REP (-1)
#endif
constexpr int MOE_GU_SPLIT = 13056;
#ifndef PH_MASK
#define PH_MASK 0xFFFFFFFFu
#endif
DI unsigned char* ptr_opaque(unsigned char* p) { GAS unsigned char* g = (GAS unsigned char*)p; asm volatile("" : "+s"(g)); return (unsigned char*)g; }
DI int lane_opaque() { int l; asm volatile("v_mbcnt_lo_u32_b32 %0, -1, 0\n\tv_mbcnt_hi_u32_b32 %0, -1, %0" : "=v"(l)); return l; }
__global__ void __launch_bounds__(512, 2) fwd_kernel(Args args) {
    extern __shared__ __attribute__((aligned(16))) unsigned char lds[];
    LAS unsigned char* L = (LAS unsigned char*)lds;
    volatile LAS unsigned* MISC = (volatile LAS unsigned*)(L + MISC_OFF);
    const int tid = threadIdx.x, lane0 = tid & 63, wave = __builtin_amdgcn_readfirstlane(tid >> 6);
    const int G = gridDim.x, bx = blockIdx.x;
    const int gw = bx * 8 + wave, NGW = G * 8;
    unsigned char* ws0 = args.ws;
    if (tid < 128) ((LAS unsigned*)(L + LDS_ZERO_OFF))[tid] = 0u;
    __syncthreads();
    XcdBarrier bar = xcd_barrier_post((unsigned*)(ws0 + WS_CTL) + CW_BAR, MISC + 8);
    LAS float* scr = (LAS float*)(L + wave * 16384);
#if PROBE
    int tsi = 0;
#define GRID_BAR() do { xcd_barrier(bar, wave == 0); if (bx == 0 && tid == 0) { ((unsigned*)(ws0 + WS_CTL))[512 + tsi] = (unsigned)__builtin_amdgcn_s_memrealtime(); } ++tsi; } while (0)
    if (bx == 0 && tid == 0) ((unsigned*)(ws0 + WS_CTL))[511] = (unsigned)__builtin_amdgcn_s_memrealtime();
#else
#define GRID_BAR() xcd_barrier(bar, wave == 0)
#endif

    if constexpr ((PH_MASK >> 0) & 1) {
    const int lane = lane_opaque(); unsigned char* const ws = ptr_opaque(args.ws);
    {
        const float* const* in = args.in;
        for (int it = gw; ; it += NGW) {
            int r = it;
            if (transpose_job(r, in[3], 1024, 3072, 3072, (bf16*)(ws + WS_WIN0), 0, 0, 0, scr, lane)) continue;
            if (transpose_job(r, in[9], 1024, 64, 64, (bf16*)(ws + WS_WL), 0, 0, 0, scr, lane)) continue;
            if (transpose_job(r, in[9] + 65536, 1024, 64, 64, (bf16*)(ws + WS_WL), 64, 0, 0, scr, lane)) continue;
            if (transpose_job(r, in[12], 1024, 64, 64, (bf16*)(ws + WS_WL), 128, 0, 0, scr, lane)) continue;
            if (transpose_job(r, in[12] + 65536, 1024, 64, 64, (bf16*)(ws + WS_WL), 192, 0, 0, scr, lane)) continue;
            if (transpose_job(r, in[14], 1024, 128, 256, (bf16*)(ws + WS_WL), 256, 0, 0, scr, lane)) continue;
            if (transpose_job(r, in[21], 1024, 1024, 1024, (bf16*)(ws + WS_WOUT0), 0, 0, 0, scr, lane)) continue;
            if (transpose_job(r, in[10], 64, 512, 512, (bf16*)(ws + WS_W2T), 0, 0, 0, scr, lane)) continue;
            if (transpose_job(r, in[10] + 32768, 64, 512, 512, (bf16*)(ws + WS_W2T) + 32768, 0, 0, 0, scr, lane)) continue;
            if (transpose_job(r, in[13], 64, 512, 512, (bf16*)(ws + WS_W2T) + 65536, 0, 0, 0, scr, lane)) continue;
            if (transpose_job(r, in[13] + 32768, 64, 512, 512, (bf16*)(ws + WS_W2T) + 98304, 0, 0, 0, scr, lane)) continue;
            if (transpose_job(r, in[15], 128, 512, 512, (bf16*)(ws + WS_W2T) + 131072, 0, 0, 0, scr, lane)) continue;
            break;
        }
        norm_rows(args.in[0], args.in[2], args.in[7], (bf16*)(ws + WS_H), (bf16*)(ws + WS_HX), gw, NGW, lane);
    }
    if constexpr (PROBE_REP == 0) {
    {
        const float* const* in = args.in;
        for (int it = gw; ; it += NGW) {
            int r = it;
            if (transpose_job(r, in[3], 1024, 3072, 3072, (bf16*)(ws + WS_WIN0), 0, 0, 0, scr, lane)) continue;
            if (transpose_job(r, in[9], 1024, 64, 64, (bf16*)(ws + WS_WL), 0, 0, 0, scr, lane)) continue;
            if (transpose_job(r, in[9] + 65536, 1024, 64, 64, (bf16*)(ws + WS_WL), 64, 0, 0, scr, lane)) continue;
            if (transpose_job(r, in[12], 1024, 64, 64, (bf16*)(ws + WS_WL), 128, 0, 0, scr, lane)) continue;
            if (transpose_job(r, in[12] + 65536, 1024, 64, 64, (bf16*)(ws + WS_WL), 192, 0, 0, scr, lane)) continue;
            if (transpose_job(r, in[14], 1024, 128, 256, (bf16*)(ws + WS_WL), 256, 0, 0, scr, lane)) continue;
            if (transpose_job(r, in[21], 1024, 1024, 1024, (bf16*)(ws + WS_WOUT0), 0, 0, 0, scr, lane)) continue;
            if (transpose_job(r, in[10], 64, 512, 512, (bf16*)(ws + WS_W2T), 0, 0, 0, scr, lane)) continue;
            if (transpose_job(r, in[10] + 32768, 64, 512, 512, (bf16*)(ws + WS_W2T) + 32768, 0, 0, 0, scr, lane)) continue;
            if (transpose_job(r, in[13], 64, 512, 512, (bf16*)(ws + WS_W2T) + 65536, 0, 0, 0, scr, lane)) continue;
            if (transpose_job(r, in[13] + 32768, 64, 512, 512, (bf16*)(ws + WS_W2T) + 98304, 0, 0, 0, scr, lane)) continue;
            if (transpose_job(r, in[15], 128, 512, 512, (bf16*)(ws + WS_W2T) + 131072, 0, 0, 0, scr, lane)) continue;
            break;
        }
        norm_rows(args.in[0], args.in[2], args.in[7], (bf16*)(ws + WS_H), (bf16*)(ws + WS_HX), gw, NGW, lane);
    }
    }
    GRID_BAR();
    }
    if constexpr (PROBE_REP == 50) { for (int i = 0; i < 10; ++i) GRID_BAR(); }
    if constexpr ((PH_MASK >> 1) & 1) {
    const int lane = lane_opaque(); unsigned char* const ws = ptr_opaque(args.ws);
    {
        { pg8::Gemm g{(const bf16*)(ws + WS_H), (const bf16*)(ws + WS_WIN0), S_, EVEN_IN, D_}; pg8::StaticOrder S; S.init(S_, EVEN_IN, G, bx);
          pg8::EpiStoreBf16 E{(bf16*)(ws + WS_PROJ0), EVEN_IN, 0, nullptr}; pg8::gemm_phase<pg8::EpiStoreBf16, pg8::StaticOrder, true, true>(L, g, S, E, wave); }
        { pg8::Gemm g{(const bf16*)(ws + WS_HX), (const bf16*)(ws + WS_WL), S_, LORA_N, D_}; pg8::StaticOrder S; S.init(S_, LORA_N, G, bx);
          pg8::EpiStoreBf16 E{(bf16*)(ws + WS_LORA), LORA_N, 0, nullptr}; pg8::gemm_phase<pg8::EpiStoreBf16, pg8::StaticOrder, true, true>(L, g, S, E, wave); }
        if constexpr (PROBE_REP == 1) {
        { pg8::Gemm g{(const bf16*)(ws + WS_H), (const bf16*)(ws + WS_WIN0), S_, EVEN_IN, D_}; pg8::StaticOrder S; S.init(S_, EVEN_IN, G, bx);
          pg8::EpiStoreBf16 E{(bf16*)(ws + WS_PROJ0), EVEN_IN, 0, nullptr}; pg8::gemm_phase<pg8::EpiStoreBf16, pg8::StaticOrder, true, true>(L, g, S, E, wave); }
        { pg8::Gemm g{(const bf16*)(ws + WS_HX), (const bf16*)(ws + WS_WL), S_, LORA_N, D_}; pg8::StaticOrder S; S.init(S_, LORA_N, G, bx);
          pg8::EpiStoreBf16 E{(bf16*)(ws + WS_LORA), LORA_N, 0, nullptr}; pg8::gemm_phase<pg8::EpiStoreBf16, pg8::StaticOrder, true, true>(L, g, S, E, wave); }
        }
    }
    GRID_BAR();
    }
    if constexpr ((PH_MASK >> 2) & 1) {
    const int lane = lane_opaque(); unsigned char* const ws = ptr_opaque(args.ws);
    for (int t = gw; t < S_; t += NGW) prep0_token(args, ws, scr, t, lane);
    if constexpr (PROBE_REP == 30) { for (int t = gw; t < S_; t += NGW) prep0_token(args, ws, scr, t, lane); }
    {
        const int hh = bx & 7, nbh = (G - hh + 7) >> 3;
        const int lane = lane_opaque();
        prep0_stage_w2t(ws, L, hh, wave * 64 + lane);
        LDS_WAIT(); __syncthreads();
        for (int u = wave; ; u += 8) { const int cn = (bx >> 3) + nbh * (u >> 2); if (cn >= 256) break; prep0_rwkv_unit(args, ws, L, 4 * cn + (u & 3), hh, lane); }
        if constexpr (PROBE_REP == 31) { for (int u = wave; ; u += 8) { const int cn = (bx >> 3) + nbh * (u >> 2); if (cn >= 256) break; prep0_rwkv_unit(args, ws, L, 4 * cn + (u & 3), hh, lane); } }
        asm volatile("s_waitcnt vmcnt(0)" ::: "memory");
        __syncthreads();
    }
    }
    if constexpr ((PH_MASK >> 3) & 1) {
    const int lane = lane_opaque(); unsigned char* const ws = ptr_opaque(args.ws);
    {
        if constexpr (PROBE_REP == 40) { if (wave < 2) { for (int it = bx * 2 + wave; it < 4096; it += G * 2) rwkv_pass1_item<true>(ws, L + wave * 65536, it, lane); } }
        if constexpr (PROBE_REP >= 41 && PROBE_REP <= 47) { if (wave < 2) { for (int it = bx * 2 + wave; it < 4096; it += G * 2) rwkv_pass1_item<true, PROBE_REP - 40>(ws, L + wave * 65536, it, lane); } }
        if (wave < 2) { const int hh = bx & 7, nbh = (G - hh + 7) >> 3;
            for (int u = wave; ; u += 2) { const int cn = (bx >> 3) + nbh * (u >> 1); if (cn >= 256) break; const int z = u & 1;
                rwkv_pass1_item(ws, L + wave * 65536, z * 2048 + hh * 256 + (z ? 255 - cn : cn), lane); } }
        else if (wave < 4) {
            const float* const* in = args.in; LAS float* scr2 = (LAS float*)(L + 131072 + (wave - 2) * 8448);
            for (int it = bx * 2 + (wave - 2); ; it += G * 2) {
                int r = it;
                if (transpose_job(r, in[23], 1024, FF0, FF0, (bf16*)(ws + WS_WGU0), 0, 128, 0, scr2, lane)) continue;
                if (transpose_job(r, in[24], 1024, FF0, FF0, (bf16*)(ws + WS_WGU0), 0, 128, 1, scr2, lane)) continue;
                if (transpose_job(r, in[25], FF0, 1024, 1024, (bf16*)(ws + WS_WD0), 0, 0, 0, scr2, lane)) continue;
                if (transpose_job(r, in[27], 1024, ODD_IN, ODD_PAD, (bf16*)(ws + WS_WIN1), 0, 0, 0, scr2, lane)) continue;
                if (transpose_job(r, in[33], 1024, 1024, 1024, (bf16*)(ws + WS_WOUT1), 0, 0, 0, scr2, lane)) continue;
                break;
            }
        }
    }
    GRID_BAR();
    if (bx < 16) { rwkv_pass2_block(ws, L, bx, wave, lane); __syncthreads(); if constexpr (PROBE_REP == 4) { rwkv_pass2_block(ws, L, bx, wave, lane); __syncthreads(); } }
    else { for (int rep_ = 0; rep_ < (PROBE_REP == 3 ? 2 : 1); ++rep_) for (int unit = bx - 16; unit < 512; unit += G - 16) attn_unit(ws, L, unit, wave, lane); }
    GRID_BAR();
    for (int it = gw; it < 2048; it += NGW) rwkv_pass3_post_item(args, ws, it, lane);
    if constexpr (PROBE_REP == 63) { for (int it = gw; it < 2048; it += NGW) rwkv_pass3_post_item(args, ws, it, lane); }
    GRID_BAR();
    }
    if constexpr ((PH_MASK >> 5) & 1) {
    const int lane = lane_opaque(); unsigned char* const ws = ptr_opaque(args.ws);
    { pg8::Gemm g{(const bf16*)(ws + WS_Y), (const bf16*)(ws + WS_WOUT0), S_, D_, D_}; pg8::StaticOrder S; S.init(S_, D_, G, bx);
      pg8::EpiResF32 E{args.in[0], args.out, D_, nullptr, nullptr}; pg8::gemm_phase<pg8::EpiResF32, pg8::StaticOrder, true, true>(L, g, S, E, wave); }
    if constexpr (PROBE_REP == 7) {
    { pg8::Gemm g{(const bf16*)(ws + WS_Y), (const bf16*)(ws + WS_WOUT0), S_, D_, D_}; pg8::StaticOrder S; S.init(S_, D_, G, bx);
      pg8::EpiResF32 E{args.in[0], args.out, D_, nullptr, nullptr}; pg8::gemm_phase<pg8::EpiResF32, pg8::StaticOrder, true, true>(L, g, S, E, wave); }
    }
    GRID_BAR();
    }
    if constexpr ((PH_MASK >> 6) & 1) {
    const int lane = lane_opaque(); unsigned char* const ws = ptr_opaque(args.ws);
    norm_rows(args.out, args.in[22], nullptr, (bf16*)(ws + WS_H2), nullptr, gw, NGW, lane);
    GRID_BAR();
    }
    if constexpr ((PH_MASK >> 7) & 1) {
    const int lane = lane_opaque(); unsigned char* const ws = ptr_opaque(args.ws);
    { pg8::Gemm g{(const bf16*)(ws + WS_H2), (const bf16*)(ws + WS_WGU0), S_, 2 * FF0, D_}; pg8::StaticOrder S; S.init(S_, 2 * FF0, G, bx);
      pg8::EpiSwiGLU E{(bf16*)(ws + WS_ACT0), FF0, 0, nullptr}; pg8::gemm_phase<pg8::EpiSwiGLU, pg8::StaticOrder, true, true>(L, g, S, E, wave); }
    if constexpr (PROBE_REP == 9) {
    { pg8::Gemm g{(const bf16*)(ws + WS_H2), (const bf16*)(ws + WS_WGU0), S_, 2 * FF0, D_}; pg8::StaticOrder S; S.init(S_, 2 * FF0, G, bx);
      pg8::EpiSwiGLU E{(bf16*)(ws + WS_ACT0), FF0, 0, nullptr}; pg8::gemm_phase<pg8::EpiSwiGLU, pg8::StaticOrder, true, true>(L, g, S, E, wave); }
    }
    GRID_BAR();
    }
    if constexpr ((PH_MASK >> 8) & 1) {
    const int lane = lane_opaque(); unsigned char* const ws = ptr_opaque(args.ws);
    { pg8::Gemm g{(const bf16*)(ws + WS_ACT0), (const bf16*)(ws + WS_WD0), S_, D_, FF0}; pg8::StaticOrder S; S.init(S_, D_, G, bx);
      pg8::EpiResF32 E{args.out, args.out, D_, nullptr, nullptr}; pg8::gemm_phase<pg8::EpiResF32, pg8::StaticOrder, true, true>(L, g, S, E, wave); }
    GRID_BAR();
    }
    if constexpr ((PH_MASK >> 9) & 1) {
    const int lane = lane_opaque(); unsigned char* const ws = ptr_opaque(args.ws);
    norm_rows(args.out, args.in[26], nullptr, (bf16*)(ws + WS_H3), nullptr, gw, NGW, lane);
    GRID_BAR();
    }
    if constexpr ((PH_MASK >> 10) & 1) {
    const int lane = lane_opaque(); unsigned char* const ws = ptr_opaque(args.ws);
    { pg8::Gemm g{(const bf16*)(ws + WS_H3), (const bf16*)(ws + WS_WIN1), S_, ODD_PAD, D_}; pg8::StaticOrder S; S.init(S_, ODD_PAD, G, bx);
      pg8::EpiStoreBf16 E{(bf16*)(ws + WS_PROJ1), ODD_PAD, 0, nullptr}; pg8::gemm_phase<pg8::EpiStoreBf16, pg8::StaticOrder, true, true>(L, g, S, E, wave); }
    if constexpr (PROBE_REP == 12) {
    { pg8::Gemm g{(const bf16*)(ws + WS_H3), (const bf16*)(ws + WS_WIN1), S_, ODD_PAD, D_}; pg8::StaticOrder S; S.init(S_, ODD_PAD, G, bx);
      pg8::EpiStoreBf16 E{(bf16*)(ws + WS_PROJ1), ODD_PAD, 0, nullptr}; pg8::gemm_phase<pg8::EpiStoreBf16, pg8::StaticOrder, true, true>(L, g, S, E, wave); }
    }
    GRID_BAR();
    }
    if constexpr ((PH_MASK >> 11) & 1) {
    const int lane = lane_opaque(); unsigned char* const ws = ptr_opaque(args.ws);
    for (int cn = bx; cn < 256; cn += G) for (int i = wave; i < 64; i += 8) prep1_token(args, ws, cn * 64 + i, lane);
    GRID_BAR();
    }
    if constexpr ((PH_MASK >> 12) & 1) {
    const int lane = lane_opaque(); unsigned char* const ws = ptr_opaque(args.ws);
    {
        if (wave < 4) { const int z = wave & 1;
            for (int cn = bx; cn < 256; cn += G) for (int hh = (wave >> 1) * 2; hh < (wave >> 1) * 2 + 2; ++hh) dn_pass1_item(ws, L + wave * DN_LDS_PER_WAVE, (z * 4 + hh) * 256 + (z ? 255 - cn : cn), lane); }
        else if (wave < 7) {
            LAS float* scr2 = (LAS float*)(L + 4 * DN_LDS_PER_WAVE + (wave - 4) * 8448);
            moe_copy_loop<true>(args, ws, scr2, bx * 3 + (wave - 4), G * 3, MOE_GU_SPLIT, lane);
        }
    }
    GRID_BAR();
    { const int task = bx; if (task < 512) dn_scan_block(ws, L, task >> 8, (task & 3) < 2 ? 1 : 2, (task >> 6) & 3, task & 1, (task >> 2) & 15, wave, lane); __syncthreads(); }
    { const int task = bx + G; if (task < 512) dn_scan_block(ws, L, task >> 8, (task & 3) < 2 ? 1 : 2, (task >> 6) & 3, task & 1, (task >> 2) & 15, wave, lane); __syncthreads(); }
    if constexpr (PROBE_REP == 60) { { const int task = bx; if (task < 512) dn_scan_block(ws, L, task >> 8, (task & 3) < 2 ? 1 : 2, (task >> 6) & 3, task & 1, (task >> 2) & 15, wave, lane); __syncthreads(); }
      { const int task = bx + G; if (task < 512) dn_scan_block(ws, L, task >> 8, (task & 3) < 2 ? 1 : 2, (task >> 6) & 3, task & 1, (task >> 2) & 15, wave, lane); __syncthreads(); } }
    GRID_BAR();
    if (bx < 64) { if (wave == 0) dn_scan_groups(ws, bx, lane); }
    else {
        moe_copy_loop<true>(args, ws, scr, MOE_GU_SPLIT + (bx - 64) * 8 + wave, (G - 64) * 8, 28672, lane);
    }
    if constexpr (PROBE_REP == 61) { if (bx < 64) { if (wave == 0) dn_scan_groups(ws, bx, lane); } }
    GRID_BAR();
    { const int task = bx; if (task < 256) dn_scan_block(ws, L, task >> 7, 0, (task >> 5) & 3, (task >> 4) & 1, task & 15, wave, lane); __syncthreads(); }
    if constexpr (PROBE_REP == 62) { const int task = bx; if (task < 256) dn_scan_block(ws, L, task >> 7, 0, (task >> 5) & 3, (task >> 4) & 1, task & 15, wave, lane); __syncthreads(); }
    GRID_BAR();
for (int rep_ = 0; rep_ < (PROBE_REP == 16 ? 2 : 1); ++rep_) {     for (int it = gw; it < 2048; it += NGW) dn_pass3_item(ws, it, lane); }
    GRID_BAR();
    }
    if constexpr ((PH_MASK >> 13) & 1) {
    const int lane = lane_opaque(); unsigned char* const ws = ptr_opaque(args.ws);
    for (int t = gw; t < S_; t += NGW) dn_post_token(args, ws, t, lane);
    moe_copy_loop<false>(args, ws, scr, gw, NGW, 14336, lane);
    GRID_BAR();
    }
    if constexpr ((PH_MASK >> 14) & 1) {
    const int lane = lane_opaque(); unsigned char* const ws = ptr_opaque(args.ws);
    { pg8::Gemm g{(const bf16*)(ws + WS_YCAT1), (const bf16*)(ws + WS_WOUT1), S_, D_, D_}; pg8::StaticOrder S; S.init(S_, D_, G, bx);
      pg8::EpiResF32 E{args.out, args.out, D_, nullptr, nullptr}; pg8::gemm_phase<pg8::EpiResF32, pg8::StaticOrder, true, true>(L, g, S, E, wave); }
    GRID_BAR();
    }
    if constexpr ((PH_MASK >> 15) & 1) {
    const int lane = lane_opaque(); unsigned char* const ws = ptr_opaque(args.ws);
    { RouterRegs RR; route_load(args, RR, lane); for (int tg = bx; tg < 256; tg += G) route_group(RR, ws, args.out, (LAS int*)L, tg, wave, lane); }
    GRID_BAR();
    }
    int tot[8], off[9]; moe_totals(ws0, lane_opaque(), tot); moe_offsets(tot, off);
    const int ntiles = off[8] >> 8;
    if constexpr ((PH_MASK >> 16) & 1) {
    const int lane = lane_opaque(); unsigned char* const ws = ptr_opaque(args.ws);
    {
        for (int tg = bx; tg < 256; tg += G) gather_group(args, ws, args.out, off, tg, wave, lane);
        const int tid2 = wave * 64 + lane;
        if (bx == 0 && tid2 < 160) { int e = 0;
#pragma unroll
            for (int k = 1; k < 8; ++k) if (tid2 * 256 >= off[k]) e = k;
            ((int*)(ws + WS_TILE))[tid2] = e; }
#pragma unroll
        for (int e = 0; e < NEXP; ++e) { const int r0 = off[e] + tot[e], r1 = off[e + 1];
            for (int rr = r0 + gw; rr < r1; rr += NGW) { unsigned long long* o8 = (unsigned long long*)((bf16*)(ws + WS_AMOE) + (size_t)rr * D_) + lane;
#pragma unroll
                for (int j = 0; j < 4; ++j) o8[64 * j] = 0ull; } }
    }
    if constexpr (PROBE_REP == 20) {
    {
        for (int tg = bx; tg < 256; tg += G) gather_group(args, ws, args.out, off, tg, wave, lane);
        const int tid2 = wave * 64 + lane;
        if (bx == 0 && tid2 < 160) { int e = 0;
#pragma unroll
            for (int k = 1; k < 8; ++k) if (tid2 * 256 >= off[k]) e = k;
            ((int*)(ws + WS_TILE))[tid2] = e; }
#pragma unroll
        for (int e = 0; e < NEXP; ++e) { const int r0 = off[e] + tot[e], r1 = off[e + 1];
            for (int rr = r0 + gw; rr < r1; rr += NGW) { unsigned long long* o8 = (unsigned long long*)((bf16*)(ws + WS_AMOE) + (size_t)rr * D_) + lane;
#pragma unroll
                for (int j = 0; j < 4; ++j) o8[64 * j] = 0ull; } }
    }
    }
    GRID_BAR();
    }
    if constexpr ((PH_MASK >> 17) & 1) {
    const int lane = lane_opaque(); unsigned char* const ws = ptr_opaque(args.ws);
    for (int b = 0; b < 3; ++b) {
        const int tlo = b * MOE_BATCH_TILES; int nt = ntiles - tlo; nt = nt < 0 ? 0 : (nt > MOE_BATCH_TILES ? MOE_BATCH_TILES : nt);
        { pg8::Gemm g{(const bf16*)(ws + WS_AMOE), (const bf16*)(ws + WS_WMGU), MOE_ROWS, NEXP * 2 * FFE, D_};
          pg8::MoeOrder S{(const int*)(ws + WS_TILE), tlo, nt, 2 * FFE / 256, G, bx};
          pg8::EpiSwiGLU E{(bf16*)(ws + WS_MACT) - (size_t)tlo * 256 * FFE, FFE, 2 * FFE / 256, nullptr};
          pg8::gemm_phase<pg8::EpiSwiGLU, pg8::MoeOrder, true, true>(L, g, S, E, wave); }
        if constexpr (PROBE_REP == 21) {
        { pg8::Gemm g{(const bf16*)(ws + WS_AMOE), (const bf16*)(ws + WS_WMGU), MOE_ROWS, NEXP * 2 * FFE, D_};
          pg8::MoeOrder S{(const int*)(ws + WS_TILE), tlo, nt, 2 * FFE / 256, G, bx};
          pg8::EpiSwiGLU E{(bf16*)(ws + WS_MACT) - (size_t)tlo * 256 * FFE, FFE, 2 * FFE / 256, nullptr};
          pg8::gemm_phase<pg8::EpiSwiGLU, pg8::MoeOrder, true, true>(L, g, S, E, wave); }
        }
        GRID_BAR();
        { pg8::Gemm g{(const bf16*)(ws + WS_MACT) - (size_t)tlo * 256 * FFE, (const bf16*)(ws + WS_WMD), MOE_ROWS, NEXP * D_, FFE};
          pg8::MoeOrder S{(const int*)(ws + WS_TILE), tlo, nt, D_ / 256, G, bx};
          pg8::EpiStoreBf16 E{(bf16*)(ws + WS_AMOE), D_, D_ / 256, nullptr};
          pg8::gemm_phase<pg8::EpiStoreBf16, pg8::MoeOrder, true, true>(L, g, S, E, wave); }
        if constexpr (PROBE_REP == 22) {
        { pg8::Gemm g{(const bf16*)(ws + WS_MACT) - (size_t)tlo * 256 * FFE, (const bf16*)(ws + WS_WMD), MOE_ROWS, NEXP * D_, FFE};
          pg8::MoeOrder S{(const int*)(ws + WS_TILE), tlo, nt, D_ / 256, G, bx};
          pg8::EpiStoreBf16 E{(bf16*)(ws + WS_AMOE), D_, D_ / 256, nullptr};
          pg8::gemm_phase<pg8::EpiStoreBf16, pg8::MoeOrder, true, true>(L, g, S, E, wave); }
        }
        GRID_BAR();
    }
    }
    if constexpr ((PH_MASK >> 18) & 1) {
    const int lane = lane_opaque(); unsigned char* const ws = ptr_opaque(args.ws);
    for (int t = gw; t < S_; t += NGW) combine_token(ws, args.out, off, t, lane);
#if PROBE
    {
        const unsigned* ts = (const unsigned*)(ws + WS_CTL) + 512;
        const unsigned dA = PROBE_A < 0 ? 32000u : (__hip_atomic_load(ts + PROBE_A, __ATOMIC_RELAXED, __HIP_MEMORY_SCOPE_AGENT) - __hip_atomic_load(ts + PROBE_A - 1, __ATOMIC_RELAXED, __HIP_MEMORY_SCOPE_AGENT));
        const unsigned dB = __hip_atomic_load(ts + PROBE_B, __ATOMIC_RELAXED, __HIP_MEMORY_SCOPE_AGENT) - __hip_atomic_load(ts + PROBE_B - 1, __ATOMIC_RELAXED, __HIP_MEMORY_SCOPE_AGENT);
        const int rows = 8 * (int)(dA / 3200u) + 64;
        const float addB = 4.0f * (float)(dB / 3200u) + 8.0f;
        for (int t = gw; t < S_; t += NGW) {
            if (t < rows) { f32x4* xo = (f32x4*)(args.out + (size_t)t * D_) + lane;
#pragma unroll
                for (int j = 0; j < 4; ++j) xo[64 * j] = xo[64 * j] + 5.0f; }
            if (t == S_ - 1 && lane == 63) args.out[(size_t)t * D_ + 1023] += addB;
        }
    }
#endif
    }
}

extern "C" void kernel_launch(void* const* d_in, const int* in_sizes, int n_in, void* d_out, int out_size, void* d_ws, size_t ws_size, hipStream_t stream) {
    static int grid = 0;
    if (grid == 0) {
        if (n_in != 39 || out_size != S_ * D_ || ws_size < WS_END) { fprintf(stderr, "kernel_launch: unexpected shapes (n_in %d out %d ws %zu)\n", n_in, out_size, ws_size); grid = -1; return; }
        int dev = 0, cus = 0, per_cu = 0;
        if (hipGetDevice(&dev) != hipSuccess || hipDeviceGetAttribute(&cus, hipDeviceAttributeMultiprocessorCount, dev) != hipSuccess) { grid = -1; return; }
        if (hipFuncSetAttribute((const void*)fwd_kernel, hipFuncAttributeMaxDynamicSharedMemorySize, LDS_BYTES) != hipSuccess) { grid = -1; return; }
        if (hipOccupancyMaxActiveBlocksPerMultiprocessor(&per_cu, (const void*)fwd_kernel, 512, LDS_BYTES) != hipSuccess || per_cu < 1) { fprintf(stderr, "kernel_launch: occupancy query says %d\n", per_cu); }
        (void)hipGetLastError();
        if (cus < 256) { fprintf(stderr, "kernel_launch: this build needs >= 256 CUs (task slots of the delta-net scan); got %d\n", cus); grid = -1; return; }
        grid = 256;
    }
    if (grid < 0) return;
    if (hipMemsetAsync((char*)d_ws + WS_CTL, 0, CTL_ZERO_BYTES, stream) != hipSuccess) return;
    Args a{};
    for (int i = 0; i < 39; ++i) a.in[i] = (const float*)d_in[i];
    a.out = (float*)d_out; a.ws = (unsigned char*)d_ws;
    hipLaunchKernelGGL(fwd_kernel, dim3(grid), dim3(512), LDS_BYTES, stream, a);
}
```

```cpp
#include <hip/hip_runtime.h>
#include <cstdio>
#include <cstdint>
namespace pg8 {
#define PG8_LAS __attribute__((address_space(3)))
typedef unsigned short bf16_t;
typedef short bf16x8 __attribute__((ext_vector_type(8)));
typedef float f32x4 __attribute__((ext_vector_type(4)));
typedef unsigned u32x4 __attribute__((ext_vector_type(4)));
constexpr int BM = 256, BK = 64, HALF = 128, HTB = HALF * BK * 2  , STAGE_BYTES = 8 * HTB, NXCD = 8, WGM = 8;

__host__ __device__ __forceinline__ int lds_byte(int r, int c) { const int st = (r >> 4) * 2 + (c >> 5), rr = r & 15, cc = c & 31, ob = rr * 64 + cc * 2; return st * 1024 + (ob ^ (((ob >> 9) & 1) << 5)); }
__host__ __device__ __forceinline__ void stage_rc(int b, int& R, int& C) { const int st = b / 1024, sb = b % 1024, swz = sb ^ (((sb >> 9) & 1) << 5); R = (st >> 1) * 16 + swz / 64; C = (st & 1) * 32 + (swz % 64) / 2; }
__host__ __device__ __forceinline__ int perm32(int rho) { const int n = rho >> 4, i = rho & 15; return 8 * (i >> 2) + 4 * n + (i & 3); }

struct Unit { int pm, pn; };
struct Gemm { const bf16_t* A; const bf16_t* Bt; int M, N, K; };

struct StaticOrder {
    int nM, nN, nwg, G, c;
    __host__ __device__ void init(int M, int N, int G_, int c_) { nM = M / BM; nN = N / BM; nwg = nM * nN; G = G_; c = c_; }
    __host__ __device__ bool next(int i, Unit& u) const {
        const long L = (long)i * G + c; if (L >= nwg) return false;
        int wgid = (int)L; { const int q = nwg / NXCD, r = nwg % NXCD, xcd = wgid % NXCD, off = wgid / NXCD; wgid = (xcd < r ? xcd * (q + 1) : r * (q + 1) + (xcd - r) * q) + off; }
        const int nig = WGM * nN, gid = wgid / nig, fm = gid * WGM, gsz = (nM - fm) < WGM ? (nM - fm) : WGM;
        u.pm = fm + ((wgid % nig) % gsz); u.pn = (wgid % nig) / gsz; return true;
    }
    __device__ __forceinline__ void a_ready(const Unit&) const {}
    __device__ __forceinline__ void done(const Unit&) const {}
};

__device__ __forceinline__ unsigned cvt_pk_bf16(float lo, float hi) { unsigned r; asm volatile("v_cvt_pk_bf16_f32 %0, %1, %2" : "=v"(r) : "v"(lo), "v"(hi)); return r; }
struct EpiStoreBf16 {
    static constexpr bool PERM = true, AFTER_DRAIN = false;
    bf16_t* O; int ldc; int ntn; const float* rowss;
    __device__ __forceinline__ void operator()(const f32x4 (&acc)[2][2][4][2], const Unit& u, int wr, int wc, int fr, int fq) const {
        const int row0 = u.pm * BM + wr * 64 + fr; const int pn = ntn ? (u.pn % ntn) : u.pn;
        const int col0 = pn * BM + wc * 32 + 8 * fq;
#pragma unroll
        for (int ai = 0; ai < 2; ++ai)
#pragma unroll
            for (int m = 0; m < 4; ++m) { bf16_t* rowp = O + (size_t)(row0 + ai * HALF + m * 16) * ldc + col0;
                float rs = 1.0f; if (rowss) { const f32x4* sp = (const f32x4*)(rowss + (size_t)(row0 + ai * HALF + m * 16) * 16); const f32x4 s0 = sp[0], s1 = sp[1], s2 = sp[2], s3 = sp[3]; const f32x4 st = (s0 + s1) + (s2 + s3); rs = 1.0f / sqrtf(((st[0] + st[1]) + (st[2] + st[3])) * (1.0f / 1024.f) + 1e-6f); }
#pragma unroll
                for (int bj = 0; bj < 2; ++bj) { const f32x4 v0 = acc[ai][bj][m][0] * rs, v1 = acc[ai][bj][m][1] * rs;
                    u32x4 w; w.x = cvt_pk_bf16(v0[0], v0[1]); w.y = cvt_pk_bf16(v0[2], v0[3]); w.z = cvt_pk_bf16(v1[0], v1[1]); w.w = cvt_pk_bf16(v1[2], v1[3]);
                    *(u32x4*)(rowp + bj * HALF) = w; } }
    }
};
struct EpiResF32 {
    static constexpr bool PERM = false, AFTER_DRAIN = false;
    const float* base; float* out; int ldc; bf16_t* xb; float* rowss;
    __device__ __forceinline__ void operator()(const f32x4 (&acc)[2][2][4][2], const Unit& u, int wr, int wc, int fr, int fq) const {
        const int row0 = u.pm * BM + wr * 64 + fr, col0 = u.pn * BM + wc * 32 + 4 * fq;
#pragma unroll
        for (int ai = 0; ai < 2; ++ai)
#pragma unroll
            for (int m = 0; m < 4; ++m) { const size_t off = (size_t)(row0 + ai * HALF + m * 16) * ldc + col0; float ss = 0.f;
#pragma unroll
                for (int bj = 0; bj < 2; ++bj)
#pragma unroll
                    for (int n = 0; n < 2; ++n) { const f32x4 b = *(const f32x4*)(base + off + bj * HALF + n * 16); const f32x4 o = b + acc[ai][bj][m][n]; *(f32x4*)(out + off + bj * HALF + n * 16) = o;
                        if (xb) { ss += (o[0] * o[0] + o[1] * o[1]) + (o[2] * o[2] + o[3] * o[3]);
                            unsigned long long w = (unsigned long long)cvt_pk_bf16(o[0], o[1]) | ((unsigned long long)cvt_pk_bf16(o[2], o[3]) << 32); *(unsigned long long*)(xb + off + bj * HALF + n * 16) = w; } }
                if (xb) { ss += __shfl_xor(ss, 16); ss += __shfl_xor(ss, 32); if (fq == 0) rowss[(size_t)(row0 + ai * HALF + m * 16) * 16 + u.pn * 4 + wc] = ss; } }
    }
};
struct EpiSwiGLU {
    static constexpr bool PERM = true, AFTER_DRAIN = false;
    bf16_t* O; int ldc; int ntn; const float* rowss;
    __device__ __forceinline__ void operator()(const f32x4 (&acc)[2][2][4][2], const Unit& u, int wr, int wc, int fr, int fq) const {
        const int row0 = u.pm * BM + wr * 64 + fr; const int pn = ntn ? (u.pn % ntn) : u.pn;
        const int col0 = pn * HALF + wc * 32 + 8 * fq;
#pragma unroll
        for (int ai = 0; ai < 2; ++ai)
#pragma unroll
            for (int m = 0; m < 4; ++m) { bf16_t* rowp = O + (size_t)(row0 + ai * HALF + m * 16) * ldc + col0;
                float rs = 1.0f; if (rowss) { const f32x4* sp = (const f32x4*)(rowss + (size_t)(row0 + ai * HALF + m * 16) * 16); const f32x4 s0 = sp[0], s1 = sp[1], s2 = sp[2], s3 = sp[3]; const f32x4 st = (s0 + s1) + (s2 + s3); rs = 1.0f / sqrtf(((st[0] + st[1]) + (st[2] + st[3])) * (1.0f / 1024.f) + 1e-6f); }
                float r[8];
#pragma unroll
                for (int n = 0; n < 2; ++n)
#pragma unroll
                    for (int i = 0; i < 4; ++i) { const float g = acc[ai][0][m][n][i] * rs, up = acc[ai][1][m][n][i] * rs; r[n * 4 + i] = g * __builtin_amdgcn_rcpf(1.0f + __expf(-g)) * up; }
                u32x4 w; w.x = cvt_pk_bf16(r[0], r[1]); w.y = cvt_pk_bf16(r[2], r[3]); w.z = cvt_pk_bf16(r[4], r[5]); w.w = cvt_pk_bf16(r[6], r[7]);
                *(u32x4*)rowp = w; }
    }
};
struct MoeOrder {
    const int* tile_exp; int tlo, nt, nN, G, c;
    __device__ __forceinline__ bool next(int i, Unit& u) const {
        const int L = i * G + c; if (nt <= 0 || L >= nt * nN) return false;
        const int t = tlo + (L % nt), cn = L / nt;
        const int e = __builtin_amdgcn_readfirstlane(__hip_atomic_load(tile_exp + t, __ATOMIC_RELAXED, __HIP_MEMORY_SCOPE_AGENT));
        u.pm = t; u.pn = e * nN + cn; return true;
    }
    __device__ __forceinline__ void a_ready(const Unit&) const {}
    __device__ __forceinline__ void done(const Unit&) const {}
};
template <class Epi, class Sched, bool ALIGN_EPI = false, bool SP2 = false>
__device__ __forceinline__ void gemm_phase(PG8_LAS unsigned char* lds, const Gemm g, const Sched& S, const Epi& E, const int wave_id) {
    int tid_; asm volatile("v_mbcnt_lo_u32_b32 %0, -1, 0\n\tv_mbcnt_hi_u32_b32 %0, -1, %0" : "=v"(tid_)); tid_ += wave_id * 64;
    const int tid = tid_, wid = __builtin_amdgcn_readfirstlane(tid >> 6), lane = tid & 63, wr = wid >> 2, wc = wid & 3, fr = lane & 15, fq = lane >> 4;
    const int K = g.K, nt = K / BK;
    unsigned voffA[2], voffB[2];
#pragma unroll
    for (int i = 0; i < 2; ++i) { int R, C; stage_rc(tid * 16 + i * 8192, R, C); const int Rb = Epi::PERM ? ((R & ~31) + perm32(R & 31)) : R;
        voffA[i] = (unsigned)(R * K + C) * 2u; voffB[i] = (unsigned)(Rb * K + C) * 2u; }
    const size_t kstep = (size_t)(BK * 2);
    const size_t hstep = (size_t)HALF * K * 2;
    const size_t tstep = 2 * hstep;
    const unsigned ldsw = (unsigned)wid * 1024u;
    const int aoff = lds_byte(wr * 64 + fr, fq * 8), boff = lds_byte(wc * 32 + fr, fq * 8);
#define PG8_SA(b, h) (((b) * 2 + (h)) * HTB)
#define PG8_SB(b, h) ((4 + (b) * 2 + (h)) * HTB)
#define PG8_STAGE(bufoff, gbase, voff) do { _Pragma("unroll") for (int _i = 0; _i < 2; ++_i) \
        __builtin_amdgcn_global_load_lds((const unsigned*)((const char*)(gbase) + (voff)[_i]), (PG8_LAS unsigned*)(lds + (bufoff) + ldsw + _i * 8192), 16, 0, 0); } while (0)
#define PG8_LDA(dst, b, h) do { _Pragma("unroll") for (int m = 0; m < 4; ++m) _Pragma("unroll") for (int k = 0; k < 2; ++k) dst[m][k] = *(const PG8_LAS bf16x8*)(lds + PG8_SA(b, h) + aoff + m * 2048 + k * 1024); } while (0)
#define PG8_LDB(dst, b, h) do { _Pragma("unroll") for (int n = 0; n < 2; ++n) _Pragma("unroll") for (int k = 0; k < 2; ++k) dst[n][k] = *(const PG8_LAS bf16x8*)(lds + PG8_SB(b, h) + boff + n * 2048 + k * 1024); } while (0)
#define PG8_MMA(ai, bj, At, Bt) do { __builtin_amdgcn_s_setprio(1); _Pragma("unroll") for (int m = 0; m < 4; ++m) _Pragma("unroll") for (int n = 0; n < 2; ++n) _Pragma("unroll") for (int k = 0; k < 2; ++k) \
        acc[ai][bj][m][n] = __builtin_amdgcn_mfma_f32_16x16x32_bf16(Bt[n][k], At[m][k], acc[ai][bj][m][n], 0, 0, 0); __builtin_amdgcn_s_setprio(0); } while (0)
#define PG8_WAIT_V(n) asm volatile("s_waitcnt vmcnt(" #n ")" ::: "memory")
#define PG8_WAIT_L(n) asm volatile("s_waitcnt lgkmcnt(" #n ")" ::: "memory")
#define PG8_BAR __builtin_amdgcn_s_barrier()
#define PG8_SCHED __builtin_amdgcn_sched_barrier(0)
    Unit cur, nxt; int ui = 0;
    if (!S.next(0, cur)) return;
    f32x4 acc[2][2][4][2];
#pragma unroll
    for (int a = 0; a < 2; ++a)
#pragma unroll
        for (int b = 0; b < 2; ++b)
#pragma unroll
            for (int m = 0; m < 4; ++m)
#pragma unroll
                for (int n = 0; n < 2; ++n) acc[a][b][m][n] = (f32x4){0.f, 0.f, 0.f, 0.f};
    bf16x8 At[4][2], B0[2][2], B1[2][2];
    const char* cA = (const char*)g.A + (size_t)cur.pm * tstep; const char* cB = (const char*)g.Bt + (size_t)cur.pn * tstep;
    S.a_ready(cur);
    if constexpr (SP2) {
        PG8_STAGE(PG8_SB(0, 0), cB, voffB); PG8_STAGE(PG8_SB(0, 1), cB + hstep, voffB); PG8_STAGE(PG8_SA(0, 0), cA, voffA); PG8_STAGE(PG8_SA(0, 1), cA + hstep, voffA);
        if (wr == 1) PG8_BAR;
        PG8_WAIT_V(2); PG8_BAR;
        PG8_STAGE(PG8_SB(1, 0), cB + kstep, voffB); PG8_STAGE(PG8_SA(1, 0), cA + kstep, voffA); PG8_STAGE(PG8_SB(1, 1), cB + hstep + kstep, voffB);
        PG8_WAIT_V(6); PG8_BAR;
    } else {
        PG8_STAGE(PG8_SB(0, 0), cB, voffB); PG8_STAGE(PG8_SA(0, 0), cA, voffA); PG8_STAGE(PG8_SB(0, 1), cB + hstep, voffB); PG8_STAGE(PG8_SA(0, 1), cA + hstep, voffA);
        if (wr == 1) PG8_BAR;
        PG8_WAIT_V(4); PG8_BAR;
        PG8_STAGE(PG8_SB(1, 0), cB + kstep, voffB); PG8_STAGE(PG8_SA(1, 0), cA + kstep, voffA); PG8_STAGE(PG8_SB(1, 1), cB + hstep + kstep, voffB);
        PG8_WAIT_V(6); PG8_BAR;
    }
    for (;;) {
        const bool has_next = S.next(ui + 1, nxt);
        const char* nA = has_next ? (const char*)g.A + (size_t)nxt.pm * tstep : cA; const char* nB = has_next ? (const char*)g.Bt + (size_t)nxt.pn * tstep : cB;
        for (int t = 0; t < nt; t += 2) {
            const bool last = (t == nt - 2);
            const char* a1 = cA + (size_t)(t + 1) * kstep;
            const char* a2 = last ? nA : cA + (size_t)(t + 2) * kstep; const char* b2 = last ? nB : cB + (size_t)(t + 2) * kstep;
            const char* a3 = a2 + kstep; const char* b3 = b2 + kstep;
            if (last && has_next) S.a_ready(nxt);
            if constexpr (SP2) {
            PG8_LDB(B0, 0, 0); PG8_LDB(B1, 0, 1); PG8_SCHED; PG8_LDA(At, 0, 0); PG8_STAGE(PG8_SA(1, 1), a1 + hstep, voffA);
            PG8_WAIT_V(8); PG8_WAIT_L(0); PG8_BAR; PG8_MMA(0, 0, At, B0); PG8_MMA(0, 1, At, B1); PG8_BAR; PG8_SCHED;
            PG8_LDA(At, 0, 1); PG8_STAGE(PG8_SB(0, 0), b2, voffB); PG8_STAGE(PG8_SB(0, 1), b2 + hstep, voffB); PG8_STAGE(PG8_SA(0, 0), a2, voffA);
            PG8_WAIT_V(8); PG8_WAIT_L(0); PG8_BAR; PG8_MMA(1, 0, At, B0); PG8_MMA(1, 1, At, B1); PG8_BAR; PG8_SCHED;
            PG8_LDB(B0, 1, 0); PG8_LDB(B1, 1, 1); PG8_SCHED; PG8_LDA(At, 1, 0); PG8_STAGE(PG8_SA(0, 1), a2 + hstep, voffA);
            PG8_WAIT_V(8); PG8_WAIT_L(0); PG8_BAR; PG8_MMA(0, 0, At, B0); PG8_MMA(0, 1, At, B1); PG8_BAR; PG8_SCHED;
            PG8_LDA(At, 1, 1); PG8_STAGE(PG8_SB(1, 0), b3, voffB); PG8_STAGE(PG8_SB(1, 1), b3 + hstep, voffB); PG8_STAGE(PG8_SA(1, 0), a3, voffA);
            PG8_WAIT_V(8); PG8_WAIT_L(0); PG8_BAR; PG8_MMA(1, 0, At, B0); PG8_MMA(1, 1, At, B1); PG8_BAR; PG8_SCHED;
            } else {
            PG8_LDB(B0, 0, 0); PG8_SCHED; PG8_LDA(At, 0, 0); PG8_STAGE(PG8_SA(1, 1), a1 + hstep, voffA);
            PG8_WAIT_L(8); PG8_BAR; PG8_WAIT_L(0); PG8_MMA(0, 0, At, B0); PG8_BAR; PG8_SCHED;
            PG8_LDB(B1, 0, 1); PG8_STAGE(PG8_SB(0, 0), b2, voffB);
            PG8_BAR; PG8_WAIT_L(0); PG8_MMA(0, 1, At, B1); PG8_BAR;
            PG8_LDA(At, 0, 1); PG8_STAGE(PG8_SA(0, 0), a2, voffA);
            PG8_BAR; PG8_WAIT_L(0); PG8_MMA(1, 0, At, B0); PG8_BAR; PG8_SCHED;
            PG8_STAGE(PG8_SB(0, 1), b2 + hstep, voffB);
            PG8_WAIT_V(6); PG8_BAR; PG8_MMA(1, 1, At, B1); PG8_BAR;
            PG8_LDB(B0, 1, 0); PG8_SCHED; PG8_LDA(At, 1, 0); PG8_STAGE(PG8_SA(0, 1), a2 + hstep, voffA);
            PG8_WAIT_L(8); PG8_BAR; PG8_WAIT_L(0); PG8_MMA(0, 0, At, B0); PG8_BAR; PG8_SCHED;
            PG8_LDB(B1, 1, 1); PG8_STAGE(PG8_SB(1, 0), b3, voffB);
            PG8_BAR; PG8_WAIT_L(0); PG8_MMA(0, 1, At, B1); PG8_BAR;
            PG8_LDA(At, 1, 1); PG8_STAGE(PG8_SA(1, 0), a3, voffA);
            PG8_BAR; PG8_WAIT_L(0); PG8_MMA(1, 0, At, B0); PG8_BAR; PG8_SCHED;
            PG8_STAGE(PG8_SB(1, 1), b3 + hstep, voffB);
            PG8_WAIT_V(6); PG8_BAR; PG8_MMA(1, 1, At, B1); PG8_BAR;
            }
        }
        if constexpr (ALIGN_EPI) { if (wr == 0) PG8_BAR; }
        if constexpr (!Epi::AFTER_DRAIN) { E(acc, cur, wr, wc, fr, fq); S.done(cur); }
        if (!has_next) break;
#pragma unroll
        for (int a = 0; a < 2; ++a)
#pragma unroll
            for (int b = 0; b < 2; ++b)
#pragma unroll
                for (int m = 0; m < 4; ++m)
#pragma unroll
                    for (int n = 0; n < 2; ++n) acc[a][b][m][n] = (f32x4){0.f, 0.f, 0.f, 0.f};
        cur = nxt; cA = nA; cB = nB; ++ui;
        if constexpr (ALIGN_EPI) { if (wr == 1) PG8_BAR; }
    }
    PG8_WAIT_V(0);
    if constexpr (!ALIGN_EPI) { if (wr == 0) PG8_BAR; }
    PG8_BAR;
    if constexpr (Epi::AFTER_DRAIN) { E.fused(acc, cur, wr, wc, fr, fq, lds, wid, lane); S.done(cur); }
#undef PG8_SA
#undef PG8_SB
#undef PG8_STAGE
#undef PG8_LDA
#undef PG8_LDB
#undef PG8_MMA
#undef PG8_WAIT_V
#undef PG8_WAIT_L
#undef PG8_BAR
#undef PG8_SCHED
}
}
constexpr int S_ = 16384, D_ = 1024;
constexpr int EVEN_IN = 3072, LORA_N = 512, FF0 = 2816, ODD_IN = 3600, ODD_PAD = 3840, FFE = 3584, NEXP = 8;
constexpr int MOE_ROWS = 32768 + 8 * 256;
constexpr int MOE_BATCH_TILES = 64;
constexpr size_t MiB = 1u << 20;
constexpr size_t WS_CTL = 0, CTL_ZERO_BYTES = 1 * MiB;
constexpr size_t WS_WIN0 = 2 * MiB, WS_WL = 8 * MiB, WS_WOUT0 = 9 * MiB, WS_WGU0 = 11 * MiB, WS_WD0 = 22 * MiB, WS_WIN1 = 28 * MiB, WS_WOUT1 = 36 * MiB;
constexpr size_t WS_TOK = 38 * MiB;
constexpr size_t WS_TILE = 39 * MiB;
constexpr size_t WS_A = 40 * MiB;
constexpr size_t WS_H = WS_A, WS_HX = WS_A + 32 * MiB;
constexpr size_t WS_LW0 = WS_A, WS_LW1 = WS_A + 32 * MiB, WS_R = WS_A + 64 * MiB, WS_V = WS_A + 80 * MiB, WS_KK = WS_A + 96 * MiB, WS_KD0 = WS_A + 112 * MiB, WS_KD1 = WS_A + 128 * MiB, WS_B0 = WS_A + 144 * MiB;
constexpr size_t WS_H2 = WS_A, WS_H3 = WS_A + 32 * MiB;
constexpr size_t WS_WMGU = WS_A, WS_WMD = WS_A + 112 * MiB;
constexpr size_t WS_B = 208 * MiB;
constexpr size_t WS_PROJ0 = WS_B, WS_LORA = WS_B + 96 * MiB, WS_QN = WS_B + 112 * MiB, WS_KN = WS_B + 128 * MiB, WS_Y = WS_B + 144 * MiB;
constexpr size_t WS_B1 = WS_B + 176 * MiB, WS_GATE = WS_B + 192 * MiB, WS_BONUS = WS_B + 208 * MiB, WS_Y0 = WS_LORA, WS_Y1 = WS_B + 224 * MiB;
constexpr size_t WS_ACT0 = WS_B, WS_PROJ1 = WS_B + 88 * MiB;
constexpr size_t WS_QD = WS_B, WS_KD = WS_B + 16 * MiB, WS_VD = WS_B + 32 * MiB, WS_YCAT1 = WS_B + 48 * MiB, WS_GB = WS_B + 80 * MiB  ;
constexpr size_t WS_O0 = WS_B + 208 * MiB, WS_O1 = WS_B + 224 * MiB;
constexpr size_t WS_AMOE = WS_B, WS_MACT = WS_B + 88 * MiB;
constexpr size_t WS_END_OLD = 448 * MiB, WS_RSS1 = 460 * MiB, WS_RSS2 = 461 * MiB, WS_END = 462 * MiB;
static_assert(WS_MACT + (size_t)MOE_BATCH_TILES * 256 * FFE * 2 <= WS_END, "moe act");
static_assert(WS_AMOE + (size_t)MOE_ROWS * D_ * 2 <= WS_MACT, "amoe");
static_assert(WS_PROJ1 + (size_t)S_ * ODD_PAD * 2 <= WS_O0, "proj1");
constexpr int CW_CNT = 64;
constexpr int CW_RSS1 = 32768, CW_RSS2 = 32768 + 16384;
constexpr int CW_BAR = 4096;
constexpr int LDS_BYTES = 159744, LDS_ZERO_OFF = LDS_BYTES - 512, MISC_OFF = LDS_ZERO_OFF + 64;

#define GAS __attribute__((address_space(1)))
#define LAS __attribute__((address_space(3)))
#define DI __device__ __forceinline__
typedef unsigned short bf16;
typedef unsigned v4u __attribute__((ext_vector_type(4)));
typedef float f32x4 __attribute__((ext_vector_type(4)));
typedef GAS unsigned gu32;
#define LDS_WAIT() asm volatile("s_waitcnt lgkmcnt(0)" ::: "memory")
DI unsigned f2bf(float f) { unsigned u = __builtin_bit_cast(unsigned, f); return (u + 0x7fffu + ((u >> 16) & 1u)) >> 16; }
typedef float f32x2_t __attribute__((ext_vector_type(2))); typedef __bf16 bf16x2_t __attribute__((ext_vector_type(2)));
DI unsigned pk2(float lo, float hi) { const f32x2_t v = {lo, hi}; const bf16x2_t b = __builtin_convertvector(v, bf16x2_t); return __builtin_bit_cast(unsigned, b); }
DI float bflo(unsigned w) { return __uint_as_float(w << 16); }
DI float bfhi(unsigned w) { return __uint_as_float(w & 0xffff0000u); }
DI float bf2f(bf16 b) { return __uint_as_float(((unsigned)b) << 16); }
DI void ld8(const bf16* p, float (&v)[8]) { const v4u w = *(const v4u*)p; v[0] = bflo(w.x); v[1] = bfhi(w.x); v[2] = bflo(w.y); v[3] = bfhi(w.y); v[4] = bflo(w.z); v[5] = bfhi(w.z); v[6] = bflo(w.w); v[7] = bfhi(w.w); }
DI void st8(bf16* p, const float (&v)[8]) { v4u w; w.x = pk2(v[0], v[1]); w.y = pk2(v[2], v[3]); w.z = pk2(v[4], v[5]); w.w = pk2(v[6], v[7]); *(v4u*)p = w; }
DI void ld8f(const float* p, float (&v)[8]) { const f32x4 a = *(const f32x4*)p, b = *(const f32x4*)(p + 4); v[0] = a.x; v[1] = a.y; v[2] = a.z; v[3] = a.w; v[4] = b.x; v[5] = b.y; v[6] = b.z; v[7] = b.w; }
DI void st8f(float* p, const float (&v)[8]) { *(f32x4*)p = (f32x4){v[0], v[1], v[2], v[3]}; *(f32x4*)(p + 4) = (f32x4){v[4], v[5], v[6], v[7]}; }
DI float wave_sum(float v) {
#pragma unroll
    for (int o = 1; o < 64; o <<= 1) v += __shfl_xor(v, o);
    return v;
}
template <int W> DI float grp_sum(float v) {
#pragma unroll
    for (int o = 1; o < W; o <<= 1) v += __shfl_xor(v, o);
    return v;
}
DI float sigmoidf_(float x) { return 1.0f / (1.0f + __expf(-x)); }
DI float softplusf_(float x) { return x > 20.f ? x : log1pf(__expf(x)); }
DI float siluf_(float x) { return x / (1.0f + __expf(-x)); }

struct Args { const float* in[39]; float* out; unsigned char* ws; };

DI void transpose_item(const float* W, int K, int N, bf16* WT, int rowbase, LAS float* scr, int k0, int n0, int lane, const float* kscale = nullptr) {
    const int nn = n0 + (lane & 31); const bool ok = nn < N;
#pragma unroll
    for (int i = 0; i < 32; ++i) { const int kk = 2 * i + (lane >> 5); scr[kk * 33 + (lane & 31)] = ok ? W[(size_t)(k0 + kk) * N + nn] * (kscale ? kscale[k0 + kk] : 1.0f) : 0.f; }
    LDS_WAIT(); asm volatile("" ::: "memory");
    const int c = lane & 7;
#pragma unroll
    for (int j = 0; j < 4; ++j) { const int n = (lane >> 3) + 8 * j; const LAS float* s = scr + (8 * c) * 33 + n;
        v4u o; o.x = pk2(s[0 * 33], s[1 * 33]); o.y = pk2(s[2 * 33], s[3 * 33]); o.z = pk2(s[4 * 33], s[5 * 33]); o.w = pk2(s[6 * 33], s[7 * 33]);
        *(v4u*)(WT + (size_t)(rowbase + n) * K + k0 + 8 * c) = o; }
    LDS_WAIT(); asm volatile("" ::: "memory");
}

struct TrItem { const float* src; bf16* dst; int K, N, k0, n0, rowbase; };
DI void tr_load(const TrItem& d, int lane, float (&v)[32]) {
#pragma unroll
    for (int i = 0; i < 32; ++i) { const int kk = 2 * i + (lane >> 5); v[i] = d.src[(size_t)(d.k0 + kk) * d.N + d.n0 + (lane & 31)]; }
}
DI void tr_store(const TrItem& d, int lane, const float (&v)[32], LAS float* scr) {
#pragma unroll
    for (int i = 0; i < 32; ++i) scr[(2 * i + (lane >> 5)) * 33 + (lane & 31)] = v[i];
    LDS_WAIT(); asm volatile("" ::: "memory");
    const int c = lane & 7;
#pragma unroll
    for (int j = 0; j < 4; ++j) { const int n = (lane >> 3) + 8 * j; const LAS float* s = scr + (8 * c) * 33 + n;
        v4u o; o.x = pk2(s[0 * 33], s[1 * 33]); o.y = pk2(s[2 * 33], s[3 * 33]); o.z = pk2(s[4 * 33], s[5 * 33]); o.w = pk2(s[6 * 33], s[7 * 33]);
        *(v4u*)(d.dst + (size_t)(d.rowbase + n) * d.K + d.k0 + 8 * c) = o; }
    LDS_WAIT(); asm volatile("" ::: "memory");
}
DI void moe_gu_item(const Args& a, unsigned char* ws, int it, TrItem& d) {
    const int mtx = it / 1792, r = it % 1792, e = mtx >> 1, sel = mtx & 1, kb = r / 112, nb = r % 112, n0 = 32 * nb;
    d.src = (sel ? a.in[37] : a.in[36]) + (size_t)e * 1024 * FFE; d.dst = (bf16*)(ws + WS_WMGU) + (size_t)e * 2 * FFE * 1024; d.K = 1024; d.N = FFE; d.k0 = 64 * kb; d.n0 = n0;
    d.rowbase = (n0 / 128) * 256 + sel * 128 + (n0 % 128);
}
DI void moe_dn_item(const Args& a, unsigned char* ws, int it, TrItem& d) {
    const int e = it / 1792, r = it % 1792, kb = r / 32, nb = r % 32;
    d.src = a.in[38] + (size_t)e * 1024 * FFE; d.dst = (bf16*)(ws + WS_WMD) + (size_t)e * 1024 * FFE; d.K = FFE; d.N = 1024; d.k0 = 64 * kb; d.n0 = 32 * nb; d.rowbase = 32 * nb;
}
template <bool GU> DI void moe_copy_loop(const Args& a, unsigned char* ws, LAS float* scr, int first, int stride, int last, int lane) {
    first = __builtin_amdgcn_readfirstlane(first); stride = __builtin_amdgcn_readfirstlane(stride);
    if (first >= last) return;
    TrItem cur, nxt; float vc[32], vn[32];
    if (GU) moe_gu_item(a, ws, first, cur); else moe_dn_item(a, ws, first, cur);
    tr_load(cur, lane, vc);
    for (int it = first; it < last; it += stride) {
        const int itn = it + stride; const bool more = itn < last;
        if (more) { if (GU) moe_gu_item(a, ws, itn, nxt); else moe_dn_item(a, ws, itn, nxt); tr_load(nxt, lane, vn); }
        tr_store(cur, lane, vc, scr);
        if (more) { cur = nxt;
#pragma unroll
            for (int i = 0; i < 32; ++i) vc[i] = vn[i]; }
    }
}
DI bool transpose_job(int& r, const float* W, int K, int N, int Npad, bf16* WT, int row_off, int grp, int sel, LAS float* scr, int lane, const float* kscale = nullptr) {
    const int nblk = Npad / 32, cnt = (K / 64) * nblk;
    if (r >= cnt) { r -= cnt; return false; }
    const int kb = r / nblk, nb = r % nblk, n0 = 32 * nb;
    const int rowbase = row_off + (grp ? (n0 / grp) * (2 * grp) + sel * grp + (n0 % grp) : n0);
    transpose_item(W, K, N, WT, rowbase, scr, 64 * kb, n0, lane, kscale);
    return true;
}
#define XB_TMO      128
#define XB_XCNT(j)  (256  + 64 * (j))
#define XB_XSUB(j)  (1280 + 64 * (j))
#define XB_XGEN(j)  (2304 + 64 * (j))
#define XB_TOP      3328
#define XB_TOPGEN   3392
#define XCD_BAR_WORDS 3456
#define XB_SPIN_CAP (1u << 22)

__device__ __forceinline__ unsigned xb_ld(unsigned* p)              { return __hip_atomic_load(p, __ATOMIC_RELAXED, __HIP_MEMORY_SCOPE_AGENT); }
__device__ __forceinline__ unsigned xb_add(unsigned* p, unsigned v) { return __hip_atomic_fetch_add(p, v, __ATOMIC_RELAXED, __HIP_MEMORY_SCOPE_AGENT); }
__device__ __forceinline__ unsigned xb_xcc_id() { return (unsigned)__builtin_amdgcn_s_getreg((3 << 11) | 20) & 0xFu; }
#define XB_SPIN(cond, bar) do { unsigned _sp = 0; while (cond) { __builtin_amdgcn_s_sleep(1); \
    if ((++_sp & 255u) == 0u) { if (xb_ld(&(bar)[XB_TMO])) break; if (_sp > XB_SPIN_CAP) { atomicAdd(&(bar)[XB_TMO], 1u); break; } } } } while (0)

struct XcdBarrier {
    unsigned* bar; unsigned x;
    volatile LAS unsigned* st;
};

__device__ __forceinline__ XcdBarrier xcd_barrier_post(unsigned* bar, volatile LAS unsigned* st) {
    XcdBarrier b; b.bar = bar; b.x = xb_xcc_id(); b.st = st;
    if (threadIdx.x == 0) (void)xb_add(&bar[XB_XCNT(b.x)], 1u);
    return b;
}
__device__ __forceinline__ void xcd_barrier_complete(unsigned* bar, unsigned x, unsigned& nloc, unsigned& nx) {
    const unsigned G = gridDim.x * gridDim.y * gridDim.z;
    unsigned sum, cnt, mine, sp = 0u;
    for (;;) {
        sum = 0u; cnt = 0u; mine = 0u;
#pragma unroll
        for (unsigned j = 0; j < 16; ++j) { const unsigned c = xb_ld(&bar[XB_XCNT(j)]); sum += c; cnt += (c > 0u) ? 1u : 0u; mine = (j == x) ? c : mine; }
        if (sum == G) break;
        __builtin_amdgcn_s_sleep(1);
        if ((++sp & 255u) == 0u) { if (xb_ld(&bar[XB_TMO])) break; if (sp > XB_SPIN_CAP) { atomicAdd(&bar[XB_TMO], 1u); break; } }
    }
    nloc = mine > 0u ? mine : 1u; nx = cnt > 0u ? cnt : 1u;
}

__device__ __forceinline__ void xcd_barrier(const XcdBarrier& b, const bool wave0) {
    asm volatile("s_waitcnt vmcnt(0)" ::: "memory");
    __syncthreads();
    if (wave0 && __builtin_amdgcn_mbcnt_hi(~0u, __builtin_amdgcn_mbcnt_lo(~0u, 0u)) == 0u) {
        unsigned* bar = b.bar; asm volatile("" : "+s"(bar)); const unsigned bx_ = xb_xcc_id();
        __builtin_amdgcn_s_waitcnt(0);
        unsigned nloc = b.st[0], nx = b.st[1];
        if (nloc == 0u) { xcd_barrier_complete(bar, bx_, nloc, nx); b.st[0] = nloc; b.st[1] = nx; }
        const unsigned old = xb_add(&bar[XB_XSUB(bx_)], 1u);
        const unsigned gen = old / nloc;
        if (old + 1u == (gen + 1u) * nloc) {
            __builtin_amdgcn_fence(__ATOMIC_RELEASE, "agent");
            asm volatile("s_waitcnt vmcnt(0)" ::: "memory");
            const unsigned og = xb_add(&bar[XB_TOP], 1u);
            const unsigned tg = og / nx;
            if (og + 1u == (tg + 1u) * nx) xb_add(&bar[XB_TOPGEN], 1u);
            else XB_SPIN(xb_ld(&bar[XB_TOPGEN]) == tg, bar);
            __builtin_amdgcn_fence(__ATOMIC_ACQUIRE, "agent");
            xb_add(&bar[XB_XGEN(bx_)], 1u);
            asm volatile("s_waitcnt vmcnt(0)" ::: "memory");
        } else {
            XB_SPIN(xb_ld(&bar[XB_XGEN(bx_)]) == gen, bar);
            __builtin_amdgcn_fence(__ATOMIC_ACQUIRE, "agent");
            asm volatile("s_waitcnt vmcnt(0)" ::: "memory");
        }
    }
    __syncthreads();
}
DI float row_rstd(const f32x4 (&v)[4]) {
    float s = 0.f;
#pragma unroll
    for (int j = 0; j < 4; ++j) s += (v[j].x * v[j].x + v[j].y * v[j].y) + (v[j].z * v[j].z + v[j].w * v[j].w);
    return 1.0f / sqrtf(wave_sum(s) * (1.0f / D_) + 1e-6f);
}
DI void load_row(const float* x, int t, int lane, f32x4 (&v)[4]) {
    if (t >= 0 && t < S_) { const f32x4* p = (const f32x4*)(x + (size_t)t * D_) + lane;
#pragma unroll
        for (int j = 0; j < 4; ++j) v[j] = p[64 * j];
    } else {
#pragma unroll
        for (int j = 0; j < 4; ++j) v[j] = (f32x4){0.f, 0.f, 0.f, 0.f};
    }
}
DI void store_row_bf16(bf16* o, int lane, const f32x4 (&v)[4]) {
    unsigned long long* o8 = (unsigned long long*)o + lane;
#pragma unroll
    for (int j = 0; j < 4; ++j) o8[64 * j] = (unsigned long long)pk2(v[j].x, v[j].y) | ((unsigned long long)pk2(v[j].z, v[j].w) << 32);
}
DI void norm_rows(const float* x, const float* w, const float* mu  , bf16* H, bf16* HX, int gw, int NGW, int lane) {
    f32x4 wv[4];
#pragma unroll
    for (int j = 0; j < 4; ++j) wv[j] = ((const f32x4*)w)[lane + 64 * j];
    for (int t = gw; t < S_; t += NGW) {
        f32x4 v[4]; load_row(x, t, lane, v); const float rs = row_rstd(v);
#pragma unroll
        for (int j = 0; j < 4; ++j) v[j] = v[j] * rs * wv[j];
        store_row_bf16(H + (size_t)t * D_, lane, v);
        if (mu) {
            f32x4 p[4], n[4]; load_row(x, t - 1, lane, p); load_row(x, t + 1, lane, n);
            const float rp = row_rstd(p), rn = row_rstd(n);
#pragma unroll
            for (int j = 0; j < 4; ++j) { const f32x4 m0 = ((const f32x4*)mu)[lane + 64 * j], m1 = ((const f32x4*)(mu + D_))[lane + 64 * j];
                const f32x4 hp = p[j] * rp * wv[j], hn = n[j] * rn * wv[j]; p[j] = v[j] + m0 * (hp - v[j]) + m1 * (hn - v[j]); }
            store_row_bf16(HX + (size_t)t * D_, lane, p);
        }
    }
}

DI void prep0_token(const Args& a, unsigned char* ws, LAS float* scr, int t, int lane) {
    const bf16* P = (const bf16*)(ws + WS_PROJ0) + (size_t)t * EVEN_IN;
    const int c0 = 8 * lane;
    {
        float q[8], k[8]; ld8(P + c0, q); ld8(P + 512 + c0, k);
        float sq = 0.f, sk = 0.f;
#pragma unroll
        for (int i = 0; i < 8; ++i) { sq += q[i] * q[i]; sk += k[i] * k[i]; }
        sq = grp_sum<8>(sq); sk = grp_sum<8>(sk);
        const float rq = 1.0f / sqrtf(sq * (1.0f / 64.f) + 1e-6f), rk = 1.0f / sqrtf(sk * (1.0f / 64.f) + 1e-6f);
        const int d0 = 8 * (lane & 7);
        float qw[8], kw[8]; ld8f(a.in[4] + d0, qw); ld8f(a.in[5] + d0, kw);
#pragma unroll
        for (int i = 0; i < 8; ++i) { q[i] = q[i] * rq * qw[i]; k[i] = k[i] * rk * kw[i]; }
        const float pos = (float)((const int*)a.in[1])[t];
        float qo[8], ko[8];
#pragma unroll
        for (int i = 0; i < 8; ++i) { qo[i] = __shfl_xor(q[i], 1); ko[i] = __shfl_xor(k[i], 1); }
        const int sub = lane & 7;
        if (sub < 2) {
#pragma unroll
            for (int i = 0; i < 8; ++i) {
                constexpr float kInv[8] = {1.0f, 0.1939227432012558f, 0.03760603070259094f, 0.007292664609849453f, 0.0014142135623842478f, 0.00027424818836152554f, 5.3182957344688475e-05f, 1.0313385246263351e-05f};
                const float ang = pos * kInv[i]; const float kq = rintf(ang * 0.15915494309189535f);
                float rr = fmaf(-kq, 6.28318548202514648f, ang); rr = fmaf(-kq, -1.74845553146951715e-07f, rr);
                const float sn = __sinf(rr), cs = __cosf(rr);
                if (sub == 0) { q[i] = q[i] * cs - qo[i] * sn; k[i] = k[i] * cs - ko[i] * sn; }
                else          { q[i] = q[i] * cs + qo[i] * sn; k[i] = k[i] * cs + ko[i] * sn; }
            }
        }
#pragma unroll
        for (int i = 0; i < 8; ++i) q[i] *= 0.125f;
        st8((bf16*)(ws + WS_QN) + (size_t)t * 512 + c0, q); st8((bf16*)(ws + WS_KN) + (size_t)t * 512 + c0, k);
        *(v4u*)((bf16*)(ws + WS_Y1) + (size_t)t * 512 + c0) = *(const v4u*)(P + 1024 + c0);
    }
}

DI void rwkv_scan_naive(unsigned char* ws, int w  , int lane) {
    const int z = w >> 9, h = (w >> 6) & 7, vr = w & 63;
    const float* LW = (const float*)(ws + (z ? WS_LW1 : WS_LW0));
    const bf16* KD = (const bf16*)(ws + (z ? WS_KD1 : WS_KD0)); const bf16* BB = (const bf16*)(ws + (z ? WS_B1 : WS_B0));
    const bf16* KK = (const bf16*)(ws + WS_KK); const bf16* R = (const bf16*)(ws + WS_R); const bf16* V = (const bf16*)(ws + WS_V);
    bf16* Y = (bf16*)(ws + (z ? WS_Y1 : WS_Y0));
    const int cc = h * 64 + lane, cv = h * 64 + vr;
    float S = 0.f;
    int t = z ? S_ - 1 : 0; const int dt = z ? -1 : 1;
    size_t o = (size_t)t * 512;
    float lw = LW[o + cc], kd = bf2f(KD[o + cc]), bb = bf2f(BB[o + cc]), kk = bf2f(KK[o + cc]), rr = bf2f(R[o + cc]), vv = bf2f(V[o + cv]);
    for (int s = 0; s < S_; ++s) {
        const int tn = t + dt; const bool more = s + 1 < S_;
        const size_t on = (size_t)(more ? tn : t) * 512;
        const float lw_n = LW[on + cc], kd_n = bf2f(KD[on + cc]), bb_n = bf2f(BB[on + cc]), kk_n = bf2f(KK[on + cc]), rr_n = bf2f(R[on + cc]), vv_n = bf2f(V[on + cv]);
        const float sa = wave_sum(S * (-kk));
        S = S * __expf(lw) + sa * bb + vv * kd;
        const float y = wave_sum(S * rr);
        if (lane == 0) Y[(size_t)t * 512 + cv] = (bf16)f2bf(y);
        lw = lw_n; kd = kd_n; bb = bb_n; kk = kk_n; rr = rr_n; vv = vv_n; t = tn;
    }
}

DI void attn_token_naive(unsigned char* ws, int t, int lane) {
    const bf16* QN = (const bf16*)(ws + WS_QN); const bf16* KN = (const bf16*)(ws + WS_KN); const bf16* P = (const bf16*)(ws + WS_PROJ0);
    const int c0 = 8 * lane;
    float q[8]; ld8(QN + (size_t)t * 512 + c0, q);
    float m = -1e30f, l = 0.f, acc[8];
#pragma unroll
    for (int i = 0; i < 8; ++i) acc[i] = 0.f;
    for (int br = 0; br < 3; ++br) {
        const int d = br == 0 ? 1 : (br == 1 ? 4 : 16);
        for (int mm = -64; mm <= 64; ++mm) {
            const int j = t + d * mm; if (j < 0 || j >= S_) continue;
            float k[8], v[8]; ld8(KN + (size_t)j * 512 + c0, k); ld8(P + (size_t)j * EVEN_IN + 1024 + c0, v);
            float s = 0.f;
#pragma unroll
            for (int i = 0; i < 8; ++i) s += q[i] * k[i];
            s = grp_sum<8>(s);
            const float mn = fmaxf(m, s), sc = __expf(m - mn), p = __expf(s - mn);
            l = l * sc + p;
#pragma unroll
            for (int i = 0; i < 8; ++i) acc[i] = acc[i] * sc + p * v[i];
            m = mn;
        }
    }
    const float il = 1.0f / l;
#pragma unroll
    for (int i = 0; i < 8; ++i) acc[i] *= il;
    st8((bf16*)(ws + WS_Y) + (size_t)t * D_ + c0, acc);
}

DI void rwkv_post_token(const Args& a, unsigned char* ws, int t, int lane) {
    const int c0 = 8 * lane; const size_t o = (size_t)t * 512 + c0;
    float y0[8], y1[8], g[8], bn[8], lw[8], lb[8];
    ld8((const bf16*)(ws + WS_Y0) + o, y0); ld8((const bf16*)(ws + WS_Y1) + o, y1); ld8((const bf16*)(ws + WS_GATE) + o, g); ld8((const bf16*)(ws + WS_BONUS) + o, bn);
    ld8f(a.in[19] + c0, lw); ld8f(a.in[20] + c0, lb);
    float s = 0.f;
#pragma unroll
    for (int i = 0; i < 8; ++i) { y0[i] += y1[i]; s += y0[i]; }
    const float mu = grp_sum<8>(s) * (1.0f / 64.f);
    float q = 0.f;
#pragma unroll
    for (int i = 0; i < 8; ++i) { y0[i] -= mu; q += y0[i] * y0[i]; }
    const float rs = 1.0f / sqrtf(grp_sum<8>(q) * (1.0f / 64.f) + 64e-5f);
#pragma unroll
    for (int i = 0; i < 8; ++i) y0[i] = (y0[i] * rs * lw[i] + lb[i] + bn[i]) * g[i];
    st8((bf16*)(ws + WS_Y) + (size_t)t * D_ + 512 + c0, y0);
}
typedef short s16x8 __attribute__((ext_vector_type(8)));
typedef short s16x4 __attribute__((ext_vector_type(4)));
typedef LAS unsigned char* ldsp;
DI f32x4 mfma16(s16x8 a, s16x8 b, f32x4 c) { return __builtin_amdgcn_mfma_f32_16x16x32_bf16(a, b, c, 0, 0, 0); }
DI s16x8 frag_row(ldsp img, int row0, int col0, int lane) { return *(LAS const s16x8*)(img + (row0 + (lane & 15)) * 128 + (col0 + 8 * (lane >> 4)) * 2); }
DI s16x4 tr16(ldsp p) { return __builtin_bit_cast(s16x4, __builtin_amdgcn_ds_read_tr16_b64_v4i16((LAS s16x4*)p)); }
DI s16x8 frag_tr(ldsp img, int row0, int col0, int lane) {
    ldsp a0 = img + (row0 + 8 * (lane >> 4) + ((lane & 15) >> 2)) * 128 + col0 * 2 + 8 * (lane & 3);
    const s16x4 lo = tr16(a0), hi = tr16(a0 + 4 * 128);
    return __builtin_shufflevector(lo, hi, 0, 1, 2, 3, 4, 5, 6, 7);
}
DI void ctile_to_img(ldsp img, int mt, int nt, const f32x4& c, int lane) {
    LAS bf16* p = (LAS bf16*)(img + (16 * mt + 4 * (lane >> 4)) * 128 + (16 * nt + (lane & 15)) * 2);
#pragma unroll
    for (int e = 0; e < 4; ++e) p[e * 64] = (bf16)f2bf(c[e]);
}
#define CFENCE() asm volatile("" ::: "memory")
#define MM_LOOPH(ACC, AEXPR, BEXPR) _Pragma("unroll") for (int mt = 2 * mh; mt < 2 * mh + 2; ++mt) _Pragma("unroll") for (int nt = 0; nt < 4; ++nt) _Pragma("unroll") for (int ks = 0; ks < 2; ++ks) ACC[mt][nt] = mfma16((AEXPR), (BEXPR), ACC[mt][nt])
#define MM_LOOP(ACC, AEXPR, BEXPR) _Pragma("unroll") for (int mt = 0; mt < 4; ++mt) _Pragma("unroll") for (int nt = 0; nt < 4; ++nt) _Pragma("unroll") for (int ks = 0; ks < 2; ++ks) ACC[mt][nt] = mfma16((AEXPR), (BEXPR), ACC[mt][nt])

DI int tok_of(int z, int cn, int i) { return z ? cn * 64 + 63 - i : cn * 64 + i; }

template <bool DRY = false, int STOP = 99> DI void rwkv_pass1_item(unsigned char* ws, ldsp lds, int item, int lane) {
    asm volatile("" : "+v"(lane));
    const int z = item >> 11, h = (item >> 8) & 7, c = item & 255;
    const int cn = z ? 255 - c : c;
    float* LW = (float*)(ws + (z ? WS_LW1 : WS_LW0));
    bf16* KD = (bf16*)(ws + (z ? WS_KD1 : WS_KD0)); bf16* BB = (bf16*)(ws + (z ? WS_B1 : WS_B0));
    const bf16* KK = (const bf16*)(ws + WS_KK); const bf16* R = (const bf16*)(ws + WS_R); const bf16* V = (const bf16*)(ws + WS_V);
    float* LWo = DRY ? (float*)(ws + WS_Y) : LW; bf16* KDo = DRY ? (bf16*)(ws + WS_Y) : KD; bf16* BBo = DRY ? (bf16*)(ws + WS_Y) : BB;
    ldsp S0 = lds, S1 = lds + 8192, S2 = lds + 16384, S3 = lds + 24576, S4 = lds + 32768, S5 = lds + 40960, S6 = lds + 49152, S7 = lds + 57344;
    ldsp IA = S0, IB = S1, IK = S2, IR = S3;
    const int ch = h * 64 + lane;
    float G = 0.f;
#pragma unroll 16
    for (int i = 0; i < 64; ++i) {
        const size_t o = (size_t)tok_of(z, cn, i) * 512 + ch;
        const float lw = LW[o], a = -bf2f(KK[o]), b = bf2f(BB[o]), kd = bf2f(KD[o]), r = bf2f(R[o]);
        const float eprev = __expf(G); G += lw; const float ecur = __expf(G), einv = __expf(-G);
        ((LAS bf16*)IA)[i * 64 + lane] = (bf16)f2bf(a * eprev); ((LAS bf16*)IB)[i * 64 + lane] = (bf16)f2bf(b * einv);
        ((LAS bf16*)IK)[i * 64 + lane] = (bf16)f2bf(kd * einv); ((LAS bf16*)IR)[i * 64 + lane] = (bf16)f2bf(r * ecur);
    }
    const float GT = __expf(G);
    LDS_WAIT(); CFENCE();
    if (STOP == 1) { if (GT == 123.f) LWo[0] = GT; return; }
    int lane2 = lane; asm volatile("" : "+v"(lane2));
    const int n_ = lane2 & 15, q_ = lane2 >> 4;
    {
#pragma unroll
        for (int mh = 0; mh < 2; ++mh) {
        f32x4 acc[4][4];
#pragma unroll
        for (int mt = 2 * mh; mt < 2 * mh + 2; ++mt)
#pragma unroll
            for (int nt = 0; nt < 4; ++nt) acc[mt][nt] = (f32x4){0.f, 0.f, 0.f, 0.f};
        MM_LOOPH(acc, frag_row(IA, 16 * mt, 32 * ks, lane), frag_row(IB, 16 * nt, 32 * ks, lane));
#pragma unroll
        for (int mt = 2 * mh; mt < 2 * mh + 2; ++mt)
#pragma unroll
            for (int nt = 0; nt < 4; ++nt)
#pragma unroll
                for (int e = 0; e < 4; ++e) { const int i = 16 * mt + 4 * q_ + e, j = 16 * nt + n_; ((LAS float*)S4)[i * 64 + j] = (j < i) ? acc[mt][nt][e] : 0.f; }
        }
    }
    LDS_WAIT(); CFENCE();
    if (STOP == 4) return;
    {
        float t[64];
        int lane_o = lane; asm volatile("" : "+v"(lane_o));
        f32x4 ar[2][16];
#pragma unroll
        for (int i = 0; i < 64; ++i) {
            if (i + 1 < 64) {
#pragma unroll
                for (int jg = 0; jg < (i + 1 + 3) / 4; ++jg) ar[(i + 1) & 1][jg] = *(LAS const f32x4*)(S4 + ((i + 1) * 64 + 4 * jg) * 4);
            }
            __builtin_amdgcn_sched_barrier(0);
            float acc0 = (lane_o == i) ? 1.f : 0.f, acc1 = 0.f, acc2 = 0.f, acc3 = 0.f;
#pragma unroll
            for (int jg = 0; jg < (i + 3) / 4; ++jg) { const f32x4 a4 = ar[i & 1][jg];
                if (4 * jg + 0 < i) acc0 += a4[0] * t[4 * jg + 0];
                if (4 * jg + 1 < i) acc1 += a4[1] * t[4 * jg + 1];
                if (4 * jg + 2 < i) acc2 += a4[2] * t[4 * jg + 2];
                if (4 * jg + 3 < i) acc3 += a4[3] * t[4 * jg + 3]; }
            t[i] = (acc0 + acc1) + (acc2 + acc3);
            __builtin_amdgcn_sched_barrier(0);
        }
        LDS_WAIT(); CFENCE();
#pragma unroll
        for (int i = 0; i < 64; ++i) ((LAS bf16*)S4)[i * 64 + lane] = (bf16)f2bf(t[i]);
    }
    LDS_WAIT(); CFENCE();
    if (STOP == 2) return;
    ldsp IT = S4, IW = S5, IAK = S6;
    {
#pragma unroll
        for (int mh = 0; mh < 2; ++mh) {
        f32x4 acc[4][4];
#pragma unroll
        for (int mt = 2 * mh; mt < 2 * mh + 2; ++mt)
#pragma unroll
            for (int nt = 0; nt < 4; ++nt) acc[mt][nt] = (f32x4){0.f, 0.f, 0.f, 0.f};
        MM_LOOPH(acc, frag_row(IA, 16 * mt, 32 * ks, lane), frag_row(IK, 16 * nt, 32 * ks, lane));
#pragma unroll
        for (int mt = 2 * mh; mt < 2 * mh + 2; ++mt)
#pragma unroll
            for (int nt = 0; nt < 4; ++nt) {
#pragma unroll
                for (int e = 0; e < 4; ++e) { const int i = 16 * mt + 4 * q_ + e, j = 16 * nt + n_; if (!(j < i)) acc[mt][nt][e] = 0.f; }
                ctile_to_img(IAK, mt, nt, acc[mt][nt], lane); }
        }
    }
    if (STOP == 5) return;
    {
#pragma unroll
        for (int mh = 0; mh < 2; ++mh) {
        f32x4 acc[4][4];
#pragma unroll
        for (int mt = 2 * mh; mt < 2 * mh + 2; ++mt)
#pragma unroll
            for (int nt = 0; nt < 4; ++nt) acc[mt][nt] = (f32x4){0.f, 0.f, 0.f, 0.f};
        MM_LOOPH(acc, frag_row(IT, 16 * mt, 32 * ks, lane), frag_tr(IA, 32 * ks, 16 * nt, lane));
#pragma unroll
        for (int mt = 2 * mh; mt < 2 * mh + 2; ++mt)
#pragma unroll
            for (int nt = 0; nt < 4; ++nt) ctile_to_img(IW, mt, nt, acc[mt][nt], lane);
        }
    }
    LDS_WAIT(); CFENCE();
    if (STOP == 6) return;
    ldsp IV = S0;
    {
        v4u vr[8];
#pragma unroll
        for (int it = 0; it < 8; ++it) vr[it] = *(const v4u*)(V + (size_t)tok_of(z, cn, (lane >> 3) + 8 * it) * 512 + h * 64 + (lane & 7) * 8);
#pragma unroll
        for (int it = 0; it < 8; ++it) *(LAS v4u*)(IV + ((lane >> 3) + 8 * it) * 128 + (lane & 7) * 16) = vr[it];
    }
    LDS_WAIT(); CFENCE();
    ldsp IAV = S7;
    {
#pragma unroll
        for (int mh = 0; mh < 2; ++mh) {
        f32x4 acc[4][4];
#pragma unroll
        for (int mt = 2 * mh; mt < 2 * mh + 2; ++mt)
#pragma unroll
            for (int nt = 0; nt < 4; ++nt) acc[mt][nt] = (f32x4){0.f, 0.f, 0.f, 0.f};
        MM_LOOPH(acc, frag_row(IAK, 16 * mt, 32 * ks, lane), frag_tr(IV, 32 * ks, 16 * nt, lane));
#pragma unroll
        for (int mt = 2 * mh; mt < 2 * mh + 2; ++mt)
#pragma unroll
            for (int nt = 0; nt < 4; ++nt) ctile_to_img(IAV, mt, nt, acc[mt][nt], lane);
        }
    }
    LDS_WAIT(); CFENCE();
    if (STOP == 7) return;
    ldsp IU = S6;
    {
#pragma unroll
        for (int mh = 0; mh < 2; ++mh) {
        f32x4 acc[4][4];
#pragma unroll
        for (int mt = 2 * mh; mt < 2 * mh + 2; ++mt)
#pragma unroll
            for (int nt = 0; nt < 4; ++nt) acc[mt][nt] = (f32x4){0.f, 0.f, 0.f, 0.f};
        MM_LOOPH(acc, frag_row(IT, 16 * mt, 32 * ks, lane), frag_tr(IAV, 32 * ks, 16 * nt, lane));
        LDS_WAIT(); CFENCE();
#pragma unroll
        for (int mt = 2 * mh; mt < 2 * mh + 2; ++mt)
#pragma unroll
            for (int nt = 0; nt < 4; ++nt) ctile_to_img(IU, mt, nt, acc[mt][nt], lane);
        }
    }
    LDS_WAIT(); CFENCE();
    if (STOP == 3) return;
    ldsp IRB = S4, IRK = S7;
    {
#pragma unroll
        for (int mh = 0; mh < 2; ++mh) {
        f32x4 acc[4][4];
#pragma unroll
        for (int mt = 2 * mh; mt < 2 * mh + 2; ++mt)
#pragma unroll
            for (int nt = 0; nt < 4; ++nt) acc[mt][nt] = (f32x4){0.f, 0.f, 0.f, 0.f};
        MM_LOOPH(acc, frag_row(IR, 16 * mt, 32 * ks, lane), frag_row(IB, 16 * nt, 32 * ks, lane));
#pragma unroll
        for (int mt = 2 * mh; mt < 2 * mh + 2; ++mt)
#pragma unroll
            for (int nt = 0; nt < 4; ++nt) {
#pragma unroll
                for (int e = 0; e < 4; ++e) { const int i = 16 * mt + 4 * q_ + e, j = 16 * nt + n_; if (!(j <= i)) acc[mt][nt][e] = 0.f; }
                ctile_to_img(IRB, mt, nt, acc[mt][nt], lane); }
        }
    }
    {
#pragma unroll
        for (int mh = 0; mh < 2; ++mh) {
        f32x4 acc[4][4];
#pragma unroll
        for (int mt = 2 * mh; mt < 2 * mh + 2; ++mt)
#pragma unroll
            for (int nt = 0; nt < 4; ++nt) acc[mt][nt] = (f32x4){0.f, 0.f, 0.f, 0.f};
        MM_LOOPH(acc, frag_row(IR, 16 * mt, 32 * ks, lane), frag_row(IK, 16 * nt, 32 * ks, lane));
#pragma unroll
        for (int mt = 2 * mh; mt < 2 * mh + 2; ++mt)
#pragma unroll
            for (int nt = 0; nt < 4; ++nt) {
#pragma unroll
                for (int e = 0; e < 4; ++e) { const int i = 16 * mt + 4 * q_ + e, j = 16 * nt + n_; if (!(j <= i)) acc[mt][nt][e] = 0.f; }
                ctile_to_img(IRK, mt, nt, acc[mt][nt], lane); }
        }
    }
    LDS_WAIT(); CFENCE();
    int lane3 = lane; asm volatile("" : "+v"(lane3));
    const int n3 = lane3 & 15, q3 = lane3 >> 4;
    const size_t slot0 = (size_t)cn * 64 * 512 + h * 64;
    {
#pragma unroll
        for (int mh = 0; mh < 2; ++mh) {
        f32x4 acc[4][4];
#pragma unroll
        for (int mt = 2 * mh; mt < 2 * mh + 2; ++mt)
#pragma unroll
            for (int nt = 0; nt < 4; ++nt) { const s16x4 r4 = *(LAS const s16x4*)(IR + (16 * nt + n3) * 128 + (16 * mt + 4 * q3) * 2);
#pragma unroll
                for (int e = 0; e < 4; ++e) acc[mt][nt][e] = bf2f((bf16)r4[e]); }
        MM_LOOPH(acc, frag_tr(IW, 32 * ks, 16 * mt, lane), frag_row(IRB, 16 * nt, 32 * ks, lane));
#pragma unroll
        for (int mt = 2 * mh; mt < 2 * mh + 2; ++mt)
#pragma unroll
            for (int nt = 0; nt < 4; ++nt) { bf16* dst = (bf16*)(LWo + slot0 + (size_t)(16 * nt + n3) * 512) + 16 * mt + 4 * q3;
                *(unsigned long long*)dst = (unsigned long long)pk2(acc[mt][nt][0], acc[mt][nt][1]) | ((unsigned long long)pk2(acc[mt][nt][2], acc[mt][nt][3]) << 32); }
        }
    }
    {
#pragma unroll
        for (int mh = 0; mh < 2; ++mh) {
        f32x4 acc[4][4];
#pragma unroll
        for (int mt = 2 * mh; mt < 2 * mh + 2; ++mt)
#pragma unroll
            for (int nt = 0; nt < 4; ++nt) acc[mt][nt] = (f32x4){0.f, 0.f, 0.f, 0.f};
        MM_LOOPH(acc, frag_tr(IU, 32 * ks, 16 * mt, lane), frag_row(IRB, 16 * nt, 32 * ks, lane));
        MM_LOOPH(acc, frag_tr(IV, 32 * ks, 16 * mt, lane), frag_row(IRK, 16 * nt, 32 * ks, lane));
#pragma unroll
        for (int mt = 2 * mh; mt < 2 * mh + 2; ++mt)
#pragma unroll
            for (int nt = 0; nt < 4; ++nt) { bf16* dst = (bf16*)(LWo + slot0 + (size_t)(16 * nt + n3) * 512) + 64 + 16 * mt + 4 * q3;
                *(unsigned long long*)dst = (unsigned long long)pk2(acc[mt][nt][0], acc[mt][nt][1]) | ((unsigned long long)pk2(acc[mt][nt][2], acc[mt][nt][3]) << 32); }
        }
    }
    {
#pragma unroll
        for (int mh = 0; mh < 2; ++mh) {
        f32x4 acc[4][4];
#pragma unroll
        for (int mt = 2 * mh; mt < 2 * mh + 2; ++mt)
#pragma unroll
            for (int nt = 0; nt < 4; ++nt) acc[mt][nt] = (f32x4){0.f, 0.f, 0.f, 0.f};
        MM_LOOPH(acc, frag_tr(IW, 32 * ks, 16 * mt, lane), frag_tr(IB, 32 * ks, 16 * nt, lane));
#pragma unroll
        for (int nt = 0; nt < 4; ++nt) { const float gk = __shfl(GT, 16 * nt + n3);
#pragma unroll
            for (int mt = 2 * mh; mt < 2 * mh + 2; ++mt) { float o[4];
#pragma unroll
                for (int e = 0; e < 4; ++e) o[e] = gk * (acc[mt][nt][e] + ((16 * mt + 4 * q3 + e) == (16 * nt + n3) ? 1.f : 0.f));
                bf16* dst = KDo + slot0 + (size_t)(16 * nt + n3) * 512 + 16 * mt + 4 * q3;
                *(unsigned long long*)dst = (unsigned long long)pk2(o[0], o[1]) | ((unsigned long long)pk2(o[2], o[3]) << 32); } }
        }
    }
    {
#pragma unroll
        for (int mh = 0; mh < 2; ++mh) {
        f32x4 acc[4][4];
#pragma unroll
        for (int mt = 2 * mh; mt < 2 * mh + 2; ++mt)
#pragma unroll
            for (int nt = 0; nt < 4; ++nt) acc[mt][nt] = (f32x4){0.f, 0.f, 0.f, 0.f};
        MM_LOOPH(acc, frag_tr(IB, 32 * ks, 16 * mt, lane), frag_tr(IU, 32 * ks, 16 * nt, lane));
        MM_LOOPH(acc, frag_tr(IK, 32 * ks, 16 * mt, lane), frag_tr(IV, 32 * ks, 16 * nt, lane));
#pragma unroll
        for (int mt = 2 * mh; mt < 2 * mh + 2; ++mt) { float gk[4];
#pragma unroll
            for (int e = 0; e < 4; ++e) gk[e] = __shfl(GT, 16 * mt + 4 * q3 + e);
#pragma unroll
            for (int nt = 0; nt < 4; ++nt) { bf16* dst = BBo + slot0 + (size_t)(16 * nt + n3) * 512 + 16 * mt + 4 * q3;
                *(unsigned long long*)dst = (unsigned long long)pk2(gk[0] * acc[mt][nt][0], gk[1] * acc[mt][nt][1]) | ((unsigned long long)pk2(gk[2] * acc[mt][nt][2], gk[3] * acc[mt][nt][3]) << 32); } }
        }
    }
    LDS_WAIT(); CFENCE();
}
DI unsigned long long pk4(const f32x4& v) { return (unsigned long long)pk2(v[0], v[1]) | ((unsigned long long)pk2(v[2], v[3]) << 32); }
DI f32x4 unpk4(unsigned long long w) { return (f32x4){bflo((unsigned)w), bfhi((unsigned)w), bflo((unsigned)(w >> 32)), bfhi((unsigned)(w >> 32))}; }
DI s16x8 pack_cpair(const f32x4& lo, const f32x4& hi) {
    v4u p; p.x = pk2(lo[0], lo[1]); p.y = pk2(lo[2], lo[3]); p.z = pk2(hi[0], hi[1]); p.w = pk2(hi[2], hi[3]);
    return __builtin_bit_cast(s16x8, p);
}
DI void rwkv_pass2_wave(unsigned char* ws, int w  , int lane) {
    const int z = w >> 5, h = (w >> 2) & 7, vs = w & 3;
    const bf16* Mm = (const bf16*)(ws + (z ? WS_KD1 : WS_KD0)); const bf16* Nn = (const bf16*)(ws + (z ? WS_B1 : WS_B0));
    bf16* Hst = (bf16*)(ws + (z ? WS_V : WS_R));
    const int n_ = lane & 15, q_ = lane >> 4;
    f32x4 H[4];
#pragma unroll
    for (int kt = 0; kt < 4; ++kt) H[kt] = (f32x4){0.f, 0.f, 0.f, 0.f};
    unsigned long long ma[4][2][2], nn[4];
    {
        const int cn = z ? 255 : 0; const size_t slot0 = (size_t)cn * 64 * 512 + h * 64;
#pragma unroll
        for (int kt = 0; kt < 4; ++kt) {
#pragma unroll
            for (int ks = 0; ks < 2; ++ks) { const bf16* row = Mm + slot0 + (size_t)(16 * kt + n_) * 512 + 32 * ks + 4 * q_;
                ma[kt][ks][0] = *(const unsigned long long*)row; ma[kt][ks][1] = *(const unsigned long long*)(row + 16); }
            nn[kt] = *(const unsigned long long*)(Nn + slot0 + (size_t)(16 * vs + n_) * 512 + 16 * kt + 4 * q_); }
    }
    for (int c = 0; c < 256; ++c) {
        { bf16* dst = Hst + ((size_t)(c * 8 + h) * 64 + 16 * vs + n_) * 64 + 4 * q_;
#pragma unroll
          for (int kt = 0; kt < 4; ++kt) *(unsigned long long*)(dst + 16 * kt) = (unsigned long long)pk2(H[kt][0], H[kt][1]) | ((unsigned long long)pk2(H[kt][2], H[kt][3]) << 32); }
        unsigned long long ma2[4][2][2], nn2[4];
        { const int c2 = c + 1 < 256 ? c + 1 : c; const int cn = z ? 255 - c2 : c2; const size_t slot0 = (size_t)cn * 64 * 512 + h * 64;
#pragma unroll
          for (int kt = 0; kt < 4; ++kt) {
#pragma unroll
            for (int ks = 0; ks < 2; ++ks) { const bf16* row = Mm + slot0 + (size_t)(16 * kt + n_) * 512 + 32 * ks + 4 * q_;
                ma2[kt][ks][0] = *(const unsigned long long*)row; ma2[kt][ks][1] = *(const unsigned long long*)(row + 16); }
            nn2[kt] = *(const unsigned long long*)(Nn + slot0 + (size_t)(16 * vs + n_) * 512 + 16 * kt + 4 * q_); } }
        const s16x8 b0 = pack_cpair(H[0], H[1]), b1 = pack_cpair(H[2], H[3]);
#pragma unroll
        for (int kt = 0; kt < 4; ++kt) {
            f32x4 acc = (f32x4){bflo((unsigned)nn[kt]), bfhi((unsigned)nn[kt]), bflo((unsigned)(nn[kt] >> 32)), bfhi((unsigned)(nn[kt] >> 32))};
            { v4u a; a.x = (unsigned)ma[kt][0][0]; a.y = (unsigned)(ma[kt][0][0] >> 32); a.z = (unsigned)ma[kt][0][1]; a.w = (unsigned)(ma[kt][0][1] >> 32); acc = mfma16(__builtin_bit_cast(s16x8, a), b0, acc); }
            { v4u a; a.x = (unsigned)ma[kt][1][0]; a.y = (unsigned)(ma[kt][1][0] >> 32); a.z = (unsigned)ma[kt][1][1]; a.w = (unsigned)(ma[kt][1][1] >> 32); acc = mfma16(__builtin_bit_cast(s16x8, a), b1, acc); }
            H[kt] = acc;
        }
#pragma unroll
        for (int kt = 0; kt < 4; ++kt) { nn[kt] = nn2[kt];
#pragma unroll
            for (int ks = 0; ks < 2; ++ks) { ma[kt][ks][0] = ma2[kt][ks][0]; ma[kt][ks][1] = ma2[kt][ks][1]; } }
    }
}
DI void rwkv_pass3_item(unsigned char* ws, int item, int lane) {
    const int z = item >> 11, h = (item >> 8) & 7, c = item & 255;
    const int cn = z ? 255 - c : c;
    const float* LW = (const float*)(ws + (z ? WS_LW1 : WS_LW0));
    const bf16* Hst = (const bf16*)(ws + (z ? WS_V : WS_R)) + (size_t)(c * 8 + h) * 64 * 64;
    bf16* Y = (bf16*)(ws + (z ? WS_Y1 : WS_Y0));
    const int n_ = lane & 15, q_ = lane >> 4;
    const size_t slot0 = (size_t)cn * 64 * 512 + h * 64;
    s16x8 hA[4][2], qB[4][2];
#pragma unroll
    for (int t = 0; t < 4; ++t)
#pragma unroll
        for (int ks = 0; ks < 2; ++ks) {
            hA[t][ks] = *(const s16x8*)(Hst + (size_t)(16 * t + n_) * 64 + 32 * ks + 8 * q_);
            qB[t][ks] = *(const s16x8*)((const bf16*)(LW + slot0 + (size_t)(16 * t + n_) * 512) + 32 * ks + 8 * q_); }
#pragma unroll
    for (int nt = 0; nt < 4; ++nt) {
        const int i = 16 * nt + n_; const bf16* ycrow = (const bf16*)(LW + slot0 + (size_t)i * 512) + 64;
        bf16* yrow = Y + (size_t)tok_of(z, cn, i) * 512 + h * 64;
#pragma unroll
        for (int mt = 0; mt < 4; ++mt) {
            const unsigned long long y4 = *(const unsigned long long*)(ycrow + 16 * mt + 4 * q_);
            f32x4 acc = (f32x4){bflo((unsigned)y4), bfhi((unsigned)y4), bflo((unsigned)(y4 >> 32)), bfhi((unsigned)(y4 >> 32))};
            acc = mfma16(hA[mt][0], qB[nt][0], acc); acc = mfma16(hA[mt][1], qB[nt][1], acc);
            *(unsigned long long*)(yrow + 16 * mt + 4 * q_) = (unsigned long long)pk2(acc[0], acc[1]) | ((unsigned long long)pk2(acc[2], acc[3]) << 32);
        }
    }
}
DI void rwkv_pass2_block(unsigned char* ws, ldsp L, int b  , int wave, int lane) {
    const int z = b >> 3, h = b & 7;
    if (wave >= 4) {
        const int lw = wave - 4;
        const char* Mm = (const char*)(ws + (z ? WS_KD1 : WS_KD0)); const char* Nn = (const char*)(ws + (z ? WS_B1 : WS_B0));
#define RW_ISSUE(cc) do { const int c_ = (cc); if (c_ < 256) { const int cn_ = z ? 255 - c_ : c_; const size_t slot0 = ((size_t)cn_ * 64 * 512 + h * 64) * 2; ldsp slot = L + (c_ & 7) * 16384; \
            _Pragma("unroll") for (int k = 0; k < 4; ++k) { const int pid = lw * 4 + k; const int pr = pid & 7; const int row = 8 * pr + (lane >> 3), p = lane & 7, cch = p ^ (row & 7); \
                const char* src = (pid < 8 ? Mm : Nn) + slot0 + (size_t)row * 1024 + cch * 16; \
                __builtin_amdgcn_global_load_lds((const unsigned*)src, (LAS unsigned*)(slot + (pid < 8 ? 0 : 8192) + pr * 1024), 16, 0, 0); } } } while (0)
        RW_ISSUE(0); RW_ISSUE(1); RW_ISSUE(2); RW_ISSUE(3); RW_ISSUE(4); RW_ISSUE(5); RW_ISSUE(6);
        for (int c = 0; c < 256; ++c) {
            if (c < 250) asm volatile("s_waitcnt vmcnt(24)" ::: "memory"); else asm volatile("s_waitcnt vmcnt(0)" ::: "memory");
            __builtin_amdgcn_s_barrier();
            asm volatile("" ::: "memory");
            RW_ISSUE(c + 7);
        }
#undef RW_ISSUE
        asm volatile("s_waitcnt vmcnt(0)" ::: "memory");
        return;
    }
    const int vs = wave;
    bf16* Hst = (bf16*)(ws + (z ? WS_V : WS_R));
    const int n_ = lane & 15, q_ = lane >> 4, wbyte = (q_ & 1) * 8, sw = n_ & 7;
    f32x4 H[4];
#pragma unroll
    for (int kt = 0; kt < 4; ++kt) H[kt] = (f32x4){0.f, 0.f, 0.f, 0.f};
    for (int c = 0; c < 256; ++c) {
        { bf16* dst = Hst + ((size_t)(c * 8 + h) * 64 + 16 * vs + n_) * 64 + 4 * q_;
#pragma unroll
          for (int kt = 0; kt < 4; ++kt) *(unsigned long long*)(dst + 16 * kt) = pk4(H[kt]); }
        asm volatile("s_waitcnt lgkmcnt(0)" ::: "memory");
        __builtin_amdgcn_s_barrier();
        asm volatile("" ::: "memory");
        ldsp slot = L + (c & 7) * 16384;
        const s16x8 b0 = pack_cpair(H[0], H[1]), b1 = pack_cpair(H[2], H[3]);
#pragma unroll
        for (int kt = 0; kt < 4; ++kt) {
            ldsp nrow = slot + 8192 + (16 * vs + n_) * 128 + wbyte;
            f32x4 acc = unpk4(*(LAS const unsigned long long*)(nrow + (((2 * kt + (q_ >> 1)) ^ sw) * 16)));
            ldsp mrow = slot + (16 * kt + n_) * 128 + wbyte;
#pragma unroll
            for (int ks = 0; ks < 2; ++ks) { const int c0 = 4 * ks + (q_ >> 1);
                const unsigned long long a0 = *(LAS const unsigned long long*)(mrow + ((c0 ^ sw) * 16)), a1 = *(LAS const unsigned long long*)(mrow + (((c0 + 2) ^ sw) * 16));
                v4u a; a.x = (unsigned)a0; a.y = (unsigned)(a0 >> 32); a.z = (unsigned)a1; a.w = (unsigned)(a1 >> 32);
                acc = mfma16(__builtin_bit_cast(s16x8, a), ks == 0 ? b0 : b1, acc); }
            H[kt] = acc;
        }
    }
}
DI void rwkv_pass3_post_item(const Args& a, unsigned char* ws, int item, int lane) {
    asm volatile("" : "+v"(lane));
    const int h = item >> 8, cn = item & 255;
    const int n_ = lane & 15, q_ = lane >> 4;
    const size_t slot0 = (size_t)cn * 64 * 512 + h * 64;
    const float* LW0 = (const float*)(ws + WS_LW0); const float* LW1 = (const float*)(ws + WS_LW1);
    const bf16* H0 = (const bf16*)(ws + WS_R) + (size_t)(cn * 8 + h) * 4096;
    const bf16* H1 = (const bf16*)(ws + WS_V) + (size_t)((255 - cn) * 8 + h) * 4096;
    s16x8 hA0[4][2], hA1[4][2];
#pragma unroll
    for (int t = 0; t < 4; ++t)
#pragma unroll
        for (int ks = 0; ks < 2; ++ks) { hA0[t][ks] = *(const s16x8*)(H0 + (size_t)(16 * t + n_) * 64 + 32 * ks + 8 * q_); hA1[t][ks] = *(const s16x8*)(H1 + (size_t)(16 * t + n_) * 64 + 32 * ks + 8 * q_); }
#pragma unroll
    for (int nt = 0; nt < 4; ++nt) {
        const int i0 = 16 * nt + n_, i1 = 63 - i0;
        const bf16* q0 = (const bf16*)(LW0 + slot0 + (size_t)i0 * 512); const bf16* q1 = (const bf16*)(LW1 + slot0 + (size_t)i1 * 512);
        s16x8 qB0[2], qB1[2];
#pragma unroll
        for (int ks = 0; ks < 2; ++ks) { qB0[ks] = *(const s16x8*)(q0 + 32 * ks + 8 * q_); qB1[ks] = *(const s16x8*)(q1 + 32 * ks + 8 * q_); }
        f32x4 y[4]; float sum = 0.f;
#pragma unroll
        for (int mt = 0; mt < 4; ++mt) {
            f32x4 acc = unpk4(*(const unsigned long long*)(q0 + 64 + 16 * mt + 4 * q_)) + unpk4(*(const unsigned long long*)(q1 + 64 + 16 * mt + 4 * q_));
            acc = mfma16(hA0[mt][0], qB0[0], acc); acc = mfma16(hA0[mt][1], qB0[1], acc);
            acc = mfma16(hA1[mt][0], qB1[0], acc); acc = mfma16(hA1[mt][1], qB1[1], acc);
            y[mt] = acc; sum += (acc[0] + acc[1]) + (acc[2] + acc[3]);
        }
        sum += __shfl_xor(sum, 16); sum += __shfl_xor(sum, 32);
        const float mu = sum * (1.0f / 64.f); float sq = 0.f;
#pragma unroll
        for (int mt = 0; mt < 4; ++mt)
#pragma unroll
            for (int e = 0; e < 4; ++e) { y[mt][e] -= mu; sq += y[mt][e] * y[mt][e]; }
        sq += __shfl_xor(sq, 16); sq += __shfl_xor(sq, 32);
        const float rs = 1.0f / sqrtf(sq * (1.0f / 64.f) + 64e-5f);
        const size_t tok = (size_t)(cn * 64 + i0);
#pragma unroll
        for (int mt = 0; mt < 4; ++mt) { const int c0 = h * 64 + 16 * mt + 4 * q_;
            const f32x4 lw = *(const f32x4*)(a.in[19] + c0), lb = *(const f32x4*)(a.in[20] + c0);
            const f32x4 bn = unpk4(*(const unsigned long long*)((const bf16*)(ws + WS_BONUS) + tok * 512 + c0)), gt = unpk4(*(const unsigned long long*)((const bf16*)(ws + WS_GATE) + tok * 512 + c0));
            const f32x4 o = (y[mt] * rs * lw + lb + bn) * gt;
            *(unsigned long long*)((bf16*)(ws + WS_Y) + tok * D_ + 512 + c0) = pk4(o); }
    }
}
constexpr size_t WS_W2T = WS_TILE + 65536;
constexpr size_t WS_PARK = WS_Y;
DI s16x8 act_frag(const bf16* p, int mode) {
    float v[8]; ld8(p, v);
#pragma unroll
    for (int i = 0; i < 8; ++i) { if (mode == 0) v[i] = 1.0f - 2.0f / (__expf(2.0f * v[i]) + 1.0f); else if (mode == 2) v[i] = 1.0f / (1.0f + __expf(-v[i])); }
    v4u w; w.x = pk2(v[0], v[1]); w.y = pk2(v[2], v[3]); w.z = pk2(v[4], v[5]); w.w = pk2(v[6], v[7]);
    return __builtin_bit_cast(s16x8, w);
}
DI void ld4(const bf16* p, float (&v)[4]) { const unsigned long long w = *(const unsigned long long*)p; v[0] = bflo((unsigned)w); v[1] = bfhi((unsigned)w); v[2] = bflo((unsigned)(w >> 32)); v[3] = bfhi((unsigned)(w >> 32)); }
DI void st4(bf16* p, const float (&v)[4]) { *(unsigned long long*)p = (unsigned long long)pk2(v[0], v[1]) | ((unsigned long long)pk2(v[2], v[3]) << 32); }
template <bool WLDS> DI void prep0_rwkv_unit(const Args& a, unsigned char* ws_, ldsp wl, int tile, int h, int lane) {
    asm volatile("" : "+v"(lane));
    GAS unsigned char* wsg = (GAS unsigned char*)ws_; asm volatile("" : "+s"(wsg)); unsigned char* ws = (unsigned char*)wsg;
    const int t0 = tile * 16, n_ = lane & 15, q_ = lane >> 4, t = t0 + n_;
    const bf16* LR = (const bf16*)(ws + WS_LORA) + (size_t)t * LORA_N + 8 * q_;
    const bf16* P = (const bf16*)(ws + WS_PROJ0) + (size_t)t * EVEN_IN + 1536 + h * 64 + 4 * q_;
    const bool hp = t > 0, hn = t < S_ - 1;
    unsigned long long cu[3][4], pv[3][4], nx[3][4];
#pragma unroll
    for (int part = 0; part < 3; ++part)
#pragma unroll
        for (int mt = 0; mt < 4; ++mt) { const bf16* p = P + part * 512 + 16 * mt;
            cu[part][mt] = *(const unsigned long long*)p; pv[part][mt] = hp ? *(const unsigned long long*)(p - EVEN_IN) : 0ull; nx[part][mt] = hn ? *(const unsigned long long*)(p + EVEN_IN) : 0ull; }
    unsigned long long rkv[3][4];
#pragma unroll
    for (int part = 0; part < 3; ++part)
#pragma unroll
        for (int mt = 0; mt < 4; ++mt) { const int c0 = h * 64 + 16 * mt + 4 * q_;
            const f32x4 m0 = *(const f32x4*)(a.in[6] + part * 512 + c0), m1 = *(const f32x4*)(a.in[6] + 1536 + part * 512 + c0);
            const f32x4 c4 = unpk4(cu[part][mt]), p4 = unpk4(pv[part][mt]), n4 = unpk4(nx[part][mt]);
            rkv[part][mt] = pk4(c4 + m0 * (p4 - c4) + m1 * (n4 - c4)); }
    asm volatile("" ::: "memory");
    v4u lraw[12];
#pragma unroll
    for (int i = 0; i < 12; ++i) lraw[i] = *(const v4u*)(LR + 32 * i);
    float ss = 0.f;
#pragma unroll
    for (int mt = 0; mt < 4; ++mt) { const f32x4 kkw = *(const f32x4*)(a.in[16] + h * 64 + 16 * mt + 4 * q_);
        const f32x4 k4 = unpk4(rkv[1][mt]);
#pragma unroll
        for (int e = 0; e < 4; ++e) { const float x = k4[e] * kkw[e]; ss += x * x; } }
    ss += __shfl_xor(ss, 16); ss += __shfl_xor(ss, 32);
    const float rn = 1.0f / sqrtf(ss + 1e-6f);
    s16x8 lfr[12];
#pragma unroll
    for (int i = 0; i < 12; ++i) { float x[8]; const v4u w = lraw[i];
        x[0] = bflo(w.x); x[1] = bfhi(w.x); x[2] = bflo(w.y); x[3] = bfhi(w.y); x[4] = bflo(w.z); x[5] = bfhi(w.z); x[6] = bflo(w.w); x[7] = bfhi(w.w);
#pragma unroll
        for (int j = 0; j < 8; ++j) { if (i < 4) x[j] = 1.0f - 2.0f * __builtin_amdgcn_rcpf(__expf(2.0f * x[j]) + 1.0f); else if (i >= 8) x[j] = __builtin_amdgcn_rcpf(1.0f + __expf(-x[j])); }
        v4u o; o.x = pk2(x[0], x[1]); o.y = pk2(x[2], x[3]); o.z = pk2(x[4], x[5]); o.w = pk2(x[6], x[7]); lfr[i] = __builtin_bit_cast(s16x8, o); }
    float dotb = 0.f;
#pragma unroll
    for (int mt = 0; mt < 4; ++mt) {
        const int c0 = h * 64 + 16 * mt + 4 * q_;
        f32x4 aw0 = *(const f32x4*)(a.in[8] + c0), aw1 = *(const f32x4*)(a.in[8] + 512 + c0), aa0 = *(const f32x4*)(a.in[11] + c0), aa1 = *(const f32x4*)(a.in[11] + 512 + c0), ag = (f32x4){0.f, 0.f, 0.f, 0.f};
        const int rl = 16 * mt + n_, sw = rl & 7;
        if (WLDS) {
#pragma unroll
            for (int ks = 0; ks < 2; ++ks) { const int po = ((4 * ks + q_) ^ sw) * 16;
                aw0 = mfma16(*(LAS const s16x8*)(wl + rl * 128 + po), lfr[ks], aw0);
                aw1 = mfma16(*(LAS const s16x8*)(wl + 8192 + rl * 128 + po), lfr[2 + ks], aw1);
                aa0 = mfma16(*(LAS const s16x8*)(wl + 16384 + rl * 128 + po), lfr[4 + ks], aa0);
                aa1 = mfma16(*(LAS const s16x8*)(wl + 24576 + rl * 128 + po), lfr[6 + ks], aa1);
            }
#pragma unroll
            for (int ks = 0; ks < 4; ++ks) ag = mfma16(*(LAS const s16x8*)(wl + 32768 + rl * 256 + ((((4 * ks + q_) & 8) | (((4 * ks + q_) & 7) ^ sw)) * 16)), lfr[8 + ks], ag);
        } else {
            const bf16* W2T = (const bf16*)(ws + WS_W2T); const size_t cr = (size_t)(h * 64 + rl);
#pragma unroll
            for (int ks = 0; ks < 2; ++ks) {
                aw0 = mfma16(*(const s16x8*)(W2T + cr * 64 + 32 * ks + 8 * q_), lfr[ks], aw0);
                aw1 = mfma16(*(const s16x8*)(W2T + 32768 + cr * 64 + 32 * ks + 8 * q_), lfr[2 + ks], aw1);
                aa0 = mfma16(*(const s16x8*)(W2T + 65536 + cr * 64 + 32 * ks + 8 * q_), lfr[4 + ks], aa0);
                aa1 = mfma16(*(const s16x8*)(W2T + 98304 + cr * 64 + 32 * ks + 8 * q_), lfr[6 + ks], aa1);
            }
#pragma unroll
            for (int ks = 0; ks < 4; ++ks) ag = mfma16(*(const s16x8*)(W2T + 131072 + cr * 128 + 32 * ks + 8 * q_), lfr[8 + ks], ag);
        }
        const f32x4 kkw = *(const f32x4*)(a.in[16] + c0), kaw = *(const f32x4*)(a.in[17] + c0), rkw = *(const f32x4*)(a.in[18] + c0);
        float l0[4], l1[4], g4[4], d0[4], d1[4], kk4[4], b0[4], b1[4];
        const f32x4 r4 = unpk4(rkv[0][mt]), k4 = unpk4(rkv[1][mt]);
#pragma unroll
        for (int e = 0; e < 4; ++e) {
            l0[e] = -__expf(-__logf(1.0f + __expf(-aw0[e])) - 0.5f); l1[e] = -__expf(-__logf(1.0f + __expf(-aw1[e])) - 0.5f);
            const float i0 = __builtin_amdgcn_rcpf(1.0f + __expf(-aa0[e])), i1 = __builtin_amdgcn_rcpf(1.0f + __expf(-aa1[e])); g4[e] = ag[e];
            kk4[e] = k4[e] * kkw[e] * rn; b0[e] = kk4[e] * i0; b1[e] = kk4[e] * i1;
            d0[e] = k4[e] * (1.0f + (i0 - 1.0f) * kaw[e]); d1[e] = k4[e] * (1.0f + (i1 - 1.0f) * kaw[e]);
            dotb += r4[e] * (d0[e] + d1[e]) * rkw[e]; }
        const size_t o = (size_t)t * 512 + c0;
        *(f32x4*)((float*)(ws + WS_LW0) + o) = (f32x4){l0[0], l0[1], l0[2], l0[3]};
        *(f32x4*)((float*)(ws + WS_LW1) + o) = (f32x4){l1[0], l1[1], l1[2], l1[3]};
        *(unsigned long long*)((bf16*)(ws + WS_R) + o) = rkv[0][mt]; *(unsigned long long*)((bf16*)(ws + WS_V) + o) = rkv[2][mt]; st4((bf16*)(ws + WS_KK) + o, kk4); st4((bf16*)(ws + WS_KD0) + o, d0); st4((bf16*)(ws + WS_KD1) + o, d1);
        st4((bf16*)(ws + WS_B0) + o, b0); st4((bf16*)(ws + WS_B1) + o, b1); st4((bf16*)(ws + WS_GATE) + o, g4);
        if (!WLDS) asm volatile("" ::: "memory");
    }
    dotb += __shfl_xor(dotb, 16); dotb += __shfl_xor(dotb, 32);
#pragma unroll
    for (int mt = 0; mt < 4; ++mt) { float bo[4]; const f32x4 v4 = unpk4(rkv[2][mt]);
#pragma unroll
        for (int e = 0; e < 4; ++e) bo[e] = dotb * v4[e];
        st4((bf16*)(ws + WS_BONUS) + (size_t)t * 512 + h * 64 + 16 * mt + 4 * q_, bo); }
}
DI void prep0_stage_w2t(unsigned char* ws, ldsp wl, int h, int tid) {
    const bf16* W2T = (const bf16*)(ws + WS_W2T);
    for (int i = tid; i < 3072; i += 512) {
        if (i < 2048) { const int mtx = i >> 9, r = (i >> 3) & 63, c = i & 7;
            *(LAS v4u*)(wl + mtx * 8192 + r * 128 + ((c ^ (r & 7)) * 16)) = *(const v4u*)(W2T + (size_t)mtx * 32768 + (size_t)(h * 64 + r) * 64 + c * 8); }
        else { const int j = i - 2048, r = j >> 4, c = j & 15;
            *(LAS v4u*)(wl + 32768 + r * 256 + (((c & 8) | ((c & 7) ^ (r & 7))) * 16)) = *(const v4u*)(W2T + 131072 + (size_t)(h * 64 + r) * 128 + c * 8); }
    }
}
constexpr int AT_ACC = 0, AT_M = 65536, AT_L = 66560, AT_V = 67584;
DI void attn_unit(unsigned char* ws, ldsp L, int unit, int wave, int lane) {
    const int h = unit & 7, T0 = (unit >> 3) * 256;
    const bf16* QN = (const bf16*)(ws + WS_QN); const bf16* KN = (const bf16*)(ws + WS_KN); const bf16* VN = (const bf16*)(ws + WS_Y1);
    LAS float* accO = (LAS float*)(L + AT_ACC); LAS float* accM = (LAS float*)(L + AT_M); LAS float* accL = (LAS float*)(L + AT_L);
    ldsp Vst = L + AT_V + wave * 8192;
#pragma unroll 1
    for (int br = 0; br < 3; ++br) {
        const int d = br == 0 ? 1 : (br == 1 ? 4 : 16);
#pragma unroll 1
        for (int si = 0; si < 2; ++si) {
            int lane_s = lane; asm volatile("" : "+v"(lane_s));
            const int n_ = lane_s & 15, q_ = lane_s >> 4;
            const int sidx = wave + 8 * si;
            const int tb = br == 0 ? T0 + 16 * sidx : (br == 1 ? T0 + (sidx & 3) + 64 * (sidx >> 2) : T0 + sidx);
            s16x8 qf[2];
            { const bf16* qrow = QN + (size_t)(tb + d * n_) * 512 + h * 64 + 8 * q_; qf[0] = *(const s16x8*)qrow; qf[1] = *(const s16x8*)(qrow + 32); }
            v4u vreg[5][4];
#pragma unroll
            for (int pp = 0; pp < 5; ++pp)
#pragma unroll
                for (int it = 0; it < 4; ++it) { const int pc = lane + 64 * it, row = pc >> 3, ck = pc & 7;
                    int tk = tb + d * (32 * pp + row - 64); tk = tk < 0 ? 0 : (tk > S_ - 1 ? S_ - 1 : tk);
                    vreg[pp][it] = *(const v4u*)(VN + (size_t)tk * 512 + h * 64 + ck * 8); }
            f32x4 st[10]; st[9] = (f32x4){0.f, 0.f, 0.f, 0.f};
#pragma unroll
            for (int kt = 0; kt < 9; ++kt) {
                int tk = tb + d * (16 * kt + n_ - 64); tk = tk < 0 ? 0 : (tk > S_ - 1 ? S_ - 1 : tk);
                const bf16* krow = KN + (size_t)tk * 512 + h * 64 + 8 * q_;
                f32x4 acc = (f32x4){0.f, 0.f, 0.f, 0.f};
                acc = mfma16(*(const s16x8*)krow, qf[0], acc); acc = mfma16(*(const s16x8*)(krow + 32), qf[1], acc);
                st[kt] = acc;
            }
            float mx = -3.0e38f;
            const bool edge = (tb - 64 * d < 0) || (tb + d * 95 >= S_);
#pragma unroll
            for (int kt = 0; kt < 9; ++kt)
#pragma unroll
                for (int e = 0; e < 4; ++e) { const int j = 16 * kt + 4 * q_ + e;
                    bool ok = true;
                    if (kt == 0) ok = (j >= n_);
                    if (kt == 8) ok = (j <= n_ + 128);
                    if (edge) { const int tk = tb + d * (j - 64); ok = ok && (tk >= 0) && (tk < S_); }
                    st[kt][e] = ok ? st[kt][e] : -3.0e38f; mx = fmaxf(mx, st[kt][e]); }
            mx = fmaxf(mx, __shfl_xor(mx, 16)); mx = fmaxf(mx, __shfl_xor(mx, 32));
            float ls = 0.f;
#pragma unroll
            for (int kt = 0; kt < 9; ++kt)
#pragma unroll
                for (int e = 0; e < 4; ++e) { const float p = st[kt][e] > -1.0e38f ? __expf(st[kt][e] - mx) : 0.f; st[kt][e] = p; ls += p; }
            ls += __shfl_xor(ls, 16); ls += __shfl_xor(ls, 32);
            f32x4 O[4];
#pragma unroll
            for (int dt = 0; dt < 4; ++dt) O[dt] = (f32x4){0.f, 0.f, 0.f, 0.f};
#pragma unroll
            for (int pp = 0; pp < 5; ++pp) {
                ldsp vb = Vst + (pp & 1) * 4096;
#pragma unroll
                for (int it = 0; it < 4; ++it) { const int pc = lane + 64 * it, row = pc >> 3, ck = pc & 7; *(LAS v4u*)(vb + row * 128 + ck * 16) = vreg[pp][it]; }
                LDS_WAIT(); CFENCE();
                const s16x8 pa = pack_cpair(st[2 * pp], st[2 * pp + 1]);
                ldsp a0 = vb + (4 * q_ + ((lane & 15) >> 2)) * 128 + 8 * (lane & 3);
#pragma unroll
                for (int dt = 0; dt < 4; ++dt) { const s16x4 lo = tr16(a0 + 32 * dt), hi = tr16(a0 + 16 * 128 + 32 * dt);
                    O[dt] = mfma16(pa, __builtin_shufflevector(lo, hi, 0, 1, 2, 3, 4, 5, 6, 7), O[dt]); }
            }
            float ms[4], lsv[4]; int li[4];
#pragma unroll
            for (int e = 0; e < 4; ++e) { ms[e] = __shfl(mx, 4 * q_ + e); lsv[e] = __shfl(ls, 4 * q_ + e); li[e] = tb + d * (4 * q_ + e) - T0; }
            if (br == 0) {
#pragma unroll
                for (int e = 0; e < 4; ++e) {
#pragma unroll
                    for (int dt = 0; dt < 4; ++dt) accO[li[e] * 64 + 16 * dt + n_] = O[dt][e];
                    if (n_ == 0) { accM[li[e]] = ms[e]; accL[li[e]] = lsv[e]; } }
            } else {
                float fo[4], fn[4], mn[4], lo_[4];
#pragma unroll
                for (int e = 0; e < 4; ++e) { const float mo = accM[li[e]]; lo_[e] = accL[li[e]]; mn[e] = fmaxf(mo, ms[e]); fo[e] = __expf(mo - mn[e]); fn[e] = __expf(ms[e] - mn[e]); }
                LDS_WAIT(); CFENCE();
#pragma unroll
                for (int e = 0; e < 4; ++e) {
#pragma unroll
                    for (int dt = 0; dt < 4; ++dt) { LAS float* p = accO + li[e] * 64 + 16 * dt + n_; *p = *p * fo[e] + O[dt][e] * fn[e]; }
                    if (n_ == 0) { accM[li[e]] = mn[e]; accL[li[e]] = lo_[e] * fo[e] + lsv[e] * fn[e]; } }
            }
            LDS_WAIT(); CFENCE();
        }
        __syncthreads();
    }
    {
        const int tid = wave * 64 + lane, tl = tid >> 1, hf = tid & 1;
        const float il = 1.0f / accL[tl];
        const LAS float* src = accO + tl * 64 + 32 * hf; bf16* dst = (bf16*)(ws + WS_Y) + (size_t)(T0 + tl) * D_ + h * 64 + 32 * hf;
#pragma unroll
        for (int c = 0; c < 4; ++c) { const f32x4 a = *(LAS const f32x4*)(src + 8 * c), b = *(LAS const f32x4*)(src + 8 * c + 4);
            v4u w; w.x = pk2(a.x * il, a.y * il); w.y = pk2(a.z * il, a.w * il); w.z = pk2(b.x * il, b.y * il); w.w = pk2(b.z * il, b.w * il);
            *(v4u*)(dst + 8 * c) = w; }
    }
    __syncthreads();
}
constexpr size_t WS_SST = WS_PROJ1, WS_UB = WS_PROJ1 + 64 * MiB, WS_AT = WS_PROJ1 + 96 * MiB, WS_GC = WS_PROJ1 + 112 * MiB;
constexpr size_t WS_WN = WS_A + 112 * MiB, WS_KT = WS_A + 144 * MiB;
static_assert(WS_GC + 2048 * 64 * 4 <= WS_O0, "dn map");
template <int PITCH> DI s16x8 frag_row_p(ldsp img, int row0, int col0, int lane) { return *(LAS const s16x8*)(img + (row0 + (lane & 15)) * PITCH + (col0 + 8 * (lane >> 4)) * 2); }
template <int PITCH> DI s16x8 frag_tr_p(ldsp img, int row0, int col0, int lane) {
    ldsp a0 = img + (row0 + 8 * (lane >> 4) + ((lane & 15) >> 2)) * PITCH + col0 * 2 + 8 * (lane & 3);
    const s16x4 lo = tr16(a0), hi = tr16(a0 + 4 * PITCH);
    return __builtin_shufflevector(lo, hi, 0, 1, 2, 3, 4, 5, 6, 7);
}
constexpr int DN_LDS_PER_WAVE = 32768 + 512;
DI void dn_pass1_item(unsigned char* ws, ldsp lds, int item, int lane) {
    asm volatile("" : "+v"(lane));
    const int z = item >> 10, h = (item >> 8) & 3, c = item & 255, cn = z ? 255 - c : c;
    const bf16* Q = (const bf16*)(ws + WS_QD); const bf16* K = (const bf16*)(ws + WS_KD); const bf16* V = (const bf16*)(ws + WS_VD);
    ldsp IKd = lds, IVd = lds, LT = lds + 16384; LAS float* gcs = (LAS float*)(lds + 32768); LAS float* bts = gcs + 64;
    const int n_ = lane & 15, q_ = lane >> 4;
    {
        const int tok = tok_of(z, cn, lane);
        float gc = ((const float*)(ws + WS_GB))[(size_t)tok * 8 + z * 4 + h]; const float bt = ((const float*)(ws + WS_GB + 512 * 1024))[(size_t)tok * 8 + z * 4 + h];
#pragma unroll
        for (int o = 1; o < 64; o <<= 1) { const float t = __shfl_up(gc, o); if (lane >= o) gc += t; }
        gcs[lane] = gc; bts[lane] = bt; ((float*)(ws + WS_GC))[(size_t)item * 64 + lane] = gc;
    }
#pragma unroll 4
    for (int it = 0; it < 16; ++it) { const int p = lane + 64 * it, row = p >> 4, ck = p & 15; const size_t go = (size_t)tok_of(z, cn, row) * 512 + h * 128 + ck * 8;
        *(LAS v4u*)(IKd + row * 256 + ck * 16) = *(const v4u*)(K + go); }
    LDS_WAIT(); CFENCE();
    s16x8 kf[4][4];
#pragma unroll
    for (int rt = 0; rt < 4; ++rt)
#pragma unroll
        for (int ks = 0; ks < 4; ++ks) kf[rt][ks] = frag_row_p<256>(IKd, 16 * rt, 32 * ks, lane);
#pragma unroll
    for (int mt = 0; mt < 4; ++mt) { f32x4 gi, bi;
#pragma unroll
        for (int e = 0; e < 4; ++e) { gi[e] = gcs[16 * mt + 4 * q_ + e]; bi[e] = bts[16 * mt + 4 * q_ + e]; }
#pragma unroll
        for (int nt = 0; nt < 4; ++nt) { f32x4 acc = (f32x4){0.f, 0.f, 0.f, 0.f};
            if (nt <= mt) {
#pragma unroll
                for (int ks = 0; ks < 4; ++ks) acc = mfma16(kf[mt][ks], kf[nt][ks], acc); }
            const float gj = gcs[16 * nt + n_];
#pragma unroll
            for (int e = 0; e < 4; ++e) { const int i = 16 * mt + 4 * q_ + e, j = 16 * nt + n_; ((LAS float*)LT)[i * 64 + j] = (j < i) ? bi[e] * acc[e] * __expf(gi[e] - gj) : 0.f; } } }
    {
        bf16* At = (bf16*)(ws + WS_AT) + (size_t)item * 4096;
#pragma unroll
        for (int nt = 0; nt < 4; ++nt) { s16x8 qf[4]; const bf16* qrow = Q + (size_t)tok_of(z, cn, 16 * nt + n_) * 512 + h * 128 + 8 * q_;
#pragma unroll
            for (int ks = 0; ks < 4; ++ks) qf[ks] = *(const s16x8*)(qrow + 32 * ks);
            const float gi = gcs[16 * nt + n_];
#pragma unroll
            for (int mt = 0; mt < 4; ++mt) { f32x4 acc = (f32x4){0.f, 0.f, 0.f, 0.f};
                if (mt <= nt) {
#pragma unroll
                    for (int ks = 0; ks < 4; ++ks) acc = mfma16(kf[mt][ks], qf[ks], acc); }
                f32x4 o;
#pragma unroll
                for (int e = 0; e < 4; ++e) { const int j = 16 * mt + 4 * q_ + e, i = 16 * nt + n_; o[e] = (j <= i) ? acc[e] * __expf(gi - gcs[j]) : 0.f; }
                *(unsigned long long*)(At + (size_t)(16 * nt + n_) * 64 + 16 * mt + 4 * q_) = pk4(o); } }
    }
    LDS_WAIT(); CFENCE();
    {
        float t[64];
        int lane_o = lane; asm volatile("" : "+v"(lane_o));
        f32x4 ar[2][16];
#pragma unroll
        for (int i = 0; i < 64; ++i) {
            if (i + 1 < 64) {
#pragma unroll
                for (int jg = 0; jg < (i + 1 + 3) / 4; ++jg) ar[(i + 1) & 1][jg] = *(LAS const f32x4*)(LT + ((i + 1) * 64 + 4 * jg) * 4);
            }
            __builtin_amdgcn_sched_barrier(0);
            float acc0 = (lane_o == i) ? 1.f : 0.f, acc1 = 0.f, acc2 = 0.f, acc3 = 0.f;
#pragma unroll
            for (int jg = 0; jg < (i + 3) / 4; ++jg) { const f32x4 a4 = ar[i & 1][jg];
                if (4 * jg + 0 < i) acc0 -= a4[0] * t[4 * jg + 0];
                if (4 * jg + 1 < i) acc1 -= a4[1] * t[4 * jg + 1];
                if (4 * jg + 2 < i) acc2 -= a4[2] * t[4 * jg + 2];
                if (4 * jg + 3 < i) acc3 -= a4[3] * t[4 * jg + 3]; }
            t[i] = (acc0 + acc1) + (acc2 + acc3);
            __builtin_amdgcn_sched_barrier(0);
        }
        LDS_WAIT(); CFENCE();
        const float s1 = bts[lane], s2 = -s1 * __expf(gcs[lane]);
#pragma unroll
        for (int i = 0; i < 64; ++i) { ((LAS bf16*)LT)[i * 64 + lane] = (bf16)f2bf(t[i] * s1); ((LAS bf16*)(LT + 8192))[i * 64 + lane] = (bf16)f2bf(t[i] * s2); }
    }
    LDS_WAIT(); CFENCE();
    ldsp IT1 = LT, IT2 = LT + 8192;
    v4u vimg[16];
#pragma unroll
    for (int it = 0; it < 16; ++it) { const int p = lane + 64 * it, row = p >> 4, ck = p & 15; vimg[it] = *(const v4u*)(V + (size_t)tok_of(z, cn, row) * 512 + h * 128 + ck * 8); }
    {
        bf16* Wn = (bf16*)(ws + WS_WN) + (size_t)item * 8192;
        s16x8 tf[4][2];
#pragma unroll
        for (int nt = 0; nt < 4; ++nt)
#pragma unroll
            for (int ks = 0; ks < 2; ++ks) tf[nt][ks] = frag_row_p<128>(IT2, 16 * nt, 32 * ks, lane);
#pragma unroll
        for (int mt = 0; mt < 8; ++mt) { const s16x8 k0 = frag_tr_p<256>(IKd, 0, 16 * mt, lane), k1 = frag_tr_p<256>(IKd, 32, 16 * mt, lane);
            if (z == 0) { bf16* KT = (bf16*)(ws + WS_KT) + ((size_t)(h * 256 + cn) * 128 + 16 * mt + n_) * 64 + 8 * q_; *(s16x8*)KT = k0; *(s16x8*)(KT + 32) = k1; }
#pragma unroll
            for (int nt = 0; nt < 4; ++nt) { f32x4 acc = (f32x4){0.f, 0.f, 0.f, 0.f}; acc = mfma16(k0, tf[nt][0], acc); acc = mfma16(k1, tf[nt][1], acc);
                *(unsigned long long*)(Wn + (size_t)(16 * nt + n_) * 128 + 16 * mt + 4 * q_) = pk4(acc); } }
    }
    LDS_WAIT(); CFENCE();
#pragma unroll
    for (int it = 0; it < 16; ++it) { const int p = lane + 64 * it, row = p >> 4, ck = p & 15; *(LAS v4u*)(IVd + row * 256 + ck * 16) = vimg[it]; }
    LDS_WAIT(); CFENCE();
    {
        bf16* Ub = (bf16*)(ws + WS_UB) + (size_t)item * 8192;
        s16x8 tf[4][2];
#pragma unroll
        for (int mt = 0; mt < 4; ++mt)
#pragma unroll
            for (int ks = 0; ks < 2; ++ks) tf[mt][ks] = frag_row_p<128>(IT1, 16 * mt, 32 * ks, lane);
#pragma unroll
        for (int nt = 0; nt < 8; ++nt) { const s16x8 v0 = frag_tr_p<256>(IVd, 0, 16 * nt, lane), v1 = frag_tr_p<256>(IVd, 32, 16 * nt, lane);
#pragma unroll
            for (int mt = 0; mt < 4; ++mt) { f32x4 acc = (f32x4){0.f, 0.f, 0.f, 0.f}; acc = mfma16(tf[mt][0], v0, acc); acc = mfma16(tf[mt][1], v1, acc);
                *(unsigned long long*)(Ub + (size_t)(16 * nt + n_) * 64 + 16 * mt + 4 * q_) = pk4(acc); } }
    }
    LDS_WAIT(); CFENCE();
}
DI s16x8 pack_cpair_rev(const f32x4& lo, const f32x4& hi) { v4u p; p.x = pk2(lo[3], lo[2]); p.y = pk2(lo[1], lo[0]); p.z = pk2(hi[3], hi[2]); p.w = pk2(hi[1], hi[0]); return __builtin_bit_cast(s16x8, p); }
DI unsigned long long rev4(unsigned long long x) { return (x >> 48) | ((x >> 16) & 0xffff0000ull) | ((x << 16) & 0xffff00000000ull) | (x << 48); }
DI void dn_pass2_wave(unsigned char* ws, int w  , int lane) {
    const int z = w >> 5, h = (w >> 3) & 3, vs = w & 7;
    const int n_ = lane & 15, q_ = lane >> 4;
    f32x4 S[8];
#pragma unroll
    for (int kt = 0; kt < 8; ++kt) S[kt] = (f32x4){0.f, 0.f, 0.f, 0.f};
    for (int c = 0; c < 256; ++c) {
        const int item = (z * 4 + h) * 256 + c, cn = z ? 255 - c : c;
        const bf16* Wn = (const bf16*)(ws + WS_WN) + (size_t)item * 8192; const bf16* Ub = (const bf16*)(ws + WS_UB) + (size_t)item * 8192;
        const float* gcu = (const float*)(ws + WS_GC) + (size_t)item * 64;
        const bf16* KT = (const bf16*)(ws + WS_KT) + (size_t)(h * 256 + cn) * 128 * 64;
        bf16* Sst = (bf16*)(ws + WS_SST) + (size_t)item * 16384;
        f32x4 u[4], gv[4];
#pragma unroll
        for (int mt = 0; mt < 4; ++mt) { u[mt] = unpk4(*(const unsigned long long*)(Ub + (size_t)(16 * vs + n_) * 64 + 16 * mt + 4 * q_)); gv[mt] = *(const f32x4*)(gcu + 16 * mt + 4 * q_); }
        const float gl = gcu[63];
        unsigned long long wa[4][4][2], ka[8][2][2];
#pragma unroll
        for (int mt = 0; mt < 4; ++mt)
#pragma unroll
            for (int ks = 0; ks < 4; ++ks) { const bf16* row = Wn + (size_t)(16 * mt + n_) * 128 + 32 * ks + 4 * q_; wa[mt][ks][0] = *(const unsigned long long*)row; wa[mt][ks][1] = *(const unsigned long long*)(row + 16); }
#pragma unroll
        for (int kt = 0; kt < 8; ++kt)
#pragma unroll
            for (int ks = 0; ks < 2; ++ks) { const bf16* row = KT + (size_t)(16 * kt + n_) * 64;
                if (z == 0) { ka[kt][ks][0] = *(const unsigned long long*)(row + 32 * ks + 4 * q_); ka[kt][ks][1] = *(const unsigned long long*)(row + 32 * ks + 16 + 4 * q_); }
                else { ka[kt][ks][0] = rev4(*(const unsigned long long*)(row + 60 - 32 * ks - 4 * q_)); ka[kt][ks][1] = rev4(*(const unsigned long long*)(row + 44 - 32 * ks - 4 * q_)); } }
#pragma unroll
        for (int kt = 0; kt < 8; ++kt) *(unsigned long long*)(Sst + (size_t)(16 * vs + n_) * 128 + 16 * kt + 4 * q_) = pk4(S[kt]);
#pragma unroll
        for (int ks = 0; ks < 4; ++ks) { const s16x8 b = pack_cpair(S[2 * ks], S[2 * ks + 1]);
#pragma unroll
            for (int mt = 0; mt < 4; ++mt) { v4u a; a.x = (unsigned)wa[mt][ks][0]; a.y = (unsigned)(wa[mt][ks][0] >> 32); a.z = (unsigned)wa[mt][ks][1]; a.w = (unsigned)(wa[mt][ks][1] >> 32);
                u[mt] = mfma16(__builtin_bit_cast(s16x8, a), b, u[mt]); } }
#pragma unroll
        for (int mt = 0; mt < 4; ++mt)
#pragma unroll
            for (int e = 0; e < 4; ++e) u[mt][e] *= __expf(gl - gv[mt][e]);
        const float egl = __expf(gl);
        const s16x8 b0 = pack_cpair(u[0], u[1]), b1 = pack_cpair(u[2], u[3]);
#pragma unroll
        for (int kt = 0; kt < 8; ++kt) { f32x4 acc = S[kt] * egl;
            { v4u a; a.x = (unsigned)ka[kt][0][0]; a.y = (unsigned)(ka[kt][0][0] >> 32); a.z = (unsigned)ka[kt][0][1]; a.w = (unsigned)(ka[kt][0][1] >> 32); acc = mfma16(__builtin_bit_cast(s16x8, a), b0, acc); }
            { v4u a; a.x = (unsigned)ka[kt][1][0]; a.y = (unsigned)(ka[kt][1][0] >> 32); a.z = (unsigned)ka[kt][1][1]; a.w = (unsigned)(ka[kt][1][1] >> 32); acc = mfma16(__builtin_bit_cast(s16x8, a), b1, acc); }
            S[kt] = acc; }
    }
}
DI void dn_pass3_item(unsigned char* ws, int item, int lane) {
    asm volatile("" : "+v"(lane));
    const int z = item >> 10, h = (item >> 8) & 3, c = item & 255, cn = z ? 255 - c : c;
    const int n_ = lane & 15, q_ = lane >> 4;
    const bf16* Q = (const bf16*)(ws + WS_QD);
    const bf16* Wn = (const bf16*)(ws + WS_WN) + (size_t)item * 8192; const bf16* Ub = (const bf16*)(ws + WS_UB) + (size_t)item * 8192;
    const bf16* At = (const bf16*)(ws + WS_AT) + (size_t)item * 4096; const float* gcu = (const float*)(ws + WS_GC) + (size_t)item * 64;
    const bf16* Sst = (const bf16*)(ws + WS_SST) + (size_t)item * 16384;
    bf16* O = (bf16*)(ws + (z ? WS_O1 : WS_O0));
    s16x8 wf[4][4], qf[4][4]; unsigned long long af[4][2][2]; float eg[4];
#pragma unroll
    for (int t = 0; t < 4; ++t) {
        const bf16* qrow = Q + (size_t)tok_of(z, cn, 16 * t + n_) * 512 + h * 128 + 8 * q_;
#pragma unroll
        for (int ks = 0; ks < 4; ++ks) { wf[t][ks] = *(const s16x8*)(Wn + (size_t)(16 * t + n_) * 128 + 32 * ks + 8 * q_); qf[t][ks] = *(const s16x8*)(qrow + 32 * ks); }
#pragma unroll
        for (int ks = 0; ks < 2; ++ks) { const bf16* arow = At + (size_t)(16 * t + n_) * 64 + 32 * ks + 4 * q_; af[t][ks][0] = *(const unsigned long long*)arow; af[t][ks][1] = *(const unsigned long long*)(arow + 16); }
        eg[t] = __expf(gcu[16 * t + n_]);
    }
#pragma unroll
    for (int mt = 0; mt < 8; ++mt) {
        s16x8 sf[4];
#pragma unroll
        for (int ks = 0; ks < 4; ++ks) sf[ks] = *(const s16x8*)(Sst + (size_t)(16 * mt + n_) * 128 + 32 * ks + 8 * q_);
        f32x4 u[4];
#pragma unroll
        for (int jt = 0; jt < 4; ++jt) { u[jt] = unpk4(*(const unsigned long long*)(Ub + (size_t)(16 * mt + n_) * 64 + 16 * jt + 4 * q_));
#pragma unroll
            for (int ks = 0; ks < 4; ++ks) u[jt] = mfma16(wf[jt][ks], sf[ks], u[jt]); }
        const s16x8 ua0 = pack_cpair(u[0], u[1]), ua1 = pack_cpair(u[2], u[3]);
#pragma unroll
        for (int nt = 0; nt < 4; ++nt) {
            f32x4 acc = (f32x4){0.f, 0.f, 0.f, 0.f};
#pragma unroll
            for (int ks = 0; ks < 4; ++ks) acc = mfma16(sf[ks], qf[nt][ks], acc);
            acc = acc * eg[nt];
            { v4u b; b.x = (unsigned)af[nt][0][0]; b.y = (unsigned)(af[nt][0][0] >> 32); b.z = (unsigned)af[nt][0][1]; b.w = (unsigned)(af[nt][0][1] >> 32); acc = mfma16(ua0, __builtin_bit_cast(s16x8, b), acc); }
            { v4u b; b.x = (unsigned)af[nt][1][0]; b.y = (unsigned)(af[nt][1][0] >> 32); b.z = (unsigned)af[nt][1][1]; b.w = (unsigned)(af[nt][1][1] >> 32); acc = mfma16(ua1, __builtin_bit_cast(s16x8, b), acc); }
            *(unsigned long long*)(O + (size_t)tok_of(z, cn, 16 * nt + n_) * 512 + h * 128 + 16 * mt + 4 * q_) = pk4(acc);
        }
    }
}
constexpr int DN_SLOT = 41984, DN_GRP = 16;
constexpr size_t WS_MG = WS_END_OLD, WS_NG = WS_END_OLD + 4 * MiB, WS_SG = WS_END_OLD + 8 * MiB;
DI void dn_scan_block(unsigned char* ws, ldsp L, const int Z, const int MODE, int h, int hv, int g, int wave, int lane) {
    const int item0 = (Z * 4 + h) * 256, cb = g * DN_GRP, zhg = (Z * 4 + h) * 16 + g;
    if (wave >= 4) {
        const int lw = wave - 4;
        unsigned so[11], ld[11];
#pragma unroll
        for (int k = 0; k < 4; ++k) { const int pid = lw * 4 + k; const int row = 4 * pid + (lane >> 4), p = lane & 15, cch = p ^ (row & 15); so[k] = row * 256 + cch * 16; ld[k] = pid * 1024 + lane * 16; }
#pragma unroll
        for (int k = 0; k < 4; ++k) { const int pid = lw * 4 + k; const int row = 8 * pid + (lane >> 3), p = lane & 7, cch = p ^ (row & 7); so[4 + k] = row * 128 + cch * 16; ld[4 + k] = 16384 + pid * 1024 + lane * 16; }
#pragma unroll
        for (int k = 0; k < 2; ++k) { const int pid = lw * 2 + k; const int row = 8 * pid + (lane >> 3), p = lane & 7, cch = p ^ (row & 7); so[8 + k] = row * 128 + cch * 16; ld[8 + k] = 32768 + pid * 1024 + lane * 16; }
        so[10] = lane * 16; ld[10] = 40960 + lane * 16;
        v4u rA[11], rB[11];
#define DN_GLOAD(R, ss) do { const int s_ = (ss) < DN_GRP ? (ss) : DN_GRP - 1; const int c_ = cb + s_; const int cn_ = Z ? 255 - c_ : c_; \
            const char* wsrc = (const char*)((const bf16*)(ws + WS_WN) + (size_t)(item0 + c_) * 8192); const char* ksrc = (const char*)((const bf16*)(ws + WS_KT) + (size_t)(h * 256 + cn_) * 8192); \
            const char* usrc = (const char*)((const bf16*)(ws + WS_UB) + (size_t)(item0 + c_) * 8192 + hv * 4096); const char* gsrc = (const char*)((const float*)(ws + WS_GC) + (size_t)(item0 + c_) * 64); \
            _Pragma("unroll") for (int k = 0; k < 4; ++k) R[k] = *(const v4u*)(wsrc + so[k]); \
            _Pragma("unroll") for (int k = 4; k < 8; ++k) R[k] = *(const v4u*)(ksrc + so[k]); \
            _Pragma("unroll") for (int k = 8; k < 10; ++k) R[k] = *(const v4u*)(usrc + so[k]); \
            if (lw == 0) R[10] = *(const v4u*)(gsrc + so[10]); } while (0)
#define DN_LWRITE(R, ss) do { ldsp slot = L + ((ss) % 3) * DN_SLOT; \
            _Pragma("unroll") for (int k = 0; k < 10; ++k) *(LAS v4u*)(slot + ld[k]) = R[k]; \
            if (lw == 0) *(LAS v4u*)(slot + ld[10]) = R[10]; } while (0)
        DN_GLOAD(rA, 0); DN_GLOAD(rB, 1); DN_LWRITE(rA, 0); DN_LWRITE(rB, 1);
        DN_GLOAD(rA, 2); DN_GLOAD(rB, 3);
#define DN_LSTEP(R, ss) do { asm volatile("s_waitcnt lgkmcnt(0)" ::: "memory"); __builtin_amdgcn_s_barrier(); asm volatile("" ::: "memory"); \
            DN_LWRITE(R, (ss) + 2); DN_GLOAD(R, (ss) + 4); } while (0)
        for (int s2 = 0; s2 < DN_GRP; s2 += 2) { DN_LSTEP(rA, s2); DN_LSTEP(rB, s2 + 1); }
#undef DN_LSTEP
#undef DN_LWRITE
#undef DN_GLOAD
        asm volatile("s_waitcnt vmcnt(0) lgkmcnt(0)" ::: "memory");
        return;
    }
    const int vs = 4 * hv + wave;
    const int n_ = lane & 15, q_ = lane >> 4, wbyte = (q_ & 1) * 8, sw = n_ & 7;
    int kao[2][2];
#pragma unroll
    for (int ks = 0; ks < 2; ++ks) { const int r0 = Z ? 60 - 32 * ks - 4 * q_ : 32 * ks + 4 * q_, r1 = Z ? r0 - 16 : r0 + 16; kao[ks][0] = (((r0 >> 3) ^ sw) * 16) + (r0 & 7) * 2; kao[ks][1] = (((r1 >> 3) ^ sw) * 16) + (r1 & 7) * 2; }
    const float ubm = MODE == 2 ? 0.f : 1.f;
    f32x4 S[8];
    if (MODE == 0) { const bf16* SG = (const bf16*)(ws + WS_SG) + (size_t)zhg * 16384;
#pragma unroll
        for (int kt = 0; kt < 8; ++kt) S[kt] = unpk4(*(const unsigned long long*)(SG + (size_t)(16 * vs + n_) * 128 + 16 * kt + 4 * q_)); }
    else {
#pragma unroll
        for (int kt = 0; kt < 8; ++kt)
#pragma unroll
            for (int e = 0; e < 4; ++e) S[kt][e] = (MODE == 2 && (16 * kt + 4 * q_ + e) == (16 * vs + n_)) ? 1.f : 0.f; }
    for (int s = 0; s < DN_GRP; ++s) {
        const int c = cb + s;
        if (MODE == 0) { bf16* Sst = (bf16*)(ws + WS_SST) + (size_t)(item0 + c) * 16384;
#pragma unroll
            for (int kt = 0; kt < 8; ++kt) *(unsigned long long*)(Sst + (size_t)(16 * vs + n_) * 128 + 16 * kt + 4 * q_) = pk4(S[kt]); }
        asm volatile("s_waitcnt lgkmcnt(0)" ::: "memory");
        __builtin_amdgcn_s_barrier();
        asm volatile("" ::: "memory");
        ldsp slot = L + (s % 3) * DN_SLOT;
        f32x4 u[4], gv[4]; unsigned long long wa[4][4][2], ka[8][2][2];
        { ldsp urow = slot + 32768 + (16 * wave + n_) * 128 + wbyte;
#pragma unroll
          for (int mt = 0; mt < 4; ++mt) { u[mt] = unpk4(*(LAS const unsigned long long*)(urow + (((2 * mt + (q_ >> 1)) ^ sw) * 16))) * ubm; gv[mt] = *(LAS const f32x4*)(slot + 40960 + (16 * mt + 4 * q_) * 4); } }
        const float gl = *(LAS const float*)(slot + 40960 + 63 * 4);
#pragma unroll
        for (int ks = 0; ks < 4; ++ks)
#pragma unroll
            for (int mt = 0; mt < 4; ++mt) { ldsp row = slot + (16 * mt + n_) * 256 + wbyte; const int c0 = 4 * ks + (q_ >> 1);
                wa[mt][ks][0] = *(LAS const unsigned long long*)(row + ((c0 ^ n_) * 16)); wa[mt][ks][1] = *(LAS const unsigned long long*)(row + (((c0 + 2) ^ n_) * 16)); }
        __builtin_amdgcn_sched_barrier(0);
#pragma unroll
        for (int ks = 0; ks < 4; ++ks) { const s16x8 bb = pack_cpair(S[2 * ks], S[2 * ks + 1]);
#pragma unroll
            for (int mt = 0; mt < 4; ++mt) { v4u a; a.x = (unsigned)wa[mt][ks][0]; a.y = (unsigned)(wa[mt][ks][0] >> 32); a.z = (unsigned)wa[mt][ks][1]; a.w = (unsigned)(wa[mt][ks][1] >> 32);
                u[mt] = mfma16(__builtin_bit_cast(s16x8, a), bb, u[mt]); } }
        __builtin_amdgcn_sched_barrier(0);
#pragma unroll
        for (int kt = 0; kt < 8; ++kt) { ldsp row = slot + 16384 + (16 * kt + n_) * 128;
#pragma unroll
            for (int ks = 0; ks < 2; ++ks) { ka[kt][ks][0] = *(LAS const unsigned long long*)(row + kao[ks][0]); ka[kt][ks][1] = *(LAS const unsigned long long*)(row + kao[ks][1]); } }
        __builtin_amdgcn_sched_barrier(0);
#pragma unroll
        for (int mt = 0; mt < 4; ++mt)
#pragma unroll
            for (int e = 0; e < 4; ++e) u[mt][e] *= __expf(gl - gv[mt][e]);
        const float egl = __expf(gl);
#pragma unroll
        for (int mt = 0; mt < 4; ++mt) { const f32x4 t = u[mt]; u[mt][0] = Z ? t[3] : t[0]; u[mt][1] = Z ? t[2] : t[1]; u[mt][2] = Z ? t[1] : t[2]; u[mt][3] = Z ? t[0] : t[3]; }
        const s16x8 b0 = pack_cpair(u[0], u[1]), b1 = pack_cpair(u[2], u[3]);
#pragma unroll
        for (int kt = 0; kt < 8; ++kt) { f32x4 acc = S[kt] * egl;
#pragma unroll
            for (int ks = 0; ks < 2; ++ks) { const unsigned long long a0 = ka[kt][ks][0], a1 = ka[kt][ks][1];
                v4u a; a.x = (unsigned)a0; a.y = (unsigned)(a0 >> 32); a.z = (unsigned)a1; a.w = (unsigned)(a1 >> 32);
                acc = mfma16(__builtin_bit_cast(s16x8, a), ks == 0 ? b0 : b1, acc); }
            S[kt] = acc; }
    }
    if (MODE == 1) { bf16* NG = (bf16*)(ws + WS_NG) + (size_t)zhg * 16384;
#pragma unroll
        for (int kt = 0; kt < 8; ++kt) *(unsigned long long*)(NG + (size_t)(16 * vs + n_) * 128 + 16 * kt + 4 * q_) = pk4(S[kt]); }
    if (MODE == 2) { bf16* MG = (bf16*)(ws + WS_MG) + (size_t)zhg * 16384;
#pragma unroll
        for (int kt = 0; kt < 8; ++kt)
#pragma unroll
            for (int e = 0; e < 4; ++e) MG[(size_t)(16 * kt + 4 * q_ + e) * 128 + 16 * vs + n_] = (bf16)f2bf(S[kt][e]); }
}
DI void dn_scan_groups(unsigned char* ws, int w  , int lane) {
    const int zh = w >> 3, vs = w & 7, n_ = lane & 15, q_ = lane >> 4;
    f32x4 S[8];
#pragma unroll
    for (int kt = 0; kt < 8; ++kt) S[kt] = (f32x4){0.f, 0.f, 0.f, 0.f};
    for (int g = 0; g < 16; ++g) {
        const size_t zhg = (size_t)(zh * 16 + g) * 16384;
        bf16* SG = (bf16*)(ws + WS_SG) + zhg; const bf16* MG = (const bf16*)(ws + WS_MG) + zhg; const bf16* NG = (const bf16*)(ws + WS_NG) + zhg;
#pragma unroll
        for (int kt = 0; kt < 8; ++kt) *(unsigned long long*)(SG + (size_t)(16 * vs + n_) * 128 + 16 * kt + 4 * q_) = pk4(S[kt]);
        if (g == 15) break;
        s16x8 bb[4];
#pragma unroll
        for (int ks = 0; ks < 4; ++ks) bb[ks] = pack_cpair(S[2 * ks], S[2 * ks + 1]);
#pragma unroll
        for (int kt = 0; kt < 8; ++kt) { f32x4 acc = unpk4(*(const unsigned long long*)(NG + (size_t)(16 * vs + n_) * 128 + 16 * kt + 4 * q_));
#pragma unroll
            for (int ks = 0; ks < 4; ++ks) { const bf16* row = MG + (size_t)(16 * kt + n_) * 128 + 32 * ks + 4 * q_;
                const unsigned long long a0 = *(const unsigned long long*)row, a1 = *(const unsigned long long*)(row + 16);
                v4u a; a.x = (unsigned)a0; a.y = (unsigned)(a0 >> 32); a.z = (unsigned)a1; a.w = (unsigned)(a1 >> 32);
                acc = mfma16(__builtin_bit_cast(s16x8, a), bb[ks], acc); }
            S[kt] = acc; }
    }
}
DI void prep1_token(const Args& a, unsigned char* ws, int t, int lane) {
    const bf16* P = (const bf16*)(ws + WS_PROJ1) + (size_t)t * ODD_PAD;
    const int c0 = 8 * lane; const bool hp = t > 0, hn = t < S_ - 1;
    float z8[8];
#pragma unroll
    for (int i = 0; i < 8; ++i) z8[i] = 0.f;
    {
        float cb[8], cc[8], cx[8], pc[8], px[8], nc[8], nx[8], w0[8], w1[8], w2[8], o[8];
        ld8(P + c0, cb); ld8(P + 512 + c0, cc); ld8(P + 1024 + c0, cx);
        if (hp) { ld8(P - ODD_PAD + 512 + c0, pc); ld8(P - ODD_PAD + 1024 + c0, px); } else {
#pragma unroll
            for (int i = 0; i < 8; ++i) { pc[i] = 0.f; px[i] = 0.f; } }
        if (hn) { ld8(P + ODD_PAD + 512 + c0, nc); ld8(P + ODD_PAD + 1024 + c0, nx); } else {
#pragma unroll
            for (int i = 0; i < 8; ++i) { nc[i] = 0.f; nx[i] = 0.f; } }
        ld8f(a.in[28] + c0, w0); ld8f(a.in[28] + 512 + c0, w1); ld8f(a.in[28] + 1024 + c0, w2);
#pragma unroll
        for (int i = 0; i < 8; ++i) o[i] = cb[i] * (w0[i] * pc[i] * px[i] + w1[i] * cc[i] * cx[i] + w2[i] * nc[i] * nx[i]);
        st8((bf16*)(ws + WS_YCAT1) + (size_t)t * D_ + c0, o);
    }
#pragma unroll
    for (int part = 0; part < 3; ++part) {
        float cu[8], pv[8], nx[8], w0[8], w1[8], w2[8], o[8];
        const int col = 1536 + part * 512 + c0;
        ld8(P + col, cu);
        if (hp) ld8(P - ODD_PAD + col, pv); else {
#pragma unroll
            for (int i = 0; i < 8; ++i) pv[i] = 0.f; }
        if (hn) ld8(P + ODD_PAD + col, nx); else {
#pragma unroll
            for (int i = 0; i < 8; ++i) nx[i] = 0.f; }
        const float* cw = a.in[29] + part * 512 + c0;
        ld8f(cw, w0); ld8f(cw + 1536, w1); ld8f(cw + 3072, w2);
        float ss = 0.f;
#pragma unroll
        for (int i = 0; i < 8; ++i) { o[i] = siluf_(w0[i] * pv[i] + w1[i] * cu[i] + w2[i] * nx[i]); ss += o[i] * o[i]; }
        if (part < 2) { ss = grp_sum<16>(ss); const float rn = (1.0f / sqrtf(ss + 1e-6f)) * (part == 0 ? 0.08838834764831845f : 1.0f);
#pragma unroll
            for (int i = 0; i < 8; ++i) o[i] *= rn; }
        st8((bf16*)(ws + (part == 0 ? WS_QD : (part == 1 ? WS_KD : WS_VD))) + (size_t)t * 512 + c0, o);
    }
    *(v4u*)((bf16*)(ws + WS_YCAT1) + (size_t)t * D_ + 512 + c0) = *(const v4u*)(P + 3072 + c0);
    if (lane < 8) {
        const float bt = sigmoidf_(bf2f(P[3584 + lane])); const float al = bf2f(P[3592 + lane]);
        const float g = -__expf(a.in[30][lane]) * softplusf_(al + a.in[31][lane]);
        ((float*)(ws + WS_GB))[(size_t)t * 8 + lane] = g; ((float*)(ws + WS_GB + 512 * 1024))[(size_t)t * 8 + lane] = bt;
    }
}
DI void dn_scan_naive(unsigned char* ws, int w  , int lane) {
    const int z = w >> 9, h = (w >> 7) & 3, vc = w & 127;
    const bf16* Q = (const bf16*)(ws + WS_QD); const bf16* K = (const bf16*)(ws + WS_KD); const bf16* V = (const bf16*)(ws + WS_VD);
    const float* G = (const float*)(ws + WS_GB); const float* Bt = (const float*)(ws + WS_GB + 512 * 1024);
    bf16* O = (bf16*)(ws + (z ? WS_O1 : WS_O0));
    float s0 = 0.f, s1 = 0.f;
    int t = z ? S_ - 1 : 0; const int dt = z ? -1 : 1;
    size_t o = (size_t)t * 512 + h * 128;
    float k0 = bf2f(K[o + lane]), k1 = bf2f(K[o + 64 + lane]), q0 = bf2f(Q[o + lane]), q1 = bf2f(Q[o + 64 + lane]), vv = bf2f(V[o + vc]), g = G[(size_t)t * 8 + z * 4 + h], bt = Bt[(size_t)t * 8 + z * 4 + h];
    for (int s = 0; s < S_; ++s) {
        const int tn = (s + 1 < S_) ? t + dt : t; const size_t on = (size_t)tn * 512 + h * 128;
        const float k0n = bf2f(K[on + lane]), k1n = bf2f(K[on + 64 + lane]), q0n = bf2f(Q[on + lane]), q1n = bf2f(Q[on + 64 + lane]), vvn = bf2f(V[on + vc]), gn = G[(size_t)tn * 8 + z * 4 + h], btn = Bt[(size_t)tn * 8 + z * 4 + h];
        const float eg = __expf(g);
        const float dot = wave_sum(k0 * s0 + k1 * s1);
        const float cf = bt * (vv - eg * dot);
        s0 = eg * s0 + cf * k0; s1 = eg * s1 + cf * k1;
        const float ov = wave_sum(q0 * s0 + q1 * s1);
        if (lane == 0) O[(size_t)t * 512 + h * 128 + vc] = (bf16)f2bf(ov);
        k0 = k0n; k1 = k1n; q0 = q0n; q1 = q1n; vv = vvn; g = gn; bt = btn; t = tn;
    }
}
DI void dn_post_token(const Args& a, unsigned char* ws, int t, int lane) {
    const int c0 = 8 * lane; const size_t o = (size_t)t * 512 + c0;
    float o0[8], o1[8], zz[8], nw[8];
    ld8((const bf16*)(ws + WS_O0) + o, o0); ld8((const bf16*)(ws + WS_O1) + o, o1);
    ld8((const bf16*)(ws + WS_YCAT1) + (size_t)t * D_ + 512 + c0, zz); ld8f(a.in[32] + (c0 & 127), nw);
    float ss = 0.f;
#pragma unroll
    for (int i = 0; i < 8; ++i) { o0[i] += o1[i]; ss += o0[i] * o0[i]; }
    const float rs = 1.0f / sqrtf(grp_sum<16>(ss) * (1.0f / 128.f) + 1e-6f);
#pragma unroll
    for (int i = 0; i < 8; ++i) o0[i] = o0[i] * rs * nw[i] * siluf_(zz[i]);
    st8((bf16*)(ws + WS_YCAT1) + (size_t)t * D_ + 512 + c0, o0);
}
struct TokInfo { int e1, e2, s1, s2; float p1, p2; int pad0, pad1; };
struct RouterRegs { f32x4 r0[16], r1[16]; f32x4 w[4]; };
DI void route_load(const Args& a, RouterRegs& R, int lane) {
#pragma unroll
    for (int j = 0; j < 4; ++j) { R.w[j] = ((const f32x4*)a.in[34])[lane + 64 * j];
#pragma unroll
        for (int i = 0; i < 4; ++i) { const float* rr = a.in[35] + (size_t)(4 * lane + 256 * j + i) * 8; R.r0[4 * j + i] = *(const f32x4*)rr; R.r1[4 * j + i] = *(const f32x4*)(rr + 4); } }
}
constexpr size_t WS_BC = WS_TILE + 4096;
DI int sel8(const int (&v)[8], int e) { int r = 0;
#pragma unroll
    for (int k = 0; k < 8; ++k) r += v[k] & -(int)(e == k);
    return r; }
DI int wave_isum(int v) {
#pragma unroll
    for (int o = 1; o < 64; o <<= 1) v += __shfl_xor(v, o);
    return v; }
DI void route_eval(const RouterRegs& R, const float* x3, int t, int lane, int& e1, int& e2, float& p1, float& p2) {
    f32x4 v[4]; load_row(x3, t, lane, v); const float rs = row_rstd(v);
    float lg[8];
#pragma unroll
    for (int e = 0; e < 8; ++e) lg[e] = 0.f;
#pragma unroll
    for (int j = 0; j < 4; ++j)
#pragma unroll
        for (int i = 0; i < 4; ++i) { const float hv = v[j][i] * rs * R.w[j][i]; const f32x4 r0 = R.r0[4 * j + i], r1 = R.r1[4 * j + i];
            lg[0] += hv * r0.x; lg[1] += hv * r0.y; lg[2] += hv * r0.z; lg[3] += hv * r0.w; lg[4] += hv * r1.x; lg[5] += hv * r1.y; lg[6] += hv * r1.z; lg[7] += hv * r1.w; }
#pragma unroll
    for (int e = 0; e < 8; ++e) lg[e] = wave_sum(lg[e]);
    e1 = 0; float m1 = lg[0];
#pragma unroll
    for (int e = 1; e < 8; ++e) if (lg[e] > m1) { m1 = lg[e]; e1 = e; }
    e2 = -1; float m2 = -3.0e38f;
#pragma unroll
    for (int e = 0; e < 8; ++e) if (e != e1 && lg[e] > m2) { m2 = lg[e]; e2 = e; }
    const float x2 = __expf(m2 - m1); p1 = 1.0f / (1.0f + x2); p2 = x2 / (1.0f + x2);
}
DI void route_group(const RouterRegs& R, unsigned char* ws, const float* x3, LAS int* wc, int tg, int wave, int lane) {
    int cw[8];
#pragma unroll
    for (int e = 0; e < 8; ++e) cw[e] = 0;
    TokInfo* TI = (TokInfo*)(ws + WS_TOK) + (size_t)tg * 64 + wave * 8;
#pragma unroll 1
    for (int i = 0; i < 8; ++i) {
        int e1, e2; float p1, p2; route_eval(R, x3, tg * 64 + wave * 8 + i, lane, e1, e2, p1, p2);
        const int s1 = sel8(cw, e1);
#pragma unroll
        for (int e = 0; e < 8; ++e) cw[e] += (e == e1) ? 1 : 0;
        const int s2 = sel8(cw, e2);
#pragma unroll
        for (int e = 0; e < 8; ++e) cw[e] += (e == e2) ? 1 : 0;
        if (lane == 0) { v4u* rec = (v4u*)(TI + i); rec[0] = (v4u){(unsigned)e1, (unsigned)e2, (unsigned)s1, (unsigned)s2}; rec[1] = (v4u){__float_as_uint(p1), __float_as_uint(p2), 0u, 0u}; }
    }
    if (lane < 8) wc[wave * 8 + lane] = sel8(cw, lane);
    LDS_WAIT(); __syncthreads();
    int wb[8], bc[8];
#pragma unroll
    for (int e = 0; e < 8; ++e) { wb[e] = 0; bc[e] = 0;
#pragma unroll
        for (int w = 0; w < 8; ++w) { const int c = wc[w * 8 + e]; bc[e] += c; wb[e] += (w < wave) ? c : 0; } }
    if (wave == 0 && lane < 8) ((int*)(ws + WS_BC))[tg * 8 + lane] = sel8(bc, lane);
    if (lane < 8) { v4u* rec = (v4u*)(TI + lane); v4u r = rec[0]; r.z += (unsigned)sel8(wb, (int)r.x); r.w += (unsigned)sel8(wb, (int)r.y); rec[0] = r; }
    LDS_WAIT(); __syncthreads();
}
DI void moe_totals(const unsigned char* ws, int lane, int (&tot)[8]) {
    const int* BC = (const int*)(ws + WS_BC); int part[8];
#pragma unroll
    for (int e = 0; e < 8; ++e) part[e] = 0;
#pragma unroll
    for (int k = 0; k < 4; ++k) { const int r = lane + 64 * k;
#pragma unroll
        for (int e = 0; e < 8; ++e) part[e] += __hip_atomic_load(BC + r * 8 + e, __ATOMIC_RELAXED, __HIP_MEMORY_SCOPE_AGENT); }
#pragma unroll
    for (int e = 0; e < 8; ++e) tot[e] = __builtin_amdgcn_readfirstlane(wave_isum(part[e]));
}
DI void moe_offsets(const int (&tot)[8], int (&off)[9]) { int o = 0;
#pragma unroll
    for (int e = 0; e < 8; ++e) { off[e] = o; o += (tot[e] + 255) & ~255; }
    off[8] = o; }
DI void gather_group(const Args& a, unsigned char* ws, const float* x3, const int (&off)[9], int tg, int wave, int lane) {
    const int* BC = (const int*)(ws + WS_BC); int pre[8];
#pragma unroll
    for (int e = 0; e < 8; ++e) pre[e] = 0;
#pragma unroll
    for (int k = 0; k < 4; ++k) { const int r = lane + 64 * k;
#pragma unroll
        for (int e = 0; e < 8; ++e) { const int c = __hip_atomic_load(BC + r * 8 + e, __ATOMIC_RELAXED, __HIP_MEMORY_SCOPE_AGENT); pre[e] += (r < tg) ? c : 0; } }
#pragma unroll
    for (int e = 0; e < 8; ++e) pre[e] = __builtin_amdgcn_readfirstlane(wave_isum(pre[e])) + off[e];
    TokInfo* TI = (TokInfo*)(ws + WS_TOK) + (size_t)tg * 64 + wave * 8;
    bf16* A = (bf16*)(ws + WS_AMOE);
#pragma unroll 1
    for (int i = 0; i < 8; ++i) { const int t = tg * 64 + wave * 8 + i;
        f32x4 v[4]; load_row(x3, t, lane, v); const float rs = row_rstd(v);
#pragma unroll
        for (int j = 0; j < 4; ++j) v[j] = v[j] * rs * ((const f32x4*)a.in[34])[lane + 64 * j];
        v4u* rec = (v4u*)(TI + i); v4u r = rec[0];
        const int r1 = sel8(pre, (int)r.x) + (int)r.z, r2 = sel8(pre, (int)r.y) + (int)r.w;
        store_row_bf16(A + (size_t)r1 * D_, lane, v); store_row_bf16(A + (size_t)r2 * D_, lane, v);
        if (lane == 0) { r.z = (unsigned)r1; r.w = (unsigned)r2; rec[0] = r; }
    }
}
DI void combine_token(unsigned char* ws, float* out, const int (&off)[9], int t, int lane) {
    const v4u* rec = (const v4u*)((const TokInfo*)(ws + WS_TOK) + t); const v4u ra = rec[0], rb = rec[1];
    struct { float p1, p2; } ti; ti.p1 = __uint_as_float(rb.x); ti.p2 = __uint_as_float(rb.y);
    const bf16* A = (const bf16*)(ws + WS_AMOE);
    const unsigned long long* r1 = (const unsigned long long*)(A + (size_t)ra.z * D_) + lane; const unsigned long long* r2 = (const unsigned long long*)(A + (size_t)ra.w * D_) + lane;
    f32x4* xo = (f32x4*)(out + (size_t)t * D_) + lane;
#pragma unroll
    for (int j = 0; j < 4; ++j) { const unsigned long long a1 = r1[64 * j], a2 = r2[64 * j]; f32x4 x = xo[64 * j];
        x.x += ti.p1 * bflo((unsigned)a1) + ti.p2 * bflo((unsigned)a2); x.y += ti.p1 * bfhi((unsigned)a1) + ti.p2 * bfhi((unsigned)a2);
        x.z += ti.p1 * bflo((unsigned)(a1 >> 32)) + ti.p2 * bflo((unsigned)(a2 >> 32)); x.w += ti.p1 * bfhi((unsigned)(a1 >> 32)) + ti.p2 * bfhi((unsigned)(a2 >> 32));
        xo[64 * j] = x; }
}
#ifndef PROBE
#define PROBE 0
#endif
#ifndef PROBE_REP
#define PROBE_REP (-1)
#endif
constexpr int MOE_GU_SPLIT = 16128;
#ifndef PH_MASK
#define PH_MASK 0xFFFFFFFFu
#endif
DI unsigned char* ptr_opaque(unsigned char* p) { GAS unsigned char* g = (GAS unsigned char*)p; asm volatile("" : "+s"(g)); return (unsigned char*)g; }
DI int lane_opaque() { int l; asm volatile("v_mbcnt_lo_u32_b32 %0, -1, 0\n\tv_mbcnt_hi_u32_b32 %0, -1, %0" : "=v"(l)); return l; }
__global__ void __launch_bounds__(512, 2) fwd_kernel(Args args) {
    extern __shared__ __attribute__((aligned(16))) unsigned char lds[];
    LAS unsigned char* L = (LAS unsigned char*)lds;
    volatile LAS unsigned* MISC = (volatile LAS unsigned*)(L + MISC_OFF);
    const int tid = threadIdx.x, lane0 = tid & 63, wave = __builtin_amdgcn_readfirstlane(tid >> 6);
    const int G = gridDim.x, bx = blockIdx.x;
    const int gw = bx * 8 + wave, NGW = G * 8;
    unsigned char* ws0 = args.ws;
    if (tid < 128) ((LAS unsigned*)(L + LDS_ZERO_OFF))[tid] = 0u;
    __syncthreads();
    XcdBarrier bar = xcd_barrier_post((unsigned*)(ws0 + WS_CTL) + CW_BAR, MISC + 8);
    LAS float* scr = (LAS float*)(L + wave * 16384);
#if PROBE
    int tsi = 0;
#define GRID_BAR() do { xcd_barrier(bar, wave == 0); if (bx == 0 && tid == 0) { ((unsigned*)(ws0 + WS_CTL))[512 + tsi] = (unsigned)__builtin_amdgcn_s_memrealtime(); } ++tsi; } while (0)
    if (bx == 0 && tid == 0) ((unsigned*)(ws0 + WS_CTL))[511] = (unsigned)__builtin_amdgcn_s_memrealtime();
#else
#define GRID_BAR() xcd_barrier(bar, wave == 0)
#endif

    if constexpr ((PH_MASK >> 0) & 1) {
    const int lane = lane_opaque(); unsigned char* const ws = ptr_opaque(args.ws);
    {
        const float* const* in = args.in;
        for (int it = gw; ; it += NGW) {
            int r = it;
            if (transpose_job(r, in[3], 1024, 3072, 3072, (bf16*)(ws + WS_WIN0), 0, 0, 0, scr, lane)) continue;
            if (transpose_job(r, in[9], 1024, 64, 64, (bf16*)(ws + WS_WL), 0, 0, 0, scr, lane)) continue;
            if (transpose_job(r, in[9] + 65536, 1024, 64, 64, (bf16*)(ws + WS_WL), 64, 0, 0, scr, lane)) continue;
            if (transpose_job(r, in[12], 1024, 64, 64, (bf16*)(ws + WS_WL), 128, 0, 0, scr, lane)) continue;
            if (transpose_job(r, in[12] + 65536, 1024, 64, 64, (bf16*)(ws + WS_WL), 192, 0, 0, scr, lane)) continue;
            if (transpose_job(r, in[14], 1024, 128, 256, (bf16*)(ws + WS_WL), 256, 0, 0, scr, lane)) continue;
            if (transpose_job(r, in[21], 1024, 1024, 1024, (bf16*)(ws + WS_WOUT0), 0, 0, 0, scr, lane)) continue;
            if (transpose_job(r, in[10], 64, 512, 512, (bf16*)(ws + WS_W2T), 0, 0, 0, scr, lane)) continue;
            if (transpose_job(r, in[10] + 32768, 64, 512, 512, (bf16*)(ws + WS_W2T) + 32768, 0, 0, 0, scr, lane)) continue;
            if (transpose_job(r, in[13], 64, 512, 512, (bf16*)(ws + WS_W2T) + 65536, 0, 0, 0, scr, lane)) continue;
            if (transpose_job(r, in[13] + 32768, 64, 512, 512, (bf16*)(ws + WS_W2T) + 98304, 0, 0, 0, scr, lane)) continue;
            if (transpose_job(r, in[15], 128, 512, 512, (bf16*)(ws + WS_W2T) + 131072, 0, 0, 0, scr, lane)) continue;
            break;
        }
        norm_rows(args.in[0], args.in[2], args.in[7], (bf16*)(ws + WS_H), (bf16*)(ws + WS_HX), gw, NGW, lane);
    }
    if constexpr (PROBE_REP == 0) {
    {
        const float* const* in = args.in;
        for (int it = gw; ; it += NGW) {
            int r = it;
            if (transpose_job(r, in[3], 1024, 3072, 3072, (bf16*)(ws + WS_WIN0), 0, 0, 0, scr, lane)) continue;
            if (transpose_job(r, in[9], 1024, 64, 64, (bf16*)(ws + WS_WL), 0, 0, 0, scr, lane)) continue;
            if (transpose_job(r, in[9] + 65536, 1024, 64, 64, (bf16*)(ws + WS_WL), 64, 0, 0, scr, lane)) continue;
            if (transpose_job(r, in[12], 1024, 64, 64, (bf16*)(ws + WS_WL), 128, 0, 0, scr, lane)) continue;
            if (transpose_job(r, in[12] + 65536, 1024, 64, 64, (bf16*)(ws + WS_WL), 192, 0, 0, scr, lane)) continue;
            if (transpose_job(r, in[14], 1024, 128, 256, (bf16*)(ws + WS_WL), 256, 0, 0, scr, lane)) continue;
            if (transpose_job(r, in[21], 1024, 1024, 1024, (bf16*)(ws + WS_WOUT0), 0, 0, 0, scr, lane)) continue;
            if (transpose_job(r, in[10], 64, 512, 512, (bf16*)(ws + WS_W2T), 0, 0, 0, scr, lane)) continue;
            if (transpose_job(r, in[10] + 32768, 64, 512, 512, (bf16*)(ws + WS_W2T) + 32768, 0, 0, 0, scr, lane)) continue;
            if (transpose_job(r, in[13], 64, 512, 512, (bf16*)(ws + WS_W2T) + 65536, 0, 0, 0, scr, lane)) continue;
            if (transpose_job(r, in[13] + 32768, 64, 512, 512, (bf16*)(ws + WS_W2T) + 98304, 0, 0, 0, scr, lane)) continue;
            if (transpose_job(r, in[15], 128, 512, 512, (bf16*)(ws + WS_W2T) + 131072, 0, 0, 0, scr, lane)) continue;
            break;
        }
        norm_rows(args.in[0], args.in[2], args.in[7], (bf16*)(ws + WS_H), (bf16*)(ws + WS_HX), gw, NGW, lane);
    }
    }
    GRID_BAR();
    }
    if constexpr (PROBE_REP == 50) { for (int i = 0; i < 10; ++i) GRID_BAR(); }
    if constexpr ((PH_MASK >> 1) & 1) {
    const int lane = lane_opaque(); unsigned char* const ws = ptr_opaque(args.ws);
    {
        { pg8::Gemm g{(const bf16*)(ws + WS_H), (const bf16*)(ws + WS_WIN0), S_, EVEN_IN, D_}; pg8::StaticOrder S; S.init(S_, EVEN_IN, G, bx);
          pg8::EpiStoreBf16 E{(bf16*)(ws + WS_PROJ0), EVEN_IN, 0, nullptr}; pg8::gemm_phase<pg8::EpiStoreBf16, pg8::StaticOrder, true, true>(L, g, S, E, wave); }
        { pg8::Gemm g{(const bf16*)(ws + WS_HX), (const bf16*)(ws + WS_WL), S_, LORA_N, D_}; pg8::StaticOrder S; S.init(S_, LORA_N, G, bx);
          pg8::EpiStoreBf16 E{(bf16*)(ws + WS_LORA), LORA_N, 0, nullptr}; pg8::gemm_phase<pg8::EpiStoreBf16, pg8::StaticOrder, true, true>(L, g, S, E, wave); }
        if constexpr (PROBE_REP == 1) {
        { pg8::Gemm g{(const bf16*)(ws + WS_H), (const bf16*)(ws + WS_WIN0), S_, EVEN_IN, D_}; pg8::StaticOrder S; S.init(S_, EVEN_IN, G, bx);
          pg8::EpiStoreBf16 E{(bf16*)(ws + WS_PROJ0), EVEN_IN, 0, nullptr}; pg8::gemm_phase<pg8::EpiStoreBf16, pg8::StaticOrder, true, true>(L, g, S, E, wave); }
        { pg8::Gemm g{(const bf16*)(ws + WS_HX), (const bf16*)(ws + WS_WL), S_, LORA_N, D_}; pg8::StaticOrder S; S.init(S_, LORA_N, G, bx);
          pg8::EpiStoreBf16 E{(bf16*)(ws + WS_LORA), LORA_N, 0, nullptr}; pg8::gemm_phase<pg8::EpiStoreBf16, pg8::StaticOrder, true, true>(L, g, S, E, wave); }
        }
    }
    GRID_BAR();
    }
    if constexpr ((PH_MASK >> 2) & 1) {
    const int lane = lane_opaque(); unsigned char* const ws = ptr_opaque(args.ws);
    for (int t = gw; t < S_; t += NGW) prep0_token(args, ws, scr, t, lane);
    if constexpr (PROBE_REP == 30) { for (int t = gw; t < S_; t += NGW) prep0_token(args, ws, scr, t, lane); }
    }
    if constexpr ((PH_MASK >> 3) & 1) {
    const int lane = lane_opaque(); unsigned char* const ws = ptr_opaque(args.ws);
    {
        const int hh = bx & 7, nbh = (G - hh + 7) >> 3, rank = bx >> 3;
#define STEP_SYNC() do { asm volatile("s_waitcnt vmcnt(0) lgkmcnt(0)" ::: "memory"); __builtin_amdgcn_s_barrier(); asm volatile("" ::: "memory"); } while (0)
        if (wave < 2) {
            for (int kk = -1; rank + nbh * (kk + 1) < 256 + nbh; ++kk) { const int cn = rank + nbh * kk, z = wave;
                if (kk >= 0 && cn < 256) rwkv_pass1_item(ws, L + wave * 65536, z * 2048 + hh * 256 + (z ? 255 - cn : cn), lane); STEP_SYNC(); }
        } else if (wave < 6) {
            for (int kk = -1; rank + nbh * (kk + 1) < 256 + nbh; ++kk) { const int cn1 = rank + nbh * (kk + 1);
                if (cn1 < 256) prep0_rwkv_unit<false>(args, ws, L, 4 * cn1 + (wave - 2), hh, lane); STEP_SYNC(); }
        } else {
            const float* const* in = args.in; LAS float* scr2 = (LAS float*)(L + 131072 + (wave - 6) * 8448);
            for (int kk = -1; rank + nbh * (kk + 1) < 256 + nbh; ++kk) {
                for (int j = 2 * (kk + 1); j < 2 * (kk + 1) + 2; ++j) { int r = bx * 2 + (wave - 6) + j * (G * 2);
                    if (transpose_job(r, in[23], 1024, FF0, FF0, (bf16*)(ws + WS_WGU0), 0, 128, 0, scr2, lane)) continue;
                    if (transpose_job(r, in[24], 1024, FF0, FF0, (bf16*)(ws + WS_WGU0), 0, 128, 1, scr2, lane)) continue;
                    if (transpose_job(r, in[25], FF0, 1024, 1024, (bf16*)(ws + WS_WD0), 0, 0, 0, scr2, lane)) continue;
                    if (transpose_job(r, in[27], 1024, ODD_IN, ODD_PAD, (bf16*)(ws + WS_WIN1), 0, 0, 0, scr2, lane)) continue;
                    if (transpose_job(r, in[33], 1024, 1024, 1024, (bf16*)(ws + WS_WOUT1), 0, 0, 0, scr2, lane)) continue; }
                STEP_SYNC(); }
        }
#undef STEP_SYNC
    }
    GRID_BAR();
    if (bx < 16) { rwkv_pass2_block(ws, L, bx, wave, lane); __syncthreads(); if constexpr (PROBE_REP == 4) { rwkv_pass2_block(ws, L, bx, wave, lane); __syncthreads(); } }
    else { for (int rep_ = 0; rep_ < (PROBE_REP == 3 ? 2 : 1); ++rep_) for (int unit = bx - 16; unit < 512; unit += G - 16) attn_unit(ws, L, unit, wave, lane); }
    GRID_BAR();
    for (int it = gw; it < 2048; it += NGW) rwkv_pass3_post_item(args, ws, it, lane);
    if constexpr (PROBE_REP == 63) { for (int it = gw; it < 2048; it += NGW) rwkv_pass3_post_item(args, ws, it, lane); }
    GRID_BAR();
    }
    if constexpr ((PH_MASK >> 5) & 1) {
    const int lane = lane_opaque(); unsigned char* const ws = ptr_opaque(args.ws);
    { pg8::Gemm g{(const bf16*)(ws + WS_Y), (const bf16*)(ws + WS_WOUT0), S_, D_, D_}; pg8::StaticOrder S; S.init(S_, D_, G, bx);
      pg8::EpiResF32 E{args.in[0], args.out, D_, nullptr, nullptr}; pg8::gemm_phase<pg8::EpiResF32, pg8::StaticOrder, true, true>(L, g, S, E, wave); }
    if constexpr (PROBE_REP == 7) {
    { pg8::Gemm g{(const bf16*)(ws + WS_Y), (const bf16*)(ws + WS_WOUT0), S_, D_, D_}; pg8::StaticOrder S; S.init(S_, D_, G, bx);
      pg8::EpiResF32 E{args.in[0], args.out, D_, nullptr, nullptr}; pg8::gemm_phase<pg8::EpiResF32, pg8::StaticOrder, true, true>(L, g, S, E, wave); }
    }
    GRID_BAR();
    }
    if constexpr ((PH_MASK >> 6) & 1) {
    const int lane = lane_opaque(); unsigned char* const ws = ptr_opaque(args.ws);
    norm_rows(args.out, args.in[22], nullptr, (bf16*)(ws + WS_H2), nullptr, gw, NGW, lane);
    GRID_BAR();
    }
    if constexpr ((PH_MASK >> 7) & 1) {
    const int lane = lane_opaque(); unsigned char* const ws = ptr_opaque(args.ws);
    { pg8::Gemm g{(const bf16*)(ws + WS_H2), (const bf16*)(ws + WS_WGU0), S_, 2 * FF0, D_}; pg8::StaticOrder S; S.init(S_, 2 * FF0, G, bx);
      pg8::EpiSwiGLU E{(bf16*)(ws + WS_ACT0), FF0, 0, nullptr}; pg8::gemm_phase<pg8::EpiSwiGLU, pg8::StaticOrder, true, true>(L, g, S, E, wave); }
    if constexpr (PROBE_REP == 9) {
    { pg8::Gemm g{(const bf16*)(ws + WS_H2), (const bf16*)(ws + WS_WGU0), S_, 2 * FF0, D_}; pg8::StaticOrder S; S.init(S_, 2 * FF0, G, bx);
      pg8::EpiSwiGLU E{(bf16*)(ws + WS_ACT0), FF0, 0, nullptr}; pg8::gemm_phase<pg8::EpiSwiGLU, pg8::StaticOrder, true, true>(L, g, S, E, wave); }
    }
    GRID_BAR();
    }
    if constexpr ((PH_MASK >> 8) & 1) {
    const int lane = lane_opaque(); unsigned char* const ws = ptr_opaque(args.ws);
    { pg8::Gemm g{(const bf16*)(ws + WS_ACT0), (const bf16*)(ws + WS_WD0), S_, D_, FF0}; pg8::StaticOrder S; S.init(S_, D_, G, bx);
      pg8::EpiResF32 E{args.out, args.out, D_, nullptr, nullptr}; pg8::gemm_phase<pg8::EpiResF32, pg8::StaticOrder, true, true>(L, g, S, E, wave); }
    GRID_BAR();
    }
    if constexpr ((PH_MASK >> 9) & 1) {
    const int lane = lane_opaque(); unsigned char* const ws = ptr_opaque(args.ws);
    norm_rows(args.out, args.in[26], nullptr, (bf16*)(ws + WS_H3), nullptr, gw, NGW, lane);
    GRID_BAR();
    }
    if constexpr ((PH_MASK >> 10) & 1) {
    const int lane = lane_opaque(); unsigned char* const ws = ptr_opaque(args.ws);
    { pg8::Gemm g{(const bf16*)(ws + WS_H3), (const bf16*)(ws + WS_WIN1), S_, ODD_PAD, D_}; pg8::StaticOrder S; S.init(S_, ODD_PAD, G, bx);
      pg8::EpiStoreBf16 E{(bf16*)(ws + WS_PROJ1), ODD_PAD, 0, nullptr}; pg8::gemm_phase<pg8::EpiStoreBf16, pg8::StaticOrder, true, true>(L, g, S, E, wave); }
    if constexpr (PROBE_REP == 12) {
    { pg8::Gemm g{(const bf16*)(ws + WS_H3), (const bf16*)(ws + WS_WIN1), S_, ODD_PAD, D_}; pg8::StaticOrder S; S.init(S_, ODD_PAD, G, bx);
      pg8::EpiStoreBf16 E{(bf16*)(ws + WS_PROJ1), ODD_PAD, 0, nullptr}; pg8::gemm_phase<pg8::EpiStoreBf16, pg8::StaticOrder, true, true>(L, g, S, E, wave); }
    }
    GRID_BAR();
    }
    if constexpr ((PH_MASK >> 11) & 1) {
    const int lane = lane_opaque(); unsigned char* const ws = ptr_opaque(args.ws);
    for (int cn = bx; cn < 256; cn += G) for (int i = wave; i < 64; i += 8) prep1_token(args, ws, cn * 64 + i, lane);
    GRID_BAR();
    }
    if constexpr ((PH_MASK >> 12) & 1) {
    const int lane = lane_opaque(); unsigned char* const ws = ptr_opaque(args.ws);
    {
        if (wave < 4) { const int z = wave & 1;
            for (int cn = bx; cn < 256; cn += G) for (int hh = (wave >> 1) * 2; hh < (wave >> 1) * 2 + 2; ++hh) dn_pass1_item(ws, L + wave * DN_LDS_PER_WAVE, (z * 4 + hh) * 256 + (z ? 255 - cn : cn), lane); }
        else if (wave < 7) {
            LAS float* scr2 = (LAS float*)(L + 4 * DN_LDS_PER_WAVE + (wave - 4) * 8448);
            moe_copy_loop<true>(args, ws, scr2, bx * 3 + (wave - 4), G * 3, MOE_GU_SPLIT, lane);
        }
    }
    GRID_BAR();
    { const int task = bx; if (task < 512) dn_scan_block(ws, L, task >> 8, (task & 3) < 2 ? 1 : 2, (task >> 6) & 3, task & 1, (task >> 2) & 15, wave, lane); __syncthreads(); }
    { const int task = bx + G; if (task < 512) dn_scan_block(ws, L, task >> 8, (task & 3) < 2 ? 1 : 2, (task >> 6) & 3, task & 1, (task >> 2) & 15, wave, lane); __syncthreads(); }
    if constexpr (PROBE_REP == 60) { { const int task = bx; if (task < 512) dn_scan_block(ws, L, task >> 8, (task & 3) < 2 ? 1 : 2, (task >> 6) & 3, task & 1, (task >> 2) & 15, wave, lane); __syncthreads(); }
      { const int task = bx + G; if (task < 512) dn_scan_block(ws, L, task >> 8, (task & 3) < 2 ? 1 : 2, (task >> 6) & 3, task & 1, (task >> 2) & 15, wave, lane); __syncthreads(); } }
    GRID_BAR();
    if (bx < 64) { if (wave == 0) dn_scan_groups(ws, bx, lane); }
    else {
        moe_copy_loop<true>(args, ws, scr, MOE_GU_SPLIT + (bx - 64) * 8 + wave, (G - 64) * 8, 28672, lane);
    }
    if constexpr (PROBE_REP == 61) { if (bx < 64) { if (wave == 0) dn_scan_groups(ws, bx, lane); } }
    GRID_BAR();
    { const int task = bx; if (task < 256) dn_scan_block(ws, L, task >> 7, 0, (task >> 5) & 3, (task >> 4) & 1, task & 15, wave, lane); __syncthreads(); }
    if constexpr (PROBE_REP == 62) { const int task = bx; if (task < 256) dn_scan_block(ws, L, task >> 7, 0, (task >> 5) & 3, (task >> 4) & 1, task & 15, wave, lane); __syncthreads(); }
    GRID_BAR();
for (int rep_ = 0; rep_ < (PROBE_REP == 16 ? 2 : 1); ++rep_) {     for (int it = gw; it < 2048; it += NGW) dn_pass3_item(ws, it, lane); }
    GRID_BAR();
    }
    if constexpr ((PH_MASK >> 13) & 1) {
    const int lane = lane_opaque(); unsigned char* const ws = ptr_opaque(args.ws);
    for (int t = gw; t < S_; t += NGW) dn_post_token(args, ws, t, lane);
    moe_copy_loop<false>(args, ws, scr, gw, NGW, 14336, lane);
    GRID_BAR();
    }
    if constexpr ((PH_MASK >> 14) & 1) {
    const int lane = lane_opaque(); unsigned char* const ws = ptr_opaque(args.ws);
    { pg8::Gemm g{(const bf16*)(ws + WS_YCAT1), (const bf16*)(ws + WS_WOUT1), S_, D_, D_}; pg8::StaticOrder S; S.init(S_, D_, G, bx);
      pg8::EpiResF32 E{args.out, args.out, D_, nullptr, nullptr}; pg8::gemm_phase<pg8::EpiResF32, pg8::StaticOrder, true, true>(L, g, S, E, wave); }
    GRID_BAR();
    }
    if constexpr ((PH_MASK >> 15) & 1) {
    const int lane = lane_opaque(); unsigned char* const ws = ptr_opaque(args.ws);
    { RouterRegs RR; route_load(args, RR, lane); for (int tg = bx; tg < 256; tg += G) route_group(RR, ws, args.out, (LAS int*)L, tg, wave, lane); }
    GRID_BAR();
    }
    int tot[8], off[9]; moe_totals(ws0, lane_opaque(), tot); moe_offsets(tot, off);
    const int ntiles = off[8] >> 8;
    if constexpr ((PH_MASK >> 16) & 1) {
    const int lane = lane_opaque(); unsigned char* const ws = ptr_opaque(args.ws);
    {
        for (int tg = bx; tg < 256; tg += G) gather_group(args, ws, args.out, off, tg, wave, lane);
        const int tid2 = wave * 64 + lane;
        if (bx == 0 && tid2 < 160) { int e = 0;
#pragma unroll
            for (int k = 1; k < 8; ++k) if (tid2 * 256 >= off[k]) e = k;
            ((int*)(ws + WS_TILE))[tid2] = e; }
#pragma unroll
        for (int e = 0; e < NEXP; ++e) { const int r0 = off[e] + tot[e], r1 = off[e + 1];
            for (int rr = r0 + gw; rr < r1; rr += NGW) { unsigned long long* o8 = (unsigned long long*)((bf16*)(ws + WS_AMOE) + (size_t)rr * D_) + lane;
#pragma unroll
                for (int j = 0; j < 4; ++j) o8[64 * j] = 0ull; } }
    }
    if constexpr (PROBE_REP == 20) {
    {
        for (int tg = bx; tg < 256; tg += G) gather_group(args, ws, args.out, off, tg, wave, lane);
        const int tid2 = wave * 64 + lane;
        if (bx == 0 && tid2 < 160) { int e = 0;
#pragma unroll
            for (int k = 1; k < 8; ++k) if (tid2 * 256 >= off[k]) e = k;
            ((int*)(ws + WS_TILE))[tid2] = e; }
#pragma unroll
        for (int e = 0; e < NEXP; ++e) { const int r0 = off[e] + tot[e], r1 = off[e + 1];
            for (int rr = r0 + gw; rr < r1; rr += NGW) { unsigned long long* o8 = (unsigned long long*)((bf16*)(ws + WS_AMOE) + (size_t)rr * D_) + lane;
#pragma unroll
                for (int j = 0; j < 4; ++j) o8[64 * j] = 0ull; } }
    }
    }
    GRID_BAR();
    }
    if constexpr ((PH_MASK >> 17) & 1) {
    const int lane = lane_opaque(); unsigned char* const ws = ptr_opaque(args.ws);
    for (int b = 0; b < 3; ++b) {
        const int tlo = b * MOE_BATCH_TILES; int nt = ntiles - tlo; nt = nt < 0 ? 0 : (nt > MOE_BATCH_TILES ? MOE_BATCH_TILES : nt);
        { pg8::Gemm g{(const bf16*)(ws + WS_AMOE), (const bf16*)(ws + WS_WMGU), MOE_ROWS, NEXP * 2 * FFE, D_};
          pg8::MoeOrder S{(const int*)(ws + WS_TILE), tlo, nt, 2 * FFE / 256, G, bx};
          pg8::EpiSwiGLU E{(bf16*)(ws + WS_MACT) - (size_t)tlo * 256 * FFE, FFE, 2 * FFE / 256, nullptr};
          pg8::gemm_phase<pg8::EpiSwiGLU, pg8::MoeOrder, true, true>(L, g, S, E, wave); }
        if constexpr (PROBE_REP == 21) {
        { pg8::Gemm g{(const bf16*)(ws + WS_AMOE), (const bf16*)(ws + WS_WMGU), MOE_ROWS, NEXP * 2 * FFE, D_};
          pg8::MoeOrder S{(const int*)(ws + WS_TILE), tlo, nt, 2 * FFE / 256, G, bx};
          pg8::EpiSwiGLU E{(bf16*)(ws + WS_MACT) - (size_t)tlo * 256 * FFE, FFE, 2 * FFE / 256, nullptr};
          pg8::gemm_phase<pg8::EpiSwiGLU, pg8::MoeOrder, true, true>(L, g, S, E, wave); }
        }
        GRID_BAR();
        { pg8::Gemm g{(const bf16*)(ws + WS_MACT) - (size_t)tlo * 256 * FFE, (const bf16*)(ws + WS_WMD), MOE_ROWS, NEXP * D_, FFE};
          pg8::MoeOrder S{(const int*)(ws + WS_TILE), tlo, nt, D_ / 256, G, bx};
          pg8::EpiStoreBf16 E{(bf16*)(ws + WS_AMOE), D_, D_ / 256, nullptr};
          pg8::gemm_phase<pg8::EpiStoreBf16, pg8::MoeOrder, true, true>(L, g, S, E, wave); }
        if constexpr (PROBE_REP == 22) {
        { pg8::Gemm g{(const bf16*)(ws + WS_MACT) - (size_t)tlo * 256 * FFE, (const bf16*)(ws + WS_WMD), MOE_ROWS, NEXP * D_, FFE};
          pg8::MoeOrder S{(const int*)(ws + WS_TILE), tlo, nt, D_ / 256, G, bx};
          pg8::EpiStoreBf16 E{(bf16*)(ws + WS_AMOE), D_, D_ / 256, nullptr};
          pg8::gemm_phase<pg8::EpiStoreBf16, pg8::MoeOrder, true, true>(L, g, S, E, wave); }
        }
        GRID_BAR();
    }
    }
    if constexpr ((PH_MASK >> 18) & 1) {
    const int lane = lane_opaque(); unsigned char* const ws = ptr_opaque(args.ws);
    for (int t = gw; t < S_; t += NGW) combine_token(ws, args.out, off, t, lane);
#if PROBE
    {
        const unsigned* ts = (const unsigned*)(ws + WS_CTL) + 512;
        const unsigned dA = PROBE_A < 0 ? 32000u : (__hip_atomic_load(ts + PROBE_A, __ATOMIC_RELAXED, __HIP_MEMORY_SCOPE_AGENT) - __hip_atomic_load(ts + PROBE_A - 1, __ATOMIC_RELAXED, __HIP_MEMORY_SCOPE_AGENT));
        const unsigned dB = __hip_atomic_load(ts + PROBE_B, __ATOMIC_RELAXED, __HIP_MEMORY_SCOPE_AGENT) - __hip_atomic_load(ts + PROBE_B - 1, __ATOMIC_RELAXED, __HIP_MEMORY_SCOPE_AGENT);
        const int rows = 8 * (int)(dA / 3200u) + 64;
        const float addB = 4.0f * (float)(dB / 3200u) + 8.0f;
        for (int t = gw; t < S_; t += NGW) {
            if (t < rows) { f32x4* xo = (f32x4*)(args.out + (size_t)t * D_) + lane;
#pragma unroll
                for (int j = 0; j < 4; ++j) xo[64 * j] = xo[64 * j] + 5.0f; }
            if (t == S_ - 1 && lane == 63) args.out[(size_t)t * D_ + 1023] += addB;
        }
    }
#endif
    }
}

extern "C" void kernel_launch(void* const* d_in, const int* in_sizes, int n_in, void* d_out, int out_size, void* d_ws, size_t ws_size, hipStream_t stream) {
    static int grid = 0;
    if (grid == 0) {
        if (n_in != 39 || out_size != S_ * D_ || ws_size < WS_END) { fprintf(stderr, "kernel_launch: unexpected shapes (n_in %d out %d ws %zu)\n", n_in, out_size, ws_size); grid = -1; return; }
        int dev = 0, cus = 0, per_cu = 0;
        if (hipGetDevice(&dev) != hipSuccess || hipDeviceGetAttribute(&cus, hipDeviceAttributeMultiprocessorCount, dev) != hipSuccess) { grid = -1; return; }
        if (hipFuncSetAttribute((const void*)fwd_kernel, hipFuncAttributeMaxDynamicSharedMemorySize, LDS_BYTES) != hipSuccess) { grid = -1; return; }
        if (hipOccupancyMaxActiveBlocksPerMultiprocessor(&per_cu, (const void*)fwd_kernel, 512, LDS_BYTES) != hipSuccess || per_cu < 1) { fprintf(stderr, "kernel_launch: occupancy query says %d\n", per_cu); }
        (void)hipGetLastError();
        if (cus < 256) { fprintf(stderr, "kernel_launch: this build needs >= 256 CUs (task slots of the delta-net scan); got %d\n", cus); grid = -1; return; }
        grid = 256;
    }
    if (grid < 0) return;
    if (hipMemsetAsync((char*)d_ws + WS_CTL, 0, CTL_ZERO_BYTES, stream) != hipSuccess) return;
    Args a{};
    for (int i = 0; i < 39; ++i) a.in[i] = (const float*)d_in[i];
    a.out = (float*)d_out; a.ws = (unsigned char*)d_ws;
    hipLaunchKernelGGL(fwd_kernel, dim3(grid), dim3(512), LDS_BYTES, stream, a);
}
```

```cpp
#include <hip/hip_runtime.h>
#include <cstdio>
#include <cstdint>
namespace pg8 {
#define PG8_LAS __attribute__((address_space(3)))
typedef unsigned short bf16_t;
typedef short bf16x8 __attribute__((ext_vector_type(8)));
typedef float f32x4 __attribute__((ext_vector_type(4)));
typedef unsigned u32x4 __attribute__((ext_vector_type(4)));
typedef int i32x8 __attribute__((ext_vector_type(8)));
typedef unsigned u32x2 __attribute__((ext_vector_type(2)));
constexpr int BM = 256, BK = 64, HALF = 128, HTB = HALF * BK * 2  , STAGE_BYTES = 8 * HTB, NXCD = 8, WGM = 8;

__host__ __device__ __forceinline__ int lds_byte(int r, int c) { const int st = (r >> 4) * 2 + (c >> 5), rr = r & 15, cc = c & 31, ob = rr * 64 + cc * 2; return st * 1024 + (ob ^ (((ob >> 9) & 1) << 5)); }
__host__ __device__ __forceinline__ void stage_rc(int b, int& R, int& C) { const int st = b / 1024, sb = b % 1024, swz = sb ^ (((sb >> 9) & 1) << 5); R = (st >> 1) * 16 + swz / 64; C = (st & 1) * 32 + (swz % 64) / 2; }
__host__ __device__ __forceinline__ int perm32(int rho) { const int n = rho >> 4, i = rho & 15; return 8 * (i >> 2) + 4 * n + (i & 3); }

struct Unit { int pm, pn; };
struct Gemm { const bf16_t* A; const bf16_t* Bt; int M, N, K; };

struct StaticOrder {
    int nM, nN, nwg, G, c;
    __host__ __device__ void init(int M, int N, int G_, int c_) { nM = M / BM; nN = N / BM; nwg = nM * nN; G = G_; c = c_; }
    __host__ __device__ bool next(int i, Unit& u) const {
        const long L = (long)i * G + c; if (L >= nwg) return false;
        int wgid = (int)L; { const int q = nwg / NXCD, r = nwg % NXCD, xcd = wgid % NXCD, off = wgid / NXCD; wgid = (xcd < r ? xcd * (q + 1) : r * (q + 1) + (xcd - r) * q) + off; }
        const int nig = WGM * nN, gid = wgid / nig, fm = gid * WGM, gsz = (nM - fm) < WGM ? (nM - fm) : WGM;
        u.pm = fm + ((wgid % nig) % gsz); u.pn = (wgid % nig) / gsz; return true;
    }
    __device__ __forceinline__ void a_ready(const Unit&) const {}
    __device__ __forceinline__ void done(const Unit&) const {}
};

__device__ __forceinline__ unsigned cvt_pk_bf16(float lo, float hi) { unsigned r; asm volatile("v_cvt_pk_bf16_f32 %0, %1, %2" : "=v"(r) : "v"(lo), "v"(hi)); return r; }
struct EpiStoreBf16 {
    static constexpr bool PERM = true, AFTER_DRAIN = false;
    bf16_t* O; int ldc; int ntn; const float* rowss;
    float scale = 1.0f;
    __device__ __forceinline__ void operator()(const f32x4 (&acc)[2][2][4][2], const Unit& u, int wr, int wc, int fr, int fq) const {
        const int row0 = u.pm * BM + wr * 64 + fr; const int pn = ntn ? (u.pn % ntn) : u.pn;
        const int col0 = pn * BM + wc * 32 + 8 * fq;
#pragma unroll
        for (int ai = 0; ai < 2; ++ai)
#pragma unroll
            for (int m = 0; m < 4; ++m) { bf16_t* rowp = O + (size_t)(row0 + ai * HALF + m * 16) * ldc + col0;
                float rs = scale; if (rowss) { const f32x4* sp = (const f32x4*)(rowss + (size_t)(row0 + ai * HALF + m * 16) * 16); const f32x4 s0 = sp[0], s1 = sp[1], s2 = sp[2], s3 = sp[3]; const f32x4 st = (s0 + s1) + (s2 + s3); rs *= 1.0f / sqrtf(((st[0] + st[1]) + (st[2] + st[3])) * (1.0f / 1024.f) + 1e-6f); }
#pragma unroll
                for (int bj = 0; bj < 2; ++bj) { const f32x4 v0 = acc[ai][bj][m][0] * rs, v1 = acc[ai][bj][m][1] * rs;
                    u32x4 w; w.x = cvt_pk_bf16(v0[0], v0[1]); w.y = cvt_pk_bf16(v0[2], v0[3]); w.z = cvt_pk_bf16(v1[0], v1[1]); w.w = cvt_pk_bf16(v1[2], v1[3]);
                    *(u32x4*)(rowp + bj * HALF) = w; } }
    }
};
struct EpiResF32 {
    static constexpr bool PERM = false, AFTER_DRAIN = false;
    const float* base; float* out; int ldc; bf16_t* xb; float* rowss;
    __device__ __forceinline__ void operator()(const f32x4 (&acc)[2][2][4][2], const Unit& u, int wr, int wc, int fr, int fq) const {
        const int row0 = u.pm * BM + wr * 64 + fr, col0 = u.pn * BM + wc * 32 + 4 * fq;
#pragma unroll
        for (int ai = 0; ai < 2; ++ai)
#pragma unroll
            for (int m = 0; m < 4; ++m) { const size_t off = (size_t)(row0 + ai * HALF + m * 16) * ldc + col0; float ss = 0.f;
#pragma unroll
                for (int bj = 0; bj < 2; ++bj)
#pragma unroll
                    for (int n = 0; n < 2; ++n) { const f32x4 b = *(const f32x4*)(base + off + bj * HALF + n * 16); const f32x4 o = b + acc[ai][bj][m][n]; *(f32x4*)(out + off + bj * HALF + n * 16) = o;
                        if (xb) { ss += (o[0] * o[0] + o[1] * o[1]) + (o[2] * o[2] + o[3] * o[3]);
                            unsigned long long w = (unsigned long long)cvt_pk_bf16(o[0], o[1]) | ((unsigned long long)cvt_pk_bf16(o[2], o[3]) << 32); *(unsigned long long*)(xb + off + bj * HALF + n * 16) = w; } }
                if (xb) { ss += __shfl_xor(ss, 16); ss += __shfl_xor(ss, 32); if (fq == 0) rowss[(size_t)(row0 + ai * HALF + m * 16) * 16 + u.pn * 4 + wc] = ss; } }
    }
};
struct EpiSwiGLU {
    static constexpr bool PERM = true, AFTER_DRAIN = false;
    bf16_t* O; int ldc; int ntn; const float* rowss;
    __device__ __forceinline__ void operator()(const f32x4 (&acc)[2][2][4][2], const Unit& u, int wr, int wc, int fr, int fq) const {
        const int row0 = u.pm * BM + wr * 64 + fr; const int pn = ntn ? (u.pn % ntn) : u.pn;
        const int col0 = pn * HALF + wc * 32 + 8 * fq;
#pragma unroll
        for (int ai = 0; ai < 2; ++ai)
#pragma unroll
            for (int m = 0; m < 4; ++m) { bf16_t* rowp = O + (size_t)(row0 + ai * HALF + m * 16) * ldc + col0;
                float rs = 1.0f; if (rowss) { const f32x4* sp = (const f32x4*)(rowss + (size_t)(row0 + ai * HALF + m * 16) * 16); const f32x4 s0 = sp[0], s1 = sp[1], s2 = sp[2], s3 = sp[3]; const f32x4 st = (s0 + s1) + (s2 + s3); rs = 1.0f / sqrtf(((st[0] + st[1]) + (st[2] + st[3])) * (1.0f / 1024.f) + 1e-6f); }
                float r[8];
#pragma unroll
                for (int n = 0; n < 2; ++n)
#pragma unroll
                    for (int i = 0; i < 4; ++i) { const float g = acc[ai][0][m][n][i] * rs, up = acc[ai][1][m][n][i] * rs; r[n * 4 + i] = g * __builtin_amdgcn_rcpf(1.0f + __expf(-g)) * up; }
                u32x4 w; w.x = cvt_pk_bf16(r[0], r[1]); w.y = cvt_pk_bf16(r[2], r[3]); w.z = cvt_pk_bf16(r[4], r[5]); w.w = cvt_pk_bf16(r[6], r[7]);
                *(u32x4*)rowp = w; }
    }
};
__device__ __forceinline__ unsigned cvt_pk4_fp8(float a, float b, float c, float d) { int w = __builtin_amdgcn_cvt_pk_fp8_f32(a, b, 0, false); w = __builtin_amdgcn_cvt_pk_fp8_f32(c, d, w, true); return (unsigned)w; }
struct EpiSwiGLU8 {
    static constexpr bool PERM = true, AFTER_DRAIN = false;
    unsigned char* O; int ldc; int ntn; float scale;
    __device__ __forceinline__ void operator()(const f32x4 (&acc)[2][2][4][2], const Unit& u, int wr, int wc, int fr, int fq) const {
        const int row0 = u.pm * BM + wr * 64 + fr; const int pn = ntn ? (u.pn % ntn) : u.pn;
        const int col0 = pn * HALF + wc * 32 + 8 * fq;
#pragma unroll
        for (int ai = 0; ai < 2; ++ai)
#pragma unroll
            for (int m = 0; m < 4; ++m) { unsigned char* rowp = O + (size_t)(row0 + ai * HALF + m * 16) * ldc + col0;
                float r[8];
#pragma unroll
                for (int n = 0; n < 2; ++n)
#pragma unroll
                    for (int i = 0; i < 4; ++i) { const float g = acc[ai][0][m][n][i] * scale, up = acc[ai][1][m][n][i] * scale; r[n * 4 + i] = g * __builtin_amdgcn_rcpf(1.0f + __expf(-g)) * up; }
                u32x2 w; w.x = cvt_pk4_fp8(r[0], r[1], r[2], r[3]); w.y = cvt_pk4_fp8(r[4], r[5], r[6], r[7]);
                *(u32x2*)rowp = w; }
    }
};
struct MoeOrder {
    const int* tile_exp; int tlo, nt, nN, G, c;
    __device__ __forceinline__ bool next(int i, Unit& u) const {
        const int L = i * G + c; if (nt <= 0 || L >= nt * nN) return false;
        const int t = tlo + (L % nt), cn = L / nt;
        const int e = __builtin_amdgcn_readfirstlane(__hip_atomic_load(tile_exp + t, __ATOMIC_RELAXED, __HIP_MEMORY_SCOPE_AGENT));
        u.pm = t; u.pn = e * nN + cn; return true;
    }
    __device__ __forceinline__ void a_ready(const Unit&) const {}
    __device__ __forceinline__ void done(const Unit&) const {}
};
template <class Epi, class Sched, bool ALIGN_EPI = false, bool SP2 = false, bool F8 = false>
__device__ __forceinline__ void gemm_phase(PG8_LAS unsigned char* lds, const Gemm g, const Sched& S, const Epi& E, const int wave_id) {
    int tid_; asm volatile("v_mbcnt_lo_u32_b32 %0, -1, 0\n\tv_mbcnt_hi_u32_b32 %0, -1, %0" : "=v"(tid_)); tid_ += wave_id * 64;
    const int tid = tid_, wid = __builtin_amdgcn_readfirstlane(tid >> 6), lane = tid & 63, wr = wid >> 2, wc = wid & 3, fr = lane & 15, fq = lane >> 4;
    const int K = g.K, nt = K / BK;
    unsigned voffA[2], voffB[2];
#pragma unroll
    for (int i = 0; i < 2; ++i) { int R, C; stage_rc(tid * 16 + i * 8192, R, C); const int Rb = Epi::PERM ? ((R & ~31) + perm32(R & 31)) : R;
        voffA[i] = (unsigned)(R * K + C) * 2u; voffB[i] = (unsigned)(Rb * K + C) * 2u; }
    const size_t kstep = (size_t)(BK * 2);
    const size_t hstep = (size_t)HALF * K * 2;
    const size_t tstep = 2 * hstep;
    const unsigned ldsw = (unsigned)wid * 1024u;
    const int aoff = lds_byte(wr * 64 + fr, fq * 8), boff = lds_byte(wc * 32 + fr, fq * 8);
#define PG8_SA(b, h) (((b) * 2 + (h)) * HTB)
#define PG8_SB(b, h) ((4 + (b) * 2 + (h)) * HTB)
#define PG8_STAGE(bufoff, gbase, voff) do { _Pragma("unroll") for (int _i = 0; _i < 2; ++_i) \
        __builtin_amdgcn_global_load_lds((const unsigned*)((const char*)(gbase) + (voff)[_i]), (PG8_LAS unsigned*)(lds + (bufoff) + ldsw + _i * 8192), 16, 0, 0); } while (0)
#define PG8_LDA(dst, b, h) do { _Pragma("unroll") for (int m = 0; m < 4; ++m) _Pragma("unroll") for (int k = 0; k < 2; ++k) dst[m][k] = *(const PG8_LAS bf16x8*)(lds + PG8_SA(b, h) + aoff + m * 2048 + k * 1024); } while (0)
#define PG8_LDB(dst, b, h) do { _Pragma("unroll") for (int n = 0; n < 2; ++n) _Pragma("unroll") for (int k = 0; k < 2; ++k) dst[n][k] = *(const PG8_LAS bf16x8*)(lds + PG8_SB(b, h) + boff + n * 2048 + k * 1024); } while (0)
#define PG8_CAT(x) __builtin_bit_cast(i32x8, __builtin_shufflevector((x)[0], (x)[1], 0, 1, 2, 3, 4, 5, 6, 7, 8, 9, 10, 11, 12, 13, 14, 15))
#define PG8_MMA(ai, bj, At, Bt) do { __builtin_amdgcn_s_setprio(1); _Pragma("unroll") for (int m = 0; m < 4; ++m) _Pragma("unroll") for (int n = 0; n < 2; ++n) { \
        if constexpr (F8) asm volatile("v_mfma_f32_16x16x128_f8f6f4 %0, %1, %2, %0" : "+v"(acc[ai][bj][m][n]) : "v"(PG8_CAT(Bt[n])), "v"(PG8_CAT(At[m])));   \
        else { _Pragma("unroll") for (int k = 0; k < 2; ++k) acc[ai][bj][m][n] = __builtin_amdgcn_mfma_f32_16x16x32_bf16(Bt[n][k], At[m][k], acc[ai][bj][m][n], 0, 0, 0); } } \
        __builtin_amdgcn_s_setprio(0); } while (0)
#define PG8_WAIT_V(n) asm volatile("s_waitcnt vmcnt(" #n ")" ::: "memory")
#define PG8_WAIT_L(n) asm volatile("s_waitcnt lgkmcnt(" #n ")" ::: "memory")
#define PG8_BAR __builtin_amdgcn_s_barrier()
#define PG8_SCHED __builtin_amdgcn_sched_barrier(0)
    Unit cur, nxt; int ui = 0;
    if (!S.next(0, cur)) return;
    f32x4 acc[2][2][4][2];
#pragma unroll
    for (int a = 0; a < 2; ++a)
#pragma unroll
        for (int b = 0; b < 2; ++b)
#pragma unroll
            for (int m = 0; m < 4; ++m)
#pragma unroll
                for (int n = 0; n < 2; ++n) acc[a][b][m][n] = (f32x4){0.f, 0.f, 0.f, 0.f};
    bf16x8 At[4][2], B0[2][2], B1[2][2];
    const char* cA = (const char*)g.A + (size_t)cur.pm * tstep; const char* cB = (const char*)g.Bt + (size_t)cur.pn * tstep;
    S.a_ready(cur);
    if constexpr (SP2) {
        PG8_STAGE(PG8_SB(0, 0), cB, voffB); PG8_STAGE(PG8_SB(0, 1), cB + hstep, voffB); PG8_STAGE(PG8_SA(0, 0), cA, voffA); PG8_STAGE(PG8_SA(0, 1), cA + hstep, voffA);
        if (wr == 1) PG8_BAR;
        PG8_WAIT_V(2); PG8_BAR;
        PG8_STAGE(PG8_SB(1, 0), cB + kstep, voffB); PG8_STAGE(PG8_SA(1, 0), cA + kstep, voffA); PG8_STAGE(PG8_SB(1, 1), cB + hstep + kstep, voffB);
        PG8_WAIT_V(6); PG8_BAR;
    } else {
        PG8_STAGE(PG8_SB(0, 0), cB, voffB); PG8_STAGE(PG8_SA(0, 0), cA, voffA); PG8_STAGE(PG8_SB(0, 1), cB + hstep, voffB); PG8_STAGE(PG8_SA(0, 1), cA + hstep, voffA);
        if (wr == 1) PG8_BAR;
        PG8_WAIT_V(4); PG8_BAR;
        PG8_STAGE(PG8_SB(1, 0), cB + kstep, voffB); PG8_STAGE(PG8_SA(1, 0), cA + kstep, voffA); PG8_STAGE(PG8_SB(1, 1), cB + hstep + kstep, voffB);
        PG8_WAIT_V(6); PG8_BAR;
    }
    for (;;) {
        const bool has_next = S.next(ui + 1, nxt);
        const char* nA = has_next ? (const char*)g.A + (size_t)nxt.pm * tstep : cA; const char* nB = has_next ? (const char*)g.Bt + (size_t)nxt.pn * tstep : cB;
        for (int t = 0; t < nt; t += 2) {
            const bool last = (t == nt - 2);
            const char* a1 = cA + (size_t)(t + 1) * kstep;
            const char* a2 = last ? nA : cA + (size_t)(t + 2) * kstep; const char* b2 = last ? nB : cB + (size_t)(t + 2) * kstep;
            const char* a3 = a2 + kstep; const char* b3 = b2 + kstep;
            if (last && has_next) S.a_ready(nxt);
            if constexpr (SP2) {
            PG8_LDB(B0, 0, 0); PG8_LDB(B1, 0, 1); PG8_SCHED; PG8_LDA(At, 0, 0); PG8_STAGE(PG8_SA(1, 1), a1 + hstep, voffA);
            PG8_WAIT_V(8); PG8_WAIT_L(0); PG8_BAR; PG8_MMA(0, 0, At, B0); PG8_MMA(0, 1, At, B1); PG8_BAR; PG8_SCHED;
            PG8_LDA(At, 0, 1); PG8_STAGE(PG8_SB(0, 0), b2, voffB); PG8_STAGE(PG8_SB(0, 1), b2 + hstep, voffB); PG8_STAGE(PG8_SA(0, 0), a2, voffA);
            PG8_WAIT_V(8); PG8_WAIT_L(0); PG8_BAR; PG8_MMA(1, 0, At, B0); PG8_MMA(1, 1, At, B1); PG8_BAR; PG8_SCHED;
            PG8_LDB(B0, 1, 0); PG8_LDB(B1, 1, 1); PG8_SCHED; PG8_LDA(At, 1, 0); PG8_STAGE(PG8_SA(0, 1), a2 + hstep, voffA);
            PG8_WAIT_V(8); PG8_WAIT_L(0); PG8_BAR; PG8_MMA(0, 0, At, B0); PG8_MMA(0, 1, At, B1); PG8_BAR; PG8_SCHED;
            PG8_LDA(At, 1, 1); PG8_STAGE(PG8_SB(1, 0), b3, voffB); PG8_STAGE(PG8_SB(1, 1), b3 + hstep, voffB); PG8_STAGE(PG8_SA(1, 0), a3, voffA);
            PG8_WAIT_V(8); PG8_WAIT_L(0); PG8_BAR; PG8_MMA(1, 0, At, B0); PG8_MMA(1, 1, At, B1); PG8_BAR; PG8_SCHED;
            } else {
            PG8_LDB(B0, 0, 0); PG8_SCHED; PG8_LDA(At, 0, 0); PG8_STAGE(PG8_SA(1, 1), a1 + hstep, voffA);
            PG8_WAIT_L(8); PG8_BAR; PG8_WAIT_L(0); PG8_MMA(0, 0, At, B0); PG8_BAR; PG8_SCHED;
            PG8_LDB(B1, 0, 1); PG8_STAGE(PG8_SB(0, 0), b2, voffB);
            PG8_BAR; PG8_WAIT_L(0); PG8_MMA(0, 1, At, B1); PG8_BAR;
            PG8_LDA(At, 0, 1); PG8_STAGE(PG8_SA(0, 0), a2, voffA);
            PG8_BAR; PG8_WAIT_L(0); PG8_MMA(1, 0, At, B0); PG8_BAR; PG8_SCHED;
            PG8_STAGE(PG8_SB(0, 1), b2 + hstep, voffB);
            PG8_WAIT_V(6); PG8_BAR; PG8_MMA(1, 1, At, B1); PG8_BAR;
            PG8_LDB(B0, 1, 0); PG8_SCHED; PG8_LDA(At, 1, 0); PG8_STAGE(PG8_SA(0, 1), a2 + hstep, voffA);
            PG8_WAIT_L(8); PG8_BAR; PG8_WAIT_L(0); PG8_MMA(0, 0, At, B0); PG8_BAR; PG8_SCHED;
            PG8_LDB(B1, 1, 1); PG8_STAGE(PG8_SB(1, 0), b3, voffB);
            PG8_BAR; PG8_WAIT_L(0); PG8_MMA(0, 1, At, B1); PG8_BAR;
            PG8_LDA(At, 1, 1); PG8_STAGE(PG8_SA(1, 0), a3, voffA);
            PG8_BAR; PG8_WAIT_L(0); PG8_MMA(1, 0, At, B0); PG8_BAR; PG8_SCHED;
            PG8_STAGE(PG8_SB(1, 1), b3 + hstep, voffB);
            PG8_WAIT_V(6); PG8_BAR; PG8_MMA(1, 1, At, B1); PG8_BAR;
            }
        }
        if constexpr (ALIGN_EPI) { if (wr == 0) PG8_BAR; }
        if constexpr (F8) { asm volatile("s_nop 15\n\ts_nop 15" ::: "memory"); PG8_SCHED; }
        if constexpr (!Epi::AFTER_DRAIN) { E(acc, cur, wr, wc, fr, fq); S.done(cur); }
        if (!has_next) break;
#pragma unroll
        for (int a = 0; a < 2; ++a)
#pragma unroll
            for (int b = 0; b < 2; ++b)
#pragma unroll
                for (int m = 0; m < 4; ++m)
#pragma unroll
                    for (int n = 0; n < 2; ++n) acc[a][b][m][n] = (f32x4){0.f, 0.f, 0.f, 0.f};
        cur = nxt; cA = nA; cB = nB; ++ui;
        if constexpr (ALIGN_EPI) { if (wr == 1) PG8_BAR; }
    }
    PG8_WAIT_V(0);
    if constexpr (!ALIGN_EPI) { if (wr == 0) PG8_BAR; }
    PG8_BAR;
    if constexpr (Epi::AFTER_DRAIN) { E.fused(acc, cur, wr, wc, fr, fq, lds, wid, lane); S.done(cur); }
#undef PG8_SA
#undef PG8_SB
#undef PG8_STAGE
#undef PG8_LDA
#undef PG8_LDB
#undef PG8_MMA
#undef PG8_CAT
#undef PG8_WAIT_V
#undef PG8_WAIT_L
#undef PG8_BAR
#undef PG8_SCHED
}
}
constexpr int S_ = 16384, D_ = 1024;
constexpr int EVEN_IN = 3072, LORA_N = 512, FF0 = 2816, ODD_IN = 3600, ODD_PAD = 3840, FFE = 3584, NEXP = 8;
constexpr int MOE_ROWS = 32768 + 8 * 256;
constexpr int MOE_BATCH_TILES = 64;
constexpr size_t MiB = 1u << 20;
constexpr size_t WS_CTL = 0, CTL_ZERO_BYTES = 1 * MiB;
constexpr size_t WS_WIN0 = 2 * MiB, WS_WL = 8 * MiB, WS_WOUT0 = 9 * MiB, WS_WGU0 = 11 * MiB, WS_WD0 = 22 * MiB, WS_WIN1 = 28 * MiB, WS_WOUT1 = 36 * MiB;
constexpr size_t WS_TOK = 38 * MiB;
constexpr size_t WS_TILE = 39 * MiB;
constexpr size_t WS_A = 40 * MiB;
constexpr size_t WS_H = WS_A, WS_HX = WS_A + 32 * MiB;
constexpr size_t WS_LW0 = WS_A, WS_LW1 = WS_A + 32 * MiB, WS_R = WS_A + 64 * MiB, WS_V = WS_A + 80 * MiB, WS_KK = WS_A + 96 * MiB, WS_KD0 = WS_A + 112 * MiB, WS_KD1 = WS_A + 128 * MiB, WS_B0 = WS_A + 144 * MiB;
constexpr size_t WS_H2 = WS_A, WS_H3 = WS_A + 32 * MiB;
constexpr size_t WS_WMGU = WS_A, WS_WMD = WS_A + 112 * MiB;
constexpr size_t WS_B = 208 * MiB;
constexpr size_t WS_PROJ0 = WS_B, WS_LORA = WS_B + 96 * MiB, WS_QN = WS_B + 112 * MiB, WS_KN = WS_B + 128 * MiB, WS_Y = WS_B + 144 * MiB;
constexpr size_t WS_B1 = WS_B + 176 * MiB, WS_GATE = WS_B + 192 * MiB, WS_BONUS = WS_B + 208 * MiB, WS_Y0 = WS_LORA, WS_Y1 = WS_B + 224 * MiB;
constexpr size_t WS_ACT0 = WS_B, WS_PROJ1 = WS_B + 88 * MiB;
constexpr size_t WS_QD = WS_B, WS_KD = WS_B + 16 * MiB, WS_VD = WS_B + 32 * MiB, WS_YCAT1 = WS_B + 48 * MiB, WS_GB = WS_B + 80 * MiB  ;
constexpr size_t WS_O0 = WS_B + 208 * MiB, WS_O1 = WS_B + 224 * MiB;
constexpr size_t WS_AMOE = WS_B, WS_MACT = WS_B + 88 * MiB, WS_AMOE8 = WS_B + 144 * MiB;
constexpr size_t WS_END_OLD = 448 * MiB, WS_RSS1 = 460 * MiB, WS_RSS2 = 461 * MiB, WS_END = 462 * MiB;
static_assert(WS_MACT + (size_t)MOE_BATCH_TILES * 256 * FFE <= WS_AMOE8 && WS_AMOE8 + (size_t)MOE_ROWS * D_ <= WS_END_OLD, "moe act");
static_assert(WS_AMOE + (size_t)MOE_ROWS * D_ * 2 <= WS_MACT, "amoe");
static_assert(WS_PROJ1 + (size_t)S_ * ODD_PAD * 2 <= WS_O0, "proj1");
constexpr int CW_CNT = 64;
constexpr int CW_RSS1 = 32768, CW_RSS2 = 32768 + 16384;
constexpr int CW_BAR = 4096;
constexpr int LDS_BYTES = 159744, LDS_ZERO_OFF = LDS_BYTES - 512, MISC_OFF = LDS_ZERO_OFF + 64;

#define GAS __attribute__((address_space(1)))
#define LAS __attribute__((address_space(3)))
#define DI __device__ __forceinline__
typedef unsigned short bf16;
typedef unsigned v4u __attribute__((ext_vector_type(4)));
typedef float f32x4 __attribute__((ext_vector_type(4)));
typedef GAS unsigned gu32;
#define LDS_WAIT() asm volatile("s_waitcnt lgkmcnt(0)" ::: "memory")
DI unsigned f2bf(float f) { unsigned u = __builtin_bit_cast(unsigned, f); return (u + 0x7fffu + ((u >> 16) & 1u)) >> 16; }
typedef float f32x2_t __attribute__((ext_vector_type(2))); typedef __bf16 bf16x2_t __attribute__((ext_vector_type(2)));
DI unsigned pk2(float lo, float hi) { const f32x2_t v = {lo, hi}; const bf16x2_t b = __builtin_convertvector(v, bf16x2_t); return __builtin_bit_cast(unsigned, b); }
DI float bflo(unsigned w) { return __uint_as_float(w << 16); }
DI float bfhi(unsigned w) { return __uint_as_float(w & 0xffff0000u); }
DI float bf2f(bf16 b) { return __uint_as_float(((unsigned)b) << 16); }
DI void ld8(const bf16* p, float (&v)[8]) { const v4u w = *(const v4u*)p; v[0] = bflo(w.x); v[1] = bfhi(w.x); v[2] = bflo(w.y); v[3] = bfhi(w.y); v[4] = bflo(w.z); v[5] = bfhi(w.z); v[6] = bflo(w.w); v[7] = bfhi(w.w); }
DI void st8(bf16* p, const float (&v)[8]) { v4u w; w.x = pk2(v[0], v[1]); w.y = pk2(v[2], v[3]); w.z = pk2(v[4], v[5]); w.w = pk2(v[6], v[7]); *(v4u*)p = w; }
DI void ld8f(const float* p, float (&v)[8]) { const f32x4 a = *(const f32x4*)p, b = *(const f32x4*)(p + 4); v[0] = a.x; v[1] = a.y; v[2] = a.z; v[3] = a.w; v[4] = b.x; v[5] = b.y; v[6] = b.z; v[7] = b.w; }
DI void st8f(float* p, const float (&v)[8]) { *(f32x4*)p = (f32x4){v[0], v[1], v[2], v[3]}; *(f32x4*)(p + 4) = (f32x4){v[4], v[5], v[6], v[7]}; }
DI float wave_sum(float v) {
#pragma unroll
    for (int o = 1; o < 64; o <<= 1) v += __shfl_xor(v, o);
    return v;
}
template <int W> DI float grp_sum(float v) {
#pragma unroll
    for (int o = 1; o < W; o <<= 1) v += __shfl_xor(v, o);
    return v;
}
DI float sigmoidf_(float x) { return 1.0f / (1.0f + __expf(-x)); }
DI float softplusf_(float x) { return x > 20.f ? x : log1pf(__expf(x)); }
DI float siluf_(float x) { return x / (1.0f + __expf(-x)); }

struct Args { const float* in[39]; float* out; unsigned char* ws; };

DI void transpose_item(const float* W, int K, int N, bf16* WT, int rowbase, LAS float* scr, int k0, int n0, int lane, const float* kscale = nullptr) {
    const int nn = n0 + (lane & 31); const bool ok = nn < N;
#pragma unroll
    for (int i = 0; i < 32; ++i) { const int kk = 2 * i + (lane >> 5); scr[kk * 33 + (lane & 31)] = ok ? W[(size_t)(k0 + kk) * N + nn] * (kscale ? kscale[k0 + kk] : 1.0f) : 0.f; }
    LDS_WAIT(); asm volatile("" ::: "memory");
    const int c = lane & 7;
#pragma unroll
    for (int j = 0; j < 4; ++j) { const int n = (lane >> 3) + 8 * j; const LAS float* s = scr + (8 * c) * 33 + n;
        v4u o; o.x = pk2(s[0 * 33], s[1 * 33]); o.y = pk2(s[2 * 33], s[3 * 33]); o.z = pk2(s[4 * 33], s[5 * 33]); o.w = pk2(s[6 * 33], s[7 * 33]);
        *(v4u*)(WT + (size_t)(rowbase + n) * K + k0 + 8 * c) = o; }
    LDS_WAIT(); asm volatile("" ::: "memory");
}

struct TrItem { const float* src; unsigned char* dst; int K, N, k0, n0, rowbase; };
DI void tr_load(const TrItem& d, int lane, float (&v)[32]) {
#pragma unroll
    for (int i = 0; i < 32; ++i) { const int kk = 2 * i + (lane >> 5); v[i] = d.src[(size_t)(d.k0 + kk) * d.N + d.n0 + (lane & 31)]; }
}
DI unsigned pk4f8(float a, float b, float c, float d) { int w = __builtin_amdgcn_cvt_pk_fp8_f32(a, b, 0, false); w = __builtin_amdgcn_cvt_pk_fp8_f32(c, d, w, true); return (unsigned)w; }
constexpr float MOE_WSCALE = 32.0f;
DI void tr_store(const TrItem& d, int lane, const float (&v)[32], LAS float* scr) {
#pragma unroll
    for (int i = 0; i < 32; ++i) scr[(2 * i + (lane >> 5)) * 33 + (lane & 31)] = v[i] * MOE_WSCALE;
    LDS_WAIT(); asm volatile("" ::: "memory");
    const int c = lane & 3;
#pragma unroll
    for (int j = 0; j < 2; ++j) { const int n = (lane >> 2) + 16 * j; const LAS float* s = scr + (16 * c) * 33 + n;
        v4u o; o.x = pk4f8(s[0 * 33], s[1 * 33], s[2 * 33], s[3 * 33]); o.y = pk4f8(s[4 * 33], s[5 * 33], s[6 * 33], s[7 * 33]);
        o.z = pk4f8(s[8 * 33], s[9 * 33], s[10 * 33], s[11 * 33]); o.w = pk4f8(s[12 * 33], s[13 * 33], s[14 * 33], s[15 * 33]);
        *(v4u*)(d.dst + (size_t)(d.rowbase + n) * d.K + d.k0 + 16 * c) = o; }
    LDS_WAIT(); asm volatile("" ::: "memory");
}
DI void moe_gu_item(const Args& a, unsigned char* ws, int it, TrItem& d) {
    const int mtx = it / 1792, r = it % 1792, e = mtx >> 1, sel = mtx & 1, kb = r / 112, nb = r % 112, n0 = 32 * nb;
    d.src = (sel ? a.in[37] : a.in[36]) + (size_t)e * 1024 * FFE; d.dst = ws + WS_WMGU + (size_t)e * 2 * FFE * 1024; d.K = 1024; d.N = FFE; d.k0 = 64 * kb; d.n0 = n0;
    d.rowbase = (n0 / 128) * 256 + sel * 128 + (n0 % 128);
}
DI void moe_dn_item(const Args& a, unsigned char* ws, int it, TrItem& d) {
    const int e = it / 1792, r = it % 1792, kb = r / 32, nb = r % 32;
    d.src = a.in[38] + (size_t)e * 1024 * FFE; d.dst = ws + WS_WMD + (size_t)e * 1024 * FFE; d.K = FFE; d.N = 1024; d.k0 = 64 * kb; d.n0 = 32 * nb; d.rowbase = 32 * nb;
}
template <bool GU> DI void moe_copy_loop(const Args& a, unsigned char* ws, LAS float* scr, int first, int stride, int last, int lane) {
    first = __builtin_amdgcn_readfirstlane(first); stride = __builtin_amdgcn_readfirstlane(stride);
    if (first >= last) return;
    TrItem cur, nxt; float vc[32], vn[32];
    if (GU) moe_gu_item(a, ws, first, cur); else moe_dn_item(a, ws, first, cur);
    tr_load(cur, lane, vc);
    for (int it = first; it < last; it += stride) {
        const int itn = it + stride; const bool more = itn < last;
        if (more) { if (GU) moe_gu_item(a, ws, itn, nxt); else moe_dn_item(a, ws, itn, nxt); tr_load(nxt, lane, vn); }
        tr_store(cur, lane, vc, scr);
        if (more) { cur = nxt;
#pragma unroll
            for (int i = 0; i < 32; ++i) vc[i] = vn[i]; }
    }
}
DI bool transpose_job(int& r, const float* W, int K, int N, int Npad, bf16* WT, int row_off, int grp, int sel, LAS float* scr, int lane, const float* kscale = nullptr) {
    const int nblk = Npad / 32, cnt = (K / 64) * nblk;
    if (r >= cnt) { r -= cnt; return false; }
    const int kb = r / nblk, nb = r % nblk, n0 = 32 * nb;
    const int rowbase = row_off + (grp ? (n0 / grp) * (2 * grp) + sel * grp + (n0 % grp) : n0);
    transpose_item(W, K, N, WT, rowbase, scr, 64 * kb, n0, lane, kscale);
    return true;
}
#define XB_TMO      128
#define XB_XCNT(j)  (256  + 64 * (j))
#define XB_XSUB(j)  (1280 + 64 * (j))
#define XB_XGEN(j)  (2304 + 64 * (j))
#define XB_TOP      3328
#define XB_TOPGEN   3392
#define XCD_BAR_WORDS 3456
#define XB_SPIN_CAP (1u << 22)

__device__ __forceinline__ unsigned xb_ld(unsigned* p)              { return __hip_atomic_load(p, __ATOMIC_RELAXED, __HIP_MEMORY_SCOPE_AGENT); }
__device__ __forceinline__ unsigned xb_add(unsigned* p, unsigned v) { return __hip_atomic_fetch_add(p, v, __ATOMIC_RELAXED, __HIP_MEMORY_SCOPE_AGENT); }
__device__ __forceinline__ unsigned xb_xcc_id() { return (unsigned)__builtin_amdgcn_s_getreg((3 << 11) | 20) & 0xFu; }
#define XB_SPIN(cond, bar) do { unsigned _sp = 0; while (cond) { __builtin_amdgcn_s_sleep(1); \
    if ((++_sp & 255u) == 0u) { if (xb_ld(&(bar)[XB_TMO])) break; if (_sp > XB_SPIN_CAP) { atomicAdd(&(bar)[XB_TMO], 1u); break; } } } } while (0)

struct XcdBarrier {
    unsigned* bar; unsigned x;
    volatile LAS unsigned* st;
};

__device__ __forceinline__ XcdBarrier xcd_barrier_post(unsigned* bar, volatile LAS unsigned* st) {
    XcdBarrier b; b.bar = bar; b.x = xb_xcc_id(); b.st = st;
    if (threadIdx.x == 0) (void)xb_add(&bar[XB_XCNT(b.x)], 1u);
    return b;
}
__device__ __forceinline__ void xcd_barrier_complete(unsigned* bar, unsigned x, unsigned& nloc, unsigned& nx) {
    const unsigned G = gridDim.x * gridDim.y * gridDim.z;
    unsigned sum, cnt, mine, sp = 0u;
    for (;;) {
        sum = 0u; cnt = 0u; mine = 0u;
#pragma unroll
        for (unsigned j = 0; j < 16; ++j) { const unsigned c = xb_ld(&bar[XB_XCNT(j)]); sum += c; cnt += (c > 0u) ? 1u : 0u; mine = (j == x) ? c : mine; }
        if (sum == G) break;
        __builtin_amdgcn_s_sleep(1);
        if ((++sp & 255u) == 0u) { if (xb_ld(&bar[XB_TMO])) break; if (sp > XB_SPIN_CAP) { atomicAdd(&bar[XB_TMO], 1u); break; } }
    }
    nloc = mine > 0u ? mine : 1u; nx = cnt > 0u ? cnt : 1u;
}

__device__ __forceinline__ void xcd_barrier(const XcdBarrier& b, const bool wave0) {
    asm volatile("s_waitcnt vmcnt(0)" ::: "memory");
    __syncthreads();
    if (wave0 && __builtin_amdgcn_mbcnt_hi(~0u, __builtin_amdgcn_mbcnt_lo(~0u, 0u)) == 0u) {
        unsigned* bar = b.bar; asm volatile("" : "+s"(bar)); const unsigned bx_ = xb_xcc_id();
        __builtin_amdgcn_s_waitcnt(0);
        unsigned nloc = b.st[0], nx = b.st[1];
        if (nloc == 0u) { xcd_barrier_complete(bar, bx_, nloc, nx); b.st[0] = nloc; b.st[1] = nx; }
        const unsigned old = xb_add(&bar[XB_XSUB(bx_)], 1u);
        const unsigned gen = old / nloc;
        if (old + 1u == (gen + 1u) * nloc) {
            __builtin_amdgcn_fence(__ATOMIC_RELEASE, "agent");
            asm volatile("s_waitcnt vmcnt(0)" ::: "memory");
            const unsigned og = xb_add(&bar[XB_TOP], 1u);
            const unsigned tg = og / nx;
            if (og + 1u == (tg + 1u) * nx) xb_add(&bar[XB_TOPGEN], 1u);
            else XB_SPIN(xb_ld(&bar[XB_TOPGEN]) == tg, bar);
            __builtin_amdgcn_fence(__ATOMIC_ACQUIRE, "agent");
            xb_add(&bar[XB_XGEN(bx_)], 1u);
            asm volatile("s_waitcnt vmcnt(0)" ::: "memory");
        } else {
            XB_SPIN(xb_ld(&bar[XB_XGEN(bx_)]) == gen, bar);
            __builtin_amdgcn_fence(__ATOMIC_ACQUIRE, "agent");
            asm volatile("s_waitcnt vmcnt(0)" ::: "memory");
        }
    }
    __syncthreads();
}
DI float row_rstd(const f32x4 (&v)[4]) {
    float s = 0.f;
#pragma unroll
    for (int j = 0; j < 4; ++j) s += (v[j].x * v[j].x + v[j].y * v[j].y) + (v[j].z * v[j].z + v[j].w * v[j].w);
    return 1.0f / sqrtf(wave_sum(s) * (1.0f / D_) + 1e-6f);
}
DI void load_row(const float* x, int t, int lane, f32x4 (&v)[4]) {
    if (t >= 0 && t < S_) { const f32x4* p = (const f32x4*)(x + (size_t)t * D_) + lane;
#pragma unroll
        for (int j = 0; j < 4; ++j) v[j] = p[64 * j];
    } else {
#pragma unroll
        for (int j = 0; j < 4; ++j) v[j] = (f32x4){0.f, 0.f, 0.f, 0.f};
    }
}
DI void store_row_bf16(bf16* o, int lane, const f32x4 (&v)[4]) {
    unsigned long long* o8 = (unsigned long long*)o + lane;
#pragma unroll
    for (int j = 0; j < 4; ++j) o8[64 * j] = (unsigned long long)pk2(v[j].x, v[j].y) | ((unsigned long long)pk2(v[j].z, v[j].w) << 32);
}
DI void norm_rows(const float* x, const float* w, const float* mu  , bf16* H, bf16* HX, int gw, int NGW, int lane) {
    f32x4 wv[4];
#pragma unroll
    for (int j = 0; j < 4; ++j) wv[j] = ((const f32x4*)w)[lane + 64 * j];
    for (int t = gw; t < S_; t += NGW) {
        f32x4 v[4]; load_row(x, t, lane, v); const float rs = row_rstd(v);
#pragma unroll
        for (int j = 0; j < 4; ++j) v[j] = v[j] * rs * wv[j];
        store_row_bf16(H + (size_t)t * D_, lane, v);
        if (mu) {
            f32x4 p[4], n[4]; load_row(x, t - 1, lane, p); load_row(x, t + 1, lane, n);
            const float rp = row_rstd(p), rn = row_rstd(n);
#pragma unroll
            for (int j = 0; j < 4; ++j) { const f32x4 m0 = ((const f32x4*)mu)[lane + 64 * j], m1 = ((const f32x4*)(mu + D_))[lane + 64 * j];
                const f32x4 hp = p[j] * rp * wv[j], hn = n[j] * rn * wv[j]; p[j] = v[j] + m0 * (hp - v[j]) + m1 * (hn - v[j]); }
            store_row_bf16(HX + (size_t)t * D_, lane, p);
        }
    }
}

DI void prep0_token(const Args& a, unsigned char* ws, LAS float* scr, int t, int lane) {
    const bf16* P = (const bf16*)(ws + WS_PROJ0) + (size_t)t * EVEN_IN;
    const int c0 = 8 * lane;
    {
        float q[8], k[8]; ld8(P + c0, q); ld8(P + 512 + c0, k);
        float sq = 0.f, sk = 0.f;
#pragma unroll
        for (int i = 0; i < 8; ++i) { sq += q[i] * q[i]; sk += k[i] * k[i]; }
        sq = grp_sum<8>(sq); sk = grp_sum<8>(sk);
        const float rq = 1.0f / sqrtf(sq * (1.0f / 64.f) + 1e-6f), rk = 1.0f / sqrtf(sk * (1.0f / 64.f) + 1e-6f);
        const int d0 = 8 * (lane & 7);
        float qw[8], kw[8]; ld8f(a.in[4] + d0, qw); ld8f(a.in[5] + d0, kw);
#pragma unroll
        for (int i = 0; i < 8; ++i) { q[i] = q[i] * rq * qw[i]; k[i] = k[i] * rk * kw[i]; }
        const float pos = (float)((const int*)a.in[1])[t];
        float qo[8], ko[8];
#pragma unroll
        for (int i = 0; i < 8; ++i) { qo[i] = __shfl_xor(q[i], 1); ko[i] = __shfl_xor(k[i], 1); }
        const int sub = lane & 7;
        if (sub < 2) {
#pragma unroll
            for (int i = 0; i < 8; ++i) {
                constexpr float kInv[8] = {1.0f, 0.1939227432012558f, 0.03760603070259094f, 0.007292664609849453f, 0.0014142135623842478f, 0.00027424818836152554f, 5.3182957344688475e-05f, 1.0313385246263351e-05f};
                const float ang = pos * kInv[i]; const float kq = rintf(ang * 0.15915494309189535f);
                float rr = fmaf(-kq, 6.28318548202514648f, ang); rr = fmaf(-kq, -1.74845553146951715e-07f, rr);
                const float sn = __sinf(rr), cs = __cosf(rr);
                if (sub == 0) { q[i] = q[i] * cs - qo[i] * sn; k[i] = k[i] * cs - ko[i] * sn; }
                else          { q[i] = q[i] * cs + qo[i] * sn; k[i] = k[i] * cs + ko[i] * sn; }
            }
        }
#pragma unroll
        for (int i = 0; i < 8; ++i) q[i] *= 0.125f;
        st8((bf16*)(ws + WS_QN) + (size_t)t * 512 + c0, q); st8((bf16*)(ws + WS_KN) + (size_t)t * 512 + c0, k);
        *(v4u*)((bf16*)(ws + WS_Y1) + (size_t)t * 512 + c0) = *(const v4u*)(P + 1024 + c0);
    }
}

DI void rwkv_scan_naive(unsigned char* ws, int w  , int lane) {
    const int z = w >> 9, h = (w >> 6) & 7, vr = w & 63;
    const float* LW = (const float*)(ws + (z ? WS_LW1 : WS_LW0));
    const bf16* KD = (const bf16*)(ws + (z ? WS_KD1 : WS_KD0)); const bf16* BB = (const bf16*)(ws + (z ? WS_B1 : WS_B0));
    const bf16* KK = (const bf16*)(ws + WS_KK); const bf16* R = (const bf16*)(ws + WS_R); const bf16* V = (const bf16*)(ws + WS_V);
    bf16* Y = (bf16*)(ws + (z ? WS_Y1 : WS_Y0));
    const int cc = h * 64 + lane, cv = h * 64 + vr;
    float S = 0.f;
    int t = z ? S_ - 1 : 0; const int dt = z ? -1 : 1;
    size_t o = (size_t)t * 512;
    float lw = LW[o + cc], kd = bf2f(KD[o + cc]), bb = bf2f(BB[o + cc]), kk = bf2f(KK[o + cc]), rr = bf2f(R[o + cc]), vv = bf2f(V[o + cv]);
    for (int s = 0; s < S_; ++s) {
        const int tn = t + dt; const bool more = s + 1 < S_;
        const size_t on = (size_t)(more ? tn : t) * 512;
        const float lw_n = LW[on + cc], kd_n = bf2f(KD[on + cc]), bb_n = bf2f(BB[on + cc]), kk_n = bf2f(KK[on + cc]), rr_n = bf2f(R[on + cc]), vv_n = bf2f(V[on + cv]);
        const float sa = wave_sum(S * (-kk));
        S = S * __expf(lw) + sa * bb + vv * kd;
        const float y = wave_sum(S * rr);
        if (lane == 0) Y[(size_t)t * 512 + cv] = (bf16)f2bf(y);
        lw = lw_n; kd = kd_n; bb = bb_n; kk = kk_n; rr = rr_n; vv = vv_n; t = tn;
    }
}

DI void attn_token_naive(unsigned char* ws, int t, int lane) {
    const bf16* QN = (const bf16*)(ws + WS_QN); const bf16* KN = (const bf16*)(ws + WS_KN); const bf16* P = (const bf16*)(ws + WS_PROJ0);
    const int c0 = 8 * lane;
    float q[8]; ld8(QN + (size_t)t * 512 + c0, q);
    float m = -1e30f, l = 0.f, acc[8];
#pragma unroll
    for (int i = 0; i < 8; ++i) acc[i] = 0.f;
    for (int br = 0; br < 3; ++br) {
        const int d = br == 0 ? 1 : (br == 1 ? 4 : 16);
        for (int mm = -64; mm <= 64; ++mm) {
            const int j = t + d * mm; if (j < 0 || j >= S_) continue;
            float k[8], v[8]; ld8(KN + (size_t)j * 512 + c0, k); ld8(P + (size_t)j * EVEN_IN + 1024 + c0, v);
            float s = 0.f;
#pragma unroll
            for (int i = 0; i < 8; ++i) s += q[i] * k[i];
            s = grp_sum<8>(s);
            const float mn = fmaxf(m, s), sc = __expf(m - mn), p = __expf(s - mn);
            l = l * sc + p;
#pragma unroll
            for (int i = 0; i < 8; ++i) acc[i] = acc[i] * sc + p * v[i];
            m = mn;
        }
    }
    const float il = 1.0f / l;
#pragma unroll
    for (int i = 0; i < 8; ++i) acc[i] *= il;
    st8((bf16*)(ws + WS_Y) + (size_t)t * D_ + c0, acc);
}

DI void rwkv_post_token(const Args& a, unsigned char* ws, int t, int lane) {
    const int c0 = 8 * lane; const size_t o = (size_t)t * 512 + c0;
    float y0[8], y1[8], g[8], bn[8], lw[8], lb[8];
    ld8((const bf16*)(ws + WS_Y0) + o, y0); ld8((const bf16*)(ws + WS_Y1) + o, y1); ld8((const bf16*)(ws + WS_GATE) + o, g); ld8((const bf16*)(ws + WS_BONUS) + o, bn);
    ld8f(a.in[19] + c0, lw); ld8f(a.in[20] + c0, lb);
    float s = 0.f;
#pragma unroll
    for (int i = 0; i < 8; ++i) { y0[i] += y1[i]; s += y0[i]; }
    const float mu = grp_sum<8>(s) * (1.0f / 64.f);
    float q = 0.f;
#pragma unroll
    for (int i = 0; i < 8; ++i) { y0[i] -= mu; q += y0[i] * y0[i]; }
    const float rs = 1.0f / sqrtf(grp_sum<8>(q) * (1.0f / 64.f) + 64e-5f);
#pragma unroll
    for (int i = 0; i < 8; ++i) y0[i] = (y0[i] * rs * lw[i] + lb[i] + bn[i]) * g[i];
    st8((bf16*)(ws + WS_Y) + (size_t)t * D_ + 512 + c0, y0);
}
typedef short s16x8 __attribute__((ext_vector_type(8)));
typedef short s16x4 __attribute__((ext_vector_type(4)));
typedef LAS unsigned char* ldsp;
DI f32x4 mfma16(s16x8 a, s16x8 b, f32x4 c) { return __builtin_amdgcn_mfma_f32_16x16x32_bf16(a, b, c, 0, 0, 0); }
DI s16x8 frag_row(ldsp img, int row0, int col0, int lane) { return *(LAS const s16x8*)(img + (row0 + (lane & 15)) * 128 + (col0 + 8 * (lane >> 4)) * 2); }
DI s16x4 tr16(ldsp p) { return __builtin_bit_cast(s16x4, __builtin_amdgcn_ds_read_tr16_b64_v4i16((LAS s16x4*)p)); }
DI s16x8 frag_tr(ldsp img, int row0, int col0, int lane) {
    ldsp a0 = img + (row0 + 8 * (lane >> 4) + ((lane & 15) >> 2)) * 128 + col0 * 2 + 8 * (lane & 3);
    const s16x4 lo = tr16(a0), hi = tr16(a0 + 4 * 128);
    return __builtin_shufflevector(lo, hi, 0, 1, 2, 3, 4, 5, 6, 7);
}
DI void ctile_to_img(ldsp img, int mt, int nt, const f32x4& c, int lane) {
    LAS bf16* p = (LAS bf16*)(img + (16 * mt + 4 * (lane >> 4)) * 128 + (16 * nt + (lane & 15)) * 2);
#pragma unroll
    for (int e = 0; e < 4; ++e) p[e * 64] = (bf16)f2bf(c[e]);
}
#define CFENCE() asm volatile("" ::: "memory")
#define MM_LOOPH(ACC, AEXPR, BEXPR) _Pragma("unroll") for (int mt = 2 * mh; mt < 2 * mh + 2; ++mt) _Pragma("unroll") for (int nt = 0; nt < 4; ++nt) _Pragma("unroll") for (int ks = 0; ks < 2; ++ks) ACC[mt][nt] = mfma16((AEXPR), (BEXPR), ACC[mt][nt])
#define MM_LOOP(ACC, AEXPR, BEXPR) _Pragma("unroll") for (int mt = 0; mt < 4; ++mt) _Pragma("unroll") for (int nt = 0; nt < 4; ++nt) _Pragma("unroll") for (int ks = 0; ks < 2; ++ks) ACC[mt][nt] = mfma16((AEXPR), (BEXPR), ACC[mt][nt])

DI int tok_of(int z, int cn, int i) { return z ? cn * 64 + 63 - i : cn * 64 + i; }

template <bool DRY = false, int STOP = 99> DI void rwkv_pass1_item(unsigned char* ws, ldsp lds, int item, int lane) {
    asm volatile("" : "+v"(lane));
    const int z = item >> 11, h = (item >> 8) & 7, c = item & 255;
    const int cn = z ? 255 - c : c;
    float* LW = (float*)(ws + (z ? WS_LW1 : WS_LW0));
    bf16* KD = (bf16*)(ws + (z ? WS_KD1 : WS_KD0)); bf16* BB = (bf16*)(ws + (z ? WS_B1 : WS_B0));
    const bf16* KK = (const bf16*)(ws + WS_KK); const bf16* R = (const bf16*)(ws + WS_R); const bf16* V = (const bf16*)(ws + WS_V);
    float* LWo = DRY ? (float*)(ws + WS_Y) : LW; bf16* KDo = DRY ? (bf16*)(ws + WS_Y) : KD; bf16* BBo = DRY ? (bf16*)(ws + WS_Y) : BB;
    ldsp S0 = lds, S1 = lds + 8192, S2 = lds + 16384, S3 = lds + 24576, S4 = lds + 32768, S5 = lds + 40960, S6 = lds + 49152, S7 = lds + 57344;
    ldsp IA = S0, IB = S1, IK = S2, IR = S3;
    const int ch = h * 64 + lane;
    float G = 0.f;
#pragma unroll 16
    for (int i = 0; i < 64; ++i) {
        const size_t o = (size_t)tok_of(z, cn, i) * 512 + ch;
        const float lw = LW[o], a = -bf2f(KK[o]), b = bf2f(BB[o]), kd = bf2f(KD[o]), r = bf2f(R[o]);
        const float eprev = __expf(G); G += lw; const float ecur = __expf(G), einv = __expf(-G);
        ((LAS bf16*)IA)[i * 64 + lane] = (bf16)f2bf(a * eprev); ((LAS bf16*)IB)[i * 64 + lane] = (bf16)f2bf(b * einv);
        ((LAS bf16*)IK)[i * 64 + lane] = (bf16)f2bf(kd * einv); ((LAS bf16*)IR)[i * 64 + lane] = (bf16)f2bf(r * ecur);
    }
    const float GT = __expf(G);
    LDS_WAIT(); CFENCE();
    if (STOP == 1) { if (GT == 123.f) LWo[0] = GT; return; }
    int lane2 = lane; asm volatile("" : "+v"(lane2));
    const int n_ = lane2 & 15, q_ = lane2 >> 4;
    {
#pragma unroll
        for (int mh = 0; mh < 2; ++mh) {
        f32x4 acc[4][4];
#pragma unroll
        for (int mt = 2 * mh; mt < 2 * mh + 2; ++mt)
#pragma unroll
            for (int nt = 0; nt < 4; ++nt) acc[mt][nt] = (f32x4){0.f, 0.f, 0.f, 0.f};
        MM_LOOPH(acc, frag_row(IA, 16 * mt, 32 * ks, lane), frag_row(IB, 16 * nt, 32 * ks, lane));
#pragma unroll
        for (int mt = 2 * mh; mt < 2 * mh + 2; ++mt)
#pragma unroll
            for (int nt = 0; nt < 4; ++nt)
#pragma unroll
                for (int e = 0; e < 4; ++e) { const int i = 16 * mt + 4 * q_ + e, j = 16 * nt + n_; ((LAS float*)S4)[i * 64 + j] = (j < i) ? acc[mt][nt][e] : 0.f; }
        }
    }
    LDS_WAIT(); CFENCE();
    if (STOP == 4) return;
    {
        float t[64];
        int lane_o = lane; asm volatile("" : "+v"(lane_o));
        f32x4 ar[2][16];
#pragma unroll
        for (int i = 0; i < 64; ++i) {
            if (i + 1 < 64) {
#pragma unroll
                for (int jg = 0; jg < (i + 1 + 3) / 4; ++jg) ar[(i + 1) & 1][jg] = *(LAS const f32x4*)(S4 + ((i + 1) * 64 + 4 * jg) * 4);
            }
            __builtin_amdgcn_sched_barrier(0);
            float acc0 = (lane_o == i) ? 1.f : 0.f, acc1 = 0.f, acc2 = 0.f, acc3 = 0.f;
#pragma unroll
            for (int jg = 0; jg < (i + 3) / 4; ++jg) { const f32x4 a4 = ar[i & 1][jg];
                if (4 * jg + 0 < i) acc0 += a4[0] * t[4 * jg + 0];
                if (4 * jg + 1 < i) acc1 += a4[1] * t[4 * jg + 1];
                if (4 * jg + 2 < i) acc2 += a4[2] * t[4 * jg + 2];
                if (4 * jg + 3 < i) acc3 += a4[3] * t[4 * jg + 3]; }
            t[i] = (acc0 + acc1) + (acc2 + acc3);
            __builtin_amdgcn_sched_barrier(0);
        }
        LDS_WAIT(); CFENCE();
#pragma unroll
        for (int i = 0; i < 64; ++i) ((LAS bf16*)S4)[i * 64 + lane] = (bf16)f2bf(t[i]);
    }
    LDS_WAIT(); CFENCE();
    if (STOP == 2) return;
    ldsp IT = S4, IW = S5, IAK = S6;
    {
#pragma unroll
        for (int mh = 0; mh < 2; ++mh) {
        f32x4 acc[4][4];
#pragma unroll
        for (int mt = 2 * mh; mt < 2 * mh + 2; ++mt)
#pragma unroll
            for (int nt = 0; nt < 4; ++nt) acc[mt][nt] = (f32x4){0.f, 0.f, 0.f, 0.f};
        MM_LOOPH(acc, frag_row(IA, 16 * mt, 32 * ks, lane), frag_row(IK, 16 * nt, 32 * ks, lane));
#pragma unroll
        for (int mt = 2 * mh; mt < 2 * mh + 2; ++mt)
#pragma unroll
            for (int nt = 0; nt < 4; ++nt) {
#pragma unroll
                for (int e = 0; e < 4; ++e) { const int i = 16 * mt + 4 * q_ + e, j = 16 * nt + n_; if (!(j < i)) acc[mt][nt][e] = 0.f; }
                ctile_to_img(IAK, mt, nt, acc[mt][nt], lane); }
        }
    }
    if (STOP == 5) return;
    {
#pragma unroll
        for (int mh = 0; mh < 2; ++mh) {
        f32x4 acc[4][4];
#pragma unroll
        for (int mt = 2 * mh; mt < 2 * mh + 2; ++mt)
#pragma unroll
            for (int nt = 0; nt < 4; ++nt) acc[mt][nt] = (f32x4){0.f, 0.f, 0.f, 0.f};
        MM_LOOPH(acc, frag_row(IT, 16 * mt, 32 * ks, lane), frag_tr(IA, 32 * ks, 16 * nt, lane));
#pragma unroll
        for (int mt = 2 * mh; mt < 2 * mh + 2; ++mt)
#pragma unroll
            for (int nt = 0; nt < 4; ++nt) ctile_to_img(IW, mt, nt, acc[mt][nt], lane);
        }
    }
    LDS_WAIT(); CFENCE();
    if (STOP == 6) return;
    ldsp IV = S0;
    {
        v4u vr[8];
#pragma unroll
        for (int it = 0; it < 8; ++it) vr[it] = *(const v4u*)(V + (size_t)tok_of(z, cn, (lane >> 3) + 8 * it) * 512 + h * 64 + (lane & 7) * 8);
#pragma unroll
        for (int it = 0; it < 8; ++it) *(LAS v4u*)(IV + ((lane >> 3) + 8 * it) * 128 + (lane & 7) * 16) = vr[it];
    }
    LDS_WAIT(); CFENCE();
    ldsp IAV = S7;
    {
#pragma unroll
        for (int mh = 0; mh < 2; ++mh) {
        f32x4 acc[4][4];
#pragma unroll
        for (int mt = 2 * mh; mt < 2 * mh + 2; ++mt)
#pragma unroll
            for (int nt = 0; nt < 4; ++nt) acc[mt][nt] = (f32x4){0.f, 0.f, 0.f, 0.f};
        MM_LOOPH(acc, frag_row(IAK, 16 * mt, 32 * ks, lane), frag_tr(IV, 32 * ks, 16 * nt, lane));
#pragma unroll
        for (int mt = 2 * mh; mt < 2 * mh + 2; ++mt)
#pragma unroll
            for (int nt = 0; nt < 4; ++nt) ctile_to_img(IAV, mt, nt, acc[mt][nt], lane);
        }
    }
    LDS_WAIT(); CFENCE();
    if (STOP == 7) return;
    ldsp IU = S6;
    {
#pragma unroll
        for (int mh = 0; mh < 2; ++mh) {
        f32x4 acc[4][4];
#pragma unroll
        for (int mt = 2 * mh; mt < 2 * mh + 2; ++mt)
#pragma unroll
            for (int nt = 0; nt < 4; ++nt) acc[mt][nt] = (f32x4){0.f, 0.f, 0.f, 0.f};
        MM_LOOPH(acc, frag_row(IT, 16 * mt, 32 * ks, lane), frag_tr(IAV, 32 * ks, 16 * nt, lane));
        LDS_WAIT(); CFENCE();
#pragma unroll
        for (int mt = 2 * mh; mt < 2 * mh + 2; ++mt)
#pragma unroll
            for (int nt = 0; nt < 4; ++nt) ctile_to_img(IU, mt, nt, acc[mt][nt], lane);
        }
    }
    LDS_WAIT(); CFENCE();
    if (STOP == 3) return;
    ldsp IRB = S4, IRK = S7;
    {
#pragma unroll
        for (int mh = 0; mh < 2; ++mh) {
        f32x4 acc[4][4];
#pragma unroll
        for (int mt = 2 * mh; mt < 2 * mh + 2; ++mt)
#pragma unroll
            for (int nt = 0; nt < 4; ++nt) acc[mt][nt] = (f32x4){0.f, 0.f, 0.f, 0.f};
        MM_LOOPH(acc, frag_row(IR, 16 * mt, 32 * ks, lane), frag_row(IB, 16 * nt, 32 * ks, lane));
#pragma unroll
        for (int mt = 2 * mh; mt < 2 * mh + 2; ++mt)
#pragma unroll
            for (int nt = 0; nt < 4; ++nt) {
#pragma unroll
                for (int e = 0; e < 4; ++e) { const int i = 16 * mt + 4 * q_ + e, j = 16 * nt + n_; if (!(j <= i)) acc[mt][nt][e] = 0.f; }
                ctile_to_img(IRB, mt, nt, acc[mt][nt], lane); }
        }
    }
    {
#pragma unroll
        for (int mh = 0; mh < 2; ++mh) {
        f32x4 acc[4][4];
#pragma unroll
        for (int mt = 2 * mh; mt < 2 * mh + 2; ++mt)
#pragma unroll
            for (int nt = 0; nt < 4; ++nt) acc[mt][nt] = (f32x4){0.f, 0.f, 0.f, 0.f};
        MM_LOOPH(acc, frag_row(IR, 16 * mt, 32 * ks, lane), frag_row(IK, 16 * nt, 32 * ks, lane));
#pragma unroll
        for (int mt = 2 * mh; mt < 2 * mh + 2; ++mt)
#pragma unroll
            for (int nt = 0; nt < 4; ++nt) {
#pragma unroll
                for (int e = 0; e < 4; ++e) { const int i = 16 * mt + 4 * q_ + e, j = 16 * nt + n_; if (!(j <= i)) acc[mt][nt][e] = 0.f; }
                ctile_to_img(IRK, mt, nt, acc[mt][nt], lane); }
        }
    }
    LDS_WAIT(); CFENCE();
    int lane3 = lane; asm volatile("" : "+v"(lane3));
    const int n3 = lane3 & 15, q3 = lane3 >> 4;
    const size_t slot0 = (size_t)cn * 64 * 512 + h * 64;
    {
#pragma unroll
        for (int mh = 0; mh < 2; ++mh) {
        f32x4 acc[4][4];
#pragma unroll
        for (int mt = 2 * mh; mt < 2 * mh + 2; ++mt)
#pragma unroll
            for (int nt = 0; nt < 4; ++nt) { const s16x4 r4 = *(LAS const s16x4*)(IR + (16 * nt + n3) * 128 + (16 * mt + 4 * q3) * 2);
#pragma unroll
                for (int e = 0; e < 4; ++e) acc[mt][nt][e] = bf2f((bf16)r4[e]); }
        MM_LOOPH(acc, frag_tr(IW, 32 * ks, 16 * mt, lane), frag_row(IRB, 16 * nt, 32 * ks, lane));
#pragma unroll
        for (int mt = 2 * mh; mt < 2 * mh + 2; ++mt)
#pragma unroll
            for (int nt = 0; nt < 4; ++nt) { bf16* dst = (bf16*)(LWo + slot0 + (size_t)(16 * nt + n3) * 512) + 16 * mt + 4 * q3;
                *(unsigned long long*)dst = (unsigned long long)pk2(acc[mt][nt][0], acc[mt][nt][1]) | ((unsigned long long)pk2(acc[mt][nt][2], acc[mt][nt][3]) << 32); }
        }
    }
    {
#pragma unroll
        for (int mh = 0; mh < 2; ++mh) {
        f32x4 acc[4][4];
#pragma unroll
        for (int mt = 2 * mh; mt < 2 * mh + 2; ++mt)
#pragma unroll
            for (int nt = 0; nt < 4; ++nt) acc[mt][nt] = (f32x4){0.f, 0.f, 0.f, 0.f};
        MM_LOOPH(acc, frag_tr(IU, 32 * ks, 16 * mt, lane), frag_row(IRB, 16 * nt, 32 * ks, lane));
        MM_LOOPH(acc, frag_tr(IV, 32 * ks, 16 * mt, lane), frag_row(IRK, 16 * nt, 32 * ks, lane));
#pragma unroll
        for (int mt = 2 * mh; mt < 2 * mh + 2; ++mt)
#pragma unroll
            for (int nt = 0; nt < 4; ++nt) { bf16* dst = (bf16*)(LWo + slot0 + (size_t)(16 * nt + n3) * 512) + 64 + 16 * mt + 4 * q3;
                *(unsigned long long*)dst = (unsigned long long)pk2(acc[mt][nt][0], acc[mt][nt][1]) | ((unsigned long long)pk2(acc[mt][nt][2], acc[mt][nt][3]) << 32); }
        }
    }
    {
#pragma unroll
        for (int mh = 0; mh < 2; ++mh) {
        f32x4 acc[4][4];
#pragma unroll
        for (int mt = 2 * mh; mt < 2 * mh + 2; ++mt)
#pragma unroll
            for (int nt = 0; nt < 4; ++nt) acc[mt][nt] = (f32x4){0.f, 0.f, 0.f, 0.f};
        MM_LOOPH(acc, frag_tr(IW, 32 * ks, 16 * mt, lane), frag_tr(IB, 32 * ks, 16 * nt, lane));
#pragma unroll
        for (int nt = 0; nt < 4; ++nt) { const float gk = __shfl(GT, 16 * nt + n3);
#pragma unroll
            for (int mt = 2 * mh; mt < 2 * mh + 2; ++mt) { float o[4];
#pragma unroll
                for (int e = 0; e < 4; ++e) o[e] = gk * (acc[mt][nt][e] + ((16 * mt + 4 * q3 + e) == (16 * nt + n3) ? 1.f : 0.f));
                bf16* dst = KDo + slot0 + (size_t)(16 * nt + n3) * 512 + 16 * mt + 4 * q3;
                *(unsigned long long*)dst = (unsigned long long)pk2(o[0], o[1]) | ((unsigned long long)pk2(o[2], o[3]) << 32); } }
        }
    }
    {
#pragma unroll
        for (int mh = 0; mh < 2; ++mh) {
        f32x4 acc[4][4];
#pragma unroll
        for (int mt = 2 * mh; mt < 2 * mh + 2; ++mt)
#pragma unroll
            for (int nt = 0; nt < 4; ++nt) acc[mt][nt] = (f32x4){0.f, 0.f, 0.f, 0.f};
        MM_LOOPH(acc, frag_tr(IB, 32 * ks, 16 * mt, lane), frag_tr(IU, 32 * ks, 16 * nt, lane));
        MM_LOOPH(acc, frag_tr(IK, 32 * ks, 16 * mt, lane), frag_tr(IV, 32 * ks, 16 * nt, lane));
#pragma unroll
        for (int mt = 2 * mh; mt < 2 * mh + 2; ++mt) { float gk[4];
#pragma unroll
            for (int e = 0; e < 4; ++e) gk[e] = __shfl(GT, 16 * mt + 4 * q3 + e);
#pragma unroll
            for (int nt = 0; nt < 4; ++nt) { bf16* dst = BBo + slot0 + (size_t)(16 * nt + n3) * 512 + 16 * mt + 4 * q3;
                *(unsigned long long*)dst = (unsigned long long)pk2(gk[0] * acc[mt][nt][0], gk[1] * acc[mt][nt][1]) | ((unsigned long long)pk2(gk[2] * acc[mt][nt][2], gk[3] * acc[mt][nt][3]) << 32); } }
        }
    }
    LDS_WAIT(); CFENCE();
}
DI unsigned long long pk4(const f32x4& v) { return (unsigned long long)pk2(v[0], v[1]) | ((unsigned long long)pk2(v[2], v[3]) << 32); }
DI f32x4 unpk4(unsigned long long w) { return (f32x4){bflo((unsigned)w), bfhi((unsigned)w), bflo((unsigned)(w >> 32)), bfhi((unsigned)(w >> 32))}; }
DI s16x8 pack_cpair(const f32x4& lo, const f32x4& hi) {
    v4u p; p.x = pk2(lo[0], lo[1]); p.y = pk2(lo[2], lo[3]); p.z = pk2(hi[0], hi[1]); p.w = pk2(hi[2], hi[3]);
    return __builtin_bit_cast(s16x8, p);
}
DI void rwkv_pass2_wave(unsigned char* ws, int w  , int lane) {
    const int z = w >> 5, h = (w >> 2) & 7, vs = w & 3;
    const bf16* Mm = (const bf16*)(ws + (z ? WS_KD1 : WS_KD0)); const bf16* Nn = (const bf16*)(ws + (z ? WS_B1 : WS_B0));
    bf16* Hst = (bf16*)(ws + (z ? WS_V : WS_R));
    const int n_ = lane & 15, q_ = lane >> 4;
    f32x4 H[4];
#pragma unroll
    for (int kt = 0; kt < 4; ++kt) H[kt] = (f32x4){0.f, 0.f, 0.f, 0.f};
    unsigned long long ma[4][2][2], nn[4];
    {
        const int cn = z ? 255 : 0; const size_t slot0 = (size_t)cn * 64 * 512 + h * 64;
#pragma unroll
        for (int kt = 0; kt < 4; ++kt) {
#pragma unroll
            for (int ks = 0; ks < 2; ++ks) { const bf16* row = Mm + slot0 + (size_t)(16 * kt + n_) * 512 + 32 * ks + 4 * q_;
                ma[kt][ks][0] = *(const unsigned long long*)row; ma[kt][ks][1] = *(const unsigned long long*)(row + 16); }
            nn[kt] = *(const unsigned long long*)(Nn + slot0 + (size_t)(16 * vs + n_) * 512 + 16 * kt + 4 * q_); }
    }
    for (int c = 0; c < 256; ++c) {
        { bf16* dst = Hst + ((size_t)(c * 8 + h) * 64 + 16 * vs + n_) * 64 + 4 * q_;
#pragma unroll
          for (int kt = 0; kt < 4; ++kt) *(unsigned long long*)(dst + 16 * kt) = (unsigned long long)pk2(H[kt][0], H[kt][1]) | ((unsigned long long)pk2(H[kt][2], H[kt][3]) << 32); }
        unsigned long long ma2[4][2][2], nn2[4];
        { const int c2 = c + 1 < 256 ? c + 1 : c; const int cn = z ? 255 - c2 : c2; const size_t slot0 = (size_t)cn * 64 * 512 + h * 64;
#pragma unroll
          for (int kt = 0; kt < 4; ++kt) {
#pragma unroll
            for (int ks = 0; ks < 2; ++ks) { const bf16* row = Mm + slot0 + (size_t)(16 * kt + n_) * 512 + 32 * ks + 4 * q_;
                ma2[kt][ks][0] = *(const unsigned long long*)row; ma2[kt][ks][1] = *(const unsigned long long*)(row + 16); }
            nn2[kt] = *(const unsigned long long*)(Nn + slot0 + (size_t)(16 * vs + n_) * 512 + 16 * kt + 4 * q_); } }
        const s16x8 b0 = pack_cpair(H[0], H[1]), b1 = pack_cpair(H[2], H[3]);
#pragma unroll
        for (int kt = 0; kt < 4; ++kt) {
            f32x4 acc = (f32x4){bflo((unsigned)nn[kt]), bfhi((unsigned)nn[kt]), bflo((unsigned)(nn[kt] >> 32)), bfhi((unsigned)(nn[kt] >> 32))};
            { v4u a; a.x = (unsigned)ma[kt][0][0]; a.y = (unsigned)(ma[kt][0][0] >> 32); a.z = (unsigned)ma[kt][0][1]; a.w = (unsigned)(ma[kt][0][1] >> 32); acc = mfma16(__builtin_bit_cast(s16x8, a), b0, acc); }
            { v4u a; a.x = (unsigned)ma[kt][1][0]; a.y = (unsigned)(ma[kt][1][0] >> 32); a.z = (unsigned)ma[kt][1][1]; a.w = (unsigned)(ma[kt][1][1] >> 32); acc = mfma16(__builtin_bit_cast(s16x8, a), b1, acc); }
            H[kt] = acc;
        }
#pragma unroll
        for (int kt = 0; kt < 4; ++kt) { nn[kt] = nn2[kt];
#pragma unroll
            for (int ks = 0; ks < 2; ++ks) { ma[kt][ks][0] = ma2[kt][ks][0]; ma[kt][ks][1] = ma2[kt][ks][1]; } }
    }
}
DI void rwkv_pass3_item(unsigned char* ws, int item, int lane) {
    const int z = item >> 11, h = (item >> 8) & 7, c = item & 255;
    const int cn = z ? 255 - c : c;
    const float* LW = (const float*)(ws + (z ? WS_LW1 : WS_LW0));
    const bf16* Hst = (const bf16*)(ws + (z ? WS_V : WS_R)) + (size_t)(c * 8 + h) * 64 * 64;
    bf16* Y = (bf16*)(ws + (z ? WS_Y1 : WS_Y0));
    const int n_ = lane & 15, q_ = lane >> 4;
    const size_t slot0 = (size_t)cn * 64 * 512 + h * 64;
    s16x8 hA[4][2], qB[4][2];
#pragma unroll
    for (int t = 0; t < 4; ++t)
#pragma unroll
        for (int ks = 0; ks < 2; ++ks) {
            hA[t][ks] = *(const s16x8*)(Hst + (size_t)(16 * t + n_) * 64 + 32 * ks + 8 * q_);
            qB[t][ks] = *(const s16x8*)((const bf16*)(LW + slot0 + (size_t)(16 * t + n_) * 512) + 32 * ks + 8 * q_); }
#pragma unroll
    for (int nt = 0; nt < 4; ++nt) {
        const int i = 16 * nt + n_; const bf16* ycrow = (const bf16*)(LW + slot0 + (size_t)i * 512) + 64;
        bf16* yrow = Y + (size_t)tok_of(z, cn, i) * 512 + h * 64;
#pragma unroll
        for (int mt = 0; mt < 4; ++mt) {
            const unsigned long long y4 = *(const unsigned long long*)(ycrow + 16 * mt + 4 * q_);
            f32x4 acc = (f32x4){bflo((unsigned)y4), bfhi((unsigned)y4), bflo((unsigned)(y4 >> 32)), bfhi((unsigned)(y4 >> 32))};
            acc = mfma16(hA[mt][0], qB[nt][0], acc); acc = mfma16(hA[mt][1], qB[nt][1], acc);
            *(unsigned long long*)(yrow + 16 * mt + 4 * q_) = (unsigned long long)pk2(acc[0], acc[1]) | ((unsigned long long)pk2(acc[2], acc[3]) << 32);
        }
    }
}
DI void rwkv_pass2_block(unsigned char* ws, ldsp L, int b  , int wave, int lane) {
    const int z = b >> 3, h = b & 7;
    if (wave >= 4) {
        const int lw = wave - 4;
        const char* Mm = (const char*)(ws + (z ? WS_KD1 : WS_KD0)); const char* Nn = (const char*)(ws + (z ? WS_B1 : WS_B0));
#define RW_ISSUE(cc) do { const int c_ = (cc); if (c_ < 256) { const int cn_ = z ? 255 - c_ : c_; const size_t slot0 = ((size_t)cn_ * 64 * 512 + h * 64) * 2; ldsp slot = L + (c_ & 7) * 16384; \
            _Pragma("unroll") for (int k = 0; k < 4; ++k) { const int pid = lw * 4 + k; const int pr = pid & 7; const int row = 8 * pr + (lane >> 3), p = lane & 7, cch = p ^ (row & 7); \
                const char* src = (pid < 8 ? Mm : Nn) + slot0 + (size_t)row * 1024 + cch * 16; \
                __builtin_amdgcn_global_load_lds((const unsigned*)src, (LAS unsigned*)(slot + (pid < 8 ? 0 : 8192) + pr * 1024), 16, 0, 0); } } } while (0)
        RW_ISSUE(0); RW_ISSUE(1); RW_ISSUE(2); RW_ISSUE(3); RW_ISSUE(4); RW_ISSUE(5); RW_ISSUE(6);
        for (int c = 0; c < 256; ++c) {
            if (c < 250) asm volatile("s_waitcnt vmcnt(24)" ::: "memory"); else asm volatile("s_waitcnt vmcnt(0)" ::: "memory");
            __builtin_amdgcn_s_barrier();
            asm volatile("" ::: "memory");
            RW_ISSUE(c + 7);
        }
#undef RW_ISSUE
        asm volatile("s_waitcnt vmcnt(0)" ::: "memory");
        return;
    }
    const int vs = wave;
    bf16* Hst = (bf16*)(ws + (z ? WS_V : WS_R));
    const int n_ = lane & 15, q_ = lane >> 4, wbyte = (q_ & 1) * 8, sw = n_ & 7;
    f32x4 H[4];
#pragma unroll
    for (int kt = 0; kt < 4; ++kt) H[kt] = (f32x4){0.f, 0.f, 0.f, 0.f};
    for (int c = 0; c < 256; ++c) {
        { bf16* dst = Hst + ((size_t)(c * 8 + h) * 64 + 16 * vs + n_) * 64 + 4 * q_;
#pragma unroll
          for (int kt = 0; kt < 4; ++kt) *(unsigned long long*)(dst + 16 * kt) = pk4(H[kt]); }
        asm volatile("s_waitcnt lgkmcnt(0)" ::: "memory");
        __builtin_amdgcn_s_barrier();
        asm volatile("" ::: "memory");
        ldsp slot = L + (c & 7) * 16384;
        const s16x8 b0 = pack_cpair(H[0], H[1]), b1 = pack_cpair(H[2], H[3]);
#pragma unroll
        for (int kt = 0; kt < 4; ++kt) {
            ldsp nrow = slot + 8192 + (16 * vs + n_) * 128 + wbyte;
            f32x4 acc = unpk4(*(LAS const unsigned long long*)(nrow + (((2 * kt + (q_ >> 1)) ^ sw) * 16)));
            ldsp mrow = slot + (16 * kt + n_) * 128 + wbyte;
#pragma unroll
            for (int ks = 0; ks < 2; ++ks) { const int c0 = 4 * ks + (q_ >> 1);
                const unsigned long long a0 = *(LAS const unsigned long long*)(mrow + ((c0 ^ sw) * 16)), a1 = *(LAS const unsigned long long*)(mrow + (((c0 + 2) ^ sw) * 16));
                v4u a; a.x = (unsigned)a0; a.y = (unsigned)(a0 >> 32); a.z = (unsigned)a1; a.w = (unsigned)(a1 >> 32);
                acc = mfma16(__builtin_bit_cast(s16x8, a), ks == 0 ? b0 : b1, acc); }
            H[kt] = acc;
        }
    }
}
DI void rwkv_pass3_post_item(const Args& a, unsigned char* ws, int item, int lane) {
    asm volatile("" : "+v"(lane));
    const int h = item >> 8, cn = item & 255;
    const int n_ = lane & 15, q_ = lane >> 4;
    const size_t slot0 = (size_t)cn * 64 * 512 + h * 64;
    const float* LW0 = (const float*)(ws + WS_LW0); const float* LW1 = (const float*)(ws + WS_LW1);
    const bf16* H0 = (const bf16*)(ws + WS_R) + (size_t)(cn * 8 + h) * 4096;
    const bf16* H1 = (const bf16*)(ws + WS_V) + (size_t)((255 - cn) * 8 + h) * 4096;
    s16x8 hA0[4][2], hA1[4][2];
#pragma unroll
    for (int t = 0; t < 4; ++t)
#pragma unroll
        for (int ks = 0; ks < 2; ++ks) { hA0[t][ks] = *(const s16x8*)(H0 + (size_t)(16 * t + n_) * 64 + 32 * ks + 8 * q_); hA1[t][ks] = *(const s16x8*)(H1 + (size_t)(16 * t + n_) * 64 + 32 * ks + 8 * q_); }
#pragma unroll
    for (int nt = 0; nt < 4; ++nt) {
        const int i0 = 16 * nt + n_, i1 = 63 - i0;
        const bf16* q0 = (const bf16*)(LW0 + slot0 + (size_t)i0 * 512); const bf16* q1 = (const bf16*)(LW1 + slot0 + (size_t)i1 * 512);
        s16x8 qB0[2], qB1[2];
#pragma unroll
        for (int ks = 0; ks < 2; ++ks) { qB0[ks] = *(const s16x8*)(q0 + 32 * ks + 8 * q_); qB1[ks] = *(const s16x8*)(q1 + 32 * ks + 8 * q_); }
        f32x4 y[4]; float sum = 0.f;
#pragma unroll
        for (int mt = 0; mt < 4; ++mt) {
            f32x4 acc = unpk4(*(const unsigned long long*)(q0 + 64 + 16 * mt + 4 * q_)) + unpk4(*(const unsigned long long*)(q1 + 64 + 16 * mt + 4 * q_));
            acc = mfma16(hA0[mt][0], qB0[0], acc); acc = mfma16(hA0[mt][1], qB0[1], acc);
            acc = mfma16(hA1[mt][0], qB1[0], acc); acc = mfma16(hA1[mt][1], qB1[1], acc);
            y[mt] = acc; sum += (acc[0] + acc[1]) + (acc[2] + acc[3]);
        }
        sum += __shfl_xor(sum, 16); sum += __shfl_xor(sum, 32);
        const float mu = sum * (1.0f / 64.f); float sq = 0.f;
#pragma unroll
        for (int mt = 0; mt < 4; ++mt)
#pragma unroll
            for (int e = 0; e < 4; ++e) { y[mt][e] -= mu; sq += y[mt][e] * y[mt][e]; }
        sq += __shfl_xor(sq, 16); sq += __shfl_xor(sq, 32);
        const float rs = 1.0f / sqrtf(sq * (1.0f / 64.f) + 64e-5f);
        const size_t tok = (size_t)(cn * 64 + i0);
#pragma unroll
        for (int mt = 0; mt < 4; ++mt) { const int c0 = h * 64 + 16 * mt + 4 * q_;
            const f32x4 lw = *(const f32x4*)(a.in[19] + c0), lb = *(const f32x4*)(a.in[20] + c0);
            const f32x4 bn = unpk4(*(const unsigned long long*)((const bf16*)(ws + WS_BONUS) + tok * 512 + c0)), gt = unpk4(*(const unsigned long long*)((const bf16*)(ws + WS_GATE) + tok * 512 + c0));
            const f32x4 o = (y[mt] * rs * lw + lb + bn) * gt;
            *(unsigned long long*)((bf16*)(ws + WS_Y) + tok * D_ + 512 + c0) = pk4(o); }
    }
}
constexpr size_t WS_W2T = WS_TILE + 65536;
constexpr size_t WS_PARK = WS_Y;
DI s16x8 act_frag(const bf16* p, int mode) {
    float v[8]; ld8(p, v);
#pragma unroll
    for (int i = 0; i < 8; ++i) { if (mode == 0) v[i] = 1.0f - 2.0f / (__expf(2.0f * v[i]) + 1.0f); else if (mode == 2) v[i] = 1.0f / (1.0f + __expf(-v[i])); }
    v4u w; w.x = pk2(v[0], v[1]); w.y = pk2(v[2], v[3]); w.z = pk2(v[4], v[5]); w.w = pk2(v[6], v[7]);
    return __builtin_bit_cast(s16x8, w);
}
DI void ld4(const bf16* p, float (&v)[4]) { const unsigned long long w = *(const unsigned long long*)p; v[0] = bflo((unsigned)w); v[1] = bfhi((unsigned)w); v[2] = bflo((unsigned)(w >> 32)); v[3] = bfhi((unsigned)(w >> 32)); }
DI void st4(bf16* p, const float (&v)[4]) { *(unsigned long long*)p = (unsigned long long)pk2(v[0], v[1]) | ((unsigned long long)pk2(v[2], v[3]) << 32); }
template <bool WLDS> DI void prep0_rwkv_unit(const Args& a, unsigned char* ws_, ldsp wl, int tile, int h, int lane) {
    asm volatile("" : "+v"(lane));
    GAS unsigned char* wsg = (GAS unsigned char*)ws_; asm volatile("" : "+s"(wsg)); unsigned char* ws = (unsigned char*)wsg;
    const int t0 = tile * 16, n_ = lane & 15, q_ = lane >> 4, t = t0 + n_;
    const bf16* LR = (const bf16*)(ws + WS_LORA) + (size_t)t * LORA_N + 8 * q_;
    const bf16* P = (const bf16*)(ws + WS_PROJ0) + (size_t)t * EVEN_IN + 1536 + h * 64 + 4 * q_;
    const bool hp = t > 0, hn = t < S_ - 1;
    unsigned long long cu[3][4], pv[3][4], nx[3][4];
#pragma unroll
    for (int part = 0; part < 3; ++part)
#pragma unroll
        for (int mt = 0; mt < 4; ++mt) { const bf16* p = P + part * 512 + 16 * mt;
            cu[part][mt] = *(const unsigned long long*)p; pv[part][mt] = hp ? *(const unsigned long long*)(p - EVEN_IN) : 0ull; nx[part][mt] = hn ? *(const unsigned long long*)(p + EVEN_IN) : 0ull; }
    unsigned long long rkv[3][4];
#pragma unroll
    for (int part = 0; part < 3; ++part)
#pragma unroll
        for (int mt = 0; mt < 4; ++mt) { const int c0 = h * 64 + 16 * mt + 4 * q_;
            const f32x4 m0 = *(const f32x4*)(a.in[6] + part * 512 + c0), m1 = *(const f32x4*)(a.in[6] + 1536 + part * 512 + c0);
            const f32x4 c4 = unpk4(cu[part][mt]), p4 = unpk4(pv[part][mt]), n4 = unpk4(nx[part][mt]);
            rkv[part][mt] = pk4(c4 + m0 * (p4 - c4) + m1 * (n4 - c4)); }
    asm volatile("" ::: "memory");
    v4u lraw[12];
#pragma unroll
    for (int i = 0; i < 12; ++i) lraw[i] = *(const v4u*)(LR + 32 * i);
    float ss = 0.f;
#pragma unroll
    for (int mt = 0; mt < 4; ++mt) { const f32x4 kkw = *(const f32x4*)(a.in[16] + h * 64 + 16 * mt + 4 * q_);
        const f32x4 k4 = unpk4(rkv[1][mt]);
#pragma unroll
        for (int e = 0; e < 4; ++e) { const float x = k4[e] * kkw[e]; ss += x * x; } }
    ss += __shfl_xor(ss, 16); ss += __shfl_xor(ss, 32);
    const float rn = 1.0f / sqrtf(ss + 1e-6f);
    s16x8 lfr[12];
#pragma unroll
    for (int i = 0; i < 12; ++i) { float x[8]; const v4u w = lraw[i];
        x[0] = bflo(w.x); x[1] = bfhi(w.x); x[2] = bflo(w.y); x[3] = bfhi(w.y); x[4] = bflo(w.z); x[5] = bfhi(w.z); x[6] = bflo(w.w); x[7] = bfhi(w.w);
#pragma unroll
        for (int j = 0; j < 8; ++j) { if (i < 4) x[j] = 1.0f - 2.0f * __builtin_amdgcn_rcpf(__expf(2.0f * x[j]) + 1.0f); else if (i >= 8) x[j] = __builtin_amdgcn_rcpf(1.0f + __expf(-x[j])); }
        v4u o; o.x = pk2(x[0], x[1]); o.y = pk2(x[2], x[3]); o.z = pk2(x[4], x[5]); o.w = pk2(x[6], x[7]); lfr[i] = __builtin_bit_cast(s16x8, o); }
    float dotb = 0.f;
#pragma unroll
    for (int mt = 0; mt < 4; ++mt) {
        const int c0 = h * 64 + 16 * mt + 4 * q_;
        f32x4 aw0 = *(const f32x4*)(a.in[8] + c0), aw1 = *(const f32x4*)(a.in[8] + 512 + c0), aa0 = *(const f32x4*)(a.in[11] + c0), aa1 = *(const f32x4*)(a.in[11] + 512 + c0), ag = (f32x4){0.f, 0.f, 0.f, 0.f};
        const int rl = 16 * mt + n_, sw = rl & 7;
        if (WLDS) {
#pragma unroll
            for (int ks = 0; ks < 2; ++ks) { const int po = ((4 * ks + q_) ^ sw) * 16;
                aw0 = mfma16(*(LAS const s16x8*)(wl + rl * 128 + po), lfr[ks], aw0);
                aw1 = mfma16(*(LAS const s16x8*)(wl + 8192 + rl * 128 + po), lfr[2 + ks], aw1);
                aa0 = mfma16(*(LAS const s16x8*)(wl + 16384 + rl * 128 + po), lfr[4 + ks], aa0);
                aa1 = mfma16(*(LAS const s16x8*)(wl + 24576 + rl * 128 + po), lfr[6 + ks], aa1);
            }
#pragma unroll
            for (int ks = 0; ks < 4; ++ks) ag = mfma16(*(LAS const s16x8*)(wl + 32768 + rl * 256 + ((((4 * ks + q_) & 8) | (((4 * ks + q_) & 7) ^ sw)) * 16)), lfr[8 + ks], ag);
        } else {
            const bf16* W2T = (const bf16*)(ws + WS_W2T); const size_t cr = (size_t)(h * 64 + rl);
#pragma unroll
            for (int ks = 0; ks < 2; ++ks) {
                aw0 = mfma16(*(const s16x8*)(W2T + cr * 64 + 32 * ks + 8 * q_), lfr[ks], aw0);
                aw1 = mfma16(*(const s16x8*)(W2T + 32768 + cr * 64 + 32 * ks + 8 * q_), lfr[2 + ks], aw1);
                aa0 = mfma16(*(const s16x8*)(W2T + 65536 + cr * 64 + 32 * ks + 8 * q_), lfr[4 + ks], aa0);
                aa1 = mfma16(*(const s16x8*)(W2T + 98304 + cr * 64 + 32 * ks + 8 * q_), lfr[6 + ks], aa1);
            }
#pragma unroll
            for (int ks = 0; ks < 4; ++ks) ag = mfma16(*(const s16x8*)(W2T + 131072 + cr * 128 + 32 * ks + 8 * q_), lfr[8 + ks], ag);
        }
        const f32x4 kkw = *(const f32x4*)(a.in[16] + c0), kaw = *(const f32x4*)(a.in[17] + c0), rkw = *(const f32x4*)(a.in[18] + c0);
        float l0[4], l1[4], g4[4], d0[4], d1[4], kk4[4], b0[4], b1[4];
        const f32x4 r4 = unpk4(rkv[0][mt]), k4 = unpk4(rkv[1][mt]);
#pragma unroll
        for (int e = 0; e < 4; ++e) {
            l0[e] = -__expf(-__logf(1.0f + __expf(-aw0[e])) - 0.5f); l1[e] = -__expf(-__logf(1.0f + __expf(-aw1[e])) - 0.5f);
            const float i0 = __builtin_amdgcn_rcpf(1.0f + __expf(-aa0[e])), i1 = __builtin_amdgcn_rcpf(1.0f + __expf(-aa1[e])); g4[e] = ag[e];
            kk4[e] = k4[e] * kkw[e] * rn; b0[e] = kk4[e] * i0; b1[e] = kk4[e] * i1;
            d0[e] = k4[e] * (1.0f + (i0 - 1.0f) * kaw[e]); d1[e] = k4[e] * (1.0f + (i1 - 1.0f) * kaw[e]);
            dotb += r4[e] * (d0[e] + d1[e]) * rkw[e]; }
        const size_t o = (size_t)t * 512 + c0;
        *(f32x4*)((float*)(ws + WS_LW0) + o) = (f32x4){l0[0], l0[1], l0[2], l0[3]};
        *(f32x4*)((float*)(ws + WS_LW1) + o) = (f32x4){l1[0], l1[1], l1[2], l1[3]};
        *(unsigned long long*)((bf16*)(ws + WS_R) + o) = rkv[0][mt]; *(unsigned long long*)((bf16*)(ws + WS_V) + o) = rkv[2][mt]; st4((bf16*)(ws + WS_KK) + o, kk4); st4((bf16*)(ws + WS_KD0) + o, d0); st4((bf16*)(ws + WS_KD1) + o, d1);
        st4((bf16*)(ws + WS_B0) + o, b0); st4((bf16*)(ws + WS_B1) + o, b1); st4((bf16*)(ws + WS_GATE) + o, g4);
        if (!WLDS) asm volatile("" ::: "memory");
    }
    dotb += __shfl_xor(dotb, 16); dotb += __shfl_xor(dotb, 32);
#pragma unroll
    for (int mt = 0; mt < 4; ++mt) { float bo[4]; const f32x4 v4 = unpk4(rkv[2][mt]);
#pragma unroll
        for (int e = 0; e < 4; ++e) bo[e] = dotb * v4[e];
        st4((bf16*)(ws + WS_BONUS) + (size_t)t * 512 + h * 64 + 16 * mt + 4 * q_, bo); }
}
DI void prep0_stage_w2t(unsigned char* ws, ldsp wl, int h, int tid) {
    const bf16* W2T = (const bf16*)(ws + WS_W2T);
    for (int i = tid; i < 3072; i += 512) {
        if (i < 2048) { const int mtx = i >> 9, r = (i >> 3) & 63, c = i & 7;
            *(LAS v4u*)(wl + mtx * 8192 + r * 128 + ((c ^ (r & 7)) * 16)) = *(const v4u*)(W2T + (size_t)mtx * 32768 + (size_t)(h * 64 + r) * 64 + c * 8); }
        else { const int j = i - 2048, r = j >> 4, c = j & 15;
            *(LAS v4u*)(wl + 32768 + r * 256 + (((c & 8) | ((c & 7) ^ (r & 7))) * 16)) = *(const v4u*)(W2T + 131072 + (size_t)(h * 64 + r) * 128 + c * 8); }
    }
}
constexpr int AT_ACC = 0, AT_M = 65536, AT_L = 66560, AT_V = 67584;
DI void attn_unit(unsigned char* ws, ldsp L, int unit, int wave, int lane) {
    const int h = unit & 7, T0 = (unit >> 3) * 256;
    const bf16* QN = (const bf16*)(ws + WS_QN); const bf16* KN = (const bf16*)(ws + WS_KN); const bf16* VN = (const bf16*)(ws + WS_Y1);
    LAS float* accO = (LAS float*)(L + AT_ACC); LAS float* accM = (LAS float*)(L + AT_M); LAS float* accL = (LAS float*)(L + AT_L);
    ldsp Vst = L + AT_V + wave * 8192;
#pragma unroll 1
    for (int br = 0; br < 3; ++br) {
        const int d = br == 0 ? 1 : (br == 1 ? 4 : 16);
#pragma unroll 1
        for (int si = 0; si < 2; ++si) {
            int lane_s = lane; asm volatile("" : "+v"(lane_s));
            const int n_ = lane_s & 15, q_ = lane_s >> 4;
            const int sidx = wave + 8 * si;
            const int tb = br == 0 ? T0 + 16 * sidx : (br == 1 ? T0 + (sidx & 3) + 64 * (sidx >> 2) : T0 + sidx);
            s16x8 qf[2];
            { const bf16* qrow = QN + (size_t)(tb + d * n_) * 512 + h * 64 + 8 * q_; qf[0] = *(const s16x8*)qrow; qf[1] = *(const s16x8*)(qrow + 32); }
            v4u vreg[5][4];
#pragma unroll
            for (int pp = 0; pp < 5; ++pp)
#pragma unroll
                for (int it = 0; it < 4; ++it) { const int pc = lane + 64 * it, row = pc >> 3, ck = pc & 7;
                    int tk = tb + d * (32 * pp + row - 64); tk = tk < 0 ? 0 : (tk > S_ - 1 ? S_ - 1 : tk);
                    vreg[pp][it] = *(const v4u*)(VN + (size_t)tk * 512 + h * 64 + ck * 8); }
            f32x4 st[10]; st[9] = (f32x4){0.f, 0.f, 0.f, 0.f};
#pragma unroll
            for (int kt = 0; kt < 9; ++kt) {
                int tk = tb + d * (16 * kt + n_ - 64); tk = tk < 0 ? 0 : (tk > S_ - 1 ? S_ - 1 : tk);
                const bf16* krow = KN + (size_t)tk * 512 + h * 64 + 8 * q_;
                f32x4 acc = (f32x4){0.f, 0.f, 0.f, 0.f};
                acc = mfma16(*(const s16x8*)krow, qf[0], acc); acc = mfma16(*(const s16x8*)(krow + 32), qf[1], acc);
                st[kt] = acc;
            }
            float mx = -3.0e38f;
            const bool edge = (tb - 64 * d < 0) || (tb + d * 95 >= S_);
#pragma unroll
            for (int kt = 0; kt < 9; ++kt)
#pragma unroll
                for (int e = 0; e < 4; ++e) { const int j = 16 * kt + 4 * q_ + e;
                    bool ok = true;
                    if (kt == 0) ok = (j >= n_);
                    if (kt == 8) ok = (j <= n_ + 128);
                    if (edge) { const int tk = tb + d * (j - 64); ok = ok && (tk >= 0) && (tk < S_); }
                    st[kt][e] = ok ? st[kt][e] : -3.0e38f; mx = fmaxf(mx, st[kt][e]); }
            mx = fmaxf(mx, __shfl_xor(mx, 16)); mx = fmaxf(mx, __shfl_xor(mx, 32));
            float ls = 0.f;
#pragma unroll
            for (int kt = 0; kt < 9; ++kt)
#pragma unroll
                for (int e = 0; e < 4; ++e) { const float p = st[kt][e] > -1.0e38f ? __expf(st[kt][e] - mx) : 0.f; st[kt][e] = p; ls += p; }
            ls += __shfl_xor(ls, 16); ls += __shfl_xor(ls, 32);
            f32x4 O[4];
#pragma unroll
            for (int dt = 0; dt < 4; ++dt) O[dt] = (f32x4){0.f, 0.f, 0.f, 0.f};
#pragma unroll
            for (int pp = 0; pp < 5; ++pp) {
                ldsp vb = Vst + (pp & 1) * 4096;
#pragma unroll
                for (int it = 0; it < 4; ++it) { const int pc = lane + 64 * it, row = pc >> 3, ck = pc & 7; *(LAS v4u*)(vb + row * 128 + ck * 16) = vreg[pp][it]; }
                LDS_WAIT(); CFENCE();
                const s16x8 pa = pack_cpair(st[2 * pp], st[2 * pp + 1]);
                ldsp a0 = vb + (4 * q_ + ((lane & 15) >> 2)) * 128 + 8 * (lane & 3);
#pragma unroll
                for (int dt = 0; dt < 4; ++dt) { const s16x4 lo = tr16(a0 + 32 * dt), hi = tr16(a0 + 16 * 128 + 32 * dt);
                    O[dt] = mfma16(pa, __builtin_shufflevector(lo, hi, 0, 1, 2, 3, 4, 5, 6, 7), O[dt]); }
            }
            float ms[4], lsv[4]; int li[4];
#pragma unroll
            for (int e = 0; e < 4; ++e) { ms[e] = __shfl(mx, 4 * q_ + e); lsv[e] = __shfl(ls, 4 * q_ + e); li[e] = tb + d * (4 * q_ + e) - T0; }
            if (br == 0) {
#pragma unroll
                for (int e = 0; e < 4; ++e) {
#pragma unroll
                    for (int dt = 0; dt < 4; ++dt) accO[li[e] * 64 + 16 * dt + n_] = O[dt][e];
                    if (n_ == 0) { accM[li[e]] = ms[e]; accL[li[e]] = lsv[e]; } }
            } else {
                float fo[4], fn[4], mn[4], lo_[4];
#pragma unroll
                for (int e = 0; e < 4; ++e) { const float mo = accM[li[e]]; lo_[e] = accL[li[e]]; mn[e] = fmaxf(mo, ms[e]); fo[e] = __expf(mo - mn[e]); fn[e] = __expf(ms[e] - mn[e]); }
                LDS_WAIT(); CFENCE();
#pragma unroll
                for (int e = 0; e < 4; ++e) {
#pragma unroll
                    for (int dt = 0; dt < 4; ++dt) { LAS float* p = accO + li[e] * 64 + 16 * dt + n_; *p = *p * fo[e] + O[dt][e] * fn[e]; }
                    if (n_ == 0) { accM[li[e]] = mn[e]; accL[li[e]] = lo_[e] * fo[e] + lsv[e] * fn[e]; } }
            }
            LDS_WAIT(); CFENCE();
        }
        __syncthreads();
    }
    {
        const int tid = wave * 64 + lane, tl = tid >> 1, hf = tid & 1;
        const float il = 1.0f / accL[tl];
        const LAS float* src = accO + tl * 64 + 32 * hf; bf16* dst = (bf16*)(ws + WS_Y) + (size_t)(T0 + tl) * D_ + h * 64 + 32 * hf;
#pragma unroll
        for (int c = 0; c < 4; ++c) { const f32x4 a = *(LAS const f32x4*)(src + 8 * c), b = *(LAS const f32x4*)(src + 8 * c + 4);
            v4u w; w.x = pk2(a.x * il, a.y * il); w.y = pk2(a.z * il, a.w * il); w.z = pk2(b.x * il, b.y * il); w.w = pk2(b.z * il, b.w * il);
            *(v4u*)(dst + 8 * c) = w; }
    }
    __syncthreads();
}
constexpr size_t WS_SST = WS_PROJ1, WS_UB = WS_PROJ1 + 64 * MiB, WS_AT = WS_PROJ1 + 96 * MiB, WS_GC = WS_PROJ1 + 112 * MiB;
constexpr size_t WS_WN = WS_A + 112 * MiB, WS_KT = WS_A + 144 * MiB;
static_assert(WS_GC + 2048 * 64 * 4 <= WS_O0, "dn map");
template <int PITCH> DI s16x8 frag_row_p(ldsp img, int row0, int col0, int lane) { return *(LAS const s16x8*)(img + (row0 + (lane & 15)) * PITCH + (col0 + 8 * (lane >> 4)) * 2); }
template <int PITCH> DI s16x8 frag_tr_p(ldsp img, int row0, int col0, int lane) {
    ldsp a0 = img + (row0 + 8 * (lane >> 4) + ((lane & 15) >> 2)) * PITCH + col0 * 2 + 8 * (lane & 3);
    const s16x4 lo = tr16(a0), hi = tr16(a0 + 4 * PITCH);
    return __builtin_shufflevector(lo, hi, 0, 1, 2, 3, 4, 5, 6, 7);
}
constexpr int DN_LDS_PER_WAVE = 32768 + 512;
DI void dn_pass1_item(unsigned char* ws, ldsp lds, int item, int lane) {
    asm volatile("" : "+v"(lane));
    const int z = item >> 10, h = (item >> 8) & 3, c = item & 255, cn = z ? 255 - c : c;
    const bf16* Q = (const bf16*)(ws + WS_QD); const bf16* K = (const bf16*)(ws + WS_KD); const bf16* V = (const bf16*)(ws + WS_VD);
    ldsp IKd = lds, IVd = lds, LT = lds + 16384; LAS float* gcs = (LAS float*)(lds + 32768); LAS float* bts = gcs + 64;
    const int n_ = lane & 15, q_ = lane >> 4;
    {
        const int tok = tok_of(z, cn, lane);
        float gc = ((const float*)(ws + WS_GB))[(size_t)tok * 8 + z * 4 + h]; const float bt = ((const float*)(ws + WS_GB + 512 * 1024))[(size_t)tok * 8 + z * 4 + h];
#pragma unroll
        for (int o = 1; o < 64; o <<= 1) { const float t = __shfl_up(gc, o); if (lane >= o) gc += t; }
        gcs[lane] = gc; bts[lane] = bt; ((float*)(ws + WS_GC))[(size_t)item * 64 + lane] = gc;
    }
#pragma unroll 4
    for (int it = 0; it < 16; ++it) { const int p = lane + 64 * it, row = p >> 4, ck = p & 15; const size_t go = (size_t)tok_of(z, cn, row) * 512 + h * 128 + ck * 8;
        *(LAS v4u*)(IKd + row * 256 + ck * 16) = *(const v4u*)(K + go); }
    LDS_WAIT(); CFENCE();
    s16x8 kf[4][4];
#pragma unroll
    for (int rt = 0; rt < 4; ++rt)
#pragma unroll
        for (int ks = 0; ks < 4; ++ks) kf[rt][ks] = frag_row_p<256>(IKd, 16 * rt, 32 * ks, lane);
#pragma unroll
    for (int mt = 0; mt < 4; ++mt) { f32x4 gi, bi;
#pragma unroll
        for (int e = 0; e < 4; ++e) { gi[e] = gcs[16 * mt + 4 * q_ + e]; bi[e] = bts[16 * mt + 4 * q_ + e]; }
#pragma unroll
        for (int nt = 0; nt < 4; ++nt) { f32x4 acc = (f32x4){0.f, 0.f, 0.f, 0.f};
            if (nt <= mt) {
#pragma unroll
                for (int ks = 0; ks < 4; ++ks) acc = mfma16(kf[mt][ks], kf[nt][ks], acc); }
            const float gj = gcs[16 * nt + n_];
#pragma unroll
            for (int e = 0; e < 4; ++e) { const int i = 16 * mt + 4 * q_ + e, j = 16 * nt + n_; ((LAS float*)LT)[i * 64 + j] = (j < i) ? bi[e] * acc[e] * __expf(gi[e] - gj) : 0.f; } } }
    {
        bf16* At = (bf16*)(ws + WS_AT) + (size_t)item * 4096;
#pragma unroll
        for (int nt = 0; nt < 4; ++nt) { s16x8 qf[4]; const bf16* qrow = Q + (size_t)tok_of(z, cn, 16 * nt + n_) * 512 + h * 128 + 8 * q_;
#pragma unroll
            for (int ks = 0; ks < 4; ++ks) qf[ks] = *(const s16x8*)(qrow + 32 * ks);
            const float gi = gcs[16 * nt + n_];
#pragma unroll
            for (int mt = 0; mt < 4; ++mt) { f32x4 acc = (f32x4){0.f, 0.f, 0.f, 0.f};
                if (mt <= nt) {
#pragma unroll
                    for (int ks = 0; ks < 4; ++ks) acc = mfma16(kf[mt][ks], qf[ks], acc); }
                f32x4 o;
#pragma unroll
                for (int e = 0; e < 4; ++e) { const int j = 16 * mt + 4 * q_ + e, i = 16 * nt + n_; o[e] = (j <= i) ? acc[e] * __expf(gi - gcs[j]) : 0.f; }
                *(unsigned long long*)(At + (size_t)(16 * nt + n_) * 64 + 16 * mt + 4 * q_) = pk4(o); } }
    }
    LDS_WAIT(); CFENCE();
    {
        float t[64];
        int lane_o = lane; asm volatile("" : "+v"(lane_o));
        f32x4 ar[2][16];
#pragma unroll
        for (int i = 0; i < 64; ++i) {
            if (i + 1 < 64) {
#pragma unroll
                for (int jg = 0; jg < (i + 1 + 3) / 4; ++jg) ar[(i + 1) & 1][jg] = *(LAS const f32x4*)(LT + ((i + 1) * 64 + 4 * jg) * 4);
            }
            __builtin_amdgcn_sched_barrier(0);
            float acc0 = (lane_o == i) ? 1.f : 0.f, acc1 = 0.f, acc2 = 0.f, acc3 = 0.f;
#pragma unroll
            for (int jg = 0; jg < (i + 3) / 4; ++jg) { const f32x4 a4 = ar[i & 1][jg];
                if (4 * jg + 0 < i) acc0 -= a4[0] * t[4 * jg + 0];
                if (4 * jg + 1 < i) acc1 -= a4[1] * t[4 * jg + 1];
                if (4 * jg + 2 < i) acc2 -= a4[2] * t[4 * jg + 2];
                if (4 * jg + 3 < i) acc3 -= a4[3] * t[4 * jg + 3]; }
            t[i] = (acc0 + acc1) + (acc2 + acc3);
            __builtin_amdgcn_sched_barrier(0);
        }
        LDS_WAIT(); CFENCE();
        const float s1 = bts[lane], s2 = -s1 * __expf(gcs[lane]);
#pragma unroll
        for (int i = 0; i < 64; ++i) { ((LAS bf16*)LT)[i * 64 + lane] = (bf16)f2bf(t[i] * s1); ((LAS bf16*)(LT + 8192))[i * 64 + lane] = (bf16)f2bf(t[i] * s2); }
    }
    LDS_WAIT(); CFENCE();
    ldsp IT1 = LT, IT2 = LT + 8192;
    v4u vimg[16];
#pragma unroll
    for (int it = 0; it < 16; ++it) { const int p = lane + 64 * it, row = p >> 4, ck = p & 15; vimg[it] = *(const v4u*)(V + (size_t)tok_of(z, cn, row) * 512 + h * 128 + ck * 8); }
    {
        bf16* Wn = (bf16*)(ws + WS_WN) + (size_t)item * 8192;
        s16x8 tf[4][2];
#pragma unroll
        for (int nt = 0; nt < 4; ++nt)
#pragma unroll
            for (int ks = 0; ks < 2; ++ks) tf[nt][ks] = frag_row_p<128>(IT2, 16 * nt, 32 * ks, lane);
#pragma unroll
        for (int mt = 0; mt < 8; ++mt) { const s16x8 k0 = frag_tr_p<256>(IKd, 0, 16 * mt, lane), k1 = frag_tr_p<256>(IKd, 32, 16 * mt, lane);
            if (z == 0) { bf16* KT = (bf16*)(ws + WS_KT) + ((size_t)(h * 256 + cn) * 128 + 16 * mt + n_) * 64 + 8 * q_; *(s16x8*)KT = k0; *(s16x8*)(KT + 32) = k1; }
#pragma unroll
            for (int nt = 0; nt < 4; ++nt) { f32x4 acc = (f32x4){0.f, 0.f, 0.f, 0.f}; acc = mfma16(k0, tf[nt][0], acc); acc = mfma16(k1, tf[nt][1], acc);
                *(unsigned long long*)(Wn + (size_t)(16 * nt + n_) * 128 + 16 * mt + 4 * q_) = pk4(acc); } }
    }
    LDS_WAIT(); CFENCE();
#pragma unroll
    for (int it = 0; it < 16; ++it) { const int p = lane + 64 * it, row = p >> 4, ck = p & 15; *(LAS v4u*)(IVd + row * 256 + ck * 16) = vimg[it]; }
    LDS_WAIT(); CFENCE();
    {
        bf16* Ub = (bf16*)(ws + WS_UB) + (size_t)item * 8192;
        s16x8 tf[4][2];
#pragma unroll
        for (int mt = 0; mt < 4; ++mt)
#pragma unroll
            for (int ks = 0; ks < 2; ++ks) tf[mt][ks] = frag_row_p<128>(IT1, 16 * mt, 32 * ks, lane);
#pragma unroll
        for (int nt = 0; nt < 8; ++nt) { const s16x8 v0 = frag_tr_p<256>(IVd, 0, 16 * nt, lane), v1 = frag_tr_p<256>(IVd, 32, 16 * nt, lane);
#pragma unroll
            for (int mt = 0; mt < 4; ++mt) { f32x4 acc = (f32x4){0.f, 0.f, 0.f, 0.f}; acc = mfma16(tf[mt][0], v0, acc); acc = mfma16(tf[mt][1], v1, acc);
                *(unsigned long long*)(Ub + (size_t)(16 * nt + n_) * 64 + 16 * mt + 4 * q_) = pk4(acc); } }
    }
    LDS_WAIT(); CFENCE();
}
DI s16x8 pack_cpair_rev(const f32x4& lo, const f32x4& hi) { v4u p; p.x = pk2(lo[3], lo[2]); p.y = pk2(lo[1], lo[0]); p.z = pk2(hi[3], hi[2]); p.w = pk2(hi[1], hi[0]); return __builtin_bit_cast(s16x8, p); }
DI unsigned long long rev4(unsigned long long x) { return (x >> 48) | ((x >> 16) & 0xffff0000ull) | ((x << 16) & 0xffff00000000ull) | (x << 48); }
DI void dn_pass2_wave(unsigned char* ws, int w  , int lane) {
    const int z = w >> 5, h = (w >> 3) & 3, vs = w & 7;
    const int n_ = lane & 15, q_ = lane >> 4;
    f32x4 S[8];
#pragma unroll
    for (int kt = 0; kt < 8; ++kt) S[kt] = (f32x4){0.f, 0.f, 0.f, 0.f};
    for (int c = 0; c < 256; ++c) {
        const int item = (z * 4 + h) * 256 + c, cn = z ? 255 - c : c;
        const bf16* Wn = (const bf16*)(ws + WS_WN) + (size_t)item * 8192; const bf16* Ub = (const bf16*)(ws + WS_UB) + (size_t)item * 8192;
        const float* gcu = (const float*)(ws + WS_GC) + (size_t)item * 64;
        const bf16* KT = (const bf16*)(ws + WS_KT) + (size_t)(h * 256 + cn) * 128 * 64;
        bf16* Sst = (bf16*)(ws + WS_SST) + (size_t)item * 16384;
        f32x4 u[4], gv[4];
#pragma unroll
        for (int mt = 0; mt < 4; ++mt) { u[mt] = unpk4(*(const unsigned long long*)(Ub + (size_t)(16 * vs + n_) * 64 + 16 * mt + 4 * q_)); gv[mt] = *(const f32x4*)(gcu + 16 * mt + 4 * q_); }
        const float gl = gcu[63];
        unsigned long long wa[4][4][2], ka[8][2][2];
#pragma unroll
        for (int mt = 0; mt < 4; ++mt)
#pragma unroll
            for (int ks = 0; ks < 4; ++ks) { const bf16* row = Wn + (size_t)(16 * mt + n_) * 128 + 32 * ks + 4 * q_; wa[mt][ks][0] = *(const unsigned long long*)row; wa[mt][ks][1] = *(const unsigned long long*)(row + 16); }
#pragma unroll
        for (int kt = 0; kt < 8; ++kt)
#pragma unroll
            for (int ks = 0; ks < 2; ++ks) { const bf16* row = KT + (size_t)(16 * kt + n_) * 64;
                if (z == 0) { ka[kt][ks][0] = *(const unsigned long long*)(row + 32 * ks + 4 * q_); ka[kt][ks][1] = *(const unsigned long long*)(row + 32 * ks + 16 + 4 * q_); }
                else { ka[kt][ks][0] = rev4(*(const unsigned long long*)(row + 60 - 32 * ks - 4 * q_)); ka[kt][ks][1] = rev4(*(const unsigned long long*)(row + 44 - 32 * ks - 4 * q_)); } }
#pragma unroll
        for (int kt = 0; kt < 8; ++kt) *(unsigned long long*)(Sst + (size_t)(16 * vs + n_) * 128 + 16 * kt + 4 * q_) = pk4(S[kt]);
#pragma unroll
        for (int ks = 0; ks < 4; ++ks) { const s16x8 b = pack_cpair(S[2 * ks], S[2 * ks + 1]);
#pragma unroll
            for (int mt = 0; mt < 4; ++mt) { v4u a; a.x = (unsigned)wa[mt][ks][0]; a.y = (unsigned)(wa[mt][ks][0] >> 32); a.z = (unsigned)wa[mt][ks][1]; a.w = (unsigned)(wa[mt][ks][1] >> 32);
                u[mt] = mfma16(__builtin_bit_cast(s16x8, a), b, u[mt]); } }
#pragma unroll
        for (int mt = 0; mt < 4; ++mt)
#pragma unroll
            for (int e = 0; e < 4; ++e) u[mt][e] *= __expf(gl - gv[mt][e]);
        const float egl = __expf(gl);
        const s16x8 b0 = pack_cpair(u[0], u[1]), b1 = pack_cpair(u[2], u[3]);
#pragma unroll
        for (int kt = 0; kt < 8; ++kt) { f32x4 acc = S[kt] * egl;
            { v4u a; a.x = (unsigned)ka[kt][0][0]; a.y = (unsigned)(ka[kt][0][0] >> 32); a.z = (unsigned)ka[kt][0][1]; a.w = (unsigned)(ka[kt][0][1] >> 32); acc = mfma16(__builtin_bit_cast(s16x8, a), b0, acc); }
            { v4u a; a.x = (unsigned)ka[kt][1][0]; a.y = (unsigned)(ka[kt][1][0] >> 32); a.z = (unsigned)ka[kt][1][1]; a.w = (unsigned)(ka[kt][1][1] >> 32); acc = mfma16(__builtin_bit_cast(s16x8, a), b1, acc); }
            S[kt] = acc; }
    }
}
DI void dn_pass3_item(unsigned char* ws, int item, int lane) {
    asm volatile("" : "+v"(lane));
    const int z = item >> 10, h = (item >> 8) & 3, c = item & 255, cn = z ? 255 - c : c;
    const int n_ = lane & 15, q_ = lane >> 4;
    const bf16* Q = (const bf16*)(ws + WS_QD);
    const bf16* Wn = (const bf16*)(ws + WS_WN) + (size_t)item * 8192; const bf16* Ub = (const bf16*)(ws + WS_UB) + (size_t)item * 8192;
    const bf16* At = (const bf16*)(ws + WS_AT) + (size_t)item * 4096; const float* gcu = (const float*)(ws + WS_GC) + (size_t)item * 64;
    const bf16* Sst = (const bf16*)(ws + WS_SST) + (size_t)item * 16384;
    bf16* O = (bf16*)(ws + (z ? WS_O1 : WS_O0));
    s16x8 wf[4][4], qf[4][4]; unsigned long long af[4][2][2]; float eg[4];
#pragma unroll
    for (int t = 0; t < 4; ++t) {
        const bf16* qrow = Q + (size_t)tok_of(z, cn, 16 * t + n_) * 512 + h * 128 + 8 * q_;
#pragma unroll
        for (int ks = 0; ks < 4; ++ks) { wf[t][ks] = *(const s16x8*)(Wn + (size_t)(16 * t + n_) * 128 + 32 * ks + 8 * q_); qf[t][ks] = *(const s16x8*)(qrow + 32 * ks); }
#pragma unroll
        for (int ks = 0; ks < 2; ++ks) { const bf16* arow = At + (size_t)(16 * t + n_) * 64 + 32 * ks + 4 * q_; af[t][ks][0] = *(const unsigned long long*)arow; af[t][ks][1] = *(const unsigned long long*)(arow + 16); }
        eg[t] = __expf(gcu[16 * t + n_]);
    }
#pragma unroll
    for (int mt = 0; mt < 8; ++mt) {
        s16x8 sf[4];
#pragma unroll
        for (int ks = 0; ks < 4; ++ks) sf[ks] = *(const s16x8*)(Sst + (size_t)(16 * mt + n_) * 128 + 32 * ks + 8 * q_);
        f32x4 u[4];
#pragma unroll
        for (int jt = 0; jt < 4; ++jt) { u[jt] = unpk4(*(const unsigned long long*)(Ub + (size_t)(16 * mt + n_) * 64 + 16 * jt + 4 * q_));
#pragma unroll
            for (int ks = 0; ks < 4; ++ks) u[jt] = mfma16(wf[jt][ks], sf[ks], u[jt]); }
        const s16x8 ua0 = pack_cpair(u[0], u[1]), ua1 = pack_cpair(u[2], u[3]);
#pragma unroll
        for (int nt = 0; nt < 4; ++nt) {
            f32x4 acc = (f32x4){0.f, 0.f, 0.f, 0.f};
#pragma unroll
            for (int ks = 0; ks < 4; ++ks) acc = mfma16(sf[ks], qf[nt][ks], acc);
            acc = acc * eg[nt];
            { v4u b; b.x = (unsigned)af[nt][0][0]; b.y = (unsigned)(af[nt][0][0] >> 32); b.z = (unsigned)af[nt][0][1]; b.w = (unsigned)(af[nt][0][1] >> 32); acc = mfma16(ua0, __builtin_bit_cast(s16x8, b), acc); }
            { v4u b; b.x = (unsigned)af[nt][1][0]; b.y = (unsigned)(af[nt][1][0] >> 32); b.z = (unsigned)af[nt][1][1]; b.w = (unsigned)(af[nt][1][1] >> 32); acc = mfma16(ua1, __builtin_bit_cast(s16x8, b), acc); }
            *(unsigned long long*)(O + (size_t)tok_of(z, cn, 16 * nt + n_) * 512 + h * 128 + 16 * mt + 4 * q_) = pk4(acc);
        }
    }
}
constexpr int DN_SLOT = 41984, DN_GRP = 16;
constexpr size_t WS_MG = WS_END_OLD, WS_NG = WS_END_OLD + 4 * MiB, WS_SG = WS_END_OLD + 8 * MiB;
DI void dn_scan_block(unsigned char* ws, ldsp L, const int Z, const int MODE, int h, int hv, int g, int wave, int lane) {
    const int item0 = (Z * 4 + h) * 256, cb = g * DN_GRP, zhg = (Z * 4 + h) * 16 + g;
    if (wave >= 4) {
        const int lw = wave - 4;
        unsigned so[11], ld[11];
#pragma unroll
        for (int k = 0; k < 4; ++k) { const int pid = lw * 4 + k; const int row = 4 * pid + (lane >> 4), p = lane & 15, cch = p ^ (row & 15); so[k] = row * 256 + cch * 16; ld[k] = pid * 1024 + lane * 16; }
#pragma unroll
        for (int k = 0; k < 4; ++k) { const int pid = lw * 4 + k; const int row = 8 * pid + (lane >> 3), p = lane & 7, cch = p ^ (row & 7); so[4 + k] = row * 128 + cch * 16; ld[4 + k] = 16384 + pid * 1024 + lane * 16; }
#pragma unroll
        for (int k = 0; k < 2; ++k) { const int pid = lw * 2 + k; const int row = 8 * pid + (lane >> 3), p = lane & 7, cch = p ^ (row & 7); so[8 + k] = row * 128 + cch * 16; ld[8 + k] = 32768 + pid * 1024 + lane * 16; }
        so[10] = lane * 16; ld[10] = 40960 + lane * 16;
        v4u rA[11], rB[11];
#define DN_GLOAD(R, ss) do { const int s_ = (ss) < DN_GRP ? (ss) : DN_GRP - 1; const int c_ = cb + s_; const int cn_ = Z ? 255 - c_ : c_; \
            const char* wsrc = (const char*)((const bf16*)(ws + WS_WN) + (size_t)(item0 + c_) * 8192); const char* ksrc = (const char*)((const bf16*)(ws + WS_KT) + (size_t)(h * 256 + cn_) * 8192); \
            const char* usrc = (const char*)((const bf16*)(ws + WS_UB) + (size_t)(item0 + c_) * 8192 + hv * 4096); const char* gsrc = (const char*)((const float*)(ws + WS_GC) + (size_t)(item0 + c_) * 64); \
            _Pragma("unroll") for (int k = 0; k < 4; ++k) R[k] = *(const v4u*)(wsrc + so[k]); \
            _Pragma("unroll") for (int k = 4; k < 8; ++k) R[k] = *(const v4u*)(ksrc + so[k]); \
            _Pragma("unroll") for (int k = 8; k < 10; ++k) R[k] = *(const v4u*)(usrc + so[k]); \
            if (lw == 0) R[10] = *(const v4u*)(gsrc + so[10]); } while (0)
#define DN_LWRITE(R, ss) do { ldsp slot = L + ((ss) % 3) * DN_SLOT; \
            _Pragma("unroll") for (int k = 0; k < 10; ++k) *(LAS v4u*)(slot + ld[k]) = R[k]; \
            if (lw == 0) *(LAS v4u*)(slot + ld[10]) = R[10]; } while (0)
        DN_GLOAD(rA, 0); DN_GLOAD(rB, 1); DN_LWRITE(rA, 0); DN_LWRITE(rB, 1);
        DN_GLOAD(rA, 2); DN_GLOAD(rB, 3);
#define DN_LSTEP(R, ss) do { asm volatile("s_waitcnt lgkmcnt(0)" ::: "memory"); __builtin_amdgcn_s_barrier(); asm volatile("" ::: "memory"); \
            DN_LWRITE(R, (ss) + 2); DN_GLOAD(R, (ss) + 4); } while (0)
        for (int s2 = 0; s2 < DN_GRP; s2 += 2) { DN_LSTEP(rA, s2); DN_LSTEP(rB, s2 + 1); }
#undef DN_LSTEP
#undef DN_LWRITE
#undef DN_GLOAD
        asm volatile("s_waitcnt vmcnt(0) lgkmcnt(0)" ::: "memory");
        return;
    }
    const int vs = 4 * hv + wave;
    const int n_ = lane & 15, q_ = lane >> 4, wbyte = (q_ & 1) * 8, sw = n_ & 7;
    int kao[2][2];
#pragma unroll
    for (int ks = 0; ks < 2; ++ks) { const int r0 = Z ? 60 - 32 * ks - 4 * q_ : 32 * ks + 4 * q_, r1 = Z ? r0 - 16 : r0 + 16; kao[ks][0] = (((r0 >> 3) ^ sw) * 16) + (r0 & 7) * 2; kao[ks][1] = (((r1 >> 3) ^ sw) * 16) + (r1 & 7) * 2; }
    const float ubm = MODE == 2 ? 0.f : 1.f;
    f32x4 S[8];
    if (MODE == 0) { const bf16* SG = (const bf16*)(ws + WS_SG) + (size_t)zhg * 16384;
#pragma unroll
        for (int kt = 0; kt < 8; ++kt) S[kt] = unpk4(*(const unsigned long long*)(SG + (size_t)(16 * vs + n_) * 128 + 16 * kt + 4 * q_)); }
    else {
#pragma unroll
        for (int kt = 0; kt < 8; ++kt)
#pragma unroll
            for (int e = 0; e < 4; ++e) S[kt][e] = (MODE == 2 && (16 * kt + 4 * q_ + e) == (16 * vs + n_)) ? 1.f : 0.f; }
    for (int s = 0; s < DN_GRP; ++s) {
        const int c = cb + s;
        if (MODE == 0) { bf16* Sst = (bf16*)(ws + WS_SST) + (size_t)(item0 + c) * 16384;
#pragma unroll
            for (int kt = 0; kt < 8; ++kt) *(unsigned long long*)(Sst + (size_t)(16 * vs + n_) * 128 + 16 * kt + 4 * q_) = pk4(S[kt]); }
        asm volatile("s_waitcnt lgkmcnt(0)" ::: "memory");
        __builtin_amdgcn_s_barrier();
        asm volatile("" ::: "memory");
        ldsp slot = L + (s % 3) * DN_SLOT;
        f32x4 u[4], gv[4]; unsigned long long wa[4][4][2], ka[8][2][2];
        { ldsp urow = slot + 32768 + (16 * wave + n_) * 128 + wbyte;
#pragma unroll
          for (int mt = 0; mt < 4; ++mt) { u[mt] = unpk4(*(LAS const unsigned long long*)(urow + (((2 * mt + (q_ >> 1)) ^ sw) * 16))) * ubm; gv[mt] = *(LAS const f32x4*)(slot + 40960 + (16 * mt + 4 * q_) * 4); } }
        const float gl = *(LAS const float*)(slot + 40960 + 63 * 4);
#pragma unroll
        for (int ks = 0; ks < 4; ++ks)
#pragma unroll
            for (int mt = 0; mt < 4; ++mt) { ldsp row = slot + (16 * mt + n_) * 256 + wbyte; const int c0 = 4 * ks + (q_ >> 1);
                wa[mt][ks][0] = *(LAS const unsigned long long*)(row + ((c0 ^ n_) * 16)); wa[mt][ks][1] = *(LAS const unsigned long long*)(row + (((c0 + 2) ^ n_) * 16)); }
        __builtin_amdgcn_sched_barrier(0);
#pragma unroll
        for (int ks = 0; ks < 4; ++ks) { const s16x8 bb = pack_cpair(S[2 * ks], S[2 * ks + 1]);
#pragma unroll
            for (int mt = 0; mt < 4; ++mt) { v4u a; a.x = (unsigned)wa[mt][ks][0]; a.y = (unsigned)(wa[mt][ks][0] >> 32); a.z = (unsigned)wa[mt][ks][1]; a.w = (unsigned)(wa[mt][ks][1] >> 32);
                u[mt] = mfma16(__builtin_bit_cast(s16x8, a), bb, u[mt]); } }
        __builtin_amdgcn_sched_barrier(0);
#pragma unroll
        for (int kt = 0; kt < 8; ++kt) { ldsp row = slot + 16384 + (16 * kt + n_) * 128;
#pragma unroll
            for (int ks = 0; ks < 2; ++ks) { ka[kt][ks][0] = *(LAS const unsigned long long*)(row + kao[ks][0]); ka[kt][ks][1] = *(LAS const unsigned long long*)(row + kao[ks][1]); } }
        __builtin_amdgcn_sched_barrier(0);
#pragma unroll
        for (int mt = 0; mt < 4; ++mt)
#pragma unroll
            for (int e = 0; e < 4; ++e) u[mt][e] *= __expf(gl - gv[mt][e]);
        const float egl = __expf(gl);
#pragma unroll
        for (int mt = 0; mt < 4; ++mt) { const f32x4 t = u[mt]; u[mt][0] = Z ? t[3] : t[0]; u[mt][1] = Z ? t[2] : t[1]; u[mt][2] = Z ? t[1] : t[2]; u[mt][3] = Z ? t[0] : t[3]; }
        const s16x8 b0 = pack_cpair(u[0], u[1]), b1 = pack_cpair(u[2], u[3]);
#pragma unroll
        for (int kt = 0; kt < 8; ++kt) { f32x4 acc = S[kt] * egl;
#pragma unroll
            for (int ks = 0; ks < 2; ++ks) { const unsigned long long a0 = ka[kt][ks][0], a1 = ka[kt][ks][1];
                v4u a; a.x = (unsigned)a0; a.y = (unsigned)(a0 >> 32); a.z = (unsigned)a1; a.w = (unsigned)(a1 >> 32);
                acc = mfma16(__builtin_bit_cast(s16x8, a), ks == 0 ? b0 : b1, acc); }
            S[kt] = acc; }
    }
    if (MODE == 1) { bf16* NG = (bf16*)(ws + WS_NG) + (size_t)zhg * 16384;
#pragma unroll
        for (int kt = 0; kt < 8; ++kt) *(unsigned long long*)(NG + (size_t)(16 * vs + n_) * 128 + 16 * kt + 4 * q_) = pk4(S[kt]); }
    if (MODE == 2) { bf16* MG = (bf16*)(ws + WS_MG) + (size_t)zhg * 16384;
#pragma unroll
        for (int kt = 0; kt < 8; ++kt)
#pragma unroll
            for (int e = 0; e < 4; ++e) MG[(size_t)(16 * kt + 4 * q_ + e) * 128 + 16 * vs + n_] = (bf16)f2bf(S[kt][e]); }
}
DI void dn_scan_groups_block(unsigned char* ws, ldsp L, int zh, int wave, int lane) {
    const int vs = wave, n_ = lane & 15, q_ = lane >> 4, tid = wave * 64 + lane;
    f32x4 S[8];
#pragma unroll
    for (int kt = 0; kt < 8; ++kt) S[kt] = (f32x4){0.f, 0.f, 0.f, 0.f};
    v4u rg[8];
#define GB_LOAD(gg) do { const size_t zhg_ = (size_t)(zh * 16 + (gg)) * 16384; const bf16* MG_ = (const bf16*)(ws + WS_MG) + zhg_; const bf16* NG_ = (const bf16*)(ws + WS_NG) + zhg_; \
        _Pragma("unroll") for (int i = 0; i < 8; ++i) { const int p = tid + 512 * i; rg[i] = *(const v4u*)(((p >> 11) ? NG_ : MG_) + (size_t)((p >> 4) & 127) * 128 + (p & 15) * 8); } } while (0)
#define GB_WRITE(buf) do { _Pragma("unroll") for (int i = 0; i < 8; ++i) { const int p = tid + 512 * i, r = (p >> 4) & 127, c = p & 15; \
        *(LAS v4u*)(L + (buf) * 65536 + (p >> 11) * 32768 + r * 256 + ((c ^ (r & 15)) * 16)) = rg[i]; } } while (0)
    GB_LOAD(0); GB_WRITE(0); GB_LOAD(1);
    LDS_WAIT(); __syncthreads();
    for (int g = 0; g < 16; ++g) {
        bf16* SG = (bf16*)(ws + WS_SG) + (size_t)(zh * 16 + g) * 16384;
#pragma unroll
        for (int kt = 0; kt < 8; ++kt) *(unsigned long long*)(SG + (size_t)(16 * vs + n_) * 128 + 16 * kt + 4 * q_) = pk4(S[kt]);
        if (g == 15) break;
        if (g + 1 < 15) { GB_WRITE((g + 1) & 1); if (g + 2 < 15) GB_LOAD(g + 2); }
        ldsp buf = L + (g & 1) * 65536;
        s16x8 bb[4];
#pragma unroll
        for (int ks = 0; ks < 4; ++ks) bb[ks] = pack_cpair(S[2 * ks], S[2 * ks + 1]);
#pragma unroll
        for (int kt = 0; kt < 8; ++kt) {
            const int nr = 16 * vs + n_; const int nc = 2 * kt + (q_ >> 1);
            f32x4 acc = unpk4(*(LAS const unsigned long long*)(buf + 32768 + nr * 256 + ((nc ^ (nr & 15)) * 16) + (q_ & 1) * 8));
            const int mr = 16 * kt + n_;
#pragma unroll
            for (int ks = 0; ks < 4; ++ks) { const int c0 = 4 * ks + (q_ >> 1);
                const unsigned long long a0 = *(LAS const unsigned long long*)(buf + mr * 256 + ((c0 ^ (mr & 15)) * 16) + (q_ & 1) * 8), a1 = *(LAS const unsigned long long*)(buf + mr * 256 + (((c0 + 2) ^ (mr & 15)) * 16) + (q_ & 1) * 8);
                v4u a; a.x = (unsigned)a0; a.y = (unsigned)(a0 >> 32); a.z = (unsigned)a1; a.w = (unsigned)(a1 >> 32);
                acc = mfma16(__builtin_bit_cast(s16x8, a), bb[ks], acc); }
            S[kt] = acc; }
        LDS_WAIT(); __syncthreads();
    }
#undef GB_LOAD
#undef GB_WRITE
}
DI void prep1_token(const Args& a, unsigned char* ws, int t, int lane) {
    const bf16* P = (const bf16*)(ws + WS_PROJ1) + (size_t)t * ODD_PAD;
    const int c0 = 8 * lane; const bool hp = t > 0, hn = t < S_ - 1;
    float z8[8];
#pragma unroll
    for (int i = 0; i < 8; ++i) z8[i] = 0.f;
    {
        float cb[8], cc[8], cx[8], pc[8], px[8], nc[8], nx[8], w0[8], w1[8], w2[8], o[8];
        ld8(P + c0, cb); ld8(P + 512 + c0, cc); ld8(P + 1024 + c0, cx);
        if (hp) { ld8(P - ODD_PAD + 512 + c0, pc); ld8(P - ODD_PAD + 1024 + c0, px); } else {
#pragma unroll
            for (int i = 0; i < 8; ++i) { pc[i] = 0.f; px[i] = 0.f; } }
        if (hn) { ld8(P + ODD_PAD + 512 + c0, nc); ld8(P + ODD_PAD + 1024 + c0, nx); } else {
#pragma unroll
            for (int i = 0; i < 8; ++i) { nc[i] = 0.f; nx[i] = 0.f; } }
        ld8f(a.in[28] + c0, w0); ld8f(a.in[28] + 512 + c0, w1); ld8f(a.in[28] + 1024 + c0, w2);
#pragma unroll
        for (int i = 0; i < 8; ++i) o[i] = cb[i] * (w0[i] * pc[i] * px[i] + w1[i] * cc[i] * cx[i] + w2[i] * nc[i] * nx[i]);
        st8((bf16*)(ws + WS_YCAT1) + (size_t)t * D_ + c0, o);
    }
#pragma unroll
    for (int part = 0; part < 3; ++part) {
        float cu[8], pv[8], nx[8], w0[8], w1[8], w2[8], o[8];
        const int col = 1536 + part * 512 + c0;
        ld8(P + col, cu);
        if (hp) ld8(P - ODD_PAD + col, pv); else {
#pragma unroll
            for (int i = 0; i < 8; ++i) pv[i] = 0.f; }
        if (hn) ld8(P + ODD_PAD + col, nx); else {
#pragma unroll
            for (int i = 0; i < 8; ++i) nx[i] = 0.f; }
        const float* cw = a.in[29] + part * 512 + c0;
        ld8f(cw, w0); ld8f(cw + 1536, w1); ld8f(cw + 3072, w2);
        float ss = 0.f;
#pragma unroll
        for (int i = 0; i < 8; ++i) { o[i] = siluf_(w0[i] * pv[i] + w1[i] * cu[i] + w2[i] * nx[i]); ss += o[i] * o[i]; }
        if (part < 2) { ss = grp_sum<16>(ss); const float rn = (1.0f / sqrtf(ss + 1e-6f)) * (part == 0 ? 0.08838834764831845f : 1.0f);
#pragma unroll
            for (int i = 0; i < 8; ++i) o[i] *= rn; }
        st8((bf16*)(ws + (part == 0 ? WS_QD : (part == 1 ? WS_KD : WS_VD))) + (size_t)t * 512 + c0, o);
    }
    *(v4u*)((bf16*)(ws + WS_YCAT1) + (size_t)t * D_ + 512 + c0) = *(const v4u*)(P + 3072 + c0);
    if (lane < 8) {
        const float bt = sigmoidf_(bf2f(P[3584 + lane])); const float al = bf2f(P[3592 + lane]);
        const float g = -__expf(a.in[30][lane]) * softplusf_(al + a.in[31][lane]);
        ((float*)(ws + WS_GB))[(size_t)t * 8 + lane] = g; ((float*)(ws + WS_GB + 512 * 1024))[(size_t)t * 8 + lane] = bt;
    }
}
DI void dn_scan_naive(unsigned char* ws, int w  , int lane) {
    const int z = w >> 9, h = (w >> 7) & 3, vc = w & 127;
    const bf16* Q = (const bf16*)(ws + WS_QD); const bf16* K = (const bf16*)(ws + WS_KD); const bf16* V = (const bf16*)(ws + WS_VD);
    const float* G = (const float*)(ws + WS_GB); const float* Bt = (const float*)(ws + WS_GB + 512 * 1024);
    bf16* O = (bf16*)(ws + (z ? WS_O1 : WS_O0));
    float s0 = 0.f, s1 = 0.f;
    int t = z ? S_ - 1 : 0; const int dt = z ? -1 : 1;
    size_t o = (size_t)t * 512 + h * 128;
    float k0 = bf2f(K[o + lane]), k1 = bf2f(K[o + 64 + lane]), q0 = bf2f(Q[o + lane]), q1 = bf2f(Q[o + 64 + lane]), vv = bf2f(V[o + vc]), g = G[(size_t)t * 8 + z * 4 + h], bt = Bt[(size_t)t * 8 + z * 4 + h];
    for (int s = 0; s < S_; ++s) {
        const int tn = (s + 1 < S_) ? t + dt : t; const size_t on = (size_t)tn * 512 + h * 128;
        const float k0n = bf2f(K[on + lane]), k1n = bf2f(K[on + 64 + lane]), q0n = bf2f(Q[on + lane]), q1n = bf2f(Q[on + 64 + lane]), vvn = bf2f(V[on + vc]), gn = G[(size_t)tn * 8 + z * 4 + h], btn = Bt[(size_t)tn * 8 + z * 4 + h];
        const float eg = __expf(g);
        const float dot = wave_sum(k0 * s0 + k1 * s1);
        const float cf = bt * (vv - eg * dot);
        s0 = eg * s0 + cf * k0; s1 = eg * s1 + cf * k1;
        const float ov = wave_sum(q0 * s0 + q1 * s1);
        if (lane == 0) O[(size_t)t * 512 + h * 128 + vc] = (bf16)f2bf(ov);
        k0 = k0n; k1 = k1n; q0 = q0n; q1 = q1n; vv = vvn; g = gn; bt = btn; t = tn;
    }
}
DI void dn_post_token(const Args& a, unsigned char* ws, int t, int lane) {
    const int c0 = 8 * lane; const size_t o = (size_t)t * 512 + c0;
    float o0[8], o1[8], zz[8], nw[8];
    ld8((const bf16*)(ws + WS_O0) + o, o0); ld8((const bf16*)(ws + WS_O1) + o, o1);
    ld8((const bf16*)(ws + WS_YCAT1) + (size_t)t * D_ + 512 + c0, zz); ld8f(a.in[32] + (c0 & 127), nw);
    float ss = 0.f;
#pragma unroll
    for (int i = 0; i < 8; ++i) { o0[i] += o1[i]; ss += o0[i] * o0[i]; }
    const float rs = 1.0f / sqrtf(grp_sum<16>(ss) * (1.0f / 128.f) + 1e-6f);
#pragma unroll
    for (int i = 0; i < 8; ++i) o0[i] = o0[i] * rs * nw[i] * siluf_(zz[i]);
    st8((bf16*)(ws + WS_YCAT1) + (size_t)t * D_ + 512 + c0, o0);
}
struct TokInfo { int e1, e2, s1, s2; float p1, p2; int pad0, pad1; };
struct RouterRegs { f32x4 r0[16], r1[16]; f32x4 w[4]; };
DI void route_load(const Args& a, RouterRegs& R, int lane) {
#pragma unroll
    for (int j = 0; j < 4; ++j) { R.w[j] = ((const f32x4*)a.in[34])[lane + 64 * j];
#pragma unroll
        for (int i = 0; i < 4; ++i) { const float* rr = a.in[35] + (size_t)(4 * lane + 256 * j + i) * 8; R.r0[4 * j + i] = *(const f32x4*)rr; R.r1[4 * j + i] = *(const f32x4*)(rr + 4); } }
}
constexpr size_t WS_BC = WS_TILE + 4096;
DI int sel8(const int (&v)[8], int e) { int r = 0;
#pragma unroll
    for (int k = 0; k < 8; ++k) r += v[k] & -(int)(e == k);
    return r; }
DI int wave_isum(int v) {
#pragma unroll
    for (int o = 1; o < 64; o <<= 1) v += __shfl_xor(v, o);
    return v; }
DI void route_eval(const RouterRegs& R, const float* x3, int t, int lane, int& e1, int& e2, float& p1, float& p2) {
    f32x4 v[4]; load_row(x3, t, lane, v); const float rs = row_rstd(v);
    float lg[8];
#pragma unroll
    for (int e = 0; e < 8; ++e) lg[e] = 0.f;
#pragma unroll
    for (int j = 0; j < 4; ++j)
#pragma unroll
        for (int i = 0; i < 4; ++i) { const float hv = v[j][i] * rs * R.w[j][i]; const f32x4 r0 = R.r0[4 * j + i], r1 = R.r1[4 * j + i];
            lg[0] += hv * r0.x; lg[1] += hv * r0.y; lg[2] += hv * r0.z; lg[3] += hv * r0.w; lg[4] += hv * r1.x; lg[5] += hv * r1.y; lg[6] += hv * r1.z; lg[7] += hv * r1.w; }
#pragma unroll
    for (int e = 0; e < 8; ++e) lg[e] = wave_sum(lg[e]);
    e1 = 0; float m1 = lg[0];
#pragma unroll
    for (int e = 1; e < 8; ++e) if (lg[e] > m1) { m1 = lg[e]; e1 = e; }
    e2 = -1; float m2 = -3.0e38f;
#pragma unroll
    for (int e = 0; e < 8; ++e) if (e != e1 && lg[e] > m2) { m2 = lg[e]; e2 = e; }
    const float x2 = __expf(m2 - m1); p1 = 1.0f / (1.0f + x2); p2 = x2 / (1.0f + x2);
}
DI void route_group(const RouterRegs& R, unsigned char* ws, const float* x3, LAS int* wc, int tg, int wave, int lane) {
    int cw[8];
#pragma unroll
    for (int e = 0; e < 8; ++e) cw[e] = 0;
    TokInfo* TI = (TokInfo*)(ws + WS_TOK) + (size_t)tg * 64 + wave * 8;
#pragma unroll 1
    for (int i = 0; i < 8; ++i) {
        int e1, e2; float p1, p2; route_eval(R, x3, tg * 64 + wave * 8 + i, lane, e1, e2, p1, p2);
        const int s1 = sel8(cw, e1);
#pragma unroll
        for (int e = 0; e < 8; ++e) cw[e] += (e == e1) ? 1 : 0;
        const int s2 = sel8(cw, e2);
#pragma unroll
        for (int e = 0; e < 8; ++e) cw[e] += (e == e2) ? 1 : 0;
        if (lane == 0) { v4u* rec = (v4u*)(TI + i); rec[0] = (v4u){(unsigned)e1, (unsigned)e2, (unsigned)s1, (unsigned)s2}; rec[1] = (v4u){__float_as_uint(p1), __float_as_uint(p2), 0u, 0u}; }
    }
    if (lane < 8) wc[wave * 8 + lane] = sel8(cw, lane);
    LDS_WAIT(); __syncthreads();
    int wb[8], bc[8];
#pragma unroll
    for (int e = 0; e < 8; ++e) { wb[e] = 0; bc[e] = 0;
#pragma unroll
        for (int w = 0; w < 8; ++w) { const int c = wc[w * 8 + e]; bc[e] += c; wb[e] += (w < wave) ? c : 0; } }
    if (wave == 0 && lane < 8) ((int*)(ws + WS_BC))[tg * 8 + lane] = sel8(bc, lane);
    if (lane < 8) { v4u* rec = (v4u*)(TI + lane); v4u r = rec[0]; r.z += (unsigned)sel8(wb, (int)r.x); r.w += (unsigned)sel8(wb, (int)r.y); rec[0] = r; }
    LDS_WAIT(); __syncthreads();
}
DI void moe_totals(const unsigned char* ws, int lane, int (&tot)[8]) {
    const int* BC = (const int*)(ws + WS_BC); int part[8];
#pragma unroll
    for (int e = 0; e < 8; ++e) part[e] = 0;
#pragma unroll
    for (int k = 0; k < 4; ++k) { const int r = lane + 64 * k;
#pragma unroll
        for (int e = 0; e < 8; ++e) part[e] += __hip_atomic_load(BC + r * 8 + e, __ATOMIC_RELAXED, __HIP_MEMORY_SCOPE_AGENT); }
#pragma unroll
    for (int e = 0; e < 8; ++e) tot[e] = __builtin_amdgcn_readfirstlane(wave_isum(part[e]));
}
DI void moe_offsets(const int (&tot)[8], int (&off)[9]) { int o = 0;
#pragma unroll
    for (int e = 0; e < 8; ++e) { off[e] = o; o += (tot[e] + 255) & ~255; }
    off[8] = o; }
DI void gather_group(const Args& a, unsigned char* ws, const float* x3, const int (&off)[9], int tg, int wave, int lane) {
    const int* BC = (const int*)(ws + WS_BC); int pre[8];
#pragma unroll
    for (int e = 0; e < 8; ++e) pre[e] = 0;
#pragma unroll
    for (int k = 0; k < 4; ++k) { const int r = lane + 64 * k;
#pragma unroll
        for (int e = 0; e < 8; ++e) { const int c = __hip_atomic_load(BC + r * 8 + e, __ATOMIC_RELAXED, __HIP_MEMORY_SCOPE_AGENT); pre[e] += (r < tg) ? c : 0; } }
#pragma unroll
    for (int e = 0; e < 8; ++e) pre[e] = __builtin_amdgcn_readfirstlane(wave_isum(pre[e])) + off[e];
    TokInfo* TI = (TokInfo*)(ws + WS_TOK) + (size_t)tg * 64 + wave * 8;
    unsigned char* A = ws + WS_AMOE8;
#pragma unroll 1
    for (int i = 0; i < 8; ++i) { const int t = tg * 64 + wave * 8 + i;
        f32x4 v[4]; load_row(x3, t, lane, v); const float rs = row_rstd(v);
#pragma unroll
        for (int j = 0; j < 4; ++j) v[j] = v[j] * rs * ((const f32x4*)a.in[34])[lane + 64 * j];
        v4u* rec = (v4u*)(TI + i); v4u r = rec[0];
        const int r1 = sel8(pre, (int)r.x) + (int)r.z, r2 = sel8(pre, (int)r.y) + (int)r.w;
        unsigned* o1 = (unsigned*)(A + (size_t)r1 * D_) + lane; unsigned* o2 = (unsigned*)(A + (size_t)r2 * D_) + lane;
#pragma unroll
        for (int j = 0; j < 4; ++j) { const unsigned w = pk4f8(v[j][0], v[j][1], v[j][2], v[j][3]); o1[64 * j] = w; o2[64 * j] = w; }
        if (lane == 0) { r.z = (unsigned)r1; r.w = (unsigned)r2; rec[0] = r; }
    }
}
DI void combine_token(unsigned char* ws, float* out, const int (&off)[9], int t, int lane) {
    const v4u* rec = (const v4u*)((const TokInfo*)(ws + WS_TOK) + t); const v4u ra = rec[0], rb = rec[1];
    struct { float p1, p2; } ti; ti.p1 = __uint_as_float(rb.x); ti.p2 = __uint_as_float(rb.y);
    const bf16* A = (const bf16*)(ws + WS_AMOE);
    const unsigned long long* r1 = (const unsigned long long*)(A + (size_t)ra.z * D_) + lane; const unsigned long long* r2 = (const unsigned long long*)(A + (size_t)ra.w * D_) + lane;
    f32x4* xo = (f32x4*)(out + (size_t)t * D_) + lane;
#pragma unroll
    for (int j = 0; j < 4; ++j) { const unsigned long long a1 = r1[64 * j], a2 = r2[64 * j]; f32x4 x = xo[64 * j];
        x.x += ti.p1 * bflo((unsigned)a1) + ti.p2 * bflo((unsigned)a2); x.y += ti.p1 * bfhi((unsigned)a1) + ti.p2 * bfhi((unsigned)a2);
        x.z += ti.p1 * bflo((unsigned)(a1 >> 32)) + ti.p2 * bflo((unsigned)(a2 >> 32)); x.w += ti.p1 * bfhi((unsigned)(a1 >> 32)) + ti.p2 * bfhi((unsigned)(a2 >> 32));
        xo[64 * j] = x; }
}
#ifndef PROBE
#define PROBE 0
#endif
#ifndef PROBE_REP
#define PROBE_REP (-1)
#endif
constexpr int MOE_GU_SPLIT = 16128;
#ifndef PH_MASK
#define PH_MASK 0xFFFFFFFFu
#endif
DI unsigned char* ptr_opaque(unsigned char* p) { GAS unsigned char* g = (GAS unsigned char*)p; asm volatile("" : "+s"(g)); return (unsigned char*)g; }
DI int lane_opaque() { int l; asm volatile("v_mbcnt_lo_u32_b32 %0, -1, 0\n\tv_mbcnt_hi_u32_b32 %0, -1, %0" : "=v"(l)); return l; }
__global__ void __launch_bounds__(512, 2) fwd_kernel(Args args) {
    extern __shared__ __attribute__((aligned(16))) unsigned char lds[];
    LAS unsigned char* L = (LAS unsigned char*)lds;
    volatile LAS unsigned* MISC = (volatile LAS unsigned*)(L + MISC_OFF);
    const int tid = threadIdx.x, lane0 = tid & 63, wave = __builtin_amdgcn_readfirstlane(tid >> 6);
    const int G = gridDim.x, bx = blockIdx.x;
    const int gw = bx * 8 + wave, NGW = G * 8;
    unsigned char* ws0 = args.ws;
    if (tid < 128) ((LAS unsigned*)(L + LDS_ZERO_OFF))[tid] = 0u;
    __syncthreads();
    XcdBarrier bar = xcd_barrier_post((unsigned*)(ws0 + WS_CTL) + CW_BAR, MISC + 8);
    LAS float* scr = (LAS float*)(L + wave * 16384);
#if PROBE
    int tsi = 0;
#define GRID_BAR() do { xcd_barrier(bar, wave == 0); if (bx == 0 && tid == 0) { ((unsigned*)(ws0 + WS_CTL))[512 + tsi] = (unsigned)__builtin_amdgcn_s_memrealtime(); } ++tsi; } while (0)
    if (bx == 0 && tid == 0) ((unsigned*)(ws0 + WS_CTL))[511] = (unsigned)__builtin_amdgcn_s_memrealtime();
#else
#define GRID_BAR() xcd_barrier(bar, wave == 0)
#endif

    if constexpr ((PH_MASK >> 0) & 1) {
    const int lane = lane_opaque(); unsigned char* const ws = ptr_opaque(args.ws);
    {
        const float* const* in = args.in;
        for (int it = gw; ; it += NGW) {
            int r = it;
            if (transpose_job(r, in[3], 1024, 3072, 3072, (bf16*)(ws + WS_WIN0), 0, 0, 0, scr, lane)) continue;
            if (transpose_job(r, in[9], 1024, 64, 64, (bf16*)(ws + WS_WL), 0, 0, 0, scr, lane)) continue;
            if (transpose_job(r, in[9] + 65536, 1024, 64, 64, (bf16*)(ws + WS_WL), 64, 0, 0, scr, lane)) continue;
            if (transpose_job(r, in[12], 1024, 64, 64, (bf16*)(ws + WS_WL), 128, 0, 0, scr, lane)) continue;
            if (transpose_job(r, in[12] + 65536, 1024, 64, 64, (bf16*)(ws + WS_WL), 192, 0, 0, scr, lane)) continue;
            if (transpose_job(r, in[14], 1024, 128, 256, (bf16*)(ws + WS_WL), 256, 0, 0, scr, lane)) continue;
            if (transpose_job(r, in[21], 1024, 1024, 1024, (bf16*)(ws + WS_WOUT0), 0, 0, 0, scr, lane)) continue;
            if (transpose_job(r, in[10], 64, 512, 512, (bf16*)(ws + WS_W2T), 0, 0, 0, scr, lane)) continue;
            if (transpose_job(r, in[10] + 32768, 64, 512, 512, (bf16*)(ws + WS_W2T) + 32768, 0, 0, 0, scr, lane)) continue;
            if (transpose_job(r, in[13], 64, 512, 512, (bf16*)(ws + WS_W2T) + 65536, 0, 0, 0, scr, lane)) continue;
            if (transpose_job(r, in[13] + 32768, 64, 512, 512, (bf16*)(ws + WS_W2T) + 98304, 0, 0, 0, scr, lane)) continue;
            if (transpose_job(r, in[15], 128, 512, 512, (bf16*)(ws + WS_W2T) + 131072, 0, 0, 0, scr, lane)) continue;
            break;
        }
        norm_rows(args.in[0], args.in[2], args.in[7], (bf16*)(ws + WS_H), (bf16*)(ws + WS_HX), gw, NGW, lane);
    }
    if constexpr (PROBE_REP == 0) {
    {
        const float* const* in = args.in;
        for (int it = gw; ; it += NGW) {
            int r = it;
            if (transpose_job(r, in[3], 1024, 3072, 3072, (bf16*)(ws + WS_WIN0), 0, 0, 0, scr, lane)) continue;
            if (transpose_job(r, in[9], 1024, 64, 64, (bf16*)(ws + WS_WL), 0, 0, 0, scr, lane)) continue;
            if (transpose_job(r, in[9] + 65536, 1024, 64, 64, (bf16*)(ws + WS_WL), 64, 0, 0, scr, lane)) continue;
            if (transpose_job(r, in[12], 1024, 64, 64, (bf16*)(ws + WS_WL), 128, 0, 0, scr, lane)) continue;
            if (transpose_job(r, in[12] + 65536, 1024, 64, 64, (bf16*)(ws + WS_WL), 192, 0, 0, scr, lane)) continue;
            if (transpose_job(r, in[14], 1024, 128, 256, (bf16*)(ws + WS_WL), 256, 0, 0, scr, lane)) continue;
            if (transpose_job(r, in[21], 1024, 1024, 1024, (bf16*)(ws + WS_WOUT0), 0, 0, 0, scr, lane)) continue;
            if (transpose_job(r, in[10], 64, 512, 512, (bf16*)(ws + WS_W2T), 0, 0, 0, scr, lane)) continue;
            if (transpose_job(r, in[10] + 32768, 64, 512, 512, (bf16*)(ws + WS_W2T) + 32768, 0, 0, 0, scr, lane)) continue;
            if (transpose_job(r, in[13], 64, 512, 512, (bf16*)(ws + WS_W2T) + 65536, 0, 0, 0, scr, lane)) continue;
            if (transpose_job(r, in[13] + 32768, 64, 512, 512, (bf16*)(ws + WS_W2T) + 98304, 0, 0, 0, scr, lane)) continue;
            if (transpose_job(r, in[15], 128, 512, 512, (bf16*)(ws + WS_W2T) + 131072, 0, 0, 0, scr, lane)) continue;
            break;
        }
        norm_rows(args.in[0], args.in[2], args.in[7], (bf16*)(ws + WS_H), (bf16*)(ws + WS_HX), gw, NGW, lane);
    }
    }
    GRID_BAR();
    }
    if constexpr (PROBE_REP == 50) { for (int i = 0; i < 10; ++i) GRID_BAR(); }
    if constexpr ((PH_MASK >> 1) & 1) {
    const int lane = lane_opaque(); unsigned char* const ws = ptr_opaque(args.ws);
    {
        { pg8::Gemm g{(const bf16*)(ws + WS_H), (const bf16*)(ws + WS_WIN0), S_, EVEN_IN, D_}; pg8::StaticOrder S; S.init(S_, EVEN_IN, G, bx);
          pg8::EpiStoreBf16 E{(bf16*)(ws + WS_PROJ0), EVEN_IN, 0, nullptr}; pg8::gemm_phase<pg8::EpiStoreBf16, pg8::StaticOrder, true, true>(L, g, S, E, wave); }
        { pg8::Gemm g{(const bf16*)(ws + WS_HX), (const bf16*)(ws + WS_WL), S_, LORA_N, D_}; pg8::StaticOrder S; S.init(S_, LORA_N, G, bx);
          pg8::EpiStoreBf16 E{(bf16*)(ws + WS_LORA), LORA_N, 0, nullptr}; pg8::gemm_phase<pg8::EpiStoreBf16, pg8::StaticOrder, true, true>(L, g, S, E, wave); }
        if constexpr (PROBE_REP == 1) {
        { pg8::Gemm g{(const bf16*)(ws + WS_H), (const bf16*)(ws + WS_WIN0), S_, EVEN_IN, D_}; pg8::StaticOrder S; S.init(S_, EVEN_IN, G, bx);
          pg8::EpiStoreBf16 E{(bf16*)(ws + WS_PROJ0), EVEN_IN, 0, nullptr}; pg8::gemm_phase<pg8::EpiStoreBf16, pg8::StaticOrder, true, true>(L, g, S, E, wave); }
        { pg8::Gemm g{(const bf16*)(ws + WS_HX), (const bf16*)(ws + WS_WL), S_, LORA_N, D_}; pg8::StaticOrder S; S.init(S_, LORA_N, G, bx);
          pg8::EpiStoreBf16 E{(bf16*)(ws + WS_LORA), LORA_N, 0, nullptr}; pg8::gemm_phase<pg8::EpiStoreBf16, pg8::StaticOrder, true, true>(L, g, S, E, wave); }
        }
    }
    GRID_BAR();
    }
    if constexpr ((PH_MASK >> 2) & 1) {
    const int lane = lane_opaque(); unsigned char* const ws = ptr_opaque(args.ws);
    for (int t = gw; t < S_; t += NGW) prep0_token(args, ws, scr, t, lane);
    if constexpr (PROBE_REP == 30) { for (int t = gw; t < S_; t += NGW) prep0_token(args, ws, scr, t, lane); }
    }
    if constexpr ((PH_MASK >> 3) & 1) {
    const int lane = lane_opaque(); unsigned char* const ws = ptr_opaque(args.ws);
    {
        const int hh = bx & 7, nbh = (G - hh + 7) >> 3, rank = bx >> 3;
#define STEP_SYNC() do { asm volatile("s_waitcnt vmcnt(0) lgkmcnt(0)" ::: "memory"); __builtin_amdgcn_s_barrier(); asm volatile("" ::: "memory"); } while (0)
        if (wave < 2) {
            for (int kk = -1; rank + nbh * (kk + 1) < 256 + nbh; ++kk) { const int cn = rank + nbh * kk, z = wave;
                if (kk >= 0 && cn < 256) rwkv_pass1_item(ws, L + wave * 65536, z * 2048 + hh * 256 + (z ? 255 - cn : cn), lane); STEP_SYNC(); }
        } else if (wave < 6) {
            for (int kk = -1; rank + nbh * (kk + 1) < 256 + nbh; ++kk) { const int cn1 = rank + nbh * (kk + 1);
                if (cn1 < 256) prep0_rwkv_unit<false>(args, ws, L, 4 * cn1 + (wave - 2), hh, lane); STEP_SYNC(); }
        } else {
            const float* const* in = args.in; LAS float* scr2 = (LAS float*)(L + 131072 + (wave - 6) * 8448);
            for (int kk = -1; rank + nbh * (kk + 1) < 256 + nbh; ++kk) {
                for (int j = 2 * (kk + 1); j < 2 * (kk + 1) + 2; ++j) { int r = bx * 2 + (wave - 6) + j * (G * 2);
                    if (transpose_job(r, in[23], 1024, FF0, FF0, (bf16*)(ws + WS_WGU0), 0, 128, 0, scr2, lane)) continue;
                    if (transpose_job(r, in[24], 1024, FF0, FF0, (bf16*)(ws + WS_WGU0), 0, 128, 1, scr2, lane)) continue;
                    if (transpose_job(r, in[25], FF0, 1024, 1024, (bf16*)(ws + WS_WD0), 0, 0, 0, scr2, lane)) continue;
                    if (transpose_job(r, in[27], 1024, ODD_IN, ODD_PAD, (bf16*)(ws + WS_WIN1), 0, 0, 0, scr2, lane)) continue;
                    if (transpose_job(r, in[33], 1024, 1024, 1024, (bf16*)(ws + WS_WOUT1), 0, 0, 0, scr2, lane)) continue; }
                STEP_SYNC(); }
        }
#undef STEP_SYNC
    }
    GRID_BAR();
    if (bx < 16) { rwkv_pass2_block(ws, L, bx, wave, lane); __syncthreads(); if constexpr (PROBE_REP == 4) { rwkv_pass2_block(ws, L, bx, wave, lane); __syncthreads(); } }
    else { for (int rep_ = 0; rep_ < (PROBE_REP == 3 ? 2 : 1); ++rep_) for (int unit = bx - 16; unit < 512; unit += G - 16) attn_unit(ws, L, unit, wave, lane); }
    GRID_BAR();
    for (int it = gw; it < 2048; it += NGW) rwkv_pass3_post_item(args, ws, it, lane);
    if constexpr (PROBE_REP == 63) { for (int it = gw; it < 2048; it += NGW) rwkv_pass3_post_item(args, ws, it, lane); }
    GRID_BAR();
    }
    if constexpr ((PH_MASK >> 5) & 1) {
    const int lane = lane_opaque(); unsigned char* const ws = ptr_opaque(args.ws);
    { pg8::Gemm g{(const bf16*)(ws + WS_Y), (const bf16*)(ws + WS_WOUT0), S_, D_, D_}; pg8::StaticOrder S; S.init(S_, D_, G, bx);
      pg8::EpiResF32 E{args.in[0], args.out, D_, nullptr, nullptr}; pg8::gemm_phase<pg8::EpiResF32, pg8::StaticOrder, true, true>(L, g, S, E, wave); }
    if constexpr (PROBE_REP == 7) {
    { pg8::Gemm g{(const bf16*)(ws + WS_Y), (const bf16*)(ws + WS_WOUT0), S_, D_, D_}; pg8::StaticOrder S; S.init(S_, D_, G, bx);
      pg8::EpiResF32 E{args.in[0], args.out, D_, nullptr, nullptr}; pg8::gemm_phase<pg8::EpiResF32, pg8::StaticOrder, true, true>(L, g, S, E, wave); }
    }
    GRID_BAR();
    }
    if constexpr ((PH_MASK >> 6) & 1) {
    const int lane = lane_opaque(); unsigned char* const ws = ptr_opaque(args.ws);
    norm_rows(args.out, args.in[22], nullptr, (bf16*)(ws + WS_H2), nullptr, gw, NGW, lane);
    GRID_BAR();
    }
    if constexpr ((PH_MASK >> 7) & 1) {
    const int lane = lane_opaque(); unsigned char* const ws = ptr_opaque(args.ws);
    { pg8::Gemm g{(const bf16*)(ws + WS_H2), (const bf16*)(ws + WS_WGU0), S_, 2 * FF0, D_}; pg8::StaticOrder S; S.init(S_, 2 * FF0, G, bx);
      pg8::EpiSwiGLU E{(bf16*)(ws + WS_ACT0), FF0, 0, nullptr}; pg8::gemm_phase<pg8::EpiSwiGLU, pg8::StaticOrder, true, true>(L, g, S, E, wave); }
    if constexpr (PROBE_REP == 9) {
    { pg8::Gemm g{(const bf16*)(ws + WS_H2), (const bf16*)(ws + WS_WGU0), S_, 2 * FF0, D_}; pg8::StaticOrder S; S.init(S_, 2 * FF0, G, bx);
      pg8::EpiSwiGLU E{(bf16*)(ws + WS_ACT0), FF0, 0, nullptr}; pg8::gemm_phase<pg8::EpiSwiGLU, pg8::StaticOrder, true, true>(L, g, S, E, wave); }
    }
    GRID_BAR();
    }
    if constexpr ((PH_MASK >> 8) & 1) {
    const int lane = lane_opaque(); unsigned char* const ws = ptr_opaque(args.ws);
    { pg8::Gemm g{(const bf16*)(ws + WS_ACT0), (const bf16*)(ws + WS_WD0), S_, D_, FF0}; pg8::StaticOrder S; S.init(S_, D_, G, bx);
      pg8::EpiResF32 E{args.out, args.out, D_, nullptr, nullptr}; pg8::gemm_phase<pg8::EpiResF32, pg8::StaticOrder, true, true>(L, g, S, E, wave); }
    GRID_BAR();
    }
    if constexpr ((PH_MASK >> 9) & 1) {
    const int lane = lane_opaque(); unsigned char* const ws = ptr_opaque(args.ws);
    norm_rows(args.out, args.in[26], nullptr, (bf16*)(ws + WS_H3), nullptr, gw, NGW, lane);
    GRID_BAR();
    }
    if constexpr ((PH_MASK >> 10) & 1) {
    const int lane = lane_opaque(); unsigned char* const ws = ptr_opaque(args.ws);
    { pg8::Gemm g{(const bf16*)(ws + WS_H3), (const bf16*)(ws + WS_WIN1), S_, ODD_PAD, D_}; pg8::StaticOrder S; S.init(S_, ODD_PAD, G, bx);
      pg8::EpiStoreBf16 E{(bf16*)(ws + WS_PROJ1), ODD_PAD, 0, nullptr}; pg8::gemm_phase<pg8::EpiStoreBf16, pg8::StaticOrder, true, true>(L, g, S, E, wave); }
    if constexpr (PROBE_REP == 12) {
    { pg8::Gemm g{(const bf16*)(ws + WS_H3), (const bf16*)(ws + WS_WIN1), S_, ODD_PAD, D_}; pg8::StaticOrder S; S.init(S_, ODD_PAD, G, bx);
      pg8::EpiStoreBf16 E{(bf16*)(ws + WS_PROJ1), ODD_PAD, 0, nullptr}; pg8::gemm_phase<pg8::EpiStoreBf16, pg8::StaticOrder, true, true>(L, g, S, E, wave); }
    }
    GRID_BAR();
    }
    if constexpr ((PH_MASK >> 11) & 1) {
    const int lane = lane_opaque(); unsigned char* const ws = ptr_opaque(args.ws);
    for (int cn = bx; cn < 256; cn += G) for (int i = wave; i < 64; i += 8) prep1_token(args, ws, cn * 64 + i, lane);
    GRID_BAR();
    }
    if constexpr ((PH_MASK >> 12) & 1) {
    const int lane = lane_opaque(); unsigned char* const ws = ptr_opaque(args.ws);
    {
        if (wave < 4) { const int z = wave & 1;
            for (int cn = bx; cn < 256; cn += G) for (int hh = (wave >> 1) * 2; hh < (wave >> 1) * 2 + 2; ++hh) dn_pass1_item(ws, L + wave * DN_LDS_PER_WAVE, (z * 4 + hh) * 256 + (z ? 255 - cn : cn), lane); }
        else if (wave < 7) {
            LAS float* scr2 = (LAS float*)(L + 4 * DN_LDS_PER_WAVE + (wave - 4) * 8448);
            moe_copy_loop<true>(args, ws, scr2, bx * 3 + (wave - 4), G * 3, MOE_GU_SPLIT, lane);
        }
    }
    GRID_BAR();
    { const int task = bx; if (task < 512) dn_scan_block(ws, L, task >> 8, (task & 3) < 2 ? 1 : 2, (task >> 6) & 3, task & 1, (task >> 2) & 15, wave, lane); __syncthreads(); }
    { const int task = bx + G; if (task < 512) dn_scan_block(ws, L, task >> 8, (task & 3) < 2 ? 1 : 2, (task >> 6) & 3, task & 1, (task >> 2) & 15, wave, lane); __syncthreads(); }
    if constexpr (PROBE_REP == 60) { { const int task = bx; if (task < 512) dn_scan_block(ws, L, task >> 8, (task & 3) < 2 ? 1 : 2, (task >> 6) & 3, task & 1, (task >> 2) & 15, wave, lane); __syncthreads(); }
      { const int task = bx + G; if (task < 512) dn_scan_block(ws, L, task >> 8, (task & 3) < 2 ? 1 : 2, (task >> 6) & 3, task & 1, (task >> 2) & 15, wave, lane); __syncthreads(); } }
    GRID_BAR();
    if (bx < 8) { dn_scan_groups_block(ws, L, bx, wave, lane); }
    else {
        moe_copy_loop<true>(args, ws, scr, MOE_GU_SPLIT + (bx - 8) * 8 + wave, (G - 8) * 8, 28672, lane);
    }
    GRID_BAR();
    { const int task = bx; if (task < 256) dn_scan_block(ws, L, task >> 7, 0, (task >> 5) & 3, (task >> 4) & 1, task & 15, wave, lane); __syncthreads(); }
    if constexpr (PROBE_REP == 62) { const int task = bx; if (task < 256) dn_scan_block(ws, L, task >> 7, 0, (task >> 5) & 3, (task >> 4) & 1, task & 15, wave, lane); __syncthreads(); }
    GRID_BAR();
for (int rep_ = 0; rep_ < (PROBE_REP == 16 ? 2 : 1); ++rep_) {     for (int it = gw; it < 2048; it += NGW) dn_pass3_item(ws, it, lane); }
    GRID_BAR();
    }
    if constexpr ((PH_MASK >> 13) & 1) {
    const int lane = lane_opaque(); unsigned char* const ws = ptr_opaque(args.ws);
    for (int t = gw; t < S_; t += NGW) dn_post_token(args, ws, t, lane);
    moe_copy_loop<false>(args, ws, scr, gw, NGW, 14336, lane);
    GRID_BAR();
    }
    if constexpr ((PH_MASK >> 14) & 1) {
    const int lane = lane_opaque(); unsigned char* const ws = ptr_opaque(args.ws);
    { pg8::Gemm g{(const bf16*)(ws + WS_YCAT1), (const bf16*)(ws + WS_WOUT1), S_, D_, D_}; pg8::StaticOrder S; S.init(S_, D_, G, bx);
      pg8::EpiResF32 E{args.out, args.out, D_, nullptr, nullptr}; pg8::gemm_phase<pg8::EpiResF32, pg8::StaticOrder, true, true>(L, g, S, E, wave); }
    GRID_BAR();
    }
    if constexpr ((PH_MASK >> 15) & 1) {
    const int lane = lane_opaque(); unsigned char* const ws = ptr_opaque(args.ws);
    { RouterRegs RR; route_load(args, RR, lane); for (int tg = bx; tg < 256; tg += G) route_group(RR, ws, args.out, (LAS int*)L, tg, wave, lane); }
    GRID_BAR();
    }
    int tot[8], off[9]; moe_totals(ws0, lane_opaque(), tot); moe_offsets(tot, off);
    const int ntiles = off[8] >> 8;
    if constexpr ((PH_MASK >> 16) & 1) {
    const int lane = lane_opaque(); unsigned char* const ws = ptr_opaque(args.ws);
    {
        for (int tg = bx; tg < 256; tg += G) gather_group(args, ws, args.out, off, tg, wave, lane);
        const int tid2 = wave * 64 + lane;
        if (bx == 0 && tid2 < 160) { int e = 0;
#pragma unroll
            for (int k = 1; k < 8; ++k) if (tid2 * 256 >= off[k]) e = k;
            ((int*)(ws + WS_TILE))[tid2] = e; }
#pragma unroll
        for (int e = 0; e < NEXP; ++e) { const int r0 = off[e] + tot[e], r1 = off[e + 1];
            for (int rr = r0 + gw; rr < r1; rr += NGW) { unsigned long long* o8 = (unsigned long long*)(ws + WS_AMOE8 + (size_t)rr * D_) + lane;
#pragma unroll
                for (int j = 0; j < 2; ++j) o8[64 * j] = 0ull; } }
    }
    if constexpr (PROBE_REP == 20) {
    {
        for (int tg = bx; tg < 256; tg += G) gather_group(args, ws, args.out, off, tg, wave, lane);
        const int tid2 = wave * 64 + lane;
        if (bx == 0 && tid2 < 160) { int e = 0;
#pragma unroll
            for (int k = 1; k < 8; ++k) if (tid2 * 256 >= off[k]) e = k;
            ((int*)(ws + WS_TILE))[tid2] = e; }
#pragma unroll
        for (int e = 0; e < NEXP; ++e) { const int r0 = off[e] + tot[e], r1 = off[e + 1];
            for (int rr = r0 + gw; rr < r1; rr += NGW) { unsigned long long* o8 = (unsigned long long*)(ws + WS_AMOE8 + (size_t)rr * D_) + lane;
#pragma unroll
                for (int j = 0; j < 2; ++j) o8[64 * j] = 0ull; } }
    }
    }
    GRID_BAR();
    }
    if constexpr ((PH_MASK >> 17) & 1) {
    const int lane = lane_opaque(); unsigned char* const ws = ptr_opaque(args.ws);
    for (int b = 0; b < 3; ++b) {
        const int tlo = b * MOE_BATCH_TILES; int nt = ntiles - tlo; nt = nt < 0 ? 0 : (nt > MOE_BATCH_TILES ? MOE_BATCH_TILES : nt);
        { pg8::Gemm g{(const bf16*)(ws + WS_AMOE8), (const bf16*)(ws + WS_WMGU), MOE_ROWS, NEXP * 2 * FFE, D_ / 2};
          pg8::MoeOrder S{(const int*)(ws + WS_TILE), tlo, nt, 2 * FFE / 256, G, bx};
          pg8::EpiSwiGLU8 E{ws + WS_MACT - (size_t)tlo * 256 * FFE, FFE, 2 * FFE / 256, 1.0f / MOE_WSCALE};
          pg8::gemm_phase<pg8::EpiSwiGLU8, pg8::MoeOrder, true, true, true>(L, g, S, E, wave); }
        if constexpr (PROBE_REP == 21) {
        { pg8::Gemm g{(const bf16*)(ws + WS_AMOE8), (const bf16*)(ws + WS_WMGU), MOE_ROWS, NEXP * 2 * FFE, D_ / 2};
          pg8::MoeOrder S{(const int*)(ws + WS_TILE), tlo, nt, 2 * FFE / 256, G, bx};
          pg8::EpiSwiGLU8 E{ws + WS_MACT - (size_t)tlo * 256 * FFE, FFE, 2 * FFE / 256, 1.0f / MOE_WSCALE};
          pg8::gemm_phase<pg8::EpiSwiGLU8, pg8::MoeOrder, true, true, true>(L, g, S, E, wave); }
        }
        GRID_BAR();
        { pg8::Gemm g{(const bf16*)(ws + WS_MACT - (size_t)tlo * 256 * FFE), (const bf16*)(ws + WS_WMD), MOE_ROWS, NEXP * D_, FFE / 2};
          pg8::MoeOrder S{(const int*)(ws + WS_TILE), tlo, nt, D_ / 256, G, bx};
          pg8::EpiStoreBf16 E{(bf16*)(ws + WS_AMOE), D_, D_ / 256, nullptr, 1.0f / MOE_WSCALE};
          pg8::gemm_phase<pg8::EpiStoreBf16, pg8::MoeOrder, true, true, true>(L, g, S, E, wave); }
        if constexpr (PROBE_REP == 22) {
        { pg8::Gemm g{(const bf16*)(ws + WS_MACT - (size_t)tlo * 256 * FFE), (const bf16*)(ws + WS_WMD), MOE_ROWS, NEXP * D_, FFE / 2};
          pg8::MoeOrder S{(const int*)(ws + WS_TILE), tlo, nt, D_ / 256, G, bx};
          pg8::EpiStoreBf16 E{(bf16*)(ws + WS_AMOE), D_, D_ / 256, nullptr, 1.0f / MOE_WSCALE};
          pg8::gemm_phase<pg8::EpiStoreBf16, pg8::MoeOrder, true, true, true>(L, g, S, E, wave); }
        }
        GRID_BAR();
    }
    }
    if constexpr ((PH_MASK >> 18) & 1) {
    const int lane = lane_opaque(); unsigned char* const ws = ptr_opaque(args.ws);
    for (int t = gw; t < S_; t += NGW) combine_token(ws, args.out, off, t, lane);
#if PROBE
    {
        const unsigned* ts = (const unsigned*)(ws + WS_CTL) + 512;
        const unsigned dA = PROBE_A < 0 ? 32000u : (__hip_atomic_load(ts + PROBE_A, __ATOMIC_RELAXED, __HIP_MEMORY_SCOPE_AGENT) - __hip_atomic_load(ts + PROBE_A - 1, __ATOMIC_RELAXED, __HIP_MEMORY_SCOPE_AGENT));
        const unsigned dB = __hip_atomic_load(ts + PROBE_B, __ATOMIC_RELAXED, __HIP_MEMORY_SCOPE_AGENT) - __hip_atomic_load(ts + PROBE_B - 1, __ATOMIC_RELAXED, __HIP_MEMORY_SCOPE_AGENT);
        const int rows = 8 * (int)(dA / 3200u) + 64;
        const float addB = 4.0f * (float)(dB / 3200u) + 8.0f;
        for (int t = gw; t < S_; t += NGW) {
            if (t < rows) { f32x4* xo = (f32x4*)(args.out + (size_t)t * D_) + lane;
#pragma unroll
                for (int j = 0; j < 4; ++j) xo[64 * j] = xo[64 * j] + 5.0f; }
            if (t == S_ - 1 && lane == 63) args.out[(size_t)t * D_ + 1023] += addB;
        }
    }
#endif
    }
}

extern "C" void kernel_launch(void* const* d_in, const int* in_sizes, int n_in, void* d_out, int out_size, void* d_ws, size_t ws_size, hipStream_t stream) {
    static int grid = 0;
    if (grid == 0) {
        if (n_in != 39 || out_size != S_ * D_ || ws_size < WS_END) { fprintf(stderr, "kernel_launch: unexpected shapes (n_in %d out %d ws %zu)\n", n_in, out_size, ws_size); grid = -1; return; }
        int dev = 0, cus = 0, per_cu = 0;
        if (hipGetDevice(&dev) != hipSuccess || hipDeviceGetAttribute(&cus, hipDeviceAttributeMultiprocessorCount, dev) != hipSuccess) { grid = -1; return; }
        if (hipFuncSetAttribute((const void*)fwd_kernel, hipFuncAttributeMaxDynamicSharedMemorySize, LDS_BYTES) != hipSuccess) { grid = -1; return; }
        if (hipOccupancyMaxActiveBlocksPerMultiprocessor(&per_cu, (const void*)fwd_kernel, 512, LDS_BYTES) != hipSuccess || per_cu < 1) { fprintf(stderr, "kernel_launch: occupancy query says %d\n", per_cu); }
        (void)hipGetLastError();
        if (cus < 256) { fprintf(stderr, "kernel_launch: this build needs >= 256 CUs (task slots of the delta-net scan); got %d\n", cus); grid = -1; return; }
        grid = 256;
    }
    if (grid < 0) return;
    if (hipMemsetAsync((char*)d_ws + WS_CTL, 0, CTL_ZERO_BYTES, stream) != hipSuccess) return;
    Args a{};
    for (int i = 0; i < 39; ++i) a.in[i] = (const float*)d_in[i];
    a.out = (float*)d_out; a.ws = (unsigned char*)d_ws;
    hipLaunchKernelGGL(fwd_kernel, dim3(grid), dim3(512), LDS_BYTES, stream, a);
}
```

```cpp
#include <hip/hip_runtime.h>
#include <cstdio>
#include <cstdint>
namespace pg8 {
#define PG8_LAS __attribute__((address_space(3)))
typedef unsigned short bf16_t;
typedef short bf16x8 __attribute__((ext_vector_type(8)));
typedef float f32x4 __attribute__((ext_vector_type(4)));
typedef unsigned u32x4 __attribute__((ext_vector_type(4)));
typedef int i32x8 __attribute__((ext_vector_type(8)));
typedef unsigned u32x2 __attribute__((ext_vector_type(2)));
constexpr int BM = 256, BK = 64, HALF = 128, HTB = HALF * BK * 2  , STAGE_BYTES = 8 * HTB, NXCD = 8, WGM = 8;

__host__ __device__ __forceinline__ int lds_byte(int r, int c) { const int st = (r >> 4) * 2 + (c >> 5), rr = r & 15, cc = c & 31, ob = rr * 64 + cc * 2; return st * 1024 + (ob ^ (((ob >> 9) & 1) << 5)); }
__host__ __device__ __forceinline__ void stage_rc(int b, int& R, int& C) { const int st = b / 1024, sb = b % 1024, swz = sb ^ (((sb >> 9) & 1) << 5); R = (st >> 1) * 16 + swz / 64; C = (st & 1) * 32 + (swz % 64) / 2; }
__host__ __device__ __forceinline__ int perm32(int rho) { const int n = rho >> 4, i = rho & 15; return 8 * (i >> 2) + 4 * n + (i & 3); }

struct Unit { int pm, pn; };
struct Gemm { const bf16_t* A; const bf16_t* Bt; int M, N, K; };

struct StaticOrder {
    int nM, nN, nwg, G, c;
    __host__ __device__ void init(int M, int N, int G_, int c_) { nM = M / BM; nN = N / BM; nwg = nM * nN; G = G_; c = c_; }
    __host__ __device__ bool next(int i, Unit& u) const {
        const long L = (long)i * G + c; if (L >= nwg) return false;
        int wgid = (int)L; { const int q = nwg / NXCD, r = nwg % NXCD, xcd = wgid % NXCD, off = wgid / NXCD; wgid = (xcd < r ? xcd * (q + 1) : r * (q + 1) + (xcd - r) * q) + off; }
        const int nig = WGM * nN, gid = wgid / nig, fm = gid * WGM, gsz = (nM - fm) < WGM ? (nM - fm) : WGM;
        u.pm = fm + ((wgid % nig) % gsz); u.pn = (wgid % nig) / gsz; return true;
    }
    __device__ __forceinline__ void a_ready(const Unit&) const {}
    __device__ __forceinline__ void done(const Unit&) const {}
};

__device__ __forceinline__ unsigned cvt_pk_bf16(float lo, float hi) { unsigned r; asm volatile("v_cvt_pk_bf16_f32 %0, %1, %2" : "=v"(r) : "v"(lo), "v"(hi)); return r; }
struct EpiStoreBf16 {
    static constexpr bool PERM = true, AFTER_DRAIN = false;
    bf16_t* O; int ldc; int ntn; const float* rowss;
    float scale = 1.0f;
    __device__ __forceinline__ void operator()(const f32x4 (&acc)[2][2][4][2], const Unit& u, int wr, int wc, int fr, int fq) const {
        const int row0 = u.pm * BM + wr * 64 + fr; const int pn = ntn ? (u.pn % ntn) : u.pn;
        const int col0 = pn * BM + wc * 32 + 8 * fq;
#pragma unroll
        for (int ai = 0; ai < 2; ++ai)
#pragma unroll
            for (int m = 0; m < 4; ++m) { bf16_t* rowp = O + (size_t)(row0 + ai * HALF + m * 16) * ldc + col0;
                float rs = scale; if (rowss) { const f32x4* sp = (const f32x4*)(rowss + (size_t)(row0 + ai * HALF + m * 16) * 16); const f32x4 s0 = sp[0], s1 = sp[1], s2 = sp[2], s3 = sp[3]; const f32x4 st = (s0 + s1) + (s2 + s3); rs *= 1.0f / sqrtf(((st[0] + st[1]) + (st[2] + st[3])) * (1.0f / 1024.f) + 1e-6f); }
#pragma unroll
                for (int bj = 0; bj < 2; ++bj) { const f32x4 v0 = acc[ai][bj][m][0] * rs, v1 = acc[ai][bj][m][1] * rs;
                    u32x4 w; w.x = cvt_pk_bf16(v0[0], v0[1]); w.y = cvt_pk_bf16(v0[2], v0[3]); w.z = cvt_pk_bf16(v1[0], v1[1]); w.w = cvt_pk_bf16(v1[2], v1[3]);
                    *(u32x4*)(rowp + bj * HALF) = w; } }
    }
};
struct EpiResF32 {
    static constexpr bool PERM = false, AFTER_DRAIN = false;
    const float* base; float* out; int ldc; bf16_t* xb; float* rowss;
    __device__ __forceinline__ void operator()(const f32x4 (&acc)[2][2][4][2], const Unit& u, int wr, int wc, int fr, int fq) const {
        const int row0 = u.pm * BM + wr * 64 + fr, col0 = u.pn * BM + wc * 32 + 4 * fq;
#pragma unroll
        for (int ai = 0; ai < 2; ++ai)
#pragma unroll
            for (int m = 0; m < 4; ++m) { const size_t off = (size_t)(row0 + ai * HALF + m * 16) * ldc + col0; float ss = 0.f;
#pragma unroll
                for (int bj = 0; bj < 2; ++bj)
#pragma unroll
                    for (int n = 0; n < 2; ++n) { const f32x4 b = *(const f32x4*)(base + off + bj * HALF + n * 16); const f32x4 o = b + acc[ai][bj][m][n]; *(f32x4*)(out + off + bj * HALF + n * 16) = o;
                        if (xb) { ss += (o[0] * o[0] + o[1] * o[1]) + (o[2] * o[2] + o[3] * o[3]);
                            unsigned long long w = (unsigned long long)cvt_pk_bf16(o[0], o[1]) | ((unsigned long long)cvt_pk_bf16(o[2], o[3]) << 32); *(unsigned long long*)(xb + off + bj * HALF + n * 16) = w; } }
                if (xb) { ss += __shfl_xor(ss, 16); ss += __shfl_xor(ss, 32); if (fq == 0) rowss[(size_t)(row0 + ai * HALF + m * 16) * 16 + u.pn * 4 + wc] = ss; } }
    }
};
struct EpiSwiGLU {
    static constexpr bool PERM = true, AFTER_DRAIN = false;
    bf16_t* O; int ldc; int ntn; const float* rowss;
    __device__ __forceinline__ void operator()(const f32x4 (&acc)[2][2][4][2], const Unit& u, int wr, int wc, int fr, int fq) const {
        const int row0 = u.pm * BM + wr * 64 + fr; const int pn = ntn ? (u.pn % ntn) : u.pn;
        const int col0 = pn * HALF + wc * 32 + 8 * fq;
#pragma unroll
        for (int ai = 0; ai < 2; ++ai)
#pragma unroll
            for (int m = 0; m < 4; ++m) { bf16_t* rowp = O + (size_t)(row0 + ai * HALF + m * 16) * ldc + col0;
                float rs = 1.0f; if (rowss) { const f32x4* sp = (const f32x4*)(rowss + (size_t)(row0 + ai * HALF + m * 16) * 16); const f32x4 s0 = sp[0], s1 = sp[1], s2 = sp[2], s3 = sp[3]; const f32x4 st = (s0 + s1) + (s2 + s3); rs = 1.0f / sqrtf(((st[0] + st[1]) + (st[2] + st[3])) * (1.0f / 1024.f) + 1e-6f); }
                float r[8];
#pragma unroll
                for (int n = 0; n < 2; ++n)
#pragma unroll
                    for (int i = 0; i < 4; ++i) { const float g = acc[ai][0][m][n][i] * rs, up = acc[ai][1][m][n][i] * rs; r[n * 4 + i] = g * __builtin_amdgcn_rcpf(1.0f + __expf(-g)) * up; }
                u32x4 w; w.x = cvt_pk_bf16(r[0], r[1]); w.y = cvt_pk_bf16(r[2], r[3]); w.z = cvt_pk_bf16(r[4], r[5]); w.w = cvt_pk_bf16(r[6], r[7]);
                *(u32x4*)rowp = w; }
    }
};
__device__ __forceinline__ unsigned cvt_pk4_fp8(float a, float b, float c, float d) { int w = __builtin_amdgcn_cvt_pk_fp8_f32(a, b, 0, false); w = __builtin_amdgcn_cvt_pk_fp8_f32(c, d, w, true); return (unsigned)w; }
struct EpiSwiGLU8 {
    static constexpr bool PERM = true, AFTER_DRAIN = false;
    unsigned char* O; int ldc; int ntn; float scale;
    __device__ __forceinline__ void operator()(const f32x4 (&acc)[2][2][4][2], const Unit& u, int wr, int wc, int fr, int fq) const {
        const int row0 = u.pm * BM + wr * 64 + fr; const int pn = ntn ? (u.pn % ntn) : u.pn;
        const int col0 = pn * HALF + wc * 32 + 8 * fq;
#pragma unroll
        for (int ai = 0; ai < 2; ++ai)
#pragma unroll
            for (int m = 0; m < 4; ++m) { unsigned char* rowp = O + (size_t)(row0 + ai * HALF + m * 16) * ldc + col0;
                float r[8];
#pragma unroll
                for (int n = 0; n < 2; ++n)
#pragma unroll
                    for (int i = 0; i < 4; ++i) { const float g = acc[ai][0][m][n][i] * scale, up = acc[ai][1][m][n][i] * scale; r[n * 4 + i] = g * __builtin_amdgcn_rcpf(1.0f + __expf(-g)) * up; }
                u32x2 w; w.x = cvt_pk4_fp8(r[0], r[1], r[2], r[3]); w.y = cvt_pk4_fp8(r[4], r[5], r[6], r[7]);
                *(u32x2*)rowp = w; }
    }
};
struct MoeOrder {
    const int* tile_exp; int tlo, nt, nN, G, c;
    __device__ __forceinline__ bool next(int i, Unit& u) const {
        const int L = i * G + c; if (nt <= 0 || L >= nt * nN) return false;
        const int t = tlo + (L % nt), cn = L / nt;
        const int e = __builtin_amdgcn_readfirstlane(__hip_atomic_load(tile_exp + t, __ATOMIC_RELAXED, __HIP_MEMORY_SCOPE_AGENT));
        u.pm = t; u.pn = e * nN + cn; return true;
    }
    __device__ __forceinline__ void a_ready(const Unit&) const {}
    __device__ __forceinline__ void done(const Unit&) const {}
};
template <class Epi, class Sched, bool ALIGN_EPI = false, bool SP2 = false, bool F8 = false>
__device__ __forceinline__ void gemm_phase(PG8_LAS unsigned char* lds, const Gemm g, const Sched& S, const Epi& E, const int wave_id) {
    int tid_; asm volatile("v_mbcnt_lo_u32_b32 %0, -1, 0\n\tv_mbcnt_hi_u32_b32 %0, -1, %0" : "=v"(tid_)); tid_ += wave_id * 64;
    const int tid = tid_, wid = __builtin_amdgcn_readfirstlane(tid >> 6), lane = tid & 63, wr = wid >> 2, wc = wid & 3, fr = lane & 15, fq = lane >> 4;
    const int K = g.K, nt = K / BK;
    unsigned voffA[2], voffB[2];
#pragma unroll
    for (int i = 0; i < 2; ++i) { int R, C; stage_rc(tid * 16 + i * 8192, R, C); const int Rb = Epi::PERM ? ((R & ~31) + perm32(R & 31)) : R;
        voffA[i] = (unsigned)(R * K + C) * 2u; voffB[i] = (unsigned)(Rb * K + C) * 2u; }
    const size_t kstep = (size_t)(BK * 2);
    const size_t hstep = (size_t)HALF * K * 2;
    const size_t tstep = 2 * hstep;
    const unsigned ldsw = (unsigned)wid * 1024u;
    const int aoff = lds_byte(wr * 64 + fr, fq * 8), boff = lds_byte(wc * 32 + fr, fq * 8);
#define PG8_SA(b, h) (((b) * 2 + (h)) * HTB)
#define PG8_SB(b, h) ((4 + (b) * 2 + (h)) * HTB)
#define PG8_STAGE(bufoff, gbase, voff) do { _Pragma("unroll") for (int _i = 0; _i < 2; ++_i) \
        __builtin_amdgcn_global_load_lds((const unsigned*)((const char*)(gbase) + (voff)[_i]), (PG8_LAS unsigned*)(lds + (bufoff) + ldsw + _i * 8192), 16, 0, 0); } while (0)
#define PG8_LDA(dst, b, h) do { _Pragma("unroll") for (int m = 0; m < 4; ++m) _Pragma("unroll") for (int k = 0; k < 2; ++k) dst[m][k] = *(const PG8_LAS bf16x8*)(lds + PG8_SA(b, h) + aoff + m * 2048 + k * 1024); } while (0)
#define PG8_LDB(dst, b, h) do { _Pragma("unroll") for (int n = 0; n < 2; ++n) _Pragma("unroll") for (int k = 0; k < 2; ++k) dst[n][k] = *(const PG8_LAS bf16x8*)(lds + PG8_SB(b, h) + boff + n * 2048 + k * 1024); } while (0)
#define PG8_CAT(x) __builtin_bit_cast(i32x8, __builtin_shufflevector((x)[0], (x)[1], 0, 1, 2, 3, 4, 5, 6, 7, 8, 9, 10, 11, 12, 13, 14, 15))
#define PG8_MMA(ai, bj, At, Bt) do { __builtin_amdgcn_s_setprio(1); _Pragma("unroll") for (int m = 0; m < 4; ++m) _Pragma("unroll") for (int n = 0; n < 2; ++n) { \
        if constexpr (F8) asm volatile("v_mfma_f32_16x16x128_f8f6f4 %0, %1, %2, %0" : "+v"(acc[ai][bj][m][n]) : "v"(PG8_CAT(Bt[n])), "v"(PG8_CAT(At[m])));   \
        else { _Pragma("unroll") for (int k = 0; k < 2; ++k) acc[ai][bj][m][n] = __builtin_amdgcn_mfma_f32_16x16x32_bf16(Bt[n][k], At[m][k], acc[ai][bj][m][n], 0, 0, 0); } } \
        __builtin_amdgcn_s_setprio(0); } while (0)
#define PG8_WAIT_V(n) asm volatile("s_waitcnt vmcnt(" #n ")" ::: "memory")
#define PG8_WAIT_L(n) asm volatile("s_waitcnt lgkmcnt(" #n ")" ::: "memory")
#define PG8_BAR __builtin_amdgcn_s_barrier()
#define PG8_SCHED __builtin_amdgcn_sched_barrier(0)
    Unit cur, nxt; int ui = 0;
    if (!S.next(0, cur)) return;
    f32x4 acc[2][2][4][2];
#pragma unroll
    for (int a = 0; a < 2; ++a)
#pragma unroll
        for (int b = 0; b < 2; ++b)
#pragma unroll
            for (int m = 0; m < 4; ++m)
#pragma unroll
                for (int n = 0; n < 2; ++n) acc[a][b][m][n] = (f32x4){0.f, 0.f, 0.f, 0.f};
    bf16x8 At[4][2], B0[2][2], B1[2][2];
    const char* cA = (const char*)g.A + (size_t)cur.pm * tstep; const char* cB = (const char*)g.Bt + (size_t)cur.pn * tstep;
    S.a_ready(cur);
    if constexpr (SP2) {
        PG8_STAGE(PG8_SB(0, 0), cB, voffB); PG8_STAGE(PG8_SB(0, 1), cB + hstep, voffB); PG8_STAGE(PG8_SA(0, 0), cA, voffA); PG8_STAGE(PG8_SA(0, 1), cA + hstep, voffA);
        if (wr == 1) PG8_BAR;
        PG8_WAIT_V(2); PG8_BAR;
        PG8_STAGE(PG8_SB(1, 0), cB + kstep, voffB); PG8_STAGE(PG8_SA(1, 0), cA + kstep, voffA); PG8_STAGE(PG8_SB(1, 1), cB + hstep + kstep, voffB);
        PG8_WAIT_V(6); PG8_BAR;
    } else {
        PG8_STAGE(PG8_SB(0, 0), cB, voffB); PG8_STAGE(PG8_SA(0, 0), cA, voffA); PG8_STAGE(PG8_SB(0, 1), cB + hstep, voffB); PG8_STAGE(PG8_SA(0, 1), cA + hstep, voffA);
        if (wr == 1) PG8_BAR;
        PG8_WAIT_V(4); PG8_BAR;
        PG8_STAGE(PG8_SB(1, 0), cB + kstep, voffB); PG8_STAGE(PG8_SA(1, 0), cA + kstep, voffA); PG8_STAGE(PG8_SB(1, 1), cB + hstep + kstep, voffB);
        PG8_WAIT_V(6); PG8_BAR;
    }
    for (;;) {
        const bool has_next = S.next(ui + 1, nxt);
        const char* nA = has_next ? (const char*)g.A + (size_t)nxt.pm * tstep : cA; const char* nB = has_next ? (const char*)g.Bt + (size_t)nxt.pn * tstep : cB;
        for (int t = 0; t < nt; t += 2) {
            const bool last = (t == nt - 2);
            const char* a1 = cA + (size_t)(t + 1) * kstep;
            const char* a2 = last ? nA : cA + (size_t)(t + 2) * kstep; const char* b2 = last ? nB : cB + (size_t)(t + 2) * kstep;
            const char* a3 = a2 + kstep; const char* b3 = b2 + kstep;
            if (last && has_next) S.a_ready(nxt);
            if constexpr (SP2) {
            PG8_LDB(B0, 0, 0); PG8_LDB(B1, 0, 1); PG8_SCHED; PG8_LDA(At, 0, 0); PG8_STAGE(PG8_SA(1, 1), a1 + hstep, voffA);
            PG8_WAIT_V(8); PG8_WAIT_L(0); PG8_BAR; PG8_MMA(0, 0, At, B0); PG8_MMA(0, 1, At, B1); PG8_BAR; PG8_SCHED;
            PG8_LDA(At, 0, 1); PG8_STAGE(PG8_SB(0, 0), b2, voffB); PG8_STAGE(PG8_SB(0, 1), b2 + hstep, voffB); PG8_STAGE(PG8_SA(0, 0), a2, voffA);
            PG8_WAIT_V(8); PG8_WAIT_L(0); PG8_BAR; PG8_MMA(1, 0, At, B0); PG8_MMA(1, 1, At, B1); PG8_BAR; PG8_SCHED;
            PG8_LDB(B0, 1, 0); PG8_LDB(B1, 1, 1); PG8_SCHED; PG8_LDA(At, 1, 0); PG8_STAGE(PG8_SA(0, 1), a2 + hstep, voffA);
            PG8_WAIT_V(8); PG8_WAIT_L(0); PG8_BAR; PG8_MMA(0, 0, At, B0); PG8_MMA(0, 1, At, B1); PG8_BAR; PG8_SCHED;
            PG8_LDA(At, 1, 1); PG8_STAGE(PG8_SB(1, 0), b3, voffB); PG8_STAGE(PG8_SB(1, 1), b3 + hstep, voffB); PG8_STAGE(PG8_SA(1, 0), a3, voffA);
            PG8_WAIT_V(8); PG8_WAIT_L(0); PG8_BAR; PG8_MMA(1, 0, At, B0); PG8_MMA(1, 1, At, B1); PG8_BAR; PG8_SCHED;
            } else {
            PG8_LDB(B0, 0, 0); PG8_SCHED; PG8_LDA(At, 0, 0); PG8_STAGE(PG8_SA(1, 1), a1 + hstep, voffA);
            PG8_WAIT_L(8); PG8_BAR; PG8_WAIT_L(0); PG8_MMA(0, 0, At, B0); PG8_BAR; PG8_SCHED;
            PG8_LDB(B1, 0, 1); PG8_STAGE(PG8_SB(0, 0), b2, voffB);
            PG8_BAR; PG8_WAIT_L(0); PG8_MMA(0, 1, At, B1); PG8_BAR;
            PG8_LDA(At, 0, 1); PG8_STAGE(PG8_SA(0, 0), a2, voffA);
            PG8_BAR; PG8_WAIT_L(0); PG8_MMA(1, 0, At, B0); PG8_BAR; PG8_SCHED;
            PG8_STAGE(PG8_SB(0, 1), b2 + hstep, voffB);
            PG8_WAIT_V(6); PG8_BAR; PG8_MMA(1, 1, At, B1); PG8_BAR;
            PG8_LDB(B0, 1, 0); PG8_SCHED; PG8_LDA(At, 1, 0); PG8_STAGE(PG8_SA(0, 1), a2 + hstep, voffA);
            PG8_WAIT_L(8); PG8_BAR; PG8_WAIT_L(0); PG8_MMA(0, 0, At, B0); PG8_BAR; PG8_SCHED;
            PG8_LDB(B1, 1, 1); PG8_STAGE(PG8_SB(1, 0), b3, voffB);
            PG8_BAR; PG8_WAIT_L(0); PG8_MMA(0, 1, At, B1); PG8_BAR;
            PG8_LDA(At, 1, 1); PG8_STAGE(PG8_SA(1, 0), a3, voffA);
            PG8_BAR; PG8_WAIT_L(0); PG8_MMA(1, 0, At, B0); PG8_BAR; PG8_SCHED;
            PG8_STAGE(PG8_SB(1, 1), b3 + hstep, voffB);
            PG8_WAIT_V(6); PG8_BAR; PG8_MMA(1, 1, At, B1); PG8_BAR;
            }
        }
        if constexpr (ALIGN_EPI) { if (wr == 0) PG8_BAR; }
        if constexpr (F8) { asm volatile("s_nop 15\n\ts_nop 15" ::: "memory"); PG8_SCHED; }
        if constexpr (!Epi::AFTER_DRAIN) { E(acc, cur, wr, wc, fr, fq); S.done(cur); }
        if (!has_next) break;
#pragma unroll
        for (int a = 0; a < 2; ++a)
#pragma unroll
            for (int b = 0; b < 2; ++b)
#pragma unroll
                for (int m = 0; m < 4; ++m)
#pragma unroll
                    for (int n = 0; n < 2; ++n) acc[a][b][m][n] = (f32x4){0.f, 0.f, 0.f, 0.f};
        cur = nxt; cA = nA; cB = nB; ++ui;
        if constexpr (ALIGN_EPI) { if (wr == 1) PG8_BAR; }
    }
    PG8_WAIT_V(0);
    if constexpr (!ALIGN_EPI) { if (wr == 0) PG8_BAR; }
    PG8_BAR;
    if constexpr (Epi::AFTER_DRAIN) { E.fused(acc, cur, wr, wc, fr, fq, lds, wid, lane); S.done(cur); }
#undef PG8_SA
#undef PG8_SB
#undef PG8_STAGE
#undef PG8_LDA
#undef PG8_LDB
#undef PG8_MMA
#undef PG8_CAT
#undef PG8_WAIT_V
#undef PG8_WAIT_L
#undef PG8_BAR
#undef PG8_SCHED
}
}
constexpr int S_ = 16384, D_ = 1024;
constexpr int EVEN_IN = 3072, LORA_N = 512, FF0 = 2816, ODD_IN = 3600, ODD_PAD = 3840, FFE = 3584, NEXP = 8;
constexpr int MOE_ROWS = 32768 + 8 * 256;
constexpr int MOE_BATCH_TILES = 64;
constexpr size_t MiB = 1u << 20;
constexpr size_t WS_CTL = 0, CTL_ZERO_BYTES = 1 * MiB;
constexpr size_t WS_WIN0 = 2 * MiB, WS_WL = 8 * MiB, WS_WOUT0 = 9 * MiB, WS_WGU0 = 11 * MiB, WS_WD0 = 22 * MiB, WS_WIN1 = 28 * MiB, WS_WOUT1 = 36 * MiB;
constexpr size_t WS_TOK = 38 * MiB;
constexpr size_t WS_TILE = 39 * MiB;
constexpr size_t WS_A = 40 * MiB;
constexpr size_t WS_H = WS_A, WS_HX = WS_A + 32 * MiB;
constexpr size_t WS_LW0 = WS_A, WS_LW1 = WS_A + 32 * MiB, WS_R = WS_A + 64 * MiB, WS_V = WS_A + 80 * MiB, WS_KK = WS_A + 96 * MiB, WS_KD0 = WS_A + 112 * MiB, WS_KD1 = WS_A + 128 * MiB, WS_B0 = WS_A + 144 * MiB;
constexpr size_t WS_H2 = WS_A, WS_H3 = WS_A + 32 * MiB;
constexpr size_t WS_WMGU = WS_A, WS_WMD = WS_A + 112 * MiB;
constexpr size_t WS_B = 208 * MiB;
constexpr size_t WS_PROJ0 = WS_B, WS_LORA = WS_B + 96 * MiB, WS_QN = WS_B + 112 * MiB, WS_KN = WS_B + 128 * MiB, WS_Y = WS_B + 144 * MiB;
constexpr size_t WS_B1 = WS_B + 176 * MiB, WS_GATE = WS_B + 192 * MiB, WS_BONUS = WS_B + 208 * MiB, WS_Y0 = WS_LORA, WS_Y1 = WS_B + 224 * MiB;
constexpr size_t WS_ACT0 = WS_B, WS_PROJ1 = WS_B + 88 * MiB;
constexpr size_t WS_QD = WS_B, WS_KD = WS_B + 16 * MiB, WS_VD = WS_B + 32 * MiB, WS_YCAT1 = WS_B + 48 * MiB, WS_GB = WS_B + 80 * MiB  ;
constexpr size_t WS_O0 = WS_B + 208 * MiB, WS_O1 = WS_B + 224 * MiB;
constexpr size_t WS_AMOE = WS_B, WS_MACT = WS_B + 88 * MiB, WS_AMOE8 = WS_B + 144 * MiB;
constexpr size_t WS_END_OLD = 448 * MiB, WS_RSS1 = 460 * MiB, WS_RSS2 = 461 * MiB, WS_END = 462 * MiB;
static_assert(WS_MACT + (size_t)MOE_BATCH_TILES * 256 * FFE <= WS_AMOE8 && WS_AMOE8 + (size_t)MOE_ROWS * D_ <= WS_END_OLD, "moe act");
static_assert(WS_AMOE + (size_t)MOE_ROWS * D_ * 2 <= WS_MACT, "amoe");
static_assert(WS_PROJ1 + (size_t)S_ * ODD_PAD * 2 <= WS_O0, "proj1");
constexpr int CW_CNT = 64;
constexpr int CW_RSS1 = 32768, CW_RSS2 = 32768 + 16384;
constexpr int CW_BAR = 4096;
constexpr int LDS_BYTES = 159744, LDS_ZERO_OFF = LDS_BYTES - 512, MISC_OFF = LDS_ZERO_OFF + 64;

#define GAS __attribute__((address_space(1)))
#define LAS __attribute__((address_space(3)))
#define DI __device__ __forceinline__
typedef unsigned short bf16;
typedef unsigned v4u __attribute__((ext_vector_type(4)));
typedef float f32x4 __attribute__((ext_vector_type(4)));
typedef GAS unsigned gu32;
#define LDS_WAIT() asm volatile("s_waitcnt lgkmcnt(0)" ::: "memory")
DI unsigned f2bf(float f) { unsigned u = __builtin_bit_cast(unsigned, f); return (u + 0x7fffu + ((u >> 16) & 1u)) >> 16; }
typedef float f32x2_t __attribute__((ext_vector_type(2))); typedef __bf16 bf16x2_t __attribute__((ext_vector_type(2)));
DI unsigned pk2(float lo, float hi) { const f32x2_t v = {lo, hi}; const bf16x2_t b = __builtin_convertvector(v, bf16x2_t); return __builtin_bit_cast(unsigned, b); }
DI float bflo(unsigned w) { return __uint_as_float(w << 16); }
DI float bfhi(unsigned w) { return __uint_as_float(w & 0xffff0000u); }
DI float bf2f(bf16 b) { return __uint_as_float(((unsigned)b) << 16); }
DI void ld8(const bf16* p, float (&v)[8]) { const v4u w = *(const v4u*)p; v[0] = bflo(w.x); v[1] = bfhi(w.x); v[2] = bflo(w.y); v[3] = bfhi(w.y); v[4] = bflo(w.z); v[5] = bfhi(w.z); v[6] = bflo(w.w); v[7] = bfhi(w.w); }
DI void st8(bf16* p, const float (&v)[8]) { v4u w; w.x = pk2(v[0], v[1]); w.y = pk2(v[2], v[3]); w.z = pk2(v[4], v[5]); w.w = pk2(v[6], v[7]); *(v4u*)p = w; }
DI void ld8f(const float* p, float (&v)[8]) { const f32x4 a = *(const f32x4*)p, b = *(const f32x4*)(p + 4); v[0] = a.x; v[1] = a.y; v[2] = a.z; v[3] = a.w; v[4] = b.x; v[5] = b.y; v[6] = b.z; v[7] = b.w; }
DI void st8f(float* p, const float (&v)[8]) { *(f32x4*)p = (f32x4){v[0], v[1], v[2], v[3]}; *(f32x4*)(p + 4) = (f32x4){v[4], v[5], v[6], v[7]}; }
DI float wave_sum(float v) {
#pragma unroll
    for (int o = 1; o < 64; o <<= 1) v += __shfl_xor(v, o);
    return v;
}
template <int W> DI float grp_sum(float v) {
#pragma unroll
    for (int o = 1; o < W; o <<= 1) v += __shfl_xor(v, o);
    return v;
}
DI float sigmoidf_(float x) { return 1.0f / (1.0f + __expf(-x)); }
DI float softplusf_(float x) { return x > 20.f ? x : log1pf(__expf(x)); }
DI float siluf_(float x) { return x / (1.0f + __expf(-x)); }

struct Args { const float* in[39]; float* out; unsigned char* ws; };

DI void transpose_item(const float* W, int K, int N, bf16* WT, int rowbase, LAS float* scr, int k0, int n0, int lane, const float* kscale = nullptr) {
    const int nn = n0 + (lane & 31); const bool ok = nn < N;
#pragma unroll
    for (int i = 0; i < 32; ++i) { const int kk = 2 * i + (lane >> 5); scr[kk * 33 + (lane & 31)] = ok ? W[(size_t)(k0 + kk) * N + nn] * (kscale ? kscale[k0 + kk] : 1.0f) : 0.f; }
    LDS_WAIT(); asm volatile("" ::: "memory");
    const int c = lane & 7;
#pragma unroll
    for (int j = 0; j < 4; ++j) { const int n = (lane >> 3) + 8 * j; const LAS float* s = scr + (8 * c) * 33 + n;
        v4u o; o.x = pk2(s[0 * 33], s[1 * 33]); o.y = pk2(s[2 * 33], s[3 * 33]); o.z = pk2(s[4 * 33], s[5 * 33]); o.w = pk2(s[6 * 33], s[7 * 33]);
        *(v4u*)(WT + (size_t)(rowbase + n) * K + k0 + 8 * c) = o; }
    LDS_WAIT(); asm volatile("" ::: "memory");
}

struct TrItem { const float* src; unsigned char* dst; int K, N, k0, n0, rowbase; };
DI void tr_load(const TrItem& d, int lane, float (&v)[32]) {
#pragma unroll
    for (int i = 0; i < 32; ++i) { const int kk = 2 * i + (lane >> 5); v[i] = d.src[(size_t)(d.k0 + kk) * d.N + d.n0 + (lane & 31)]; }
}
DI unsigned pk4f8(float a, float b, float c, float d) { int w = __builtin_amdgcn_cvt_pk_fp8_f32(a, b, 0, false); w = __builtin_amdgcn_cvt_pk_fp8_f32(c, d, w, true); return (unsigned)w; }
constexpr float MOE_WSCALE = 32.0f;
DI void tr_store(const TrItem& d, int lane, const float (&v)[32], LAS float* scr) {
#pragma unroll
    for (int i = 0; i < 32; ++i) scr[(2 * i + (lane >> 5)) * 33 + (lane & 31)] = v[i] * MOE_WSCALE;
    LDS_WAIT(); asm volatile("" ::: "memory");
    const int c = lane & 3;
#pragma unroll
    for (int j = 0; j < 2; ++j) { const int n = (lane >> 2) + 16 * j; const LAS float* s = scr + (16 * c) * 33 + n;
        v4u o; o.x = pk4f8(s[0 * 33], s[1 * 33], s[2 * 33], s[3 * 33]); o.y = pk4f8(s[4 * 33], s[5 * 33], s[6 * 33], s[7 * 33]);
        o.z = pk4f8(s[8 * 33], s[9 * 33], s[10 * 33], s[11 * 33]); o.w = pk4f8(s[12 * 33], s[13 * 33], s[14 * 33], s[15 * 33]);
        *(v4u*)(d.dst + (size_t)(d.rowbase + n) * d.K + d.k0 + 16 * c) = o; }
    LDS_WAIT(); asm volatile("" ::: "memory");
}
DI void moe_gu_item(const Args& a, unsigned char* ws, int it, TrItem& d) {
    const int mtx = it / 1792, r = it % 1792, e = mtx >> 1, sel = mtx & 1, kb = r / 112, nb = r % 112, n0 = 32 * nb;
    d.src = (sel ? a.in[37] : a.in[36]) + (size_t)e * 1024 * FFE; d.dst = ws + WS_WMGU + (size_t)e * 2 * FFE * 1024; d.K = 1024; d.N = FFE; d.k0 = 64 * kb; d.n0 = n0;
    d.rowbase = (n0 / 128) * 256 + sel * 128 + (n0 % 128);
}
DI void moe_dn_item(const Args& a, unsigned char* ws, int it, TrItem& d) {
    const int e = it / 1792, r = it % 1792, kb = r / 32, nb = r % 32;
    d.src = a.in[38] + (size_t)e * 1024 * FFE; d.dst = ws + WS_WMD + (size_t)e * 1024 * FFE; d.K = FFE; d.N = 1024; d.k0 = 64 * kb; d.n0 = 32 * nb; d.rowbase = 32 * nb;
}
template <bool GU> DI void moe_copy_loop(const Args& a, unsigned char* ws, LAS float* scr, int first, int stride, int last, int lane) {
    first = __builtin_amdgcn_readfirstlane(first); stride = __builtin_amdgcn_readfirstlane(stride);
    if (first >= last) return;
    TrItem cur, nxt; float vc[32], vn[32];
    if (GU) moe_gu_item(a, ws, first, cur); else moe_dn_item(a, ws, first, cur);
    tr_load(cur, lane, vc);
    for (int it = first; it < last; it += stride) {
        const int itn = it + stride; const bool more = itn < last;
        if (more) { if (GU) moe_gu_item(a, ws, itn, nxt); else moe_dn_item(a, ws, itn, nxt); tr_load(nxt, lane, vn); }
        tr_store(cur, lane, vc, scr);
        if (more) { cur = nxt;
#pragma unroll
            for (int i = 0; i < 32; ++i) vc[i] = vn[i]; }
    }
}
DI bool transpose_job(int& r, const float* W, int K, int N, int Npad, bf16* WT, int row_off, int grp, int sel, LAS float* scr, int lane, const float* kscale = nullptr) {
    const int nblk = Npad / 32, cnt = (K / 64) * nblk;
    if (r >= cnt) { r -= cnt; return false; }
    const int kb = r / nblk, nb = r % nblk, n0 = 32 * nb;
    const int rowbase = row_off + (grp ? (n0 / grp) * (2 * grp) + sel * grp + (n0 % grp) : n0);
    transpose_item(W, K, N, WT, rowbase, scr, 64 * kb, n0, lane, kscale);
    return true;
}
#define XB_TMO      128
#define XB_XCNT(j)  (256  + 64 * (j))
#define XB_XSUB(j)  (1280 + 64 * (j))
#define XB_XGEN(j)  (2304 + 64 * (j))
#define XB_TOP      3328
#define XB_TOPGEN   3392
#define XCD_BAR_WORDS 3456
#define XB_SPIN_CAP (1u << 22)

__device__ __forceinline__ unsigned xb_ld(unsigned* p)              { return __hip_atomic_load(p, __ATOMIC_RELAXED, __HIP_MEMORY_SCOPE_AGENT); }
__device__ __forceinline__ unsigned xb_add(unsigned* p, unsigned v) { return __hip_atomic_fetch_add(p, v, __ATOMIC_RELAXED, __HIP_MEMORY_SCOPE_AGENT); }
__device__ __forceinline__ unsigned xb_xcc_id() { return (unsigned)__builtin_amdgcn_s_getreg((3 << 11) | 20) & 0xFu; }
#define XB_SPIN(cond, bar) do { unsigned _sp = 0; while (cond) { __builtin_amdgcn_s_sleep(1); \
    if ((++_sp & 255u) == 0u) { if (xb_ld(&(bar)[XB_TMO])) break; if (_sp > XB_SPIN_CAP) { atomicAdd(&(bar)[XB_TMO], 1u); break; } } } } while (0)

struct XcdBarrier {
    unsigned* bar; unsigned x;
    volatile LAS unsigned* st;
};

__device__ __forceinline__ XcdBarrier xcd_barrier_post(unsigned* bar, volatile LAS unsigned* st) {
    XcdBarrier b; b.bar = bar; b.x = xb_xcc_id(); b.st = st;
    if (threadIdx.x == 0) (void)xb_add(&bar[XB_XCNT(b.x)], 1u);
    return b;
}
__device__ __forceinline__ void xcd_barrier_complete(unsigned* bar, unsigned x, unsigned& nloc, unsigned& nx) {
    const unsigned G = gridDim.x * gridDim.y * gridDim.z;
    unsigned sum, cnt, mine, sp = 0u;
    for (;;) {
        sum = 0u; cnt = 0u; mine = 0u;
#pragma unroll
        for (unsigned j = 0; j < 16; ++j) { const unsigned c = xb_ld(&bar[XB_XCNT(j)]); sum += c; cnt += (c > 0u) ? 1u : 0u; mine = (j == x) ? c : mine; }
        if (sum == G) break;
        __builtin_amdgcn_s_sleep(1);
        if ((++sp & 255u) == 0u) { if (xb_ld(&bar[XB_TMO])) break; if (sp > XB_SPIN_CAP) { atomicAdd(&bar[XB_TMO], 1u); break; } }
    }
    nloc = mine > 0u ? mine : 1u; nx = cnt > 0u ? cnt : 1u;
}

__device__ __forceinline__ void xcd_barrier(const XcdBarrier& b, const bool wave0) {
    asm volatile("s_waitcnt vmcnt(0)" ::: "memory");
    __syncthreads();
    if (wave0 && __builtin_amdgcn_mbcnt_hi(~0u, __builtin_amdgcn_mbcnt_lo(~0u, 0u)) == 0u) {
        unsigned* bar = b.bar; asm volatile("" : "+s"(bar)); const unsigned bx_ = xb_xcc_id();
        __builtin_amdgcn_s_waitcnt(0);
        unsigned nloc = b.st[0], nx = b.st[1];
        if (nloc == 0u) { xcd_barrier_complete(bar, bx_, nloc, nx); b.st[0] = nloc; b.st[1] = nx; }
        const unsigned old = xb_add(&bar[XB_XSUB(bx_)], 1u);
        const unsigned gen = old / nloc;
        if (old + 1u == (gen + 1u) * nloc) {
            __builtin_amdgcn_fence(__ATOMIC_RELEASE, "agent");
            asm volatile("s_waitcnt vmcnt(0)" ::: "memory");
            const unsigned og = xb_add(&bar[XB_TOP], 1u);
            const unsigned tg = og / nx;
            if (og + 1u == (tg + 1u) * nx) xb_add(&bar[XB_TOPGEN], 1u);
            else XB_SPIN(xb_ld(&bar[XB_TOPGEN]) == tg, bar);
            __builtin_amdgcn_fence(__ATOMIC_ACQUIRE, "agent");
            xb_add(&bar[XB_XGEN(bx_)], 1u);
            asm volatile("s_waitcnt vmcnt(0)" ::: "memory");
        } else {
            XB_SPIN(xb_ld(&bar[XB_XGEN(bx_)]) == gen, bar);
            __builtin_amdgcn_fence(__ATOMIC_ACQUIRE, "agent");
            asm volatile("s_waitcnt vmcnt(0)" ::: "memory");
        }
    }
    __syncthreads();
}
DI float row_rstd(const f32x4 (&v)[4]) {
    float s = 0.f;
#pragma unroll
    for (int j = 0; j < 4; ++j) s += (v[j].x * v[j].x + v[j].y * v[j].y) + (v[j].z * v[j].z + v[j].w * v[j].w);
    return 1.0f / sqrtf(wave_sum(s) * (1.0f / D_) + 1e-6f);
}
DI void load_row(const float* x, int t, int lane, f32x4 (&v)[4]) {
    if (t >= 0 && t < S_) { const f32x4* p = (const f32x4*)(x + (size_t)t * D_) + lane;
#pragma unroll
        for (int j = 0; j < 4; ++j) v[j] = p[64 * j];
    } else {
#pragma unroll
        for (int j = 0; j < 4; ++j) v[j] = (f32x4){0.f, 0.f, 0.f, 0.f};
    }
}
DI void store_row_bf16(bf16* o, int lane, const f32x4 (&v)[4]) {
    unsigned long long* o8 = (unsigned long long*)o + lane;
#pragma unroll
    for (int j = 0; j < 4; ++j) o8[64 * j] = (unsigned long long)pk2(v[j].x, v[j].y) | ((unsigned long long)pk2(v[j].z, v[j].w) << 32);
}
DI void norm_rows(const float* x, const float* w, const float* mu  , bf16* H, bf16* HX, int gw, int NGW, int lane) {
    f32x4 wv[4];
#pragma unroll
    for (int j = 0; j < 4; ++j) wv[j] = ((const f32x4*)w)[lane + 64 * j];
    for (int t = gw; t < S_; t += NGW) {
        f32x4 v[4]; load_row(x, t, lane, v); const float rs = row_rstd(v);
#pragma unroll
        for (int j = 0; j < 4; ++j) v[j] = v[j] * rs * wv[j];
        store_row_bf16(H + (size_t)t * D_, lane, v);
        if (mu) {
            f32x4 p[4], n[4]; load_row(x, t - 1, lane, p); load_row(x, t + 1, lane, n);
            const float rp = row_rstd(p), rn = row_rstd(n);
#pragma unroll
            for (int j = 0; j < 4; ++j) { const f32x4 m0 = ((const f32x4*)mu)[lane + 64 * j], m1 = ((const f32x4*)(mu + D_))[lane + 64 * j];
                const f32x4 hp = p[j] * rp * wv[j], hn = n[j] * rn * wv[j]; p[j] = v[j] + m0 * (hp - v[j]) + m1 * (hn - v[j]); }
            store_row_bf16(HX + (size_t)t * D_, lane, p);
        }
    }
}

DI void prep0_token(const Args& a, unsigned char* ws, LAS float* scr, int t, int lane) {
    const bf16* P = (const bf16*)(ws + WS_PROJ0) + (size_t)t * EVEN_IN;
    const int c0 = 8 * lane;
    {
        float q[8], k[8]; ld8(P + c0, q); ld8(P + 512 + c0, k);
        float sq = 0.f, sk = 0.f;
#pragma unroll
        for (int i = 0; i < 8; ++i) { sq += q[i] * q[i]; sk += k[i] * k[i]; }
        sq = grp_sum<8>(sq); sk = grp_sum<8>(sk);
        const float rq = 1.0f / sqrtf(sq * (1.0f / 64.f) + 1e-6f), rk = 1.0f / sqrtf(sk * (1.0f / 64.f) + 1e-6f);
        const int d0 = 8 * (lane & 7);
        float qw[8], kw[8]; ld8f(a.in[4] + d0, qw); ld8f(a.in[5] + d0, kw);
#pragma unroll
        for (int i = 0; i < 8; ++i) { q[i] = q[i] * rq * qw[i]; k[i] = k[i] * rk * kw[i]; }
        const float pos = (float)((const int*)a.in[1])[t];
        float qo[8], ko[8];
#pragma unroll
        for (int i = 0; i < 8; ++i) { qo[i] = __shfl_xor(q[i], 1); ko[i] = __shfl_xor(k[i], 1); }
        const int sub = lane & 7;
        if (sub < 2) {
#pragma unroll
            for (int i = 0; i < 8; ++i) {
                constexpr float kInv[8] = {1.0f, 0.1939227432012558f, 0.03760603070259094f, 0.007292664609849453f, 0.0014142135623842478f, 0.00027424818836152554f, 5.3182957344688475e-05f, 1.0313385246263351e-05f};
                const float ang = pos * kInv[i]; const float kq = rintf(ang * 0.15915494309189535f);
                float rr = fmaf(-kq, 6.28318548202514648f, ang); rr = fmaf(-kq, -1.74845553146951715e-07f, rr);
                const float sn = __sinf(rr), cs = __cosf(rr);
                if (sub == 0) { q[i] = q[i] * cs - qo[i] * sn; k[i] = k[i] * cs - ko[i] * sn; }
                else          { q[i] = q[i] * cs + qo[i] * sn; k[i] = k[i] * cs + ko[i] * sn; }
            }
        }
#pragma unroll
        for (int i = 0; i < 8; ++i) q[i] *= 0.125f;
        st8((bf16*)(ws + WS_QN) + (size_t)t * 512 + c0, q); st8((bf16*)(ws + WS_KN) + (size_t)t * 512 + c0, k);
        *(v4u*)((bf16*)(ws + WS_Y1) + (size_t)t * 512 + c0) = *(const v4u*)(P + 1024 + c0);
    }
}

DI void rwkv_scan_naive(unsigned char* ws, int w  , int lane) {
    const int z = w >> 9, h = (w >> 6) & 7, vr = w & 63;
    const float* LW = (const float*)(ws + (z ? WS_LW1 : WS_LW0));
    const bf16* KD = (const bf16*)(ws + (z ? WS_KD1 : WS_KD0)); const bf16* BB = (const bf16*)(ws + (z ? WS_B1 : WS_B0));
    const bf16* KK = (const bf16*)(ws + WS_KK); const bf16* R = (const bf16*)(ws + WS_R); const bf16* V = (const bf16*)(ws + WS_V);
    bf16* Y = (bf16*)(ws + (z ? WS_Y1 : WS_Y0));
    const int cc = h * 64 + lane, cv = h * 64 + vr;
    float S = 0.f;
    int t = z ? S_ - 1 : 0; const int dt = z ? -1 : 1;
    size_t o = (size_t)t * 512;
    float lw = LW[o + cc], kd = bf2f(KD[o + cc]), bb = bf2f(BB[o + cc]), kk = bf2f(KK[o + cc]), rr = bf2f(R[o + cc]), vv = bf2f(V[o + cv]);
    for (int s = 0; s < S_; ++s) {
        const int tn = t + dt; const bool more = s + 1 < S_;
        const size_t on = (size_t)(more ? tn : t) * 512;
        const float lw_n = LW[on + cc], kd_n = bf2f(KD[on + cc]), bb_n = bf2f(BB[on + cc]), kk_n = bf2f(KK[on + cc]), rr_n = bf2f(R[on + cc]), vv_n = bf2f(V[on + cv]);
        const float sa = wave_sum(S * (-kk));
        S = S * __expf(lw) + sa * bb + vv * kd;
        const float y = wave_sum(S * rr);
        if (lane == 0) Y[(size_t)t * 512 + cv] = (bf16)f2bf(y);
        lw = lw_n; kd = kd_n; bb = bb_n; kk = kk_n; rr = rr_n; vv = vv_n; t = tn;
    }
}

DI void attn_token_naive(unsigned char* ws, int t, int lane) {
    const bf16* QN = (const bf16*)(ws + WS_QN); const bf16* KN = (const bf16*)(ws + WS_KN); const bf16* P = (const bf16*)(ws + WS_PROJ0);
    const int c0 = 8 * lane;
    float q[8]; ld8(QN + (size_t)t * 512 + c0, q);
    float m = -1e30f, l = 0.f, acc[8];
#pragma unroll
    for (int i = 0; i < 8; ++i) acc[i] = 0.f;
    for (int br = 0; br < 3; ++br) {
        const int d = br == 0 ? 1 : (br == 1 ? 4 : 16);
        for (int mm = -64; mm <= 64; ++mm) {
            const int j = t + d * mm; if (j < 0 || j >= S_) continue;
            float k[8], v[8]; ld8(KN + (size_t)j * 512 + c0, k); ld8(P + (size_t)j * EVEN_IN + 1024 + c0, v);
            float s = 0.f;
#pragma unroll
            for (int i = 0; i < 8; ++i) s += q[i] * k[i];
            s = grp_sum<8>(s);
            const float mn = fmaxf(m, s), sc = __expf(m - mn), p = __expf(s - mn);
            l = l * sc + p;
#pragma unroll
            for (int i = 0; i < 8; ++i) acc[i] = acc[i] * sc + p * v[i];
            m = mn;
        }
    }
    const float il = 1.0f / l;
#pragma unroll
    for (int i = 0; i < 8; ++i) acc[i] *= il;
    st8((bf16*)(ws + WS_Y) + (size_t)t * D_ + c0, acc);
}

DI void rwkv_post_token(const Args& a, unsigned char* ws, int t, int lane) {
    const int c0 = 8 * lane; const size_t o = (size_t)t * 512 + c0;
    float y0[8], y1[8], g[8], bn[8], lw[8], lb[8];
    ld8((const bf16*)(ws + WS_Y0) + o, y0); ld8((const bf16*)(ws + WS_Y1) + o, y1); ld8((const bf16*)(ws + WS_GATE) + o, g); ld8((const bf16*)(ws + WS_BONUS) + o, bn);
    ld8f(a.in[19] + c0, lw); ld8f(a.in[20] + c0, lb);
    float s = 0.f;
#pragma unroll
    for (int i = 0; i < 8; ++i) { y0[i] += y1[i]; s += y0[i]; }
    const float mu = grp_sum<8>(s) * (1.0f / 64.f);
    float q = 0.f;
#pragma unroll
    for (int i = 0; i < 8; ++i) { y0[i] -= mu; q += y0[i] * y0[i]; }
    const float rs = 1.0f / sqrtf(grp_sum<8>(q) * (1.0f / 64.f) + 64e-5f);
#pragma unroll
    for (int i = 0; i < 8; ++i) y0[i] = (y0[i] * rs * lw[i] + lb[i] + bn[i]) * g[i];
    st8((bf16*)(ws + WS_Y) + (size_t)t * D_ + 512 + c0, y0);
}
typedef short s16x8 __attribute__((ext_vector_type(8)));
typedef short s16x4 __attribute__((ext_vector_type(4)));
typedef LAS unsigned char* ldsp;
DI f32x4 mfma16(s16x8 a, s16x8 b, f32x4 c) { return __builtin_amdgcn_mfma_f32_16x16x32_bf16(a, b, c, 0, 0, 0); }
DI s16x8 frag_row(ldsp img, int row0, int col0, int lane) { return *(LAS const s16x8*)(img + (row0 + (lane & 15)) * 128 + (col0 + 8 * (lane >> 4)) * 2); }
DI s16x4 tr16(ldsp p) { return __builtin_bit_cast(s16x4, __builtin_amdgcn_ds_read_tr16_b64_v4i16((LAS s16x4*)p)); }
DI s16x8 frag_tr(ldsp img, int row0, int col0, int lane) {
    ldsp a0 = img + (row0 + 8 * (lane >> 4) + ((lane & 15) >> 2)) * 128 + col0 * 2 + 8 * (lane & 3);
    const s16x4 lo = tr16(a0), hi = tr16(a0 + 4 * 128);
    return __builtin_shufflevector(lo, hi, 0, 1, 2, 3, 4, 5, 6, 7);
}
DI void ctile_to_img(ldsp img, int mt, int nt, const f32x4& c, int lane) {
    LAS bf16* p = (LAS bf16*)(img + (16 * mt + 4 * (lane >> 4)) * 128 + (16 * nt + (lane & 15)) * 2);
#pragma unroll
    for (int e = 0; e < 4; ++e) p[e * 64] = (bf16)f2bf(c[e]);
}
#define CFENCE() asm volatile("" ::: "memory")
#define MM_LOOPH(ACC, AEXPR, BEXPR) _Pragma("unroll") for (int mt = 2 * mh; mt < 2 * mh + 2; ++mt) _Pragma("unroll") for (int nt = 0; nt < 4; ++nt) _Pragma("unroll") for (int ks = 0; ks < 2; ++ks) ACC[mt][nt] = mfma16((AEXPR), (BEXPR), ACC[mt][nt])
#define MM_LOOP(ACC, AEXPR, BEXPR) _Pragma("unroll") for (int mt = 0; mt < 4; ++mt) _Pragma("unroll") for (int nt = 0; nt < 4; ++nt) _Pragma("unroll") for (int ks = 0; ks < 2; ++ks) ACC[mt][nt] = mfma16((AEXPR), (BEXPR), ACC[mt][nt])

DI int tok_of(int z, int cn, int i) { return z ? cn * 64 + 63 - i : cn * 64 + i; }

struct P1NoWork { DI void operator()() const {} };
template <int ROLE> DI void p1_sync(volatile LAS unsigned* fl, unsigned& ep, int lane) {
    LDS_WAIT(); CFENCE();
    if constexpr (ROLE != 0) {
        ++ep; if (lane == 0) fl[ROLE - 1] = ep;
        while (__builtin_amdgcn_readfirstlane((int)fl[2 - ROLE]) < (int)ep) __builtin_amdgcn_s_sleep(1);
        CFENCE();
    }
}
template <bool DRY = false, int STOP = 99, int ROLE = 0, class PRE = P1NoWork, class MID = P1NoWork> DI void rwkv_pass1_item(unsigned char* ws, ldsp lds, int item, int lane, volatile LAS unsigned* fl = nullptr, unsigned* epp = nullptr, LAS float* gts = nullptr, const PRE& pre = PRE(), const MID& mid = MID()) {
    constexpr int MH0 = ROLE == 2 ? 1 : 0, MH1 = ROLE == 1 ? 1 : 2;
    unsigned ep_ = 0; unsigned& ep = epp ? *epp : ep_;
#define P1_SYNC() p1_sync<ROLE>(fl, ep, lane)
    asm volatile("" : "+v"(lane));
    const int z = item >> 11, h = (item >> 8) & 7, c = item & 255;
    const int cn = z ? 255 - c : c;
    float* LW = (float*)(ws + (z ? WS_LW1 : WS_LW0));
    bf16* KD = (bf16*)(ws + (z ? WS_KD1 : WS_KD0)); bf16* BB = (bf16*)(ws + (z ? WS_B1 : WS_B0));
    const bf16* KK = (const bf16*)(ws + WS_KK); const bf16* R = (const bf16*)(ws + WS_R); const bf16* V = (const bf16*)(ws + WS_V);
    float* LWo = DRY ? (float*)(ws + WS_Y) : LW; bf16* KDo = DRY ? (bf16*)(ws + WS_Y) : KD; bf16* BBo = DRY ? (bf16*)(ws + WS_Y) : BB;
    ldsp S0 = lds, S1 = lds + 8192, S2 = lds + 16384, S3 = lds + 24576, S4 = lds + 32768, S5 = lds + 40960, S6 = lds + 49152, S7 = lds + 57344;
    ldsp IA = S0, IB = S1, IK = S2, IR = S3;
    const int ch = h * 64 + lane;
    float G = 0.f;
    if constexpr (ROLE == 2) pre();
    else {
#pragma unroll 16
    for (int i = 0; i < 64; ++i) {
        const size_t o = (size_t)tok_of(z, cn, i) * 512 + ch;
        const float lw = LW[o], a = -bf2f(KK[o]), b = bf2f(BB[o]), kd = bf2f(KD[o]), r = bf2f(R[o]);
        const float eprev = __expf(G); G += lw; const float ecur = __expf(G), einv = __expf(-G);
        ((LAS bf16*)IA)[i * 64 + lane] = (bf16)f2bf(a * eprev); ((LAS bf16*)IB)[i * 64 + lane] = (bf16)f2bf(b * einv);
        ((LAS bf16*)IK)[i * 64 + lane] = (bf16)f2bf(kd * einv); ((LAS bf16*)IR)[i * 64 + lane] = (bf16)f2bf(r * ecur);
    }
    }
    float GT = __expf(G);
    if constexpr (ROLE == 1) gts[lane] = GT;
    P1_SYNC();
    if constexpr (ROLE == 2) GT = gts[lane];
    if (STOP == 1) { if (GT == 123.f) LWo[0] = GT; return; }
    int lane2 = lane; asm volatile("" : "+v"(lane2));
    const int n_ = lane2 & 15, q_ = lane2 >> 4;
    {
#pragma unroll
        for (int mh = MH0; mh < MH1; ++mh) {
        f32x4 acc[4][4];
#pragma unroll
        for (int mt = 2 * mh; mt < 2 * mh + 2; ++mt)
#pragma unroll
            for (int nt = 0; nt < 4; ++nt) acc[mt][nt] = (f32x4){0.f, 0.f, 0.f, 0.f};
        MM_LOOPH(acc, frag_row(IA, 16 * mt, 32 * ks, lane), frag_row(IB, 16 * nt, 32 * ks, lane));
#pragma unroll
        for (int mt = 2 * mh; mt < 2 * mh + 2; ++mt)
#pragma unroll
            for (int nt = 0; nt < 4; ++nt)
#pragma unroll
                for (int e = 0; e < 4; ++e) { const int i = 16 * mt + 4 * q_ + e, j = 16 * nt + n_; ((LAS float*)S4)[i * 64 + j] = (j < i) ? acc[mt][nt][e] : 0.f; }
        }
    }
    P1_SYNC();
    if (STOP == 4) return;
    if constexpr (ROLE != 2) {
        float t[64];
        int lane_o = lane; asm volatile("" : "+v"(lane_o));
        f32x4 ar[2][16];
#pragma unroll
        for (int i = 0; i < 64; ++i) {
            if (i + 1 < 64) {
#pragma unroll
                for (int jg = 0; jg < (i + 1 + 3) / 4; ++jg) ar[(i + 1) & 1][jg] = *(LAS const f32x4*)(S4 + ((i + 1) * 64 + 4 * jg) * 4);
            }
            __builtin_amdgcn_sched_barrier(0);
            float acc0 = (lane_o == i) ? 1.f : 0.f, acc1 = 0.f, acc2 = 0.f, acc3 = 0.f;
#pragma unroll
            for (int jg = 0; jg < (i + 3) / 4; ++jg) { const f32x4 a4 = ar[i & 1][jg];
                if (4 * jg + 0 < i) acc0 += a4[0] * t[4 * jg + 0];
                if (4 * jg + 1 < i) acc1 += a4[1] * t[4 * jg + 1];
                if (4 * jg + 2 < i) acc2 += a4[2] * t[4 * jg + 2];
                if (4 * jg + 3 < i) acc3 += a4[3] * t[4 * jg + 3]; }
            t[i] = (acc0 + acc1) + (acc2 + acc3);
            __builtin_amdgcn_sched_barrier(0);
        }
        LDS_WAIT(); CFENCE();
#pragma unroll
        for (int i = 0; i < 64; ++i) ((LAS bf16*)S4)[i * 64 + lane] = (bf16)f2bf(t[i]);
    }
    if constexpr (ROLE == 0) { LDS_WAIT(); CFENCE(); }
    if (STOP == 2) return;
    ldsp IT = S4, IW = S5, IAK = S6;
    if constexpr (ROLE != 1) {
#pragma unroll
        for (int mh = 0; mh < 2; ++mh) {
        f32x4 acc[4][4];
#pragma unroll
        for (int mt = 2 * mh; mt < 2 * mh + 2; ++mt)
#pragma unroll
            for (int nt = 0; nt < 4; ++nt) acc[mt][nt] = (f32x4){0.f, 0.f, 0.f, 0.f};
        MM_LOOPH(acc, frag_row(IA, 16 * mt, 32 * ks, lane), frag_row(IK, 16 * nt, 32 * ks, lane));
#pragma unroll
        for (int mt = 2 * mh; mt < 2 * mh + 2; ++mt)
#pragma unroll
            for (int nt = 0; nt < 4; ++nt) {
#pragma unroll
                for (int e = 0; e < 4; ++e) { const int i = 16 * mt + 4 * q_ + e, j = 16 * nt + n_; if (!(j < i)) acc[mt][nt][e] = 0.f; }
                ctile_to_img(IAK, mt, nt, acc[mt][nt], lane); }
        }
    }
    if constexpr (ROLE == 2) mid();
    if constexpr (ROLE != 0) P1_SYNC();
    if (STOP == 5) return;
    {
#pragma unroll
        for (int mh = MH0; mh < MH1; ++mh) {
        f32x4 acc[4][4];
#pragma unroll
        for (int mt = 2 * mh; mt < 2 * mh + 2; ++mt)
#pragma unroll
            for (int nt = 0; nt < 4; ++nt) acc[mt][nt] = (f32x4){0.f, 0.f, 0.f, 0.f};
        MM_LOOPH(acc, frag_row(IT, 16 * mt, 32 * ks, lane), frag_tr(IA, 32 * ks, 16 * nt, lane));
#pragma unroll
        for (int mt = 2 * mh; mt < 2 * mh + 2; ++mt)
#pragma unroll
            for (int nt = 0; nt < 4; ++nt) ctile_to_img(IW, mt, nt, acc[mt][nt], lane);
        }
    }
    P1_SYNC();
    if (STOP == 6) return;
    ldsp IV = S0;
    {
        v4u vr[8];
#pragma unroll
        for (int it = 4 * MH0; it < 4 * MH1; ++it) vr[it] = *(const v4u*)(V + (size_t)tok_of(z, cn, (lane >> 3) + 8 * it) * 512 + h * 64 + (lane & 7) * 8);
#pragma unroll
        for (int it = 4 * MH0; it < 4 * MH1; ++it) *(LAS v4u*)(IV + ((lane >> 3) + 8 * it) * 128 + (lane & 7) * 16) = vr[it];
    }
    P1_SYNC();
    ldsp IAV = S7;
    {
#pragma unroll
        for (int mh = MH0; mh < MH1; ++mh) {
        f32x4 acc[4][4];
#pragma unroll
        for (int mt = 2 * mh; mt < 2 * mh + 2; ++mt)
#pragma unroll
            for (int nt = 0; nt < 4; ++nt) acc[mt][nt] = (f32x4){0.f, 0.f, 0.f, 0.f};
        MM_LOOPH(acc, frag_row(IAK, 16 * mt, 32 * ks, lane), frag_tr(IV, 32 * ks, 16 * nt, lane));
#pragma unroll
        for (int mt = 2 * mh; mt < 2 * mh + 2; ++mt)
#pragma unroll
            for (int nt = 0; nt < 4; ++nt) ctile_to_img(IAV, mt, nt, acc[mt][nt], lane);
        }
    }
    P1_SYNC();
    if (STOP == 7) return;
    ldsp IU = S6;
    {
#pragma unroll
        for (int mh = MH0; mh < MH1; ++mh) {
        f32x4 acc[4][4];
#pragma unroll
        for (int mt = 2 * mh; mt < 2 * mh + 2; ++mt)
#pragma unroll
            for (int nt = 0; nt < 4; ++nt) acc[mt][nt] = (f32x4){0.f, 0.f, 0.f, 0.f};
        MM_LOOPH(acc, frag_row(IT, 16 * mt, 32 * ks, lane), frag_tr(IAV, 32 * ks, 16 * nt, lane));
        LDS_WAIT(); CFENCE();
#pragma unroll
        for (int mt = 2 * mh; mt < 2 * mh + 2; ++mt)
#pragma unroll
            for (int nt = 0; nt < 4; ++nt) ctile_to_img(IU, mt, nt, acc[mt][nt], lane);
        }
    }
    P1_SYNC();
    if (STOP == 3) return;
    ldsp IRB = S4, IRK = S7;
    {
#pragma unroll
        for (int mh = MH0; mh < MH1; ++mh) {
        f32x4 acc[4][4];
#pragma unroll
        for (int mt = 2 * mh; mt < 2 * mh + 2; ++mt)
#pragma unroll
            for (int nt = 0; nt < 4; ++nt) acc[mt][nt] = (f32x4){0.f, 0.f, 0.f, 0.f};
        MM_LOOPH(acc, frag_row(IR, 16 * mt, 32 * ks, lane), frag_row(IB, 16 * nt, 32 * ks, lane));
#pragma unroll
        for (int mt = 2 * mh; mt < 2 * mh + 2; ++mt)
#pragma unroll
            for (int nt = 0; nt < 4; ++nt) {
#pragma unroll
                for (int e = 0; e < 4; ++e) { const int i = 16 * mt + 4 * q_ + e, j = 16 * nt + n_; if (!(j <= i)) acc[mt][nt][e] = 0.f; }
                ctile_to_img(IRB, mt, nt, acc[mt][nt], lane); }
        }
    }
    {
#pragma unroll
        for (int mh = MH0; mh < MH1; ++mh) {
        f32x4 acc[4][4];
#pragma unroll
        for (int mt = 2 * mh; mt < 2 * mh + 2; ++mt)
#pragma unroll
            for (int nt = 0; nt < 4; ++nt) acc[mt][nt] = (f32x4){0.f, 0.f, 0.f, 0.f};
        MM_LOOPH(acc, frag_row(IR, 16 * mt, 32 * ks, lane), frag_row(IK, 16 * nt, 32 * ks, lane));
#pragma unroll
        for (int mt = 2 * mh; mt < 2 * mh + 2; ++mt)
#pragma unroll
            for (int nt = 0; nt < 4; ++nt) {
#pragma unroll
                for (int e = 0; e < 4; ++e) { const int i = 16 * mt + 4 * q_ + e, j = 16 * nt + n_; if (!(j <= i)) acc[mt][nt][e] = 0.f; }
                ctile_to_img(IRK, mt, nt, acc[mt][nt], lane); }
        }
    }
    P1_SYNC();
    int lane3 = lane; asm volatile("" : "+v"(lane3));
    const int n3 = lane3 & 15, q3 = lane3 >> 4;
    const size_t slot0 = (size_t)cn * 64 * 512 + h * 64;
    {
#pragma unroll
        for (int mh = MH0; mh < MH1; ++mh) {
        f32x4 acc[4][4];
#pragma unroll
        for (int mt = 2 * mh; mt < 2 * mh + 2; ++mt)
#pragma unroll
            for (int nt = 0; nt < 4; ++nt) { const s16x4 r4 = *(LAS const s16x4*)(IR + (16 * nt + n3) * 128 + (16 * mt + 4 * q3) * 2);
#pragma unroll
                for (int e = 0; e < 4; ++e) acc[mt][nt][e] = bf2f((bf16)r4[e]); }
        MM_LOOPH(acc, frag_tr(IW, 32 * ks, 16 * mt, lane), frag_row(IRB, 16 * nt, 32 * ks, lane));
#pragma unroll
        for (int mt = 2 * mh; mt < 2 * mh + 2; ++mt)
#pragma unroll
            for (int nt = 0; nt < 4; ++nt) { bf16* dst = (bf16*)(LWo + slot0 + (size_t)(16 * nt + n3) * 512) + 16 * mt + 4 * q3;
                *(unsigned long long*)dst = (unsigned long long)pk2(acc[mt][nt][0], acc[mt][nt][1]) | ((unsigned long long)pk2(acc[mt][nt][2], acc[mt][nt][3]) << 32); }
        }
    }
    {
#pragma unroll
        for (int mh = MH0; mh < MH1; ++mh) {
        f32x4 acc[4][4];
#pragma unroll
        for (int mt = 2 * mh; mt < 2 * mh + 2; ++mt)
#pragma unroll
            for (int nt = 0; nt < 4; ++nt) acc[mt][nt] = (f32x4){0.f, 0.f, 0.f, 0.f};
        MM_LOOPH(acc, frag_tr(IU, 32 * ks, 16 * mt, lane), frag_row(IRB, 16 * nt, 32 * ks, lane));
        MM_LOOPH(acc, frag_tr(IV, 32 * ks, 16 * mt, lane), frag_row(IRK, 16 * nt, 32 * ks, lane));
#pragma unroll
        for (int mt = 2 * mh; mt < 2 * mh + 2; ++mt)
#pragma unroll
            for (int nt = 0; nt < 4; ++nt) { bf16* dst = (bf16*)(LWo + slot0 + (size_t)(16 * nt + n3) * 512) + 64 + 16 * mt + 4 * q3;
                *(unsigned long long*)dst = (unsigned long long)pk2(acc[mt][nt][0], acc[mt][nt][1]) | ((unsigned long long)pk2(acc[mt][nt][2], acc[mt][nt][3]) << 32); }
        }
    }
    {
#pragma unroll
        for (int mh = MH0; mh < MH1; ++mh) {
        f32x4 acc[4][4];
#pragma unroll
        for (int mt = 2 * mh; mt < 2 * mh + 2; ++mt)
#pragma unroll
            for (int nt = 0; nt < 4; ++nt) acc[mt][nt] = (f32x4){0.f, 0.f, 0.f, 0.f};
        MM_LOOPH(acc, frag_tr(IW, 32 * ks, 16 * mt, lane), frag_tr(IB, 32 * ks, 16 * nt, lane));
#pragma unroll
        for (int nt = 0; nt < 4; ++nt) { const float gk = __shfl(GT, 16 * nt + n3);
#pragma unroll
            for (int mt = 2 * mh; mt < 2 * mh + 2; ++mt) { float o[4];
#pragma unroll
                for (int e = 0; e < 4; ++e) o[e] = gk * (acc[mt][nt][e] + ((16 * mt + 4 * q3 + e) == (16 * nt + n3) ? 1.f : 0.f));
                bf16* dst = KDo + slot0 + (size_t)(16 * nt + n3) * 512 + 16 * mt + 4 * q3;
                *(unsigned long long*)dst = (unsigned long long)pk2(o[0], o[1]) | ((unsigned long long)pk2(o[2], o[3]) << 32); } }
        }
    }
    {
#pragma unroll
        for (int mh = MH0; mh < MH1; ++mh) {
        f32x4 acc[4][4];
#pragma unroll
        for (int mt = 2 * mh; mt < 2 * mh + 2; ++mt)
#pragma unroll
            for (int nt = 0; nt < 4; ++nt) acc[mt][nt] = (f32x4){0.f, 0.f, 0.f, 0.f};
        MM_LOOPH(acc, frag_tr(IB, 32 * ks, 16 * mt, lane), frag_tr(IU, 32 * ks, 16 * nt, lane));
        MM_LOOPH(acc, frag_tr(IK, 32 * ks, 16 * mt, lane), frag_tr(IV, 32 * ks, 16 * nt, lane));
#pragma unroll
        for (int mt = 2 * mh; mt < 2 * mh + 2; ++mt) { float gk[4];
#pragma unroll
            for (int e = 0; e < 4; ++e) gk[e] = __shfl(GT, 16 * mt + 4 * q3 + e);
#pragma unroll
            for (int nt = 0; nt < 4; ++nt) { bf16* dst = BBo + slot0 + (size_t)(16 * nt + n3) * 512 + 16 * mt + 4 * q3;
                *(unsigned long long*)dst = (unsigned long long)pk2(gk[0] * acc[mt][nt][0], gk[1] * acc[mt][nt][1]) | ((unsigned long long)pk2(gk[2] * acc[mt][nt][2], gk[3] * acc[mt][nt][3]) << 32); } }
        }
    }
    LDS_WAIT(); CFENCE();
#undef P1_SYNC
}
DI unsigned long long pk4(const f32x4& v) { return (unsigned long long)pk2(v[0], v[1]) | ((unsigned long long)pk2(v[2], v[3]) << 32); }
DI f32x4 unpk4(unsigned long long w) { return (f32x4){bflo((unsigned)w), bfhi((unsigned)w), bflo((unsigned)(w >> 32)), bfhi((unsigned)(w >> 32))}; }
DI s16x8 pack_cpair(const f32x4& lo, const f32x4& hi) {
    v4u p; p.x = pk2(lo[0], lo[1]); p.y = pk2(lo[2], lo[3]); p.z = pk2(hi[0], hi[1]); p.w = pk2(hi[2], hi[3]);
    return __builtin_bit_cast(s16x8, p);
}
DI void rwkv_pass2_wave(unsigned char* ws, int w  , int lane) {
    const int z = w >> 5, h = (w >> 2) & 7, vs = w & 3;
    const bf16* Mm = (const bf16*)(ws + (z ? WS_KD1 : WS_KD0)); const bf16* Nn = (const bf16*)(ws + (z ? WS_B1 : WS_B0));
    bf16* Hst = (bf16*)(ws + (z ? WS_V : WS_R));
    const int n_ = lane & 15, q_ = lane >> 4;
    f32x4 H[4];
#pragma unroll
    for (int kt = 0; kt < 4; ++kt) H[kt] = (f32x4){0.f, 0.f, 0.f, 0.f};
    unsigned long long ma[4][2][2], nn[4];
    {
        const int cn = z ? 255 : 0; const size_t slot0 = (size_t)cn * 64 * 512 + h * 64;
#pragma unroll
        for (int kt = 0; kt < 4; ++kt) {
#pragma unroll
            for (int ks = 0; ks < 2; ++ks) { const bf16* row = Mm + slot0 + (size_t)(16 * kt + n_) * 512 + 32 * ks + 4 * q_;
                ma[kt][ks][0] = *(const unsigned long long*)row; ma[kt][ks][1] = *(const unsigned long long*)(row + 16); }
            nn[kt] = *(const unsigned long long*)(Nn + slot0 + (size_t)(16 * vs + n_) * 512 + 16 * kt + 4 * q_); }
    }
    for (int c = 0; c < 256; ++c) {
        { bf16* dst = Hst + ((size_t)(c * 8 + h) * 64 + 16 * vs + n_) * 64 + 4 * q_;
#pragma unroll
          for (int kt = 0; kt < 4; ++kt) *(unsigned long long*)(dst + 16 * kt) = (unsigned long long)pk2(H[kt][0], H[kt][1]) | ((unsigned long long)pk2(H[kt][2], H[kt][3]) << 32); }
        unsigned long long ma2[4][2][2], nn2[4];
        { const int c2 = c + 1 < 256 ? c + 1 : c; const int cn = z ? 255 - c2 : c2; const size_t slot0 = (size_t)cn * 64 * 512 + h * 64;
#pragma unroll
          for (int kt = 0; kt < 4; ++kt) {
#pragma unroll
            for (int ks = 0; ks < 2; ++ks) { const bf16* row = Mm + slot0 + (size_t)(16 * kt + n_) * 512 + 32 * ks + 4 * q_;
                ma2[kt][ks][0] = *(const unsigned long long*)row; ma2[kt][ks][1] = *(const unsigned long long*)(row + 16); }
            nn2[kt] = *(const unsigned long long*)(Nn + slot0 + (size_t)(16 * vs + n_) * 512 + 16 * kt + 4 * q_); } }
        const s16x8 b0 = pack_cpair(H[0], H[1]), b1 = pack_cpair(H[2], H[3]);
#pragma unroll
        for (int kt = 0; kt < 4; ++kt) {
            f32x4 acc = (f32x4){bflo((unsigned)nn[kt]), bfhi((unsigned)nn[kt]), bflo((unsigned)(nn[kt] >> 32)), bfhi((unsigned)(nn[kt] >> 32))};
            { v4u a; a.x = (unsigned)ma[kt][0][0]; a.y = (unsigned)(ma[kt][0][0] >> 32); a.z = (unsigned)ma[kt][0][1]; a.w = (unsigned)(ma[kt][0][1] >> 32); acc = mfma16(__builtin_bit_cast(s16x8, a), b0, acc); }
            { v4u a; a.x = (unsigned)ma[kt][1][0]; a.y = (unsigned)(ma[kt][1][0] >> 32); a.z = (unsigned)ma[kt][1][1]; a.w = (unsigned)(ma[kt][1][1] >> 32); acc = mfma16(__builtin_bit_cast(s16x8, a), b1, acc); }
            H[kt] = acc;
        }
#pragma unroll
        for (int kt = 0; kt < 4; ++kt) { nn[kt] = nn2[kt];
#pragma unroll
            for (int ks = 0; ks < 2; ++ks) { ma[kt][ks][0] = ma2[kt][ks][0]; ma[kt][ks][1] = ma2[kt][ks][1]; } }
    }
}
DI void rwkv_pass3_item(unsigned char* ws, int item, int lane) {
    const int z = item >> 11, h = (item >> 8) & 7, c = item & 255;
    const int cn = z ? 255 - c : c;
    const float* LW = (const float*)(ws + (z ? WS_LW1 : WS_LW0));
    const bf16* Hst = (const bf16*)(ws + (z ? WS_V : WS_R)) + (size_t)(c * 8 + h) * 64 * 64;
    bf16* Y = (bf16*)(ws + (z ? WS_Y1 : WS_Y0));
    const int n_ = lane & 15, q_ = lane >> 4;
    const size_t slot0 = (size_t)cn * 64 * 512 + h * 64;
    s16x8 hA[4][2], qB[4][2];
#pragma unroll
    for (int t = 0; t < 4; ++t)
#pragma unroll
        for (int ks = 0; ks < 2; ++ks) {
            hA[t][ks] = *(const s16x8*)(Hst + (size_t)(16 * t + n_) * 64 + 32 * ks + 8 * q_);
            qB[t][ks] = *(const s16x8*)((const bf16*)(LW + slot0 + (size_t)(16 * t + n_) * 512) + 32 * ks + 8 * q_); }
#pragma unroll
    for (int nt = 0; nt < 4; ++nt) {
        const int i = 16 * nt + n_; const bf16* ycrow = (const bf16*)(LW + slot0 + (size_t)i * 512) + 64;
        bf16* yrow = Y + (size_t)tok_of(z, cn, i) * 512 + h * 64;
#pragma unroll
        for (int mt = 0; mt < 4; ++mt) {
            const unsigned long long y4 = *(const unsigned long long*)(ycrow + 16 * mt + 4 * q_);
            f32x4 acc = (f32x4){bflo((unsigned)y4), bfhi((unsigned)y4), bflo((unsigned)(y4 >> 32)), bfhi((unsigned)(y4 >> 32))};
            acc = mfma16(hA[mt][0], qB[nt][0], acc); acc = mfma16(hA[mt][1], qB[nt][1], acc);
            *(unsigned long long*)(yrow + 16 * mt + 4 * q_) = (unsigned long long)pk2(acc[0], acc[1]) | ((unsigned long long)pk2(acc[2], acc[3]) << 32);
        }
    }
}
DI void rwkv_pass2_block(unsigned char* ws, ldsp L, int b  , int wave, int lane) {
    const int z = b >> 3, h = b & 7;
    if (wave >= 4) {
        const int lw = wave - 4;
        const char* Mm = (const char*)(ws + (z ? WS_KD1 : WS_KD0)); const char* Nn = (const char*)(ws + (z ? WS_B1 : WS_B0));
#define RW_ISSUE(cc) do { const int c_ = (cc); if (c_ < 256) { const int cn_ = z ? 255 - c_ : c_; const size_t slot0 = ((size_t)cn_ * 64 * 512 + h * 64) * 2; ldsp slot = L + (c_ & 7) * 16384; \
            _Pragma("unroll") for (int k = 0; k < 4; ++k) { const int pid = lw * 4 + k; const int pr = pid & 7; const int row = 8 * pr + (lane >> 3), p = lane & 7, cch = p ^ (row & 7); \
                const char* src = (pid < 8 ? Mm : Nn) + slot0 + (size_t)row * 1024 + cch * 16; \
                __builtin_amdgcn_global_load_lds((const unsigned*)src, (LAS unsigned*)(slot + (pid < 8 ? 0 : 8192) + pr * 1024), 16, 0, 0); } } } while (0)
        RW_ISSUE(0); RW_ISSUE(1); RW_ISSUE(2); RW_ISSUE(3); RW_ISSUE(4); RW_ISSUE(5); RW_ISSUE(6);
        for (int c = 0; c < 256; ++c) {
            if (c < 250) asm volatile("s_waitcnt vmcnt(24)" ::: "memory"); else asm volatile("s_waitcnt vmcnt(0)" ::: "memory");
            __builtin_amdgcn_s_barrier();
            asm volatile("" ::: "memory");
            RW_ISSUE(c + 7);
        }
#undef RW_ISSUE
        asm volatile("s_waitcnt vmcnt(0)" ::: "memory");
        return;
    }
    const int vs = wave;
    bf16* Hst = (bf16*)(ws + (z ? WS_V : WS_R));
    const int n_ = lane & 15, q_ = lane >> 4, wbyte = (q_ & 1) * 8, sw = n_ & 7;
    f32x4 H[4];
#pragma unroll
    for (int kt = 0; kt < 4; ++kt) H[kt] = (f32x4){0.f, 0.f, 0.f, 0.f};
    for (int c = 0; c < 256; ++c) {
        { bf16* dst = Hst + ((size_t)(c * 8 + h) * 64 + 16 * vs + n_) * 64 + 4 * q_;
#pragma unroll
          for (int kt = 0; kt < 4; ++kt) *(unsigned long long*)(dst + 16 * kt) = pk4(H[kt]); }
        asm volatile("s_waitcnt lgkmcnt(0)" ::: "memory");
        __builtin_amdgcn_s_barrier();
        asm volatile("" ::: "memory");
        ldsp slot = L + (c & 7) * 16384;
        const s16x8 b0 = pack_cpair(H[0], H[1]), b1 = pack_cpair(H[2], H[3]);
#pragma unroll
        for (int kt = 0; kt < 4; ++kt) {
            ldsp nrow = slot + 8192 + (16 * vs + n_) * 128 + wbyte;
            f32x4 acc = unpk4(*(LAS const unsigned long long*)(nrow + (((2 * kt + (q_ >> 1)) ^ sw) * 16)));
            ldsp mrow = slot + (16 * kt + n_) * 128 + wbyte;
#pragma unroll
            for (int ks = 0; ks < 2; ++ks) { const int c0 = 4 * ks + (q_ >> 1);
                const unsigned long long a0 = *(LAS const unsigned long long*)(mrow + ((c0 ^ sw) * 16)), a1 = *(LAS const unsigned long long*)(mrow + (((c0 + 2) ^ sw) * 16));
                v4u a; a.x = (unsigned)a0; a.y = (unsigned)(a0 >> 32); a.z = (unsigned)a1; a.w = (unsigned)(a1 >> 32);
                acc = mfma16(__builtin_bit_cast(s16x8, a), ks == 0 ? b0 : b1, acc); }
            H[kt] = acc;
        }
    }
}
DI void rwkv_pass3_post_item(const Args& a, unsigned char* ws, int item, int lane) {
    asm volatile("" : "+v"(lane));
    const int h = item >> 8, cn = item & 255;
    const int n_ = lane & 15, q_ = lane >> 4;
    const size_t slot0 = (size_t)cn * 64 * 512 + h * 64;
    const float* LW0 = (const float*)(ws + WS_LW0); const float* LW1 = (const float*)(ws + WS_LW1);
    const bf16* H0 = (const bf16*)(ws + WS_R) + (size_t)(cn * 8 + h) * 4096;
    const bf16* H1 = (const bf16*)(ws + WS_V) + (size_t)((255 - cn) * 8 + h) * 4096;
    s16x8 hA0[4][2], hA1[4][2];
#pragma unroll
    for (int t = 0; t < 4; ++t)
#pragma unroll
        for (int ks = 0; ks < 2; ++ks) { hA0[t][ks] = *(const s16x8*)(H0 + (size_t)(16 * t + n_) * 64 + 32 * ks + 8 * q_); hA1[t][ks] = *(const s16x8*)(H1 + (size_t)(16 * t + n_) * 64 + 32 * ks + 8 * q_); }
#pragma unroll
    for (int nt = 0; nt < 4; ++nt) {
        const int i0 = 16 * nt + n_, i1 = 63 - i0;
        const bf16* q0 = (const bf16*)(LW0 + slot0 + (size_t)i0 * 512); const bf16* q1 = (const bf16*)(LW1 + slot0 + (size_t)i1 * 512);
        s16x8 qB0[2], qB1[2];
#pragma unroll
        for (int ks = 0; ks < 2; ++ks) { qB0[ks] = *(const s16x8*)(q0 + 32 * ks + 8 * q_); qB1[ks] = *(const s16x8*)(q1 + 32 * ks + 8 * q_); }
        f32x4 y[4]; float sum = 0.f;
#pragma unroll
        for (int mt = 0; mt < 4; ++mt) {
            f32x4 acc = unpk4(*(const unsigned long long*)(q0 + 64 + 16 * mt + 4 * q_)) + unpk4(*(const unsigned long long*)(q1 + 64 + 16 * mt + 4 * q_));
            acc = mfma16(hA0[mt][0], qB0[0], acc); acc = mfma16(hA0[mt][1], qB0[1], acc);
            acc = mfma16(hA1[mt][0], qB1[0], acc); acc = mfma16(hA1[mt][1], qB1[1], acc);
            y[mt] = acc; sum += (acc[0] + acc[1]) + (acc[2] + acc[3]);
        }
        sum += __shfl_xor(sum, 16); sum += __shfl_xor(sum, 32);
        const float mu = sum * (1.0f / 64.f); float sq = 0.f;
#pragma unroll
        for (int mt = 0; mt < 4; ++mt)
#pragma unroll
            for (int e = 0; e < 4; ++e) { y[mt][e] -= mu; sq += y[mt][e] * y[mt][e]; }
        sq += __shfl_xor(sq, 16); sq += __shfl_xor(sq, 32);
        const float rs = 1.0f / sqrtf(sq * (1.0f / 64.f) + 64e-5f);
        const size_t tok = (size_t)(cn * 64 + i0);
#pragma unroll
        for (int mt = 0; mt < 4; ++mt) { const int c0 = h * 64 + 16 * mt + 4 * q_;
            const f32x4 lw = *(const f32x4*)(a.in[19] + c0), lb = *(const f32x4*)(a.in[20] + c0);
            const f32x4 bn = unpk4(*(const unsigned long long*)((const bf16*)(ws + WS_BONUS) + tok * 512 + c0)), gt = unpk4(*(const unsigned long long*)((const bf16*)(ws + WS_GATE) + tok * 512 + c0));
            const f32x4 o = (y[mt] * rs * lw + lb + bn) * gt;
            *(unsigned long long*)((bf16*)(ws + WS_Y) + tok * D_ + 512 + c0) = pk4(o); }
    }
}
constexpr size_t WS_W2T = WS_TILE + 65536;
constexpr size_t WS_PARK = WS_Y;
DI s16x8 act_frag(const bf16* p, int mode) {
    float v[8]; ld8(p, v);
#pragma unroll
    for (int i = 0; i < 8; ++i) { if (mode == 0) v[i] = 1.0f - 2.0f / (__expf(2.0f * v[i]) + 1.0f); else if (mode == 2) v[i] = 1.0f / (1.0f + __expf(-v[i])); }
    v4u w; w.x = pk2(v[0], v[1]); w.y = pk2(v[2], v[3]); w.z = pk2(v[4], v[5]); w.w = pk2(v[6], v[7]);
    return __builtin_bit_cast(s16x8, w);
}
DI void ld4(const bf16* p, float (&v)[4]) { const unsigned long long w = *(const unsigned long long*)p; v[0] = bflo((unsigned)w); v[1] = bfhi((unsigned)w); v[2] = bflo((unsigned)(w >> 32)); v[3] = bfhi((unsigned)(w >> 32)); }
DI void st4(bf16* p, const float (&v)[4]) { *(unsigned long long*)p = (unsigned long long)pk2(v[0], v[1]) | ((unsigned long long)pk2(v[2], v[3]) << 32); }
template <bool WLDS> DI void prep0_rwkv_unit(const Args& a, unsigned char* ws_, ldsp wl, int tile, int h, int lane) {
    asm volatile("" : "+v"(lane));
    GAS unsigned char* wsg = (GAS unsigned char*)ws_; asm volatile("" : "+s"(wsg)); unsigned char* ws = (unsigned char*)wsg;
    const int t0 = tile * 16, n_ = lane & 15, q_ = lane >> 4, t = t0 + n_;
    const bf16* LR = (const bf16*)(ws + WS_LORA) + (size_t)t * LORA_N + 8 * q_;
    const bf16* P = (const bf16*)(ws + WS_PROJ0) + (size_t)t * EVEN_IN + 1536 + h * 64 + 4 * q_;
    const bool hp = t > 0, hn = t < S_ - 1;
    unsigned long long cu[3][4], pv[3][4], nx[3][4];
#pragma unroll
    for (int part = 0; part < 3; ++part)
#pragma unroll
        for (int mt = 0; mt < 4; ++mt) { const bf16* p = P + part * 512 + 16 * mt;
            cu[part][mt] = *(const unsigned long long*)p; pv[part][mt] = hp ? *(const unsigned long long*)(p - EVEN_IN) : 0ull; nx[part][mt] = hn ? *(const unsigned long long*)(p + EVEN_IN) : 0ull; }
    unsigned long long rkv[3][4];
#pragma unroll
    for (int part = 0; part < 3; ++part)
#pragma unroll
        for (int mt = 0; mt < 4; ++mt) { const int c0 = h * 64 + 16 * mt + 4 * q_;
            const f32x4 m0 = *(const f32x4*)(a.in[6] + part * 512 + c0), m1 = *(const f32x4*)(a.in[6] + 1536 + part * 512 + c0);
            const f32x4 c4 = unpk4(cu[part][mt]), p4 = unpk4(pv[part][mt]), n4 = unpk4(nx[part][mt]);
            rkv[part][mt] = pk4(c4 + m0 * (p4 - c4) + m1 * (n4 - c4)); }
    asm volatile("" ::: "memory");
    v4u lraw[12];
#pragma unroll
    for (int i = 0; i < 12; ++i) lraw[i] = *(const v4u*)(LR + 32 * i);
    float ss = 0.f;
#pragma unroll
    for (int mt = 0; mt < 4; ++mt) { const f32x4 kkw = *(const f32x4*)(a.in[16] + h * 64 + 16 * mt + 4 * q_);
        const f32x4 k4 = unpk4(rkv[1][mt]);
#pragma unroll
        for (int e = 0; e < 4; ++e) { const float x = k4[e] * kkw[e]; ss += x * x; } }
    ss += __shfl_xor(ss, 16); ss += __shfl_xor(ss, 32);
    const float rn = 1.0f / sqrtf(ss + 1e-6f);
    s16x8 lfr[12];
#pragma unroll
    for (int i = 0; i < 12; ++i) { float x[8]; const v4u w = lraw[i];
        x[0] = bflo(w.x); x[1] = bfhi(w.x); x[2] = bflo(w.y); x[3] = bfhi(w.y); x[4] = bflo(w.z); x[5] = bfhi(w.z); x[6] = bflo(w.w); x[7] = bfhi(w.w);
#pragma unroll
        for (int j = 0; j < 8; ++j) { if (i < 4) x[j] = 1.0f - 2.0f * __builtin_amdgcn_rcpf(__expf(2.0f * x[j]) + 1.0f); else if (i >= 8) x[j] = __builtin_amdgcn_rcpf(1.0f + __expf(-x[j])); }
        v4u o; o.x = pk2(x[0], x[1]); o.y = pk2(x[2], x[3]); o.z = pk2(x[4], x[5]); o.w = pk2(x[6], x[7]); lfr[i] = __builtin_bit_cast(s16x8, o); }
    float dotb = 0.f;
#pragma unroll
    for (int mt = 0; mt < 4; ++mt) {
        const int c0 = h * 64 + 16 * mt + 4 * q_;
        f32x4 aw0 = *(const f32x4*)(a.in[8] + c0), aw1 = *(const f32x4*)(a.in[8] + 512 + c0), aa0 = *(const f32x4*)(a.in[11] + c0), aa1 = *(const f32x4*)(a.in[11] + 512 + c0), ag = (f32x4){0.f, 0.f, 0.f, 0.f};
        const int rl = 16 * mt + n_, sw = rl & 7;
        if (WLDS) {
#pragma unroll
            for (int ks = 0; ks < 2; ++ks) { const int po = ((4 * ks + q_) ^ sw) * 16;
                aw0 = mfma16(*(LAS const s16x8*)(wl + rl * 128 + po), lfr[ks], aw0);
                aw1 = mfma16(*(LAS const s16x8*)(wl + 8192 + rl * 128 + po), lfr[2 + ks], aw1);
                aa0 = mfma16(*(LAS const s16x8*)(wl + 16384 + rl * 128 + po), lfr[4 + ks], aa0);
                aa1 = mfma16(*(LAS const s16x8*)(wl + 24576 + rl * 128 + po), lfr[6 + ks], aa1);
            }
#pragma unroll
            for (int ks = 0; ks < 4; ++ks) ag = mfma16(*(LAS const s16x8*)(wl + 32768 + rl * 256 + ((((4 * ks + q_) & 8) | (((4 * ks + q_) & 7) ^ sw)) * 16)), lfr[8 + ks], ag);
        } else {
            const bf16* W2T = (const bf16*)(ws + WS_W2T); const size_t cr = (size_t)(h * 64 + rl);
#pragma unroll
            for (int ks = 0; ks < 2; ++ks) {
                aw0 = mfma16(*(const s16x8*)(W2T + cr * 64 + 32 * ks + 8 * q_), lfr[ks], aw0);
                aw1 = mfma16(*(const s16x8*)(W2T + 32768 + cr * 64 + 32 * ks + 8 * q_), lfr[2 + ks], aw1);
                aa0 = mfma16(*(const s16x8*)(W2T + 65536 + cr * 64 + 32 * ks + 8 * q_), lfr[4 + ks], aa0);
                aa1 = mfma16(*(const s16x8*)(W2T + 98304 + cr * 64 + 32 * ks + 8 * q_), lfr[6 + ks], aa1);
            }
#pragma unroll
            for (int ks = 0; ks < 4; ++ks) ag = mfma16(*(const s16x8*)(W2T + 131072 + cr * 128 + 32 * ks + 8 * q_), lfr[8 + ks], ag);
        }
        const f32x4 kkw = *(const f32x4*)(a.in[16] + c0), kaw = *(const f32x4*)(a.in[17] + c0), rkw = *(const f32x4*)(a.in[18] + c0);
        float l0[4], l1[4], g4[4], d0[4], d1[4], kk4[4], b0[4], b1[4];
        const f32x4 r4 = unpk4(rkv[0][mt]), k4 = unpk4(rkv[1][mt]);
#pragma unroll
        for (int e = 0; e < 4; ++e) {
            l0[e] = -__expf(-__logf(1.0f + __expf(-aw0[e])) - 0.5f); l1[e] = -__expf(-__logf(1.0f + __expf(-aw1[e])) - 0.5f);
            const float i0 = __builtin_amdgcn_rcpf(1.0f + __expf(-aa0[e])), i1 = __builtin_amdgcn_rcpf(1.0f + __expf(-aa1[e])); g4[e] = ag[e];
            kk4[e] = k4[e] * kkw[e] * rn; b0[e] = kk4[e] * i0; b1[e] = kk4[e] * i1;
            d0[e] = k4[e] * (1.0f + (i0 - 1.0f) * kaw[e]); d1[e] = k4[e] * (1.0f + (i1 - 1.0f) * kaw[e]);
            dotb += r4[e] * (d0[e] + d1[e]) * rkw[e]; }
        const size_t o = (size_t)t * 512 + c0;
        *(f32x4*)((float*)(ws + WS_LW0) + o) = (f32x4){l0[0], l0[1], l0[2], l0[3]};
        *(f32x4*)((float*)(ws + WS_LW1) + o) = (f32x4){l1[0], l1[1], l1[2], l1[3]};
        *(unsigned long long*)((bf16*)(ws + WS_R) + o) = rkv[0][mt]; *(unsigned long long*)((bf16*)(ws + WS_V) + o) = rkv[2][mt]; st4((bf16*)(ws + WS_KK) + o, kk4); st4((bf16*)(ws + WS_KD0) + o, d0); st4((bf16*)(ws + WS_KD1) + o, d1);
        st4((bf16*)(ws + WS_B0) + o, b0); st4((bf16*)(ws + WS_B1) + o, b1); st4((bf16*)(ws + WS_GATE) + o, g4);
        if (!WLDS) asm volatile("" ::: "memory");
    }
    dotb += __shfl_xor(dotb, 16); dotb += __shfl_xor(dotb, 32);
#pragma unroll
    for (int mt = 0; mt < 4; ++mt) { float bo[4]; const f32x4 v4 = unpk4(rkv[2][mt]);
#pragma unroll
        for (int e = 0; e < 4; ++e) bo[e] = dotb * v4[e];
        st4((bf16*)(ws + WS_BONUS) + (size_t)t * 512 + h * 64 + 16 * mt + 4 * q_, bo); }
}
DI void prep0_stage_w2t(unsigned char* ws, ldsp wl, int h, int tid) {
    const bf16* W2T = (const bf16*)(ws + WS_W2T);
    for (int i = tid; i < 3072; i += 512) {
        if (i < 2048) { const int mtx = i >> 9, r = (i >> 3) & 63, c = i & 7;
            *(LAS v4u*)(wl + mtx * 8192 + r * 128 + ((c ^ (r & 7)) * 16)) = *(const v4u*)(W2T + (size_t)mtx * 32768 + (size_t)(h * 64 + r) * 64 + c * 8); }
        else { const int j = i - 2048, r = j >> 4, c = j & 15;
            *(LAS v4u*)(wl + 32768 + r * 256 + (((c & 8) | ((c & 7) ^ (r & 7))) * 16)) = *(const v4u*)(W2T + 131072 + (size_t)(h * 64 + r) * 128 + c * 8); }
    }
}
constexpr int AT_ACC = 0, AT_M = 65536, AT_L = 66560, AT_V = 67584;
DI void attn_unit(unsigned char* ws, ldsp L, int unit, int wave, int lane) {
    const int h = unit & 7, T0 = (unit >> 3) * 256;
    const bf16* QN = (const bf16*)(ws + WS_QN); const bf16* KN = (const bf16*)(ws + WS_KN); const bf16* VN = (const bf16*)(ws + WS_Y1);
    LAS float* accO = (LAS float*)(L + AT_ACC); LAS float* accM = (LAS float*)(L + AT_M); LAS float* accL = (LAS float*)(L + AT_L);
    ldsp Vst = L + AT_V + wave * 8192;
#pragma unroll 1
    for (int br = 0; br < 3; ++br) {
        const int d = br == 0 ? 1 : (br == 1 ? 4 : 16);
#pragma unroll 1
        for (int si = 0; si < 2; ++si) {
            int lane_s = lane; asm volatile("" : "+v"(lane_s));
            const int n_ = lane_s & 15, q_ = lane_s >> 4;
            const int sidx = wave + 8 * si;
            const int tb = br == 0 ? T0 + 16 * sidx : (br == 1 ? T0 + (sidx & 3) + 64 * (sidx >> 2) : T0 + sidx);
            s16x8 qf[2];
            { const bf16* qrow = QN + (size_t)(tb + d * n_) * 512 + h * 64 + 8 * q_; qf[0] = *(const s16x8*)qrow; qf[1] = *(const s16x8*)(qrow + 32); }
            v4u vreg[5][4];
#pragma unroll
            for (int pp = 0; pp < 5; ++pp)
#pragma unroll
                for (int it = 0; it < 4; ++it) { const int pc = lane + 64 * it, row = pc >> 3, ck = pc & 7;
                    int tk = tb + d * (32 * pp + row - 64); tk = tk < 0 ? 0 : (tk > S_ - 1 ? S_ - 1 : tk);
                    vreg[pp][it] = *(const v4u*)(VN + (size_t)tk * 512 + h * 64 + ck * 8); }
            f32x4 st[10]; st[9] = (f32x4){0.f, 0.f, 0.f, 0.f};
#pragma unroll
            for (int kt = 0; kt < 9; ++kt) {
                int tk = tb + d * (16 * kt + n_ - 64); tk = tk < 0 ? 0 : (tk > S_ - 1 ? S_ - 1 : tk);
                const bf16* krow = KN + (size_t)tk * 512 + h * 64 + 8 * q_;
                f32x4 acc = (f32x4){0.f, 0.f, 0.f, 0.f};
                acc = mfma16(*(const s16x8*)krow, qf[0], acc); acc = mfma16(*(const s16x8*)(krow + 32), qf[1], acc);
                st[kt] = acc;
            }
            float mx = -3.0e38f;
            const bool edge = (tb - 64 * d < 0) || (tb + d * 95 >= S_);
#pragma unroll
            for (int kt = 0; kt < 9; ++kt)
#pragma unroll
                for (int e = 0; e < 4; ++e) { const int j = 16 * kt + 4 * q_ + e;
                    bool ok = true;
                    if (kt == 0) ok = (j >= n_);
                    if (kt == 8) ok = (j <= n_ + 128);
                    if (edge) { const int tk = tb + d * (j - 64); ok = ok && (tk >= 0) && (tk < S_); }
                    st[kt][e] = ok ? st[kt][e] : -3.0e38f; mx = fmaxf(mx, st[kt][e]); }
            mx = fmaxf(mx, __shfl_xor(mx, 16)); mx = fmaxf(mx, __shfl_xor(mx, 32));
            float ls = 0.f;
#pragma unroll
            for (int kt = 0; kt < 9; ++kt)
#pragma unroll
                for (int e = 0; e < 4; ++e) { const float p = st[kt][e] > -1.0e38f ? __expf(st[kt][e] - mx) : 0.f; st[kt][e] = p; ls += p; }
            ls += __shfl_xor(ls, 16); ls += __shfl_xor(ls, 32);
            f32x4 O[4];
#pragma unroll
            for (int dt = 0; dt < 4; ++dt) O[dt] = (f32x4){0.f, 0.f, 0.f, 0.f};
#pragma unroll
            for (int pp = 0; pp < 5; ++pp) {
                ldsp vb = Vst + (pp & 1) * 4096;
#pragma unroll
                for (int it = 0; it < 4; ++it) { const int pc = lane + 64 * it, row = pc >> 3, ck = pc & 7; *(LAS v4u*)(vb + row * 128 + ck * 16) = vreg[pp][it]; }
                LDS_WAIT(); CFENCE();
                const s16x8 pa = pack_cpair(st[2 * pp], st[2 * pp + 1]);
                ldsp a0 = vb + (4 * q_ + ((lane & 15) >> 2)) * 128 + 8 * (lane & 3);
#pragma unroll
                for (int dt = 0; dt < 4; ++dt) { const s16x4 lo = tr16(a0 + 32 * dt), hi = tr16(a0 + 16 * 128 + 32 * dt);
                    O[dt] = mfma16(pa, __builtin_shufflevector(lo, hi, 0, 1, 2, 3, 4, 5, 6, 7), O[dt]); }
            }
            float ms[4], lsv[4]; int li[4];
#pragma unroll
            for (int e = 0; e < 4; ++e) { ms[e] = __shfl(mx, 4 * q_ + e); lsv[e] = __shfl(ls, 4 * q_ + e); li[e] = tb + d * (4 * q_ + e) - T0; }
            if (br == 0) {
#pragma unroll
                for (int e = 0; e < 4; ++e) {
#pragma unroll
                    for (int dt = 0; dt < 4; ++dt) accO[li[e] * 64 + 16 * dt + n_] = O[dt][e];
                    if (n_ == 0) { accM[li[e]] = ms[e]; accL[li[e]] = lsv[e]; } }
            } else {
                float fo[4], fn[4], mn[4], lo_[4];
#pragma unroll
                for (int e = 0; e < 4; ++e) { const float mo = accM[li[e]]; lo_[e] = accL[li[e]]; mn[e] = fmaxf(mo, ms[e]); fo[e] = __expf(mo - mn[e]); fn[e] = __expf(ms[e] - mn[e]); }
                LDS_WAIT(); CFENCE();
#pragma unroll
                for (int e = 0; e < 4; ++e) {
#pragma unroll
                    for (int dt = 0; dt < 4; ++dt) { LAS float* p = accO + li[e] * 64 + 16 * dt + n_; *p = *p * fo[e] + O[dt][e] * fn[e]; }
                    if (n_ == 0) { accM[li[e]] = mn[e]; accL[li[e]] = lo_[e] * fo[e] + lsv[e] * fn[e]; } }
            }
            LDS_WAIT(); CFENCE();
        }
        __syncthreads();
    }
    {
        const int tid = wave * 64 + lane, tl = tid >> 1, hf = tid & 1;
        const float il = 1.0f / accL[tl];
        const LAS float* src = accO + tl * 64 + 32 * hf; bf16* dst = (bf16*)(ws + WS_Y) + (size_t)(T0 + tl) * D_ + h * 64 + 32 * hf;
#pragma unroll
        for (int c = 0; c < 4; ++c) { const f32x4 a = *(LAS const f32x4*)(src + 8 * c), b = *(LAS const f32x4*)(src + 8 * c + 4);
            v4u w; w.x = pk2(a.x * il, a.y * il); w.y = pk2(a.z * il, a.w * il); w.z = pk2(b.x * il, b.y * il); w.w = pk2(b.z * il, b.w * il);
            *(v4u*)(dst + 8 * c) = w; }
    }
    __syncthreads();
}
constexpr size_t WS_SST = WS_PROJ1, WS_UB = WS_PROJ1 + 64 * MiB, WS_AT = WS_PROJ1 + 96 * MiB, WS_GC = WS_PROJ1 + 112 * MiB;
constexpr size_t WS_WN = WS_A + 112 * MiB, WS_KT = WS_A + 144 * MiB;
static_assert(WS_GC + 2048 * 64 * 4 <= WS_O0, "dn map");
template <int PITCH> DI s16x8 frag_row_p(ldsp img, int row0, int col0, int lane) { return *(LAS const s16x8*)(img + (row0 + (lane & 15)) * PITCH + (col0 + 8 * (lane >> 4)) * 2); }
template <int PITCH> DI s16x8 frag_tr_p(ldsp img, int row0, int col0, int lane) {
    ldsp a0 = img + (row0 + 8 * (lane >> 4) + ((lane & 15) >> 2)) * PITCH + col0 * 2 + 8 * (lane & 3);
    const s16x4 lo = tr16(a0), hi = tr16(a0 + 4 * PITCH);
    return __builtin_shufflevector(lo, hi, 0, 1, 2, 3, 4, 5, 6, 7);
}
constexpr int DN_LDS_PER_WAVE = 32768 + 512;
DI void dn_pass1_item(unsigned char* ws, ldsp lds, int item, int lane) {
    asm volatile("" : "+v"(lane));
    const int z = item >> 10, h = (item >> 8) & 3, c = item & 255, cn = z ? 255 - c : c;
    const bf16* Q = (const bf16*)(ws + WS_QD); const bf16* K = (const bf16*)(ws + WS_KD); const bf16* V = (const bf16*)(ws + WS_VD);
    ldsp IKd = lds, IVd = lds, LT = lds + 16384; LAS float* gcs = (LAS float*)(lds + 32768); LAS float* bts = gcs + 64;
    const int n_ = lane & 15, q_ = lane >> 4;
    {
        const int tok = tok_of(z, cn, lane);
        float gc = ((const float*)(ws + WS_GB))[(size_t)tok * 8 + z * 4 + h]; const float bt = ((const float*)(ws + WS_GB + 512 * 1024))[(size_t)tok * 8 + z * 4 + h];
#pragma unroll
        for (int o = 1; o < 64; o <<= 1) { const float t = __shfl_up(gc, o); if (lane >= o) gc += t; }
        gcs[lane] = gc; bts[lane] = bt; ((float*)(ws + WS_GC))[(size_t)item * 64 + lane] = gc;
    }
#pragma unroll 4
    for (int it = 0; it < 16; ++it) { const int p = lane + 64 * it, row = p >> 4, ck = p & 15; const size_t go = (size_t)tok_of(z, cn, row) * 512 + h * 128 + ck * 8;
        *(LAS v4u*)(IKd + row * 256 + ck * 16) = *(const v4u*)(K + go); }
    LDS_WAIT(); CFENCE();
    s16x8 kf[4][4];
#pragma unroll
    for (int rt = 0; rt < 4; ++rt)
#pragma unroll
        for (int ks = 0; ks < 4; ++ks) kf[rt][ks] = frag_row_p<256>(IKd, 16 * rt, 32 * ks, lane);
#pragma unroll
    for (int mt = 0; mt < 4; ++mt) { f32x4 gi, bi;
#pragma unroll
        for (int e = 0; e < 4; ++e) { gi[e] = gcs[16 * mt + 4 * q_ + e]; bi[e] = bts[16 * mt + 4 * q_ + e]; }
#pragma unroll
        for (int nt = 0; nt < 4; ++nt) { f32x4 acc = (f32x4){0.f, 0.f, 0.f, 0.f};
            if (nt <= mt) {
#pragma unroll
                for (int ks = 0; ks < 4; ++ks) acc = mfma16(kf[mt][ks], kf[nt][ks], acc); }
            const float gj = gcs[16 * nt + n_];
#pragma unroll
            for (int e = 0; e < 4; ++e) { const int i = 16 * mt + 4 * q_ + e, j = 16 * nt + n_; ((LAS float*)LT)[i * 64 + j] = (j < i) ? bi[e] * acc[e] * __expf(gi[e] - gj) : 0.f; } } }
    {
        bf16* At = (bf16*)(ws + WS_AT) + (size_t)item * 4096;
#pragma unroll
        for (int nt = 0; nt < 4; ++nt) { s16x8 qf[4]; const bf16* qrow = Q + (size_t)tok_of(z, cn, 16 * nt + n_) * 512 + h * 128 + 8 * q_;
#pragma unroll
            for (int ks = 0; ks < 4; ++ks) qf[ks] = *(const s16x8*)(qrow + 32 * ks);
            const float gi = gcs[16 * nt + n_];
#pragma unroll
            for (int mt = 0; mt < 4; ++mt) { f32x4 acc = (f32x4){0.f, 0.f, 0.f, 0.f};
                if (mt <= nt) {
#pragma unroll
                    for (int ks = 0; ks < 4; ++ks) acc = mfma16(kf[mt][ks], qf[ks], acc); }
                f32x4 o;
#pragma unroll
                for (int e = 0; e < 4; ++e) { const int j = 16 * mt + 4 * q_ + e, i = 16 * nt + n_; o[e] = (j <= i) ? acc[e] * __expf(gi - gcs[j]) : 0.f; }
                *(unsigned long long*)(At + (size_t)(16 * nt + n_) * 64 + 16 * mt + 4 * q_) = pk4(o); } }
    }
    LDS_WAIT(); CFENCE();
    {
        float t[64];
        int lane_o = lane; asm volatile("" : "+v"(lane_o));
        f32x4 ar[2][16];
#pragma unroll
        for (int i = 0; i < 64; ++i) {
            if (i + 1 < 64) {
#pragma unroll
                for (int jg = 0; jg < (i + 1 + 3) / 4; ++jg) ar[(i + 1) & 1][jg] = *(LAS const f32x4*)(LT + ((i + 1) * 64 + 4 * jg) * 4);
            }
            __builtin_amdgcn_sched_barrier(0);
            float acc0 = (lane_o == i) ? 1.f : 0.f, acc1 = 0.f, acc2 = 0.f, acc3 = 0.f;
#pragma unroll
            for (int jg = 0; jg < (i + 3) / 4; ++jg) { const f32x4 a4 = ar[i & 1][jg];
                if (4 * jg + 0 < i) acc0 -= a4[0] * t[4 * jg + 0];
                if (4 * jg + 1 < i) acc1 -= a4[1] * t[4 * jg + 1];
                if (4 * jg + 2 < i) acc2 -= a4[2] * t[4 * jg + 2];
                if (4 * jg + 3 < i) acc3 -= a4[3] * t[4 * jg + 3]; }
            t[i] = (acc0 + acc1) + (acc2 + acc3);
            __builtin_amdgcn_sched_barrier(0);
        }
        LDS_WAIT(); CFENCE();
        const float s1 = bts[lane], s2 = -s1 * __expf(gcs[lane]);
#pragma unroll
        for (int i = 0; i < 64; ++i) { ((LAS bf16*)LT)[i * 64 + lane] = (bf16)f2bf(t[i] * s1); ((LAS bf16*)(LT + 8192))[i * 64 + lane] = (bf16)f2bf(t[i] * s2); }
    }
    LDS_WAIT(); CFENCE();
    ldsp IT1 = LT, IT2 = LT + 8192;
    v4u vimg[16];
#pragma unroll
    for (int it = 0; it < 16; ++it) { const int p = lane + 64 * it, row = p >> 4, ck = p & 15; vimg[it] = *(const v4u*)(V + (size_t)tok_of(z, cn, row) * 512 + h * 128 + ck * 8); }
    {
        bf16* Wn = (bf16*)(ws + WS_WN) + (size_t)item * 8192;
        s16x8 tf[4][2];
#pragma unroll
        for (int nt = 0; nt < 4; ++nt)
#pragma unroll
            for (int ks = 0; ks < 2; ++ks) tf[nt][ks] = frag_row_p<128>(IT2, 16 * nt, 32 * ks, lane);
#pragma unroll
        for (int mt = 0; mt < 8; ++mt) { const s16x8 k0 = frag_tr_p<256>(IKd, 0, 16 * mt, lane), k1 = frag_tr_p<256>(IKd, 32, 16 * mt, lane);
            if (z == 0) { bf16* KT = (bf16*)(ws + WS_KT) + ((size_t)(h * 256 + cn) * 128 + 16 * mt + n_) * 64 + 8 * q_; *(s16x8*)KT = k0; *(s16x8*)(KT + 32) = k1; }
#pragma unroll
            for (int nt = 0; nt < 4; ++nt) { f32x4 acc = (f32x4){0.f, 0.f, 0.f, 0.f}; acc = mfma16(k0, tf[nt][0], acc); acc = mfma16(k1, tf[nt][1], acc);
                *(unsigned long long*)(Wn + (size_t)(16 * nt + n_) * 128 + 16 * mt + 4 * q_) = pk4(acc); } }
    }
    LDS_WAIT(); CFENCE();
#pragma unroll
    for (int it = 0; it < 16; ++it) { const int p = lane + 64 * it, row = p >> 4, ck = p & 15; *(LAS v4u*)(IVd + row * 256 + ck * 16) = vimg[it]; }
    LDS_WAIT(); CFENCE();
    {
        bf16* Ub = (bf16*)(ws + WS_UB) + (size_t)item * 8192;
        s16x8 tf[4][2];
#pragma unroll
        for (int mt = 0; mt < 4; ++mt)
#pragma unroll
            for (int ks = 0; ks < 2; ++ks) tf[mt][ks] = frag_row_p<128>(IT1, 16 * mt, 32 * ks, lane);
#pragma unroll
        for (int nt = 0; nt < 8; ++nt) { const s16x8 v0 = frag_tr_p<256>(IVd, 0, 16 * nt, lane), v1 = frag_tr_p<256>(IVd, 32, 16 * nt, lane);
#pragma unroll
            for (int mt = 0; mt < 4; ++mt) { f32x4 acc = (f32x4){0.f, 0.f, 0.f, 0.f}; acc = mfma16(tf[mt][0], v0, acc); acc = mfma16(tf[mt][1], v1, acc);
                *(unsigned long long*)(Ub + (size_t)(16 * nt + n_) * 64 + 16 * mt + 4 * q_) = pk4(acc); } }
    }
    LDS_WAIT(); CFENCE();
}
DI s16x8 pack_cpair_rev(const f32x4& lo, const f32x4& hi) { v4u p; p.x = pk2(lo[3], lo[2]); p.y = pk2(lo[1], lo[0]); p.z = pk2(hi[3], hi[2]); p.w = pk2(hi[1], hi[0]); return __builtin_bit_cast(s16x8, p); }
DI unsigned long long rev4(unsigned long long x) { return (x >> 48) | ((x >> 16) & 0xffff0000ull) | ((x << 16) & 0xffff00000000ull) | (x << 48); }
DI void dn_pass2_wave(unsigned char* ws, int w  , int lane) {
    const int z = w >> 5, h = (w >> 3) & 3, vs = w & 7;
    const int n_ = lane & 15, q_ = lane >> 4;
    f32x4 S[8];
#pragma unroll
    for (int kt = 0; kt < 8; ++kt) S[kt] = (f32x4){0.f, 0.f, 0.f, 0.f};
    for (int c = 0; c < 256; ++c) {
        const int item = (z * 4 + h) * 256 + c, cn = z ? 255 - c : c;
        const bf16* Wn = (const bf16*)(ws + WS_WN) + (size_t)item * 8192; const bf16* Ub = (const bf16*)(ws + WS_UB) + (size_t)item * 8192;
        const float* gcu = (const float*)(ws + WS_GC) + (size_t)item * 64;
        const bf16* KT = (const bf16*)(ws + WS_KT) + (size_t)(h * 256 + cn) * 128 * 64;
        bf16* Sst = (bf16*)(ws + WS_SST) + (size_t)item * 16384;
        f32x4 u[4], gv[4];
#pragma unroll
        for (int mt = 0; mt < 4; ++mt) { u[mt] = unpk4(*(const unsigned long long*)(Ub + (size_t)(16 * vs + n_) * 64 + 16 * mt + 4 * q_)); gv[mt] = *(const f32x4*)(gcu + 16 * mt + 4 * q_); }
        const float gl = gcu[63];
        unsigned long long wa[4][4][2], ka[8][2][2];
#pragma unroll
        for (int mt = 0; mt < 4; ++mt)
#pragma unroll
            for (int ks = 0; ks < 4; ++ks) { const bf16* row = Wn + (size_t)(16 * mt + n_) * 128 + 32 * ks + 4 * q_; wa[mt][ks][0] = *(const unsigned long long*)row; wa[mt][ks][1] = *(const unsigned long long*)(row + 16); }
#pragma unroll
        for (int kt = 0; kt < 8; ++kt)
#pragma unroll
            for (int ks = 0; ks < 2; ++ks) { const bf16* row = KT + (size_t)(16 * kt + n_) * 64;
                if (z == 0) { ka[kt][ks][0] = *(const unsigned long long*)(row + 32 * ks + 4 * q_); ka[kt][ks][1] = *(const unsigned long long*)(row + 32 * ks + 16 + 4 * q_); }
                else { ka[kt][ks][0] = rev4(*(const unsigned long long*)(row + 60 - 32 * ks - 4 * q_)); ka[kt][ks][1] = rev4(*(const unsigned long long*)(row + 44 - 32 * ks - 4 * q_)); } }
#pragma unroll
        for (int kt = 0; kt < 8; ++kt) *(unsigned long long*)(Sst + (size_t)(16 * vs + n_) * 128 + 16 * kt + 4 * q_) = pk4(S[kt]);
#pragma unroll
        for (int ks = 0; ks < 4; ++ks) { const s16x8 b = pack_cpair(S[2 * ks], S[2 * ks + 1]);
#pragma unroll
            for (int mt = 0; mt < 4; ++mt) { v4u a; a.x = (unsigned)wa[mt][ks][0]; a.y = (unsigned)(wa[mt][ks][0] >> 32); a.z = (unsigned)wa[mt][ks][1]; a.w = (unsigned)(wa[mt][ks][1] >> 32);
                u[mt] = mfma16(__builtin_bit_cast(s16x8, a), b, u[mt]); } }
#pragma unroll
        for (int mt = 0; mt < 4; ++mt)
#pragma unroll
            for (int e = 0; e < 4; ++e) u[mt][e] *= __expf(gl - gv[mt][e]);
        const float egl = __expf(gl);
        const s16x8 b0 = pack_cpair(u[0], u[1]), b1 = pack_cpair(u[2], u[3]);
#pragma unroll
        for (int kt = 0; kt < 8; ++kt) { f32x4 acc = S[kt] * egl;
            { v4u a; a.x = (unsigned)ka[kt][0][0]; a.y = (unsigned)(ka[kt][0][0] >> 32); a.z = (unsigned)ka[kt][0][1]; a.w = (unsigned)(ka[kt][0][1] >> 32); acc = mfma16(__builtin_bit_cast(s16x8, a), b0, acc); }
            { v4u a; a.x = (unsigned)ka[kt][1][0]; a.y = (unsigned)(ka[kt][1][0] >> 32); a.z = (unsigned)ka[kt][1][1]; a.w = (unsigned)(ka[kt][1][1] >> 32); acc = mfma16(__builtin_bit_cast(s16x8, a), b1, acc); }
            S[kt] = acc; }
    }
}
DI void dn_pass3_item(unsigned char* ws, int item, int lane) {
    asm volatile("" : "+v"(lane));
    const int z = item >> 10, h = (item >> 8) & 3, c = item & 255, cn = z ? 255 - c : c;
    const int n_ = lane & 15, q_ = lane >> 4;
    const bf16* Q = (const bf16*)(ws + WS_QD);
    const bf16* Wn = (const bf16*)(ws + WS_WN) + (size_t)item * 8192; const bf16* Ub = (const bf16*)(ws + WS_UB) + (size_t)item * 8192;
    const bf16* At = (const bf16*)(ws + WS_AT) + (size_t)item * 4096; const float* gcu = (const float*)(ws + WS_GC) + (size_t)item * 64;
    const bf16* Sst = (const bf16*)(ws + WS_SST) + (size_t)item * 16384;
    bf16* O = (bf16*)(ws + (z ? WS_O1 : WS_O0));
    s16x8 wf[4][4], qf[4][4]; unsigned long long af[4][2][2]; float eg[4];
#pragma unroll
    for (int t = 0; t < 4; ++t) {
        const bf16* qrow = Q + (size_t)tok_of(z, cn, 16 * t + n_) * 512 + h * 128 + 8 * q_;
#pragma unroll
        for (int ks = 0; ks < 4; ++ks) { wf[t][ks] = *(const s16x8*)(Wn + (size_t)(16 * t + n_) * 128 + 32 * ks + 8 * q_); qf[t][ks] = *(const s16x8*)(qrow + 32 * ks); }
#pragma unroll
        for (int ks = 0; ks < 2; ++ks) { const bf16* arow = At + (size_t)(16 * t + n_) * 64 + 32 * ks + 4 * q_; af[t][ks][0] = *(const unsigned long long*)arow; af[t][ks][1] = *(const unsigned long long*)(arow + 16); }
        eg[t] = __expf(gcu[16 * t + n_]);
    }
#pragma unroll
    for (int mt = 0; mt < 8; ++mt) {
        s16x8 sf[4];
#pragma unroll
        for (int ks = 0; ks < 4; ++ks) sf[ks] = *(const s16x8*)(Sst + (size_t)(16 * mt + n_) * 128 + 32 * ks + 8 * q_);
        f32x4 u[4];
#pragma unroll
        for (int jt = 0; jt < 4; ++jt) { u[jt] = unpk4(*(const unsigned long long*)(Ub + (size_t)(16 * mt + n_) * 64 + 16 * jt + 4 * q_));
#pragma unroll
            for (int ks = 0; ks < 4; ++ks) u[jt] = mfma16(wf[jt][ks], sf[ks], u[jt]); }
        const s16x8 ua0 = pack_cpair(u[0], u[1]), ua1 = pack_cpair(u[2], u[3]);
#pragma unroll
        for (int nt = 0; nt < 4; ++nt) {
            f32x4 acc = (f32x4){0.f, 0.f, 0.f, 0.f};
#pragma unroll
            for (int ks = 0; ks < 4; ++ks) acc = mfma16(sf[ks], qf[nt][ks], acc);
            acc = acc * eg[nt];
            { v4u b; b.x = (unsigned)af[nt][0][0]; b.y = (unsigned)(af[nt][0][0] >> 32); b.z = (unsigned)af[nt][0][1]; b.w = (unsigned)(af[nt][0][1] >> 32); acc = mfma16(ua0, __builtin_bit_cast(s16x8, b), acc); }
            { v4u b; b.x = (unsigned)af[nt][1][0]; b.y = (unsigned)(af[nt][1][0] >> 32); b.z = (unsigned)af[nt][1][1]; b.w = (unsigned)(af[nt][1][1] >> 32); acc = mfma16(ua1, __builtin_bit_cast(s16x8, b), acc); }
            *(unsigned long long*)(O + (size_t)tok_of(z, cn, 16 * nt + n_) * 512 + h * 128 + 16 * mt + 4 * q_) = pk4(acc);
        }
    }
}
constexpr int DN_SLOT = 41984, DN_GRP = 16;
constexpr size_t WS_MG = WS_END_OLD, WS_NG = WS_END_OLD + 4 * MiB, WS_SG = WS_END_OLD + 8 * MiB;
DI void dn_scan_block(unsigned char* ws, ldsp L, const int Z, const int MODE, int h, int hv, int g, int wave, int lane) {
    const int item0 = (Z * 4 + h) * 256, cb = g * DN_GRP, zhg = (Z * 4 + h) * 16 + g;
    if (wave >= 4) {
        const int lw = wave - 4;
        unsigned so[11], ld[11];
#pragma unroll
        for (int k = 0; k < 4; ++k) { const int pid = lw * 4 + k; const int row = 4 * pid + (lane >> 4), p = lane & 15, cch = p ^ (row & 15); so[k] = row * 256 + cch * 16; ld[k] = pid * 1024 + lane * 16; }
#pragma unroll
        for (int k = 0; k < 4; ++k) { const int pid = lw * 4 + k; const int row = 8 * pid + (lane >> 3), p = lane & 7, cch = p ^ (row & 7); so[4 + k] = row * 128 + cch * 16; ld[4 + k] = 16384 + pid * 1024 + lane * 16; }
#pragma unroll
        for (int k = 0; k < 2; ++k) { const int pid = lw * 2 + k; const int row = 8 * pid + (lane >> 3), p = lane & 7, cch = p ^ (row & 7); so[8 + k] = row * 128 + cch * 16; ld[8 + k] = 32768 + pid * 1024 + lane * 16; }
        so[10] = lane * 16; ld[10] = 40960 + lane * 16;
        v4u rA[11], rB[11];
#define DN_GLOAD(R, ss) do { const int s_ = (ss) < DN_GRP ? (ss) : DN_GRP - 1; const int c_ = cb + s_; const int cn_ = Z ? 255 - c_ : c_; \
            const char* wsrc = (const char*)((const bf16*)(ws + WS_WN) + (size_t)(item0 + c_) * 8192); const char* ksrc = (const char*)((const bf16*)(ws + WS_KT) + (size_t)(h * 256 + cn_) * 8192); \
            const char* usrc = (const char*)((const bf16*)(ws + WS_UB) + (size_t)(item0 + c_) * 8192 + hv * 4096); const char* gsrc = (const char*)((const float*)(ws + WS_GC) + (size_t)(item0 + c_) * 64); \
            _Pragma("unroll") for (int k = 0; k < 4; ++k) R[k] = *(const v4u*)(wsrc + so[k]); \
            _Pragma("unroll") for (int k = 4; k < 8; ++k) R[k] = *(const v4u*)(ksrc + so[k]); \
            _Pragma("unroll") for (int k = 8; k < 10; ++k) R[k] = *(const v4u*)(usrc + so[k]); \
            if (lw == 0) R[10] = *(const v4u*)(gsrc + so[10]); } while (0)
#define DN_LWRITE(R, ss) do { ldsp slot = L + ((ss) % 3) * DN_SLOT; \
            _Pragma("unroll") for (int k = 0; k < 10; ++k) *(LAS v4u*)(slot + ld[k]) = R[k]; \
            if (lw == 0) *(LAS v4u*)(slot + ld[10]) = R[10]; } while (0)
        DN_GLOAD(rA, 0); DN_GLOAD(rB, 1); DN_LWRITE(rA, 0); DN_LWRITE(rB, 1);
        DN_GLOAD(rA, 2); DN_GLOAD(rB, 3);
#define DN_LSTEP(R, ss) do { asm volatile("s_waitcnt lgkmcnt(0)" ::: "memory"); __builtin_amdgcn_s_barrier(); asm volatile("" ::: "memory"); \
            DN_LWRITE(R, (ss) + 2); DN_GLOAD(R, (ss) + 4); } while (0)
        for (int s2 = 0; s2 < DN_GRP; s2 += 2) { DN_LSTEP(rA, s2); DN_LSTEP(rB, s2 + 1); }
#undef DN_LSTEP
#undef DN_LWRITE
#undef DN_GLOAD
        asm volatile("s_waitcnt vmcnt(0) lgkmcnt(0)" ::: "memory");
        return;
    }
    const int vs = 4 * hv + wave;
    const int n_ = lane & 15, q_ = lane >> 4, wbyte = (q_ & 1) * 8, sw = n_ & 7;
    int kao[2][2];
#pragma unroll
    for (int ks = 0; ks < 2; ++ks) { const int r0 = Z ? 60 - 32 * ks - 4 * q_ : 32 * ks + 4 * q_, r1 = Z ? r0 - 16 : r0 + 16; kao[ks][0] = (((r0 >> 3) ^ sw) * 16) + (r0 & 7) * 2; kao[ks][1] = (((r1 >> 3) ^ sw) * 16) + (r1 & 7) * 2; }
    const float ubm = MODE == 2 ? 0.f : 1.f;
    f32x4 S[8];
    if (MODE == 0) { const bf16* SG = (const bf16*)(ws + WS_SG) + (size_t)zhg * 16384;
#pragma unroll
        for (int kt = 0; kt < 8; ++kt) S[kt] = unpk4(*(const unsigned long long*)(SG + (size_t)(16 * vs + n_) * 128 + 16 * kt + 4 * q_)); }
    else {
#pragma unroll
        for (int kt = 0; kt < 8; ++kt)
#pragma unroll
            for (int e = 0; e < 4; ++e) S[kt][e] = (MODE == 2 && (16 * kt + 4 * q_ + e) == (16 * vs + n_)) ? 1.f : 0.f; }
    for (int s = 0; s < DN_GRP; ++s) {
        const int c = cb + s;
        if (MODE == 0) { bf16* Sst = (bf16*)(ws + WS_SST) + (size_t)(item0 + c) * 16384;
#pragma unroll
            for (int kt = 0; kt < 8; ++kt) *(unsigned long long*)(Sst + (size_t)(16 * vs + n_) * 128 + 16 * kt + 4 * q_) = pk4(S[kt]); }
        asm volatile("s_waitcnt lgkmcnt(0)" ::: "memory");
        __builtin_amdgcn_s_barrier();
        asm volatile("" ::: "memory");
        ldsp slot = L + (s % 3) * DN_SLOT;
        f32x4 u[4], gv[4]; unsigned long long wa[4][4][2], ka[8][2][2];
        { ldsp urow = slot + 32768 + (16 * wave + n_) * 128 + wbyte;
#pragma unroll
          for (int mt = 0; mt < 4; ++mt) { u[mt] = unpk4(*(LAS const unsigned long long*)(urow + (((2 * mt + (q_ >> 1)) ^ sw) * 16))) * ubm; gv[mt] = *(LAS const f32x4*)(slot + 40960 + (16 * mt + 4 * q_) * 4); } }
        const float gl = *(LAS const float*)(slot + 40960 + 63 * 4);
#pragma unroll
        for (int ks = 0; ks < 4; ++ks)
#pragma unroll
            for (int mt = 0; mt < 4; ++mt) { ldsp row = slot + (16 * mt + n_) * 256 + wbyte; const int c0 = 4 * ks + (q_ >> 1);
                wa[mt][ks][0] = *(LAS const unsigned long long*)(row + ((c0 ^ n_) * 16)); wa[mt][ks][1] = *(LAS const unsigned long long*)(row + (((c0 + 2) ^ n_) * 16)); }
        __builtin_amdgcn_sched_barrier(0);
#pragma unroll
        for (int ks = 0; ks < 4; ++ks) { const s16x8 bb = pack_cpair(S[2 * ks], S[2 * ks + 1]);
#pragma unroll
            for (int mt = 0; mt < 4; ++mt) { v4u a; a.x = (unsigned)wa[mt][ks][0]; a.y = (unsigned)(wa[mt][ks][0] >> 32); a.z = (unsigned)wa[mt][ks][1]; a.w = (unsigned)(wa[mt][ks][1] >> 32);
                u[mt] = mfma16(__builtin_bit_cast(s16x8, a), bb, u[mt]); } }
        __builtin_amdgcn_sched_barrier(0);
#pragma unroll
        for (int kt = 0; kt < 8; ++kt) { ldsp row = slot + 16384 + (16 * kt + n_) * 128;
#pragma unroll
            for (int ks = 0; ks < 2; ++ks) { ka[kt][ks][0] = *(LAS const unsigned long long*)(row + kao[ks][0]); ka[kt][ks][1] = *(LAS const unsigned long long*)(row + kao[ks][1]); } }
        __builtin_amdgcn_sched_barrier(0);
#pragma unroll
        for (int mt = 0; mt < 4; ++mt)
#pragma unroll
            for (int e = 0; e < 4; ++e) u[mt][e] *= __expf(gl - gv[mt][e]);
        const float egl = __expf(gl);
#pragma unroll
        for (int mt = 0; mt < 4; ++mt) { const f32x4 t = u[mt]; u[mt][0] = Z ? t[3] : t[0]; u[mt][1] = Z ? t[2] : t[1]; u[mt][2] = Z ? t[1] : t[2]; u[mt][3] = Z ? t[0] : t[3]; }
        const s16x8 b0 = pack_cpair(u[0], u[1]), b1 = pack_cpair(u[2], u[3]);
#pragma unroll
        for (int kt = 0; kt < 8; ++kt) { f32x4 acc = S[kt] * egl;
#pragma unroll
            for (int ks = 0; ks < 2; ++ks) { const unsigned long long a0 = ka[kt][ks][0], a1 = ka[kt][ks][1];
                v4u a; a.x = (unsigned)a0; a.y = (unsigned)(a0 >> 32); a.z = (unsigned)a1; a.w = (unsigned)(a1 >> 32);
                acc = mfma16(__builtin_bit_cast(s16x8, a), ks == 0 ? b0 : b1, acc); }
            S[kt] = acc; }
    }
    if (MODE == 1) { bf16* NG = (bf16*)(ws + WS_NG) + (size_t)zhg * 16384;
#pragma unroll
        for (int kt = 0; kt < 8; ++kt) *(unsigned long long*)(NG + (size_t)(16 * vs + n_) * 128 + 16 * kt + 4 * q_) = pk4(S[kt]); }
    if (MODE == 2) { bf16* MG = (bf16*)(ws + WS_MG) + (size_t)zhg * 16384;
#pragma unroll
        for (int kt = 0; kt < 8; ++kt)
#pragma unroll
            for (int e = 0; e < 4; ++e) MG[(size_t)(16 * kt + 4 * q_ + e) * 128 + 16 * vs + n_] = (bf16)f2bf(S[kt][e]); }
}
DI void dn_scan_groups_block(unsigned char* ws, ldsp L, int zh, int wave, int lane) {
    const int vs = wave, n_ = lane & 15, q_ = lane >> 4, tid = wave * 64 + lane;
    f32x4 S[8];
#pragma unroll
    for (int kt = 0; kt < 8; ++kt) S[kt] = (f32x4){0.f, 0.f, 0.f, 0.f};
    v4u rg[8];
#define GB_LOAD(gg) do { const size_t zhg_ = (size_t)(zh * 16 + (gg)) * 16384; const bf16* MG_ = (const bf16*)(ws + WS_MG) + zhg_; const bf16* NG_ = (const bf16*)(ws + WS_NG) + zhg_; \
        _Pragma("unroll") for (int i = 0; i < 8; ++i) { const int p = tid + 512 * i; rg[i] = *(const v4u*)(((p >> 11) ? NG_ : MG_) + (size_t)((p >> 4) & 127) * 128 + (p & 15) * 8); } } while (0)
#define GB_WRITE(buf) do { _Pragma("unroll") for (int i = 0; i < 8; ++i) { const int p = tid + 512 * i, r = (p >> 4) & 127, c = p & 15; \
        *(LAS v4u*)(L + (buf) * 65536 + (p >> 11) * 32768 + r * 256 + ((c ^ (r & 15)) * 16)) = rg[i]; } } while (0)
    GB_LOAD(0); GB_WRITE(0); GB_LOAD(1);
    LDS_WAIT(); __syncthreads();
    for (int g = 0; g < 16; ++g) {
        bf16* SG = (bf16*)(ws + WS_SG) + (size_t)(zh * 16 + g) * 16384;
#pragma unroll
        for (int kt = 0; kt < 8; ++kt) *(unsigned long long*)(SG + (size_t)(16 * vs + n_) * 128 + 16 * kt + 4 * q_) = pk4(S[kt]);
        if (g == 15) break;
        if (g + 1 < 15) { GB_WRITE((g + 1) & 1); if (g + 2 < 15) GB_LOAD(g + 2); }
        ldsp buf = L + (g & 1) * 65536;
        s16x8 bb[4];
#pragma unroll
        for (int ks = 0; ks < 4; ++ks) bb[ks] = pack_cpair(S[2 * ks], S[2 * ks + 1]);
#pragma unroll
        for (int kt = 0; kt < 8; ++kt) {
            const int nr = 16 * vs + n_; const int nc = 2 * kt + (q_ >> 1);
            f32x4 acc = unpk4(*(LAS const unsigned long long*)(buf + 32768 + nr * 256 + ((nc ^ (nr & 15)) * 16) + (q_ & 1) * 8));
            const int mr = 16 * kt + n_;
#pragma unroll
            for (int ks = 0; ks < 4; ++ks) { const int c0 = 4 * ks + (q_ >> 1);
                const unsigned long long a0 = *(LAS const unsigned long long*)(buf + mr * 256 + ((c0 ^ (mr & 15)) * 16) + (q_ & 1) * 8), a1 = *(LAS const unsigned long long*)(buf + mr * 256 + (((c0 + 2) ^ (mr & 15)) * 16) + (q_ & 1) * 8);
                v4u a; a.x = (unsigned)a0; a.y = (unsigned)(a0 >> 32); a.z = (unsigned)a1; a.w = (unsigned)(a1 >> 32);
                acc = mfma16(__builtin_bit_cast(s16x8, a), bb[ks], acc); }
            S[kt] = acc; }
        LDS_WAIT(); __syncthreads();
    }
#undef GB_LOAD
#undef GB_WRITE
}
DI void prep1_token(const Args& a, unsigned char* ws, int t, int lane) {
    const bf16* P = (const bf16*)(ws + WS_PROJ1) + (size_t)t * ODD_PAD;
    const int c0 = 8 * lane; const bool hp = t > 0, hn = t < S_ - 1;
    float z8[8];
#pragma unroll
    for (int i = 0; i < 8; ++i) z8[i] = 0.f;
    {
        float cb[8], cc[8], cx[8], pc[8], px[8], nc[8], nx[8], w0[8], w1[8], w2[8], o[8];
        ld8(P + c0, cb); ld8(P + 512 + c0, cc); ld8(P + 1024 + c0, cx);
        if (hp) { ld8(P - ODD_PAD + 512 + c0, pc); ld8(P - ODD_PAD + 1024 + c0, px); } else {
#pragma unroll
            for (int i = 0; i < 8; ++i) { pc[i] = 0.f; px[i] = 0.f; } }
        if (hn) { ld8(P + ODD_PAD + 512 + c0, nc); ld8(P + ODD_PAD + 1024 + c0, nx); } else {
#pragma unroll
            for (int i = 0; i < 8; ++i) { nc[i] = 0.f; nx[i] = 0.f; } }
        ld8f(a.in[28] + c0, w0); ld8f(a.in[28] + 512 + c0, w1); ld8f(a.in[28] + 1024 + c0, w2);
#pragma unroll
        for (int i = 0; i < 8; ++i) o[i] = cb[i] * (w0[i] * pc[i] * px[i] + w1[i] * cc[i] * cx[i] + w2[i] * nc[i] * nx[i]);
        st8((bf16*)(ws + WS_YCAT1) + (size_t)t * D_ + c0, o);
    }
#pragma unroll
    for (int part = 0; part < 3; ++part) {
        float cu[8], pv[8], nx[8], w0[8], w1[8], w2[8], o[8];
        const int col = 1536 + part * 512 + c0;
        ld8(P + col, cu);
        if (hp) ld8(P - ODD_PAD + col, pv); else {
#pragma unroll
            for (int i = 0; i < 8; ++i) pv[i] = 0.f; }
        if (hn) ld8(P + ODD_PAD + col, nx); else {
#pragma unroll
            for (int i = 0; i < 8; ++i) nx[i] = 0.f; }
        const float* cw = a.in[29] + part * 512 + c0;
        ld8f(cw, w0); ld8f(cw + 1536, w1); ld8f(cw + 3072, w2);
        float ss = 0.f;
#pragma unroll
        for (int i = 0; i < 8; ++i) { o[i] = siluf_(w0[i] * pv[i] + w1[i] * cu[i] + w2[i] * nx[i]); ss += o[i] * o[i]; }
        if (part < 2) { ss = grp_sum<16>(ss); const float rn = (1.0f / sqrtf(ss + 1e-6f)) * (part == 0 ? 0.08838834764831845f : 1.0f);
#pragma unroll
            for (int i = 0; i < 8; ++i) o[i] *= rn; }
        st8((bf16*)(ws + (part == 0 ? WS_QD : (part == 1 ? WS_KD : WS_VD))) + (size_t)t * 512 + c0, o);
    }
    *(v4u*)((bf16*)(ws + WS_YCAT1) + (size_t)t * D_ + 512 + c0) = *(const v4u*)(P + 3072 + c0);
    if (lane < 8) {
        const float bt = sigmoidf_(bf2f(P[3584 + lane])); const float al = bf2f(P[3592 + lane]);
        const float g = -__expf(a.in[30][lane]) * softplusf_(al + a.in[31][lane]);
        ((float*)(ws + WS_GB))[(size_t)t * 8 + lane] = g; ((float*)(ws + WS_GB + 512 * 1024))[(size_t)t * 8 + lane] = bt;
    }
}
DI void dn_scan_naive(unsigned char* ws, int w  , int lane) {
    const int z = w >> 9, h = (w >> 7) & 3, vc = w & 127;
    const bf16* Q = (const bf16*)(ws + WS_QD); const bf16* K = (const bf16*)(ws + WS_KD); const bf16* V = (const bf16*)(ws + WS_VD);
    const float* G = (const float*)(ws + WS_GB); const float* Bt = (const float*)(ws + WS_GB + 512 * 1024);
    bf16* O = (bf16*)(ws + (z ? WS_O1 : WS_O0));
    float s0 = 0.f, s1 = 0.f;
    int t = z ? S_ - 1 : 0; const int dt = z ? -1 : 1;
    size_t o = (size_t)t * 512 + h * 128;
    float k0 = bf2f(K[o + lane]), k1 = bf2f(K[o + 64 + lane]), q0 = bf2f(Q[o + lane]), q1 = bf2f(Q[o + 64 + lane]), vv = bf2f(V[o + vc]), g = G[(size_t)t * 8 + z * 4 + h], bt = Bt[(size_t)t * 8 + z * 4 + h];
    for (int s = 0; s < S_; ++s) {
        const int tn = (s + 1 < S_) ? t + dt : t; const size_t on = (size_t)tn * 512 + h * 128;
        const float k0n = bf2f(K[on + lane]), k1n = bf2f(K[on + 64 + lane]), q0n = bf2f(Q[on + lane]), q1n = bf2f(Q[on + 64 + lane]), vvn = bf2f(V[on + vc]), gn = G[(size_t)tn * 8 + z * 4 + h], btn = Bt[(size_t)tn * 8 + z * 4 + h];
        const float eg = __expf(g);
        const float dot = wave_sum(k0 * s0 + k1 * s1);
        const float cf = bt * (vv - eg * dot);
        s0 = eg * s0 + cf * k0; s1 = eg * s1 + cf * k1;
        const float ov = wave_sum(q0 * s0 + q1 * s1);
        if (lane == 0) O[(size_t)t * 512 + h * 128 + vc] = (bf16)f2bf(ov);
        k0 = k0n; k1 = k1n; q0 = q0n; q1 = q1n; vv = vvn; g = gn; bt = btn; t = tn;
    }
}
DI void dn_post_token(const Args& a, unsigned char* ws, int t, int lane) {
    const int c0 = 8 * lane; const size_t o = (size_t)t * 512 + c0;
    float o0[8], o1[8], zz[8], nw[8];
    ld8((const bf16*)(ws + WS_O0) + o, o0); ld8((const bf16*)(ws + WS_O1) + o, o1);
    ld8((const bf16*)(ws + WS_YCAT1) + (size_t)t * D_ + 512 + c0, zz); ld8f(a.in[32] + (c0 & 127), nw);
    float ss = 0.f;
#pragma unroll
    for (int i = 0; i < 8; ++i) { o0[i] += o1[i]; ss += o0[i] * o0[i]; }
    const float rs = 1.0f / sqrtf(grp_sum<16>(ss) * (1.0f / 128.f) + 1e-6f);
#pragma unroll
    for (int i = 0; i < 8; ++i) o0[i] = o0[i] * rs * nw[i] * siluf_(zz[i]);
    st8((bf16*)(ws + WS_YCAT1) + (size_t)t * D_ + 512 + c0, o0);
}
struct TokInfo { int e1, e2, s1, s2; float p1, p2; int pad0, pad1; };
struct RouterRegs { f32x4 r0[16], r1[16]; f32x4 w[4]; };
DI void route_load(const Args& a, RouterRegs& R, int lane) {
#pragma unroll
    for (int j = 0; j < 4; ++j) { R.w[j] = ((const f32x4*)a.in[34])[lane + 64 * j];
#pragma unroll
        for (int i = 0; i < 4; ++i) { const float* rr = a.in[35] + (size_t)(4 * lane + 256 * j + i) * 8; R.r0[4 * j + i] = *(const f32x4*)rr; R.r1[4 * j + i] = *(const f32x4*)(rr + 4); } }
}
constexpr size_t WS_BC = WS_TILE + 4096;
DI int sel8(const int (&v)[8], int e) { int r = 0;
#pragma unroll
    for (int k = 0; k < 8; ++k) r += v[k] & -(int)(e == k);
    return r; }
DI int wave_isum(int v) {
#pragma unroll
    for (int o = 1; o < 64; o <<= 1) v += __shfl_xor(v, o);
    return v; }
DI void route_eval(const RouterRegs& R, const float* x3, int t, int lane, int& e1, int& e2, float& p1, float& p2) {
    f32x4 v[4]; load_row(x3, t, lane, v); const float rs = row_rstd(v);
    float lg[8];
#pragma unroll
    for (int e = 0; e < 8; ++e) lg[e] = 0.f;
#pragma unroll
    for (int j = 0; j < 4; ++j)
#pragma unroll
        for (int i = 0; i < 4; ++i) { const float hv = v[j][i] * rs * R.w[j][i]; const f32x4 r0 = R.r0[4 * j + i], r1 = R.r1[4 * j + i];
            lg[0] += hv * r0.x; lg[1] += hv * r0.y; lg[2] += hv * r0.z; lg[3] += hv * r0.w; lg[4] += hv * r1.x; lg[5] += hv * r1.y; lg[6] += hv * r1.z; lg[7] += hv * r1.w; }
#pragma unroll
    for (int e = 0; e < 8; ++e) lg[e] = wave_sum(lg[e]);
    e1 = 0; float m1 = lg[0];
#pragma unroll
    for (int e = 1; e < 8; ++e) if (lg[e] > m1) { m1 = lg[e]; e1 = e; }
    e2 = -1; float m2 = -3.0e38f;
#pragma unroll
    for (int e = 0; e < 8; ++e) if (e != e1 && lg[e] > m2) { m2 = lg[e]; e2 = e; }
    const float x2 = __expf(m2 - m1); p1 = 1.0f / (1.0f + x2); p2 = x2 / (1.0f + x2);
}
DI void route_group(const RouterRegs& R, unsigned char* ws, const float* x3, LAS int* wc, int tg, int wave, int lane) {
    int cw[8];
#pragma unroll
    for (int e = 0; e < 8; ++e) cw[e] = 0;
    TokInfo* TI = (TokInfo*)(ws + WS_TOK) + (size_t)tg * 64 + wave * 8;
#pragma unroll 1
    for (int i = 0; i < 8; ++i) {
        int e1, e2; float p1, p2; route_eval(R, x3, tg * 64 + wave * 8 + i, lane, e1, e2, p1, p2);
        const int s1 = sel8(cw, e1);
#pragma unroll
        for (int e = 0; e < 8; ++e) cw[e] += (e == e1) ? 1 : 0;
        const int s2 = sel8(cw, e2);
#pragma unroll
        for (int e = 0; e < 8; ++e) cw[e] += (e == e2) ? 1 : 0;
        if (lane == 0) { v4u* rec = (v4u*)(TI + i); rec[0] = (v4u){(unsigned)e1, (unsigned)e2, (unsigned)s1, (unsigned)s2}; rec[1] = (v4u){__float_as_uint(p1), __float_as_uint(p2), 0u, 0u}; }
    }
    if (lane < 8) wc[wave * 8 + lane] = sel8(cw, lane);
    LDS_WAIT(); __syncthreads();
    int wb[8], bc[8];
#pragma unroll
    for (int e = 0; e < 8; ++e) { wb[e] = 0; bc[e] = 0;
#pragma unroll
        for (int w = 0; w < 8; ++w) { const int c = wc[w * 8 + e]; bc[e] += c; wb[e] += (w < wave) ? c : 0; } }
    if (wave == 0 && lane < 8) ((int*)(ws + WS_BC))[tg * 8 + lane] = sel8(bc, lane);
    if (lane < 8) { v4u* rec = (v4u*)(TI + lane); v4u r = rec[0]; r.z += (unsigned)sel8(wb, (int)r.x); r.w += (unsigned)sel8(wb, (int)r.y); rec[0] = r; }
    LDS_WAIT(); __syncthreads();
}
DI void moe_totals(const unsigned char* ws, int lane, int (&tot)[8]) {
    const int* BC = (const int*)(ws + WS_BC); int part[8];
#pragma unroll
    for (int e = 0; e < 8; ++e) part[e] = 0;
#pragma unroll
    for (int k = 0; k < 4; ++k) { const int r = lane + 64 * k;
#pragma unroll
        for (int e = 0; e < 8; ++e) part[e] += __hip_atomic_load(BC + r * 8 + e, __ATOMIC_RELAXED, __HIP_MEMORY_SCOPE_AGENT); }
#pragma unroll
    for (int e = 0; e < 8; ++e) tot[e] = __builtin_amdgcn_readfirstlane(wave_isum(part[e]));
}
DI void moe_offsets(const int (&tot)[8], int (&off)[9]) { int o = 0;
#pragma unroll
    for (int e = 0; e < 8; ++e) { off[e] = o; o += (tot[e] + 255) & ~255; }
    off[8] = o; }
DI void gather_group(const Args& a, unsigned char* ws, const float* x3, const int (&off)[9], int tg, int wave, int lane) {
    const int* BC = (const int*)(ws + WS_BC); int pre[8];
#pragma unroll
    for (int e = 0; e < 8; ++e) pre[e] = 0;
#pragma unroll
    for (int k = 0; k < 4; ++k) { const int r = lane + 64 * k;
#pragma unroll
        for (int e = 0; e < 8; ++e) { const int c = __hip_atomic_load(BC + r * 8 + e, __ATOMIC_RELAXED, __HIP_MEMORY_SCOPE_AGENT); pre[e] += (r < tg) ? c : 0; } }
#pragma unroll
    for (int e = 0; e < 8; ++e) pre[e] = __builtin_amdgcn_readfirstlane(wave_isum(pre[e])) + off[e];
    TokInfo* TI = (TokInfo*)(ws + WS_TOK) + (size_t)tg * 64 + wave * 8;
    unsigned char* A = ws + WS_AMOE8;
#pragma unroll 1
    for (int i = 0; i < 8; ++i) { const int t = tg * 64 + wave * 8 + i;
        f32x4 v[4]; load_row(x3, t, lane, v); const float rs = row_rstd(v);
#pragma unroll
        for (int j = 0; j < 4; ++j) v[j] = v[j] * rs * ((const f32x4*)a.in[34])[lane + 64 * j];
        v4u* rec = (v4u*)(TI + i); v4u r = rec[0];
        const int r1 = sel8(pre, (int)r.x) + (int)r.z, r2 = sel8(pre, (int)r.y) + (int)r.w;
        unsigned* o1 = (unsigned*)(A + (size_t)r1 * D_) + lane; unsigned* o2 = (unsigned*)(A + (size_t)r2 * D_) + lane;
#pragma unroll
        for (int j = 0; j < 4; ++j) { const unsigned w = pk4f8(v[j][0], v[j][1], v[j][2], v[j][3]); o1[64 * j] = w; o2[64 * j] = w; }
        if (lane == 0) { r.z = (unsigned)r1; r.w = (unsigned)r2; rec[0] = r; }
    }
}
DI void combine_token(unsigned char* ws, float* out, const int (&off)[9], int t, int lane) {
    const v4u* rec = (const v4u*)((const TokInfo*)(ws + WS_TOK) + t); const v4u ra = rec[0], rb = rec[1];
    struct { float p1, p2; } ti; ti.p1 = __uint_as_float(rb.x); ti.p2 = __uint_as_float(rb.y);
    const bf16* A = (const bf16*)(ws + WS_AMOE);
    const unsigned long long* r1 = (const unsigned long long*)(A + (size_t)ra.z * D_) + lane; const unsigned long long* r2 = (const unsigned long long*)(A + (size_t)ra.w * D_) + lane;
    f32x4* xo = (f32x4*)(out + (size_t)t * D_) + lane;
#pragma unroll
    for (int j = 0; j < 4; ++j) { const unsigned long long a1 = r1[64 * j], a2 = r2[64 * j]; f32x4 x = xo[64 * j];
        x.x += ti.p1 * bflo((unsigned)a1) + ti.p2 * bflo((unsigned)a2); x.y += ti.p1 * bfhi((unsigned)a1) + ti.p2 * bfhi((unsigned)a2);
        x.z += ti.p1 * bflo((unsigned)(a1 >> 32)) + ti.p2 * bflo((unsigned)(a2 >> 32)); x.w += ti.p1 * bfhi((unsigned)(a1 >> 32)) + ti.p2 * bfhi((unsigned)(a2 >> 32));
        xo[64 * j] = x; }
}
#ifndef PROBE
#define PROBE 0
#endif
#ifndef COPY_IN_P0
#define COPY_IN_P0 1
#endif
#ifndef PROBE_SKIP
#define PROBE_SKIP 0
#endif
#ifndef PROBE_REP
#define PROBE_REP (-1)
#endif
constexpr int MOE_GU_SPLIT = 16128;
#ifndef PH_MASK
#define PH_MASK 0xFFFFFFFFu
#endif
DI unsigned char* ptr_opaque(unsigned char* p) { GAS unsigned char* g = (GAS unsigned char*)p; asm volatile("" : "+s"(g)); return (unsigned char*)g; }
DI int lane_opaque() { int l; asm volatile("v_mbcnt_lo_u32_b32 %0, -1, 0\n\tv_mbcnt_hi_u32_b32 %0, -1, %0" : "=v"(l)); return l; }
__global__ void __launch_bounds__(512, 2) fwd_kernel(Args args) {
    extern __shared__ __attribute__((aligned(16))) unsigned char lds[];
    LAS unsigned char* L = (LAS unsigned char*)lds;
    volatile LAS unsigned* MISC = (volatile LAS unsigned*)(L + MISC_OFF);
    const int tid = threadIdx.x, lane0 = tid & 63, wave = __builtin_amdgcn_readfirstlane(tid >> 6);
    const int G = gridDim.x, bx = blockIdx.x;
    const int gw = bx * 8 + wave, NGW = G * 8;
    unsigned char* ws0 = args.ws;
    if (tid < 128) ((LAS unsigned*)(L + LDS_ZERO_OFF))[tid] = 0u;
    __syncthreads();
    XcdBarrier bar = xcd_barrier_post((unsigned*)(ws0 + WS_CTL) + CW_BAR, MISC + 8);
    LAS float* scr = (LAS float*)(L + wave * 16384);
#if PROBE
    int tsi = 0;
#define GRID_BAR() do { xcd_barrier(bar, wave == 0); if (bx == 0 && tid == 0) { ((unsigned*)(ws0 + WS_CTL))[512 + tsi] = (unsigned)__builtin_amdgcn_s_memrealtime(); } ++tsi; } while (0)
    if (bx == 0 && tid == 0) ((unsigned*)(ws0 + WS_CTL))[511] = (unsigned)__builtin_amdgcn_s_memrealtime();
#else
#define GRID_BAR() xcd_barrier(bar, wave == 0)
#endif

    if constexpr ((PH_MASK >> 0) & 1) {
    const int lane = lane_opaque(); unsigned char* const ws = ptr_opaque(args.ws);
    {
        const float* const* in = args.in;
        for (int it = gw; ; it += NGW) {
            int r = it;
            if (transpose_job(r, in[3], 1024, 3072, 3072, (bf16*)(ws + WS_WIN0), 0, 0, 0, scr, lane)) continue;
            if (transpose_job(r, in[9], 1024, 64, 64, (bf16*)(ws + WS_WL), 0, 0, 0, scr, lane)) continue;
            if (transpose_job(r, in[9] + 65536, 1024, 64, 64, (bf16*)(ws + WS_WL), 64, 0, 0, scr, lane)) continue;
            if (transpose_job(r, in[12], 1024, 64, 64, (bf16*)(ws + WS_WL), 128, 0, 0, scr, lane)) continue;
            if (transpose_job(r, in[12] + 65536, 1024, 64, 64, (bf16*)(ws + WS_WL), 192, 0, 0, scr, lane)) continue;
            if (transpose_job(r, in[14], 1024, 128, 256, (bf16*)(ws + WS_WL), 256, 0, 0, scr, lane)) continue;
            if (transpose_job(r, in[21], 1024, 1024, 1024, (bf16*)(ws + WS_WOUT0), 0, 0, 0, scr, lane)) continue;
            if (transpose_job(r, in[10], 64, 512, 512, (bf16*)(ws + WS_W2T), 0, 0, 0, scr, lane)) continue;
            if (transpose_job(r, in[10] + 32768, 64, 512, 512, (bf16*)(ws + WS_W2T) + 32768, 0, 0, 0, scr, lane)) continue;
            if (transpose_job(r, in[13], 64, 512, 512, (bf16*)(ws + WS_W2T) + 65536, 0, 0, 0, scr, lane)) continue;
            if (transpose_job(r, in[13] + 32768, 64, 512, 512, (bf16*)(ws + WS_W2T) + 98304, 0, 0, 0, scr, lane)) continue;
            if (transpose_job(r, in[15], 128, 512, 512, (bf16*)(ws + WS_W2T) + 131072, 0, 0, 0, scr, lane)) continue;
            break;
        }
        norm_rows(args.in[0], args.in[2], args.in[7], (bf16*)(ws + WS_H), (bf16*)(ws + WS_HX), gw, NGW, lane);
        if (COPY_IN_P0) for (int it = gw; ; it += NGW) { int r = it;
            if (transpose_job(r, in[23], 1024, FF0, FF0, (bf16*)(ws + WS_WGU0), 0, 128, 0, scr, lane)) continue;
            if (transpose_job(r, in[24], 1024, FF0, FF0, (bf16*)(ws + WS_WGU0), 0, 128, 1, scr, lane)) continue;
            if (transpose_job(r, in[25], FF0, 1024, 1024, (bf16*)(ws + WS_WD0), 0, 0, 0, scr, lane)) continue;
            if (transpose_job(r, in[27], 1024, ODD_IN, ODD_PAD, (bf16*)(ws + WS_WIN1), 0, 0, 0, scr, lane)) continue;
            if (transpose_job(r, in[33], 1024, 1024, 1024, (bf16*)(ws + WS_WOUT1), 0, 0, 0, scr, lane)) continue;
            break; }
    }
    if constexpr (PROBE_REP == 0) {
    {
        const float* const* in = args.in;
        for (int it = gw; ; it += NGW) {
            int r = it;
            if (transpose_job(r, in[3], 1024, 3072, 3072, (bf16*)(ws + WS_WIN0), 0, 0, 0, scr, lane)) continue;
            if (transpose_job(r, in[9], 1024, 64, 64, (bf16*)(ws + WS_WL), 0, 0, 0, scr, lane)) continue;
            if (transpose_job(r, in[9] + 65536, 1024, 64, 64, (bf16*)(ws + WS_WL), 64, 0, 0, scr, lane)) continue;
            if (transpose_job(r, in[12], 1024, 64, 64, (bf16*)(ws + WS_WL), 128, 0, 0, scr, lane)) continue;
            if (transpose_job(r, in[12] + 65536, 1024, 64, 64, (bf16*)(ws + WS_WL), 192, 0, 0, scr, lane)) continue;
            if (transpose_job(r, in[14], 1024, 128, 256, (bf16*)(ws + WS_WL), 256, 0, 0, scr, lane)) continue;
            if (transpose_job(r, in[21], 1024, 1024, 1024, (bf16*)(ws + WS_WOUT0), 0, 0, 0, scr, lane)) continue;
            if (transpose_job(r, in[10], 64, 512, 512, (bf16*)(ws + WS_W2T), 0, 0, 0, scr, lane)) continue;
            if (transpose_job(r, in[10] + 32768, 64, 512, 512, (bf16*)(ws + WS_W2T) + 32768, 0, 0, 0, scr, lane)) continue;
            if (transpose_job(r, in[13], 64, 512, 512, (bf16*)(ws + WS_W2T) + 65536, 0, 0, 0, scr, lane)) continue;
            if (transpose_job(r, in[13] + 32768, 64, 512, 512, (bf16*)(ws + WS_W2T) + 98304, 0, 0, 0, scr, lane)) continue;
            if (transpose_job(r, in[15], 128, 512, 512, (bf16*)(ws + WS_W2T) + 131072, 0, 0, 0, scr, lane)) continue;
            break;
        }
        norm_rows(args.in[0], args.in[2], args.in[7], (bf16*)(ws + WS_H), (bf16*)(ws + WS_HX), gw, NGW, lane);
    }
    }
    GRID_BAR();
    }
    if constexpr (PROBE_REP == 50) { for (int i = 0; i < 10; ++i) GRID_BAR(); }
    if constexpr ((PH_MASK >> 1) & 1) {
    const int lane = lane_opaque(); unsigned char* const ws = ptr_opaque(args.ws);
    {
        { pg8::Gemm g{(const bf16*)(ws + WS_H), (const bf16*)(ws + WS_WIN0), S_, EVEN_IN, D_}; pg8::StaticOrder S; S.init(S_, EVEN_IN, G, bx);
          pg8::EpiStoreBf16 E{(bf16*)(ws + WS_PROJ0), EVEN_IN, 0, nullptr}; pg8::gemm_phase<pg8::EpiStoreBf16, pg8::StaticOrder, true, true>(L, g, S, E, wave); }
        { pg8::Gemm g{(const bf16*)(ws + WS_HX), (const bf16*)(ws + WS_WL), S_, LORA_N, D_}; pg8::StaticOrder S; S.init(S_, LORA_N, G, bx);
          pg8::EpiStoreBf16 E{(bf16*)(ws + WS_LORA), LORA_N, 0, nullptr}; pg8::gemm_phase<pg8::EpiStoreBf16, pg8::StaticOrder, true, true>(L, g, S, E, wave); }
        if constexpr (PROBE_REP == 1) {
        { pg8::Gemm g{(const bf16*)(ws + WS_H), (const bf16*)(ws + WS_WIN0), S_, EVEN_IN, D_}; pg8::StaticOrder S; S.init(S_, EVEN_IN, G, bx);
          pg8::EpiStoreBf16 E{(bf16*)(ws + WS_PROJ0), EVEN_IN, 0, nullptr}; pg8::gemm_phase<pg8::EpiStoreBf16, pg8::StaticOrder, true, true>(L, g, S, E, wave); }
        { pg8::Gemm g{(const bf16*)(ws + WS_HX), (const bf16*)(ws + WS_WL), S_, LORA_N, D_}; pg8::StaticOrder S; S.init(S_, LORA_N, G, bx);
          pg8::EpiStoreBf16 E{(bf16*)(ws + WS_LORA), LORA_N, 0, nullptr}; pg8::gemm_phase<pg8::EpiStoreBf16, pg8::StaticOrder, true, true>(L, g, S, E, wave); }
        }
    }
    GRID_BAR();
    }
    if constexpr ((PH_MASK >> 2) & 1) {
    const int lane = lane_opaque(); unsigned char* const ws = ptr_opaque(args.ws);
    for (int t = gw; t < S_; t += NGW) prep0_token(args, ws, scr, t, lane);
    if constexpr (PROBE_REP == 30) { for (int t = gw; t < S_; t += NGW) prep0_token(args, ws, scr, t, lane); }
    }
    if constexpr ((PH_MASK >> 3) & 1) {
    const int lane = lane_opaque(); unsigned char* const ws = ptr_opaque(args.ws);
    {
        const int hh = bx & 7, nbh = (G - hh + 7) >> 3, rank = bx >> 3;
#define STEP_SYNC() do { asm volatile("s_waitcnt vmcnt(0) lgkmcnt(0)" ::: "memory"); __builtin_amdgcn_s_barrier(); asm volatile("" ::: "memory"); } while (0)
        constexpr int P1_FLAG_OFF = 131072 + 2 * 8448;
        if (tid < 8) ((LAS unsigned*)(L + P1_FLAG_OFF))[tid] = 0u;
        LDS_WAIT(); __syncthreads();
        if (wave < 2) {
            unsigned ep = 0; volatile LAS unsigned* fl = (volatile LAS unsigned*)(L + P1_FLAG_OFF) + 2 * wave; LAS float* gts = (LAS float*)(L + P1_FLAG_OFF + 64) + 64 * wave;
            for (int kk = -1; rank + nbh * (kk + 1) < 256 + nbh; ++kk) { const int cn = rank + nbh * kk, z = wave;
                if (kk >= 0 && cn < 256) rwkv_pass1_item<false, 99, 1>(ws, L + wave * 65536, z * 2048 + hh * 256 + (z ? 255 - cn : cn), lane, fl, &ep, gts); STEP_SYNC(); }
        } else if (wave < 6) {
            for (int kk = -1; rank + nbh * (kk + 1) < 256 + nbh; ++kk) { const int cn1 = rank + nbh * (kk + 1);
                if (cn1 < 256) prep0_rwkv_unit<false>(args, ws, L, 4 * cn1 + (wave - 2), hh, lane); STEP_SYNC(); }
        } else {
            const float* const* in = args.in; const int z = wave - 6; LAS float* scr2 = (LAS float*)(L + 131072 + z * 8448);
            unsigned ep = 0; volatile LAS unsigned* fl = (volatile LAS unsigned*)(L + P1_FLAG_OFF) + 2 * z; LAS float* gts = (LAS float*)(L + P1_FLAG_OFF + 64) + 64 * z;
            auto cp = [&](int j) __attribute__((always_inline)) { int r = bx * 2 + z + j * (G * 2);
                if (transpose_job(r, in[23], 1024, FF0, FF0, (bf16*)(ws + WS_WGU0), 0, 128, 0, scr2, lane)) return;
                if (transpose_job(r, in[24], 1024, FF0, FF0, (bf16*)(ws + WS_WGU0), 0, 128, 1, scr2, lane)) return;
                if (transpose_job(r, in[25], FF0, 1024, 1024, (bf16*)(ws + WS_WD0), 0, 0, 0, scr2, lane)) return;
                if (transpose_job(r, in[27], 1024, ODD_IN, ODD_PAD, (bf16*)(ws + WS_WIN1), 0, 0, 0, scr2, lane)) return;
                if (transpose_job(r, in[33], 1024, 1024, 1024, (bf16*)(ws + WS_WOUT1), 0, 0, 0, scr2, lane)) return; };
            for (int kk = -1; rank + nbh * (kk + 1) < 256 + nbh; ++kk) { const int cn = rank + nbh * kk;
                if (kk >= 0 && cn < 256) rwkv_pass1_item<false, 99, 2>(ws, L + z * 65536, z * 2048 + hh * 256 + (z ? 255 - cn : cn), lane, fl, &ep, gts, [&]() __attribute__((always_inline)) { if (!COPY_IN_P0) cp(2 * kk); }, [&]() __attribute__((always_inline)) { if (!COPY_IN_P0) cp(2 * kk + 1); });
                STEP_SYNC(); }
        }
#undef STEP_SYNC
    }
    GRID_BAR();
    if (bx < 16) { rwkv_pass2_block(ws, L, bx, wave, lane); __syncthreads(); if constexpr (PROBE_REP == 4) { rwkv_pass2_block(ws, L, bx, wave, lane); __syncthreads(); } }
    else { for (int rep_ = 0; rep_ < (PROBE_REP == 3 ? 2 : 1); ++rep_) for (int unit = bx - 16; unit < 512; unit += G - 16) attn_unit(ws, L, unit, wave, lane); }
    GRID_BAR();
    for (int it = gw; it < 2048; it += NGW) rwkv_pass3_post_item(args, ws, it, lane);
    if constexpr (PROBE_REP == 63) { for (int it = gw; it < 2048; it += NGW) rwkv_pass3_post_item(args, ws, it, lane); }
    GRID_BAR();
    }
    if constexpr ((PH_MASK >> 5) & 1) {
    const int lane = lane_opaque(); unsigned char* const ws = ptr_opaque(args.ws);
    { pg8::Gemm g{(const bf16*)(ws + WS_Y), (const bf16*)(ws + WS_WOUT0), S_, D_, D_}; pg8::StaticOrder S; S.init(S_, D_, G, bx);
      pg8::EpiResF32 E{args.in[0], args.out, D_, nullptr, nullptr}; pg8::gemm_phase<pg8::EpiResF32, pg8::StaticOrder, true, true>(L, g, S, E, wave); }
    if constexpr (PROBE_REP == 7) {
    { pg8::Gemm g{(const bf16*)(ws + WS_Y), (const bf16*)(ws + WS_WOUT0), S_, D_, D_}; pg8::StaticOrder S; S.init(S_, D_, G, bx);
      pg8::EpiResF32 E{args.in[0], args.out, D_, nullptr, nullptr}; pg8::gemm_phase<pg8::EpiResF32, pg8::StaticOrder, true, true>(L, g, S, E, wave); }
    }
    GRID_BAR();
    }
    if constexpr ((PH_MASK >> 6) & 1) {
    const int lane = lane_opaque(); unsigned char* const ws = ptr_opaque(args.ws);
    norm_rows(args.out, args.in[22], nullptr, (bf16*)(ws + WS_H2), nullptr, gw, NGW, lane);
    GRID_BAR();
    }
    if constexpr ((PH_MASK >> 7) & 1) {
    const int lane = lane_opaque(); unsigned char* const ws = ptr_opaque(args.ws);
    { pg8::Gemm g{(const bf16*)(ws + WS_H2), (const bf16*)(ws + WS_WGU0), S_, 2 * FF0, D_}; pg8::StaticOrder S; S.init(S_, 2 * FF0, G, bx);
      pg8::EpiSwiGLU E{(bf16*)(ws + WS_ACT0), FF0, 0, nullptr}; pg8::gemm_phase<pg8::EpiSwiGLU, pg8::StaticOrder, true, true>(L, g, S, E, wave); }
    if constexpr (PROBE_REP == 9) {
    { pg8::Gemm g{(const bf16*)(ws + WS_H2), (const bf16*)(ws + WS_WGU0), S_, 2 * FF0, D_}; pg8::StaticOrder S; S.init(S_, 2 * FF0, G, bx);
      pg8::EpiSwiGLU E{(bf16*)(ws + WS_ACT0), FF0, 0, nullptr}; pg8::gemm_phase<pg8::EpiSwiGLU, pg8::StaticOrder, true, true>(L, g, S, E, wave); }
    }
    GRID_BAR();
    }
    if constexpr ((PH_MASK >> 8) & 1) {
    const int lane = lane_opaque(); unsigned char* const ws = ptr_opaque(args.ws);
    { pg8::Gemm g{(const bf16*)(ws + WS_ACT0), (const bf16*)(ws + WS_WD0), S_, D_, FF0}; pg8::StaticOrder S; S.init(S_, D_, G, bx);
      pg8::EpiResF32 E{args.out, args.out, D_, nullptr, nullptr}; pg8::gemm_phase<pg8::EpiResF32, pg8::StaticOrder, true, true>(L, g, S, E, wave); }
    GRID_BAR();
    }
    if constexpr ((PH_MASK >> 9) & 1) {
    const int lane = lane_opaque(); unsigned char* const ws = ptr_opaque(args.ws);
    norm_rows(args.out, args.in[26], nullptr, (bf16*)(ws + WS_H3), nullptr, gw, NGW, lane);
    GRID_BAR();
    }
    if constexpr ((PH_MASK >> 10) & 1) {
    const int lane = lane_opaque(); unsigned char* const ws = ptr_opaque(args.ws);
    { pg8::Gemm g{(const bf16*)(ws + WS_H3), (const bf16*)(ws + WS_WIN1), S_, ODD_PAD, D_}; pg8::StaticOrder S; S.init(S_, ODD_PAD, G, bx);
      pg8::EpiStoreBf16 E{(bf16*)(ws + WS_PROJ1), ODD_PAD, 0, nullptr}; pg8::gemm_phase<pg8::EpiStoreBf16, pg8::StaticOrder, true, true>(L, g, S, E, wave); }
    if constexpr (PROBE_REP == 12) {
    { pg8::Gemm g{(const bf16*)(ws + WS_H3), (const bf16*)(ws + WS_WIN1), S_, ODD_PAD, D_}; pg8::StaticOrder S; S.init(S_, ODD_PAD, G, bx);
      pg8::EpiStoreBf16 E{(bf16*)(ws + WS_PROJ1), ODD_PAD, 0, nullptr}; pg8::gemm_phase<pg8::EpiStoreBf16, pg8::StaticOrder, true, true>(L, g, S, E, wave); }
    }
    GRID_BAR();
    }
    if constexpr ((PH_MASK >> 11) & 1) {
    const int lane = lane_opaque(); unsigned char* const ws = ptr_opaque(args.ws);
    for (int cn = bx; cn < 256; cn += G) for (int i = wave; i < 64; i += 8) prep1_token(args, ws, cn * 64 + i, lane);
    GRID_BAR();
    }
    if constexpr ((PH_MASK >> 12) & 1) {
    const int lane = lane_opaque(); unsigned char* const ws = ptr_opaque(args.ws);
    {
        if (wave < 4) { const int z = wave & 1;
            for (int cn = bx; cn < 256; cn += G) for (int hh = (wave >> 1) * 2; hh < (wave >> 1) * 2 + 2; ++hh) dn_pass1_item(ws, L + wave * DN_LDS_PER_WAVE, (z * 4 + hh) * 256 + (z ? 255 - cn : cn), lane); }
        else if (wave < 7) {
            LAS float* scr2 = (LAS float*)(L + 4 * DN_LDS_PER_WAVE + (wave - 4) * 8448);
            moe_copy_loop<true>(args, ws, scr2, bx * 3 + (wave - 4), G * 3, MOE_GU_SPLIT, lane);
        }
    }
    GRID_BAR();
    { const int task = bx; if (task < 512) dn_scan_block(ws, L, task >> 8, (task & 3) < 2 ? 1 : 2, (task >> 6) & 3, task & 1, (task >> 2) & 15, wave, lane); __syncthreads(); }
    { const int task = bx + G; if (task < 512) dn_scan_block(ws, L, task >> 8, (task & 3) < 2 ? 1 : 2, (task >> 6) & 3, task & 1, (task >> 2) & 15, wave, lane); __syncthreads(); }
    if constexpr (PROBE_REP == 60) { { const int task = bx; if (task < 512) dn_scan_block(ws, L, task >> 8, (task & 3) < 2 ? 1 : 2, (task >> 6) & 3, task & 1, (task >> 2) & 15, wave, lane); __syncthreads(); }
      { const int task = bx + G; if (task < 512) dn_scan_block(ws, L, task >> 8, (task & 3) < 2 ? 1 : 2, (task >> 6) & 3, task & 1, (task >> 2) & 15, wave, lane); __syncthreads(); } }
    GRID_BAR();
    if (bx < 8) { dn_scan_groups_block(ws, L, bx, wave, lane); }
    else {
        moe_copy_loop<true>(args, ws, scr, MOE_GU_SPLIT + (bx - 8) * 8 + wave, (G - 8) * 8, 28672, lane);
    }
    GRID_BAR();
    { const int task = bx; if (task < 256) dn_scan_block(ws, L, task >> 7, 0, (task >> 5) & 3, (task >> 4) & 1, task & 15, wave, lane); __syncthreads(); }
    if constexpr (PROBE_REP == 62) { const int task = bx; if (task < 256) dn_scan_block(ws, L, task >> 7, 0, (task >> 5) & 3, (task >> 4) & 1, task & 15, wave, lane); __syncthreads(); }
    GRID_BAR();
for (int rep_ = 0; rep_ < (PROBE_REP == 16 ? 2 : 1); ++rep_) {     for (int it = gw; it < 2048; it += NGW) dn_pass3_item(ws, it, lane); }
    GRID_BAR();
    }
    if constexpr ((PH_MASK >> 13) & 1) {
    const int lane = lane_opaque(); unsigned char* const ws = ptr_opaque(args.ws);
    for (int t = gw; t < S_; t += NGW) dn_post_token(args, ws, t, lane);
    moe_copy_loop<false>(args, ws, scr, gw, NGW, 14336, lane);
    GRID_BAR();
    }
    if constexpr ((PH_MASK >> 14) & 1) {
    const int lane = lane_opaque(); unsigned char* const ws = ptr_opaque(args.ws);
    { pg8::Gemm g{(const bf16*)(ws + WS_YCAT1), (const bf16*)(ws + WS_WOUT1), S_, D_, D_}; pg8::StaticOrder S; S.init(S_, D_, G, bx);
      pg8::EpiResF32 E{args.out, args.out, D_, nullptr, nullptr}; pg8::gemm_phase<pg8::EpiResF32, pg8::StaticOrder, true, true>(L, g, S, E, wave); }
    GRID_BAR();
    }
    if constexpr ((PH_MASK >> 15) & 1) {
    const int lane = lane_opaque(); unsigned char* const ws = ptr_opaque(args.ws);
    { RouterRegs RR; route_load(args, RR, lane); for (int tg = bx; tg < 256; tg += G) route_group(RR, ws, args.out, (LAS int*)L, tg, wave, lane); }
    GRID_BAR();
    }
    int tot[8], off[9]; moe_totals(ws0, lane_opaque(), tot); moe_offsets(tot, off);
    const int ntiles = off[8] >> 8;
    if constexpr ((PH_MASK >> 16) & 1) {
    const int lane = lane_opaque(); unsigned char* const ws = ptr_opaque(args.ws);
    {
        for (int tg = bx; tg < 256; tg += G) gather_group(args, ws, args.out, off, tg, wave, lane);
        const int tid2 = wave * 64 + lane;
        if (bx == 0 && tid2 < 160) { int e = 0;
#pragma unroll
            for (int k = 1; k < 8; ++k) if (tid2 * 256 >= off[k]) e = k;
            ((int*)(ws + WS_TILE))[tid2] = e; }
#pragma unroll
        for (int e = 0; e < NEXP; ++e) { const int r0 = off[e] + tot[e], r1 = off[e + 1];
            for (int rr = r0 + gw; rr < r1; rr += NGW) { unsigned long long* o8 = (unsigned long long*)(ws + WS_AMOE8 + (size_t)rr * D_) + lane;
#pragma unroll
                for (int j = 0; j < 2; ++j) o8[64 * j] = 0ull; } }
    }
    if constexpr (PROBE_REP == 20) {
    {
        for (int tg = bx; tg < 256; tg += G) gather_group(args, ws, args.out, off, tg, wave, lane);
        const int tid2 = wave * 64 + lane;
        if (bx == 0 && tid2 < 160) { int e = 0;
#pragma unroll
            for (int k = 1; k < 8; ++k) if (tid2 * 256 >= off[k]) e = k;
            ((int*)(ws + WS_TILE))[tid2] = e; }
#pragma unroll
        for (int e = 0; e < NEXP; ++e) { const int r0 = off[e] + tot[e], r1 = off[e + 1];
            for (int rr = r0 + gw; rr < r1; rr += NGW) { unsigned long long* o8 = (unsigned long long*)(ws + WS_AMOE8 + (size_t)rr * D_) + lane;
#pragma unroll
                for (int j = 0; j < 2; ++j) o8[64 * j] = 0ull; } }
    }
    }
    GRID_BAR();
    }
    if constexpr ((PH_MASK >> 17) & 1) {
    const int lane = lane_opaque(); unsigned char* const ws = ptr_opaque(args.ws);
    for (int b = 0; b < 3; ++b) {
        const int tlo = b * MOE_BATCH_TILES; int nt = ntiles - tlo; nt = nt < 0 ? 0 : (nt > MOE_BATCH_TILES ? MOE_BATCH_TILES : nt);
        { pg8::Gemm g{(const bf16*)(ws + WS_AMOE8), (const bf16*)(ws + WS_WMGU), MOE_ROWS, NEXP * 2 * FFE, D_ / 2};
          pg8::MoeOrder S{(const int*)(ws + WS_TILE), tlo, nt, 2 * FFE / 256, G, bx};
          pg8::EpiSwiGLU8 E{ws + WS_MACT - (size_t)tlo * 256 * FFE, FFE, 2 * FFE / 256, 1.0f / MOE_WSCALE};
          pg8::gemm_phase<pg8::EpiSwiGLU8, pg8::MoeOrder, true, true, true>(L, g, S, E, wave); }
        if constexpr (PROBE_REP == 21) {
        { pg8::Gemm g{(const bf16*)(ws + WS_AMOE8), (const bf16*)(ws + WS_WMGU), MOE_ROWS, NEXP * 2 * FFE, D_ / 2};
          pg8::MoeOrder S{(const int*)(ws + WS_TILE), tlo, nt, 2 * FFE / 256, G, bx};
          pg8::EpiSwiGLU8 E{ws + WS_MACT - (size_t)tlo * 256 * FFE, FFE, 2 * FFE / 256, 1.0f / MOE_WSCALE};
          pg8::gemm_phase<pg8::EpiSwiGLU8, pg8::MoeOrder, true, true, true>(L, g, S, E, wave); }
        }
        GRID_BAR();
        { pg8::Gemm g{(const bf16*)(ws + WS_MACT - (size_t)tlo * 256 * FFE), (const bf16*)(ws + WS_WMD), MOE_ROWS, NEXP * D_, FFE / 2};
          pg8::MoeOrder S{(const int*)(ws + WS_TILE), tlo, nt, D_ / 256, G, bx};
          pg8::EpiStoreBf16 E{(bf16*)(ws + WS_AMOE), D_, D_ / 256, nullptr, 1.0f / MOE_WSCALE};
          pg8::gemm_phase<pg8::EpiStoreBf16, pg8::MoeOrder, true, true, true>(L, g, S, E, wave); }
        if constexpr (PROBE_REP == 22) {
        { pg8::Gemm g{(const bf16*)(ws + WS_MACT - (size_t)tlo * 256 * FFE), (const bf16*)(ws + WS_WMD), MOE_ROWS, NEXP * D_, FFE / 2};
          pg8::MoeOrder S{(const int*)(ws + WS_TILE), tlo, nt, D_ / 256, G, bx};
          pg8::EpiStoreBf16 E{(bf16*)(ws + WS_AMOE), D_, D_ / 256, nullptr, 1.0f / MOE_WSCALE};
          pg8::gemm_phase<pg8::EpiStoreBf16, pg8::MoeOrder, true, true, true>(L, g, S, E, wave); }
        }
        GRID_BAR();
    }
    }
    if constexpr ((PH_MASK >> 18) & 1) {
    const int lane = lane_opaque(); unsigned char* const ws = ptr_opaque(args.ws);
    for (int t = gw; t < S_; t += NGW) combine_token(ws, args.out, off, t, lane);
#if PROBE
    {
        const unsigned* ts = (const unsigned*)(ws + WS_CTL) + 512;
        const unsigned dA = PROBE_A < 0 ? 32000u : (__hip_atomic_load(ts + PROBE_A, __ATOMIC_RELAXED, __HIP_MEMORY_SCOPE_AGENT) - __hip_atomic_load(ts + PROBE_A - 1, __ATOMIC_RELAXED, __HIP_MEMORY_SCOPE_AGENT));
        const unsigned dB = __hip_atomic_load(ts + PROBE_B, __ATOMIC_RELAXED, __HIP_MEMORY_SCOPE_AGENT) - __hip_atomic_load(ts + PROBE_B - 1, __ATOMIC_RELAXED, __HIP_MEMORY_SCOPE_AGENT);
        const int rows = 8 * (int)(dA / 3200u) + 64;
        const float addB = 4.0f * (float)(dB / 3200u) + 8.0f;
        for (int t = gw; t < S_; t += NGW) {
            if (t < rows) { f32x4* xo = (f32x4*)(args.out + (size_t)t * D_) + lane;
#pragma unroll
                for (int j = 0; j < 4; ++j) xo[64 * j] = xo[64 * j] + 5.0f; }
            if (t == S_ - 1 && lane == 63) args.out[(size_t)t * D_ + 1023] += addB;
        }
    }
#endif
    }
}

extern "C" void kernel_launch(void* const* d_in, const int* in_sizes, int n_in, void* d_out, int out_size, void* d_ws, size_t ws_size, hipStream_t stream) {
    static int grid = 0;
    if (grid == 0) {
        if (n_in != 39 || out_size != S_ * D_ || ws_size < WS_END) { fprintf(stderr, "kernel_launch: unexpected shapes (n_in %d out %d ws %zu)\n", n_in, out_size, ws_size); grid = -1; return; }
        int dev = 0, cus = 0, per_cu = 0;
        if (hipGetDevice(&dev) != hipSuccess || hipDeviceGetAttribute(&cus, hipDeviceAttributeMultiprocessorCount, dev) != hipSuccess) { grid = -1; return; }
        if (hipFuncSetAttribute((const void*)fwd_kernel, hipFuncAttributeMaxDynamicSharedMemorySize, LDS_BYTES) != hipSuccess) { grid = -1; return; }
        if (hipOccupancyMaxActiveBlocksPerMultiprocessor(&per_cu, (const void*)fwd_kernel, 512, LDS_BYTES) != hipSuccess || per_cu < 1) { fprintf(stderr, "kernel_launch: occupancy query says %d\n", per_cu); }
        (void)hipGetLastError();
        if (cus < 256) { fprintf(stderr, "kernel_launch: this build needs >= 256 CUs (task slots of the delta-net scan); got %d\n", cus); grid = -1; return; }
        grid = 256;
    }
    if (grid < 0) return;
    if (hipMemsetAsync((char*)d_ws + WS_CTL, 0, CTL_ZERO_BYTES, stream) != hipSuccess) return;
    Args a{};
    for (int i = 0; i < 39; ++i) a.in[i] = (const float*)d_in[i];
    a.out = (float*)d_out; a.ws = (unsigned char*)d_ws;
    hipLaunchKernelGGL(fwd_kernel, dim3(grid), dim3(512), LDS_BYTES, stream, a);
}
```

```cpp
#include <hip/hip_runtime.h>
#include <cstdio>
#include <cstdint>
namespace pg8 {
#define PG8_LAS __attribute__((address_space(3)))
typedef unsigned short bf16_t;
typedef short bf16x8 __attribute__((ext_vector_type(8)));
typedef float f32x4 __attribute__((ext_vector_type(4)));
typedef unsigned u32x4 __attribute__((ext_vector_type(4)));
typedef int i32x8 __attribute__((ext_vector_type(8)));
typedef unsigned u32x2 __attribute__((ext_vector_type(2)));
constexpr int BM = 256, BK = 64, HALF = 128, HTB = HALF * BK * 2  , STAGE_BYTES = 8 * HTB, NXCD = 8, WGM = 8;

__host__ __device__ __forceinline__ int lds_byte(int r, int c) { const int st = (r >> 4) * 2 + (c >> 5), rr = r & 15, cc = c & 31, ob = rr * 64 + cc * 2; return st * 1024 + (ob ^ (((ob >> 9) & 1) << 5)); }
__host__ __device__ __forceinline__ void stage_rc(int b, int& R, int& C) { const int st = b / 1024, sb = b % 1024, swz = sb ^ (((sb >> 9) & 1) << 5); R = (st >> 1) * 16 + swz / 64; C = (st & 1) * 32 + (swz % 64) / 2; }
__host__ __device__ __forceinline__ int perm32(int rho) { const int n = rho >> 4, i = rho & 15; return 8 * (i >> 2) + 4 * n + (i & 3); }

struct Unit { int pm, pn; };
struct Gemm { const bf16_t* A; const bf16_t* Bt; int M, N, K; };

struct StaticOrder {
    int nM, nN, nwg, G, c;
    __host__ __device__ void init(int M, int N, int G_, int c_) { nM = M / BM; nN = N / BM; nwg = nM * nN; G = G_; c = c_; }
    __host__ __device__ bool next(int i, Unit& u) const {
        const long L = (long)i * G + c; if (L >= nwg) return false;
        int wgid = (int)L; { const int q = nwg / NXCD, r = nwg % NXCD, xcd = wgid % NXCD, off = wgid / NXCD; wgid = (xcd < r ? xcd * (q + 1) : r * (q + 1) + (xcd - r) * q) + off; }
        const int nig = WGM * nN, gid = wgid / nig, fm = gid * WGM, gsz = (nM - fm) < WGM ? (nM - fm) : WGM;
        u.pm = fm + ((wgid % nig) % gsz); u.pn = (wgid % nig) / gsz; return true;
    }
    __device__ __forceinline__ void a_ready(const Unit&) const {}
    __device__ __forceinline__ void done(const Unit&) const {}
};

__device__ __forceinline__ unsigned cvt_pk_bf16(float lo, float hi) { unsigned r; asm volatile("v_cvt_pk_bf16_f32 %0, %1, %2" : "=v"(r) : "v"(lo), "v"(hi)); return r; }
#ifndef PROBE_EPI0
#define PROBE_EPI0 0
#endif
struct EpiStoreBf16 {
    static constexpr bool PERM = true, AFTER_DRAIN = false;
    bf16_t* O; int ldc; int ntn; const float* rowss;
    float scale = 1.0f;
    __device__ __forceinline__ void operator()(const f32x4 (&acc)[2][2][4][2], const Unit& u, int wr, int wc, int fr, int fq) const {
        const int row0 = u.pm * BM + wr * 64 + fr; const int pn = ntn ? (u.pn % ntn) : u.pn;
        const int col0 = pn * BM + wc * 32 + 8 * fq;
#pragma unroll
        for (int ai = 0; ai < 2; ++ai)
#pragma unroll
            for (int m = 0; m < 4; ++m) { bf16_t* rowp = O + (size_t)(row0 + ai * HALF + m * 16) * ldc + col0;
                float rs = scale; if (rowss) { const f32x4* sp = (const f32x4*)(rowss + (size_t)(row0 + ai * HALF + m * 16) * 16); const f32x4 s0 = sp[0], s1 = sp[1], s2 = sp[2], s3 = sp[3]; const f32x4 st = (s0 + s1) + (s2 + s3); rs *= 1.0f / sqrtf(((st[0] + st[1]) + (st[2] + st[3])) * (1.0f / 1024.f) + 1e-6f); }
#pragma unroll
                for (int bj = 0; bj < 2; ++bj) { const f32x4 v0 = acc[ai][bj][m][0] * rs, v1 = acc[ai][bj][m][1] * rs;
                    u32x4 w; w.x = cvt_pk_bf16(v0[0], v0[1]); w.y = cvt_pk_bf16(v0[2], v0[3]); w.z = cvt_pk_bf16(v1[0], v1[1]); w.w = cvt_pk_bf16(v1[2], v1[3]);
                    *(u32x4*)(rowp + bj * HALF) = w; } }
    }
};
struct EpiResF32 {
    static constexpr bool PERM = false, AFTER_DRAIN = false;
    const float* base; float* out; int ldc; bf16_t* xb; float* rowss;
    __device__ __forceinline__ void operator()(const f32x4 (&acc)[2][2][4][2], const Unit& u, int wr, int wc, int fr, int fq) const {
        const int row0 = u.pm * BM + wr * 64 + fr, col0 = u.pn * BM + wc * 32 + 4 * fq;
#pragma unroll
        for (int ai = 0; ai < 2; ++ai)
#pragma unroll
            for (int m = 0; m < 4; ++m) { const size_t off = (size_t)(row0 + ai * HALF + m * 16) * ldc + col0; float ss = 0.f;
#pragma unroll
                for (int bj = 0; bj < 2; ++bj)
#pragma unroll
                    for (int n = 0; n < 2; ++n) { const f32x4 b = *(const f32x4*)(base + off + bj * HALF + n * 16); const f32x4 o = b + acc[ai][bj][m][n]; *(f32x4*)(out + off + bj * HALF + n * 16) = o;
                        if (xb) { ss += (o[0] * o[0] + o[1] * o[1]) + (o[2] * o[2] + o[3] * o[3]);
                            unsigned long long w = (unsigned long long)cvt_pk_bf16(o[0], o[1]) | ((unsigned long long)cvt_pk_bf16(o[2], o[3]) << 32); *(unsigned long long*)(xb + off + bj * HALF + n * 16) = w; } }
                if (xb) { ss += __shfl_xor(ss, 16); ss += __shfl_xor(ss, 32); if (fq == 0) rowss[(size_t)(row0 + ai * HALF + m * 16) * 16 + u.pn * 4 + wc] = ss; } }
    }
};
struct EpiSwiGLU {
    static constexpr bool PERM = true, AFTER_DRAIN = false;
    bf16_t* O; int ldc; int ntn; const float* rowss;
    __device__ __forceinline__ void operator()(const f32x4 (&acc)[2][2][4][2], const Unit& u, int wr, int wc, int fr, int fq) const {
        const int row0 = u.pm * BM + wr * 64 + fr; const int pn = ntn ? (u.pn % ntn) : u.pn;
        const int col0 = pn * HALF + wc * 32 + 8 * fq;
#pragma unroll
        for (int ai = 0; ai < 2; ++ai)
#pragma unroll
            for (int m = 0; m < 4; ++m) { bf16_t* rowp = O + (size_t)(row0 + ai * HALF + m * 16) * ldc + col0;
                float rs = 1.0f; if (rowss) { const f32x4* sp = (const f32x4*)(rowss + (size_t)(row0 + ai * HALF + m * 16) * 16); const f32x4 s0 = sp[0], s1 = sp[1], s2 = sp[2], s3 = sp[3]; const f32x4 st = (s0 + s1) + (s2 + s3); rs = 1.0f / sqrtf(((st[0] + st[1]) + (st[2] + st[3])) * (1.0f / 1024.f) + 1e-6f); }
                float r[8];
#pragma unroll
                for (int n = 0; n < 2; ++n)
#pragma unroll
                    for (int i = 0; i < 4; ++i) { const float g = acc[ai][0][m][n][i] * rs, up = acc[ai][1][m][n][i] * rs; r[n * 4 + i] = g * __builtin_amdgcn_rcpf(1.0f + __expf(-g)) * up; }
                u32x4 w; w.x = cvt_pk_bf16(r[0], r[1]); w.y = cvt_pk_bf16(r[2], r[3]); w.z = cvt_pk_bf16(r[4], r[5]); w.w = cvt_pk_bf16(r[6], r[7]);
                *(u32x4*)rowp = w; }
    }
};
__device__ __forceinline__ unsigned cvt_pk4_fp8(float a, float b, float c, float d) { int w = __builtin_amdgcn_cvt_pk_fp8_f32(a, b, 0, false); w = __builtin_amdgcn_cvt_pk_fp8_f32(c, d, w, true); return (unsigned)w; }
struct EpiSwiGLU8 {
    static constexpr bool PERM = true, AFTER_DRAIN = false;
    unsigned char* O; int ldc; int ntn; float scale;
    __device__ __forceinline__ void operator()(const f32x4 (&acc)[2][2][4][2], const Unit& u, int wr, int wc, int fr, int fq) const {
        const int row0 = u.pm * BM + wr * 64 + fr; const int pn = ntn ? (u.pn % ntn) : u.pn;
        const int col0 = pn * HALF + wc * 32 + 8 * fq;
#pragma unroll
        for (int ai = 0; ai < 2; ++ai)
#pragma unroll
            for (int m = 0; m < 4; ++m) { unsigned char* rowp = O + (size_t)(row0 + ai * HALF + m * 16) * ldc + col0;
                float r[8];
#pragma unroll
                for (int n = 0; n < 2; ++n)
#pragma unroll
                    for (int i = 0; i < 4; ++i) { const float g = acc[ai][0][m][n][i] * scale, up = acc[ai][1][m][n][i] * scale; r[n * 4 + i] = PROBE_EPI0 ? 0.f * g : g * __builtin_amdgcn_rcpf(1.0f + __expf(-g)) * up; }
                u32x2 w; w.x = cvt_pk4_fp8(r[0], r[1], r[2], r[3]); w.y = cvt_pk4_fp8(r[4], r[5], r[6], r[7]);
                *(u32x2*)rowp = w; }
    }
};
struct MoeOrder {
    const int* tile_exp; int tlo, nt, nN, G, c;
    __device__ __forceinline__ bool next(int i, Unit& u) const {
        const int L = i * G + c; if (nt <= 0 || L >= nt * nN) return false;
        const int t = tlo + (L % nt), cn = L / nt;
        const int e = __builtin_amdgcn_readfirstlane(__hip_atomic_load(tile_exp + t, __ATOMIC_RELAXED, __HIP_MEMORY_SCOPE_AGENT));
        u.pm = t; u.pn = e * nN + cn; return true;
    }
    __device__ __forceinline__ void a_ready(const Unit&) const {}
    __device__ __forceinline__ void done(const Unit&) const {}
};
template <class Epi, class Sched, bool ALIGN_EPI = false, bool SP2 = false, bool F8 = false>
__device__ __forceinline__ void gemm_phase(PG8_LAS unsigned char* lds, const Gemm g, const Sched& S, const Epi& E, const int wave_id) {
    int tid_; asm volatile("v_mbcnt_lo_u32_b32 %0, -1, 0\n\tv_mbcnt_hi_u32_b32 %0, -1, %0" : "=v"(tid_)); tid_ += wave_id * 64;
    const int tid = tid_, wid = __builtin_amdgcn_readfirstlane(tid >> 6), lane = tid & 63, wr = wid >> 2, wc = wid & 3, fr = lane & 15, fq = lane >> 4;
    const int K = g.K, nt = K / BK;
    unsigned voffA[2], voffB[2];
#pragma unroll
    for (int i = 0; i < 2; ++i) { int R, C; stage_rc(tid * 16 + i * 8192, R, C); const int Rb = Epi::PERM ? ((R & ~31) + perm32(R & 31)) : R;
        voffA[i] = (unsigned)(R * K + C) * 2u; voffB[i] = (unsigned)(Rb * K + C) * 2u; }
    const size_t kstep = (size_t)(BK * 2);
    const size_t hstep = (size_t)HALF * K * 2;
    const size_t tstep = 2 * hstep;
    const unsigned ldsw = (unsigned)wid * 1024u;
    const int aoff = lds_byte(wr * 64 + fr, fq * 8), boff = lds_byte(wc * 32 + fr, fq * 8);
#define PG8_SA(b, h) (((b) * 2 + (h)) * HTB)
#define PG8_SB(b, h) ((4 + (b) * 2 + (h)) * HTB)
#define PG8_STAGE(bufoff, gbase, voff) do { _Pragma("unroll") for (int _i = 0; _i < 2; ++_i) \
        __builtin_amdgcn_global_load_lds((const unsigned*)((const char*)(gbase) + (voff)[_i]), (PG8_LAS unsigned*)(lds + (bufoff) + ldsw + _i * 8192), 16, 0, 0); } while (0)
#define PG8_LDA(dst, b, h) do { _Pragma("unroll") for (int m = 0; m < 4; ++m) _Pragma("unroll") for (int k = 0; k < 2; ++k) dst[m][k] = *(const PG8_LAS bf16x8*)(lds + PG8_SA(b, h) + aoff + m * 2048 + k * 1024); } while (0)
#define PG8_LDB(dst, b, h) do { _Pragma("unroll") for (int n = 0; n < 2; ++n) _Pragma("unroll") for (int k = 0; k < 2; ++k) dst[n][k] = *(const PG8_LAS bf16x8*)(lds + PG8_SB(b, h) + boff + n * 2048 + k * 1024); } while (0)
#define PG8_CAT(x) __builtin_bit_cast(i32x8, __builtin_shufflevector((x)[0], (x)[1], 0, 1, 2, 3, 4, 5, 6, 7, 8, 9, 10, 11, 12, 13, 14, 15))
#define PG8_MMA(ai, bj, At, Bt) do { __builtin_amdgcn_s_setprio(1); _Pragma("unroll") for (int m = 0; m < 4; ++m) _Pragma("unroll") for (int n = 0; n < 2; ++n) { \
        if constexpr (F8) asm volatile("v_mfma_f32_16x16x128_f8f6f4 %0, %1, %2, %0" : "+v"(acc[ai][bj][m][n]) : "v"(PG8_CAT(Bt[n])), "v"(PG8_CAT(At[m])));   \
        else { _Pragma("unroll") for (int k = 0; k < 2; ++k) acc[ai][bj][m][n] = __builtin_amdgcn_mfma_f32_16x16x32_bf16(Bt[n][k], At[m][k], acc[ai][bj][m][n], 0, 0, 0); } } \
        __builtin_amdgcn_s_setprio(0); } while (0)
#define PG8_WAIT_V(n) asm volatile("s_waitcnt vmcnt(" #n ")" ::: "memory")
#define PG8_WAIT_L(n) asm volatile("s_waitcnt lgkmcnt(" #n ")" ::: "memory")
#define PG8_BAR __builtin_amdgcn_s_barrier()
#define PG8_SCHED __builtin_amdgcn_sched_barrier(0)
    Unit cur, nxt; int ui = 0;
    if (!S.next(0, cur)) return;
    f32x4 acc[2][2][4][2];
#pragma unroll
    for (int a = 0; a < 2; ++a)
#pragma unroll
        for (int b = 0; b < 2; ++b)
#pragma unroll
            for (int m = 0; m < 4; ++m)
#pragma unroll
                for (int n = 0; n < 2; ++n) acc[a][b][m][n] = (f32x4){0.f, 0.f, 0.f, 0.f};
    bf16x8 At[4][2], B0[2][2], B1[2][2];
    const char* cA = (const char*)g.A + (size_t)cur.pm * tstep; const char* cB = (const char*)g.Bt + (size_t)cur.pn * tstep;
    S.a_ready(cur);
    if constexpr (SP2) {
        PG8_STAGE(PG8_SB(0, 0), cB, voffB); PG8_STAGE(PG8_SB(0, 1), cB + hstep, voffB); PG8_STAGE(PG8_SA(0, 0), cA, voffA); PG8_STAGE(PG8_SA(0, 1), cA + hstep, voffA);
        if (wr == 1) PG8_BAR;
        PG8_WAIT_V(2); PG8_BAR;
        PG8_STAGE(PG8_SB(1, 0), cB + kstep, voffB); PG8_STAGE(PG8_SA(1, 0), cA + kstep, voffA); PG8_STAGE(PG8_SB(1, 1), cB + hstep + kstep, voffB);
        PG8_WAIT_V(6); PG8_BAR;
    } else {
        PG8_STAGE(PG8_SB(0, 0), cB, voffB); PG8_STAGE(PG8_SA(0, 0), cA, voffA); PG8_STAGE(PG8_SB(0, 1), cB + hstep, voffB); PG8_STAGE(PG8_SA(0, 1), cA + hstep, voffA);
        if (wr == 1) PG8_BAR;
        PG8_WAIT_V(4); PG8_BAR;
        PG8_STAGE(PG8_SB(1, 0), cB + kstep, voffB); PG8_STAGE(PG8_SA(1, 0), cA + kstep, voffA); PG8_STAGE(PG8_SB(1, 1), cB + hstep + kstep, voffB);
        PG8_WAIT_V(6); PG8_BAR;
    }
    for (;;) {
        const bool has_next = S.next(ui + 1, nxt);
        const char* nA = has_next ? (const char*)g.A + (size_t)nxt.pm * tstep : cA; const char* nB = has_next ? (const char*)g.Bt + (size_t)nxt.pn * tstep : cB;
        for (int t = 0; t < nt; t += 2) {
            const bool last = (t == nt - 2);
            const char* a1 = cA + (size_t)(t + 1) * kstep;
            const char* a2 = last ? nA : cA + (size_t)(t + 2) * kstep; const char* b2 = last ? nB : cB + (size_t)(t + 2) * kstep;
            const char* a3 = a2 + kstep; const char* b3 = b2 + kstep;
            if (last && has_next) S.a_ready(nxt);
            if constexpr (SP2) {
            PG8_LDB(B0, 0, 0); PG8_LDB(B1, 0, 1); PG8_SCHED; PG8_LDA(At, 0, 0); PG8_STAGE(PG8_SA(1, 1), a1 + hstep, voffA);
            PG8_WAIT_V(8); PG8_WAIT_L(0); PG8_BAR; PG8_MMA(0, 0, At, B0); PG8_MMA(0, 1, At, B1); PG8_BAR; PG8_SCHED;
            PG8_LDA(At, 0, 1); PG8_STAGE(PG8_SB(0, 0), b2, voffB); PG8_STAGE(PG8_SB(0, 1), b2 + hstep, voffB); PG8_STAGE(PG8_SA(0, 0), a2, voffA);
            PG8_WAIT_V(8); PG8_WAIT_L(0); PG8_BAR; PG8_MMA(1, 0, At, B0); PG8_MMA(1, 1, At, B1); PG8_BAR; PG8_SCHED;
            PG8_LDB(B0, 1, 0); PG8_LDB(B1, 1, 1); PG8_SCHED; PG8_LDA(At, 1, 0); PG8_STAGE(PG8_SA(0, 1), a2 + hstep, voffA);
            PG8_WAIT_V(8); PG8_WAIT_L(0); PG8_BAR; PG8_MMA(0, 0, At, B0); PG8_MMA(0, 1, At, B1); PG8_BAR; PG8_SCHED;
            PG8_LDA(At, 1, 1); PG8_STAGE(PG8_SB(1, 0), b3, voffB); PG8_STAGE(PG8_SB(1, 1), b3 + hstep, voffB); PG8_STAGE(PG8_SA(1, 0), a3, voffA);
            PG8_WAIT_V(8); PG8_WAIT_L(0); PG8_BAR; PG8_MMA(1, 0, At, B0); PG8_MMA(1, 1, At, B1); PG8_BAR; PG8_SCHED;
            } else {
            PG8_LDB(B0, 0, 0); PG8_SCHED; PG8_LDA(At, 0, 0); PG8_STAGE(PG8_SA(1, 1), a1 + hstep, voffA);
            PG8_WAIT_L(8); PG8_BAR; PG8_WAIT_L(0); PG8_MMA(0, 0, At, B0); PG8_BAR; PG8_SCHED;
            PG8_LDB(B1, 0, 1); PG8_STAGE(PG8_SB(0, 0), b2, voffB);
            PG8_BAR; PG8_WAIT_L(0); PG8_MMA(0, 1, At, B1); PG8_BAR;
            PG8_LDA(At, 0, 1); PG8_STAGE(PG8_SA(0, 0), a2, voffA);
            PG8_BAR; PG8_WAIT_L(0); PG8_MMA(1, 0, At, B0); PG8_BAR; PG8_SCHED;
            PG8_STAGE(PG8_SB(0, 1), b2 + hstep, voffB);
            PG8_WAIT_V(6); PG8_BAR; PG8_MMA(1, 1, At, B1); PG8_BAR;
            PG8_LDB(B0, 1, 0); PG8_SCHED; PG8_LDA(At, 1, 0); PG8_STAGE(PG8_SA(0, 1), a2 + hstep, voffA);
            PG8_WAIT_L(8); PG8_BAR; PG8_WAIT_L(0); PG8_MMA(0, 0, At, B0); PG8_BAR; PG8_SCHED;
            PG8_LDB(B1, 1, 1); PG8_STAGE(PG8_SB(1, 0), b3, voffB);
            PG8_BAR; PG8_WAIT_L(0); PG8_MMA(0, 1, At, B1); PG8_BAR;
            PG8_LDA(At, 1, 1); PG8_STAGE(PG8_SA(1, 0), a3, voffA);
            PG8_BAR; PG8_WAIT_L(0); PG8_MMA(1, 0, At, B0); PG8_BAR; PG8_SCHED;
            PG8_STAGE(PG8_SB(1, 1), b3 + hstep, voffB);
            PG8_WAIT_V(6); PG8_BAR; PG8_MMA(1, 1, At, B1); PG8_BAR;
            }
        }
        if constexpr (ALIGN_EPI) { if (wr == 0) PG8_BAR; }
        if constexpr (F8) { asm volatile("s_nop 15\n\ts_nop 15" ::: "memory"); PG8_SCHED; }
        if constexpr (!Epi::AFTER_DRAIN) { E(acc, cur, wr, wc, fr, fq); S.done(cur); }
        if (!has_next) break;
#pragma unroll
        for (int a = 0; a < 2; ++a)
#pragma unroll
            for (int b = 0; b < 2; ++b)
#pragma unroll
                for (int m = 0; m < 4; ++m)
#pragma unroll
                    for (int n = 0; n < 2; ++n) acc[a][b][m][n] = (f32x4){0.f, 0.f, 0.f, 0.f};
        cur = nxt; cA = nA; cB = nB; ++ui;
        if constexpr (ALIGN_EPI) { if (wr == 1) PG8_BAR; }
    }
    PG8_WAIT_V(0);
    if constexpr (!ALIGN_EPI) { if (wr == 0) PG8_BAR; }
    PG8_BAR;
    if constexpr (Epi::AFTER_DRAIN) { E.fused(acc, cur, wr, wc, fr, fq, lds, wid, lane); S.done(cur); }
#undef PG8_SA
#undef PG8_SB
#undef PG8_STAGE
#undef PG8_LDA
#undef PG8_LDB
#undef PG8_MMA
#undef PG8_CAT
#undef PG8_WAIT_V
#undef PG8_WAIT_L
#undef PG8_BAR
#undef PG8_SCHED
}
}
constexpr int S_ = 16384, D_ = 1024;
constexpr int EVEN_IN = 3072, LORA_N = 512, FF0 = 2816, ODD_IN = 3600, ODD_PAD = 3840, FFE = 3584, NEXP = 8;
constexpr int MOE_ROWS = 32768 + 8 * 256;
constexpr int MOE_BATCH_TILES = 64;
constexpr size_t MiB = 1u << 20;
constexpr size_t WS_CTL = 0, CTL_ZERO_BYTES = 1 * MiB;
constexpr size_t WS_WIN0 = 2 * MiB, WS_WL = 8 * MiB, WS_WOUT0 = 9 * MiB, WS_WGU0 = 11 * MiB, WS_WD0 = 22 * MiB, WS_WIN1 = 28 * MiB, WS_WOUT1 = 36 * MiB;
constexpr size_t WS_TOK = 38 * MiB;
constexpr size_t WS_TILE = 39 * MiB;
constexpr size_t WS_A = 40 * MiB;
constexpr size_t WS_H = WS_A, WS_HX = WS_A + 32 * MiB;
constexpr size_t WS_LW0 = WS_A, WS_LW1 = WS_A + 32 * MiB, WS_R = WS_A + 64 * MiB, WS_V = WS_A + 80 * MiB, WS_KK = WS_A + 96 * MiB, WS_KD0 = WS_A + 112 * MiB, WS_KD1 = WS_A + 128 * MiB, WS_B0 = WS_A + 144 * MiB;
constexpr size_t WS_H2 = WS_A, WS_H3 = WS_A + 32 * MiB;
constexpr size_t WS_WMGU = WS_A, WS_WMD = WS_A + 112 * MiB;
constexpr size_t WS_B = 208 * MiB;
constexpr size_t WS_PROJ0 = WS_B, WS_LORA = WS_B + 96 * MiB, WS_QN = WS_B + 112 * MiB, WS_KN = WS_B + 128 * MiB, WS_Y = WS_B + 144 * MiB;
constexpr size_t WS_B1 = WS_B + 176 * MiB, WS_GATE = WS_B + 192 * MiB, WS_BONUS = WS_B + 208 * MiB, WS_Y0 = WS_LORA, WS_Y1 = WS_B + 224 * MiB;
constexpr size_t WS_ACT0 = WS_B, WS_PROJ1 = WS_B + 88 * MiB;
constexpr size_t WS_QD = WS_B, WS_KD = WS_B + 16 * MiB, WS_VD = WS_B + 32 * MiB, WS_YCAT1 = WS_B + 48 * MiB, WS_GB = WS_B + 80 * MiB  ;
constexpr size_t WS_O0 = WS_B + 208 * MiB, WS_O1 = WS_B + 224 * MiB;
constexpr size_t WS_AMOE = WS_B, WS_MACT = WS_B + 88 * MiB, WS_AMOE8 = WS_B + 144 * MiB;
constexpr size_t WS_END_OLD = 448 * MiB, WS_RSS1 = 460 * MiB, WS_RSS2 = 461 * MiB, WS_END = 462 * MiB;
static_assert(WS_MACT + (size_t)MOE_BATCH_TILES * 256 * FFE <= WS_AMOE8 && WS_AMOE8 + (size_t)MOE_ROWS * D_ <= WS_END_OLD, "moe act");
static_assert(WS_AMOE + (size_t)MOE_ROWS * D_ * 2 <= WS_MACT, "amoe");
static_assert(WS_PROJ1 + (size_t)S_ * ODD_PAD * 2 <= WS_O0, "proj1");
constexpr int CW_CNT = 64;
constexpr int CW_RSS1 = 32768, CW_RSS2 = 32768 + 16384;
constexpr int CW_BAR = 4096;
constexpr int LDS_BYTES = 159744, LDS_ZERO_OFF = LDS_BYTES - 512, MISC_OFF = LDS_ZERO_OFF + 64;

#define GAS __attribute__((address_space(1)))
#define LAS __attribute__((address_space(3)))
#define DI __device__ __forceinline__
typedef unsigned short bf16;
typedef unsigned v4u __attribute__((ext_vector_type(4)));
typedef float f32x4 __attribute__((ext_vector_type(4)));
typedef GAS unsigned gu32;
#define LDS_WAIT() asm volatile("s_waitcnt lgkmcnt(0)" ::: "memory")
DI unsigned f2bf(float f) { unsigned u = __builtin_bit_cast(unsigned, f); return (u + 0x7fffu + ((u >> 16) & 1u)) >> 16; }
typedef float f32x2_t __attribute__((ext_vector_type(2))); typedef __bf16 bf16x2_t __attribute__((ext_vector_type(2)));
DI unsigned pk2(float lo, float hi) { const f32x2_t v = {lo, hi}; const bf16x2_t b = __builtin_convertvector(v, bf16x2_t); return __builtin_bit_cast(unsigned, b); }
DI float bflo(unsigned w) { return __uint_as_float(w << 16); }
DI float bfhi(unsigned w) { return __uint_as_float(w & 0xffff0000u); }
DI float bf2f(bf16 b) { return __uint_as_float(((unsigned)b) << 16); }
DI void ld8(const bf16* p, float (&v)[8]) { const v4u w = *(const v4u*)p; v[0] = bflo(w.x); v[1] = bfhi(w.x); v[2] = bflo(w.y); v[3] = bfhi(w.y); v[4] = bflo(w.z); v[5] = bfhi(w.z); v[6] = bflo(w.w); v[7] = bfhi(w.w); }
DI void st8(bf16* p, const float (&v)[8]) { v4u w; w.x = pk2(v[0], v[1]); w.y = pk2(v[2], v[3]); w.z = pk2(v[4], v[5]); w.w = pk2(v[6], v[7]); *(v4u*)p = w; }
DI void ld8f(const float* p, float (&v)[8]) { const f32x4 a = *(const f32x4*)p, b = *(const f32x4*)(p + 4); v[0] = a.x; v[1] = a.y; v[2] = a.z; v[3] = a.w; v[4] = b.x; v[5] = b.y; v[6] = b.z; v[7] = b.w; }
DI void st8f(float* p, const float (&v)[8]) { *(f32x4*)p = (f32x4){v[0], v[1], v[2], v[3]}; *(f32x4*)(p + 4) = (f32x4){v[4], v[5], v[6], v[7]}; }
DI float wave_sum(float v) {
#pragma unroll
    for (int o = 1; o < 64; o <<= 1) v += __shfl_xor(v, o);
    return v;
}
template <int W> DI float grp_sum(float v) {
#pragma unroll
    for (int o = 1; o < W; o <<= 1) v += __shfl_xor(v, o);
    return v;
}
DI float sigmoidf_(float x) { return 1.0f / (1.0f + __expf(-x)); }
DI float softplusf_(float x) { return x > 20.f ? x : log1pf(__expf(x)); }
DI float siluf_(float x) { return x / (1.0f + __expf(-x)); }

struct Args { const float* in[39]; float* out; unsigned char* ws; };

DI void transpose_item(const float* W, int K, int N, bf16* WT, int rowbase, LAS float* scr, int k0, int n0, int lane, const float* kscale = nullptr) {
    const int nn = n0 + (lane & 31); const bool ok = nn < N;
#pragma unroll
    for (int i = 0; i < 32; ++i) { const int kk = 2 * i + (lane >> 5); scr[kk * 33 + (lane & 31)] = ok ? W[(size_t)(k0 + kk) * N + nn] * (kscale ? kscale[k0 + kk] : 1.0f) : 0.f; }
    LDS_WAIT(); asm volatile("" ::: "memory");
    const int c = lane & 7;
#pragma unroll
    for (int j = 0; j < 4; ++j) { const int n = (lane >> 3) + 8 * j; const LAS float* s = scr + (8 * c) * 33 + n;
        v4u o; o.x = pk2(s[0 * 33], s[1 * 33]); o.y = pk2(s[2 * 33], s[3 * 33]); o.z = pk2(s[4 * 33], s[5 * 33]); o.w = pk2(s[6 * 33], s[7 * 33]);
        *(v4u*)(WT + (size_t)(rowbase + n) * K + k0 + 8 * c) = o; }
    LDS_WAIT(); asm volatile("" ::: "memory");
}

struct TrItem { const float* src; unsigned char* dst; int K, N, k0, n0, rowbase; };
DI void tr_load(const TrItem& d, int lane, float (&v)[32]) {
#pragma unroll
    for (int i = 0; i < 32; ++i) { const int kk = 2 * i + (lane >> 5); v[i] = d.src[(size_t)(d.k0 + kk) * d.N + d.n0 + (lane & 31)]; }
}
DI unsigned pk4f8(float a, float b, float c, float d) { int w = __builtin_amdgcn_cvt_pk_fp8_f32(a, b, 0, false); w = __builtin_amdgcn_cvt_pk_fp8_f32(c, d, w, true); return (unsigned)w; }
constexpr float MOE_WSCALE = 32.0f;
DI void tr_store(const TrItem& d, int lane, const float (&v)[32], LAS float* scr) {
#pragma unroll
    for (int i = 0; i < 32; ++i) scr[(2 * i + (lane >> 5)) * 33 + (lane & 31)] = v[i] * MOE_WSCALE;
    LDS_WAIT(); asm volatile("" ::: "memory");
    const int c = lane & 3;
#pragma unroll
    for (int j = 0; j < 2; ++j) { const int n = (lane >> 2) + 16 * j; const LAS float* s = scr + (16 * c) * 33 + n;
        v4u o; o.x = pk4f8(s[0 * 33], s[1 * 33], s[2 * 33], s[3 * 33]); o.y = pk4f8(s[4 * 33], s[5 * 33], s[6 * 33], s[7 * 33]);
        o.z = pk4f8(s[8 * 33], s[9 * 33], s[10 * 33], s[11 * 33]); o.w = pk4f8(s[12 * 33], s[13 * 33], s[14 * 33], s[15 * 33]);
        *(v4u*)(d.dst + (size_t)(d.rowbase + n) * d.K + d.k0 + 16 * c) = o; }
    LDS_WAIT(); asm volatile("" ::: "memory");
}
DI void moe_gu_item(const Args& a, unsigned char* ws, int it, TrItem& d) {
    const int mtx = it / 1792, r = it % 1792, e = mtx >> 1, sel = mtx & 1, kb = r / 112, nb = r % 112, n0 = 32 * nb;
    d.src = (sel ? a.in[37] : a.in[36]) + (size_t)e * 1024 * FFE; d.dst = ws + WS_WMGU + (size_t)e * 2 * FFE * 1024; d.K = 1024; d.N = FFE; d.k0 = 64 * kb; d.n0 = n0;
    d.rowbase = (n0 / 128) * 256 + sel * 128 + (n0 % 128);
}
DI void moe_dn_item(const Args& a, unsigned char* ws, int it, TrItem& d) {
    const int e = it / 1792, r = it % 1792, kb = r / 32, nb = r % 32;
    d.src = a.in[38] + (size_t)e * 1024 * FFE; d.dst = ws + WS_WMD + (size_t)e * 1024 * FFE; d.K = FFE; d.N = 1024; d.k0 = 64 * kb; d.n0 = 32 * nb; d.rowbase = 32 * nb;
}
template <bool GU> DI void moe_copy_loop(const Args& a, unsigned char* ws, LAS float* scr, int first, int stride, int last, int lane) {
    first = __builtin_amdgcn_readfirstlane(first); stride = __builtin_amdgcn_readfirstlane(stride);
    if (first >= last) return;
    TrItem cur, nxt; float vc[32], vn[32];
    if (GU) moe_gu_item(a, ws, first, cur); else moe_dn_item(a, ws, first, cur);
    tr_load(cur, lane, vc);
    for (int it = first; it < last; it += stride) {
        const int itn = it + stride; const bool more = itn < last;
        if (more) { if (GU) moe_gu_item(a, ws, itn, nxt); else moe_dn_item(a, ws, itn, nxt); tr_load(nxt, lane, vn); }
        tr_store(cur, lane, vc, scr);
        if (more) { cur = nxt;
#pragma unroll
            for (int i = 0; i < 32; ++i) vc[i] = vn[i]; }
    }
}
struct TrItemB { const float* src; bf16* dst; int K, N, k0, n0, rowbase; };
DI void ffn_item(const Args& a, unsigned char* ws, int it, TrItemB& d) {
    int r = it;
    if (r < 2816) { const int sel = r >= 1408 ? 1 : 0; r -= sel * 1408; const int kb = r / 88, nb = r % 88, n0 = 32 * nb;
        d.src = sel ? a.in[24] : a.in[23]; d.dst = (bf16*)(ws + WS_WGU0); d.K = 1024; d.N = FF0; d.k0 = 64 * kb; d.n0 = n0; d.rowbase = (n0 / 128) * 256 + sel * 128 + (n0 % 128); return; }
    r -= 2816;
    if (r < 1408) { const int kb = r / 32, nb = r % 32; d.src = a.in[25]; d.dst = (bf16*)(ws + WS_WD0); d.K = FF0; d.N = 1024; d.k0 = 64 * kb; d.n0 = 32 * nb; d.rowbase = 32 * nb; return; }
    r -= 1408;
    if (r < 1920) { const int kb = r / 120, nb = r % 120; d.src = a.in[27]; d.dst = (bf16*)(ws + WS_WIN1); d.K = 1024; d.N = ODD_IN; d.k0 = 64 * kb; d.n0 = 32 * nb; d.rowbase = 32 * nb; return; }
    r -= 1920;
    { const int kb = r / 32, nb = r % 32; d.src = a.in[33]; d.dst = (bf16*)(ws + WS_WOUT1); d.K = 1024; d.N = 1024; d.k0 = 64 * kb; d.n0 = 32 * nb; d.rowbase = 32 * nb; }
}
DI void trb_load(const TrItemB& d, int lane, float (&v)[32]) {
    const int n = d.n0 + (lane & 31); const bool ok = n < d.N; const int nc = ok ? n : d.N - 1; const float m = ok ? 1.f : 0.f;
#pragma unroll
    for (int i = 0; i < 32; ++i) { const int kk = 2 * i + (lane >> 5); v[i] = d.src[(size_t)(d.k0 + kk) * d.N + nc] * m; }
}
DI void trb_store(const TrItemB& d, int lane, const float (&v)[32], LAS float* scr) {
#pragma unroll
    for (int i = 0; i < 32; ++i) scr[(2 * i + (lane >> 5)) * 33 + (lane & 31)] = v[i];
    LDS_WAIT(); asm volatile("" ::: "memory");
    const int c = lane & 7;
#pragma unroll
    for (int j = 0; j < 4; ++j) { const int n = (lane >> 3) + 8 * j; const LAS float* s = scr + (8 * c) * 33 + n;
        v4u o; o.x = pk2(s[0 * 33], s[1 * 33]); o.y = pk2(s[2 * 33], s[3 * 33]); o.z = pk2(s[4 * 33], s[5 * 33]); o.w = pk2(s[6 * 33], s[7 * 33]);
        *(v4u*)(d.dst + (size_t)(d.rowbase + n) * d.K + d.k0 + 8 * c) = o; }
    LDS_WAIT(); asm volatile("" ::: "memory");
}
DI void ffn_copy_loop(const Args& a, unsigned char* ws, LAS float* scr, int first, int stride, int last, int lane) {
    first = __builtin_amdgcn_readfirstlane(first); stride = __builtin_amdgcn_readfirstlane(stride);
    if (first >= last) return;
    TrItemB cur, nxt; float vc[32], vn[32];
    ffn_item(a, ws, first, cur); trb_load(cur, lane, vc);
    for (int it = first; it < last; it += stride) {
        const int itn = it + stride; const bool more = itn < last;
        if (more) { ffn_item(a, ws, itn, nxt); trb_load(nxt, lane, vn); }
        trb_store(cur, lane, vc, scr);
        if (more) { cur = nxt;
#pragma unroll
            for (int i = 0; i < 32; ++i) vc[i] = vn[i]; }
    }
}
DI bool transpose_job(int& r, const float* W, int K, int N, int Npad, bf16* WT, int row_off, int grp, int sel, LAS float* scr, int lane, const float* kscale = nullptr) {
    const int nblk = Npad / 32, cnt = (K / 64) * nblk;
    if (r >= cnt) { r -= cnt; return false; }
    const int kb = r / nblk, nb = r % nblk, n0 = 32 * nb;
    const int rowbase = row_off + (grp ? (n0 / grp) * (2 * grp) + sel * grp + (n0 % grp) : n0);
    transpose_item(W, K, N, WT, rowbase, scr, 64 * kb, n0, lane, kscale);
    return true;
}
#define XB_TMO      128
#define XB_XCNT(j)  (256  + 64 * (j))
#define XB_XSUB(j)  (1280 + 64 * (j))
#define XB_XGEN(j)  (2304 + 64 * (j))
#define XB_TOP      3328
#define XB_TOPGEN   3392
#define XCD_BAR_WORDS 3456
#define XB_SPIN_CAP (1u << 22)

__device__ __forceinline__ unsigned xb_ld(unsigned* p)              { return __hip_atomic_load(p, __ATOMIC_RELAXED, __HIP_MEMORY_SCOPE_AGENT); }
__device__ __forceinline__ unsigned xb_add(unsigned* p, unsigned v) { return __hip_atomic_fetch_add(p, v, __ATOMIC_RELAXED, __HIP_MEMORY_SCOPE_AGENT); }
__device__ __forceinline__ unsigned xb_xcc_id() { return (unsigned)__builtin_amdgcn_s_getreg((3 << 11) | 20) & 0xFu; }
#define XB_SPIN(cond, bar) do { unsigned _sp = 0; while (cond) { __builtin_amdgcn_s_sleep(1); \
    if ((++_sp & 255u) == 0u) { if (xb_ld(&(bar)[XB_TMO])) break; if (_sp > XB_SPIN_CAP) { atomicAdd(&(bar)[XB_TMO], 1u); break; } } } } while (0)

struct XcdBarrier {
    unsigned* bar; unsigned x;
    volatile LAS unsigned* st;
};

__device__ __forceinline__ XcdBarrier xcd_barrier_post(unsigned* bar, volatile LAS unsigned* st) {
    XcdBarrier b; b.bar = bar; b.x = xb_xcc_id(); b.st = st;
    if (threadIdx.x == 0) (void)xb_add(&bar[XB_XCNT(b.x)], 1u);
    return b;
}
__device__ __forceinline__ void xcd_barrier_complete(unsigned* bar, unsigned x, unsigned& nloc, unsigned& nx) {
    const unsigned G = gridDim.x * gridDim.y * gridDim.z;
    unsigned sum, cnt, mine, sp = 0u;
    for (;;) {
        sum = 0u; cnt = 0u; mine = 0u;
#pragma unroll
        for (unsigned j = 0; j < 16; ++j) { const unsigned c = xb_ld(&bar[XB_XCNT(j)]); sum += c; cnt += (c > 0u) ? 1u : 0u; mine = (j == x) ? c : mine; }
        if (sum == G) break;
        __builtin_amdgcn_s_sleep(1);
        if ((++sp & 255u) == 0u) { if (xb_ld(&bar[XB_TMO])) break; if (sp > XB_SPIN_CAP) { atomicAdd(&bar[XB_TMO], 1u); break; } }
    }
    nloc = mine > 0u ? mine : 1u; nx = cnt > 0u ? cnt : 1u;
}

__device__ __forceinline__ void xcd_barrier(const XcdBarrier& b, const bool wave0) {
    asm volatile("s_waitcnt vmcnt(0)" ::: "memory");
    __syncthreads();
    if (wave0 && __builtin_amdgcn_mbcnt_hi(~0u, __builtin_amdgcn_mbcnt_lo(~0u, 0u)) == 0u) {
        unsigned* bar = b.bar; asm volatile("" : "+s"(bar)); const unsigned bx_ = xb_xcc_id();
        __builtin_amdgcn_s_waitcnt(0);
        unsigned nloc = b.st[0], nx = b.st[1];
        if (nloc == 0u) { xcd_barrier_complete(bar, bx_, nloc, nx); b.st[0] = nloc; b.st[1] = nx; }
        const unsigned old = xb_add(&bar[XB_XSUB(bx_)], 1u);
        const unsigned gen = old / nloc;
        if (old + 1u == (gen + 1u) * nloc) {
            __builtin_amdgcn_fence(__ATOMIC_RELEASE, "agent");
            asm volatile("s_waitcnt vmcnt(0)" ::: "memory");
            const unsigned og = xb_add(&bar[XB_TOP], 1u);
            const unsigned tg = og / nx;
            if (og + 1u == (tg + 1u) * nx) xb_add(&bar[XB_TOPGEN], 1u);
            else XB_SPIN(xb_ld(&bar[XB_TOPGEN]) == tg, bar);
            __builtin_amdgcn_fence(__ATOMIC_ACQUIRE, "agent");
            xb_add(&bar[XB_XGEN(bx_)], 1u);
            asm volatile("s_waitcnt vmcnt(0)" ::: "memory");
        } else {
            XB_SPIN(xb_ld(&bar[XB_XGEN(bx_)]) == gen, bar);
            __builtin_amdgcn_fence(__ATOMIC_ACQUIRE, "agent");
            asm volatile("s_waitcnt vmcnt(0)" ::: "memory");
        }
    }
    __syncthreads();
}
DI float row_rstd(const f32x4 (&v)[4]) {
    float s = 0.f;
#pragma unroll
    for (int j = 0; j < 4; ++j) s += (v[j].x * v[j].x + v[j].y * v[j].y) + (v[j].z * v[j].z + v[j].w * v[j].w);
    return 1.0f / sqrtf(wave_sum(s) * (1.0f / D_) + 1e-6f);
}
DI void load_row(const float* x, int t, int lane, f32x4 (&v)[4]) {
    if (t >= 0 && t < S_) { const f32x4* p = (const f32x4*)(x + (size_t)t * D_) + lane;
#pragma unroll
        for (int j = 0; j < 4; ++j) v[j] = p[64 * j];
    } else {
#pragma unroll
        for (int j = 0; j < 4; ++j) v[j] = (f32x4){0.f, 0.f, 0.f, 0.f};
    }
}
DI void store_row_bf16(bf16* o, int lane, const f32x4 (&v)[4]) {
    unsigned long long* o8 = (unsigned long long*)o + lane;
#pragma unroll
    for (int j = 0; j < 4; ++j) o8[64 * j] = (unsigned long long)pk2(v[j].x, v[j].y) | ((unsigned long long)pk2(v[j].z, v[j].w) << 32);
}
DI void norm_rows(const float* x, const float* w, const float* mu  , bf16* H, bf16* HX, int gw, int NGW, int lane) {
    f32x4 wv[4];
#pragma unroll
    for (int j = 0; j < 4; ++j) wv[j] = ((const f32x4*)w)[lane + 64 * j];
    for (int t = gw; t < S_; t += NGW) {
        f32x4 v[4]; load_row(x, t, lane, v); const float rs = row_rstd(v);
#pragma unroll
        for (int j = 0; j < 4; ++j) v[j] = v[j] * rs * wv[j];
        store_row_bf16(H + (size_t)t * D_, lane, v);
        if (mu) {
            f32x4 p[4], n[4]; load_row(x, t - 1, lane, p); load_row(x, t + 1, lane, n);
            const float rp = row_rstd(p), rn = row_rstd(n);
#pragma unroll
            for (int j = 0; j < 4; ++j) { const f32x4 m0 = ((const f32x4*)mu)[lane + 64 * j], m1 = ((const f32x4*)(mu + D_))[lane + 64 * j];
                const f32x4 hp = p[j] * rp * wv[j], hn = n[j] * rn * wv[j]; p[j] = v[j] + m0 * (hp - v[j]) + m1 * (hn - v[j]); }
            store_row_bf16(HX + (size_t)t * D_, lane, p);
        }
    }
}

DI void prep0_token(const Args& a, unsigned char* ws, LAS float* scr, int t, int lane) {
    const bf16* P = (const bf16*)(ws + WS_PROJ0) + (size_t)t * EVEN_IN;
    const int c0 = 8 * lane;
    {
        float q[8], k[8]; ld8(P + c0, q); ld8(P + 512 + c0, k);
        float sq = 0.f, sk = 0.f;
#pragma unroll
        for (int i = 0; i < 8; ++i) { sq += q[i] * q[i]; sk += k[i] * k[i]; }
        sq = grp_sum<8>(sq); sk = grp_sum<8>(sk);
        const float rq = 1.0f / sqrtf(sq * (1.0f / 64.f) + 1e-6f), rk = 1.0f / sqrtf(sk * (1.0f / 64.f) + 1e-6f);
        const int d0 = 8 * (lane & 7);
        float qw[8], kw[8]; ld8f(a.in[4] + d0, qw); ld8f(a.in[5] + d0, kw);
#pragma unroll
        for (int i = 0; i < 8; ++i) { q[i] = q[i] * rq * qw[i]; k[i] = k[i] * rk * kw[i]; }
        const float pos = (float)((const int*)a.in[1])[t];
        float qo[8], ko[8];
#pragma unroll
        for (int i = 0; i < 8; ++i) { qo[i] = __shfl_xor(q[i], 1); ko[i] = __shfl_xor(k[i], 1); }
        const int sub = lane & 7;
        if (sub < 2) {
#pragma unroll
            for (int i = 0; i < 8; ++i) {
                constexpr float kInv[8] = {1.0f, 0.1939227432012558f, 0.03760603070259094f, 0.007292664609849453f, 0.0014142135623842478f, 0.00027424818836152554f, 5.3182957344688475e-05f, 1.0313385246263351e-05f};
                const float ang = pos * kInv[i]; const float kq = rintf(ang * 0.15915494309189535f);
                float rr = fmaf(-kq, 6.28318548202514648f, ang); rr = fmaf(-kq, -1.74845553146951715e-07f, rr);
                const float sn = __sinf(rr), cs = __cosf(rr);
                if (sub == 0) { q[i] = q[i] * cs - qo[i] * sn; k[i] = k[i] * cs - ko[i] * sn; }
                else          { q[i] = q[i] * cs + qo[i] * sn; k[i] = k[i] * cs + ko[i] * sn; }
            }
        }
#pragma unroll
        for (int i = 0; i < 8; ++i) q[i] *= 0.125f;
        st8((bf16*)(ws + WS_QN) + (size_t)t * 512 + c0, q); st8((bf16*)(ws + WS_KN) + (size_t)t * 512 + c0, k);
        *(v4u*)((bf16*)(ws + WS_Y1) + (size_t)t * 512 + c0) = *(const v4u*)(P + 1024 + c0);
    }
}

DI void rwkv_scan_naive(unsigned char* ws, int w  , int lane) {
    const int z = w >> 9, h = (w >> 6) & 7, vr = w & 63;
    const float* LW = (const float*)(ws + (z ? WS_LW1 : WS_LW0));
    const bf16* KD = (const bf16*)(ws + (z ? WS_KD1 : WS_KD0)); const bf16* BB = (const bf16*)(ws + (z ? WS_B1 : WS_B0));
    const bf16* KK = (const bf16*)(ws + WS_KK); const bf16* R = (const bf16*)(ws + WS_R); const bf16* V = (const bf16*)(ws + WS_V);
    bf16* Y = (bf16*)(ws + (z ? WS_Y1 : WS_Y0));
    const int cc = h * 64 + lane, cv = h * 64 + vr;
    float S = 0.f;
    int t = z ? S_ - 1 : 0; const int dt = z ? -1 : 1;
    size_t o = (size_t)t * 512;
    float lw = LW[o + cc], kd = bf2f(KD[o + cc]), bb = bf2f(BB[o + cc]), kk = bf2f(KK[o + cc]), rr = bf2f(R[o + cc]), vv = bf2f(V[o + cv]);
    for (int s = 0; s < S_; ++s) {
        const int tn = t + dt; const bool more = s + 1 < S_;
        const size_t on = (size_t)(more ? tn : t) * 512;
        const float lw_n = LW[on + cc], kd_n = bf2f(KD[on + cc]), bb_n = bf2f(BB[on + cc]), kk_n = bf2f(KK[on + cc]), rr_n = bf2f(R[on + cc]), vv_n = bf2f(V[on + cv]);
        const float sa = wave_sum(S * (-kk));
        S = S * __expf(lw) + sa * bb + vv * kd;
        const float y = wave_sum(S * rr);
        if (lane == 0) Y[(size_t)t * 512 + cv] = (bf16)f2bf(y);
        lw = lw_n; kd = kd_n; bb = bb_n; kk = kk_n; rr = rr_n; vv = vv_n; t = tn;
    }
}

DI void attn_token_naive(unsigned char* ws, int t, int lane) {
    const bf16* QN = (const bf16*)(ws + WS_QN); const bf16* KN = (const bf16*)(ws + WS_KN); const bf16* P = (const bf16*)(ws + WS_PROJ0);
    const int c0 = 8 * lane;
    float q[8]; ld8(QN + (size_t)t * 512 + c0, q);
    float m = -1e30f, l = 0.f, acc[8];
#pragma unroll
    for (int i = 0; i < 8; ++i) acc[i] = 0.f;
    for (int br = 0; br < 3; ++br) {
        const int d = br == 0 ? 1 : (br == 1 ? 4 : 16);
        for (int mm = -64; mm <= 64; ++mm) {
            const int j = t + d * mm; if (j < 0 || j >= S_) continue;
            float k[8], v[8]; ld8(KN + (size_t)j * 512 + c0, k); ld8(P + (size_t)j * EVEN_IN + 1024 + c0, v);
            float s = 0.f;
#pragma unroll
            for (int i = 0; i < 8; ++i) s += q[i] * k[i];
            s = grp_sum<8>(s);
            const float mn = fmaxf(m, s), sc = __expf(m - mn), p = __expf(s - mn);
            l = l * sc + p;
#pragma unroll
            for (int i = 0; i < 8; ++i) acc[i] = acc[i] * sc + p * v[i];
            m = mn;
        }
    }
    const float il = 1.0f / l;
#pragma unroll
    for (int i = 0; i < 8; ++i) acc[i] *= il;
    st8((bf16*)(ws + WS_Y) + (size_t)t * D_ + c0, acc);
}

DI void rwkv_post_token(const Args& a, unsigned char* ws, int t, int lane) {
    const int c0 = 8 * lane; const size_t o = (size_t)t * 512 + c0;
    float y0[8], y1[8], g[8], bn[8], lw[8], lb[8];
    ld8((const bf16*)(ws + WS_Y0) + o, y0); ld8((const bf16*)(ws + WS_Y1) + o, y1); ld8((const bf16*)(ws + WS_GATE) + o, g); ld8((const bf16*)(ws + WS_BONUS) + o, bn);
    ld8f(a.in[19] + c0, lw); ld8f(a.in[20] + c0, lb);
    float s = 0.f;
#pragma unroll
    for (int i = 0; i < 8; ++i) { y0[i] += y1[i]; s += y0[i]; }
    const float mu = grp_sum<8>(s) * (1.0f / 64.f);
    float q = 0.f;
#pragma unroll
    for (int i = 0; i < 8; ++i) { y0[i] -= mu; q += y0[i] * y0[i]; }
    const float rs = 1.0f / sqrtf(grp_sum<8>(q) * (1.0f / 64.f) + 64e-5f);
#pragma unroll
    for (int i = 0; i < 8; ++i) y0[i] = (y0[i] * rs * lw[i] + lb[i] + bn[i]) * g[i];
    st8((bf16*)(ws + WS_Y) + (size_t)t * D_ + 512 + c0, y0);
}
typedef short s16x8 __attribute__((ext_vector_type(8)));
typedef short s16x4 __attribute__((ext_vector_type(4)));
typedef LAS unsigned char* ldsp;
DI f32x4 mfma16(s16x8 a, s16x8 b, f32x4 c) { return __builtin_amdgcn_mfma_f32_16x16x32_bf16(a, b, c, 0, 0, 0); }
DI s16x8 frag_row(ldsp img, int row0, int col0, int lane) { return *(LAS const s16x8*)(img + (row0 + (lane & 15)) * 128 + (col0 + 8 * (lane >> 4)) * 2); }
DI s16x4 tr16(ldsp p) { return __builtin_bit_cast(s16x4, __builtin_amdgcn_ds_read_tr16_b64_v4i16((LAS s16x4*)p)); }
DI s16x8 frag_tr(ldsp img, int row0, int col0, int lane) {
    ldsp a0 = img + (row0 + 8 * (lane >> 4) + ((lane & 15) >> 2)) * 128 + col0 * 2 + 8 * (lane & 3);
    const s16x4 lo = tr16(a0), hi = tr16(a0 + 4 * 128);
    return __builtin_shufflevector(lo, hi, 0, 1, 2, 3, 4, 5, 6, 7);
}
DI void ctile_to_img(ldsp img, int mt, int nt, const f32x4& c, int lane) {
    LAS bf16* p = (LAS bf16*)(img + (16 * mt + 4 * (lane >> 4)) * 128 + (16 * nt + (lane & 15)) * 2);
#pragma unroll
    for (int e = 0; e < 4; ++e) p[e * 64] = (bf16)f2bf(c[e]);
}
#define CFENCE() asm volatile("" ::: "memory")
#define MM_LOOPH(ACC, AEXPR, BEXPR) _Pragma("unroll") for (int mt = 2 * mh; mt < 2 * mh + 2; ++mt) _Pragma("unroll") for (int nt = 0; nt < 4; ++nt) _Pragma("unroll") for (int ks = 0; ks < 2; ++ks) ACC[mt][nt] = mfma16((AEXPR), (BEXPR), ACC[mt][nt])
#define MM_LOOP(ACC, AEXPR, BEXPR) _Pragma("unroll") for (int mt = 0; mt < 4; ++mt) _Pragma("unroll") for (int nt = 0; nt < 4; ++nt) _Pragma("unroll") for (int ks = 0; ks < 2; ++ks) ACC[mt][nt] = mfma16((AEXPR), (BEXPR), ACC[mt][nt])

DI int tok_of(int z, int cn, int i) { return z ? cn * 64 + 63 - i : cn * 64 + i; }

#ifndef P1_SKIP_SUBST
#define P1_SKIP_SUBST 0
#endif
struct P1NoWork { DI void operator()() const {} };
template <int ROLE> DI void p1_sync(volatile LAS unsigned* fl, unsigned& ep, int lane) {
    LDS_WAIT(); CFENCE();
    if constexpr (ROLE != 0) {
        ++ep; if (lane == 0) fl[ROLE - 1] = ep;
        while (__builtin_amdgcn_readfirstlane((int)fl[2 - ROLE]) < (int)ep) __builtin_amdgcn_s_sleep(1);
        CFENCE();
    }
}
template <bool DRY = false, int STOP = 99, int ROLE = 0, class PRE = P1NoWork, class MID = P1NoWork> DI void rwkv_pass1_item(unsigned char* ws, ldsp lds, int item, int lane, volatile LAS unsigned* fl = nullptr, unsigned* epp = nullptr, LAS float* gts = nullptr, const PRE& pre = PRE(), const MID& mid = MID()) {
    constexpr int MH0 = ROLE == 2 ? 1 : 0, MH1 = ROLE == 1 ? 1 : 2;
    unsigned ep_ = 0; unsigned& ep = epp ? *epp : ep_;
#define P1_SYNC() p1_sync<ROLE>(fl, ep, lane)
    asm volatile("" : "+v"(lane));
    const int z = item >> 11, h = (item >> 8) & 7, c = item & 255;
    const int cn = z ? 255 - c : c;
    float* LW = (float*)(ws + (z ? WS_LW1 : WS_LW0));
    bf16* KD = (bf16*)(ws + (z ? WS_KD1 : WS_KD0)); bf16* BB = (bf16*)(ws + (z ? WS_B1 : WS_B0));
    const bf16* KK = (const bf16*)(ws + WS_KK); const bf16* R = (const bf16*)(ws + WS_R); const bf16* V = (const bf16*)(ws + WS_V);
    float* LWo = DRY ? (float*)(ws + WS_Y) : LW; bf16* KDo = DRY ? (bf16*)(ws + WS_Y) : KD; bf16* BBo = DRY ? (bf16*)(ws + WS_Y) : BB;
    ldsp S0 = lds, S1 = lds + 8192, S2 = lds + 16384, S3 = lds + 24576, S4 = lds + 32768, S5 = lds + 40960, S6 = lds + 49152, S7 = lds + 57344;
    ldsp IA = S0, IB = S1, IK = S2, IR = S3;
    const int ch = h * 64 + lane;
    float G = 0.f;
    if constexpr (ROLE == 2) pre();
    else {
#pragma unroll 16
    for (int i = 0; i < 64; ++i) {
        const size_t o = (size_t)tok_of(z, cn, i) * 512 + ch;
        const float lw = LW[o], a = -bf2f(KK[o]), b = bf2f(BB[o]), kd = bf2f(KD[o]), r = bf2f(R[o]);
        const float eprev = __expf(G); G += lw; const float ecur = __expf(G), einv = __expf(-G);
        ((LAS bf16*)IA)[i * 64 + lane] = (bf16)f2bf(a * eprev); ((LAS bf16*)IB)[i * 64 + lane] = (bf16)f2bf(b * einv);
        ((LAS bf16*)IK)[i * 64 + lane] = (bf16)f2bf(kd * einv); ((LAS bf16*)IR)[i * 64 + lane] = (bf16)f2bf(r * ecur);
    }
    }
    float GT = __expf(G);
    if constexpr (ROLE == 1) gts[lane] = GT;
    P1_SYNC();
    if constexpr (ROLE == 2) GT = gts[lane];
    if (STOP == 1) { if (GT == 123.f) LWo[0] = GT; return; }
    int lane2 = lane; asm volatile("" : "+v"(lane2));
    const int n_ = lane2 & 15, q_ = lane2 >> 4;
    {
#pragma unroll
        for (int mh = MH0; mh < MH1; ++mh) {
        f32x4 acc[4][4];
#pragma unroll
        for (int mt = 2 * mh; mt < 2 * mh + 2; ++mt)
#pragma unroll
            for (int nt = 0; nt < 4; ++nt) acc[mt][nt] = (f32x4){0.f, 0.f, 0.f, 0.f};
        MM_LOOPH(acc, frag_row(IA, 16 * mt, 32 * ks, lane), frag_row(IB, 16 * nt, 32 * ks, lane));
#pragma unroll
        for (int mt = 2 * mh; mt < 2 * mh + 2; ++mt)
#pragma unroll
            for (int nt = 0; nt < 4; ++nt)
#pragma unroll
                for (int e = 0; e < 4; ++e) { const int i = 16 * mt + 4 * q_ + e, j = 16 * nt + n_; ((LAS float*)S4)[i * 64 + j] = (j < i) ? acc[mt][nt][e] : 0.f; }
        }
    }
    P1_SYNC();
    if (STOP == 4) return;
    if constexpr (ROLE != 2 && !(ROLE == 1 && P1_SKIP_SUBST)) {
        float t[64];
        int lane_o = lane; asm volatile("" : "+v"(lane_o));
        f32x4 ar[2][16];
#pragma unroll
        for (int i = 0; i < 64; ++i) {
            if (i + 1 < 64) {
#pragma unroll
                for (int jg = 0; jg < (i + 1 + 3) / 4; ++jg) ar[(i + 1) & 1][jg] = *(LAS const f32x4*)(S4 + ((i + 1) * 64 + 4 * jg) * 4);
            }
            __builtin_amdgcn_sched_barrier(0);
            float acc0 = (lane_o == i) ? 1.f : 0.f, acc1 = 0.f, acc2 = 0.f, acc3 = 0.f;
#pragma unroll
            for (int jg = 0; jg < (i + 3) / 4; ++jg) { const f32x4 a4 = ar[i & 1][jg];
                if (4 * jg + 0 < i) acc0 += a4[0] * t[4 * jg + 0];
                if (4 * jg + 1 < i) acc1 += a4[1] * t[4 * jg + 1];
                if (4 * jg + 2 < i) acc2 += a4[2] * t[4 * jg + 2];
                if (4 * jg + 3 < i) acc3 += a4[3] * t[4 * jg + 3]; }
            t[i] = (acc0 + acc1) + (acc2 + acc3);
            __builtin_amdgcn_sched_barrier(0);
        }
        LDS_WAIT(); CFENCE();
#pragma unroll
        for (int i = 0; i < 64; ++i) ((LAS bf16*)S4)[i * 64 + lane] = (bf16)f2bf(t[i]);
    }
    if constexpr (ROLE == 0) { LDS_WAIT(); CFENCE(); }
    if (STOP == 2) return;
    ldsp IT = S4, IW = S5, IAK = S6;
    if constexpr (ROLE != 1) {
#pragma unroll
        for (int mh = 0; mh < 2; ++mh) {
        f32x4 acc[4][4];
#pragma unroll
        for (int mt = 2 * mh; mt < 2 * mh + 2; ++mt)
#pragma unroll
            for (int nt = 0; nt < 4; ++nt) acc[mt][nt] = (f32x4){0.f, 0.f, 0.f, 0.f};
        MM_LOOPH(acc, frag_row(IA, 16 * mt, 32 * ks, lane), frag_row(IK, 16 * nt, 32 * ks, lane));
#pragma unroll
        for (int mt = 2 * mh; mt < 2 * mh + 2; ++mt)
#pragma unroll
            for (int nt = 0; nt < 4; ++nt) {
#pragma unroll
                for (int e = 0; e < 4; ++e) { const int i = 16 * mt + 4 * q_ + e, j = 16 * nt + n_; if (!(j < i)) acc[mt][nt][e] = 0.f; }
                ctile_to_img(IAK, mt, nt, acc[mt][nt], lane); }
        }
    }
    if constexpr (ROLE == 2) mid();
    if constexpr (ROLE != 0) P1_SYNC();
    if (STOP == 5) return;
    {
#pragma unroll
        for (int mh = MH0; mh < MH1; ++mh) {
        f32x4 acc[4][4];
#pragma unroll
        for (int mt = 2 * mh; mt < 2 * mh + 2; ++mt)
#pragma unroll
            for (int nt = 0; nt < 4; ++nt) acc[mt][nt] = (f32x4){0.f, 0.f, 0.f, 0.f};
        MM_LOOPH(acc, frag_row(IT, 16 * mt, 32 * ks, lane), frag_tr(IA, 32 * ks, 16 * nt, lane));
#pragma unroll
        for (int mt = 2 * mh; mt < 2 * mh + 2; ++mt)
#pragma unroll
            for (int nt = 0; nt < 4; ++nt) ctile_to_img(IW, mt, nt, acc[mt][nt], lane);
        }
    }
    P1_SYNC();
    if (STOP == 6) return;
    ldsp IV = S0;
    {
        v4u vr[8];
#pragma unroll
        for (int it = 4 * MH0; it < 4 * MH1; ++it) vr[it] = *(const v4u*)(V + (size_t)tok_of(z, cn, (lane >> 3) + 8 * it) * 512 + h * 64 + (lane & 7) * 8);
#pragma unroll
        for (int it = 4 * MH0; it < 4 * MH1; ++it) *(LAS v4u*)(IV + ((lane >> 3) + 8 * it) * 128 + (lane & 7) * 16) = vr[it];
    }
    P1_SYNC();
    ldsp IAV = S7;
    {
#pragma unroll
        for (int mh = MH0; mh < MH1; ++mh) {
        f32x4 acc[4][4];
#pragma unroll
        for (int mt = 2 * mh; mt < 2 * mh + 2; ++mt)
#pragma unroll
            for (int nt = 0; nt < 4; ++nt) acc[mt][nt] = (f32x4){0.f, 0.f, 0.f, 0.f};
        MM_LOOPH(acc, frag_row(IAK, 16 * mt, 32 * ks, lane), frag_tr(IV, 32 * ks, 16 * nt, lane));
#pragma unroll
        for (int mt = 2 * mh; mt < 2 * mh + 2; ++mt)
#pragma unroll
            for (int nt = 0; nt < 4; ++nt) ctile_to_img(IAV, mt, nt, acc[mt][nt], lane);
        }
    }
    P1_SYNC();
    if (STOP == 7) return;
    ldsp IU = S6;
    {
#pragma unroll
        for (int mh = MH0; mh < MH1; ++mh) {
        f32x4 acc[4][4];
#pragma unroll
        for (int mt = 2 * mh; mt < 2 * mh + 2; ++mt)
#pragma unroll
            for (int nt = 0; nt < 4; ++nt) acc[mt][nt] = (f32x4){0.f, 0.f, 0.f, 0.f};
        MM_LOOPH(acc, frag_row(IT, 16 * mt, 32 * ks, lane), frag_tr(IAV, 32 * ks, 16 * nt, lane));
        LDS_WAIT(); CFENCE();
#pragma unroll
        for (int mt = 2 * mh; mt < 2 * mh + 2; ++mt)
#pragma unroll
            for (int nt = 0; nt < 4; ++nt) ctile_to_img(IU, mt, nt, acc[mt][nt], lane);
        }
    }
    P1_SYNC();
    if (STOP == 3) return;
    ldsp IRB = S4, IRK = S7;
    {
#pragma unroll
        for (int mh = MH0; mh < MH1; ++mh) {
        f32x4 acc[4][4];
#pragma unroll
        for (int mt = 2 * mh; mt < 2 * mh + 2; ++mt)
#pragma unroll
            for (int nt = 0; nt < 4; ++nt) acc[mt][nt] = (f32x4){0.f, 0.f, 0.f, 0.f};
        MM_LOOPH(acc, frag_row(IR, 16 * mt, 32 * ks, lane), frag_row(IB, 16 * nt, 32 * ks, lane));
#pragma unroll
        for (int mt = 2 * mh; mt < 2 * mh + 2; ++mt)
#pragma unroll
            for (int nt = 0; nt < 4; ++nt) {
#pragma unroll
                for (int e = 0; e < 4; ++e) { const int i = 16 * mt + 4 * q_ + e, j = 16 * nt + n_; if (!(j <= i)) acc[mt][nt][e] = 0.f; }
                ctile_to_img(IRB, mt, nt, acc[mt][nt], lane); }
        }
    }
    {
#pragma unroll
        for (int mh = MH0; mh < MH1; ++mh) {
        f32x4 acc[4][4];
#pragma unroll
        for (int mt = 2 * mh; mt < 2 * mh + 2; ++mt)
#pragma unroll
            for (int nt = 0; nt < 4; ++nt) acc[mt][nt] = (f32x4){0.f, 0.f, 0.f, 0.f};
        MM_LOOPH(acc, frag_row(IR, 16 * mt, 32 * ks, lane), frag_row(IK, 16 * nt, 32 * ks, lane));
#pragma unroll
        for (int mt = 2 * mh; mt < 2 * mh + 2; ++mt)
#pragma unroll
            for (int nt = 0; nt < 4; ++nt) {
#pragma unroll
                for (int e = 0; e < 4; ++e) { const int i = 16 * mt + 4 * q_ + e, j = 16 * nt + n_; if (!(j <= i)) acc[mt][nt][e] = 0.f; }
                ctile_to_img(IRK, mt, nt, acc[mt][nt], lane); }
        }
    }
    P1_SYNC();
    int lane3 = lane; asm volatile("" : "+v"(lane3));
    const int n3 = lane3 & 15, q3 = lane3 >> 4;
    const size_t slot0 = (size_t)cn * 64 * 512 + h * 64;
    {
#pragma unroll
        for (int mh = MH0; mh < MH1; ++mh) {
        f32x4 acc[4][4];
#pragma unroll
        for (int mt = 2 * mh; mt < 2 * mh + 2; ++mt)
#pragma unroll
            for (int nt = 0; nt < 4; ++nt) { const s16x4 r4 = *(LAS const s16x4*)(IR + (16 * nt + n3) * 128 + (16 * mt + 4 * q3) * 2);
#pragma unroll
                for (int e = 0; e < 4; ++e) acc[mt][nt][e] = bf2f((bf16)r4[e]); }
        MM_LOOPH(acc, frag_tr(IW, 32 * ks, 16 * mt, lane), frag_row(IRB, 16 * nt, 32 * ks, lane));
#pragma unroll
        for (int mt = 2 * mh; mt < 2 * mh + 2; ++mt)
#pragma unroll
            for (int nt = 0; nt < 4; ++nt) { bf16* dst = (bf16*)(LWo + slot0 + (size_t)(16 * nt + n3) * 512) + 16 * mt + 4 * q3;
                *(unsigned long long*)dst = (unsigned long long)pk2(acc[mt][nt][0], acc[mt][nt][1]) | ((unsigned long long)pk2(acc[mt][nt][2], acc[mt][nt][3]) << 32); }
        }
    }
    {
#pragma unroll
        for (int mh = MH0; mh < MH1; ++mh) {
        f32x4 acc[4][4];
#pragma unroll
        for (int mt = 2 * mh; mt < 2 * mh + 2; ++mt)
#pragma unroll
            for (int nt = 0; nt < 4; ++nt) acc[mt][nt] = (f32x4){0.f, 0.f, 0.f, 0.f};
        MM_LOOPH(acc, frag_tr(IU, 32 * ks, 16 * mt, lane), frag_row(IRB, 16 * nt, 32 * ks, lane));
        MM_LOOPH(acc, frag_tr(IV, 32 * ks, 16 * mt, lane), frag_row(IRK, 16 * nt, 32 * ks, lane));
#pragma unroll
        for (int mt = 2 * mh; mt < 2 * mh + 2; ++mt)
#pragma unroll
            for (int nt = 0; nt < 4; ++nt) { bf16* dst = (bf16*)(LWo + slot0 + (size_t)(16 * nt + n3) * 512) + 64 + 16 * mt + 4 * q3;
                *(unsigned long long*)dst = (unsigned long long)pk2(acc[mt][nt][0], acc[mt][nt][1]) | ((unsigned long long)pk2(acc[mt][nt][2], acc[mt][nt][3]) << 32); }
        }
    }
    {
#pragma unroll
        for (int mh = MH0; mh < MH1; ++mh) {
        f32x4 acc[4][4];
#pragma unroll
        for (int mt = 2 * mh; mt < 2 * mh + 2; ++mt)
#pragma unroll
            for (int nt = 0; nt < 4; ++nt) acc[mt][nt] = (f32x4){0.f, 0.f, 0.f, 0.f};
        MM_LOOPH(acc, frag_tr(IW, 32 * ks, 16 * mt, lane), frag_tr(IB, 32 * ks, 16 * nt, lane));
#pragma unroll
        for (int nt = 0; nt < 4; ++nt) { const float gk = __shfl(GT, 16 * nt + n3);
#pragma unroll
            for (int mt = 2 * mh; mt < 2 * mh + 2; ++mt) { float o[4];
#pragma unroll
                for (int e = 0; e < 4; ++e) o[e] = gk * (acc[mt][nt][e] + ((16 * mt + 4 * q3 + e) == (16 * nt + n3) ? 1.f : 0.f));
                bf16* dst = KDo + slot0 + (size_t)(16 * nt + n3) * 512 + 16 * mt + 4 * q3;
                *(unsigned long long*)dst = (unsigned long long)pk2(o[0], o[1]) | ((unsigned long long)pk2(o[2], o[3]) << 32); } }
        }
    }
    {
#pragma unroll
        for (int mh = MH0; mh < MH1; ++mh) {
        f32x4 acc[4][4];
#pragma unroll
        for (int mt = 2 * mh; mt < 2 * mh + 2; ++mt)
#pragma unroll
            for (int nt = 0; nt < 4; ++nt) acc[mt][nt] = (f32x4){0.f, 0.f, 0.f, 0.f};
        MM_LOOPH(acc, frag_tr(IB, 32 * ks, 16 * mt, lane), frag_tr(IU, 32 * ks, 16 * nt, lane));
        MM_LOOPH(acc, frag_tr(IK, 32 * ks, 16 * mt, lane), frag_tr(IV, 32 * ks, 16 * nt, lane));
#pragma unroll
        for (int mt = 2 * mh; mt < 2 * mh + 2; ++mt) { float gk[4];
#pragma unroll
            for (int e = 0; e < 4; ++e) gk[e] = __shfl(GT, 16 * mt + 4 * q3 + e);
#pragma unroll
            for (int nt = 0; nt < 4; ++nt) { bf16* dst = BBo + slot0 + (size_t)(16 * nt + n3) * 512 + 16 * mt + 4 * q3;
                *(unsigned long long*)dst = (unsigned long long)pk2(gk[0] * acc[mt][nt][0], gk[1] * acc[mt][nt][1]) | ((unsigned long long)pk2(gk[2] * acc[mt][nt][2], gk[3] * acc[mt][nt][3]) << 32); } }
        }
    }
    LDS_WAIT(); CFENCE();
#undef P1_SYNC
}
DI unsigned long long pk4(const f32x4& v) { return (unsigned long long)pk2(v[0], v[1]) | ((unsigned long long)pk2(v[2], v[3]) << 32); }
DI f32x4 unpk4(unsigned long long w) { return (f32x4){bflo((unsigned)w), bfhi((unsigned)w), bflo((unsigned)(w >> 32)), bfhi((unsigned)(w >> 32))}; }
DI s16x8 pack_cpair(const f32x4& lo, const f32x4& hi) {
    v4u p; p.x = pk2(lo[0], lo[1]); p.y = pk2(lo[2], lo[3]); p.z = pk2(hi[0], hi[1]); p.w = pk2(hi[2], hi[3]);
    return __builtin_bit_cast(s16x8, p);
}
DI void rwkv_pass2_wave(unsigned char* ws, int w  , int lane) {
    const int z = w >> 5, h = (w >> 2) & 7, vs = w & 3;
    const bf16* Mm = (const bf16*)(ws + (z ? WS_KD1 : WS_KD0)); const bf16* Nn = (const bf16*)(ws + (z ? WS_B1 : WS_B0));
    bf16* Hst = (bf16*)(ws + (z ? WS_V : WS_R));
    const int n_ = lane & 15, q_ = lane >> 4;
    f32x4 H[4];
#pragma unroll
    for (int kt = 0; kt < 4; ++kt) H[kt] = (f32x4){0.f, 0.f, 0.f, 0.f};
    unsigned long long ma[4][2][2], nn[4];
    {
        const int cn = z ? 255 : 0; const size_t slot0 = (size_t)cn * 64 * 512 + h * 64;
#pragma unroll
        for (int kt = 0; kt < 4; ++kt) {
#pragma unroll
            for (int ks = 0; ks < 2; ++ks) { const bf16* row = Mm + slot0 + (size_t)(16 * kt + n_) * 512 + 32 * ks + 4 * q_;
                ma[kt][ks][0] = *(const unsigned long long*)row; ma[kt][ks][1] = *(const unsigned long long*)(row + 16); }
            nn[kt] = *(const unsigned long long*)(Nn + slot0 + (size_t)(16 * vs + n_) * 512 + 16 * kt + 4 * q_); }
    }
    for (int c = 0; c < 256; ++c) {
        { bf16* dst = Hst + ((size_t)(c * 8 + h) * 64 + 16 * vs + n_) * 64 + 4 * q_;
#pragma unroll
          for (int kt = 0; kt < 4; ++kt) *(unsigned long long*)(dst + 16 * kt) = (unsigned long long)pk2(H[kt][0], H[kt][1]) | ((unsigned long long)pk2(H[kt][2], H[kt][3]) << 32); }
        unsigned long long ma2[4][2][2], nn2[4];
        { const int c2 = c + 1 < 256 ? c + 1 : c; const int cn = z ? 255 - c2 : c2; const size_t slot0 = (size_t)cn * 64 * 512 + h * 64;
#pragma unroll
          for (int kt = 0; kt < 4; ++kt) {
#pragma unroll
            for (int ks = 0; ks < 2; ++ks) { const bf16* row = Mm + slot0 + (size_t)(16 * kt + n_) * 512 + 32 * ks + 4 * q_;
                ma2[kt][ks][0] = *(const unsigned long long*)row; ma2[kt][ks][1] = *(const unsigned long long*)(row + 16); }
            nn2[kt] = *(const unsigned long long*)(Nn + slot0 + (size_t)(16 * vs + n_) * 512 + 16 * kt + 4 * q_); } }
        const s16x8 b0 = pack_cpair(H[0], H[1]), b1 = pack_cpair(H[2], H[3]);
#pragma unroll
        for (int kt = 0; kt < 4; ++kt) {
            f32x4 acc = (f32x4){bflo((unsigned)nn[kt]), bfhi((unsigned)nn[kt]), bflo((unsigned)(nn[kt] >> 32)), bfhi((unsigned)(nn[kt] >> 32))};
            { v4u a; a.x = (unsigned)ma[kt][0][0]; a.y = (unsigned)(ma[kt][0][0] >> 32); a.z = (unsigned)ma[kt][0][1]; a.w = (unsigned)(ma[kt][0][1] >> 32); acc = mfma16(__builtin_bit_cast(s16x8, a), b0, acc); }
            { v4u a; a.x = (unsigned)ma[kt][1][0]; a.y = (unsigned)(ma[kt][1][0] >> 32); a.z = (unsigned)ma[kt][1][1]; a.w = (unsigned)(ma[kt][1][1] >> 32); acc = mfma16(__builtin_bit_cast(s16x8, a), b1, acc); }
            H[kt] = acc;
        }
#pragma unroll
        for (int kt = 0; kt < 4; ++kt) { nn[kt] = nn2[kt];
#pragma unroll
            for (int ks = 0; ks < 2; ++ks) { ma[kt][ks][0] = ma2[kt][ks][0]; ma[kt][ks][1] = ma2[kt][ks][1]; } }
    }
}
DI void rwkv_pass3_item(unsigned char* ws, int item, int lane) {
    const int z = item >> 11, h = (item >> 8) & 7, c = item & 255;
    const int cn = z ? 255 - c : c;
    const float* LW = (const float*)(ws + (z ? WS_LW1 : WS_LW0));
    const bf16* Hst = (const bf16*)(ws + (z ? WS_V : WS_R)) + (size_t)(c * 8 + h) * 64 * 64;
    bf16* Y = (bf16*)(ws + (z ? WS_Y1 : WS_Y0));
    const int n_ = lane & 15, q_ = lane >> 4;
    const size_t slot0 = (size_t)cn * 64 * 512 + h * 64;
    s16x8 hA[4][2], qB[4][2];
#pragma unroll
    for (int t = 0; t < 4; ++t)
#pragma unroll
        for (int ks = 0; ks < 2; ++ks) {
            hA[t][ks] = *(const s16x8*)(Hst + (size_t)(16 * t + n_) * 64 + 32 * ks + 8 * q_);
            qB[t][ks] = *(const s16x8*)((const bf16*)(LW + slot0 + (size_t)(16 * t + n_) * 512) + 32 * ks + 8 * q_); }
#pragma unroll
    for (int nt = 0; nt < 4; ++nt) {
        const int i = 16 * nt + n_; const bf16* ycrow = (const bf16*)(LW + slot0 + (size_t)i * 512) + 64;
        bf16* yrow = Y + (size_t)tok_of(z, cn, i) * 512 + h * 64;
#pragma unroll
        for (int mt = 0; mt < 4; ++mt) {
            const unsigned long long y4 = *(const unsigned long long*)(ycrow + 16 * mt + 4 * q_);
            f32x4 acc = (f32x4){bflo((unsigned)y4), bfhi((unsigned)y4), bflo((unsigned)(y4 >> 32)), bfhi((unsigned)(y4 >> 32))};
            acc = mfma16(hA[mt][0], qB[nt][0], acc); acc = mfma16(hA[mt][1], qB[nt][1], acc);
            *(unsigned long long*)(yrow + 16 * mt + 4 * q_) = (unsigned long long)pk2(acc[0], acc[1]) | ((unsigned long long)pk2(acc[2], acc[3]) << 32);
        }
    }
}
DI void rwkv_pass2_block(unsigned char* ws, ldsp L, int b  , int wave, int lane) {
    const int z = b >> 3, h = b & 7;
    if (wave >= 4) {
        const int lw = wave - 4;
        const char* Mm = (const char*)(ws + (z ? WS_KD1 : WS_KD0)); const char* Nn = (const char*)(ws + (z ? WS_B1 : WS_B0));
#define RW_ISSUE(cc) do { const int c_ = (cc); if (c_ < 256) { const int cn_ = z ? 255 - c_ : c_; const size_t slot0 = ((size_t)cn_ * 64 * 512 + h * 64) * 2; ldsp slot = L + (c_ & 7) * 16384; \
            _Pragma("unroll") for (int k = 0; k < 4; ++k) { const int pid = lw * 4 + k; const int pr = pid & 7; const int row = 8 * pr + (lane >> 3), p = lane & 7, cch = p ^ (row & 7); \
                const char* src = (pid < 8 ? Mm : Nn) + slot0 + (size_t)row * 1024 + cch * 16; \
                __builtin_amdgcn_global_load_lds((const unsigned*)src, (LAS unsigned*)(slot + (pid < 8 ? 0 : 8192) + pr * 1024), 16, 0, 0); } } } while (0)
        RW_ISSUE(0); RW_ISSUE(1); RW_ISSUE(2); RW_ISSUE(3); RW_ISSUE(4); RW_ISSUE(5); RW_ISSUE(6);
        for (int c = 0; c < 256; ++c) {
            if (c < 250) asm volatile("s_waitcnt vmcnt(24)" ::: "memory"); else asm volatile("s_waitcnt vmcnt(0)" ::: "memory");
            __builtin_amdgcn_s_barrier();
            asm volatile("" ::: "memory");
            RW_ISSUE(c + 7);
        }
#undef RW_ISSUE
        asm volatile("s_waitcnt vmcnt(0)" ::: "memory");
        return;
    }
    const int vs = wave;
    bf16* Hst = (bf16*)(ws + (z ? WS_V : WS_R));
    const int n_ = lane & 15, q_ = lane >> 4, wbyte = (q_ & 1) * 8, sw = n_ & 7;
    f32x4 H[4];
#pragma unroll
    for (int kt = 0; kt < 4; ++kt) H[kt] = (f32x4){0.f, 0.f, 0.f, 0.f};
    for (int c = 0; c < 256; ++c) {
        { bf16* dst = Hst + ((size_t)(c * 8 + h) * 64 + 16 * vs + n_) * 64 + 4 * q_;
#pragma unroll
          for (int kt = 0; kt < 4; ++kt) *(unsigned long long*)(dst + 16 * kt) = pk4(H[kt]); }
        asm volatile("s_waitcnt lgkmcnt(0)" ::: "memory");
        __builtin_amdgcn_s_barrier();
        asm volatile("" ::: "memory");
        ldsp slot = L + (c & 7) * 16384;
        const s16x8 b0 = pack_cpair(H[0], H[1]), b1 = pack_cpair(H[2], H[3]);
#pragma unroll
        for (int kt = 0; kt < 4; ++kt) {
            ldsp nrow = slot + 8192 + (16 * vs + n_) * 128 + wbyte;
            f32x4 acc = unpk4(*(LAS const unsigned long long*)(nrow + (((2 * kt + (q_ >> 1)) ^ sw) * 16)));
            ldsp mrow = slot + (16 * kt + n_) * 128 + wbyte;
#pragma unroll
            for (int ks = 0; ks < 2; ++ks) { const int c0 = 4 * ks + (q_ >> 1);
                const unsigned long long a0 = *(LAS const unsigned long long*)(mrow + ((c0 ^ sw) * 16)), a1 = *(LAS const unsigned long long*)(mrow + (((c0 + 2) ^ sw) * 16));
                v4u a; a.x = (unsigned)a0; a.y = (unsigned)(a0 >> 32); a.z = (unsigned)a1; a.w = (unsigned)(a1 >> 32);
                acc = mfma16(__builtin_bit_cast(s16x8, a), ks == 0 ? b0 : b1, acc); }
            H[kt] = acc;
        }
    }
}
DI void rwkv_pass3_post_item(const Args& a, unsigned char* ws, int item, int lane) {
    asm volatile("" : "+v"(lane));
    const int h = item >> 8, cn = item & 255;
    const int n_ = lane & 15, q_ = lane >> 4;
    const size_t slot0 = (size_t)cn * 64 * 512 + h * 64;
    const float* LW0 = (const float*)(ws + WS_LW0); const float* LW1 = (const float*)(ws + WS_LW1);
    const bf16* H0 = (const bf16*)(ws + WS_R) + (size_t)(cn * 8 + h) * 4096;
    const bf16* H1 = (const bf16*)(ws + WS_V) + (size_t)((255 - cn) * 8 + h) * 4096;
    s16x8 hA0[4][2], hA1[4][2];
#pragma unroll
    for (int t = 0; t < 4; ++t)
#pragma unroll
        for (int ks = 0; ks < 2; ++ks) { hA0[t][ks] = *(const s16x8*)(H0 + (size_t)(16 * t + n_) * 64 + 32 * ks + 8 * q_); hA1[t][ks] = *(const s16x8*)(H1 + (size_t)(16 * t + n_) * 64 + 32 * ks + 8 * q_); }
#pragma unroll
    for (int nt = 0; nt < 4; ++nt) {
        const int i0 = 16 * nt + n_, i1 = 63 - i0;
        const bf16* q0 = (const bf16*)(LW0 + slot0 + (size_t)i0 * 512); const bf16* q1 = (const bf16*)(LW1 + slot0 + (size_t)i1 * 512);
        s16x8 qB0[2], qB1[2];
#pragma unroll
        for (int ks = 0; ks < 2; ++ks) { qB0[ks] = *(const s16x8*)(q0 + 32 * ks + 8 * q_); qB1[ks] = *(const s16x8*)(q1 + 32 * ks + 8 * q_); }
        f32x4 y[4]; float sum = 0.f;
#pragma unroll
        for (int mt = 0; mt < 4; ++mt) {
            f32x4 acc = unpk4(*(const unsigned long long*)(q0 + 64 + 16 * mt + 4 * q_)) + unpk4(*(const unsigned long long*)(q1 + 64 + 16 * mt + 4 * q_));
            acc = mfma16(hA0[mt][0], qB0[0], acc); acc = mfma16(hA0[mt][1], qB0[1], acc);
            acc = mfma16(hA1[mt][0], qB1[0], acc); acc = mfma16(hA1[mt][1], qB1[1], acc);
            y[mt] = acc; sum += (acc[0] + acc[1]) + (acc[2] + acc[3]);
        }
        sum += __shfl_xor(sum, 16); sum += __shfl_xor(sum, 32);
        const float mu = sum * (1.0f / 64.f); float sq = 0.f;
#pragma unroll
        for (int mt = 0; mt < 4; ++mt)
#pragma unroll
            for (int e = 0; e < 4; ++e) { y[mt][e] -= mu; sq += y[mt][e] * y[mt][e]; }
        sq += __shfl_xor(sq, 16); sq += __shfl_xor(sq, 32);
        const float rs = 1.0f / sqrtf(sq * (1.0f / 64.f) + 64e-5f);
        const size_t tok = (size_t)(cn * 64 + i0);
#pragma unroll
        for (int mt = 0; mt < 4; ++mt) { const int c0 = h * 64 + 16 * mt + 4 * q_;
            const f32x4 lw = *(const f32x4*)(a.in[19] + c0), lb = *(const f32x4*)(a.in[20] + c0);
            const f32x4 bn = unpk4(*(const unsigned long long*)((const bf16*)(ws + WS_BONUS) + tok * 512 + c0)), gt = unpk4(*(const unsigned long long*)((const bf16*)(ws + WS_GATE) + tok * 512 + c0));
            const f32x4 o = (y[mt] * rs * lw + lb + bn) * gt;
            *(unsigned long long*)((bf16*)(ws + WS_Y) + tok * D_ + 512 + c0) = pk4(o); }
    }
}
constexpr size_t WS_W2T = WS_TILE + 65536;
constexpr size_t WS_PARK = WS_Y;
DI s16x8 act_frag(const bf16* p, int mode) {
    float v[8]; ld8(p, v);
#pragma unroll
    for (int i = 0; i < 8; ++i) { if (mode == 0) v[i] = 1.0f - 2.0f / (__expf(2.0f * v[i]) + 1.0f); else if (mode == 2) v[i] = 1.0f / (1.0f + __expf(-v[i])); }
    v4u w; w.x = pk2(v[0], v[1]); w.y = pk2(v[2], v[3]); w.z = pk2(v[4], v[5]); w.w = pk2(v[6], v[7]);
    return __builtin_bit_cast(s16x8, w);
}
DI void ld4(const bf16* p, float (&v)[4]) { const unsigned long long w = *(const unsigned long long*)p; v[0] = bflo((unsigned)w); v[1] = bfhi((unsigned)w); v[2] = bflo((unsigned)(w >> 32)); v[3] = bfhi((unsigned)(w >> 32)); }
DI void st4(bf16* p, const float (&v)[4]) { *(unsigned long long*)p = (unsigned long long)pk2(v[0], v[1]) | ((unsigned long long)pk2(v[2], v[3]) << 32); }
template <bool WLDS> DI void prep0_rwkv_unit(const Args& a, unsigned char* ws_, ldsp wl, int tile, int h, int lane) {
    asm volatile("" : "+v"(lane));
    GAS unsigned char* wsg = (GAS unsigned char*)ws_; asm volatile("" : "+s"(wsg)); unsigned char* ws = (unsigned char*)wsg;
    const int t0 = tile * 16, n_ = lane & 15, q_ = lane >> 4, t = t0 + n_;
    const bf16* LR = (const bf16*)(ws + WS_LORA) + (size_t)t * LORA_N + 8 * q_;
    const bf16* P = (const bf16*)(ws + WS_PROJ0) + (size_t)t * EVEN_IN + 1536 + h * 64 + 4 * q_;
    const bool hp = t > 0, hn = t < S_ - 1;
    unsigned long long cu[3][4], pv[3][4], nx[3][4];
#pragma unroll
    for (int part = 0; part < 3; ++part)
#pragma unroll
        for (int mt = 0; mt < 4; ++mt) { const bf16* p = P + part * 512 + 16 * mt;
            cu[part][mt] = *(const unsigned long long*)p; pv[part][mt] = hp ? *(const unsigned long long*)(p - EVEN_IN) : 0ull; nx[part][mt] = hn ? *(const unsigned long long*)(p + EVEN_IN) : 0ull; }
    unsigned long long rkv[3][4];
#pragma unroll
    for (int part = 0; part < 3; ++part)
#pragma unroll
        for (int mt = 0; mt < 4; ++mt) { const int c0 = h * 64 + 16 * mt + 4 * q_;
            const f32x4 m0 = *(const f32x4*)(a.in[6] + part * 512 + c0), m1 = *(const f32x4*)(a.in[6] + 1536 + part * 512 + c0);
            const f32x4 c4 = unpk4(cu[part][mt]), p4 = unpk4(pv[part][mt]), n4 = unpk4(nx[part][mt]);
            rkv[part][mt] = pk4(c4 + m0 * (p4 - c4) + m1 * (n4 - c4)); }
    asm volatile("" ::: "memory");
    v4u lraw[12];
#pragma unroll
    for (int i = 0; i < 12; ++i) lraw[i] = *(const v4u*)(LR + 32 * i);
    float ss = 0.f;
#pragma unroll
    for (int mt = 0; mt < 4; ++mt) { const f32x4 kkw = *(const f32x4*)(a.in[16] + h * 64 + 16 * mt + 4 * q_);
        const f32x4 k4 = unpk4(rkv[1][mt]);
#pragma unroll
        for (int e = 0; e < 4; ++e) { const float x = k4[e] * kkw[e]; ss += x * x; } }
    ss += __shfl_xor(ss, 16); ss += __shfl_xor(ss, 32);
    const float rn = 1.0f / sqrtf(ss + 1e-6f);
    s16x8 lfr[12];
#pragma unroll
    for (int i = 0; i < 12; ++i) { float x[8]; const v4u w = lraw[i];
        x[0] = bflo(w.x); x[1] = bfhi(w.x); x[2] = bflo(w.y); x[3] = bfhi(w.y); x[4] = bflo(w.z); x[5] = bfhi(w.z); x[6] = bflo(w.w); x[7] = bfhi(w.w);
#pragma unroll
        for (int j = 0; j < 8; ++j) { if (i < 4) x[j] = 1.0f - 2.0f * __builtin_amdgcn_rcpf(__expf(2.0f * x[j]) + 1.0f); else if (i >= 8) x[j] = __builtin_amdgcn_rcpf(1.0f + __expf(-x[j])); }
        v4u o; o.x = pk2(x[0], x[1]); o.y = pk2(x[2], x[3]); o.z = pk2(x[4], x[5]); o.w = pk2(x[6], x[7]); lfr[i] = __builtin_bit_cast(s16x8, o); }
    float dotb = 0.f;
#pragma unroll
    for (int mt = 0; mt < 4; ++mt) {
        const int c0 = h * 64 + 16 * mt + 4 * q_;
        f32x4 aw0 = *(const f32x4*)(a.in[8] + c0), aw1 = *(const f32x4*)(a.in[8] + 512 + c0), aa0 = *(const f32x4*)(a.in[11] + c0), aa1 = *(const f32x4*)(a.in[11] + 512 + c0), ag = (f32x4){0.f, 0.f, 0.f, 0.f};
        const int rl = 16 * mt + n_, sw = rl & 7;
        if (WLDS) {
#pragma unroll
            for (int ks = 0; ks < 2; ++ks) { const int po = ((4 * ks + q_) ^ sw) * 16;
                aw0 = mfma16(*(LAS const s16x8*)(wl + rl * 128 + po), lfr[ks], aw0);
                aw1 = mfma16(*(LAS const s16x8*)(wl + 8192 + rl * 128 + po), lfr[2 + ks], aw1);
                aa0 = mfma16(*(LAS const s16x8*)(wl + 16384 + rl * 128 + po), lfr[4 + ks], aa0);
                aa1 = mfma16(*(LAS const s16x8*)(wl + 24576 + rl * 128 + po), lfr[6 + ks], aa1);
            }
#pragma unroll
            for (int ks = 0; ks < 4; ++ks) ag = mfma16(*(LAS const s16x8*)(wl + 32768 + rl * 256 + ((((4 * ks + q_) & 8) | (((4 * ks + q_) & 7) ^ sw)) * 16)), lfr[8 + ks], ag);
        } else {
            const bf16* W2T = (const bf16*)(ws + WS_W2T); const size_t cr = (size_t)(h * 64 + rl);
#pragma unroll
            for (int ks = 0; ks < 2; ++ks) {
                aw0 = mfma16(*(const s16x8*)(W2T + cr * 64 + 32 * ks + 8 * q_), lfr[ks], aw0);
                aw1 = mfma16(*(const s16x8*)(W2T + 32768 + cr * 64 + 32 * ks + 8 * q_), lfr[2 + ks], aw1);
                aa0 = mfma16(*(const s16x8*)(W2T + 65536 + cr * 64 + 32 * ks + 8 * q_), lfr[4 + ks], aa0);
                aa1 = mfma16(*(const s16x8*)(W2T + 98304 + cr * 64 + 32 * ks + 8 * q_), lfr[6 + ks], aa1);
            }
#pragma unroll
            for (int ks = 0; ks < 4; ++ks) ag = mfma16(*(const s16x8*)(W2T + 131072 + cr * 128 + 32 * ks + 8 * q_), lfr[8 + ks], ag);
        }
        const f32x4 kkw = *(const f32x4*)(a.in[16] + c0), kaw = *(const f32x4*)(a.in[17] + c0), rkw = *(const f32x4*)(a.in[18] + c0);
        float l0[4], l1[4], g4[4], d0[4], d1[4], kk4[4], b0[4], b1[4];
        const f32x4 r4 = unpk4(rkv[0][mt]), k4 = unpk4(rkv[1][mt]);
#pragma unroll
        for (int e = 0; e < 4; ++e) {
            l0[e] = -__expf(-__logf(1.0f + __expf(-aw0[e])) - 0.5f); l1[e] = -__expf(-__logf(1.0f + __expf(-aw1[e])) - 0.5f);
            const float i0 = __builtin_amdgcn_rcpf(1.0f + __expf(-aa0[e])), i1 = __builtin_amdgcn_rcpf(1.0f + __expf(-aa1[e])); g4[e] = ag[e];
            kk4[e] = k4[e] * kkw[e] * rn; b0[e] = kk4[e] * i0; b1[e] = kk4[e] * i1;
            d0[e] = k4[e] * (1.0f + (i0 - 1.0f) * kaw[e]); d1[e] = k4[e] * (1.0f + (i1 - 1.0f) * kaw[e]);
            dotb += r4[e] * (d0[e] + d1[e]) * rkw[e]; }
        const size_t o = (size_t)t * 512 + c0;
        *(f32x4*)((float*)(ws + WS_LW0) + o) = (f32x4){l0[0], l0[1], l0[2], l0[3]};
        *(f32x4*)((float*)(ws + WS_LW1) + o) = (f32x4){l1[0], l1[1], l1[2], l1[3]};
        *(unsigned long long*)((bf16*)(ws + WS_R) + o) = rkv[0][mt]; *(unsigned long long*)((bf16*)(ws + WS_V) + o) = rkv[2][mt]; st4((bf16*)(ws + WS_KK) + o, kk4); st4((bf16*)(ws + WS_KD0) + o, d0); st4((bf16*)(ws + WS_KD1) + o, d1);
        st4((bf16*)(ws + WS_B0) + o, b0); st4((bf16*)(ws + WS_B1) + o, b1); st4((bf16*)(ws + WS_GATE) + o, g4);
        if (!WLDS) asm volatile("" ::: "memory");
    }
    dotb += __shfl_xor(dotb, 16); dotb += __shfl_xor(dotb, 32);
#pragma unroll
    for (int mt = 0; mt < 4; ++mt) { float bo[4]; const f32x4 v4 = unpk4(rkv[2][mt]);
#pragma unroll
        for (int e = 0; e < 4; ++e) bo[e] = dotb * v4[e];
        st4((bf16*)(ws + WS_BONUS) + (size_t)t * 512 + h * 64 + 16 * mt + 4 * q_, bo); }
}
DI void prep0_stage_w2t(unsigned char* ws, ldsp wl, int h, int tid) {
    const bf16* W2T = (const bf16*)(ws + WS_W2T);
    for (int i = tid; i < 3072; i += 512) {
        if (i < 2048) { const int mtx = i >> 9, r = (i >> 3) & 63, c = i & 7;
            *(LAS v4u*)(wl + mtx * 8192 + r * 128 + ((c ^ (r & 7)) * 16)) = *(const v4u*)(W2T + (size_t)mtx * 32768 + (size_t)(h * 64 + r) * 64 + c * 8); }
        else { const int j = i - 2048, r = j >> 4, c = j & 15;
            *(LAS v4u*)(wl + 32768 + r * 256 + (((c & 8) | ((c & 7) ^ (r & 7))) * 16)) = *(const v4u*)(W2T + 131072 + (size_t)(h * 64 + r) * 128 + c * 8); }
    }
}
constexpr int AT_ACC = 0, AT_M = 65536, AT_L = 66560, AT_V = 67584;
DI void attn_unit(unsigned char* ws, ldsp L, int unit, int wave, int lane) {
    const int h = unit & 7, T0 = (unit >> 3) * 256;
    const bf16* QN = (const bf16*)(ws + WS_QN); const bf16* KN = (const bf16*)(ws + WS_KN); const bf16* VN = (const bf16*)(ws + WS_Y1);
    LAS float* accO = (LAS float*)(L + AT_ACC); LAS float* accM = (LAS float*)(L + AT_M); LAS float* accL = (LAS float*)(L + AT_L);
    ldsp Vst = L + AT_V + wave * 8192;
#pragma unroll 1
    for (int br = 0; br < 3; ++br) {
        const int d = br == 0 ? 1 : (br == 1 ? 4 : 16);
#pragma unroll 1
        for (int si = 0; si < 2; ++si) {
            int lane_s = lane; asm volatile("" : "+v"(lane_s));
            const int n_ = lane_s & 15, q_ = lane_s >> 4;
            const int sidx = wave + 8 * si;
            const int tb = br == 0 ? T0 + 16 * sidx : (br == 1 ? T0 + (sidx & 3) + 64 * (sidx >> 2) : T0 + sidx);
            s16x8 qf[2];
            { const bf16* qrow = QN + (size_t)(tb + d * n_) * 512 + h * 64 + 8 * q_; qf[0] = *(const s16x8*)qrow; qf[1] = *(const s16x8*)(qrow + 32); }
            v4u vreg[5][4];
#pragma unroll
            for (int pp = 0; pp < 5; ++pp)
#pragma unroll
                for (int it = 0; it < 4; ++it) { const int pc = lane + 64 * it, row = pc >> 3, ck = pc & 7;
                    int tk = tb + d * (32 * pp + row - 64); tk = tk < 0 ? 0 : (tk > S_ - 1 ? S_ - 1 : tk);
                    vreg[pp][it] = *(const v4u*)(VN + (size_t)tk * 512 + h * 64 + ck * 8); }
            f32x4 st[10]; st[9] = (f32x4){0.f, 0.f, 0.f, 0.f};
#pragma unroll
            for (int kt = 0; kt < 9; ++kt) {
                int tk = tb + d * (16 * kt + n_ - 64); tk = tk < 0 ? 0 : (tk > S_ - 1 ? S_ - 1 : tk);
                const bf16* krow = KN + (size_t)tk * 512 + h * 64 + 8 * q_;
                f32x4 acc = (f32x4){0.f, 0.f, 0.f, 0.f};
                acc = mfma16(*(const s16x8*)krow, qf[0], acc); acc = mfma16(*(const s16x8*)(krow + 32), qf[1], acc);
                st[kt] = acc;
            }
            float mx = -3.0e38f;
            const bool edge = (tb - 64 * d < 0) || (tb + d * 95 >= S_);
#pragma unroll
            for (int kt = 0; kt < 9; ++kt)
#pragma unroll
                for (int e = 0; e < 4; ++e) { const int j = 16 * kt + 4 * q_ + e;
                    bool ok = true;
                    if (kt == 0) ok = (j >= n_);
                    if (kt == 8) ok = (j <= n_ + 128);
                    if (edge) { const int tk = tb + d * (j - 64); ok = ok && (tk >= 0) && (tk < S_); }
                    st[kt][e] = ok ? st[kt][e] : -3.0e38f; mx = fmaxf(mx, st[kt][e]); }
            mx = fmaxf(mx, __shfl_xor(mx, 16)); mx = fmaxf(mx, __shfl_xor(mx, 32));
            float ls = 0.f;
#pragma unroll
            for (int kt = 0; kt < 9; ++kt)
#pragma unroll
                for (int e = 0; e < 4; ++e) { const float p = st[kt][e] > -1.0e38f ? __expf(st[kt][e] - mx) : 0.f; st[kt][e] = p; ls += p; }
            ls += __shfl_xor(ls, 16); ls += __shfl_xor(ls, 32);
            f32x4 O[4];
#pragma unroll
            for (int dt = 0; dt < 4; ++dt) O[dt] = (f32x4){0.f, 0.f, 0.f, 0.f};
#pragma unroll
            for (int pp = 0; pp < 5; ++pp) {
                ldsp vb = Vst + (pp & 1) * 4096;
#pragma unroll
                for (int it = 0; it < 4; ++it) { const int pc = lane + 64 * it, row = pc >> 3, ck = pc & 7; *(LAS v4u*)(vb + row * 128 + ck * 16) = vreg[pp][it]; }
                LDS_WAIT(); CFENCE();
                const s16x8 pa = pack_cpair(st[2 * pp], st[2 * pp + 1]);
                ldsp a0 = vb + (4 * q_ + ((lane & 15) >> 2)) * 128 + 8 * (lane & 3);
#pragma unroll
                for (int dt = 0; dt < 4; ++dt) { const s16x4 lo = tr16(a0 + 32 * dt), hi = tr16(a0 + 16 * 128 + 32 * dt);
                    O[dt] = mfma16(pa, __builtin_shufflevector(lo, hi, 0, 1, 2, 3, 4, 5, 6, 7), O[dt]); }
            }
            float ms[4], lsv[4]; int li[4];
#pragma unroll
            for (int e = 0; e < 4; ++e) { ms[e] = __shfl(mx, 4 * q_ + e); lsv[e] = __shfl(ls, 4 * q_ + e); li[e] = tb + d * (4 * q_ + e) - T0; }
            if (br == 0) {
#pragma unroll
                for (int e = 0; e < 4; ++e) {
#pragma unroll
                    for (int dt = 0; dt < 4; ++dt) accO[li[e] * 64 + 16 * dt + n_] = O[dt][e];
                    if (n_ == 0) { accM[li[e]] = ms[e]; accL[li[e]] = lsv[e]; } }
            } else {
                float fo[4], fn[4], mn[4], lo_[4];
#pragma unroll
                for (int e = 0; e < 4; ++e) { const float mo = accM[li[e]]; lo_[e] = accL[li[e]]; mn[e] = fmaxf(mo, ms[e]); fo[e] = __expf(mo - mn[e]); fn[e] = __expf(ms[e] - mn[e]); }
                LDS_WAIT(); CFENCE();
#pragma unroll
                for (int e = 0; e < 4; ++e) {
#pragma unroll
                    for (int dt = 0; dt < 4; ++dt) { LAS float* p = accO + li[e] * 64 + 16 * dt + n_; *p = *p * fo[e] + O[dt][e] * fn[e]; }
                    if (n_ == 0) { accM[li[e]] = mn[e]; accL[li[e]] = lo_[e] * fo[e] + lsv[e] * fn[e]; } }
            }
            LDS_WAIT(); CFENCE();
        }
        __syncthreads();
    }
    {
        const int tid = wave * 64 + lane, tl = tid >> 1, hf = tid & 1;
        const float il = 1.0f / accL[tl];
        const LAS float* src = accO + tl * 64 + 32 * hf; bf16* dst = (bf16*)(ws + WS_Y) + (size_t)(T0 + tl) * D_ + h * 64 + 32 * hf;
#pragma unroll
        for (int c = 0; c < 4; ++c) { const f32x4 a = *(LAS const f32x4*)(src + 8 * c), b = *(LAS const f32x4*)(src + 8 * c + 4);
            v4u w; w.x = pk2(a.x * il, a.y * il); w.y = pk2(a.z * il, a.w * il); w.z = pk2(b.x * il, b.y * il); w.w = pk2(b.z * il, b.w * il);
            *(v4u*)(dst + 8 * c) = w; }
    }
    __syncthreads();
}
constexpr size_t WS_SST = WS_PROJ1, WS_UB = WS_PROJ1 + 64 * MiB, WS_AT = WS_PROJ1 + 96 * MiB, WS_GC = WS_PROJ1 + 112 * MiB;
constexpr size_t WS_WN = WS_A + 112 * MiB, WS_KT = WS_A + 144 * MiB;
static_assert(WS_GC + 2048 * 64 * 4 <= WS_O0, "dn map");
template <int PITCH> DI s16x8 frag_row_p(ldsp img, int row0, int col0, int lane) { return *(LAS const s16x8*)(img + (row0 + (lane & 15)) * PITCH + (col0 + 8 * (lane >> 4)) * 2); }
template <int PITCH> DI s16x8 frag_tr_p(ldsp img, int row0, int col0, int lane) {
    ldsp a0 = img + (row0 + 8 * (lane >> 4) + ((lane & 15) >> 2)) * PITCH + col0 * 2 + 8 * (lane & 3);
    const s16x4 lo = tr16(a0), hi = tr16(a0 + 4 * PITCH);
    return __builtin_shufflevector(lo, hi, 0, 1, 2, 3, 4, 5, 6, 7);
}
constexpr int DN_LDS_PER_WAVE = 32768 + 512;
DI void dn_pass1_item(unsigned char* ws, ldsp lds, int item, int lane) {
    asm volatile("" : "+v"(lane));
    const int z = item >> 10, h = (item >> 8) & 3, c = item & 255, cn = z ? 255 - c : c;
    const bf16* Q = (const bf16*)(ws + WS_QD); const bf16* K = (const bf16*)(ws + WS_KD); const bf16* V = (const bf16*)(ws + WS_VD);
    ldsp IKd = lds, IVd = lds, LT = lds + 16384; LAS float* gcs = (LAS float*)(lds + 32768); LAS float* bts = gcs + 64;
    const int n_ = lane & 15, q_ = lane >> 4;
    {
        const int tok = tok_of(z, cn, lane);
        float gc = ((const float*)(ws + WS_GB))[(size_t)tok * 8 + z * 4 + h]; const float bt = ((const float*)(ws + WS_GB + 512 * 1024))[(size_t)tok * 8 + z * 4 + h];
#pragma unroll
        for (int o = 1; o < 64; o <<= 1) { const float t = __shfl_up(gc, o); if (lane >= o) gc += t; }
        gcs[lane] = gc; bts[lane] = bt; ((float*)(ws + WS_GC))[(size_t)item * 64 + lane] = gc;
    }
#pragma unroll 4
    for (int it = 0; it < 16; ++it) { const int p = lane + 64 * it, row = p >> 4, ck = p & 15; const size_t go = (size_t)tok_of(z, cn, row) * 512 + h * 128 + ck * 8;
        *(LAS v4u*)(IKd + row * 256 + ck * 16) = *(const v4u*)(K + go); }
    LDS_WAIT(); CFENCE();
    s16x8 kf[4][4];
#pragma unroll
    for (int rt = 0; rt < 4; ++rt)
#pragma unroll
        for (int ks = 0; ks < 4; ++ks) kf[rt][ks] = frag_row_p<256>(IKd, 16 * rt, 32 * ks, lane);
#pragma unroll
    for (int mt = 0; mt < 4; ++mt) { f32x4 gi, bi;
#pragma unroll
        for (int e = 0; e < 4; ++e) { gi[e] = gcs[16 * mt + 4 * q_ + e]; bi[e] = bts[16 * mt + 4 * q_ + e]; }
#pragma unroll
        for (int nt = 0; nt < 4; ++nt) { f32x4 acc = (f32x4){0.f, 0.f, 0.f, 0.f};
            if (nt <= mt) {
#pragma unroll
                for (int ks = 0; ks < 4; ++ks) acc = mfma16(kf[mt][ks], kf[nt][ks], acc); }
            const float gj = gcs[16 * nt + n_];
#pragma unroll
            for (int e = 0; e < 4; ++e) { const int i = 16 * mt + 4 * q_ + e, j = 16 * nt + n_; ((LAS float*)LT)[i * 64 + j] = (j < i) ? bi[e] * acc[e] * __expf(gi[e] - gj) : 0.f; } } }
    {
        bf16* At = (bf16*)(ws + WS_AT) + (size_t)item * 4096;
#pragma unroll
        for (int nt = 0; nt < 4; ++nt) { s16x8 qf[4]; const bf16* qrow = Q + (size_t)tok_of(z, cn, 16 * nt + n_) * 512 + h * 128 + 8 * q_;
#pragma unroll
            for (int ks = 0; ks < 4; ++ks) qf[ks] = *(const s16x8*)(qrow + 32 * ks);
            const float gi = gcs[16 * nt + n_];
#pragma unroll
            for (int mt = 0; mt < 4; ++mt) { f32x4 acc = (f32x4){0.f, 0.f, 0.f, 0.f};
                if (mt <= nt) {
#pragma unroll
                    for (int ks = 0; ks < 4; ++ks) acc = mfma16(kf[mt][ks], qf[ks], acc); }
                f32x4 o;
#pragma unroll
                for (int e = 0; e < 4; ++e) { const int j = 16 * mt + 4 * q_ + e, i = 16 * nt + n_; o[e] = (j <= i) ? acc[e] * __expf(gi - gcs[j]) : 0.f; }
                *(unsigned long long*)(At + (size_t)(16 * nt + n_) * 64 + 16 * mt + 4 * q_) = pk4(o); } }
    }
    LDS_WAIT(); CFENCE();
    {
        float t[64];
        int lane_o = lane; asm volatile("" : "+v"(lane_o));
        f32x4 ar[2][16];
#pragma unroll
        for (int i = 0; i < 64; ++i) {
            if (i + 1 < 64) {
#pragma unroll
                for (int jg = 0; jg < (i + 1 + 3) / 4; ++jg) ar[(i + 1) & 1][jg] = *(LAS const f32x4*)(LT + ((i + 1) * 64 + 4 * jg) * 4);
            }
            __builtin_amdgcn_sched_barrier(0);
            float acc0 = (lane_o == i) ? 1.f : 0.f, acc1 = 0.f, acc2 = 0.f, acc3 = 0.f;
#pragma unroll
            for (int jg = 0; jg < (i + 3) / 4; ++jg) { const f32x4 a4 = ar[i & 1][jg];
                if (4 * jg + 0 < i) acc0 -= a4[0] * t[4 * jg + 0];
                if (4 * jg + 1 < i) acc1 -= a4[1] * t[4 * jg + 1];
                if (4 * jg + 2 < i) acc2 -= a4[2] * t[4 * jg + 2];
                if (4 * jg + 3 < i) acc3 -= a4[3] * t[4 * jg + 3]; }
            t[i] = (acc0 + acc1) + (acc2 + acc3);
            __builtin_amdgcn_sched_barrier(0);
        }
        LDS_WAIT(); CFENCE();
        const float s1 = bts[lane], s2 = -s1 * __expf(gcs[lane]);
#pragma unroll
        for (int i = 0; i < 64; ++i) { ((LAS bf16*)LT)[i * 64 + lane] = (bf16)f2bf(t[i] * s1); ((LAS bf16*)(LT + 8192))[i * 64 + lane] = (bf16)f2bf(t[i] * s2); }
    }
    LDS_WAIT(); CFENCE();
    ldsp IT1 = LT, IT2 = LT + 8192;
    v4u vimg[16];
#pragma unroll
    for (int it = 0; it < 16; ++it) { const int p = lane + 64 * it, row = p >> 4, ck = p & 15; vimg[it] = *(const v4u*)(V + (size_t)tok_of(z, cn, row) * 512 + h * 128 + ck * 8); }
    {
        bf16* Wn = (bf16*)(ws + WS_WN) + (size_t)item * 8192;
        s16x8 tf[4][2];
#pragma unroll
        for (int nt = 0; nt < 4; ++nt)
#pragma unroll
            for (int ks = 0; ks < 2; ++ks) tf[nt][ks] = frag_row_p<128>(IT2, 16 * nt, 32 * ks, lane);
#pragma unroll
        for (int mt = 0; mt < 8; ++mt) { const s16x8 k0 = frag_tr_p<256>(IKd, 0, 16 * mt, lane), k1 = frag_tr_p<256>(IKd, 32, 16 * mt, lane);
            if (z == 0) { bf16* KT = (bf16*)(ws + WS_KT) + ((size_t)(h * 256 + cn) * 128 + 16 * mt + n_) * 64 + 8 * q_; *(s16x8*)KT = k0; *(s16x8*)(KT + 32) = k1; }
#pragma unroll
            for (int nt = 0; nt < 4; ++nt) { f32x4 acc = (f32x4){0.f, 0.f, 0.f, 0.f}; acc = mfma16(k0, tf[nt][0], acc); acc = mfma16(k1, tf[nt][1], acc);
                *(unsigned long long*)(Wn + (size_t)(16 * nt + n_) * 128 + 16 * mt + 4 * q_) = pk4(acc); } }
    }
    LDS_WAIT(); CFENCE();
#pragma unroll
    for (int it = 0; it < 16; ++it) { const int p = lane + 64 * it, row = p >> 4, ck = p & 15; *(LAS v4u*)(IVd + row * 256 + ck * 16) = vimg[it]; }
    LDS_WAIT(); CFENCE();
    {
        bf16* Ub = (bf16*)(ws + WS_UB) + (size_t)item * 8192;
        s16x8 tf[4][2];
#pragma unroll
        for (int mt = 0; mt < 4; ++mt)
#pragma unroll
            for (int ks = 0; ks < 2; ++ks) tf[mt][ks] = frag_row_p<128>(IT1, 16 * mt, 32 * ks, lane);
#pragma unroll
        for (int nt = 0; nt < 8; ++nt) { const s16x8 v0 = frag_tr_p<256>(IVd, 0, 16 * nt, lane), v1 = frag_tr_p<256>(IVd, 32, 16 * nt, lane);
#pragma unroll
            for (int mt = 0; mt < 4; ++mt) { f32x4 acc = (f32x4){0.f, 0.f, 0.f, 0.f}; acc = mfma16(tf[mt][0], v0, acc); acc = mfma16(tf[mt][1], v1, acc);
                *(unsigned long long*)(Ub + (size_t)(16 * nt + n_) * 64 + 16 * mt + 4 * q_) = pk4(acc); } }
    }
    LDS_WAIT(); CFENCE();
}
DI s16x8 pack_cpair_rev(const f32x4& lo, const f32x4& hi) { v4u p; p.x = pk2(lo[3], lo[2]); p.y = pk2(lo[1], lo[0]); p.z = pk2(hi[3], hi[2]); p.w = pk2(hi[1], hi[0]); return __builtin_bit_cast(s16x8, p); }
DI unsigned long long rev4(unsigned long long x) { return (x >> 48) | ((x >> 16) & 0xffff0000ull) | ((x << 16) & 0xffff00000000ull) | (x << 48); }
DI void dn_pass2_wave(unsigned char* ws, int w  , int lane) {
    const int z = w >> 5, h = (w >> 3) & 3, vs = w & 7;
    const int n_ = lane & 15, q_ = lane >> 4;
    f32x4 S[8];
#pragma unroll
    for (int kt = 0; kt < 8; ++kt) S[kt] = (f32x4){0.f, 0.f, 0.f, 0.f};
    for (int c = 0; c < 256; ++c) {
        const int item = (z * 4 + h) * 256 + c, cn = z ? 255 - c : c;
        const bf16* Wn = (const bf16*)(ws + WS_WN) + (size_t)item * 8192; const bf16* Ub = (const bf16*)(ws + WS_UB) + (size_t)item * 8192;
        const float* gcu = (const float*)(ws + WS_GC) + (size_t)item * 64;
        const bf16* KT = (const bf16*)(ws + WS_KT) + (size_t)(h * 256 + cn) * 128 * 64;
        bf16* Sst = (bf16*)(ws + WS_SST) + (size_t)item * 16384;
        f32x4 u[4], gv[4];
#pragma unroll
        for (int mt = 0; mt < 4; ++mt) { u[mt] = unpk4(*(const unsigned long long*)(Ub + (size_t)(16 * vs + n_) * 64 + 16 * mt + 4 * q_)); gv[mt] = *(const f32x4*)(gcu + 16 * mt + 4 * q_); }
        const float gl = gcu[63];
        unsigned long long wa[4][4][2], ka[8][2][2];
#pragma unroll
        for (int mt = 0; mt < 4; ++mt)
#pragma unroll
            for (int ks = 0; ks < 4; ++ks) { const bf16* row = Wn + (size_t)(16 * mt + n_) * 128 + 32 * ks + 4 * q_; wa[mt][ks][0] = *(const unsigned long long*)row; wa[mt][ks][1] = *(const unsigned long long*)(row + 16); }
#pragma unroll
        for (int kt = 0; kt < 8; ++kt)
#pragma unroll
            for (int ks = 0; ks < 2; ++ks) { const bf16* row = KT + (size_t)(16 * kt + n_) * 64;
                if (z == 0) { ka[kt][ks][0] = *(const unsigned long long*)(row + 32 * ks + 4 * q_); ka[kt][ks][1] = *(const unsigned long long*)(row + 32 * ks + 16 + 4 * q_); }
                else { ka[kt][ks][0] = rev4(*(const unsigned long long*)(row + 60 - 32 * ks - 4 * q_)); ka[kt][ks][1] = rev4(*(const unsigned long long*)(row + 44 - 32 * ks - 4 * q_)); } }
#pragma unroll
        for (int kt = 0; kt < 8; ++kt) *(unsigned long long*)(Sst + (size_t)(16 * vs + n_) * 128 + 16 * kt + 4 * q_) = pk4(S[kt]);
#pragma unroll
        for (int ks = 0; ks < 4; ++ks) { const s16x8 b = pack_cpair(S[2 * ks], S[2 * ks + 1]);
#pragma unroll
            for (int mt = 0; mt < 4; ++mt) { v4u a; a.x = (unsigned)wa[mt][ks][0]; a.y = (unsigned)(wa[mt][ks][0] >> 32); a.z = (unsigned)wa[mt][ks][1]; a.w = (unsigned)(wa[mt][ks][1] >> 32);
                u[mt] = mfma16(__builtin_bit_cast(s16x8, a), b, u[mt]); } }
#pragma unroll
        for (int mt = 0; mt < 4; ++mt)
#pragma unroll
            for (int e = 0; e < 4; ++e) u[mt][e] *= __expf(gl - gv[mt][e]);
        const float egl = __expf(gl);
        const s16x8 b0 = pack_cpair(u[0], u[1]), b1 = pack_cpair(u[2], u[3]);
#pragma unroll
        for (int kt = 0; kt < 8; ++kt) { f32x4 acc = S[kt] * egl;
            { v4u a; a.x = (unsigned)ka[kt][0][0]; a.y = (unsigned)(ka[kt][0][0] >> 32); a.z = (unsigned)ka[kt][0][1]; a.w = (unsigned)(ka[kt][0][1] >> 32); acc = mfma16(__builtin_bit_cast(s16x8, a), b0, acc); }
            { v4u a; a.x = (unsigned)ka[kt][1][0]; a.y = (unsigned)(ka[kt][1][0] >> 32); a.z = (unsigned)ka[kt][1][1]; a.w = (unsigned)(ka[kt][1][1] >> 32); acc = mfma16(__builtin_bit_cast(s16x8, a), b1, acc); }
            S[kt] = acc; }
    }
}
DI void dn_pass3_item(unsigned char* ws, int item, int lane) {
    asm volatile("" : "+v"(lane));
    const int z = item >> 10, h = (item >> 8) & 3, c = item & 255, cn = z ? 255 - c : c;
    const int n_ = lane & 15, q_ = lane >> 4;
    const bf16* Q = (const bf16*)(ws + WS_QD);
    const bf16* Wn = (const bf16*)(ws + WS_WN) + (size_t)item * 8192; const bf16* Ub = (const bf16*)(ws + WS_UB) + (size_t)item * 8192;
    const bf16* At = (const bf16*)(ws + WS_AT) + (size_t)item * 4096; const float* gcu = (const float*)(ws + WS_GC) + (size_t)item * 64;
    const bf16* Sst = (const bf16*)(ws + WS_SST) + (size_t)item * 16384;
    bf16* O = (bf16*)(ws + (z ? WS_O1 : WS_O0));
    s16x8 wf[4][4], qf[4][4]; unsigned long long af[4][2][2]; float eg[4];
#pragma unroll
    for (int t = 0; t < 4; ++t) {
        const bf16* qrow = Q + (size_t)tok_of(z, cn, 16 * t + n_) * 512 + h * 128 + 8 * q_;
#pragma unroll
        for (int ks = 0; ks < 4; ++ks) { wf[t][ks] = *(const s16x8*)(Wn + (size_t)(16 * t + n_) * 128 + 32 * ks + 8 * q_); qf[t][ks] = *(const s16x8*)(qrow + 32 * ks); }
#pragma unroll
        for (int ks = 0; ks < 2; ++ks) { const bf16* arow = At + (size_t)(16 * t + n_) * 64 + 32 * ks + 4 * q_; af[t][ks][0] = *(const unsigned long long*)arow; af[t][ks][1] = *(const unsigned long long*)(arow + 16); }
        eg[t] = __expf(gcu[16 * t + n_]);
    }
#pragma unroll
    for (int mt = 0; mt < 8; ++mt) {
        s16x8 sf[4];
#pragma unroll
        for (int ks = 0; ks < 4; ++ks) sf[ks] = *(const s16x8*)(Sst + (size_t)(16 * mt + n_) * 128 + 32 * ks + 8 * q_);
        f32x4 u[4];
#pragma unroll
        for (int jt = 0; jt < 4; ++jt) { u[jt] = unpk4(*(const unsigned long long*)(Ub + (size_t)(16 * mt + n_) * 64 + 16 * jt + 4 * q_));
#pragma unroll
            for (int ks = 0; ks < 4; ++ks) u[jt] = mfma16(wf[jt][ks], sf[ks], u[jt]); }
        const s16x8 ua0 = pack_cpair(u[0], u[1]), ua1 = pack_cpair(u[2], u[3]);
#pragma unroll
        for (int nt = 0; nt < 4; ++nt) {
            f32x4 acc = (f32x4){0.f, 0.f, 0.f, 0.f};
#pragma unroll
            for (int ks = 0; ks < 4; ++ks) acc = mfma16(sf[ks], qf[nt][ks], acc);
            acc = acc * eg[nt];
            { v4u b; b.x = (unsigned)af[nt][0][0]; b.y = (unsigned)(af[nt][0][0] >> 32); b.z = (unsigned)af[nt][0][1]; b.w = (unsigned)(af[nt][0][1] >> 32); acc = mfma16(ua0, __builtin_bit_cast(s16x8, b), acc); }
            { v4u b; b.x = (unsigned)af[nt][1][0]; b.y = (unsigned)(af[nt][1][0] >> 32); b.z = (unsigned)af[nt][1][1]; b.w = (unsigned)(af[nt][1][1] >> 32); acc = mfma16(ua1, __builtin_bit_cast(s16x8, b), acc); }
            *(unsigned long long*)(O + (size_t)tok_of(z, cn, 16 * nt + n_) * 512 + h * 128 + 16 * mt + 4 * q_) = pk4(acc);
        }
    }
}
constexpr int DN_SLOT = 41984, DN_GRP = 16;
constexpr size_t WS_MG = WS_END_OLD, WS_NG = WS_END_OLD + 4 * MiB, WS_SG = WS_END_OLD + 8 * MiB;
DI void dn_scan_block(unsigned char* ws, ldsp L, const int Z, const int MODE, int h, int hv, int g, int wave, int lane) {
    const int item0 = (Z * 4 + h) * 256, cb = g * DN_GRP, zhg = (Z * 4 + h) * 16 + g;
    if (wave >= 4) {
        const int lw = wave - 4;
        unsigned so[11], ld[11];
#pragma unroll
        for (int k = 0; k < 4; ++k) { const int pid = lw * 4 + k; const int row = 4 * pid + (lane >> 4), p = lane & 15, cch = p ^ (row & 15); so[k] = row * 256 + cch * 16; ld[k] = pid * 1024 + lane * 16; }
#pragma unroll
        for (int k = 0; k < 4; ++k) { const int pid = lw * 4 + k; const int row = 8 * pid + (lane >> 3), p = lane & 7, cch = p ^ (row & 7); so[4 + k] = row * 128 + cch * 16; ld[4 + k] = 16384 + pid * 1024 + lane * 16; }
#pragma unroll
        for (int k = 0; k < 2; ++k) { const int pid = lw * 2 + k; const int row = 8 * pid + (lane >> 3), p = lane & 7, cch = p ^ (row & 7); so[8 + k] = row * 128 + cch * 16; ld[8 + k] = 32768 + pid * 1024 + lane * 16; }
        so[10] = lane * 16; ld[10] = 40960 + lane * 16;
        v4u rA[11], rB[11];
#define DN_GLOAD(R, ss) do { const int s_ = (ss) < DN_GRP ? (ss) : DN_GRP - 1; const int c_ = cb + s_; const int cn_ = Z ? 255 - c_ : c_; \
            const char* wsrc = (const char*)((const bf16*)(ws + WS_WN) + (size_t)(item0 + c_) * 8192); const char* ksrc = (const char*)((const bf16*)(ws + WS_KT) + (size_t)(h * 256 + cn_) * 8192); \
            const char* usrc = (const char*)((const bf16*)(ws + WS_UB) + (size_t)(item0 + c_) * 8192 + hv * 4096); const char* gsrc = (const char*)((const float*)(ws + WS_GC) + (size_t)(item0 + c_) * 64); \
            _Pragma("unroll") for (int k = 0; k < 4; ++k) R[k] = *(const v4u*)(wsrc + so[k]); \
            _Pragma("unroll") for (int k = 4; k < 8; ++k) R[k] = *(const v4u*)(ksrc + so[k]); \
            _Pragma("unroll") for (int k = 8; k < 10; ++k) R[k] = *(const v4u*)(usrc + so[k]); \
            if (lw == 0) R[10] = *(const v4u*)(gsrc + so[10]); } while (0)
#define DN_LWRITE(R, ss) do { ldsp slot = L + ((ss) % 3) * DN_SLOT; \
            _Pragma("unroll") for (int k = 0; k < 10; ++k) *(LAS v4u*)(slot + ld[k]) = R[k]; \
            if (lw == 0) *(LAS v4u*)(slot + ld[10]) = R[10]; } while (0)
        DN_GLOAD(rA, 0); DN_GLOAD(rB, 1); DN_LWRITE(rA, 0); DN_LWRITE(rB, 1);
        DN_GLOAD(rA, 2); DN_GLOAD(rB, 3);
#define DN_LSTEP(R, ss) do { asm volatile("s_waitcnt lgkmcnt(0)" ::: "memory"); __builtin_amdgcn_s_barrier(); asm volatile("" ::: "memory"); \
            DN_LWRITE(R, (ss) + 2); DN_GLOAD(R, (ss) + 4); } while (0)
        for (int s2 = 0; s2 < DN_GRP; s2 += 2) { DN_LSTEP(rA, s2); DN_LSTEP(rB, s2 + 1); }
#undef DN_LSTEP
#undef DN_LWRITE
#undef DN_GLOAD
        asm volatile("s_waitcnt vmcnt(0) lgkmcnt(0)" ::: "memory");
        return;
    }
    const int vs = 4 * hv + wave;
    const int n_ = lane & 15, q_ = lane >> 4, wbyte = (q_ & 1) * 8, sw = n_ & 7;
    int kao[2][2];
#pragma unroll
    for (int ks = 0; ks < 2; ++ks) { const int r0 = Z ? 60 - 32 * ks - 4 * q_ : 32 * ks + 4 * q_, r1 = Z ? r0 - 16 : r0 + 16; kao[ks][0] = (((r0 >> 3) ^ sw) * 16) + (r0 & 7) * 2; kao[ks][1] = (((r1 >> 3) ^ sw) * 16) + (r1 & 7) * 2; }
    const float ubm = MODE == 2 ? 0.f : 1.f;
    f32x4 S[8];
    if (MODE == 0) { const bf16* SG = (const bf16*)(ws + WS_SG) + (size_t)zhg * 16384;
#pragma unroll
        for (int kt = 0; kt < 8; ++kt) S[kt] = unpk4(*(const unsigned long long*)(SG + (size_t)(16 * vs + n_) * 128 + 16 * kt + 4 * q_)); }
    else {
#pragma unroll
        for (int kt = 0; kt < 8; ++kt)
#pragma unroll
            for (int e = 0; e < 4; ++e) S[kt][e] = (MODE == 2 && (16 * kt + 4 * q_ + e) == (16 * vs + n_)) ? 1.f : 0.f; }
    for (int s = 0; s < DN_GRP; ++s) {
        const int c = cb + s;
        if (MODE == 0) { bf16* Sst = (bf16*)(ws + WS_SST) + (size_t)(item0 + c) * 16384;
#pragma unroll
            for (int kt = 0; kt < 8; ++kt) *(unsigned long long*)(Sst + (size_t)(16 * vs + n_) * 128 + 16 * kt + 4 * q_) = pk4(S[kt]); }
        asm volatile("s_waitcnt lgkmcnt(0)" ::: "memory");
        __builtin_amdgcn_s_barrier();
        asm volatile("" ::: "memory");
        ldsp slot = L + (s % 3) * DN_SLOT;
        f32x4 u[4], gv[4]; unsigned long long wa[4][4][2], ka[8][2][2];
        { ldsp urow = slot + 32768 + (16 * wave + n_) * 128 + wbyte;
#pragma unroll
          for (int mt = 0; mt < 4; ++mt) { u[mt] = unpk4(*(LAS const unsigned long long*)(urow + (((2 * mt + (q_ >> 1)) ^ sw) * 16))) * ubm; gv[mt] = *(LAS const f32x4*)(slot + 40960 + (16 * mt + 4 * q_) * 4); } }
        const float gl = *(LAS const float*)(slot + 40960 + 63 * 4);
#pragma unroll
        for (int ks = 0; ks < 4; ++ks)
#pragma unroll
            for (int mt = 0; mt < 4; ++mt) { ldsp row = slot + (16 * mt + n_) * 256 + wbyte; const int c0 = 4 * ks + (q_ >> 1);
                wa[mt][ks][0] = *(LAS const unsigned long long*)(row + ((c0 ^ n_) * 16)); wa[mt][ks][1] = *(LAS const unsigned long long*)(row + (((c0 + 2) ^ n_) * 16)); }
        __builtin_amdgcn_sched_barrier(0);
#pragma unroll
        for (int ks = 0; ks < 4; ++ks) { const s16x8 bb = pack_cpair(S[2 * ks], S[2 * ks + 1]);
#pragma unroll
            for (int mt = 0; mt < 4; ++mt) { v4u a; a.x = (unsigned)wa[mt][ks][0]; a.y = (unsigned)(wa[mt][ks][0] >> 32); a.z = (unsigned)wa[mt][ks][1]; a.w = (unsigned)(wa[mt][ks][1] >> 32);
                u[mt] = mfma16(__builtin_bit_cast(s16x8, a), bb, u[mt]); } }
        __builtin_amdgcn_sched_barrier(0);
#pragma unroll
        for (int kt = 0; kt < 8; ++kt) { ldsp row = slot + 16384 + (16 * kt + n_) * 128;
#pragma unroll
            for (int ks = 0; ks < 2; ++ks) { ka[kt][ks][0] = *(LAS const unsigned long long*)(row + kao[ks][0]); ka[kt][ks][1] = *(LAS const unsigned long long*)(row + kao[ks][1]); } }
        __builtin_amdgcn_sched_barrier(0);
#pragma unroll
        for (int mt = 0; mt < 4; ++mt)
#pragma unroll
            for (int e = 0; e < 4; ++e) u[mt][e] *= __expf(gl - gv[mt][e]);
        const float egl = __expf(gl);
#pragma unroll
        for (int mt = 0; mt < 4; ++mt) { const f32x4 t = u[mt]; u[mt][0] = Z ? t[3] : t[0]; u[mt][1] = Z ? t[2] : t[1]; u[mt][2] = Z ? t[1] : t[2]; u[mt][3] = Z ? t[0] : t[3]; }
        const s16x8 b0 = pack_cpair(u[0], u[1]), b1 = pack_cpair(u[2], u[3]);
#pragma unroll
        for (int kt = 0; kt < 8; ++kt) { f32x4 acc = S[kt] * egl;
#pragma unroll
            for (int ks = 0; ks < 2; ++ks) { const unsigned long long a0 = ka[kt][ks][0], a1 = ka[kt][ks][1];
                v4u a; a.x = (unsigned)a0; a.y = (unsigned)(a0 >> 32); a.z = (unsigned)a1; a.w = (unsigned)(a1 >> 32);
                acc = mfma16(__builtin_bit_cast(s16x8, a), ks == 0 ? b0 : b1, acc); }
            S[kt] = acc; }
    }
    if (MODE == 1) { bf16* NG = (bf16*)(ws + WS_NG) + (size_t)zhg * 16384;
#pragma unroll
        for (int kt = 0; kt < 8; ++kt) *(unsigned long long*)(NG + (size_t)(16 * vs + n_) * 128 + 16 * kt + 4 * q_) = pk4(S[kt]); }
    if (MODE == 2) { bf16* MG = (bf16*)(ws + WS_MG) + (size_t)zhg * 16384;
#pragma unroll
        for (int kt = 0; kt < 8; ++kt)
#pragma unroll
            for (int e = 0; e < 4; ++e) MG[(size_t)(16 * kt + 4 * q_ + e) * 128 + 16 * vs + n_] = (bf16)f2bf(S[kt][e]); }
}
DI void dn_scan_groups_block(unsigned char* ws, ldsp L, int zh, int wave, int lane) {
    const int vs = wave, n_ = lane & 15, q_ = lane >> 4, tid = wave * 64 + lane;
    f32x4 S[8];
#pragma unroll
    for (int kt = 0; kt < 8; ++kt) S[kt] = (f32x4){0.f, 0.f, 0.f, 0.f};
    v4u rg[8];
#define GB_LOAD(gg) do { const size_t zhg_ = (size_t)(zh * 16 + (gg)) * 16384; const bf16* MG_ = (const bf16*)(ws + WS_MG) + zhg_; const bf16* NG_ = (const bf16*)(ws + WS_NG) + zhg_; \
        _Pragma("unroll") for (int i = 0; i < 8; ++i) { const int p = tid + 512 * i; rg[i] = *(const v4u*)(((p >> 11) ? NG_ : MG_) + (size_t)((p >> 4) & 127) * 128 + (p & 15) * 8); } } while (0)
#define GB_WRITE(buf) do { _Pragma("unroll") for (int i = 0; i < 8; ++i) { const int p = tid + 512 * i, r = (p >> 4) & 127, c = p & 15; \
        *(LAS v4u*)(L + (buf) * 65536 + (p >> 11) * 32768 + r * 256 + ((c ^ (r & 15)) * 16)) = rg[i]; } } while (0)
    GB_LOAD(0); GB_WRITE(0); GB_LOAD(1);
    LDS_WAIT(); __syncthreads();
    for (int g = 0; g < 16; ++g) {
        bf16* SG = (bf16*)(ws + WS_SG) + (size_t)(zh * 16 + g) * 16384;
#pragma unroll
        for (int kt = 0; kt < 8; ++kt) *(unsigned long long*)(SG + (size_t)(16 * vs + n_) * 128 + 16 * kt + 4 * q_) = pk4(S[kt]);
        if (g == 15) break;
        if (g + 1 < 15) { GB_WRITE((g + 1) & 1); if (g + 2 < 15) GB_LOAD(g + 2); }
        ldsp buf = L + (g & 1) * 65536;
        s16x8 bb[4];
#pragma unroll
        for (int ks = 0; ks < 4; ++ks) bb[ks] = pack_cpair(S[2 * ks], S[2 * ks + 1]);
#pragma unroll
        for (int kt = 0; kt < 8; ++kt) {
            const int nr = 16 * vs + n_; const int nc = 2 * kt + (q_ >> 1);
            f32x4 acc = unpk4(*(LAS const unsigned long long*)(buf + 32768 + nr * 256 + ((nc ^ (nr & 15)) * 16) + (q_ & 1) * 8));
            const int mr = 16 * kt + n_;
#pragma unroll
            for (int ks = 0; ks < 4; ++ks) { const int c0 = 4 * ks + (q_ >> 1);
                const unsigned long long a0 = *(LAS const unsigned long long*)(buf + mr * 256 + ((c0 ^ (mr & 15)) * 16) + (q_ & 1) * 8), a1 = *(LAS const unsigned long long*)(buf + mr * 256 + (((c0 + 2) ^ (mr & 15)) * 16) + (q_ & 1) * 8);
                v4u a; a.x = (unsigned)a0; a.y = (unsigned)(a0 >> 32); a.z = (unsigned)a1; a.w = (unsigned)(a1 >> 32);
                acc = mfma16(__builtin_bit_cast(s16x8, a), bb[ks], acc); }
            S[kt] = acc; }
        LDS_WAIT(); __syncthreads();
    }
#undef GB_LOAD
#undef GB_WRITE
}
struct Prep1W { float c[3][8], d[3][3][8]; };
DI void prep1_load_w(const Args& a, int lane, Prep1W& W) { const int c0 = 8 * lane;
#pragma unroll
    for (int k = 0; k < 3; ++k) { ld8f(a.in[28] + k * 512 + c0, W.c[k]);
#pragma unroll
        for (int part = 0; part < 3; ++part) ld8f(a.in[29] + k * 1536 + part * 512 + c0, W.d[k][part]); } }
DI void prep1_token(const Args& a, unsigned char* ws, int t, int lane, const Prep1W& W) {
    const bf16* P = (const bf16*)(ws + WS_PROJ1) + (size_t)t * ODD_PAD;
    const int c0 = 8 * lane; const bool hp = t > 0, hn = t < S_ - 1;
    const bf16* Pp = hp ? P - ODD_PAD : P; const bf16* Pn = hn ? P + ODD_PAD : P; const float fp = hp ? 1.f : 0.f, fn = hn ? 1.f : 0.f;
    float z8[8];
#pragma unroll
    for (int i = 0; i < 8; ++i) z8[i] = 0.f;
    {
        float cb[8], cc[8], cx[8], pc[8], px[8], nc[8], nx[8], o[8];
        ld8(P + c0, cb); ld8(P + 512 + c0, cc); ld8(P + 1024 + c0, cx);
        ld8(Pp + 512 + c0, pc); ld8(Pp + 1024 + c0, px); ld8(Pn + 512 + c0, nc); ld8(Pn + 1024 + c0, nx);
#pragma unroll
        for (int i = 0; i < 8; ++i) { pc[i] *= fp; nc[i] *= fn; }
#pragma unroll
        for (int i = 0; i < 8; ++i) o[i] = cb[i] * (W.c[0][i] * pc[i] * px[i] + W.c[1][i] * cc[i] * cx[i] + W.c[2][i] * nc[i] * nx[i]);
        st8((bf16*)(ws + WS_YCAT1) + (size_t)t * D_ + c0, o);
    }
#pragma unroll
    for (int part = 0; part < 3; ++part) {
        float cu[8], pv[8], nx[8], o[8];
        const int col = 1536 + part * 512 + c0;
        ld8(P + col, cu);
        ld8(Pp + col, pv); ld8(Pn + col, nx);
#pragma unroll
        for (int i = 0; i < 8; ++i) { pv[i] *= fp; nx[i] *= fn; }
        float ss = 0.f;
#pragma unroll
        for (int i = 0; i < 8; ++i) { o[i] = siluf_(W.d[0][part][i] * pv[i] + W.d[1][part][i] * cu[i] + W.d[2][part][i] * nx[i]); ss += o[i] * o[i]; }
        if (part < 2) { ss = grp_sum<16>(ss); const float rn = (1.0f / sqrtf(ss + 1e-6f)) * (part == 0 ? 0.08838834764831845f : 1.0f);
#pragma unroll
            for (int i = 0; i < 8; ++i) o[i] *= rn; }
        st8((bf16*)(ws + (part == 0 ? WS_QD : (part == 1 ? WS_KD : WS_VD))) + (size_t)t * 512 + c0, o);
    }
    *(v4u*)((bf16*)(ws + WS_YCAT1) + (size_t)t * D_ + 512 + c0) = *(const v4u*)(P + 3072 + c0);
    if (lane < 8) {
        const float bt = sigmoidf_(bf2f(P[3584 + lane])); const float al = bf2f(P[3592 + lane]);
        const float g = -__expf(a.in[30][lane]) * softplusf_(al + a.in[31][lane]);
        ((float*)(ws + WS_GB))[(size_t)t * 8 + lane] = g; ((float*)(ws + WS_GB + 512 * 1024))[(size_t)t * 8 + lane] = bt;
    }
}
DI void dn_scan_naive(unsigned char* ws, int w  , int lane) {
    const int z = w >> 9, h = (w >> 7) & 3, vc = w & 127;
    const bf16* Q = (const bf16*)(ws + WS_QD); const bf16* K = (const bf16*)(ws + WS_KD); const bf16* V = (const bf16*)(ws + WS_VD);
    const float* G = (const float*)(ws + WS_GB); const float* Bt = (const float*)(ws + WS_GB + 512 * 1024);
    bf16* O = (bf16*)(ws + (z ? WS_O1 : WS_O0));
    float s0 = 0.f, s1 = 0.f;
    int t = z ? S_ - 1 : 0; const int dt = z ? -1 : 1;
    size_t o = (size_t)t * 512 + h * 128;
    float k0 = bf2f(K[o + lane]), k1 = bf2f(K[o + 64 + lane]), q0 = bf2f(Q[o + lane]), q1 = bf2f(Q[o + 64 + lane]), vv = bf2f(V[o + vc]), g = G[(size_t)t * 8 + z * 4 + h], bt = Bt[(size_t)t * 8 + z * 4 + h];
    for (int s = 0; s < S_; ++s) {
        const int tn = (s + 1 < S_) ? t + dt : t; const size_t on = (size_t)tn * 512 + h * 128;
        const float k0n = bf2f(K[on + lane]), k1n = bf2f(K[on + 64 + lane]), q0n = bf2f(Q[on + lane]), q1n = bf2f(Q[on + 64 + lane]), vvn = bf2f(V[on + vc]), gn = G[(size_t)tn * 8 + z * 4 + h], btn = Bt[(size_t)tn * 8 + z * 4 + h];
        const float eg = __expf(g);
        const float dot = wave_sum(k0 * s0 + k1 * s1);
        const float cf = bt * (vv - eg * dot);
        s0 = eg * s0 + cf * k0; s1 = eg * s1 + cf * k1;
        const float ov = wave_sum(q0 * s0 + q1 * s1);
        if (lane == 0) O[(size_t)t * 512 + h * 128 + vc] = (bf16)f2bf(ov);
        k0 = k0n; k1 = k1n; q0 = q0n; q1 = q1n; vv = vvn; g = gn; bt = btn; t = tn;
    }
}
DI void dn_post_token(const Args& a, unsigned char* ws, int t, int lane) {
    const int c0 = 8 * lane; const size_t o = (size_t)t * 512 + c0;
    float o0[8], o1[8], zz[8], nw[8];
    ld8((const bf16*)(ws + WS_O0) + o, o0); ld8((const bf16*)(ws + WS_O1) + o, o1);
    ld8((const bf16*)(ws + WS_YCAT1) + (size_t)t * D_ + 512 + c0, zz); ld8f(a.in[32] + (c0 & 127), nw);
    float ss = 0.f;
#pragma unroll
    for (int i = 0; i < 8; ++i) { o0[i] += o1[i]; ss += o0[i] * o0[i]; }
    const float rs = 1.0f / sqrtf(grp_sum<16>(ss) * (1.0f / 128.f) + 1e-6f);
#pragma unroll
    for (int i = 0; i < 8; ++i) o0[i] = o0[i] * rs * nw[i] * siluf_(zz[i]);
    st8((bf16*)(ws + WS_YCAT1) + (size_t)t * D_ + 512 + c0, o0);
}
struct TokInfo { int e1, e2, s1, s2; float p1, p2; int pad0, pad1; };
struct RouterRegs { f32x4 r0[16], r1[16]; f32x4 w[4]; };
DI void route_load(const Args& a, RouterRegs& R, int lane) {
#pragma unroll
    for (int j = 0; j < 4; ++j) { R.w[j] = ((const f32x4*)a.in[34])[lane + 64 * j];
#pragma unroll
        for (int i = 0; i < 4; ++i) { const float* rr = a.in[35] + (size_t)(4 * lane + 256 * j + i) * 8; R.r0[4 * j + i] = *(const f32x4*)rr; R.r1[4 * j + i] = *(const f32x4*)(rr + 4); } }
}
constexpr size_t WS_BC = WS_TILE + 4096;
DI int sel8(const int (&v)[8], int e) { int r = 0;
#pragma unroll
    for (int k = 0; k < 8; ++k) r += v[k] & -(int)(e == k);
    return r; }
DI int wave_isum(int v) {
#pragma unroll
    for (int o = 1; o < 64; o <<= 1) v += __shfl_xor(v, o);
    return v; }
DI void route_eval(const RouterRegs& R, const float* x3, int t, int lane, int& e1, int& e2, float& p1, float& p2) {
    f32x4 v[4]; load_row(x3, t, lane, v); const float rs = row_rstd(v);
    float lg[8];
#pragma unroll
    for (int e = 0; e < 8; ++e) lg[e] = 0.f;
#pragma unroll
    for (int j = 0; j < 4; ++j)
#pragma unroll
        for (int i = 0; i < 4; ++i) { const float hv = v[j][i] * rs * R.w[j][i]; const f32x4 r0 = R.r0[4 * j + i], r1 = R.r1[4 * j + i];
            lg[0] += hv * r0.x; lg[1] += hv * r0.y; lg[2] += hv * r0.z; lg[3] += hv * r0.w; lg[4] += hv * r1.x; lg[5] += hv * r1.y; lg[6] += hv * r1.z; lg[7] += hv * r1.w; }
#pragma unroll
    for (int e = 0; e < 8; ++e) lg[e] = wave_sum(lg[e]);
    e1 = 0; float m1 = lg[0];
#pragma unroll
    for (int e = 1; e < 8; ++e) if (lg[e] > m1) { m1 = lg[e]; e1 = e; }
    e2 = -1; float m2 = -3.0e38f;
#pragma unroll
    for (int e = 0; e < 8; ++e) if (e != e1 && lg[e] > m2) { m2 = lg[e]; e2 = e; }
    const float x2 = __expf(m2 - m1); p1 = 1.0f / (1.0f + x2); p2 = x2 / (1.0f + x2);
}
DI void route_group(const RouterRegs& R, unsigned char* ws, const float* x3, LAS int* wc, int tg, int wave, int lane) {
    int cw[8];
#pragma unroll
    for (int e = 0; e < 8; ++e) cw[e] = 0;
    TokInfo* TI = (TokInfo*)(ws + WS_TOK) + (size_t)tg * 64 + wave * 8;
#pragma unroll 1
    for (int i = 0; i < 8; ++i) {
        int e1, e2; float p1, p2; route_eval(R, x3, tg * 64 + wave * 8 + i, lane, e1, e2, p1, p2);
        const int s1 = sel8(cw, e1);
#pragma unroll
        for (int e = 0; e < 8; ++e) cw[e] += (e == e1) ? 1 : 0;
        const int s2 = sel8(cw, e2);
#pragma unroll
        for (int e = 0; e < 8; ++e) cw[e] += (e == e2) ? 1 : 0;
        if (lane == 0) { v4u* rec = (v4u*)(TI + i); rec[0] = (v4u){(unsigned)e1, (unsigned)e2, (unsigned)s1, (unsigned)s2}; rec[1] = (v4u){__float_as_uint(p1), __float_as_uint(p2), 0u, 0u}; }
    }
    if (lane < 8) wc[wave * 8 + lane] = sel8(cw, lane);
    LDS_WAIT(); __syncthreads();
    int wb[8], bc[8];
#pragma unroll
    for (int e = 0; e < 8; ++e) { wb[e] = 0; bc[e] = 0;
#pragma unroll
        for (int w = 0; w < 8; ++w) { const int c = wc[w * 8 + e]; bc[e] += c; wb[e] += (w < wave) ? c : 0; } }
    if (wave == 0 && lane < 8) ((int*)(ws + WS_BC))[tg * 8 + lane] = sel8(bc, lane);
    if (lane < 8) { v4u* rec = (v4u*)(TI + lane); v4u r = rec[0]; r.z += (unsigned)sel8(wb, (int)r.x); r.w += (unsigned)sel8(wb, (int)r.y); rec[0] = r; }
    LDS_WAIT(); __syncthreads();
}
DI void moe_totals(const unsigned char* ws, int lane, int (&tot)[8]) {
    const int* BC = (const int*)(ws + WS_BC); int part[8];
#pragma unroll
    for (int e = 0; e < 8; ++e) part[e] = 0;
#pragma unroll
    for (int k = 0; k < 4; ++k) { const int r = lane + 64 * k;
#pragma unroll
        for (int e = 0; e < 8; ++e) part[e] += __hip_atomic_load(BC + r * 8 + e, __ATOMIC_RELAXED, __HIP_MEMORY_SCOPE_AGENT); }
#pragma unroll
    for (int e = 0; e < 8; ++e) tot[e] = __builtin_amdgcn_readfirstlane(wave_isum(part[e]));
}
DI void moe_offsets(const int (&tot)[8], int (&off)[9]) { int o = 0;
#pragma unroll
    for (int e = 0; e < 8; ++e) { off[e] = o; o += (tot[e] + 255) & ~255; }
    off[8] = o; }
DI void gather_group(const Args& a, unsigned char* ws, const float* x3, const int (&off)[9], int tg, int wave, int lane) {
    const int* BC = (const int*)(ws + WS_BC); int pre[8];
#pragma unroll
    for (int e = 0; e < 8; ++e) pre[e] = 0;
#pragma unroll
    for (int k = 0; k < 4; ++k) { const int r = lane + 64 * k;
#pragma unroll
        for (int e = 0; e < 8; ++e) { const int c = __hip_atomic_load(BC + r * 8 + e, __ATOMIC_RELAXED, __HIP_MEMORY_SCOPE_AGENT); pre[e] += (r < tg) ? c : 0; } }
#pragma unroll
    for (int e = 0; e < 8; ++e) pre[e] = __builtin_amdgcn_readfirstlane(wave_isum(pre[e])) + off[e];
    TokInfo* TI = (TokInfo*)(ws + WS_TOK) + (size_t)tg * 64 + wave * 8;
    unsigned char* A = ws + WS_AMOE8;
#pragma unroll 1
    for (int i = 0; i < 8; ++i) { const int t = tg * 64 + wave * 8 + i;
        f32x4 v[4]; load_row(x3, t, lane, v); const float rs = row_rstd(v);
#pragma unroll
        for (int j = 0; j < 4; ++j) v[j] = v[j] * rs * ((const f32x4*)a.in[34])[lane + 64 * j];
        v4u* rec = (v4u*)(TI + i); v4u r = rec[0];
        const int r1 = sel8(pre, (int)r.x) + (int)r.z, r2 = sel8(pre, (int)r.y) + (int)r.w;
        unsigned* o1 = (unsigned*)(A + (size_t)r1 * D_) + lane; unsigned* o2 = (unsigned*)(A + (size_t)r2 * D_) + lane;
#pragma unroll
        for (int j = 0; j < 4; ++j) { const unsigned w = pk4f8(v[j][0], v[j][1], v[j][2], v[j][3]); o1[64 * j] = w; o2[64 * j] = w; }
        if (lane == 0) { r.z = (unsigned)r1; r.w = (unsigned)r2; rec[0] = r; }
    }
}
DI void combine_token(unsigned char* ws, float* out, const int (&off)[9], int t, int lane) {
    const v4u* rec = (const v4u*)((const TokInfo*)(ws + WS_TOK) + t); const v4u ra = rec[0], rb = rec[1];
    struct { float p1, p2; } ti; ti.p1 = __uint_as_float(rb.x); ti.p2 = __uint_as_float(rb.y);
    const bf16* A = (const bf16*)(ws + WS_AMOE);
    const unsigned long long* r1 = (const unsigned long long*)(A + (size_t)ra.z * D_) + lane; const unsigned long long* r2 = (const unsigned long long*)(A + (size_t)ra.w * D_) + lane;
    f32x4* xo = (f32x4*)(out + (size_t)t * D_) + lane;
#pragma unroll
    for (int j = 0; j < 4; ++j) { const unsigned long long a1 = r1[64 * j], a2 = r2[64 * j]; f32x4 x = xo[64 * j];
        x.x += ti.p1 * bflo((unsigned)a1) + ti.p2 * bflo((unsigned)a2); x.y += ti.p1 * bfhi((unsigned)a1) + ti.p2 * bfhi((unsigned)a2);
        x.z += ti.p1 * bflo((unsigned)(a1 >> 32)) + ti.p2 * bflo((unsigned)(a2 >> 32)); x.w += ti.p1 * bfhi((unsigned)(a1 >> 32)) + ti.p2 * bfhi((unsigned)(a2 >> 32));
        xo[64 * j] = x; }
}
#ifndef PROBE
#define PROBE 0
#endif
#ifndef COPY_IN_P0
#define COPY_IN_P0 1
#endif
#ifndef PROBE_BUCKET
#define PROBE_BUCKET 3200u
#endif
#ifndef PROBE_SKIP
#define PROBE_SKIP 0
#endif
#ifndef PROBE_REP
#define PROBE_REP (-1)
#endif
constexpr int MOE_GU_SPLIT = 13056;
#ifndef PH_MASK
#define PH_MASK 0xFFFFFFFFu
#endif
DI unsigned char* ptr_opaque(unsigned char* p) { GAS unsigned char* g = (GAS unsigned char*)p; asm volatile("" : "+s"(g)); return (unsigned char*)g; }
DI int lane_opaque() { int l; asm volatile("v_mbcnt_lo_u32_b32 %0, -1, 0\n\tv_mbcnt_hi_u32_b32 %0, -1, %0" : "=v"(l)); return l; }
__global__ void __launch_bounds__(512, 2) fwd_kernel(Args args) {
    extern __shared__ __attribute__((aligned(16))) unsigned char lds[];
    LAS unsigned char* L = (LAS unsigned char*)lds;
    volatile LAS unsigned* MISC = (volatile LAS unsigned*)(L + MISC_OFF);
    const int tid = threadIdx.x, lane0 = tid & 63, wave = __builtin_amdgcn_readfirstlane(tid >> 6);
    const int G = gridDim.x, bx = blockIdx.x;
    const int gw = bx * 8 + wave, NGW = G * 8;
    unsigned char* ws0 = args.ws;
    if (tid < 128) ((LAS unsigned*)(L + LDS_ZERO_OFF))[tid] = 0u;
    __syncthreads();
    XcdBarrier bar = xcd_barrier_post((unsigned*)(ws0 + WS_CTL) + CW_BAR, MISC + 8);
    LAS float* scr = (LAS float*)(L + wave * 16384);
#if PROBE
    int tsi = 0;
#define GRID_BAR() do { xcd_barrier(bar, wave == 0); if (bx == 0 && tid == 0) { ((unsigned*)(ws0 + WS_CTL))[512 + tsi] = (unsigned)__builtin_amdgcn_s_memrealtime(); } ++tsi; } while (0)
    if (bx == 0 && tid == 0) ((unsigned*)(ws0 + WS_CTL))[511] = (unsigned)__builtin_amdgcn_s_memrealtime();
#else
#define GRID_BAR() xcd_barrier(bar, wave == 0)
#endif

    if constexpr ((PH_MASK >> 0) & 1) {
    const int lane = lane_opaque(); unsigned char* const ws = ptr_opaque(args.ws);
    {
        const float* const* in = args.in;
        for (int it = gw; ; it += NGW) {
            int r = it;
            if (transpose_job(r, in[3], 1024, 3072, 3072, (bf16*)(ws + WS_WIN0), 0, 0, 0, scr, lane)) continue;
            if (transpose_job(r, in[9], 1024, 64, 64, (bf16*)(ws + WS_WL), 0, 0, 0, scr, lane)) continue;
            if (transpose_job(r, in[9] + 65536, 1024, 64, 64, (bf16*)(ws + WS_WL), 64, 0, 0, scr, lane)) continue;
            if (transpose_job(r, in[12], 1024, 64, 64, (bf16*)(ws + WS_WL), 128, 0, 0, scr, lane)) continue;
            if (transpose_job(r, in[12] + 65536, 1024, 64, 64, (bf16*)(ws + WS_WL), 192, 0, 0, scr, lane)) continue;
            if (transpose_job(r, in[14], 1024, 128, 256, (bf16*)(ws + WS_WL), 256, 0, 0, scr, lane)) continue;
            if (transpose_job(r, in[21], 1024, 1024, 1024, (bf16*)(ws + WS_WOUT0), 0, 0, 0, scr, lane)) continue;
            if (transpose_job(r, in[10], 64, 512, 512, (bf16*)(ws + WS_W2T), 0, 0, 0, scr, lane)) continue;
            if (transpose_job(r, in[10] + 32768, 64, 512, 512, (bf16*)(ws + WS_W2T) + 32768, 0, 0, 0, scr, lane)) continue;
            if (transpose_job(r, in[13], 64, 512, 512, (bf16*)(ws + WS_W2T) + 65536, 0, 0, 0, scr, lane)) continue;
            if (transpose_job(r, in[13] + 32768, 64, 512, 512, (bf16*)(ws + WS_W2T) + 98304, 0, 0, 0, scr, lane)) continue;
            if (transpose_job(r, in[15], 128, 512, 512, (bf16*)(ws + WS_W2T) + 131072, 0, 0, 0, scr, lane)) continue;
            break;
        }
        norm_rows(args.in[0], args.in[2], args.in[7], (bf16*)(ws + WS_H), (bf16*)(ws + WS_HX), gw, NGW, lane);
        if (COPY_IN_P0) ffn_copy_loop(args, ws, scr, gw, NGW, 6656, lane);
    }
    if constexpr (PROBE_REP == 0) {
    {
        const float* const* in = args.in;
        for (int it = gw; ; it += NGW) {
            int r = it;
            if (transpose_job(r, in[3], 1024, 3072, 3072, (bf16*)(ws + WS_WIN0), 0, 0, 0, scr, lane)) continue;
            if (transpose_job(r, in[9], 1024, 64, 64, (bf16*)(ws + WS_WL), 0, 0, 0, scr, lane)) continue;
            if (transpose_job(r, in[9] + 65536, 1024, 64, 64, (bf16*)(ws + WS_WL), 64, 0, 0, scr, lane)) continue;
            if (transpose_job(r, in[12], 1024, 64, 64, (bf16*)(ws + WS_WL), 128, 0, 0, scr, lane)) continue;
            if (transpose_job(r, in[12] + 65536, 1024, 64, 64, (bf16*)(ws + WS_WL), 192, 0, 0, scr, lane)) continue;
            if (transpose_job(r, in[14], 1024, 128, 256, (bf16*)(ws + WS_WL), 256, 0, 0, scr, lane)) continue;
            if (transpose_job(r, in[21], 1024, 1024, 1024, (bf16*)(ws + WS_WOUT0), 0, 0, 0, scr, lane)) continue;
            if (transpose_job(r, in[10], 64, 512, 512, (bf16*)(ws + WS_W2T), 0, 0, 0, scr, lane)) continue;
            if (transpose_job(r, in[10] + 32768, 64, 512, 512, (bf16*)(ws + WS_W2T) + 32768, 0, 0, 0, scr, lane)) continue;
            if (transpose_job(r, in[13], 64, 512, 512, (bf16*)(ws + WS_W2T) + 65536, 0, 0, 0, scr, lane)) continue;
            if (transpose_job(r, in[13] + 32768, 64, 512, 512, (bf16*)(ws + WS_W2T) + 98304, 0, 0, 0, scr, lane)) continue;
            if (transpose_job(r, in[15], 128, 512, 512, (bf16*)(ws + WS_W2T) + 131072, 0, 0, 0, scr, lane)) continue;
            break;
        }
        norm_rows(args.in[0], args.in[2], args.in[7], (bf16*)(ws + WS_H), (bf16*)(ws + WS_HX), gw, NGW, lane);
    }
    }
    GRID_BAR();
    }
    if constexpr (PROBE_REP == 50) { for (int i = 0; i < 10; ++i) GRID_BAR(); }
    if constexpr ((PH_MASK >> 1) & 1) {
    const int lane = lane_opaque(); unsigned char* const ws = ptr_opaque(args.ws);
    {
        { pg8::Gemm g{(const bf16*)(ws + WS_H), (const bf16*)(ws + WS_WIN0), S_, EVEN_IN, D_}; pg8::StaticOrder S; S.init(S_, EVEN_IN, G, bx);
          pg8::EpiStoreBf16 E{(bf16*)(ws + WS_PROJ0), EVEN_IN, 0, nullptr}; pg8::gemm_phase<pg8::EpiStoreBf16, pg8::StaticOrder, true, true>(L, g, S, E, wave); }
        { pg8::Gemm g{(const bf16*)(ws + WS_HX), (const bf16*)(ws + WS_WL), S_, LORA_N, D_}; pg8::StaticOrder S; S.init(S_, LORA_N, G, bx);
          pg8::EpiStoreBf16 E{(bf16*)(ws + WS_LORA), LORA_N, 0, nullptr}; pg8::gemm_phase<pg8::EpiStoreBf16, pg8::StaticOrder, true, true>(L, g, S, E, wave); }
        if constexpr (PROBE_REP == 1) {
        { pg8::Gemm g{(const bf16*)(ws + WS_H), (const bf16*)(ws + WS_WIN0), S_, EVEN_IN, D_}; pg8::StaticOrder S; S.init(S_, EVEN_IN, G, bx);
          pg8::EpiStoreBf16 E{(bf16*)(ws + WS_PROJ0), EVEN_IN, 0, nullptr}; pg8::gemm_phase<pg8::EpiStoreBf16, pg8::StaticOrder, true, true>(L, g, S, E, wave); }
        { pg8::Gemm g{(const bf16*)(ws + WS_HX), (const bf16*)(ws + WS_WL), S_, LORA_N, D_}; pg8::StaticOrder S; S.init(S_, LORA_N, G, bx);
          pg8::EpiStoreBf16 E{(bf16*)(ws + WS_LORA), LORA_N, 0, nullptr}; pg8::gemm_phase<pg8::EpiStoreBf16, pg8::StaticOrder, true, true>(L, g, S, E, wave); }
        }
    }
    GRID_BAR();
    }
    if constexpr ((PH_MASK >> 2) & 1) {
    const int lane = lane_opaque(); unsigned char* const ws = ptr_opaque(args.ws);
    for (int t = gw; t < S_; t += NGW) prep0_token(args, ws, scr, t, lane);
    if constexpr (PROBE_REP == 30) { for (int t = gw; t < S_; t += NGW) prep0_token(args, ws, scr, t, lane); }
    }
    if constexpr ((PH_MASK >> 3) & 1) {
    const int lane = lane_opaque(); unsigned char* const ws = ptr_opaque(args.ws);
    {
        const int hh = bx & 7, nbh = (G - hh + 7) >> 3, rank = bx >> 3;
#define STEP_SYNC() do { asm volatile("s_waitcnt vmcnt(0) lgkmcnt(0)" ::: "memory"); __builtin_amdgcn_s_barrier(); asm volatile("" ::: "memory"); } while (0)
        constexpr int P1_FLAG_OFF = 131072 + 2 * 8448;
        if (tid < 8) ((LAS unsigned*)(L + P1_FLAG_OFF))[tid] = 0u;
        LDS_WAIT(); __syncthreads();
        if (wave < 2) {
            unsigned ep = 0; volatile LAS unsigned* fl = (volatile LAS unsigned*)(L + P1_FLAG_OFF) + 2 * wave; LAS float* gts = (LAS float*)(L + P1_FLAG_OFF + 64) + 64 * wave;
            for (int kk = -1; rank + nbh * (kk + 1) < 256 + nbh; ++kk) { const int cn = rank + nbh * kk, z = wave;
                if (kk >= 0 && cn < 256) rwkv_pass1_item<false, 99, 1>(ws, L + wave * 65536, z * 2048 + hh * 256 + (z ? 255 - cn : cn), lane, fl, &ep, gts); STEP_SYNC(); }
        } else if (wave < 6) {
            for (int kk = -1; rank + nbh * (kk + 1) < 256 + nbh; ++kk) { const int cn1 = rank + nbh * (kk + 1);
                if (cn1 < 256) prep0_rwkv_unit<false>(args, ws, L, 4 * cn1 + (wave - 2), hh, lane); STEP_SYNC(); }
        } else {
            const float* const* in = args.in; const int z = wave - 6; LAS float* scr2 = (LAS float*)(L + 131072 + z * 8448);
            unsigned ep = 0; volatile LAS unsigned* fl = (volatile LAS unsigned*)(L + P1_FLAG_OFF) + 2 * z; LAS float* gts = (LAS float*)(L + P1_FLAG_OFF + 64) + 64 * z;
            auto cp = [&](int j) __attribute__((always_inline)) { int r = bx * 2 + z + j * (G * 2);
                if (transpose_job(r, in[23], 1024, FF0, FF0, (bf16*)(ws + WS_WGU0), 0, 128, 0, scr2, lane)) return;
                if (transpose_job(r, in[24], 1024, FF0, FF0, (bf16*)(ws + WS_WGU0), 0, 128, 1, scr2, lane)) return;
                if (transpose_job(r, in[25], FF0, 1024, 1024, (bf16*)(ws + WS_WD0), 0, 0, 0, scr2, lane)) return;
                if (transpose_job(r, in[27], 1024, ODD_IN, ODD_PAD, (bf16*)(ws + WS_WIN1), 0, 0, 0, scr2, lane)) return;
                if (transpose_job(r, in[33], 1024, 1024, 1024, (bf16*)(ws + WS_WOUT1), 0, 0, 0, scr2, lane)) return; };
            for (int kk = -1; rank + nbh * (kk + 1) < 256 + nbh; ++kk) { const int cn = rank + nbh * kk;
                if (kk >= 0 && cn < 256) rwkv_pass1_item<false, 99, 2>(ws, L + z * 65536, z * 2048 + hh * 256 + (z ? 255 - cn : cn), lane, fl, &ep, gts, P1NoWork(), P1NoWork());
                STEP_SYNC(); }
        }
#undef STEP_SYNC
    }
    GRID_BAR();
    if (bx < 16) { rwkv_pass2_block(ws, L, bx, wave, lane); __syncthreads(); if constexpr (PROBE_REP == 4) { rwkv_pass2_block(ws, L, bx, wave, lane); __syncthreads(); } }
    else {
        for (int rep_ = 0; rep_ < (PROBE_REP == 3 ? 2 : 1); ++rep_) for (int unit = bx - 16; unit < 512; unit += G - 16) attn_unit(ws, L, unit, wave, lane); }
    GRID_BAR();
    for (int it = gw; it < 2048; it += NGW) rwkv_pass3_post_item(args, ws, it, lane);
    if constexpr (PROBE_REP == 63) { for (int it = gw; it < 2048; it += NGW) rwkv_pass3_post_item(args, ws, it, lane); }
    GRID_BAR();
    }
    if constexpr ((PH_MASK >> 5) & 1) {
    const int lane = lane_opaque(); unsigned char* const ws = ptr_opaque(args.ws);
    { pg8::Gemm g{(const bf16*)(ws + WS_Y), (const bf16*)(ws + WS_WOUT0), S_, D_, D_}; pg8::StaticOrder S; S.init(S_, D_, G, bx);
      pg8::EpiResF32 E{args.in[0], args.out, D_, nullptr, nullptr}; pg8::gemm_phase<pg8::EpiResF32, pg8::StaticOrder, true, true>(L, g, S, E, wave); }
    if constexpr (PROBE_REP == 7) {
    { pg8::Gemm g{(const bf16*)(ws + WS_Y), (const bf16*)(ws + WS_WOUT0), S_, D_, D_}; pg8::StaticOrder S; S.init(S_, D_, G, bx);
      pg8::EpiResF32 E{args.in[0], args.out, D_, nullptr, nullptr}; pg8::gemm_phase<pg8::EpiResF32, pg8::StaticOrder, true, true>(L, g, S, E, wave); }
    }
    GRID_BAR();
    }
    if constexpr ((PH_MASK >> 6) & 1) {
    const int lane = lane_opaque(); unsigned char* const ws = ptr_opaque(args.ws);
    norm_rows(args.out, args.in[22], nullptr, (bf16*)(ws + WS_H2), nullptr, gw, NGW, lane);
    GRID_BAR();
    }
    if constexpr ((PH_MASK >> 7) & 1) {
    const int lane = lane_opaque(); unsigned char* const ws = ptr_opaque(args.ws);
    { pg8::Gemm g{(const bf16*)(ws + WS_H2), (const bf16*)(ws + WS_WGU0), S_, 2 * FF0, D_}; pg8::StaticOrder S; S.init(S_, 2 * FF0, G, bx);
      pg8::EpiSwiGLU E{(bf16*)(ws + WS_ACT0), FF0, 0, nullptr}; pg8::gemm_phase<pg8::EpiSwiGLU, pg8::StaticOrder, true, true>(L, g, S, E, wave); }
    if constexpr (PROBE_REP == 9) {
    { pg8::Gemm g{(const bf16*)(ws + WS_H2), (const bf16*)(ws + WS_WGU0), S_, 2 * FF0, D_}; pg8::StaticOrder S; S.init(S_, 2 * FF0, G, bx);
      pg8::EpiSwiGLU E{(bf16*)(ws + WS_ACT0), FF0, 0, nullptr}; pg8::gemm_phase<pg8::EpiSwiGLU, pg8::StaticOrder, true, true>(L, g, S, E, wave); }
    }
    GRID_BAR();
    }
    if constexpr ((PH_MASK >> 8) & 1) {
    const int lane = lane_opaque(); unsigned char* const ws = ptr_opaque(args.ws);
    { pg8::Gemm g{(const bf16*)(ws + WS_ACT0), (const bf16*)(ws + WS_WD0), S_, D_, FF0}; pg8::StaticOrder S; S.init(S_, D_, G, bx);
      pg8::EpiResF32 E{args.out, args.out, D_, nullptr, nullptr}; pg8::gemm_phase<pg8::EpiResF32, pg8::StaticOrder, true, true>(L, g, S, E, wave); }
    GRID_BAR();
    }
    if constexpr ((PH_MASK >> 9) & 1) {
    const int lane = lane_opaque(); unsigned char* const ws = ptr_opaque(args.ws);
    norm_rows(args.out, args.in[26], nullptr, (bf16*)(ws + WS_H3), nullptr, gw, NGW, lane);
    GRID_BAR();
    }
    if constexpr ((PH_MASK >> 10) & 1) {
    const int lane = lane_opaque(); unsigned char* const ws = ptr_opaque(args.ws);
    { pg8::Gemm g{(const bf16*)(ws + WS_H3), (const bf16*)(ws + WS_WIN1), S_, ODD_PAD, D_}; pg8::StaticOrder S; S.init(S_, ODD_PAD, G, bx);
      pg8::EpiStoreBf16 E{(bf16*)(ws + WS_PROJ1), ODD_PAD, 0, nullptr}; pg8::gemm_phase<pg8::EpiStoreBf16, pg8::StaticOrder, true, true>(L, g, S, E, wave); }
    if constexpr (PROBE_REP == 12) {
    { pg8::Gemm g{(const bf16*)(ws + WS_H3), (const bf16*)(ws + WS_WIN1), S_, ODD_PAD, D_}; pg8::StaticOrder S; S.init(S_, ODD_PAD, G, bx);
      pg8::EpiStoreBf16 E{(bf16*)(ws + WS_PROJ1), ODD_PAD, 0, nullptr}; pg8::gemm_phase<pg8::EpiStoreBf16, pg8::StaticOrder, true, true>(L, g, S, E, wave); }
    }
    GRID_BAR();
    }
    if constexpr ((PH_MASK >> 11) & 1) {
    const int lane = lane_opaque(); unsigned char* const ws = ptr_opaque(args.ws);
    { Prep1W W; prep1_load_w(args, lane, W);
      for (int cn = bx; cn < 256; cn += G) for (int i = wave; i < 64; i += 8) prep1_token(args, ws, cn * 64 + i, lane, W); }
    GRID_BAR();
    }
    if constexpr ((PH_MASK >> 12) & 1) {
    const int lane = lane_opaque(); unsigned char* const ws = ptr_opaque(args.ws);
    {
        if (wave < 4) { const int z = wave & 1;
            for (int cn = bx; cn < 256; cn += G) for (int hh = (wave >> 1) * 2; hh < (wave >> 1) * 2 + 2; ++hh) dn_pass1_item(ws, L + wave * DN_LDS_PER_WAVE, (z * 4 + hh) * 256 + (z ? 255 - cn : cn), lane); }
        else if (wave < 7) {
            LAS float* scr2 = (LAS float*)(L + 4 * DN_LDS_PER_WAVE + (wave - 4) * 8448);
            moe_copy_loop<true>(args, ws, scr2, bx * 3 + (wave - 4), G * 3, MOE_GU_SPLIT, lane);
        }
    }
    GRID_BAR();
    { const int task = bx; if (task < 512) dn_scan_block(ws, L, task >> 8, (task & 3) < 2 ? 1 : 2, (task >> 6) & 3, task & 1, (task >> 2) & 15, wave, lane); __syncthreads(); }
    { const int task = bx + G; if (task < 512) dn_scan_block(ws, L, task >> 8, (task & 3) < 2 ? 1 : 2, (task >> 6) & 3, task & 1, (task >> 2) & 15, wave, lane); __syncthreads(); }
    if constexpr (PROBE_REP == 60) { { const int task = bx; if (task < 512) dn_scan_block(ws, L, task >> 8, (task & 3) < 2 ? 1 : 2, (task >> 6) & 3, task & 1, (task >> 2) & 15, wave, lane); __syncthreads(); }
      { const int task = bx + G; if (task < 512) dn_scan_block(ws, L, task >> 8, (task & 3) < 2 ? 1 : 2, (task >> 6) & 3, task & 1, (task >> 2) & 15, wave, lane); __syncthreads(); } }
    GRID_BAR();
    if (bx < 8) { dn_scan_groups_block(ws, L, bx, wave, lane); }
    else {
        moe_copy_loop<true>(args, ws, scr, MOE_GU_SPLIT + (bx - 8) * 8 + wave, (G - 8) * 8, 28672, lane);
    }
    GRID_BAR();
    { const int task = bx; if (task < 256) dn_scan_block(ws, L, task >> 7, 0, (task >> 5) & 3, (task >> 4) & 1, task & 15, wave, lane); __syncthreads(); }
    if constexpr (PROBE_REP == 62) { const int task = bx; if (task < 256) dn_scan_block(ws, L, task >> 7, 0, (task >> 5) & 3, (task >> 4) & 1, task & 15, wave, lane); __syncthreads(); }
    GRID_BAR();
for (int rep_ = 0; rep_ < (PROBE_REP == 16 ? 2 : 1); ++rep_) {     for (int it = gw; it < 2048; it += NGW) dn_pass3_item(ws, it, lane); }
    GRID_BAR();
    }
    if constexpr ((PH_MASK >> 13) & 1) {
    const int lane = lane_opaque(); unsigned char* const ws = ptr_opaque(args.ws);
    for (int t = gw; t < S_; t += NGW) dn_post_token(args, ws, t, lane);
    moe_copy_loop<false>(args, ws, scr, gw, NGW, 14336, lane);
    GRID_BAR();
    }
    if constexpr ((PH_MASK >> 14) & 1) {
    const int lane = lane_opaque(); unsigned char* const ws = ptr_opaque(args.ws);
    { pg8::Gemm g{(const bf16*)(ws + WS_YCAT1), (const bf16*)(ws + WS_WOUT1), S_, D_, D_}; pg8::StaticOrder S; S.init(S_, D_, G, bx);
      pg8::EpiResF32 E{args.out, args.out, D_, nullptr, nullptr}; pg8::gemm_phase<pg8::EpiResF32, pg8::StaticOrder, true, true>(L, g, S, E, wave); }
    GRID_BAR();
    }
    if constexpr ((PH_MASK >> 15) & 1) {
    const int lane = lane_opaque(); unsigned char* const ws = ptr_opaque(args.ws);
    { RouterRegs RR; route_load(args, RR, lane); for (int tg = bx; tg < 256; tg += G) route_group(RR, ws, args.out, (LAS int*)L, tg, wave, lane); }
    GRID_BAR();
    }
    int tot[8], off[9]; moe_totals(ws0, lane_opaque(), tot); moe_offsets(tot, off);
    const int ntiles = off[8] >> 8;
    if constexpr ((PH_MASK >> 16) & 1) {
    const int lane = lane_opaque(); unsigned char* const ws = ptr_opaque(args.ws);
    {
        for (int tg = bx; tg < 256; tg += G) gather_group(args, ws, args.out, off, tg, wave, lane);
        const int tid2 = wave * 64 + lane;
        if (bx == 0 && tid2 < 160) { int e = 0;
#pragma unroll
            for (int k = 1; k < 8; ++k) if (tid2 * 256 >= off[k]) e = k;
            ((int*)(ws + WS_TILE))[tid2] = e; }
#pragma unroll
        for (int e = 0; e < NEXP; ++e) { const int r0 = off[e] + tot[e], r1 = off[e + 1];
            for (int rr = r0 + gw; rr < r1; rr += NGW) { unsigned long long* o8 = (unsigned long long*)(ws + WS_AMOE8 + (size_t)rr * D_) + lane;
#pragma unroll
                for (int j = 0; j < 2; ++j) o8[64 * j] = 0ull; } }
    }
    if constexpr (PROBE_REP == 20) {
    {
        for (int tg = bx; tg < 256; tg += G) gather_group(args, ws, args.out, off, tg, wave, lane);
        const int tid2 = wave * 64 + lane;
        if (bx == 0 && tid2 < 160) { int e = 0;
#pragma unroll
            for (int k = 1; k < 8; ++k) if (tid2 * 256 >= off[k]) e = k;
            ((int*)(ws + WS_TILE))[tid2] = e; }
#pragma unroll
        for (int e = 0; e < NEXP; ++e) { const int r0 = off[e] + tot[e], r1 = off[e + 1];
            for (int rr = r0 + gw; rr < r1; rr += NGW) { unsigned long long* o8 = (unsigned long long*)(ws + WS_AMOE8 + (size_t)rr * D_) + lane;
#pragma unroll
                for (int j = 0; j < 2; ++j) o8[64 * j] = 0ull; } }
    }
    }
    GRID_BAR();
    }
    if constexpr ((PH_MASK >> 17) & 1) {
    const int lane = lane_opaque(); unsigned char* const ws = ptr_opaque(args.ws);
    for (int b = 0; b < 3; ++b) {
        const int tlo = b * MOE_BATCH_TILES; int nt = ntiles - tlo; nt = nt < 0 ? 0 : (nt > MOE_BATCH_TILES ? MOE_BATCH_TILES : nt);
        { pg8::Gemm g{(const bf16*)(ws + WS_AMOE8), (const bf16*)(ws + WS_WMGU), MOE_ROWS, NEXP * 2 * FFE, D_ / 2};
          pg8::MoeOrder S{(const int*)(ws + WS_TILE), tlo, nt, 2 * FFE / 256, G, bx};
          pg8::EpiSwiGLU8 E{ws + WS_MACT - (size_t)tlo * 256 * FFE, FFE, 2 * FFE / 256, 1.0f / MOE_WSCALE};
          pg8::gemm_phase<pg8::EpiSwiGLU8, pg8::MoeOrder, true, true, true>(L, g, S, E, wave); }
        if constexpr (PROBE_REP == 21) {
        { pg8::Gemm g{(const bf16*)(ws + WS_AMOE8), (const bf16*)(ws + WS_WMGU), MOE_ROWS, NEXP * 2 * FFE, D_ / 2};
          pg8::MoeOrder S{(const int*)(ws + WS_TILE), tlo, nt, 2 * FFE / 256, G, bx};
          pg8::EpiSwiGLU8 E{ws + WS_MACT - (size_t)tlo * 256 * FFE, FFE, 2 * FFE / 256, 1.0f / MOE_WSCALE};
          pg8::gemm_phase<pg8::EpiSwiGLU8, pg8::MoeOrder, true, true, true>(L, g, S, E, wave); }
        }
        GRID_BAR();
        { pg8::Gemm g{(const bf16*)(ws + WS_MACT - (size_t)tlo * 256 * FFE), (const bf16*)(ws + WS_WMD), MOE_ROWS, NEXP * D_, FFE / 2};
          pg8::MoeOrder S{(const int*)(ws + WS_TILE), tlo, nt, D_ / 256, G, bx};
          pg8::EpiStoreBf16 E{(bf16*)(ws + WS_AMOE), D_, D_ / 256, nullptr, 1.0f / MOE_WSCALE};
          pg8::gemm_phase<pg8::EpiStoreBf16, pg8::MoeOrder, true, true, true>(L, g, S, E, wave); }
        if constexpr (PROBE_REP == 22) {
        { pg8::Gemm g{(const bf16*)(ws + WS_MACT - (size_t)tlo * 256 * FFE), (const bf16*)(ws + WS_WMD), MOE_ROWS, NEXP * D_, FFE / 2};
          pg8::MoeOrder S{(const int*)(ws + WS_TILE), tlo, nt, D_ / 256, G, bx};
          pg8::EpiStoreBf16 E{(bf16*)(ws + WS_AMOE), D_, D_ / 256, nullptr, 1.0f / MOE_WSCALE};
          pg8::gemm_phase<pg8::EpiStoreBf16, pg8::MoeOrder, true, true, true>(L, g, S, E, wave); }
        }
        GRID_BAR();
    }
    }
    if constexpr ((PH_MASK >> 18) & 1) {
    const int lane = lane_opaque(); unsigned char* const ws = ptr_opaque(args.ws);
    for (int t = gw; t < S_; t += NGW) combine_token(ws, args.out, off, t, lane);
#if PROBE
    {
        const unsigned* ts = (const unsigned*)(ws + WS_CTL) + 512;
        const unsigned dA = PROBE_A < 0 ? 32000u : (__hip_atomic_load(ts + PROBE_A, __ATOMIC_RELAXED, __HIP_MEMORY_SCOPE_AGENT) - __hip_atomic_load(ts + PROBE_A - 1, __ATOMIC_RELAXED, __HIP_MEMORY_SCOPE_AGENT));
        const unsigned dB = __hip_atomic_load(ts + PROBE_B, __ATOMIC_RELAXED, __HIP_MEMORY_SCOPE_AGENT) - __hip_atomic_load(ts + PROBE_B - 1, __ATOMIC_RELAXED, __HIP_MEMORY_SCOPE_AGENT);
        const int rows = 8 * (int)(dA / PROBE_BUCKET) + 64;
        const float addB = 4.0f * (float)(dB / PROBE_BUCKET) + 8.0f;
        for (int t = gw; t < S_; t += NGW) {
            if (t < rows) { f32x4* xo = (f32x4*)(args.out + (size_t)t * D_) + lane;
#pragma unroll
                for (int j = 0; j < 4; ++j) xo[64 * j] = xo[64 * j] + 5.0f; }
            if (t == S_ - 1 && lane == 63) args.out[(size_t)t * D_ + 1023] += addB;
        }
    }
#endif
    }
}

extern "C" void kernel_launch(void* const* d_in, const int* in_sizes, int n_in, void* d_out, int out_size, void* d_ws, size_t ws_size, hipStream_t stream) {
    static int grid = 0;
    if (grid == 0) {
        if (n_in != 39 || out_size != S_ * D_ || ws_size < WS_END) { fprintf(stderr, "kernel_launch: unexpected shapes (n_in %d out %d ws %zu)\n", n_in, out_size, ws_size); grid = -1; return; }
        int dev = 0, cus = 0, per_cu = 0;
        if (hipGetDevice(&dev) != hipSuccess || hipDeviceGetAttribute(&cus, hipDeviceAttributeMultiprocessorCount, dev) != hipSuccess) { grid = -1; return; }
        if (hipFuncSetAttribute((const void*)fwd_kernel, hipFuncAttributeMaxDynamicSharedMemorySize, LDS_BYTES) != hipSuccess) { grid = -1; return; }
        if (hipOccupancyMaxActiveBlocksPerMultiprocessor(&per_cu, (const void*)fwd_kernel, 512, LDS_BYTES) != hipSuccess || per_cu < 1) { fprintf(stderr, "kernel_launch: occupancy query says %d\n", per_cu); }
        (void)hipGetLastError();
        if (cus < 256) { fprintf(stderr, "kernel_launch: this build needs >= 256 CUs (task slots of the delta-net scan); got %d\n", cus); grid = -1; return; }
        grid = 256;
    }
    if (grid < 0) return;
    if (hipMemsetAsync((char*)d_ws + WS_CTL, 0, CTL_ZERO_BYTES, stream) != hipSuccess) return;
    Args a{};
    for (int i = 0; i < 39; ++i) a.in[i] = (const float*)d_in[i];
    a.out = (float*)d_out; a.ws = (unsigned char*)d_ws;
    hipLaunchKernelGGL(fwd_kernel, dim3(grid), dim3(512), LDS_BYTES, stream, a);
}
```
